# Optimizing an MI355X kernel written in HIP

```python
import math
import jax, jax.numpy as jnp
from jax import lax
import numpy as np

D_MODEL = 1024
BATCH = 8
SEQ = 2048
DEPTH = 2

HEAD_DIM = 64
N_MIX_GROUPS = 4
GROUP_WIDTH = D_MODEL // N_MIX_GROUPS
HEADS_PER_GROUP = GROUP_WIDTH // HEAD_DIM
D_MIX = GROUP_WIDTH * N_MIX_GROUPS
CHUNK = 64
Q_BLOCK = 128
CONV_W = 4
LRU_C = 8.0
MEM_LEN = 256
MEM_HEADS = 4
MEM_HEAD_DIM = 64
MEM_WIDTH = MEM_HEADS * MEM_HEAD_DIM
N_EXPERT_GROUPS = 4
EXPERTS_PER_GROUP = 8
N_EXPERTS = N_EXPERT_GROUPS * EXPERTS_PER_GROUP
TOP_K_IN_GROUP = 2
D_EXPERT = 256
EPS = 1e-6

COL_SIZES = (
    GROUP_WIDTH, GROUP_WIDTH, GROUP_WIDTH, GROUP_WIDTH,
    GROUP_WIDTH, GROUP_WIDTH, GROUP_WIDTH, HEADS_PER_GROUP,
    GROUP_WIDTH, GROUP_WIDTH,
    GROUP_WIDTH, GROUP_WIDTH, GROUP_WIDTH, HEADS_PER_GROUP, HEADS_PER_GROUP, GROUP_WIDTH,
)
N_IN = sum(COL_SIZES)

kernel_name = "hybrid_parallel_hgrn2_fox_rglru_gdn_hmoe"

F32 = jnp.float32


def _rmsnorm(x, g):
    xf = x.astype(F32)
    y = xf * lax.rsqrt(jnp.mean(xf * xf, axis=-1, keepdims=True) + EPS)
    return (y * g.astype(F32)).astype(x.dtype)


def _head_rms(x):
    return x * lax.rsqrt(jnp.mean(x * x, axis=-1, keepdims=True) + EPS)


def _l2norm(x):
    return x * lax.rsqrt(jnp.sum(x * x, axis=-1, keepdims=True) + EPS)


def _heads(t):
    b, s, w = t.shape
    return t.astype(F32).reshape(b, s, w // HEAD_DIM, HEAD_DIM)


def _causal_dwconv(x, w):
    c = x.shape[-1]
    return lax.conv_general_dilated(x, w[:, None, :], window_strides=(1,), padding=[(w.shape[0] - 1, 0)],
                                    dimension_numbers=('NWC', 'WIO', 'NWC'), feature_group_count=c)


def _to_chunks(t):
    b, s, h, d = t.shape
    return t.reshape(b, s // CHUNK, CHUNK, h, d).transpose(1, 0, 3, 2, 4)


def _from_chunks(t):
    n, b, h, c, d = t.shape
    return t.transpose(1, 0, 3, 2, 4).reshape(b, n * c, h, d)


def hgrn2_group(q, f_logit, i, g, lb):
    b, s, w = q.shape
    q = jax.nn.silu(_heads(q))
    fl = _heads(f_logit)
    lb = lb.astype(F32).reshape(HEADS_PER_GROUP, HEAD_DIM)
    log_f = jnp.logaddexp(jnp.log(lb), jnp.log1p(-lb) + jax.nn.log_sigmoid(fl))
    k = (1.0 - lb) * jax.nn.sigmoid(-fl)
    v = _heads(i)
    qc, kc, vc, lc = _to_chunks(q), _to_chunks(k), _to_chunks(v), _to_chunks(log_f)
    bc = jnp.cumsum(lc, axis=3)
    causal = jnp.tril(jnp.ones((CHUNK, CHUNK), bool))[:, :, None]

    def step(state, inp):
        qi, ki, vi, bi = inp
        diff = bi[:, :, :, None, :] - bi[:, :, None, :, :]
        decay = jnp.where(causal, jnp.exp(jnp.where(causal, diff, 0.0)), 0.0)
        scores = jnp.einsum('bhtk,bhsk,bhtsk->bhts', qi, ki, decay)
        o = jnp.einsum('bhts,bhsv->bhtv', scores, vi) + jnp.einsum('bhtk,bhkv->bhtv', qi * jnp.exp(bi), state)
        b_last = bi[:, :, -1:, :]
        state = jnp.exp(b_last[:, :, 0, :, None]) * state + jnp.einsum('bhsk,bhsv->bhkv', ki * jnp.exp(b_last - bi), vi)
        return state, o

    s0 = jnp.zeros((b, HEADS_PER_GROUP, HEAD_DIM, HEAD_DIM), F32)
    _, o = lax.scan(step, s0, (qc, kc, vc, bc))
    o = _from_chunks(o)
    y = _head_rms(o) * jax.nn.silu(_heads(g))
    return y.reshape(b, s, w)


def fox_group(q, k, v, f_logit, f_bias):
    b, s, w = q.shape
    q, k, v = _heads(q), _heads(k), _heads(v)
    log_f = jax.nn.log_sigmoid(f_logit.astype(F32) + f_bias.astype(F32))
    c = jnp.cumsum(log_f, axis=1).transpose(0, 2, 1)
    nb = s // Q_BLOCK
    qb = q.reshape(b, nb, Q_BLOCK, HEADS_PER_GROUP, HEAD_DIM).transpose(1, 0, 2, 3, 4)
    cb = c.reshape(b, HEADS_PER_GROUP, nb, Q_BLOCK).transpose(2, 0, 1, 3)
    qpos = jnp.arange(s).reshape(nb, Q_BLOCK)
    kpos = jnp.arange(s)
    scale = HEAD_DIM ** -0.5

    def block(args):
        qi, ci, pi = args
        sc = jnp.einsum('bqhd,bkhd->bhqk', qi, k) * scale + (ci[..., :, None] - c[:, :, None, :])
        sc = jnp.where(pi[:, None] >= kpos[None, :], sc, -jnp.inf)
        p = jax.nn.softmax(sc, axis=-1)
        return jnp.einsum('bhqk,bkhd->bqhd', p, v)

    o = lax.map(block, (qb, cb, qpos))
    o = o.transpose(1, 0, 2, 3, 4).reshape(b, s, HEADS_PER_GROUP, HEAD_DIM)
    return _head_rms(o).reshape(b, s, w)


def rglru_group(xb, gate, conv_w, conv_b, w_a, b_a, w_x, b_x, lam):
    b, s, w = xb.shape
    xc = _causal_dwconv(xb.astype(F32), conv_w.astype(F32)) + conv_b.astype(F32)
    xh = xc.reshape(b, s, HEADS_PER_GROUP, HEAD_DIM)
    r = jax.nn.sigmoid(jnp.einsum('bshi,hij->bshj', xh, w_a.astype(F32)).reshape(b, s, w) + b_a.astype(F32))
    ig = jax.nn.sigmoid(jnp.einsum('bshi,hij->bshj', xh, w_x.astype(F32)).reshape(b, s, w) + b_x.astype(F32))
    log_a = -LRU_C * r * jax.nn.softplus(-lam.astype(F32))
    a = jnp.exp(log_a)
    u = jnp.sqrt(-jnp.expm1(2.0 * log_a)) * (ig * xc)

    def combine(left, right):
        a_l, u_l = left
        a_r, u_r = right
        return a_l * a_r, a_r * u_l + u_r

    _, h = lax.associative_scan(combine, (a, u), axis=1)
    y = h * jax.nn.gelu(gate.astype(F32))
    return _head_rms(y.reshape(b, s, HEADS_PER_GROUP, HEAD_DIM)).reshape(b, s, w)


def gdn_group(q, k, v, beta_logit, a_logit, z, conv_w, a_log, dt_bias):
    b, s, w = q.shape
    qkv = jax.nn.silu(_causal_dwconv(jnp.concatenate([q, k, v], axis=-1).astype(F32), conv_w.astype(F32)))
    q, k, v = [_heads(t) for t in jnp.split(qkv, 3, axis=-1)]
    q = _l2norm(q) * HEAD_DIM ** -0.5
    k = _l2norm(k)
    beta = jax.nn.sigmoid(beta_logit.astype(F32))
    g = -jnp.exp(a_log.astype(F32)) * jax.nn.softplus(a_logit.astype(F32) + dt_bias.astype(F32))
    qc, kc, vc = _to_chunks(q), _to_chunks(k), _to_chunks(v)
    bc = _to_chunks(beta[..., None])[..., 0]
    G = jnp.cumsum(_to_chunks(g[..., None])[..., 0], axis=-1)
    incl = jnp.tril(jnp.ones((CHUNK, CHUNK), bool))
    strict = jnp.tril(jnp.ones((CHUNK, CHUNK), bool), -1)
    diff = G[..., :, None] - G[..., None, :]
    gamma = jnp.where(incl, jnp.exp(jnp.where(incl, diff, 0.0)), 0.0)
    k_beta = kc * bc[..., None]
    m = jnp.where(strict, jnp.einsum('...tk,...sk->...ts', k_beta, kc) * gamma, 0.0)
    eye = jnp.eye(CHUNK, dtype=F32)
    t_inv = lax.linalg.triangular_solve(eye + m, jnp.broadcast_to(eye, m.shape), left_side=True, lower=True)
    u = t_inv @ (vc * bc[..., None])
    wk = t_inv @ (k_beta * jnp.exp(G)[..., None])
    a_qk = jnp.einsum('...tk,...sk->...ts', qc, kc) * gamma
    q_dec = qc * jnp.exp(G)[..., None]
    k_dec = kc * jnp.exp(G[..., -1:] - G)[..., None]
    g_last = jnp.exp(G[..., -1])

    def step(state, inp):
        ui, wi, aqi, qdi, kdi, gli = inp
        v_new = ui - wi @ state
        o = qdi @ state + aqi @ v_new
        state = gli[..., None, None] * state + jnp.einsum('bhsk,bhsv->bhkv', kdi, v_new)
        return state, o

    s0 = jnp.zeros((b, HEADS_PER_GROUP, HEAD_DIM, HEAD_DIM), F32)
    _, o = lax.scan(step, s0, (u, wk, a_qk, q_dec, k_dec, g_last))
    o = _from_chunks(o)
    y = _head_rms(o) * jax.nn.silu(_heads(z))
    return y.reshape(b, s, w)


def mem_cross_attention(h, memn, w_q, w_kv, w_o):
    b, s, _ = h.shape
    q = (h @ w_q).reshape(b, s, MEM_HEADS, MEM_HEAD_DIM)
    k, v = jnp.split(memn @ w_kv, 2, axis=-1)
    k = k.reshape(b, MEM_LEN, MEM_HEADS, MEM_HEAD_DIM)
    v = v.reshape(b, MEM_LEN, MEM_HEADS, MEM_HEAD_DIM)
    sc = jnp.einsum('bshd,bmhd->bhsm', q, k).astype(F32) * MEM_HEAD_DIM ** -0.5
    p = jax.nn.softmax(sc, axis=-1).astype(v.dtype)
    o = jnp.einsum('bhsm,bmhd->bshd', p, v).reshape(b, s, MEM_WIDTH)
    return o @ w_o


def hier_moe(h, w_rg, b_rg, w_re, b_re, w_gu, w_dn):
    b, s, d = h.shape
    ht = h.reshape(-1, d)
    t = ht.shape[0]
    grp_prob = jax.nn.softmax((ht @ w_rg + b_rg).astype(F32), axis=-1)
    p_grp, g_sel = lax.top_k(grp_prob, 1)
    exp_logits = (ht @ w_re + b_re).astype(F32).reshape(t, N_EXPERT_GROUPS, EXPERTS_PER_GROUP)
    sel = jnp.take_along_axis(exp_logits, g_sel[:, :, None], axis=1)[:, 0]
    w_top, i_top = lax.top_k(jax.nn.softmax(sel, axis=-1), TOP_K_IN_GROUP)
    w_top = w_top / jnp.sum(w_top, axis=-1, keepdims=True)
    gates = p_grp * w_top
    idx = g_sel * EXPERTS_PER_GROUP + i_top
    combine = jnp.sum(jax.nn.one_hot(idx, N_EXPERTS, dtype=F32) * gates[..., None], axis=1).astype(h.dtype)
    out = jnp.zeros_like(ht)
    for gi in range(N_EXPERT_GROUPS):
        sl = slice(gi * EXPERTS_PER_GROUP, (gi + 1) * EXPERTS_PER_GROUP)
        gu = jnp.einsum('td,edf->tef', ht, w_gu[sl])
        g_act, up = jnp.split(gu, 2, axis=-1)
        act = jax.nn.silu(g_act) * up * combine[:, sl, None]
        out = out + jnp.einsum('tef,efd->td', act, w_dn[sl])
    return out.reshape(b, s, d)


def setup_inputs(seed: int = 0) -> dict:
    key = jax.random.key(seed)
    ks = jax.random.split(key, 34)
    L, H = DEPTH, HEADS_PER_GROUP

    def nrm(k, shape, scale):
        return scale * jax.random.normal(k, shape, F32)

    def gain(k, shape):
        return 1.0 + nrm(k, shape, 0.02)

    lru_u = jax.random.uniform(ks[12], (L, GROUP_WIDTH), F32, minval=0.9, maxval=0.999)
    dt = jnp.exp(jax.random.uniform(ks[15], (L, H), F32, minval=math.log(1e-3), maxval=math.log(1e-1)))
    return {
        "x": nrm(ks[0], (BATCH, SEQ, D_MODEL), 1.0),
        "mem": nrm(ks[1], (BATCH, MEM_LEN, D_MODEL), 1.0),
        "norm_mix": gain(ks[2], (L, D_MODEL)),
        "w_in": nrm(ks[3], (L, D_MODEL, N_IN), D_MODEL ** -0.5),
        "hgrn_lb": nrm(ks[4], (L, GROUP_WIDTH), 0.1),
        "fox_fb": 2.0 + nrm(ks[5], (L, H), 0.5),
        "lru_conv_w": nrm(ks[6], (L, CONV_W, GROUP_WIDTH), CONV_W ** -0.5),
        "lru_conv_b": nrm(ks[7], (L, GROUP_WIDTH), 0.01),
        "lru_wa": nrm(ks[8], (L, H, HEAD_DIM, HEAD_DIM), HEAD_DIM ** -0.5),
        "lru_ba": nrm(ks[9], (L, GROUP_WIDTH), 0.01),
        "lru_wx": nrm(ks[10], (L, H, HEAD_DIM, HEAD_DIM), HEAD_DIM ** -0.5),
        "lru_bx": nrm(ks[11], (L, GROUP_WIDTH), 0.01),
        "lru_lam": jnp.log(lru_u) - jnp.log1p(-lru_u),
        "gdn_conv_w": nrm(ks[13], (L, CONV_W, 3 * GROUP_WIDTH), CONV_W ** -0.5),
        "gdn_a_log": jnp.log(jax.random.uniform(ks[14], (L, H), F32, minval=1.0, maxval=16.0)),
        "gdn_dt_bias": dt + jnp.log(-jnp.expm1(-dt)),
        "mix_gain": gain(ks[16], (L, D_MIX)),
        "w_out": nrm(ks[17], (L, D_MIX, D_MODEL), D_MIX ** -0.5),
        "norm_mem": gain(ks[18], (L, D_MODEL)),
        "norm_memkv": gain(ks[19], (L, D_MODEL)),
        "w_mq": nrm(ks[20], (L, D_MODEL, MEM_WIDTH), D_MODEL ** -0.5),
        "w_mkv": nrm(ks[21], (L, D_MODEL, 2 * MEM_WIDTH), D_MODEL ** -0.5),
        "w_mo": nrm(ks[22], (L, MEM_WIDTH, D_MODEL), MEM_WIDTH ** -0.5),
        "norm_ffn": gain(ks[23], (L, D_MODEL)),
        "w_rg": nrm(ks[24], (L, D_MODEL, N_EXPERT_GROUPS), D_MODEL ** -0.5),
        "b_rg": nrm(ks[25], (L, N_EXPERT_GROUPS), 0.01),
        "w_re": nrm(ks[26], (L, D_MODEL, N_EXPERTS), D_MODEL ** -0.5),
        "b_re": nrm(ks[27], (L, N_EXPERTS), 0.01),
        "w_e_gu": nrm(ks[28], (L, N_EXPERTS, D_MODEL, 2 * D_EXPERT), D_MODEL ** -0.5),
        "w_e_dn": nrm(ks[29], (L, N_EXPERTS, D_EXPERT, D_MODEL), D_EXPERT ** -0.5),
        "norm_final": gain(ks[30], (D_MODEL,)),
    }


def reference(x, mem, norm_mix, w_in, hgrn_lb, fox_fb, lru_conv_w, lru_conv_b, lru_wa, lru_ba, lru_wx, lru_bx,
              lru_lam, gdn_conv_w, gdn_a_log, gdn_dt_bias, mix_gain, w_out, norm_mem, norm_memkv, w_mq, w_mkv,
              w_mo, norm_ffn, w_rg, b_rg, w_re, b_re, w_e_gu, w_e_dn, norm_final):
    lb_all = jnp.cumsum(jax.nn.softmax(hgrn_lb.astype(F32), axis=0), axis=0)
    lb_all = lb_all - lb_all[0]
    split_at = np.cumsum(COL_SIZES)[:-1].tolist()
    for l in range(DEPTH):
        h = _rmsnorm(x, norm_mix[l])
        parts = jnp.split(h @ w_in[l], split_at, axis=-1)
        (a_q, a_f, a_i, a_g, b_q, b_k, b_v, b_f, c_x, c_g, d_q, d_k, d_v, d_b, d_a, d_z) = parts
        y_a = hgrn2_group(a_q, a_f, a_i, a_g, lb_all[l])
        y_b = fox_group(b_q, b_k, b_v, b_f, fox_fb[l])
        y_c = rglru_group(c_x, c_g, lru_conv_w[l], lru_conv_b[l], lru_wa[l], lru_ba[l], lru_wx[l], lru_bx[l], lru_lam[l])
        y_d = gdn_group(d_q, d_k, d_v, d_b, d_a, d_z, gdn_conv_w[l], gdn_a_log[l], gdn_dt_bias[l])
        y = jnp.concatenate([y_a, y_b, y_c, y_d], axis=-1) * mix_gain[l].astype(F32)
        x = x + y.astype(x.dtype) @ w_out[l]
        h = _rmsnorm(x, norm_mem[l])
        memn = _rmsnorm(mem, norm_memkv[l])
        x = x + mem_cross_attention(h, memn, w_mq[l], w_mkv[l], w_mo[l])
        h = _rmsnorm(x, norm_ffn[l])
        x = x + hier_moe(h, w_rg[l], b_rg[l], w_re[l], b_re[l], w_e_gu[l], w_e_dn[l])
    return _rmsnorm(x, norm_final)
```

```cpp
#include <hip/hip_runtime.h>
#include <stdint.h>
#include <stdio.h>

typedef unsigned short bf16_t;
typedef short bf16x8 __attribute__((ext_vector_type(8)));
typedef float f32x4 __attribute__((ext_vector_type(4)));
typedef unsigned u32x4 __attribute__((ext_vector_type(4)));

constexpr int NB = 8, SEQ = 2048, DM = 1024, T = NB * SEQ, NL = 2;
constexpr int NP = 3456;
constexpr int NIN = 3340;
constexpr int C_AQ = 0, C_AF = 256, C_AI = 512, C_AG = 768, C_BQ = 1024, C_BK = 1280, C_BV = 1536, C_CX = 1792, C_CG = 2048,
              C_DQ = 2304, C_DK = 2560, C_DV = 2816, C_DZ = 3072, C_GATE = 3328;
constexpr int MEMLEN = 256;
constexpr int NEXP = 32, DEXP = 256;
constexpr float EPS = 1e-6f;

constexpr size_t al256(size_t x) { return (x + 255) & ~(size_t)255; }
constexpr size_t SZ_WIN = (size_t)NP * 1024 * 2, SZ_WOUT = (size_t)1024 * 1024 * 2, SZ_WMQ = (size_t)256 * 1024 * 2, SZ_WMKV = (size_t)512 * 1024 * 2,
                 SZ_WMO = (size_t)1024 * 256 * 2, SZ_WGU = (size_t)32 * 512 * 1024 * 2, SZ_WDN = (size_t)32 * 1024 * 256 * 2;
constexpr size_t OFF_WIN = 0;
constexpr size_t OFF_WOUT = OFF_WIN + NL * SZ_WIN;
constexpr size_t OFF_WMQ = OFF_WOUT + NL * SZ_WOUT;
constexpr size_t OFF_WMKV = OFF_WMQ + NL * SZ_WMQ;
constexpr size_t OFF_WMO = OFF_WMKV + NL * SZ_WMKV;
constexpr size_t OFF_WGU = OFF_WMO + NL * SZ_WMO;
constexpr size_t OFF_WDN = OFF_WGU + NL * SZ_WGU;
constexpr size_t OFF_HN = OFF_WDN + NL * SZ_WDN;
constexpr size_t OFF_PROJ = OFF_HN + (size_t)T * 1024 * 2;
constexpr size_t OFF_GATES = OFF_PROJ + (size_t)T * NP * 2;
constexpr size_t OFF_Y = OFF_GATES + (size_t)T * 16 * 4;
constexpr size_t OFF_XB = OFF_Y + (size_t)T * 1024 * 2;
constexpr size_t OFF_QM = OFF_XB + (size_t)T * 1024 * 4;
constexpr size_t OFF_OM = OFF_QM + (size_t)T * 256 * 2;
constexpr size_t OFF_KVM = OFF_OM + (size_t)T * 256 * 2;
constexpr size_t OFF_MEMN = OFF_KVM + (size_t)NL * 2048 * 512 * 2;
constexpr size_t OFF_FOXC = OFF_MEMN + (size_t)2048 * 1024 * 2;
constexpr size_t OFF_LRUA = OFF_FOXC + (size_t)NB * 4 * SEQ * 4;
constexpr size_t OFF_LRUU = OFF_LRUA + (size_t)T * 256 * 4;
constexpr size_t OFF_CNT = OFF_LRUU + (size_t)T * 256 * 4;
constexpr size_t OFF_LIST = OFF_CNT + 256;
constexpr size_t OFF_PGATE = OFF_LIST + (size_t)NEXP * T * 4;
constexpr size_t OFF_END = OFF_PGATE + (size_t)2 * T * 4;
constexpr size_t OFF_ACT = OFF_PROJ;
constexpr size_t OFF_EO = OFF_PROJ + (size_t)2 * T * 256 * 2;
static_assert(OFF_EO + (size_t)2 * T * 1024 * 2 <= OFF_GATES, "overlay fits");

__device__ __forceinline__ float bf2f(bf16_t v) { return __uint_as_float(((unsigned)v) << 16); }
__device__ __forceinline__ bf16_t f2bf(float f) { unsigned u = __float_as_uint(f); return (bf16_t)((u + 0x7fffu + ((u >> 16) & 1u)) >> 16); }
__device__ __forceinline__ unsigned pk2(float lo, float hi) { return (unsigned)f2bf(lo) | ((unsigned)f2bf(hi) << 16); }
__device__ __forceinline__ float sigmoidf_(float x) { return 1.f / (1.f + __expf(-x)); }
__device__ __forceinline__ float siluf_(float x) { return x / (1.f + __expf(-x)); }
__device__ __forceinline__ float softplusf_(float x) { return x > 20.f ? x : log1pf(__expf(x)); }
__device__ __forceinline__ float logsigmoidf_(float x) { return x < 0.f ? x - log1pf(__expf(x)) : -log1pf(__expf(-x)); }
__device__ __forceinline__ float geluf_(float x) { float u = 0.7978845608028654f * (x + 0.044715f * x * x * x); return 0.5f * x * (1.f + tanhf(u)); }
__device__ __forceinline__ float wave_sum(float v) {
#pragma unroll
    for (int o = 1; o < 64; o <<= 1) v += __shfl_xor(v, o);
    return v;
}
__device__ __forceinline__ float rdlane(float v, int l) { return __int_as_float(__builtin_amdgcn_readlane(__float_as_int(v), l)); }

__device__ __forceinline__ int rowmap_fn(int mode, int n) {
    if (mode == 1) {
        if (n < 1792) return n;
        if (n < 1796) return C_GATE + (n - 1792);
        if (n < 3076) return n - 4;
        if (n < 3084) return C_GATE + 4 + (n - 3076);
        return n - 12;
    } else if (mode == 2) {
        int j = n & 255; return (j >> 4) * 32 + ((n >= 256) ? 16 : 0) + (j & 15);
    }
    return n;
}
__global__ void __launch_bounds__(256) convT_kernel(const float* __restrict__ src, int K, int N, bf16_t* __restrict__ dst, int mode, size_t src_stride, size_t dst_stride) {
    __shared__ float tile[64][65];
    const int mat = blockIdx.z;
    src += (size_t)mat * src_stride; dst += (size_t)mat * dst_stride;
    const int n0 = blockIdx.x * 64, k0 = blockIdx.y * 64;
    const int tx = threadIdx.x & 63, ty = threadIdx.x >> 6;
#pragma unroll
    for (int i = 0; i < 16; ++i) {
        int k = ty + i * 4; int n = n0 + tx;
        tile[k][tx] = (n < N) ? src[(size_t)(k0 + k) * N + n] : 0.f;
    }
    __syncthreads();
    const int kx = threadIdx.x & 31, ny = threadIdx.x >> 5;
#pragma unroll
    for (int i = 0; i < 8; ++i) {
        int nl = ny + i * 8; int n = n0 + nl;
        if (n < N) {
            int r = rowmap_fn(mode, n);
            *(unsigned*)(dst + (size_t)r * K + k0 + 2 * kx) = pk2(tile[2 * kx][nl], tile[2 * kx + 1][nl]);
        }
    }
}
__global__ void zero_kernel(unsigned* p, size_t nwords) {
    size_t i = (size_t)blockIdx.x * blockDim.x + threadIdx.x;
    if (i < nwords) p[i] = 0u;
}

__global__ void __launch_bounds__(256) rmsnorm_bf16_kernel(const float* __restrict__ x, const float* __restrict__ g, bf16_t* __restrict__ out, int rows) {
    const int row = blockIdx.x * 4 + (threadIdx.x >> 6), lane = threadIdx.x & 63;
    if (row >= rows) return;
    const f32x4* xr = (const f32x4*)(x + (size_t)row * 1024) + lane;
    f32x4 v[4]; float s = 0.f;
#pragma unroll
    for (int j = 0; j < 4; ++j) { v[j] = xr[64 * j]; s += v[j].x * v[j].x + v[j].y * v[j].y + v[j].z * v[j].z + v[j].w * v[j].w; }
    const float rinv = rsqrtf(wave_sum(s) * (1.f / 1024.f) + EPS);
#pragma unroll
    for (int j = 0; j < 4; ++j) {
        f32x4 gg = ((const f32x4*)g)[lane + 64 * j];
        uint2 o; o.x = pk2(v[j].x * rinv * gg.x, v[j].y * rinv * gg.y); o.y = pk2(v[j].z * rinv * gg.z, v[j].w * rinv * gg.w);
        *(uint2*)(out + (size_t)row * 1024 + (lane + 64 * j) * 4) = o;
    }
}
__global__ void __launch_bounds__(256) rmsnorm_f32_kernel(const float* __restrict__ x, const float* __restrict__ g, float* __restrict__ out, int rows) {
    const int row = blockIdx.x * 4 + (threadIdx.x >> 6), lane = threadIdx.x & 63;
    if (row >= rows) return;
    const f32x4* xr = (const f32x4*)(x + (size_t)row * 1024) + lane;
    f32x4 v[4]; float s = 0.f;
#pragma unroll
    for (int j = 0; j < 4; ++j) { v[j] = xr[64 * j]; s += v[j].x * v[j].x + v[j].y * v[j].y + v[j].z * v[j].z + v[j].w * v[j].w; }
    const float rinv = rsqrtf(wave_sum(s) * (1.f / 1024.f) + EPS);
#pragma unroll
    for (int j = 0; j < 4; ++j) {
        f32x4 gg = ((const f32x4*)g)[lane + 64 * j];
        f32x4 o = v[j] * rinv * gg;
        ((f32x4*)(out + (size_t)row * 1024))[lane + 64 * j] = o;
    }
}

constexpr int GLD = 72;
constexpr int GEMM_LDS = 2 * 128 * GLD * 2;
template <class RowPtr>
__device__ __forceinline__ void gemm_tile_128(char* smem, RowPtr rowptr, const bf16_t* __restrict__ Bt, int ldb, int n0, int K, f32x4 (&acc)[4][4]) {
    bf16_t* sA = (bf16_t*)smem; bf16_t* sB = sA + 128 * GLD;
    const int tid = threadIdx.x, lane = tid & 63, wave = tid >> 6, wm = wave >> 1, wn = wave & 1;
    const u32x4* ga[4]; const u32x4* gb[4];
#pragma unroll
    for (int i = 0; i < 4; ++i) {
        int c = tid + i * 256, r = c >> 3, ch = c & 7;
        ga[i] = (const u32x4*)(rowptr(r) + ch * 8);
        gb[i] = (const u32x4*)(Bt + (size_t)(n0 + r) * ldb + ch * 8);
    }
#pragma unroll
    for (int m = 0; m < 4; ++m)
#pragma unroll
        for (int n = 0; n < 4; ++n) acc[m][n] = (f32x4){0.f, 0.f, 0.f, 0.f};
    u32x4 ra[4], rb[4];
#pragma unroll
    for (int i = 0; i < 4; ++i) { ra[i] = ga[i][0]; rb[i] = gb[i][0]; }
    const int nk = K / 64;
    for (int kt = 0; kt < nk; ++kt) {
        __syncthreads();
#pragma unroll
        for (int i = 0; i < 4; ++i) {
            int c = tid + i * 256, r = c >> 3, ch = c & 7;
            *(u32x4*)(sA + r * GLD + ch * 8) = ra[i];
            *(u32x4*)(sB + r * GLD + ch * 8) = rb[i];
        }
        __syncthreads();
        if (kt + 1 < nk) {
#pragma unroll
            for (int i = 0; i < 4; ++i) { ra[i] = ga[i][(kt + 1) * 8]; rb[i] = gb[i][(kt + 1) * 8]; }
        }
#pragma unroll
        for (int kk = 0; kk < 2; ++kk) {
            bf16x8 af[4], bfr[4];
#pragma unroll
            for (int m = 0; m < 4; ++m) af[m] = *(const bf16x8*)(sA + (wm * 64 + m * 16 + (lane & 15)) * GLD + kk * 32 + (lane >> 4) * 8);
#pragma unroll
            for (int n = 0; n < 4; ++n) bfr[n] = *(const bf16x8*)(sB + (wn * 64 + n * 16 + (lane & 15)) * GLD + kk * 32 + (lane >> 4) * 8);
#pragma unroll
            for (int m = 0; m < 4; ++m)
#pragma unroll
                for (int n = 0; n < 4; ++n) acc[m][n] = __builtin_amdgcn_mfma_f32_16x16x32_bf16(bfr[n], af[m], acc[m][n], 0, 0, 0);
        }
    }
}

struct RowDirect { const bf16_t* A; int lda; int m0; __device__ __forceinline__ const bf16_t* operator()(int r) const { return A + (size_t)(m0 + r) * lda; } };

enum { EPI_INPROJ = 0, EPI_RESID = 1, EPI_BF16 = 2 };
struct GemmP { const bf16_t* A; const bf16_t* Bt; void* out; const float* resid; float* gates; int lda, ldb, K, ldo; };
static_assert(sizeof(GemmP) == 56, "no padding");

template <int EPI>
__global__ void __launch_bounds__(256) gemm_kernel(GemmP p) {
    __shared__ __attribute__((aligned(16))) char smem[GEMM_LDS];
    const int n0 = blockIdx.x * 128, m0 = blockIdx.y * 128;
    f32x4 acc[4][4];
    RowDirect rp{p.A, p.lda, m0};
    gemm_tile_128(smem, rp, p.Bt, p.ldb, n0, p.K, acc);
    const int lane = threadIdx.x & 63, wave = threadIdx.x >> 6, wm = wave >> 1, wn = wave & 1;
#pragma unroll
    for (int m = 0; m < 4; ++m)
#pragma unroll
        for (int n = 0; n < 4; ++n) {
            const int row = m0 + wm * 64 + m * 16 + (lane & 15), col = n0 + wn * 64 + n * 16 + (lane >> 4) * 4;
            const f32x4 v = acc[m][n];
            if (EPI == EPI_INPROJ) {
                uint2 o; o.x = pk2(v.x, v.y); o.y = pk2(v.z, v.w);
                *(uint2*)((bf16_t*)p.out + (size_t)row * p.ldo + col) = o;
                if (col >= C_GATE && col < C_GATE + 16) *(f32x4*)(p.gates + (size_t)row * 16 + (col - C_GATE)) = v;
            } else if (EPI == EPI_RESID) {
                const f32x4 r = *(const f32x4*)(p.resid + (size_t)row * p.ldo + col);
                *(f32x4*)((float*)p.out + (size_t)row * p.ldo + col) = r + v;
            } else {
                uint2 o; o.x = pk2(v.x, v.y); o.y = pk2(v.z, v.w);
                *(uint2*)((bf16_t*)p.out + (size_t)row * p.ldo + col) = o;
            }
        }
}

struct MoeP { const bf16_t* A; const bf16_t* Wt; const int* cnt; const int* list; const float* pgate; bf16_t* out; size_t wstride; int lda, ldb, K, pad; };
static_assert(sizeof(MoeP) == 72, "no padding");
struct RowGather { const bf16_t* A; int lda; const int* ids; int shift; __device__ __forceinline__ const bf16_t* operator()(int r) const { return A + (size_t)(ids[r] >> shift) * lda; } };

template <int STAGE>
__global__ void __launch_bounds__(256) moe_gemm_kernel(MoeP p) {
    __shared__ __attribute__((aligned(16))) char smem[GEMM_LDS];
    __shared__ int ids[128];
    int e = -1, mt = 0; { int acc_t = 0; const int want = blockIdx.y;
        for (int i = 0; i < NEXP; ++i) { int nt = (p.cnt[i] + 127) >> 7; if (want < acc_t + nt) { e = i; mt = want - acc_t; break; } acc_t += nt; } }
    if (e < 0) return;
    const int cnt = p.cnt[e];
    if (threadIdx.x < 128) { int pos = mt * 128 + threadIdx.x; ids[threadIdx.x] = p.list[(size_t)e * T + (pos < cnt ? pos : cnt - 1)]; }
    __syncthreads();
    const int n0 = blockIdx.x * 128;
    f32x4 acc[4][4];
    RowGather rp{p.A, p.lda, ids, STAGE == 1 ? 1 : 0};
    gemm_tile_128(smem, rp, p.Wt + (size_t)e * p.wstride, p.ldb, n0, p.K, acc);
    const int lane = threadIdx.x & 63, wave = threadIdx.x >> 6, wm = wave >> 1, wn = wave & 1;
#pragma unroll
    for (int m = 0; m < 4; ++m) {
        const int rl = wm * 64 + m * 16 + (lane & 15);
        if (mt * 128 + rl >= cnt) continue;
        const int pid = ids[rl];
        if (STAGE == 1) {
            const float gt = p.pgate[pid];
#pragma unroll
            for (int np = 0; np < 2; ++np) {
                const f32x4 g = acc[m][2 * np], u = acc[m][2 * np + 1];
                const int j = (n0 + wn * 64 + np * 32) / 2 + (lane >> 4) * 4;
                uint2 o; o.x = pk2(siluf_(g.x) * u.x * gt, siluf_(g.y) * u.y * gt); o.y = pk2(siluf_(g.z) * u.z * gt, siluf_(g.w) * u.w * gt);
                *(uint2*)(p.out + (size_t)pid * DEXP + j) = o;
            }
        } else {
#pragma unroll
            for (int n = 0; n < 4; ++n) {
                const f32x4 v = acc[m][n]; const int col = n0 + wn * 64 + n * 16 + (lane >> 4) * 4;
                uint2 o; o.x = pk2(v.x, v.y); o.y = pk2(v.z, v.w);
                *(uint2*)(p.out + (size_t)pid * 1024 + col) = o;
            }
        }
    }
}

__global__ void __launch_bounds__(64) hgrn2_naive_kernel(const bf16_t* __restrict__ proj, const float* __restrict__ hgrn_lb, int layer, const float* __restrict__ mix_gain, bf16_t* __restrict__ y) {
    const int b = blockIdx.x >> 2, h = blockIdx.x & 3, lane = threadIdx.x;
    float lbk = 0.f;
    if (layer == 1) { float a0 = hgrn_lb[h * 64 + lane], a1 = hgrn_lb[256 + h * 64 + lane]; lbk = 1.f / (1.f + __expf(a0 - a1)); }
    const float mg = mix_gain[C_AQ + h * 64 + lane];
    float S[64];
#pragma unroll
    for (int k = 0; k < 64; ++k) S[k] = 0.f;
    for (int t = 0; t < SEQ; ++t) {
        const bf16_t* pr = proj + (size_t)(b * SEQ + t) * NP + h * 64 + lane;
        const float qk = siluf_(bf2f(pr[C_AQ]));
        const float sg = sigmoidf_(bf2f(pr[C_AF]));
        const float f = lbk + (1.f - lbk) * sg, kk = (1.f - lbk) * (1.f - sg);
        const float iv = bf2f(pr[C_AI]);
        const float gv = bf2f(pr[C_AG]);
        float o = 0.f;
#pragma unroll
        for (int k = 0; k < 64; ++k) { S[k] = rdlane(f, k) * S[k] + rdlane(kk, k) * iv; o += rdlane(qk, k) * S[k]; }
        const float ms = wave_sum(o * o) * (1.f / 64.f);
        const float yv = o * rsqrtf(ms + EPS) * siluf_(gv) * mg;
        y[(size_t)(b * SEQ + t) * 1024 + 0 + h * 64 + lane] = f2bf(yv);
    }
}

__global__ void __launch_bounds__(64) gdn_naive_kernel(const bf16_t* __restrict__ proj, const float* __restrict__ gates, const float* __restrict__ conv_w  ,
                                                     const float* __restrict__ a_log, const float* __restrict__ dt_bias, const float* __restrict__ mix_gain, bf16_t* __restrict__ y) {
    const int b = blockIdx.x >> 2, h = blockIdx.x & 3, lane = threadIdx.x;
    float wq[4], wk[4], wv[4];
#pragma unroll
    for (int j = 0; j < 4; ++j) { wq[j] = conv_w[j * 768 + h * 64 + lane]; wk[j] = conv_w[j * 768 + 256 + h * 64 + lane]; wv[j] = conv_w[j * 768 + 512 + h * 64 + lane]; }
    float xq[3] = {0.f, 0.f, 0.f}, xk[3] = {0.f, 0.f, 0.f}, xv[3] = {0.f, 0.f, 0.f};
    const float Aexp = __expf(a_log[h]), dtb = dt_bias[h];
    const float mg = mix_gain[768 + h * 64 + lane];
    float S[64];
#pragma unroll
    for (int k = 0; k < 64; ++k) S[k] = 0.f;
    for (int t = 0; t < SEQ; ++t) {
        const size_t row = (size_t)(b * SEQ + t);
        const bf16_t* pr = proj + row * NP + h * 64 + lane;
        const float q0 = bf2f(pr[C_DQ]), k0 = bf2f(pr[C_DK]), v0 = bf2f(pr[C_DV]), zv = bf2f(pr[C_DZ]);
        float q = siluf_(wq[0] * xq[0] + wq[1] * xq[1] + wq[2] * xq[2] + wq[3] * q0);
        float k = siluf_(wk[0] * xk[0] + wk[1] * xk[1] + wk[2] * xk[2] + wk[3] * k0);
        float v = siluf_(wv[0] * xv[0] + wv[1] * xv[1] + wv[2] * xv[2] + wv[3] * v0);
        xq[0] = xq[1]; xq[1] = xq[2]; xq[2] = q0; xk[0] = xk[1]; xk[1] = xk[2]; xk[2] = k0; xv[0] = xv[1]; xv[1] = xv[2]; xv[2] = v0;
        q = q * rsqrtf(wave_sum(q * q) + EPS) * 0.125f;
        k = k * rsqrtf(wave_sum(k * k) + EPS);
        const float beta = sigmoidf_(gates[row * 16 + 4 + h]);
        const float g = -Aexp * softplusf_(gates[row * 16 + 8 + h] + dtb);
        const float eg = __expf(g);
        float r = 0.f;
#pragma unroll
        for (int i = 0; i < 64; ++i) { S[i] *= eg; r += rdlane(k, i) * S[i]; }
        const float dlt = beta * (v - r);
        float o = 0.f;
#pragma unroll
        for (int i = 0; i < 64; ++i) { S[i] += rdlane(k, i) * dlt; o += rdlane(q, i) * S[i]; }
        const float ms = wave_sum(o * o) * (1.f / 64.f);
        const float yv = o * rsqrtf(ms + EPS) * siluf_(zv) * mg;
        y[row * 1024 + 768 + h * 64 + lane] = f2bf(yv);
    }
}

__global__ void __launch_bounds__(256) lru_prep_kernel(const bf16_t* __restrict__ proj, const float* __restrict__ conv_w  , const float* __restrict__ conv_b,
                                                    const float* __restrict__ w_a  , const float* __restrict__ b_a, const float* __restrict__ w_x, const float* __restrict__ b_x,
                                                    const float* __restrict__ lam, float* __restrict__ a_out, float* __restrict__ u_out) {
    __shared__ float xc[16][256];
    const int c = threadIdx.x, t0 = blockIdx.x * 16;
    const float w0 = conv_w[c], w1 = conv_w[256 + c], w2 = conv_w[512 + c], w3 = conv_w[768 + c], cb = conv_b[c];
    for (int i = 0; i < 16; ++i) {
        const int t = t0 + i, s = t & (SEQ - 1);
        const bf16_t* pr = proj + (size_t)t * NP + C_CX + c;
        float acc = cb + w3 * bf2f(pr[0]);
        if (s >= 1) acc += w2 * bf2f(pr[-(ptrdiff_t)NP]);
        if (s >= 2) acc += w1 * bf2f(pr[-(ptrdiff_t)2 * NP]);
        if (s >= 3) acc += w0 * bf2f(pr[-(ptrdiff_t)3 * NP]);
        xc[i][c] = acc;
    }
    __syncthreads();
    const int h = c >> 6, jj = c & 63;
    float ra[16], rx[16];
#pragma unroll
    for (int i = 0; i < 16; ++i) { ra[i] = 0.f; rx[i] = 0.f; }
    for (int k = 0; k < 64; ++k) {
        const float wa = w_a[(h * 64 + k) * 64 + jj], wx = w_x[(h * 64 + k) * 64 + jj];
#pragma unroll
        for (int i = 0; i < 16; ++i) { const float xv = xc[i][h * 64 + k]; ra[i] += xv * wa; rx[i] += xv * wx; }
    }
    const float ba = b_a[c], bx = b_x[c], sp = softplusf_(-lam[c]);
#pragma unroll
    for (int i = 0; i < 16; ++i) {
        const float r = sigmoidf_(ra[i] + ba), ig = sigmoidf_(rx[i] + bx);
        const float log_a = -8.f * r * sp;
        const float a = __expf(log_a);
        const float u = sqrtf(-expm1f(2.f * log_a)) * (ig * xc[i][c]);
        a_out[(size_t)(t0 + i) * 256 + c] = a; u_out[(size_t)(t0 + i) * 256 + c] = u;
    }
}
__global__ void __launch_bounds__(256) lru_scan_kernel(const float* __restrict__ a_in, const float* __restrict__ u_in, const bf16_t* __restrict__ proj, const float* __restrict__ mix_gain, bf16_t* __restrict__ y) {
    const int b = blockIdx.x, c = threadIdx.x;
    const float mg = mix_gain[512 + c];
    float hst = 0.f;
    for (int t = 0; t < SEQ; ++t) {
        const size_t row = (size_t)(b * SEQ + t);
        hst = a_in[row * 256 + c] * hst + u_in[row * 256 + c];
        const float yv = hst * geluf_(bf2f(proj[row * NP + C_CG + c]));
        const float ms = wave_sum(yv * yv) * (1.f / 64.f);
        y[row * 1024 + 512 + c] = f2bf(yv * rsqrtf(ms + EPS) * mg);
    }
}

__global__ void __launch_bounds__(64) fox_cumsum_kernel(const float* __restrict__ gates, const float* __restrict__ fb, float* __restrict__ cc) {
    const int b = blockIdx.x >> 2, h = blockIdx.x & 3, lane = threadIdx.x;
    const float bias = fb[h];
    float carry = 0.f;
    for (int t0 = 0; t0 < SEQ; t0 += 64) {
        float v = logsigmoidf_(gates[(size_t)(b * SEQ + t0 + lane) * 16 + h] + bias);
#pragma unroll
        for (int o = 1; o < 64; o <<= 1) { float n = __shfl_up(v, o); if (lane >= o) v += n; }
        v += carry;
        cc[(size_t)(b * 4 + h) * SEQ + t0 + lane] = v;
        carry = __shfl(v, 63);
    }
}

struct AttnP { const bf16_t* Q; const bf16_t* K; const bf16_t* V; const float* bias; bf16_t* O; const float* gain; int ldq, ldk, ldv, nq_per_b, nk_per_b, causal, ldo, rms; float scale; int pad; };
static_assert(sizeof(AttnP) == 88, "no padding");
__global__ void __launch_bounds__(256) attn_naive_kernel(AttnP p) {
    __shared__ __attribute__((aligned(16))) float sK[64][64];
    __shared__ __attribute__((aligned(16))) float sV[64][64];
    __shared__ float sBias[64];
    const int h = blockIdx.y, b = blockIdx.z, q0 = blockIdx.x * 256, tq = q0 + threadIdx.x;
    const size_t qrow = (size_t)b * p.nq_per_b + tq;
    float q[64], acc[64];
    { const bf16_t* qp = p.Q + qrow * p.ldq + h * 64;
#pragma unroll
      for (int d = 0; d < 64; ++d) { q[d] = bf2f(qp[d]) * p.scale; acc[d] = 0.f; } }
    float mrun = -INFINITY, lrun = 0.f;
    const float cq = p.bias ? p.bias[(size_t)(b * 4 + h) * p.nq_per_b + tq] : 0.f;
    const int kend = p.causal ? (q0 + 256) : p.nk_per_b;
    for (int k0 = 0; k0 < kend; k0 += 64) {
        __syncthreads();
        for (int i = threadIdx.x; i < 64 * 64; i += 256) {
            int r = i >> 6, d = i & 63; const size_t krow = (size_t)b * p.nk_per_b + k0 + r;
            sK[r][d] = bf2f(p.K[krow * p.ldk + h * 64 + d]); sV[r][d] = bf2f(p.V[krow * p.ldv + h * 64 + d]);
        }
        if (threadIdx.x < 64) sBias[threadIdx.x] = p.bias ? p.bias[(size_t)(b * 4 + h) * p.nk_per_b + k0 + threadIdx.x] : 0.f;
        __syncthreads();
        for (int r = 0; r < 64; ++r) {
            if (p.causal && (k0 + r > tq)) break;
            float s = 0.f;
#pragma unroll
            for (int d = 0; d < 64; d += 4) { const f32x4 kv = *(const f32x4*)&sK[r][d]; s += q[d] * kv.x + q[d + 1] * kv.y + q[d + 2] * kv.z + q[d + 3] * kv.w; }
            s += cq - sBias[r];
            const float mnew = fmaxf(mrun, s);
            const float corr = __expf(mrun - mnew), pe = __expf(s - mnew);
            lrun = lrun * corr + pe; mrun = mnew;
#pragma unroll
            for (int d = 0; d < 64; d += 4) { const f32x4 vv = *(const f32x4*)&sV[r][d];
                acc[d] = acc[d] * corr + pe * vv.x; acc[d + 1] = acc[d + 1] * corr + pe * vv.y; acc[d + 2] = acc[d + 2] * corr + pe * vv.z; acc[d + 3] = acc[d + 3] * corr + pe * vv.w; }
        }
    }
    const float inv = 1.f / lrun;
    float ms = 0.f;
#pragma unroll
    for (int d = 0; d < 64; ++d) { acc[d] *= inv; ms += acc[d] * acc[d]; }
    const float rinv = p.rms ? rsqrtf(ms * (1.f / 64.f) + EPS) : 1.f;
    bf16_t* op = p.O + qrow * p.ldo + h * 64;
#pragma unroll
    for (int d = 0; d < 64; d += 2) {
        const float g0 = p.gain ? p.gain[h * 64 + d] : 1.f, g1 = p.gain ? p.gain[h * 64 + d + 1] : 1.f;
        *(unsigned*)(op + d) = pk2(acc[d] * rinv * g0, acc[d + 1] * rinv * g1);
    }
}

__global__ void __launch_bounds__(256) router_kernel(const float* __restrict__ x, const float* __restrict__ g, const float* __restrict__ w_rg, const float* __restrict__ b_rg,
                                                  const float* __restrict__ w_re, const float* __restrict__ b_re, bf16_t* __restrict__ hn, int* __restrict__ cnt, int* __restrict__ list, float* __restrict__ pgate) {
    __shared__ float sh[4][1024];
    __shared__ float slog[4][64];
    const int w = threadIdx.x >> 6, lane = threadIdx.x & 63, t = blockIdx.x * 4 + w;
    const f32x4* xr = (const f32x4*)(x + (size_t)t * 1024) + lane;
    f32x4 v[4]; float s = 0.f;
#pragma unroll
    for (int j = 0; j < 4; ++j) { v[j] = xr[64 * j]; s += v[j].x * v[j].x + v[j].y * v[j].y + v[j].z * v[j].z + v[j].w * v[j].w; }
    const float rinv = rsqrtf(wave_sum(s) * (1.f / 1024.f) + EPS);
#pragma unroll
    for (int j = 0; j < 4; ++j) {
        const f32x4 gg = ((const f32x4*)g)[lane + 64 * j];
        const f32x4 hv = v[j] * rinv * gg;
        *(f32x4*)&sh[w][(lane + 64 * j) * 4] = hv;
        uint2 o; o.x = pk2(hv.x, hv.y); o.y = pk2(hv.z, hv.w);
        *(uint2*)(hn + (size_t)t * 1024 + (lane + 64 * j) * 4) = o;
    }
    __syncthreads();
    float a = 0.f;
    if (lane < 36) {
        const float* wp = lane < 4 ? (w_rg + lane) : (w_re + (lane - 4));
        const int ld = lane < 4 ? 4 : 32;
        for (int k = 0; k < 1024; ++k) a += sh[w][k] * wp[(size_t)k * ld];
        a += lane < 4 ? b_rg[lane] : b_re[lane - 4];
        slog[w][lane] = a;
    }
    __syncthreads();
    if (lane == 0) {
        const float* lg = slog[w];
        int gs = 0; float gm = lg[0];
        for (int i = 1; i < 4; ++i) if (lg[i] > gm) { gm = lg[i]; gs = i; }
        float den = 0.f; for (int i = 0; i < 4; ++i) den += __expf(lg[i] - gm);
        const float pg = 1.f / den;
        const float* le = lg + 4 + gs * 8;
        int i0 = 0; float m0 = le[0];
        for (int i = 1; i < 8; ++i) if (le[i] > m0) { m0 = le[i]; i0 = i; }
        int i1 = -1; float m1 = -INFINITY;
        for (int i = 0; i < 8; ++i) if (i != i0 && le[i] > m1) { m1 = le[i]; i1 = i; }
        const float e1 = __expf(m1 - m0); const float w0 = 1.f / (1.f + e1), w1 = e1 / (1.f + e1);
        const int ex0 = gs * 8 + i0, ex1 = gs * 8 + i1;
        int pos0 = atomicAdd(&cnt[ex0], 1); list[(size_t)ex0 * T + pos0] = 2 * t; pgate[2 * t] = pg * w0;
        int pos1 = atomicAdd(&cnt[ex1], 1); list[(size_t)ex1 * T + pos1] = 2 * t + 1; pgate[2 * t + 1] = pg * w1;
    }
}

__global__ void __launch_bounds__(256) combine_kernel(const float* x2, const bf16_t* __restrict__ eo, const float* __restrict__ g, float* xout, bf16_t* __restrict__ hn, int mode) {
    const int t = blockIdx.x * 4 + (threadIdx.x >> 6), lane = threadIdx.x & 63;
    f32x4 v[4]; float s = 0.f;
#pragma unroll
    for (int j = 0; j < 4; ++j) {
        const int c = (lane + 64 * j) * 4;
        v[j] = *(const f32x4*)(x2 + (size_t)t * 1024 + c);
        const uint2 e0 = *(const uint2*)(eo + (size_t)(2 * t) * 1024 + c), e1 = *(const uint2*)(eo + (size_t)(2 * t + 1) * 1024 + c);
        v[j].x += __uint_as_float(e0.x << 16) + __uint_as_float(e1.x << 16);
        v[j].y += __uint_as_float(e0.x & 0xffff0000u) + __uint_as_float(e1.x & 0xffff0000u);
        v[j].z += __uint_as_float(e0.y << 16) + __uint_as_float(e1.y << 16);
        v[j].w += __uint_as_float(e0.y & 0xffff0000u) + __uint_as_float(e1.y & 0xffff0000u);
        s += v[j].x * v[j].x + v[j].y * v[j].y + v[j].z * v[j].z + v[j].w * v[j].w;
    }
    const float rinv = rsqrtf(wave_sum(s) * (1.f / 1024.f) + EPS);
#pragma unroll
    for (int j = 0; j < 4; ++j) {
        const int c = (lane + 64 * j) * 4;
        const f32x4 gg = *(const f32x4*)(g + c);
        const f32x4 hv = v[j] * rinv * gg;
        if (mode == 0) {
            *(f32x4*)(xout + (size_t)t * 1024 + c) = v[j];
            uint2 o; o.x = pk2(hv.x, hv.y); o.y = pk2(hv.z, hv.w);
            *(uint2*)(hn + (size_t)t * 1024 + c) = o;
        } else {
            *(f32x4*)(xout + (size_t)t * 1024 + c) = hv;
        }
    }
}

enum { I_X = 0, I_MEM, I_NORM_MIX, I_W_IN, I_HGRN_LB, I_FOX_FB, I_LRU_CONV_W, I_LRU_CONV_B, I_LRU_WA, I_LRU_BA, I_LRU_WX, I_LRU_BX, I_LRU_LAM, I_GDN_CONV_W, I_GDN_A_LOG,
       I_GDN_DT_BIAS, I_MIX_GAIN, I_W_OUT, I_NORM_MEM, I_NORM_MEMKV, I_W_MQ, I_W_MKV, I_W_MO, I_NORM_FFN, I_W_RG, I_B_RG, I_W_RE, I_B_RE, I_W_E_GU, I_W_E_DN, I_NORM_FINAL };


#include <string.h>
static GemmP mkG(const bf16_t* A, int lda, const bf16_t* Bt, int ldb, int K, void* out, int ldo, const float* resid, float* gates) {
    GemmP p; memset(&p, 0, sizeof p); p.A = A; p.lda = lda; p.Bt = Bt; p.ldb = ldb; p.K = K; p.out = out; p.ldo = ldo; p.resid = resid; p.gates = gates; return p; }
static MoeP mkM(const bf16_t* A, int lda, const bf16_t* Wt, size_t wstride, int ldb, int K, const int* cnt, const int* list, const float* pgate, bf16_t* out) {
    MoeP p; memset(&p, 0, sizeof p); p.A = A; p.lda = lda; p.Wt = Wt; p.wstride = wstride; p.ldb = ldb; p.K = K; p.cnt = cnt; p.list = list; p.pgate = pgate; p.out = out; return p; }
static AttnP mkA(const bf16_t* Q, int ldq, const bf16_t* K, int ldk, const bf16_t* V, int ldv, const float* bias, int nq, int nk, int causal, float scale, bf16_t* O, int ldo, const float* gain, int rms) {
    AttnP p; memset(&p, 0, sizeof p); p.Q = Q; p.ldq = ldq; p.K = K; p.ldk = ldk; p.V = V; p.ldv = ldv; p.bias = bias; p.nq_per_b = nq; p.nk_per_b = nk; p.causal = causal; p.scale = scale; p.O = O; p.ldo = ldo; p.gain = gain; p.rms = rms; return p; }

extern "C" void kernel_launch(void* const* d_in, const int* in_sizes, int n_in, void* d_out, int out_size, void* d_ws, size_t ws_size, hipStream_t stream) {
    if (n_in != 31 || ws_size < OFF_END || out_size != T * 1024) { fprintf(stderr, "kernel_launch: unexpected sizes n_in=%d ws=%zu out=%d (need ws >= %zu)\n", n_in, ws_size, out_size, (size_t)OFF_END); return; }
    char* ws = (char*)d_ws;
    auto F = [&](int i) { return (const float*)d_in[i]; };
    bf16_t* Wt_in = (bf16_t*)(ws + OFF_WIN); bf16_t* Wt_out = (bf16_t*)(ws + OFF_WOUT); bf16_t* Wt_mq = (bf16_t*)(ws + OFF_WMQ); bf16_t* Wt_mkv = (bf16_t*)(ws + OFF_WMKV);
    bf16_t* Wt_mo = (bf16_t*)(ws + OFF_WMO); bf16_t* Wt_gu = (bf16_t*)(ws + OFF_WGU); bf16_t* Wt_dn = (bf16_t*)(ws + OFF_WDN);
    bf16_t* hn = (bf16_t*)(ws + OFF_HN); bf16_t* proj = (bf16_t*)(ws + OFF_PROJ); float* gates = (float*)(ws + OFF_GATES); bf16_t* y = (bf16_t*)(ws + OFF_Y);
    float* XA = (float*)d_out; float* XB = (float*)(ws + OFF_XB);
    bf16_t* qm = (bf16_t*)(ws + OFF_QM); bf16_t* om = (bf16_t*)(ws + OFF_OM); bf16_t* kvm = (bf16_t*)(ws + OFF_KVM); bf16_t* memn = (bf16_t*)(ws + OFF_MEMN);
    float* foxc = (float*)(ws + OFF_FOXC); float* lrua = (float*)(ws + OFF_LRUA); float* lruu = (float*)(ws + OFF_LRUU);
    int* cnt = (int*)(ws + OFF_CNT); int* list = (int*)(ws + OFF_LIST); float* pgate = (float*)(ws + OFF_PGATE);
    bf16_t* act = (bf16_t*)(ws + OFF_ACT); bf16_t* eo = (bf16_t*)(ws + OFF_EO);

    {
        size_t nw = (size_t)NL * SZ_WIN / 4; zero_kernel<<<(unsigned)((nw + 255) / 256), 256, 0, stream>>>((unsigned*)Wt_in, nw); }
    for (int l = 0; l < NL; ++l) {
        convT_kernel<<<dim3((NIN + 63) / 64, 16, 1), 256, 0, stream>>>(F(I_W_IN) + (size_t)l * 1024 * NIN, 1024, NIN, Wt_in + (size_t)l * NP * 1024, 1, 0, 0);
        convT_kernel<<<dim3(16, 16, 1), 256, 0, stream>>>(F(I_W_OUT) + (size_t)l * 1024 * 1024, 1024, 1024, Wt_out + (size_t)l * 1024 * 1024, 0, 0, 0);
        convT_kernel<<<dim3(4, 16, 1), 256, 0, stream>>>(F(I_W_MQ) + (size_t)l * 1024 * 256, 1024, 256, Wt_mq + (size_t)l * 256 * 1024, 0, 0, 0);
        convT_kernel<<<dim3(8, 16, 1), 256, 0, stream>>>(F(I_W_MKV) + (size_t)l * 1024 * 512, 1024, 512, Wt_mkv + (size_t)l * 512 * 1024, 0, 0, 0);
        convT_kernel<<<dim3(16, 4, 1), 256, 0, stream>>>(F(I_W_MO) + (size_t)l * 256 * 1024, 256, 1024, Wt_mo + (size_t)l * 1024 * 256, 0, 0, 0);
    }
    convT_kernel<<<dim3(8, 16, NL * 32), 256, 0, stream>>>(F(I_W_E_GU), 1024, 512, Wt_gu, 2, (size_t)1024 * 512, (size_t)512 * 1024);
    convT_kernel<<<dim3(16, 4, NL * 32), 256, 0, stream>>>(F(I_W_E_DN), 256, 1024, Wt_dn, 0, (size_t)256 * 1024, (size_t)1024 * 256);

    for (int l = 0; l < NL; ++l) {
        rmsnorm_bf16_kernel<<<2048 / 4, 256, 0, stream>>>(F(I_MEM), F(I_NORM_MEMKV) + l * 1024, memn, 2048);
        GemmP p = mkG(memn, 1024, Wt_mkv + (size_t)l * 512 * 1024, 1024, 1024, kvm + (size_t)l * 2048 * 512, 512, nullptr, nullptr);
        gemm_kernel<EPI_BF16><<<dim3(512 / 128, 2048 / 128), 256, 0, stream>>>(p);
    }

    const float* xcur = F(I_X);
    rmsnorm_bf16_kernel<<<T / 4, 256, 0, stream>>>(xcur, F(I_NORM_MIX), hn, T);
    for (int l = 0; l < NL; ++l) {
        float* x1 = (l == 0) ? XA : XB;
        float* x2 = (l == 0) ? XB : XA;
        { GemmP p = mkG(hn, 1024, Wt_in + (size_t)l * NP * 1024, 1024, 1024, proj, NP, nullptr, gates);
          gemm_kernel<EPI_INPROJ><<<dim3(NP / 128, T / 128), 256, 0, stream>>>(p); }
        const float* mg = F(I_MIX_GAIN) + l * 1024;
        hgrn2_naive_kernel<<<32, 64, 0, stream>>>(proj, F(I_HGRN_LB), l, mg, y);
        fox_cumsum_kernel<<<32, 64, 0, stream>>>(gates, F(I_FOX_FB) + l * 4, foxc);
        { AttnP a = mkA(proj + C_BQ, NP, proj + C_BK, NP, proj + C_BV, NP, foxc, SEQ, SEQ, 1, 0.125f, y + 256, 1024, mg + 256, 1);
          attn_naive_kernel<<<dim3(SEQ / 256, 4, NB), 256, 0, stream>>>(a); }
        lru_prep_kernel<<<T / 16, 256, 0, stream>>>(proj, F(I_LRU_CONV_W) + l * 1024, F(I_LRU_CONV_B) + l * 256, F(I_LRU_WA) + l * 16384, F(I_LRU_BA) + l * 256,
                                                     F(I_LRU_WX) + l * 16384, F(I_LRU_BX) + l * 256, F(I_LRU_LAM) + l * 256, lrua, lruu);
        lru_scan_kernel<<<NB, 256, 0, stream>>>(lrua, lruu, proj, mg, y);
        gdn_naive_kernel<<<32, 64, 0, stream>>>(proj, gates, F(I_GDN_CONV_W) + l * 4 * 768, F(I_GDN_A_LOG) + l * 4, F(I_GDN_DT_BIAS) + l * 4, mg, y);
        { GemmP p = mkG(y, 1024, Wt_out + (size_t)l * 1024 * 1024, 1024, 1024, x1, 1024, xcur, nullptr);
          gemm_kernel<EPI_RESID><<<dim3(1024 / 128, T / 128), 256, 0, stream>>>(p); }
        rmsnorm_bf16_kernel<<<T / 4, 256, 0, stream>>>(x1, F(I_NORM_MEM) + l * 1024, hn, T);
        { GemmP p = mkG(hn, 1024, Wt_mq + (size_t)l * 256 * 1024, 1024, 1024, qm, 256, nullptr, nullptr);
          gemm_kernel<EPI_BF16><<<dim3(256 / 128, T / 128), 256, 0, stream>>>(p); }
        { const bf16_t* kv = kvm + (size_t)l * 2048 * 512;
          AttnP a = mkA(qm, 256, kv, 512, kv + 256, 512, nullptr, SEQ, MEMLEN, 0, 0.125f, om, 256, nullptr, 0);
          attn_naive_kernel<<<dim3(SEQ / 256, 4, NB), 256, 0, stream>>>(a); }
        { GemmP p = mkG(om, 256, Wt_mo + (size_t)l * 1024 * 256, 256, 256, x2, 1024, x1, nullptr);
          gemm_kernel<EPI_RESID><<<dim3(1024 / 128, T / 128), 256, 0, stream>>>(p); }
        (void)hipMemsetAsync(cnt, 0, 256, stream);
        router_kernel<<<T / 4, 256, 0, stream>>>(x2, F(I_NORM_FFN) + l * 1024, F(I_W_RG) + l * 4096, F(I_B_RG) + l * 4, F(I_W_RE) + l * 32768, F(I_B_RE) + l * 32, hn, cnt, list, pgate);
        { MoeP p = mkM(hn, 1024, Wt_gu + (size_t)l * 32 * 512 * 1024, (size_t)512 * 1024, 1024, 1024, cnt, list, pgate, act);
          moe_gemm_kernel<1><<<dim3(512 / 128, 2 * T / 128 + NEXP), 256, 0, stream>>>(p); }
        { MoeP p = mkM(act, 256, Wt_dn + (size_t)l * 32 * 1024 * 256, (size_t)1024 * 256, 256, 256, cnt, list, pgate, eo);
          moe_gemm_kernel<2><<<dim3(1024 / 128, 2 * T / 128 + NEXP), 256, 0, stream>>>(p); }
        if (l == 0) {
            combine_kernel<<<T / 4, 256, 0, stream>>>(x2, eo, F(I_NORM_MIX) + 1024, XA, hn, 0);
            xcur = XA;
        } else {
            combine_kernel<<<T / 4, 256, 0, stream>>>(x2, eo, F(I_NORM_FINAL), (float*)d_out, hn, 1);
        }
    }
}
```

```cpp
#include <hip/hip_runtime.h>
#include <stdint.h>
#include <stdio.h>
#include <string.h>
#include <hip/hip_cooperative_groups.h>
namespace cg = cooperative_groups;

typedef unsigned short bf16_t;
typedef short bf16x8 __attribute__((ext_vector_type(8)));
typedef float f32x4 __attribute__((ext_vector_type(4)));
typedef unsigned u32x4 __attribute__((ext_vector_type(4)));

constexpr int NB = 8, SEQ = 2048, DM = 1024, T = NB * SEQ, NL = 2;
constexpr int NP = 3456;
constexpr int NIN = 3340;
constexpr int C_AQ = 0, C_AF = 256, C_AI = 512, C_AG = 768, C_BQ = 1024, C_BK = 1280, C_BV = 1536, C_CX = 1792, C_CG = 2048,
              C_DQ = 2304, C_DK = 2560, C_DV = 2816, C_DZ = 3072, C_GATE = 3328;
constexpr int MEMLEN = 256;
constexpr int NEXP = 32, DEXP = 256;
constexpr float EPS = 1e-6f;

constexpr size_t al256(size_t x) { return (x + 255) & ~(size_t)255; }
constexpr size_t SZ_WIN = (size_t)NP * 1024 * 2, SZ_WOUT = (size_t)1024 * 1024 * 2, SZ_WMQ = (size_t)256 * 1024 * 2, SZ_WMKV = (size_t)512 * 1024 * 2,
                 SZ_WMO = (size_t)1024 * 256 * 2, SZ_WGU = (size_t)32 * 512 * 1024 * 2, SZ_WDN = (size_t)32 * 1024 * 256 * 2;
constexpr size_t OFF_WIN = 0;
constexpr size_t OFF_WOUT = OFF_WIN + NL * SZ_WIN;
constexpr size_t OFF_WMQ = OFF_WOUT + NL * SZ_WOUT;
constexpr size_t OFF_WMKV = OFF_WMQ + NL * SZ_WMQ;
constexpr size_t OFF_WMO = OFF_WMKV + NL * SZ_WMKV;
constexpr size_t OFF_WGU = OFF_WMO + NL * SZ_WMO;
constexpr size_t OFF_WDN = OFF_WGU + NL * SZ_WGU;
constexpr size_t OFF_HN = OFF_WDN + NL * SZ_WDN;
constexpr size_t OFF_PROJ = OFF_HN + (size_t)T * 1024 * 2;
constexpr size_t OFF_GATES = OFF_PROJ + (size_t)T * NP * 2;
constexpr size_t OFF_Y = OFF_GATES + (size_t)T * 16 * 4;
constexpr size_t OFF_XB = OFF_Y + (size_t)T * 1024 * 2;
constexpr size_t OFF_QM = OFF_XB + (size_t)T * 1024 * 4;
constexpr size_t OFF_OM = OFF_QM + (size_t)T * 256 * 2;
constexpr size_t OFF_KVM = OFF_OM + (size_t)T * 256 * 2;
constexpr size_t OFF_MEMN = OFF_KVM + (size_t)NL * 2048 * 512 * 2;
constexpr size_t OFF_FOXC = OFF_MEMN + (size_t)2048 * 1024 * 2;
constexpr size_t OFF_LRUA = OFF_FOXC + (size_t)NB * 4 * SEQ * 4;
constexpr size_t OFF_LRUU = OFF_LRUA + (size_t)T * 256 * 4;
constexpr size_t OFF_CNT = OFF_LRUU + (size_t)T * 256 * 4;
constexpr size_t OFF_LIST = OFF_CNT + 256;
constexpr size_t OFF_PGATE = OFF_LIST + (size_t)NEXP * T * 4;
constexpr size_t OFF_END = OFF_PGATE + (size_t)2 * T * 4;
constexpr size_t OFF_ACT = OFF_PROJ;
constexpr size_t OFF_EO = OFF_PROJ + (size_t)2 * T * 256 * 2;
static_assert(OFF_EO + (size_t)2 * T * 1024 * 2 <= OFF_GATES, "overlay fits");

__device__ __forceinline__ float bf2f(bf16_t v) { return __uint_as_float(((unsigned)v) << 16); }
__device__ __forceinline__ bf16_t f2bf(float f) { unsigned u = __float_as_uint(f); return (bf16_t)((u + 0x7fffu + ((u >> 16) & 1u)) >> 16); }
__device__ __forceinline__ unsigned pk2(float lo, float hi) { return (unsigned)f2bf(lo) | ((unsigned)f2bf(hi) << 16); }
__device__ __forceinline__ float sigmoidf_(float x) { return 1.f / (1.f + __expf(-x)); }
__device__ __forceinline__ float siluf_(float x) { return x / (1.f + __expf(-x)); }
__device__ __forceinline__ float softplusf_(float x) { return x > 20.f ? x : log1pf(__expf(x)); }
__device__ __forceinline__ float logsigmoidf_(float x) { return x < 0.f ? x - log1pf(__expf(x)) : -log1pf(__expf(-x)); }
__device__ __forceinline__ float geluf_(float x) { float u = 0.7978845608028654f * (x + 0.044715f * x * x * x); return 0.5f * x * (1.f + tanhf(u)); }
__device__ __forceinline__ float wave_sum(float v) {
#pragma unroll
    for (int o = 1; o < 64; o <<= 1) v += __shfl_xor(v, o);
    return v;
}
__device__ __forceinline__ float rdlane(float v, int l) { return __int_as_float(__builtin_amdgcn_readlane(__float_as_int(v), l)); }

constexpr int NTHR = 512;
constexpr int LDS_BYTES = 147456;
enum { I_X = 0, I_MEM, I_NORM_MIX, I_W_IN, I_HGRN_LB, I_FOX_FB, I_LRU_CONV_W, I_LRU_CONV_B, I_LRU_WA, I_LRU_BA, I_LRU_WX, I_LRU_BX, I_LRU_LAM, I_GDN_CONV_W, I_GDN_A_LOG,
       I_GDN_DT_BIAS, I_MIX_GAIN, I_W_OUT, I_NORM_MEM, I_NORM_MEMKV, I_W_MQ, I_W_MKV, I_W_MO, I_NORM_FFN, I_W_RG, I_B_RG, I_W_RE, I_B_RE, I_W_E_GU, I_W_E_DN, I_NORM_FINAL, N_INPUTS };
struct Params { const float* in[N_INPUTS]; float* out; char* ws; };
static_assert(sizeof(Params) == 8 * (N_INPUTS + 2), "no padding");

#define BLK_LOOP(it, n) for (int it = (int)blockIdx.x; it < (n); it += (int)gridDim.x)

__device__ __forceinline__ int rowmap_fn(int mode, int n) {
    if (mode == 1) {
        if (n < 1792) return n;
        if (n < 1796) return C_GATE + (n - 1792);
        if (n < 3076) return n - 4;
        if (n < 3084) return C_GATE + 4 + (n - 3076);
        return n - 12;
    } else if (mode == 2) {
        int j = n & 255; return (j >> 4) * 32 + ((n >= 256) ? 16 : 0) + (j & 15);
    }
    return n;
}
__device__ __forceinline__ void convT_tile(float* tile  , const float* __restrict__ src, int K, int N, bf16_t* __restrict__ dst, int mode, int ntn, int idx) {
    const int n0 = (idx % ntn) * 64, k0 = (idx / ntn) * 64;
    const int tx = threadIdx.x & 63, ty = threadIdx.x >> 6;
    __syncthreads();
#pragma unroll
    for (int i = 0; i < 8; ++i) {
        const int k = ty + i * 8, n = n0 + tx;
        tile[k * 65 + tx] = (n < N) ? src[(size_t)(k0 + k) * N + n] : 0.f;
    }
    __syncthreads();
    const int kx = threadIdx.x & 31, ny = threadIdx.x >> 5;
#pragma unroll
    for (int i = 0; i < 4; ++i) {
        const int nl = ny + i * 16, n = n0 + nl;
        if (n < N) {
            const int r = rowmap_fn(mode, n);
            *(unsigned*)(dst + (size_t)r * K + k0 + 2 * kx) = pk2(tile[(2 * kx) * 65 + nl], tile[(2 * kx + 1) * 65 + nl]);
        }
    }
}
__device__ __forceinline__ void rms_row_bf16(const float* __restrict__ xrow, const float* __restrict__ g, bf16_t* __restrict__ orow, int lane) {
    const f32x4* xr = (const f32x4*)xrow + lane;
    f32x4 v[4]; float s = 0.f;
#pragma unroll
    for (int j = 0; j < 4; ++j) { v[j] = xr[64 * j]; s += v[j].x * v[j].x + v[j].y * v[j].y + v[j].z * v[j].z + v[j].w * v[j].w; }
    const float rinv = rsqrtf(wave_sum(s) * (1.f / 1024.f) + EPS);
#pragma unroll
    for (int j = 0; j < 4; ++j) {
        const f32x4 gg = ((const f32x4*)g)[lane + 64 * j];
        uint2 o; o.x = pk2(v[j].x * rinv * gg.x, v[j].y * rinv * gg.y); o.y = pk2(v[j].z * rinv * gg.z, v[j].w * rinv * gg.w);
        *(uint2*)(orow + (lane + 64 * j) * 4) = o;
    }
}

constexpr int CT_PER_LAYER = 53 * 16 + 256 + 64 + 128 + 64;
constexpr int CT_GU = 64 * 128, CT_DN = 64 * 64;
constexpr int CT_TOTAL = NL * CT_PER_LAYER + CT_GU + CT_DN;

__device__ __forceinline__ void phase0(const Params& P, char* smem) {
    char* ws = P.ws;
    float* tile = (float*)smem;
    BLK_LOOP(it, CT_TOTAL) {
        int r = it;
        if (r < NL * CT_PER_LAYER) {
            const int l = r / CT_PER_LAYER; r -= l * CT_PER_LAYER;
            if (r < 848) { convT_tile(tile, P.in[I_W_IN] + (size_t)l * 1024 * NIN, 1024, NIN, (bf16_t*)(ws + OFF_WIN) + (size_t)l * NP * 1024, 1, 53, r); continue; } r -= 848;
            if (r < 256) { convT_tile(tile, P.in[I_W_OUT] + (size_t)l * 1024 * 1024, 1024, 1024, (bf16_t*)(ws + OFF_WOUT) + (size_t)l * 1024 * 1024, 0, 16, r); continue; } r -= 256;
            if (r < 64) { convT_tile(tile, P.in[I_W_MQ] + (size_t)l * 1024 * 256, 1024, 256, (bf16_t*)(ws + OFF_WMQ) + (size_t)l * 256 * 1024, 0, 4, r); continue; } r -= 64;
            if (r < 128) { convT_tile(tile, P.in[I_W_MKV] + (size_t)l * 1024 * 512, 1024, 512, (bf16_t*)(ws + OFF_WMKV) + (size_t)l * 512 * 1024, 0, 8, r); continue; } r -= 128;
            convT_tile(tile, P.in[I_W_MO] + (size_t)l * 256 * 1024, 256, 1024, (bf16_t*)(ws + OFF_WMO) + (size_t)l * 1024 * 256, 0, 16, r); continue;
        }
        r -= NL * CT_PER_LAYER;
        if (r < CT_GU) { const int m = r >> 7; convT_tile(tile, P.in[I_W_E_GU] + (size_t)m * 1024 * 512, 1024, 512, (bf16_t*)(ws + OFF_WGU) + (size_t)m * 512 * 1024, 2, 8, r & 127); continue; }
        r -= CT_GU;
        { const int m = r >> 6; convT_tile(tile, P.in[I_W_E_DN] + (size_t)m * 256 * 1024, 256, 1024, (bf16_t*)(ws + OFF_WDN) + (size_t)m * 1024 * 256, 0, 16, r & 63); }
    }
    for (int i = blockIdx.x * NTHR + threadIdx.x; i < NL * (NP - NIN) * 512; i += gridDim.x * NTHR) {
        const int l = i / ((NP - NIN) * 512), w = i % ((NP - NIN) * 512);
        ((unsigned*)((bf16_t*)(ws + OFF_WIN) + (size_t)l * NP * 1024 + (size_t)NIN * 1024))[w] = 0u;
    }
    if (blockIdx.x == 0 && threadIdx.x < 64) ((int*)(ws + OFF_CNT))[threadIdx.x] = 0;
    const int gw = blockIdx.x * 8 + (threadIdx.x >> 6), ngw = gridDim.x * 8, lane = threadIdx.x & 63;
    for (int row = gw; row < T + NL * 2048; row += ngw) {
        if (row < T) rms_row_bf16(P.in[I_X] + (size_t)row * 1024, P.in[I_NORM_MIX], (bf16_t*)(ws + OFF_HN) + (size_t)row * 1024, lane);
        else { const int r2 = row - T, l = r2 >> 11, rr = r2 & 2047;
               rms_row_bf16(P.in[I_MEM] + (size_t)rr * 1024, P.in[I_NORM_MEMKV] + l * 1024, (bf16_t*)(ws + OFF_MEMN) + (size_t)r2 * 1024, lane); }
    }
}

constexpr int GLD = 72;
constexpr int GEMM_LDS = (256 + 128) * GLD * 2;
template <class RowPtr>
__device__ __forceinline__ void gemm_tile(char* smem, RowPtr rowptr, const bf16_t* __restrict__ Bt, int ldb, int n0, int K, f32x4 (&acc)[4][4]) {
    bf16_t* sA = (bf16_t*)smem; bf16_t* sB = sA + 256 * GLD;
    const int tid = threadIdx.x, lane = tid & 63, wave = tid >> 6, wm = wave >> 1, wn = wave & 1;
    const u32x4* ga[4]; const u32x4* gb[2];
#pragma unroll
    for (int i = 0; i < 4; ++i) { const int c = tid + i * 512, r = c >> 3, ch = c & 7; ga[i] = (const u32x4*)(rowptr(r) + ch * 8); }
#pragma unroll
    for (int i = 0; i < 2; ++i) { const int c = tid + i * 512, r = c >> 3, ch = c & 7; gb[i] = (const u32x4*)(Bt + (size_t)(n0 + r) * ldb + ch * 8); }
#pragma unroll
    for (int m = 0; m < 4; ++m)
#pragma unroll
        for (int n = 0; n < 4; ++n) acc[m][n] = (f32x4){0.f, 0.f, 0.f, 0.f};
    u32x4 ra[4], rb[2];
#pragma unroll
    for (int i = 0; i < 4; ++i) ra[i] = ga[i][0];
#pragma unroll
    for (int i = 0; i < 2; ++i) rb[i] = gb[i][0];
    const int nk = K / 64;
    for (int kt = 0; kt < nk; ++kt) {
        __syncthreads();
#pragma unroll
        for (int i = 0; i < 4; ++i) { const int c = tid + i * 512, r = c >> 3, ch = c & 7; *(u32x4*)(sA + r * GLD + ch * 8) = ra[i]; }
#pragma unroll
        for (int i = 0; i < 2; ++i) { const int c = tid + i * 512, r = c >> 3, ch = c & 7; *(u32x4*)(sB + r * GLD + ch * 8) = rb[i]; }
        __syncthreads();
        if (kt + 1 < nk) {
#pragma unroll
            for (int i = 0; i < 4; ++i) ra[i] = ga[i][(kt + 1) * 8];
#pragma unroll
            for (int i = 0; i < 2; ++i) rb[i] = gb[i][(kt + 1) * 8];
        }
#pragma unroll
        for (int kk = 0; kk < 2; ++kk) {
            bf16x8 af[4], bfr[4];
#pragma unroll
            for (int m = 0; m < 4; ++m) af[m] = *(const bf16x8*)(sA + (wm * 64 + m * 16 + (lane & 15)) * GLD + kk * 32 + (lane >> 4) * 8);
#pragma unroll
            for (int n = 0; n < 4; ++n) bfr[n] = *(const bf16x8*)(sB + (wn * 64 + n * 16 + (lane & 15)) * GLD + kk * 32 + (lane >> 4) * 8);
#pragma unroll
            for (int m = 0; m < 4; ++m)
#pragma unroll
                for (int n = 0; n < 4; ++n) acc[m][n] = __builtin_amdgcn_mfma_f32_16x16x32_bf16(bfr[n], af[m], acc[m][n], 0, 0, 0);
        }
    }
}
struct RowDirect { const bf16_t* A; int lda; int m0; __device__ __forceinline__ const bf16_t* operator()(int r) const { return A + (size_t)(m0 + r) * lda; } };
enum { EPI_INPROJ = 0, EPI_RESID = 1, EPI_BF16 = 2 };

__device__ __forceinline__ int vcu_id() { const int G = gridDim.x, bx = blockIdx.x; return (G % 8 == 0) ? (bx % 8) * (G / 8) + bx / 8 : bx; }

template <int EPI>
__device__ __forceinline__ void gemm_phase(char* smem, const bf16_t* A, int lda, const bf16_t* Bt, int ldb, int M, int N, int K, void* out, int ldo, const float* resid, float* gates) {
    const int ntn = N / 128, ntiles = (M / 256) * ntn;
    const int lane = threadIdx.x & 63, wave = threadIdx.x >> 6, wm = wave >> 1, wn = wave & 1;
    for (int tIdx = vcu_id(); tIdx < ntiles; tIdx += gridDim.x) {
        const int m0 = (tIdx / ntn) * 256, n0 = (tIdx % ntn) * 128;
        f32x4 acc[4][4];
        RowDirect rp{A, lda, m0};
        gemm_tile(smem, rp, Bt, ldb, n0, K, acc);
#pragma unroll
        for (int m = 0; m < 4; ++m)
#pragma unroll
            for (int n = 0; n < 4; ++n) {
                const int row = m0 + wm * 64 + m * 16 + (lane & 15), col = n0 + wn * 64 + n * 16 + (lane >> 4) * 4;
                const f32x4 v = acc[m][n];
                if (EPI == EPI_INPROJ) {
                    uint2 o; o.x = pk2(v.x, v.y); o.y = pk2(v.z, v.w);
                    *(uint2*)((bf16_t*)out + (size_t)row * ldo + col) = o;
                    if (col >= C_GATE && col < C_GATE + 16) *(f32x4*)(gates + (size_t)row * 16 + (col - C_GATE)) = v;
                } else if (EPI == EPI_RESID) {
                    const f32x4 r = *(const f32x4*)(resid + (size_t)row * ldo + col);
                    *(f32x4*)((float*)out + (size_t)row * ldo + col) = r + v;
                } else {
                    uint2 o; o.x = pk2(v.x, v.y); o.y = pk2(v.z, v.w);
                    *(uint2*)((bf16_t*)out + (size_t)row * ldo + col) = o;
                }
            }
    }
}

struct RowGather { const bf16_t* A; int lda; const int* ids; int shift; __device__ __forceinline__ const bf16_t* operator()(int r) const { return A + (size_t)(ids[r] >> shift) * lda; } };
template <int STAGE>
__device__ __forceinline__ void moe_phase(char* smem, const bf16_t* A, int lda, const bf16_t* Wt, size_t wstride, int ldb, int K, const int* cnt, const int* list, const float* pgate, bf16_t* out) {
    int* ids = (int*)(smem + GEMM_LDS);
    int* tpre = ids + 256;
    constexpr int NTN = (STAGE == 1) ? 4 : 8;
    __syncthreads();
    if (threadIdx.x == 0) { int a = 0; for (int i = 0; i < NEXP; ++i) { tpre[i] = a; a += (cnt[i] + 255) >> 8; } tpre[NEXP] = a; }
    __syncthreads();
    const int ntiles = tpre[NEXP] * NTN;
    const int lane = threadIdx.x & 63, wave = threadIdx.x >> 6, wm = wave >> 1, wn = wave & 1;
    for (int tIdx = vcu_id(); tIdx < ntiles; tIdx += gridDim.x) {
        const int mtg = tIdx / NTN, n0 = (tIdx % NTN) * 128;
        int e = 0;
        for (int i = 1; i < NEXP; ++i) if (tpre[i] <= mtg) e = i;
        const int mt = mtg - tpre[e];
        const int cn = cnt[e];
        __syncthreads();
        if (threadIdx.x < 256) { const int pos = mt * 256 + threadIdx.x; ids[threadIdx.x] = list[(size_t)e * T + (pos < cn ? pos : cn - 1)]; }
        __syncthreads();
        f32x4 acc[4][4];
        RowGather rp{A, lda, ids, STAGE == 1 ? 1 : 0};
        gemm_tile(smem, rp, Wt + (size_t)e * wstride, ldb, n0, K, acc);
#pragma unroll
        for (int m = 0; m < 4; ++m) {
            const int rl = wm * 64 + m * 16 + (lane & 15);
            if (mt * 256 + rl >= cn) continue;
            const int pid = ids[rl];
            if (STAGE == 1) {
                const float gt = pgate[pid];
#pragma unroll
                for (int np = 0; np < 2; ++np) {
                    const f32x4 g = acc[m][2 * np], u = acc[m][2 * np + 1];
                    const int j = (n0 + wn * 64 + np * 32) / 2 + (lane >> 4) * 4;
                    uint2 o; o.x = pk2(siluf_(g.x) * u.x * gt, siluf_(g.y) * u.y * gt); o.y = pk2(siluf_(g.z) * u.z * gt, siluf_(g.w) * u.w * gt);
                    *(uint2*)(out + (size_t)pid * DEXP + j) = o;
                }
            } else {
#pragma unroll
                for (int n = 0; n < 4; ++n) {
                    const f32x4 v = acc[m][n]; const int col = n0 + wn * 64 + n * 16 + (lane >> 4) * 4;
                    uint2 o; o.x = pk2(v.x, v.y); o.y = pk2(v.z, v.w);
                    *(uint2*)(out + (size_t)pid * 1024 + col) = o;
                }
            }
        }
    }
}

__device__ __forceinline__ void hgrn2_naive(const bf16_t* __restrict__ proj, const float* __restrict__ hgrn_lb, int layer, const float* __restrict__ mix_gain, bf16_t* __restrict__ y, int bh, int lane) {
    const int b = bh >> 2, h = bh & 3;
    float lbk = 0.f;
    if (layer == 1) { float a0 = hgrn_lb[h * 64 + lane], a1 = hgrn_lb[256 + h * 64 + lane]; lbk = 1.f / (1.f + __expf(a0 - a1)); }
    const float mg = mix_gain[C_AQ + h * 64 + lane];
    float S[64];
#pragma unroll
    for (int k = 0; k < 64; ++k) S[k] = 0.f;
    for (int t = 0; t < SEQ; ++t) {
        const bf16_t* pr = proj + (size_t)(b * SEQ + t) * NP + h * 64 + lane;
        const float qk = siluf_(bf2f(pr[C_AQ]));
        const float sg = sigmoidf_(bf2f(pr[C_AF]));
        const float f = lbk + (1.f - lbk) * sg, kk = (1.f - lbk) * (1.f - sg);
        const float iv = bf2f(pr[C_AI]);
        const float gv = bf2f(pr[C_AG]);
        float o = 0.f;
#pragma unroll
        for (int k = 0; k < 64; ++k) { S[k] = rdlane(f, k) * S[k] + rdlane(kk, k) * iv; o += rdlane(qk, k) * S[k]; }
        const float ms = wave_sum(o * o) * (1.f / 64.f);
        const float yv = o * rsqrtf(ms + EPS) * siluf_(gv) * mg;
        y[(size_t)(b * SEQ + t) * 1024 + 0 + h * 64 + lane] = f2bf(yv);
    }
}
__device__ __forceinline__ void gdn_naive(const bf16_t* __restrict__ proj, const float* __restrict__ gates, const float* __restrict__ conv_w  ,
                                          const float* __restrict__ a_log, const float* __restrict__ dt_bias, const float* __restrict__ mix_gain, bf16_t* __restrict__ y, int bh, int lane) {
    const int b = bh >> 2, h = bh & 3;
    float wq[4], wk[4], wv[4];
#pragma unroll
    for (int j = 0; j < 4; ++j) { wq[j] = conv_w[j * 768 + h * 64 + lane]; wk[j] = conv_w[j * 768 + 256 + h * 64 + lane]; wv[j] = conv_w[j * 768 + 512 + h * 64 + lane]; }
    float xq[3] = {0.f, 0.f, 0.f}, xk[3] = {0.f, 0.f, 0.f}, xv[3] = {0.f, 0.f, 0.f};
    const float Aexp = __expf(a_log[h]), dtb = dt_bias[h];
    const float mg = mix_gain[768 + h * 64 + lane];
    float S[64];
#pragma unroll
    for (int k = 0; k < 64; ++k) S[k] = 0.f;
    for (int t = 0; t < SEQ; ++t) {
        const size_t row = (size_t)(b * SEQ + t);
        const bf16_t* pr = proj + row * NP + h * 64 + lane;
        const float q0 = bf2f(pr[C_DQ]), k0 = bf2f(pr[C_DK]), v0 = bf2f(pr[C_DV]), zv = bf2f(pr[C_DZ]);
        float q = siluf_(wq[0] * xq[0] + wq[1] * xq[1] + wq[2] * xq[2] + wq[3] * q0);
        float k = siluf_(wk[0] * xk[0] + wk[1] * xk[1] + wk[2] * xk[2] + wk[3] * k0);
        float v = siluf_(wv[0] * xv[0] + wv[1] * xv[1] + wv[2] * xv[2] + wv[3] * v0);
        xq[0] = xq[1]; xq[1] = xq[2]; xq[2] = q0; xk[0] = xk[1]; xk[1] = xk[2]; xk[2] = k0; xv[0] = xv[1]; xv[1] = xv[2]; xv[2] = v0;
        q = q * rsqrtf(wave_sum(q * q) + EPS) * 0.125f;
        k = k * rsqrtf(wave_sum(k * k) + EPS);
        const float beta = sigmoidf_(gates[row * 16 + 4 + h]);
        const float g = -Aexp * softplusf_(gates[row * 16 + 8 + h] + dtb);
        const float eg = __expf(g);
        float r = 0.f;
#pragma unroll
        for (int i = 0; i < 64; ++i) { S[i] *= eg; r += rdlane(k, i) * S[i]; }
        const float dlt = beta * (v - r);
        float o = 0.f;
#pragma unroll
        for (int i = 0; i < 64; ++i) { S[i] += rdlane(k, i) * dlt; o += rdlane(q, i) * S[i]; }
        const float ms = wave_sum(o * o) * (1.f / 64.f);
        const float yv = o * rsqrtf(ms + EPS) * siluf_(zv) * mg;
        y[row * 1024 + 768 + h * 64 + lane] = f2bf(yv);
    }
}
__device__ __forceinline__ void fox_cumsum(const float* __restrict__ gates, const float* __restrict__ fb, float* __restrict__ cc, int bh, int lane) {
    const int b = bh >> 2, h = bh & 3;
    const float bias = fb[h];
    float carry = 0.f;
    for (int t0 = 0; t0 < SEQ; t0 += 64) {
        float v = logsigmoidf_(gates[(size_t)(b * SEQ + t0 + lane) * 16 + h] + bias);
#pragma unroll
        for (int o = 1; o < 64; o <<= 1) { float n = __shfl_up(v, o); if (lane >= o) v += n; }
        v += carry;
        cc[(size_t)(b * 4 + h) * SEQ + t0 + lane] = v;
        carry = __shfl(v, 63);
    }
}
__device__ __forceinline__ void lru_prep_task(float* xc  , const bf16_t* __restrict__ proj, const float* __restrict__ conv_w, const float* __restrict__ conv_b,
                                              const float* __restrict__ w_a, const float* __restrict__ b_a, const float* __restrict__ w_x, const float* __restrict__ b_x,
                                              const float* __restrict__ lam, float* __restrict__ a_out, float* __restrict__ u_out, int task, bool active) {
    const int c = threadIdx.x & 255, t0 = task * 16;
    if (active) {
        const float w0 = conv_w[c], w1 = conv_w[256 + c], w2 = conv_w[512 + c], w3 = conv_w[768 + c], cb = conv_b[c];
        for (int i = 0; i < 16; ++i) {
            const int t = t0 + i, s = t & (SEQ - 1);
            const bf16_t* pr = proj + (size_t)t * NP + C_CX + c;
            float acc = cb + w3 * bf2f(pr[0]);
            if (s >= 1) acc += w2 * bf2f(pr[-(ptrdiff_t)NP]);
            if (s >= 2) acc += w1 * bf2f(pr[-(ptrdiff_t)2 * NP]);
            if (s >= 3) acc += w0 * bf2f(pr[-(ptrdiff_t)3 * NP]);
            xc[i * 256 + c] = acc;
        }
    }
    __syncthreads();
    if (active) {
        const int h = c >> 6, jj = c & 63;
        float ra[16], rx[16];
#pragma unroll
        for (int i = 0; i < 16; ++i) { ra[i] = 0.f; rx[i] = 0.f; }
        for (int k = 0; k < 64; ++k) {
            const float wa = w_a[(h * 64 + k) * 64 + jj], wx = w_x[(h * 64 + k) * 64 + jj];
#pragma unroll
            for (int i = 0; i < 16; ++i) { const float xv = xc[i * 256 + h * 64 + k]; ra[i] += xv * wa; rx[i] += xv * wx; }
        }
        const float ba = b_a[c], bx = b_x[c], sp = softplusf_(-lam[c]);
#pragma unroll
        for (int i = 0; i < 16; ++i) {
            const float r = sigmoidf_(ra[i] + ba), ig = sigmoidf_(rx[i] + bx);
            const float log_a = -8.f * r * sp;
            const float a = __expf(log_a);
            const float u = sqrtf(-expm1f(2.f * log_a)) * (ig * xc[i * 256 + c]);
            a_out[(size_t)(t0 + i) * 256 + c] = a; u_out[(size_t)(t0 + i) * 256 + c] = u;
        }
    }
    __syncthreads();
}
__device__ __forceinline__ void lru_scan_task(const float* __restrict__ a_in, const float* __restrict__ u_in, const bf16_t* __restrict__ proj, const float* __restrict__ mix_gain, bf16_t* __restrict__ y, int b) {
    const int c = threadIdx.x;
    const float mg = mix_gain[512 + c];
    float hst = 0.f;
    for (int t = 0; t < SEQ; ++t) {
        const size_t row = (size_t)(b * SEQ + t);
        hst = a_in[row * 256 + c] * hst + u_in[row * 256 + c];
        const float yv = hst * geluf_(bf2f(proj[row * NP + C_CG + c]));
        const float ms = wave_sum(yv * yv) * (1.f / 64.f);
        y[row * 1024 + 512 + c] = f2bf(yv * rsqrtf(ms + EPS) * mg);
    }
}

__device__ __forceinline__ void attn_naive_task(char* smem, const bf16_t* __restrict__ Q, int ldq, const bf16_t* __restrict__ Kp, int ldk, const bf16_t* __restrict__ Vp, int ldv, const float* __restrict__ bias,
                                                int nq_per_b, int nk_per_b, int causal, float scale, bf16_t* __restrict__ O, int ldo, const float* __restrict__ gain, int rms, int task) {
    float* sK = (float*)smem; float* sV = sK + 64 * 64; float* sBias = sV + 64 * 64;
    const int nqt = nq_per_b / 512;
    const int qt = task % nqt, h = (task / nqt) & 3, b = task / (nqt * 4);
    const int q0 = qt * 512, tq = q0 + threadIdx.x;
    const size_t qrow = (size_t)b * nq_per_b + tq;
    float q[64], acc[64];
    { const bf16_t* qp = Q + qrow * ldq + h * 64;
#pragma unroll
      for (int d = 0; d < 64; ++d) { q[d] = bf2f(qp[d]) * scale; acc[d] = 0.f; } }
    float mrun = -INFINITY, lrun = 0.f;
    const float cq = bias ? bias[(size_t)(b * 4 + h) * nq_per_b + tq] : 0.f;
    const int kend = causal ? (q0 + 512) : nk_per_b;
    for (int k0 = 0; k0 < kend; k0 += 64) {
        __syncthreads();
        for (int i = threadIdx.x; i < 64 * 64; i += NTHR) {
            const int r = i >> 6, d = i & 63; const size_t krow = (size_t)b * nk_per_b + k0 + r;
            sK[i] = bf2f(Kp[krow * ldk + h * 64 + d]); sV[i] = bf2f(Vp[krow * ldv + h * 64 + d]);
        }
        if (threadIdx.x < 64) sBias[threadIdx.x] = bias ? bias[(size_t)(b * 4 + h) * nk_per_b + k0 + threadIdx.x] : 0.f;
        __syncthreads();
        for (int r = 0; r < 64; ++r) {
            if (causal && (k0 + r > tq)) break;
            float s = 0.f;
#pragma unroll
            for (int d = 0; d < 64; d += 4) { const f32x4 kv = *(const f32x4*)&sK[r * 64 + d]; s += q[d] * kv.x + q[d + 1] * kv.y + q[d + 2] * kv.z + q[d + 3] * kv.w; }
            s += cq - sBias[r];
            const float mnew = fmaxf(mrun, s);
            const float corr = __expf(mrun - mnew), pe = __expf(s - mnew);
            lrun = lrun * corr + pe; mrun = mnew;
#pragma unroll
            for (int d = 0; d < 64; d += 4) { const f32x4 vv = *(const f32x4*)&sV[r * 64 + d];
                acc[d] = acc[d] * corr + pe * vv.x; acc[d + 1] = acc[d + 1] * corr + pe * vv.y; acc[d + 2] = acc[d + 2] * corr + pe * vv.z; acc[d + 3] = acc[d + 3] * corr + pe * vv.w; }
        }
    }
    const float inv = 1.f / lrun;
    float ms = 0.f;
#pragma unroll
    for (int d = 0; d < 64; ++d) { acc[d] *= inv; ms += acc[d] * acc[d]; }
    const float rinv = rms ? rsqrtf(ms * (1.f / 64.f) + EPS) : 1.f;
    bf16_t* op = O + qrow * ldo + h * 64;
#pragma unroll
    for (int d = 0; d < 64; d += 2) {
        const float g0 = gain ? gain[h * 64 + d] : 1.f, g1 = gain ? gain[h * 64 + d + 1] : 1.f;
        *(unsigned*)(op + d) = pk2(acc[d] * rinv * g0, acc[d + 1] * rinv * g1);
    }
    __syncthreads();
}

__device__ __forceinline__ void router_phase(char* smem, const float* __restrict__ x, const float* __restrict__ g, const float* __restrict__ w_rg, const float* __restrict__ b_rg,
                                             const float* __restrict__ w_re, const float* __restrict__ b_re, bf16_t* __restrict__ hn, int* __restrict__ cnt, int* __restrict__ list, float* __restrict__ pgate) {
    const int w = threadIdx.x >> 6, lane = threadIdx.x & 63;
    float* sh = (float*)smem + w * 1024;
    float* slog = (float*)smem + 8 * 1024 + w * 64;
    for (int t = blockIdx.x * 8 + w; t < T; t += gridDim.x * 8) {
        const f32x4* xr = (const f32x4*)(x + (size_t)t * 1024) + lane;
        f32x4 v[4]; float s = 0.f;
#pragma unroll
        for (int j = 0; j < 4; ++j) { v[j] = xr[64 * j]; s += v[j].x * v[j].x + v[j].y * v[j].y + v[j].z * v[j].z + v[j].w * v[j].w; }
        const float rinv = rsqrtf(wave_sum(s) * (1.f / 1024.f) + EPS);
#pragma unroll
        for (int j = 0; j < 4; ++j) {
            const f32x4 gg = ((const f32x4*)g)[lane + 64 * j];
            const f32x4 hv = v[j] * rinv * gg;
            *(f32x4*)&sh[(lane + 64 * j) * 4] = hv;
            uint2 o; o.x = pk2(hv.x, hv.y); o.y = pk2(hv.z, hv.w);
            *(uint2*)(hn + (size_t)t * 1024 + (lane + 64 * j) * 4) = o;
        }
        __builtin_amdgcn_wave_barrier();
        float a = 0.f;
        if (lane < 36) {
            const float* wp = lane < 4 ? (w_rg + lane) : (w_re + (lane - 4));
            const int ld = lane < 4 ? 4 : 32;
            for (int k = 0; k < 1024; ++k) a += sh[k] * wp[(size_t)k * ld];
            a += lane < 4 ? b_rg[lane] : b_re[lane - 4];
            slog[lane] = a;
        }
        __builtin_amdgcn_wave_barrier();
        if (lane == 0) {
            const float* lg = slog;
            int gs = 0; float gm = lg[0];
            for (int i = 1; i < 4; ++i) if (lg[i] > gm) { gm = lg[i]; gs = i; }
            float den = 0.f; for (int i = 0; i < 4; ++i) den += __expf(lg[i] - gm);
            const float pg = 1.f / den;
            const float* le = lg + 4 + gs * 8;
            int i0 = 0; float m0 = le[0];
            for (int i = 1; i < 8; ++i) if (le[i] > m0) { m0 = le[i]; i0 = i; }
            int i1 = -1; float m1 = -INFINITY;
            for (int i = 0; i < 8; ++i) if (i != i0 && le[i] > m1) { m1 = le[i]; i1 = i; }
            const float e1 = __expf(m1 - m0); const float w0 = 1.f / (1.f + e1), w1 = e1 / (1.f + e1);
            const int ex0 = gs * 8 + i0, ex1 = gs * 8 + i1;
            const int pos0 = atomicAdd(&cnt[ex0], 1); list[(size_t)ex0 * T + pos0] = 2 * t; pgate[2 * t] = pg * w0;
            const int pos1 = atomicAdd(&cnt[ex1], 1); list[(size_t)ex1 * T + pos1] = 2 * t + 1; pgate[2 * t + 1] = pg * w1;
        }
        __builtin_amdgcn_wave_barrier();
    }
}

__device__ __forceinline__ void combine_phase(const float* x2, const bf16_t* __restrict__ eo, const float* __restrict__ g, float* xout, bf16_t* __restrict__ hn, int mode) {
    const int lane = threadIdx.x & 63;
    for (int t = blockIdx.x * 8 + (threadIdx.x >> 6); t < T; t += gridDim.x * 8) {
        f32x4 v[4]; float s = 0.f;
#pragma unroll
        for (int j = 0; j < 4; ++j) {
            const int c = (lane + 64 * j) * 4;
            v[j] = *(const f32x4*)(x2 + (size_t)t * 1024 + c);
            const uint2 e0 = *(const uint2*)(eo + (size_t)(2 * t) * 1024 + c), e1 = *(const uint2*)(eo + (size_t)(2 * t + 1) * 1024 + c);
            v[j].x += __uint_as_float(e0.x << 16) + __uint_as_float(e1.x << 16);
            v[j].y += __uint_as_float(e0.x & 0xffff0000u) + __uint_as_float(e1.x & 0xffff0000u);
            v[j].z += __uint_as_float(e0.y << 16) + __uint_as_float(e1.y << 16);
            v[j].w += __uint_as_float(e0.y & 0xffff0000u) + __uint_as_float(e1.y & 0xffff0000u);
            s += v[j].x * v[j].x + v[j].y * v[j].y + v[j].z * v[j].z + v[j].w * v[j].w;
        }
        const float rinv = rsqrtf(wave_sum(s) * (1.f / 1024.f) + EPS);
#pragma unroll
        for (int j = 0; j < 4; ++j) {
            const int c = (lane + 64 * j) * 4;
            const f32x4 gg = *(const f32x4*)(g + c);
            const f32x4 hv = v[j] * rinv * gg;
            if (mode == 0) {
                *(f32x4*)(xout + (size_t)t * 1024 + c) = v[j];
                uint2 o; o.x = pk2(hv.x, hv.y); o.y = pk2(hv.z, hv.w);
                *(uint2*)(hn + (size_t)t * 1024 + c) = o;
            } else {
                *(f32x4*)(xout + (size_t)t * 1024 + c) = hv;
            }
        }
    }
}

template <int l>
__device__ __forceinline__ void layer_body(const Params& P, char* smem, cg::grid_group& grid, const float* xcur) {
    char* ws = P.ws;
    bf16_t* Wt_in = (bf16_t*)(ws + OFF_WIN); bf16_t* Wt_out = (bf16_t*)(ws + OFF_WOUT); bf16_t* Wt_mq = (bf16_t*)(ws + OFF_WMQ); bf16_t* Wt_mkv = (bf16_t*)(ws + OFF_WMKV);
    bf16_t* Wt_mo = (bf16_t*)(ws + OFF_WMO); bf16_t* Wt_gu = (bf16_t*)(ws + OFF_WGU); bf16_t* Wt_dn = (bf16_t*)(ws + OFF_WDN);
    bf16_t* hn = (bf16_t*)(ws + OFF_HN); bf16_t* proj = (bf16_t*)(ws + OFF_PROJ); float* gates = (float*)(ws + OFF_GATES); bf16_t* y = (bf16_t*)(ws + OFF_Y);
    float* XA = P.out; float* XB = (float*)(ws + OFF_XB);
    bf16_t* qm = (bf16_t*)(ws + OFF_QM); bf16_t* om = (bf16_t*)(ws + OFF_OM); bf16_t* kvm = (bf16_t*)(ws + OFF_KVM); bf16_t* memn = (bf16_t*)(ws + OFF_MEMN);
    float* foxc = (float*)(ws + OFF_FOXC); float* lrua = (float*)(ws + OFF_LRUA); float* lruu = (float*)(ws + OFF_LRUU);
    int* cnt_all = (int*)(ws + OFF_CNT); int* list = (int*)(ws + OFF_LIST); float* pgate = (float*)(ws + OFF_PGATE);
    bf16_t* act = (bf16_t*)(ws + OFF_ACT); bf16_t* eo = (bf16_t*)(ws + OFF_EO);
    const int wave = threadIdx.x >> 6, lane = threadIdx.x & 63;


        float* x1 = (l == 0) ? XA : XB;
        float* x2 = (l == 0) ? XB : XA;
        int* cnt = cnt_all + 32 * l;
        const float* mg = P.in[I_MIX_GAIN] + l * 1024;
        gemm_phase<EPI_INPROJ>(smem, hn, 1024, Wt_in + (size_t)l * NP * 1024, 1024, T, NP, 1024, proj, NP, nullptr, gates);
        if (l == 0) for (int l2 = 0; l2 < NL; ++l2)
            gemm_phase<EPI_BF16>(smem, memn + (size_t)l2 * 2048 * 1024, 1024, Wt_mkv + (size_t)l2 * 512 * 1024, 1024, 2048, 512, 1024, kvm + (size_t)l2 * 2048 * 512, 512, nullptr, nullptr);
        grid.sync();
        {
            const int bx = blockIdx.x;
            if (bx < 32) {
                if (wave == 0) hgrn2_naive(proj, P.in[I_HGRN_LB], l, mg, y, bx, lane);
                else if (wave == 1) fox_cumsum(gates, P.in[I_FOX_FB] + l * 4, foxc, bx, lane);
            } else if (bx < 64) {
                if (wave == 0) gdn_naive(proj, gates, P.in[I_GDN_CONV_W] + l * 4 * 768, P.in[I_GDN_A_LOG] + l * 4, P.in[I_GDN_DT_BIAS] + l * 4, mg, y, bx - 32, lane);
            } else {
                const int nb = gridDim.x - 64, half = threadIdx.x >> 8;
                for (int base = 0; base < T / 16; base += nb * 2) {
                    const int task = base + (bx - 64) * 2 + half;
                    lru_prep_task((float*)smem + half * 16 * 256, proj, P.in[I_LRU_CONV_W] + l * 1024, P.in[I_LRU_CONV_B] + l * 256, P.in[I_LRU_WA] + l * 16384, P.in[I_LRU_BA] + l * 256,
                                  P.in[I_LRU_WX] + l * 16384, P.in[I_LRU_BX] + l * 256, P.in[I_LRU_LAM] + l * 256, lrua, lruu, task, task < T / 16);
                }
            }
        }
        grid.sync();
        {
            const int natt = (SEQ / 512) * 4 * NB;
            if ((int)blockIdx.x < natt || (int)gridDim.x < natt + NB) {
                BLK_LOOP(task, natt) attn_naive_task(smem, proj + C_BQ, NP, proj + C_BK, NP, proj + C_BV, NP, foxc, SEQ, SEQ, 1, 0.125f, y + 256, 1024, mg + 256, 1, task);
            }
            if ((int)gridDim.x >= natt + NB) { if ((int)blockIdx.x >= natt && (int)blockIdx.x < natt + NB && threadIdx.x < 256) lru_scan_task(lrua, lruu, proj, mg, y, blockIdx.x - natt); }
            else { if ((int)blockIdx.x < NB && threadIdx.x < 256) lru_scan_task(lrua, lruu, proj, mg, y, blockIdx.x); }
        }
        grid.sync();
        gemm_phase<EPI_RESID>(smem, y, 1024, Wt_out + (size_t)l * 1024 * 1024, 1024, T, 1024, 1024, x1, 1024, xcur, nullptr);
        grid.sync();
        for (int row = blockIdx.x * 8 + wave; row < T; row += gridDim.x * 8) rms_row_bf16(x1 + (size_t)row * 1024, P.in[I_NORM_MEM] + l * 1024, hn + (size_t)row * 1024, lane);
        grid.sync();
        gemm_phase<EPI_BF16>(smem, hn, 1024, Wt_mq + (size_t)l * 256 * 1024, 1024, T, 256, 1024, qm, 256, nullptr, nullptr);
        grid.sync();
        { const bf16_t* kv = kvm + (size_t)l * 2048 * 512;
          BLK_LOOP(task, (SEQ / 512) * 4 * NB) attn_naive_task(smem, qm, 256, kv, 512, kv + 256, 512, nullptr, SEQ, MEMLEN, 0, 0.125f, om, 256, nullptr, 0, task); }
        grid.sync();
        gemm_phase<EPI_RESID>(smem, om, 256, Wt_mo + (size_t)l * 1024 * 256, 256, T, 1024, 256, x2, 1024, x1, nullptr);
        grid.sync();
        router_phase(smem, x2, P.in[I_NORM_FFN] + l * 1024, P.in[I_W_RG] + l * 4096, P.in[I_B_RG] + l * 4, P.in[I_W_RE] + l * 32768, P.in[I_B_RE] + l * 32, hn, cnt, list, pgate);
        grid.sync();
        moe_phase<1>(smem, hn, 1024, Wt_gu + (size_t)l * 32 * 512 * 1024, (size_t)512 * 1024, 1024, 1024, cnt, list, pgate, act);
        grid.sync();
        moe_phase<2>(smem, act, 256, Wt_dn + (size_t)l * 32 * 1024 * 256, (size_t)1024 * 256, 256, 256, cnt, list, pgate, eo);
        grid.sync();
        if (l == 0) { combine_phase(x2, eo, P.in[I_NORM_MIX] + 1024, XA, hn, 0); grid.sync(); }
        else combine_phase(x2, eo, P.in[I_NORM_FINAL], P.out, hn, 1);
}
__global__ void __launch_bounds__(NTHR, 2) mega_kernel(Params P) {
    extern __shared__ __attribute__((aligned(16))) char smem[];
    cg::grid_group grid = cg::this_grid();
    phase0(P, smem);
    grid.sync();
    layer_body<0>(P, smem, grid, P.in[I_X]);
    layer_body<1>(P, smem, grid, P.out);
}

extern "C" void kernel_launch(void* const* d_in, const int* in_sizes, int n_in, void* d_out, int out_size, void* d_ws, size_t ws_size, hipStream_t stream) {
    static int grid_blocks = 0;
    if (grid_blocks == 0) {
        if (n_in != N_INPUTS || ws_size < OFF_END || out_size != T * 1024) { fprintf(stderr, "kernel_launch: unexpected sizes n_in=%d ws=%zu out=%d (need ws >= %zu)\n", n_in, ws_size, out_size, (size_t)OFF_END); grid_blocks = -1; return; }
        int dev = 0, cus = 0, per_cu = 0;
        if (hipGetDevice(&dev) != hipSuccess || hipDeviceGetAttribute(&cus, hipDeviceAttributeMultiprocessorCount, dev) != hipSuccess) { fprintf(stderr, "kernel_launch: device query failed\n"); grid_blocks = -1; return; }
        if (hipFuncSetAttribute((const void*)mega_kernel, hipFuncAttributeMaxDynamicSharedMemorySize, LDS_BYTES) != hipSuccess) { fprintf(stderr, "kernel_launch: hipFuncSetAttribute failed\n"); grid_blocks = -1; return; }
        if (hipOccupancyMaxActiveBlocksPerMultiprocessor(&per_cu, (const void*)mega_kernel, NTHR, LDS_BYTES) != hipSuccess || per_cu < 1) { fprintf(stderr, "kernel_launch: occupancy query says %d blocks/CU\n", per_cu); grid_blocks = -1; return; }
        grid_blocks = cus;
        fprintf(stderr, "kernel_launch: cus=%d per_cu=%d grid=%d\n", cus, per_cu, grid_blocks);
    }
    if (grid_blocks < 0) return;
    Params p; memset(&p, 0, sizeof p);
    for (int i = 0; i < N_INPUTS; ++i) p.in[i] = (const float*)d_in[i];
    p.out = (float*)d_out; p.ws = (char*)d_ws;
    void* args[] = {&p};
    hipError_t e = hipLaunchCooperativeKernel((const void*)mega_kernel, dim3(grid_blocks), dim3(NTHR), args, LDS_BYTES, stream);
    if (e != hipSuccess) fprintf(stderr, "kernel_launch: cooperative launch failed: %s (grid %d)\n", hipGetErrorString(e), grid_blocks);
}
```

```cpp
#include <hip/hip_runtime.h>
#include <stdint.h>
#include <stdio.h>
#include <string.h>
#include <hip/hip_cooperative_groups.h>
namespace cg = cooperative_groups;

typedef unsigned short bf16_t;
typedef short bf16x8 __attribute__((ext_vector_type(8)));
typedef float f32x4 __attribute__((ext_vector_type(4)));
typedef unsigned u32x4 __attribute__((ext_vector_type(4)));

constexpr int NB = 8, SEQ = 2048, DM = 1024, T = NB * SEQ, NL = 2;
constexpr int NP = 3456;
constexpr int NIN = 3340;
constexpr int C_AQ = 0, C_AF = 256, C_AI = 512, C_AG = 768, C_BQ = 1024, C_BK = 1280, C_BV = 1536, C_CX = 1792, C_CG = 2048,
              C_DQ = 2304, C_DK = 2560, C_DV = 2816, C_DZ = 3072, C_GATE = 3328;
constexpr int MEMLEN = 256;
constexpr int NEXP = 32, DEXP = 256;
constexpr float EPS = 1e-6f;

constexpr size_t al256(size_t x) { return (x + 255) & ~(size_t)255; }
constexpr size_t SZ_WIN = (size_t)NP * 1024 * 2, SZ_WOUT = (size_t)1024 * 1024 * 2, SZ_WMQ = (size_t)256 * 1024 * 2, SZ_WMKV = (size_t)512 * 1024 * 2,
                 SZ_WMO = (size_t)1024 * 256 * 2, SZ_WGU = (size_t)32 * 512 * 1024 * 2, SZ_WDN = (size_t)32 * 1024 * 256 * 2;
constexpr size_t OFF_WIN = 0;
constexpr size_t OFF_WOUT = OFF_WIN + NL * SZ_WIN;
constexpr size_t OFF_WMQ = OFF_WOUT + NL * SZ_WOUT;
constexpr size_t OFF_WMKV = OFF_WMQ + NL * SZ_WMQ;
constexpr size_t OFF_WMO = OFF_WMKV + NL * SZ_WMKV;
constexpr size_t OFF_WGU = OFF_WMO + NL * SZ_WMO;
constexpr size_t OFF_WDN = OFF_WGU + NL * SZ_WGU;
constexpr size_t OFF_HN = OFF_WDN + NL * SZ_WDN;
constexpr size_t OFF_PROJ = OFF_HN + (size_t)T * 1024 * 2;
constexpr size_t OFF_GATES = OFF_PROJ + (size_t)T * NP * 2;
constexpr size_t OFF_Y = OFF_GATES + (size_t)T * 16 * 4;
constexpr size_t OFF_XB = OFF_Y + (size_t)T * 1024 * 2;
constexpr size_t OFF_QM = OFF_XB + (size_t)T * 1024 * 4;
constexpr size_t OFF_OM = OFF_QM + (size_t)T * 256 * 2;
constexpr size_t OFF_KVM = OFF_OM + (size_t)T * 256 * 2;
constexpr size_t OFF_MEMN = OFF_KVM + (size_t)NL * 2048 * 512 * 2;
constexpr size_t OFF_FOXC = OFF_MEMN + (size_t)2048 * 1024 * 2;
constexpr size_t OFF_LRUA = OFF_FOXC + (size_t)NB * 4 * SEQ * 4;
constexpr size_t OFF_LRUU = OFF_LRUA + (size_t)T * 256 * 4;
constexpr size_t OFF_CNT = OFF_LRUU + (size_t)T * 256 * 4;
constexpr size_t OFF_LIST = OFF_CNT + 256;
constexpr size_t OFF_PGATE = OFF_LIST + (size_t)NEXP * T * 4;
constexpr size_t OFF_END = OFF_PGATE + (size_t)2 * T * 4;
constexpr size_t OFF_ACT = OFF_PROJ;
constexpr size_t OFF_EO = OFF_PROJ + (size_t)2 * T * 256 * 2;
static_assert(OFF_EO + (size_t)2 * T * 1024 * 2 <= OFF_GATES, "overlay fits");

__device__ __forceinline__ float bf2f(bf16_t v) { return __uint_as_float(((unsigned)v) << 16); }
__device__ __forceinline__ bf16_t f2bf(float f) { unsigned u = __float_as_uint(f); return (bf16_t)((u + 0x7fffu + ((u >> 16) & 1u)) >> 16); }
__device__ __forceinline__ unsigned pk2(float lo, float hi) { return (unsigned)f2bf(lo) | ((unsigned)f2bf(hi) << 16); }
__device__ __forceinline__ float sigmoidf_(float x) { return 1.f / (1.f + __expf(-x)); }
__device__ __forceinline__ float siluf_(float x) { return x / (1.f + __expf(-x)); }
__device__ __forceinline__ float softplusf_(float x) { return x > 20.f ? x : log1pf(__expf(x)); }
__device__ __forceinline__ float logsigmoidf_(float x) { return x < 0.f ? x - log1pf(__expf(x)) : -log1pf(__expf(-x)); }
__device__ __forceinline__ float geluf_(float x) { float u = 0.7978845608028654f * (x + 0.044715f * x * x * x); return 0.5f * x * (1.f + tanhf(u)); }
__device__ __forceinline__ float wave_sum(float v) {
#pragma unroll
    for (int o = 1; o < 64; o <<= 1) v += __shfl_xor(v, o);
    return v;
}
__device__ __forceinline__ float rdlane(float v, int l) { return __int_as_float(__builtin_amdgcn_readlane(__float_as_int(v), l)); }

constexpr int NTHR = 512;
constexpr int LDS_BYTES = 147456;
enum { I_X = 0, I_MEM, I_NORM_MIX, I_W_IN, I_HGRN_LB, I_FOX_FB, I_LRU_CONV_W, I_LRU_CONV_B, I_LRU_WA, I_LRU_BA, I_LRU_WX, I_LRU_BX, I_LRU_LAM, I_GDN_CONV_W, I_GDN_A_LOG,
       I_GDN_DT_BIAS, I_MIX_GAIN, I_W_OUT, I_NORM_MEM, I_NORM_MEMKV, I_W_MQ, I_W_MKV, I_W_MO, I_NORM_FFN, I_W_RG, I_B_RG, I_W_RE, I_B_RE, I_W_E_GU, I_W_E_DN, I_NORM_FINAL, N_INPUTS };
struct Params { const float* in[N_INPUTS]; float* out; char* ws; };
static_assert(sizeof(Params) == 8 * (N_INPUTS + 2), "no padding");

#define BLK_LOOP(it, n) for (int it = (int)blockIdx.x; it < (n); it += (int)gridDim.x)

__device__ __forceinline__ int rowmap_fn(int mode, int n) {
    if (mode == 1) {
        if (n < 1792) return n;
        if (n < 1796) return C_GATE + (n - 1792);
        if (n < 3076) return n - 4;
        if (n < 3084) return C_GATE + 4 + (n - 3076);
        return n - 12;
    } else if (mode == 2) {
        int j = n & 255; return (j >> 4) * 32 + ((n >= 256) ? 16 : 0) + (j & 15);
    }
    return n;
}
__device__ __forceinline__ void convT_tile(float* tile  , const float* __restrict__ src, int K, int N, bf16_t* __restrict__ dst, int mode, int ntn, int idx) {
    const int n0 = (idx % ntn) * 64, k0 = (idx / ntn) * 64;
    const int tx = threadIdx.x & 63, ty = threadIdx.x >> 6;
    __syncthreads();
#pragma unroll
    for (int i = 0; i < 8; ++i) {
        const int k = ty + i * 8, n = n0 + tx;
        tile[k * 65 + tx] = (n < N) ? src[(size_t)(k0 + k) * N + n] : 0.f;
    }
    __syncthreads();
    const int kx = threadIdx.x & 31, ny = threadIdx.x >> 5;
#pragma unroll
    for (int i = 0; i < 4; ++i) {
        const int nl = ny + i * 16, n = n0 + nl;
        if (n < N) {
            const int r = rowmap_fn(mode, n);
            *(unsigned*)(dst + (size_t)r * K + k0 + 2 * kx) = pk2(tile[(2 * kx) * 65 + nl], tile[(2 * kx + 1) * 65 + nl]);
        }
    }
}
__device__ __forceinline__ void rms_row_bf16(const float* __restrict__ xrow, const float* __restrict__ g, bf16_t* __restrict__ orow, int lane) {
    const f32x4* xr = (const f32x4*)xrow + lane;
    f32x4 v[4]; float s = 0.f;
#pragma unroll
    for (int j = 0; j < 4; ++j) { v[j] = xr[64 * j]; s += v[j].x * v[j].x + v[j].y * v[j].y + v[j].z * v[j].z + v[j].w * v[j].w; }
    const float rinv = rsqrtf(wave_sum(s) * (1.f / 1024.f) + EPS);
#pragma unroll
    for (int j = 0; j < 4; ++j) {
        const f32x4 gg = ((const f32x4*)g)[lane + 64 * j];
        uint2 o; o.x = pk2(v[j].x * rinv * gg.x, v[j].y * rinv * gg.y); o.y = pk2(v[j].z * rinv * gg.z, v[j].w * rinv * gg.w);
        *(uint2*)(orow + (lane + 64 * j) * 4) = o;
    }
}

constexpr int CT_PER_LAYER = 53 * 16 + 256 + 64 + 128 + 64;
constexpr int CT_GU = 64 * 128, CT_DN = 64 * 64;
constexpr int CT_TOTAL = NL * CT_PER_LAYER + CT_GU + CT_DN;

__device__ __forceinline__ void phase0(const Params& P, char* smem) {
    char* ws = P.ws;
    float* tile = (float*)smem;
    BLK_LOOP(it, CT_TOTAL) {
        int r = it;
        if (r < NL * CT_PER_LAYER) {
            const int l = r / CT_PER_LAYER; r -= l * CT_PER_LAYER;
            if (r < 848) { convT_tile(tile, P.in[I_W_IN] + (size_t)l * 1024 * NIN, 1024, NIN, (bf16_t*)(ws + OFF_WIN) + (size_t)l * NP * 1024, 1, 53, r); continue; } r -= 848;
            if (r < 256) { convT_tile(tile, P.in[I_W_OUT] + (size_t)l * 1024 * 1024, 1024, 1024, (bf16_t*)(ws + OFF_WOUT) + (size_t)l * 1024 * 1024, 0, 16, r); continue; } r -= 256;
            if (r < 64) { convT_tile(tile, P.in[I_W_MQ] + (size_t)l * 1024 * 256, 1024, 256, (bf16_t*)(ws + OFF_WMQ) + (size_t)l * 256 * 1024, 0, 4, r); continue; } r -= 64;
            if (r < 128) { convT_tile(tile, P.in[I_W_MKV] + (size_t)l * 1024 * 512, 1024, 512, (bf16_t*)(ws + OFF_WMKV) + (size_t)l * 512 * 1024, 0, 8, r); continue; } r -= 128;
            convT_tile(tile, P.in[I_W_MO] + (size_t)l * 256 * 1024, 256, 1024, (bf16_t*)(ws + OFF_WMO) + (size_t)l * 1024 * 256, 0, 16, r); continue;
        }
        r -= NL * CT_PER_LAYER;
        if (r < CT_GU) { const int m = r >> 7; convT_tile(tile, P.in[I_W_E_GU] + (size_t)m * 1024 * 512, 1024, 512, (bf16_t*)(ws + OFF_WGU) + (size_t)m * 512 * 1024, 2, 8, r & 127); continue; }
        r -= CT_GU;
        { const int m = r >> 6; convT_tile(tile, P.in[I_W_E_DN] + (size_t)m * 256 * 1024, 256, 1024, (bf16_t*)(ws + OFF_WDN) + (size_t)m * 1024 * 256, 0, 16, r & 63); }
    }
    for (int i = blockIdx.x * NTHR + threadIdx.x; i < NL * (NP - NIN) * 512; i += gridDim.x * NTHR) {
        const int l = i / ((NP - NIN) * 512), w = i % ((NP - NIN) * 512);
        ((unsigned*)((bf16_t*)(ws + OFF_WIN) + (size_t)l * NP * 1024 + (size_t)NIN * 1024))[w] = 0u;
    }
    if (blockIdx.x == 0 && threadIdx.x < 64) ((int*)(ws + OFF_CNT))[threadIdx.x] = 0;
    const int gw = blockIdx.x * 8 + (threadIdx.x >> 6), ngw = gridDim.x * 8, lane = threadIdx.x & 63;
    for (int row = gw; row < T + NL * 2048; row += ngw) {
        if (row < T) rms_row_bf16(P.in[I_X] + (size_t)row * 1024, P.in[I_NORM_MIX], (bf16_t*)(ws + OFF_HN) + (size_t)row * 1024, lane);
        else { const int r2 = row - T, l = r2 >> 11, rr = r2 & 2047;
               rms_row_bf16(P.in[I_MEM] + (size_t)rr * 1024, P.in[I_NORM_MEMKV] + l * 1024, (bf16_t*)(ws + OFF_MEMN) + (size_t)r2 * 1024, lane); }
    }
}

constexpr int GLD = 72;
constexpr int GEMM_LDS = (256 + 128) * GLD * 2;
template <class RowPtr>
__device__ __forceinline__ void gemm_tile(char* smem, RowPtr rowptr, const bf16_t* __restrict__ Bt, int ldb, int n0, int K, f32x4 (&acc)[4][4]) {
    bf16_t* sA = (bf16_t*)smem; bf16_t* sB = sA + 256 * GLD;
    const int tid = threadIdx.x, lane = tid & 63, wave = tid >> 6, wm = wave >> 1, wn = wave & 1;
    const u32x4* ga[4]; const u32x4* gb[2];
#pragma unroll
    for (int i = 0; i < 4; ++i) { const int c = tid + i * 512, r = c >> 3, ch = c & 7; ga[i] = (const u32x4*)(rowptr(r) + ch * 8); }
#pragma unroll
    for (int i = 0; i < 2; ++i) { const int c = tid + i * 512, r = c >> 3, ch = c & 7; gb[i] = (const u32x4*)(Bt + (size_t)(n0 + r) * ldb + ch * 8); }
#pragma unroll
    for (int m = 0; m < 4; ++m)
#pragma unroll
        for (int n = 0; n < 4; ++n) acc[m][n] = (f32x4){0.f, 0.f, 0.f, 0.f};
    u32x4 ra[4], rb[2];
#pragma unroll
    for (int i = 0; i < 4; ++i) ra[i] = ga[i][0];
#pragma unroll
    for (int i = 0; i < 2; ++i) rb[i] = gb[i][0];
    const int nk = K / 64;
    for (int kt = 0; kt < nk; ++kt) {
        __syncthreads();
#pragma unroll
        for (int i = 0; i < 4; ++i) { const int c = tid + i * 512, r = c >> 3, ch = c & 7; *(u32x4*)(sA + r * GLD + ch * 8) = ra[i]; }
#pragma unroll
        for (int i = 0; i < 2; ++i) { const int c = tid + i * 512, r = c >> 3, ch = c & 7; *(u32x4*)(sB + r * GLD + ch * 8) = rb[i]; }
        __syncthreads();
        if (kt + 1 < nk) {
#pragma unroll
            for (int i = 0; i < 4; ++i) ra[i] = ga[i][(kt + 1) * 8];
#pragma unroll
            for (int i = 0; i < 2; ++i) rb[i] = gb[i][(kt + 1) * 8];
        }
#pragma unroll
        for (int kk = 0; kk < 2; ++kk) {
            bf16x8 af[4], bfr[4];
#pragma unroll
            for (int m = 0; m < 4; ++m) af[m] = *(const bf16x8*)(sA + (wm * 64 + m * 16 + (lane & 15)) * GLD + kk * 32 + (lane >> 4) * 8);
#pragma unroll
            for (int n = 0; n < 4; ++n) bfr[n] = *(const bf16x8*)(sB + (wn * 64 + n * 16 + (lane & 15)) * GLD + kk * 32 + (lane >> 4) * 8);
#pragma unroll
            for (int m = 0; m < 4; ++m)
#pragma unroll
                for (int n = 0; n < 4; ++n) acc[m][n] = __builtin_amdgcn_mfma_f32_16x16x32_bf16(bfr[n], af[m], acc[m][n], 0, 0, 0);
        }
    }
}
struct RowDirect { const bf16_t* A; int lda; int m0; __device__ __forceinline__ const bf16_t* operator()(int r) const { return A + (size_t)(m0 + r) * lda; } };
enum { EPI_INPROJ = 0, EPI_RESID = 1, EPI_BF16 = 2 };

__device__ __forceinline__ int vcu_id() { const int G = gridDim.x, bx = blockIdx.x; return (G % 8 == 0) ? (bx % 8) * (G / 8) + bx / 8 : bx; }

template <int EPI>
__device__ __forceinline__ void gemm_phase(char* smem, const bf16_t* A, int lda, const bf16_t* Bt, int ldb, int M, int N, int K, void* out, int ldo, const float* resid, float* gates) {
    const int ntn = N / 128, ntiles = (M / 256) * ntn;
    const int lane = threadIdx.x & 63, wave = threadIdx.x >> 6, wm = wave >> 1, wn = wave & 1;
    for (int tIdx = vcu_id(); tIdx < ntiles; tIdx += gridDim.x) {
        const int m0 = (tIdx / ntn) * 256, n0 = (tIdx % ntn) * 128;
        f32x4 acc[4][4];
        RowDirect rp{A, lda, m0};
        gemm_tile(smem, rp, Bt, ldb, n0, K, acc);
#pragma unroll
        for (int m = 0; m < 4; ++m)
#pragma unroll
            for (int n = 0; n < 4; ++n) {
                const int row = m0 + wm * 64 + m * 16 + (lane & 15), col = n0 + wn * 64 + n * 16 + (lane >> 4) * 4;
                const f32x4 v = acc[m][n];
                if (EPI == EPI_INPROJ) {
                    uint2 o; o.x = pk2(v.x, v.y); o.y = pk2(v.z, v.w);
                    *(uint2*)((bf16_t*)out + (size_t)row * ldo + col) = o;
                    if (col >= C_GATE && col < C_GATE + 16) *(f32x4*)(gates + (size_t)row * 16 + (col - C_GATE)) = v;
                } else if (EPI == EPI_RESID) {
                    const f32x4 r = *(const f32x4*)(resid + (size_t)row * ldo + col);
                    *(f32x4*)((float*)out + (size_t)row * ldo + col) = r + v;
                } else {
                    uint2 o; o.x = pk2(v.x, v.y); o.y = pk2(v.z, v.w);
                    *(uint2*)((bf16_t*)out + (size_t)row * ldo + col) = o;
                }
            }
    }
}

struct RowGather { const bf16_t* A; int lda; const int* ids; int shift; __device__ __forceinline__ const bf16_t* operator()(int r) const { return A + (size_t)(ids[r] >> shift) * lda; } };
template <int STAGE>
__device__ __forceinline__ void moe_phase(char* smem, const bf16_t* A, int lda, const bf16_t* Wt, size_t wstride, int ldb, int K, const int* cnt, const int* list, const float* pgate, bf16_t* out) {
    int* ids = (int*)(smem + GEMM_LDS);
    int* tpre = ids + 256;
    constexpr int NTN = (STAGE == 1) ? 4 : 8;
    __syncthreads();
    if (threadIdx.x == 0) { int a = 0; for (int i = 0; i < NEXP; ++i) { tpre[i] = a; a += (cnt[i] + 255) >> 8; } tpre[NEXP] = a; }
    __syncthreads();
    const int ntiles = tpre[NEXP] * NTN;
    const int lane = threadIdx.x & 63, wave = threadIdx.x >> 6, wm = wave >> 1, wn = wave & 1;
    for (int tIdx = vcu_id(); tIdx < ntiles; tIdx += gridDim.x) {
        const int mtg = tIdx / NTN, n0 = (tIdx % NTN) * 128;
        int e = 0;
        for (int i = 1; i < NEXP; ++i) if (tpre[i] <= mtg) e = i;
        const int mt = mtg - tpre[e];
        const int cn = cnt[e];
        __syncthreads();
        if (threadIdx.x < 256) { const int pos = mt * 256 + threadIdx.x; ids[threadIdx.x] = list[(size_t)e * T + (pos < cn ? pos : cn - 1)]; }
        __syncthreads();
        f32x4 acc[4][4];
        RowGather rp{A, lda, ids, STAGE == 1 ? 1 : 0};
        gemm_tile(smem, rp, Wt + (size_t)e * wstride, ldb, n0, K, acc);
#pragma unroll
        for (int m = 0; m < 4; ++m) {
            const int rl = wm * 64 + m * 16 + (lane & 15);
            if (mt * 256 + rl >= cn) continue;
            const int pid = ids[rl];
            if (STAGE == 1) {
                const float gt = pgate[pid];
#pragma unroll
                for (int np = 0; np < 2; ++np) {
                    const f32x4 g = acc[m][2 * np], u = acc[m][2 * np + 1];
                    const int j = (n0 + wn * 64 + np * 32) / 2 + (lane >> 4) * 4;
                    uint2 o; o.x = pk2(siluf_(g.x) * u.x * gt, siluf_(g.y) * u.y * gt); o.y = pk2(siluf_(g.z) * u.z * gt, siluf_(g.w) * u.w * gt);
                    *(uint2*)(out + (size_t)pid * DEXP + j) = o;
                }
            } else {
#pragma unroll
                for (int n = 0; n < 4; ++n) {
                    const f32x4 v = acc[m][n]; const int col = n0 + wn * 64 + n * 16 + (lane >> 4) * 4;
                    uint2 o; o.x = pk2(v.x, v.y); o.y = pk2(v.z, v.w);
                    *(uint2*)(out + (size_t)pid * 1024 + col) = o;
                }
            }
        }
    }
}

__device__ __forceinline__ void hgrn2_naive(const bf16_t* __restrict__ proj, const float* __restrict__ hgrn_lb, int layer, const float* __restrict__ mix_gain, bf16_t* __restrict__ y, int bh, int lane) {
    const int b = bh >> 2, h = bh & 3;
    float lbk = 0.f;
    if (layer == 1) { float a0 = hgrn_lb[h * 64 + lane], a1 = hgrn_lb[256 + h * 64 + lane]; lbk = 1.f / (1.f + __expf(a0 - a1)); }
    const float mg = mix_gain[C_AQ + h * 64 + lane];
    float S[64];
#pragma unroll
    for (int k = 0; k < 64; ++k) S[k] = 0.f;
    for (int t = 0; t < SEQ; ++t) {
        const bf16_t* pr = proj + (size_t)(b * SEQ + t) * NP + h * 64 + lane;
        const float qk = siluf_(bf2f(pr[C_AQ]));
        const float sg = sigmoidf_(bf2f(pr[C_AF]));
        const float f = lbk + (1.f - lbk) * sg, kk = (1.f - lbk) * (1.f - sg);
        const float iv = bf2f(pr[C_AI]);
        const float gv = bf2f(pr[C_AG]);
        float o = 0.f;
#pragma unroll
        for (int k = 0; k < 64; ++k) { S[k] = rdlane(f, k) * S[k] + rdlane(kk, k) * iv; o += rdlane(qk, k) * S[k]; }
        const float ms = wave_sum(o * o) * (1.f / 64.f);
        const float yv = o * rsqrtf(ms + EPS) * siluf_(gv) * mg;
        y[(size_t)(b * SEQ + t) * 1024 + 0 + h * 64 + lane] = f2bf(yv);
    }
}
__device__ __forceinline__ void gdn_naive(const bf16_t* __restrict__ proj, const float* __restrict__ gates, const float* __restrict__ conv_w  ,
                                          const float* __restrict__ a_log, const float* __restrict__ dt_bias, const float* __restrict__ mix_gain, bf16_t* __restrict__ y, int bh, int lane) {
    const int b = bh >> 2, h = bh & 3;
    float wq[4], wk[4], wv[4];
#pragma unroll
    for (int j = 0; j < 4; ++j) { wq[j] = conv_w[j * 768 + h * 64 + lane]; wk[j] = conv_w[j * 768 + 256 + h * 64 + lane]; wv[j] = conv_w[j * 768 + 512 + h * 64 + lane]; }
    float xq[3] = {0.f, 0.f, 0.f}, xk[3] = {0.f, 0.f, 0.f}, xv[3] = {0.f, 0.f, 0.f};
    const float Aexp = __expf(a_log[h]), dtb = dt_bias[h];
    const float mg = mix_gain[768 + h * 64 + lane];
    float S[64];
#pragma unroll
    for (int k = 0; k < 64; ++k) S[k] = 0.f;
    for (int t = 0; t < SEQ; ++t) {
        const size_t row = (size_t)(b * SEQ + t);
        const bf16_t* pr = proj + row * NP + h * 64 + lane;
        const float q0 = bf2f(pr[C_DQ]), k0 = bf2f(pr[C_DK]), v0 = bf2f(pr[C_DV]), zv = bf2f(pr[C_DZ]);
        float q = siluf_(wq[0] * xq[0] + wq[1] * xq[1] + wq[2] * xq[2] + wq[3] * q0);
        float k = siluf_(wk[0] * xk[0] + wk[1] * xk[1] + wk[2] * xk[2] + wk[3] * k0);
        float v = siluf_(wv[0] * xv[0] + wv[1] * xv[1] + wv[2] * xv[2] + wv[3] * v0);
        xq[0] = xq[1]; xq[1] = xq[2]; xq[2] = q0; xk[0] = xk[1]; xk[1] = xk[2]; xk[2] = k0; xv[0] = xv[1]; xv[1] = xv[2]; xv[2] = v0;
        q = q * rsqrtf(wave_sum(q * q) + EPS) * 0.125f;
        k = k * rsqrtf(wave_sum(k * k) + EPS);
        const float beta = sigmoidf_(gates[row * 16 + 4 + h]);
        const float g = -Aexp * softplusf_(gates[row * 16 + 8 + h] + dtb);
        const float eg = __expf(g);
        float r = 0.f;
#pragma unroll
        for (int i = 0; i < 64; ++i) { S[i] *= eg; r += rdlane(k, i) * S[i]; }
        const float dlt = beta * (v - r);
        float o = 0.f;
#pragma unroll
        for (int i = 0; i < 64; ++i) { S[i] += rdlane(k, i) * dlt; o += rdlane(q, i) * S[i]; }
        const float ms = wave_sum(o * o) * (1.f / 64.f);
        const float yv = o * rsqrtf(ms + EPS) * siluf_(zv) * mg;
        y[row * 1024 + 768 + h * 64 + lane] = f2bf(yv);
    }
}
__device__ __forceinline__ void fox_cumsum(const float* __restrict__ gates, const float* __restrict__ fb, float* __restrict__ cc, int bh, int lane) {
    const int b = bh >> 2, h = bh & 3;
    const float bias = fb[h];
    float carry = 0.f;
    for (int t0 = 0; t0 < SEQ; t0 += 64) {
        float v = logsigmoidf_(gates[(size_t)(b * SEQ + t0 + lane) * 16 + h] + bias);
#pragma unroll
        for (int o = 1; o < 64; o <<= 1) { float n = __shfl_up(v, o); if (lane >= o) v += n; }
        v += carry;
        cc[(size_t)(b * 4 + h) * SEQ + t0 + lane] = v;
        carry = __shfl(v, 63);
    }
}
__device__ __forceinline__ void lru_prep_task(float* xc  , const bf16_t* __restrict__ proj, const float* __restrict__ conv_w, const float* __restrict__ conv_b,
                                              const float* __restrict__ w_a, const float* __restrict__ b_a, const float* __restrict__ w_x, const float* __restrict__ b_x,
                                              const float* __restrict__ lam, float* __restrict__ a_out, float* __restrict__ u_out, int task, bool active) {
    const int c = threadIdx.x & 255, t0 = task * 16;
    if (active) {
        const float w0 = conv_w[c], w1 = conv_w[256 + c], w2 = conv_w[512 + c], w3 = conv_w[768 + c], cb = conv_b[c];
        for (int i = 0; i < 16; ++i) {
            const int t = t0 + i, s = t & (SEQ - 1);
            const bf16_t* pr = proj + (size_t)t * NP + C_CX + c;
            float acc = cb + w3 * bf2f(pr[0]);
            if (s >= 1) acc += w2 * bf2f(pr[-(ptrdiff_t)NP]);
            if (s >= 2) acc += w1 * bf2f(pr[-(ptrdiff_t)2 * NP]);
            if (s >= 3) acc += w0 * bf2f(pr[-(ptrdiff_t)3 * NP]);
            xc[i * 256 + c] = acc;
        }
    }
    __syncthreads();
    if (active) {
        const int h = c >> 6, jj = c & 63;
        float ra[16], rx[16];
#pragma unroll
        for (int i = 0; i < 16; ++i) { ra[i] = 0.f; rx[i] = 0.f; }
        for (int k = 0; k < 64; ++k) {
            const float wa = w_a[(h * 64 + k) * 64 + jj], wx = w_x[(h * 64 + k) * 64 + jj];
#pragma unroll
            for (int i = 0; i < 16; ++i) { const float xv = xc[i * 256 + h * 64 + k]; ra[i] += xv * wa; rx[i] += xv * wx; }
        }
        const float ba = b_a[c], bx = b_x[c], sp = softplusf_(-lam[c]);
#pragma unroll
        for (int i = 0; i < 16; ++i) {
            const float r = sigmoidf_(ra[i] + ba), ig = sigmoidf_(rx[i] + bx);
            const float log_a = -8.f * r * sp;
            const float a = __expf(log_a);
            const float u = sqrtf(-expm1f(2.f * log_a)) * (ig * xc[i * 256 + c]);
            a_out[(size_t)(t0 + i) * 256 + c] = a; u_out[(size_t)(t0 + i) * 256 + c] = u;
        }
    }
    __syncthreads();
}
__device__ __forceinline__ void lru_scan_task(const float* __restrict__ a_in, const float* __restrict__ u_in, const bf16_t* __restrict__ proj, const float* __restrict__ mix_gain, bf16_t* __restrict__ y, int b) {
    const int c = threadIdx.x;
    const float mg = mix_gain[512 + c];
    float hst = 0.f;
    for (int t = 0; t < SEQ; ++t) {
        const size_t row = (size_t)(b * SEQ + t);
        hst = a_in[row * 256 + c] * hst + u_in[row * 256 + c];
        const float yv = hst * geluf_(bf2f(proj[row * NP + C_CG + c]));
        const float ms = wave_sum(yv * yv) * (1.f / 64.f);
        y[row * 1024 + 512 + c] = f2bf(yv * rsqrtf(ms + EPS) * mg);
    }
}

typedef short s16x4 __attribute__((ext_vector_type(4)));
#define LDS_AS __attribute__((address_space(3)))
__device__ __forceinline__ bf16x8 frag_rm(const bf16_t* tile, int ld, int r0, int k0, int lane) { return *(const bf16x8*)(tile + (r0 + (lane & 15)) * ld + k0 + (lane >> 4) * 8); }
__device__ __forceinline__ s16x4 tr4(const bf16_t* tile, int ld, int rbase, int c0, int lane) {
    const bf16_t* p = tile + (rbase + ((lane & 15) >> 2)) * ld + c0 + 4 * (lane & 3);
    return __builtin_amdgcn_ds_read_tr16_b64_v4i16((LDS_AS s16x4*)p);
}
__device__ __forceinline__ bf16x8 frag_cm(const bf16_t* tile, int ld, int k0, int c0, int lane) {
    const s16x4 lo = tr4(tile, ld, k0 + (lane >> 4) * 8, c0, lane), hi = tr4(tile, ld, k0 + (lane >> 4) * 8 + 4, c0, lane);
    return (bf16x8){lo[0], lo[1], lo[2], lo[3], hi[0], hi[1], hi[2], hi[3]};
}
#define MFMA16(a, b, c) __builtin_amdgcn_mfma_f32_16x16x32_bf16((a), (b), (c), 0, 0, 0)
constexpr int TLD = 72;

__device__ __forceinline__ void attn_task(char* smem, const bf16_t* __restrict__ Q, int ldq, const bf16_t* __restrict__ Kp, int ldk, const bf16_t* __restrict__ Vp, int ldv, const float* __restrict__ bias,
                                          int nq_per_b, int nk_per_b, int causal, float scale, bf16_t* __restrict__ O, int ldo, const float* __restrict__ gain, int rms, int task) {
    bf16_t* sK = (bf16_t*)smem;
    bf16_t* sV = sK + 2 * 64 * TLD;
    float* sC = (float*)(sV + 2 * 64 * TLD);
    const int tid = threadIdx.x, lane = tid & 63, wave = tid >> 6, g = lane >> 4, li = lane & 15;
    const int nqt = nq_per_b / 128;
    const int qt = task % nqt, h = (task / nqt) & 3, b = task / (nqt * 4);
    const int q0 = qt * 128, tq = q0 + wave * 16 + li;
    const size_t qrow = (size_t)b * nq_per_b + tq;
    bf16x8 qf[2];
#pragma unroll
    for (int kk = 0; kk < 2; ++kk) qf[kk] = *(const bf16x8*)(Q + qrow * ldq + h * 64 + kk * 32 + g * 8);
    const float ct = bias ? bias[(size_t)(b * 4 + h) * nq_per_b + tq] : 0.f;
    const int nkt = causal ? (q0 + 128) / 64 : nk_per_b / 64;
    const int sr = tid >> 3, sc = tid & 7;
    const bf16_t* kg = Kp + ((size_t)b * nk_per_b + sr) * ldk + h * 64 + sc * 8;
    const bf16_t* vg = Vp + ((size_t)b * nk_per_b + sr) * ldv + h * 64 + sc * 8;
    const float* cg_ = bias ? bias + (size_t)(b * 4 + h) * nk_per_b : nullptr;
    u32x4 rk = *(const u32x4*)kg, rv = *(const u32x4*)vg; float rc = (cg_ && tid < 64) ? cg_[tid] : 0.f;
    __syncthreads();
    *(u32x4*)(sK + sr * TLD + sc * 8) = rk; *(u32x4*)(sV + sr * TLD + sc * 8) = rv; if (tid < 64) sC[tid] = rc;
    __syncthreads();
    f32x4 oacc[4];
#pragma unroll
    for (int n = 0; n < 4; ++n) oacc[n] = (f32x4){0.f, 0.f, 0.f, 0.f};
    float mrun = -INFINITY, lrun = 0.f;
    for (int kt = 0; kt < nkt; ++kt) {
        const int buf = kt & 1;
        if (kt + 1 < nkt) { rk = *(const u32x4*)(kg + (size_t)(kt + 1) * 64 * ldk); rv = *(const u32x4*)(vg + (size_t)(kt + 1) * 64 * ldv); rc = (cg_ && tid < 64) ? cg_[(kt + 1) * 64 + tid] : 0.f; }
        const bf16_t* cK = sK + buf * 64 * TLD; const bf16_t* cV = sV + buf * 64 * TLD; const float* cC = sC + buf * 64;
        const bool skip = causal && (kt * 64 > q0 + wave * 16 + 15);
        if (!skip) {
            f32x4 sacc[4];
#pragma unroll
            for (int n = 0; n < 4; ++n) {
                sacc[n] = (f32x4){0.f, 0.f, 0.f, 0.f};
#pragma unroll
                for (int kk = 0; kk < 2; ++kk) sacc[n] = MFMA16(frag_rm(cK, TLD, n * 16, kk * 32, lane), qf[kk], sacc[n]);
            }
            float mx = -INFINITY;
#pragma unroll
            for (int n = 0; n < 4; ++n) {
                const f32x4 cs = *(const f32x4*)(cC + n * 16 + 4 * g);
#pragma unroll
                for (int r = 0; r < 4; ++r) {
                    float v = sacc[n][r] * scale + (ct - cs[r]);
                    if (causal && (kt * 64 + n * 16 + 4 * g + r > tq)) v = -INFINITY;
                    sacc[n][r] = v; mx = fmaxf(mx, v);
                }
            }
            mx = fmaxf(mx, __shfl_xor(mx, 16)); mx = fmaxf(mx, __shfl_xor(mx, 32));
            const float mnew = fmaxf(mrun, mx);
            const float corr = __expf(mrun - mnew);
            float rs = 0.f;
#pragma unroll
            for (int n = 0; n < 4; ++n)
#pragma unroll
                for (int r = 0; r < 4; ++r) { const float p = __expf(sacc[n][r] - mnew); sacc[n][r] = p; rs += p; }
            rs += __shfl_xor(rs, 16); rs += __shfl_xor(rs, 32);
            lrun = lrun * corr + rs; mrun = mnew;
            bf16x8 pf[2];
#pragma unroll
            for (int kk = 0; kk < 2; ++kk) {
                const unsigned a0 = pk2(sacc[2 * kk][0], sacc[2 * kk][1]), a1 = pk2(sacc[2 * kk][2], sacc[2 * kk][3]);
                const unsigned a2 = pk2(sacc[2 * kk + 1][0], sacc[2 * kk + 1][1]), a3 = pk2(sacc[2 * kk + 1][2], sacc[2 * kk + 1][3]);
                const u32x4 pk = (u32x4){a0, a1, a2, a3};
                pf[kk] = __builtin_bit_cast(bf16x8, pk);
            }
#pragma unroll
            for (int n2 = 0; n2 < 4; ++n2) {
                oacc[n2] = oacc[n2] * corr;
#pragma unroll
                for (int kk = 0; kk < 2; ++kk) {
                    const s16x4 lo = tr4(cV, TLD, (2 * kk) * 16 + 4 * g, n2 * 16, lane), hi = tr4(cV, TLD, (2 * kk + 1) * 16 + 4 * g, n2 * 16, lane);
                    const bf16x8 vf = (bf16x8){lo[0], lo[1], lo[2], lo[3], hi[0], hi[1], hi[2], hi[3]};
                    oacc[n2] = MFMA16(vf, pf[kk], oacc[n2]);
                }
            }
        }
        if (kt + 1 < nkt) { const int nb = buf ^ 1; *(u32x4*)(sK + nb * 64 * TLD + sr * TLD + sc * 8) = rk; *(u32x4*)(sV + nb * 64 * TLD + sr * TLD + sc * 8) = rv; if (tid < 64) sC[nb * 64 + tid] = rc; }
        __syncthreads();
    }
    const float inv = 1.f / lrun;
    float ms = 0.f;
#pragma unroll
    for (int n = 0; n < 4; ++n) { oacc[n] = oacc[n] * inv; ms += oacc[n][0] * oacc[n][0] + oacc[n][1] * oacc[n][1] + oacc[n][2] * oacc[n][2] + oacc[n][3] * oacc[n][3]; }
    ms += __shfl_xor(ms, 16); ms += __shfl_xor(ms, 32);
    const float rinv = rms ? rsqrtf(ms * (1.f / 64.f) + EPS) : 1.f;
#pragma unroll
    for (int n = 0; n < 4; ++n) {
        const int d = n * 16 + 4 * g;
        f32x4 gg = (f32x4){1.f, 1.f, 1.f, 1.f};
        if (gain) gg = *(const f32x4*)(gain + h * 64 + d);
        uint2 o; o.x = pk2(oacc[n][0] * rinv * gg[0], oacc[n][1] * rinv * gg[1]); o.y = pk2(oacc[n][2] * rinv * gg[2], oacc[n][3] * rinv * gg[3]);
        *(uint2*)(O + qrow * ldo + h * 64 + d) = o;
    }
}

__device__ __forceinline__ void router_phase(char* smem, const float* __restrict__ x, const float* __restrict__ g, const float* __restrict__ w_rg, const float* __restrict__ b_rg,
                                             const float* __restrict__ w_re, const float* __restrict__ b_re, bf16_t* __restrict__ hn, int* __restrict__ cnt, int* __restrict__ list, float* __restrict__ pgate) {
    const int w = threadIdx.x >> 6, lane = threadIdx.x & 63;
    float* sh = (float*)smem + w * 1024;
    float* slog = (float*)smem + 8 * 1024 + w * 64;
    for (int t = blockIdx.x * 8 + w; t < T; t += gridDim.x * 8) {
        const f32x4* xr = (const f32x4*)(x + (size_t)t * 1024) + lane;
        f32x4 v[4]; float s = 0.f;
#pragma unroll
        for (int j = 0; j < 4; ++j) { v[j] = xr[64 * j]; s += v[j].x * v[j].x + v[j].y * v[j].y + v[j].z * v[j].z + v[j].w * v[j].w; }
        const float rinv = rsqrtf(wave_sum(s) * (1.f / 1024.f) + EPS);
#pragma unroll
        for (int j = 0; j < 4; ++j) {
            const f32x4 gg = ((const f32x4*)g)[lane + 64 * j];
            const f32x4 hv = v[j] * rinv * gg;
            *(f32x4*)&sh[(lane + 64 * j) * 4] = hv;
            uint2 o; o.x = pk2(hv.x, hv.y); o.y = pk2(hv.z, hv.w);
            *(uint2*)(hn + (size_t)t * 1024 + (lane + 64 * j) * 4) = o;
        }
        __builtin_amdgcn_wave_barrier();
        float a = 0.f;
        if (lane < 36) {
            const float* wp = lane < 4 ? (w_rg + lane) : (w_re + (lane - 4));
            const int ld = lane < 4 ? 4 : 32;
            for (int k = 0; k < 1024; ++k) a += sh[k] * wp[(size_t)k * ld];
            a += lane < 4 ? b_rg[lane] : b_re[lane - 4];
            slog[lane] = a;
        }
        __builtin_amdgcn_wave_barrier();
        if (lane == 0) {
            const float* lg = slog;
            int gs = 0; float gm = lg[0];
            for (int i = 1; i < 4; ++i) if (lg[i] > gm) { gm = lg[i]; gs = i; }
            float den = 0.f; for (int i = 0; i < 4; ++i) den += __expf(lg[i] - gm);
            const float pg = 1.f / den;
            const float* le = lg + 4 + gs * 8;
            int i0 = 0; float m0 = le[0];
            for (int i = 1; i < 8; ++i) if (le[i] > m0) { m0 = le[i]; i0 = i; }
            int i1 = -1; float m1 = -INFINITY;
            for (int i = 0; i < 8; ++i) if (i != i0 && le[i] > m1) { m1 = le[i]; i1 = i; }
            const float e1 = __expf(m1 - m0); const float w0 = 1.f / (1.f + e1), w1 = e1 / (1.f + e1);
            const int ex0 = gs * 8 + i0, ex1 = gs * 8 + i1;
            const int pos0 = atomicAdd(&cnt[ex0], 1); list[(size_t)ex0 * T + pos0] = 2 * t; pgate[2 * t] = pg * w0;
            const int pos1 = atomicAdd(&cnt[ex1], 1); list[(size_t)ex1 * T + pos1] = 2 * t + 1; pgate[2 * t + 1] = pg * w1;
        }
        __builtin_amdgcn_wave_barrier();
    }
}

__device__ __forceinline__ void combine_phase(const float* x2, const bf16_t* __restrict__ eo, const float* __restrict__ g, float* xout, bf16_t* __restrict__ hn, int mode) {
    const int lane = threadIdx.x & 63;
    for (int t = blockIdx.x * 8 + (threadIdx.x >> 6); t < T; t += gridDim.x * 8) {
        f32x4 v[4]; float s = 0.f;
#pragma unroll
        for (int j = 0; j < 4; ++j) {
            const int c = (lane + 64 * j) * 4;
            v[j] = *(const f32x4*)(x2 + (size_t)t * 1024 + c);
            const uint2 e0 = *(const uint2*)(eo + (size_t)(2 * t) * 1024 + c), e1 = *(const uint2*)(eo + (size_t)(2 * t + 1) * 1024 + c);
            v[j].x += __uint_as_float(e0.x << 16) + __uint_as_float(e1.x << 16);
            v[j].y += __uint_as_float(e0.x & 0xffff0000u) + __uint_as_float(e1.x & 0xffff0000u);
            v[j].z += __uint_as_float(e0.y << 16) + __uint_as_float(e1.y << 16);
            v[j].w += __uint_as_float(e0.y & 0xffff0000u) + __uint_as_float(e1.y & 0xffff0000u);
            s += v[j].x * v[j].x + v[j].y * v[j].y + v[j].z * v[j].z + v[j].w * v[j].w;
        }
        const float rinv = rsqrtf(wave_sum(s) * (1.f / 1024.f) + EPS);
#pragma unroll
        for (int j = 0; j < 4; ++j) {
            const int c = (lane + 64 * j) * 4;
            const f32x4 gg = *(const f32x4*)(g + c);
            const f32x4 hv = v[j] * rinv * gg;
            if (mode == 0) {
                *(f32x4*)(xout + (size_t)t * 1024 + c) = v[j];
                uint2 o; o.x = pk2(hv.x, hv.y); o.y = pk2(hv.z, hv.w);
                *(uint2*)(hn + (size_t)t * 1024 + c) = o;
            } else {
                *(f32x4*)(xout + (size_t)t * 1024 + c) = hv;
            }
        }
    }
}

template <int l>
__device__ __forceinline__ void layer_body(const Params& P, char* smem, cg::grid_group& grid, const float* xcur) {
    char* ws = P.ws;
    bf16_t* Wt_in = (bf16_t*)(ws + OFF_WIN); bf16_t* Wt_out = (bf16_t*)(ws + OFF_WOUT); bf16_t* Wt_mq = (bf16_t*)(ws + OFF_WMQ); bf16_t* Wt_mkv = (bf16_t*)(ws + OFF_WMKV);
    bf16_t* Wt_mo = (bf16_t*)(ws + OFF_WMO); bf16_t* Wt_gu = (bf16_t*)(ws + OFF_WGU); bf16_t* Wt_dn = (bf16_t*)(ws + OFF_WDN);
    bf16_t* hn = (bf16_t*)(ws + OFF_HN); bf16_t* proj = (bf16_t*)(ws + OFF_PROJ); float* gates = (float*)(ws + OFF_GATES); bf16_t* y = (bf16_t*)(ws + OFF_Y);
    float* XA = P.out; float* XB = (float*)(ws + OFF_XB);
    bf16_t* qm = (bf16_t*)(ws + OFF_QM); bf16_t* om = (bf16_t*)(ws + OFF_OM); bf16_t* kvm = (bf16_t*)(ws + OFF_KVM); bf16_t* memn = (bf16_t*)(ws + OFF_MEMN);
    float* foxc = (float*)(ws + OFF_FOXC); float* lrua = (float*)(ws + OFF_LRUA); float* lruu = (float*)(ws + OFF_LRUU);
    int* cnt_all = (int*)(ws + OFF_CNT); int* list = (int*)(ws + OFF_LIST); float* pgate = (float*)(ws + OFF_PGATE);
    bf16_t* act = (bf16_t*)(ws + OFF_ACT); bf16_t* eo = (bf16_t*)(ws + OFF_EO);
    const int wave = threadIdx.x >> 6, lane = threadIdx.x & 63;


        float* x1 = (l == 0) ? XA : XB;
        float* x2 = (l == 0) ? XB : XA;
        int* cnt = cnt_all + 32 * l;
        const float* mg = P.in[I_MIX_GAIN] + l * 1024;
        gemm_phase<EPI_INPROJ>(smem, hn, 1024, Wt_in + (size_t)l * NP * 1024, 1024, T, NP, 1024, proj, NP, nullptr, gates);
        if (l == 0) for (int l2 = 0; l2 < NL; ++l2)
            gemm_phase<EPI_BF16>(smem, memn + (size_t)l2 * 2048 * 1024, 1024, Wt_mkv + (size_t)l2 * 512 * 1024, 1024, 2048, 512, 1024, kvm + (size_t)l2 * 2048 * 512, 512, nullptr, nullptr);
        grid.sync();
        {
            const int bx = blockIdx.x;
            if (bx < 32) {
                if (wave == 0) hgrn2_naive(proj, P.in[I_HGRN_LB], l, mg, y, bx, lane);
                else if (wave == 1) fox_cumsum(gates, P.in[I_FOX_FB] + l * 4, foxc, bx, lane);
            } else if (bx < 64) {
                if (wave == 0) gdn_naive(proj, gates, P.in[I_GDN_CONV_W] + l * 4 * 768, P.in[I_GDN_A_LOG] + l * 4, P.in[I_GDN_DT_BIAS] + l * 4, mg, y, bx - 32, lane);
            } else {
                const int nb = gridDim.x - 64, half = threadIdx.x >> 8;
                for (int base = 0; base < T / 16; base += nb * 2) {
                    const int task = base + (bx - 64) * 2 + half;
                    lru_prep_task((float*)smem + half * 16 * 256, proj, P.in[I_LRU_CONV_W] + l * 1024, P.in[I_LRU_CONV_B] + l * 256, P.in[I_LRU_WA] + l * 16384, P.in[I_LRU_BA] + l * 256,
                                  P.in[I_LRU_WX] + l * 16384, P.in[I_LRU_BX] + l * 256, P.in[I_LRU_LAM] + l * 256, lrua, lruu, task, task < T / 16);
                }
            }
        }
        grid.sync();
        {
            const int natt = (SEQ / 128) * 4 * NB;
            if ((int)blockIdx.x >= NB) {
                for (int i = (int)blockIdx.x - NB; i < natt; i += (int)gridDim.x - NB) {
                    const int qt = 15 - (i >> 5), bh = i & 31;
                    attn_task(smem, proj + C_BQ, NP, proj + C_BK, NP, proj + C_BV, NP, foxc, SEQ, SEQ, 1, 0.125f, y + 256, 1024, mg + 256, 1, (bh * 16) + qt);
                }
            } else if (threadIdx.x < 256) lru_scan_task(lrua, lruu, proj, mg, y, blockIdx.x);
        }
        grid.sync();
        gemm_phase<EPI_RESID>(smem, y, 1024, Wt_out + (size_t)l * 1024 * 1024, 1024, T, 1024, 1024, x1, 1024, xcur, nullptr);
        grid.sync();
        for (int row = blockIdx.x * 8 + wave; row < T; row += gridDim.x * 8) rms_row_bf16(x1 + (size_t)row * 1024, P.in[I_NORM_MEM] + l * 1024, hn + (size_t)row * 1024, lane);
        grid.sync();
        gemm_phase<EPI_BF16>(smem, hn, 1024, Wt_mq + (size_t)l * 256 * 1024, 1024, T, 256, 1024, qm, 256, nullptr, nullptr);
        grid.sync();
        { const bf16_t* kv = kvm + (size_t)l * 2048 * 512;
          BLK_LOOP(task, (SEQ / 128) * 4 * NB) attn_task(smem, qm, 256, kv, 512, kv + 256, 512, nullptr, SEQ, MEMLEN, 0, 0.125f, om, 256, nullptr, 0, task); }
        grid.sync();
        gemm_phase<EPI_RESID>(smem, om, 256, Wt_mo + (size_t)l * 1024 * 256, 256, T, 1024, 256, x2, 1024, x1, nullptr);
        grid.sync();
        router_phase(smem, x2, P.in[I_NORM_FFN] + l * 1024, P.in[I_W_RG] + l * 4096, P.in[I_B_RG] + l * 4, P.in[I_W_RE] + l * 32768, P.in[I_B_RE] + l * 32, hn, cnt, list, pgate);
        grid.sync();
        moe_phase<1>(smem, hn, 1024, Wt_gu + (size_t)l * 32 * 512 * 1024, (size_t)512 * 1024, 1024, 1024, cnt, list, pgate, act);
        grid.sync();
        moe_phase<2>(smem, act, 256, Wt_dn + (size_t)l * 32 * 1024 * 256, (size_t)1024 * 256, 256, 256, cnt, list, pgate, eo);
        grid.sync();
        if (l == 0) { combine_phase(x2, eo, P.in[I_NORM_MIX] + 1024, XA, hn, 0); grid.sync(); }
        else combine_phase(x2, eo, P.in[I_NORM_FINAL], P.out, hn, 1);
}
__global__ void __launch_bounds__(NTHR, 2) mega_kernel(Params P) {
    extern __shared__ __attribute__((aligned(16))) char smem[];
    cg::grid_group grid = cg::this_grid();
    phase0(P, smem);
    grid.sync();
    layer_body<0>(P, smem, grid, P.in[I_X]);
    layer_body<1>(P, smem, grid, P.out);
}

extern "C" void kernel_launch(void* const* d_in, const int* in_sizes, int n_in, void* d_out, int out_size, void* d_ws, size_t ws_size, hipStream_t stream) {
    static int grid_blocks = 0;
    if (grid_blocks == 0) {
        if (n_in != N_INPUTS || ws_size < OFF_END || out_size != T * 1024) { fprintf(stderr, "kernel_launch: unexpected sizes n_in=%d ws=%zu out=%d (need ws >= %zu)\n", n_in, ws_size, out_size, (size_t)OFF_END); grid_blocks = -1; return; }
        int dev = 0, cus = 0, per_cu = 0;
        if (hipGetDevice(&dev) != hipSuccess || hipDeviceGetAttribute(&cus, hipDeviceAttributeMultiprocessorCount, dev) != hipSuccess) { fprintf(stderr, "kernel_launch: device query failed\n"); grid_blocks = -1; return; }
        if (hipFuncSetAttribute((const void*)mega_kernel, hipFuncAttributeMaxDynamicSharedMemorySize, LDS_BYTES) != hipSuccess) { fprintf(stderr, "kernel_launch: hipFuncSetAttribute failed\n"); grid_blocks = -1; return; }
        if (hipOccupancyMaxActiveBlocksPerMultiprocessor(&per_cu, (const void*)mega_kernel, NTHR, LDS_BYTES) != hipSuccess || per_cu < 1) { fprintf(stderr, "kernel_launch: occupancy query says %d blocks/CU\n", per_cu); grid_blocks = -1; return; }
        grid_blocks = cus;
        fprintf(stderr, "kernel_launch: cus=%d per_cu=%d grid=%d\n", cus, per_cu, grid_blocks);
    }
    if (grid_blocks < 0) return;
    Params p; memset(&p, 0, sizeof p);
    for (int i = 0; i < N_INPUTS; ++i) p.in[i] = (const float*)d_in[i];
    p.out = (float*)d_out; p.ws = (char*)d_ws;
    void* args[] = {&p};
    hipError_t e = hipLaunchCooperativeKernel((const void*)mega_kernel, dim3(grid_blocks), dim3(NTHR), args, LDS_BYTES, stream);
    if (e != hipSuccess) fprintf(stderr, "kernel_launch: cooperative launch failed: %s (grid %d)\n", hipGetErrorString(e), grid_blocks);
}
```

```cpp
#include <hip/hip_runtime.h>
#include <stdint.h>
#include <stdio.h>
#include <string.h>
#include <hip/hip_cooperative_groups.h>
namespace cg = cooperative_groups;

typedef unsigned short bf16_t;
typedef short bf16x8 __attribute__((ext_vector_type(8)));
typedef float f32x4 __attribute__((ext_vector_type(4)));
typedef unsigned u32x4 __attribute__((ext_vector_type(4)));

constexpr int NB = 8, SEQ = 2048, DM = 1024, T = NB * SEQ, NL = 2;
constexpr int NP = 3456;
constexpr int NIN = 3340;
constexpr int C_AQ = 0, C_AF = 256, C_AI = 512, C_AG = 768, C_BQ = 1024, C_BK = 1280, C_BV = 1536, C_CX = 1792, C_CG = 2048,
              C_DQ = 2304, C_DK = 2560, C_DV = 2816, C_DZ = 3072, C_GATE = 3328;
constexpr int MEMLEN = 256;
constexpr int NEXP = 32, DEXP = 256;
constexpr float EPS = 1e-6f;

constexpr size_t al256(size_t x) { return (x + 255) & ~(size_t)255; }
constexpr size_t SZ_WIN = (size_t)NP * 1024 * 2, SZ_WOUT = (size_t)1024 * 1024 * 2, SZ_WMQ = (size_t)256 * 1024 * 2, SZ_WMKV = (size_t)512 * 1024 * 2,
                 SZ_WMO = (size_t)1024 * 256 * 2, SZ_WGU = (size_t)32 * 512 * 1024 * 2, SZ_WDN = (size_t)32 * 1024 * 256 * 2;
constexpr size_t OFF_WIN = 0;
constexpr size_t OFF_WOUT = OFF_WIN + NL * SZ_WIN;
constexpr size_t OFF_WMQ = OFF_WOUT + NL * SZ_WOUT;
constexpr size_t OFF_WMKV = OFF_WMQ + NL * SZ_WMQ;
constexpr size_t OFF_WMO = OFF_WMKV + NL * SZ_WMKV;
constexpr size_t OFF_WGU = OFF_WMO + NL * SZ_WMO;
constexpr size_t OFF_WDN = OFF_WGU + NL * SZ_WGU;
constexpr size_t OFF_HN = OFF_WDN + NL * SZ_WDN;
constexpr size_t OFF_PROJ = OFF_HN + (size_t)T * 1024 * 2;
constexpr size_t OFF_GATES = OFF_PROJ + (size_t)T * NP * 2;
constexpr size_t OFF_Y = OFF_GATES + (size_t)T * 16 * 4;
constexpr size_t OFF_XB = OFF_Y + (size_t)T * 1024 * 2;
constexpr size_t OFF_QM = OFF_XB + (size_t)T * 1024 * 4;
constexpr size_t OFF_OM = OFF_QM + (size_t)T * 256 * 2;
constexpr size_t OFF_KVM = OFF_OM + (size_t)T * 256 * 2;
constexpr size_t OFF_MEMN = OFF_KVM + (size_t)NL * 2048 * 512 * 2;
constexpr size_t OFF_FOXC = OFF_MEMN + (size_t)2048 * 1024 * 2;
constexpr size_t OFF_LRUA = OFF_FOXC + (size_t)NB * 4 * SEQ * 4;
constexpr size_t OFF_LRUU = OFF_LRUA + (size_t)T * 256 * 4;
constexpr size_t OFF_CNT = OFF_LRUU + (size_t)T * 256 * 4;
constexpr size_t OFF_LIST = OFF_CNT + 256;
constexpr size_t OFF_PGATE = OFF_LIST + (size_t)NEXP * T * 4;
constexpr size_t OFF_HL = OFF_PGATE + (size_t)2 * T * 4;
constexpr size_t OFF_HD = OFF_HL + (size_t)1024 * 4096 * 4;
constexpr size_t OFF_GDN = OFF_HD + (size_t)1024 * 64 * 4;
constexpr size_t OFF_GLAST = OFF_GDN + (size_t)1024 * 5 * 4096 * 2;
constexpr size_t OFF_LSUM = OFF_GLAST + 4096;
constexpr size_t OFF_END = OFF_LSUM + (size_t)2 * 256 * 256 * 4;
constexpr size_t OFF_ACT = OFF_PROJ;
constexpr size_t OFF_EO = OFF_PROJ + (size_t)2 * T * 256 * 2;
static_assert(OFF_EO + (size_t)2 * T * 1024 * 2 <= OFF_GATES, "overlay fits");

__device__ __forceinline__ float bf2f(bf16_t v) { return __uint_as_float(((unsigned)v) << 16); }
__device__ __forceinline__ bf16_t f2bf(float f) { unsigned u = __float_as_uint(f); return (bf16_t)((u + 0x7fffu + ((u >> 16) & 1u)) >> 16); }
__device__ __forceinline__ unsigned pk2(float lo, float hi) { return (unsigned)f2bf(lo) | ((unsigned)f2bf(hi) << 16); }
__device__ __forceinline__ float sigmoidf_(float x) { return 1.f / (1.f + __expf(-x)); }
__device__ __forceinline__ float siluf_(float x) { return x / (1.f + __expf(-x)); }
__device__ __forceinline__ float softplusf_(float x) { return x > 20.f ? x : log1pf(__expf(x)); }
__device__ __forceinline__ float logsigmoidf_(float x) { return x < 0.f ? x - log1pf(__expf(x)) : -log1pf(__expf(-x)); }
__device__ __forceinline__ float geluf_(float x) { float u = 0.7978845608028654f * (x + 0.044715f * x * x * x); return 0.5f * x * (1.f + tanhf(u)); }
__device__ __forceinline__ float wave_sum(float v) {
#pragma unroll
    for (int o = 1; o < 64; o <<= 1) v += __shfl_xor(v, o);
    return v;
}
__device__ __forceinline__ float rdlane(float v, int l) { return __int_as_float(__builtin_amdgcn_readlane(__float_as_int(v), l)); }

constexpr int NTHR = 512;
constexpr int LDS_BYTES = 147456;
enum { I_X = 0, I_MEM, I_NORM_MIX, I_W_IN, I_HGRN_LB, I_FOX_FB, I_LRU_CONV_W, I_LRU_CONV_B, I_LRU_WA, I_LRU_BA, I_LRU_WX, I_LRU_BX, I_LRU_LAM, I_GDN_CONV_W, I_GDN_A_LOG,
       I_GDN_DT_BIAS, I_MIX_GAIN, I_W_OUT, I_NORM_MEM, I_NORM_MEMKV, I_W_MQ, I_W_MKV, I_W_MO, I_NORM_FFN, I_W_RG, I_B_RG, I_W_RE, I_B_RE, I_W_E_GU, I_W_E_DN, I_NORM_FINAL, N_INPUTS };
struct Params { const float* in[N_INPUTS]; float* out; char* ws; };
static_assert(sizeof(Params) == 8 * (N_INPUTS + 2), "no padding");

#define BLK_LOOP(it, n) for (int it = (int)blockIdx.x; it < (n); it += (int)gridDim.x)

__device__ __forceinline__ int rowmap_fn(int mode, int n) {
    if (mode == 1) {
        if (n < 1792) return n;
        if (n < 1796) return C_GATE + (n - 1792);
        if (n < 3076) return n - 4;
        if (n < 3084) return C_GATE + 4 + (n - 3076);
        return n - 12;
    } else if (mode == 2) {
        int j = n & 255; return (j >> 4) * 32 + ((n >= 256) ? 16 : 0) + (j & 15);
    }
    return n;
}
__device__ __forceinline__ void convT_tile(float* tile  , const float* __restrict__ src, int K, int N, bf16_t* __restrict__ dst, int mode, int ntn, int idx) {
    const int n0 = (idx % ntn) * 64, k0 = (idx / ntn) * 64;
    const int tx = threadIdx.x & 63, ty = threadIdx.x >> 6;
    __syncthreads();
#pragma unroll
    for (int i = 0; i < 8; ++i) {
        const int k = ty + i * 8, n = n0 + tx;
        tile[k * 65 + tx] = (n < N) ? src[(size_t)(k0 + k) * N + n] : 0.f;
    }
    __syncthreads();
    const int kx = threadIdx.x & 31, ny = threadIdx.x >> 5;
#pragma unroll
    for (int i = 0; i < 4; ++i) {
        const int nl = ny + i * 16, n = n0 + nl;
        if (n < N) {
            const int r = rowmap_fn(mode, n);
            *(unsigned*)(dst + (size_t)r * K + k0 + 2 * kx) = pk2(tile[(2 * kx) * 65 + nl], tile[(2 * kx + 1) * 65 + nl]);
        }
    }
}
__device__ __forceinline__ void rms_row_bf16(const float* __restrict__ xrow, const float* __restrict__ g, bf16_t* __restrict__ orow, int lane) {
    const f32x4* xr = (const f32x4*)xrow + lane;
    f32x4 v[4]; float s = 0.f;
#pragma unroll
    for (int j = 0; j < 4; ++j) { v[j] = xr[64 * j]; s += v[j].x * v[j].x + v[j].y * v[j].y + v[j].z * v[j].z + v[j].w * v[j].w; }
    const float rinv = rsqrtf(wave_sum(s) * (1.f / 1024.f) + EPS);
#pragma unroll
    for (int j = 0; j < 4; ++j) {
        const f32x4 gg = ((const f32x4*)g)[lane + 64 * j];
        uint2 o; o.x = pk2(v[j].x * rinv * gg.x, v[j].y * rinv * gg.y); o.y = pk2(v[j].z * rinv * gg.z, v[j].w * rinv * gg.w);
        *(uint2*)(orow + (lane + 64 * j) * 4) = o;
    }
}

constexpr int CT_PER_LAYER = 53 * 16 + 256 + 64 + 128 + 64;
constexpr int CT_GU = 64 * 128, CT_DN = 64 * 64;
constexpr int CT_TOTAL = NL * CT_PER_LAYER + CT_GU + CT_DN;

__device__ __forceinline__ void phase0(const Params& P, char* smem) {
    char* ws = P.ws;
    float* tile = (float*)smem;
    BLK_LOOP(it, CT_TOTAL) {
        int r = it;
        if (r < NL * CT_PER_LAYER) {
            const int l = r / CT_PER_LAYER; r -= l * CT_PER_LAYER;
            if (r < 848) { convT_tile(tile, P.in[I_W_IN] + (size_t)l * 1024 * NIN, 1024, NIN, (bf16_t*)(ws + OFF_WIN) + (size_t)l * NP * 1024, 1, 53, r); continue; } r -= 848;
            if (r < 256) { convT_tile(tile, P.in[I_W_OUT] + (size_t)l * 1024 * 1024, 1024, 1024, (bf16_t*)(ws + OFF_WOUT) + (size_t)l * 1024 * 1024, 0, 16, r); continue; } r -= 256;
            if (r < 64) { convT_tile(tile, P.in[I_W_MQ] + (size_t)l * 1024 * 256, 1024, 256, (bf16_t*)(ws + OFF_WMQ) + (size_t)l * 256 * 1024, 0, 4, r); continue; } r -= 64;
            if (r < 128) { convT_tile(tile, P.in[I_W_MKV] + (size_t)l * 1024 * 512, 1024, 512, (bf16_t*)(ws + OFF_WMKV) + (size_t)l * 512 * 1024, 0, 8, r); continue; } r -= 128;
            convT_tile(tile, P.in[I_W_MO] + (size_t)l * 256 * 1024, 256, 1024, (bf16_t*)(ws + OFF_WMO) + (size_t)l * 1024 * 256, 0, 16, r); continue;
        }
        r -= NL * CT_PER_LAYER;
        if (r < CT_GU) { const int m = r >> 7; convT_tile(tile, P.in[I_W_E_GU] + (size_t)m * 1024 * 512, 1024, 512, (bf16_t*)(ws + OFF_WGU) + (size_t)m * 512 * 1024, 2, 8, r & 127); continue; }
        r -= CT_GU;
        { const int m = r >> 6; convT_tile(tile, P.in[I_W_E_DN] + (size_t)m * 256 * 1024, 256, 1024, (bf16_t*)(ws + OFF_WDN) + (size_t)m * 1024 * 256, 0, 16, r & 63); }
    }
    for (int i = blockIdx.x * NTHR + threadIdx.x; i < NL * (NP - NIN) * 512; i += gridDim.x * NTHR) {
        const int l = i / ((NP - NIN) * 512), w = i % ((NP - NIN) * 512);
        ((unsigned*)((bf16_t*)(ws + OFF_WIN) + (size_t)l * NP * 1024 + (size_t)NIN * 1024))[w] = 0u;
    }
    if (blockIdx.x == 0 && threadIdx.x < 64) ((int*)(ws + OFF_CNT))[threadIdx.x] = 0;
    const int gw = blockIdx.x * 8 + (threadIdx.x >> 6), ngw = gridDim.x * 8, lane = threadIdx.x & 63;
    for (int row = gw; row < T + NL * 2048; row += ngw) {
        if (row < T) rms_row_bf16(P.in[I_X] + (size_t)row * 1024, P.in[I_NORM_MIX], (bf16_t*)(ws + OFF_HN) + (size_t)row * 1024, lane);
        else { const int r2 = row - T, l = r2 >> 11, rr = r2 & 2047;
               rms_row_bf16(P.in[I_MEM] + (size_t)rr * 1024, P.in[I_NORM_MEMKV] + l * 1024, (bf16_t*)(ws + OFF_MEMN) + (size_t)r2 * 1024, lane); }
    }
}

constexpr int GLD = 72;
constexpr int GEMM_LDS = (256 + 128) * GLD * 2;
template <class RowPtr>
__device__ __forceinline__ void gemm_tile(char* smem, RowPtr rowptr, const bf16_t* __restrict__ Bt, int ldb, int n0, int K, f32x4 (&acc)[4][4]) {
    bf16_t* sA = (bf16_t*)smem; bf16_t* sB = sA + 256 * GLD;
    const int tid = threadIdx.x, lane = tid & 63, wave = tid >> 6, wm = wave >> 1, wn = wave & 1;
    const u32x4* ga[4]; const u32x4* gb[2];
#pragma unroll
    for (int i = 0; i < 4; ++i) { const int c = tid + i * 512, r = c >> 3, ch = c & 7; ga[i] = (const u32x4*)(rowptr(r) + ch * 8); }
#pragma unroll
    for (int i = 0; i < 2; ++i) { const int c = tid + i * 512, r = c >> 3, ch = c & 7; gb[i] = (const u32x4*)(Bt + (size_t)(n0 + r) * ldb + ch * 8); }
#pragma unroll
    for (int m = 0; m < 4; ++m)
#pragma unroll
        for (int n = 0; n < 4; ++n) acc[m][n] = (f32x4){0.f, 0.f, 0.f, 0.f};
    u32x4 ra[4], rb[2];
#pragma unroll
    for (int i = 0; i < 4; ++i) ra[i] = ga[i][0];
#pragma unroll
    for (int i = 0; i < 2; ++i) rb[i] = gb[i][0];
    const int nk = K / 64;
    for (int kt = 0; kt < nk; ++kt) {
        __syncthreads();
#pragma unroll
        for (int i = 0; i < 4; ++i) { const int c = tid + i * 512, r = c >> 3, ch = c & 7; *(u32x4*)(sA + r * GLD + ch * 8) = ra[i]; }
#pragma unroll
        for (int i = 0; i < 2; ++i) { const int c = tid + i * 512, r = c >> 3, ch = c & 7; *(u32x4*)(sB + r * GLD + ch * 8) = rb[i]; }
        __syncthreads();
        if (kt + 1 < nk) {
#pragma unroll
            for (int i = 0; i < 4; ++i) ra[i] = ga[i][(kt + 1) * 8];
#pragma unroll
            for (int i = 0; i < 2; ++i) rb[i] = gb[i][(kt + 1) * 8];
        }
#pragma unroll
        for (int kk = 0; kk < 2; ++kk) {
            bf16x8 af[4], bfr[4];
#pragma unroll
            for (int m = 0; m < 4; ++m) af[m] = *(const bf16x8*)(sA + (wm * 64 + m * 16 + (lane & 15)) * GLD + kk * 32 + (lane >> 4) * 8);
#pragma unroll
            for (int n = 0; n < 4; ++n) bfr[n] = *(const bf16x8*)(sB + (wn * 64 + n * 16 + (lane & 15)) * GLD + kk * 32 + (lane >> 4) * 8);
#pragma unroll
            for (int m = 0; m < 4; ++m)
#pragma unroll
                for (int n = 0; n < 4; ++n) acc[m][n] = __builtin_amdgcn_mfma_f32_16x16x32_bf16(bfr[n], af[m], acc[m][n], 0, 0, 0);
        }
    }
}
struct RowDirect { const bf16_t* A; int lda; int m0; __device__ __forceinline__ const bf16_t* operator()(int r) const { return A + (size_t)(m0 + r) * lda; } };
enum { EPI_INPROJ = 0, EPI_RESID = 1, EPI_BF16 = 2 };

__device__ __forceinline__ int vcu_id() { const int G = gridDim.x, bx = blockIdx.x; return (G % 8 == 0) ? (bx % 8) * (G / 8) + bx / 8 : bx; }

template <int EPI>
__device__ __forceinline__ void gemm_phase(char* smem, const bf16_t* A, int lda, const bf16_t* Bt, int ldb, int M, int N, int K, void* out, int ldo, const float* resid, float* gates) {
    const int ntn = N / 128, ntiles = (M / 256) * ntn;
    const int lane = threadIdx.x & 63, wave = threadIdx.x >> 6, wm = wave >> 1, wn = wave & 1;
    for (int tIdx = vcu_id(); tIdx < ntiles; tIdx += gridDim.x) {
        const int m0 = (tIdx / ntn) * 256, n0 = (tIdx % ntn) * 128;
        f32x4 acc[4][4];
        RowDirect rp{A, lda, m0};
        gemm_tile(smem, rp, Bt, ldb, n0, K, acc);
#pragma unroll
        for (int m = 0; m < 4; ++m)
#pragma unroll
            for (int n = 0; n < 4; ++n) {
                const int row = m0 + wm * 64 + m * 16 + (lane & 15), col = n0 + wn * 64 + n * 16 + (lane >> 4) * 4;
                const f32x4 v = acc[m][n];
                if (EPI == EPI_INPROJ) {
                    uint2 o; o.x = pk2(v.x, v.y); o.y = pk2(v.z, v.w);
                    *(uint2*)((bf16_t*)out + (size_t)row * ldo + col) = o;
                    if (col >= C_GATE && col < C_GATE + 16) *(f32x4*)(gates + (size_t)row * 16 + (col - C_GATE)) = v;
                } else if (EPI == EPI_RESID) {
                    const f32x4 r = *(const f32x4*)(resid + (size_t)row * ldo + col);
                    *(f32x4*)((float*)out + (size_t)row * ldo + col) = r + v;
                } else {
                    uint2 o; o.x = pk2(v.x, v.y); o.y = pk2(v.z, v.w);
                    *(uint2*)((bf16_t*)out + (size_t)row * ldo + col) = o;
                }
            }
    }
}

struct RowGather { const bf16_t* A; int lda; const int* ids; int shift; __device__ __forceinline__ const bf16_t* operator()(int r) const { return A + (size_t)(ids[r] >> shift) * lda; } };
template <int STAGE>
__device__ __forceinline__ void moe_phase(char* smem, const bf16_t* A, int lda, const bf16_t* Wt, size_t wstride, int ldb, int K, const int* cnt, const int* list, const float* pgate, bf16_t* out) {
    int* ids = (int*)(smem + GEMM_LDS);
    int* tpre = ids + 256;
    constexpr int NTN = (STAGE == 1) ? 4 : 8;
    __syncthreads();
    if (threadIdx.x == 0) { int a = 0; for (int i = 0; i < NEXP; ++i) { tpre[i] = a; a += (cnt[i] + 255) >> 8; } tpre[NEXP] = a; }
    __syncthreads();
    const int ntiles = tpre[NEXP] * NTN;
    const int lane = threadIdx.x & 63, wave = threadIdx.x >> 6, wm = wave >> 1, wn = wave & 1;
    for (int tIdx = vcu_id(); tIdx < ntiles; tIdx += gridDim.x) {
        const int mtg = tIdx / NTN, n0 = (tIdx % NTN) * 128;
        int e = 0;
        for (int i = 1; i < NEXP; ++i) if (tpre[i] <= mtg) e = i;
        const int mt = mtg - tpre[e];
        const int cn = cnt[e];
        __syncthreads();
        if (threadIdx.x < 256) { const int pos = mt * 256 + threadIdx.x; ids[threadIdx.x] = list[(size_t)e * T + (pos < cn ? pos : cn - 1)]; }
        __syncthreads();
        f32x4 acc[4][4];
        RowGather rp{A, lda, ids, STAGE == 1 ? 1 : 0};
        gemm_tile(smem, rp, Wt + (size_t)e * wstride, ldb, n0, K, acc);
#pragma unroll
        for (int m = 0; m < 4; ++m) {
            const int rl = wm * 64 + m * 16 + (lane & 15);
            if (mt * 256 + rl >= cn) continue;
            const int pid = ids[rl];
            if (STAGE == 1) {
                const float gt = pgate[pid];
#pragma unroll
                for (int np = 0; np < 2; ++np) {
                    const f32x4 g = acc[m][2 * np], u = acc[m][2 * np + 1];
                    const int j = (n0 + wn * 64 + np * 32) / 2 + (lane >> 4) * 4;
                    uint2 o; o.x = pk2(siluf_(g.x) * u.x * gt, siluf_(g.y) * u.y * gt); o.y = pk2(siluf_(g.z) * u.z * gt, siluf_(g.w) * u.w * gt);
                    *(uint2*)(out + (size_t)pid * DEXP + j) = o;
                }
            } else {
#pragma unroll
                for (int n = 0; n < 4; ++n) {
                    const f32x4 v = acc[m][n]; const int col = n0 + wn * 64 + n * 16 + (lane >> 4) * 4;
                    uint2 o; o.x = pk2(v.x, v.y); o.y = pk2(v.z, v.w);
                    *(uint2*)(out + (size_t)pid * 1024 + col) = o;
                }
            }
        }
    }
}

__device__ __forceinline__ void hgrn2_naive(const bf16_t* __restrict__ proj, const float* __restrict__ hgrn_lb, int layer, const float* __restrict__ mix_gain, bf16_t* __restrict__ y, int bh, int lane) {
    const int b = bh >> 2, h = bh & 3;
    float lbk = 0.f;
    if (layer == 1) { float a0 = hgrn_lb[h * 64 + lane], a1 = hgrn_lb[256 + h * 64 + lane]; lbk = 1.f / (1.f + __expf(a0 - a1)); }
    const float mg = mix_gain[C_AQ + h * 64 + lane];
    float S[64];
#pragma unroll
    for (int k = 0; k < 64; ++k) S[k] = 0.f;
    for (int t = 0; t < SEQ; ++t) {
        const bf16_t* pr = proj + (size_t)(b * SEQ + t) * NP + h * 64 + lane;
        const float qk = siluf_(bf2f(pr[C_AQ]));
        const float sg = sigmoidf_(bf2f(pr[C_AF]));
        const float f = lbk + (1.f - lbk) * sg, kk = (1.f - lbk) * (1.f - sg);
        const float iv = bf2f(pr[C_AI]);
        const float gv = bf2f(pr[C_AG]);
        float o = 0.f;
#pragma unroll
        for (int k = 0; k < 64; ++k) { S[k] = rdlane(f, k) * S[k] + rdlane(kk, k) * iv; o += rdlane(qk, k) * S[k]; }
        const float ms = wave_sum(o * o) * (1.f / 64.f);
        const float yv = o * rsqrtf(ms + EPS) * siluf_(gv) * mg;
        y[(size_t)(b * SEQ + t) * 1024 + 0 + h * 64 + lane] = f2bf(yv);
    }
}
__device__ __forceinline__ void gdn_naive(const bf16_t* __restrict__ proj, const float* __restrict__ gates, const float* __restrict__ conv_w  ,
                                          const float* __restrict__ a_log, const float* __restrict__ dt_bias, const float* __restrict__ mix_gain, bf16_t* __restrict__ y, int bh, int lane) {
    const int b = bh >> 2, h = bh & 3;
    float wq[4], wk[4], wv[4];
#pragma unroll
    for (int j = 0; j < 4; ++j) { wq[j] = conv_w[j * 768 + h * 64 + lane]; wk[j] = conv_w[j * 768 + 256 + h * 64 + lane]; wv[j] = conv_w[j * 768 + 512 + h * 64 + lane]; }
    float xq[3] = {0.f, 0.f, 0.f}, xk[3] = {0.f, 0.f, 0.f}, xv[3] = {0.f, 0.f, 0.f};
    const float Aexp = __expf(a_log[h]), dtb = dt_bias[h];
    const float mg = mix_gain[768 + h * 64 + lane];
    float S[64];
#pragma unroll
    for (int k = 0; k < 64; ++k) S[k] = 0.f;
    for (int t = 0; t < SEQ; ++t) {
        const size_t row = (size_t)(b * SEQ + t);
        const bf16_t* pr = proj + row * NP + h * 64 + lane;
        const float q0 = bf2f(pr[C_DQ]), k0 = bf2f(pr[C_DK]), v0 = bf2f(pr[C_DV]), zv = bf2f(pr[C_DZ]);
        float q = siluf_(wq[0] * xq[0] + wq[1] * xq[1] + wq[2] * xq[2] + wq[3] * q0);
        float k = siluf_(wk[0] * xk[0] + wk[1] * xk[1] + wk[2] * xk[2] + wk[3] * k0);
        float v = siluf_(wv[0] * xv[0] + wv[1] * xv[1] + wv[2] * xv[2] + wv[3] * v0);
        xq[0] = xq[1]; xq[1] = xq[2]; xq[2] = q0; xk[0] = xk[1]; xk[1] = xk[2]; xk[2] = k0; xv[0] = xv[1]; xv[1] = xv[2]; xv[2] = v0;
        q = q * rsqrtf(wave_sum(q * q) + EPS) * 0.125f;
        k = k * rsqrtf(wave_sum(k * k) + EPS);
        const float beta = sigmoidf_(gates[row * 16 + 4 + h]);
        const float g = -Aexp * softplusf_(gates[row * 16 + 8 + h] + dtb);
        const float eg = __expf(g);
        float r = 0.f;
#pragma unroll
        for (int i = 0; i < 64; ++i) { S[i] *= eg; r += rdlane(k, i) * S[i]; }
        const float dlt = beta * (v - r);
        float o = 0.f;
#pragma unroll
        for (int i = 0; i < 64; ++i) { S[i] += rdlane(k, i) * dlt; o += rdlane(q, i) * S[i]; }
        const float ms = wave_sum(o * o) * (1.f / 64.f);
        const float yv = o * rsqrtf(ms + EPS) * siluf_(zv) * mg;
        y[row * 1024 + 768 + h * 64 + lane] = f2bf(yv);
    }
}
__device__ __forceinline__ void fox_cumsum(const float* __restrict__ gates, const float* __restrict__ fb, float* __restrict__ cc, int bh, int lane) {
    const int b = bh >> 2, h = bh & 3;
    const float bias = fb[h];
    float carry = 0.f;
    for (int t0 = 0; t0 < SEQ; t0 += 64) {
        float v = logsigmoidf_(gates[(size_t)(b * SEQ + t0 + lane) * 16 + h] + bias);
#pragma unroll
        for (int o = 1; o < 64; o <<= 1) { float n = __shfl_up(v, o); if (lane >= o) v += n; }
        v += carry;
        cc[(size_t)(b * 4 + h) * SEQ + t0 + lane] = v;
        carry = __shfl(v, 63);
    }
}
__device__ __forceinline__ void lru_prep_task(float* xc  , const bf16_t* __restrict__ proj, const float* __restrict__ conv_w, const float* __restrict__ conv_b,
                                              const float* __restrict__ w_a, const float* __restrict__ b_a, const float* __restrict__ w_x, const float* __restrict__ b_x,
                                              const float* __restrict__ lam, float* __restrict__ a_out, float* __restrict__ u_out, int task, bool active) {
    const int c = threadIdx.x & 255, t0 = task * 16;
    if (active) {
        const float w0 = conv_w[c], w1 = conv_w[256 + c], w2 = conv_w[512 + c], w3 = conv_w[768 + c], cb = conv_b[c];
        for (int i = 0; i < 16; ++i) {
            const int t = t0 + i, s = t & (SEQ - 1);
            const bf16_t* pr = proj + (size_t)t * NP + C_CX + c;
            float acc = cb + w3 * bf2f(pr[0]);
            if (s >= 1) acc += w2 * bf2f(pr[-(ptrdiff_t)NP]);
            if (s >= 2) acc += w1 * bf2f(pr[-(ptrdiff_t)2 * NP]);
            if (s >= 3) acc += w0 * bf2f(pr[-(ptrdiff_t)3 * NP]);
            xc[i * 256 + c] = acc;
        }
    }
    __syncthreads();
    if (active) {
        const int h = c >> 6, jj = c & 63;
        float ra[16], rx[16];
#pragma unroll
        for (int i = 0; i < 16; ++i) { ra[i] = 0.f; rx[i] = 0.f; }
        for (int k = 0; k < 64; ++k) {
            const float wa = w_a[(h * 64 + k) * 64 + jj], wx = w_x[(h * 64 + k) * 64 + jj];
#pragma unroll
            for (int i = 0; i < 16; ++i) { const float xv = xc[i * 256 + h * 64 + k]; ra[i] += xv * wa; rx[i] += xv * wx; }
        }
        const float ba = b_a[c], bx = b_x[c], sp = softplusf_(-lam[c]);
#pragma unroll
        for (int i = 0; i < 16; ++i) {
            const float r = sigmoidf_(ra[i] + ba), ig = sigmoidf_(rx[i] + bx);
            const float log_a = -8.f * r * sp;
            const float a = __expf(log_a);
            const float u = sqrtf(-expm1f(2.f * log_a)) * (ig * xc[i * 256 + c]);
            a_out[(size_t)(t0 + i) * 256 + c] = a; u_out[(size_t)(t0 + i) * 256 + c] = u;
        }
    }
    __syncthreads();
}
__device__ __forceinline__ void lru_scan_task(const float* __restrict__ a_in, const float* __restrict__ u_in, const bf16_t* __restrict__ proj, const float* __restrict__ mix_gain, bf16_t* __restrict__ y, int b) {
    const int c = threadIdx.x;
    const float mg = mix_gain[512 + c];
    float hst = 0.f;
    for (int t = 0; t < SEQ; ++t) {
        const size_t row = (size_t)(b * SEQ + t);
        hst = a_in[row * 256 + c] * hst + u_in[row * 256 + c];
        const float yv = hst * geluf_(bf2f(proj[row * NP + C_CG + c]));
        const float ms = wave_sum(yv * yv) * (1.f / 64.f);
        y[row * 1024 + 512 + c] = f2bf(yv * rsqrtf(ms + EPS) * mg);
    }
}

typedef short s16x4 __attribute__((ext_vector_type(4)));
#define LDS_AS __attribute__((address_space(3)))
__device__ __forceinline__ bf16x8 frag_rm(const bf16_t* tile, int ld, int r0, int k0, int lane) { return *(const bf16x8*)(tile + (r0 + (lane & 15)) * ld + k0 + (lane >> 4) * 8); }
__device__ __forceinline__ s16x4 tr4(const bf16_t* tile, int ld, int rbase, int c0, int lane) {
    const bf16_t* p = tile + (rbase + ((lane & 15) >> 2)) * ld + c0 + 4 * (lane & 3);
    return __builtin_amdgcn_ds_read_tr16_b64_v4i16((LDS_AS s16x4*)p);
}
__device__ __forceinline__ bf16x8 frag_cm(const bf16_t* tile, int ld, int k0, int c0, int lane) {
    const s16x4 lo = tr4(tile, ld, k0 + (lane >> 4) * 8, c0, lane), hi = tr4(tile, ld, k0 + (lane >> 4) * 8 + 4, c0, lane);
    return (bf16x8){lo[0], lo[1], lo[2], lo[3], hi[0], hi[1], hi[2], hi[3]};
}
#define MFMA16(a, b, c) __builtin_amdgcn_mfma_f32_16x16x32_bf16((a), (b), (c), 0, 0, 0)
constexpr int TLD = 72;

__device__ __forceinline__ void attn_task(char* smem, const bf16_t* __restrict__ Q, int ldq, const bf16_t* __restrict__ Kp, int ldk, const bf16_t* __restrict__ Vp, int ldv, const float* __restrict__ bias,
                                          int nq_per_b, int nk_per_b, int causal, float scale, bf16_t* __restrict__ O, int ldo, const float* __restrict__ gain, int rms, int task) {
    bf16_t* sK = (bf16_t*)smem;
    bf16_t* sV = sK + 2 * 64 * TLD;
    float* sC = (float*)(sV + 2 * 64 * TLD);
    const int tid = threadIdx.x, lane = tid & 63, wave = tid >> 6, g = lane >> 4, li = lane & 15;
    const int nqt = nq_per_b / 128;
    const int qt = task % nqt, h = (task / nqt) & 3, b = task / (nqt * 4);
    const int q0 = qt * 128, tq = q0 + wave * 16 + li;
    const size_t qrow = (size_t)b * nq_per_b + tq;
    bf16x8 qf[2];
#pragma unroll
    for (int kk = 0; kk < 2; ++kk) qf[kk] = *(const bf16x8*)(Q + qrow * ldq + h * 64 + kk * 32 + g * 8);
    const float ct = bias ? bias[(size_t)(b * 4 + h) * nq_per_b + tq] : 0.f;
    const int nkt = causal ? (q0 + 128) / 64 : nk_per_b / 64;
    const int sr = tid >> 3, sc = tid & 7;
    const bf16_t* kg = Kp + ((size_t)b * nk_per_b + sr) * ldk + h * 64 + sc * 8;
    const bf16_t* vg = Vp + ((size_t)b * nk_per_b + sr) * ldv + h * 64 + sc * 8;
    const float* cg_ = bias ? bias + (size_t)(b * 4 + h) * nk_per_b : nullptr;
    u32x4 rk = *(const u32x4*)kg, rv = *(const u32x4*)vg; float rc = (cg_ && tid < 64) ? cg_[tid] : 0.f;
    __syncthreads();
    *(u32x4*)(sK + sr * TLD + sc * 8) = rk; *(u32x4*)(sV + sr * TLD + sc * 8) = rv; if (tid < 64) sC[tid] = rc;
    __syncthreads();
    f32x4 oacc[4];
#pragma unroll
    for (int n = 0; n < 4; ++n) oacc[n] = (f32x4){0.f, 0.f, 0.f, 0.f};
    float mrun = -INFINITY, lrun = 0.f;
    for (int kt = 0; kt < nkt; ++kt) {
        const int buf = kt & 1;
        if (kt + 1 < nkt) { rk = *(const u32x4*)(kg + (size_t)(kt + 1) * 64 * ldk); rv = *(const u32x4*)(vg + (size_t)(kt + 1) * 64 * ldv); rc = (cg_ && tid < 64) ? cg_[(kt + 1) * 64 + tid] : 0.f; }
        const bf16_t* cK = sK + buf * 64 * TLD; const bf16_t* cV = sV + buf * 64 * TLD; const float* cC = sC + buf * 64;
        const bool skip = causal && (kt * 64 > q0 + wave * 16 + 15);
        if (!skip) {
            f32x4 sacc[4];
#pragma unroll
            for (int n = 0; n < 4; ++n) {
                sacc[n] = (f32x4){0.f, 0.f, 0.f, 0.f};
#pragma unroll
                for (int kk = 0; kk < 2; ++kk) sacc[n] = MFMA16(frag_rm(cK, TLD, n * 16, kk * 32, lane), qf[kk], sacc[n]);
            }
            float mx = -INFINITY;
#pragma unroll
            for (int n = 0; n < 4; ++n) {
                const f32x4 cs = *(const f32x4*)(cC + n * 16 + 4 * g);
#pragma unroll
                for (int r = 0; r < 4; ++r) {
                    float v = sacc[n][r] * scale + (ct - cs[r]);
                    if (causal && (kt * 64 + n * 16 + 4 * g + r > tq)) v = -INFINITY;
                    sacc[n][r] = v; mx = fmaxf(mx, v);
                }
            }
            mx = fmaxf(mx, __shfl_xor(mx, 16)); mx = fmaxf(mx, __shfl_xor(mx, 32));
            const float mnew = fmaxf(mrun, mx);
            const float corr = __expf(mrun - mnew);
            float rs = 0.f;
#pragma unroll
            for (int n = 0; n < 4; ++n)
#pragma unroll
                for (int r = 0; r < 4; ++r) { const float p = __expf(sacc[n][r] - mnew); sacc[n][r] = p; rs += p; }
            rs += __shfl_xor(rs, 16); rs += __shfl_xor(rs, 32);
            lrun = lrun * corr + rs; mrun = mnew;
            bf16x8 pf[2];
#pragma unroll
            for (int kk = 0; kk < 2; ++kk) {
                const unsigned a0 = pk2(sacc[2 * kk][0], sacc[2 * kk][1]), a1 = pk2(sacc[2 * kk][2], sacc[2 * kk][3]);
                const unsigned a2 = pk2(sacc[2 * kk + 1][0], sacc[2 * kk + 1][1]), a3 = pk2(sacc[2 * kk + 1][2], sacc[2 * kk + 1][3]);
                const u32x4 pk = (u32x4){a0, a1, a2, a3};
                pf[kk] = __builtin_bit_cast(bf16x8, pk);
            }
#pragma unroll
            for (int n2 = 0; n2 < 4; ++n2) {
                oacc[n2] = oacc[n2] * corr;
#pragma unroll
                for (int kk = 0; kk < 2; ++kk) {
                    const s16x4 lo = tr4(cV, TLD, (2 * kk) * 16 + 4 * g, n2 * 16, lane), hi = tr4(cV, TLD, (2 * kk + 1) * 16 + 4 * g, n2 * 16, lane);
                    const bf16x8 vf = (bf16x8){lo[0], lo[1], lo[2], lo[3], hi[0], hi[1], hi[2], hi[3]};
                    oacc[n2] = MFMA16(vf, pf[kk], oacc[n2]);
                }
            }
        }
        if (kt + 1 < nkt) { const int nb = buf ^ 1; *(u32x4*)(sK + nb * 64 * TLD + sr * TLD + sc * 8) = rk; *(u32x4*)(sV + nb * 64 * TLD + sr * TLD + sc * 8) = rv; if (tid < 64) sC[nb * 64 + tid] = rc; }
        __syncthreads();
    }
    const float inv = 1.f / lrun;
    float ms = 0.f;
#pragma unroll
    for (int n = 0; n < 4; ++n) { oacc[n] = oacc[n] * inv; ms += oacc[n][0] * oacc[n][0] + oacc[n][1] * oacc[n][1] + oacc[n][2] * oacc[n][2] + oacc[n][3] * oacc[n][3]; }
    ms += __shfl_xor(ms, 16); ms += __shfl_xor(ms, 32);
    const float rinv = rms ? rsqrtf(ms * (1.f / 64.f) + EPS) : 1.f;
#pragma unroll
    for (int n = 0; n < 4; ++n) {
        const int d = n * 16 + 4 * g;
        f32x4 gg = (f32x4){1.f, 1.f, 1.f, 1.f};
        if (gain) gg = *(const f32x4*)(gain + h * 64 + d);
        uint2 o; o.x = pk2(oacc[n][0] * rinv * gg[0], oacc[n][1] * rinv * gg[1]); o.y = pk2(oacc[n][2] * rinv * gg[2], oacc[n][3] * rinv * gg[3]);
        *(uint2*)(O + qrow * ldo + h * 64 + d) = o;
    }
}


__device__ __forceinline__ void hgrn_scan(float* LF  , float* SEGT  , const bf16_t* __restrict__ prow  , const float* __restrict__ hgrn_lb, int layer, int h, float (&kk)[8]) {
    const int tid = threadIdx.x, t = tid >> 3, k8 = (tid & 7) * 8;
    const u32x4 raw = *(const u32x4*)(prow + (size_t)t * NP + C_AF + k8);
#pragma unroll
    for (int j = 0; j < 8; ++j) {
        const float fl = __uint_as_float((j & 1) ? (raw[j >> 1] & 0xffff0000u) : (raw[j >> 1] << 16));
        float lbk = 0.f;
        if (layer == 1) { const float a0 = hgrn_lb[h * 64 + k8 + j], a1 = hgrn_lb[256 + h * 64 + k8 + j]; lbk = 1.f / (1.f + __expf(a0 - a1)); }
        const float sg = sigmoidf_(fl);
        const float f = lbk + (1.f - lbk) * sg;
        kk[j] = (1.f - lbk) * (1.f - sg);
        LF[t * 65 + k8 + j] = __logf(f);
    }
    __syncthreads();
    { const int k = tid & 63, seg = tid >> 6; float run = 0.f;
#pragma unroll
      for (int i = 0; i < 8; ++i) { run += LF[(seg * 8 + i) * 65 + k]; LF[(seg * 8 + i) * 65 + k] = run; }
      SEGT[seg * 64 + k] = run; }
    __syncthreads();
    { const int k = tid & 63, seg = tid >> 6; float off = 0.f;
      for (int s2 = 0; s2 < seg; ++s2) off += SEGT[s2 * 64 + k];
#pragma unroll
      for (int i = 0; i < 8; ++i) LF[(seg * 8 + i) * 65 + k] += off; }
    __syncthreads();
}
__device__ __forceinline__ float bfx(const u32x4& raw, int j) { return __uint_as_float((j & 1) ? (raw[j >> 1] & 0xffff0000u) : (raw[j >> 1] << 16)); }

__device__ __forceinline__ void hgrn_local_task(char* smem, const bf16_t* __restrict__ proj, const float* __restrict__ hgrn_lb, int layer, float* __restrict__ HL, float* __restrict__ HD, int ch) {
    float* LF = (float*)smem; float* SEGT = LF + 64 * 65;
    bf16_t* sKd = (bf16_t*)(SEGT + 8 * 64); bf16_t* sV = sKd + 64 * TLD;
    const int tid = threadIdx.x, lane = tid & 63, wave = tid >> 6, g = lane >> 4, li = lane & 15;
    const int bh = ch >> 5, n = ch & 31, b = bh >> 2, h = bh & 3;
    const bf16_t* prow = proj + (size_t)(b * SEQ + n * 64) * NP + h * 64;
    const int t = tid >> 3, k8 = (tid & 7) * 8;
    __syncthreads();
    *(u32x4*)(sV + t * TLD + k8) = *(const u32x4*)(prow + (size_t)t * NP + C_AI + k8);
    float kk[8];
    hgrn_scan(LF, SEGT, prow, hgrn_lb, layer, h, kk);
    { u32x4 o;
#pragma unroll
      for (int j = 0; j < 8; j += 2) {
          const float e0 = kk[j] * __expf(LF[63 * 65 + k8 + j] - LF[t * 65 + k8 + j]), e1 = kk[j + 1] * __expf(LF[63 * 65 + k8 + j + 1] - LF[t * 65 + k8 + j + 1]);
          o[j >> 1] = pk2(e0, e1);
      }
      *(u32x4*)(sKd + t * TLD + k8) = o; }
    if (tid < 64) HD[(size_t)ch * 64 + tid] = __expf(LF[63 * 65 + tid]);
    __syncthreads();
#pragma unroll
    for (int i = 0; i < 2; ++i) {
        const int idx = wave * 2 + i, vt = idx >> 2, kt = idx & 3;
        f32x4 acc = (f32x4){0.f, 0.f, 0.f, 0.f};
#pragma unroll
        for (int ks = 0; ks < 2; ++ks) acc = MFMA16(frag_cm(sV, TLD, ks * 32, vt * 16, lane), frag_cm(sKd, TLD, ks * 32, kt * 16, lane), acc);
        *(f32x4*)(HL + (size_t)ch * 4096 + (kt * 16 + li) * 64 + vt * 16 + 4 * g) = acc;
    }
}

__device__ __forceinline__ void hgrn_out_task(char* smem, const bf16_t* __restrict__ proj, const float* __restrict__ hgrn_lb, int layer, const float* __restrict__ HL, const float* __restrict__ HD,
                                              const float* __restrict__ mix_gain, bf16_t* __restrict__ y, int ch) {
    float* LF = (float*)smem; float* SEGT = LF + 64 * 65; float* sMS = SEGT + 8 * 64;
    bf16_t* sST = (bf16_t*)(sMS + 128); bf16_t* sQ0 = sST + 64 * TLD; bf16_t* sQm = sQ0 + 64 * TLD; bf16_t* sKm = sQm + 64 * TLD; bf16_t* sV = sKm + 64 * TLD; bf16_t* sA = sV + 64 * TLD;
    const int tid = threadIdx.x, lane = tid & 63, wave = tid >> 6, g = lane >> 4, li = lane & 15;
    const int bh = ch >> 5, n = ch & 31, b = bh >> 2, h = bh & 3;
    const bf16_t* prow = proj + (size_t)(b * SEQ + n * 64) * NP + h * 64;
    const int t = tid >> 3, k8 = (tid & 7) * 8;
    __syncthreads();
    { const int v = tid & 63, kg = tid >> 6;
      float S[8];
#pragma unroll
      for (int j = 0; j < 8; ++j) S[j] = 0.f;
      const int ch0 = bh * 32;
      for (int m = 0; m < n; ++m) {
          const float* Lm = HL + (size_t)(ch0 + m) * 4096 + (kg * 8) * 64 + v; const float* Dm = HD + (size_t)(ch0 + m) * 64 + kg * 8;
#pragma unroll
          for (int j = 0; j < 8; ++j) S[j] = Dm[j] * S[j] + Lm[j * 64];
      }
      u32x4 o; o[0] = pk2(S[0], S[1]); o[1] = pk2(S[2], S[3]); o[2] = pk2(S[4], S[5]); o[3] = pk2(S[6], S[7]);
      *(u32x4*)(sST + v * TLD + kg * 8) = o; }
    const u32x4 qraw = *(const u32x4*)(prow + (size_t)t * NP + C_AQ + k8);
    *(u32x4*)(sV + t * TLD + k8) = *(const u32x4*)(prow + (size_t)t * NP + C_AI + k8);
    float kk[8];
    hgrn_scan(LF, SEGT, prow, hgrn_lb, layer, h, kk);
    { u32x4 o0, om, ok;
#pragma unroll
      for (int j = 0; j < 8; j += 2) {
          float q0v[2], qmv[2], kmv[2];
#pragma unroll
          for (int e = 0; e < 2; ++e) {
              const float bt = LF[t * 65 + k8 + j + e], r = LF[31 * 65 + k8 + j + e], q = siluf_(bfx(qraw, j + e));
              q0v[e] = q * __expf(bt); qmv[e] = q * __expf(bt - r); kmv[e] = kk[j + e] * __expf(r - bt);
          }
          o0[j >> 1] = pk2(q0v[0], q0v[1]); om[j >> 1] = pk2(qmv[0], qmv[1]); ok[j >> 1] = pk2(kmv[0], kmv[1]);
      }
      *(u32x4*)(sQ0 + t * TLD + k8) = o0; *(u32x4*)(sQm + t * TLD + k8) = om; *(u32x4*)(sKm + t * TLD + k8) = ok; }
    __syncthreads();
#pragma unroll
    for (int i = 0; i < 2; ++i) {
        const int idx = wave * 2 + i, tt = idx >> 2, st = idx & 3;
        f32x4 acc = (f32x4){0.f, 0.f, 0.f, 0.f};
#pragma unroll
        for (int ks = 0; ks < 2; ++ks) acc = MFMA16(frag_rm(sKm, TLD, st * 16, ks * 32, lane), frag_rm(sQm, TLD, tt * 16, ks * 32, lane), acc);
        const int tq = tt * 16 + li, s0 = st * 16 + 4 * g;
        uint2 o; o.x = pk2(s0 <= tq ? acc[0] : 0.f, s0 + 1 <= tq ? acc[1] : 0.f); o.y = pk2(s0 + 2 <= tq ? acc[2] : 0.f, s0 + 3 <= tq ? acc[3] : 0.f);
        *(uint2*)(sA + tq * TLD + s0) = o;
    }
    __syncthreads();
    { const int tt = wave >> 1;
      f32x4 oacc[2]; float ms = 0.f;
#pragma unroll
      for (int i = 0; i < 2; ++i) {
          const int vt = (wave & 1) * 2 + i;
          f32x4 acc = (f32x4){0.f, 0.f, 0.f, 0.f};
#pragma unroll
          for (int ks = 0; ks < 2; ++ks) acc = MFMA16(frag_rm(sST, TLD, vt * 16, ks * 32, lane), frag_rm(sQ0, TLD, tt * 16, ks * 32, lane), acc);
#pragma unroll
          for (int ks = 0; ks < 2; ++ks) acc = MFMA16(frag_cm(sV, TLD, ks * 32, vt * 16, lane), frag_rm(sA, TLD, tt * 16, ks * 32, lane), acc);
          oacc[i] = acc; ms += acc[0] * acc[0] + acc[1] * acc[1] + acc[2] * acc[2] + acc[3] * acc[3];
      }
      ms += __shfl_xor(ms, 16); ms += __shfl_xor(ms, 32);
      if (g == 0) sMS[(tt * 16 + li) * 2 + (wave & 1)] = ms;
      __syncthreads();
      const int tq = tt * 16 + li;
      const float rinv = rsqrtf((sMS[tq * 2] + sMS[tq * 2 + 1]) * (1.f / 64.f) + EPS);
      const size_t row = (size_t)(b * SEQ + n * 64 + tq);
#pragma unroll
      for (int i = 0; i < 2; ++i) {
          const int v0 = ((wave & 1) * 2 + i) * 16 + 4 * g;
          const uint2 graw = *(const uint2*)(proj + row * NP + C_AG + h * 64 + v0);
          const f32x4 mgv = *(const f32x4*)(mix_gain + C_AQ + h * 64 + v0);
          const float g0 = __uint_as_float(graw.x << 16), g1 = __uint_as_float(graw.x & 0xffff0000u), g2 = __uint_as_float(graw.y << 16), g3 = __uint_as_float(graw.y & 0xffff0000u);
          uint2 o; o.x = pk2(oacc[i][0] * rinv * siluf_(g0) * mgv[0], oacc[i][1] * rinv * siluf_(g1) * mgv[1]);
          o.y = pk2(oacc[i][2] * rinv * siluf_(g2) * mgv[2], oacc[i][3] * rinv * siluf_(g3) * mgv[3]);
          *(uint2*)(y + row * 1024 + h * 64 + v0) = o;
      }
    }
}

__device__ __forceinline__ void router_phase(char* smem, const float* __restrict__ x, const float* __restrict__ g, const float* __restrict__ w_rg, const float* __restrict__ b_rg,
                                             const float* __restrict__ w_re, const float* __restrict__ b_re, bf16_t* __restrict__ hn, int* __restrict__ cnt, int* __restrict__ list, float* __restrict__ pgate) {
    const int w = threadIdx.x >> 6, lane = threadIdx.x & 63;
    float* sh = (float*)smem + w * 1024;
    float* slog = (float*)smem + 8 * 1024 + w * 64;
    for (int t = blockIdx.x * 8 + w; t < T; t += gridDim.x * 8) {
        const f32x4* xr = (const f32x4*)(x + (size_t)t * 1024) + lane;
        f32x4 v[4]; float s = 0.f;
#pragma unroll
        for (int j = 0; j < 4; ++j) { v[j] = xr[64 * j]; s += v[j].x * v[j].x + v[j].y * v[j].y + v[j].z * v[j].z + v[j].w * v[j].w; }
        const float rinv = rsqrtf(wave_sum(s) * (1.f / 1024.f) + EPS);
#pragma unroll
        for (int j = 0; j < 4; ++j) {
            const f32x4 gg = ((const f32x4*)g)[lane + 64 * j];
            const f32x4 hv = v[j] * rinv * gg;
            *(f32x4*)&sh[(lane + 64 * j) * 4] = hv;
            uint2 o; o.x = pk2(hv.x, hv.y); o.y = pk2(hv.z, hv.w);
            *(uint2*)(hn + (size_t)t * 1024 + (lane + 64 * j) * 4) = o;
        }
        __builtin_amdgcn_wave_barrier();
        float a = 0.f;
        if (lane < 36) {
            const float* wp = lane < 4 ? (w_rg + lane) : (w_re + (lane - 4));
            const int ld = lane < 4 ? 4 : 32;
            for (int k = 0; k < 1024; ++k) a += sh[k] * wp[(size_t)k * ld];
            a += lane < 4 ? b_rg[lane] : b_re[lane - 4];
            slog[lane] = a;
        }
        __builtin_amdgcn_wave_barrier();
        if (lane == 0) {
            const float* lg = slog;
            int gs = 0; float gm = lg[0];
            for (int i = 1; i < 4; ++i) if (lg[i] > gm) { gm = lg[i]; gs = i; }
            float den = 0.f; for (int i = 0; i < 4; ++i) den += __expf(lg[i] - gm);
            const float pg = 1.f / den;
            const float* le = lg + 4 + gs * 8;
            int i0 = 0; float m0 = le[0];
            for (int i = 1; i < 8; ++i) if (le[i] > m0) { m0 = le[i]; i0 = i; }
            int i1 = -1; float m1 = -INFINITY;
            for (int i = 0; i < 8; ++i) if (i != i0 && le[i] > m1) { m1 = le[i]; i1 = i; }
            const float e1 = __expf(m1 - m0); const float w0 = 1.f / (1.f + e1), w1 = e1 / (1.f + e1);
            const int ex0 = gs * 8 + i0, ex1 = gs * 8 + i1;
            const int pos0 = atomicAdd(&cnt[ex0], 1); list[(size_t)ex0 * T + pos0] = 2 * t; pgate[2 * t] = pg * w0;
            const int pos1 = atomicAdd(&cnt[ex1], 1); list[(size_t)ex1 * T + pos1] = 2 * t + 1; pgate[2 * t + 1] = pg * w1;
        }
        __builtin_amdgcn_wave_barrier();
    }
}

__device__ __forceinline__ void combine_phase(const float* x2, const bf16_t* __restrict__ eo, const float* __restrict__ g, float* xout, bf16_t* __restrict__ hn, int mode) {
    const int lane = threadIdx.x & 63;
    for (int t = blockIdx.x * 8 + (threadIdx.x >> 6); t < T; t += gridDim.x * 8) {
        f32x4 v[4]; float s = 0.f;
#pragma unroll
        for (int j = 0; j < 4; ++j) {
            const int c = (lane + 64 * j) * 4;
            v[j] = *(const f32x4*)(x2 + (size_t)t * 1024 + c);
            const uint2 e0 = *(const uint2*)(eo + (size_t)(2 * t) * 1024 + c), e1 = *(const uint2*)(eo + (size_t)(2 * t + 1) * 1024 + c);
            v[j].x += __uint_as_float(e0.x << 16) + __uint_as_float(e1.x << 16);
            v[j].y += __uint_as_float(e0.x & 0xffff0000u) + __uint_as_float(e1.x & 0xffff0000u);
            v[j].z += __uint_as_float(e0.y << 16) + __uint_as_float(e1.y << 16);
            v[j].w += __uint_as_float(e0.y & 0xffff0000u) + __uint_as_float(e1.y & 0xffff0000u);
            s += v[j].x * v[j].x + v[j].y * v[j].y + v[j].z * v[j].z + v[j].w * v[j].w;
        }
        const float rinv = rsqrtf(wave_sum(s) * (1.f / 1024.f) + EPS);
#pragma unroll
        for (int j = 0; j < 4; ++j) {
            const int c = (lane + 64 * j) * 4;
            const f32x4 gg = *(const f32x4*)(g + c);
            const f32x4 hv = v[j] * rinv * gg;
            if (mode == 0) {
                *(f32x4*)(xout + (size_t)t * 1024 + c) = v[j];
                uint2 o; o.x = pk2(hv.x, hv.y); o.y = pk2(hv.z, hv.w);
                *(uint2*)(hn + (size_t)t * 1024 + c) = o;
            } else {
                *(f32x4*)(xout + (size_t)t * 1024 + c) = hv;
            }
        }
    }
}

template <int l>
__device__ __forceinline__ void layer_body(const Params& P, char* smem, cg::grid_group& grid, const float* xcur) {
    char* ws = P.ws;
    bf16_t* Wt_in = (bf16_t*)(ws + OFF_WIN); bf16_t* Wt_out = (bf16_t*)(ws + OFF_WOUT); bf16_t* Wt_mq = (bf16_t*)(ws + OFF_WMQ); bf16_t* Wt_mkv = (bf16_t*)(ws + OFF_WMKV);
    bf16_t* Wt_mo = (bf16_t*)(ws + OFF_WMO); bf16_t* Wt_gu = (bf16_t*)(ws + OFF_WGU); bf16_t* Wt_dn = (bf16_t*)(ws + OFF_WDN);
    bf16_t* hn = (bf16_t*)(ws + OFF_HN); bf16_t* proj = (bf16_t*)(ws + OFF_PROJ); float* gates = (float*)(ws + OFF_GATES); bf16_t* y = (bf16_t*)(ws + OFF_Y);
    float* XA = P.out; float* XB = (float*)(ws + OFF_XB);
    bf16_t* qm = (bf16_t*)(ws + OFF_QM); bf16_t* om = (bf16_t*)(ws + OFF_OM); bf16_t* kvm = (bf16_t*)(ws + OFF_KVM); bf16_t* memn = (bf16_t*)(ws + OFF_MEMN);
    float* foxc = (float*)(ws + OFF_FOXC); float* lrua = (float*)(ws + OFF_LRUA); float* lruu = (float*)(ws + OFF_LRUU);
    int* cnt_all = (int*)(ws + OFF_CNT); int* list = (int*)(ws + OFF_LIST); float* pgate = (float*)(ws + OFF_PGATE);
    bf16_t* act = (bf16_t*)(ws + OFF_ACT); bf16_t* eo = (bf16_t*)(ws + OFF_EO);
    const int wave = threadIdx.x >> 6, lane = threadIdx.x & 63;


        float* x1 = (l == 0) ? XA : XB;
        float* x2 = (l == 0) ? XB : XA;
        int* cnt = cnt_all + 32 * l;
        const float* mg = P.in[I_MIX_GAIN] + l * 1024;
        gemm_phase<EPI_INPROJ>(smem, hn, 1024, Wt_in + (size_t)l * NP * 1024, 1024, T, NP, 1024, proj, NP, nullptr, gates);
        if (l == 0) for (int l2 = 0; l2 < NL; ++l2)
            gemm_phase<EPI_BF16>(smem, memn + (size_t)l2 * 2048 * 1024, 1024, Wt_mkv + (size_t)l2 * 512 * 1024, 1024, 2048, 512, 1024, kvm + (size_t)l2 * 2048 * 512, 512, nullptr, nullptr);
        grid.sync();
        {
            const int bx = blockIdx.x;
            if (bx < 32) {
                if (wave == 1) fox_cumsum(gates, P.in[I_FOX_FB] + l * 4, foxc, bx, lane);
            } else if (bx < 64) {
                if (wave == 0) gdn_naive(proj, gates, P.in[I_GDN_CONV_W] + l * 4 * 768, P.in[I_GDN_A_LOG] + l * 4, P.in[I_GDN_DT_BIAS] + l * 4, mg, y, bx - 32, lane);
            } else {
                const int nb = gridDim.x - 64, half = threadIdx.x >> 8;
                for (int ch = bx - 64; ch < 1024; ch += nb) hgrn_local_task(smem, proj, P.in[I_HGRN_LB], l, (float*)(ws + OFF_HL), (float*)(ws + OFF_HD), ch);
                __syncthreads();
                for (int base = 0; base < T / 16; base += nb * 2) {
                    const int task = base + (bx - 64) * 2 + half;
                    lru_prep_task((float*)smem + half * 16 * 256, proj, P.in[I_LRU_CONV_W] + l * 1024, P.in[I_LRU_CONV_B] + l * 256, P.in[I_LRU_WA] + l * 16384, P.in[I_LRU_BA] + l * 256,
                                  P.in[I_LRU_WX] + l * 16384, P.in[I_LRU_BX] + l * 256, P.in[I_LRU_LAM] + l * 256, lrua, lruu, task, task < T / 16);
                }
            }
        }
        grid.sync();
        {
            const int natt = (SEQ / 128) * 4 * NB;
            if ((int)blockIdx.x >= NB) {
                for (int i = (int)blockIdx.x - NB; i < natt; i += (int)gridDim.x - NB) {
                    const int qt = 15 - (i >> 5), bh = i & 31;
                    attn_task(smem, proj + C_BQ, NP, proj + C_BK, NP, proj + C_BV, NP, foxc, SEQ, SEQ, 1, 0.125f, y + 256, 1024, mg + 256, 1, (bh * 16) + qt);
                }
                for (int i = (int)blockIdx.x - NB; i < 1024; i += (int)gridDim.x - NB) {
                    const int ch = (i & 31) * 32 + (31 - (i >> 5));
                    hgrn_out_task(smem, proj, P.in[I_HGRN_LB], l, (const float*)(ws + OFF_HL), (const float*)(ws + OFF_HD), mg, y, ch);
                }
            } else if (threadIdx.x < 256) lru_scan_task(lrua, lruu, proj, mg, y, blockIdx.x);
        }
        grid.sync();
        gemm_phase<EPI_RESID>(smem, y, 1024, Wt_out + (size_t)l * 1024 * 1024, 1024, T, 1024, 1024, x1, 1024, xcur, nullptr);
        grid.sync();
        for (int row = blockIdx.x * 8 + wave; row < T; row += gridDim.x * 8) rms_row_bf16(x1 + (size_t)row * 1024, P.in[I_NORM_MEM] + l * 1024, hn + (size_t)row * 1024, lane);
        grid.sync();
        gemm_phase<EPI_BF16>(smem, hn, 1024, Wt_mq + (size_t)l * 256 * 1024, 1024, T, 256, 1024, qm, 256, nullptr, nullptr);
        grid.sync();
        { const bf16_t* kv = kvm + (size_t)l * 2048 * 512;
          BLK_LOOP(task, (SEQ / 128) * 4 * NB) attn_task(smem, qm, 256, kv, 512, kv + 256, 512, nullptr, SEQ, MEMLEN, 0, 0.125f, om, 256, nullptr, 0, task); }
        grid.sync();
        gemm_phase<EPI_RESID>(smem, om, 256, Wt_mo + (size_t)l * 1024 * 256, 256, T, 1024, 256, x2, 1024, x1, nullptr);
        grid.sync();
        router_phase(smem, x2, P.in[I_NORM_FFN] + l * 1024, P.in[I_W_RG] + l * 4096, P.in[I_B_RG] + l * 4, P.in[I_W_RE] + l * 32768, P.in[I_B_RE] + l * 32, hn, cnt, list, pgate);
        grid.sync();
        moe_phase<1>(smem, hn, 1024, Wt_gu + (size_t)l * 32 * 512 * 1024, (size_t)512 * 1024, 1024, 1024, cnt, list, pgate, act);
        grid.sync();
        moe_phase<2>(smem, act, 256, Wt_dn + (size_t)l * 32 * 1024 * 256, (size_t)1024 * 256, 256, 256, cnt, list, pgate, eo);
        grid.sync();
        if (l == 0) { combine_phase(x2, eo, P.in[I_NORM_MIX] + 1024, XA, hn, 0); grid.sync(); }
        else combine_phase(x2, eo, P.in[I_NORM_FINAL], P.out, hn, 1);
}
__global__ void __launch_bounds__(NTHR, 2) mega_kernel(Params P) {
    extern __shared__ __attribute__((aligned(16))) char smem[];
    cg::grid_group grid = cg::this_grid();
    phase0(P, smem);
    grid.sync();
    layer_body<0>(P, smem, grid, P.in[I_X]);
    layer_body<1>(P, smem, grid, P.out);
}

extern "C" void kernel_launch(void* const* d_in, const int* in_sizes, int n_in, void* d_out, int out_size, void* d_ws, size_t ws_size, hipStream_t stream) {
    static int grid_blocks = 0;
    if (grid_blocks == 0) {
        if (n_in != N_INPUTS || ws_size < OFF_END || out_size != T * 1024) { fprintf(stderr, "kernel_launch: unexpected sizes n_in=%d ws=%zu out=%d (need ws >= %zu)\n", n_in, ws_size, out_size, (size_t)OFF_END); grid_blocks = -1; return; }
        int dev = 0, cus = 0, per_cu = 0;
        if (hipGetDevice(&dev) != hipSuccess || hipDeviceGetAttribute(&cus, hipDeviceAttributeMultiprocessorCount, dev) != hipSuccess) { fprintf(stderr, "kernel_launch: device query failed\n"); grid_blocks = -1; return; }
        if (hipFuncSetAttribute((const void*)mega_kernel, hipFuncAttributeMaxDynamicSharedMemorySize, LDS_BYTES) != hipSuccess) { fprintf(stderr, "kernel_launch: hipFuncSetAttribute failed\n"); grid_blocks = -1; return; }
        if (hipOccupancyMaxActiveBlocksPerMultiprocessor(&per_cu, (const void*)mega_kernel, NTHR, LDS_BYTES) != hipSuccess || per_cu < 1) { fprintf(stderr, "kernel_launch: occupancy query says %d blocks/CU\n", per_cu); grid_blocks = -1; return; }
        grid_blocks = cus;
        fprintf(stderr, "kernel_launch: cus=%d per_cu=%d grid=%d\n", cus, per_cu, grid_blocks);
    }
    if (grid_blocks < 0) return;
    Params p; memset(&p, 0, sizeof p);
    for (int i = 0; i < N_INPUTS; ++i) p.in[i] = (const float*)d_in[i];
    p.out = (float*)d_out; p.ws = (char*)d_ws;
    void* args[] = {&p};
    hipError_t e = hipLaunchCooperativeKernel((const void*)mega_kernel, dim3(grid_blocks), dim3(NTHR), args, LDS_BYTES, stream);
    if (e != hipSuccess) fprintf(stderr, "kernel_launch: cooperative launch failed: %s (grid %d)\n", hipGetErrorString(e), grid_blocks);
}
```

```cpp
#include <hip/hip_runtime.h>
#include <stdint.h>
#include <stdio.h>
#include <string.h>
#include <hip/hip_cooperative_groups.h>
namespace cg = cooperative_groups;

typedef unsigned short bf16_t;
typedef short bf16x8 __attribute__((ext_vector_type(8)));
typedef float f32x4 __attribute__((ext_vector_type(4)));
typedef unsigned u32x4 __attribute__((ext_vector_type(4)));

constexpr int NB = 8, SEQ = 2048, DM = 1024, T = NB * SEQ, NL = 2;
constexpr int NP = 3456;
constexpr int NIN = 3340;
constexpr int C_AQ = 0, C_AF = 256, C_AI = 512, C_AG = 768, C_BQ = 1024, C_BK = 1280, C_BV = 1536, C_CX = 1792, C_CG = 2048,
              C_DQ = 2304, C_DK = 2560, C_DV = 2816, C_DZ = 3072, C_GATE = 3328;
constexpr int MEMLEN = 256;
constexpr int NEXP = 32, DEXP = 256;
constexpr float EPS = 1e-6f;

constexpr size_t al256(size_t x) { return (x + 255) & ~(size_t)255; }
constexpr size_t SZ_WIN = (size_t)NP * 1024 * 2, SZ_WOUT = (size_t)1024 * 1024 * 2, SZ_WMQ = (size_t)256 * 1024 * 2, SZ_WMKV = (size_t)512 * 1024 * 2,
                 SZ_WMO = (size_t)1024 * 256 * 2, SZ_WGU = (size_t)32 * 512 * 1024 * 2, SZ_WDN = (size_t)32 * 1024 * 256 * 2;
constexpr size_t OFF_WIN = 0;
constexpr size_t OFF_WOUT = OFF_WIN + NL * SZ_WIN;
constexpr size_t OFF_WMQ = OFF_WOUT + NL * SZ_WOUT;
constexpr size_t OFF_WMKV = OFF_WMQ + NL * SZ_WMQ;
constexpr size_t OFF_WMO = OFF_WMKV + NL * SZ_WMKV;
constexpr size_t OFF_WGU = OFF_WMO + NL * SZ_WMO;
constexpr size_t OFF_WDN = OFF_WGU + NL * SZ_WGU;
constexpr size_t OFF_HN = OFF_WDN + NL * SZ_WDN;
constexpr size_t OFF_PROJ = OFF_HN + (size_t)T * 1024 * 2;
constexpr size_t OFF_GATES = OFF_PROJ + (size_t)T * NP * 2;
constexpr size_t OFF_Y = OFF_GATES + (size_t)T * 16 * 4;
constexpr size_t OFF_XB = OFF_Y + (size_t)T * 1024 * 2;
constexpr size_t OFF_QM = OFF_XB + (size_t)T * 1024 * 4;
constexpr size_t OFF_OM = OFF_QM + (size_t)T * 256 * 2;
constexpr size_t OFF_KVM = OFF_OM + (size_t)T * 256 * 2;
constexpr size_t OFF_MEMN = OFF_KVM + (size_t)NL * 2048 * 512 * 2;
constexpr size_t OFF_FOXC = OFF_MEMN + (size_t)2048 * 1024 * 2;
constexpr size_t OFF_LRUA = OFF_FOXC + (size_t)NB * 4 * SEQ * 4;
constexpr size_t OFF_LRUU = OFF_LRUA + (size_t)T * 256 * 4;
constexpr size_t OFF_CNT = OFF_LRUU + (size_t)T * 256 * 4;
constexpr size_t OFF_LIST = OFF_CNT + 256;
constexpr size_t OFF_PGATE = OFF_LIST + (size_t)NEXP * T * 4;
constexpr size_t OFF_HL = OFF_PGATE + (size_t)2 * T * 4;
constexpr size_t OFF_HD = OFF_HL + (size_t)1024 * 4096 * 4;
constexpr size_t OFF_GDN = OFF_HD + (size_t)1024 * 64 * 4;
constexpr size_t OFF_GLAST = OFF_GDN + (size_t)1024 * 5 * 4096 * 2;
constexpr size_t OFF_LSUM = OFF_GLAST + 4096;
constexpr size_t OFF_END = OFF_LSUM + (size_t)2 * 256 * 256 * 4;
constexpr size_t OFF_ACT = OFF_PROJ;
constexpr size_t OFF_EO = OFF_PROJ + (size_t)2 * T * 256 * 2;
static_assert(OFF_EO + (size_t)2 * T * 1024 * 2 <= OFF_GATES, "overlay fits");

__device__ __forceinline__ float bf2f(bf16_t v) { return __uint_as_float(((unsigned)v) << 16); }
__device__ __forceinline__ bf16_t f2bf(float f) { unsigned u = __float_as_uint(f); return (bf16_t)((u + 0x7fffu + ((u >> 16) & 1u)) >> 16); }
__device__ __forceinline__ unsigned pk2(float lo, float hi) { return (unsigned)f2bf(lo) | ((unsigned)f2bf(hi) << 16); }
__device__ __forceinline__ float sigmoidf_(float x) { return 1.f / (1.f + __expf(-x)); }
__device__ __forceinline__ float siluf_(float x) { return x / (1.f + __expf(-x)); }
__device__ __forceinline__ float softplusf_(float x) { return x > 20.f ? x : log1pf(__expf(x)); }
__device__ __forceinline__ float logsigmoidf_(float x) { return x < 0.f ? x - log1pf(__expf(x)) : -log1pf(__expf(-x)); }
__device__ __forceinline__ float geluf_(float x) { float u = 0.7978845608028654f * (x + 0.044715f * x * x * x); return 0.5f * x * (1.f + tanhf(u)); }
__device__ __forceinline__ float wave_sum(float v) {
#pragma unroll
    for (int o = 1; o < 64; o <<= 1) v += __shfl_xor(v, o);
    return v;
}
__device__ __forceinline__ float rdlane(float v, int l) { return __int_as_float(__builtin_amdgcn_readlane(__float_as_int(v), l)); }

constexpr int NTHR = 512;
constexpr int LDS_BYTES = 147456;
enum { I_X = 0, I_MEM, I_NORM_MIX, I_W_IN, I_HGRN_LB, I_FOX_FB, I_LRU_CONV_W, I_LRU_CONV_B, I_LRU_WA, I_LRU_BA, I_LRU_WX, I_LRU_BX, I_LRU_LAM, I_GDN_CONV_W, I_GDN_A_LOG,
       I_GDN_DT_BIAS, I_MIX_GAIN, I_W_OUT, I_NORM_MEM, I_NORM_MEMKV, I_W_MQ, I_W_MKV, I_W_MO, I_NORM_FFN, I_W_RG, I_B_RG, I_W_RE, I_B_RE, I_W_E_GU, I_W_E_DN, I_NORM_FINAL, N_INPUTS };
struct Params { const float* in[N_INPUTS]; float* out; char* ws; };
static_assert(sizeof(Params) == 8 * (N_INPUTS + 2), "no padding");

#define BLK_LOOP(it, n) for (int it = (int)blockIdx.x; it < (n); it += (int)gridDim.x)

__device__ __forceinline__ int rowmap_fn(int mode, int n) {
    if (mode == 1) {
        if (n < 1792) return n;
        if (n < 1796) return C_GATE + (n - 1792);
        if (n < 3076) return n - 4;
        if (n < 3084) return C_GATE + 4 + (n - 3076);
        return n - 12;
    } else if (mode == 2) {
        int j = n & 255; return (j >> 4) * 32 + ((n >= 256) ? 16 : 0) + (j & 15);
    }
    return n;
}
__device__ __forceinline__ void convT_tile(float* tile  , const float* __restrict__ src, int K, int N, bf16_t* __restrict__ dst, int mode, int ntn, int idx) {
    const int n0 = (idx % ntn) * 64, k0 = (idx / ntn) * 64;
    const int tx = threadIdx.x & 63, ty = threadIdx.x >> 6;
    __syncthreads();
#pragma unroll
    for (int i = 0; i < 8; ++i) {
        const int k = ty + i * 8, n = n0 + tx;
        tile[k * 65 + tx] = (n < N) ? src[(size_t)(k0 + k) * N + n] : 0.f;
    }
    __syncthreads();
    const int kx = threadIdx.x & 31, ny = threadIdx.x >> 5;
#pragma unroll
    for (int i = 0; i < 4; ++i) {
        const int nl = ny + i * 16, n = n0 + nl;
        if (n < N) {
            const int r = rowmap_fn(mode, n);
            *(unsigned*)(dst + (size_t)r * K + k0 + 2 * kx) = pk2(tile[(2 * kx) * 65 + nl], tile[(2 * kx + 1) * 65 + nl]);
        }
    }
}
__device__ __forceinline__ void rms_row_bf16(const float* __restrict__ xrow, const float* __restrict__ g, bf16_t* __restrict__ orow, int lane) {
    const f32x4* xr = (const f32x4*)xrow + lane;
    f32x4 v[4]; float s = 0.f;
#pragma unroll
    for (int j = 0; j < 4; ++j) { v[j] = xr[64 * j]; s += v[j].x * v[j].x + v[j].y * v[j].y + v[j].z * v[j].z + v[j].w * v[j].w; }
    const float rinv = rsqrtf(wave_sum(s) * (1.f / 1024.f) + EPS);
#pragma unroll
    for (int j = 0; j < 4; ++j) {
        const f32x4 gg = ((const f32x4*)g)[lane + 64 * j];
        uint2 o; o.x = pk2(v[j].x * rinv * gg.x, v[j].y * rinv * gg.y); o.y = pk2(v[j].z * rinv * gg.z, v[j].w * rinv * gg.w);
        *(uint2*)(orow + (lane + 64 * j) * 4) = o;
    }
}

constexpr int CT_PER_LAYER = 53 * 16 + 256 + 64 + 128 + 64;
constexpr int CT_GU = 64 * 128, CT_DN = 64 * 64;
constexpr int CT_TOTAL = NL * CT_PER_LAYER + CT_GU + CT_DN;

__device__ __forceinline__ void phase0(const Params& P, char* smem) {
    char* ws = P.ws;
    float* tile = (float*)smem;
    BLK_LOOP(it, CT_TOTAL) {
        int r = it;
        if (r < NL * CT_PER_LAYER) {
            const int l = r / CT_PER_LAYER; r -= l * CT_PER_LAYER;
            if (r < 848) { convT_tile(tile, P.in[I_W_IN] + (size_t)l * 1024 * NIN, 1024, NIN, (bf16_t*)(ws + OFF_WIN) + (size_t)l * NP * 1024, 1, 53, r); continue; } r -= 848;
            if (r < 256) { convT_tile(tile, P.in[I_W_OUT] + (size_t)l * 1024 * 1024, 1024, 1024, (bf16_t*)(ws + OFF_WOUT) + (size_t)l * 1024 * 1024, 0, 16, r); continue; } r -= 256;
            if (r < 64) { convT_tile(tile, P.in[I_W_MQ] + (size_t)l * 1024 * 256, 1024, 256, (bf16_t*)(ws + OFF_WMQ) + (size_t)l * 256 * 1024, 0, 4, r); continue; } r -= 64;
            if (r < 128) { convT_tile(tile, P.in[I_W_MKV] + (size_t)l * 1024 * 512, 1024, 512, (bf16_t*)(ws + OFF_WMKV) + (size_t)l * 512 * 1024, 0, 8, r); continue; } r -= 128;
            convT_tile(tile, P.in[I_W_MO] + (size_t)l * 256 * 1024, 256, 1024, (bf16_t*)(ws + OFF_WMO) + (size_t)l * 1024 * 256, 0, 16, r); continue;
        }
        r -= NL * CT_PER_LAYER;
        if (r < CT_GU) { const int m = r >> 7; convT_tile(tile, P.in[I_W_E_GU] + (size_t)m * 1024 * 512, 1024, 512, (bf16_t*)(ws + OFF_WGU) + (size_t)m * 512 * 1024, 2, 8, r & 127); continue; }
        r -= CT_GU;
        { const int m = r >> 6; convT_tile(tile, P.in[I_W_E_DN] + (size_t)m * 256 * 1024, 256, 1024, (bf16_t*)(ws + OFF_WDN) + (size_t)m * 1024 * 256, 0, 16, r & 63); }
    }
    for (int i = blockIdx.x * NTHR + threadIdx.x; i < NL * (NP - NIN) * 512; i += gridDim.x * NTHR) {
        const int l = i / ((NP - NIN) * 512), w = i % ((NP - NIN) * 512);
        ((unsigned*)((bf16_t*)(ws + OFF_WIN) + (size_t)l * NP * 1024 + (size_t)NIN * 1024))[w] = 0u;
    }
    if (blockIdx.x == 0 && threadIdx.x < 64) ((int*)(ws + OFF_CNT))[threadIdx.x] = 0;
    const int gw = blockIdx.x * 8 + (threadIdx.x >> 6), ngw = gridDim.x * 8, lane = threadIdx.x & 63;
    for (int row = gw; row < T + NL * 2048; row += ngw) {
        if (row < T) rms_row_bf16(P.in[I_X] + (size_t)row * 1024, P.in[I_NORM_MIX], (bf16_t*)(ws + OFF_HN) + (size_t)row * 1024, lane);
        else { const int r2 = row - T, l = r2 >> 11, rr = r2 & 2047;
               rms_row_bf16(P.in[I_MEM] + (size_t)rr * 1024, P.in[I_NORM_MEMKV] + l * 1024, (bf16_t*)(ws + OFF_MEMN) + (size_t)r2 * 1024, lane); }
    }
}

constexpr int GLD = 72;
constexpr int GEMM_LDS = (256 + 128) * GLD * 2;
template <class RowPtr>
__device__ __forceinline__ void gemm_tile(char* smem, RowPtr rowptr, const bf16_t* __restrict__ Bt, int ldb, int n0, int K, f32x4 (&acc)[4][4]) {
    bf16_t* sA = (bf16_t*)smem; bf16_t* sB = sA + 256 * GLD;
    const int tid = threadIdx.x, lane = tid & 63, wave = tid >> 6, wm = wave >> 1, wn = wave & 1;
    const u32x4* ga[4]; const u32x4* gb[2];
#pragma unroll
    for (int i = 0; i < 4; ++i) { const int c = tid + i * 512, r = c >> 3, ch = c & 7; ga[i] = (const u32x4*)(rowptr(r) + ch * 8); }
#pragma unroll
    for (int i = 0; i < 2; ++i) { const int c = tid + i * 512, r = c >> 3, ch = c & 7; gb[i] = (const u32x4*)(Bt + (size_t)(n0 + r) * ldb + ch * 8); }
#pragma unroll
    for (int m = 0; m < 4; ++m)
#pragma unroll
        for (int n = 0; n < 4; ++n) acc[m][n] = (f32x4){0.f, 0.f, 0.f, 0.f};
    u32x4 ra[4], rb[2];
#pragma unroll
    for (int i = 0; i < 4; ++i) ra[i] = ga[i][0];
#pragma unroll
    for (int i = 0; i < 2; ++i) rb[i] = gb[i][0];
    const int nk = K / 64;
    for (int kt = 0; kt < nk; ++kt) {
        __syncthreads();
#pragma unroll
        for (int i = 0; i < 4; ++i) { const int c = tid + i * 512, r = c >> 3, ch = c & 7; *(u32x4*)(sA + r * GLD + ch * 8) = ra[i]; }
#pragma unroll
        for (int i = 0; i < 2; ++i) { const int c = tid + i * 512, r = c >> 3, ch = c & 7; *(u32x4*)(sB + r * GLD + ch * 8) = rb[i]; }
        __syncthreads();
        if (kt + 1 < nk) {
#pragma unroll
            for (int i = 0; i < 4; ++i) ra[i] = ga[i][(kt + 1) * 8];
#pragma unroll
            for (int i = 0; i < 2; ++i) rb[i] = gb[i][(kt + 1) * 8];
        }
#pragma unroll
        for (int kk = 0; kk < 2; ++kk) {
            bf16x8 af[4], bfr[4];
#pragma unroll
            for (int m = 0; m < 4; ++m) af[m] = *(const bf16x8*)(sA + (wm * 64 + m * 16 + (lane & 15)) * GLD + kk * 32 + (lane >> 4) * 8);
#pragma unroll
            for (int n = 0; n < 4; ++n) bfr[n] = *(const bf16x8*)(sB + (wn * 64 + n * 16 + (lane & 15)) * GLD + kk * 32 + (lane >> 4) * 8);
#pragma unroll
            for (int m = 0; m < 4; ++m)
#pragma unroll
                for (int n = 0; n < 4; ++n) acc[m][n] = __builtin_amdgcn_mfma_f32_16x16x32_bf16(bfr[n], af[m], acc[m][n], 0, 0, 0);
        }
    }
}
struct RowDirect { const bf16_t* A; int lda; int m0; __device__ __forceinline__ const bf16_t* operator()(int r) const { return A + (size_t)(m0 + r) * lda; } };
enum { EPI_INPROJ = 0, EPI_RESID = 1, EPI_BF16 = 2 };

__device__ __forceinline__ int vcu_id() { const int G = gridDim.x, bx = blockIdx.x; return (G % 8 == 0) ? (bx % 8) * (G / 8) + bx / 8 : bx; }

template <int EPI>
__device__ __forceinline__ void gemm_phase(char* smem, const bf16_t* A, int lda, const bf16_t* Bt, int ldb, int M, int N, int K, void* out, int ldo, const float* resid, float* gates) {
    const int ntn = N / 128, ntiles = (M / 256) * ntn;
    const int lane = threadIdx.x & 63, wave = threadIdx.x >> 6, wm = wave >> 1, wn = wave & 1;
    for (int tIdx = vcu_id(); tIdx < ntiles; tIdx += gridDim.x) {
        const int m0 = (tIdx / ntn) * 256, n0 = (tIdx % ntn) * 128;
        f32x4 acc[4][4];
        RowDirect rp{A, lda, m0};
        gemm_tile(smem, rp, Bt, ldb, n0, K, acc);
#pragma unroll
        for (int m = 0; m < 4; ++m)
#pragma unroll
            for (int n = 0; n < 4; ++n) {
                const int row = m0 + wm * 64 + m * 16 + (lane & 15), col = n0 + wn * 64 + n * 16 + (lane >> 4) * 4;
                const f32x4 v = acc[m][n];
                if (EPI == EPI_INPROJ) {
                    uint2 o; o.x = pk2(v.x, v.y); o.y = pk2(v.z, v.w);
                    *(uint2*)((bf16_t*)out + (size_t)row * ldo + col) = o;
                    if (col >= C_GATE && col < C_GATE + 16) *(f32x4*)(gates + (size_t)row * 16 + (col - C_GATE)) = v;
                } else if (EPI == EPI_RESID) {
                    const f32x4 r = *(const f32x4*)(resid + (size_t)row * ldo + col);
                    *(f32x4*)((float*)out + (size_t)row * ldo + col) = r + v;
                } else {
                    uint2 o; o.x = pk2(v.x, v.y); o.y = pk2(v.z, v.w);
                    *(uint2*)((bf16_t*)out + (size_t)row * ldo + col) = o;
                }
            }
    }
}

struct RowGather { const bf16_t* A; int lda; const int* ids; int shift; __device__ __forceinline__ const bf16_t* operator()(int r) const { return A + (size_t)(ids[r] >> shift) * lda; } };
template <int STAGE>
__device__ __forceinline__ void moe_phase(char* smem, const bf16_t* A, int lda, const bf16_t* Wt, size_t wstride, int ldb, int K, const int* cnt, const int* list, const float* pgate, bf16_t* out) {
    int* ids = (int*)(smem + GEMM_LDS);
    int* tpre = ids + 256;
    constexpr int NTN = (STAGE == 1) ? 4 : 8;
    __syncthreads();
    if (threadIdx.x == 0) { int a = 0; for (int i = 0; i < NEXP; ++i) { tpre[i] = a; a += (cnt[i] + 255) >> 8; } tpre[NEXP] = a; }
    __syncthreads();
    const int ntiles = tpre[NEXP] * NTN;
    const int lane = threadIdx.x & 63, wave = threadIdx.x >> 6, wm = wave >> 1, wn = wave & 1;
    for (int tIdx = vcu_id(); tIdx < ntiles; tIdx += gridDim.x) {
        const int mtg = tIdx / NTN, n0 = (tIdx % NTN) * 128;
        int e = 0;
        for (int i = 1; i < NEXP; ++i) if (tpre[i] <= mtg) e = i;
        const int mt = mtg - tpre[e];
        const int cn = cnt[e];
        __syncthreads();
        if (threadIdx.x < 256) { const int pos = mt * 256 + threadIdx.x; ids[threadIdx.x] = list[(size_t)e * T + (pos < cn ? pos : cn - 1)]; }
        __syncthreads();
        f32x4 acc[4][4];
        RowGather rp{A, lda, ids, STAGE == 1 ? 1 : 0};
        gemm_tile(smem, rp, Wt + (size_t)e * wstride, ldb, n0, K, acc);
#pragma unroll
        for (int m = 0; m < 4; ++m) {
            const int rl = wm * 64 + m * 16 + (lane & 15);
            if (mt * 256 + rl >= cn) continue;
            const int pid = ids[rl];
            if (STAGE == 1) {
                const float gt = pgate[pid];
#pragma unroll
                for (int np = 0; np < 2; ++np) {
                    const f32x4 g = acc[m][2 * np], u = acc[m][2 * np + 1];
                    const int j = (n0 + wn * 64 + np * 32) / 2 + (lane >> 4) * 4;
                    uint2 o; o.x = pk2(siluf_(g.x) * u.x * gt, siluf_(g.y) * u.y * gt); o.y = pk2(siluf_(g.z) * u.z * gt, siluf_(g.w) * u.w * gt);
                    *(uint2*)(out + (size_t)pid * DEXP + j) = o;
                }
            } else {
#pragma unroll
                for (int n = 0; n < 4; ++n) {
                    const f32x4 v = acc[m][n]; const int col = n0 + wn * 64 + n * 16 + (lane >> 4) * 4;
                    uint2 o; o.x = pk2(v.x, v.y); o.y = pk2(v.z, v.w);
                    *(uint2*)(out + (size_t)pid * 1024 + col) = o;
                }
            }
        }
    }
}

__device__ __forceinline__ void hgrn2_naive(const bf16_t* __restrict__ proj, const float* __restrict__ hgrn_lb, int layer, const float* __restrict__ mix_gain, bf16_t* __restrict__ y, int bh, int lane) {
    const int b = bh >> 2, h = bh & 3;
    float lbk = 0.f;
    if (layer == 1) { float a0 = hgrn_lb[h * 64 + lane], a1 = hgrn_lb[256 + h * 64 + lane]; lbk = 1.f / (1.f + __expf(a0 - a1)); }
    const float mg = mix_gain[C_AQ + h * 64 + lane];
    float S[64];
#pragma unroll
    for (int k = 0; k < 64; ++k) S[k] = 0.f;
    for (int t = 0; t < SEQ; ++t) {
        const bf16_t* pr = proj + (size_t)(b * SEQ + t) * NP + h * 64 + lane;
        const float qk = siluf_(bf2f(pr[C_AQ]));
        const float sg = sigmoidf_(bf2f(pr[C_AF]));
        const float f = lbk + (1.f - lbk) * sg, kk = (1.f - lbk) * (1.f - sg);
        const float iv = bf2f(pr[C_AI]);
        const float gv = bf2f(pr[C_AG]);
        float o = 0.f;
#pragma unroll
        for (int k = 0; k < 64; ++k) { S[k] = rdlane(f, k) * S[k] + rdlane(kk, k) * iv; o += rdlane(qk, k) * S[k]; }
        const float ms = wave_sum(o * o) * (1.f / 64.f);
        const float yv = o * rsqrtf(ms + EPS) * siluf_(gv) * mg;
        y[(size_t)(b * SEQ + t) * 1024 + 0 + h * 64 + lane] = f2bf(yv);
    }
}
__device__ __forceinline__ void gdn_naive(const bf16_t* __restrict__ proj, const float* __restrict__ gates, const float* __restrict__ conv_w  ,
                                          const float* __restrict__ a_log, const float* __restrict__ dt_bias, const float* __restrict__ mix_gain, bf16_t* __restrict__ y, int bh, int lane) {
    const int b = bh >> 2, h = bh & 3;
    float wq[4], wk[4], wv[4];
#pragma unroll
    for (int j = 0; j < 4; ++j) { wq[j] = conv_w[j * 768 + h * 64 + lane]; wk[j] = conv_w[j * 768 + 256 + h * 64 + lane]; wv[j] = conv_w[j * 768 + 512 + h * 64 + lane]; }
    float xq[3] = {0.f, 0.f, 0.f}, xk[3] = {0.f, 0.f, 0.f}, xv[3] = {0.f, 0.f, 0.f};
    const float Aexp = __expf(a_log[h]), dtb = dt_bias[h];
    const float mg = mix_gain[768 + h * 64 + lane];
    float S[64];
#pragma unroll
    for (int k = 0; k < 64; ++k) S[k] = 0.f;
    for (int t = 0; t < SEQ; ++t) {
        const size_t row = (size_t)(b * SEQ + t);
        const bf16_t* pr = proj + row * NP + h * 64 + lane;
        const float q0 = bf2f(pr[C_DQ]), k0 = bf2f(pr[C_DK]), v0 = bf2f(pr[C_DV]), zv = bf2f(pr[C_DZ]);
        float q = siluf_(wq[0] * xq[0] + wq[1] * xq[1] + wq[2] * xq[2] + wq[3] * q0);
        float k = siluf_(wk[0] * xk[0] + wk[1] * xk[1] + wk[2] * xk[2] + wk[3] * k0);
        float v = siluf_(wv[0] * xv[0] + wv[1] * xv[1] + wv[2] * xv[2] + wv[3] * v0);
        xq[0] = xq[1]; xq[1] = xq[2]; xq[2] = q0; xk[0] = xk[1]; xk[1] = xk[2]; xk[2] = k0; xv[0] = xv[1]; xv[1] = xv[2]; xv[2] = v0;
        q = q * rsqrtf(wave_sum(q * q) + EPS) * 0.125f;
        k = k * rsqrtf(wave_sum(k * k) + EPS);
        const float beta = sigmoidf_(gates[row * 16 + 4 + h]);
        const float g = -Aexp * softplusf_(gates[row * 16 + 8 + h] + dtb);
        const float eg = __expf(g);
        float r = 0.f;
#pragma unroll
        for (int i = 0; i < 64; ++i) { S[i] *= eg; r += rdlane(k, i) * S[i]; }
        const float dlt = beta * (v - r);
        float o = 0.f;
#pragma unroll
        for (int i = 0; i < 64; ++i) { S[i] += rdlane(k, i) * dlt; o += rdlane(q, i) * S[i]; }
        const float ms = wave_sum(o * o) * (1.f / 64.f);
        const float yv = o * rsqrtf(ms + EPS) * siluf_(zv) * mg;
        y[row * 1024 + 768 + h * 64 + lane] = f2bf(yv);
    }
}
__device__ __forceinline__ void fox_cumsum(const float* __restrict__ gates, const float* __restrict__ fb, float* __restrict__ cc, int bh, int lane) {
    const int b = bh >> 2, h = bh & 3;
    const float bias = fb[h];
    float carry = 0.f;
    for (int t0 = 0; t0 < SEQ; t0 += 64) {
        float v = logsigmoidf_(gates[(size_t)(b * SEQ + t0 + lane) * 16 + h] + bias);
#pragma unroll
        for (int o = 1; o < 64; o <<= 1) { float n = __shfl_up(v, o); if (lane >= o) v += n; }
        v += carry;
        cc[(size_t)(b * 4 + h) * SEQ + t0 + lane] = v;
        carry = __shfl(v, 63);
    }
}
__device__ __forceinline__ void lru_prep_task(float* xc  , const bf16_t* __restrict__ proj, const float* __restrict__ conv_w, const float* __restrict__ conv_b,
                                              const float* __restrict__ w_a, const float* __restrict__ b_a, const float* __restrict__ w_x, const float* __restrict__ b_x,
                                              const float* __restrict__ lam, float* __restrict__ a_out, float* __restrict__ u_out, int task, bool active) {
    const int c = threadIdx.x & 255, t0 = task * 16;
    if (active) {
        const float w0 = conv_w[c], w1 = conv_w[256 + c], w2 = conv_w[512 + c], w3 = conv_w[768 + c], cb = conv_b[c];
        for (int i = 0; i < 16; ++i) {
            const int t = t0 + i, s = t & (SEQ - 1);
            const bf16_t* pr = proj + (size_t)t * NP + C_CX + c;
            float acc = cb + w3 * bf2f(pr[0]);
            if (s >= 1) acc += w2 * bf2f(pr[-(ptrdiff_t)NP]);
            if (s >= 2) acc += w1 * bf2f(pr[-(ptrdiff_t)2 * NP]);
            if (s >= 3) acc += w0 * bf2f(pr[-(ptrdiff_t)3 * NP]);
            xc[i * 256 + c] = acc;
        }
    }
    __syncthreads();
    if (active) {
        const int h = c >> 6, jj = c & 63;
        float ra[16], rx[16];
#pragma unroll
        for (int i = 0; i < 16; ++i) { ra[i] = 0.f; rx[i] = 0.f; }
        for (int k = 0; k < 64; ++k) {
            const float wa = w_a[(h * 64 + k) * 64 + jj], wx = w_x[(h * 64 + k) * 64 + jj];
#pragma unroll
            for (int i = 0; i < 16; ++i) { const float xv = xc[i * 256 + h * 64 + k]; ra[i] += xv * wa; rx[i] += xv * wx; }
        }
        const float ba = b_a[c], bx = b_x[c], sp = softplusf_(-lam[c]);
#pragma unroll
        for (int i = 0; i < 16; ++i) {
            const float r = sigmoidf_(ra[i] + ba), ig = sigmoidf_(rx[i] + bx);
            const float log_a = -8.f * r * sp;
            const float a = __expf(log_a);
            const float u = sqrtf(-expm1f(2.f * log_a)) * (ig * xc[i * 256 + c]);
            a_out[(size_t)(t0 + i) * 256 + c] = a; u_out[(size_t)(t0 + i) * 256 + c] = u;
        }
    }
    __syncthreads();
}
__device__ __forceinline__ void lru_scan_task(const float* __restrict__ a_in, const float* __restrict__ u_in, const bf16_t* __restrict__ proj, const float* __restrict__ mix_gain, bf16_t* __restrict__ y, int b) {
    const int c = threadIdx.x;
    const float mg = mix_gain[512 + c];
    float hst = 0.f;
    for (int t = 0; t < SEQ; ++t) {
        const size_t row = (size_t)(b * SEQ + t);
        hst = a_in[row * 256 + c] * hst + u_in[row * 256 + c];
        const float yv = hst * geluf_(bf2f(proj[row * NP + C_CG + c]));
        const float ms = wave_sum(yv * yv) * (1.f / 64.f);
        y[row * 1024 + 512 + c] = f2bf(yv * rsqrtf(ms + EPS) * mg);
    }
}

typedef short s16x4 __attribute__((ext_vector_type(4)));
#define LDS_AS __attribute__((address_space(3)))
__device__ __forceinline__ bf16x8 frag_rm(const bf16_t* tile, int ld, int r0, int k0, int lane) { return *(const bf16x8*)(tile + (r0 + (lane & 15)) * ld + k0 + (lane >> 4) * 8); }
__device__ __forceinline__ s16x4 tr4(const bf16_t* tile, int ld, int rbase, int c0, int lane) {
    const bf16_t* p = tile + (rbase + ((lane & 15) >> 2)) * ld + c0 + 4 * (lane & 3);
    return __builtin_amdgcn_ds_read_tr16_b64_v4i16((LDS_AS s16x4*)p);
}
__device__ __forceinline__ bf16x8 frag_cm(const bf16_t* tile, int ld, int k0, int c0, int lane) {
    const s16x4 lo = tr4(tile, ld, k0 + (lane >> 4) * 8, c0, lane), hi = tr4(tile, ld, k0 + (lane >> 4) * 8 + 4, c0, lane);
    return (bf16x8){lo[0], lo[1], lo[2], lo[3], hi[0], hi[1], hi[2], hi[3]};
}
#define MFMA16(a, b, c) __builtin_amdgcn_mfma_f32_16x16x32_bf16((a), (b), (c), 0, 0, 0)
constexpr int TLD = 72;

__device__ __forceinline__ void attn_task(char* smem, const bf16_t* __restrict__ Q, int ldq, const bf16_t* __restrict__ Kp, int ldk, const bf16_t* __restrict__ Vp, int ldv, const float* __restrict__ bias,
                                          int nq_per_b, int nk_per_b, int causal, float scale, bf16_t* __restrict__ O, int ldo, const float* __restrict__ gain, int rms, int task) {
    bf16_t* sK = (bf16_t*)smem;
    bf16_t* sV = sK + 2 * 64 * TLD;
    float* sC = (float*)(sV + 2 * 64 * TLD);
    const int tid = threadIdx.x, lane = tid & 63, wave = tid >> 6, g = lane >> 4, li = lane & 15;
    const int nqt = nq_per_b / 128;
    const int qt = task % nqt, h = (task / nqt) & 3, b = task / (nqt * 4);
    const int q0 = qt * 128, tq = q0 + wave * 16 + li;
    const size_t qrow = (size_t)b * nq_per_b + tq;
    bf16x8 qf[2];
#pragma unroll
    for (int kk = 0; kk < 2; ++kk) qf[kk] = *(const bf16x8*)(Q + qrow * ldq + h * 64 + kk * 32 + g * 8);
    const float ct = bias ? bias[(size_t)(b * 4 + h) * nq_per_b + tq] : 0.f;
    const int nkt = causal ? (q0 + 128) / 64 : nk_per_b / 64;
    const int sr = tid >> 3, sc = tid & 7;
    const bf16_t* kg = Kp + ((size_t)b * nk_per_b + sr) * ldk + h * 64 + sc * 8;
    const bf16_t* vg = Vp + ((size_t)b * nk_per_b + sr) * ldv + h * 64 + sc * 8;
    const float* cg_ = bias ? bias + (size_t)(b * 4 + h) * nk_per_b : nullptr;
    u32x4 rk = *(const u32x4*)kg, rv = *(const u32x4*)vg; float rc = (cg_ && tid < 64) ? cg_[tid] : 0.f;
    __syncthreads();
    *(u32x4*)(sK + sr * TLD + sc * 8) = rk; *(u32x4*)(sV + sr * TLD + sc * 8) = rv; if (tid < 64) sC[tid] = rc;
    __syncthreads();
    f32x4 oacc[4];
#pragma unroll
    for (int n = 0; n < 4; ++n) oacc[n] = (f32x4){0.f, 0.f, 0.f, 0.f};
    float mrun = -INFINITY, lrun = 0.f;
    for (int kt = 0; kt < nkt; ++kt) {
        const int buf = kt & 1;
        if (kt + 1 < nkt) { rk = *(const u32x4*)(kg + (size_t)(kt + 1) * 64 * ldk); rv = *(const u32x4*)(vg + (size_t)(kt + 1) * 64 * ldv); rc = (cg_ && tid < 64) ? cg_[(kt + 1) * 64 + tid] : 0.f; }
        const bf16_t* cK = sK + buf * 64 * TLD; const bf16_t* cV = sV + buf * 64 * TLD; const float* cC = sC + buf * 64;
        const bool skip = causal && (kt * 64 > q0 + wave * 16 + 15);
        if (!skip) {
            f32x4 sacc[4];
#pragma unroll
            for (int n = 0; n < 4; ++n) {
                sacc[n] = (f32x4){0.f, 0.f, 0.f, 0.f};
#pragma unroll
                for (int kk = 0; kk < 2; ++kk) sacc[n] = MFMA16(frag_rm(cK, TLD, n * 16, kk * 32, lane), qf[kk], sacc[n]);
            }
            float mx = -INFINITY;
#pragma unroll
            for (int n = 0; n < 4; ++n) {
                const f32x4 cs = *(const f32x4*)(cC + n * 16 + 4 * g);
#pragma unroll
                for (int r = 0; r < 4; ++r) {
                    float v = sacc[n][r] * scale + (ct - cs[r]);
                    if (causal && (kt * 64 + n * 16 + 4 * g + r > tq)) v = -INFINITY;
                    sacc[n][r] = v; mx = fmaxf(mx, v);
                }
            }
            mx = fmaxf(mx, __shfl_xor(mx, 16)); mx = fmaxf(mx, __shfl_xor(mx, 32));
            const float mnew = fmaxf(mrun, mx);
            const float corr = __expf(mrun - mnew);
            float rs = 0.f;
#pragma unroll
            for (int n = 0; n < 4; ++n)
#pragma unroll
                for (int r = 0; r < 4; ++r) { const float p = __expf(sacc[n][r] - mnew); sacc[n][r] = p; rs += p; }
            rs += __shfl_xor(rs, 16); rs += __shfl_xor(rs, 32);
            lrun = lrun * corr + rs; mrun = mnew;
            bf16x8 pf[2];
#pragma unroll
            for (int kk = 0; kk < 2; ++kk) {
                const unsigned a0 = pk2(sacc[2 * kk][0], sacc[2 * kk][1]), a1 = pk2(sacc[2 * kk][2], sacc[2 * kk][3]);
                const unsigned a2 = pk2(sacc[2 * kk + 1][0], sacc[2 * kk + 1][1]), a3 = pk2(sacc[2 * kk + 1][2], sacc[2 * kk + 1][3]);
                const u32x4 pk = (u32x4){a0, a1, a2, a3};
                pf[kk] = __builtin_bit_cast(bf16x8, pk);
            }
#pragma unroll
            for (int n2 = 0; n2 < 4; ++n2) {
                oacc[n2] = oacc[n2] * corr;
#pragma unroll
                for (int kk = 0; kk < 2; ++kk) {
                    const s16x4 lo = tr4(cV, TLD, (2 * kk) * 16 + 4 * g, n2 * 16, lane), hi = tr4(cV, TLD, (2 * kk + 1) * 16 + 4 * g, n2 * 16, lane);
                    const bf16x8 vf = (bf16x8){lo[0], lo[1], lo[2], lo[3], hi[0], hi[1], hi[2], hi[3]};
                    oacc[n2] = MFMA16(vf, pf[kk], oacc[n2]);
                }
            }
        }
        if (kt + 1 < nkt) { const int nb = buf ^ 1; *(u32x4*)(sK + nb * 64 * TLD + sr * TLD + sc * 8) = rk; *(u32x4*)(sV + nb * 64 * TLD + sr * TLD + sc * 8) = rv; if (tid < 64) sC[nb * 64 + tid] = rc; }
        __syncthreads();
    }
    const float inv = 1.f / lrun;
    float ms = 0.f;
#pragma unroll
    for (int n = 0; n < 4; ++n) { oacc[n] = oacc[n] * inv; ms += oacc[n][0] * oacc[n][0] + oacc[n][1] * oacc[n][1] + oacc[n][2] * oacc[n][2] + oacc[n][3] * oacc[n][3]; }
    ms += __shfl_xor(ms, 16); ms += __shfl_xor(ms, 32);
    const float rinv = rms ? rsqrtf(ms * (1.f / 64.f) + EPS) : 1.f;
#pragma unroll
    for (int n = 0; n < 4; ++n) {
        const int d = n * 16 + 4 * g;
        f32x4 gg = (f32x4){1.f, 1.f, 1.f, 1.f};
        if (gain) gg = *(const f32x4*)(gain + h * 64 + d);
        uint2 o; o.x = pk2(oacc[n][0] * rinv * gg[0], oacc[n][1] * rinv * gg[1]); o.y = pk2(oacc[n][2] * rinv * gg[2], oacc[n][3] * rinv * gg[3]);
        *(uint2*)(O + qrow * ldo + h * 64 + d) = o;
    }
}


__device__ __forceinline__ void hgrn_scan(float* LF  , float* SEGT  , const bf16_t* __restrict__ prow  , const float* __restrict__ hgrn_lb, int layer, int h, float (&kk)[8]) {
    const int tid = threadIdx.x, t = tid >> 3, k8 = (tid & 7) * 8;
    const u32x4 raw = *(const u32x4*)(prow + (size_t)t * NP + C_AF + k8);
#pragma unroll
    for (int j = 0; j < 8; ++j) {
        const float fl = __uint_as_float((j & 1) ? (raw[j >> 1] & 0xffff0000u) : (raw[j >> 1] << 16));
        float lbk = 0.f;
        if (layer == 1) { const float a0 = hgrn_lb[h * 64 + k8 + j], a1 = hgrn_lb[256 + h * 64 + k8 + j]; lbk = 1.f / (1.f + __expf(a0 - a1)); }
        const float sg = sigmoidf_(fl);
        const float f = lbk + (1.f - lbk) * sg;
        kk[j] = (1.f - lbk) * (1.f - sg);
        LF[t * 65 + k8 + j] = __logf(f);
    }
    __syncthreads();
    { const int k = tid & 63, seg = tid >> 6; float run = 0.f;
#pragma unroll
      for (int i = 0; i < 8; ++i) { run += LF[(seg * 8 + i) * 65 + k]; LF[(seg * 8 + i) * 65 + k] = run; }
      SEGT[seg * 64 + k] = run; }
    __syncthreads();
    { const int k = tid & 63, seg = tid >> 6; float off = 0.f;
      for (int s2 = 0; s2 < seg; ++s2) off += SEGT[s2 * 64 + k];
#pragma unroll
      for (int i = 0; i < 8; ++i) LF[(seg * 8 + i) * 65 + k] += off; }
    __syncthreads();
}
__device__ __forceinline__ float bfx(const u32x4& raw, int j) { return __uint_as_float((j & 1) ? (raw[j >> 1] & 0xffff0000u) : (raw[j >> 1] << 16)); }

__device__ __forceinline__ void hgrn_local_task(char* smem, const bf16_t* __restrict__ proj, const float* __restrict__ hgrn_lb, int layer, float* __restrict__ HL, float* __restrict__ HD, int ch) {
    float* LF = (float*)smem; float* SEGT = LF + 64 * 65;
    bf16_t* sKd = (bf16_t*)(SEGT + 8 * 64); bf16_t* sV = sKd + 64 * TLD;
    const int tid = threadIdx.x, lane = tid & 63, wave = tid >> 6, g = lane >> 4, li = lane & 15;
    const int bh = ch >> 5, n = ch & 31, b = bh >> 2, h = bh & 3;
    const bf16_t* prow = proj + (size_t)(b * SEQ + n * 64) * NP + h * 64;
    const int t = tid >> 3, k8 = (tid & 7) * 8;
    __syncthreads();
    *(u32x4*)(sV + t * TLD + k8) = *(const u32x4*)(prow + (size_t)t * NP + C_AI + k8);
    float kk[8];
    hgrn_scan(LF, SEGT, prow, hgrn_lb, layer, h, kk);
    { u32x4 o;
#pragma unroll
      for (int j = 0; j < 8; j += 2) {
          const float e0 = kk[j] * __expf(LF[63 * 65 + k8 + j] - LF[t * 65 + k8 + j]), e1 = kk[j + 1] * __expf(LF[63 * 65 + k8 + j + 1] - LF[t * 65 + k8 + j + 1]);
          o[j >> 1] = pk2(e0, e1);
      }
      *(u32x4*)(sKd + t * TLD + k8) = o; }
    if (tid < 64) HD[(size_t)ch * 64 + tid] = __expf(LF[63 * 65 + tid]);
    __syncthreads();
#pragma unroll
    for (int i = 0; i < 2; ++i) {
        const int idx = wave * 2 + i, vt = idx >> 2, kt = idx & 3;
        f32x4 acc = (f32x4){0.f, 0.f, 0.f, 0.f};
#pragma unroll
        for (int ks = 0; ks < 2; ++ks) acc = MFMA16(frag_cm(sV, TLD, ks * 32, vt * 16, lane), frag_cm(sKd, TLD, ks * 32, kt * 16, lane), acc);
        *(f32x4*)(HL + (size_t)ch * 4096 + (kt * 16 + li) * 64 + vt * 16 + 4 * g) = acc;
    }
}

__device__ __forceinline__ void hgrn_out_task(char* smem, const bf16_t* __restrict__ proj, const float* __restrict__ hgrn_lb, int layer, const float* __restrict__ HL, const float* __restrict__ HD,
                                              const float* __restrict__ mix_gain, bf16_t* __restrict__ y, int ch) {
    float* LF = (float*)smem; float* SEGT = LF + 64 * 65; float* sMS = SEGT + 8 * 64;
    bf16_t* sST = (bf16_t*)(sMS + 128); bf16_t* sQ0 = sST + 64 * TLD; bf16_t* sQm = sQ0 + 64 * TLD; bf16_t* sKm = sQm + 64 * TLD; bf16_t* sV = sKm + 64 * TLD; bf16_t* sA = sV + 64 * TLD;
    const int tid = threadIdx.x, lane = tid & 63, wave = tid >> 6, g = lane >> 4, li = lane & 15;
    const int bh = ch >> 5, n = ch & 31, b = bh >> 2, h = bh & 3;
    const bf16_t* prow = proj + (size_t)(b * SEQ + n * 64) * NP + h * 64;
    const int t = tid >> 3, k8 = (tid & 7) * 8;
    __syncthreads();
    { const int v = tid & 63, kg = tid >> 6;
      float S[8];
#pragma unroll
      for (int j = 0; j < 8; ++j) S[j] = 0.f;
      const int ch0 = bh * 32;
      for (int m = 0; m < n; ++m) {
          const float* Lm = HL + (size_t)(ch0 + m) * 4096 + (kg * 8) * 64 + v; const float* Dm = HD + (size_t)(ch0 + m) * 64 + kg * 8;
#pragma unroll
          for (int j = 0; j < 8; ++j) S[j] = Dm[j] * S[j] + Lm[j * 64];
      }
      u32x4 o; o[0] = pk2(S[0], S[1]); o[1] = pk2(S[2], S[3]); o[2] = pk2(S[4], S[5]); o[3] = pk2(S[6], S[7]);
      *(u32x4*)(sST + v * TLD + kg * 8) = o; }
    const u32x4 qraw = *(const u32x4*)(prow + (size_t)t * NP + C_AQ + k8);
    *(u32x4*)(sV + t * TLD + k8) = *(const u32x4*)(prow + (size_t)t * NP + C_AI + k8);
    float kk[8];
    hgrn_scan(LF, SEGT, prow, hgrn_lb, layer, h, kk);
    { u32x4 o0, om, ok;
#pragma unroll
      for (int j = 0; j < 8; j += 2) {
          float q0v[2], qmv[2], kmv[2];
#pragma unroll
          for (int e = 0; e < 2; ++e) {
              const float bt = LF[t * 65 + k8 + j + e], r = LF[31 * 65 + k8 + j + e], q = siluf_(bfx(qraw, j + e));
              q0v[e] = q * __expf(bt); qmv[e] = q * __expf(bt - r); kmv[e] = kk[j + e] * __expf(r - bt);
          }
          o0[j >> 1] = pk2(q0v[0], q0v[1]); om[j >> 1] = pk2(qmv[0], qmv[1]); ok[j >> 1] = pk2(kmv[0], kmv[1]);
      }
      *(u32x4*)(sQ0 + t * TLD + k8) = o0; *(u32x4*)(sQm + t * TLD + k8) = om; *(u32x4*)(sKm + t * TLD + k8) = ok; }
    __syncthreads();
#pragma unroll
    for (int i = 0; i < 2; ++i) {
        const int idx = wave * 2 + i, tt = idx >> 2, st = idx & 3;
        f32x4 acc = (f32x4){0.f, 0.f, 0.f, 0.f};
#pragma unroll
        for (int ks = 0; ks < 2; ++ks) acc = MFMA16(frag_rm(sKm, TLD, st * 16, ks * 32, lane), frag_rm(sQm, TLD, tt * 16, ks * 32, lane), acc);
        const int tq = tt * 16 + li, s0 = st * 16 + 4 * g;
        uint2 o; o.x = pk2(s0 <= tq ? acc[0] : 0.f, s0 + 1 <= tq ? acc[1] : 0.f); o.y = pk2(s0 + 2 <= tq ? acc[2] : 0.f, s0 + 3 <= tq ? acc[3] : 0.f);
        *(uint2*)(sA + tq * TLD + s0) = o;
    }
    __syncthreads();
    { const int tt = wave >> 1;
      f32x4 oacc[2]; float ms = 0.f;
#pragma unroll
      for (int i = 0; i < 2; ++i) {
          const int vt = (wave & 1) * 2 + i;
          f32x4 acc = (f32x4){0.f, 0.f, 0.f, 0.f};
#pragma unroll
          for (int ks = 0; ks < 2; ++ks) acc = MFMA16(frag_rm(sST, TLD, vt * 16, ks * 32, lane), frag_rm(sQ0, TLD, tt * 16, ks * 32, lane), acc);
#pragma unroll
          for (int ks = 0; ks < 2; ++ks) acc = MFMA16(frag_cm(sV, TLD, ks * 32, vt * 16, lane), frag_rm(sA, TLD, tt * 16, ks * 32, lane), acc);
          oacc[i] = acc; ms += acc[0] * acc[0] + acc[1] * acc[1] + acc[2] * acc[2] + acc[3] * acc[3];
      }
      ms += __shfl_xor(ms, 16); ms += __shfl_xor(ms, 32);
      if (g == 0) sMS[(tt * 16 + li) * 2 + (wave & 1)] = ms;
      __syncthreads();
      const int tq = tt * 16 + li;
      const float rinv = rsqrtf((sMS[tq * 2] + sMS[tq * 2 + 1]) * (1.f / 64.f) + EPS);
      const size_t row = (size_t)(b * SEQ + n * 64 + tq);
#pragma unroll
      for (int i = 0; i < 2; ++i) {
          const int v0 = ((wave & 1) * 2 + i) * 16 + 4 * g;
          const uint2 graw = *(const uint2*)(proj + row * NP + C_AG + h * 64 + v0);
          const f32x4 mgv = *(const f32x4*)(mix_gain + C_AQ + h * 64 + v0);
          const float g0 = __uint_as_float(graw.x << 16), g1 = __uint_as_float(graw.x & 0xffff0000u), g2 = __uint_as_float(graw.y << 16), g3 = __uint_as_float(graw.y & 0xffff0000u);
          uint2 o; o.x = pk2(oacc[i][0] * rinv * siluf_(g0) * mgv[0], oacc[i][1] * rinv * siluf_(g1) * mgv[1]);
          o.y = pk2(oacc[i][2] * rinv * siluf_(g2) * mgv[2], oacc[i][3] * rinv * siluf_(g3) * mgv[3]);
          *(uint2*)(y + row * 1024 + h * 64 + v0) = o;
      }
    }
}


__device__ __forceinline__ void gdn_prep_task(char* smem, const bf16_t* __restrict__ proj, const float* __restrict__ gates, const float* __restrict__ conv_w  ,
                                              const float* __restrict__ a_log, const float* __restrict__ dt_bias, bf16_t* __restrict__ gt_all, float* __restrict__ glast, int ch) {
    float* sG = (float*)smem; float* sBeta = sG + 64;
    float* RHS = sBeta + 64;
    float* sM = RHS + 64 * 132;
    bf16_t* sK = (bf16_t*)(sM + 64 * 68); bf16_t* sQ = sK + 64 * TLD;
    const int tid = threadIdx.x, lane = tid & 63, wave = tid >> 6, g = lane >> 4, li = lane & 15;
    const int bh = ch >> 5, n = ch & 31, b = bh >> 2, h = bh & 3;
    const int t = tid >> 3, d8 = (tid & 7) * 8;
    const size_t row0 = (size_t)(b * SEQ + n * 64);
    bf16_t* gt = gt_all + (size_t)ch * 5 * 4096;
    __syncthreads();
    float qn[8], kn[8], vv[8];
    {
        const int spos = n * 64 + t;
#pragma unroll
        for (int sec = 0; sec < 3; ++sec) {
            const int col = (sec == 0 ? C_DQ : (sec == 1 ? C_DK : C_DV)) + h * 64 + d8;
            float acc[8];
#pragma unroll
            for (int e = 0; e < 8; ++e) acc[e] = 0.f;
#pragma unroll
            for (int j = 0; j < 4; ++j) {
                if (spos - (3 - j) >= 0) {
                    const u32x4 raw = *(const u32x4*)(proj + (row0 + t - (3 - j)) * NP + col);
                    const f32x4 w0 = *(const f32x4*)(conv_w + j * 768 + sec * 256 + h * 64 + d8), w1 = *(const f32x4*)(conv_w + j * 768 + sec * 256 + h * 64 + d8 + 4);
#pragma unroll
                    for (int e = 0; e < 8; ++e) acc[e] += (e < 4 ? w0[e] : w1[e - 4]) * bfx(raw, e);
                }
            }
#pragma unroll
            for (int e = 0; e < 8; ++e) { const float sv = siluf_(acc[e]); if (sec == 0) qn[e] = sv; else if (sec == 1) kn[e] = sv; else vv[e] = sv; }
        }
        float sq = 0.f, sk = 0.f;
#pragma unroll
        for (int e = 0; e < 8; ++e) { sq += qn[e] * qn[e]; sk += kn[e] * kn[e]; }
        sq += __shfl_xor(sq, 1); sq += __shfl_xor(sq, 2); sq += __shfl_xor(sq, 4);
        sk += __shfl_xor(sk, 1); sk += __shfl_xor(sk, 2); sk += __shfl_xor(sk, 4);
        const float rq = rsqrtf(sq + EPS) * 0.125f, rk = rsqrtf(sk + EPS);
#pragma unroll
        for (int e = 0; e < 8; ++e) { qn[e] *= rq; kn[e] *= rk; }
    }
    if ((tid & 7) == 0) {
        const float* gr = gates + (row0 + t) * 16;
        sBeta[t] = sigmoidf_(gr[4 + h]);
        sG[t] = -__expf(a_log[h]) * softplusf_(gr[8 + h] + dt_bias[h]);
    }
    __syncthreads();
    if (wave == 0) {
        float v = sG[lane];
#pragma unroll
        for (int o = 1; o < 64; o <<= 1) { const float nb = __shfl_up(v, o); if (lane >= o) v += nb; }
        sG[lane] = v;
    }
    __syncthreads();
    {
        const float Gt = sG[t], Gl = sG[63], bt = sBeta[t];
        const float eG = __expf(Gt), eD = __expf(Gl - Gt);
        u32x4 ok, oq, oqd, okd;
#pragma unroll
        for (int e = 0; e < 8; e += 2) {
            ok[e >> 1] = pk2(kn[e], kn[e + 1]); oq[e >> 1] = pk2(qn[e], qn[e + 1]);
            oqd[e >> 1] = pk2(qn[e] * eG, qn[e + 1] * eG); okd[e >> 1] = pk2(kn[e] * eD, kn[e + 1] * eD);
        }
        *(u32x4*)(sK + t * TLD + d8) = ok; *(u32x4*)(sQ + t * TLD + d8) = oq;
        *(u32x4*)(gt + 2 * 4096 + t * 64 + d8) = oqd; *(u32x4*)(gt + 3 * 4096 + t * 64 + d8) = okd;
#pragma unroll
        for (int e = 0; e < 8; ++e) { RHS[t * 132 + d8 + e] = vv[e] * bt; RHS[t * 132 + 64 + d8 + e] = kn[e] * bt * eG; }
        if (tid == 0) glast[ch] = __expf(Gl);
    }
    __syncthreads();
#pragma unroll
    for (int i = 0; i < 2; ++i) {
        const int idx = wave * 2 + i, tt = idx >> 2, st = idx & 3;
        f32x4 am = (f32x4){0.f, 0.f, 0.f, 0.f}, aq = (f32x4){0.f, 0.f, 0.f, 0.f};
#pragma unroll
        for (int ks = 0; ks < 2; ++ks) {
            const bf16x8 kf = frag_rm(sK, TLD, st * 16, ks * 32, lane);
            am = MFMA16(kf, frag_rm(sK, TLD, tt * 16, ks * 32, lane), am);
            aq = MFMA16(kf, frag_rm(sQ, TLD, tt * 16, ks * 32, lane), aq);
        }
        const int tq = tt * 16 + li, s0 = st * 16 + 4 * g;
        const float Gt = sG[tq], bt = sBeta[tq];
        f32x4 mo; float ao[4];
#pragma unroll
        for (int r = 0; r < 4; ++r) {
            const int sx = s0 + r;
            const float gm = (sx <= tq) ? __expf(Gt - sG[sx]) : 0.f;
            mo[r] = (sx < tq) ? bt * am[r] * gm : 0.f;
            ao[r] = aq[r] * gm;
        }
        *(f32x4*)(sM + tq * 68 + s0) = mo;
        uint2 o; o.x = pk2(ao[0], ao[1]); o.y = pk2(ao[2], ao[3]);
        *(uint2*)(gt + 4 * 4096 + tq * 64 + s0) = o;
    }
    __syncthreads();
    if (tid < 128) {
        float X[64];
#pragma unroll
        for (int i = 0; i < 64; ++i) X[i] = 0.f;
#pragma unroll
        for (int tt = 0; tt < 64; ++tt) {
            float a0 = RHS[tt * 132 + tid], a1 = 0.f;
#pragma unroll
            for (int s4 = 0; s4 < tt; s4 += 4) {
                const f32x4 m = *(const f32x4*)(sM + tt * 68 + s4);
                if ((s4 >> 2) & 1) { a1 -= m[0] * X[s4]; a1 -= m[1] * X[s4 + 1]; a1 -= m[2] * X[s4 + 2]; a1 -= m[3] * X[s4 + 3]; }
                else { a0 -= m[0] * X[s4]; a0 -= m[1] * X[s4 + 1]; a0 -= m[2] * X[s4 + 2]; a0 -= m[3] * X[s4 + 3]; }
            }
            X[tt] = a0 + a1;
        }
        if (tid < 64) {
#pragma unroll
            for (int tt = 0; tt < 64; ++tt) gt[tt * 64 + tid] = f2bf(X[tt]);
        } else {
#pragma unroll
            for (int tt = 0; tt < 64; ++tt) gt[4096 + tt * 64 + (tid - 64)] = f2bf(-X[tt]);
        }
    }
}

__device__ __forceinline__ void gdn_scan_task(char* smem, const bf16_t* __restrict__ gt_all, const float* __restrict__ glast, const bf16_t* __restrict__ proj, const float* __restrict__ mix_gain,
                                              bf16_t* __restrict__ y, int bh) {
    bf16_t* sT = (bf16_t*)smem;
    bf16_t* sST = sT + 2 * 5 * 64 * TLD;
    bf16_t* sVn = sST + 2 * 64 * TLD;
    const int tid = threadIdx.x, lane = tid & 63, wave = tid >> 6, g = lane >> 4, li = lane & 15;
    const int b = bh >> 2, h = bh & 3;
    const int sr = tid >> 3, sc8 = (tid & 7) * 8;
    const bf16_t* gsrc = gt_all + (size_t)bh * 32 * 5 * 4096 + sr * 64 + sc8;
    __syncthreads();
    u32x4 regs[5];
#pragma unroll
    for (int i = 0; i < 5; ++i) regs[i] = *(const u32x4*)(gsrc + i * 4096);
#pragma unroll
    for (int i = 0; i < 5; ++i) *(u32x4*)(sT + i * 64 * TLD + sr * TLD + sc8) = regs[i];
    *(u32x4*)(sST + sr * TLD + sc8) = (u32x4){0u, 0u, 0u, 0u};
    f32x4 sacc[4];
#pragma unroll
    for (int i = 0; i < 4; ++i) sacc[i] = (f32x4){0.f, 0.f, 0.f, 0.f};
    __syncthreads();
    for (int n = 0; n < 32; ++n) {
        const int buf = n & 1;
        const bf16_t* cT = sT + buf * 5 * 64 * TLD;
        const bf16_t* sU = cT; const bf16_t* sWn = cT + 64 * TLD; const bf16_t* sQd = cT + 2 * 64 * TLD; const bf16_t* sKd = cT + 3 * 64 * TLD; const bf16_t* sAq = cT + 4 * 64 * TLD;
        const bf16_t* cST = sST + buf * 64 * TLD; bf16_t* nST = sST + (buf ^ 1) * 64 * TLD;
        if (n + 1 < 32) {
#pragma unroll
            for (int i = 0; i < 5; ++i) regs[i] = *(const u32x4*)(gsrc + (size_t)(n + 1) * 5 * 4096 + i * 4096);
        }
        const size_t rowz = (size_t)(b * SEQ + n * 64 + (wave & 3) * 16 + li);
        uint2 zraw[4];
        if (wave < 4) {
#pragma unroll
            for (int vt = 0; vt < 4; ++vt) zraw[vt] = *(const uint2*)(proj + rowz * NP + C_DZ + h * 64 + vt * 16 + 4 * g);
        }
#pragma unroll
        for (int i = 0; i < 2; ++i) {
            const int idx = wave * 2 + i, tt = idx >> 2, vt = idx & 3;
            const int tq = tt * 16 + li, v0 = vt * 16 + 4 * g;
            const uint2 uraw = *(const uint2*)(sU + tq * TLD + v0);
            f32x4 acc = (f32x4){__uint_as_float(uraw.x << 16), __uint_as_float(uraw.x & 0xffff0000u), __uint_as_float(uraw.y << 16), __uint_as_float(uraw.y & 0xffff0000u)};
#pragma unroll
            for (int ks = 0; ks < 2; ++ks) acc = MFMA16(frag_rm(cST, TLD, vt * 16, ks * 32, lane), frag_rm(sWn, TLD, tt * 16, ks * 32, lane), acc);
            uint2 o; o.x = pk2(acc[0], acc[1]); o.y = pk2(acc[2], acc[3]);
            *(uint2*)(sVn + tq * TLD + v0) = o;
        }
        __syncthreads();
        if (wave < 4) {
            const int tt = wave;
            f32x4 oacc[4]; float ms = 0.f;
#pragma unroll
            for (int vt = 0; vt < 4; ++vt) {
                f32x4 acc = (f32x4){0.f, 0.f, 0.f, 0.f};
#pragma unroll
                for (int ks = 0; ks < 2; ++ks) acc = MFMA16(frag_rm(cST, TLD, vt * 16, ks * 32, lane), frag_rm(sQd, TLD, tt * 16, ks * 32, lane), acc);
#pragma unroll
                for (int ks = 0; ks < 2; ++ks) acc = MFMA16(frag_cm(sVn, TLD, ks * 32, vt * 16, lane), frag_rm(sAq, TLD, tt * 16, ks * 32, lane), acc);
                oacc[vt] = acc; ms += acc[0] * acc[0] + acc[1] * acc[1] + acc[2] * acc[2] + acc[3] * acc[3];
            }
            ms += __shfl_xor(ms, 16); ms += __shfl_xor(ms, 32);
            const float rinv = rsqrtf(ms * (1.f / 64.f) + EPS);
#pragma unroll
            for (int vt = 0; vt < 4; ++vt) {
                const int v0 = vt * 16 + 4 * g;
                const f32x4 mgv = *(const f32x4*)(mix_gain + 768 + h * 64 + v0);
                const float z0 = __uint_as_float(zraw[vt].x << 16), z1 = __uint_as_float(zraw[vt].x & 0xffff0000u), z2 = __uint_as_float(zraw[vt].y << 16), z3 = __uint_as_float(zraw[vt].y & 0xffff0000u);
                uint2 o; o.x = pk2(oacc[vt][0] * rinv * siluf_(z0) * mgv[0], oacc[vt][1] * rinv * siluf_(z1) * mgv[1]);
                o.y = pk2(oacc[vt][2] * rinv * siluf_(z2) * mgv[2], oacc[vt][3] * rinv * siluf_(z3) * mgv[3]);
                *(uint2*)(y + rowz * 1024 + 768 + h * 64 + v0) = o;
            }
        } else {
            const int kt = wave - 4;
            const float gl = glast[bh * 32 + n];
#pragma unroll
            for (int vt = 0; vt < 4; ++vt) {
                f32x4 acc = sacc[vt] * gl;
#pragma unroll
                for (int ks = 0; ks < 2; ++ks) acc = MFMA16(frag_cm(sKd, TLD, ks * 32, kt * 16, lane), frag_cm(sVn, TLD, ks * 32, vt * 16, lane), acc);
                sacc[vt] = acc;
                uint2 o; o.x = pk2(acc[0], acc[1]); o.y = pk2(acc[2], acc[3]);
                *(uint2*)(nST + (vt * 16 + li) * TLD + kt * 16 + 4 * g) = o;
            }
        }
        if (n + 1 < 32) {
            bf16_t* nT = sT + (buf ^ 1) * 5 * 64 * TLD;
#pragma unroll
            for (int i = 0; i < 5; ++i) *(u32x4*)(nT + i * 64 * TLD + sr * TLD + sc8) = regs[i];
        }
        __syncthreads();
    }
}

__device__ __forceinline__ void router_phase(char* smem, const float* __restrict__ x, const float* __restrict__ g, const float* __restrict__ w_rg, const float* __restrict__ b_rg,
                                             const float* __restrict__ w_re, const float* __restrict__ b_re, bf16_t* __restrict__ hn, int* __restrict__ cnt, int* __restrict__ list, float* __restrict__ pgate) {
    const int w = threadIdx.x >> 6, lane = threadIdx.x & 63;
    float* sh = (float*)smem + w * 1024;
    float* slog = (float*)smem + 8 * 1024 + w * 64;
    for (int t = blockIdx.x * 8 + w; t < T; t += gridDim.x * 8) {
        const f32x4* xr = (const f32x4*)(x + (size_t)t * 1024) + lane;
        f32x4 v[4]; float s = 0.f;
#pragma unroll
        for (int j = 0; j < 4; ++j) { v[j] = xr[64 * j]; s += v[j].x * v[j].x + v[j].y * v[j].y + v[j].z * v[j].z + v[j].w * v[j].w; }
        const float rinv = rsqrtf(wave_sum(s) * (1.f / 1024.f) + EPS);
#pragma unroll
        for (int j = 0; j < 4; ++j) {
            const f32x4 gg = ((const f32x4*)g)[lane + 64 * j];
            const f32x4 hv = v[j] * rinv * gg;
            *(f32x4*)&sh[(lane + 64 * j) * 4] = hv;
            uint2 o; o.x = pk2(hv.x, hv.y); o.y = pk2(hv.z, hv.w);
            *(uint2*)(hn + (size_t)t * 1024 + (lane + 64 * j) * 4) = o;
        }
        __builtin_amdgcn_wave_barrier();
        float a = 0.f;
        if (lane < 36) {
            const float* wp = lane < 4 ? (w_rg + lane) : (w_re + (lane - 4));
            const int ld = lane < 4 ? 4 : 32;
            for (int k = 0; k < 1024; ++k) a += sh[k] * wp[(size_t)k * ld];
            a += lane < 4 ? b_rg[lane] : b_re[lane - 4];
            slog[lane] = a;
        }
        __builtin_amdgcn_wave_barrier();
        if (lane == 0) {
            const float* lg = slog;
            int gs = 0; float gm = lg[0];
            for (int i = 1; i < 4; ++i) if (lg[i] > gm) { gm = lg[i]; gs = i; }
            float den = 0.f; for (int i = 0; i < 4; ++i) den += __expf(lg[i] - gm);
            const float pg = 1.f / den;
            const float* le = lg + 4 + gs * 8;
            int i0 = 0; float m0 = le[0];
            for (int i = 1; i < 8; ++i) if (le[i] > m0) { m0 = le[i]; i0 = i; }
            int i1 = -1; float m1 = -INFINITY;
            for (int i = 0; i < 8; ++i) if (i != i0 && le[i] > m1) { m1 = le[i]; i1 = i; }
            const float e1 = __expf(m1 - m0); const float w0 = 1.f / (1.f + e1), w1 = e1 / (1.f + e1);
            const int ex0 = gs * 8 + i0, ex1 = gs * 8 + i1;
            const int pos0 = atomicAdd(&cnt[ex0], 1); list[(size_t)ex0 * T + pos0] = 2 * t; pgate[2 * t] = pg * w0;
            const int pos1 = atomicAdd(&cnt[ex1], 1); list[(size_t)ex1 * T + pos1] = 2 * t + 1; pgate[2 * t + 1] = pg * w1;
        }
        __builtin_amdgcn_wave_barrier();
    }
}

__device__ __forceinline__ void combine_phase(const float* x2, const bf16_t* __restrict__ eo, const float* __restrict__ g, float* xout, bf16_t* __restrict__ hn, int mode) {
    const int lane = threadIdx.x & 63;
    for (int t = blockIdx.x * 8 + (threadIdx.x >> 6); t < T; t += gridDim.x * 8) {
        f32x4 v[4]; float s = 0.f;
#pragma unroll
        for (int j = 0; j < 4; ++j) {
            const int c = (lane + 64 * j) * 4;
            v[j] = *(const f32x4*)(x2 + (size_t)t * 1024 + c);
            const uint2 e0 = *(const uint2*)(eo + (size_t)(2 * t) * 1024 + c), e1 = *(const uint2*)(eo + (size_t)(2 * t + 1) * 1024 + c);
            v[j].x += __uint_as_float(e0.x << 16) + __uint_as_float(e1.x << 16);
            v[j].y += __uint_as_float(e0.x & 0xffff0000u) + __uint_as_float(e1.x & 0xffff0000u);
            v[j].z += __uint_as_float(e0.y << 16) + __uint_as_float(e1.y << 16);
            v[j].w += __uint_as_float(e0.y & 0xffff0000u) + __uint_as_float(e1.y & 0xffff0000u);
            s += v[j].x * v[j].x + v[j].y * v[j].y + v[j].z * v[j].z + v[j].w * v[j].w;
        }
        const float rinv = rsqrtf(wave_sum(s) * (1.f / 1024.f) + EPS);
#pragma unroll
        for (int j = 0; j < 4; ++j) {
            const int c = (lane + 64 * j) * 4;
            const f32x4 gg = *(const f32x4*)(g + c);
            const f32x4 hv = v[j] * rinv * gg;
            if (mode == 0) {
                *(f32x4*)(xout + (size_t)t * 1024 + c) = v[j];
                uint2 o; o.x = pk2(hv.x, hv.y); o.y = pk2(hv.z, hv.w);
                *(uint2*)(hn + (size_t)t * 1024 + c) = o;
            } else {
                *(f32x4*)(xout + (size_t)t * 1024 + c) = hv;
            }
        }
    }
}

template <int l>
__device__ __forceinline__ void layer_body(const Params& P, char* smem, cg::grid_group& grid, const float* xcur) {
    char* ws = P.ws;
    bf16_t* Wt_in = (bf16_t*)(ws + OFF_WIN); bf16_t* Wt_out = (bf16_t*)(ws + OFF_WOUT); bf16_t* Wt_mq = (bf16_t*)(ws + OFF_WMQ); bf16_t* Wt_mkv = (bf16_t*)(ws + OFF_WMKV);
    bf16_t* Wt_mo = (bf16_t*)(ws + OFF_WMO); bf16_t* Wt_gu = (bf16_t*)(ws + OFF_WGU); bf16_t* Wt_dn = (bf16_t*)(ws + OFF_WDN);
    bf16_t* hn = (bf16_t*)(ws + OFF_HN); bf16_t* proj = (bf16_t*)(ws + OFF_PROJ); float* gates = (float*)(ws + OFF_GATES); bf16_t* y = (bf16_t*)(ws + OFF_Y);
    float* XA = P.out; float* XB = (float*)(ws + OFF_XB);
    bf16_t* qm = (bf16_t*)(ws + OFF_QM); bf16_t* om = (bf16_t*)(ws + OFF_OM); bf16_t* kvm = (bf16_t*)(ws + OFF_KVM); bf16_t* memn = (bf16_t*)(ws + OFF_MEMN);
    float* foxc = (float*)(ws + OFF_FOXC); float* lrua = (float*)(ws + OFF_LRUA); float* lruu = (float*)(ws + OFF_LRUU);
    int* cnt_all = (int*)(ws + OFF_CNT); int* list = (int*)(ws + OFF_LIST); float* pgate = (float*)(ws + OFF_PGATE);
    bf16_t* act = (bf16_t*)(ws + OFF_ACT); bf16_t* eo = (bf16_t*)(ws + OFF_EO);
    const int wave = threadIdx.x >> 6, lane = threadIdx.x & 63;


        float* x1 = (l == 0) ? XA : XB;
        float* x2 = (l == 0) ? XB : XA;
        int* cnt = cnt_all + 32 * l;
        const float* mg = P.in[I_MIX_GAIN] + l * 1024;
        gemm_phase<EPI_INPROJ>(smem, hn, 1024, Wt_in + (size_t)l * NP * 1024, 1024, T, NP, 1024, proj, NP, nullptr, gates);
        if (l == 0) for (int l2 = 0; l2 < NL; ++l2)
            gemm_phase<EPI_BF16>(smem, memn + (size_t)l2 * 2048 * 1024, 1024, Wt_mkv + (size_t)l2 * 512 * 1024, 1024, 2048, 512, 1024, kvm + (size_t)l2 * 2048 * 512, 512, nullptr, nullptr);
        grid.sync();
        {
            const int bx = blockIdx.x;
            bf16_t* gtiles = (bf16_t*)(ws + OFF_GDN); float* glast = (float*)(ws + OFF_GLAST);
            if (bx < 32 && wave == 1) fox_cumsum(gates, P.in[I_FOX_FB] + l * 4, foxc, bx, lane);
            BLK_LOOP(ch, 1024) gdn_prep_task(smem, proj, gates, P.in[I_GDN_CONV_W] + l * 4 * 768, P.in[I_GDN_A_LOG] + l * 4, P.in[I_GDN_DT_BIAS] + l * 4, gtiles, glast, ch);
            BLK_LOOP(ch, 1024) hgrn_local_task(smem, proj, P.in[I_HGRN_LB], l, (float*)(ws + OFF_HL), (float*)(ws + OFF_HD), ch);
            __syncthreads();
            {
                const int half = threadIdx.x >> 8;
                for (int base = 0; base < T / 16; base += gridDim.x * 2) {
                    const int task = base + bx * 2 + half;
                    lru_prep_task((float*)smem + half * 16 * 256, proj, P.in[I_LRU_CONV_W] + l * 1024, P.in[I_LRU_CONV_B] + l * 256, P.in[I_LRU_WA] + l * 16384, P.in[I_LRU_BA] + l * 256,
                                  P.in[I_LRU_WX] + l * 16384, P.in[I_LRU_BX] + l * 256, P.in[I_LRU_LAM] + l * 256, lrua, lruu, task, task < T / 16);
                }
            }
        }
        grid.sync();
        {
            const int natt = (SEQ / 128) * 4 * NB;
            const int bx = blockIdx.x, nfree = (int)gridDim.x - 32;
            if (bx < 32) gdn_scan_task(smem, (const bf16_t*)(ws + OFF_GDN), (const float*)(ws + OFF_GLAST), proj, mg, y, bx);
            else {
                if (bx < 32 + NB && threadIdx.x < 256) lru_scan_task(lrua, lruu, proj, mg, y, bx - 32);
                for (int i = bx - 32; i < natt; i += nfree) {
                    const int qt = 15 - (i >> 5), bh = i & 31;
                    attn_task(smem, proj + C_BQ, NP, proj + C_BK, NP, proj + C_BV, NP, foxc, SEQ, SEQ, 1, 0.125f, y + 256, 1024, mg + 256, 1, (bh * 16) + qt);
                }
                for (int i = bx - 32; i < 1024; i += nfree) {
                    const int ch = (i & 31) * 32 + (31 - (i >> 5));
                    hgrn_out_task(smem, proj, P.in[I_HGRN_LB], l, (const float*)(ws + OFF_HL), (const float*)(ws + OFF_HD), mg, y, ch);
                }
            }
        }
        grid.sync();
        gemm_phase<EPI_RESID>(smem, y, 1024, Wt_out + (size_t)l * 1024 * 1024, 1024, T, 1024, 1024, x1, 1024, xcur, nullptr);
        grid.sync();
        for (int row = blockIdx.x * 8 + wave; row < T; row += gridDim.x * 8) rms_row_bf16(x1 + (size_t)row * 1024, P.in[I_NORM_MEM] + l * 1024, hn + (size_t)row * 1024, lane);
        grid.sync();
        gemm_phase<EPI_BF16>(smem, hn, 1024, Wt_mq + (size_t)l * 256 * 1024, 1024, T, 256, 1024, qm, 256, nullptr, nullptr);
        grid.sync();
        { const bf16_t* kv = kvm + (size_t)l * 2048 * 512;
          BLK_LOOP(task, (SEQ / 128) * 4 * NB) attn_task(smem, qm, 256, kv, 512, kv + 256, 512, nullptr, SEQ, MEMLEN, 0, 0.125f, om, 256, nullptr, 0, task); }
        grid.sync();
        gemm_phase<EPI_RESID>(smem, om, 256, Wt_mo + (size_t)l * 1024 * 256, 256, T, 1024, 256, x2, 1024, x1, nullptr);
        grid.sync();
        router_phase(smem, x2, P.in[I_NORM_FFN] + l * 1024, P.in[I_W_RG] + l * 4096, P.in[I_B_RG] + l * 4, P.in[I_W_RE] + l * 32768, P.in[I_B_RE] + l * 32, hn, cnt, list, pgate);
        grid.sync();
        moe_phase<1>(smem, hn, 1024, Wt_gu + (size_t)l * 32 * 512 * 1024, (size_t)512 * 1024, 1024, 1024, cnt, list, pgate, act);
        grid.sync();
        moe_phase<2>(smem, act, 256, Wt_dn + (size_t)l * 32 * 1024 * 256, (size_t)1024 * 256, 256, 256, cnt, list, pgate, eo);
        grid.sync();
        if (l == 0) { combine_phase(x2, eo, P.in[I_NORM_MIX] + 1024, XA, hn, 0); grid.sync(); }
        else combine_phase(x2, eo, P.in[I_NORM_FINAL], P.out, hn, 1);
}
__global__ void __launch_bounds__(NTHR, 2) mega_kernel(Params P) {
    extern __shared__ __attribute__((aligned(16))) char smem[];
    cg::grid_group grid = cg::this_grid();
    phase0(P, smem);
    grid.sync();
    layer_body<0>(P, smem, grid, P.in[I_X]);
    layer_body<1>(P, smem, grid, P.out);
}

extern "C" void kernel_launch(void* const* d_in, const int* in_sizes, int n_in, void* d_out, int out_size, void* d_ws, size_t ws_size, hipStream_t stream) {
    static int grid_blocks = 0;
    if (grid_blocks == 0) {
        if (n_in != N_INPUTS || ws_size < OFF_END || out_size != T * 1024) { fprintf(stderr, "kernel_launch: unexpected sizes n_in=%d ws=%zu out=%d (need ws >= %zu)\n", n_in, ws_size, out_size, (size_t)OFF_END); grid_blocks = -1; return; }
        int dev = 0, cus = 0, per_cu = 0;
        if (hipGetDevice(&dev) != hipSuccess || hipDeviceGetAttribute(&cus, hipDeviceAttributeMultiprocessorCount, dev) != hipSuccess) { fprintf(stderr, "kernel_launch: device query failed\n"); grid_blocks = -1; return; }
        if (hipFuncSetAttribute((const void*)mega_kernel, hipFuncAttributeMaxDynamicSharedMemorySize, LDS_BYTES) != hipSuccess) { fprintf(stderr, "kernel_launch: hipFuncSetAttribute failed\n"); grid_blocks = -1; return; }
        if (hipOccupancyMaxActiveBlocksPerMultiprocessor(&per_cu, (const void*)mega_kernel, NTHR, LDS_BYTES) != hipSuccess || per_cu < 1) { fprintf(stderr, "kernel_launch: occupancy query says %d blocks/CU\n", per_cu); grid_blocks = -1; return; }
        grid_blocks = cus;
        fprintf(stderr, "kernel_launch: cus=%d per_cu=%d grid=%d\n", cus, per_cu, grid_blocks);
    }
    if (grid_blocks < 0) return;
    Params p; memset(&p, 0, sizeof p);
    for (int i = 0; i < N_INPUTS; ++i) p.in[i] = (const float*)d_in[i];
    p.out = (float*)d_out; p.ws = (char*)d_ws;
    void* args[] = {&p};
    hipError_t e = hipLaunchCooperativeKernel((const void*)mega_kernel, dim3(grid_blocks), dim3(NTHR), args, LDS_BYTES, stream);
    if (e != hipSuccess) fprintf(stderr, "kernel_launch: cooperative launch failed: %s (grid %d)\n", hipGetErrorString(e), grid_blocks);
}
```

```cpp
#include <hip/hip_runtime.h>
#include <stdint.h>
#include <stdio.h>
#include <string.h>
#include <hip/hip_cooperative_groups.h>
namespace cg = cooperative_groups;

typedef unsigned short bf16_t;
typedef short bf16x8 __attribute__((ext_vector_type(8)));
typedef float f32x4 __attribute__((ext_vector_type(4)));
typedef unsigned u32x4 __attribute__((ext_vector_type(4)));

constexpr int NB = 8, SEQ = 2048, DM = 1024, T = NB * SEQ, NL = 2;
constexpr int NP = 3456;
constexpr int NIN = 3340;
constexpr int C_AQ = 0, C_AF = 256, C_AI = 512, C_AG = 768, C_BQ = 1024, C_BK = 1280, C_BV = 1536, C_CX = 1792, C_CG = 2048,
              C_DQ = 2304, C_DK = 2560, C_DV = 2816, C_DZ = 3072, C_GATE = 3328;
constexpr int MEMLEN = 256;
constexpr int NEXP = 32, DEXP = 256;
constexpr float EPS = 1e-6f;

constexpr size_t al256(size_t x) { return (x + 255) & ~(size_t)255; }
constexpr size_t SZ_WIN = (size_t)NP * 1024 * 2, SZ_WOUT = (size_t)1024 * 1024 * 2, SZ_WMQ = (size_t)256 * 1024 * 2, SZ_WMKV = (size_t)512 * 1024 * 2,
                 SZ_WMO = (size_t)1024 * 256 * 2, SZ_WGU = (size_t)32 * 512 * 1024 * 2, SZ_WDN = (size_t)32 * 1024 * 256 * 2;
constexpr size_t OFF_WIN = 0;
constexpr size_t OFF_WOUT = OFF_WIN + NL * SZ_WIN;
constexpr size_t OFF_WMQ = OFF_WOUT + NL * SZ_WOUT;
constexpr size_t OFF_WMKV = OFF_WMQ + NL * SZ_WMQ;
constexpr size_t OFF_WMO = OFF_WMKV + NL * SZ_WMKV;
constexpr size_t OFF_WGU = OFF_WMO + NL * SZ_WMO;
constexpr size_t OFF_WDN = OFF_WGU + NL * SZ_WGU;
constexpr size_t OFF_HN = OFF_WDN + NL * SZ_WDN;
constexpr size_t OFF_PROJ = OFF_HN + (size_t)T * 1024 * 2;
constexpr size_t OFF_GATES = OFF_PROJ + (size_t)T * NP * 2;
constexpr size_t OFF_Y = OFF_GATES + (size_t)T * 16 * 4;
constexpr size_t OFF_XB = OFF_Y + (size_t)T * 1024 * 2;
constexpr size_t OFF_QM = OFF_XB + (size_t)T * 1024 * 4;
constexpr size_t OFF_OM = OFF_QM + (size_t)T * 256 * 2;
constexpr size_t OFF_KVM = OFF_OM + (size_t)T * 256 * 2;
constexpr size_t OFF_MEMN = OFF_KVM + (size_t)NL * 2048 * 512 * 2;
constexpr size_t OFF_FOXC = OFF_MEMN + (size_t)2048 * 1024 * 2;
constexpr size_t OFF_LRUA = OFF_FOXC + (size_t)NB * 4 * SEQ * 4;
constexpr size_t OFF_LRUU = OFF_LRUA + (size_t)T * 256 * 4;
constexpr size_t OFF_CNT = OFF_LRUU + (size_t)T * 256 * 4;
constexpr size_t OFF_LIST = OFF_CNT + 256;
constexpr size_t OFF_PGATE = OFF_LIST + (size_t)NEXP * T * 4;
constexpr size_t OFF_HL = OFF_PGATE + (size_t)2 * T * 4;
constexpr size_t OFF_HD = OFF_HL + (size_t)1024 * 4096 * 4;
constexpr size_t OFF_GDN = OFF_HD + (size_t)1024 * 64 * 4;
constexpr size_t OFF_GLAST = OFF_GDN + (size_t)1024 * 5 * 4096 * 2;
constexpr size_t OFF_LSUM = OFF_GLAST + 4096;
constexpr size_t OFF_END = OFF_LSUM + (size_t)2 * 256 * 256 * 4;
constexpr size_t OFF_ACT = OFF_PROJ;
constexpr size_t OFF_EO = OFF_PROJ + (size_t)2 * T * 256 * 2;
static_assert(OFF_EO + (size_t)2 * T * 1024 * 2 <= OFF_GATES, "overlay fits");

__device__ __forceinline__ float bf2f(bf16_t v) { return __uint_as_float(((unsigned)v) << 16); }
__device__ __forceinline__ bf16_t f2bf(float f) { unsigned u = __float_as_uint(f); return (bf16_t)((u + 0x7fffu + ((u >> 16) & 1u)) >> 16); }
__device__ __forceinline__ unsigned pk2(float lo, float hi) { return (unsigned)f2bf(lo) | ((unsigned)f2bf(hi) << 16); }
__device__ __forceinline__ float sigmoidf_(float x) { return 1.f / (1.f + __expf(-x)); }
__device__ __forceinline__ float siluf_(float x) { return x / (1.f + __expf(-x)); }
__device__ __forceinline__ float softplusf_(float x) { return x > 20.f ? x : log1pf(__expf(x)); }
__device__ __forceinline__ float logsigmoidf_(float x) { return x < 0.f ? x - log1pf(__expf(x)) : -log1pf(__expf(-x)); }
__device__ __forceinline__ float geluf_(float x) { float u = 0.7978845608028654f * (x + 0.044715f * x * x * x); return 0.5f * x * (1.f + tanhf(u)); }
__device__ __forceinline__ float wave_sum(float v) {
#pragma unroll
    for (int o = 1; o < 64; o <<= 1) v += __shfl_xor(v, o);
    return v;
}
__device__ __forceinline__ float rdlane(float v, int l) { return __int_as_float(__builtin_amdgcn_readlane(__float_as_int(v), l)); }

constexpr int NTHR = 512;
constexpr int LDS_BYTES = 147456;
enum { I_X = 0, I_MEM, I_NORM_MIX, I_W_IN, I_HGRN_LB, I_FOX_FB, I_LRU_CONV_W, I_LRU_CONV_B, I_LRU_WA, I_LRU_BA, I_LRU_WX, I_LRU_BX, I_LRU_LAM, I_GDN_CONV_W, I_GDN_A_LOG,
       I_GDN_DT_BIAS, I_MIX_GAIN, I_W_OUT, I_NORM_MEM, I_NORM_MEMKV, I_W_MQ, I_W_MKV, I_W_MO, I_NORM_FFN, I_W_RG, I_B_RG, I_W_RE, I_B_RE, I_W_E_GU, I_W_E_DN, I_NORM_FINAL, N_INPUTS };
struct Params { const float* in[N_INPUTS]; float* out; char* ws; };
static_assert(sizeof(Params) == 8 * (N_INPUTS + 2), "no padding");

#define BLK_LOOP(it, n) for (int it = (int)blockIdx.x; it < (n); it += (int)gridDim.x)

__device__ __forceinline__ int rowmap_fn(int mode, int n) {
    if (mode == 1) {
        if (n < 1792) return n;
        if (n < 1796) return C_GATE + (n - 1792);
        if (n < 3076) return n - 4;
        if (n < 3084) return C_GATE + 4 + (n - 3076);
        return n - 12;
    } else if (mode == 2) {
        int j = n & 255; return (j >> 4) * 32 + ((n >= 256) ? 16 : 0) + (j & 15);
    }
    return n;
}
__device__ __forceinline__ void convT_tile(float* tile  , const float* __restrict__ src, int K, int N, bf16_t* __restrict__ dst, int mode, int ntn, int idx) {
    const int n0 = (idx % ntn) * 64, k0 = (idx / ntn) * 64;
    const int tx = threadIdx.x & 63, ty = threadIdx.x >> 6;
    __syncthreads();
#pragma unroll
    for (int i = 0; i < 8; ++i) {
        const int k = ty + i * 8, n = n0 + tx;
        tile[k * 65 + tx] = (n < N) ? src[(size_t)(k0 + k) * N + n] : 0.f;
    }
    __syncthreads();
    const int kx = threadIdx.x & 31, ny = threadIdx.x >> 5;
#pragma unroll
    for (int i = 0; i < 4; ++i) {
        const int nl = ny + i * 16, n = n0 + nl;
        if (n < N) {
            const int r = rowmap_fn(mode, n);
            *(unsigned*)(dst + (size_t)r * K + k0 + 2 * kx) = pk2(tile[(2 * kx) * 65 + nl], tile[(2 * kx + 1) * 65 + nl]);
        }
    }
}
__device__ __forceinline__ void rms_row_bf16(const float* __restrict__ xrow, const float* __restrict__ g, bf16_t* __restrict__ orow, int lane) {
    const f32x4* xr = (const f32x4*)xrow + lane;
    f32x4 v[4]; float s = 0.f;
#pragma unroll
    for (int j = 0; j < 4; ++j) { v[j] = xr[64 * j]; s += v[j].x * v[j].x + v[j].y * v[j].y + v[j].z * v[j].z + v[j].w * v[j].w; }
    const float rinv = rsqrtf(wave_sum(s) * (1.f / 1024.f) + EPS);
#pragma unroll
    for (int j = 0; j < 4; ++j) {
        const f32x4 gg = ((const f32x4*)g)[lane + 64 * j];
        uint2 o; o.x = pk2(v[j].x * rinv * gg.x, v[j].y * rinv * gg.y); o.y = pk2(v[j].z * rinv * gg.z, v[j].w * rinv * gg.w);
        *(uint2*)(orow + (lane + 64 * j) * 4) = o;
    }
}

constexpr int CT_PER_LAYER = 53 * 16 + 256 + 64 + 128 + 64;
constexpr int CT_GU = 64 * 128, CT_DN = 64 * 64;
constexpr int CT_TOTAL = NL * CT_PER_LAYER + CT_GU + CT_DN;

__device__ __forceinline__ void phase0(const Params& P, char* smem) {
    char* ws = P.ws;
    float* tile = (float*)smem;
    BLK_LOOP(it, CT_TOTAL) {
        int r = it;
        if (r < NL * CT_PER_LAYER) {
            const int l = r / CT_PER_LAYER; r -= l * CT_PER_LAYER;
            if (r < 848) { convT_tile(tile, P.in[I_W_IN] + (size_t)l * 1024 * NIN, 1024, NIN, (bf16_t*)(ws + OFF_WIN) + (size_t)l * NP * 1024, 1, 53, r); continue; } r -= 848;
            if (r < 256) { convT_tile(tile, P.in[I_W_OUT] + (size_t)l * 1024 * 1024, 1024, 1024, (bf16_t*)(ws + OFF_WOUT) + (size_t)l * 1024 * 1024, 0, 16, r); continue; } r -= 256;
            if (r < 64) { convT_tile(tile, P.in[I_W_MQ] + (size_t)l * 1024 * 256, 1024, 256, (bf16_t*)(ws + OFF_WMQ) + (size_t)l * 256 * 1024, 0, 4, r); continue; } r -= 64;
            if (r < 128) { convT_tile(tile, P.in[I_W_MKV] + (size_t)l * 1024 * 512, 1024, 512, (bf16_t*)(ws + OFF_WMKV) + (size_t)l * 512 * 1024, 0, 8, r); continue; } r -= 128;
            convT_tile(tile, P.in[I_W_MO] + (size_t)l * 256 * 1024, 256, 1024, (bf16_t*)(ws + OFF_WMO) + (size_t)l * 1024 * 256, 0, 16, r); continue;
        }
        r -= NL * CT_PER_LAYER;
        if (r < CT_GU) { const int m = r >> 7; convT_tile(tile, P.in[I_W_E_GU] + (size_t)m * 1024 * 512, 1024, 512, (bf16_t*)(ws + OFF_WGU) + (size_t)m * 512 * 1024, 2, 8, r & 127); continue; }
        r -= CT_GU;
        { const int m = r >> 6; convT_tile(tile, P.in[I_W_E_DN] + (size_t)m * 256 * 1024, 256, 1024, (bf16_t*)(ws + OFF_WDN) + (size_t)m * 1024 * 256, 0, 16, r & 63); }
    }
    for (int i = blockIdx.x * NTHR + threadIdx.x; i < NL * (NP - NIN) * 512; i += gridDim.x * NTHR) {
        const int l = i / ((NP - NIN) * 512), w = i % ((NP - NIN) * 512);
        ((unsigned*)((bf16_t*)(ws + OFF_WIN) + (size_t)l * NP * 1024 + (size_t)NIN * 1024))[w] = 0u;
    }
    if (blockIdx.x == 0 && threadIdx.x < 64) ((int*)(ws + OFF_CNT))[threadIdx.x] = 0;
    const int gw = blockIdx.x * 8 + (threadIdx.x >> 6), ngw = gridDim.x * 8, lane = threadIdx.x & 63;
    for (int row = gw; row < T + NL * 2048; row += ngw) {
        if (row < T) rms_row_bf16(P.in[I_X] + (size_t)row * 1024, P.in[I_NORM_MIX], (bf16_t*)(ws + OFF_HN) + (size_t)row * 1024, lane);
        else { const int r2 = row - T, l = r2 >> 11, rr = r2 & 2047;
               rms_row_bf16(P.in[I_MEM] + (size_t)rr * 1024, P.in[I_NORM_MEMKV] + l * 1024, (bf16_t*)(ws + OFF_MEMN) + (size_t)r2 * 1024, lane); }
    }
}

constexpr int GLD = 72;
constexpr int GEMM_LDS = (256 + 128) * GLD * 2;
template <class RowPtr>
__device__ __forceinline__ void gemm_tile(char* smem, RowPtr rowptr, const bf16_t* __restrict__ Bt, int ldb, int n0, int K, f32x4 (&acc)[4][4]) {
    bf16_t* sA = (bf16_t*)smem; bf16_t* sB = sA + 256 * GLD;
    const int tid = threadIdx.x, lane = tid & 63, wave = tid >> 6, wm = wave >> 1, wn = wave & 1;
    const u32x4* ga[4]; const u32x4* gb[2];
#pragma unroll
    for (int i = 0; i < 4; ++i) { const int c = tid + i * 512, r = c >> 3, ch = c & 7; ga[i] = (const u32x4*)(rowptr(r) + ch * 8); }
#pragma unroll
    for (int i = 0; i < 2; ++i) { const int c = tid + i * 512, r = c >> 3, ch = c & 7; gb[i] = (const u32x4*)(Bt + (size_t)(n0 + r) * ldb + ch * 8); }
#pragma unroll
    for (int m = 0; m < 4; ++m)
#pragma unroll
        for (int n = 0; n < 4; ++n) acc[m][n] = (f32x4){0.f, 0.f, 0.f, 0.f};
    u32x4 ra[4], rb[2];
#pragma unroll
    for (int i = 0; i < 4; ++i) ra[i] = ga[i][0];
#pragma unroll
    for (int i = 0; i < 2; ++i) rb[i] = gb[i][0];
    const int nk = K / 64;
    for (int kt = 0; kt < nk; ++kt) {
        __syncthreads();
#pragma unroll
        for (int i = 0; i < 4; ++i) { const int c = tid + i * 512, r = c >> 3, ch = c & 7; *(u32x4*)(sA + r * GLD + ch * 8) = ra[i]; }
#pragma unroll
        for (int i = 0; i < 2; ++i) { const int c = tid + i * 512, r = c >> 3, ch = c & 7; *(u32x4*)(sB + r * GLD + ch * 8) = rb[i]; }
        __syncthreads();
        if (kt + 1 < nk) {
#pragma unroll
            for (int i = 0; i < 4; ++i) ra[i] = ga[i][(kt + 1) * 8];
#pragma unroll
            for (int i = 0; i < 2; ++i) rb[i] = gb[i][(kt + 1) * 8];
        }
#pragma unroll
        for (int kk = 0; kk < 2; ++kk) {
            bf16x8 af[4], bfr[4];
#pragma unroll
            for (int m = 0; m < 4; ++m) af[m] = *(const bf16x8*)(sA + (wm * 64 + m * 16 + (lane & 15)) * GLD + kk * 32 + (lane >> 4) * 8);
#pragma unroll
            for (int n = 0; n < 4; ++n) bfr[n] = *(const bf16x8*)(sB + (wn * 64 + n * 16 + (lane & 15)) * GLD + kk * 32 + (lane >> 4) * 8);
#pragma unroll
            for (int m = 0; m < 4; ++m)
#pragma unroll
                for (int n = 0; n < 4; ++n) acc[m][n] = __builtin_amdgcn_mfma_f32_16x16x32_bf16(bfr[n], af[m], acc[m][n], 0, 0, 0);
        }
    }
}
struct RowDirect { const bf16_t* A; int lda; int m0; __device__ __forceinline__ const bf16_t* operator()(int r) const { return A + (size_t)(m0 + r) * lda; } };
enum { EPI_INPROJ = 0, EPI_RESID = 1, EPI_BF16 = 2 };

__device__ __forceinline__ int vcu_id() { const int G = gridDim.x, bx = blockIdx.x; return (G % 8 == 0) ? (bx % 8) * (G / 8) + bx / 8 : bx; }

template <int EPI>
__device__ __forceinline__ void gemm_phase(char* smem, const bf16_t* A, int lda, const bf16_t* Bt, int ldb, int M, int N, int K, void* out, int ldo, const float* resid, float* gates) {
    const int ntn = N / 128, ntiles = (M / 256) * ntn;
    const int lane = threadIdx.x & 63, wave = threadIdx.x >> 6, wm = wave >> 1, wn = wave & 1;
    for (int tIdx = vcu_id(); tIdx < ntiles; tIdx += gridDim.x) {
        const int m0 = (tIdx / ntn) * 256, n0 = (tIdx % ntn) * 128;
        f32x4 acc[4][4];
        RowDirect rp{A, lda, m0};
        gemm_tile(smem, rp, Bt, ldb, n0, K, acc);
#pragma unroll
        for (int m = 0; m < 4; ++m)
#pragma unroll
            for (int n = 0; n < 4; ++n) {
                const int row = m0 + wm * 64 + m * 16 + (lane & 15), col = n0 + wn * 64 + n * 16 + (lane >> 4) * 4;
                const f32x4 v = acc[m][n];
                if (EPI == EPI_INPROJ) {
                    uint2 o; o.x = pk2(v.x, v.y); o.y = pk2(v.z, v.w);
                    *(uint2*)((bf16_t*)out + (size_t)row * ldo + col) = o;
                    if (col >= C_GATE && col < C_GATE + 16) *(f32x4*)(gates + (size_t)row * 16 + (col - C_GATE)) = v;
                } else if (EPI == EPI_RESID) {
                    const f32x4 r = *(const f32x4*)(resid + (size_t)row * ldo + col);
                    *(f32x4*)((float*)out + (size_t)row * ldo + col) = r + v;
                } else {
                    uint2 o; o.x = pk2(v.x, v.y); o.y = pk2(v.z, v.w);
                    *(uint2*)((bf16_t*)out + (size_t)row * ldo + col) = o;
                }
            }
    }
}

struct RowGather { const bf16_t* A; int lda; const int* ids; int shift; __device__ __forceinline__ const bf16_t* operator()(int r) const { return A + (size_t)(ids[r] >> shift) * lda; } };
template <int STAGE>
__device__ __forceinline__ void moe_phase(char* smem, const bf16_t* A, int lda, const bf16_t* Wt, size_t wstride, int ldb, int K, const int* cnt, const int* list, const float* pgate, bf16_t* out) {
    int* ids = (int*)(smem + GEMM_LDS);
    int* tpre = ids + 256;
    constexpr int NTN = (STAGE == 1) ? 4 : 8;
    __syncthreads();
    if (threadIdx.x == 0) { int a = 0; for (int i = 0; i < NEXP; ++i) { tpre[i] = a; a += (cnt[i] + 255) >> 8; } tpre[NEXP] = a; }
    __syncthreads();
    const int ntiles = tpre[NEXP] * NTN;
    const int lane = threadIdx.x & 63, wave = threadIdx.x >> 6, wm = wave >> 1, wn = wave & 1;
    for (int tIdx = vcu_id(); tIdx < ntiles; tIdx += gridDim.x) {
        const int mtg = tIdx / NTN, n0 = (tIdx % NTN) * 128;
        int e = 0;
        for (int i = 1; i < NEXP; ++i) if (tpre[i] <= mtg) e = i;
        const int mt = mtg - tpre[e];
        const int cn = cnt[e];
        __syncthreads();
        if (threadIdx.x < 256) { const int pos = mt * 256 + threadIdx.x; ids[threadIdx.x] = list[(size_t)e * T + (pos < cn ? pos : cn - 1)]; }
        __syncthreads();
        f32x4 acc[4][4];
        RowGather rp{A, lda, ids, STAGE == 1 ? 1 : 0};
        gemm_tile(smem, rp, Wt + (size_t)e * wstride, ldb, n0, K, acc);
#pragma unroll
        for (int m = 0; m < 4; ++m) {
            const int rl = wm * 64 + m * 16 + (lane & 15);
            if (mt * 256 + rl >= cn) continue;
            const int pid = ids[rl];
            if (STAGE == 1) {
                const float gt = pgate[pid];
#pragma unroll
                for (int np = 0; np < 2; ++np) {
                    const f32x4 g = acc[m][2 * np], u = acc[m][2 * np + 1];
                    const int j = (n0 + wn * 64 + np * 32) / 2 + (lane >> 4) * 4;
                    uint2 o; o.x = pk2(siluf_(g.x) * u.x * gt, siluf_(g.y) * u.y * gt); o.y = pk2(siluf_(g.z) * u.z * gt, siluf_(g.w) * u.w * gt);
                    *(uint2*)(out + (size_t)pid * DEXP + j) = o;
                }
            } else {
#pragma unroll
                for (int n = 0; n < 4; ++n) {
                    const f32x4 v = acc[m][n]; const int col = n0 + wn * 64 + n * 16 + (lane >> 4) * 4;
                    uint2 o; o.x = pk2(v.x, v.y); o.y = pk2(v.z, v.w);
                    *(uint2*)(out + (size_t)pid * 1024 + col) = o;
                }
            }
        }
    }
}

__device__ __forceinline__ void hgrn2_naive(const bf16_t* __restrict__ proj, const float* __restrict__ hgrn_lb, int layer, const float* __restrict__ mix_gain, bf16_t* __restrict__ y, int bh, int lane) {
    const int b = bh >> 2, h = bh & 3;
    float lbk = 0.f;
    if (layer == 1) { float a0 = hgrn_lb[h * 64 + lane], a1 = hgrn_lb[256 + h * 64 + lane]; lbk = 1.f / (1.f + __expf(a0 - a1)); }
    const float mg = mix_gain[C_AQ + h * 64 + lane];
    float S[64];
#pragma unroll
    for (int k = 0; k < 64; ++k) S[k] = 0.f;
    for (int t = 0; t < SEQ; ++t) {
        const bf16_t* pr = proj + (size_t)(b * SEQ + t) * NP + h * 64 + lane;
        const float qk = siluf_(bf2f(pr[C_AQ]));
        const float sg = sigmoidf_(bf2f(pr[C_AF]));
        const float f = lbk + (1.f - lbk) * sg, kk = (1.f - lbk) * (1.f - sg);
        const float iv = bf2f(pr[C_AI]);
        const float gv = bf2f(pr[C_AG]);
        float o = 0.f;
#pragma unroll
        for (int k = 0; k < 64; ++k) { S[k] = rdlane(f, k) * S[k] + rdlane(kk, k) * iv; o += rdlane(qk, k) * S[k]; }
        const float ms = wave_sum(o * o) * (1.f / 64.f);
        const float yv = o * rsqrtf(ms + EPS) * siluf_(gv) * mg;
        y[(size_t)(b * SEQ + t) * 1024 + 0 + h * 64 + lane] = f2bf(yv);
    }
}
__device__ __forceinline__ void gdn_naive(const bf16_t* __restrict__ proj, const float* __restrict__ gates, const float* __restrict__ conv_w  ,
                                          const float* __restrict__ a_log, const float* __restrict__ dt_bias, const float* __restrict__ mix_gain, bf16_t* __restrict__ y, int bh, int lane) {
    const int b = bh >> 2, h = bh & 3;
    float wq[4], wk[4], wv[4];
#pragma unroll
    for (int j = 0; j < 4; ++j) { wq[j] = conv_w[j * 768 + h * 64 + lane]; wk[j] = conv_w[j * 768 + 256 + h * 64 + lane]; wv[j] = conv_w[j * 768 + 512 + h * 64 + lane]; }
    float xq[3] = {0.f, 0.f, 0.f}, xk[3] = {0.f, 0.f, 0.f}, xv[3] = {0.f, 0.f, 0.f};
    const float Aexp = __expf(a_log[h]), dtb = dt_bias[h];
    const float mg = mix_gain[768 + h * 64 + lane];
    float S[64];
#pragma unroll
    for (int k = 0; k < 64; ++k) S[k] = 0.f;
    for (int t = 0; t < SEQ; ++t) {
        const size_t row = (size_t)(b * SEQ + t);
        const bf16_t* pr = proj + row * NP + h * 64 + lane;
        const float q0 = bf2f(pr[C_DQ]), k0 = bf2f(pr[C_DK]), v0 = bf2f(pr[C_DV]), zv = bf2f(pr[C_DZ]);
        float q = siluf_(wq[0] * xq[0] + wq[1] * xq[1] + wq[2] * xq[2] + wq[3] * q0);
        float k = siluf_(wk[0] * xk[0] + wk[1] * xk[1] + wk[2] * xk[2] + wk[3] * k0);
        float v = siluf_(wv[0] * xv[0] + wv[1] * xv[1] + wv[2] * xv[2] + wv[3] * v0);
        xq[0] = xq[1]; xq[1] = xq[2]; xq[2] = q0; xk[0] = xk[1]; xk[1] = xk[2]; xk[2] = k0; xv[0] = xv[1]; xv[1] = xv[2]; xv[2] = v0;
        q = q * rsqrtf(wave_sum(q * q) + EPS) * 0.125f;
        k = k * rsqrtf(wave_sum(k * k) + EPS);
        const float beta = sigmoidf_(gates[row * 16 + 4 + h]);
        const float g = -Aexp * softplusf_(gates[row * 16 + 8 + h] + dtb);
        const float eg = __expf(g);
        float r = 0.f;
#pragma unroll
        for (int i = 0; i < 64; ++i) { S[i] *= eg; r += rdlane(k, i) * S[i]; }
        const float dlt = beta * (v - r);
        float o = 0.f;
#pragma unroll
        for (int i = 0; i < 64; ++i) { S[i] += rdlane(k, i) * dlt; o += rdlane(q, i) * S[i]; }
        const float ms = wave_sum(o * o) * (1.f / 64.f);
        const float yv = o * rsqrtf(ms + EPS) * siluf_(zv) * mg;
        y[row * 1024 + 768 + h * 64 + lane] = f2bf(yv);
    }
}
__device__ __forceinline__ void fox_cumsum(const float* __restrict__ gates, const float* __restrict__ fb, float* __restrict__ cc, int bh, int lane) {
    const int b = bh >> 2, h = bh & 3;
    const float bias = fb[h];
    float carry = 0.f;
    for (int t0 = 0; t0 < SEQ; t0 += 64) {
        float v = logsigmoidf_(gates[(size_t)(b * SEQ + t0 + lane) * 16 + h] + bias);
#pragma unroll
        for (int o = 1; o < 64; o <<= 1) { float n = __shfl_up(v, o); if (lane >= o) v += n; }
        v += carry;
        cc[(size_t)(b * 4 + h) * SEQ + t0 + lane] = v;
        carry = __shfl(v, 63);
    }
}
__device__ __forceinline__ void lru_prep_task(float* xc  , const bf16_t* __restrict__ proj, const float* __restrict__ conv_w, const float* __restrict__ conv_b,
                                              const float* __restrict__ w_a, const float* __restrict__ b_a, const float* __restrict__ w_x, const float* __restrict__ b_x,
                                              const float* __restrict__ lam, float* __restrict__ a_out, float* __restrict__ u_out, int task, bool active) {
    const int c = threadIdx.x & 255, t0 = task * 16;
    if (active) {
        const float w0 = conv_w[c], w1 = conv_w[256 + c], w2 = conv_w[512 + c], w3 = conv_w[768 + c], cb = conv_b[c];
        for (int i = 0; i < 16; ++i) {
            const int t = t0 + i, s = t & (SEQ - 1);
            const bf16_t* pr = proj + (size_t)t * NP + C_CX + c;
            float acc = cb + w3 * bf2f(pr[0]);
            if (s >= 1) acc += w2 * bf2f(pr[-(ptrdiff_t)NP]);
            if (s >= 2) acc += w1 * bf2f(pr[-(ptrdiff_t)2 * NP]);
            if (s >= 3) acc += w0 * bf2f(pr[-(ptrdiff_t)3 * NP]);
            xc[i * 256 + c] = acc;
        }
    }
    __syncthreads();
    if (active) {
        const int h = c >> 6, jj = c & 63;
        float ra[16], rx[16];
#pragma unroll
        for (int i = 0; i < 16; ++i) { ra[i] = 0.f; rx[i] = 0.f; }
        for (int k = 0; k < 64; ++k) {
            const float wa = w_a[(h * 64 + k) * 64 + jj], wx = w_x[(h * 64 + k) * 64 + jj];
#pragma unroll
            for (int i = 0; i < 16; ++i) { const float xv = xc[i * 256 + h * 64 + k]; ra[i] += xv * wa; rx[i] += xv * wx; }
        }
        const float ba = b_a[c], bx = b_x[c], sp = softplusf_(-lam[c]);
#pragma unroll
        for (int i = 0; i < 16; ++i) {
            const float r = sigmoidf_(ra[i] + ba), ig = sigmoidf_(rx[i] + bx);
            const float log_a = -8.f * r * sp;
            const float a = __expf(log_a);
            const float u = sqrtf(-expm1f(2.f * log_a)) * (ig * xc[i * 256 + c]);
            a_out[(size_t)(t0 + i) * 256 + c] = a; u_out[(size_t)(t0 + i) * 256 + c] = u;
        }
    }
    __syncthreads();
}
__device__ __forceinline__ void lru_scan_task(const float* __restrict__ a_in, const float* __restrict__ u_in, const bf16_t* __restrict__ proj, const float* __restrict__ mix_gain, bf16_t* __restrict__ y, int b) {
    const int c = threadIdx.x;
    const float mg = mix_gain[512 + c];
    float hst = 0.f;
    for (int t = 0; t < SEQ; ++t) {
        const size_t row = (size_t)(b * SEQ + t);
        hst = a_in[row * 256 + c] * hst + u_in[row * 256 + c];
        const float yv = hst * geluf_(bf2f(proj[row * NP + C_CG + c]));
        const float ms = wave_sum(yv * yv) * (1.f / 64.f);
        y[row * 1024 + 512 + c] = f2bf(yv * rsqrtf(ms + EPS) * mg);
    }
}

typedef short s16x4 __attribute__((ext_vector_type(4)));
#define LDS_AS __attribute__((address_space(3)))
__device__ __forceinline__ bf16x8 frag_rm(const bf16_t* tile, int ld, int r0, int k0, int lane) { return *(const bf16x8*)(tile + (r0 + (lane & 15)) * ld + k0 + (lane >> 4) * 8); }
__device__ __forceinline__ s16x4 tr4(const bf16_t* tile, int ld, int rbase, int c0, int lane) {
    const bf16_t* p = tile + (rbase + ((lane & 15) >> 2)) * ld + c0 + 4 * (lane & 3);
    return __builtin_amdgcn_ds_read_tr16_b64_v4i16((LDS_AS s16x4*)p);
}
__device__ __forceinline__ bf16x8 frag_cm(const bf16_t* tile, int ld, int k0, int c0, int lane) {
    const s16x4 lo = tr4(tile, ld, k0 + (lane >> 4) * 8, c0, lane), hi = tr4(tile, ld, k0 + (lane >> 4) * 8 + 4, c0, lane);
    return (bf16x8){lo[0], lo[1], lo[2], lo[3], hi[0], hi[1], hi[2], hi[3]};
}
#define MFMA16(a, b, c) __builtin_amdgcn_mfma_f32_16x16x32_bf16((a), (b), (c), 0, 0, 0)
constexpr int TLD = 72;

__device__ __forceinline__ void attn_task(char* smem, const bf16_t* __restrict__ Q, int ldq, const bf16_t* __restrict__ Kp, int ldk, const bf16_t* __restrict__ Vp, int ldv, const float* __restrict__ bias,
                                          int nq_per_b, int nk_per_b, int causal, float scale, bf16_t* __restrict__ O, int ldo, const float* __restrict__ gain, int rms, int task) {
    bf16_t* sK = (bf16_t*)smem;
    bf16_t* sV = sK + 2 * 64 * TLD;
    float* sC = (float*)(sV + 2 * 64 * TLD);
    const int tid = threadIdx.x, lane = tid & 63, wave = tid >> 6, g = lane >> 4, li = lane & 15;
    const int nqt = nq_per_b / 128;
    const int qt = task % nqt, h = (task / nqt) & 3, b = task / (nqt * 4);
    const int q0 = qt * 128, tq = q0 + wave * 16 + li;
    const size_t qrow = (size_t)b * nq_per_b + tq;
    bf16x8 qf[2];
#pragma unroll
    for (int kk = 0; kk < 2; ++kk) qf[kk] = *(const bf16x8*)(Q + qrow * ldq + h * 64 + kk * 32 + g * 8);
    const float ct = bias ? bias[(size_t)(b * 4 + h) * nq_per_b + tq] : 0.f;
    const int nkt = causal ? (q0 + 128) / 64 : nk_per_b / 64;
    const int sr = tid >> 3, sc = tid & 7;
    const bf16_t* kg = Kp + ((size_t)b * nk_per_b + sr) * ldk + h * 64 + sc * 8;
    const bf16_t* vg = Vp + ((size_t)b * nk_per_b + sr) * ldv + h * 64 + sc * 8;
    const float* cg_ = bias ? bias + (size_t)(b * 4 + h) * nk_per_b : nullptr;
    u32x4 rk = *(const u32x4*)kg, rv = *(const u32x4*)vg; float rc = (cg_ && tid < 64) ? cg_[tid] : 0.f;
    __syncthreads();
    *(u32x4*)(sK + sr * TLD + sc * 8) = rk; *(u32x4*)(sV + sr * TLD + sc * 8) = rv; if (tid < 64) sC[tid] = rc;
    __syncthreads();
    f32x4 oacc[4];
#pragma unroll
    for (int n = 0; n < 4; ++n) oacc[n] = (f32x4){0.f, 0.f, 0.f, 0.f};
    float mrun = -INFINITY, lrun = 0.f;
    for (int kt = 0; kt < nkt; ++kt) {
        const int buf = kt & 1;
        if (kt + 1 < nkt) { rk = *(const u32x4*)(kg + (size_t)(kt + 1) * 64 * ldk); rv = *(const u32x4*)(vg + (size_t)(kt + 1) * 64 * ldv); rc = (cg_ && tid < 64) ? cg_[(kt + 1) * 64 + tid] : 0.f; }
        const bf16_t* cK = sK + buf * 64 * TLD; const bf16_t* cV = sV + buf * 64 * TLD; const float* cC = sC + buf * 64;
        const bool skip = causal && (kt * 64 > q0 + wave * 16 + 15);
        if (!skip) {
            f32x4 sacc[4];
#pragma unroll
            for (int n = 0; n < 4; ++n) {
                sacc[n] = (f32x4){0.f, 0.f, 0.f, 0.f};
#pragma unroll
                for (int kk = 0; kk < 2; ++kk) sacc[n] = MFMA16(frag_rm(cK, TLD, n * 16, kk * 32, lane), qf[kk], sacc[n]);
            }
            float mx = -INFINITY;
#pragma unroll
            for (int n = 0; n < 4; ++n) {
                const f32x4 cs = *(const f32x4*)(cC + n * 16 + 4 * g);
#pragma unroll
                for (int r = 0; r < 4; ++r) {
                    float v = sacc[n][r] * scale + (ct - cs[r]);
                    if (causal && (kt * 64 + n * 16 + 4 * g + r > tq)) v = -INFINITY;
                    sacc[n][r] = v; mx = fmaxf(mx, v);
                }
            }
            mx = fmaxf(mx, __shfl_xor(mx, 16)); mx = fmaxf(mx, __shfl_xor(mx, 32));
            const float mnew = fmaxf(mrun, mx);
            const float corr = __expf(mrun - mnew);
            float rs = 0.f;
#pragma unroll
            for (int n = 0; n < 4; ++n)
#pragma unroll
                for (int r = 0; r < 4; ++r) { const float p = __expf(sacc[n][r] - mnew); sacc[n][r] = p; rs += p; }
            rs += __shfl_xor(rs, 16); rs += __shfl_xor(rs, 32);
            lrun = lrun * corr + rs; mrun = mnew;
            bf16x8 pf[2];
#pragma unroll
            for (int kk = 0; kk < 2; ++kk) {
                const unsigned a0 = pk2(sacc[2 * kk][0], sacc[2 * kk][1]), a1 = pk2(sacc[2 * kk][2], sacc[2 * kk][3]);
                const unsigned a2 = pk2(sacc[2 * kk + 1][0], sacc[2 * kk + 1][1]), a3 = pk2(sacc[2 * kk + 1][2], sacc[2 * kk + 1][3]);
                const u32x4 pk = (u32x4){a0, a1, a2, a3};
                pf[kk] = __builtin_bit_cast(bf16x8, pk);
            }
#pragma unroll
            for (int n2 = 0; n2 < 4; ++n2) {
                oacc[n2] = oacc[n2] * corr;
#pragma unroll
                for (int kk = 0; kk < 2; ++kk) {
                    const s16x4 lo = tr4(cV, TLD, (2 * kk) * 16 + 4 * g, n2 * 16, lane), hi = tr4(cV, TLD, (2 * kk + 1) * 16 + 4 * g, n2 * 16, lane);
                    const bf16x8 vf = (bf16x8){lo[0], lo[1], lo[2], lo[3], hi[0], hi[1], hi[2], hi[3]};
                    oacc[n2] = MFMA16(vf, pf[kk], oacc[n2]);
                }
            }
        }
        if (kt + 1 < nkt) { const int nb = buf ^ 1; *(u32x4*)(sK + nb * 64 * TLD + sr * TLD + sc * 8) = rk; *(u32x4*)(sV + nb * 64 * TLD + sr * TLD + sc * 8) = rv; if (tid < 64) sC[nb * 64 + tid] = rc; }
        __syncthreads();
    }
    const float inv = 1.f / lrun;
    float ms = 0.f;
#pragma unroll
    for (int n = 0; n < 4; ++n) { oacc[n] = oacc[n] * inv; ms += oacc[n][0] * oacc[n][0] + oacc[n][1] * oacc[n][1] + oacc[n][2] * oacc[n][2] + oacc[n][3] * oacc[n][3]; }
    ms += __shfl_xor(ms, 16); ms += __shfl_xor(ms, 32);
    const float rinv = rms ? rsqrtf(ms * (1.f / 64.f) + EPS) : 1.f;
#pragma unroll
    for (int n = 0; n < 4; ++n) {
        const int d = n * 16 + 4 * g;
        f32x4 gg = (f32x4){1.f, 1.f, 1.f, 1.f};
        if (gain) gg = *(const f32x4*)(gain + h * 64 + d);
        uint2 o; o.x = pk2(oacc[n][0] * rinv * gg[0], oacc[n][1] * rinv * gg[1]); o.y = pk2(oacc[n][2] * rinv * gg[2], oacc[n][3] * rinv * gg[3]);
        *(uint2*)(O + qrow * ldo + h * 64 + d) = o;
    }
}


__device__ __forceinline__ void hgrn_scan(float* LF  , float* SEGT  , const bf16_t* __restrict__ prow  , const float* __restrict__ hgrn_lb, int layer, int h, float (&kk)[8]) {
    const int tid = threadIdx.x, t = tid >> 3, k8 = (tid & 7) * 8;
    const u32x4 raw = *(const u32x4*)(prow + (size_t)t * NP + C_AF + k8);
#pragma unroll
    for (int j = 0; j < 8; ++j) {
        const float fl = __uint_as_float((j & 1) ? (raw[j >> 1] & 0xffff0000u) : (raw[j >> 1] << 16));
        float lbk = 0.f;
        if (layer == 1) { const float a0 = hgrn_lb[h * 64 + k8 + j], a1 = hgrn_lb[256 + h * 64 + k8 + j]; lbk = 1.f / (1.f + __expf(a0 - a1)); }
        const float sg = sigmoidf_(fl);
        const float f = lbk + (1.f - lbk) * sg;
        kk[j] = (1.f - lbk) * (1.f - sg);
        LF[t * 65 + k8 + j] = __logf(f);
    }
    __syncthreads();
    { const int k = tid & 63, seg = tid >> 6; float run = 0.f;
#pragma unroll
      for (int i = 0; i < 8; ++i) { run += LF[(seg * 8 + i) * 65 + k]; LF[(seg * 8 + i) * 65 + k] = run; }
      SEGT[seg * 64 + k] = run; }
    __syncthreads();
    { const int k = tid & 63, seg = tid >> 6; float off = 0.f;
      for (int s2 = 0; s2 < seg; ++s2) off += SEGT[s2 * 64 + k];
#pragma unroll
      for (int i = 0; i < 8; ++i) LF[(seg * 8 + i) * 65 + k] += off; }
    __syncthreads();
}
__device__ __forceinline__ float bfx(const u32x4& raw, int j) { return __uint_as_float((j & 1) ? (raw[j >> 1] & 0xffff0000u) : (raw[j >> 1] << 16)); }

__device__ __forceinline__ void hgrn_local_task(char* smem, const bf16_t* __restrict__ proj, const float* __restrict__ hgrn_lb, int layer, float* __restrict__ HL, float* __restrict__ HD, int ch) {
    float* LF = (float*)smem; float* SEGT = LF + 64 * 65;
    bf16_t* sKd = (bf16_t*)(SEGT + 8 * 64); bf16_t* sV = sKd + 64 * TLD;
    const int tid = threadIdx.x, lane = tid & 63, wave = tid >> 6, g = lane >> 4, li = lane & 15;
    const int bh = ch >> 5, n = ch & 31, b = bh >> 2, h = bh & 3;
    const bf16_t* prow = proj + (size_t)(b * SEQ + n * 64) * NP + h * 64;
    const int t = tid >> 3, k8 = (tid & 7) * 8;
    __syncthreads();
    *(u32x4*)(sV + t * TLD + k8) = *(const u32x4*)(prow + (size_t)t * NP + C_AI + k8);
    float kk[8];
    hgrn_scan(LF, SEGT, prow, hgrn_lb, layer, h, kk);
    { u32x4 o;
#pragma unroll
      for (int j = 0; j < 8; j += 2) {
          const float e0 = kk[j] * __expf(LF[63 * 65 + k8 + j] - LF[t * 65 + k8 + j]), e1 = kk[j + 1] * __expf(LF[63 * 65 + k8 + j + 1] - LF[t * 65 + k8 + j + 1]);
          o[j >> 1] = pk2(e0, e1);
      }
      *(u32x4*)(sKd + t * TLD + k8) = o; }
    if (tid < 64) HD[(size_t)ch * 64 + tid] = __expf(LF[63 * 65 + tid]);
    __syncthreads();
#pragma unroll
    for (int i = 0; i < 2; ++i) {
        const int idx = wave * 2 + i, vt = idx >> 2, kt = idx & 3;
        f32x4 acc = (f32x4){0.f, 0.f, 0.f, 0.f};
#pragma unroll
        for (int ks = 0; ks < 2; ++ks) acc = MFMA16(frag_cm(sV, TLD, ks * 32, vt * 16, lane), frag_cm(sKd, TLD, ks * 32, kt * 16, lane), acc);
        *(f32x4*)(HL + (size_t)ch * 4096 + (kt * 16 + li) * 64 + vt * 16 + 4 * g) = acc;
    }
}

__device__ __forceinline__ void hgrn_out_task(char* smem, const bf16_t* __restrict__ proj, const float* __restrict__ hgrn_lb, int layer, const float* __restrict__ HL, const float* __restrict__ HD,
                                              const float* __restrict__ mix_gain, bf16_t* __restrict__ y, int ch) {
    float* LF = (float*)smem; float* SEGT = LF + 64 * 65; float* sMS = SEGT + 8 * 64;
    bf16_t* sST = (bf16_t*)(sMS + 128); bf16_t* sQ0 = sST + 64 * TLD; bf16_t* sQm = sQ0 + 64 * TLD; bf16_t* sKm = sQm + 64 * TLD; bf16_t* sV = sKm + 64 * TLD; bf16_t* sA = sV + 64 * TLD;
    const int tid = threadIdx.x, lane = tid & 63, wave = tid >> 6, g = lane >> 4, li = lane & 15;
    const int bh = ch >> 5, n = ch & 31, b = bh >> 2, h = bh & 3;
    const bf16_t* prow = proj + (size_t)(b * SEQ + n * 64) * NP + h * 64;
    const int t = tid >> 3, k8 = (tid & 7) * 8;
    __syncthreads();
    { const int v = tid & 63, kg = tid >> 6;
      float S[8];
#pragma unroll
      for (int j = 0; j < 8; ++j) S[j] = 0.f;
      const int ch0 = bh * 32;
      for (int m = 0; m < n; ++m) {
          const float* Lm = HL + (size_t)(ch0 + m) * 4096 + (kg * 8) * 64 + v; const float* Dm = HD + (size_t)(ch0 + m) * 64 + kg * 8;
#pragma unroll
          for (int j = 0; j < 8; ++j) S[j] = Dm[j] * S[j] + Lm[j * 64];
      }
      u32x4 o; o[0] = pk2(S[0], S[1]); o[1] = pk2(S[2], S[3]); o[2] = pk2(S[4], S[5]); o[3] = pk2(S[6], S[7]);
      *(u32x4*)(sST + v * TLD + kg * 8) = o; }
    const u32x4 qraw = *(const u32x4*)(prow + (size_t)t * NP + C_AQ + k8);
    *(u32x4*)(sV + t * TLD + k8) = *(const u32x4*)(prow + (size_t)t * NP + C_AI + k8);
    float kk[8];
    hgrn_scan(LF, SEGT, prow, hgrn_lb, layer, h, kk);
    { u32x4 o0, om, ok;
#pragma unroll
      for (int j = 0; j < 8; j += 2) {
          float q0v[2], qmv[2], kmv[2];
#pragma unroll
          for (int e = 0; e < 2; ++e) {
              const float bt = LF[t * 65 + k8 + j + e], r = LF[31 * 65 + k8 + j + e], q = siluf_(bfx(qraw, j + e));
              q0v[e] = q * __expf(bt); qmv[e] = q * __expf(bt - r); kmv[e] = kk[j + e] * __expf(r - bt);
          }
          o0[j >> 1] = pk2(q0v[0], q0v[1]); om[j >> 1] = pk2(qmv[0], qmv[1]); ok[j >> 1] = pk2(kmv[0], kmv[1]);
      }
      *(u32x4*)(sQ0 + t * TLD + k8) = o0; *(u32x4*)(sQm + t * TLD + k8) = om; *(u32x4*)(sKm + t * TLD + k8) = ok; }
    __syncthreads();
#pragma unroll
    for (int i = 0; i < 2; ++i) {
        const int idx = wave * 2 + i, tt = idx >> 2, st = idx & 3;
        f32x4 acc = (f32x4){0.f, 0.f, 0.f, 0.f};
#pragma unroll
        for (int ks = 0; ks < 2; ++ks) acc = MFMA16(frag_rm(sKm, TLD, st * 16, ks * 32, lane), frag_rm(sQm, TLD, tt * 16, ks * 32, lane), acc);
        const int tq = tt * 16 + li, s0 = st * 16 + 4 * g;
        uint2 o; o.x = pk2(s0 <= tq ? acc[0] : 0.f, s0 + 1 <= tq ? acc[1] : 0.f); o.y = pk2(s0 + 2 <= tq ? acc[2] : 0.f, s0 + 3 <= tq ? acc[3] : 0.f);
        *(uint2*)(sA + tq * TLD + s0) = o;
    }
    __syncthreads();
    { const int tt = wave >> 1;
      f32x4 oacc[2]; float ms = 0.f;
#pragma unroll
      for (int i = 0; i < 2; ++i) {
          const int vt = (wave & 1) * 2 + i;
          f32x4 acc = (f32x4){0.f, 0.f, 0.f, 0.f};
#pragma unroll
          for (int ks = 0; ks < 2; ++ks) acc = MFMA16(frag_rm(sST, TLD, vt * 16, ks * 32, lane), frag_rm(sQ0, TLD, tt * 16, ks * 32, lane), acc);
#pragma unroll
          for (int ks = 0; ks < 2; ++ks) acc = MFMA16(frag_cm(sV, TLD, ks * 32, vt * 16, lane), frag_rm(sA, TLD, tt * 16, ks * 32, lane), acc);
          oacc[i] = acc; ms += acc[0] * acc[0] + acc[1] * acc[1] + acc[2] * acc[2] + acc[3] * acc[3];
      }
      ms += __shfl_xor(ms, 16); ms += __shfl_xor(ms, 32);
      if (g == 0) sMS[(tt * 16 + li) * 2 + (wave & 1)] = ms;
      __syncthreads();
      const int tq = tt * 16 + li;
      const float rinv = rsqrtf((sMS[tq * 2] + sMS[tq * 2 + 1]) * (1.f / 64.f) + EPS);
      const size_t row = (size_t)(b * SEQ + n * 64 + tq);
#pragma unroll
      for (int i = 0; i < 2; ++i) {
          const int v0 = ((wave & 1) * 2 + i) * 16 + 4 * g;
          const uint2 graw = *(const uint2*)(proj + row * NP + C_AG + h * 64 + v0);
          const f32x4 mgv = *(const f32x4*)(mix_gain + C_AQ + h * 64 + v0);
          const float g0 = __uint_as_float(graw.x << 16), g1 = __uint_as_float(graw.x & 0xffff0000u), g2 = __uint_as_float(graw.y << 16), g3 = __uint_as_float(graw.y & 0xffff0000u);
          uint2 o; o.x = pk2(oacc[i][0] * rinv * siluf_(g0) * mgv[0], oacc[i][1] * rinv * siluf_(g1) * mgv[1]);
          o.y = pk2(oacc[i][2] * rinv * siluf_(g2) * mgv[2], oacc[i][3] * rinv * siluf_(g3) * mgv[3]);
          *(uint2*)(y + row * 1024 + h * 64 + v0) = o;
      }
    }
}


__device__ __forceinline__ void gdn_prep_task(char* smem, const bf16_t* __restrict__ proj, const float* __restrict__ gates, const float* __restrict__ conv_w  ,
                                              const float* __restrict__ a_log, const float* __restrict__ dt_bias, bf16_t* __restrict__ gt_all, float* __restrict__ glast, int ch) {
    float* sG = (float*)smem; float* sBeta = sG + 64;
    float* RHS = sBeta + 64;
    float* sM = RHS + 64 * 132;
    bf16_t* sK = (bf16_t*)(sM + 64 * 68); bf16_t* sQ = sK + 64 * TLD;
    const int tid = threadIdx.x, lane = tid & 63, wave = tid >> 6, g = lane >> 4, li = lane & 15;
    const int bh = ch >> 5, n = ch & 31, b = bh >> 2, h = bh & 3;
    const int t = tid >> 3, d8 = (tid & 7) * 8;
    const size_t row0 = (size_t)(b * SEQ + n * 64);
    bf16_t* gt = gt_all + (size_t)ch * 5 * 4096;
    __syncthreads();
    float qn[8], kn[8], vv[8];
    {
        const int spos = n * 64 + t;
#pragma unroll
        for (int sec = 0; sec < 3; ++sec) {
            const int col = (sec == 0 ? C_DQ : (sec == 1 ? C_DK : C_DV)) + h * 64 + d8;
            float acc[8];
#pragma unroll
            for (int e = 0; e < 8; ++e) acc[e] = 0.f;
#pragma unroll
            for (int j = 0; j < 4; ++j) {
                if (spos - (3 - j) >= 0) {
                    const u32x4 raw = *(const u32x4*)(proj + (row0 + t - (3 - j)) * NP + col);
                    const f32x4 w0 = *(const f32x4*)(conv_w + j * 768 + sec * 256 + h * 64 + d8), w1 = *(const f32x4*)(conv_w + j * 768 + sec * 256 + h * 64 + d8 + 4);
#pragma unroll
                    for (int e = 0; e < 8; ++e) acc[e] += (e < 4 ? w0[e] : w1[e - 4]) * bfx(raw, e);
                }
            }
#pragma unroll
            for (int e = 0; e < 8; ++e) { const float sv = siluf_(acc[e]); if (sec == 0) qn[e] = sv; else if (sec == 1) kn[e] = sv; else vv[e] = sv; }
        }
        float sq = 0.f, sk = 0.f;
#pragma unroll
        for (int e = 0; e < 8; ++e) { sq += qn[e] * qn[e]; sk += kn[e] * kn[e]; }
        sq += __shfl_xor(sq, 1); sq += __shfl_xor(sq, 2); sq += __shfl_xor(sq, 4);
        sk += __shfl_xor(sk, 1); sk += __shfl_xor(sk, 2); sk += __shfl_xor(sk, 4);
        const float rq = rsqrtf(sq + EPS) * 0.125f, rk = rsqrtf(sk + EPS);
#pragma unroll
        for (int e = 0; e < 8; ++e) { qn[e] *= rq; kn[e] *= rk; }
    }
    if ((tid & 7) == 0) {
        const float* gr = gates + (row0 + t) * 16;
        sBeta[t] = sigmoidf_(gr[4 + h]);
        sG[t] = -__expf(a_log[h]) * softplusf_(gr[8 + h] + dt_bias[h]);
    }
    __syncthreads();
    if (wave == 0) {
        float v = sG[lane];
#pragma unroll
        for (int o = 1; o < 64; o <<= 1) { const float nb = __shfl_up(v, o); if (lane >= o) v += nb; }
        sG[lane] = v;
    }
    __syncthreads();
    {
        const float Gt = sG[t], Gl = sG[63], bt = sBeta[t];
        const float eG = __expf(Gt), eD = __expf(Gl - Gt);
        u32x4 ok, oq, oqd, okd;
#pragma unroll
        for (int e = 0; e < 8; e += 2) {
            ok[e >> 1] = pk2(kn[e], kn[e + 1]); oq[e >> 1] = pk2(qn[e], qn[e + 1]);
            oqd[e >> 1] = pk2(qn[e] * eG, qn[e + 1] * eG); okd[e >> 1] = pk2(kn[e] * eD, kn[e + 1] * eD);
        }
        *(u32x4*)(sK + t * TLD + d8) = ok; *(u32x4*)(sQ + t * TLD + d8) = oq;
        *(u32x4*)(gt + 2 * 4096 + t * 64 + d8) = oqd; *(u32x4*)(gt + 3 * 4096 + t * 64 + d8) = okd;
#pragma unroll
        for (int e = 0; e < 8; ++e) { RHS[t * 132 + d8 + e] = vv[e] * bt; RHS[t * 132 + 64 + d8 + e] = kn[e] * bt * eG; }
        if (tid == 0) glast[ch] = __expf(Gl);
    }
    __syncthreads();
#pragma unroll
    for (int i = 0; i < 2; ++i) {
        const int idx = wave * 2 + i, tt = idx >> 2, st = idx & 3;
        f32x4 am = (f32x4){0.f, 0.f, 0.f, 0.f}, aq = (f32x4){0.f, 0.f, 0.f, 0.f};
#pragma unroll
        for (int ks = 0; ks < 2; ++ks) {
            const bf16x8 kf = frag_rm(sK, TLD, st * 16, ks * 32, lane);
            am = MFMA16(kf, frag_rm(sK, TLD, tt * 16, ks * 32, lane), am);
            aq = MFMA16(kf, frag_rm(sQ, TLD, tt * 16, ks * 32, lane), aq);
        }
        const int tq = tt * 16 + li, s0 = st * 16 + 4 * g;
        const float Gt = sG[tq], bt = sBeta[tq];
        f32x4 mo; float ao[4];
#pragma unroll
        for (int r = 0; r < 4; ++r) {
            const int sx = s0 + r;
            const float gm = (sx <= tq) ? __expf(Gt - sG[sx]) : 0.f;
            mo[r] = (sx < tq) ? bt * am[r] * gm : 0.f;
            ao[r] = aq[r] * gm;
        }
        *(f32x4*)(sM + tq * 68 + s0) = mo;
        uint2 o; o.x = pk2(ao[0], ao[1]); o.y = pk2(ao[2], ao[3]);
        *(uint2*)(gt + 4 * 4096 + tq * 64 + s0) = o;
    }
    __syncthreads();
    if (tid < 128) {
        float X[64];
#pragma unroll
        for (int i = 0; i < 64; ++i) X[i] = 0.f;
#pragma unroll
        for (int tt = 0; tt < 64; ++tt) {
            float a0 = RHS[tt * 132 + tid], a1 = 0.f;
#pragma unroll
            for (int s4 = 0; s4 < tt; s4 += 4) {
                const f32x4 m = *(const f32x4*)(sM + tt * 68 + s4);
                if ((s4 >> 2) & 1) { a1 -= m[0] * X[s4]; a1 -= m[1] * X[s4 + 1]; a1 -= m[2] * X[s4 + 2]; a1 -= m[3] * X[s4 + 3]; }
                else { a0 -= m[0] * X[s4]; a0 -= m[1] * X[s4 + 1]; a0 -= m[2] * X[s4 + 2]; a0 -= m[3] * X[s4 + 3]; }
            }
            X[tt] = a0 + a1;
        }
        if (tid < 64) {
#pragma unroll
            for (int tt = 0; tt < 64; ++tt) gt[tt * 64 + tid] = f2bf(X[tt]);
        } else {
#pragma unroll
            for (int tt = 0; tt < 64; ++tt) gt[4096 + tt * 64 + (tid - 64)] = f2bf(-X[tt]);
        }
    }
}

__device__ __forceinline__ void gdn_scan_task(char* smem, const bf16_t* __restrict__ gt_all, const float* __restrict__ glast, const bf16_t* __restrict__ proj, const float* __restrict__ mix_gain,
                                              bf16_t* __restrict__ y, int bh) {
    bf16_t* sT = (bf16_t*)smem;
    bf16_t* sST = sT + 2 * 5 * 64 * TLD;
    bf16_t* sVn = sST + 2 * 64 * TLD;
    const int tid = threadIdx.x, lane = tid & 63, wave = tid >> 6, g = lane >> 4, li = lane & 15;
    const int b = bh >> 2, h = bh & 3;
    const int sr = tid >> 3, sc8 = (tid & 7) * 8;
    const bf16_t* gsrc = gt_all + (size_t)bh * 32 * 5 * 4096 + sr * 64 + sc8;
    __syncthreads();
    u32x4 regs[5];
#pragma unroll
    for (int i = 0; i < 5; ++i) regs[i] = *(const u32x4*)(gsrc + i * 4096);
#pragma unroll
    for (int i = 0; i < 5; ++i) *(u32x4*)(sT + i * 64 * TLD + sr * TLD + sc8) = regs[i];
    *(u32x4*)(sST + sr * TLD + sc8) = (u32x4){0u, 0u, 0u, 0u};
    f32x4 sacc[4];
#pragma unroll
    for (int i = 0; i < 4; ++i) sacc[i] = (f32x4){0.f, 0.f, 0.f, 0.f};
    __syncthreads();
    for (int n = 0; n < 32; ++n) {
        const int buf = n & 1;
        const bf16_t* cT = sT + buf * 5 * 64 * TLD;
        const bf16_t* sU = cT; const bf16_t* sWn = cT + 64 * TLD; const bf16_t* sQd = cT + 2 * 64 * TLD; const bf16_t* sKd = cT + 3 * 64 * TLD; const bf16_t* sAq = cT + 4 * 64 * TLD;
        const bf16_t* cST = sST + buf * 64 * TLD; bf16_t* nST = sST + (buf ^ 1) * 64 * TLD;
        if (n + 1 < 32) {
#pragma unroll
            for (int i = 0; i < 5; ++i) regs[i] = *(const u32x4*)(gsrc + (size_t)(n + 1) * 5 * 4096 + i * 4096);
        }
        const size_t rowz = (size_t)(b * SEQ + n * 64 + (wave & 3) * 16 + li);
        uint2 zraw[4];
        if (wave < 4) {
#pragma unroll
            for (int vt = 0; vt < 4; ++vt) zraw[vt] = *(const uint2*)(proj + rowz * NP + C_DZ + h * 64 + vt * 16 + 4 * g);
        }
#pragma unroll
        for (int i = 0; i < 2; ++i) {
            const int idx = wave * 2 + i, tt = idx >> 2, vt = idx & 3;
            const int tq = tt * 16 + li, v0 = vt * 16 + 4 * g;
            const uint2 uraw = *(const uint2*)(sU + tq * TLD + v0);
            f32x4 acc = (f32x4){__uint_as_float(uraw.x << 16), __uint_as_float(uraw.x & 0xffff0000u), __uint_as_float(uraw.y << 16), __uint_as_float(uraw.y & 0xffff0000u)};
#pragma unroll
            for (int ks = 0; ks < 2; ++ks) acc = MFMA16(frag_rm(cST, TLD, vt * 16, ks * 32, lane), frag_rm(sWn, TLD, tt * 16, ks * 32, lane), acc);
            uint2 o; o.x = pk2(acc[0], acc[1]); o.y = pk2(acc[2], acc[3]);
            *(uint2*)(sVn + tq * TLD + v0) = o;
        }
        __syncthreads();
        if (wave < 4) {
            const int tt = wave;
            f32x4 oacc[4]; float ms = 0.f;
#pragma unroll
            for (int vt = 0; vt < 4; ++vt) {
                f32x4 acc = (f32x4){0.f, 0.f, 0.f, 0.f};
#pragma unroll
                for (int ks = 0; ks < 2; ++ks) acc = MFMA16(frag_rm(cST, TLD, vt * 16, ks * 32, lane), frag_rm(sQd, TLD, tt * 16, ks * 32, lane), acc);
#pragma unroll
                for (int ks = 0; ks < 2; ++ks) acc = MFMA16(frag_cm(sVn, TLD, ks * 32, vt * 16, lane), frag_rm(sAq, TLD, tt * 16, ks * 32, lane), acc);
                oacc[vt] = acc; ms += acc[0] * acc[0] + acc[1] * acc[1] + acc[2] * acc[2] + acc[3] * acc[3];
            }
            ms += __shfl_xor(ms, 16); ms += __shfl_xor(ms, 32);
            const float rinv = rsqrtf(ms * (1.f / 64.f) + EPS);
#pragma unroll
            for (int vt = 0; vt < 4; ++vt) {
                const int v0 = vt * 16 + 4 * g;
                const f32x4 mgv = *(const f32x4*)(mix_gain + 768 + h * 64 + v0);
                const float z0 = __uint_as_float(zraw[vt].x << 16), z1 = __uint_as_float(zraw[vt].x & 0xffff0000u), z2 = __uint_as_float(zraw[vt].y << 16), z3 = __uint_as_float(zraw[vt].y & 0xffff0000u);
                uint2 o; o.x = pk2(oacc[vt][0] * rinv * siluf_(z0) * mgv[0], oacc[vt][1] * rinv * siluf_(z1) * mgv[1]);
                o.y = pk2(oacc[vt][2] * rinv * siluf_(z2) * mgv[2], oacc[vt][3] * rinv * siluf_(z3) * mgv[3]);
                *(uint2*)(y + rowz * 1024 + 768 + h * 64 + v0) = o;
            }
        } else {
            const int kt = wave - 4;
            const float gl = glast[bh * 32 + n];
#pragma unroll
            for (int vt = 0; vt < 4; ++vt) {
                f32x4 acc = sacc[vt] * gl;
#pragma unroll
                for (int ks = 0; ks < 2; ++ks) acc = MFMA16(frag_cm(sKd, TLD, ks * 32, kt * 16, lane), frag_cm(sVn, TLD, ks * 32, vt * 16, lane), acc);
                sacc[vt] = acc;
                uint2 o; o.x = pk2(acc[0], acc[1]); o.y = pk2(acc[2], acc[3]);
                *(uint2*)(nST + (vt * 16 + li) * TLD + kt * 16 + 4 * g) = o;
            }
        }
        if (n + 1 < 32) {
            bf16_t* nT = sT + (buf ^ 1) * 5 * 64 * TLD;
#pragma unroll
            for (int i = 0; i < 5; ++i) *(u32x4*)(nT + i * 64 * TLD + sr * TLD + sc8) = regs[i];
        }
        __syncthreads();
    }
}


constexpr int XLD = 264;
__device__ __forceinline__ void lru_local_task(char* smem, const bf16_t* __restrict__ proj, const float* __restrict__ conv_w, const float* __restrict__ conv_b,
                                               const float* __restrict__ w_a, const float* __restrict__ b_a, const float* __restrict__ w_x, const float* __restrict__ b_x,
                                               const float* __restrict__ lam, float* __restrict__ hl_out, float* __restrict__ ac_out, float* __restrict__ lsum, int task) {
    bf16_t* sX = (bf16_t*)smem;
    bf16_t* sW = sX + 64 * XLD;
    float* sAa = (float*)(sW + 2 * 64 * TLD);
    float* sU = sAa + 64 * 65;
    float* sSegA = sU + 64 * 65; float* sSegH = sSegA + 8 * 64;
    const int tid = threadIdx.x, lane = tid & 63, wave = tid >> 6, g = lane >> 4, li = lane & 15;
    const int b = task >> 5, n = task & 31;
    const size_t row0 = (size_t)(b * SEQ + n * 64);
    const int t = tid >> 3;
    __syncthreads();
    {
        const int spos = n * 64 + t;
#pragma unroll
        for (int i = 0; i < 4; ++i) {
            const int c8 = ((tid & 7) + 8 * i) * 8;
            float acc[8];
            { const f32x4 cb0 = *(const f32x4*)(conv_b + c8), cb1 = *(const f32x4*)(conv_b + c8 + 4);
#pragma unroll
              for (int e = 0; e < 8; ++e) acc[e] = e < 4 ? cb0[e] : cb1[e - 4]; }
#pragma unroll
            for (int j = 0; j < 4; ++j) {
                if (spos - (3 - j) >= 0) {
                    const u32x4 raw = *(const u32x4*)(proj + (row0 + t - (3 - j)) * NP + C_CX + c8);
                    const f32x4 w0 = *(const f32x4*)(conv_w + j * 256 + c8), w1 = *(const f32x4*)(conv_w + j * 256 + c8 + 4);
#pragma unroll
                    for (int e = 0; e < 8; ++e) acc[e] += (e < 4 ? w0[e] : w1[e - 4]) * bfx(raw, e);
                }
            }
            u32x4 o; o[0] = pk2(acc[0], acc[1]); o[1] = pk2(acc[2], acc[3]); o[2] = pk2(acc[4], acc[5]); o[3] = pk2(acc[6], acc[7]);
            *(u32x4*)(sX + t * XLD + c8) = o;
        }
    }
    for (int hh = 0; hh < 4; ++hh) {
        {
            const int i = tid >> 3, j8 = (tid & 7) * 8;
#pragma unroll
            for (int m = 0; m < 2; ++m) {
                const float* src = (m == 0 ? w_a : w_x) + (size_t)hh * 4096 + i * 64 + j8;
                const f32x4 v0 = *(const f32x4*)src, v1 = *(const f32x4*)(src + 4);
                u32x4 o; o[0] = pk2(v0[0], v0[1]); o[1] = pk2(v0[2], v0[3]); o[2] = pk2(v1[0], v1[1]); o[3] = pk2(v1[2], v1[3]);
                *(u32x4*)(sW + m * 64 * TLD + i * TLD + j8) = o;
            }
        }
        __syncthreads();
#pragma unroll
        for (int i2 = 0; i2 < 2; ++i2) {
            const int idx = wave * 2 + i2, tt = idx >> 2, jt = idx & 3;
            f32x4 ra = (f32x4){0.f, 0.f, 0.f, 0.f}, rx = (f32x4){0.f, 0.f, 0.f, 0.f};
#pragma unroll
            for (int ks = 0; ks < 2; ++ks) {
                const bf16x8 xf = frag_rm(sX + hh * 64, XLD, tt * 16, ks * 32, lane);
                ra = MFMA16(frag_cm(sW, TLD, ks * 32, jt * 16, lane), xf, ra);
                rx = MFMA16(frag_cm(sW + 64 * TLD, TLD, ks * 32, jt * 16, lane), xf, rx);
            }
            const int tq = tt * 16 + li, cl = jt * 16 + 4 * g, c = hh * 64 + cl;
            const f32x4 ba = *(const f32x4*)(b_a + c), bx = *(const f32x4*)(b_x + c), lm = *(const f32x4*)(lam + c);
            const uint2 xraw = *(const uint2*)(sX + tq * XLD + c);
            const float xc[4] = {__uint_as_float(xraw.x << 16), __uint_as_float(xraw.x & 0xffff0000u), __uint_as_float(xraw.y << 16), __uint_as_float(xraw.y & 0xffff0000u)};
#pragma unroll
            for (int r = 0; r < 4; ++r) {
                const float rr = sigmoidf_(ra[r] + ba[r]), ig = sigmoidf_(rx[r] + bx[r]);
                const float log_a = -8.f * rr * softplusf_(-lm[r]);
                sAa[tq * 65 + cl + r] = __expf(log_a);
                sU[tq * 65 + cl + r] = sqrtf(-expm1f(2.f * log_a)) * (ig * xc[r]);
            }
        }
        __syncthreads();
        const int cl = tid & 63, seg = tid >> 6;
        float Al[8], Hl[8];
        { float A = 1.f, H = 0.f;
#pragma unroll
          for (int i = 0; i < 8; ++i) { const float a = sAa[(seg * 8 + i) * 65 + cl], u = sU[(seg * 8 + i) * 65 + cl]; H = a * H + u; A *= a; Al[i] = A; Hl[i] = H; }
          sSegA[seg * 64 + cl] = A; sSegH[seg * 64 + cl] = H; }
        __syncthreads();
        { float Ac = 1.f, Hc = 0.f;
          for (int s2 = 0; s2 < seg; ++s2) { const float a = sSegA[s2 * 64 + cl]; Hc = a * Hc + sSegH[s2 * 64 + cl]; Ac *= a; }
#pragma unroll
          for (int i = 0; i < 8; ++i) {
              const size_t o = (row0 + seg * 8 + i) * 256 + hh * 64 + cl;
              const float hv = Hl[i] + Al[i] * Hc, av = Al[i] * Ac;
              hl_out[o] = hv; ac_out[o] = av;
              if (seg == 7 && i == 7) { lsum[(size_t)task * 256 + hh * 64 + cl] = av; lsum[(size_t)(256 + task) * 256 + hh * 64 + cl] = hv; }
          } }
        __syncthreads();
    }
}
__device__ __forceinline__ void lru_out_task(const float* __restrict__ hl_in, const float* __restrict__ ac_in, const float* __restrict__ lsum, const bf16_t* __restrict__ proj,
                                             const float* __restrict__ mix_gain, bf16_t* __restrict__ y, int task) {
    const int b = task >> 5, n = task & 31, c = threadIdx.x & 255, half = threadIdx.x >> 8;
    float Hc = 0.f;
    for (int m = 0; m < n; ++m) Hc = lsum[(size_t)(b * 32 + m) * 256 + c] * Hc + lsum[(size_t)(256 + b * 32 + m) * 256 + c];
    const float mg = mix_gain[512 + c];
    const size_t row0 = (size_t)(b * SEQ + n * 64 + half * 32);
#pragma unroll 4
    for (int i = 0; i < 32; ++i) {
        const size_t row = row0 + i;
        const float hv = hl_in[row * 256 + c] + ac_in[row * 256 + c] * Hc;
        const float yv = hv * geluf_(bf2f(proj[row * NP + C_CG + c]));
        const float ms = wave_sum(yv * yv) * (1.f / 64.f);
        y[row * 1024 + 512 + c] = f2bf(yv * rsqrtf(ms + EPS) * mg);
    }
}

__device__ __forceinline__ void router_phase(char* smem, const float* __restrict__ x, const float* __restrict__ g, const float* __restrict__ w_rg, const float* __restrict__ b_rg,
                                             const float* __restrict__ w_re, const float* __restrict__ b_re, bf16_t* __restrict__ hn, int* __restrict__ cnt, int* __restrict__ list, float* __restrict__ pgate) {
    const int w = threadIdx.x >> 6, lane = threadIdx.x & 63;
    float* sh = (float*)smem + w * 1024;
    float* slog = (float*)smem + 8 * 1024 + w * 64;
    for (int t = blockIdx.x * 8 + w; t < T; t += gridDim.x * 8) {
        const f32x4* xr = (const f32x4*)(x + (size_t)t * 1024) + lane;
        f32x4 v[4]; float s = 0.f;
#pragma unroll
        for (int j = 0; j < 4; ++j) { v[j] = xr[64 * j]; s += v[j].x * v[j].x + v[j].y * v[j].y + v[j].z * v[j].z + v[j].w * v[j].w; }
        const float rinv = rsqrtf(wave_sum(s) * (1.f / 1024.f) + EPS);
#pragma unroll
        for (int j = 0; j < 4; ++j) {
            const f32x4 gg = ((const f32x4*)g)[lane + 64 * j];
            const f32x4 hv = v[j] * rinv * gg;
            *(f32x4*)&sh[(lane + 64 * j) * 4] = hv;
            uint2 o; o.x = pk2(hv.x, hv.y); o.y = pk2(hv.z, hv.w);
            *(uint2*)(hn + (size_t)t * 1024 + (lane + 64 * j) * 4) = o;
        }
        __builtin_amdgcn_wave_barrier();
        float a = 0.f;
        if (lane < 36) {
            const float* wp = lane < 4 ? (w_rg + lane) : (w_re + (lane - 4));
            const int ld = lane < 4 ? 4 : 32;
            for (int k = 0; k < 1024; ++k) a += sh[k] * wp[(size_t)k * ld];
            a += lane < 4 ? b_rg[lane] : b_re[lane - 4];
            slog[lane] = a;
        }
        __builtin_amdgcn_wave_barrier();
        if (lane == 0) {
            const float* lg = slog;
            int gs = 0; float gm = lg[0];
            for (int i = 1; i < 4; ++i) if (lg[i] > gm) { gm = lg[i]; gs = i; }
            float den = 0.f; for (int i = 0; i < 4; ++i) den += __expf(lg[i] - gm);
            const float pg = 1.f / den;
            const float* le = lg + 4 + gs * 8;
            int i0 = 0; float m0 = le[0];
            for (int i = 1; i < 8; ++i) if (le[i] > m0) { m0 = le[i]; i0 = i; }
            int i1 = -1; float m1 = -INFINITY;
            for (int i = 0; i < 8; ++i) if (i != i0 && le[i] > m1) { m1 = le[i]; i1 = i; }
            const float e1 = __expf(m1 - m0); const float w0 = 1.f / (1.f + e1), w1 = e1 / (1.f + e1);
            const int ex0 = gs * 8 + i0, ex1 = gs * 8 + i1;
            const int pos0 = atomicAdd(&cnt[ex0], 1); list[(size_t)ex0 * T + pos0] = 2 * t; pgate[2 * t] = pg * w0;
            const int pos1 = atomicAdd(&cnt[ex1], 1); list[(size_t)ex1 * T + pos1] = 2 * t + 1; pgate[2 * t + 1] = pg * w1;
        }
        __builtin_amdgcn_wave_barrier();
    }
}

__device__ __forceinline__ void combine_phase(const float* x2, const bf16_t* __restrict__ eo, const float* __restrict__ g, float* xout, bf16_t* __restrict__ hn, int mode) {
    const int lane = threadIdx.x & 63;
    for (int t = blockIdx.x * 8 + (threadIdx.x >> 6); t < T; t += gridDim.x * 8) {
        f32x4 v[4]; float s = 0.f;
#pragma unroll
        for (int j = 0; j < 4; ++j) {
            const int c = (lane + 64 * j) * 4;
            v[j] = *(const f32x4*)(x2 + (size_t)t * 1024 + c);
            const uint2 e0 = *(const uint2*)(eo + (size_t)(2 * t) * 1024 + c), e1 = *(const uint2*)(eo + (size_t)(2 * t + 1) * 1024 + c);
            v[j].x += __uint_as_float(e0.x << 16) + __uint_as_float(e1.x << 16);
            v[j].y += __uint_as_float(e0.x & 0xffff0000u) + __uint_as_float(e1.x & 0xffff0000u);
            v[j].z += __uint_as_float(e0.y << 16) + __uint_as_float(e1.y << 16);
            v[j].w += __uint_as_float(e0.y & 0xffff0000u) + __uint_as_float(e1.y & 0xffff0000u);
            s += v[j].x * v[j].x + v[j].y * v[j].y + v[j].z * v[j].z + v[j].w * v[j].w;
        }
        const float rinv = rsqrtf(wave_sum(s) * (1.f / 1024.f) + EPS);
#pragma unroll
        for (int j = 0; j < 4; ++j) {
            const int c = (lane + 64 * j) * 4;
            const f32x4 gg = *(const f32x4*)(g + c);
            const f32x4 hv = v[j] * rinv * gg;
            if (mode == 0) {
                *(f32x4*)(xout + (size_t)t * 1024 + c) = v[j];
                uint2 o; o.x = pk2(hv.x, hv.y); o.y = pk2(hv.z, hv.w);
                *(uint2*)(hn + (size_t)t * 1024 + c) = o;
            } else {
                *(f32x4*)(xout + (size_t)t * 1024 + c) = hv;
            }
        }
    }
}

template <int l>
__device__ __forceinline__ void layer_body(const Params& P, char* smem, cg::grid_group& grid, const float* xcur) {
    char* ws = P.ws;
    bf16_t* Wt_in = (bf16_t*)(ws + OFF_WIN); bf16_t* Wt_out = (bf16_t*)(ws + OFF_WOUT); bf16_t* Wt_mq = (bf16_t*)(ws + OFF_WMQ); bf16_t* Wt_mkv = (bf16_t*)(ws + OFF_WMKV);
    bf16_t* Wt_mo = (bf16_t*)(ws + OFF_WMO); bf16_t* Wt_gu = (bf16_t*)(ws + OFF_WGU); bf16_t* Wt_dn = (bf16_t*)(ws + OFF_WDN);
    bf16_t* hn = (bf16_t*)(ws + OFF_HN); bf16_t* proj = (bf16_t*)(ws + OFF_PROJ); float* gates = (float*)(ws + OFF_GATES); bf16_t* y = (bf16_t*)(ws + OFF_Y);
    float* XA = P.out; float* XB = (float*)(ws + OFF_XB);
    bf16_t* qm = (bf16_t*)(ws + OFF_QM); bf16_t* om = (bf16_t*)(ws + OFF_OM); bf16_t* kvm = (bf16_t*)(ws + OFF_KVM); bf16_t* memn = (bf16_t*)(ws + OFF_MEMN);
    float* foxc = (float*)(ws + OFF_FOXC); float* lrua = (float*)(ws + OFF_LRUA); float* lruu = (float*)(ws + OFF_LRUU);
    int* cnt_all = (int*)(ws + OFF_CNT); int* list = (int*)(ws + OFF_LIST); float* pgate = (float*)(ws + OFF_PGATE);
    bf16_t* act = (bf16_t*)(ws + OFF_ACT); bf16_t* eo = (bf16_t*)(ws + OFF_EO);
    const int wave = threadIdx.x >> 6, lane = threadIdx.x & 63;


        float* x1 = (l == 0) ? XA : XB;
        float* x2 = (l == 0) ? XB : XA;
        int* cnt = cnt_all + 32 * l;
        const float* mg = P.in[I_MIX_GAIN] + l * 1024;
        gemm_phase<EPI_INPROJ>(smem, hn, 1024, Wt_in + (size_t)l * NP * 1024, 1024, T, NP, 1024, proj, NP, nullptr, gates);
        if (l == 0) for (int l2 = 0; l2 < NL; ++l2)
            gemm_phase<EPI_BF16>(smem, memn + (size_t)l2 * 2048 * 1024, 1024, Wt_mkv + (size_t)l2 * 512 * 1024, 1024, 2048, 512, 1024, kvm + (size_t)l2 * 2048 * 512, 512, nullptr, nullptr);
        grid.sync();
        {
            const int bx = blockIdx.x;
            bf16_t* gtiles = (bf16_t*)(ws + OFF_GDN); float* glast = (float*)(ws + OFF_GLAST);
            if (bx < 32 && wave == 1) fox_cumsum(gates, P.in[I_FOX_FB] + l * 4, foxc, bx, lane);
            BLK_LOOP(ch, 1024) gdn_prep_task(smem, proj, gates, P.in[I_GDN_CONV_W] + l * 4 * 768, P.in[I_GDN_A_LOG] + l * 4, P.in[I_GDN_DT_BIAS] + l * 4, gtiles, glast, ch);
            BLK_LOOP(ch, 1024) hgrn_local_task(smem, proj, P.in[I_HGRN_LB], l, (float*)(ws + OFF_HL), (float*)(ws + OFF_HD), ch);
            BLK_LOOP(task, 256) lru_local_task(smem, proj, P.in[I_LRU_CONV_W] + l * 1024, P.in[I_LRU_CONV_B] + l * 256, P.in[I_LRU_WA] + l * 16384, P.in[I_LRU_BA] + l * 256,
                                               P.in[I_LRU_WX] + l * 16384, P.in[I_LRU_BX] + l * 256, P.in[I_LRU_LAM] + l * 256, lrua, lruu, (float*)(ws + OFF_LSUM), task);
        }
        grid.sync();
        {
            const int natt = (SEQ / 128) * 4 * NB;
            const int bx = blockIdx.x, nfree = (int)gridDim.x - 32;
            if (bx < 32) gdn_scan_task(smem, (const bf16_t*)(ws + OFF_GDN), (const float*)(ws + OFF_GLAST), proj, mg, y, bx);
            else {
                for (int i = bx - 32; i < natt; i += nfree) {
                    const int qt = 15 - (i >> 5), bh = i & 31;
                    attn_task(smem, proj + C_BQ, NP, proj + C_BK, NP, proj + C_BV, NP, foxc, SEQ, SEQ, 1, 0.125f, y + 256, 1024, mg + 256, 1, (bh * 16) + qt);
                }
                for (int i = bx - 32; i < 1024; i += nfree) {
                    const int ch = (i & 31) * 32 + (31 - (i >> 5));
                    hgrn_out_task(smem, proj, P.in[I_HGRN_LB], l, (const float*)(ws + OFF_HL), (const float*)(ws + OFF_HD), mg, y, ch);
                }
                for (int i = bx - 32; i < 256; i += nfree) lru_out_task(lrua, lruu, (const float*)(ws + OFF_LSUM), proj, mg, y, i);
            }
        }
        grid.sync();
        gemm_phase<EPI_RESID>(smem, y, 1024, Wt_out + (size_t)l * 1024 * 1024, 1024, T, 1024, 1024, x1, 1024, xcur, nullptr);
        grid.sync();
        for (int row = blockIdx.x * 8 + wave; row < T; row += gridDim.x * 8) rms_row_bf16(x1 + (size_t)row * 1024, P.in[I_NORM_MEM] + l * 1024, hn + (size_t)row * 1024, lane);
        grid.sync();
        gemm_phase<EPI_BF16>(smem, hn, 1024, Wt_mq + (size_t)l * 256 * 1024, 1024, T, 256, 1024, qm, 256, nullptr, nullptr);
        grid.sync();
        { const bf16_t* kv = kvm + (size_t)l * 2048 * 512;
          BLK_LOOP(task, (SEQ / 128) * 4 * NB) attn_task(smem, qm, 256, kv, 512, kv + 256, 512, nullptr, SEQ, MEMLEN, 0, 0.125f, om, 256, nullptr, 0, task); }
        grid.sync();
        gemm_phase<EPI_RESID>(smem, om, 256, Wt_mo + (size_t)l * 1024 * 256, 256, T, 1024, 256, x2, 1024, x1, nullptr);
        grid.sync();
        router_phase(smem, x2, P.in[I_NORM_FFN] + l * 1024, P.in[I_W_RG] + l * 4096, P.in[I_B_RG] + l * 4, P.in[I_W_RE] + l * 32768, P.in[I_B_RE] + l * 32, hn, cnt, list, pgate);
        grid.sync();
        moe_phase<1>(smem, hn, 1024, Wt_gu + (size_t)l * 32 * 512 * 1024, (size_t)512 * 1024, 1024, 1024, cnt, list, pgate, act);
        grid.sync();
        moe_phase<2>(smem, act, 256, Wt_dn + (size_t)l * 32 * 1024 * 256, (size_t)1024 * 256, 256, 256, cnt, list, pgate, eo);
        grid.sync();
        if (l == 0) { combine_phase(x2, eo, P.in[I_NORM_MIX] + 1024, XA, hn, 0); grid.sync(); }
        else combine_phase(x2, eo, P.in[I_NORM_FINAL], P.out, hn, 1);
}
__global__ void __launch_bounds__(NTHR, 2) mega_kernel(Params P) {
    extern __shared__ __attribute__((aligned(16))) char smem[];
    cg::grid_group grid = cg::this_grid();
    phase0(P, smem);
    grid.sync();
    layer_body<0>(P, smem, grid, P.in[I_X]);
    layer_body<1>(P, smem, grid, P.out);
}

extern "C" void kernel_launch(void* const* d_in, const int* in_sizes, int n_in, void* d_out, int out_size, void* d_ws, size_t ws_size, hipStream_t stream) {
    static int grid_blocks = 0;
    if (grid_blocks == 0) {
        if (n_in != N_INPUTS || ws_size < OFF_END || out_size != T * 1024) { fprintf(stderr, "kernel_launch: unexpected sizes n_in=%d ws=%zu out=%d (need ws >= %zu)\n", n_in, ws_size, out_size, (size_t)OFF_END); grid_blocks = -1; return; }
        int dev = 0, cus = 0, per_cu = 0;
        if (hipGetDevice(&dev) != hipSuccess || hipDeviceGetAttribute(&cus, hipDeviceAttributeMultiprocessorCount, dev) != hipSuccess) { fprintf(stderr, "kernel_launch: device query failed\n"); grid_blocks = -1; return; }
        if (hipFuncSetAttribute((const void*)mega_kernel, hipFuncAttributeMaxDynamicSharedMemorySize, LDS_BYTES) != hipSuccess) { fprintf(stderr, "kernel_launch: hipFuncSetAttribute failed\n"); grid_blocks = -1; return; }
        if (hipOccupancyMaxActiveBlocksPerMultiprocessor(&per_cu, (const void*)mega_kernel, NTHR, LDS_BYTES) != hipSuccess || per_cu < 1) { fprintf(stderr, "kernel_launch: occupancy query says %d blocks/CU\n", per_cu); grid_blocks = -1; return; }
        grid_blocks = cus;
        fprintf(stderr, "kernel_launch: cus=%d per_cu=%d grid=%d\n", cus, per_cu, grid_blocks);
    }
    if (grid_blocks < 0) return;
    Params p; memset(&p, 0, sizeof p);
    for (int i = 0; i < N_INPUTS; ++i) p.in[i] = (const float*)d_in[i];
    p.out = (float*)d_out; p.ws = (char*)d_ws;
    void* args[] = {&p};
    hipError_t e = hipLaunchCooperativeKernel((const void*)mega_kernel, dim3(grid_blocks), dim3(NTHR), args, LDS_BYTES, stream);
    if (e != hipSuccess) fprintf(stderr, "kernel_launch: cooperative launch failed: %s (grid %d)\n", hipGetErrorString(e), grid_blocks);
}
```

```cpp
#include <hip/hip_runtime.h>
#include <stdint.h>
#include <stdio.h>
#include <string.h>
#include <hip/hip_cooperative_groups.h>
namespace cg = cooperative_groups;

typedef unsigned short bf16_t;
typedef short bf16x8 __attribute__((ext_vector_type(8)));
typedef float f32x4 __attribute__((ext_vector_type(4)));
typedef unsigned u32x4 __attribute__((ext_vector_type(4)));

constexpr int NB = 8, SEQ = 2048, DM = 1024, T = NB * SEQ, NL = 2;
constexpr int NP = 3456;
constexpr int NIN = 3340;
constexpr int C_AQ = 0, C_AF = 256, C_AI = 512, C_AG = 768, C_BQ = 1024, C_BK = 1280, C_BV = 1536, C_CX = 1792, C_CG = 2048,
              C_DQ = 2304, C_DK = 2560, C_DV = 2816, C_DZ = 3072, C_GATE = 3328;
constexpr int MEMLEN = 256;
constexpr int NEXP = 32, DEXP = 256;
constexpr float EPS = 1e-6f;

constexpr size_t al256(size_t x) { return (x + 255) & ~(size_t)255; }
constexpr size_t SZ_WIN = (size_t)NP * 1024 * 2, SZ_WOUT = (size_t)1024 * 1024 * 2, SZ_WMQ = (size_t)256 * 1024 * 2, SZ_WMKV = (size_t)512 * 1024 * 2,
                 SZ_WMO = (size_t)1024 * 256 * 2, SZ_WGU = (size_t)32 * 512 * 1024 * 2, SZ_WDN = (size_t)32 * 1024 * 256 * 2;
constexpr size_t OFF_WIN = 0;
constexpr size_t OFF_WOUT = OFF_WIN + NL * SZ_WIN;
constexpr size_t OFF_WMQ = OFF_WOUT + NL * SZ_WOUT;
constexpr size_t OFF_WMKV = OFF_WMQ + NL * SZ_WMQ;
constexpr size_t OFF_WMO = OFF_WMKV + NL * SZ_WMKV;
constexpr size_t OFF_WGU = OFF_WMO + NL * SZ_WMO;
constexpr size_t OFF_WDN = OFF_WGU + NL * SZ_WGU;
constexpr size_t OFF_HN = OFF_WDN + NL * SZ_WDN;
constexpr size_t OFF_PROJ = OFF_HN + (size_t)T * 1024 * 2;
constexpr size_t OFF_GATES = OFF_PROJ + (size_t)T * NP * 2;
constexpr size_t OFF_Y = OFF_GATES + (size_t)T * 16 * 4;
constexpr size_t OFF_XB = OFF_Y + (size_t)T * 1024 * 2;
constexpr size_t OFF_QM = OFF_XB + (size_t)T * 1024 * 4;
constexpr size_t OFF_OM = OFF_QM + (size_t)T * 256 * 2;
constexpr size_t OFF_KVM = OFF_OM + (size_t)T * 256 * 2;
constexpr size_t OFF_MEMN = OFF_KVM + (size_t)NL * 2048 * 512 * 2;
constexpr size_t OFF_FOXC = OFF_MEMN + (size_t)2048 * 1024 * 2;
constexpr size_t OFF_LRUA = OFF_FOXC + (size_t)NB * 4 * SEQ * 4;
constexpr size_t OFF_LRUU = OFF_LRUA + (size_t)T * 256 * 4;
constexpr size_t OFF_CNT = OFF_LRUU + (size_t)T * 256 * 4;
constexpr size_t OFF_LIST = OFF_CNT + 256;
constexpr size_t OFF_PGATE = OFF_LIST + (size_t)NEXP * T * 4;
constexpr size_t OFF_HL = OFF_PGATE + (size_t)2 * T * 4;
constexpr size_t OFF_HD = OFF_HL + (size_t)1024 * 4096 * 4;
constexpr size_t OFF_GDN = OFF_HD + (size_t)1024 * 64 * 4;
constexpr size_t OFF_GLAST = OFF_GDN + (size_t)1024 * 5 * 4096 * 2;
constexpr size_t OFF_LSUM = OFF_GLAST + 4096;
constexpr size_t OFF_CTL = OFF_LSUM + (size_t)2 * 256 * 256 * 4;
constexpr size_t CTL_BYTES = 16384;
constexpr int CTL_CNT_WORD = 3584;
constexpr size_t OFF_END = OFF_CTL + CTL_BYTES;
constexpr size_t OFF_ACT = OFF_PROJ;
constexpr size_t OFF_EO = OFF_PROJ + (size_t)2 * T * 256 * 2;
static_assert(OFF_EO + (size_t)2 * T * 1024 * 2 <= OFF_GATES, "overlay fits");

__device__ __forceinline__ float bf2f(bf16_t v) { return __uint_as_float(((unsigned)v) << 16); }
__device__ __forceinline__ bf16_t f2bf(float f) { unsigned u = __float_as_uint(f); return (bf16_t)((u + 0x7fffu + ((u >> 16) & 1u)) >> 16); }
__device__ __forceinline__ unsigned pk2(float lo, float hi) { return (unsigned)f2bf(lo) | ((unsigned)f2bf(hi) << 16); }
__device__ __forceinline__ float sigmoidf_(float x) { return 1.f / (1.f + __expf(-x)); }
__device__ __forceinline__ float siluf_(float x) { return x / (1.f + __expf(-x)); }
__device__ __forceinline__ float softplusf_(float x) { return x > 20.f ? x : log1pf(__expf(x)); }
__device__ __forceinline__ float logsigmoidf_(float x) { return x < 0.f ? x - log1pf(__expf(x)) : -log1pf(__expf(-x)); }
__device__ __forceinline__ float geluf_(float x) { float u = 0.7978845608028654f * (x + 0.044715f * x * x * x); return 0.5f * x * (1.f + tanhf(u)); }
__device__ __forceinline__ float wave_sum(float v) {
#pragma unroll
    for (int o = 1; o < 64; o <<= 1) v += __shfl_xor(v, o);
    return v;
}
__device__ __forceinline__ float rdlane(float v, int l) { return __int_as_float(__builtin_amdgcn_readlane(__float_as_int(v), l)); }

#define PROBE_MASK 0
#define GSYNC() xcd_barrier(xb)
#define REP(bit, ...) do { __VA_ARGS__; if (PROBE_MASK & (bit)) { GSYNC(); __VA_ARGS__; } } while (0)
constexpr int NTHR = 512;
constexpr int LDS_BYTES = 147456;
enum { I_X = 0, I_MEM, I_NORM_MIX, I_W_IN, I_HGRN_LB, I_FOX_FB, I_LRU_CONV_W, I_LRU_CONV_B, I_LRU_WA, I_LRU_BA, I_LRU_WX, I_LRU_BX, I_LRU_LAM, I_GDN_CONV_W, I_GDN_A_LOG,
       I_GDN_DT_BIAS, I_MIX_GAIN, I_W_OUT, I_NORM_MEM, I_NORM_MEMKV, I_W_MQ, I_W_MKV, I_W_MO, I_NORM_FFN, I_W_RG, I_B_RG, I_W_RE, I_B_RE, I_W_E_GU, I_W_E_DN, I_NORM_FINAL, N_INPUTS };
struct Params { const float* in[N_INPUTS]; float* out; char* ws; };
static_assert(sizeof(Params) == 8 * (N_INPUTS + 2), "no padding");

#define BLK_LOOP(it, n) for (int it = (int)blockIdx.x; it < (n); it += (int)gridDim.x)

__device__ __forceinline__ int rowmap_fn(int mode, int n) {
    if (mode == 1) {
        if (n < 1792) return n;
        if (n < 1796) return C_GATE + (n - 1792);
        if (n < 3076) return n - 4;
        if (n < 3084) return C_GATE + 4 + (n - 3076);
        return n - 12;
    } else if (mode == 2) {
        int j = n & 255; return (j >> 4) * 32 + ((n >= 256) ? 16 : 0) + (j & 15);
    }
    return n;
}
__device__ __forceinline__ void convT_tile(float* tile  , const float* __restrict__ src, int K, int N, bf16_t* __restrict__ dst, int mode, int ntn, int idx) {
    const int n0 = (idx % ntn) * 64, k0 = (idx / ntn) * 64;
    const int tx = threadIdx.x & 63, ty = threadIdx.x >> 6;
    __syncthreads();
#pragma unroll
    for (int i = 0; i < 8; ++i) {
        const int k = ty + i * 8, n = n0 + tx;
        tile[k * 65 + tx] = (n < N) ? src[(size_t)(k0 + k) * N + n] : 0.f;
    }
    __syncthreads();
    const int kx = threadIdx.x & 31, ny = threadIdx.x >> 5;
#pragma unroll
    for (int i = 0; i < 4; ++i) {
        const int nl = ny + i * 16, n = n0 + nl;
        if (n < N) {
            const int r = rowmap_fn(mode, n);
            *(unsigned*)(dst + (size_t)r * K + k0 + 2 * kx) = pk2(tile[(2 * kx) * 65 + nl], tile[(2 * kx + 1) * 65 + nl]);
        }
    }
}
__device__ __forceinline__ void rms_row_bf16(const float* __restrict__ xrow, const float* __restrict__ g, bf16_t* __restrict__ orow, int lane) {
    const f32x4* xr = (const f32x4*)xrow + lane;
    f32x4 v[4]; float s = 0.f;
#pragma unroll
    for (int j = 0; j < 4; ++j) { v[j] = xr[64 * j]; s += v[j].x * v[j].x + v[j].y * v[j].y + v[j].z * v[j].z + v[j].w * v[j].w; }
    const float rinv = rsqrtf(wave_sum(s) * (1.f / 1024.f) + EPS);
#pragma unroll
    for (int j = 0; j < 4; ++j) {
        const f32x4 gg = ((const f32x4*)g)[lane + 64 * j];
        uint2 o; o.x = pk2(v[j].x * rinv * gg.x, v[j].y * rinv * gg.y); o.y = pk2(v[j].z * rinv * gg.z, v[j].w * rinv * gg.w);
        *(uint2*)(orow + (lane + 64 * j) * 4) = o;
    }
}

constexpr int CT_PER_LAYER = 53 * 16 + 256 + 64 + 128 + 64;
constexpr int CT_GU = 64 * 128, CT_DN = 64 * 64;
constexpr int CT_TOTAL = NL * CT_PER_LAYER + CT_GU + CT_DN;

__device__ __forceinline__ void phase0(const Params& P, char* smem) {
    char* ws = P.ws;
    float* tile = (float*)smem;
    BLK_LOOP(it, CT_TOTAL) {
        int r = it;
        if (r < NL * CT_PER_LAYER) {
            const int l = r / CT_PER_LAYER; r -= l * CT_PER_LAYER;
            if (r < 848) { convT_tile(tile, P.in[I_W_IN] + (size_t)l * 1024 * NIN, 1024, NIN, (bf16_t*)(ws + OFF_WIN) + (size_t)l * NP * 1024, 1, 53, r); continue; } r -= 848;
            if (r < 256) { convT_tile(tile, P.in[I_W_OUT] + (size_t)l * 1024 * 1024, 1024, 1024, (bf16_t*)(ws + OFF_WOUT) + (size_t)l * 1024 * 1024, 0, 16, r); continue; } r -= 256;
            if (r < 64) { convT_tile(tile, P.in[I_W_MQ] + (size_t)l * 1024 * 256, 1024, 256, (bf16_t*)(ws + OFF_WMQ) + (size_t)l * 256 * 1024, 0, 4, r); continue; } r -= 64;
            if (r < 128) { convT_tile(tile, P.in[I_W_MKV] + (size_t)l * 1024 * 512, 1024, 512, (bf16_t*)(ws + OFF_WMKV) + (size_t)l * 512 * 1024, 0, 8, r); continue; } r -= 128;
            convT_tile(tile, P.in[I_W_MO] + (size_t)l * 256 * 1024, 256, 1024, (bf16_t*)(ws + OFF_WMO) + (size_t)l * 1024 * 256, 0, 16, r); continue;
        }
        r -= NL * CT_PER_LAYER;
        if (r < CT_GU) { const int m = r >> 7; convT_tile(tile, P.in[I_W_E_GU] + (size_t)m * 1024 * 512, 1024, 512, (bf16_t*)(ws + OFF_WGU) + (size_t)m * 512 * 1024, 2, 8, r & 127); continue; }
        r -= CT_GU;
        { const int m = r >> 6; convT_tile(tile, P.in[I_W_E_DN] + (size_t)m * 256 * 1024, 256, 1024, (bf16_t*)(ws + OFF_WDN) + (size_t)m * 1024 * 256, 0, 16, r & 63); }
    }
    for (int i = blockIdx.x * NTHR + threadIdx.x; i < NL * (NP - NIN) * 512; i += gridDim.x * NTHR) {
        const int l = i / ((NP - NIN) * 512), w = i % ((NP - NIN) * 512);
        ((unsigned*)((bf16_t*)(ws + OFF_WIN) + (size_t)l * NP * 1024 + (size_t)NIN * 1024))[w] = 0u;
    }
    const int gw = blockIdx.x * 8 + (threadIdx.x >> 6), ngw = gridDim.x * 8, lane = threadIdx.x & 63;
    for (int row = gw; row < T + NL * 2048; row += ngw) {
        if (row < T) rms_row_bf16(P.in[I_X] + (size_t)row * 1024, P.in[I_NORM_MIX], (bf16_t*)(ws + OFF_HN) + (size_t)row * 1024, lane);
        else { const int r2 = row - T, l = r2 >> 11, rr = r2 & 2047;
               rms_row_bf16(P.in[I_MEM] + (size_t)rr * 1024, P.in[I_NORM_MEMKV] + l * 1024, (bf16_t*)(ws + OFF_MEMN) + (size_t)r2 * 1024, lane); }
    }
}

constexpr int GLD = 72;
constexpr int GEMM_LDS = (256 + 128) * GLD * 2;
template <class RowPtr>
__device__ __forceinline__ void gemm_tile(char* smem, RowPtr rowptr, const bf16_t* __restrict__ Bt, int ldb, int n0, int K, f32x4 (&acc)[4][4]) {
    bf16_t* sA = (bf16_t*)smem; bf16_t* sB = sA + 256 * GLD;
    const int tid = threadIdx.x, lane = tid & 63, wave = tid >> 6, wm = wave >> 1, wn = wave & 1;
    const u32x4* ga[4]; const u32x4* gb[2];
#pragma unroll
    for (int i = 0; i < 4; ++i) { const int c = tid + i * 512, r = c >> 3, ch = c & 7; ga[i] = (const u32x4*)(rowptr(r) + ch * 8); }
#pragma unroll
    for (int i = 0; i < 2; ++i) { const int c = tid + i * 512, r = c >> 3, ch = c & 7; gb[i] = (const u32x4*)(Bt + (size_t)(n0 + r) * ldb + ch * 8); }
#pragma unroll
    for (int m = 0; m < 4; ++m)
#pragma unroll
        for (int n = 0; n < 4; ++n) acc[m][n] = (f32x4){0.f, 0.f, 0.f, 0.f};
    u32x4 ra[4], rb[2];
#pragma unroll
    for (int i = 0; i < 4; ++i) ra[i] = ga[i][0];
#pragma unroll
    for (int i = 0; i < 2; ++i) rb[i] = gb[i][0];
    const int nk = K / 64;
    for (int kt = 0; kt < nk; ++kt) {
        __syncthreads();
#pragma unroll
        for (int i = 0; i < 4; ++i) { const int c = tid + i * 512, r = c >> 3, ch = c & 7; *(u32x4*)(sA + r * GLD + ch * 8) = ra[i]; }
#pragma unroll
        for (int i = 0; i < 2; ++i) { const int c = tid + i * 512, r = c >> 3, ch = c & 7; *(u32x4*)(sB + r * GLD + ch * 8) = rb[i]; }
        __syncthreads();
        if (kt + 1 < nk) {
#pragma unroll
            for (int i = 0; i < 4; ++i) ra[i] = ga[i][(kt + 1) * 8];
#pragma unroll
            for (int i = 0; i < 2; ++i) rb[i] = gb[i][(kt + 1) * 8];
        }
#pragma unroll
        for (int kk = 0; kk < 2; ++kk) {
            bf16x8 af[4], bfr[4];
#pragma unroll
            for (int m = 0; m < 4; ++m) af[m] = *(const bf16x8*)(sA + (wm * 64 + m * 16 + (lane & 15)) * GLD + kk * 32 + (lane >> 4) * 8);
#pragma unroll
            for (int n = 0; n < 4; ++n) bfr[n] = *(const bf16x8*)(sB + (wn * 64 + n * 16 + (lane & 15)) * GLD + kk * 32 + (lane >> 4) * 8);
#pragma unroll
            for (int m = 0; m < 4; ++m)
#pragma unroll
                for (int n = 0; n < 4; ++n) acc[m][n] = __builtin_amdgcn_mfma_f32_16x16x32_bf16(bfr[n], af[m], acc[m][n], 0, 0, 0);
        }
    }
}
struct RowDirect { const bf16_t* A; int lda; int m0; __device__ __forceinline__ const bf16_t* operator()(int r) const { return A + (size_t)(m0 + r) * lda; } };
enum { EPI_INPROJ = 0, EPI_RESID = 1, EPI_BF16 = 2 };

__device__ __forceinline__ int vcu_id() { const int G = gridDim.x, bx = blockIdx.x; return (G % 8 == 0) ? (bx % 8) * (G / 8) + bx / 8 : bx; }

template <int EPI>
__device__ __forceinline__ void gemm_phase(char* smem, const bf16_t* A, int lda, const bf16_t* Bt, int ldb, int M, int N, int K, void* out, int ldo, const float* resid, float* gates) {
    const int ntn = N / 128, ntiles = (M / 256) * ntn;
    const int lane = threadIdx.x & 63, wave = threadIdx.x >> 6, wm = wave >> 1, wn = wave & 1;
    for (int tIdx = vcu_id(); tIdx < ntiles; tIdx += gridDim.x) {
        const int m0 = (tIdx / ntn) * 256, n0 = (tIdx % ntn) * 128;
        f32x4 acc[4][4];
        RowDirect rp{A, lda, m0};
        gemm_tile(smem, rp, Bt, ldb, n0, K, acc);
#pragma unroll
        for (int m = 0; m < 4; ++m)
#pragma unroll
            for (int n = 0; n < 4; ++n) {
                const int row = m0 + wm * 64 + m * 16 + (lane & 15), col = n0 + wn * 64 + n * 16 + (lane >> 4) * 4;
                const f32x4 v = acc[m][n];
                if (EPI == EPI_INPROJ) {
                    uint2 o; o.x = pk2(v.x, v.y); o.y = pk2(v.z, v.w);
                    *(uint2*)((bf16_t*)out + (size_t)row * ldo + col) = o;
                    if (col >= C_GATE && col < C_GATE + 16) *(f32x4*)(gates + (size_t)row * 16 + (col - C_GATE)) = v;
                } else if (EPI == EPI_RESID) {
                    const f32x4 r = *(const f32x4*)(resid + (size_t)row * ldo + col);
                    *(f32x4*)((float*)out + (size_t)row * ldo + col) = r + v;
                } else {
                    uint2 o; o.x = pk2(v.x, v.y); o.y = pk2(v.z, v.w);
                    *(uint2*)((bf16_t*)out + (size_t)row * ldo + col) = o;
                }
            }
    }
}

struct RowGather { const bf16_t* A; int lda; const int* ids; int shift; __device__ __forceinline__ const bf16_t* operator()(int r) const { return A + (size_t)(ids[r] >> shift) * lda; } };
template <int STAGE>
__device__ __forceinline__ void moe_phase(char* smem, const bf16_t* A, int lda, const bf16_t* Wt, size_t wstride, int ldb, int K, const int* cnt, const int* list, const float* pgate, bf16_t* out) {
    int* ids = (int*)(smem + GEMM_LDS);
    int* tpre = ids + 256;
    constexpr int NTN = (STAGE == 1) ? 4 : 8;
    __syncthreads();
    if (threadIdx.x == 0) { int a = 0; for (int i = 0; i < NEXP; ++i) { tpre[i] = a; a += (cnt[i] + 255) >> 8; } tpre[NEXP] = a; }
    __syncthreads();
    const int ntiles = tpre[NEXP] * NTN;
    const int lane = threadIdx.x & 63, wave = threadIdx.x >> 6, wm = wave >> 1, wn = wave & 1;
    for (int tIdx = vcu_id(); tIdx < ntiles; tIdx += gridDim.x) {
        const int mtg = tIdx / NTN, n0 = (tIdx % NTN) * 128;
        int e = 0;
        for (int i = 1; i < NEXP; ++i) if (tpre[i] <= mtg) e = i;
        const int mt = mtg - tpre[e];
        const int cn = cnt[e];
        __syncthreads();
        if (threadIdx.x < 256) { const int pos = mt * 256 + threadIdx.x; ids[threadIdx.x] = list[(size_t)e * T + (pos < cn ? pos : cn - 1)]; }
        __syncthreads();
        f32x4 acc[4][4];
        RowGather rp{A, lda, ids, STAGE == 1 ? 1 : 0};
        gemm_tile(smem, rp, Wt + (size_t)e * wstride, ldb, n0, K, acc);
#pragma unroll
        for (int m = 0; m < 4; ++m) {
            const int rl = wm * 64 + m * 16 + (lane & 15);
            if (mt * 256 + rl >= cn) continue;
            const int pid = ids[rl];
            if (STAGE == 1) {
                const float gt = pgate[pid];
#pragma unroll
                for (int np = 0; np < 2; ++np) {
                    const f32x4 g = acc[m][2 * np], u = acc[m][2 * np + 1];
                    const int j = (n0 + wn * 64 + np * 32) / 2 + (lane >> 4) * 4;
                    uint2 o; o.x = pk2(siluf_(g.x) * u.x * gt, siluf_(g.y) * u.y * gt); o.y = pk2(siluf_(g.z) * u.z * gt, siluf_(g.w) * u.w * gt);
                    *(uint2*)(out + (size_t)pid * DEXP + j) = o;
                }
            } else {
#pragma unroll
                for (int n = 0; n < 4; ++n) {
                    const f32x4 v = acc[m][n]; const int col = n0 + wn * 64 + n * 16 + (lane >> 4) * 4;
                    uint2 o; o.x = pk2(v.x, v.y); o.y = pk2(v.z, v.w);
                    *(uint2*)(out + (size_t)pid * 1024 + col) = o;
                }
            }
        }
    }
}

__device__ __forceinline__ void hgrn2_naive(const bf16_t* __restrict__ proj, const float* __restrict__ hgrn_lb, int layer, const float* __restrict__ mix_gain, bf16_t* __restrict__ y, int bh, int lane) {
    const int b = bh >> 2, h = bh & 3;
    float lbk = 0.f;
    if (layer == 1) { float a0 = hgrn_lb[h * 64 + lane], a1 = hgrn_lb[256 + h * 64 + lane]; lbk = 1.f / (1.f + __expf(a0 - a1)); }
    const float mg = mix_gain[C_AQ + h * 64 + lane];
    float S[64];
#pragma unroll
    for (int k = 0; k < 64; ++k) S[k] = 0.f;
    for (int t = 0; t < SEQ; ++t) {
        const bf16_t* pr = proj + (size_t)(b * SEQ + t) * NP + h * 64 + lane;
        const float qk = siluf_(bf2f(pr[C_AQ]));
        const float sg = sigmoidf_(bf2f(pr[C_AF]));
        const float f = lbk + (1.f - lbk) * sg, kk = (1.f - lbk) * (1.f - sg);
        const float iv = bf2f(pr[C_AI]);
        const float gv = bf2f(pr[C_AG]);
        float o = 0.f;
#pragma unroll
        for (int k = 0; k < 64; ++k) { S[k] = rdlane(f, k) * S[k] + rdlane(kk, k) * iv; o += rdlane(qk, k) * S[k]; }
        const float ms = wave_sum(o * o) * (1.f / 64.f);
        const float yv = o * rsqrtf(ms + EPS) * siluf_(gv) * mg;
        y[(size_t)(b * SEQ + t) * 1024 + 0 + h * 64 + lane] = f2bf(yv);
    }
}
__device__ __forceinline__ void gdn_naive(const bf16_t* __restrict__ proj, const float* __restrict__ gates, const float* __restrict__ conv_w  ,
                                          const float* __restrict__ a_log, const float* __restrict__ dt_bias, const float* __restrict__ mix_gain, bf16_t* __restrict__ y, int bh, int lane) {
    const int b = bh >> 2, h = bh & 3;
    float wq[4], wk[4], wv[4];
#pragma unroll
    for (int j = 0; j < 4; ++j) { wq[j] = conv_w[j * 768 + h * 64 + lane]; wk[j] = conv_w[j * 768 + 256 + h * 64 + lane]; wv[j] = conv_w[j * 768 + 512 + h * 64 + lane]; }
    float xq[3] = {0.f, 0.f, 0.f}, xk[3] = {0.f, 0.f, 0.f}, xv[3] = {0.f, 0.f, 0.f};
    const float Aexp = __expf(a_log[h]), dtb = dt_bias[h];
    const float mg = mix_gain[768 + h * 64 + lane];
    float S[64];
#pragma unroll
    for (int k = 0; k < 64; ++k) S[k] = 0.f;
    for (int t = 0; t < SEQ; ++t) {
        const size_t row = (size_t)(b * SEQ + t);
        const bf16_t* pr = proj + row * NP + h * 64 + lane;
        const float q0 = bf2f(pr[C_DQ]), k0 = bf2f(pr[C_DK]), v0 = bf2f(pr[C_DV]), zv = bf2f(pr[C_DZ]);
        float q = siluf_(wq[0] * xq[0] + wq[1] * xq[1] + wq[2] * xq[2] + wq[3] * q0);
        float k = siluf_(wk[0] * xk[0] + wk[1] * xk[1] + wk[2] * xk[2] + wk[3] * k0);
        float v = siluf_(wv[0] * xv[0] + wv[1] * xv[1] + wv[2] * xv[2] + wv[3] * v0);
        xq[0] = xq[1]; xq[1] = xq[2]; xq[2] = q0; xk[0] = xk[1]; xk[1] = xk[2]; xk[2] = k0; xv[0] = xv[1]; xv[1] = xv[2]; xv[2] = v0;
        q = q * rsqrtf(wave_sum(q * q) + EPS) * 0.125f;
        k = k * rsqrtf(wave_sum(k * k) + EPS);
        const float beta = sigmoidf_(gates[row * 16 + 4 + h]);
        const float g = -Aexp * softplusf_(gates[row * 16 + 8 + h] + dtb);
        const float eg = __expf(g);
        float r = 0.f;
#pragma unroll
        for (int i = 0; i < 64; ++i) { S[i] *= eg; r += rdlane(k, i) * S[i]; }
        const float dlt = beta * (v - r);
        float o = 0.f;
#pragma unroll
        for (int i = 0; i < 64; ++i) { S[i] += rdlane(k, i) * dlt; o += rdlane(q, i) * S[i]; }
        const float ms = wave_sum(o * o) * (1.f / 64.f);
        const float yv = o * rsqrtf(ms + EPS) * siluf_(zv) * mg;
        y[row * 1024 + 768 + h * 64 + lane] = f2bf(yv);
    }
}
__device__ __forceinline__ void fox_cumsum(const float* __restrict__ gates, const float* __restrict__ fb, float* __restrict__ cc, int bh, int lane) {
    const int b = bh >> 2, h = bh & 3;
    const float bias = fb[h];
    float carry = 0.f;
    for (int t0 = 0; t0 < SEQ; t0 += 64) {
        float v = logsigmoidf_(gates[(size_t)(b * SEQ + t0 + lane) * 16 + h] + bias);
#pragma unroll
        for (int o = 1; o < 64; o <<= 1) { float n = __shfl_up(v, o); if (lane >= o) v += n; }
        v += carry;
        cc[(size_t)(b * 4 + h) * SEQ + t0 + lane] = v;
        carry = __shfl(v, 63);
    }
}
__device__ __forceinline__ void lru_prep_task(float* xc  , const bf16_t* __restrict__ proj, const float* __restrict__ conv_w, const float* __restrict__ conv_b,
                                              const float* __restrict__ w_a, const float* __restrict__ b_a, const float* __restrict__ w_x, const float* __restrict__ b_x,
                                              const float* __restrict__ lam, float* __restrict__ a_out, float* __restrict__ u_out, int task, bool active) {
    const int c = threadIdx.x & 255, t0 = task * 16;
    if (active) {
        const float w0 = conv_w[c], w1 = conv_w[256 + c], w2 = conv_w[512 + c], w3 = conv_w[768 + c], cb = conv_b[c];
        for (int i = 0; i < 16; ++i) {
            const int t = t0 + i, s = t & (SEQ - 1);
            const bf16_t* pr = proj + (size_t)t * NP + C_CX + c;
            float acc = cb + w3 * bf2f(pr[0]);
            if (s >= 1) acc += w2 * bf2f(pr[-(ptrdiff_t)NP]);
            if (s >= 2) acc += w1 * bf2f(pr[-(ptrdiff_t)2 * NP]);
            if (s >= 3) acc += w0 * bf2f(pr[-(ptrdiff_t)3 * NP]);
            xc[i * 256 + c] = acc;
        }
    }
    __syncthreads();
    if (active) {
        const int h = c >> 6, jj = c & 63;
        float ra[16], rx[16];
#pragma unroll
        for (int i = 0; i < 16; ++i) { ra[i] = 0.f; rx[i] = 0.f; }
        for (int k = 0; k < 64; ++k) {
            const float wa = w_a[(h * 64 + k) * 64 + jj], wx = w_x[(h * 64 + k) * 64 + jj];
#pragma unroll
            for (int i = 0; i < 16; ++i) { const float xv = xc[i * 256 + h * 64 + k]; ra[i] += xv * wa; rx[i] += xv * wx; }
        }
        const float ba = b_a[c], bx = b_x[c], sp = softplusf_(-lam[c]);
#pragma unroll
        for (int i = 0; i < 16; ++i) {
            const float r = sigmoidf_(ra[i] + ba), ig = sigmoidf_(rx[i] + bx);
            const float log_a = -8.f * r * sp;
            const float a = __expf(log_a);
            const float u = sqrtf(-expm1f(2.f * log_a)) * (ig * xc[i * 256 + c]);
            a_out[(size_t)(t0 + i) * 256 + c] = a; u_out[(size_t)(t0 + i) * 256 + c] = u;
        }
    }
    __syncthreads();
}
__device__ __forceinline__ void lru_scan_task(const float* __restrict__ a_in, const float* __restrict__ u_in, const bf16_t* __restrict__ proj, const float* __restrict__ mix_gain, bf16_t* __restrict__ y, int b) {
    const int c = threadIdx.x;
    const float mg = mix_gain[512 + c];
    float hst = 0.f;
    for (int t = 0; t < SEQ; ++t) {
        const size_t row = (size_t)(b * SEQ + t);
        hst = a_in[row * 256 + c] * hst + u_in[row * 256 + c];
        const float yv = hst * geluf_(bf2f(proj[row * NP + C_CG + c]));
        const float ms = wave_sum(yv * yv) * (1.f / 64.f);
        y[row * 1024 + 512 + c] = f2bf(yv * rsqrtf(ms + EPS) * mg);
    }
}

typedef short s16x4 __attribute__((ext_vector_type(4)));
#define LDS_AS __attribute__((address_space(3)))
__device__ __forceinline__ bf16x8 frag_rm(const bf16_t* tile, int ld, int r0, int k0, int lane) { return *(const bf16x8*)(tile + (r0 + (lane & 15)) * ld + k0 + (lane >> 4) * 8); }
__device__ __forceinline__ s16x4 tr4(const bf16_t* tile, int ld, int rbase, int c0, int lane) {
    const bf16_t* p = tile + (rbase + ((lane & 15) >> 2)) * ld + c0 + 4 * (lane & 3);
    return __builtin_amdgcn_ds_read_tr16_b64_v4i16((LDS_AS s16x4*)p);
}
__device__ __forceinline__ bf16x8 frag_cm(const bf16_t* tile, int ld, int k0, int c0, int lane) {
    const s16x4 lo = tr4(tile, ld, k0 + (lane >> 4) * 8, c0, lane), hi = tr4(tile, ld, k0 + (lane >> 4) * 8 + 4, c0, lane);
    return (bf16x8){lo[0], lo[1], lo[2], lo[3], hi[0], hi[1], hi[2], hi[3]};
}
#define MFMA16(a, b, c) __builtin_amdgcn_mfma_f32_16x16x32_bf16((a), (b), (c), 0, 0, 0)
constexpr int TLD = 72;


#define XB_TMO      128
#define XB_XCNT(j)  (256  + 64 * (j))
#define XB_XSUB(j)  (1280 + 64 * (j))
#define XB_XGEN(j)  (2304 + 64 * (j))
#define XB_TOP      3328
#define XB_TOPGEN   3392
#define XCD_BAR_WORDS 3456
#define XB_SPIN_CAP (1u << 18)
__device__ __forceinline__ unsigned xb_ld(unsigned* p)              { return __hip_atomic_load(p, __ATOMIC_RELAXED, __HIP_MEMORY_SCOPE_AGENT); }
__device__ __forceinline__ unsigned xb_add(unsigned* p, unsigned v) { return __hip_atomic_fetch_add(p, v, __ATOMIC_RELAXED, __HIP_MEMORY_SCOPE_AGENT); }
__device__ __forceinline__ unsigned xb_xcc_id() { return (unsigned)__builtin_amdgcn_s_getreg((3 << 11) | 20) & 0xFu; }
#define XB_SPIN(cond, bar) do { unsigned _sp = 0; while (cond) { __builtin_amdgcn_s_sleep(1); \
    if ((++_sp & 255u) == 0u) { if (xb_ld(&(bar)[XB_TMO])) break; if (_sp > XB_SPIN_CAP) { atomicAdd(&(bar)[XB_TMO], 1u); break; } } } } while (0)
struct XcdBarrier { unsigned* bar; unsigned x; volatile LDS_AS unsigned* st; };
__device__ __forceinline__ XcdBarrier xcd_barrier_post(unsigned* bar, volatile LDS_AS unsigned* st) {
    XcdBarrier b; b.bar = bar; b.x = xb_xcc_id(); b.st = st;
    if (threadIdx.x == 0) (void)xb_add(&bar[XB_XCNT(b.x)], 1u);
    return b;
}
__device__ __forceinline__ void xcd_barrier_complete(unsigned* bar, unsigned x, unsigned& nloc, unsigned& nx) {
    const unsigned G = gridDim.x * gridDim.y * gridDim.z;
    unsigned sum, cnt, mine, sp = 0u;
    for (;;) {
        sum = 0u; cnt = 0u; mine = 0u;
#pragma unroll
        for (unsigned j = 0; j < 16; ++j) { const unsigned c = xb_ld(&bar[XB_XCNT(j)]); sum += c; cnt += (c > 0u) ? 1u : 0u; mine = (j == x) ? c : mine; }
        if (sum == G) break;
        __builtin_amdgcn_s_sleep(1);
        if ((++sp & 255u) == 0u) { if (xb_ld(&bar[XB_TMO])) break; if (sp > XB_SPIN_CAP) { atomicAdd(&bar[XB_TMO], 1u); break; } }
    }
    nloc = mine > 0u ? mine : 1u; nx = cnt > 0u ? cnt : 1u;
}
__device__ __forceinline__ void xcd_barrier(const XcdBarrier& b) {
    asm volatile("s_waitcnt vmcnt(0)" ::: "memory");
    __syncthreads();
    if (threadIdx.x == 0) {
        unsigned* bar = b.bar;
        __builtin_amdgcn_s_waitcnt(0);
        unsigned nloc = b.st[0], nx = b.st[1];
        if (nloc == 0u) { xcd_barrier_complete(bar, b.x, nloc, nx); b.st[0] = nloc; b.st[1] = nx; }
        const unsigned old = xb_add(&bar[XB_XSUB(b.x)], 1u);
        const unsigned gen = old / nloc;
        if (old + 1u == (gen + 1u) * nloc) {
            __builtin_amdgcn_fence(__ATOMIC_RELEASE, "agent");
            asm volatile("s_waitcnt vmcnt(0)" ::: "memory");
            const unsigned og = xb_add(&bar[XB_TOP], 1u);
            const unsigned tg = og / nx;
            if (og + 1u == (tg + 1u) * nx) xb_add(&bar[XB_TOPGEN], 1u);
            else XB_SPIN(xb_ld(&bar[XB_TOPGEN]) == tg, bar);
            __builtin_amdgcn_fence(__ATOMIC_ACQUIRE, "agent");
            xb_add(&bar[XB_XGEN(b.x)], 1u);
            asm volatile("s_waitcnt vmcnt(0)" ::: "memory");
        } else {
            XB_SPIN(xb_ld(&bar[XB_XGEN(b.x)]) == gen, bar);
            __builtin_amdgcn_fence(__ATOMIC_ACQUIRE, "agent");
            asm volatile("s_waitcnt vmcnt(0)" ::: "memory");
        }
    }
    __syncthreads();
}

__device__ __forceinline__ void attn_task(char* smem, const bf16_t* __restrict__ Q, int ldq, const bf16_t* __restrict__ Kp, int ldk, const bf16_t* __restrict__ Vp, int ldv, const float* __restrict__ bias,
                                          int nq_per_b, int nk_per_b, int causal, float scale, bf16_t* __restrict__ O, int ldo, const float* __restrict__ gain, int rms, int task) {
    bf16_t* sK = (bf16_t*)smem;
    bf16_t* sV = sK + 2 * 64 * TLD;
    float* sC = (float*)(sV + 2 * 64 * TLD);
    const int tid = threadIdx.x, lane = tid & 63, wave = tid >> 6, g = lane >> 4, li = lane & 15;
    const int nqt = nq_per_b / 128;
    const int qt = task % nqt, h = (task / nqt) & 3, b = task / (nqt * 4);
    const int q0 = qt * 128, tq = q0 + wave * 16 + li;
    const size_t qrow = (size_t)b * nq_per_b + tq;
    bf16x8 qf[2];
#pragma unroll
    for (int kk = 0; kk < 2; ++kk) qf[kk] = *(const bf16x8*)(Q + qrow * ldq + h * 64 + kk * 32 + g * 8);
    const float ct = bias ? bias[(size_t)(b * 4 + h) * nq_per_b + tq] : 0.f;
    const int nkt = causal ? (q0 + 128) / 64 : nk_per_b / 64;
    const int sr = tid >> 3, sc = tid & 7;
    const bf16_t* kg = Kp + ((size_t)b * nk_per_b + sr) * ldk + h * 64 + sc * 8;
    const bf16_t* vg = Vp + ((size_t)b * nk_per_b + sr) * ldv + h * 64 + sc * 8;
    const float* cg_ = bias ? bias + (size_t)(b * 4 + h) * nk_per_b : nullptr;
    u32x4 rk = *(const u32x4*)kg, rv = *(const u32x4*)vg; float rc = (cg_ && tid < 64) ? cg_[tid] : 0.f;
    __syncthreads();
    *(u32x4*)(sK + sr * TLD + sc * 8) = rk; *(u32x4*)(sV + sr * TLD + sc * 8) = rv; if (tid < 64) sC[tid] = rc;
    __syncthreads();
    f32x4 oacc[4];
#pragma unroll
    for (int n = 0; n < 4; ++n) oacc[n] = (f32x4){0.f, 0.f, 0.f, 0.f};
    float mrun = -INFINITY, lrun = 0.f;
    for (int kt = 0; kt < nkt; ++kt) {
        const int buf = kt & 1;
        if (kt + 1 < nkt) { rk = *(const u32x4*)(kg + (size_t)(kt + 1) * 64 * ldk); rv = *(const u32x4*)(vg + (size_t)(kt + 1) * 64 * ldv); rc = (cg_ && tid < 64) ? cg_[(kt + 1) * 64 + tid] : 0.f; }
        const bf16_t* cK = sK + buf * 64 * TLD; const bf16_t* cV = sV + buf * 64 * TLD; const float* cC = sC + buf * 64;
        const bool skip = causal && (kt * 64 > q0 + wave * 16 + 15);
        if (!skip) {
            f32x4 sacc[4];
#pragma unroll
            for (int n = 0; n < 4; ++n) {
                sacc[n] = (f32x4){0.f, 0.f, 0.f, 0.f};
#pragma unroll
                for (int kk = 0; kk < 2; ++kk) sacc[n] = MFMA16(frag_rm(cK, TLD, n * 16, kk * 32, lane), qf[kk], sacc[n]);
            }
            float mx = -INFINITY;
#pragma unroll
            for (int n = 0; n < 4; ++n) {
                const f32x4 cs = *(const f32x4*)(cC + n * 16 + 4 * g);
#pragma unroll
                for (int r = 0; r < 4; ++r) {
                    float v = sacc[n][r] * scale + (ct - cs[r]);
                    if (causal && (kt * 64 + n * 16 + 4 * g + r > tq)) v = -INFINITY;
                    sacc[n][r] = v; mx = fmaxf(mx, v);
                }
            }
            mx = fmaxf(mx, __shfl_xor(mx, 16)); mx = fmaxf(mx, __shfl_xor(mx, 32));
            const float mnew = fmaxf(mrun, mx);
            const float corr = __expf(mrun - mnew);
            float rs = 0.f;
#pragma unroll
            for (int n = 0; n < 4; ++n)
#pragma unroll
                for (int r = 0; r < 4; ++r) { const float p = __expf(sacc[n][r] - mnew); sacc[n][r] = p; rs += p; }
            rs += __shfl_xor(rs, 16); rs += __shfl_xor(rs, 32);
            lrun = lrun * corr + rs; mrun = mnew;
            bf16x8 pf[2];
#pragma unroll
            for (int kk = 0; kk < 2; ++kk) {
                const unsigned a0 = pk2(sacc[2 * kk][0], sacc[2 * kk][1]), a1 = pk2(sacc[2 * kk][2], sacc[2 * kk][3]);
                const unsigned a2 = pk2(sacc[2 * kk + 1][0], sacc[2 * kk + 1][1]), a3 = pk2(sacc[2 * kk + 1][2], sacc[2 * kk + 1][3]);
                const u32x4 pk = (u32x4){a0, a1, a2, a3};
                pf[kk] = __builtin_bit_cast(bf16x8, pk);
            }
#pragma unroll
            for (int n2 = 0; n2 < 4; ++n2) {
                oacc[n2] = oacc[n2] * corr;
#pragma unroll
                for (int kk = 0; kk < 2; ++kk) {
                    const s16x4 lo = tr4(cV, TLD, (2 * kk) * 16 + 4 * g, n2 * 16, lane), hi = tr4(cV, TLD, (2 * kk + 1) * 16 + 4 * g, n2 * 16, lane);
                    const bf16x8 vf = (bf16x8){lo[0], lo[1], lo[2], lo[3], hi[0], hi[1], hi[2], hi[3]};
                    oacc[n2] = MFMA16(vf, pf[kk], oacc[n2]);
                }
            }
        }
        if (kt + 1 < nkt) { const int nb = buf ^ 1; *(u32x4*)(sK + nb * 64 * TLD + sr * TLD + sc * 8) = rk; *(u32x4*)(sV + nb * 64 * TLD + sr * TLD + sc * 8) = rv; if (tid < 64) sC[nb * 64 + tid] = rc; }
        __syncthreads();
    }
    const float inv = 1.f / lrun;
    float ms = 0.f;
#pragma unroll
    for (int n = 0; n < 4; ++n) { oacc[n] = oacc[n] * inv; ms += oacc[n][0] * oacc[n][0] + oacc[n][1] * oacc[n][1] + oacc[n][2] * oacc[n][2] + oacc[n][3] * oacc[n][3]; }
    ms += __shfl_xor(ms, 16); ms += __shfl_xor(ms, 32);
    const float rinv = rms ? rsqrtf(ms * (1.f / 64.f) + EPS) : 1.f;
#pragma unroll
    for (int n = 0; n < 4; ++n) {
        const int d = n * 16 + 4 * g;
        f32x4 gg = (f32x4){1.f, 1.f, 1.f, 1.f};
        if (gain) gg = *(const f32x4*)(gain + h * 64 + d);
        uint2 o; o.x = pk2(oacc[n][0] * rinv * gg[0], oacc[n][1] * rinv * gg[1]); o.y = pk2(oacc[n][2] * rinv * gg[2], oacc[n][3] * rinv * gg[3]);
        *(uint2*)(O + qrow * ldo + h * 64 + d) = o;
    }
}


__device__ __forceinline__ void hgrn_scan(float* LF  , float* SEGT  , const bf16_t* __restrict__ prow  , const float* __restrict__ hgrn_lb, int layer, int h, float (&kk)[8]) {
    const int tid = threadIdx.x, t = tid >> 3, k8 = (tid & 7) * 8;
    const u32x4 raw = *(const u32x4*)(prow + (size_t)t * NP + C_AF + k8);
#pragma unroll
    for (int j = 0; j < 8; ++j) {
        const float fl = __uint_as_float((j & 1) ? (raw[j >> 1] & 0xffff0000u) : (raw[j >> 1] << 16));
        float lbk = 0.f;
        if (layer == 1) { const float a0 = hgrn_lb[h * 64 + k8 + j], a1 = hgrn_lb[256 + h * 64 + k8 + j]; lbk = 1.f / (1.f + __expf(a0 - a1)); }
        const float sg = sigmoidf_(fl);
        const float f = lbk + (1.f - lbk) * sg;
        kk[j] = (1.f - lbk) * (1.f - sg);
        LF[t * 65 + k8 + j] = __logf(f);
    }
    __syncthreads();
    { const int k = tid & 63, seg = tid >> 6; float run = 0.f;
#pragma unroll
      for (int i = 0; i < 8; ++i) { run += LF[(seg * 8 + i) * 65 + k]; LF[(seg * 8 + i) * 65 + k] = run; }
      SEGT[seg * 64 + k] = run; }
    __syncthreads();
    { const int k = tid & 63, seg = tid >> 6; float off = 0.f;
      for (int s2 = 0; s2 < seg; ++s2) off += SEGT[s2 * 64 + k];
#pragma unroll
      for (int i = 0; i < 8; ++i) LF[(seg * 8 + i) * 65 + k] += off; }
    __syncthreads();
}
__device__ __forceinline__ float bfx(const u32x4& raw, int j) { return __uint_as_float((j & 1) ? (raw[j >> 1] & 0xffff0000u) : (raw[j >> 1] << 16)); }

__device__ __forceinline__ void hgrn_local_task(char* smem, const bf16_t* __restrict__ proj, const float* __restrict__ hgrn_lb, int layer, float* __restrict__ HL, float* __restrict__ HD, int ch) {
    float* LF = (float*)smem; float* SEGT = LF + 64 * 65;
    bf16_t* sKd = (bf16_t*)(SEGT + 8 * 64); bf16_t* sV = sKd + 64 * TLD;
    const int tid = threadIdx.x, lane = tid & 63, wave = tid >> 6, g = lane >> 4, li = lane & 15;
    const int bh = ch >> 5, n = ch & 31, b = bh >> 2, h = bh & 3;
    const bf16_t* prow = proj + (size_t)(b * SEQ + n * 64) * NP + h * 64;
    const int t = tid >> 3, k8 = (tid & 7) * 8;
    __syncthreads();
    *(u32x4*)(sV + t * TLD + k8) = *(const u32x4*)(prow + (size_t)t * NP + C_AI + k8);
    float kk[8];
    hgrn_scan(LF, SEGT, prow, hgrn_lb, layer, h, kk);
    { u32x4 o;
#pragma unroll
      for (int j = 0; j < 8; j += 2) {
          const float e0 = kk[j] * __expf(LF[63 * 65 + k8 + j] - LF[t * 65 + k8 + j]), e1 = kk[j + 1] * __expf(LF[63 * 65 + k8 + j + 1] - LF[t * 65 + k8 + j + 1]);
          o[j >> 1] = pk2(e0, e1);
      }
      *(u32x4*)(sKd + t * TLD + k8) = o; }
    if (tid < 64) HD[(size_t)ch * 64 + tid] = __expf(LF[63 * 65 + tid]);
    __syncthreads();
#pragma unroll
    for (int i = 0; i < 2; ++i) {
        const int idx = wave * 2 + i, vt = idx >> 2, kt = idx & 3;
        f32x4 acc = (f32x4){0.f, 0.f, 0.f, 0.f};
#pragma unroll
        for (int ks = 0; ks < 2; ++ks) acc = MFMA16(frag_cm(sV, TLD, ks * 32, vt * 16, lane), frag_cm(sKd, TLD, ks * 32, kt * 16, lane), acc);
        *(f32x4*)(HL + (size_t)ch * 4096 + (kt * 16 + li) * 64 + vt * 16 + 4 * g) = acc;
    }
}

__device__ __forceinline__ void hgrn_out_task(char* smem, const bf16_t* __restrict__ proj, const float* __restrict__ hgrn_lb, int layer, const float* __restrict__ HL, const float* __restrict__ HD,
                                              const float* __restrict__ mix_gain, bf16_t* __restrict__ y, int ch) {
    float* LF = (float*)smem; float* SEGT = LF + 64 * 65; float* sMS = SEGT + 8 * 64;
    bf16_t* sST = (bf16_t*)(sMS + 128); bf16_t* sQ0 = sST + 64 * TLD; bf16_t* sQm = sQ0 + 64 * TLD; bf16_t* sKm = sQm + 64 * TLD; bf16_t* sV = sKm + 64 * TLD; bf16_t* sA = sV + 64 * TLD;
    const int tid = threadIdx.x, lane = tid & 63, wave = tid >> 6, g = lane >> 4, li = lane & 15;
    const int bh = ch >> 5, n = ch & 31, b = bh >> 2, h = bh & 3;
    const bf16_t* prow = proj + (size_t)(b * SEQ + n * 64) * NP + h * 64;
    const int t = tid >> 3, k8 = (tid & 7) * 8;
    __syncthreads();
    { const int v = tid & 63, kg = tid >> 6;
      float S[8];
#pragma unroll
      for (int j = 0; j < 8; ++j) S[j] = 0.f;
      const int ch0 = bh * 32;
      for (int m = 0; m < n; ++m) {
          const float* Lm = HL + (size_t)(ch0 + m) * 4096 + (kg * 8) * 64 + v; const float* Dm = HD + (size_t)(ch0 + m) * 64 + kg * 8;
#pragma unroll
          for (int j = 0; j < 8; ++j) S[j] = Dm[j] * S[j] + Lm[j * 64];
      }
      u32x4 o; o[0] = pk2(S[0], S[1]); o[1] = pk2(S[2], S[3]); o[2] = pk2(S[4], S[5]); o[3] = pk2(S[6], S[7]);
      *(u32x4*)(sST + v * TLD + kg * 8) = o; }
    const u32x4 qraw = *(const u32x4*)(prow + (size_t)t * NP + C_AQ + k8);
    *(u32x4*)(sV + t * TLD + k8) = *(const u32x4*)(prow + (size_t)t * NP + C_AI + k8);
    float kk[8];
    hgrn_scan(LF, SEGT, prow, hgrn_lb, layer, h, kk);
    { u32x4 o0, om, ok;
#pragma unroll
      for (int j = 0; j < 8; j += 2) {
          float q0v[2], qmv[2], kmv[2];
#pragma unroll
          for (int e = 0; e < 2; ++e) {
              const float bt = LF[t * 65 + k8 + j + e], r = LF[31 * 65 + k8 + j + e], q = siluf_(bfx(qraw, j + e));
              q0v[e] = q * __expf(bt); qmv[e] = q * __expf(bt - r); kmv[e] = kk[j + e] * __expf(r - bt);
          }
          o0[j >> 1] = pk2(q0v[0], q0v[1]); om[j >> 1] = pk2(qmv[0], qmv[1]); ok[j >> 1] = pk2(kmv[0], kmv[1]);
      }
      *(u32x4*)(sQ0 + t * TLD + k8) = o0; *(u32x4*)(sQm + t * TLD + k8) = om; *(u32x4*)(sKm + t * TLD + k8) = ok; }
    __syncthreads();
#pragma unroll
    for (int i = 0; i < 2; ++i) {
        const int idx = wave * 2 + i, tt = idx >> 2, st = idx & 3;
        f32x4 acc = (f32x4){0.f, 0.f, 0.f, 0.f};
#pragma unroll
        for (int ks = 0; ks < 2; ++ks) acc = MFMA16(frag_rm(sKm, TLD, st * 16, ks * 32, lane), frag_rm(sQm, TLD, tt * 16, ks * 32, lane), acc);
        const int tq = tt * 16 + li, s0 = st * 16 + 4 * g;
        uint2 o; o.x = pk2(s0 <= tq ? acc[0] : 0.f, s0 + 1 <= tq ? acc[1] : 0.f); o.y = pk2(s0 + 2 <= tq ? acc[2] : 0.f, s0 + 3 <= tq ? acc[3] : 0.f);
        *(uint2*)(sA + tq * TLD + s0) = o;
    }
    __syncthreads();
    { const int tt = wave >> 1;
      f32x4 oacc[2]; float ms = 0.f;
#pragma unroll
      for (int i = 0; i < 2; ++i) {
          const int vt = (wave & 1) * 2 + i;
          f32x4 acc = (f32x4){0.f, 0.f, 0.f, 0.f};
#pragma unroll
          for (int ks = 0; ks < 2; ++ks) acc = MFMA16(frag_rm(sST, TLD, vt * 16, ks * 32, lane), frag_rm(sQ0, TLD, tt * 16, ks * 32, lane), acc);
#pragma unroll
          for (int ks = 0; ks < 2; ++ks) acc = MFMA16(frag_cm(sV, TLD, ks * 32, vt * 16, lane), frag_rm(sA, TLD, tt * 16, ks * 32, lane), acc);
          oacc[i] = acc; ms += acc[0] * acc[0] + acc[1] * acc[1] + acc[2] * acc[2] + acc[3] * acc[3];
      }
      ms += __shfl_xor(ms, 16); ms += __shfl_xor(ms, 32);
      if (g == 0) sMS[(tt * 16 + li) * 2 + (wave & 1)] = ms;
      __syncthreads();
      const int tq = tt * 16 + li;
      const float rinv = rsqrtf((sMS[tq * 2] + sMS[tq * 2 + 1]) * (1.f / 64.f) + EPS);
      const size_t row = (size_t)(b * SEQ + n * 64 + tq);
#pragma unroll
      for (int i = 0; i < 2; ++i) {
          const int v0 = ((wave & 1) * 2 + i) * 16 + 4 * g;
          const uint2 graw = *(const uint2*)(proj + row * NP + C_AG + h * 64 + v0);
          const f32x4 mgv = *(const f32x4*)(mix_gain + C_AQ + h * 64 + v0);
          const float g0 = __uint_as_float(graw.x << 16), g1 = __uint_as_float(graw.x & 0xffff0000u), g2 = __uint_as_float(graw.y << 16), g3 = __uint_as_float(graw.y & 0xffff0000u);
          uint2 o; o.x = pk2(oacc[i][0] * rinv * siluf_(g0) * mgv[0], oacc[i][1] * rinv * siluf_(g1) * mgv[1]);
          o.y = pk2(oacc[i][2] * rinv * siluf_(g2) * mgv[2], oacc[i][3] * rinv * siluf_(g3) * mgv[3]);
          *(uint2*)(y + row * 1024 + h * 64 + v0) = o;
      }
    }
}


__device__ __forceinline__ void gdn_prep_task(char* smem, const bf16_t* __restrict__ proj, const float* __restrict__ gates, const float* __restrict__ conv_w  ,
                                              const float* __restrict__ a_log, const float* __restrict__ dt_bias, bf16_t* __restrict__ gt_all, float* __restrict__ glast, int ch) {
    float* sG = (float*)smem; float* sBeta = sG + 64;
    float* RHS = sBeta + 64;
    float* sM = RHS + 64 * 132;
    bf16_t* sK = (bf16_t*)(sM + 64 * 68); bf16_t* sQ = sK + 64 * TLD;
    const int tid = threadIdx.x, lane = tid & 63, wave = tid >> 6, g = lane >> 4, li = lane & 15;
    const int bh = ch >> 5, n = ch & 31, b = bh >> 2, h = bh & 3;
    const int t = tid >> 3, d8 = (tid & 7) * 8;
    const size_t row0 = (size_t)(b * SEQ + n * 64);
    bf16_t* gt = gt_all + (size_t)ch * 5 * 4096;
    __syncthreads();
    float qn[8], kn[8], vv[8];
    {
        const int spos = n * 64 + t;
#pragma unroll
        for (int sec = 0; sec < 3; ++sec) {
            const int col = (sec == 0 ? C_DQ : (sec == 1 ? C_DK : C_DV)) + h * 64 + d8;
            float acc[8];
#pragma unroll
            for (int e = 0; e < 8; ++e) acc[e] = 0.f;
#pragma unroll
            for (int j = 0; j < 4; ++j) {
                if (spos - (3 - j) >= 0) {
                    const u32x4 raw = *(const u32x4*)(proj + (row0 + t - (3 - j)) * NP + col);
                    const f32x4 w0 = *(const f32x4*)(conv_w + j * 768 + sec * 256 + h * 64 + d8), w1 = *(const f32x4*)(conv_w + j * 768 + sec * 256 + h * 64 + d8 + 4);
#pragma unroll
                    for (int e = 0; e < 8; ++e) acc[e] += (e < 4 ? w0[e] : w1[e - 4]) * bfx(raw, e);
                }
            }
#pragma unroll
            for (int e = 0; e < 8; ++e) { const float sv = siluf_(acc[e]); if (sec == 0) qn[e] = sv; else if (sec == 1) kn[e] = sv; else vv[e] = sv; }
        }
        float sq = 0.f, sk = 0.f;
#pragma unroll
        for (int e = 0; e < 8; ++e) { sq += qn[e] * qn[e]; sk += kn[e] * kn[e]; }
        sq += __shfl_xor(sq, 1); sq += __shfl_xor(sq, 2); sq += __shfl_xor(sq, 4);
        sk += __shfl_xor(sk, 1); sk += __shfl_xor(sk, 2); sk += __shfl_xor(sk, 4);
        const float rq = rsqrtf(sq + EPS) * 0.125f, rk = rsqrtf(sk + EPS);
#pragma unroll
        for (int e = 0; e < 8; ++e) { qn[e] *= rq; kn[e] *= rk; }
    }
    if ((tid & 7) == 0) {
        const float* gr = gates + (row0 + t) * 16;
        sBeta[t] = sigmoidf_(gr[4 + h]);
        sG[t] = -__expf(a_log[h]) * softplusf_(gr[8 + h] + dt_bias[h]);
    }
    __syncthreads();
    if (wave == 0) {
        float v = sG[lane];
#pragma unroll
        for (int o = 1; o < 64; o <<= 1) { const float nb = __shfl_up(v, o); if (lane >= o) v += nb; }
        sG[lane] = v;
    }
    __syncthreads();
    {
        const float Gt = sG[t], Gl = sG[63], bt = sBeta[t];
        const float eG = __expf(Gt), eD = __expf(Gl - Gt);
        u32x4 ok, oq, oqd, okd;
#pragma unroll
        for (int e = 0; e < 8; e += 2) {
            ok[e >> 1] = pk2(kn[e], kn[e + 1]); oq[e >> 1] = pk2(qn[e], qn[e + 1]);
            oqd[e >> 1] = pk2(qn[e] * eG, qn[e + 1] * eG); okd[e >> 1] = pk2(kn[e] * eD, kn[e + 1] * eD);
        }
        *(u32x4*)(sK + t * TLD + d8) = ok; *(u32x4*)(sQ + t * TLD + d8) = oq;
        *(u32x4*)(gt + 2 * 4096 + t * 64 + d8) = oqd; *(u32x4*)(gt + 3 * 4096 + t * 64 + d8) = okd;
#pragma unroll
        for (int e = 0; e < 8; ++e) { RHS[t * 132 + d8 + e] = vv[e] * bt; RHS[t * 132 + 64 + d8 + e] = kn[e] * bt * eG; }
        if (tid == 0) glast[ch] = __expf(Gl);
    }
    __syncthreads();
#pragma unroll
    for (int i = 0; i < 2; ++i) {
        const int idx = wave * 2 + i, tt = idx >> 2, st = idx & 3;
        f32x4 am = (f32x4){0.f, 0.f, 0.f, 0.f}, aq = (f32x4){0.f, 0.f, 0.f, 0.f};
#pragma unroll
        for (int ks = 0; ks < 2; ++ks) {
            const bf16x8 kf = frag_rm(sK, TLD, st * 16, ks * 32, lane);
            am = MFMA16(kf, frag_rm(sK, TLD, tt * 16, ks * 32, lane), am);
            aq = MFMA16(kf, frag_rm(sQ, TLD, tt * 16, ks * 32, lane), aq);
        }
        const int tq = tt * 16 + li, s0 = st * 16 + 4 * g;
        const float Gt = sG[tq], bt = sBeta[tq];
        f32x4 mo; float ao[4];
#pragma unroll
        for (int r = 0; r < 4; ++r) {
            const int sx = s0 + r;
            const float gm = (sx <= tq) ? __expf(Gt - sG[sx]) : 0.f;
            mo[r] = (sx < tq) ? bt * am[r] * gm : 0.f;
            ao[r] = aq[r] * gm;
        }
        *(f32x4*)(sM + tq * 68 + s0) = mo;
        uint2 o; o.x = pk2(ao[0], ao[1]); o.y = pk2(ao[2], ao[3]);
        *(uint2*)(gt + 4 * 4096 + tq * 64 + s0) = o;
    }
    __syncthreads();
    if (tid < 128) {
        float X[64];
#pragma unroll
        for (int i = 0; i < 64; ++i) X[i] = 0.f;
#pragma unroll
        for (int tt = 0; tt < 64; ++tt) {
            float a0 = RHS[tt * 132 + tid], a1 = 0.f;
#pragma unroll
            for (int s4 = 0; s4 < tt; s4 += 4) {
                const f32x4 m = *(const f32x4*)(sM + tt * 68 + s4);
                if ((s4 >> 2) & 1) { a1 -= m[0] * X[s4]; a1 -= m[1] * X[s4 + 1]; a1 -= m[2] * X[s4 + 2]; a1 -= m[3] * X[s4 + 3]; }
                else { a0 -= m[0] * X[s4]; a0 -= m[1] * X[s4 + 1]; a0 -= m[2] * X[s4 + 2]; a0 -= m[3] * X[s4 + 3]; }
            }
            X[tt] = a0 + a1;
        }
        if (tid < 64) {
#pragma unroll
            for (int tt = 0; tt < 64; ++tt) gt[tt * 64 + tid] = f2bf(X[tt]);
        } else {
#pragma unroll
            for (int tt = 0; tt < 64; ++tt) gt[4096 + tt * 64 + (tid - 64)] = f2bf(-X[tt]);
        }
    }
}

__device__ __forceinline__ void gdn_scan_task(char* smem, const bf16_t* __restrict__ gt_all, const float* __restrict__ glast, const bf16_t* __restrict__ proj, const float* __restrict__ mix_gain,
                                              bf16_t* __restrict__ y, int bh) {
    bf16_t* sT = (bf16_t*)smem;
    bf16_t* sST = sT + 2 * 5 * 64 * TLD;
    bf16_t* sVn = sST + 2 * 64 * TLD;
    const int tid = threadIdx.x, lane = tid & 63, wave = tid >> 6, g = lane >> 4, li = lane & 15;
    const int b = bh >> 2, h = bh & 3;
    const int sr = tid >> 3, sc8 = (tid & 7) * 8;
    const bf16_t* gsrc = gt_all + (size_t)bh * 32 * 5 * 4096 + sr * 64 + sc8;
    __syncthreads();
    u32x4 regs[5];
#pragma unroll
    for (int i = 0; i < 5; ++i) regs[i] = *(const u32x4*)(gsrc + i * 4096);
#pragma unroll
    for (int i = 0; i < 5; ++i) *(u32x4*)(sT + i * 64 * TLD + sr * TLD + sc8) = regs[i];
    *(u32x4*)(sST + sr * TLD + sc8) = (u32x4){0u, 0u, 0u, 0u};
    f32x4 sacc[4];
#pragma unroll
    for (int i = 0; i < 4; ++i) sacc[i] = (f32x4){0.f, 0.f, 0.f, 0.f};
    __syncthreads();
    for (int n = 0; n < 32; ++n) {
        const int buf = n & 1;
        const bf16_t* cT = sT + buf * 5 * 64 * TLD;
        const bf16_t* sU = cT; const bf16_t* sWn = cT + 64 * TLD; const bf16_t* sQd = cT + 2 * 64 * TLD; const bf16_t* sKd = cT + 3 * 64 * TLD; const bf16_t* sAq = cT + 4 * 64 * TLD;
        const bf16_t* cST = sST + buf * 64 * TLD; bf16_t* nST = sST + (buf ^ 1) * 64 * TLD;
        if (n + 1 < 32) {
#pragma unroll
            for (int i = 0; i < 5; ++i) regs[i] = *(const u32x4*)(gsrc + (size_t)(n + 1) * 5 * 4096 + i * 4096);
        }
        const size_t rowz = (size_t)(b * SEQ + n * 64 + (wave & 3) * 16 + li);
        uint2 zraw[4];
        if (wave < 4) {
#pragma unroll
            for (int vt = 0; vt < 4; ++vt) zraw[vt] = *(const uint2*)(proj + rowz * NP + C_DZ + h * 64 + vt * 16 + 4 * g);
        }
#pragma unroll
        for (int i = 0; i < 2; ++i) {
            const int idx = wave * 2 + i, tt = idx >> 2, vt = idx & 3;
            const int tq = tt * 16 + li, v0 = vt * 16 + 4 * g;
            const uint2 uraw = *(const uint2*)(sU + tq * TLD + v0);
            f32x4 acc = (f32x4){__uint_as_float(uraw.x << 16), __uint_as_float(uraw.x & 0xffff0000u), __uint_as_float(uraw.y << 16), __uint_as_float(uraw.y & 0xffff0000u)};
#pragma unroll
            for (int ks = 0; ks < 2; ++ks) acc = MFMA16(frag_rm(cST, TLD, vt * 16, ks * 32, lane), frag_rm(sWn, TLD, tt * 16, ks * 32, lane), acc);
            uint2 o; o.x = pk2(acc[0], acc[1]); o.y = pk2(acc[2], acc[3]);
            *(uint2*)(sVn + tq * TLD + v0) = o;
        }
        __syncthreads();
        if (wave < 4) {
            const int tt = wave;
            f32x4 oacc[4]; float ms = 0.f;
#pragma unroll
            for (int vt = 0; vt < 4; ++vt) {
                f32x4 acc = (f32x4){0.f, 0.f, 0.f, 0.f};
#pragma unroll
                for (int ks = 0; ks < 2; ++ks) acc = MFMA16(frag_rm(cST, TLD, vt * 16, ks * 32, lane), frag_rm(sQd, TLD, tt * 16, ks * 32, lane), acc);
#pragma unroll
                for (int ks = 0; ks < 2; ++ks) acc = MFMA16(frag_cm(sVn, TLD, ks * 32, vt * 16, lane), frag_rm(sAq, TLD, tt * 16, ks * 32, lane), acc);
                oacc[vt] = acc; ms += acc[0] * acc[0] + acc[1] * acc[1] + acc[2] * acc[2] + acc[3] * acc[3];
            }
            ms += __shfl_xor(ms, 16); ms += __shfl_xor(ms, 32);
            const float rinv = rsqrtf(ms * (1.f / 64.f) + EPS);
#pragma unroll
            for (int vt = 0; vt < 4; ++vt) {
                const int v0 = vt * 16 + 4 * g;
                const f32x4 mgv = *(const f32x4*)(mix_gain + 768 + h * 64 + v0);
                const float z0 = __uint_as_float(zraw[vt].x << 16), z1 = __uint_as_float(zraw[vt].x & 0xffff0000u), z2 = __uint_as_float(zraw[vt].y << 16), z3 = __uint_as_float(zraw[vt].y & 0xffff0000u);
                uint2 o; o.x = pk2(oacc[vt][0] * rinv * siluf_(z0) * mgv[0], oacc[vt][1] * rinv * siluf_(z1) * mgv[1]);
                o.y = pk2(oacc[vt][2] * rinv * siluf_(z2) * mgv[2], oacc[vt][3] * rinv * siluf_(z3) * mgv[3]);
                *(uint2*)(y + rowz * 1024 + 768 + h * 64 + v0) = o;
            }
        } else {
            const int kt = wave - 4;
            const float gl = glast[bh * 32 + n];
#pragma unroll
            for (int vt = 0; vt < 4; ++vt) {
                f32x4 acc = sacc[vt] * gl;
#pragma unroll
                for (int ks = 0; ks < 2; ++ks) acc = MFMA16(frag_cm(sKd, TLD, ks * 32, kt * 16, lane), frag_cm(sVn, TLD, ks * 32, vt * 16, lane), acc);
                sacc[vt] = acc;
                uint2 o; o.x = pk2(acc[0], acc[1]); o.y = pk2(acc[2], acc[3]);
                *(uint2*)(nST + (vt * 16 + li) * TLD + kt * 16 + 4 * g) = o;
            }
        }
        if (n + 1 < 32) {
            bf16_t* nT = sT + (buf ^ 1) * 5 * 64 * TLD;
#pragma unroll
            for (int i = 0; i < 5; ++i) *(u32x4*)(nT + i * 64 * TLD + sr * TLD + sc8) = regs[i];
        }
        __syncthreads();
    }
}


constexpr int XLD = 264;
__device__ __forceinline__ void lru_local_task(char* smem, const bf16_t* __restrict__ proj, const float* __restrict__ conv_w, const float* __restrict__ conv_b,
                                               const float* __restrict__ w_a, const float* __restrict__ b_a, const float* __restrict__ w_x, const float* __restrict__ b_x,
                                               const float* __restrict__ lam, float* __restrict__ hl_out, float* __restrict__ ac_out, float* __restrict__ lsum, int task) {
    bf16_t* sX = (bf16_t*)smem;
    bf16_t* sW = sX + 64 * XLD;
    float* sAa = (float*)(sW + 2 * 64 * TLD);
    float* sU = sAa + 64 * 65;
    float* sSegA = sU + 64 * 65; float* sSegH = sSegA + 8 * 64;
    const int tid = threadIdx.x, lane = tid & 63, wave = tid >> 6, g = lane >> 4, li = lane & 15;
    const int b = task >> 5, n = task & 31;
    const size_t row0 = (size_t)(b * SEQ + n * 64);
    const int t = tid >> 3;
    __syncthreads();
    {
        const int spos = n * 64 + t;
#pragma unroll
        for (int i = 0; i < 4; ++i) {
            const int c8 = ((tid & 7) + 8 * i) * 8;
            float acc[8];
            { const f32x4 cb0 = *(const f32x4*)(conv_b + c8), cb1 = *(const f32x4*)(conv_b + c8 + 4);
#pragma unroll
              for (int e = 0; e < 8; ++e) acc[e] = e < 4 ? cb0[e] : cb1[e - 4]; }
#pragma unroll
            for (int j = 0; j < 4; ++j) {
                if (spos - (3 - j) >= 0) {
                    const u32x4 raw = *(const u32x4*)(proj + (row0 + t - (3 - j)) * NP + C_CX + c8);
                    const f32x4 w0 = *(const f32x4*)(conv_w + j * 256 + c8), w1 = *(const f32x4*)(conv_w + j * 256 + c8 + 4);
#pragma unroll
                    for (int e = 0; e < 8; ++e) acc[e] += (e < 4 ? w0[e] : w1[e - 4]) * bfx(raw, e);
                }
            }
            u32x4 o; o[0] = pk2(acc[0], acc[1]); o[1] = pk2(acc[2], acc[3]); o[2] = pk2(acc[4], acc[5]); o[3] = pk2(acc[6], acc[7]);
            *(u32x4*)(sX + t * XLD + c8) = o;
        }
    }
    for (int hh = 0; hh < 4; ++hh) {
        {
            const int i = tid >> 3, j8 = (tid & 7) * 8;
#pragma unroll
            for (int m = 0; m < 2; ++m) {
                const float* src = (m == 0 ? w_a : w_x) + (size_t)hh * 4096 + i * 64 + j8;
                const f32x4 v0 = *(const f32x4*)src, v1 = *(const f32x4*)(src + 4);
                u32x4 o; o[0] = pk2(v0[0], v0[1]); o[1] = pk2(v0[2], v0[3]); o[2] = pk2(v1[0], v1[1]); o[3] = pk2(v1[2], v1[3]);
                *(u32x4*)(sW + m * 64 * TLD + i * TLD + j8) = o;
            }
        }
        __syncthreads();
#pragma unroll
        for (int i2 = 0; i2 < 2; ++i2) {
            const int idx = wave * 2 + i2, tt = idx >> 2, jt = idx & 3;
            f32x4 ra = (f32x4){0.f, 0.f, 0.f, 0.f}, rx = (f32x4){0.f, 0.f, 0.f, 0.f};
#pragma unroll
            for (int ks = 0; ks < 2; ++ks) {
                const bf16x8 xf = frag_rm(sX + hh * 64, XLD, tt * 16, ks * 32, lane);
                ra = MFMA16(frag_cm(sW, TLD, ks * 32, jt * 16, lane), xf, ra);
                rx = MFMA16(frag_cm(sW + 64 * TLD, TLD, ks * 32, jt * 16, lane), xf, rx);
            }
            const int tq = tt * 16 + li, cl = jt * 16 + 4 * g, c = hh * 64 + cl;
            const f32x4 ba = *(const f32x4*)(b_a + c), bx = *(const f32x4*)(b_x + c), lm = *(const f32x4*)(lam + c);
            const uint2 xraw = *(const uint2*)(sX + tq * XLD + c);
            const float xc[4] = {__uint_as_float(xraw.x << 16), __uint_as_float(xraw.x & 0xffff0000u), __uint_as_float(xraw.y << 16), __uint_as_float(xraw.y & 0xffff0000u)};
#pragma unroll
            for (int r = 0; r < 4; ++r) {
                const float rr = sigmoidf_(ra[r] + ba[r]), ig = sigmoidf_(rx[r] + bx[r]);
                const float log_a = -8.f * rr * softplusf_(-lm[r]);
                sAa[tq * 65 + cl + r] = __expf(log_a);
                sU[tq * 65 + cl + r] = sqrtf(-expm1f(2.f * log_a)) * (ig * xc[r]);
            }
        }
        __syncthreads();
        const int cl = tid & 63, seg = tid >> 6;
        float Al[8], Hl[8];
        { float A = 1.f, H = 0.f;
#pragma unroll
          for (int i = 0; i < 8; ++i) { const float a = sAa[(seg * 8 + i) * 65 + cl], u = sU[(seg * 8 + i) * 65 + cl]; H = a * H + u; A *= a; Al[i] = A; Hl[i] = H; }
          sSegA[seg * 64 + cl] = A; sSegH[seg * 64 + cl] = H; }
        __syncthreads();
        { float Ac = 1.f, Hc = 0.f;
          for (int s2 = 0; s2 < seg; ++s2) { const float a = sSegA[s2 * 64 + cl]; Hc = a * Hc + sSegH[s2 * 64 + cl]; Ac *= a; }
#pragma unroll
          for (int i = 0; i < 8; ++i) {
              const size_t o = (row0 + seg * 8 + i) * 256 + hh * 64 + cl;
              const float hv = Hl[i] + Al[i] * Hc, av = Al[i] * Ac;
              hl_out[o] = hv; ac_out[o] = av;
              if (seg == 7 && i == 7) { lsum[(size_t)task * 256 + hh * 64 + cl] = av; lsum[(size_t)(256 + task) * 256 + hh * 64 + cl] = hv; }
          } }
        __syncthreads();
    }
}
__device__ __forceinline__ void lru_out_task(const float* __restrict__ hl_in, const float* __restrict__ ac_in, const float* __restrict__ lsum, const bf16_t* __restrict__ proj,
                                             const float* __restrict__ mix_gain, bf16_t* __restrict__ y, int task) {
    const int b = task >> 5, n = task & 31, c = threadIdx.x & 255, half = threadIdx.x >> 8;
    float Hc = 0.f;
    for (int m = 0; m < n; ++m) Hc = lsum[(size_t)(b * 32 + m) * 256 + c] * Hc + lsum[(size_t)(256 + b * 32 + m) * 256 + c];
    const float mg = mix_gain[512 + c];
    const size_t row0 = (size_t)(b * SEQ + n * 64 + half * 32);
#pragma unroll 4
    for (int i = 0; i < 32; ++i) {
        const size_t row = row0 + i;
        const float hv = hl_in[row * 256 + c] + ac_in[row * 256 + c] * Hc;
        const float yv = hv * geluf_(bf2f(proj[row * NP + C_CG + c]));
        const float ms = wave_sum(yv * yv) * (1.f / 64.f);
        y[row * 1024 + 512 + c] = f2bf(yv * rsqrtf(ms + EPS) * mg);
    }
}

__device__ __forceinline__ void router_phase(char* smem, const float* __restrict__ x, const float* __restrict__ g, const float* __restrict__ w_rg, const float* __restrict__ b_rg,
                                             const float* __restrict__ w_re, const float* __restrict__ b_re, bf16_t* __restrict__ hn, int* __restrict__ cnt, int* __restrict__ list, float* __restrict__ pgate) {
    float* sXg = (float*)smem;
    float* sWr = sXg + 64 * 132;
    float* sLog = sWr + 128 * 40;
    float* sRinv = sLog + 64 * 40;
    const int tid = threadIdx.x;
    BLK_LOOP(tile, T / 64) {
        const int t0 = tile * 64;
        const int stok = tid >> 3;
        const int ctok = tid & 63, eg = tid >> 6;
        float acc[5] = {0.f, 0.f, 0.f, 0.f, 0.f};
        float ss = 0.f;
        for (int kc = 0; kc < 8; ++kc) {
            __syncthreads();
#pragma unroll
            for (int i = 0; i < 4; ++i) {
                const int col = ((tid & 7) + 8 * i) * 4;
                const f32x4 xv = *(const f32x4*)(x + (size_t)(t0 + stok) * 1024 + kc * 128 + col);
                const f32x4 gv = *(const f32x4*)(g + kc * 128 + col);
                ss += xv[0] * xv[0] + xv[1] * xv[1] + xv[2] * xv[2] + xv[3] * xv[3];
                *(f32x4*)(sXg + stok * 132 + col) = xv * gv;
            }
            for (int idx = tid; idx < 128 * 40; idx += NTHR) {
                const int k = idx / 40, e = idx - k * 40;
                float wv = 0.f;
                if (e < 4) wv = w_rg[(size_t)(kc * 128 + k) * 4 + e]; else if (e < 36) wv = w_re[(size_t)(kc * 128 + k) * 32 + (e - 4)];
                sWr[idx] = wv;
            }
            __syncthreads();
#pragma unroll 2
            for (int k4 = 0; k4 < 128; k4 += 4) {
                const f32x4 hv = *(const f32x4*)(sXg + ctok * 132 + k4);
#pragma unroll
                for (int kk = 0; kk < 4; ++kk) {
                    const float* wp = sWr + (k4 + kk) * 40 + eg * 5;
#pragma unroll
                    for (int j = 0; j < 5; ++j) acc[j] += hv[kk] * wp[j];
                }
            }
        }
        ss += __shfl_xor(ss, 1); ss += __shfl_xor(ss, 2); ss += __shfl_xor(ss, 4);
        if ((tid & 7) == 0) sRinv[stok] = rsqrtf(ss * (1.f / 1024.f) + EPS);
#pragma unroll
        for (int j = 0; j < 5; ++j) sLog[ctok * 40 + eg * 5 + j] = acc[j];
        __syncthreads();
        if (tid < 64) {
            const int t = t0 + tid; const float rinv = sRinv[tid];
            float lg[4];
#pragma unroll
            for (int i = 0; i < 4; ++i) lg[i] = sLog[tid * 40 + i] * rinv + b_rg[i];
            int gs = 0; float gm = lg[0];
#pragma unroll
            for (int i = 1; i < 4; ++i) if (lg[i] > gm) { gm = lg[i]; gs = i; }
            float den = 0.f;
#pragma unroll
            for (int i = 0; i < 4; ++i) den += __expf(lg[i] - gm);
            const float pg = 1.f / den;
            int i0 = 0, i1 = -1; float m0 = -INFINITY, m1 = -INFINITY;
            for (int i = 0; i < 8; ++i) {
                const float v = sLog[tid * 40 + 4 + gs * 8 + i] * rinv + b_re[gs * 8 + i];
                if (v > m0) { m1 = m0; i1 = i0; m0 = v; i0 = i; } else if (v > m1) { m1 = v; i1 = i; }
            }
            const float e1 = __expf(m1 - m0); const float w0 = 1.f / (1.f + e1), w1 = e1 / (1.f + e1);
            const int ex0 = gs * 8 + i0, ex1 = gs * 8 + i1;
            const int pos0 = atomicAdd(&cnt[ex0], 1); list[(size_t)ex0 * T + pos0] = 2 * t; pgate[2 * t] = pg * w0;
            const int pos1 = atomicAdd(&cnt[ex1], 1); list[(size_t)ex1 * T + pos1] = 2 * t + 1; pgate[2 * t + 1] = pg * w1;
        }
        {
            const float rinv = sRinv[stok];
#pragma unroll 4
            for (int i = 0; i < 32; ++i) {
                const int col = ((tid & 7) + 8 * i) * 4;
                const f32x4 xv = *(const f32x4*)(x + (size_t)(t0 + stok) * 1024 + col);
                const f32x4 gv = *(const f32x4*)(g + col);
                uint2 o; o.x = pk2(xv[0] * gv[0] * rinv, xv[1] * gv[1] * rinv); o.y = pk2(xv[2] * gv[2] * rinv, xv[3] * gv[3] * rinv);
                *(uint2*)(hn + (size_t)(t0 + stok) * 1024 + col) = o;
            }
        }
    }
}

__device__ __forceinline__ void combine_phase(const float* x2, const bf16_t* __restrict__ eo, const float* __restrict__ g, float* xout, bf16_t* __restrict__ hn, int mode) {
    const int lane = threadIdx.x & 63;
    for (int t = blockIdx.x * 8 + (threadIdx.x >> 6); t < T; t += gridDim.x * 8) {
        f32x4 v[4]; float s = 0.f;
#pragma unroll
        for (int j = 0; j < 4; ++j) {
            const int c = (lane + 64 * j) * 4;
            v[j] = *(const f32x4*)(x2 + (size_t)t * 1024 + c);
            const uint2 e0 = *(const uint2*)(eo + (size_t)(2 * t) * 1024 + c), e1 = *(const uint2*)(eo + (size_t)(2 * t + 1) * 1024 + c);
            v[j].x += __uint_as_float(e0.x << 16) + __uint_as_float(e1.x << 16);
            v[j].y += __uint_as_float(e0.x & 0xffff0000u) + __uint_as_float(e1.x & 0xffff0000u);
            v[j].z += __uint_as_float(e0.y << 16) + __uint_as_float(e1.y << 16);
            v[j].w += __uint_as_float(e0.y & 0xffff0000u) + __uint_as_float(e1.y & 0xffff0000u);
            s += v[j].x * v[j].x + v[j].y * v[j].y + v[j].z * v[j].z + v[j].w * v[j].w;
        }
        const float rinv = rsqrtf(wave_sum(s) * (1.f / 1024.f) + EPS);
#pragma unroll
        for (int j = 0; j < 4; ++j) {
            const int c = (lane + 64 * j) * 4;
            const f32x4 gg = *(const f32x4*)(g + c);
            const f32x4 hv = v[j] * rinv * gg;
            if (mode == 0) {
                *(f32x4*)(xout + (size_t)t * 1024 + c) = v[j];
                uint2 o; o.x = pk2(hv.x, hv.y); o.y = pk2(hv.z, hv.w);
                *(uint2*)(hn + (size_t)t * 1024 + c) = o;
            } else {
                *(f32x4*)(xout + (size_t)t * 1024 + c) = hv;
            }
        }
    }
}

template <int l>
__device__ __forceinline__ void layer_body(const Params& P, char* smem, const XcdBarrier& xb, const float* xcur) {
    char* ws = P.ws;
    bf16_t* Wt_in = (bf16_t*)(ws + OFF_WIN); bf16_t* Wt_out = (bf16_t*)(ws + OFF_WOUT); bf16_t* Wt_mq = (bf16_t*)(ws + OFF_WMQ); bf16_t* Wt_mkv = (bf16_t*)(ws + OFF_WMKV);
    bf16_t* Wt_mo = (bf16_t*)(ws + OFF_WMO); bf16_t* Wt_gu = (bf16_t*)(ws + OFF_WGU); bf16_t* Wt_dn = (bf16_t*)(ws + OFF_WDN);
    bf16_t* hn = (bf16_t*)(ws + OFF_HN); bf16_t* proj = (bf16_t*)(ws + OFF_PROJ); float* gates = (float*)(ws + OFF_GATES); bf16_t* y = (bf16_t*)(ws + OFF_Y);
    float* XA = P.out; float* XB = (float*)(ws + OFF_XB);
    bf16_t* qm = (bf16_t*)(ws + OFF_QM); bf16_t* om = (bf16_t*)(ws + OFF_OM); bf16_t* kvm = (bf16_t*)(ws + OFF_KVM); bf16_t* memn = (bf16_t*)(ws + OFF_MEMN);
    float* foxc = (float*)(ws + OFF_FOXC); float* lrua = (float*)(ws + OFF_LRUA); float* lruu = (float*)(ws + OFF_LRUU);
    int* cnt_all = (int*)(ws + OFF_CTL) + CTL_CNT_WORD; int* list = (int*)(ws + OFF_LIST); float* pgate = (float*)(ws + OFF_PGATE);
    bf16_t* act = (bf16_t*)(ws + OFF_ACT); bf16_t* eo = (bf16_t*)(ws + OFF_EO);
    const int wave = threadIdx.x >> 6, lane = threadIdx.x & 63;


        float* x1 = (l == 0) ? XA : XB;
        float* x2 = (l == 0) ? XB : XA;
        int* cnt = cnt_all + 32 * l;
        const float* mg = P.in[I_MIX_GAIN] + l * 1024;
        REP(2, gemm_phase<EPI_INPROJ>(smem, hn, 1024, Wt_in + (size_t)l * NP * 1024, 1024, T, NP, 1024, proj, NP, nullptr, gates));
        if (l == 0) for (int l2 = 0; l2 < NL; ++l2)
            gemm_phase<EPI_BF16>(smem, memn + (size_t)l2 * 2048 * 1024, 1024, Wt_mkv + (size_t)l2 * 512 * 1024, 1024, 2048, 512, 1024, kvm + (size_t)l2 * 2048 * 512, 512, nullptr, nullptr);
        GSYNC();
        REP(4,         {
            const int bx = blockIdx.x;
            bf16_t* gtiles = (bf16_t*)(ws + OFF_GDN); float* glast = (float*)(ws + OFF_GLAST);
            if (bx < 32 && wave == 1) fox_cumsum(gates, P.in[I_FOX_FB] + l * 4, foxc, bx, lane);
            BLK_LOOP(ch, 1024) gdn_prep_task(smem, proj, gates, P.in[I_GDN_CONV_W] + l * 4 * 768, P.in[I_GDN_A_LOG] + l * 4, P.in[I_GDN_DT_BIAS] + l * 4, gtiles, glast, ch);
            BLK_LOOP(ch, 1024) hgrn_local_task(smem, proj, P.in[I_HGRN_LB], l, (float*)(ws + OFF_HL), (float*)(ws + OFF_HD), ch);
            BLK_LOOP(task, 256) lru_local_task(smem, proj, P.in[I_LRU_CONV_W] + l * 1024, P.in[I_LRU_CONV_B] + l * 256, P.in[I_LRU_WA] + l * 16384, P.in[I_LRU_BA] + l * 256,
                                               P.in[I_LRU_WX] + l * 16384, P.in[I_LRU_BX] + l * 256, P.in[I_LRU_LAM] + l * 256, lrua, lruu, (float*)(ws + OFF_LSUM), task);
        });
        GSYNC();
        REP(8,         {
            const int natt = (SEQ / 128) * 4 * NB;
            const int bx = blockIdx.x, nfree = (int)gridDim.x - 32;
            if (bx < 32) gdn_scan_task(smem, (const bf16_t*)(ws + OFF_GDN), (const float*)(ws + OFF_GLAST), proj, mg, y, bx);
            else {
                for (int i = bx - 32; i < natt; i += nfree) {
                    const int qt = 15 - (i >> 5), bh = i & 31;
                    attn_task(smem, proj + C_BQ, NP, proj + C_BK, NP, proj + C_BV, NP, foxc, SEQ, SEQ, 1, 0.125f, y + 256, 1024, mg + 256, 1, (bh * 16) + qt);
                }
                for (int i = bx - 32; i < 1024; i += nfree) {
                    const int ch = (i & 31) * 32 + (31 - (i >> 5));
                    hgrn_out_task(smem, proj, P.in[I_HGRN_LB], l, (const float*)(ws + OFF_HL), (const float*)(ws + OFF_HD), mg, y, ch);
                }
                for (int i = bx - 32; i < 256; i += nfree) lru_out_task(lrua, lruu, (const float*)(ws + OFF_LSUM), proj, mg, y, i);
            }
        });
        GSYNC();
        REP(16, gemm_phase<EPI_RESID>(smem, y, 1024, Wt_out + (size_t)l * 1024 * 1024, 1024, T, 1024, 1024, x1, 1024, xcur, nullptr));
        GSYNC();
        REP(32, for (int row = blockIdx.x * 8 + wave; row < T; row += gridDim.x * 8) rms_row_bf16(x1 + (size_t)row * 1024, P.in[I_NORM_MEM] + l * 1024, hn + (size_t)row * 1024, lane));
        GSYNC();
        REP(64, gemm_phase<EPI_BF16>(smem, hn, 1024, Wt_mq + (size_t)l * 256 * 1024, 1024, T, 256, 1024, qm, 256, nullptr, nullptr));
        GSYNC();
        { const bf16_t* kv = kvm + (size_t)l * 2048 * 512;
          REP(128, BLK_LOOP(task, (SEQ / 128) * 4 * NB) attn_task(smem, qm, 256, kv, 512, kv + 256, 512, nullptr, SEQ, MEMLEN, 0, 0.125f, om, 256, nullptr, 0, task)); }
        GSYNC();
        REP(256, gemm_phase<EPI_RESID>(smem, om, 256, Wt_mo + (size_t)l * 1024 * 256, 256, T, 1024, 256, x2, 1024, x1, nullptr));
        GSYNC();
        router_phase(smem, x2, P.in[I_NORM_FFN] + l * 1024, P.in[I_W_RG] + l * 4096, P.in[I_B_RG] + l * 4, P.in[I_W_RE] + l * 32768, P.in[I_B_RE] + l * 32, hn, cnt, list, pgate);
        GSYNC();
        REP(512, moe_phase<1>(smem, hn, 1024, Wt_gu + (size_t)l * 32 * 512 * 1024, (size_t)512 * 1024, 1024, 1024, cnt, list, pgate, act));
        GSYNC();
        REP(1024, moe_phase<2>(smem, act, 256, Wt_dn + (size_t)l * 32 * 1024 * 256, (size_t)1024 * 256, 256, 256, cnt, list, pgate, eo));
        if (PROBE_MASK & 2048) { for (int i = 0; i < 10; ++i) GSYNC(); }
        GSYNC();
        if (l == 0) { combine_phase(x2, eo, P.in[I_NORM_MIX] + 1024, XA, hn, 0); GSYNC(); }
        else combine_phase(x2, eo, P.in[I_NORM_FINAL], P.out, hn, 1);
}
__global__ void __launch_bounds__(NTHR, 2) mega_kernel(Params P) {
    extern __shared__ __attribute__((aligned(16))) char smem[];
    cg::grid_group grid = cg::this_grid();
    volatile LDS_AS unsigned* st = (volatile LDS_AS unsigned*)(smem + LDS_BYTES - 16);
    if (threadIdx.x < 4) st[threadIdx.x] = 0u;
    __syncthreads();
    const XcdBarrier xb = xcd_barrier_post((unsigned*)(P.ws + OFF_CTL), st);
    phase0(P, smem);
    grid.sync();
    layer_body<0>(P, smem, xb, P.in[I_X]);
    layer_body<1>(P, smem, xb, P.out);
}

extern "C" void kernel_launch(void* const* d_in, const int* in_sizes, int n_in, void* d_out, int out_size, void* d_ws, size_t ws_size, hipStream_t stream) {
    static int grid_blocks = 0;
    if (grid_blocks == 0) {
        if (n_in != N_INPUTS || ws_size < OFF_END || out_size != T * 1024) { fprintf(stderr, "kernel_launch: unexpected sizes n_in=%d ws=%zu out=%d (need ws >= %zu)\n", n_in, ws_size, out_size, (size_t)OFF_END); grid_blocks = -1; return; }
        int dev = 0, cus = 0, per_cu = 0;
        if (hipGetDevice(&dev) != hipSuccess || hipDeviceGetAttribute(&cus, hipDeviceAttributeMultiprocessorCount, dev) != hipSuccess) { fprintf(stderr, "kernel_launch: device query failed\n"); grid_blocks = -1; return; }
        if (hipFuncSetAttribute((const void*)mega_kernel, hipFuncAttributeMaxDynamicSharedMemorySize, LDS_BYTES) != hipSuccess) { fprintf(stderr, "kernel_launch: hipFuncSetAttribute failed\n"); grid_blocks = -1; return; }
        if (hipOccupancyMaxActiveBlocksPerMultiprocessor(&per_cu, (const void*)mega_kernel, NTHR, LDS_BYTES) != hipSuccess || per_cu < 1) { fprintf(stderr, "kernel_launch: occupancy query says %d blocks/CU\n", per_cu); grid_blocks = -1; return; }
        grid_blocks = cus;
        fprintf(stderr, "kernel_launch: cus=%d per_cu=%d grid=%d\n", cus, per_cu, grid_blocks);
    }
    if (grid_blocks < 0) return;
    if (hipMemsetAsync((char*)d_ws + OFF_CTL, 0, CTL_BYTES, stream) != hipSuccess) { fprintf(stderr, "kernel_launch: memset failed\n"); return; }
    Params p; memset(&p, 0, sizeof p);
    for (int i = 0; i < N_INPUTS; ++i) p.in[i] = (const float*)d_in[i];
    p.out = (float*)d_out; p.ws = (char*)d_ws;
    void* args[] = {&p};
    hipError_t e = hipLaunchCooperativeKernel((const void*)mega_kernel, dim3(grid_blocks), dim3(NTHR), args, LDS_BYTES, stream);
    if (e != hipSuccess) fprintf(stderr, "kernel_launch: cooperative launch failed: %s (grid %d)\n", hipGetErrorString(e), grid_blocks);
}
```

```cpp
#include <hip/hip_runtime.h>
#include <stdint.h>
#include <stdio.h>
#include <string.h>
#include <hip/hip_cooperative_groups.h>
namespace cg = cooperative_groups;

typedef unsigned short bf16_t;
typedef short bf16x8 __attribute__((ext_vector_type(8)));
typedef float f32x4 __attribute__((ext_vector_type(4)));
typedef unsigned u32x4 __attribute__((ext_vector_type(4)));

constexpr int NB = 8, SEQ = 2048, DM = 1024, T = NB * SEQ, NL = 2;
constexpr int NP = 3456;
constexpr int NIN = 3340;
constexpr int C_AQ = 0, C_AF = 256, C_AI = 512, C_AG = 768, C_BQ = 1024, C_BK = 1280, C_BV = 1536, C_CX = 1792, C_CG = 2048,
              C_DQ = 2304, C_DK = 2560, C_DV = 2816, C_DZ = 3072, C_GATE = 3328;
constexpr int MEMLEN = 256;
constexpr int NEXP = 32, DEXP = 256;
constexpr float EPS = 1e-6f;

constexpr size_t al256(size_t x) { return (x + 255) & ~(size_t)255; }
constexpr size_t SZ_WIN = (size_t)NP * 1024 * 2, SZ_WOUT = (size_t)1024 * 1024 * 2, SZ_WMQ = (size_t)256 * 1024 * 2, SZ_WMKV = (size_t)512 * 1024 * 2,
                 SZ_WMO = (size_t)1024 * 256 * 2, SZ_WGU = (size_t)32 * 512 * 1024 * 2, SZ_WDN = (size_t)32 * 1024 * 256 * 2;
constexpr size_t OFF_WIN = 0;
constexpr size_t OFF_WOUT = OFF_WIN + NL * SZ_WIN;
constexpr size_t OFF_WMQ = OFF_WOUT + NL * SZ_WOUT;
constexpr size_t OFF_WMKV = OFF_WMQ + NL * SZ_WMQ;
constexpr size_t OFF_WMO = OFF_WMKV + NL * SZ_WMKV;
constexpr size_t OFF_WGU = OFF_WMO + NL * SZ_WMO;
constexpr size_t OFF_WDN = OFF_WGU + NL * SZ_WGU;
constexpr size_t OFF_HN = OFF_WDN + NL * SZ_WDN;
constexpr size_t OFF_PROJ = OFF_HN + (size_t)T * 1024 * 2;
constexpr size_t OFF_GATES = OFF_PROJ + (size_t)T * NP * 2;
constexpr size_t OFF_Y = OFF_GATES + (size_t)T * 16 * 4;
constexpr size_t OFF_XB = OFF_Y + (size_t)T * 1024 * 2;
constexpr size_t OFF_QM = OFF_XB + (size_t)T * 1024 * 4;
constexpr size_t OFF_OM = OFF_QM + (size_t)T * 256 * 2;
constexpr size_t OFF_KVM = OFF_OM + (size_t)T * 256 * 2;
constexpr size_t OFF_MEMN = OFF_KVM + (size_t)NL * 2048 * 512 * 2;
constexpr size_t OFF_FOXC = OFF_MEMN + (size_t)2048 * 1024 * 2;
constexpr size_t OFF_LRUA = OFF_FOXC + (size_t)NB * 4 * SEQ * 4;
constexpr size_t OFF_LRUU = OFF_LRUA + (size_t)T * 256 * 4;
constexpr size_t OFF_CNT = OFF_LRUU + (size_t)T * 256 * 4;
constexpr size_t OFF_LIST = OFF_CNT + 256;
constexpr size_t OFF_PGATE = OFF_LIST + (size_t)NEXP * T * 4;
constexpr size_t OFF_HL = OFF_PGATE + (size_t)2 * T * 4;
constexpr size_t OFF_HD = OFF_HL + (size_t)1024 * 4096 * 4;
constexpr size_t OFF_GDN = OFF_HD + (size_t)1024 * 64 * 4;
constexpr size_t OFF_GLAST = OFF_GDN + (size_t)1024 * 5 * 4096 * 2;
constexpr size_t OFF_LSUM = OFF_GLAST + 4096;
constexpr size_t OFF_CTL = OFF_LSUM + (size_t)2 * 256 * 256 * 4;
constexpr size_t CTL_BYTES = 16384;
constexpr int CTL_CNT_WORD = 3584;
constexpr size_t OFF_END = OFF_CTL + CTL_BYTES;
constexpr size_t OFF_ACT = OFF_PROJ;
constexpr size_t OFF_EO = OFF_PROJ + (size_t)2 * T * 256 * 2;
static_assert(OFF_EO + (size_t)2 * T * 1024 * 2 <= OFF_GATES, "overlay fits");

__device__ __forceinline__ float bf2f(bf16_t v) { return __uint_as_float(((unsigned)v) << 16); }
typedef __bf16 bf16x2_t __attribute__((ext_vector_type(2)));
__device__ __forceinline__ bf16_t f2bf(float f) { return __builtin_bit_cast(unsigned short, (__bf16)f); }
__device__ __forceinline__ unsigned pk2(float lo, float hi) { bf16x2_t v = {(__bf16)lo, (__bf16)hi}; return __builtin_bit_cast(unsigned, v); }
__device__ __forceinline__ float sigmoidf_(float x) { return 1.f / (1.f + __expf(-x)); }
__device__ __forceinline__ float siluf_(float x) { return x / (1.f + __expf(-x)); }
__device__ __forceinline__ float softplusf_(float x) { return x > 20.f ? x : log1pf(__expf(x)); }
__device__ __forceinline__ float logsigmoidf_(float x) { return x < 0.f ? x - log1pf(__expf(x)) : -log1pf(__expf(-x)); }
__device__ __forceinline__ float geluf_(float x) { float u = 0.7978845608028654f * (x + 0.044715f * x * x * x); return 0.5f * x * (1.f + tanhf(u)); }
__device__ __forceinline__ float wave_sum(float v) {
#pragma unroll
    for (int o = 1; o < 64; o <<= 1) v += __shfl_xor(v, o);
    return v;
}
__device__ __forceinline__ float rdlane(float v, int l) { return __int_as_float(__builtin_amdgcn_readlane(__float_as_int(v), l)); }

#define PROBE_MASK 0
#define GSYNC() xcd_barrier(xb)
#define REP(bit, ...) do { __VA_ARGS__; if (PROBE_MASK & (bit)) { GSYNC(); __VA_ARGS__; } } while (0)
constexpr int NTHR = 512;
constexpr int LDS_BYTES = 147456;
enum { I_X = 0, I_MEM, I_NORM_MIX, I_W_IN, I_HGRN_LB, I_FOX_FB, I_LRU_CONV_W, I_LRU_CONV_B, I_LRU_WA, I_LRU_BA, I_LRU_WX, I_LRU_BX, I_LRU_LAM, I_GDN_CONV_W, I_GDN_A_LOG,
       I_GDN_DT_BIAS, I_MIX_GAIN, I_W_OUT, I_NORM_MEM, I_NORM_MEMKV, I_W_MQ, I_W_MKV, I_W_MO, I_NORM_FFN, I_W_RG, I_B_RG, I_W_RE, I_B_RE, I_W_E_GU, I_W_E_DN, I_NORM_FINAL, N_INPUTS };
struct Params { const float* in[N_INPUTS]; float* out; char* ws; };
static_assert(sizeof(Params) == 8 * (N_INPUTS + 2), "no padding");

#define BLK_LOOP(it, n) for (int it = (int)blockIdx.x; it < (n); it += (int)gridDim.x)

__device__ __forceinline__ int rowmap_fn(int mode, int n) {
    if (mode == 1) {
        if (n < 1792) return n;
        if (n < 1796) return C_GATE + (n - 1792);
        if (n < 3076) return n - 4;
        if (n < 3084) return C_GATE + 4 + (n - 3076);
        return n - 12;
    } else if (mode == 2) {
        int j = n & 255; return (j >> 4) * 32 + ((n >= 256) ? 16 : 0) + (j & 15);
    }
    return n;
}
__device__ __forceinline__ void convT_tile(float* tile  , const float* __restrict__ src, int K, int N, bf16_t* __restrict__ dst, int mode, int ntn, int idx) {
    const int n0 = (idx % ntn) * 64, k0 = (idx / ntn) * 64;
    const int tx = threadIdx.x & 63, ty = threadIdx.x >> 6;
    __syncthreads();
#pragma unroll
    for (int i = 0; i < 8; ++i) {
        const int k = ty + i * 8, n = n0 + tx;
        tile[k * 65 + tx] = (n < N) ? src[(size_t)(k0 + k) * N + n] : 0.f;
    }
    __syncthreads();
    const int kx = threadIdx.x & 31, ny = threadIdx.x >> 5;
#pragma unroll
    for (int i = 0; i < 4; ++i) {
        const int nl = ny + i * 16, n = n0 + nl;
        if (n < N) {
            const int r = rowmap_fn(mode, n);
            *(unsigned*)(dst + (size_t)r * K + k0 + 2 * kx) = pk2(tile[(2 * kx) * 65 + nl], tile[(2 * kx + 1) * 65 + nl]);
        }
    }
}
__device__ __forceinline__ void rms_row_bf16(const float* __restrict__ xrow, const float* __restrict__ g, bf16_t* __restrict__ orow, int lane) {
    const f32x4* xr = (const f32x4*)xrow + lane;
    f32x4 v[4]; float s = 0.f;
#pragma unroll
    for (int j = 0; j < 4; ++j) { v[j] = xr[64 * j]; s += v[j].x * v[j].x + v[j].y * v[j].y + v[j].z * v[j].z + v[j].w * v[j].w; }
    const float rinv = rsqrtf(wave_sum(s) * (1.f / 1024.f) + EPS);
#pragma unroll
    for (int j = 0; j < 4; ++j) {
        const f32x4 gg = ((const f32x4*)g)[lane + 64 * j];
        uint2 o; o.x = pk2(v[j].x * rinv * gg.x, v[j].y * rinv * gg.y); o.y = pk2(v[j].z * rinv * gg.z, v[j].w * rinv * gg.w);
        *(uint2*)(orow + (lane + 64 * j) * 4) = o;
    }
}

constexpr int CT_PER_LAYER = 53 * 16 + 256 + 64 + 128 + 64;
constexpr int CT_GU = 64 * 128, CT_DN = 64 * 64;
constexpr int CT_TOTAL = NL * CT_PER_LAYER + CT_GU + CT_DN;

__device__ __forceinline__ void phase0(const Params& P, char* smem) {
    char* ws = P.ws;
    float* tile = (float*)smem;
    BLK_LOOP(it, CT_TOTAL) {
        int r = it;
        if (r < NL * CT_PER_LAYER) {
            const int l = r / CT_PER_LAYER; r -= l * CT_PER_LAYER;
            if (r < 848) { convT_tile(tile, P.in[I_W_IN] + (size_t)l * 1024 * NIN, 1024, NIN, (bf16_t*)(ws + OFF_WIN) + (size_t)l * NP * 1024, 1, 53, r); continue; } r -= 848;
            if (r < 256) { convT_tile(tile, P.in[I_W_OUT] + (size_t)l * 1024 * 1024, 1024, 1024, (bf16_t*)(ws + OFF_WOUT) + (size_t)l * 1024 * 1024, 0, 16, r); continue; } r -= 256;
            if (r < 64) { convT_tile(tile, P.in[I_W_MQ] + (size_t)l * 1024 * 256, 1024, 256, (bf16_t*)(ws + OFF_WMQ) + (size_t)l * 256 * 1024, 0, 4, r); continue; } r -= 64;
            if (r < 128) { convT_tile(tile, P.in[I_W_MKV] + (size_t)l * 1024 * 512, 1024, 512, (bf16_t*)(ws + OFF_WMKV) + (size_t)l * 512 * 1024, 0, 8, r); continue; } r -= 128;
            convT_tile(tile, P.in[I_W_MO] + (size_t)l * 256 * 1024, 256, 1024, (bf16_t*)(ws + OFF_WMO) + (size_t)l * 1024 * 256, 0, 16, r); continue;
        }
        r -= NL * CT_PER_LAYER;
        if (r < CT_GU) { const int m = r >> 7; convT_tile(tile, P.in[I_W_E_GU] + (size_t)m * 1024 * 512, 1024, 512, (bf16_t*)(ws + OFF_WGU) + (size_t)m * 512 * 1024, 2, 8, r & 127); continue; }
        r -= CT_GU;
        { const int m = r >> 6; convT_tile(tile, P.in[I_W_E_DN] + (size_t)m * 256 * 1024, 256, 1024, (bf16_t*)(ws + OFF_WDN) + (size_t)m * 1024 * 256, 0, 16, r & 63); }
    }
    for (int i = blockIdx.x * NTHR + threadIdx.x; i < NL * (NP - NIN) * 512; i += gridDim.x * NTHR) {
        const int l = i / ((NP - NIN) * 512), w = i % ((NP - NIN) * 512);
        ((unsigned*)((bf16_t*)(ws + OFF_WIN) + (size_t)l * NP * 1024 + (size_t)NIN * 1024))[w] = 0u;
    }
    const int gw = blockIdx.x * 8 + (threadIdx.x >> 6), ngw = gridDim.x * 8, lane = threadIdx.x & 63;
    for (int row = gw; row < T + NL * 2048; row += ngw) {
        if (row < T) rms_row_bf16(P.in[I_X] + (size_t)row * 1024, P.in[I_NORM_MIX], (bf16_t*)(ws + OFF_HN) + (size_t)row * 1024, lane);
        else { const int r2 = row - T, l = r2 >> 11, rr = r2 & 2047;
               rms_row_bf16(P.in[I_MEM] + (size_t)rr * 1024, P.in[I_NORM_MEMKV] + l * 1024, (bf16_t*)(ws + OFF_MEMN) + (size_t)r2 * 1024, lane); }
    }
}

constexpr int GLD = 72;
constexpr int GEMM_LDS = (256 + 128) * GLD * 2;
template <class RowPtr>
__device__ __forceinline__ void gemm_tile(char* smem, RowPtr rowptr, const bf16_t* __restrict__ Bt, int ldb, int n0, int K, f32x4 (&acc)[4][4]) {
    bf16_t* sA = (bf16_t*)smem; bf16_t* sB = sA + 256 * GLD;
    const int tid = threadIdx.x, lane = tid & 63, wave = tid >> 6, wm = wave >> 1, wn = wave & 1;
    const u32x4* ga[4]; const u32x4* gb[2];
#pragma unroll
    for (int i = 0; i < 4; ++i) { const int c = tid + i * 512, r = c >> 3, ch = c & 7; ga[i] = (const u32x4*)(rowptr(r) + ch * 8); }
#pragma unroll
    for (int i = 0; i < 2; ++i) { const int c = tid + i * 512, r = c >> 3, ch = c & 7; gb[i] = (const u32x4*)(Bt + (size_t)(n0 + r) * ldb + ch * 8); }
#pragma unroll
    for (int m = 0; m < 4; ++m)
#pragma unroll
        for (int n = 0; n < 4; ++n) acc[m][n] = (f32x4){0.f, 0.f, 0.f, 0.f};
    u32x4 ra[4], rb[2];
#pragma unroll
    for (int i = 0; i < 4; ++i) ra[i] = ga[i][0];
#pragma unroll
    for (int i = 0; i < 2; ++i) rb[i] = gb[i][0];
    const int nk = K / 64;
    for (int kt = 0; kt < nk; ++kt) {
        __syncthreads();
#pragma unroll
        for (int i = 0; i < 4; ++i) { const int c = tid + i * 512, r = c >> 3, ch = c & 7; *(u32x4*)(sA + r * GLD + ch * 8) = ra[i]; }
#pragma unroll
        for (int i = 0; i < 2; ++i) { const int c = tid + i * 512, r = c >> 3, ch = c & 7; *(u32x4*)(sB + r * GLD + ch * 8) = rb[i]; }
        __syncthreads();
        if (kt + 1 < nk) {
#pragma unroll
            for (int i = 0; i < 4; ++i) ra[i] = ga[i][(kt + 1) * 8];
#pragma unroll
            for (int i = 0; i < 2; ++i) rb[i] = gb[i][(kt + 1) * 8];
        }
#pragma unroll
        for (int kk = 0; kk < 2; ++kk) {
            bf16x8 af[4], bfr[4];
#pragma unroll
            for (int m = 0; m < 4; ++m) af[m] = *(const bf16x8*)(sA + (wm * 64 + m * 16 + (lane & 15)) * GLD + kk * 32 + (lane >> 4) * 8);
#pragma unroll
            for (int n = 0; n < 4; ++n) bfr[n] = *(const bf16x8*)(sB + (wn * 64 + n * 16 + (lane & 15)) * GLD + kk * 32 + (lane >> 4) * 8);
#pragma unroll
            for (int m = 0; m < 4; ++m)
#pragma unroll
                for (int n = 0; n < 4; ++n) acc[m][n] = __builtin_amdgcn_mfma_f32_16x16x32_bf16(bfr[n], af[m], acc[m][n], 0, 0, 0);
        }
    }
}
struct RowDirect { const bf16_t* A; int lda; int m0; __device__ __forceinline__ const bf16_t* operator()(int r) const { return A + (size_t)(m0 + r) * lda; } };
enum { EPI_INPROJ = 0, EPI_RESID = 1, EPI_BF16 = 2 };

__device__ __forceinline__ int vcu_id() { const int G = gridDim.x, bx = blockIdx.x; return (G % 8 == 0) ? (bx % 8) * (G / 8) + bx / 8 : bx; }

template <int EPI>
__device__ __forceinline__ void gemm_phase(char* smem, const bf16_t* A, int lda, const bf16_t* Bt, int ldb, int M, int N, int K, void* out, int ldo, const float* resid, float* gates) {
    const int ntn = N / 128, ntiles = (M / 256) * ntn;
    const int lane = threadIdx.x & 63, wave = threadIdx.x >> 6, wm = wave >> 1, wn = wave & 1;
    for (int tIdx = vcu_id(); tIdx < ntiles; tIdx += gridDim.x) {
        const int m0 = (tIdx / ntn) * 256, n0 = (tIdx % ntn) * 128;
        f32x4 acc[4][4];
        RowDirect rp{A, lda, m0};
        gemm_tile(smem, rp, Bt, ldb, n0, K, acc);
#pragma unroll
        for (int m = 0; m < 4; ++m)
#pragma unroll
            for (int n = 0; n < 4; ++n) {
                const int row = m0 + wm * 64 + m * 16 + (lane & 15), col = n0 + wn * 64 + n * 16 + (lane >> 4) * 4;
                const f32x4 v = acc[m][n];
                if (EPI == EPI_INPROJ) {
                    uint2 o; o.x = pk2(v.x, v.y); o.y = pk2(v.z, v.w);
                    *(uint2*)((bf16_t*)out + (size_t)row * ldo + col) = o;
                    if (col >= C_GATE && col < C_GATE + 16) *(f32x4*)(gates + (size_t)row * 16 + (col - C_GATE)) = v;
                } else if (EPI == EPI_RESID) {
                    const f32x4 r = *(const f32x4*)(resid + (size_t)row * ldo + col);
                    *(f32x4*)((float*)out + (size_t)row * ldo + col) = r + v;
                } else {
                    uint2 o; o.x = pk2(v.x, v.y); o.y = pk2(v.z, v.w);
                    *(uint2*)((bf16_t*)out + (size_t)row * ldo + col) = o;
                }
            }
    }
}

struct RowGather { const bf16_t* A; int lda; const int* ids; int shift; __device__ __forceinline__ const bf16_t* operator()(int r) const { return A + (size_t)(ids[r] >> shift) * lda; } };
template <int STAGE>
__device__ __forceinline__ void moe_phase(char* smem, const bf16_t* A, int lda, const bf16_t* Wt, size_t wstride, int ldb, int K, const int* cnt, const int* list, const float* pgate, bf16_t* out) {
    int* ids = (int*)(smem + GEMM_LDS);
    int* tpre = ids + 256;
    constexpr int NTN = (STAGE == 1) ? 4 : 8;
    __syncthreads();
    if (threadIdx.x == 0) { int a = 0; for (int i = 0; i < NEXP; ++i) { tpre[i] = a; a += (cnt[i] + 255) >> 8; } tpre[NEXP] = a; }
    __syncthreads();
    const int ntiles = tpre[NEXP] * NTN;
    const int lane = threadIdx.x & 63, wave = threadIdx.x >> 6, wm = wave >> 1, wn = wave & 1;
    for (int tIdx = vcu_id(); tIdx < ntiles; tIdx += gridDim.x) {
        const int mtg = tIdx / NTN, n0 = (tIdx % NTN) * 128;
        int e = 0;
        for (int i = 1; i < NEXP; ++i) if (tpre[i] <= mtg) e = i;
        const int mt = mtg - tpre[e];
        const int cn = cnt[e];
        __syncthreads();
        if (threadIdx.x < 256) { const int pos = mt * 256 + threadIdx.x; ids[threadIdx.x] = list[(size_t)e * T + (pos < cn ? pos : cn - 1)]; }
        __syncthreads();
        f32x4 acc[4][4];
        RowGather rp{A, lda, ids, STAGE == 1 ? 1 : 0};
        gemm_tile(smem, rp, Wt + (size_t)e * wstride, ldb, n0, K, acc);
#pragma unroll
        for (int m = 0; m < 4; ++m) {
            const int rl = wm * 64 + m * 16 + (lane & 15);
            if (mt * 256 + rl >= cn) continue;
            const int pid = ids[rl];
            if (STAGE == 1) {
                const float gt = pgate[pid];
#pragma unroll
                for (int np = 0; np < 2; ++np) {
                    const f32x4 g = acc[m][2 * np], u = acc[m][2 * np + 1];
                    const int j = (n0 + wn * 64 + np * 32) / 2 + (lane >> 4) * 4;
                    uint2 o; o.x = pk2(siluf_(g.x) * u.x * gt, siluf_(g.y) * u.y * gt); o.y = pk2(siluf_(g.z) * u.z * gt, siluf_(g.w) * u.w * gt);
                    *(uint2*)(out + (size_t)pid * DEXP + j) = o;
                }
            } else {
#pragma unroll
                for (int n = 0; n < 4; ++n) {
                    const f32x4 v = acc[m][n]; const int col = n0 + wn * 64 + n * 16 + (lane >> 4) * 4;
                    uint2 o; o.x = pk2(v.x, v.y); o.y = pk2(v.z, v.w);
                    *(uint2*)(out + (size_t)pid * 1024 + col) = o;
                }
            }
        }
    }
}

__device__ __forceinline__ void hgrn2_naive(const bf16_t* __restrict__ proj, const float* __restrict__ hgrn_lb, int layer, const float* __restrict__ mix_gain, bf16_t* __restrict__ y, int bh, int lane) {
    const int b = bh >> 2, h = bh & 3;
    float lbk = 0.f;
    if (layer == 1) { float a0 = hgrn_lb[h * 64 + lane], a1 = hgrn_lb[256 + h * 64 + lane]; lbk = 1.f / (1.f + __expf(a0 - a1)); }
    const float mg = mix_gain[C_AQ + h * 64 + lane];
    float S[64];
#pragma unroll
    for (int k = 0; k < 64; ++k) S[k] = 0.f;
    for (int t = 0; t < SEQ; ++t) {
        const bf16_t* pr = proj + (size_t)(b * SEQ + t) * NP + h * 64 + lane;
        const float qk = siluf_(bf2f(pr[C_AQ]));
        const float sg = sigmoidf_(bf2f(pr[C_AF]));
        const float f = lbk + (1.f - lbk) * sg, kk = (1.f - lbk) * (1.f - sg);
        const float iv = bf2f(pr[C_AI]);
        const float gv = bf2f(pr[C_AG]);
        float o = 0.f;
#pragma unroll
        for (int k = 0; k < 64; ++k) { S[k] = rdlane(f, k) * S[k] + rdlane(kk, k) * iv; o += rdlane(qk, k) * S[k]; }
        const float ms = wave_sum(o * o) * (1.f / 64.f);
        const float yv = o * rsqrtf(ms + EPS) * siluf_(gv) * mg;
        y[(size_t)(b * SEQ + t) * 1024 + 0 + h * 64 + lane] = f2bf(yv);
    }
}
__device__ __forceinline__ void gdn_naive(const bf16_t* __restrict__ proj, const float* __restrict__ gates, const float* __restrict__ conv_w  ,
                                          const float* __restrict__ a_log, const float* __restrict__ dt_bias, const float* __restrict__ mix_gain, bf16_t* __restrict__ y, int bh, int lane) {
    const int b = bh >> 2, h = bh & 3;
    float wq[4], wk[4], wv[4];
#pragma unroll
    for (int j = 0; j < 4; ++j) { wq[j] = conv_w[j * 768 + h * 64 + lane]; wk[j] = conv_w[j * 768 + 256 + h * 64 + lane]; wv[j] = conv_w[j * 768 + 512 + h * 64 + lane]; }
    float xq[3] = {0.f, 0.f, 0.f}, xk[3] = {0.f, 0.f, 0.f}, xv[3] = {0.f, 0.f, 0.f};
    const float Aexp = __expf(a_log[h]), dtb = dt_bias[h];
    const float mg = mix_gain[768 + h * 64 + lane];
    float S[64];
#pragma unroll
    for (int k = 0; k < 64; ++k) S[k] = 0.f;
    for (int t = 0; t < SEQ; ++t) {
        const size_t row = (size_t)(b * SEQ + t);
        const bf16_t* pr = proj + row * NP + h * 64 + lane;
        const float q0 = bf2f(pr[C_DQ]), k0 = bf2f(pr[C_DK]), v0 = bf2f(pr[C_DV]), zv = bf2f(pr[C_DZ]);
        float q = siluf_(wq[0] * xq[0] + wq[1] * xq[1] + wq[2] * xq[2] + wq[3] * q0);
        float k = siluf_(wk[0] * xk[0] + wk[1] * xk[1] + wk[2] * xk[2] + wk[3] * k0);
        float v = siluf_(wv[0] * xv[0] + wv[1] * xv[1] + wv[2] * xv[2] + wv[3] * v0);
        xq[0] = xq[1]; xq[1] = xq[2]; xq[2] = q0; xk[0] = xk[1]; xk[1] = xk[2]; xk[2] = k0; xv[0] = xv[1]; xv[1] = xv[2]; xv[2] = v0;
        q = q * rsqrtf(wave_sum(q * q) + EPS) * 0.125f;
        k = k * rsqrtf(wave_sum(k * k) + EPS);
        const float beta = sigmoidf_(gates[row * 16 + 4 + h]);
        const float g = -Aexp * softplusf_(gates[row * 16 + 8 + h] + dtb);
        const float eg = __expf(g);
        float r = 0.f;
#pragma unroll
        for (int i = 0; i < 64; ++i) { S[i] *= eg; r += rdlane(k, i) * S[i]; }
        const float dlt = beta * (v - r);
        float o = 0.f;
#pragma unroll
        for (int i = 0; i < 64; ++i) { S[i] += rdlane(k, i) * dlt; o += rdlane(q, i) * S[i]; }
        const float ms = wave_sum(o * o) * (1.f / 64.f);
        const float yv = o * rsqrtf(ms + EPS) * siluf_(zv) * mg;
        y[row * 1024 + 768 + h * 64 + lane] = f2bf(yv);
    }
}
__device__ __forceinline__ void fox_cumsum(const float* __restrict__ gates, const float* __restrict__ fb, float* __restrict__ cc, int bh, int lane) {
    const int b = bh >> 2, h = bh & 3;
    const float bias = fb[h];
    float carry = 0.f;
    for (int t0 = 0; t0 < SEQ; t0 += 64) {
        float v = logsigmoidf_(gates[(size_t)(b * SEQ + t0 + lane) * 16 + h] + bias);
#pragma unroll
        for (int o = 1; o < 64; o <<= 1) { float n = __shfl_up(v, o); if (lane >= o) v += n; }
        v += carry;
        cc[(size_t)(b * 4 + h) * SEQ + t0 + lane] = v;
        carry = __shfl(v, 63);
    }
}
__device__ __forceinline__ void lru_prep_task(float* xc  , const bf16_t* __restrict__ proj, const float* __restrict__ conv_w, const float* __restrict__ conv_b,
                                              const float* __restrict__ w_a, const float* __restrict__ b_a, const float* __restrict__ w_x, const float* __restrict__ b_x,
                                              const float* __restrict__ lam, float* __restrict__ a_out, float* __restrict__ u_out, int task, bool active) {
    const int c = threadIdx.x & 255, t0 = task * 16;
    if (active) {
        const float w0 = conv_w[c], w1 = conv_w[256 + c], w2 = conv_w[512 + c], w3 = conv_w[768 + c], cb = conv_b[c];
        for (int i = 0; i < 16; ++i) {
            const int t = t0 + i, s = t & (SEQ - 1);
            const bf16_t* pr = proj + (size_t)t * NP + C_CX + c;
            float acc = cb + w3 * bf2f(pr[0]);
            if (s >= 1) acc += w2 * bf2f(pr[-(ptrdiff_t)NP]);
            if (s >= 2) acc += w1 * bf2f(pr[-(ptrdiff_t)2 * NP]);
            if (s >= 3) acc += w0 * bf2f(pr[-(ptrdiff_t)3 * NP]);
            xc[i * 256 + c] = acc;
        }
    }
    __syncthreads();
    if (active) {
        const int h = c >> 6, jj = c & 63;
        float ra[16], rx[16];
#pragma unroll
        for (int i = 0; i < 16; ++i) { ra[i] = 0.f; rx[i] = 0.f; }
        for (int k = 0; k < 64; ++k) {
            const float wa = w_a[(h * 64 + k) * 64 + jj], wx = w_x[(h * 64 + k) * 64 + jj];
#pragma unroll
            for (int i = 0; i < 16; ++i) { const float xv = xc[i * 256 + h * 64 + k]; ra[i] += xv * wa; rx[i] += xv * wx; }
        }
        const float ba = b_a[c], bx = b_x[c], sp = softplusf_(-lam[c]);
#pragma unroll
        for (int i = 0; i < 16; ++i) {
            const float r = sigmoidf_(ra[i] + ba), ig = sigmoidf_(rx[i] + bx);
            const float log_a = -8.f * r * sp;
            const float a = __expf(log_a);
            const float u = sqrtf(-expm1f(2.f * log_a)) * (ig * xc[i * 256 + c]);
            a_out[(size_t)(t0 + i) * 256 + c] = a; u_out[(size_t)(t0 + i) * 256 + c] = u;
        }
    }
    __syncthreads();
}
__device__ __forceinline__ void lru_scan_task(const float* __restrict__ a_in, const float* __restrict__ u_in, const bf16_t* __restrict__ proj, const float* __restrict__ mix_gain, bf16_t* __restrict__ y, int b) {
    const int c = threadIdx.x;
    const float mg = mix_gain[512 + c];
    float hst = 0.f;
    for (int t = 0; t < SEQ; ++t) {
        const size_t row = (size_t)(b * SEQ + t);
        hst = a_in[row * 256 + c] * hst + u_in[row * 256 + c];
        const float yv = hst * geluf_(bf2f(proj[row * NP + C_CG + c]));
        const float ms = wave_sum(yv * yv) * (1.f / 64.f);
        y[row * 1024 + 512 + c] = f2bf(yv * rsqrtf(ms + EPS) * mg);
    }
}

typedef short s16x4 __attribute__((ext_vector_type(4)));
#define LDS_AS __attribute__((address_space(3)))
__device__ __forceinline__ bf16x8 frag_rm(const bf16_t* tile, int ld, int r0, int k0, int lane) { return *(const bf16x8*)(tile + (r0 + (lane & 15)) * ld + k0 + (lane >> 4) * 8); }
__device__ __forceinline__ s16x4 tr4(const bf16_t* tile, int ld, int rbase, int c0, int lane) {
    const bf16_t* p = tile + (rbase + ((lane & 15) >> 2)) * ld + c0 + 4 * (lane & 3);
    return __builtin_amdgcn_ds_read_tr16_b64_v4i16((LDS_AS s16x4*)p);
}
__device__ __forceinline__ bf16x8 frag_cm(const bf16_t* tile, int ld, int k0, int c0, int lane) {
    const s16x4 lo = tr4(tile, ld, k0 + (lane >> 4) * 8, c0, lane), hi = tr4(tile, ld, k0 + (lane >> 4) * 8 + 4, c0, lane);
    return (bf16x8){lo[0], lo[1], lo[2], lo[3], hi[0], hi[1], hi[2], hi[3]};
}
#define MFMA16(a, b, c) __builtin_amdgcn_mfma_f32_16x16x32_bf16((a), (b), (c), 0, 0, 0)
constexpr int TLD = 72;


#define XB_TMO      128
#define XB_XCNT(j)  (256  + 64 * (j))
#define XB_XSUB(j)  (1280 + 64 * (j))
#define XB_XGEN(j)  (2304 + 64 * (j))
#define XB_TOP      3328
#define XB_TOPGEN   3392
#define XCD_BAR_WORDS 3456
#define XB_SPIN_CAP (1u << 18)
__device__ __forceinline__ unsigned xb_ld(unsigned* p)              { return __hip_atomic_load(p, __ATOMIC_RELAXED, __HIP_MEMORY_SCOPE_AGENT); }
__device__ __forceinline__ unsigned xb_add(unsigned* p, unsigned v) { return __hip_atomic_fetch_add(p, v, __ATOMIC_RELAXED, __HIP_MEMORY_SCOPE_AGENT); }
__device__ __forceinline__ unsigned xb_xcc_id() { return (unsigned)__builtin_amdgcn_s_getreg((3 << 11) | 20) & 0xFu; }
#define XB_SPIN(cond, bar) do { unsigned _sp = 0; while (cond) { __builtin_amdgcn_s_sleep(1); \
    if ((++_sp & 255u) == 0u) { if (xb_ld(&(bar)[XB_TMO])) break; if (_sp > XB_SPIN_CAP) { atomicAdd(&(bar)[XB_TMO], 1u); break; } } } } while (0)
struct XcdBarrier { unsigned* bar; unsigned x; volatile LDS_AS unsigned* st; };
__device__ __forceinline__ XcdBarrier xcd_barrier_post(unsigned* bar, volatile LDS_AS unsigned* st) {
    XcdBarrier b; b.bar = bar; b.x = xb_xcc_id(); b.st = st;
    if (threadIdx.x == 0) (void)xb_add(&bar[XB_XCNT(b.x)], 1u);
    return b;
}
__device__ __forceinline__ void xcd_barrier_complete(unsigned* bar, unsigned x, unsigned& nloc, unsigned& nx) {
    const unsigned G = gridDim.x * gridDim.y * gridDim.z;
    unsigned sum, cnt, mine, sp = 0u;
    for (;;) {
        sum = 0u; cnt = 0u; mine = 0u;
#pragma unroll
        for (unsigned j = 0; j < 16; ++j) { const unsigned c = xb_ld(&bar[XB_XCNT(j)]); sum += c; cnt += (c > 0u) ? 1u : 0u; mine = (j == x) ? c : mine; }
        if (sum == G) break;
        __builtin_amdgcn_s_sleep(1);
        if ((++sp & 255u) == 0u) { if (xb_ld(&bar[XB_TMO])) break; if (sp > XB_SPIN_CAP) { atomicAdd(&bar[XB_TMO], 1u); break; } }
    }
    nloc = mine > 0u ? mine : 1u; nx = cnt > 0u ? cnt : 1u;
}
__device__ __forceinline__ void xcd_barrier(const XcdBarrier& b) {
    asm volatile("s_waitcnt vmcnt(0)" ::: "memory");
    __syncthreads();
    if (threadIdx.x == 0) {
        unsigned* bar = b.bar;
        __builtin_amdgcn_s_waitcnt(0);
        unsigned nloc = b.st[0], nx = b.st[1];
        if (nloc == 0u) { xcd_barrier_complete(bar, b.x, nloc, nx); b.st[0] = nloc; b.st[1] = nx; }
        const unsigned old = xb_add(&bar[XB_XSUB(b.x)], 1u);
        const unsigned gen = old / nloc;
        if (old + 1u == (gen + 1u) * nloc) {
            __builtin_amdgcn_fence(__ATOMIC_RELEASE, "agent");
            asm volatile("s_waitcnt vmcnt(0)" ::: "memory");
            const unsigned og = xb_add(&bar[XB_TOP], 1u);
            const unsigned tg = og / nx;
            if (og + 1u == (tg + 1u) * nx) xb_add(&bar[XB_TOPGEN], 1u);
            else XB_SPIN(xb_ld(&bar[XB_TOPGEN]) == tg, bar);
            __builtin_amdgcn_fence(__ATOMIC_ACQUIRE, "agent");
            xb_add(&bar[XB_XGEN(b.x)], 1u);
            asm volatile("s_waitcnt vmcnt(0)" ::: "memory");
        } else {
            XB_SPIN(xb_ld(&bar[XB_XGEN(b.x)]) == gen, bar);
            __builtin_amdgcn_fence(__ATOMIC_ACQUIRE, "agent");
            asm volatile("s_waitcnt vmcnt(0)" ::: "memory");
        }
    }
    __syncthreads();
}

template <bool MASK>
__device__ __forceinline__ void attn_compute_t(const bf16_t* cK, const bf16_t* cV, const float* cC, const bf16x8 (&qf)[2], f32x4 (&oacc)[4], float& mrun, float& lrun,
                                               float ct2, float scale2, int kt, int tq, int lane, int g) {
    f32x4 sacc[4];
#pragma unroll
    for (int n = 0; n < 4; ++n) {
        sacc[n] = (f32x4){0.f, 0.f, 0.f, 0.f};
#pragma unroll
        for (int kk = 0; kk < 2; ++kk) sacc[n] = MFMA16(frag_rm(cK, TLD, n * 16, kk * 32, lane), qf[kk], sacc[n]);
    }
    float mx = -INFINITY;
#pragma unroll
    for (int n = 0; n < 4; ++n) {
        const f32x4 cs = *(const f32x4*)(cC + n * 16 + 4 * g);
#pragma unroll
        for (int r = 0; r < 4; ++r) {
            float v = sacc[n][r] * scale2 + (ct2 - cs[r]);
            if (MASK) { if (kt * 64 + n * 16 + 4 * g + r > tq) v = -INFINITY; }
            sacc[n][r] = v; mx = fmaxf(mx, v);
        }
    }
    mx = fmaxf(mx, __shfl_xor(mx, 16)); mx = fmaxf(mx, __shfl_xor(mx, 32));
    const float mnew = fmaxf(mrun, mx);
    const float corr = __builtin_amdgcn_exp2f(mrun - mnew);
    float rs = 0.f;
#pragma unroll
    for (int n = 0; n < 4; ++n)
#pragma unroll
        for (int r = 0; r < 4; ++r) { const float p = __builtin_amdgcn_exp2f(sacc[n][r] - mnew); sacc[n][r] = p; rs += p; }
    rs += __shfl_xor(rs, 16); rs += __shfl_xor(rs, 32);
    lrun = lrun * corr + rs; mrun = mnew;
    bf16x8 pf[2];
#pragma unroll
    for (int kk = 0; kk < 2; ++kk) {
        const u32x4 pk = (u32x4){pk2(sacc[2 * kk][0], sacc[2 * kk][1]), pk2(sacc[2 * kk][2], sacc[2 * kk][3]), pk2(sacc[2 * kk + 1][0], sacc[2 * kk + 1][1]), pk2(sacc[2 * kk + 1][2], sacc[2 * kk + 1][3])};
        pf[kk] = __builtin_bit_cast(bf16x8, pk);
    }
#pragma unroll
    for (int n2 = 0; n2 < 4; ++n2) {
        oacc[n2] = oacc[n2] * corr;
#pragma unroll
        for (int kk = 0; kk < 2; ++kk) {
            const s16x4 lo = tr4(cV, TLD, (2 * kk) * 16 + 4 * g, n2 * 16, lane), hi = tr4(cV, TLD, (2 * kk + 1) * 16 + 4 * g, n2 * 16, lane);
            const bf16x8 vf = (bf16x8){lo[0], lo[1], lo[2], lo[3], hi[0], hi[1], hi[2], hi[3]};
            oacc[n2] = MFMA16(vf, pf[kk], oacc[n2]);
        }
    }
}
__device__ __forceinline__ void attn_compute(const bf16_t* cK, const bf16_t* cV, const float* cC, const bf16x8 (&qf)[2], f32x4 (&oacc)[4], float& mrun, float& lrun,
                                             float ct2, float scale2, int causal, int kt, int q0, int tq, int wave, int lane, int g) {
    const int r0 = q0 + wave * 16;
    if (causal && (kt * 64 > r0 + 15)) return;
    if (causal && (kt * 64 + 63 > r0)) attn_compute_t<true>(cK, cV, cC, qf, oacc, mrun, lrun, ct2, scale2, kt, tq, lane, g);
    else attn_compute_t<false>(cK, cV, cC, qf, oacc, mrun, lrun, ct2, scale2, kt, tq, lane, g);
}

__device__ __forceinline__ void attn_task(char* smem, const bf16_t* __restrict__ Q, int ldq, const bf16_t* __restrict__ Kp, int ldk, const bf16_t* __restrict__ Vp, int ldv, const float* __restrict__ bias,
                                          int nq_per_b, int nk_per_b, int causal, float scale, bf16_t* __restrict__ O, int ldo, const float* __restrict__ gain, int rms, int task) {
    bf16_t* sK = (bf16_t*)smem;
    bf16_t* sV = sK + 2 * 64 * TLD;
    float* sC = (float*)(sV + 2 * 64 * TLD);
    const int tid = threadIdx.x, lane = tid & 63, wave = tid >> 6, g = lane >> 4, li = lane & 15;
    const int nqt = nq_per_b / 128;
    const int qt = task % nqt, h = (task / nqt) & 3, b = task / (nqt * 4);
    const int q0 = qt * 128, tq = q0 + wave * 16 + li;
    const size_t qrow = (size_t)b * nq_per_b + tq;
    bf16x8 qf[2];
#pragma unroll
    for (int kk = 0; kk < 2; ++kk) qf[kk] = *(const bf16x8*)(Q + qrow * ldq + h * 64 + kk * 32 + g * 8);
    constexpr float LOG2E = 1.4426950408889634f;
    const float ct = bias ? bias[(size_t)(b * 4 + h) * nq_per_b + tq] * LOG2E : 0.f;
    const float scale2 = scale * LOG2E;
    const int nkt = causal ? (q0 + 128) / 64 : nk_per_b / 64;
    const int sr = tid >> 3, sc = tid & 7;
    const bf16_t* kg = Kp + ((size_t)b * nk_per_b + sr) * ldk + h * 64 + sc * 8;
    const bf16_t* vg = Vp + ((size_t)b * nk_per_b + sr) * ldv + h * 64 + sc * 8;
    const float* cg_ = bias ? bias + (size_t)(b * 4 + h) * nk_per_b : nullptr;
    u32x4 rkA, rvA, rkB, rvB; float rcA = 0.f, rcB = 0.f;
    {   const u32x4 rk = *(const u32x4*)kg, rv = *(const u32x4*)vg; const float rc = (cg_ && tid < 64) ? cg_[tid] * LOG2E : 0.f;
        __syncthreads();
        *(u32x4*)(sK + sr * TLD + sc * 8) = rk; *(u32x4*)(sV + sr * TLD + sc * 8) = rv; if (tid < 64) sC[tid] = rc; }
    rkA = *(const u32x4*)(kg + (size_t)64 * ldk); rvA = *(const u32x4*)(vg + (size_t)64 * ldv); rcA = (cg_ && tid < 64) ? cg_[64 + tid] * LOG2E : 0.f;
    __syncthreads();
    f32x4 oacc[4];
#pragma unroll
    for (int n = 0; n < 4; ++n) oacc[n] = (f32x4){0.f, 0.f, 0.f, 0.f};
    float mrun = -INFINITY, lrun = 0.f;
#define ATTN_ITER(kt, LK, LV, LC, WK, WV, WC) { \
        const int buf = (kt) & 1; \
        if ((kt) + 2 < nkt) { LK = *(const u32x4*)(kg + (size_t)((kt) + 2) * 64 * ldk); LV = *(const u32x4*)(vg + (size_t)((kt) + 2) * 64 * ldv); LC = (cg_ && tid < 64) ? cg_[((kt) + 2) * 64 + tid] * LOG2E : 0.f; } \
        attn_compute(sK + buf * 64 * TLD, sV + buf * 64 * TLD, sC + buf * 64, qf, oacc, mrun, lrun, ct, scale2, causal, (kt), q0, tq, wave, lane, g); \
        if ((kt) + 1 < nkt) { const int nb = buf ^ 1; *(u32x4*)(sK + nb * 64 * TLD + sr * TLD + sc * 8) = WK; *(u32x4*)(sV + nb * 64 * TLD + sr * TLD + sc * 8) = WV; if (tid < 64) sC[nb * 64 + tid] = WC; } \
        __syncthreads(); }
    for (int kt = 0; kt < nkt; kt += 2) {
        ATTN_ITER(kt, rkB, rvB, rcB, rkA, rvA, rcA)
        ATTN_ITER(kt + 1, rkA, rvA, rcA, rkB, rvB, rcB)
    }
#undef ATTN_ITER
    const float inv = 1.f / lrun;
    float ms = 0.f;
#pragma unroll
    for (int n = 0; n < 4; ++n) { oacc[n] = oacc[n] * inv; ms += oacc[n][0] * oacc[n][0] + oacc[n][1] * oacc[n][1] + oacc[n][2] * oacc[n][2] + oacc[n][3] * oacc[n][3]; }
    ms += __shfl_xor(ms, 16); ms += __shfl_xor(ms, 32);
    const float rinv = rms ? rsqrtf(ms * (1.f / 64.f) + EPS) : 1.f;
#pragma unroll
    for (int n = 0; n < 4; ++n) {
        const int d = n * 16 + 4 * g;
        f32x4 gg = (f32x4){1.f, 1.f, 1.f, 1.f};
        if (gain) gg = *(const f32x4*)(gain + h * 64 + d);
        uint2 o; o.x = pk2(oacc[n][0] * rinv * gg[0], oacc[n][1] * rinv * gg[1]); o.y = pk2(oacc[n][2] * rinv * gg[2], oacc[n][3] * rinv * gg[3]);
        *(uint2*)(O + qrow * ldo + h * 64 + d) = o;
    }
}


__device__ __forceinline__ void hgrn_scan(float* LF  , float* SEGT  , const bf16_t* __restrict__ prow  , const float* __restrict__ hgrn_lb, int layer, int h, float (&kk)[8]) {
    const int tid = threadIdx.x, t = tid >> 3, k8 = (tid & 7) * 8;
    const u32x4 raw = *(const u32x4*)(prow + (size_t)t * NP + C_AF + k8);
#pragma unroll
    for (int j = 0; j < 8; ++j) {
        const float fl = __uint_as_float((j & 1) ? (raw[j >> 1] & 0xffff0000u) : (raw[j >> 1] << 16));
        float lbk = 0.f;
        if (layer == 1) { const float a0 = hgrn_lb[h * 64 + k8 + j], a1 = hgrn_lb[256 + h * 64 + k8 + j]; lbk = 1.f / (1.f + __expf(a0 - a1)); }
        const float sg = sigmoidf_(fl);
        const float f = lbk + (1.f - lbk) * sg;
        kk[j] = (1.f - lbk) * (1.f - sg);
        LF[t * 65 + k8 + j] = __logf(f);
    }
    __syncthreads();
    { const int k = tid & 63, seg = tid >> 6; float run = 0.f;
#pragma unroll
      for (int i = 0; i < 8; ++i) { run += LF[(seg * 8 + i) * 65 + k]; LF[(seg * 8 + i) * 65 + k] = run; }
      SEGT[seg * 64 + k] = run; }
    __syncthreads();
    { const int k = tid & 63, seg = tid >> 6; float off = 0.f;
      for (int s2 = 0; s2 < seg; ++s2) off += SEGT[s2 * 64 + k];
#pragma unroll
      for (int i = 0; i < 8; ++i) LF[(seg * 8 + i) * 65 + k] += off; }
    __syncthreads();
}
__device__ __forceinline__ float bfx(const u32x4& raw, int j) { return __uint_as_float((j & 1) ? (raw[j >> 1] & 0xffff0000u) : (raw[j >> 1] << 16)); }

__device__ __forceinline__ void hgrn_local_task(char* smem, const bf16_t* __restrict__ proj, const float* __restrict__ hgrn_lb, int layer, float* __restrict__ HL, float* __restrict__ HD, int ch) {
    float* LF = (float*)smem; float* SEGT = LF + 64 * 65;
    bf16_t* sKd = (bf16_t*)(SEGT + 8 * 64); bf16_t* sV = sKd + 64 * TLD;
    const int tid = threadIdx.x, lane = tid & 63, wave = tid >> 6, g = lane >> 4, li = lane & 15;
    const int bh = ch >> 5, n = ch & 31, b = bh >> 2, h = bh & 3;
    const bf16_t* prow = proj + (size_t)(b * SEQ + n * 64) * NP + h * 64;
    const int t = tid >> 3, k8 = (tid & 7) * 8;
    __syncthreads();
    *(u32x4*)(sV + t * TLD + k8) = *(const u32x4*)(prow + (size_t)t * NP + C_AI + k8);
    float kk[8];
    hgrn_scan(LF, SEGT, prow, hgrn_lb, layer, h, kk);
    { u32x4 o;
#pragma unroll
      for (int j = 0; j < 8; j += 2) {
          const float e0 = kk[j] * __expf(LF[63 * 65 + k8 + j] - LF[t * 65 + k8 + j]), e1 = kk[j + 1] * __expf(LF[63 * 65 + k8 + j + 1] - LF[t * 65 + k8 + j + 1]);
          o[j >> 1] = pk2(e0, e1);
      }
      *(u32x4*)(sKd + t * TLD + k8) = o; }
    if (tid < 64) HD[(size_t)ch * 64 + tid] = __expf(LF[63 * 65 + tid]);
    __syncthreads();
#pragma unroll
    for (int i = 0; i < 2; ++i) {
        const int idx = wave * 2 + i, vt = idx >> 2, kt = idx & 3;
        f32x4 acc = (f32x4){0.f, 0.f, 0.f, 0.f};
#pragma unroll
        for (int ks = 0; ks < 2; ++ks) acc = MFMA16(frag_cm(sV, TLD, ks * 32, vt * 16, lane), frag_cm(sKd, TLD, ks * 32, kt * 16, lane), acc);
        *(f32x4*)(HL + (size_t)ch * 4096 + (kt * 16 + li) * 64 + vt * 16 + 4 * g) = acc;
    }
}

__device__ __forceinline__ void hgrn_out_task(char* smem, const bf16_t* __restrict__ proj, const float* __restrict__ hgrn_lb, int layer, const float* __restrict__ HL, const float* __restrict__ HD,
                                              const float* __restrict__ mix_gain, bf16_t* __restrict__ y, int ch) {
    float* LF = (float*)smem; float* SEGT = LF + 64 * 65; float* sMS = SEGT + 8 * 64;
    bf16_t* sST = (bf16_t*)(sMS + 128); bf16_t* sQ0 = sST + 64 * TLD; bf16_t* sQm = sQ0 + 64 * TLD; bf16_t* sKm = sQm + 64 * TLD; bf16_t* sV = sKm + 64 * TLD; bf16_t* sA = sV + 64 * TLD;
    const int tid = threadIdx.x, lane = tid & 63, wave = tid >> 6, g = lane >> 4, li = lane & 15;
    const int bh = ch >> 5, n = ch & 31, b = bh >> 2, h = bh & 3;
    const bf16_t* prow = proj + (size_t)(b * SEQ + n * 64) * NP + h * 64;
    const int t = tid >> 3, k8 = (tid & 7) * 8;
    __syncthreads();
    { const int v = tid & 63, kg = tid >> 6;
      float S[8];
#pragma unroll
      for (int j = 0; j < 8; ++j) S[j] = 0.f;
      const int ch0 = bh * 32;
      for (int m0 = 0; m0 < n; m0 += 4) {
          float Lv[4][8]; f32x4 Dv[4][2];
#pragma unroll
          for (int i = 0; i < 4; ++i) {
              const int m = (m0 + i < n) ? (m0 + i) : (n - 1);
              const float* Lm = HL + (size_t)(ch0 + m) * 4096 + (kg * 8) * 64 + v; const float* Dm = HD + (size_t)(ch0 + m) * 64 + kg * 8;
              Dv[i][0] = *(const f32x4*)Dm; Dv[i][1] = *(const f32x4*)(Dm + 4);
#pragma unroll
              for (int j = 0; j < 8; ++j) Lv[i][j] = Lm[j * 64];
          }
#pragma unroll
          for (int i = 0; i < 4; ++i) {
              if (m0 + i < n) {
#pragma unroll
                  for (int j = 0; j < 8; ++j) S[j] = Dv[i][j >> 2][j & 3] * S[j] + Lv[i][j];
              }
          }
      }
      u32x4 o; o[0] = pk2(S[0], S[1]); o[1] = pk2(S[2], S[3]); o[2] = pk2(S[4], S[5]); o[3] = pk2(S[6], S[7]);
      *(u32x4*)(sST + v * TLD + kg * 8) = o; }
    const u32x4 qraw = *(const u32x4*)(prow + (size_t)t * NP + C_AQ + k8);
    *(u32x4*)(sV + t * TLD + k8) = *(const u32x4*)(prow + (size_t)t * NP + C_AI + k8);
    float kk[8];
    hgrn_scan(LF, SEGT, prow, hgrn_lb, layer, h, kk);
    { u32x4 o0, om, ok;
#pragma unroll
      for (int j = 0; j < 8; j += 2) {
          float q0v[2], qmv[2], kmv[2];
#pragma unroll
          for (int e = 0; e < 2; ++e) {
              const float bt = LF[t * 65 + k8 + j + e], r = LF[31 * 65 + k8 + j + e], q = siluf_(bfx(qraw, j + e));
              q0v[e] = q * __expf(bt); qmv[e] = q * __expf(bt - r); kmv[e] = kk[j + e] * __expf(r - bt);
          }
          o0[j >> 1] = pk2(q0v[0], q0v[1]); om[j >> 1] = pk2(qmv[0], qmv[1]); ok[j >> 1] = pk2(kmv[0], kmv[1]);
      }
      *(u32x4*)(sQ0 + t * TLD + k8) = o0; *(u32x4*)(sQm + t * TLD + k8) = om; *(u32x4*)(sKm + t * TLD + k8) = ok; }
    __syncthreads();
#pragma unroll
    for (int i = 0; i < 2; ++i) {
        const int idx = wave * 2 + i, tt = idx >> 2, st = idx & 3;
        f32x4 acc = (f32x4){0.f, 0.f, 0.f, 0.f};
#pragma unroll
        for (int ks = 0; ks < 2; ++ks) acc = MFMA16(frag_rm(sKm, TLD, st * 16, ks * 32, lane), frag_rm(sQm, TLD, tt * 16, ks * 32, lane), acc);
        const int tq = tt * 16 + li, s0 = st * 16 + 4 * g;
        uint2 o; o.x = pk2(s0 <= tq ? acc[0] : 0.f, s0 + 1 <= tq ? acc[1] : 0.f); o.y = pk2(s0 + 2 <= tq ? acc[2] : 0.f, s0 + 3 <= tq ? acc[3] : 0.f);
        *(uint2*)(sA + tq * TLD + s0) = o;
    }
    __syncthreads();
    { const int tt = wave >> 1;
      f32x4 oacc[2]; float ms = 0.f;
#pragma unroll
      for (int i = 0; i < 2; ++i) {
          const int vt = (wave & 1) * 2 + i;
          f32x4 acc = (f32x4){0.f, 0.f, 0.f, 0.f};
#pragma unroll
          for (int ks = 0; ks < 2; ++ks) acc = MFMA16(frag_rm(sST, TLD, vt * 16, ks * 32, lane), frag_rm(sQ0, TLD, tt * 16, ks * 32, lane), acc);
#pragma unroll
          for (int ks = 0; ks < 2; ++ks) acc = MFMA16(frag_cm(sV, TLD, ks * 32, vt * 16, lane), frag_rm(sA, TLD, tt * 16, ks * 32, lane), acc);
          oacc[i] = acc; ms += acc[0] * acc[0] + acc[1] * acc[1] + acc[2] * acc[2] + acc[3] * acc[3];
      }
      ms += __shfl_xor(ms, 16); ms += __shfl_xor(ms, 32);
      if (g == 0) sMS[(tt * 16 + li) * 2 + (wave & 1)] = ms;
      __syncthreads();
      const int tq = tt * 16 + li;
      const float rinv = rsqrtf((sMS[tq * 2] + sMS[tq * 2 + 1]) * (1.f / 64.f) + EPS);
      const size_t row = (size_t)(b * SEQ + n * 64 + tq);
#pragma unroll
      for (int i = 0; i < 2; ++i) {
          const int v0 = ((wave & 1) * 2 + i) * 16 + 4 * g;
          const uint2 graw = *(const uint2*)(proj + row * NP + C_AG + h * 64 + v0);
          const f32x4 mgv = *(const f32x4*)(mix_gain + C_AQ + h * 64 + v0);
          const float g0 = __uint_as_float(graw.x << 16), g1 = __uint_as_float(graw.x & 0xffff0000u), g2 = __uint_as_float(graw.y << 16), g3 = __uint_as_float(graw.y & 0xffff0000u);
          uint2 o; o.x = pk2(oacc[i][0] * rinv * siluf_(g0) * mgv[0], oacc[i][1] * rinv * siluf_(g1) * mgv[1]);
          o.y = pk2(oacc[i][2] * rinv * siluf_(g2) * mgv[2], oacc[i][3] * rinv * siluf_(g3) * mgv[3]);
          *(uint2*)(y + row * 1024 + h * 64 + v0) = o;
      }
    }
}


__device__ __forceinline__ void gdn_prep_task(char* smem, const bf16_t* __restrict__ proj, const float* __restrict__ gates, const float* __restrict__ conv_w  ,
                                              const float* __restrict__ a_log, const float* __restrict__ dt_bias, bf16_t* __restrict__ gt_all, float* __restrict__ glast, int ch) {
    float* sG = (float*)smem; float* sBeta = sG + 64;
    float* RHS = sBeta + 64;
    float* sM = RHS + 64 * 132;
    bf16_t* sK = (bf16_t*)(sM + 64 * 68); bf16_t* sQ = sK + 64 * TLD;
    const int tid = threadIdx.x, lane = tid & 63, wave = tid >> 6, g = lane >> 4, li = lane & 15;
    const int bh = ch >> 5, n = ch & 31, b = bh >> 2, h = bh & 3;
    const int t = tid >> 3, d8 = (tid & 7) * 8;
    const size_t row0 = (size_t)(b * SEQ + n * 64);
    bf16_t* gt = gt_all + (size_t)ch * 5 * 4096;
    __syncthreads();
    float qn[8], kn[8], vv[8];
    {
        const int spos = n * 64 + t;
#pragma unroll
        for (int sec = 0; sec < 3; ++sec) {
            const int col = (sec == 0 ? C_DQ : (sec == 1 ? C_DK : C_DV)) + h * 64 + d8;
            float acc[8];
#pragma unroll
            for (int e = 0; e < 8; ++e) acc[e] = 0.f;
#pragma unroll
            for (int j = 0; j < 4; ++j) {
                if (spos - (3 - j) >= 0) {
                    const u32x4 raw = *(const u32x4*)(proj + (row0 + t - (3 - j)) * NP + col);
                    const f32x4 w0 = *(const f32x4*)(conv_w + j * 768 + sec * 256 + h * 64 + d8), w1 = *(const f32x4*)(conv_w + j * 768 + sec * 256 + h * 64 + d8 + 4);
#pragma unroll
                    for (int e = 0; e < 8; ++e) acc[e] += (e < 4 ? w0[e] : w1[e - 4]) * bfx(raw, e);
                }
            }
#pragma unroll
            for (int e = 0; e < 8; ++e) { const float sv = siluf_(acc[e]); if (sec == 0) qn[e] = sv; else if (sec == 1) kn[e] = sv; else vv[e] = sv; }
        }
        float sq = 0.f, sk = 0.f;
#pragma unroll
        for (int e = 0; e < 8; ++e) { sq += qn[e] * qn[e]; sk += kn[e] * kn[e]; }
        sq += __shfl_xor(sq, 1); sq += __shfl_xor(sq, 2); sq += __shfl_xor(sq, 4);
        sk += __shfl_xor(sk, 1); sk += __shfl_xor(sk, 2); sk += __shfl_xor(sk, 4);
        const float rq = rsqrtf(sq + EPS) * 0.125f, rk = rsqrtf(sk + EPS);
#pragma unroll
        for (int e = 0; e < 8; ++e) { qn[e] *= rq; kn[e] *= rk; }
    }
    if ((tid & 7) == 0) {
        const float* gr = gates + (row0 + t) * 16;
        sBeta[t] = sigmoidf_(gr[4 + h]);
        sG[t] = -__expf(a_log[h]) * softplusf_(gr[8 + h] + dt_bias[h]);
    }
    __syncthreads();
    if (wave == 0) {
        float v = sG[lane];
#pragma unroll
        for (int o = 1; o < 64; o <<= 1) { const float nb = __shfl_up(v, o); if (lane >= o) v += nb; }
        sG[lane] = v;
    }
    __syncthreads();
    {
        const float Gt = sG[t], Gl = sG[63], bt = sBeta[t];
        const float eG = __expf(Gt), eD = __expf(Gl - Gt);
        u32x4 ok, oq, oqd, okd;
#pragma unroll
        for (int e = 0; e < 8; e += 2) {
            ok[e >> 1] = pk2(kn[e], kn[e + 1]); oq[e >> 1] = pk2(qn[e], qn[e + 1]);
            oqd[e >> 1] = pk2(qn[e] * eG, qn[e + 1] * eG); okd[e >> 1] = pk2(kn[e] * eD, kn[e + 1] * eD);
        }
        *(u32x4*)(sK + t * TLD + d8) = ok; *(u32x4*)(sQ + t * TLD + d8) = oq;
        *(u32x4*)(gt + 2 * 4096 + t * 64 + d8) = oqd; *(u32x4*)(gt + 3 * 4096 + t * 64 + d8) = okd;
#pragma unroll
        for (int e = 0; e < 8; ++e) { RHS[t * 132 + d8 + e] = vv[e] * bt; RHS[t * 132 + 64 + d8 + e] = kn[e] * bt * eG; }
        if (tid == 0) glast[ch] = __expf(Gl);
    }
    __syncthreads();
#pragma unroll
    for (int i = 0; i < 2; ++i) {
        const int idx = wave * 2 + i, tt = idx >> 2, st = idx & 3;
        f32x4 am = (f32x4){0.f, 0.f, 0.f, 0.f}, aq = (f32x4){0.f, 0.f, 0.f, 0.f};
#pragma unroll
        for (int ks = 0; ks < 2; ++ks) {
            const bf16x8 kfs = frag_rm(sK, TLD, st * 16, ks * 32, lane), kft = frag_rm(sK, TLD, tt * 16, ks * 32, lane);
            am = MFMA16(kft, kfs, am);
            aq = MFMA16(kfs, frag_rm(sQ, TLD, tt * 16, ks * 32, lane), aq);
        }
        {   const int sx = st * 16 + li, t0 = tt * 16 + 4 * g; const float Gs = sG[sx];
            f32x4 mo;
#pragma unroll
            for (int r = 0; r < 4; ++r) { const int tq = t0 + r; mo[r] = (sx < tq) ? sBeta[tq] * am[r] * __expf(sG[tq] - Gs) : 0.f; }
            *(f32x4*)(sM + sx * 68 + t0) = mo; }
        {   const int tq = tt * 16 + li, s0 = st * 16 + 4 * g; const float Gt = sG[tq];
            float ao[4];
#pragma unroll
            for (int r = 0; r < 4; ++r) { const int sx = s0 + r; ao[r] = (sx <= tq) ? aq[r] * __expf(Gt - sG[sx]) : 0.f; }
            uint2 o; o.x = pk2(ao[0], ao[1]); o.y = pk2(ao[2], ao[3]);
            *(uint2*)(gt + 4 * 4096 + tq * 64 + s0) = o; }
    }
    __syncthreads();
    if (tid < 128) {
        float acc[64];
#pragma unroll
        for (int i = 0; i < 64; ++i) acc[i] = RHS[i * 132 + tid];
#pragma unroll
        for (int half = 0; half < 2; ++half) {
            const int base = half * 32;
            if (half == 1) {
#pragma unroll
                for (int sx = 0; sx < 32; sx += 2) {
                    f32x4 r0[8], r1[8];
#pragma unroll
                    for (int c = 0; c < 8; ++c) { r0[c] = *(const f32x4*)(sM + sx * 68 + 32 + c * 4); r1[c] = *(const f32x4*)(sM + (sx + 1) * 68 + 32 + c * 4); }
                    const float x0 = acc[sx], x1 = acc[sx + 1];
#pragma unroll
                    for (int tq = 0; tq < 32; ++tq) { acc[32 + tq] -= r0[tq >> 2][tq & 3] * x0; acc[32 + tq] -= r1[tq >> 2][tq & 3] * x1; }
                }
            }
            f32x4 cur[8];
#pragma unroll
            for (int c = 0; c < 8; ++c) cur[c] = *(const f32x4*)(sM + base * 68 + base + c * 4);
#pragma unroll
            for (int sx = 0; sx < 31; ++sx) {
                f32x4 nxt[8];
#pragma unroll
                for (int c = (sx + 2) >> 2; c < 8; ++c) nxt[c] = *(const f32x4*)(sM + (base + sx + 1) * 68 + base + c * 4);
                const float xs = acc[base + sx];
#pragma unroll
                for (int tq = sx + 1; tq < 32; ++tq) acc[base + tq] -= cur[tq >> 2][tq & 3] * xs;
#pragma unroll
                for (int c = (sx + 2) >> 2; c < 8; ++c) cur[c] = nxt[c];
            }
        }
        if (tid < 64) {
#pragma unroll
            for (int tt = 0; tt < 64; ++tt) gt[tt * 64 + tid] = f2bf(acc[tt]);
        } else {
#pragma unroll
            for (int tt = 0; tt < 64; ++tt) gt[4096 + tt * 64 + (tid - 64)] = f2bf(-acc[tt]);
        }
    }
}

__device__ __forceinline__ void gdn_scan_task(char* smem, const bf16_t* __restrict__ gt_all, const float* __restrict__ glast, const bf16_t* __restrict__ proj, const float* __restrict__ mix_gain,
                                              bf16_t* __restrict__ y, int bh) {
    bf16_t* sT = (bf16_t*)smem;
    bf16_t* sST = sT + 2 * 5 * 64 * TLD;
    bf16_t* sVn = sST + 2 * 64 * TLD;
    const int tid = threadIdx.x, lane = tid & 63, wave = tid >> 6, g = lane >> 4, li = lane & 15;
    const int b = bh >> 2, h = bh & 3;
    const int sr = tid >> 3, sc8 = (tid & 7) * 8;
    const bf16_t* gsrc = gt_all + (size_t)bh * 32 * 5 * 4096 + sr * 64 + sc8;
    __syncthreads();
    u32x4 regs[5];
#pragma unroll
    for (int i = 0; i < 5; ++i) regs[i] = *(const u32x4*)(gsrc + i * 4096);
#pragma unroll
    for (int i = 0; i < 5; ++i) *(u32x4*)(sT + i * 64 * TLD + sr * TLD + sc8) = regs[i];
    *(u32x4*)(sST + sr * TLD + sc8) = (u32x4){0u, 0u, 0u, 0u};
    f32x4 sacc[4];
#pragma unroll
    for (int i = 0; i < 4; ++i) sacc[i] = (f32x4){0.f, 0.f, 0.f, 0.f};
    __syncthreads();
    for (int n = 0; n < 32; ++n) {
        const int buf = n & 1;
        const bf16_t* cT = sT + buf * 5 * 64 * TLD;
        const bf16_t* sU = cT; const bf16_t* sWn = cT + 64 * TLD; const bf16_t* sQd = cT + 2 * 64 * TLD; const bf16_t* sKd = cT + 3 * 64 * TLD; const bf16_t* sAq = cT + 4 * 64 * TLD;
        const bf16_t* cST = sST + buf * 64 * TLD; bf16_t* nST = sST + (buf ^ 1) * 64 * TLD;
        if (n + 1 < 32) {
#pragma unroll
            for (int i = 0; i < 5; ++i) regs[i] = *(const u32x4*)(gsrc + (size_t)(n + 1) * 5 * 4096 + i * 4096);
        }
        const size_t rowz = (size_t)(b * SEQ + n * 64 + (wave & 3) * 16 + li);
        uint2 zraw[4];
        if (wave < 4) {
#pragma unroll
            for (int vt = 0; vt < 4; ++vt) zraw[vt] = *(const uint2*)(proj + rowz * NP + C_DZ + h * 64 + vt * 16 + 4 * g);
        }
#pragma unroll
        for (int i = 0; i < 2; ++i) {
            const int idx = wave * 2 + i, tt = idx >> 2, vt = idx & 3;
            const int tq = tt * 16 + li, v0 = vt * 16 + 4 * g;
            const uint2 uraw = *(const uint2*)(sU + tq * TLD + v0);
            f32x4 acc = (f32x4){__uint_as_float(uraw.x << 16), __uint_as_float(uraw.x & 0xffff0000u), __uint_as_float(uraw.y << 16), __uint_as_float(uraw.y & 0xffff0000u)};
#pragma unroll
            for (int ks = 0; ks < 2; ++ks) acc = MFMA16(frag_rm(cST, TLD, vt * 16, ks * 32, lane), frag_rm(sWn, TLD, tt * 16, ks * 32, lane), acc);
            uint2 o; o.x = pk2(acc[0], acc[1]); o.y = pk2(acc[2], acc[3]);
            *(uint2*)(sVn + tq * TLD + v0) = o;
        }
        __syncthreads();
        if (wave < 4) {
            const int tt = wave;
            f32x4 oacc[4]; float ms = 0.f;
#pragma unroll
            for (int vt = 0; vt < 4; ++vt) {
                f32x4 acc = (f32x4){0.f, 0.f, 0.f, 0.f};
#pragma unroll
                for (int ks = 0; ks < 2; ++ks) acc = MFMA16(frag_rm(cST, TLD, vt * 16, ks * 32, lane), frag_rm(sQd, TLD, tt * 16, ks * 32, lane), acc);
#pragma unroll
                for (int ks = 0; ks < 2; ++ks) acc = MFMA16(frag_cm(sVn, TLD, ks * 32, vt * 16, lane), frag_rm(sAq, TLD, tt * 16, ks * 32, lane), acc);
                oacc[vt] = acc; ms += acc[0] * acc[0] + acc[1] * acc[1] + acc[2] * acc[2] + acc[3] * acc[3];
            }
            ms += __shfl_xor(ms, 16); ms += __shfl_xor(ms, 32);
            const float rinv = rsqrtf(ms * (1.f / 64.f) + EPS);
#pragma unroll
            for (int vt = 0; vt < 4; ++vt) {
                const int v0 = vt * 16 + 4 * g;
                const f32x4 mgv = *(const f32x4*)(mix_gain + 768 + h * 64 + v0);
                const float z0 = __uint_as_float(zraw[vt].x << 16), z1 = __uint_as_float(zraw[vt].x & 0xffff0000u), z2 = __uint_as_float(zraw[vt].y << 16), z3 = __uint_as_float(zraw[vt].y & 0xffff0000u);
                uint2 o; o.x = pk2(oacc[vt][0] * rinv * siluf_(z0) * mgv[0], oacc[vt][1] * rinv * siluf_(z1) * mgv[1]);
                o.y = pk2(oacc[vt][2] * rinv * siluf_(z2) * mgv[2], oacc[vt][3] * rinv * siluf_(z3) * mgv[3]);
                *(uint2*)(y + rowz * 1024 + 768 + h * 64 + v0) = o;
            }
        } else {
            const int kt = wave - 4;
            const float gl = glast[bh * 32 + n];
#pragma unroll
            for (int vt = 0; vt < 4; ++vt) {
                f32x4 acc = sacc[vt] * gl;
#pragma unroll
                for (int ks = 0; ks < 2; ++ks) acc = MFMA16(frag_cm(sKd, TLD, ks * 32, kt * 16, lane), frag_cm(sVn, TLD, ks * 32, vt * 16, lane), acc);
                sacc[vt] = acc;
                uint2 o; o.x = pk2(acc[0], acc[1]); o.y = pk2(acc[2], acc[3]);
                *(uint2*)(nST + (vt * 16 + li) * TLD + kt * 16 + 4 * g) = o;
            }
        }
        if (n + 1 < 32) {
            bf16_t* nT = sT + (buf ^ 1) * 5 * 64 * TLD;
#pragma unroll
            for (int i = 0; i < 5; ++i) *(u32x4*)(nT + i * 64 * TLD + sr * TLD + sc8) = regs[i];
        }
        __syncthreads();
    }
}


constexpr int XLD = 264;
__device__ __forceinline__ void lru_local_task(char* smem, const bf16_t* __restrict__ proj, const float* __restrict__ conv_w, const float* __restrict__ conv_b,
                                               const float* __restrict__ w_a, const float* __restrict__ b_a, const float* __restrict__ w_x, const float* __restrict__ b_x,
                                               const float* __restrict__ lam, float* __restrict__ hl_out, float* __restrict__ ac_out, float* __restrict__ lsum, int task) {
    bf16_t* sX = (bf16_t*)smem;
    bf16_t* sW = sX + 64 * XLD;
    float* sAa = (float*)(sW + 2 * 64 * TLD);
    float* sU = sAa + 64 * 65;
    float* sSegA = sU + 64 * 65; float* sSegH = sSegA + 8 * 64;
    const int tid = threadIdx.x, lane = tid & 63, wave = tid >> 6, g = lane >> 4, li = lane & 15;
    const int b = task >> 5, n = task & 31;
    const size_t row0 = (size_t)(b * SEQ + n * 64);
    const int t = tid >> 3;
    __syncthreads();
    {
        const int spos = n * 64 + t;
#pragma unroll
        for (int i = 0; i < 4; ++i) {
            const int c8 = ((tid & 7) + 8 * i) * 8;
            float acc[8];
            { const f32x4 cb0 = *(const f32x4*)(conv_b + c8), cb1 = *(const f32x4*)(conv_b + c8 + 4);
#pragma unroll
              for (int e = 0; e < 8; ++e) acc[e] = e < 4 ? cb0[e] : cb1[e - 4]; }
#pragma unroll
            for (int j = 0; j < 4; ++j) {
                if (spos - (3 - j) >= 0) {
                    const u32x4 raw = *(const u32x4*)(proj + (row0 + t - (3 - j)) * NP + C_CX + c8);
                    const f32x4 w0 = *(const f32x4*)(conv_w + j * 256 + c8), w1 = *(const f32x4*)(conv_w + j * 256 + c8 + 4);
#pragma unroll
                    for (int e = 0; e < 8; ++e) acc[e] += (e < 4 ? w0[e] : w1[e - 4]) * bfx(raw, e);
                }
            }
            u32x4 o; o[0] = pk2(acc[0], acc[1]); o[1] = pk2(acc[2], acc[3]); o[2] = pk2(acc[4], acc[5]); o[3] = pk2(acc[6], acc[7]);
            *(u32x4*)(sX + t * XLD + c8) = o;
        }
    }
    for (int hh = 0; hh < 4; ++hh) {
        {
            const int i = tid >> 3, j8 = (tid & 7) * 8;
#pragma unroll
            for (int m = 0; m < 2; ++m) {
                const float* src = (m == 0 ? w_a : w_x) + (size_t)hh * 4096 + i * 64 + j8;
                const f32x4 v0 = *(const f32x4*)src, v1 = *(const f32x4*)(src + 4);
                u32x4 o; o[0] = pk2(v0[0], v0[1]); o[1] = pk2(v0[2], v0[3]); o[2] = pk2(v1[0], v1[1]); o[3] = pk2(v1[2], v1[3]);
                *(u32x4*)(sW + m * 64 * TLD + i * TLD + j8) = o;
            }
        }
        __syncthreads();
#pragma unroll
        for (int i2 = 0; i2 < 2; ++i2) {
            const int idx = wave * 2 + i2, tt = idx >> 2, jt = idx & 3;
            f32x4 ra = (f32x4){0.f, 0.f, 0.f, 0.f}, rx = (f32x4){0.f, 0.f, 0.f, 0.f};
#pragma unroll
            for (int ks = 0; ks < 2; ++ks) {
                const bf16x8 xf = frag_rm(sX + hh * 64, XLD, tt * 16, ks * 32, lane);
                ra = MFMA16(frag_cm(sW, TLD, ks * 32, jt * 16, lane), xf, ra);
                rx = MFMA16(frag_cm(sW + 64 * TLD, TLD, ks * 32, jt * 16, lane), xf, rx);
            }
            const int tq = tt * 16 + li, cl = jt * 16 + 4 * g, c = hh * 64 + cl;
            const f32x4 ba = *(const f32x4*)(b_a + c), bx = *(const f32x4*)(b_x + c), lm = *(const f32x4*)(lam + c);
            const uint2 xraw = *(const uint2*)(sX + tq * XLD + c);
            const float xc[4] = {__uint_as_float(xraw.x << 16), __uint_as_float(xraw.x & 0xffff0000u), __uint_as_float(xraw.y << 16), __uint_as_float(xraw.y & 0xffff0000u)};
#pragma unroll
            for (int r = 0; r < 4; ++r) {
                const float rr = sigmoidf_(ra[r] + ba[r]), ig = sigmoidf_(rx[r] + bx[r]);
                const float log_a = -8.f * rr * softplusf_(-lm[r]);
                sAa[tq * 65 + cl + r] = __expf(log_a);
                sU[tq * 65 + cl + r] = sqrtf(-expm1f(2.f * log_a)) * (ig * xc[r]);
            }
        }
        __syncthreads();
        const int cl = tid & 63, seg = tid >> 6;
        float Al[8], Hl[8];
        { float A = 1.f, H = 0.f;
#pragma unroll
          for (int i = 0; i < 8; ++i) { const float a = sAa[(seg * 8 + i) * 65 + cl], u = sU[(seg * 8 + i) * 65 + cl]; H = a * H + u; A *= a; Al[i] = A; Hl[i] = H; }
          sSegA[seg * 64 + cl] = A; sSegH[seg * 64 + cl] = H; }
        __syncthreads();
        { float Ac = 1.f, Hc = 0.f;
          for (int s2 = 0; s2 < seg; ++s2) { const float a = sSegA[s2 * 64 + cl]; Hc = a * Hc + sSegH[s2 * 64 + cl]; Ac *= a; }
#pragma unroll
          for (int i = 0; i < 8; ++i) {
              const size_t o = (row0 + seg * 8 + i) * 256 + hh * 64 + cl;
              const float hv = Hl[i] + Al[i] * Hc, av = Al[i] * Ac;
              hl_out[o] = hv; ac_out[o] = av;
              if (seg == 7 && i == 7) { lsum[(size_t)task * 256 + hh * 64 + cl] = av; lsum[(size_t)(256 + task) * 256 + hh * 64 + cl] = hv; }
          } }
        __syncthreads();
    }
}
__device__ __forceinline__ void lru_out_task(const float* __restrict__ hl_in, const float* __restrict__ ac_in, const float* __restrict__ lsum, const bf16_t* __restrict__ proj,
                                             const float* __restrict__ mix_gain, bf16_t* __restrict__ y, int task) {
    const int b = task >> 5, n = task & 31, c = threadIdx.x & 255, half = threadIdx.x >> 8;
    float Hc = 0.f;
    for (int m = 0; m < n; ++m) Hc = lsum[(size_t)(b * 32 + m) * 256 + c] * Hc + lsum[(size_t)(256 + b * 32 + m) * 256 + c];
    const float mg = mix_gain[512 + c];
    const size_t row0 = (size_t)(b * SEQ + n * 64 + half * 32);
#pragma unroll 4
    for (int i = 0; i < 32; ++i) {
        const size_t row = row0 + i;
        const float hv = hl_in[row * 256 + c] + ac_in[row * 256 + c] * Hc;
        const float yv = hv * geluf_(bf2f(proj[row * NP + C_CG + c]));
        const float ms = wave_sum(yv * yv) * (1.f / 64.f);
        y[row * 1024 + 512 + c] = f2bf(yv * rsqrtf(ms + EPS) * mg);
    }
}

__device__ __forceinline__ void router_phase(char* smem, const float* __restrict__ x, const float* __restrict__ g, const float* __restrict__ w_rg, const float* __restrict__ b_rg,
                                             const float* __restrict__ w_re, const float* __restrict__ b_re, bf16_t* __restrict__ hn, int* __restrict__ cnt, int* __restrict__ list, float* __restrict__ pgate) {
    float* sXg = (float*)smem;
    float* sWr = sXg + 64 * 132;
    float* sLog = sWr + 128 * 40;
    float* sRinv = sLog + 64 * 40;
    const int tid = threadIdx.x;
    BLK_LOOP(tile, T / 64) {
        const int t0 = tile * 64;
        const int stok = tid >> 3;
        const int ctok = tid & 63, eg = tid >> 6;
        float acc[5] = {0.f, 0.f, 0.f, 0.f, 0.f};
        float ss = 0.f;
        for (int kc = 0; kc < 8; ++kc) {
            __syncthreads();
#pragma unroll
            for (int i = 0; i < 4; ++i) {
                const int col = ((tid & 7) + 8 * i) * 4;
                const f32x4 xv = *(const f32x4*)(x + (size_t)(t0 + stok) * 1024 + kc * 128 + col);
                const f32x4 gv = *(const f32x4*)(g + kc * 128 + col);
                ss += xv[0] * xv[0] + xv[1] * xv[1] + xv[2] * xv[2] + xv[3] * xv[3];
                *(f32x4*)(sXg + stok * 132 + col) = xv * gv;
            }
            for (int idx = tid; idx < 128 * 40; idx += NTHR) {
                const int k = idx / 40, e = idx - k * 40;
                float wv = 0.f;
                if (e < 4) wv = w_rg[(size_t)(kc * 128 + k) * 4 + e]; else if (e < 36) wv = w_re[(size_t)(kc * 128 + k) * 32 + (e - 4)];
                sWr[idx] = wv;
            }
            __syncthreads();
#pragma unroll 2
            for (int k4 = 0; k4 < 128; k4 += 4) {
                const f32x4 hv = *(const f32x4*)(sXg + ctok * 132 + k4);
#pragma unroll
                for (int kk = 0; kk < 4; ++kk) {
                    const float* wp = sWr + (k4 + kk) * 40 + eg * 5;
#pragma unroll
                    for (int j = 0; j < 5; ++j) acc[j] += hv[kk] * wp[j];
                }
            }
        }
        ss += __shfl_xor(ss, 1); ss += __shfl_xor(ss, 2); ss += __shfl_xor(ss, 4);
        if ((tid & 7) == 0) sRinv[stok] = rsqrtf(ss * (1.f / 1024.f) + EPS);
#pragma unroll
        for (int j = 0; j < 5; ++j) sLog[ctok * 40 + eg * 5 + j] = acc[j];
        __syncthreads();
        if (tid < 64) {
            const int t = t0 + tid; const float rinv = sRinv[tid];
            float lg[4];
#pragma unroll
            for (int i = 0; i < 4; ++i) lg[i] = sLog[tid * 40 + i] * rinv + b_rg[i];
            int gs = 0; float gm = lg[0];
#pragma unroll
            for (int i = 1; i < 4; ++i) if (lg[i] > gm) { gm = lg[i]; gs = i; }
            float den = 0.f;
#pragma unroll
            for (int i = 0; i < 4; ++i) den += __expf(lg[i] - gm);
            const float pg = 1.f / den;
            int i0 = 0, i1 = -1; float m0 = -INFINITY, m1 = -INFINITY;
            for (int i = 0; i < 8; ++i) {
                const float v = sLog[tid * 40 + 4 + gs * 8 + i] * rinv + b_re[gs * 8 + i];
                if (v > m0) { m1 = m0; i1 = i0; m0 = v; i0 = i; } else if (v > m1) { m1 = v; i1 = i; }
            }
            const float e1 = __expf(m1 - m0); const float w0 = 1.f / (1.f + e1), w1 = e1 / (1.f + e1);
            const int ex0 = gs * 8 + i0, ex1 = gs * 8 + i1;
            const int pos0 = atomicAdd(&cnt[ex0], 1); list[(size_t)ex0 * T + pos0] = 2 * t; pgate[2 * t] = pg * w0;
            const int pos1 = atomicAdd(&cnt[ex1], 1); list[(size_t)ex1 * T + pos1] = 2 * t + 1; pgate[2 * t + 1] = pg * w1;
        }
        {
            const float rinv = sRinv[stok];
#pragma unroll 4
            for (int i = 0; i < 32; ++i) {
                const int col = ((tid & 7) + 8 * i) * 4;
                const f32x4 xv = *(const f32x4*)(x + (size_t)(t0 + stok) * 1024 + col);
                const f32x4 gv = *(const f32x4*)(g + col);
                uint2 o; o.x = pk2(xv[0] * gv[0] * rinv, xv[1] * gv[1] * rinv); o.y = pk2(xv[2] * gv[2] * rinv, xv[3] * gv[3] * rinv);
                *(uint2*)(hn + (size_t)(t0 + stok) * 1024 + col) = o;
            }
        }
    }
}

__device__ __forceinline__ void combine_phase(const float* x2, const bf16_t* __restrict__ eo, const float* __restrict__ g, float* xout, bf16_t* __restrict__ hn, int mode) {
    const int lane = threadIdx.x & 63;
    for (int t = blockIdx.x * 8 + (threadIdx.x >> 6); t < T; t += gridDim.x * 8) {
        f32x4 v[4]; float s = 0.f;
#pragma unroll
        for (int j = 0; j < 4; ++j) {
            const int c = (lane + 64 * j) * 4;
            v[j] = *(const f32x4*)(x2 + (size_t)t * 1024 + c);
            const uint2 e0 = *(const uint2*)(eo + (size_t)(2 * t) * 1024 + c), e1 = *(const uint2*)(eo + (size_t)(2 * t + 1) * 1024 + c);
            v[j].x += __uint_as_float(e0.x << 16) + __uint_as_float(e1.x << 16);
            v[j].y += __uint_as_float(e0.x & 0xffff0000u) + __uint_as_float(e1.x & 0xffff0000u);
            v[j].z += __uint_as_float(e0.y << 16) + __uint_as_float(e1.y << 16);
            v[j].w += __uint_as_float(e0.y & 0xffff0000u) + __uint_as_float(e1.y & 0xffff0000u);
            s += v[j].x * v[j].x + v[j].y * v[j].y + v[j].z * v[j].z + v[j].w * v[j].w;
        }
        const float rinv = rsqrtf(wave_sum(s) * (1.f / 1024.f) + EPS);
#pragma unroll
        for (int j = 0; j < 4; ++j) {
            const int c = (lane + 64 * j) * 4;
            const f32x4 gg = *(const f32x4*)(g + c);
            const f32x4 hv = v[j] * rinv * gg;
            if (mode == 0) {
                *(f32x4*)(xout + (size_t)t * 1024 + c) = v[j];
                uint2 o; o.x = pk2(hv.x, hv.y); o.y = pk2(hv.z, hv.w);
                *(uint2*)(hn + (size_t)t * 1024 + c) = o;
            } else {
                *(f32x4*)(xout + (size_t)t * 1024 + c) = hv;
            }
        }
    }
}

template <int l>
__device__ __forceinline__ void layer_body(const Params& P, char* smem, const XcdBarrier& xb, const float* xcur) {
    char* ws = P.ws;
    bf16_t* Wt_in = (bf16_t*)(ws + OFF_WIN); bf16_t* Wt_out = (bf16_t*)(ws + OFF_WOUT); bf16_t* Wt_mq = (bf16_t*)(ws + OFF_WMQ); bf16_t* Wt_mkv = (bf16_t*)(ws + OFF_WMKV);
    bf16_t* Wt_mo = (bf16_t*)(ws + OFF_WMO); bf16_t* Wt_gu = (bf16_t*)(ws + OFF_WGU); bf16_t* Wt_dn = (bf16_t*)(ws + OFF_WDN);
    bf16_t* hn = (bf16_t*)(ws + OFF_HN); bf16_t* proj = (bf16_t*)(ws + OFF_PROJ); float* gates = (float*)(ws + OFF_GATES); bf16_t* y = (bf16_t*)(ws + OFF_Y);
    float* XA = P.out; float* XB = (float*)(ws + OFF_XB);
    bf16_t* qm = (bf16_t*)(ws + OFF_QM); bf16_t* om = (bf16_t*)(ws + OFF_OM); bf16_t* kvm = (bf16_t*)(ws + OFF_KVM); bf16_t* memn = (bf16_t*)(ws + OFF_MEMN);
    float* foxc = (float*)(ws + OFF_FOXC); float* lrua = (float*)(ws + OFF_LRUA); float* lruu = (float*)(ws + OFF_LRUU);
    int* cnt_all = (int*)(ws + OFF_CTL) + CTL_CNT_WORD; int* list = (int*)(ws + OFF_LIST); float* pgate = (float*)(ws + OFF_PGATE);
    bf16_t* act = (bf16_t*)(ws + OFF_ACT); bf16_t* eo = (bf16_t*)(ws + OFF_EO);
    const int wave = threadIdx.x >> 6, lane = threadIdx.x & 63;


        float* x1 = (l == 0) ? XA : XB;
        float* x2 = (l == 0) ? XB : XA;
        int* cnt = cnt_all + 32 * l;
        const float* mg = P.in[I_MIX_GAIN] + l * 1024;
        REP(2, gemm_phase<EPI_INPROJ>(smem, hn, 1024, Wt_in + (size_t)l * NP * 1024, 1024, T, NP, 1024, proj, NP, nullptr, gates));
        if (l == 0) for (int l2 = 0; l2 < NL; ++l2)
            gemm_phase<EPI_BF16>(smem, memn + (size_t)l2 * 2048 * 1024, 1024, Wt_mkv + (size_t)l2 * 512 * 1024, 1024, 2048, 512, 1024, kvm + (size_t)l2 * 2048 * 512, 512, nullptr, nullptr);
        GSYNC();
        REP(4,         {
            const int bx = blockIdx.x;
            bf16_t* gtiles = (bf16_t*)(ws + OFF_GDN); float* glast = (float*)(ws + OFF_GLAST);
            if (bx < 32 && wave == 1) fox_cumsum(gates, P.in[I_FOX_FB] + l * 4, foxc, bx, lane);
            BLK_LOOP(ch, 1024) gdn_prep_task(smem, proj, gates, P.in[I_GDN_CONV_W] + l * 4 * 768, P.in[I_GDN_A_LOG] + l * 4, P.in[I_GDN_DT_BIAS] + l * 4, gtiles, glast, ch);
            BLK_LOOP(ch, 1024) hgrn_local_task(smem, proj, P.in[I_HGRN_LB], l, (float*)(ws + OFF_HL), (float*)(ws + OFF_HD), ch);
            BLK_LOOP(task, 256) lru_local_task(smem, proj, P.in[I_LRU_CONV_W] + l * 1024, P.in[I_LRU_CONV_B] + l * 256, P.in[I_LRU_WA] + l * 16384, P.in[I_LRU_BA] + l * 256,
                                               P.in[I_LRU_WX] + l * 16384, P.in[I_LRU_BX] + l * 256, P.in[I_LRU_LAM] + l * 256, lrua, lruu, (float*)(ws + OFF_LSUM), task);
        });
        GSYNC();
        REP(8,         {
            const int natt = (SEQ / 128) * 4 * NB;
            const int bx = blockIdx.x, nfree = (int)gridDim.x - 32;
            if (bx < 32) gdn_scan_task(smem, (const bf16_t*)(ws + OFF_GDN), (const float*)(ws + OFF_GLAST), proj, mg, y, bx);
            else {
                for (int r = 0; r * nfree < natt; ++r) {
                    const int i = r * nfree + ((r & 1) ? (nfree - 1 - (bx - 32)) : (bx - 32));
                    if (i >= natt) continue;
                    const int qt = 15 - (i >> 5), bh = i & 31;
                    attn_task(smem, proj + C_BQ, NP, proj + C_BK, NP, proj + C_BV, NP, foxc, SEQ, SEQ, 1, 0.125f, y + 256, 1024, mg + 256, 1, (bh * 16) + qt);
                }
                for (int i = bx - 32; i < 1024; i += nfree) {
                    const int ch = (i & 31) * 32 + (31 - (i >> 5));
                    hgrn_out_task(smem, proj, P.in[I_HGRN_LB], l, (const float*)(ws + OFF_HL), (const float*)(ws + OFF_HD), mg, y, ch);
                }
                for (int i = bx - 32; i < 256; i += nfree) lru_out_task(lrua, lruu, (const float*)(ws + OFF_LSUM), proj, mg, y, i);
            }
        });
        GSYNC();
        REP(16, gemm_phase<EPI_RESID>(smem, y, 1024, Wt_out + (size_t)l * 1024 * 1024, 1024, T, 1024, 1024, x1, 1024, xcur, nullptr));
        GSYNC();
        REP(32, for (int row = blockIdx.x * 8 + wave; row < T; row += gridDim.x * 8) rms_row_bf16(x1 + (size_t)row * 1024, P.in[I_NORM_MEM] + l * 1024, hn + (size_t)row * 1024, lane));
        GSYNC();
        REP(64, gemm_phase<EPI_BF16>(smem, hn, 1024, Wt_mq + (size_t)l * 256 * 1024, 1024, T, 256, 1024, qm, 256, nullptr, nullptr));
        GSYNC();
        { const bf16_t* kv = kvm + (size_t)l * 2048 * 512;
          REP(128, BLK_LOOP(task, (SEQ / 128) * 4 * NB) attn_task(smem, qm, 256, kv, 512, kv + 256, 512, nullptr, SEQ, MEMLEN, 0, 0.125f, om, 256, nullptr, 0, task)); }
        GSYNC();
        REP(256, gemm_phase<EPI_RESID>(smem, om, 256, Wt_mo + (size_t)l * 1024 * 256, 256, T, 1024, 256, x2, 1024, x1, nullptr));
        GSYNC();
        router_phase(smem, x2, P.in[I_NORM_FFN] + l * 1024, P.in[I_W_RG] + l * 4096, P.in[I_B_RG] + l * 4, P.in[I_W_RE] + l * 32768, P.in[I_B_RE] + l * 32, hn, cnt, list, pgate);
        GSYNC();
        REP(512, moe_phase<1>(smem, hn, 1024, Wt_gu + (size_t)l * 32 * 512 * 1024, (size_t)512 * 1024, 1024, 1024, cnt, list, pgate, act));
        GSYNC();
        REP(1024, moe_phase<2>(smem, act, 256, Wt_dn + (size_t)l * 32 * 1024 * 256, (size_t)1024 * 256, 256, 256, cnt, list, pgate, eo));
        if (PROBE_MASK & 2048) { for (int i = 0; i < 10; ++i) GSYNC(); }
        GSYNC();
        if (l == 0) { combine_phase(x2, eo, P.in[I_NORM_MIX] + 1024, XA, hn, 0); GSYNC(); }
        else combine_phase(x2, eo, P.in[I_NORM_FINAL], P.out, hn, 1);
}
__global__ void __launch_bounds__(NTHR, 2) mega_kernel(Params P) {
    extern __shared__ __attribute__((aligned(16))) char smem[];
    cg::grid_group grid = cg::this_grid();
    volatile LDS_AS unsigned* st = (volatile LDS_AS unsigned*)(smem + LDS_BYTES - 16);
    if (threadIdx.x < 4) st[threadIdx.x] = 0u;
    __syncthreads();
    const XcdBarrier xb = xcd_barrier_post((unsigned*)(P.ws + OFF_CTL), st);
    phase0(P, smem);
    grid.sync();
    layer_body<0>(P, smem, xb, P.in[I_X]);
    layer_body<1>(P, smem, xb, P.out);
}

extern "C" void kernel_launch(void* const* d_in, const int* in_sizes, int n_in, void* d_out, int out_size, void* d_ws, size_t ws_size, hipStream_t stream) {
    static int grid_blocks = 0;
    if (grid_blocks == 0) {
        if (n_in != N_INPUTS || ws_size < OFF_END || out_size != T * 1024) { fprintf(stderr, "kernel_launch: unexpected sizes n_in=%d ws=%zu out=%d (need ws >= %zu)\n", n_in, ws_size, out_size, (size_t)OFF_END); grid_blocks = -1; return; }
        int dev = 0, cus = 0, per_cu = 0;
        if (hipGetDevice(&dev) != hipSuccess || hipDeviceGetAttribute(&cus, hipDeviceAttributeMultiprocessorCount, dev) != hipSuccess) { fprintf(stderr, "kernel_launch: device query failed\n"); grid_blocks = -1; return; }
        if (hipFuncSetAttribute((const void*)mega_kernel, hipFuncAttributeMaxDynamicSharedMemorySize, LDS_BYTES) != hipSuccess) { fprintf(stderr, "kernel_launch: hipFuncSetAttribute failed\n"); grid_blocks = -1; return; }
        if (hipOccupancyMaxActiveBlocksPerMultiprocessor(&per_cu, (const void*)mega_kernel, NTHR, LDS_BYTES) != hipSuccess || per_cu < 1) { fprintf(stderr, "kernel_launch: occupancy query says %d blocks/CU\n", per_cu); grid_blocks = -1; return; }
        grid_blocks = cus;
        fprintf(stderr, "kernel_launch: cus=%d per_cu=%d grid=%d\n", cus, per_cu, grid_blocks);
    }
    if (grid_blocks < 0) return;
    if (hipMemsetAsync((char*)d_ws + OFF_CTL, 0, CTL_BYTES, stream) != hipSuccess) { fprintf(stderr, "kernel_launch: memset failed\n"); return; }
    Params p; memset(&p, 0, sizeof p);
    for (int i = 0; i < N_INPUTS; ++i) p.in[i] = (const float*)d_in[i];
    p.out = (float*)d_out; p.ws = (char*)d_ws;
    void* args[] = {&p};
    hipError_t e = hipLaunchCooperativeKernel((const void*)mega_kernel, dim3(grid_blocks), dim3(NTHR), args, LDS_BYTES, stream);
    if (e != hipSuccess) fprintf(stderr, "kernel_launch: cooperative launch failed: %s (grid %d)\n", hipGetErrorString(e), grid_blocks);
}
```

```cpp
#include <hip/hip_runtime.h>
#include <stdint.h>
#include <stdio.h>
#include <string.h>
#include <hip/hip_cooperative_groups.h>
namespace cg = cooperative_groups;

typedef unsigned short bf16_t;
typedef short bf16x8 __attribute__((ext_vector_type(8)));
typedef float f32x4 __attribute__((ext_vector_type(4)));
typedef unsigned u32x4 __attribute__((ext_vector_type(4)));

constexpr int NB = 8, SEQ = 2048, DM = 1024, T = NB * SEQ, NL = 2;
constexpr int NP = 3456;
constexpr int NIN = 3340;
constexpr int C_AQ = 0, C_AF = 256, C_AI = 512, C_AG = 768, C_BQ = 1024, C_BK = 1280, C_BV = 1536, C_CX = 1792, C_CG = 2048,
              C_DQ = 2304, C_DK = 2560, C_DV = 2816, C_DZ = 3072, C_GATE = 3328;
constexpr int MEMLEN = 256;
constexpr int NEXP = 32, DEXP = 256;
constexpr float EPS = 1e-6f;

constexpr size_t al256(size_t x) { return (x + 255) & ~(size_t)255; }
constexpr size_t SZ_WIN = (size_t)NP * 1024 * 2, SZ_WOUT = (size_t)1024 * 1024 * 2, SZ_WMQ = (size_t)256 * 1024 * 2, SZ_WMKV = (size_t)512 * 1024 * 2,
                 SZ_WMO = (size_t)1024 * 256 * 2, SZ_WGU = (size_t)32 * 512 * 1024 * 2, SZ_WDN = (size_t)32 * 1024 * 256 * 2;
constexpr size_t OFF_WIN = 0;
constexpr size_t OFF_WOUT = OFF_WIN + NL * SZ_WIN;
constexpr size_t OFF_WMQ = OFF_WOUT + NL * SZ_WOUT;
constexpr size_t OFF_WMKV = OFF_WMQ + NL * SZ_WMQ;
constexpr size_t OFF_WMO = OFF_WMKV + NL * SZ_WMKV;
constexpr size_t OFF_WGU = OFF_WMO + NL * SZ_WMO;
constexpr size_t OFF_WDN = OFF_WGU + NL * SZ_WGU;
constexpr size_t OFF_HN = OFF_WDN + NL * SZ_WDN;
constexpr size_t OFF_PROJ = OFF_HN + (size_t)T * 1024 * 2;
constexpr size_t OFF_GATES = OFF_PROJ + (size_t)T * NP * 2;
constexpr size_t OFF_Y = OFF_GATES + (size_t)T * 16 * 4;
constexpr size_t OFF_XB = OFF_Y + (size_t)T * 1024 * 2;
constexpr size_t OFF_QM = OFF_XB + (size_t)T * 1024 * 4;
constexpr size_t OFF_OM = OFF_QM + (size_t)T * 256 * 2;
constexpr size_t OFF_KVM = OFF_OM + (size_t)T * 256 * 2;
constexpr size_t OFF_MEMN = OFF_KVM + (size_t)NL * 2048 * 512 * 2;
constexpr size_t OFF_FOXC = OFF_MEMN + (size_t)2048 * 1024 * 2;
constexpr size_t OFF_LRUA = OFF_FOXC + (size_t)NB * 4 * SEQ * 4;
constexpr size_t OFF_LRUU = OFF_LRUA + (size_t)T * 256 * 4;
constexpr size_t OFF_CNT = OFF_LRUU + (size_t)T * 256 * 4;
constexpr size_t OFF_LIST = OFF_CNT + 256;
constexpr size_t OFF_PGATE = OFF_LIST + (size_t)NEXP * T * 4;
constexpr size_t OFF_HL = OFF_PGATE + (size_t)2 * T * 4;
constexpr size_t OFF_HD = OFF_HL + (size_t)1024 * 4096 * 4;
constexpr size_t OFF_GDN = OFF_HD + (size_t)1024 * 64 * 4;
constexpr size_t OFF_GLAST = OFF_GDN + (size_t)1024 * 5 * 4096 * 2;
constexpr size_t OFF_LSUM = OFF_GLAST + 4096;
constexpr size_t OFF_HS = OFF_LSUM + (size_t)2 * 256 * 256 * 4;
constexpr size_t OFF_LCAR = OFF_HS + (size_t)1024 * 4096 * 2;
constexpr size_t OFF_CTL = OFF_LCAR + (size_t)256 * 256 * 4;
constexpr size_t CTL_BYTES = 16384;
constexpr int CTL_CNT_WORD = 3584;
constexpr size_t OFF_END = OFF_CTL + CTL_BYTES;
constexpr size_t OFF_ACT = OFF_PROJ;
constexpr size_t OFF_EO = OFF_PROJ + (size_t)2 * T * 256 * 2;
static_assert(OFF_EO + (size_t)2 * T * 1024 * 2 <= OFF_GATES, "overlay fits");

__device__ __forceinline__ float bf2f(bf16_t v) { return __uint_as_float(((unsigned)v) << 16); }
typedef __bf16 bf16x2_t __attribute__((ext_vector_type(2)));
__device__ __forceinline__ bf16_t f2bf(float f) { return __builtin_bit_cast(unsigned short, (__bf16)f); }
__device__ __forceinline__ unsigned pk2(float lo, float hi) { bf16x2_t v = {(__bf16)lo, (__bf16)hi}; return __builtin_bit_cast(unsigned, v); }
__device__ __forceinline__ float sigmoidf_(float x) { return 1.f / (1.f + __expf(-x)); }
__device__ __forceinline__ float siluf_(float x) { return x / (1.f + __expf(-x)); }
__device__ __forceinline__ float softplusf_(float x) { return x > 20.f ? x : log1pf(__expf(x)); }
__device__ __forceinline__ float logsigmoidf_(float x) { return x < 0.f ? x - log1pf(__expf(x)) : -log1pf(__expf(-x)); }
__device__ __forceinline__ float geluf_(float x) { float u = 0.7978845608028654f * (x + 0.044715f * x * x * x); return 0.5f * x * (1.f + tanhf(u)); }
__device__ __forceinline__ float wave_sum(float v) {
#pragma unroll
    for (int o = 1; o < 64; o <<= 1) v += __shfl_xor(v, o);
    return v;
}
__device__ __forceinline__ float rdlane(float v, int l) { return __int_as_float(__builtin_amdgcn_readlane(__float_as_int(v), l)); }

#define PROBE_MASK 0
#define GSYNC() xcd_barrier(xb)
#define REP(bit, ...) do { __VA_ARGS__; if (PROBE_MASK & (bit)) { GSYNC(); __VA_ARGS__; } } while (0)
constexpr int NTHR = 512;
constexpr int LDS_BYTES = 147456;
enum { I_X = 0, I_MEM, I_NORM_MIX, I_W_IN, I_HGRN_LB, I_FOX_FB, I_LRU_CONV_W, I_LRU_CONV_B, I_LRU_WA, I_LRU_BA, I_LRU_WX, I_LRU_BX, I_LRU_LAM, I_GDN_CONV_W, I_GDN_A_LOG,
       I_GDN_DT_BIAS, I_MIX_GAIN, I_W_OUT, I_NORM_MEM, I_NORM_MEMKV, I_W_MQ, I_W_MKV, I_W_MO, I_NORM_FFN, I_W_RG, I_B_RG, I_W_RE, I_B_RE, I_W_E_GU, I_W_E_DN, I_NORM_FINAL, N_INPUTS };
struct Params { const float* in[N_INPUTS]; float* out; char* ws; };
static_assert(sizeof(Params) == 8 * (N_INPUTS + 2), "no padding");

#define BLK_LOOP(it, n) for (int it = (int)blockIdx.x; it < (n); it += (int)gridDim.x)

__device__ __forceinline__ int rowmap_fn(int mode, int n) {
    if (mode == 1) {
        if (n < 1792) return n;
        if (n < 1796) return C_GATE + (n - 1792);
        if (n < 3076) return n - 4;
        if (n < 3084) return C_GATE + 4 + (n - 3076);
        return n - 12;
    } else if (mode == 2) {
        int j = n & 255; return (j >> 4) * 32 + ((n >= 256) ? 16 : 0) + (j & 15);
    }
    return n;
}
__device__ __forceinline__ void convT_tile(float* tile  , const float* __restrict__ src, int K, int N, bf16_t* __restrict__ dst, int mode, int ntn, int idx) {
    const int n0 = (idx % ntn) * 64, k0 = (idx / ntn) * 64;
    const int tx = threadIdx.x & 63, ty = threadIdx.x >> 6;
    __syncthreads();
#pragma unroll
    for (int i = 0; i < 8; ++i) {
        const int k = ty + i * 8, n = n0 + tx;
        tile[k * 65 + tx] = (n < N) ? src[(size_t)(k0 + k) * N + n] : 0.f;
    }
    __syncthreads();
    const int kx = threadIdx.x & 31, ny = threadIdx.x >> 5;
#pragma unroll
    for (int i = 0; i < 4; ++i) {
        const int nl = ny + i * 16, n = n0 + nl;
        if (n < N) {
            const int r = rowmap_fn(mode, n);
            *(unsigned*)(dst + (size_t)r * K + k0 + 2 * kx) = pk2(tile[(2 * kx) * 65 + nl], tile[(2 * kx + 1) * 65 + nl]);
        }
    }
}
__device__ __forceinline__ void rms_row_bf16(const float* __restrict__ xrow, const float* __restrict__ g, bf16_t* __restrict__ orow, int lane) {
    const f32x4* xr = (const f32x4*)xrow + lane;
    f32x4 v[4]; float s = 0.f;
#pragma unroll
    for (int j = 0; j < 4; ++j) { v[j] = xr[64 * j]; s += v[j].x * v[j].x + v[j].y * v[j].y + v[j].z * v[j].z + v[j].w * v[j].w; }
    const float rinv = rsqrtf(wave_sum(s) * (1.f / 1024.f) + EPS);
#pragma unroll
    for (int j = 0; j < 4; ++j) {
        const f32x4 gg = ((const f32x4*)g)[lane + 64 * j];
        uint2 o; o.x = pk2(v[j].x * rinv * gg.x, v[j].y * rinv * gg.y); o.y = pk2(v[j].z * rinv * gg.z, v[j].w * rinv * gg.w);
        *(uint2*)(orow + (lane + 64 * j) * 4) = o;
    }
}

constexpr int CT_PER_LAYER = 53 * 16 + 256 + 64 + 128 + 64;
constexpr int CT_GU = 64 * 128, CT_DN = 64 * 64;
constexpr int CT_TOTAL = NL * CT_PER_LAYER + CT_GU + CT_DN;

__device__ __forceinline__ void phase0(const Params& P, char* smem) {
    char* ws = P.ws;
    float* tile = (float*)smem;
    BLK_LOOP(it, CT_TOTAL) {
        int r = it;
        if (r < NL * CT_PER_LAYER) {
            const int l = r / CT_PER_LAYER; r -= l * CT_PER_LAYER;
            if (r < 848) { convT_tile(tile, P.in[I_W_IN] + (size_t)l * 1024 * NIN, 1024, NIN, (bf16_t*)(ws + OFF_WIN) + (size_t)l * NP * 1024, 1, 53, r); continue; } r -= 848;
            if (r < 256) { convT_tile(tile, P.in[I_W_OUT] + (size_t)l * 1024 * 1024, 1024, 1024, (bf16_t*)(ws + OFF_WOUT) + (size_t)l * 1024 * 1024, 0, 16, r); continue; } r -= 256;
            if (r < 64) { convT_tile(tile, P.in[I_W_MQ] + (size_t)l * 1024 * 256, 1024, 256, (bf16_t*)(ws + OFF_WMQ) + (size_t)l * 256 * 1024, 0, 4, r); continue; } r -= 64;
            if (r < 128) { convT_tile(tile, P.in[I_W_MKV] + (size_t)l * 1024 * 512, 1024, 512, (bf16_t*)(ws + OFF_WMKV) + (size_t)l * 512 * 1024, 0, 8, r); continue; } r -= 128;
            convT_tile(tile, P.in[I_W_MO] + (size_t)l * 256 * 1024, 256, 1024, (bf16_t*)(ws + OFF_WMO) + (size_t)l * 1024 * 256, 0, 16, r); continue;
        }
        r -= NL * CT_PER_LAYER;
        if (r < CT_GU) { const int m = r >> 7; convT_tile(tile, P.in[I_W_E_GU] + (size_t)m * 1024 * 512, 1024, 512, (bf16_t*)(ws + OFF_WGU) + (size_t)m * 512 * 1024, 2, 8, r & 127); continue; }
        r -= CT_GU;
        { const int m = r >> 6; convT_tile(tile, P.in[I_W_E_DN] + (size_t)m * 256 * 1024, 256, 1024, (bf16_t*)(ws + OFF_WDN) + (size_t)m * 1024 * 256, 0, 16, r & 63); }
    }
    for (int i = blockIdx.x * NTHR + threadIdx.x; i < NL * (NP - NIN) * 512; i += gridDim.x * NTHR) {
        const int l = i / ((NP - NIN) * 512), w = i % ((NP - NIN) * 512);
        ((unsigned*)((bf16_t*)(ws + OFF_WIN) + (size_t)l * NP * 1024 + (size_t)NIN * 1024))[w] = 0u;
    }
    const int gw = blockIdx.x * 8 + (threadIdx.x >> 6), ngw = gridDim.x * 8, lane = threadIdx.x & 63;
    for (int row = gw; row < T + NL * 2048; row += ngw) {
        if (row < T) rms_row_bf16(P.in[I_X] + (size_t)row * 1024, P.in[I_NORM_MIX], (bf16_t*)(ws + OFF_HN) + (size_t)row * 1024, lane);
        else { const int r2 = row - T, l = r2 >> 11, rr = r2 & 2047;
               rms_row_bf16(P.in[I_MEM] + (size_t)rr * 1024, P.in[I_NORM_MEMKV] + l * 1024, (bf16_t*)(ws + OFF_MEMN) + (size_t)r2 * 1024, lane); }
    }
}

constexpr int GLD = 72;
constexpr int GEMM_LDS = (256 + 128) * GLD * 2;
template <class RowPtr>
__device__ __forceinline__ void gemm_tile(char* smem, RowPtr rowptr, const bf16_t* __restrict__ Bt, int ldb, int n0, int K, f32x4 (&acc)[4][4]) {
    bf16_t* sA = (bf16_t*)smem; bf16_t* sB = sA + 256 * GLD;
    const int tid = threadIdx.x, lane = tid & 63, wave = tid >> 6, wm = wave >> 1, wn = wave & 1;
    const u32x4* ga[4]; const u32x4* gb[2];
#pragma unroll
    for (int i = 0; i < 4; ++i) { const int c = tid + i * 512, r = c >> 3, ch = c & 7; ga[i] = (const u32x4*)(rowptr(r) + ch * 8); }
#pragma unroll
    for (int i = 0; i < 2; ++i) { const int c = tid + i * 512, r = c >> 3, ch = c & 7; gb[i] = (const u32x4*)(Bt + (size_t)(n0 + r) * ldb + ch * 8); }
#pragma unroll
    for (int m = 0; m < 4; ++m)
#pragma unroll
        for (int n = 0; n < 4; ++n) acc[m][n] = (f32x4){0.f, 0.f, 0.f, 0.f};
    u32x4 ra[4], rb[2];
#pragma unroll
    for (int i = 0; i < 4; ++i) ra[i] = ga[i][0];
#pragma unroll
    for (int i = 0; i < 2; ++i) rb[i] = gb[i][0];
    const int nk = K / 64;
    for (int kt = 0; kt < nk; ++kt) {
        __syncthreads();
#pragma unroll
        for (int i = 0; i < 4; ++i) { const int c = tid + i * 512, r = c >> 3, ch = c & 7; *(u32x4*)(sA + r * GLD + ch * 8) = ra[i]; }
#pragma unroll
        for (int i = 0; i < 2; ++i) { const int c = tid + i * 512, r = c >> 3, ch = c & 7; *(u32x4*)(sB + r * GLD + ch * 8) = rb[i]; }
        __syncthreads();
        if (kt + 1 < nk) {
#pragma unroll
            for (int i = 0; i < 4; ++i) ra[i] = ga[i][(kt + 1) * 8];
#pragma unroll
            for (int i = 0; i < 2; ++i) rb[i] = gb[i][(kt + 1) * 8];
        }
#pragma unroll
        for (int kk = 0; kk < 2; ++kk) {
            bf16x8 af[4], bfr[4];
#pragma unroll
            for (int m = 0; m < 4; ++m) af[m] = *(const bf16x8*)(sA + (wm * 64 + m * 16 + (lane & 15)) * GLD + kk * 32 + (lane >> 4) * 8);
#pragma unroll
            for (int n = 0; n < 4; ++n) bfr[n] = *(const bf16x8*)(sB + (wn * 64 + n * 16 + (lane & 15)) * GLD + kk * 32 + (lane >> 4) * 8);
#pragma unroll
            for (int m = 0; m < 4; ++m)
#pragma unroll
                for (int n = 0; n < 4; ++n) acc[m][n] = __builtin_amdgcn_mfma_f32_16x16x32_bf16(bfr[n], af[m], acc[m][n], 0, 0, 0);
        }
    }
}
struct RowDirect { const bf16_t* A; int lda; int m0; __device__ __forceinline__ const bf16_t* operator()(int r) const { return A + (size_t)(m0 + r) * lda; } };
enum { EPI_INPROJ = 0, EPI_RESID = 1, EPI_BF16 = 2 };

__device__ __forceinline__ int vcu_id() { const int G = gridDim.x, bx = blockIdx.x; return (G % 8 == 0) ? (bx % 8) * (G / 8) + bx / 8 : bx; }

template <int EPI>
__device__ __forceinline__ void gemm_phase(char* smem, const bf16_t* A, int lda, const bf16_t* Bt, int ldb, int M, int N, int K, void* out, int ldo, const float* resid, float* gates) {
    const int ntn = N / 128, ntiles = (M / 256) * ntn;
    const int lane = threadIdx.x & 63, wave = threadIdx.x >> 6, wm = wave >> 1, wn = wave & 1;
    for (int tIdx = vcu_id(); tIdx < ntiles; tIdx += gridDim.x) {
        const int m0 = (tIdx / ntn) * 256, n0 = (tIdx % ntn) * 128;
        f32x4 acc[4][4];
        RowDirect rp{A, lda, m0};
        gemm_tile(smem, rp, Bt, ldb, n0, K, acc);
#pragma unroll
        for (int m = 0; m < 4; ++m)
#pragma unroll
            for (int n = 0; n < 4; ++n) {
                const int row = m0 + wm * 64 + m * 16 + (lane & 15), col = n0 + wn * 64 + n * 16 + (lane >> 4) * 4;
                const f32x4 v = acc[m][n];
                if (EPI == EPI_INPROJ) {
                    uint2 o; o.x = pk2(v.x, v.y); o.y = pk2(v.z, v.w);
                    *(uint2*)((bf16_t*)out + (size_t)row * ldo + col) = o;
                    if (col >= C_GATE && col < C_GATE + 16) *(f32x4*)(gates + (size_t)row * 16 + (col - C_GATE)) = v;
                } else if (EPI == EPI_RESID) {
                    const f32x4 r = *(const f32x4*)(resid + (size_t)row * ldo + col);
                    *(f32x4*)((float*)out + (size_t)row * ldo + col) = r + v;
                } else {
                    uint2 o; o.x = pk2(v.x, v.y); o.y = pk2(v.z, v.w);
                    *(uint2*)((bf16_t*)out + (size_t)row * ldo + col) = o;
                }
            }
    }
}

struct RowGather { const bf16_t* A; int lda; const int* ids; int shift; __device__ __forceinline__ const bf16_t* operator()(int r) const { return A + (size_t)(ids[r] >> shift) * lda; } };
template <int STAGE>
__device__ __forceinline__ void moe_phase(char* smem, const bf16_t* A, int lda, const bf16_t* Wt, size_t wstride, int ldb, int K, const int* cnt, const int* list, const float* pgate, bf16_t* out) {
    int* ids = (int*)(smem + GEMM_LDS);
    int* tpre = ids + 256;
    constexpr int NTN = (STAGE == 1) ? 4 : 8;
    __syncthreads();
    if (threadIdx.x == 0) { int a = 0; for (int i = 0; i < NEXP; ++i) { tpre[i] = a; a += (cnt[i] + 255) >> 8; } tpre[NEXP] = a; }
    __syncthreads();
    const int ntiles = tpre[NEXP] * NTN;
    const int lane = threadIdx.x & 63, wave = threadIdx.x >> 6, wm = wave >> 1, wn = wave & 1;
    for (int tIdx = vcu_id(); tIdx < ntiles; tIdx += gridDim.x) {
        const int mtg = tIdx / NTN, n0 = (tIdx % NTN) * 128;
        int e = 0;
        for (int i = 1; i < NEXP; ++i) if (tpre[i] <= mtg) e = i;
        const int mt = mtg - tpre[e];
        const int cn = cnt[e];
        __syncthreads();
        if (threadIdx.x < 256) { const int pos = mt * 256 + threadIdx.x; ids[threadIdx.x] = list[(size_t)e * T + (pos < cn ? pos : cn - 1)]; }
        __syncthreads();
        f32x4 acc[4][4];
        RowGather rp{A, lda, ids, STAGE == 1 ? 1 : 0};
        gemm_tile(smem, rp, Wt + (size_t)e * wstride, ldb, n0, K, acc);
#pragma unroll
        for (int m = 0; m < 4; ++m) {
            const int rl = wm * 64 + m * 16 + (lane & 15);
            if (mt * 256 + rl >= cn) continue;
            const int pid = ids[rl];
            if (STAGE == 1) {
                const float gt = pgate[pid];
#pragma unroll
                for (int np = 0; np < 2; ++np) {
                    const f32x4 g = acc[m][2 * np], u = acc[m][2 * np + 1];
                    const int j = (n0 + wn * 64 + np * 32) / 2 + (lane >> 4) * 4;
                    uint2 o; o.x = pk2(siluf_(g.x) * u.x * gt, siluf_(g.y) * u.y * gt); o.y = pk2(siluf_(g.z) * u.z * gt, siluf_(g.w) * u.w * gt);
                    *(uint2*)(out + (size_t)pid * DEXP + j) = o;
                }
            } else {
#pragma unroll
                for (int n = 0; n < 4; ++n) {
                    const f32x4 v = acc[m][n]; const int col = n0 + wn * 64 + n * 16 + (lane >> 4) * 4;
                    uint2 o; o.x = pk2(v.x, v.y); o.y = pk2(v.z, v.w);
                    *(uint2*)(out + (size_t)pid * 1024 + col) = o;
                }
            }
        }
    }
}

__device__ __forceinline__ void hgrn2_naive(const bf16_t* __restrict__ proj, const float* __restrict__ hgrn_lb, int layer, const float* __restrict__ mix_gain, bf16_t* __restrict__ y, int bh, int lane) {
    const int b = bh >> 2, h = bh & 3;
    float lbk = 0.f;
    if (layer == 1) { float a0 = hgrn_lb[h * 64 + lane], a1 = hgrn_lb[256 + h * 64 + lane]; lbk = 1.f / (1.f + __expf(a0 - a1)); }
    const float mg = mix_gain[C_AQ + h * 64 + lane];
    float S[64];
#pragma unroll
    for (int k = 0; k < 64; ++k) S[k] = 0.f;
    for (int t = 0; t < SEQ; ++t) {
        const bf16_t* pr = proj + (size_t)(b * SEQ + t) * NP + h * 64 + lane;
        const float qk = siluf_(bf2f(pr[C_AQ]));
        const float sg = sigmoidf_(bf2f(pr[C_AF]));
        const float f = lbk + (1.f - lbk) * sg, kk = (1.f - lbk) * (1.f - sg);
        const float iv = bf2f(pr[C_AI]);
        const float gv = bf2f(pr[C_AG]);
        float o = 0.f;
#pragma unroll
        for (int k = 0; k < 64; ++k) { S[k] = rdlane(f, k) * S[k] + rdlane(kk, k) * iv; o += rdlane(qk, k) * S[k]; }
        const float ms = wave_sum(o * o) * (1.f / 64.f);
        const float yv = o * rsqrtf(ms + EPS) * siluf_(gv) * mg;
        y[(size_t)(b * SEQ + t) * 1024 + 0 + h * 64 + lane] = f2bf(yv);
    }
}
__device__ __forceinline__ void gdn_naive(const bf16_t* __restrict__ proj, const float* __restrict__ gates, const float* __restrict__ conv_w  ,
                                          const float* __restrict__ a_log, const float* __restrict__ dt_bias, const float* __restrict__ mix_gain, bf16_t* __restrict__ y, int bh, int lane) {
    const int b = bh >> 2, h = bh & 3;
    float wq[4], wk[4], wv[4];
#pragma unroll
    for (int j = 0; j < 4; ++j) { wq[j] = conv_w[j * 768 + h * 64 + lane]; wk[j] = conv_w[j * 768 + 256 + h * 64 + lane]; wv[j] = conv_w[j * 768 + 512 + h * 64 + lane]; }
    float xq[3] = {0.f, 0.f, 0.f}, xk[3] = {0.f, 0.f, 0.f}, xv[3] = {0.f, 0.f, 0.f};
    const float Aexp = __expf(a_log[h]), dtb = dt_bias[h];
    const float mg = mix_gain[768 + h * 64 + lane];
    float S[64];
#pragma unroll
    for (int k = 0; k < 64; ++k) S[k] = 0.f;
    for (int t = 0; t < SEQ; ++t) {
        const size_t row = (size_t)(b * SEQ + t);
        const bf16_t* pr = proj + row * NP + h * 64 + lane;
        const float q0 = bf2f(pr[C_DQ]), k0 = bf2f(pr[C_DK]), v0 = bf2f(pr[C_DV]), zv = bf2f(pr[C_DZ]);
        float q = siluf_(wq[0] * xq[0] + wq[1] * xq[1] + wq[2] * xq[2] + wq[3] * q0);
        float k = siluf_(wk[0] * xk[0] + wk[1] * xk[1] + wk[2] * xk[2] + wk[3] * k0);
        float v = siluf_(wv[0] * xv[0] + wv[1] * xv[1] + wv[2] * xv[2] + wv[3] * v0);
        xq[0] = xq[1]; xq[1] = xq[2]; xq[2] = q0; xk[0] = xk[1]; xk[1] = xk[2]; xk[2] = k0; xv[0] = xv[1]; xv[1] = xv[2]; xv[2] = v0;
        q = q * rsqrtf(wave_sum(q * q) + EPS) * 0.125f;
        k = k * rsqrtf(wave_sum(k * k) + EPS);
        const float beta = sigmoidf_(gates[row * 16 + 4 + h]);
        const float g = -Aexp * softplusf_(gates[row * 16 + 8 + h] + dtb);
        const float eg = __expf(g);
        float r = 0.f;
#pragma unroll
        for (int i = 0; i < 64; ++i) { S[i] *= eg; r += rdlane(k, i) * S[i]; }
        const float dlt = beta * (v - r);
        float o = 0.f;
#pragma unroll
        for (int i = 0; i < 64; ++i) { S[i] += rdlane(k, i) * dlt; o += rdlane(q, i) * S[i]; }
        const float ms = wave_sum(o * o) * (1.f / 64.f);
        const float yv = o * rsqrtf(ms + EPS) * siluf_(zv) * mg;
        y[row * 1024 + 768 + h * 64 + lane] = f2bf(yv);
    }
}
__device__ __forceinline__ void fox_cumsum(const float* __restrict__ gates, const float* __restrict__ fb, float* __restrict__ cc, int bh, int lane) {
    const int b = bh >> 2, h = bh & 3;
    const float bias = fb[h];
    float carry = 0.f;
    for (int t0 = 0; t0 < SEQ; t0 += 64) {
        float v = logsigmoidf_(gates[(size_t)(b * SEQ + t0 + lane) * 16 + h] + bias);
#pragma unroll
        for (int o = 1; o < 64; o <<= 1) { float n = __shfl_up(v, o); if (lane >= o) v += n; }
        v += carry;
        cc[(size_t)(b * 4 + h) * SEQ + t0 + lane] = v;
        carry = __shfl(v, 63);
    }
}
__device__ __forceinline__ void lru_prep_task(float* xc  , const bf16_t* __restrict__ proj, const float* __restrict__ conv_w, const float* __restrict__ conv_b,
                                              const float* __restrict__ w_a, const float* __restrict__ b_a, const float* __restrict__ w_x, const float* __restrict__ b_x,
                                              const float* __restrict__ lam, float* __restrict__ a_out, float* __restrict__ u_out, int task, bool active) {
    const int c = threadIdx.x & 255, t0 = task * 16;
    if (active) {
        const float w0 = conv_w[c], w1 = conv_w[256 + c], w2 = conv_w[512 + c], w3 = conv_w[768 + c], cb = conv_b[c];
        for (int i = 0; i < 16; ++i) {
            const int t = t0 + i, s = t & (SEQ - 1);
            const bf16_t* pr = proj + (size_t)t * NP + C_CX + c;
            float acc = cb + w3 * bf2f(pr[0]);
            if (s >= 1) acc += w2 * bf2f(pr[-(ptrdiff_t)NP]);
            if (s >= 2) acc += w1 * bf2f(pr[-(ptrdiff_t)2 * NP]);
            if (s >= 3) acc += w0 * bf2f(pr[-(ptrdiff_t)3 * NP]);
            xc[i * 256 + c] = acc;
        }
    }
    __syncthreads();
    if (active) {
        const int h = c >> 6, jj = c & 63;
        float ra[16], rx[16];
#pragma unroll
        for (int i = 0; i < 16; ++i) { ra[i] = 0.f; rx[i] = 0.f; }
        for (int k = 0; k < 64; ++k) {
            const float wa = w_a[(h * 64 + k) * 64 + jj], wx = w_x[(h * 64 + k) * 64 + jj];
#pragma unroll
            for (int i = 0; i < 16; ++i) { const float xv = xc[i * 256 + h * 64 + k]; ra[i] += xv * wa; rx[i] += xv * wx; }
        }
        const float ba = b_a[c], bx = b_x[c], sp = softplusf_(-lam[c]);
#pragma unroll
        for (int i = 0; i < 16; ++i) {
            const float r = sigmoidf_(ra[i] + ba), ig = sigmoidf_(rx[i] + bx);
            const float log_a = -8.f * r * sp;
            const float a = __expf(log_a);
            const float u = sqrtf(-expm1f(2.f * log_a)) * (ig * xc[i * 256 + c]);
            a_out[(size_t)(t0 + i) * 256 + c] = a; u_out[(size_t)(t0 + i) * 256 + c] = u;
        }
    }
    __syncthreads();
}
__device__ __forceinline__ void lru_scan_task(const float* __restrict__ a_in, const float* __restrict__ u_in, const bf16_t* __restrict__ proj, const float* __restrict__ mix_gain, bf16_t* __restrict__ y, int b) {
    const int c = threadIdx.x;
    const float mg = mix_gain[512 + c];
    float hst = 0.f;
    for (int t = 0; t < SEQ; ++t) {
        const size_t row = (size_t)(b * SEQ + t);
        hst = a_in[row * 256 + c] * hst + u_in[row * 256 + c];
        const float yv = hst * geluf_(bf2f(proj[row * NP + C_CG + c]));
        const float ms = wave_sum(yv * yv) * (1.f / 64.f);
        y[row * 1024 + 512 + c] = f2bf(yv * rsqrtf(ms + EPS) * mg);
    }
}

typedef short s16x4 __attribute__((ext_vector_type(4)));
#define LDS_AS __attribute__((address_space(3)))
__device__ __forceinline__ bf16x8 frag_rm(const bf16_t* tile, int ld, int r0, int k0, int lane) { return *(const bf16x8*)(tile + (r0 + (lane & 15)) * ld + k0 + (lane >> 4) * 8); }
__device__ __forceinline__ s16x4 tr4(const bf16_t* tile, int ld, int rbase, int c0, int lane) {
    const bf16_t* p = tile + (rbase + ((lane & 15) >> 2)) * ld + c0 + 4 * (lane & 3);
    return __builtin_amdgcn_ds_read_tr16_b64_v4i16((LDS_AS s16x4*)p);
}
__device__ __forceinline__ bf16x8 frag_cm(const bf16_t* tile, int ld, int k0, int c0, int lane) {
    const s16x4 lo = tr4(tile, ld, k0 + (lane >> 4) * 8, c0, lane), hi = tr4(tile, ld, k0 + (lane >> 4) * 8 + 4, c0, lane);
    return (bf16x8){lo[0], lo[1], lo[2], lo[3], hi[0], hi[1], hi[2], hi[3]};
}
#define MFMA16(a, b, c) __builtin_amdgcn_mfma_f32_16x16x32_bf16((a), (b), (c), 0, 0, 0)
constexpr int TLD = 72;


#define XB_TMO      128
#define XB_XCNT(j)  (256  + 64 * (j))
#define XB_XSUB(j)  (1280 + 64 * (j))
#define XB_XGEN(j)  (2304 + 64 * (j))
#define XB_TOP      3328
#define XB_TOPGEN   3392
#define XCD_BAR_WORDS 3456
#define XB_SPIN_CAP (1u << 18)
__device__ __forceinline__ unsigned xb_ld(unsigned* p)              { return __hip_atomic_load(p, __ATOMIC_RELAXED, __HIP_MEMORY_SCOPE_AGENT); }
__device__ __forceinline__ unsigned xb_add(unsigned* p, unsigned v) { return __hip_atomic_fetch_add(p, v, __ATOMIC_RELAXED, __HIP_MEMORY_SCOPE_AGENT); }
__device__ __forceinline__ unsigned xb_xcc_id() { return (unsigned)__builtin_amdgcn_s_getreg((3 << 11) | 20) & 0xFu; }
#define XB_SPIN(cond, bar) do { unsigned _sp = 0; while (cond) { __builtin_amdgcn_s_sleep(1); \
    if ((++_sp & 255u) == 0u) { if (xb_ld(&(bar)[XB_TMO])) break; if (_sp > XB_SPIN_CAP) { atomicAdd(&(bar)[XB_TMO], 1u); break; } } } } while (0)
struct XcdBarrier { unsigned* bar; unsigned x; volatile LDS_AS unsigned* st; };
__device__ __forceinline__ XcdBarrier xcd_barrier_post(unsigned* bar, volatile LDS_AS unsigned* st) {
    XcdBarrier b; b.bar = bar; b.x = xb_xcc_id(); b.st = st;
    if (threadIdx.x == 0) (void)xb_add(&bar[XB_XCNT(b.x)], 1u);
    return b;
}
__device__ __forceinline__ void xcd_barrier_complete(unsigned* bar, unsigned x, unsigned& nloc, unsigned& nx) {
    const unsigned G = gridDim.x * gridDim.y * gridDim.z;
    unsigned sum, cnt, mine, sp = 0u;
    for (;;) {
        sum = 0u; cnt = 0u; mine = 0u;
#pragma unroll
        for (unsigned j = 0; j < 16; ++j) { const unsigned c = xb_ld(&bar[XB_XCNT(j)]); sum += c; cnt += (c > 0u) ? 1u : 0u; mine = (j == x) ? c : mine; }
        if (sum == G) break;
        __builtin_amdgcn_s_sleep(1);
        if ((++sp & 255u) == 0u) { if (xb_ld(&bar[XB_TMO])) break; if (sp > XB_SPIN_CAP) { atomicAdd(&bar[XB_TMO], 1u); break; } }
    }
    nloc = mine > 0u ? mine : 1u; nx = cnt > 0u ? cnt : 1u;
}
__device__ __forceinline__ void xcd_barrier(const XcdBarrier& b) {
    asm volatile("s_waitcnt vmcnt(0)" ::: "memory");
    __syncthreads();
    if (threadIdx.x == 0) {
        unsigned* bar = b.bar;
        __builtin_amdgcn_s_waitcnt(0);
        unsigned nloc = b.st[0], nx = b.st[1];
        if (nloc == 0u) { xcd_barrier_complete(bar, b.x, nloc, nx); b.st[0] = nloc; b.st[1] = nx; }
        const unsigned old = xb_add(&bar[XB_XSUB(b.x)], 1u);
        const unsigned gen = old / nloc;
        if (old + 1u == (gen + 1u) * nloc) {
            __builtin_amdgcn_fence(__ATOMIC_RELEASE, "agent");
            asm volatile("s_waitcnt vmcnt(0)" ::: "memory");
            const unsigned og = xb_add(&bar[XB_TOP], 1u);
            const unsigned tg = og / nx;
            if (og + 1u == (tg + 1u) * nx) xb_add(&bar[XB_TOPGEN], 1u);
            else XB_SPIN(xb_ld(&bar[XB_TOPGEN]) == tg, bar);
            __builtin_amdgcn_fence(__ATOMIC_ACQUIRE, "agent");
            xb_add(&bar[XB_XGEN(b.x)], 1u);
            asm volatile("s_waitcnt vmcnt(0)" ::: "memory");
        } else {
            XB_SPIN(xb_ld(&bar[XB_XGEN(b.x)]) == gen, bar);
            __builtin_amdgcn_fence(__ATOMIC_ACQUIRE, "agent");
            asm volatile("s_waitcnt vmcnt(0)" ::: "memory");
        }
    }
    __syncthreads();
}

template <bool MASK>
__device__ __forceinline__ void attn_compute_t(const bf16_t* cK, const bf16_t* cV, const float* cC, const bf16x8 (&qf)[2], f32x4 (&oacc)[4], float& mrun, float& lrun,
                                               float ct2, float scale2, int kt, int tq, int lane, int g) {
    f32x4 sacc[4];
#pragma unroll
    for (int n = 0; n < 4; ++n) {
        sacc[n] = (f32x4){0.f, 0.f, 0.f, 0.f};
#pragma unroll
        for (int kk = 0; kk < 2; ++kk) sacc[n] = MFMA16(frag_rm(cK, TLD, n * 16, kk * 32, lane), qf[kk], sacc[n]);
    }
    float mx = -INFINITY;
#pragma unroll
    for (int n = 0; n < 4; ++n) {
        const f32x4 cs = *(const f32x4*)(cC + n * 16 + 4 * g);
#pragma unroll
        for (int r = 0; r < 4; ++r) {
            float v = sacc[n][r] * scale2 + (ct2 - cs[r]);
            if (MASK) { if (kt * 64 + n * 16 + 4 * g + r > tq) v = -INFINITY; }
            sacc[n][r] = v; mx = fmaxf(mx, v);
        }
    }
    mx = fmaxf(mx, __shfl_xor(mx, 16)); mx = fmaxf(mx, __shfl_xor(mx, 32));
    const float mnew = fmaxf(mrun, mx);
    const float corr = __builtin_amdgcn_exp2f(mrun - mnew);
    float rs = 0.f;
#pragma unroll
    for (int n = 0; n < 4; ++n)
#pragma unroll
        for (int r = 0; r < 4; ++r) { const float p = __builtin_amdgcn_exp2f(sacc[n][r] - mnew); sacc[n][r] = p; rs += p; }
    rs += __shfl_xor(rs, 16); rs += __shfl_xor(rs, 32);
    lrun = lrun * corr + rs; mrun = mnew;
    bf16x8 pf[2];
#pragma unroll
    for (int kk = 0; kk < 2; ++kk) {
        const u32x4 pk = (u32x4){pk2(sacc[2 * kk][0], sacc[2 * kk][1]), pk2(sacc[2 * kk][2], sacc[2 * kk][3]), pk2(sacc[2 * kk + 1][0], sacc[2 * kk + 1][1]), pk2(sacc[2 * kk + 1][2], sacc[2 * kk + 1][3])};
        pf[kk] = __builtin_bit_cast(bf16x8, pk);
    }
#pragma unroll
    for (int n2 = 0; n2 < 4; ++n2) {
        oacc[n2] = oacc[n2] * corr;
#pragma unroll
        for (int kk = 0; kk < 2; ++kk) {
            const s16x4 lo = tr4(cV, TLD, (2 * kk) * 16 + 4 * g, n2 * 16, lane), hi = tr4(cV, TLD, (2 * kk + 1) * 16 + 4 * g, n2 * 16, lane);
            const bf16x8 vf = (bf16x8){lo[0], lo[1], lo[2], lo[3], hi[0], hi[1], hi[2], hi[3]};
            oacc[n2] = MFMA16(vf, pf[kk], oacc[n2]);
        }
    }
}
__device__ __forceinline__ void attn_compute(const bf16_t* cK, const bf16_t* cV, const float* cC, const bf16x8 (&qf)[2], f32x4 (&oacc)[4], float& mrun, float& lrun,
                                             float ct2, float scale2, int causal, int kt, int q0, int tq, int wave, int lane, int g) {
    const int r0 = q0 + wave * 16;
    if (causal && (kt * 64 > r0 + 15)) return;
    if (causal && (kt * 64 + 63 > r0)) attn_compute_t<true>(cK, cV, cC, qf, oacc, mrun, lrun, ct2, scale2, kt, tq, lane, g);
    else attn_compute_t<false>(cK, cV, cC, qf, oacc, mrun, lrun, ct2, scale2, kt, tq, lane, g);
}

__device__ __forceinline__ void attn_task(char* smem, const bf16_t* __restrict__ Q, int ldq, const bf16_t* __restrict__ Kp, int ldk, const bf16_t* __restrict__ Vp, int ldv, const float* __restrict__ bias,
                                          int nq_per_b, int nk_per_b, int causal, float scale, bf16_t* __restrict__ O, int ldo, const float* __restrict__ gain, int rms, int task) {
    bf16_t* sK = (bf16_t*)smem;
    bf16_t* sV = sK + 2 * 64 * TLD;
    float* sC = (float*)(sV + 2 * 64 * TLD);
    const int tid = threadIdx.x, lane = tid & 63, wave = tid >> 6, g = lane >> 4, li = lane & 15;
    const int nqt = nq_per_b / 128;
    const int qt = task % nqt, h = (task / nqt) & 3, b = task / (nqt * 4);
    const int q0 = qt * 128, tq = q0 + wave * 16 + li;
    const size_t qrow = (size_t)b * nq_per_b + tq;
    bf16x8 qf[2];
#pragma unroll
    for (int kk = 0; kk < 2; ++kk) qf[kk] = *(const bf16x8*)(Q + qrow * ldq + h * 64 + kk * 32 + g * 8);
    constexpr float LOG2E = 1.4426950408889634f;
    const float ct = bias ? bias[(size_t)(b * 4 + h) * nq_per_b + tq] * LOG2E : 0.f;
    const float scale2 = scale * LOG2E;
    const int nkt = causal ? (q0 + 128) / 64 : nk_per_b / 64;
    const int sr = tid >> 3, sc = tid & 7;
    const bf16_t* kg = Kp + ((size_t)b * nk_per_b + sr) * ldk + h * 64 + sc * 8;
    const bf16_t* vg = Vp + ((size_t)b * nk_per_b + sr) * ldv + h * 64 + sc * 8;
    const float* cg_ = bias ? bias + (size_t)(b * 4 + h) * nk_per_b : nullptr;
    u32x4 rkA, rvA, rkB, rvB; float rcA = 0.f, rcB = 0.f;
    {   const u32x4 rk = *(const u32x4*)kg, rv = *(const u32x4*)vg; const float rc = (cg_ && tid < 64) ? cg_[tid] * LOG2E : 0.f;
        __syncthreads();
        *(u32x4*)(sK + sr * TLD + sc * 8) = rk; *(u32x4*)(sV + sr * TLD + sc * 8) = rv; if (tid < 64) sC[tid] = rc; }
    rkA = *(const u32x4*)(kg + (size_t)64 * ldk); rvA = *(const u32x4*)(vg + (size_t)64 * ldv); rcA = (cg_ && tid < 64) ? cg_[64 + tid] * LOG2E : 0.f;
    __syncthreads();
    f32x4 oacc[4];
#pragma unroll
    for (int n = 0; n < 4; ++n) oacc[n] = (f32x4){0.f, 0.f, 0.f, 0.f};
    float mrun = -INFINITY, lrun = 0.f;
#define ATTN_ITER(kt, LK, LV, LC, WK, WV, WC) { \
        const int buf = (kt) & 1; \
        if ((kt) + 2 < nkt) { LK = *(const u32x4*)(kg + (size_t)((kt) + 2) * 64 * ldk); LV = *(const u32x4*)(vg + (size_t)((kt) + 2) * 64 * ldv); LC = (cg_ && tid < 64) ? cg_[((kt) + 2) * 64 + tid] * LOG2E : 0.f; } \
        attn_compute(sK + buf * 64 * TLD, sV + buf * 64 * TLD, sC + buf * 64, qf, oacc, mrun, lrun, ct, scale2, causal, (kt), q0, tq, wave, lane, g); \
        if ((kt) + 1 < nkt) { const int nb = buf ^ 1; *(u32x4*)(sK + nb * 64 * TLD + sr * TLD + sc * 8) = WK; *(u32x4*)(sV + nb * 64 * TLD + sr * TLD + sc * 8) = WV; if (tid < 64) sC[nb * 64 + tid] = WC; } \
        __syncthreads(); }
    for (int kt = 0; kt < nkt; kt += 2) {
        ATTN_ITER(kt, rkB, rvB, rcB, rkA, rvA, rcA)
        ATTN_ITER(kt + 1, rkA, rvA, rcA, rkB, rvB, rcB)
    }
#undef ATTN_ITER
    const float inv = 1.f / lrun;
    float ms = 0.f;
#pragma unroll
    for (int n = 0; n < 4; ++n) { oacc[n] = oacc[n] * inv; ms += oacc[n][0] * oacc[n][0] + oacc[n][1] * oacc[n][1] + oacc[n][2] * oacc[n][2] + oacc[n][3] * oacc[n][3]; }
    ms += __shfl_xor(ms, 16); ms += __shfl_xor(ms, 32);
    const float rinv = rms ? rsqrtf(ms * (1.f / 64.f) + EPS) : 1.f;
#pragma unroll
    for (int n = 0; n < 4; ++n) {
        const int d = n * 16 + 4 * g;
        f32x4 gg = (f32x4){1.f, 1.f, 1.f, 1.f};
        if (gain) gg = *(const f32x4*)(gain + h * 64 + d);
        uint2 o; o.x = pk2(oacc[n][0] * rinv * gg[0], oacc[n][1] * rinv * gg[1]); o.y = pk2(oacc[n][2] * rinv * gg[2], oacc[n][3] * rinv * gg[3]);
        *(uint2*)(O + qrow * ldo + h * 64 + d) = o;
    }
}


__device__ __forceinline__ void hgrn_scan(float* LF  , float* SEGT  , const bf16_t* __restrict__ prow  , const float* __restrict__ hgrn_lb, int layer, int h, float (&kk)[8]) {
    const int tid = threadIdx.x, t = tid >> 3, k8 = (tid & 7) * 8;
    const u32x4 raw = *(const u32x4*)(prow + (size_t)t * NP + C_AF + k8);
#pragma unroll
    for (int j = 0; j < 8; ++j) {
        const float fl = __uint_as_float((j & 1) ? (raw[j >> 1] & 0xffff0000u) : (raw[j >> 1] << 16));
        float lbk = 0.f;
        if (layer == 1) { const float a0 = hgrn_lb[h * 64 + k8 + j], a1 = hgrn_lb[256 + h * 64 + k8 + j]; lbk = 1.f / (1.f + __expf(a0 - a1)); }
        const float sg = sigmoidf_(fl);
        const float f = lbk + (1.f - lbk) * sg;
        kk[j] = (1.f - lbk) * (1.f - sg);
        LF[t * 65 + k8 + j] = __logf(f);
    }
    __syncthreads();
    { const int k = tid & 63, seg = tid >> 6; float run = 0.f;
#pragma unroll
      for (int i = 0; i < 8; ++i) { run += LF[(seg * 8 + i) * 65 + k]; LF[(seg * 8 + i) * 65 + k] = run; }
      SEGT[seg * 64 + k] = run; }
    __syncthreads();
    { const int k = tid & 63, seg = tid >> 6; float off = 0.f;
      for (int s2 = 0; s2 < seg; ++s2) off += SEGT[s2 * 64 + k];
#pragma unroll
      for (int i = 0; i < 8; ++i) LF[(seg * 8 + i) * 65 + k] += off; }
    __syncthreads();
}
__device__ __forceinline__ float bfx(const u32x4& raw, int j) { return __uint_as_float((j & 1) ? (raw[j >> 1] & 0xffff0000u) : (raw[j >> 1] << 16)); }

__device__ __forceinline__ void hgrn_local_task(char* smem, const bf16_t* __restrict__ proj, const float* __restrict__ hgrn_lb, int layer, float* __restrict__ HL, float* __restrict__ HD, int ch) {
    float* LF = (float*)smem; float* SEGT = LF + 64 * 65;
    bf16_t* sKd = (bf16_t*)(SEGT + 8 * 64); bf16_t* sV = sKd + 64 * TLD;
    const int tid = threadIdx.x, lane = tid & 63, wave = tid >> 6, g = lane >> 4, li = lane & 15;
    const int bh = ch >> 5, n = ch & 31, b = bh >> 2, h = bh & 3;
    const bf16_t* prow = proj + (size_t)(b * SEQ + n * 64) * NP + h * 64;
    const int t = tid >> 3, k8 = (tid & 7) * 8;
    __syncthreads();
    *(u32x4*)(sV + t * TLD + k8) = *(const u32x4*)(prow + (size_t)t * NP + C_AI + k8);
    float kk[8];
    hgrn_scan(LF, SEGT, prow, hgrn_lb, layer, h, kk);
    { u32x4 o;
#pragma unroll
      for (int j = 0; j < 8; j += 2) {
          const float e0 = kk[j] * __expf(LF[63 * 65 + k8 + j] - LF[t * 65 + k8 + j]), e1 = kk[j + 1] * __expf(LF[63 * 65 + k8 + j + 1] - LF[t * 65 + k8 + j + 1]);
          o[j >> 1] = pk2(e0, e1);
      }
      *(u32x4*)(sKd + t * TLD + k8) = o; }
    if (tid < 64) HD[(size_t)ch * 64 + tid] = __expf(LF[63 * 65 + tid]);
    __syncthreads();
#pragma unroll
    for (int i = 0; i < 2; ++i) {
        const int idx = wave * 2 + i, vt = idx >> 2, kt = idx & 3;
        f32x4 acc = (f32x4){0.f, 0.f, 0.f, 0.f};
#pragma unroll
        for (int ks = 0; ks < 2; ++ks) acc = MFMA16(frag_cm(sV, TLD, ks * 32, vt * 16, lane), frag_cm(sKd, TLD, ks * 32, kt * 16, lane), acc);
        *(f32x4*)(HL + (size_t)ch * 4096 + (kt * 16 + li) * 64 + vt * 16 + 4 * g) = acc;
    }
}

__device__ __forceinline__ void hgrn_out_task(char* smem, const bf16_t* __restrict__ proj, const float* __restrict__ hgrn_lb, int layer, const bf16_t* __restrict__ HS,
                                              const float* __restrict__ mix_gain, bf16_t* __restrict__ y, int ch) {
    float* LF = (float*)smem; float* SEGT = LF + 64 * 65; float* sMS = SEGT + 8 * 64;
    bf16_t* sST = (bf16_t*)(sMS + 128); bf16_t* sQ0 = sST + 64 * TLD; bf16_t* sQm = sQ0 + 64 * TLD; bf16_t* sKm = sQm + 64 * TLD; bf16_t* sV = sKm + 64 * TLD; bf16_t* sA = sV + 64 * TLD;
    const int tid = threadIdx.x, lane = tid & 63, wave = tid >> 6, g = lane >> 4, li = lane & 15;
    const int bh = ch >> 5, n = ch & 31, b = bh >> 2, h = bh & 3;
    const bf16_t* prow = proj + (size_t)(b * SEQ + n * 64) * NP + h * 64;
    const int t = tid >> 3, k8 = (tid & 7) * 8;
    __syncthreads();
    *(u32x4*)(sST + t * TLD + k8) = *(const u32x4*)(HS + (size_t)ch * 4096 + t * 64 + k8);
    const u32x4 qraw = *(const u32x4*)(prow + (size_t)t * NP + C_AQ + k8);
    *(u32x4*)(sV + t * TLD + k8) = *(const u32x4*)(prow + (size_t)t * NP + C_AI + k8);
    float kk[8];
    hgrn_scan(LF, SEGT, prow, hgrn_lb, layer, h, kk);
    { u32x4 o0, om, ok;
#pragma unroll
      for (int j = 0; j < 8; j += 2) {
          float q0v[2], qmv[2], kmv[2];
#pragma unroll
          for (int e = 0; e < 2; ++e) {
              const float bt = LF[t * 65 + k8 + j + e], r = LF[31 * 65 + k8 + j + e], q = siluf_(bfx(qraw, j + e));
              q0v[e] = q * __expf(bt); qmv[e] = q * __expf(bt - r); kmv[e] = kk[j + e] * __expf(r - bt);
          }
          o0[j >> 1] = pk2(q0v[0], q0v[1]); om[j >> 1] = pk2(qmv[0], qmv[1]); ok[j >> 1] = pk2(kmv[0], kmv[1]);
      }
      *(u32x4*)(sQ0 + t * TLD + k8) = o0; *(u32x4*)(sQm + t * TLD + k8) = om; *(u32x4*)(sKm + t * TLD + k8) = ok; }
    __syncthreads();
#pragma unroll
    for (int i = 0; i < 2; ++i) {
        const int idx = wave * 2 + i, tt = idx >> 2, st = idx & 3;
        f32x4 acc = (f32x4){0.f, 0.f, 0.f, 0.f};
#pragma unroll
        for (int ks = 0; ks < 2; ++ks) acc = MFMA16(frag_rm(sKm, TLD, st * 16, ks * 32, lane), frag_rm(sQm, TLD, tt * 16, ks * 32, lane), acc);
        const int tq = tt * 16 + li, s0 = st * 16 + 4 * g;
        uint2 o; o.x = pk2(s0 <= tq ? acc[0] : 0.f, s0 + 1 <= tq ? acc[1] : 0.f); o.y = pk2(s0 + 2 <= tq ? acc[2] : 0.f, s0 + 3 <= tq ? acc[3] : 0.f);
        *(uint2*)(sA + tq * TLD + s0) = o;
    }
    __syncthreads();
    { const int tt = wave >> 1;
      f32x4 oacc[2]; float ms = 0.f;
#pragma unroll
      for (int i = 0; i < 2; ++i) {
          const int vt = (wave & 1) * 2 + i;
          f32x4 acc = (f32x4){0.f, 0.f, 0.f, 0.f};
#pragma unroll
          for (int ks = 0; ks < 2; ++ks) acc = MFMA16(frag_cm(sST, TLD, ks * 32, vt * 16, lane), frag_rm(sQ0, TLD, tt * 16, ks * 32, lane), acc);
#pragma unroll
          for (int ks = 0; ks < 2; ++ks) acc = MFMA16(frag_cm(sV, TLD, ks * 32, vt * 16, lane), frag_rm(sA, TLD, tt * 16, ks * 32, lane), acc);
          oacc[i] = acc; ms += acc[0] * acc[0] + acc[1] * acc[1] + acc[2] * acc[2] + acc[3] * acc[3];
      }
      ms += __shfl_xor(ms, 16); ms += __shfl_xor(ms, 32);
      if (g == 0) sMS[(tt * 16 + li) * 2 + (wave & 1)] = ms;
      __syncthreads();
      const int tq = tt * 16 + li;
      const float rinv = rsqrtf((sMS[tq * 2] + sMS[tq * 2 + 1]) * (1.f / 64.f) + EPS);
      const size_t row = (size_t)(b * SEQ + n * 64 + tq);
#pragma unroll
      for (int i = 0; i < 2; ++i) {
          const int v0 = ((wave & 1) * 2 + i) * 16 + 4 * g;
          const uint2 graw = *(const uint2*)(proj + row * NP + C_AG + h * 64 + v0);
          const f32x4 mgv = *(const f32x4*)(mix_gain + C_AQ + h * 64 + v0);
          const float g0 = __uint_as_float(graw.x << 16), g1 = __uint_as_float(graw.x & 0xffff0000u), g2 = __uint_as_float(graw.y << 16), g3 = __uint_as_float(graw.y & 0xffff0000u);
          uint2 o; o.x = pk2(oacc[i][0] * rinv * siluf_(g0) * mgv[0], oacc[i][1] * rinv * siluf_(g1) * mgv[1]);
          o.y = pk2(oacc[i][2] * rinv * siluf_(g2) * mgv[2], oacc[i][3] * rinv * siluf_(g3) * mgv[3]);
          *(uint2*)(y + row * 1024 + h * 64 + v0) = o;
      }
    }
}


__device__ __forceinline__ void gdn_prep_task(char* smem, const bf16_t* __restrict__ proj, const float* __restrict__ gates, const float* __restrict__ conv_w  ,
                                              const float* __restrict__ a_log, const float* __restrict__ dt_bias, bf16_t* __restrict__ gt_all, float* __restrict__ glast, int ch) {
    float* sG = (float*)smem; float* sBeta = sG + 64;
    float* RHS = sBeta + 64;
    float* sM = RHS + 64 * 132;
    bf16_t* sK = (bf16_t*)(sM + 64 * 68); bf16_t* sQ = sK + 64 * TLD;
    const int tid = threadIdx.x, lane = tid & 63, wave = tid >> 6, g = lane >> 4, li = lane & 15;
    const int bh = ch >> 5, n = ch & 31, b = bh >> 2, h = bh & 3;
    const int t = tid >> 3, d8 = (tid & 7) * 8;
    const size_t row0 = (size_t)(b * SEQ + n * 64);
    bf16_t* gt = gt_all + (size_t)ch * 5 * 4096;
    __syncthreads();
    float qn[8], kn[8], vv[8];
    {
        const int spos = n * 64 + t;
#pragma unroll
        for (int sec = 0; sec < 3; ++sec) {
            const int col = (sec == 0 ? C_DQ : (sec == 1 ? C_DK : C_DV)) + h * 64 + d8;
            float acc[8];
#pragma unroll
            for (int e = 0; e < 8; ++e) acc[e] = 0.f;
#pragma unroll
            for (int j = 0; j < 4; ++j) {
                if (spos - (3 - j) >= 0) {
                    const u32x4 raw = *(const u32x4*)(proj + (row0 + t - (3 - j)) * NP + col);
                    const f32x4 w0 = *(const f32x4*)(conv_w + j * 768 + sec * 256 + h * 64 + d8), w1 = *(const f32x4*)(conv_w + j * 768 + sec * 256 + h * 64 + d8 + 4);
#pragma unroll
                    for (int e = 0; e < 8; ++e) acc[e] += (e < 4 ? w0[e] : w1[e - 4]) * bfx(raw, e);
                }
            }
#pragma unroll
            for (int e = 0; e < 8; ++e) { const float sv = siluf_(acc[e]); if (sec == 0) qn[e] = sv; else if (sec == 1) kn[e] = sv; else vv[e] = sv; }
        }
        float sq = 0.f, sk = 0.f;
#pragma unroll
        for (int e = 0; e < 8; ++e) { sq += qn[e] * qn[e]; sk += kn[e] * kn[e]; }
        sq += __shfl_xor(sq, 1); sq += __shfl_xor(sq, 2); sq += __shfl_xor(sq, 4);
        sk += __shfl_xor(sk, 1); sk += __shfl_xor(sk, 2); sk += __shfl_xor(sk, 4);
        const float rq = rsqrtf(sq + EPS) * 0.125f, rk = rsqrtf(sk + EPS);
#pragma unroll
        for (int e = 0; e < 8; ++e) { qn[e] *= rq; kn[e] *= rk; }
    }
    if ((tid & 7) == 0) {
        const float* gr = gates + (row0 + t) * 16;
        sBeta[t] = sigmoidf_(gr[4 + h]);
        sG[t] = -__expf(a_log[h]) * softplusf_(gr[8 + h] + dt_bias[h]);
    }
    __syncthreads();
    if (wave == 0) {
        float v = sG[lane];
#pragma unroll
        for (int o = 1; o < 64; o <<= 1) { const float nb = __shfl_up(v, o); if (lane >= o) v += nb; }
        sG[lane] = v;
    }
    __syncthreads();
    {
        const float Gt = sG[t], Gl = sG[63], bt = sBeta[t];
        const float eG = __expf(Gt), eD = __expf(Gl - Gt);
        u32x4 ok, oq, oqd, okd;
#pragma unroll
        for (int e = 0; e < 8; e += 2) {
            ok[e >> 1] = pk2(kn[e], kn[e + 1]); oq[e >> 1] = pk2(qn[e], qn[e + 1]);
            oqd[e >> 1] = pk2(qn[e] * eG, qn[e + 1] * eG); okd[e >> 1] = pk2(kn[e] * eD, kn[e + 1] * eD);
        }
        *(u32x4*)(sK + t * TLD + d8) = ok; *(u32x4*)(sQ + t * TLD + d8) = oq;
        *(u32x4*)(gt + 2 * 4096 + t * 64 + d8) = oqd; *(u32x4*)(gt + 3 * 4096 + t * 64 + d8) = okd;
#pragma unroll
        for (int e = 0; e < 8; ++e) { RHS[t * 132 + d8 + e] = vv[e] * bt; RHS[t * 132 + 64 + d8 + e] = kn[e] * bt * eG; }
        if (tid == 0) glast[ch] = __expf(Gl);
    }
    __syncthreads();
#pragma unroll
    for (int i = 0; i < 2; ++i) {
        const int idx = wave * 2 + i, tt = idx >> 2, st = idx & 3;
        f32x4 am = (f32x4){0.f, 0.f, 0.f, 0.f}, aq = (f32x4){0.f, 0.f, 0.f, 0.f};
#pragma unroll
        for (int ks = 0; ks < 2; ++ks) {
            const bf16x8 kfs = frag_rm(sK, TLD, st * 16, ks * 32, lane), kft = frag_rm(sK, TLD, tt * 16, ks * 32, lane);
            am = MFMA16(kft, kfs, am);
            aq = MFMA16(kfs, frag_rm(sQ, TLD, tt * 16, ks * 32, lane), aq);
        }
        {   const int sx = st * 16 + li, t0 = tt * 16 + 4 * g; const float Gs = sG[sx];
            f32x4 mo;
#pragma unroll
            for (int r = 0; r < 4; ++r) { const int tq = t0 + r; mo[r] = (sx < tq) ? sBeta[tq] * am[r] * __expf(sG[tq] - Gs) : 0.f; }
            *(f32x4*)(sM + sx * 68 + t0) = mo; }
        {   const int tq = tt * 16 + li, s0 = st * 16 + 4 * g; const float Gt = sG[tq];
            float ao[4];
#pragma unroll
            for (int r = 0; r < 4; ++r) { const int sx = s0 + r; ao[r] = (sx <= tq) ? aq[r] * __expf(Gt - sG[sx]) : 0.f; }
            uint2 o; o.x = pk2(ao[0], ao[1]); o.y = pk2(ao[2], ao[3]);
            *(uint2*)(gt + 4 * 4096 + tq * 64 + s0) = o; }
    }
    __syncthreads();
    if (tid < 128) {
        float acc[64];
#pragma unroll
        for (int i = 0; i < 64; ++i) acc[i] = RHS[i * 132 + tid];
#pragma unroll
        for (int half = 0; half < 2; ++half) {
            const int base = half * 32;
            if (half == 1) {
#pragma unroll
                for (int sx = 0; sx < 32; sx += 2) {
                    f32x4 r0[8], r1[8];
#pragma unroll
                    for (int c = 0; c < 8; ++c) { r0[c] = *(const f32x4*)(sM + sx * 68 + 32 + c * 4); r1[c] = *(const f32x4*)(sM + (sx + 1) * 68 + 32 + c * 4); }
                    const float x0 = acc[sx], x1 = acc[sx + 1];
#pragma unroll
                    for (int tq = 0; tq < 32; ++tq) { acc[32 + tq] -= r0[tq >> 2][tq & 3] * x0; acc[32 + tq] -= r1[tq >> 2][tq & 3] * x1; }
                }
            }
            f32x4 cur[8];
#pragma unroll
            for (int c = 0; c < 8; ++c) cur[c] = *(const f32x4*)(sM + base * 68 + base + c * 4);
#pragma unroll
            for (int sx = 0; sx < 31; ++sx) {
                f32x4 nxt[8];
#pragma unroll
                for (int c = (sx + 2) >> 2; c < 8; ++c) nxt[c] = *(const f32x4*)(sM + (base + sx + 1) * 68 + base + c * 4);
                const float xs = acc[base + sx];
#pragma unroll
                for (int tq = sx + 1; tq < 32; ++tq) acc[base + tq] -= cur[tq >> 2][tq & 3] * xs;
#pragma unroll
                for (int c = (sx + 2) >> 2; c < 8; ++c) cur[c] = nxt[c];
            }
        }
        if (tid < 64) {
#pragma unroll
            for (int tt = 0; tt < 64; ++tt) gt[tt * 64 + tid] = f2bf(acc[tt]);
        } else {
#pragma unroll
            for (int tt = 0; tt < 64; ++tt) gt[4096 + tt * 64 + (tid - 64)] = f2bf(-acc[tt]);
        }
    }
}

__device__ __forceinline__ void gdn_scan_task(char* smem, const bf16_t* __restrict__ gt_all, const float* __restrict__ glast, const bf16_t* __restrict__ proj, const float* __restrict__ mix_gain,
                                              bf16_t* __restrict__ y, int bh) {
    bf16_t* sT = (bf16_t*)smem;
    bf16_t* sST = sT + 2 * 5 * 64 * TLD;
    bf16_t* sVn = sST + 2 * 64 * TLD;
    const int tid = threadIdx.x, lane = tid & 63, wave = tid >> 6, g = lane >> 4, li = lane & 15;
    const int b = bh >> 2, h = bh & 3;
    const int sr = tid >> 3, sc8 = (tid & 7) * 8;
    const bf16_t* gsrc = gt_all + (size_t)bh * 32 * 5 * 4096 + sr * 64 + sc8;
    __syncthreads();
    u32x4 regs[5];
#pragma unroll
    for (int i = 0; i < 5; ++i) regs[i] = *(const u32x4*)(gsrc + i * 4096);
#pragma unroll
    for (int i = 0; i < 5; ++i) *(u32x4*)(sT + i * 64 * TLD + sr * TLD + sc8) = regs[i];
    *(u32x4*)(sST + sr * TLD + sc8) = (u32x4){0u, 0u, 0u, 0u};
    f32x4 sacc[4];
#pragma unroll
    for (int i = 0; i < 4; ++i) sacc[i] = (f32x4){0.f, 0.f, 0.f, 0.f};
    __syncthreads();
    for (int n = 0; n < 32; ++n) {
        const int buf = n & 1;
        const bf16_t* cT = sT + buf * 5 * 64 * TLD;
        const bf16_t* sU = cT; const bf16_t* sWn = cT + 64 * TLD; const bf16_t* sQd = cT + 2 * 64 * TLD; const bf16_t* sKd = cT + 3 * 64 * TLD; const bf16_t* sAq = cT + 4 * 64 * TLD;
        const bf16_t* cST = sST + buf * 64 * TLD; bf16_t* nST = sST + (buf ^ 1) * 64 * TLD;
        if (n + 1 < 32) {
#pragma unroll
            for (int i = 0; i < 5; ++i) regs[i] = *(const u32x4*)(gsrc + (size_t)(n + 1) * 5 * 4096 + i * 4096);
        }
        const size_t rowz = (size_t)(b * SEQ + n * 64 + (wave & 3) * 16 + li);
        uint2 zraw[4];
        if (wave < 4) {
#pragma unroll
            for (int vt = 0; vt < 4; ++vt) zraw[vt] = *(const uint2*)(proj + rowz * NP + C_DZ + h * 64 + vt * 16 + 4 * g);
        }
#pragma unroll
        for (int i = 0; i < 2; ++i) {
            const int idx = wave * 2 + i, tt = idx >> 2, vt = idx & 3;
            const int tq = tt * 16 + li, v0 = vt * 16 + 4 * g;
            const uint2 uraw = *(const uint2*)(sU + tq * TLD + v0);
            f32x4 acc = (f32x4){__uint_as_float(uraw.x << 16), __uint_as_float(uraw.x & 0xffff0000u), __uint_as_float(uraw.y << 16), __uint_as_float(uraw.y & 0xffff0000u)};
#pragma unroll
            for (int ks = 0; ks < 2; ++ks) acc = MFMA16(frag_rm(cST, TLD, vt * 16, ks * 32, lane), frag_rm(sWn, TLD, tt * 16, ks * 32, lane), acc);
            uint2 o; o.x = pk2(acc[0], acc[1]); o.y = pk2(acc[2], acc[3]);
            *(uint2*)(sVn + tq * TLD + v0) = o;
        }
        __syncthreads();
        if (wave < 4) {
            const int tt = wave;
            f32x4 oacc[4]; float ms = 0.f;
#pragma unroll
            for (int vt = 0; vt < 4; ++vt) {
                f32x4 acc = (f32x4){0.f, 0.f, 0.f, 0.f};
#pragma unroll
                for (int ks = 0; ks < 2; ++ks) acc = MFMA16(frag_rm(cST, TLD, vt * 16, ks * 32, lane), frag_rm(sQd, TLD, tt * 16, ks * 32, lane), acc);
#pragma unroll
                for (int ks = 0; ks < 2; ++ks) acc = MFMA16(frag_cm(sVn, TLD, ks * 32, vt * 16, lane), frag_rm(sAq, TLD, tt * 16, ks * 32, lane), acc);
                oacc[vt] = acc; ms += acc[0] * acc[0] + acc[1] * acc[1] + acc[2] * acc[2] + acc[3] * acc[3];
            }
            ms += __shfl_xor(ms, 16); ms += __shfl_xor(ms, 32);
            const float rinv = rsqrtf(ms * (1.f / 64.f) + EPS);
#pragma unroll
            for (int vt = 0; vt < 4; ++vt) {
                const int v0 = vt * 16 + 4 * g;
                const f32x4 mgv = *(const f32x4*)(mix_gain + 768 + h * 64 + v0);
                const float z0 = __uint_as_float(zraw[vt].x << 16), z1 = __uint_as_float(zraw[vt].x & 0xffff0000u), z2 = __uint_as_float(zraw[vt].y << 16), z3 = __uint_as_float(zraw[vt].y & 0xffff0000u);
                uint2 o; o.x = pk2(oacc[vt][0] * rinv * siluf_(z0) * mgv[0], oacc[vt][1] * rinv * siluf_(z1) * mgv[1]);
                o.y = pk2(oacc[vt][2] * rinv * siluf_(z2) * mgv[2], oacc[vt][3] * rinv * siluf_(z3) * mgv[3]);
                *(uint2*)(y + rowz * 1024 + 768 + h * 64 + v0) = o;
            }
        } else {
            const int kt = wave - 4;
            const float gl = glast[bh * 32 + n];
#pragma unroll
            for (int vt = 0; vt < 4; ++vt) {
                f32x4 acc = sacc[vt] * gl;
#pragma unroll
                for (int ks = 0; ks < 2; ++ks) acc = MFMA16(frag_cm(sKd, TLD, ks * 32, kt * 16, lane), frag_cm(sVn, TLD, ks * 32, vt * 16, lane), acc);
                sacc[vt] = acc;
                uint2 o; o.x = pk2(acc[0], acc[1]); o.y = pk2(acc[2], acc[3]);
                *(uint2*)(nST + (vt * 16 + li) * TLD + kt * 16 + 4 * g) = o;
            }
        }
        if (n + 1 < 32) {
            bf16_t* nT = sT + (buf ^ 1) * 5 * 64 * TLD;
#pragma unroll
            for (int i = 0; i < 5; ++i) *(u32x4*)(nT + i * 64 * TLD + sr * TLD + sc8) = regs[i];
        }
        __syncthreads();
    }
}


constexpr int XLD = 264;
__device__ __forceinline__ void lru_local_task(char* smem, const bf16_t* __restrict__ proj, const float* __restrict__ conv_w, const float* __restrict__ conv_b,
                                               const float* __restrict__ w_a, const float* __restrict__ b_a, const float* __restrict__ w_x, const float* __restrict__ b_x,
                                               const float* __restrict__ lam, float* __restrict__ hl_out, float* __restrict__ ac_out, float* __restrict__ lsum, int task) {
    bf16_t* sX = (bf16_t*)smem;
    bf16_t* sW = sX + 64 * XLD;
    float* sAa = (float*)(sW + 2 * 64 * TLD);
    float* sU = sAa + 64 * 65;
    float* sSegA = sU + 64 * 65; float* sSegH = sSegA + 8 * 64;
    const int tid = threadIdx.x, lane = tid & 63, wave = tid >> 6, g = lane >> 4, li = lane & 15;
    const int b = task >> 5, n = task & 31;
    const size_t row0 = (size_t)(b * SEQ + n * 64);
    const int t = tid >> 3;
    __syncthreads();
    {
        const int spos = n * 64 + t;
#pragma unroll
        for (int i = 0; i < 4; ++i) {
            const int c8 = ((tid & 7) + 8 * i) * 8;
            float acc[8];
            { const f32x4 cb0 = *(const f32x4*)(conv_b + c8), cb1 = *(const f32x4*)(conv_b + c8 + 4);
#pragma unroll
              for (int e = 0; e < 8; ++e) acc[e] = e < 4 ? cb0[e] : cb1[e - 4]; }
#pragma unroll
            for (int j = 0; j < 4; ++j) {
                if (spos - (3 - j) >= 0) {
                    const u32x4 raw = *(const u32x4*)(proj + (row0 + t - (3 - j)) * NP + C_CX + c8);
                    const f32x4 w0 = *(const f32x4*)(conv_w + j * 256 + c8), w1 = *(const f32x4*)(conv_w + j * 256 + c8 + 4);
#pragma unroll
                    for (int e = 0; e < 8; ++e) acc[e] += (e < 4 ? w0[e] : w1[e - 4]) * bfx(raw, e);
                }
            }
            u32x4 o; o[0] = pk2(acc[0], acc[1]); o[1] = pk2(acc[2], acc[3]); o[2] = pk2(acc[4], acc[5]); o[3] = pk2(acc[6], acc[7]);
            *(u32x4*)(sX + t * XLD + c8) = o;
        }
    }
    for (int hh = 0; hh < 4; ++hh) {
        {
            const int i = tid >> 3, j8 = (tid & 7) * 8;
#pragma unroll
            for (int m = 0; m < 2; ++m) {
                const float* src = (m == 0 ? w_a : w_x) + (size_t)hh * 4096 + i * 64 + j8;
                const f32x4 v0 = *(const f32x4*)src, v1 = *(const f32x4*)(src + 4);
                u32x4 o; o[0] = pk2(v0[0], v0[1]); o[1] = pk2(v0[2], v0[3]); o[2] = pk2(v1[0], v1[1]); o[3] = pk2(v1[2], v1[3]);
                *(u32x4*)(sW + m * 64 * TLD + i * TLD + j8) = o;
            }
        }
        __syncthreads();
#pragma unroll
        for (int i2 = 0; i2 < 2; ++i2) {
            const int idx = wave * 2 + i2, tt = idx >> 2, jt = idx & 3;
            f32x4 ra = (f32x4){0.f, 0.f, 0.f, 0.f}, rx = (f32x4){0.f, 0.f, 0.f, 0.f};
#pragma unroll
            for (int ks = 0; ks < 2; ++ks) {
                const bf16x8 xf = frag_rm(sX + hh * 64, XLD, tt * 16, ks * 32, lane);
                ra = MFMA16(frag_cm(sW, TLD, ks * 32, jt * 16, lane), xf, ra);
                rx = MFMA16(frag_cm(sW + 64 * TLD, TLD, ks * 32, jt * 16, lane), xf, rx);
            }
            const int tq = tt * 16 + li, cl = jt * 16 + 4 * g, c = hh * 64 + cl;
            const f32x4 ba = *(const f32x4*)(b_a + c), bx = *(const f32x4*)(b_x + c), lm = *(const f32x4*)(lam + c);
            const uint2 xraw = *(const uint2*)(sX + tq * XLD + c);
            const float xc[4] = {__uint_as_float(xraw.x << 16), __uint_as_float(xraw.x & 0xffff0000u), __uint_as_float(xraw.y << 16), __uint_as_float(xraw.y & 0xffff0000u)};
#pragma unroll
            for (int r = 0; r < 4; ++r) {
                const float rr = sigmoidf_(ra[r] + ba[r]), ig = sigmoidf_(rx[r] + bx[r]);
                const float log_a = -8.f * rr * softplusf_(-lm[r]);
                sAa[tq * 65 + cl + r] = __expf(log_a);
                sU[tq * 65 + cl + r] = sqrtf(-expm1f(2.f * log_a)) * (ig * xc[r]);
            }
        }
        __syncthreads();
        const int cl = tid & 63, seg = tid >> 6;
        float Al[8], Hl[8];
        { float A = 1.f, H = 0.f;
#pragma unroll
          for (int i = 0; i < 8; ++i) { const float a = sAa[(seg * 8 + i) * 65 + cl], u = sU[(seg * 8 + i) * 65 + cl]; H = a * H + u; A *= a; Al[i] = A; Hl[i] = H; }
          sSegA[seg * 64 + cl] = A; sSegH[seg * 64 + cl] = H; }
        __syncthreads();
        { float Ac = 1.f, Hc = 0.f;
          for (int s2 = 0; s2 < seg; ++s2) { const float a = sSegA[s2 * 64 + cl]; Hc = a * Hc + sSegH[s2 * 64 + cl]; Ac *= a; }
#pragma unroll
          for (int i = 0; i < 8; ++i) {
              const size_t o = (row0 + seg * 8 + i) * 256 + hh * 64 + cl;
              const float hv = Hl[i] + Al[i] * Hc, av = Al[i] * Ac;
              hl_out[o] = hv; ac_out[o] = av;
              if (seg == 7 && i == 7) { lsum[(size_t)task * 256 + hh * 64 + cl] = av; lsum[(size_t)(256 + task) * 256 + hh * 64 + cl] = hv; }
          } }
        __syncthreads();
    }
}
__device__ __forceinline__ void lru_out_task(const float* __restrict__ hl_in, const float* __restrict__ ac_in, const float* __restrict__ lsum, const bf16_t* __restrict__ proj,
                                             const float* __restrict__ mix_gain, bf16_t* __restrict__ y, int task) {
    const int b = task >> 5, n = task & 31, c = threadIdx.x & 255, half = threadIdx.x >> 8;
    const float Hc = lsum[(size_t)task * 256 + c];
    const float mg = mix_gain[512 + c];
    const size_t row0 = (size_t)(b * SEQ + n * 64 + half * 32);
#pragma unroll 4
    for (int i = 0; i < 32; ++i) {
        const size_t row = row0 + i;
        const float hv = hl_in[row * 256 + c] + ac_in[row * 256 + c] * Hc;
        const float yv = hv * geluf_(bf2f(proj[row * NP + C_CG + c]));
        const float ms = wave_sum(yv * yv) * (1.f / 64.f);
        y[row * 1024 + 512 + c] = f2bf(yv * rsqrtf(ms + EPS) * mg);
    }
}


__device__ __forceinline__ void state_scan_phase(const float* __restrict__ HL, const float* __restrict__ HD, bf16_t* __restrict__ HS, const float* __restrict__ lsum, float* __restrict__ lcar) {
    const int bx = blockIdx.x, tid = threadIdx.x;
    for (int u = bx; u < 128 + 4; u += gridDim.x) {
        if (u < 128) {
            const int gid = u * NTHR + tid, bh = gid >> 11, v = gid & 63, kp = (gid >> 6) & 31;
            const float* Lb = HL + (size_t)bh * 32 * 4096 + (2 * kp) * 64 + v; const float* Db = HD + (size_t)bh * 32 * 64 + 2 * kp;
            bf16_t* Sb = HS + (size_t)bh * 32 * 4096 + (2 * kp) * 64 + v;
            float S0 = 0.f, S1 = 0.f;
            for (int n0 = 0; n0 < 32; n0 += 8) {
                float l0[8], l1[8], d0[8], d1[8];
#pragma unroll
                for (int i = 0; i < 8; ++i) { l0[i] = Lb[(size_t)(n0 + i) * 4096]; l1[i] = Lb[(size_t)(n0 + i) * 4096 + 64]; d0[i] = Db[(n0 + i) * 64]; d1[i] = Db[(n0 + i) * 64 + 1]; }
#pragma unroll
                for (int i = 0; i < 8; ++i) {
                    Sb[(size_t)(n0 + i) * 4096] = f2bf(S0); Sb[(size_t)(n0 + i) * 4096 + 64] = f2bf(S1);
                    S0 = d0[i] * S0 + l0[i]; S1 = d1[i] * S1 + l1[i];
                }
            }
        } else {
            const int gid = (u - 128) * NTHR + tid, b = gid >> 8, c = gid & 255;
            float A[32], H[32];
#pragma unroll
            for (int n = 0; n < 32; ++n) { A[n] = lsum[(size_t)(b * 32 + n) * 256 + c]; H[n] = lsum[(size_t)(256 + b * 32 + n) * 256 + c]; }
            float Hc = 0.f;
#pragma unroll
            for (int n = 0; n < 32; ++n) { lcar[(size_t)(b * 32 + n) * 256 + c] = Hc; Hc = A[n] * Hc + H[n]; }
        }
    }
}

__device__ __forceinline__ void router_phase(char* smem, const float* __restrict__ x, const float* __restrict__ g, const float* __restrict__ w_rg, const float* __restrict__ b_rg,
                                             const float* __restrict__ w_re, const float* __restrict__ b_re, bf16_t* __restrict__ hn, int* __restrict__ cnt, int* __restrict__ list, float* __restrict__ pgate) {
    float* sXg = (float*)smem;
    float* sWr = sXg + 64 * 132;
    float* sLog = sWr + 128 * 40;
    float* sRinv = sLog + 64 * 40;
    const int tid = threadIdx.x;
    BLK_LOOP(tile, T / 64) {
        const int t0 = tile * 64;
        const int stok = tid >> 3;
        const int ctok = tid & 63, eg = tid >> 6;
        float acc[5] = {0.f, 0.f, 0.f, 0.f, 0.f};
        float ss = 0.f;
        for (int kc = 0; kc < 8; ++kc) {
            __syncthreads();
#pragma unroll
            for (int i = 0; i < 4; ++i) {
                const int col = ((tid & 7) + 8 * i) * 4;
                const f32x4 xv = *(const f32x4*)(x + (size_t)(t0 + stok) * 1024 + kc * 128 + col);
                const f32x4 gv = *(const f32x4*)(g + kc * 128 + col);
                ss += xv[0] * xv[0] + xv[1] * xv[1] + xv[2] * xv[2] + xv[3] * xv[3];
                *(f32x4*)(sXg + stok * 132 + col) = xv * gv;
            }
            for (int idx = tid; idx < 128 * 40; idx += NTHR) {
                const int k = idx / 40, e = idx - k * 40;
                float wv = 0.f;
                if (e < 4) wv = w_rg[(size_t)(kc * 128 + k) * 4 + e]; else if (e < 36) wv = w_re[(size_t)(kc * 128 + k) * 32 + (e - 4)];
                sWr[idx] = wv;
            }
            __syncthreads();
#pragma unroll 2
            for (int k4 = 0; k4 < 128; k4 += 4) {
                const f32x4 hv = *(const f32x4*)(sXg + ctok * 132 + k4);
#pragma unroll
                for (int kk = 0; kk < 4; ++kk) {
                    const float* wp = sWr + (k4 + kk) * 40 + eg * 5;
#pragma unroll
                    for (int j = 0; j < 5; ++j) acc[j] += hv[kk] * wp[j];
                }
            }
        }
        ss += __shfl_xor(ss, 1); ss += __shfl_xor(ss, 2); ss += __shfl_xor(ss, 4);
        if ((tid & 7) == 0) sRinv[stok] = rsqrtf(ss * (1.f / 1024.f) + EPS);
#pragma unroll
        for (int j = 0; j < 5; ++j) sLog[ctok * 40 + eg * 5 + j] = acc[j];
        __syncthreads();
        if (tid < 64) {
            const int t = t0 + tid; const float rinv = sRinv[tid];
            float lg[4];
#pragma unroll
            for (int i = 0; i < 4; ++i) lg[i] = sLog[tid * 40 + i] * rinv + b_rg[i];
            int gs = 0; float gm = lg[0];
#pragma unroll
            for (int i = 1; i < 4; ++i) if (lg[i] > gm) { gm = lg[i]; gs = i; }
            float den = 0.f;
#pragma unroll
            for (int i = 0; i < 4; ++i) den += __expf(lg[i] - gm);
            const float pg = 1.f / den;
            int i0 = 0, i1 = -1; float m0 = -INFINITY, m1 = -INFINITY;
            for (int i = 0; i < 8; ++i) {
                const float v = sLog[tid * 40 + 4 + gs * 8 + i] * rinv + b_re[gs * 8 + i];
                if (v > m0) { m1 = m0; i1 = i0; m0 = v; i0 = i; } else if (v > m1) { m1 = v; i1 = i; }
            }
            const float e1 = __expf(m1 - m0); const float w0 = 1.f / (1.f + e1), w1 = e1 / (1.f + e1);
            const int ex0 = gs * 8 + i0, ex1 = gs * 8 + i1;
            const int pos0 = atomicAdd(&cnt[ex0], 1); list[(size_t)ex0 * T + pos0] = 2 * t; pgate[2 * t] = pg * w0;
            const int pos1 = atomicAdd(&cnt[ex1], 1); list[(size_t)ex1 * T + pos1] = 2 * t + 1; pgate[2 * t + 1] = pg * w1;
        }
        {
            const float rinv = sRinv[stok];
#pragma unroll 4
            for (int i = 0; i < 32; ++i) {
                const int col = ((tid & 7) + 8 * i) * 4;
                const f32x4 xv = *(const f32x4*)(x + (size_t)(t0 + stok) * 1024 + col);
                const f32x4 gv = *(const f32x4*)(g + col);
                uint2 o; o.x = pk2(xv[0] * gv[0] * rinv, xv[1] * gv[1] * rinv); o.y = pk2(xv[2] * gv[2] * rinv, xv[3] * gv[3] * rinv);
                *(uint2*)(hn + (size_t)(t0 + stok) * 1024 + col) = o;
            }
        }
    }
}

__device__ __forceinline__ void combine_phase(const float* x2, const bf16_t* __restrict__ eo, const float* __restrict__ g, float* xout, bf16_t* __restrict__ hn, int mode) {
    const int lane = threadIdx.x & 63;
    for (int t = blockIdx.x * 8 + (threadIdx.x >> 6); t < T; t += gridDim.x * 8) {
        f32x4 v[4]; float s = 0.f;
#pragma unroll
        for (int j = 0; j < 4; ++j) {
            const int c = (lane + 64 * j) * 4;
            v[j] = *(const f32x4*)(x2 + (size_t)t * 1024 + c);
            const uint2 e0 = *(const uint2*)(eo + (size_t)(2 * t) * 1024 + c), e1 = *(const uint2*)(eo + (size_t)(2 * t + 1) * 1024 + c);
            v[j].x += __uint_as_float(e0.x << 16) + __uint_as_float(e1.x << 16);
            v[j].y += __uint_as_float(e0.x & 0xffff0000u) + __uint_as_float(e1.x & 0xffff0000u);
            v[j].z += __uint_as_float(e0.y << 16) + __uint_as_float(e1.y << 16);
            v[j].w += __uint_as_float(e0.y & 0xffff0000u) + __uint_as_float(e1.y & 0xffff0000u);
            s += v[j].x * v[j].x + v[j].y * v[j].y + v[j].z * v[j].z + v[j].w * v[j].w;
        }
        const float rinv = rsqrtf(wave_sum(s) * (1.f / 1024.f) + EPS);
#pragma unroll
        for (int j = 0; j < 4; ++j) {
            const int c = (lane + 64 * j) * 4;
            const f32x4 gg = *(const f32x4*)(g + c);
            const f32x4 hv = v[j] * rinv * gg;
            if (mode == 0) {
                *(f32x4*)(xout + (size_t)t * 1024 + c) = v[j];
                uint2 o; o.x = pk2(hv.x, hv.y); o.y = pk2(hv.z, hv.w);
                *(uint2*)(hn + (size_t)t * 1024 + c) = o;
            } else {
                *(f32x4*)(xout + (size_t)t * 1024 + c) = hv;
            }
        }
    }
}

template <int l>
__device__ __forceinline__ void layer_body(const Params& P, char* smem, const XcdBarrier& xb, const float* xcur) {
    char* ws = P.ws;
    bf16_t* Wt_in = (bf16_t*)(ws + OFF_WIN); bf16_t* Wt_out = (bf16_t*)(ws + OFF_WOUT); bf16_t* Wt_mq = (bf16_t*)(ws + OFF_WMQ); bf16_t* Wt_mkv = (bf16_t*)(ws + OFF_WMKV);
    bf16_t* Wt_mo = (bf16_t*)(ws + OFF_WMO); bf16_t* Wt_gu = (bf16_t*)(ws + OFF_WGU); bf16_t* Wt_dn = (bf16_t*)(ws + OFF_WDN);
    bf16_t* hn = (bf16_t*)(ws + OFF_HN); bf16_t* proj = (bf16_t*)(ws + OFF_PROJ); float* gates = (float*)(ws + OFF_GATES); bf16_t* y = (bf16_t*)(ws + OFF_Y);
    float* XA = P.out; float* XB = (float*)(ws + OFF_XB);
    bf16_t* qm = (bf16_t*)(ws + OFF_QM); bf16_t* om = (bf16_t*)(ws + OFF_OM); bf16_t* kvm = (bf16_t*)(ws + OFF_KVM); bf16_t* memn = (bf16_t*)(ws + OFF_MEMN);
    float* foxc = (float*)(ws + OFF_FOXC); float* lrua = (float*)(ws + OFF_LRUA); float* lruu = (float*)(ws + OFF_LRUU);
    int* cnt_all = (int*)(ws + OFF_CTL) + CTL_CNT_WORD; int* list = (int*)(ws + OFF_LIST); float* pgate = (float*)(ws + OFF_PGATE);
    bf16_t* act = (bf16_t*)(ws + OFF_ACT); bf16_t* eo = (bf16_t*)(ws + OFF_EO);
    const int wave = threadIdx.x >> 6, lane = threadIdx.x & 63;


        float* x1 = (l == 0) ? XA : XB;
        float* x2 = (l == 0) ? XB : XA;
        int* cnt = cnt_all + 32 * l;
        const float* mg = P.in[I_MIX_GAIN] + l * 1024;
        REP(2, gemm_phase<EPI_INPROJ>(smem, hn, 1024, Wt_in + (size_t)l * NP * 1024, 1024, T, NP, 1024, proj, NP, nullptr, gates));
        if (l == 0) for (int l2 = 0; l2 < NL; ++l2)
            gemm_phase<EPI_BF16>(smem, memn + (size_t)l2 * 2048 * 1024, 1024, Wt_mkv + (size_t)l2 * 512 * 1024, 1024, 2048, 512, 1024, kvm + (size_t)l2 * 2048 * 512, 512, nullptr, nullptr);
        GSYNC();
        REP(4,         {
            const int bx = blockIdx.x;
            bf16_t* gtiles = (bf16_t*)(ws + OFF_GDN); float* glast = (float*)(ws + OFF_GLAST);
            if (bx < 32 && wave == 1) fox_cumsum(gates, P.in[I_FOX_FB] + l * 4, foxc, bx, lane);
            BLK_LOOP(ch, 1024) gdn_prep_task(smem, proj, gates, P.in[I_GDN_CONV_W] + l * 4 * 768, P.in[I_GDN_A_LOG] + l * 4, P.in[I_GDN_DT_BIAS] + l * 4, gtiles, glast, ch);
            BLK_LOOP(ch, 1024) hgrn_local_task(smem, proj, P.in[I_HGRN_LB], l, (float*)(ws + OFF_HL), (float*)(ws + OFF_HD), ch);
            BLK_LOOP(task, 256) lru_local_task(smem, proj, P.in[I_LRU_CONV_W] + l * 1024, P.in[I_LRU_CONV_B] + l * 256, P.in[I_LRU_WA] + l * 16384, P.in[I_LRU_BA] + l * 256,
                                               P.in[I_LRU_WX] + l * 16384, P.in[I_LRU_BX] + l * 256, P.in[I_LRU_LAM] + l * 256, lrua, lruu, (float*)(ws + OFF_LSUM), task);
        });
        GSYNC();
        state_scan_phase((const float*)(ws + OFF_HL), (const float*)(ws + OFF_HD), (bf16_t*)(ws + OFF_HS), (const float*)(ws + OFF_LSUM), (float*)(ws + OFF_LCAR));
        GSYNC();
        REP(8,         {
            const int natt = (SEQ / 128) * 4 * NB;
            const int bx = blockIdx.x, nfree = (int)gridDim.x - 32;
            if (bx < 32) gdn_scan_task(smem, (const bf16_t*)(ws + OFF_GDN), (const float*)(ws + OFF_GLAST), proj, mg, y, bx);
            else {
                for (int r = 0; r * nfree < natt; ++r) {
                    const int i = r * nfree + ((r & 1) ? (nfree - 1 - (bx - 32)) : (bx - 32));
                    if (i >= natt) continue;
                    const int qt = 15 - (i >> 5), bh = i & 31;
                    attn_task(smem, proj + C_BQ, NP, proj + C_BK, NP, proj + C_BV, NP, foxc, SEQ, SEQ, 1, 0.125f, y + 256, 1024, mg + 256, 1, (bh * 16) + qt);
                }
                for (int i = bx - 32; i < 1024; i += nfree) {
                    const int ch = (i & 31) * 32 + (31 - (i >> 5));
                    hgrn_out_task(smem, proj, P.in[I_HGRN_LB], l, (const bf16_t*)(ws + OFF_HS), mg, y, ch);
                }
                for (int i = bx - 32; i < 256; i += nfree) lru_out_task(lrua, lruu, (const float*)(ws + OFF_LCAR), proj, mg, y, i);
            }
        });
        GSYNC();
        REP(16, gemm_phase<EPI_RESID>(smem, y, 1024, Wt_out + (size_t)l * 1024 * 1024, 1024, T, 1024, 1024, x1, 1024, xcur, nullptr));
        GSYNC();
        REP(32, for (int row = blockIdx.x * 8 + wave; row < T; row += gridDim.x * 8) rms_row_bf16(x1 + (size_t)row * 1024, P.in[I_NORM_MEM] + l * 1024, hn + (size_t)row * 1024, lane));
        GSYNC();
        REP(64, gemm_phase<EPI_BF16>(smem, hn, 1024, Wt_mq + (size_t)l * 256 * 1024, 1024, T, 256, 1024, qm, 256, nullptr, nullptr));
        GSYNC();
        { const bf16_t* kv = kvm + (size_t)l * 2048 * 512;
          REP(128, BLK_LOOP(task, (SEQ / 128) * 4 * NB) attn_task(smem, qm, 256, kv, 512, kv + 256, 512, nullptr, SEQ, MEMLEN, 0, 0.125f, om, 256, nullptr, 0, task)); }
        GSYNC();
        REP(256, gemm_phase<EPI_RESID>(smem, om, 256, Wt_mo + (size_t)l * 1024 * 256, 256, T, 1024, 256, x2, 1024, x1, nullptr));
        GSYNC();
        router_phase(smem, x2, P.in[I_NORM_FFN] + l * 1024, P.in[I_W_RG] + l * 4096, P.in[I_B_RG] + l * 4, P.in[I_W_RE] + l * 32768, P.in[I_B_RE] + l * 32, hn, cnt, list, pgate);
        GSYNC();
        REP(512, moe_phase<1>(smem, hn, 1024, Wt_gu + (size_t)l * 32 * 512 * 1024, (size_t)512 * 1024, 1024, 1024, cnt, list, pgate, act));
        GSYNC();
        REP(1024, moe_phase<2>(smem, act, 256, Wt_dn + (size_t)l * 32 * 1024 * 256, (size_t)1024 * 256, 256, 256, cnt, list, pgate, eo));
        if (PROBE_MASK & 2048) { for (int i = 0; i < 10; ++i) GSYNC(); }
        GSYNC();
        if (l == 0) { combine_phase(x2, eo, P.in[I_NORM_MIX] + 1024, XA, hn, 0); GSYNC(); }
        else combine_phase(x2, eo, P.in[I_NORM_FINAL], P.out, hn, 1);
}
__global__ void __launch_bounds__(NTHR, 2) mega_kernel(Params P) {
    extern __shared__ __attribute__((aligned(16))) char smem[];
    cg::grid_group grid = cg::this_grid();
    volatile LDS_AS unsigned* st = (volatile LDS_AS unsigned*)(smem + LDS_BYTES - 16);
    if (threadIdx.x < 4) st[threadIdx.x] = 0u;
    __syncthreads();
    const XcdBarrier xb = xcd_barrier_post((unsigned*)(P.ws + OFF_CTL), st);
    phase0(P, smem);
    grid.sync();
    layer_body<0>(P, smem, xb, P.in[I_X]);
    layer_body<1>(P, smem, xb, P.out);
}

extern "C" void kernel_launch(void* const* d_in, const int* in_sizes, int n_in, void* d_out, int out_size, void* d_ws, size_t ws_size, hipStream_t stream) {
    static int grid_blocks = 0;
    if (grid_blocks == 0) {
        if (n_in != N_INPUTS || ws_size < OFF_END || out_size != T * 1024) { fprintf(stderr, "kernel_launch: unexpected sizes n_in=%d ws=%zu out=%d (need ws >= %zu)\n", n_in, ws_size, out_size, (size_t)OFF_END); grid_blocks = -1; return; }
        int dev = 0, cus = 0, per_cu = 0;
        if (hipGetDevice(&dev) != hipSuccess || hipDeviceGetAttribute(&cus, hipDeviceAttributeMultiprocessorCount, dev) != hipSuccess) { fprintf(stderr, "kernel_launch: device query failed\n"); grid_blocks = -1; return; }
        if (hipFuncSetAttribute((const void*)mega_kernel, hipFuncAttributeMaxDynamicSharedMemorySize, LDS_BYTES) != hipSuccess) { fprintf(stderr, "kernel_launch: hipFuncSetAttribute failed\n"); grid_blocks = -1; return; }
        if (hipOccupancyMaxActiveBlocksPerMultiprocessor(&per_cu, (const void*)mega_kernel, NTHR, LDS_BYTES) != hipSuccess || per_cu < 1) { fprintf(stderr, "kernel_launch: occupancy query says %d blocks/CU\n", per_cu); grid_blocks = -1; return; }
        grid_blocks = cus;
        fprintf(stderr, "kernel_launch: cus=%d per_cu=%d grid=%d\n", cus, per_cu, grid_blocks);
    }
    if (grid_blocks < 0) return;
    if (hipMemsetAsync((char*)d_ws + OFF_CTL, 0, CTL_BYTES, stream) != hipSuccess) { fprintf(stderr, "kernel_launch: memset failed\n"); return; }
    Params p; memset(&p, 0, sizeof p);
    for (int i = 0; i < N_INPUTS; ++i) p.in[i] = (const float*)d_in[i];
    p.out = (float*)d_out; p.ws = (char*)d_ws;
    void* args[] = {&p};
    hipError_t e = hipLaunchCooperativeKernel((const void*)mega_kernel, dim3(grid_blocks), dim3(NTHR), args, LDS_BYTES, stream);
    if (e != hipSuccess) fprintf(stderr, "kernel_launch: cooperative launch failed: %s (grid %d)\n", hipGetErrorString(e), grid_blocks);
}
```

```cpp
#include <hip/hip_runtime.h>
#include <stdint.h>
#include <stdio.h>
#include <string.h>
#include <hip/hip_cooperative_groups.h>
namespace cg = cooperative_groups;

typedef unsigned short bf16_t;
typedef short bf16x8 __attribute__((ext_vector_type(8)));
typedef float f32x4 __attribute__((ext_vector_type(4)));
typedef unsigned u32x4 __attribute__((ext_vector_type(4)));

constexpr int NB = 8, SEQ = 2048, DM = 1024, T = NB * SEQ, NL = 2;
constexpr int NP = 3584;
constexpr int NIN = 3340;
constexpr int C_AQ = 0, C_AF = 256, C_AI = 512, C_AG = 768, C_BQ = 1024, C_BK = 1280, C_BV = 1536, C_CX = 1792, C_CG = 2048,
              C_DQ = 2304, C_DK = 2560, C_DV = 2816, C_DZ = 3072, C_GATE = 3328;
constexpr int MEMLEN = 256;
constexpr int NEXP = 32, DEXP = 256;
constexpr float EPS = 1e-6f;

constexpr size_t al256(size_t x) { return (x + 255) & ~(size_t)255; }
constexpr size_t SZ_WIN = (size_t)NP * 1024 * 2, SZ_WOUT = (size_t)1024 * 1024 * 2, SZ_WMQ = (size_t)256 * 1024 * 2, SZ_WMKV = (size_t)512 * 1024 * 2,
                 SZ_WMO = (size_t)1024 * 256 * 2, SZ_WGU = (size_t)32 * 512 * 1024 * 2, SZ_WDN = (size_t)32 * 1024 * 256 * 2;
constexpr size_t OFF_WIN = 0;
constexpr size_t OFF_WOUT = OFF_WIN + NL * SZ_WIN;
constexpr size_t OFF_WMQ = OFF_WOUT + NL * SZ_WOUT;
constexpr size_t OFF_WMKV = OFF_WMQ + NL * SZ_WMQ;
constexpr size_t OFF_WMO = OFF_WMKV + NL * SZ_WMKV;
constexpr size_t OFF_WGU = OFF_WMO + NL * SZ_WMO;
constexpr size_t OFF_WDN = OFF_WGU + NL * SZ_WGU;
constexpr size_t OFF_HN = OFF_WDN + NL * SZ_WDN;
constexpr size_t OFF_PROJ = OFF_HN + (size_t)T * 1024 * 2;
constexpr size_t OFF_GATES = OFF_PROJ + (size_t)T * NP * 2;
constexpr size_t OFF_Y = OFF_GATES + (size_t)T * 16 * 4;
constexpr size_t OFF_XB = OFF_Y + (size_t)T * 1024 * 2;
constexpr size_t OFF_QM = OFF_XB + (size_t)T * 1024 * 4;
constexpr size_t OFF_OM = OFF_QM + (size_t)T * 256 * 2;
constexpr size_t OFF_KVM = OFF_OM + (size_t)T * 256 * 2;
constexpr size_t OFF_MEMN = OFF_KVM + (size_t)NL * 2048 * 512 * 2;
constexpr size_t OFF_FOXC = OFF_MEMN + (size_t)2048 * 1024 * 2;
constexpr size_t OFF_LRUA = OFF_FOXC + (size_t)NB * 4 * SEQ * 4;
constexpr size_t OFF_LRUU = OFF_LRUA + (size_t)T * 256 * 4;
constexpr size_t OFF_CNT = OFF_LRUU + (size_t)T * 256 * 4;
constexpr size_t OFF_LIST = OFF_CNT + 256;
constexpr size_t OFF_PGATE = OFF_LIST + (size_t)NEXP * T * 4;
constexpr size_t OFF_HL = OFF_PGATE + (size_t)2 * T * 4;
constexpr size_t OFF_HD = OFF_HL + (size_t)1024 * 4096 * 4;
constexpr size_t OFF_GDN = OFF_HD + (size_t)1024 * 64 * 4;
constexpr size_t OFF_GLAST = OFF_GDN + (size_t)1024 * 5 * 4096 * 2;
constexpr size_t OFF_LSUM = OFF_GLAST + 4096;
constexpr size_t OFF_HS = OFF_LSUM + (size_t)2 * 256 * 256 * 4;
constexpr size_t OFF_LCAR = OFF_HS + (size_t)1024 * 4096 * 2;
constexpr size_t OFF_CTL = OFF_LCAR + (size_t)256 * 256 * 4;
constexpr size_t CTL_BYTES = 16384;
constexpr int CTL_CNT_WORD = 3584;
constexpr size_t OFF_END = OFF_CTL + CTL_BYTES;
constexpr size_t OFF_ACT = OFF_PROJ;
constexpr size_t OFF_EO = OFF_PROJ + (size_t)2 * T * 256 * 2;
static_assert(OFF_EO + (size_t)2 * T * 1024 * 2 <= OFF_GATES, "overlay fits");

__device__ __forceinline__ int tid_opaque() { int t = threadIdx.x; asm volatile("" : "+v"(t)); return t; }
#define TIDX tid_opaque()
__device__ __forceinline__ float bf2f(bf16_t v) { return __uint_as_float(((unsigned)v) << 16); }
typedef __bf16 bf16x2_t __attribute__((ext_vector_type(2)));
__device__ __forceinline__ bf16_t f2bf(float f) { return __builtin_bit_cast(unsigned short, (__bf16)f); }
__device__ __forceinline__ unsigned pk2(float lo, float hi) { bf16x2_t v = {(__bf16)lo, (__bf16)hi}; return __builtin_bit_cast(unsigned, v); }
__device__ __forceinline__ float sigmoidf_(float x) { return 1.f / (1.f + __expf(-x)); }
__device__ __forceinline__ float siluf_(float x) { return x / (1.f + __expf(-x)); }
__device__ __forceinline__ float softplusf_(float x) { return x > 20.f ? x : log1pf(__expf(x)); }
__device__ __forceinline__ float logsigmoidf_(float x) { return x < 0.f ? x - log1pf(__expf(x)) : -log1pf(__expf(-x)); }
__device__ __forceinline__ float geluf_(float x) { float u = 0.7978845608028654f * (x + 0.044715f * x * x * x); return 0.5f * x * (1.f + tanhf(u)); }
__device__ __forceinline__ float wave_sum(float v) {
#pragma unroll
    for (int o = 1; o < 64; o <<= 1) v += __shfl_xor(v, o);
    return v;
}
__device__ __forceinline__ float rdlane(float v, int l) { return __int_as_float(__builtin_amdgcn_readlane(__float_as_int(v), l)); }

#define PROBE_MASK 0
#define GSYNC() xcd_barrier(xb)
#define REP(bit, ...) do { __VA_ARGS__; if (PROBE_MASK & (bit)) { GSYNC(); __VA_ARGS__; } } while (0)
constexpr int NTHR = 512;
constexpr int LDS_BYTES = 147456;
enum { I_X = 0, I_MEM, I_NORM_MIX, I_W_IN, I_HGRN_LB, I_FOX_FB, I_LRU_CONV_W, I_LRU_CONV_B, I_LRU_WA, I_LRU_BA, I_LRU_WX, I_LRU_BX, I_LRU_LAM, I_GDN_CONV_W, I_GDN_A_LOG,
       I_GDN_DT_BIAS, I_MIX_GAIN, I_W_OUT, I_NORM_MEM, I_NORM_MEMKV, I_W_MQ, I_W_MKV, I_W_MO, I_NORM_FFN, I_W_RG, I_B_RG, I_W_RE, I_B_RE, I_W_E_GU, I_W_E_DN, I_NORM_FINAL, N_INPUTS };
struct Params { const float* in[N_INPUTS]; float* out; char* ws; };
static_assert(sizeof(Params) == 8 * (N_INPUTS + 2), "no padding");

#define BLK_LOOP(it, n) for (int it = (int)blockIdx.x; it < (n); it += (int)gridDim.x)

__device__ __forceinline__ int rowmap_fn(int mode, int n) {
    if (mode == 1) {
        if (n < 1792) return n;
        if (n < 1796) return C_GATE + (n - 1792);
        if (n < 3076) return n - 4;
        if (n < 3084) return C_GATE + 4 + (n - 3076);
        return n - 12;
    } else if (mode == 2) {
        int j = n & 255; return (j >> 4) * 32 + ((n >= 256) ? 16 : 0) + (j & 15);
    }
    return n;
}
__device__ __forceinline__ void convT_tile(float* tile  , const float* __restrict__ src, int K, int N, bf16_t* __restrict__ dst, int mode, int ntn, int idx) {
    const int n0 = (idx % ntn) * 64, k0 = (idx / ntn) * 64;
    const int tx = TIDX & 63, ty = TIDX >> 6;
    __syncthreads();
#pragma unroll
    for (int i = 0; i < 8; ++i) {
        const int k = ty + i * 8, n = n0 + tx;
        tile[k * 65 + tx] = (n < N) ? src[(size_t)(k0 + k) * N + n] : 0.f;
    }
    __syncthreads();
    const int kx = TIDX & 31, ny = TIDX >> 5;
#pragma unroll
    for (int i = 0; i < 4; ++i) {
        const int nl = ny + i * 16, n = n0 + nl;
        if (n < N) {
            const int r = rowmap_fn(mode, n);
            *(unsigned*)(dst + (size_t)r * K + k0 + 2 * kx) = pk2(tile[(2 * kx) * 65 + nl], tile[(2 * kx + 1) * 65 + nl]);
        }
    }
}
__device__ __forceinline__ void rms_row_bf16(const float* __restrict__ xrow, const float* __restrict__ g, bf16_t* __restrict__ orow, int lane) {
    const f32x4* xr = (const f32x4*)xrow + lane;
    f32x4 v[4]; float s = 0.f;
#pragma unroll
    for (int j = 0; j < 4; ++j) { v[j] = xr[64 * j]; s += v[j].x * v[j].x + v[j].y * v[j].y + v[j].z * v[j].z + v[j].w * v[j].w; }
    const float rinv = rsqrtf(wave_sum(s) * (1.f / 1024.f) + EPS);
#pragma unroll
    for (int j = 0; j < 4; ++j) {
        const f32x4 gg = ((const f32x4*)g)[lane + 64 * j];
        uint2 o; o.x = pk2(v[j].x * rinv * gg.x, v[j].y * rinv * gg.y); o.y = pk2(v[j].z * rinv * gg.z, v[j].w * rinv * gg.w);
        *(uint2*)(orow + (lane + 64 * j) * 4) = o;
    }
}

constexpr int CT_PER_LAYER = 53 * 16 + 256 + 64 + 128 + 64;
constexpr int CT_GU = 64 * 128, CT_DN = 64 * 64;
constexpr int CT_TOTAL = NL * CT_PER_LAYER + CT_GU + CT_DN;

__device__ __forceinline__ void phase0(const Params& P, char* smem) {
    char* ws = P.ws;
    float* tile = (float*)smem;
    BLK_LOOP(it, CT_TOTAL) {
        int r = it;
        if (r < NL * CT_PER_LAYER) {
            const int l = r / CT_PER_LAYER; r -= l * CT_PER_LAYER;
            if (r < 848) { convT_tile(tile, P.in[I_W_IN] + (size_t)l * 1024 * NIN, 1024, NIN, (bf16_t*)(ws + OFF_WIN) + (size_t)l * NP * 1024, 1, 53, r); continue; } r -= 848;
            if (r < 256) { convT_tile(tile, P.in[I_W_OUT] + (size_t)l * 1024 * 1024, 1024, 1024, (bf16_t*)(ws + OFF_WOUT) + (size_t)l * 1024 * 1024, 0, 16, r); continue; } r -= 256;
            if (r < 64) { convT_tile(tile, P.in[I_W_MQ] + (size_t)l * 1024 * 256, 1024, 256, (bf16_t*)(ws + OFF_WMQ) + (size_t)l * 256 * 1024, 0, 4, r); continue; } r -= 64;
            if (r < 128) { convT_tile(tile, P.in[I_W_MKV] + (size_t)l * 1024 * 512, 1024, 512, (bf16_t*)(ws + OFF_WMKV) + (size_t)l * 512 * 1024, 0, 8, r); continue; } r -= 128;
            convT_tile(tile, P.in[I_W_MO] + (size_t)l * 256 * 1024, 256, 1024, (bf16_t*)(ws + OFF_WMO) + (size_t)l * 1024 * 256, 0, 16, r); continue;
        }
        r -= NL * CT_PER_LAYER;
        if (r < CT_GU) { const int m = r >> 7; convT_tile(tile, P.in[I_W_E_GU] + (size_t)m * 1024 * 512, 1024, 512, (bf16_t*)(ws + OFF_WGU) + (size_t)m * 512 * 1024, 2, 8, r & 127); continue; }
        r -= CT_GU;
        { const int m = r >> 6; convT_tile(tile, P.in[I_W_E_DN] + (size_t)m * 256 * 1024, 256, 1024, (bf16_t*)(ws + OFF_WDN) + (size_t)m * 1024 * 256, 0, 16, r & 63); }
    }
    for (int i = blockIdx.x * NTHR + TIDX; i < NL * (NP - NIN) * 512; i += gridDim.x * NTHR) {
        const int l = i / ((NP - NIN) * 512), w = i % ((NP - NIN) * 512);
        ((unsigned*)((bf16_t*)(ws + OFF_WIN) + (size_t)l * NP * 1024 + (size_t)NIN * 1024))[w] = 0u;
    }
    const int gw = blockIdx.x * 8 + (TIDX >> 6), ngw = gridDim.x * 8, lane = TIDX & 63;
    for (int row = gw; row < T + NL * 2048; row += ngw) {
        if (row < T) rms_row_bf16(P.in[I_X] + (size_t)row * 1024, P.in[I_NORM_MIX], (bf16_t*)(ws + OFF_HN) + (size_t)row * 1024, lane);
        else { const int r2 = row - T, l = r2 >> 11, rr = r2 & 2047;
               rms_row_bf16(P.in[I_MEM] + (size_t)rr * 1024, P.in[I_NORM_MEMKV] + l * 1024, (bf16_t*)(ws + OFF_MEMN) + (size_t)r2 * 1024, lane); }
    }
}

constexpr int GLD = 72;
constexpr int GEMM_LDS = (256 + 128) * GLD * 2;
template <class RowPtr>
__device__ __forceinline__ void gemm_tile(char* smem, RowPtr rowptr, const bf16_t* __restrict__ Bt, int ldb, int n0, int K, f32x4 (&acc)[4][4]) {
    bf16_t* sA = (bf16_t*)smem; bf16_t* sB = sA + 256 * GLD;
    const int tid = TIDX, lane = tid & 63, wave = tid >> 6, wm = wave >> 1, wn = wave & 1;
    const u32x4* ga[4]; const u32x4* gb[2];
#pragma unroll
    for (int i = 0; i < 4; ++i) { const int c = tid + i * 512, r = c >> 3, ch = c & 7; ga[i] = (const u32x4*)(rowptr(r) + ch * 8); }
#pragma unroll
    for (int i = 0; i < 2; ++i) { const int c = tid + i * 512, r = c >> 3, ch = c & 7; gb[i] = (const u32x4*)(Bt + (size_t)(n0 + r) * ldb + ch * 8); }
#pragma unroll
    for (int m = 0; m < 4; ++m)
#pragma unroll
        for (int n = 0; n < 4; ++n) acc[m][n] = (f32x4){0.f, 0.f, 0.f, 0.f};
    u32x4 ra[4], rb[2];
#pragma unroll
    for (int i = 0; i < 4; ++i) ra[i] = ga[i][0];
#pragma unroll
    for (int i = 0; i < 2; ++i) rb[i] = gb[i][0];
    const int nk = K / 64;
    for (int kt = 0; kt < nk; ++kt) {
        __syncthreads();
#pragma unroll
        for (int i = 0; i < 4; ++i) { const int c = tid + i * 512, r = c >> 3, ch = c & 7; *(u32x4*)(sA + r * GLD + ch * 8) = ra[i]; }
#pragma unroll
        for (int i = 0; i < 2; ++i) { const int c = tid + i * 512, r = c >> 3, ch = c & 7; *(u32x4*)(sB + r * GLD + ch * 8) = rb[i]; }
        __syncthreads();
        if (kt + 1 < nk) {
#pragma unroll
            for (int i = 0; i < 4; ++i) ra[i] = ga[i][(kt + 1) * 8];
#pragma unroll
            for (int i = 0; i < 2; ++i) rb[i] = gb[i][(kt + 1) * 8];
        }
#pragma unroll
        for (int kk = 0; kk < 2; ++kk) {
            bf16x8 af[4], bfr[4];
#pragma unroll
            for (int m = 0; m < 4; ++m) af[m] = *(const bf16x8*)(sA + (wm * 64 + m * 16 + (lane & 15)) * GLD + kk * 32 + (lane >> 4) * 8);
#pragma unroll
            for (int n = 0; n < 4; ++n) bfr[n] = *(const bf16x8*)(sB + (wn * 64 + n * 16 + (lane & 15)) * GLD + kk * 32 + (lane >> 4) * 8);
#pragma unroll
            for (int m = 0; m < 4; ++m)
#pragma unroll
                for (int n = 0; n < 4; ++n) acc[m][n] = __builtin_amdgcn_mfma_f32_16x16x32_bf16(bfr[n], af[m], acc[m][n], 0, 0, 0);
        }
    }
}
struct RowDirect { const bf16_t* A; int lda; int m0; __device__ __forceinline__ const bf16_t* operator()(int r) const { return A + (size_t)(m0 + r) * lda; } };
enum { EPI_INPROJ = 0, EPI_RESID = 1, EPI_BF16 = 2 };

__device__ __forceinline__ int vcu_id() { const int G = gridDim.x, bx = blockIdx.x; return (G % 8 == 0) ? (bx % 8) * (G / 8) + bx / 8 : bx; }

template <int EPI>
__device__ __forceinline__ void gemm_phase(char* smem, const bf16_t* A, int lda, const bf16_t* Bt, int ldb, int M, int N, int K, void* out, int ldo, const float* resid, float* gates) {
    const int ntn = N / 128, ntiles = (M / 256) * ntn;
    const int lane = TIDX & 63, wave = TIDX >> 6, wm = wave >> 1, wn = wave & 1;
    for (int tIdx = vcu_id(); tIdx < ntiles; tIdx += gridDim.x) {
        const int m0 = (tIdx / ntn) * 256, n0 = (tIdx % ntn) * 128;
        f32x4 acc[4][4];
        RowDirect rp{A, lda, m0};
        gemm_tile(smem, rp, Bt, ldb, n0, K, acc);
#pragma unroll
        for (int m = 0; m < 4; ++m)
#pragma unroll
            for (int n = 0; n < 4; ++n) {
                const int row = m0 + wm * 64 + m * 16 + (lane & 15), col = n0 + wn * 64 + n * 16 + (lane >> 4) * 4;
                const f32x4 v = acc[m][n];
                if (EPI == EPI_INPROJ) {
                    uint2 o; o.x = pk2(v.x, v.y); o.y = pk2(v.z, v.w);
                    *(uint2*)((bf16_t*)out + (size_t)row * ldo + col) = o;
                    if (col >= C_GATE && col < C_GATE + 16) *(f32x4*)(gates + (size_t)row * 16 + (col - C_GATE)) = v;
                } else if (EPI == EPI_RESID) {
                    const f32x4 r = *(const f32x4*)(resid + (size_t)row * ldo + col);
                    *(f32x4*)((float*)out + (size_t)row * ldo + col) = r + v;
                } else {
                    uint2 o; o.x = pk2(v.x, v.y); o.y = pk2(v.z, v.w);
                    *(uint2*)((bf16_t*)out + (size_t)row * ldo + col) = o;
                }
            }
    }
}


namespace pg8 {
#define PG8_LAS __attribute__((address_space(3)))
typedef unsigned short bf16_t;
typedef short bf16x8 __attribute__((ext_vector_type(8)));
typedef float f32x4 __attribute__((ext_vector_type(4)));
typedef unsigned u32x4 __attribute__((ext_vector_type(4)));
constexpr int BM = 256, BK = 64, HALF = 128, HTB = HALF * BK * 2  , STAGE_BYTES = 8 * HTB, NXCD = 8, WGM = 8;

__host__ __device__ __forceinline__ int lds_byte(int r, int c) { const int st = (r >> 4) * 2 + (c >> 5), rr = r & 15, cc = c & 31, ob = rr * 64 + cc * 2; return st * 1024 + (ob ^ (((ob >> 9) & 1) << 5)); }
__host__ __device__ __forceinline__ void stage_rc(int b, int& R, int& C) { const int st = b / 1024, sb = b % 1024, swz = sb ^ (((sb >> 9) & 1) << 5); R = (st >> 1) * 16 + swz / 64; C = (st & 1) * 32 + (swz % 64) / 2; }
__host__ __device__ __forceinline__ int perm32(int rho) { const int n = rho >> 4, i = rho & 15; return 8 * (i >> 2) + 4 * n + (i & 3); }

struct Unit { int pm, pn; };
struct Gemm { const bf16_t* A; const bf16_t* Bt; int M, N, K; };

struct StaticOrder {
    int nM, nN, nwg, G, c;
    __host__ __device__ void init(int M, int N, int G_, int c_) { nM = M / BM; nN = N / BM; nwg = nM * nN; G = G_; c = c_; }
    __host__ __device__ bool next(int i, Unit& u) const {
        const long L = (long)i * G + c; if (L >= nwg) return false;
        int wgid = (int)L; { const int q = nwg / NXCD, r = nwg % NXCD, xcd = wgid % NXCD, off = wgid / NXCD; wgid = (xcd < r ? xcd * (q + 1) : r * (q + 1) + (xcd - r) * q) + off; }
        const int nig = WGM * nN, gid = wgid / nig, fm = gid * WGM, gsz = (nM - fm) < WGM ? (nM - fm) : WGM;
        u.pm = fm + ((wgid % nig) % gsz); u.pn = (wgid % nig) / gsz; return true;
    }
    __device__ __forceinline__ void a_ready(const Unit&) const {}
    __device__ __forceinline__ void done(const Unit&) const {}
};
__device__ __forceinline__ unsigned cvt_pk_bf16(float lo, float hi) { unsigned r; asm volatile("v_cvt_pk_bf16_f32 %0, %1, %2" : "=v"(r) : "v"(lo), "v"(hi)); return r; }
typedef float f32x2 __attribute__((ext_vector_type(2)));

struct EpiInProj {
    static constexpr bool PERM = true, AFTER_DRAIN = false;
    bf16_t* O; int ldc; float* gates; int gate_col;
    __device__ __forceinline__ void operator()(const f32x4 (&acc)[2][2][4][2], const Unit& u, int wr, int wc, int fr, int fq) const {
        const int row0 = u.pm * BM + wr * 64 + fr, col0 = u.pn * BM + wc * 32 + 8 * fq;
#pragma unroll
        for (int ai = 0; ai < 2; ++ai)
#pragma unroll
            for (int m = 0; m < 4; ++m) {
                const int row = row0 + ai * HALF + m * 16;
                bf16_t* rowp = O + (size_t)row * ldc + col0;
#pragma unroll
                for (int bj = 0; bj < 2; ++bj) {
                    const f32x4 v0 = acc[ai][bj][m][0], v1 = acc[ai][bj][m][1];
                    u32x4 w; w.x = cvt_pk_bf16(v0[0], v0[1]); w.y = cvt_pk_bf16(v0[2], v0[3]); w.z = cvt_pk_bf16(v1[0], v1[1]); w.w = cvt_pk_bf16(v1[2], v1[3]);
                    *(u32x4*)(rowp + bj * HALF) = w;
                    const int gc = col0 + bj * HALF - gate_col;
                    if (gates && gc >= 0 && gc < 16) { *(f32x4*)(gates + (size_t)row * 16 + gc) = v0; *(f32x4*)(gates + (size_t)row * 16 + gc + 4) = v1; }
                }
            }
    }
};
struct EpiResid {
    static constexpr bool PERM = false, AFTER_DRAIN = false;
    const float* base; float* out; int ldc;
    __device__ __forceinline__ void operator()(const f32x4 (&acc)[2][2][4][2], const Unit& u, int wr, int wc, int fr, int fq) const {
        const int col0 = u.pn * BM + wc * 32 + 4 * fq;
#pragma unroll
        for (int ai = 0; ai < 2; ++ai)
#pragma unroll
            for (int m = 0; m < 4; ++m) {
                const size_t off = (size_t)(u.pm * BM + ai * HALF + wr * 64 + m * 16 + fr) * ldc + col0;
#pragma unroll
                for (int bj = 0; bj < 2; ++bj)
#pragma unroll
                    for (int n = 0; n < 2; ++n) { const f32x4 bs = *(const f32x4*)(base + off + bj * HALF + n * 16); *(f32x4*)(out + off + bj * HALF + n * 16) = bs + acc[ai][bj][m][n]; }
                if (m & 1) asm volatile("" ::: "memory");
            }
    }
};

template <class Epi, class Sched, bool ALIGN_EPI = false, bool SP2 = false>
__device__ __forceinline__ void gemm_phase(PG8_LAS unsigned char* lds, const Gemm g, const Sched& S, const Epi& E) {
    const int tid = TIDX, wid = __builtin_amdgcn_readfirstlane(tid >> 6), lane = tid & 63, wr = wid >> 2, wc = wid & 3, fr = lane & 15, fq = lane >> 4;
    const int K = g.K, nt = K / BK;
    unsigned voffA[2], voffB[2];
#pragma unroll
    for (int i = 0; i < 2; ++i) { int R, C; stage_rc(tid * 16 + i * 8192, R, C); const int Rb = Epi::PERM ? ((R & ~31) + perm32(R & 31)) : R;
        voffA[i] = (unsigned)(R * K + C) * 2u; voffB[i] = (unsigned)(Rb * K + C) * 2u; }
    const size_t kstep = (size_t)(BK * 2);
    const size_t hstep = (size_t)HALF * K * 2;
    const size_t tstep = 2 * hstep;
    const unsigned ldsw = (unsigned)wid * 1024u;
    const int aoff = lds_byte(wr * 64 + fr, fq * 8), boff = lds_byte(wc * 32 + fr, fq * 8);
#define PG8_SA(b, h) (((b) * 2 + (h)) * HTB)
#define PG8_SB(b, h) ((4 + (b) * 2 + (h)) * HTB)
#define PG8_STAGE(bufoff, gbase, voff) do { _Pragma("unroll") for (int _i = 0; _i < 2; ++_i) \
        __builtin_amdgcn_global_load_lds((const unsigned*)((const char*)(gbase) + (voff)[_i]), (PG8_LAS unsigned*)(lds + (bufoff) + ldsw + _i * 8192), 16, 0, 0); } while (0)
#define PG8_LDA(dst, b, h) do { _Pragma("unroll") for (int m = 0; m < 4; ++m) _Pragma("unroll") for (int k = 0; k < 2; ++k) dst[m][k] = *(const PG8_LAS bf16x8*)(lds + PG8_SA(b, h) + aoff + m * 2048 + k * 1024); } while (0)
#define PG8_LDB(dst, b, h) do { _Pragma("unroll") for (int n = 0; n < 2; ++n) _Pragma("unroll") for (int k = 0; k < 2; ++k) dst[n][k] = *(const PG8_LAS bf16x8*)(lds + PG8_SB(b, h) + boff + n * 2048 + k * 1024); } while (0)
#define PG8_MMA(ai, bj, At, Bt) do { __builtin_amdgcn_s_setprio(1); _Pragma("unroll") for (int m = 0; m < 4; ++m) _Pragma("unroll") for (int n = 0; n < 2; ++n) _Pragma("unroll") for (int k = 0; k < 2; ++k) \
        acc[ai][bj][m][n] = __builtin_amdgcn_mfma_f32_16x16x32_bf16(Bt[n][k], At[m][k], acc[ai][bj][m][n], 0, 0, 0); __builtin_amdgcn_s_setprio(0); } while (0)
#define PG8_WAIT_V(n) asm volatile("s_waitcnt vmcnt(" #n ")" ::: "memory")
#define PG8_WAIT_L(n) asm volatile("s_waitcnt lgkmcnt(" #n ")" ::: "memory")
#define PG8_BAR __builtin_amdgcn_s_barrier()
#define PG8_SCHED __builtin_amdgcn_sched_barrier(0)
    Unit cur, nxt; int ui = 0;
    if (!S.next(0, cur)) return;
    f32x4 acc[2][2][4][2];
#pragma unroll
    for (int a = 0; a < 2; ++a)
#pragma unroll
        for (int b = 0; b < 2; ++b)
#pragma unroll
            for (int m = 0; m < 4; ++m)
#pragma unroll
                for (int n = 0; n < 2; ++n) acc[a][b][m][n] = (f32x4){0.f, 0.f, 0.f, 0.f};
    bf16x8 At[4][2], B0[2][2], B1[2][2];
    const char* cA = (const char*)g.A + (size_t)cur.pm * tstep; const char* cB = (const char*)g.Bt + (size_t)cur.pn * tstep;
    S.a_ready(cur);
    if constexpr (SP2) {
        PG8_STAGE(PG8_SB(0, 0), cB, voffB); PG8_STAGE(PG8_SB(0, 1), cB + hstep, voffB); PG8_STAGE(PG8_SA(0, 0), cA, voffA); PG8_STAGE(PG8_SA(0, 1), cA + hstep, voffA);
        if (wr == 1) PG8_BAR;
        PG8_WAIT_V(2); PG8_BAR;
        PG8_STAGE(PG8_SB(1, 0), cB + kstep, voffB); PG8_STAGE(PG8_SA(1, 0), cA + kstep, voffA); PG8_STAGE(PG8_SB(1, 1), cB + hstep + kstep, voffB);
        PG8_WAIT_V(6); PG8_BAR;
    } else {
        PG8_STAGE(PG8_SB(0, 0), cB, voffB); PG8_STAGE(PG8_SA(0, 0), cA, voffA); PG8_STAGE(PG8_SB(0, 1), cB + hstep, voffB); PG8_STAGE(PG8_SA(0, 1), cA + hstep, voffA);
        if (wr == 1) PG8_BAR;
        PG8_WAIT_V(4); PG8_BAR;
        PG8_STAGE(PG8_SB(1, 0), cB + kstep, voffB); PG8_STAGE(PG8_SA(1, 0), cA + kstep, voffA); PG8_STAGE(PG8_SB(1, 1), cB + hstep + kstep, voffB);
        PG8_WAIT_V(6); PG8_BAR;
    }
    for (;;) {
        const bool has_next = S.next(ui + 1, nxt);
        const char* nA = has_next ? (const char*)g.A + (size_t)nxt.pm * tstep : cA; const char* nB = has_next ? (const char*)g.Bt + (size_t)nxt.pn * tstep : cB;
        for (int t = 0; t < nt; t += 2) {
            const bool last = (t == nt - 2);
            const char* a1 = cA + (size_t)(t + 1) * kstep;
            const char* a2 = last ? nA : cA + (size_t)(t + 2) * kstep; const char* b2 = last ? nB : cB + (size_t)(t + 2) * kstep;
            const char* a3 = a2 + kstep; const char* b3 = b2 + kstep;
            if (last && has_next) S.a_ready(nxt);
            if constexpr (SP2) {
            PG8_LDB(B0, 0, 0); PG8_LDB(B1, 0, 1); PG8_SCHED; PG8_LDA(At, 0, 0); PG8_STAGE(PG8_SA(1, 1), a1 + hstep, voffA);
            PG8_WAIT_V(8); PG8_WAIT_L(0); PG8_BAR; PG8_MMA(0, 0, At, B0); PG8_MMA(0, 1, At, B1); PG8_BAR; PG8_SCHED;
            PG8_LDA(At, 0, 1); PG8_STAGE(PG8_SB(0, 0), b2, voffB); PG8_STAGE(PG8_SB(0, 1), b2 + hstep, voffB); PG8_STAGE(PG8_SA(0, 0), a2, voffA);
            PG8_WAIT_V(8); PG8_WAIT_L(0); PG8_BAR; PG8_MMA(1, 0, At, B0); PG8_MMA(1, 1, At, B1); PG8_BAR; PG8_SCHED;
            PG8_LDB(B0, 1, 0); PG8_LDB(B1, 1, 1); PG8_SCHED; PG8_LDA(At, 1, 0); PG8_STAGE(PG8_SA(0, 1), a2 + hstep, voffA);
            PG8_WAIT_V(8); PG8_WAIT_L(0); PG8_BAR; PG8_MMA(0, 0, At, B0); PG8_MMA(0, 1, At, B1); PG8_BAR; PG8_SCHED;
            PG8_LDA(At, 1, 1); PG8_STAGE(PG8_SB(1, 0), b3, voffB); PG8_STAGE(PG8_SB(1, 1), b3 + hstep, voffB); PG8_STAGE(PG8_SA(1, 0), a3, voffA);
            PG8_WAIT_V(8); PG8_WAIT_L(0); PG8_BAR; PG8_MMA(1, 0, At, B0); PG8_MMA(1, 1, At, B1); PG8_BAR; PG8_SCHED;
            } else {
            PG8_LDB(B0, 0, 0); PG8_SCHED; PG8_LDA(At, 0, 0); PG8_STAGE(PG8_SA(1, 1), a1 + hstep, voffA);
            PG8_WAIT_L(8); PG8_BAR; PG8_WAIT_L(0); PG8_MMA(0, 0, At, B0); PG8_BAR; PG8_SCHED;
            PG8_LDB(B1, 0, 1); PG8_STAGE(PG8_SB(0, 0), b2, voffB);
            PG8_BAR; PG8_WAIT_L(0); PG8_MMA(0, 1, At, B1); PG8_BAR;
            PG8_LDA(At, 0, 1); PG8_STAGE(PG8_SA(0, 0), a2, voffA);
            PG8_BAR; PG8_WAIT_L(0); PG8_MMA(1, 0, At, B0); PG8_BAR; PG8_SCHED;
            PG8_STAGE(PG8_SB(0, 1), b2 + hstep, voffB);
            PG8_WAIT_V(6); PG8_BAR; PG8_MMA(1, 1, At, B1); PG8_BAR;
            PG8_LDB(B0, 1, 0); PG8_SCHED; PG8_LDA(At, 1, 0); PG8_STAGE(PG8_SA(0, 1), a2 + hstep, voffA);
            PG8_WAIT_L(8); PG8_BAR; PG8_WAIT_L(0); PG8_MMA(0, 0, At, B0); PG8_BAR; PG8_SCHED;
            PG8_LDB(B1, 1, 1); PG8_STAGE(PG8_SB(1, 0), b3, voffB);
            PG8_BAR; PG8_WAIT_L(0); PG8_MMA(0, 1, At, B1); PG8_BAR;
            PG8_LDA(At, 1, 1); PG8_STAGE(PG8_SA(1, 0), a3, voffA);
            PG8_BAR; PG8_WAIT_L(0); PG8_MMA(1, 0, At, B0); PG8_BAR; PG8_SCHED;
            PG8_STAGE(PG8_SB(1, 1), b3 + hstep, voffB);
            PG8_WAIT_V(6); PG8_BAR; PG8_MMA(1, 1, At, B1); PG8_BAR;
            }
        }
        if constexpr (ALIGN_EPI) { if (wr == 0) PG8_BAR; }
        if constexpr (!Epi::AFTER_DRAIN) { E(acc, cur, wr, wc, fr, fq); S.done(cur); }
        if (!has_next) break;
#pragma unroll
        for (int a = 0; a < 2; ++a)
#pragma unroll
            for (int b = 0; b < 2; ++b)
#pragma unroll
                for (int m = 0; m < 4; ++m)
#pragma unroll
                    for (int n = 0; n < 2; ++n) acc[a][b][m][n] = (f32x4){0.f, 0.f, 0.f, 0.f};
        cur = nxt; cA = nA; cB = nB; ++ui;
        if constexpr (ALIGN_EPI) { if (wr == 1) PG8_BAR; }
    }
    PG8_WAIT_V(0);
    if constexpr (!ALIGN_EPI) { if (wr == 0) PG8_BAR; }
    PG8_BAR;
    if constexpr (Epi::AFTER_DRAIN) { E.fused(acc, cur, wr, wc, fr, fq, lds, wid, lane); S.done(cur); }
#undef PG8_SA
#undef PG8_SB
#undef PG8_STAGE
#undef PG8_LDA
#undef PG8_LDB
#undef PG8_MMA
#undef PG8_WAIT_V
#undef PG8_WAIT_L
#undef PG8_BAR
#undef PG8_SCHED
}
}

struct RowGather { const bf16_t* A; int lda; const int* ids; int shift; __device__ __forceinline__ const bf16_t* operator()(int r) const { return A + (size_t)(ids[r] >> shift) * lda; } };
template <int STAGE>
__device__ __forceinline__ void moe_phase(char* smem, const bf16_t* A, int lda, const bf16_t* Wt, size_t wstride, int ldb, int K, const int* cnt, const int* list, const float* pgate, bf16_t* out) {
    int* ids = (int*)(smem + GEMM_LDS);
    int* tpre = ids + 256;
    constexpr int NTN = (STAGE == 1) ? 4 : 8;
    __syncthreads();
    if (TIDX == 0) { int a = 0; for (int i = 0; i < NEXP; ++i) { tpre[i] = a; a += (cnt[i] + 255) >> 8; } tpre[NEXP] = a; }
    __syncthreads();
    const int ntiles = tpre[NEXP] * NTN;
    const int lane = TIDX & 63, wave = TIDX >> 6, wm = wave >> 1, wn = wave & 1;
    for (int tIdx = vcu_id(); tIdx < ntiles; tIdx += gridDim.x) {
        const int mtg = tIdx / NTN, n0 = (tIdx % NTN) * 128;
        int e = 0;
        for (int i = 1; i < NEXP; ++i) if (tpre[i] <= mtg) e = i;
        const int mt = mtg - tpre[e];
        const int cn = cnt[e];
        __syncthreads();
        if (TIDX < 256) { const int pos = mt * 256 + TIDX; ids[TIDX] = list[(size_t)e * T + (pos < cn ? pos : cn - 1)]; }
        __syncthreads();
        f32x4 acc[4][4];
        RowGather rp{A, lda, ids, STAGE == 1 ? 1 : 0};
        gemm_tile(smem, rp, Wt + (size_t)e * wstride, ldb, n0, K, acc);
#pragma unroll
        for (int m = 0; m < 4; ++m) {
            const int rl = wm * 64 + m * 16 + (lane & 15);
            if (mt * 256 + rl >= cn) continue;
            const int pid = ids[rl];
            if (STAGE == 1) {
                const float gt = pgate[pid];
#pragma unroll
                for (int np = 0; np < 2; ++np) {
                    const f32x4 g = acc[m][2 * np], u = acc[m][2 * np + 1];
                    const int j = (n0 + wn * 64 + np * 32) / 2 + (lane >> 4) * 4;
                    uint2 o; o.x = pk2(siluf_(g.x) * u.x * gt, siluf_(g.y) * u.y * gt); o.y = pk2(siluf_(g.z) * u.z * gt, siluf_(g.w) * u.w * gt);
                    *(uint2*)(out + (size_t)pid * DEXP + j) = o;
                }
            } else {
#pragma unroll
                for (int n = 0; n < 4; ++n) {
                    const f32x4 v = acc[m][n]; const int col = n0 + wn * 64 + n * 16 + (lane >> 4) * 4;
                    uint2 o; o.x = pk2(v.x, v.y); o.y = pk2(v.z, v.w);
                    *(uint2*)(out + (size_t)pid * 1024 + col) = o;
                }
            }
        }
    }
}

__device__ __forceinline__ void hgrn2_naive(const bf16_t* __restrict__ proj, const float* __restrict__ hgrn_lb, int layer, const float* __restrict__ mix_gain, bf16_t* __restrict__ y, int bh, int lane) {
    const int b = bh >> 2, h = bh & 3;
    float lbk = 0.f;
    if (layer == 1) { float a0 = hgrn_lb[h * 64 + lane], a1 = hgrn_lb[256 + h * 64 + lane]; lbk = 1.f / (1.f + __expf(a0 - a1)); }
    const float mg = mix_gain[C_AQ + h * 64 + lane];
    float S[64];
#pragma unroll
    for (int k = 0; k < 64; ++k) S[k] = 0.f;
    for (int t = 0; t < SEQ; ++t) {
        const bf16_t* pr = proj + (size_t)(b * SEQ + t) * NP + h * 64 + lane;
        const float qk = siluf_(bf2f(pr[C_AQ]));
        const float sg = sigmoidf_(bf2f(pr[C_AF]));
        const float f = lbk + (1.f - lbk) * sg, kk = (1.f - lbk) * (1.f - sg);
        const float iv = bf2f(pr[C_AI]);
        const float gv = bf2f(pr[C_AG]);
        float o = 0.f;
#pragma unroll
        for (int k = 0; k < 64; ++k) { S[k] = rdlane(f, k) * S[k] + rdlane(kk, k) * iv; o += rdlane(qk, k) * S[k]; }
        const float ms = wave_sum(o * o) * (1.f / 64.f);
        const float yv = o * rsqrtf(ms + EPS) * siluf_(gv) * mg;
        y[(size_t)(b * SEQ + t) * 1024 + 0 + h * 64 + lane] = f2bf(yv);
    }
}
__device__ __forceinline__ void gdn_naive(const bf16_t* __restrict__ proj, const float* __restrict__ gates, const float* __restrict__ conv_w  ,
                                          const float* __restrict__ a_log, const float* __restrict__ dt_bias, const float* __restrict__ mix_gain, bf16_t* __restrict__ y, int bh, int lane) {
    const int b = bh >> 2, h = bh & 3;
    float wq[4], wk[4], wv[4];
#pragma unroll
    for (int j = 0; j < 4; ++j) { wq[j] = conv_w[j * 768 + h * 64 + lane]; wk[j] = conv_w[j * 768 + 256 + h * 64 + lane]; wv[j] = conv_w[j * 768 + 512 + h * 64 + lane]; }
    float xq[3] = {0.f, 0.f, 0.f}, xk[3] = {0.f, 0.f, 0.f}, xv[3] = {0.f, 0.f, 0.f};
    const float Aexp = __expf(a_log[h]), dtb = dt_bias[h];
    const float mg = mix_gain[768 + h * 64 + lane];
    float S[64];
#pragma unroll
    for (int k = 0; k < 64; ++k) S[k] = 0.f;
    for (int t = 0; t < SEQ; ++t) {
        const size_t row = (size_t)(b * SEQ + t);
        const bf16_t* pr = proj + row * NP + h * 64 + lane;
        const float q0 = bf2f(pr[C_DQ]), k0 = bf2f(pr[C_DK]), v0 = bf2f(pr[C_DV]), zv = bf2f(pr[C_DZ]);
        float q = siluf_(wq[0] * xq[0] + wq[1] * xq[1] + wq[2] * xq[2] + wq[3] * q0);
        float k = siluf_(wk[0] * xk[0] + wk[1] * xk[1] + wk[2] * xk[2] + wk[3] * k0);
        float v = siluf_(wv[0] * xv[0] + wv[1] * xv[1] + wv[2] * xv[2] + wv[3] * v0);
        xq[0] = xq[1]; xq[1] = xq[2]; xq[2] = q0; xk[0] = xk[1]; xk[1] = xk[2]; xk[2] = k0; xv[0] = xv[1]; xv[1] = xv[2]; xv[2] = v0;
        q = q * rsqrtf(wave_sum(q * q) + EPS) * 0.125f;
        k = k * rsqrtf(wave_sum(k * k) + EPS);
        const float beta = sigmoidf_(gates[row * 16 + 4 + h]);
        const float g = -Aexp * softplusf_(gates[row * 16 + 8 + h] + dtb);
        const float eg = __expf(g);
        float r = 0.f;
#pragma unroll
        for (int i = 0; i < 64; ++i) { S[i] *= eg; r += rdlane(k, i) * S[i]; }
        const float dlt = beta * (v - r);
        float o = 0.f;
#pragma unroll
        for (int i = 0; i < 64; ++i) { S[i] += rdlane(k, i) * dlt; o += rdlane(q, i) * S[i]; }
        const float ms = wave_sum(o * o) * (1.f / 64.f);
        const float yv = o * rsqrtf(ms + EPS) * siluf_(zv) * mg;
        y[row * 1024 + 768 + h * 64 + lane] = f2bf(yv);
    }
}
__device__ __forceinline__ void fox_cumsum(const float* __restrict__ gates, const float* __restrict__ fb, float* __restrict__ cc, int bh, int lane) {
    const int b = bh >> 2, h = bh & 3;
    const float bias = fb[h];
    float carry = 0.f;
    for (int t0 = 0; t0 < SEQ; t0 += 64) {
        float v = logsigmoidf_(gates[(size_t)(b * SEQ + t0 + lane) * 16 + h] + bias);
#pragma unroll
        for (int o = 1; o < 64; o <<= 1) { float n = __shfl_up(v, o); if (lane >= o) v += n; }
        v += carry;
        cc[(size_t)(b * 4 + h) * SEQ + t0 + lane] = v;
        carry = __shfl(v, 63);
    }
}
__device__ __forceinline__ void lru_prep_task(float* xc  , const bf16_t* __restrict__ proj, const float* __restrict__ conv_w, const float* __restrict__ conv_b,
                                              const float* __restrict__ w_a, const float* __restrict__ b_a, const float* __restrict__ w_x, const float* __restrict__ b_x,
                                              const float* __restrict__ lam, float* __restrict__ a_out, float* __restrict__ u_out, int task, bool active) {
    const int c = TIDX & 255, t0 = task * 16;
    if (active) {
        const float w0 = conv_w[c], w1 = conv_w[256 + c], w2 = conv_w[512 + c], w3 = conv_w[768 + c], cb = conv_b[c];
        for (int i = 0; i < 16; ++i) {
            const int t = t0 + i, s = t & (SEQ - 1);
            const bf16_t* pr = proj + (size_t)t * NP + C_CX + c;
            float acc = cb + w3 * bf2f(pr[0]);
            if (s >= 1) acc += w2 * bf2f(pr[-(ptrdiff_t)NP]);
            if (s >= 2) acc += w1 * bf2f(pr[-(ptrdiff_t)2 * NP]);
            if (s >= 3) acc += w0 * bf2f(pr[-(ptrdiff_t)3 * NP]);
            xc[i * 256 + c] = acc;
        }
    }
    __syncthreads();
    if (active) {
        const int h = c >> 6, jj = c & 63;
        float ra[16], rx[16];
#pragma unroll
        for (int i = 0; i < 16; ++i) { ra[i] = 0.f; rx[i] = 0.f; }
        for (int k = 0; k < 64; ++k) {
            const float wa = w_a[(h * 64 + k) * 64 + jj], wx = w_x[(h * 64 + k) * 64 + jj];
#pragma unroll
            for (int i = 0; i < 16; ++i) { const float xv = xc[i * 256 + h * 64 + k]; ra[i] += xv * wa; rx[i] += xv * wx; }
        }
        const float ba = b_a[c], bx = b_x[c], sp = softplusf_(-lam[c]);
#pragma unroll
        for (int i = 0; i < 16; ++i) {
            const float r = sigmoidf_(ra[i] + ba), ig = sigmoidf_(rx[i] + bx);
            const float log_a = -8.f * r * sp;
            const float a = __expf(log_a);
            const float u = sqrtf(-expm1f(2.f * log_a)) * (ig * xc[i * 256 + c]);
            a_out[(size_t)(t0 + i) * 256 + c] = a; u_out[(size_t)(t0 + i) * 256 + c] = u;
        }
    }
    __syncthreads();
}
__device__ __forceinline__ void lru_scan_task(const float* __restrict__ a_in, const float* __restrict__ u_in, const bf16_t* __restrict__ proj, const float* __restrict__ mix_gain, bf16_t* __restrict__ y, int b) {
    const int c = TIDX;
    const float mg = mix_gain[512 + c];
    float hst = 0.f;
    for (int t = 0; t < SEQ; ++t) {
        const size_t row = (size_t)(b * SEQ + t);
        hst = a_in[row * 256 + c] * hst + u_in[row * 256 + c];
        const float yv = hst * geluf_(bf2f(proj[row * NP + C_CG + c]));
        const float ms = wave_sum(yv * yv) * (1.f / 64.f);
        y[row * 1024 + 512 + c] = f2bf(yv * rsqrtf(ms + EPS) * mg);
    }
}

typedef short s16x4 __attribute__((ext_vector_type(4)));
#define LDS_AS __attribute__((address_space(3)))
__device__ __forceinline__ bf16x8 frag_rm(const bf16_t* tile, int ld, int r0, int k0, int lane) { return *(const bf16x8*)(tile + (r0 + (lane & 15)) * ld + k0 + (lane >> 4) * 8); }
__device__ __forceinline__ s16x4 tr4(const bf16_t* tile, int ld, int rbase, int c0, int lane) {
    const bf16_t* p = tile + (rbase + ((lane & 15) >> 2)) * ld + c0 + 4 * (lane & 3);
    return __builtin_amdgcn_ds_read_tr16_b64_v4i16((LDS_AS s16x4*)p);
}
__device__ __forceinline__ bf16x8 frag_cm(const bf16_t* tile, int ld, int k0, int c0, int lane) {
    const s16x4 lo = tr4(tile, ld, k0 + (lane >> 4) * 8, c0, lane), hi = tr4(tile, ld, k0 + (lane >> 4) * 8 + 4, c0, lane);
    return (bf16x8){lo[0], lo[1], lo[2], lo[3], hi[0], hi[1], hi[2], hi[3]};
}
#define MFMA16(a, b, c) __builtin_amdgcn_mfma_f32_16x16x32_bf16((a), (b), (c), 0, 0, 0)
constexpr int TLD = 72;


#define XB_TMO      128
#define XB_XCNT(j)  (256  + 64 * (j))
#define XB_XSUB(j)  (1280 + 64 * (j))
#define XB_XGEN(j)  (2304 + 64 * (j))
#define XB_TOP      3328
#define XB_TOPGEN   3392
#define XCD_BAR_WORDS 3456
#define XB_SPIN_CAP (1u << 18)
__device__ __forceinline__ unsigned xb_ld(unsigned* p)              { return __hip_atomic_load(p, __ATOMIC_RELAXED, __HIP_MEMORY_SCOPE_AGENT); }
__device__ __forceinline__ unsigned xb_add(unsigned* p, unsigned v) { return __hip_atomic_fetch_add(p, v, __ATOMIC_RELAXED, __HIP_MEMORY_SCOPE_AGENT); }
__device__ __forceinline__ unsigned xb_xcc_id() { return (unsigned)__builtin_amdgcn_s_getreg((3 << 11) | 20) & 0xFu; }
#define XB_SPIN(cond, bar) do { unsigned _sp = 0; while (cond) { __builtin_amdgcn_s_sleep(1); \
    if ((++_sp & 255u) == 0u) { if (xb_ld(&(bar)[XB_TMO])) break; if (_sp > XB_SPIN_CAP) { atomicAdd(&(bar)[XB_TMO], 1u); break; } } } } while (0)
struct XcdBarrier { unsigned* bar; unsigned x; volatile LDS_AS unsigned* st; };
__device__ __forceinline__ XcdBarrier xcd_barrier_post(unsigned* bar, volatile LDS_AS unsigned* st) {
    XcdBarrier b; b.bar = bar; b.x = xb_xcc_id(); b.st = st;
    if (TIDX == 0) (void)xb_add(&bar[XB_XCNT(b.x)], 1u);
    return b;
}
__device__ __forceinline__ void xcd_barrier_complete(unsigned* bar, unsigned x, unsigned& nloc, unsigned& nx) {
    const unsigned G = gridDim.x * gridDim.y * gridDim.z;
    unsigned sum, cnt, mine, sp = 0u;
    for (;;) {
        sum = 0u; cnt = 0u; mine = 0u;
#pragma unroll
        for (unsigned j = 0; j < 16; ++j) { const unsigned c = xb_ld(&bar[XB_XCNT(j)]); sum += c; cnt += (c > 0u) ? 1u : 0u; mine = (j == x) ? c : mine; }
        if (sum == G) break;
        __builtin_amdgcn_s_sleep(1);
        if ((++sp & 255u) == 0u) { if (xb_ld(&bar[XB_TMO])) break; if (sp > XB_SPIN_CAP) { atomicAdd(&bar[XB_TMO], 1u); break; } }
    }
    nloc = mine > 0u ? mine : 1u; nx = cnt > 0u ? cnt : 1u;
}
__device__ __forceinline__ void xcd_barrier(const XcdBarrier& b) {
    asm volatile("s_waitcnt vmcnt(0)" ::: "memory");
    __syncthreads();
    if (TIDX == 0) {
        unsigned* bar = b.bar;
        __builtin_amdgcn_s_waitcnt(0);
        unsigned nloc = b.st[0], nx = b.st[1];
        if (nloc == 0u) { xcd_barrier_complete(bar, b.x, nloc, nx); b.st[0] = nloc; b.st[1] = nx; }
        const unsigned old = xb_add(&bar[XB_XSUB(b.x)], 1u);
        const unsigned gen = old / nloc;
        if (old + 1u == (gen + 1u) * nloc) {
            __builtin_amdgcn_fence(__ATOMIC_RELEASE, "agent");
            asm volatile("s_waitcnt vmcnt(0)" ::: "memory");
            const unsigned og = xb_add(&bar[XB_TOP], 1u);
            const unsigned tg = og / nx;
            if (og + 1u == (tg + 1u) * nx) xb_add(&bar[XB_TOPGEN], 1u);
            else XB_SPIN(xb_ld(&bar[XB_TOPGEN]) == tg, bar);
            __builtin_amdgcn_fence(__ATOMIC_ACQUIRE, "agent");
            xb_add(&bar[XB_XGEN(b.x)], 1u);
            asm volatile("s_waitcnt vmcnt(0)" ::: "memory");
        } else {
            XB_SPIN(xb_ld(&bar[XB_XGEN(b.x)]) == gen, bar);
            __builtin_amdgcn_fence(__ATOMIC_ACQUIRE, "agent");
            asm volatile("s_waitcnt vmcnt(0)" ::: "memory");
        }
    }
    __syncthreads();
}

template <bool MASK>
__device__ __forceinline__ void attn_compute_t(const bf16_t* cK, const bf16_t* cV, const float* cC, const bf16x8 (&qf)[2], f32x4 (&oacc)[4], float& mrun, float& lrun,
                                               float ct2, float scale2, int kt, int tq, int lane, int g) {
    f32x4 sacc[4];
#pragma unroll
    for (int n = 0; n < 4; ++n) {
        sacc[n] = (f32x4){0.f, 0.f, 0.f, 0.f};
#pragma unroll
        for (int kk = 0; kk < 2; ++kk) sacc[n] = MFMA16(frag_rm(cK, TLD, n * 16, kk * 32, lane), qf[kk], sacc[n]);
    }
    float mx = -INFINITY;
#pragma unroll
    for (int n = 0; n < 4; ++n) {
        const f32x4 cs = *(const f32x4*)(cC + n * 16 + 4 * g);
#pragma unroll
        for (int r = 0; r < 4; ++r) {
            float v = sacc[n][r] * scale2 + (ct2 - cs[r]);
            if (MASK) { if (kt * 64 + n * 16 + 4 * g + r > tq) v = -INFINITY; }
            sacc[n][r] = v; mx = fmaxf(mx, v);
        }
    }
    mx = fmaxf(mx, __shfl_xor(mx, 16)); mx = fmaxf(mx, __shfl_xor(mx, 32));
    const float mnew = fmaxf(mrun, mx);
    const float corr = __builtin_amdgcn_exp2f(mrun - mnew);
    float rs = 0.f;
#pragma unroll
    for (int n = 0; n < 4; ++n)
#pragma unroll
        for (int r = 0; r < 4; ++r) { const float p = __builtin_amdgcn_exp2f(sacc[n][r] - mnew); sacc[n][r] = p; rs += p; }
    rs += __shfl_xor(rs, 16); rs += __shfl_xor(rs, 32);
    lrun = lrun * corr + rs; mrun = mnew;
    bf16x8 pf[2];
#pragma unroll
    for (int kk = 0; kk < 2; ++kk) {
        const u32x4 pk = (u32x4){pk2(sacc[2 * kk][0], sacc[2 * kk][1]), pk2(sacc[2 * kk][2], sacc[2 * kk][3]), pk2(sacc[2 * kk + 1][0], sacc[2 * kk + 1][1]), pk2(sacc[2 * kk + 1][2], sacc[2 * kk + 1][3])};
        pf[kk] = __builtin_bit_cast(bf16x8, pk);
    }
#pragma unroll
    for (int n2 = 0; n2 < 4; ++n2) {
        oacc[n2] = oacc[n2] * corr;
#pragma unroll
        for (int kk = 0; kk < 2; ++kk) {
            const s16x4 lo = tr4(cV, TLD, (2 * kk) * 16 + 4 * g, n2 * 16, lane), hi = tr4(cV, TLD, (2 * kk + 1) * 16 + 4 * g, n2 * 16, lane);
            const bf16x8 vf = (bf16x8){lo[0], lo[1], lo[2], lo[3], hi[0], hi[1], hi[2], hi[3]};
            oacc[n2] = MFMA16(vf, pf[kk], oacc[n2]);
        }
    }
}
__device__ __forceinline__ void attn_compute(const bf16_t* cK, const bf16_t* cV, const float* cC, const bf16x8 (&qf)[2], f32x4 (&oacc)[4], float& mrun, float& lrun,
                                             float ct2, float scale2, int causal, int kt, int q0, int tq, int wave, int lane, int g) {
    const int r0 = q0 + wave * 16;
    if (causal && (kt * 64 > r0 + 15)) return;
    if (causal && (kt * 64 + 63 > r0)) attn_compute_t<true>(cK, cV, cC, qf, oacc, mrun, lrun, ct2, scale2, kt, tq, lane, g);
    else attn_compute_t<false>(cK, cV, cC, qf, oacc, mrun, lrun, ct2, scale2, kt, tq, lane, g);
}

__device__ __forceinline__ void attn_task(char* smem, const bf16_t* __restrict__ Q, int ldq, const bf16_t* __restrict__ Kp, int ldk, const bf16_t* __restrict__ Vp, int ldv, const float* __restrict__ bias,
                                          int nq_per_b, int nk_per_b, int causal, float scale, bf16_t* __restrict__ O, int ldo, const float* __restrict__ gain, int rms, int task) {
    bf16_t* sK = (bf16_t*)smem;
    bf16_t* sV = sK + 2 * 64 * TLD;
    float* sC = (float*)(sV + 2 * 64 * TLD);
    const int tid = TIDX, lane = tid & 63, wave = tid >> 6, g = lane >> 4, li = lane & 15;
    const int nqt = nq_per_b / 128;
    const int qt = task % nqt, h = (task / nqt) & 3, b = task / (nqt * 4);
    const int q0 = qt * 128, tq = q0 + wave * 16 + li;
    const size_t qrow = (size_t)b * nq_per_b + tq;
    bf16x8 qf[2];
#pragma unroll
    for (int kk = 0; kk < 2; ++kk) qf[kk] = *(const bf16x8*)(Q + qrow * ldq + h * 64 + kk * 32 + g * 8);
    constexpr float LOG2E = 1.4426950408889634f;
    const float ct = bias ? bias[(size_t)(b * 4 + h) * nq_per_b + tq] * LOG2E : 0.f;
    const float scale2 = scale * LOG2E;
    const int nkt = causal ? (q0 + 128) / 64 : nk_per_b / 64;
    const int sr = tid >> 3, sc = tid & 7;
    const bf16_t* kg = Kp + ((size_t)b * nk_per_b + sr) * ldk + h * 64 + sc * 8;
    const bf16_t* vg = Vp + ((size_t)b * nk_per_b + sr) * ldv + h * 64 + sc * 8;
    const float* cg_ = bias ? bias + (size_t)(b * 4 + h) * nk_per_b : nullptr;
    u32x4 rkA, rvA, rkB, rvB; float rcA = 0.f, rcB = 0.f;
    {   const u32x4 rk = *(const u32x4*)kg, rv = *(const u32x4*)vg; const float rc = (cg_ && tid < 64) ? cg_[tid] * LOG2E : 0.f;
        __syncthreads();
        *(u32x4*)(sK + sr * TLD + sc * 8) = rk; *(u32x4*)(sV + sr * TLD + sc * 8) = rv; if (tid < 64) sC[tid] = rc; }
    rkA = *(const u32x4*)(kg + (size_t)64 * ldk); rvA = *(const u32x4*)(vg + (size_t)64 * ldv); rcA = (cg_ && tid < 64) ? cg_[64 + tid] * LOG2E : 0.f;
    __syncthreads();
    f32x4 oacc[4];
#pragma unroll
    for (int n = 0; n < 4; ++n) oacc[n] = (f32x4){0.f, 0.f, 0.f, 0.f};
    float mrun = -INFINITY, lrun = 0.f;
#define ATTN_ITER(kt, LK, LV, LC, WK, WV, WC) { \
        const int buf = (kt) & 1; \
        if ((kt) + 2 < nkt) { LK = *(const u32x4*)(kg + (size_t)((kt) + 2) * 64 * ldk); LV = *(const u32x4*)(vg + (size_t)((kt) + 2) * 64 * ldv); LC = (cg_ && tid < 64) ? cg_[((kt) + 2) * 64 + tid] * LOG2E : 0.f; } \
        attn_compute(sK + buf * 64 * TLD, sV + buf * 64 * TLD, sC + buf * 64, qf, oacc, mrun, lrun, ct, scale2, causal, (kt), q0, tq, wave, lane, g); \
        if ((kt) + 1 < nkt) { const int nb = buf ^ 1; *(u32x4*)(sK + nb * 64 * TLD + sr * TLD + sc * 8) = WK; *(u32x4*)(sV + nb * 64 * TLD + sr * TLD + sc * 8) = WV; if (tid < 64) sC[nb * 64 + tid] = WC; } \
        __syncthreads(); }
    for (int kt = 0; kt < nkt; kt += 2) {
        ATTN_ITER(kt, rkB, rvB, rcB, rkA, rvA, rcA)
        ATTN_ITER(kt + 1, rkA, rvA, rcA, rkB, rvB, rcB)
    }
#undef ATTN_ITER
    const float inv = 1.f / lrun;
    float ms = 0.f;
#pragma unroll
    for (int n = 0; n < 4; ++n) { oacc[n] = oacc[n] * inv; ms += oacc[n][0] * oacc[n][0] + oacc[n][1] * oacc[n][1] + oacc[n][2] * oacc[n][2] + oacc[n][3] * oacc[n][3]; }
    ms += __shfl_xor(ms, 16); ms += __shfl_xor(ms, 32);
    const float rinv = rms ? rsqrtf(ms * (1.f / 64.f) + EPS) : 1.f;
#pragma unroll
    for (int n = 0; n < 4; ++n) {
        const int d = n * 16 + 4 * g;
        f32x4 gg = (f32x4){1.f, 1.f, 1.f, 1.f};
        if (gain) gg = *(const f32x4*)(gain + h * 64 + d);
        uint2 o; o.x = pk2(oacc[n][0] * rinv * gg[0], oacc[n][1] * rinv * gg[1]); o.y = pk2(oacc[n][2] * rinv * gg[2], oacc[n][3] * rinv * gg[3]);
        *(uint2*)(O + qrow * ldo + h * 64 + d) = o;
    }
}


__device__ __forceinline__ void hgrn_scan(float* LF  , float* SEGT  , const bf16_t* __restrict__ prow  , const float* __restrict__ hgrn_lb, int layer, int h, float (&kk)[8]) {
    const int tid = TIDX, t = tid >> 3, k8 = (tid & 7) * 8;
    const u32x4 raw = *(const u32x4*)(prow + (size_t)t * NP + C_AF + k8);
#pragma unroll
    for (int j = 0; j < 8; ++j) {
        const float fl = __uint_as_float((j & 1) ? (raw[j >> 1] & 0xffff0000u) : (raw[j >> 1] << 16));
        float lbk = 0.f;
        if (layer == 1) { const float a0 = hgrn_lb[h * 64 + k8 + j], a1 = hgrn_lb[256 + h * 64 + k8 + j]; lbk = 1.f / (1.f + __expf(a0 - a1)); }
        const float sg = sigmoidf_(fl);
        const float f = lbk + (1.f - lbk) * sg;
        kk[j] = (1.f - lbk) * (1.f - sg);
        LF[t * 65 + k8 + j] = __logf(f);
    }
    __syncthreads();
    { const int k = tid & 63, seg = tid >> 6; float run = 0.f;
#pragma unroll
      for (int i = 0; i < 8; ++i) { run += LF[(seg * 8 + i) * 65 + k]; LF[(seg * 8 + i) * 65 + k] = run; }
      SEGT[seg * 64 + k] = run; }
    __syncthreads();
    { const int k = tid & 63, seg = tid >> 6; float off = 0.f;
      for (int s2 = 0; s2 < seg; ++s2) off += SEGT[s2 * 64 + k];
#pragma unroll
      for (int i = 0; i < 8; ++i) LF[(seg * 8 + i) * 65 + k] += off; }
    __syncthreads();
}
__device__ __forceinline__ float bfx(const u32x4& raw, int j) { return __uint_as_float((j & 1) ? (raw[j >> 1] & 0xffff0000u) : (raw[j >> 1] << 16)); }

__device__ __forceinline__ void hgrn_local_task(char* smem, const bf16_t* __restrict__ proj, const float* __restrict__ hgrn_lb, int layer, float* __restrict__ HL, float* __restrict__ HD, int ch) {
    float* LF = (float*)smem; float* SEGT = LF + 64 * 65;
    bf16_t* sKd = (bf16_t*)(SEGT + 8 * 64); bf16_t* sV = sKd + 64 * TLD;
    const int tid = TIDX, lane = tid & 63, wave = tid >> 6, g = lane >> 4, li = lane & 15;
    const int bh = ch >> 5, n = ch & 31, b = bh >> 2, h = bh & 3;
    const bf16_t* prow = proj + (size_t)(b * SEQ + n * 64) * NP + h * 64;
    const int t = tid >> 3, k8 = (tid & 7) * 8;
    __syncthreads();
    *(u32x4*)(sV + t * TLD + k8) = *(const u32x4*)(prow + (size_t)t * NP + C_AI + k8);
    float kk[8];
    hgrn_scan(LF, SEGT, prow, hgrn_lb, layer, h, kk);
    { u32x4 o;
#pragma unroll
      for (int j = 0; j < 8; j += 2) {
          const float e0 = kk[j] * __expf(LF[63 * 65 + k8 + j] - LF[t * 65 + k8 + j]), e1 = kk[j + 1] * __expf(LF[63 * 65 + k8 + j + 1] - LF[t * 65 + k8 + j + 1]);
          o[j >> 1] = pk2(e0, e1);
      }
      *(u32x4*)(sKd + t * TLD + k8) = o; }
    if (tid < 64) HD[(size_t)ch * 64 + tid] = __expf(LF[63 * 65 + tid]);
    __syncthreads();
#pragma unroll
    for (int i = 0; i < 2; ++i) {
        const int idx = wave * 2 + i, vt = idx >> 2, kt = idx & 3;
        f32x4 acc = (f32x4){0.f, 0.f, 0.f, 0.f};
#pragma unroll
        for (int ks = 0; ks < 2; ++ks) acc = MFMA16(frag_cm(sV, TLD, ks * 32, vt * 16, lane), frag_cm(sKd, TLD, ks * 32, kt * 16, lane), acc);
        *(f32x4*)(HL + (size_t)ch * 4096 + (kt * 16 + li) * 64 + vt * 16 + 4 * g) = acc;
    }
}

__device__ __forceinline__ void hgrn_out_task(char* smem, const bf16_t* __restrict__ proj, const float* __restrict__ hgrn_lb, int layer, const bf16_t* __restrict__ HS,
                                              const float* __restrict__ mix_gain, bf16_t* __restrict__ y, int ch) {
    float* LF = (float*)smem; float* SEGT = LF + 64 * 65; float* sMS = SEGT + 8 * 64;
    bf16_t* sST = (bf16_t*)(sMS + 128); bf16_t* sQ0 = sST + 64 * TLD; bf16_t* sQm = sQ0 + 64 * TLD; bf16_t* sKm = sQm + 64 * TLD; bf16_t* sV = sKm + 64 * TLD; bf16_t* sA = sV + 64 * TLD;
    const int tid = TIDX, lane = tid & 63, wave = tid >> 6, g = lane >> 4, li = lane & 15;
    const int bh = ch >> 5, n = ch & 31, b = bh >> 2, h = bh & 3;
    const bf16_t* prow = proj + (size_t)(b * SEQ + n * 64) * NP + h * 64;
    const int t = tid >> 3, k8 = (tid & 7) * 8;
    __syncthreads();
    *(u32x4*)(sST + t * TLD + k8) = *(const u32x4*)(HS + (size_t)ch * 4096 + t * 64 + k8);
    const u32x4 qraw = *(const u32x4*)(prow + (size_t)t * NP + C_AQ + k8);
    *(u32x4*)(sV + t * TLD + k8) = *(const u32x4*)(prow + (size_t)t * NP + C_AI + k8);
    float kk[8];
    hgrn_scan(LF, SEGT, prow, hgrn_lb, layer, h, kk);
    { u32x4 o0, om, ok;
#pragma unroll
      for (int j = 0; j < 8; j += 2) {
          float q0v[2], qmv[2], kmv[2];
#pragma unroll
          for (int e = 0; e < 2; ++e) {
              const float bt = LF[t * 65 + k8 + j + e], r = LF[31 * 65 + k8 + j + e], q = siluf_(bfx(qraw, j + e));
              q0v[e] = q * __expf(bt); qmv[e] = q * __expf(bt - r); kmv[e] = kk[j + e] * __expf(r - bt);
          }
          o0[j >> 1] = pk2(q0v[0], q0v[1]); om[j >> 1] = pk2(qmv[0], qmv[1]); ok[j >> 1] = pk2(kmv[0], kmv[1]);
      }
      *(u32x4*)(sQ0 + t * TLD + k8) = o0; *(u32x4*)(sQm + t * TLD + k8) = om; *(u32x4*)(sKm + t * TLD + k8) = ok; }
    __syncthreads();
#pragma unroll
    for (int i = 0; i < 2; ++i) {
        const int idx = wave * 2 + i, tt = idx >> 2, st = idx & 3;
        f32x4 acc = (f32x4){0.f, 0.f, 0.f, 0.f};
#pragma unroll
        for (int ks = 0; ks < 2; ++ks) acc = MFMA16(frag_rm(sKm, TLD, st * 16, ks * 32, lane), frag_rm(sQm, TLD, tt * 16, ks * 32, lane), acc);
        const int tq = tt * 16 + li, s0 = st * 16 + 4 * g;
        uint2 o; o.x = pk2(s0 <= tq ? acc[0] : 0.f, s0 + 1 <= tq ? acc[1] : 0.f); o.y = pk2(s0 + 2 <= tq ? acc[2] : 0.f, s0 + 3 <= tq ? acc[3] : 0.f);
        *(uint2*)(sA + tq * TLD + s0) = o;
    }
    __syncthreads();
    { const int tt = wave >> 1;
      f32x4 oacc[2]; float ms = 0.f;
#pragma unroll
      for (int i = 0; i < 2; ++i) {
          const int vt = (wave & 1) * 2 + i;
          f32x4 acc = (f32x4){0.f, 0.f, 0.f, 0.f};
#pragma unroll
          for (int ks = 0; ks < 2; ++ks) acc = MFMA16(frag_cm(sST, TLD, ks * 32, vt * 16, lane), frag_rm(sQ0, TLD, tt * 16, ks * 32, lane), acc);
#pragma unroll
          for (int ks = 0; ks < 2; ++ks) acc = MFMA16(frag_cm(sV, TLD, ks * 32, vt * 16, lane), frag_rm(sA, TLD, tt * 16, ks * 32, lane), acc);
          oacc[i] = acc; ms += acc[0] * acc[0] + acc[1] * acc[1] + acc[2] * acc[2] + acc[3] * acc[3];
      }
      ms += __shfl_xor(ms, 16); ms += __shfl_xor(ms, 32);
      if (g == 0) sMS[(tt * 16 + li) * 2 + (wave & 1)] = ms;
      __syncthreads();
      const int tq = tt * 16 + li;
      const float rinv = rsqrtf((sMS[tq * 2] + sMS[tq * 2 + 1]) * (1.f / 64.f) + EPS);
      const size_t row = (size_t)(b * SEQ + n * 64 + tq);
#pragma unroll
      for (int i = 0; i < 2; ++i) {
          const int v0 = ((wave & 1) * 2 + i) * 16 + 4 * g;
          const uint2 graw = *(const uint2*)(proj + row * NP + C_AG + h * 64 + v0);
          const f32x4 mgv = *(const f32x4*)(mix_gain + C_AQ + h * 64 + v0);
          const float g0 = __uint_as_float(graw.x << 16), g1 = __uint_as_float(graw.x & 0xffff0000u), g2 = __uint_as_float(graw.y << 16), g3 = __uint_as_float(graw.y & 0xffff0000u);
          uint2 o; o.x = pk2(oacc[i][0] * rinv * siluf_(g0) * mgv[0], oacc[i][1] * rinv * siluf_(g1) * mgv[1]);
          o.y = pk2(oacc[i][2] * rinv * siluf_(g2) * mgv[2], oacc[i][3] * rinv * siluf_(g3) * mgv[3]);
          *(uint2*)(y + row * 1024 + h * 64 + v0) = o;
      }
    }
}


__device__ __forceinline__ void gdn_prep_task(char* smem, const bf16_t* __restrict__ proj, const float* __restrict__ gates, const float* __restrict__ conv_w  ,
                                              const float* __restrict__ a_log, const float* __restrict__ dt_bias, bf16_t* __restrict__ gt_all, float* __restrict__ glast, int ch) {
    float* sG = (float*)smem; float* sBeta = sG + 64;
    float* RHS = sBeta + 64;
    float* sM = RHS + 64 * 132;
    bf16_t* sK = (bf16_t*)(sM + 64 * 68); bf16_t* sQ = sK + 64 * TLD;
    const int tid = TIDX, lane = tid & 63, wave = tid >> 6, g = lane >> 4, li = lane & 15;
    const int bh = ch >> 5, n = ch & 31, b = bh >> 2, h = bh & 3;
    const int t = tid >> 3, d8 = (tid & 7) * 8;
    const size_t row0 = (size_t)(b * SEQ + n * 64);
    bf16_t* gt = gt_all + (size_t)ch * 5 * 4096;
    __syncthreads();
    float qn[8], kn[8], vv[8];
    {
        const int spos = n * 64 + t;
#pragma unroll
        for (int sec = 0; sec < 3; ++sec) {
            const int col = (sec == 0 ? C_DQ : (sec == 1 ? C_DK : C_DV)) + h * 64 + d8;
            float acc[8];
#pragma unroll
            for (int e = 0; e < 8; ++e) acc[e] = 0.f;
#pragma unroll
            for (int j = 0; j < 4; ++j) {
                if (spos - (3 - j) >= 0) {
                    const u32x4 raw = *(const u32x4*)(proj + (row0 + t - (3 - j)) * NP + col);
                    const f32x4 w0 = *(const f32x4*)(conv_w + j * 768 + sec * 256 + h * 64 + d8), w1 = *(const f32x4*)(conv_w + j * 768 + sec * 256 + h * 64 + d8 + 4);
#pragma unroll
                    for (int e = 0; e < 8; ++e) acc[e] += (e < 4 ? w0[e] : w1[e - 4]) * bfx(raw, e);
                }
            }
#pragma unroll
            for (int e = 0; e < 8; ++e) { const float sv = siluf_(acc[e]); if (sec == 0) qn[e] = sv; else if (sec == 1) kn[e] = sv; else vv[e] = sv; }
        }
        float sq = 0.f, sk = 0.f;
#pragma unroll
        for (int e = 0; e < 8; ++e) { sq += qn[e] * qn[e]; sk += kn[e] * kn[e]; }
        sq += __shfl_xor(sq, 1); sq += __shfl_xor(sq, 2); sq += __shfl_xor(sq, 4);
        sk += __shfl_xor(sk, 1); sk += __shfl_xor(sk, 2); sk += __shfl_xor(sk, 4);
        const float rq = rsqrtf(sq + EPS) * 0.125f, rk = rsqrtf(sk + EPS);
#pragma unroll
        for (int e = 0; e < 8; ++e) { qn[e] *= rq; kn[e] *= rk; }
    }
    if ((tid & 7) == 0) {
        const float* gr = gates + (row0 + t) * 16;
        sBeta[t] = sigmoidf_(gr[4 + h]);
        sG[t] = -__expf(a_log[h]) * softplusf_(gr[8 + h] + dt_bias[h]);
    }
    __syncthreads();
    if (wave == 0) {
        float v = sG[lane];
#pragma unroll
        for (int o = 1; o < 64; o <<= 1) { const float nb = __shfl_up(v, o); if (lane >= o) v += nb; }
        sG[lane] = v;
    }
    __syncthreads();
    {
        const float Gt = sG[t], Gl = sG[63], bt = sBeta[t];
        const float eG = __expf(Gt), eD = __expf(Gl - Gt);
        u32x4 ok, oq, oqd, okd;
#pragma unroll
        for (int e = 0; e < 8; e += 2) {
            ok[e >> 1] = pk2(kn[e], kn[e + 1]); oq[e >> 1] = pk2(qn[e], qn[e + 1]);
            oqd[e >> 1] = pk2(qn[e] * eG, qn[e + 1] * eG); okd[e >> 1] = pk2(kn[e] * eD, kn[e + 1] * eD);
        }
        *(u32x4*)(sK + t * TLD + d8) = ok; *(u32x4*)(sQ + t * TLD + d8) = oq;
        *(u32x4*)(gt + 2 * 4096 + t * 64 + d8) = oqd; *(u32x4*)(gt + 3 * 4096 + t * 64 + d8) = okd;
#pragma unroll
        for (int e = 0; e < 8; ++e) { RHS[t * 132 + d8 + e] = vv[e] * bt; RHS[t * 132 + 64 + d8 + e] = kn[e] * bt * eG; }
        if (tid == 0) glast[ch] = __expf(Gl);
    }
    __syncthreads();
#pragma unroll
    for (int i = 0; i < 2; ++i) {
        const int idx = wave * 2 + i, tt = idx >> 2, st = idx & 3;
        f32x4 am = (f32x4){0.f, 0.f, 0.f, 0.f}, aq = (f32x4){0.f, 0.f, 0.f, 0.f};
#pragma unroll
        for (int ks = 0; ks < 2; ++ks) {
            const bf16x8 kfs = frag_rm(sK, TLD, st * 16, ks * 32, lane), kft = frag_rm(sK, TLD, tt * 16, ks * 32, lane);
            am = MFMA16(kft, kfs, am);
            aq = MFMA16(kfs, frag_rm(sQ, TLD, tt * 16, ks * 32, lane), aq);
        }
        {   const int sx = st * 16 + li, t0 = tt * 16 + 4 * g; const float Gs = sG[sx];
            f32x4 mo;
#pragma unroll
            for (int r = 0; r < 4; ++r) { const int tq = t0 + r; mo[r] = (sx < tq) ? sBeta[tq] * am[r] * __expf(sG[tq] - Gs) : 0.f; }
            *(f32x4*)(sM + sx * 68 + t0) = mo; }
        {   const int tq = tt * 16 + li, s0 = st * 16 + 4 * g; const float Gt = sG[tq];
            float ao[4];
#pragma unroll
            for (int r = 0; r < 4; ++r) { const int sx = s0 + r; ao[r] = (sx <= tq) ? aq[r] * __expf(Gt - sG[sx]) : 0.f; }
            uint2 o; o.x = pk2(ao[0], ao[1]); o.y = pk2(ao[2], ao[3]);
            *(uint2*)(gt + 4 * 4096 + tq * 64 + s0) = o; }
    }
    __syncthreads();
    if (tid < 128) {
        float acc[64];
#pragma unroll
        for (int i = 0; i < 64; ++i) acc[i] = RHS[i * 132 + tid];
#pragma unroll
        for (int half = 0; half < 2; ++half) {
            const int base = half * 32;
            if (half == 1) {
#pragma unroll
                for (int sx = 0; sx < 32; sx += 2) {
                    f32x4 r0[8], r1[8];
#pragma unroll
                    for (int c = 0; c < 8; ++c) { r0[c] = *(const f32x4*)(sM + sx * 68 + 32 + c * 4); r1[c] = *(const f32x4*)(sM + (sx + 1) * 68 + 32 + c * 4); }
                    const float x0 = acc[sx], x1 = acc[sx + 1];
#pragma unroll
                    for (int tq = 0; tq < 32; ++tq) { acc[32 + tq] -= r0[tq >> 2][tq & 3] * x0; acc[32 + tq] -= r1[tq >> 2][tq & 3] * x1; }
                }
            }
            f32x4 cur[8];
#pragma unroll
            for (int c = 0; c < 8; ++c) cur[c] = *(const f32x4*)(sM + base * 68 + base + c * 4);
#pragma unroll
            for (int sx = 0; sx < 31; ++sx) {
                f32x4 nxt[8];
#pragma unroll
                for (int c = (sx + 2) >> 2; c < 8; ++c) nxt[c] = *(const f32x4*)(sM + (base + sx + 1) * 68 + base + c * 4);
                const float xs = acc[base + sx];
#pragma unroll
                for (int tq = sx + 1; tq < 32; ++tq) acc[base + tq] -= cur[tq >> 2][tq & 3] * xs;
#pragma unroll
                for (int c = (sx + 2) >> 2; c < 8; ++c) cur[c] = nxt[c];
            }
        }
        if (tid < 64) {
#pragma unroll
            for (int tt = 0; tt < 64; ++tt) gt[tt * 64 + tid] = f2bf(acc[tt]);
        } else {
#pragma unroll
            for (int tt = 0; tt < 64; ++tt) gt[4096 + tt * 64 + (tid - 64)] = f2bf(-acc[tt]);
        }
    }
}

__device__ __forceinline__ void gdn_scan_task(char* smem, const bf16_t* __restrict__ gt_all, const float* __restrict__ glast, const bf16_t* __restrict__ proj, const float* __restrict__ mix_gain,
                                              bf16_t* __restrict__ y, int bh) {
    bf16_t* sT = (bf16_t*)smem;
    bf16_t* sST = sT + 2 * 5 * 64 * TLD;
    bf16_t* sVn = sST + 2 * 64 * TLD;
    const int tid = TIDX, lane = tid & 63, wave = tid >> 6, g = lane >> 4, li = lane & 15;
    const int b = bh >> 2, h = bh & 3;
    const int sr = tid >> 3, sc8 = (tid & 7) * 8;
    const bf16_t* gsrc = gt_all + (size_t)bh * 32 * 5 * 4096 + sr * 64 + sc8;
    __syncthreads();
    u32x4 regs[5];
#pragma unroll
    for (int i = 0; i < 5; ++i) regs[i] = *(const u32x4*)(gsrc + i * 4096);
#pragma unroll
    for (int i = 0; i < 5; ++i) *(u32x4*)(sT + i * 64 * TLD + sr * TLD + sc8) = regs[i];
    *(u32x4*)(sST + sr * TLD + sc8) = (u32x4){0u, 0u, 0u, 0u};
    f32x4 sacc[4];
#pragma unroll
    for (int i = 0; i < 4; ++i) sacc[i] = (f32x4){0.f, 0.f, 0.f, 0.f};
    __syncthreads();
    for (int n = 0; n < 32; ++n) {
        const int buf = n & 1;
        const bf16_t* cT = sT + buf * 5 * 64 * TLD;
        const bf16_t* sU = cT; const bf16_t* sWn = cT + 64 * TLD; const bf16_t* sQd = cT + 2 * 64 * TLD; const bf16_t* sKd = cT + 3 * 64 * TLD; const bf16_t* sAq = cT + 4 * 64 * TLD;
        const bf16_t* cST = sST + buf * 64 * TLD; bf16_t* nST = sST + (buf ^ 1) * 64 * TLD;
        if (n + 1 < 32) {
#pragma unroll
            for (int i = 0; i < 5; ++i) regs[i] = *(const u32x4*)(gsrc + (size_t)(n + 1) * 5 * 4096 + i * 4096);
        }
        const size_t rowz = (size_t)(b * SEQ + n * 64 + (wave & 3) * 16 + li);
        uint2 zraw[4];
        if (wave < 4) {
#pragma unroll
            for (int vt = 0; vt < 4; ++vt) zraw[vt] = *(const uint2*)(proj + rowz * NP + C_DZ + h * 64 + vt * 16 + 4 * g);
        }
#pragma unroll
        for (int i = 0; i < 2; ++i) {
            const int idx = wave * 2 + i, tt = idx >> 2, vt = idx & 3;
            const int tq = tt * 16 + li, v0 = vt * 16 + 4 * g;
            const uint2 uraw = *(const uint2*)(sU + tq * TLD + v0);
            f32x4 acc = (f32x4){__uint_as_float(uraw.x << 16), __uint_as_float(uraw.x & 0xffff0000u), __uint_as_float(uraw.y << 16), __uint_as_float(uraw.y & 0xffff0000u)};
#pragma unroll
            for (int ks = 0; ks < 2; ++ks) acc = MFMA16(frag_rm(cST, TLD, vt * 16, ks * 32, lane), frag_rm(sWn, TLD, tt * 16, ks * 32, lane), acc);
            uint2 o; o.x = pk2(acc[0], acc[1]); o.y = pk2(acc[2], acc[3]);
            *(uint2*)(sVn + tq * TLD + v0) = o;
        }
        __syncthreads();
        if (wave < 4) {
            const int tt = wave;
            f32x4 oacc[4]; float ms = 0.f;
#pragma unroll
            for (int vt = 0; vt < 4; ++vt) {
                f32x4 acc = (f32x4){0.f, 0.f, 0.f, 0.f};
#pragma unroll
                for (int ks = 0; ks < 2; ++ks) acc = MFMA16(frag_rm(cST, TLD, vt * 16, ks * 32, lane), frag_rm(sQd, TLD, tt * 16, ks * 32, lane), acc);
#pragma unroll
                for (int ks = 0; ks < 2; ++ks) acc = MFMA16(frag_cm(sVn, TLD, ks * 32, vt * 16, lane), frag_rm(sAq, TLD, tt * 16, ks * 32, lane), acc);
                oacc[vt] = acc; ms += acc[0] * acc[0] + acc[1] * acc[1] + acc[2] * acc[2] + acc[3] * acc[3];
            }
            ms += __shfl_xor(ms, 16); ms += __shfl_xor(ms, 32);
            const float rinv = rsqrtf(ms * (1.f / 64.f) + EPS);
#pragma unroll
            for (int vt = 0; vt < 4; ++vt) {
                const int v0 = vt * 16 + 4 * g;
                const f32x4 mgv = *(const f32x4*)(mix_gain + 768 + h * 64 + v0);
                const float z0 = __uint_as_float(zraw[vt].x << 16), z1 = __uint_as_float(zraw[vt].x & 0xffff0000u), z2 = __uint_as_float(zraw[vt].y << 16), z3 = __uint_as_float(zraw[vt].y & 0xffff0000u);
                uint2 o; o.x = pk2(oacc[vt][0] * rinv * siluf_(z0) * mgv[0], oacc[vt][1] * rinv * siluf_(z1) * mgv[1]);
                o.y = pk2(oacc[vt][2] * rinv * siluf_(z2) * mgv[2], oacc[vt][3] * rinv * siluf_(z3) * mgv[3]);
                *(uint2*)(y + rowz * 1024 + 768 + h * 64 + v0) = o;
            }
        } else {
            const int kt = wave - 4;
            const float gl = glast[bh * 32 + n];
#pragma unroll
            for (int vt = 0; vt < 4; ++vt) {
                f32x4 acc = sacc[vt] * gl;
#pragma unroll
                for (int ks = 0; ks < 2; ++ks) acc = MFMA16(frag_cm(sKd, TLD, ks * 32, kt * 16, lane), frag_cm(sVn, TLD, ks * 32, vt * 16, lane), acc);
                sacc[vt] = acc;
                uint2 o; o.x = pk2(acc[0], acc[1]); o.y = pk2(acc[2], acc[3]);
                *(uint2*)(nST + (vt * 16 + li) * TLD + kt * 16 + 4 * g) = o;
            }
        }
        if (n + 1 < 32) {
            bf16_t* nT = sT + (buf ^ 1) * 5 * 64 * TLD;
#pragma unroll
            for (int i = 0; i < 5; ++i) *(u32x4*)(nT + i * 64 * TLD + sr * TLD + sc8) = regs[i];
        }
        __syncthreads();
    }
}


constexpr int XLD = 264;
__device__ __forceinline__ void lru_local_task(char* smem, const bf16_t* __restrict__ proj, const float* __restrict__ conv_w, const float* __restrict__ conv_b,
                                               const float* __restrict__ w_a, const float* __restrict__ b_a, const float* __restrict__ w_x, const float* __restrict__ b_x,
                                               const float* __restrict__ lam, float* __restrict__ hl_out, float* __restrict__ ac_out, float* __restrict__ lsum, int task) {
    bf16_t* sX = (bf16_t*)smem;
    bf16_t* sW = sX + 64 * XLD;
    float* sAa = (float*)(sW + 2 * 64 * TLD);
    float* sU = sAa + 64 * 65;
    float* sSegA = sU + 64 * 65; float* sSegH = sSegA + 8 * 64;
    const int tid = TIDX, lane = tid & 63, wave = tid >> 6, g = lane >> 4, li = lane & 15;
    const int b = task >> 5, n = task & 31;
    const size_t row0 = (size_t)(b * SEQ + n * 64);
    const int t = tid >> 3;
    __syncthreads();
    {
        const int spos = n * 64 + t;
#pragma unroll
        for (int i = 0; i < 4; ++i) {
            const int c8 = ((tid & 7) + 8 * i) * 8;
            float acc[8];
            { const f32x4 cb0 = *(const f32x4*)(conv_b + c8), cb1 = *(const f32x4*)(conv_b + c8 + 4);
#pragma unroll
              for (int e = 0; e < 8; ++e) acc[e] = e < 4 ? cb0[e] : cb1[e - 4]; }
#pragma unroll
            for (int j = 0; j < 4; ++j) {
                if (spos - (3 - j) >= 0) {
                    const u32x4 raw = *(const u32x4*)(proj + (row0 + t - (3 - j)) * NP + C_CX + c8);
                    const f32x4 w0 = *(const f32x4*)(conv_w + j * 256 + c8), w1 = *(const f32x4*)(conv_w + j * 256 + c8 + 4);
#pragma unroll
                    for (int e = 0; e < 8; ++e) acc[e] += (e < 4 ? w0[e] : w1[e - 4]) * bfx(raw, e);
                }
            }
            u32x4 o; o[0] = pk2(acc[0], acc[1]); o[1] = pk2(acc[2], acc[3]); o[2] = pk2(acc[4], acc[5]); o[3] = pk2(acc[6], acc[7]);
            *(u32x4*)(sX + t * XLD + c8) = o;
        }
    }
    for (int hh = 0; hh < 4; ++hh) {
        {
            const int i = tid >> 3, j8 = (tid & 7) * 8;
#pragma unroll
            for (int m = 0; m < 2; ++m) {
                const float* src = (m == 0 ? w_a : w_x) + (size_t)hh * 4096 + i * 64 + j8;
                const f32x4 v0 = *(const f32x4*)src, v1 = *(const f32x4*)(src + 4);
                u32x4 o; o[0] = pk2(v0[0], v0[1]); o[1] = pk2(v0[2], v0[3]); o[2] = pk2(v1[0], v1[1]); o[3] = pk2(v1[2], v1[3]);
                *(u32x4*)(sW + m * 64 * TLD + i * TLD + j8) = o;
            }
        }
        __syncthreads();
#pragma unroll
        for (int i2 = 0; i2 < 2; ++i2) {
            const int idx = wave * 2 + i2, tt = idx >> 2, jt = idx & 3;
            f32x4 ra = (f32x4){0.f, 0.f, 0.f, 0.f}, rx = (f32x4){0.f, 0.f, 0.f, 0.f};
#pragma unroll
            for (int ks = 0; ks < 2; ++ks) {
                const bf16x8 xf = frag_rm(sX + hh * 64, XLD, tt * 16, ks * 32, lane);
                ra = MFMA16(frag_cm(sW, TLD, ks * 32, jt * 16, lane), xf, ra);
                rx = MFMA16(frag_cm(sW + 64 * TLD, TLD, ks * 32, jt * 16, lane), xf, rx);
            }
            const int tq = tt * 16 + li, cl = jt * 16 + 4 * g, c = hh * 64 + cl;
            const f32x4 ba = *(const f32x4*)(b_a + c), bx = *(const f32x4*)(b_x + c), lm = *(const f32x4*)(lam + c);
            const uint2 xraw = *(const uint2*)(sX + tq * XLD + c);
            const float xc[4] = {__uint_as_float(xraw.x << 16), __uint_as_float(xraw.x & 0xffff0000u), __uint_as_float(xraw.y << 16), __uint_as_float(xraw.y & 0xffff0000u)};
#pragma unroll
            for (int r = 0; r < 4; ++r) {
                const float rr = sigmoidf_(ra[r] + ba[r]), ig = sigmoidf_(rx[r] + bx[r]);
                const float log_a = -8.f * rr * softplusf_(-lm[r]);
                sAa[tq * 65 + cl + r] = __expf(log_a);
                sU[tq * 65 + cl + r] = sqrtf(-expm1f(2.f * log_a)) * (ig * xc[r]);
            }
        }
        __syncthreads();
        const int cl = tid & 63, seg = tid >> 6;
        float Al[8], Hl[8];
        { float A = 1.f, H = 0.f;
#pragma unroll
          for (int i = 0; i < 8; ++i) { const float a = sAa[(seg * 8 + i) * 65 + cl], u = sU[(seg * 8 + i) * 65 + cl]; H = a * H + u; A *= a; Al[i] = A; Hl[i] = H; }
          sSegA[seg * 64 + cl] = A; sSegH[seg * 64 + cl] = H; }
        __syncthreads();
        { float Ac = 1.f, Hc = 0.f;
          for (int s2 = 0; s2 < seg; ++s2) { const float a = sSegA[s2 * 64 + cl]; Hc = a * Hc + sSegH[s2 * 64 + cl]; Ac *= a; }
#pragma unroll
          for (int i = 0; i < 8; ++i) {
              const size_t o = (row0 + seg * 8 + i) * 256 + hh * 64 + cl;
              const float hv = Hl[i] + Al[i] * Hc, av = Al[i] * Ac;
              hl_out[o] = hv; ac_out[o] = av;
              if (seg == 7 && i == 7) { lsum[(size_t)task * 256 + hh * 64 + cl] = av; lsum[(size_t)(256 + task) * 256 + hh * 64 + cl] = hv; }
          } }
        __syncthreads();
    }
}
__device__ __forceinline__ void lru_out_task(const float* __restrict__ hl_in, const float* __restrict__ ac_in, const float* __restrict__ lsum, const bf16_t* __restrict__ proj,
                                             const float* __restrict__ mix_gain, bf16_t* __restrict__ y, int task) {
    const int b = task >> 5, n = task & 31, c = TIDX & 255, half = TIDX >> 8;
    const float Hc = lsum[(size_t)task * 256 + c];
    const float mg = mix_gain[512 + c];
    const size_t row0 = (size_t)(b * SEQ + n * 64 + half * 32);
#pragma unroll 4
    for (int i = 0; i < 32; ++i) {
        const size_t row = row0 + i;
        const float hv = hl_in[row * 256 + c] + ac_in[row * 256 + c] * Hc;
        const float yv = hv * geluf_(bf2f(proj[row * NP + C_CG + c]));
        const float ms = wave_sum(yv * yv) * (1.f / 64.f);
        y[row * 1024 + 512 + c] = f2bf(yv * rsqrtf(ms + EPS) * mg);
    }
}


__device__ __forceinline__ void state_scan_phase(const float* __restrict__ HL, const float* __restrict__ HD, bf16_t* __restrict__ HS, const float* __restrict__ lsum, float* __restrict__ lcar) {
    const int bx = blockIdx.x, tid = TIDX;
    for (int u = bx; u < 128 + 4; u += gridDim.x) {
        if (u < 128) {
            const int gid = u * NTHR + tid, bh = gid >> 11, v = gid & 63, kp = (gid >> 6) & 31;
            const float* Lb = HL + (size_t)bh * 32 * 4096 + (2 * kp) * 64 + v; const float* Db = HD + (size_t)bh * 32 * 64 + 2 * kp;
            bf16_t* Sb = HS + (size_t)bh * 32 * 4096 + (2 * kp) * 64 + v;
            float S0 = 0.f, S1 = 0.f;
            for (int n0 = 0; n0 < 32; n0 += 8) {
                float l0[8], l1[8], d0[8], d1[8];
#pragma unroll
                for (int i = 0; i < 8; ++i) { l0[i] = Lb[(size_t)(n0 + i) * 4096]; l1[i] = Lb[(size_t)(n0 + i) * 4096 + 64]; d0[i] = Db[(n0 + i) * 64]; d1[i] = Db[(n0 + i) * 64 + 1]; }
#pragma unroll
                for (int i = 0; i < 8; ++i) {
                    Sb[(size_t)(n0 + i) * 4096] = f2bf(S0); Sb[(size_t)(n0 + i) * 4096 + 64] = f2bf(S1);
                    S0 = d0[i] * S0 + l0[i]; S1 = d1[i] * S1 + l1[i];
                }
            }
        } else {
            const int gid = (u - 128) * NTHR + tid, b = gid >> 8, c = gid & 255;
            float A[32], H[32];
#pragma unroll
            for (int n = 0; n < 32; ++n) { A[n] = lsum[(size_t)(b * 32 + n) * 256 + c]; H[n] = lsum[(size_t)(256 + b * 32 + n) * 256 + c]; }
            float Hc = 0.f;
#pragma unroll
            for (int n = 0; n < 32; ++n) { lcar[(size_t)(b * 32 + n) * 256 + c] = Hc; Hc = A[n] * Hc + H[n]; }
        }
    }
}

__device__ __forceinline__ void router_phase(char* smem, const float* __restrict__ x, const float* __restrict__ g, const float* __restrict__ w_rg, const float* __restrict__ b_rg,
                                             const float* __restrict__ w_re, const float* __restrict__ b_re, bf16_t* __restrict__ hn, int* __restrict__ cnt, int* __restrict__ list, float* __restrict__ pgate) {
    float* sXg = (float*)smem;
    float* sWr = sXg + 64 * 132;
    float* sLog = sWr + 128 * 40;
    float* sRinv = sLog + 64 * 40;
    const int tid = TIDX;
    BLK_LOOP(tile, T / 64) {
        const int t0 = tile * 64;
        const int stok = tid >> 3;
        const int ctok = tid & 63, eg = tid >> 6;
        float acc[5] = {0.f, 0.f, 0.f, 0.f, 0.f};
        float ss = 0.f;
        for (int kc = 0; kc < 8; ++kc) {
            __syncthreads();
#pragma unroll
            for (int i = 0; i < 4; ++i) {
                const int col = ((tid & 7) + 8 * i) * 4;
                const f32x4 xv = *(const f32x4*)(x + (size_t)(t0 + stok) * 1024 + kc * 128 + col);
                const f32x4 gv = *(const f32x4*)(g + kc * 128 + col);
                ss += xv[0] * xv[0] + xv[1] * xv[1] + xv[2] * xv[2] + xv[3] * xv[3];
                *(f32x4*)(sXg + stok * 132 + col) = xv * gv;
            }
            for (int idx = tid; idx < 128 * 40; idx += NTHR) {
                const int k = idx / 40, e = idx - k * 40;
                float wv = 0.f;
                if (e < 4) wv = w_rg[(size_t)(kc * 128 + k) * 4 + e]; else if (e < 36) wv = w_re[(size_t)(kc * 128 + k) * 32 + (e - 4)];
                sWr[idx] = wv;
            }
            __syncthreads();
#pragma unroll 2
            for (int k4 = 0; k4 < 128; k4 += 4) {
                const f32x4 hv = *(const f32x4*)(sXg + ctok * 132 + k4);
#pragma unroll
                for (int kk = 0; kk < 4; ++kk) {
                    const float* wp = sWr + (k4 + kk) * 40 + eg * 5;
#pragma unroll
                    for (int j = 0; j < 5; ++j) acc[j] += hv[kk] * wp[j];
                }
            }
        }
        ss += __shfl_xor(ss, 1); ss += __shfl_xor(ss, 2); ss += __shfl_xor(ss, 4);
        if ((tid & 7) == 0) sRinv[stok] = rsqrtf(ss * (1.f / 1024.f) + EPS);
#pragma unroll
        for (int j = 0; j < 5; ++j) sLog[ctok * 40 + eg * 5 + j] = acc[j];
        __syncthreads();
        if (tid < 64) {
            const int t = t0 + tid; const float rinv = sRinv[tid];
            float lg[4];
#pragma unroll
            for (int i = 0; i < 4; ++i) lg[i] = sLog[tid * 40 + i] * rinv + b_rg[i];
            int gs = 0; float gm = lg[0];
#pragma unroll
            for (int i = 1; i < 4; ++i) if (lg[i] > gm) { gm = lg[i]; gs = i; }
            float den = 0.f;
#pragma unroll
            for (int i = 0; i < 4; ++i) den += __expf(lg[i] - gm);
            const float pg = 1.f / den;
            int i0 = 0, i1 = -1; float m0 = -INFINITY, m1 = -INFINITY;
            for (int i = 0; i < 8; ++i) {
                const float v = sLog[tid * 40 + 4 + gs * 8 + i] * rinv + b_re[gs * 8 + i];
                if (v > m0) { m1 = m0; i1 = i0; m0 = v; i0 = i; } else if (v > m1) { m1 = v; i1 = i; }
            }
            const float e1 = __expf(m1 - m0); const float w0 = 1.f / (1.f + e1), w1 = e1 / (1.f + e1);
            const int ex0 = gs * 8 + i0, ex1 = gs * 8 + i1;
            const int pos0 = atomicAdd(&cnt[ex0], 1); list[(size_t)ex0 * T + pos0] = 2 * t; pgate[2 * t] = pg * w0;
            const int pos1 = atomicAdd(&cnt[ex1], 1); list[(size_t)ex1 * T + pos1] = 2 * t + 1; pgate[2 * t + 1] = pg * w1;
        }
        {
            const float rinv = sRinv[stok];
#pragma unroll 4
            for (int i = 0; i < 32; ++i) {
                const int col = ((tid & 7) + 8 * i) * 4;
                const f32x4 xv = *(const f32x4*)(x + (size_t)(t0 + stok) * 1024 + col);
                const f32x4 gv = *(const f32x4*)(g + col);
                uint2 o; o.x = pk2(xv[0] * gv[0] * rinv, xv[1] * gv[1] * rinv); o.y = pk2(xv[2] * gv[2] * rinv, xv[3] * gv[3] * rinv);
                *(uint2*)(hn + (size_t)(t0 + stok) * 1024 + col) = o;
            }
        }
    }
}

__device__ __forceinline__ void combine_phase(const float* x2, const bf16_t* __restrict__ eo, const float* __restrict__ g, float* xout, bf16_t* __restrict__ hn, int mode) {
    const int lane = TIDX & 63;
    for (int t = blockIdx.x * 8 + (TIDX >> 6); t < T; t += gridDim.x * 8) {
        f32x4 v[4]; float s = 0.f;
#pragma unroll
        for (int j = 0; j < 4; ++j) {
            const int c = (lane + 64 * j) * 4;
            v[j] = *(const f32x4*)(x2 + (size_t)t * 1024 + c);
            const uint2 e0 = *(const uint2*)(eo + (size_t)(2 * t) * 1024 + c), e1 = *(const uint2*)(eo + (size_t)(2 * t + 1) * 1024 + c);
            v[j].x += __uint_as_float(e0.x << 16) + __uint_as_float(e1.x << 16);
            v[j].y += __uint_as_float(e0.x & 0xffff0000u) + __uint_as_float(e1.x & 0xffff0000u);
            v[j].z += __uint_as_float(e0.y << 16) + __uint_as_float(e1.y << 16);
            v[j].w += __uint_as_float(e0.y & 0xffff0000u) + __uint_as_float(e1.y & 0xffff0000u);
            s += v[j].x * v[j].x + v[j].y * v[j].y + v[j].z * v[j].z + v[j].w * v[j].w;
        }
        const float rinv = rsqrtf(wave_sum(s) * (1.f / 1024.f) + EPS);
#pragma unroll
        for (int j = 0; j < 4; ++j) {
            const int c = (lane + 64 * j) * 4;
            const f32x4 gg = *(const f32x4*)(g + c);
            const f32x4 hv = v[j] * rinv * gg;
            if (mode == 0) {
                *(f32x4*)(xout + (size_t)t * 1024 + c) = v[j];
                uint2 o; o.x = pk2(hv.x, hv.y); o.y = pk2(hv.z, hv.w);
                *(uint2*)(hn + (size_t)t * 1024 + c) = o;
            } else {
                *(f32x4*)(xout + (size_t)t * 1024 + c) = hv;
            }
        }
    }
}

template <int l>
__device__ __forceinline__ void layer_body(const Params& P, char* smem, const XcdBarrier& xb, const float* xcur) {
    char* ws = P.ws;
    bf16_t* Wt_in = (bf16_t*)(ws + OFF_WIN); bf16_t* Wt_out = (bf16_t*)(ws + OFF_WOUT); bf16_t* Wt_mq = (bf16_t*)(ws + OFF_WMQ); bf16_t* Wt_mkv = (bf16_t*)(ws + OFF_WMKV);
    bf16_t* Wt_mo = (bf16_t*)(ws + OFF_WMO); bf16_t* Wt_gu = (bf16_t*)(ws + OFF_WGU); bf16_t* Wt_dn = (bf16_t*)(ws + OFF_WDN);
    bf16_t* hn = (bf16_t*)(ws + OFF_HN); bf16_t* proj = (bf16_t*)(ws + OFF_PROJ); float* gates = (float*)(ws + OFF_GATES); bf16_t* y = (bf16_t*)(ws + OFF_Y);
    float* XA = P.out; float* XB = (float*)(ws + OFF_XB);
    bf16_t* qm = (bf16_t*)(ws + OFF_QM); bf16_t* om = (bf16_t*)(ws + OFF_OM); bf16_t* kvm = (bf16_t*)(ws + OFF_KVM); bf16_t* memn = (bf16_t*)(ws + OFF_MEMN);
    float* foxc = (float*)(ws + OFF_FOXC); float* lrua = (float*)(ws + OFF_LRUA); float* lruu = (float*)(ws + OFF_LRUU);
    int* cnt_all = (int*)(ws + OFF_CTL) + CTL_CNT_WORD; int* list = (int*)(ws + OFF_LIST); float* pgate = (float*)(ws + OFF_PGATE);
    bf16_t* act = (bf16_t*)(ws + OFF_ACT); bf16_t* eo = (bf16_t*)(ws + OFF_EO);
    const int wave = TIDX >> 6, lane = TIDX & 63;


        float* x1 = (l == 0) ? XA : XB;
        float* x2 = (l == 0) ? XB : XA;
        int* cnt = cnt_all + 32 * l;
        const float* mg = P.in[I_MIX_GAIN] + l * 1024;
        REP(2, { pg8::Gemm g{hn, Wt_in + (size_t)l * NP * 1024, T, NP, 1024}; pg8::StaticOrder S; S.init(T, NP, (int)gridDim.x, (int)blockIdx.x);
                 pg8::EpiInProj E{proj, NP, gates, C_GATE};
                 pg8::gemm_phase<pg8::EpiInProj, pg8::StaticOrder, true, true>((PG8_LAS unsigned char*)smem, g, S, E); });
        if (l == 0) for (int l2 = 0; l2 < NL; ++l2)
            gemm_phase<EPI_BF16>(smem, memn + (size_t)l2 * 2048 * 1024, 1024, Wt_mkv + (size_t)l2 * 512 * 1024, 1024, 2048, 512, 1024, kvm + (size_t)l2 * 2048 * 512, 512, nullptr, nullptr);
        GSYNC();
        REP(4,         {
            const int bx = blockIdx.x;
            bf16_t* gtiles = (bf16_t*)(ws + OFF_GDN); float* glast = (float*)(ws + OFF_GLAST);
            if (bx < 32 && wave == 1) fox_cumsum(gates, P.in[I_FOX_FB] + l * 4, foxc, bx, lane);
            BLK_LOOP(ch, 1024) gdn_prep_task(smem, proj, gates, P.in[I_GDN_CONV_W] + l * 4 * 768, P.in[I_GDN_A_LOG] + l * 4, P.in[I_GDN_DT_BIAS] + l * 4, gtiles, glast, ch);
            BLK_LOOP(ch, 1024) hgrn_local_task(smem, proj, P.in[I_HGRN_LB], l, (float*)(ws + OFF_HL), (float*)(ws + OFF_HD), ch);
            BLK_LOOP(task, 256) lru_local_task(smem, proj, P.in[I_LRU_CONV_W] + l * 1024, P.in[I_LRU_CONV_B] + l * 256, P.in[I_LRU_WA] + l * 16384, P.in[I_LRU_BA] + l * 256,
                                               P.in[I_LRU_WX] + l * 16384, P.in[I_LRU_BX] + l * 256, P.in[I_LRU_LAM] + l * 256, lrua, lruu, (float*)(ws + OFF_LSUM), task);
        });
        GSYNC();
        state_scan_phase((const float*)(ws + OFF_HL), (const float*)(ws + OFF_HD), (bf16_t*)(ws + OFF_HS), (const float*)(ws + OFF_LSUM), (float*)(ws + OFF_LCAR));
        GSYNC();
        REP(8,         {
            const int natt = (SEQ / 128) * 4 * NB;
            const int bx = blockIdx.x, nfree = (int)gridDim.x - 32;
            if (bx < 32) gdn_scan_task(smem, (const bf16_t*)(ws + OFF_GDN), (const float*)(ws + OFF_GLAST), proj, mg, y, bx);
            else {
                for (int r = 0; r * nfree < natt; ++r) {
                    const int i = r * nfree + ((r & 1) ? (nfree - 1 - (bx - 32)) : (bx - 32));
                    if (i >= natt) continue;
                    const int qt = 15 - (i >> 5), bh = i & 31;
                    attn_task(smem, proj + C_BQ, NP, proj + C_BK, NP, proj + C_BV, NP, foxc, SEQ, SEQ, 1, 0.125f, y + 256, 1024, mg + 256, 1, (bh * 16) + qt);
                }
                for (int i = bx - 32; i < 1024; i += nfree) {
                    const int ch = (i & 31) * 32 + (31 - (i >> 5));
                    hgrn_out_task(smem, proj, P.in[I_HGRN_LB], l, (const bf16_t*)(ws + OFF_HS), mg, y, ch);
                }
                for (int i = bx - 32; i < 256; i += nfree) lru_out_task(lrua, lruu, (const float*)(ws + OFF_LCAR), proj, mg, y, i);
            }
        });
        GSYNC();
        REP(16, { pg8::Gemm g{y, Wt_out + (size_t)l * 1024 * 1024, T, 1024, 1024}; pg8::StaticOrder S; S.init(T, 1024, (int)gridDim.x, (int)blockIdx.x);
                  pg8::EpiResid E{xcur, x1, 1024};
                  pg8::gemm_phase<pg8::EpiResid, pg8::StaticOrder, true, true>((PG8_LAS unsigned char*)smem, g, S, E); });
        GSYNC();
        REP(32, for (int row = blockIdx.x * 8 + wave; row < T; row += gridDim.x * 8) rms_row_bf16(x1 + (size_t)row * 1024, P.in[I_NORM_MEM] + l * 1024, hn + (size_t)row * 1024, lane));
        GSYNC();
        REP(64, gemm_phase<EPI_BF16>(smem, hn, 1024, Wt_mq + (size_t)l * 256 * 1024, 1024, T, 256, 1024, qm, 256, nullptr, nullptr));
        GSYNC();
        { const bf16_t* kv = kvm + (size_t)l * 2048 * 512;
          REP(128, BLK_LOOP(task, (SEQ / 128) * 4 * NB) attn_task(smem, qm, 256, kv, 512, kv + 256, 512, nullptr, SEQ, MEMLEN, 0, 0.125f, om, 256, nullptr, 0, task)); }
        GSYNC();
        REP(256, { pg8::Gemm g{om, Wt_mo + (size_t)l * 1024 * 256, T, 1024, 256}; pg8::StaticOrder S; S.init(T, 1024, (int)gridDim.x, (int)blockIdx.x);
                   pg8::EpiResid E{x1, x2, 1024};
                   pg8::gemm_phase<pg8::EpiResid, pg8::StaticOrder, true, true>((PG8_LAS unsigned char*)smem, g, S, E); });
        GSYNC();
        router_phase(smem, x2, P.in[I_NORM_FFN] + l * 1024, P.in[I_W_RG] + l * 4096, P.in[I_B_RG] + l * 4, P.in[I_W_RE] + l * 32768, P.in[I_B_RE] + l * 32, hn, cnt, list, pgate);
        GSYNC();
        REP(512, moe_phase<1>(smem, hn, 1024, Wt_gu + (size_t)l * 32 * 512 * 1024, (size_t)512 * 1024, 1024, 1024, cnt, list, pgate, act));
        GSYNC();
        REP(1024, moe_phase<2>(smem, act, 256, Wt_dn + (size_t)l * 32 * 1024 * 256, (size_t)1024 * 256, 256, 256, cnt, list, pgate, eo));
        if (PROBE_MASK & 2048) { for (int i = 0; i < 10; ++i) GSYNC(); }
        GSYNC();
        if (l == 0) { combine_phase(x2, eo, P.in[I_NORM_MIX] + 1024, XA, hn, 0); GSYNC(); }
        else combine_phase(x2, eo, P.in[I_NORM_FINAL], P.out, hn, 1);
}
__global__ void __launch_bounds__(NTHR, 2) mega_kernel(Params P) {
    extern __shared__ __attribute__((aligned(16))) char smem[];
    cg::grid_group grid = cg::this_grid();
    volatile LDS_AS unsigned* st = (volatile LDS_AS unsigned*)(smem + LDS_BYTES - 16);
    if (TIDX < 4) st[TIDX] = 0u;
    __syncthreads();
    const XcdBarrier xb = xcd_barrier_post((unsigned*)(P.ws + OFF_CTL), st);
    phase0(P, smem);
    grid.sync();
    layer_body<0>(P, smem, xb, P.in[I_X]);
    layer_body<1>(P, smem, xb, P.out);
}

extern "C" void kernel_launch(void* const* d_in, const int* in_sizes, int n_in, void* d_out, int out_size, void* d_ws, size_t ws_size, hipStream_t stream) {
    static int grid_blocks = 0;
    if (grid_blocks == 0) {
        if (n_in != N_INPUTS || ws_size < OFF_END || out_size != T * 1024) { fprintf(stderr, "kernel_launch: unexpected sizes n_in=%d ws=%zu out=%d (need ws >= %zu)\n", n_in, ws_size, out_size, (size_t)OFF_END); grid_blocks = -1; return; }
        int dev = 0, cus = 0, per_cu = 0;
        if (hipGetDevice(&dev) != hipSuccess || hipDeviceGetAttribute(&cus, hipDeviceAttributeMultiprocessorCount, dev) != hipSuccess) { fprintf(stderr, "kernel_launch: device query failed\n"); grid_blocks = -1; return; }
        if (hipFuncSetAttribute((const void*)mega_kernel, hipFuncAttributeMaxDynamicSharedMemorySize, LDS_BYTES) != hipSuccess) { fprintf(stderr, "kernel_launch: hipFuncSetAttribute failed\n"); grid_blocks = -1; return; }
        if (hipOccupancyMaxActiveBlocksPerMultiprocessor(&per_cu, (const void*)mega_kernel, NTHR, LDS_BYTES) != hipSuccess || per_cu < 1) { fprintf(stderr, "kernel_launch: occupancy query says %d blocks/CU\n", per_cu); grid_blocks = -1; return; }
        grid_blocks = cus;
        fprintf(stderr, "kernel_launch: cus=%d per_cu=%d grid=%d\n", cus, per_cu, grid_blocks);
    }
    if (grid_blocks < 0) return;
    if (hipMemsetAsync((char*)d_ws + OFF_CTL, 0, CTL_BYTES, stream) != hipSuccess) { fprintf(stderr, "kernel_launch: memset failed\n"); return; }
    Params p; memset(&p, 0, sizeof p);
    for (int i = 0; i < N_INPUTS; ++i) p.in[i] = (const float*)d_in[i];
    p.out = (float*)d_out; p.ws = (char*)d_ws;
    void* args[] = {&p};
    hipError_t e = hipLaunchCooperativeKernel((const void*)mega_kernel, dim3(grid_blocks), dim3(NTHR), args, LDS_BYTES, stream);
    if (e != hipSuccess) fprintf(stderr, "kernel_launch: cooperative launch failed: %s (grid %d)\n", hipGetErrorString(e), grid_blocks);
}
```

```cpp
#include <hip/hip_runtime.h>
#include <stdint.h>
#include <stdio.h>
#include <string.h>
#include <hip/hip_cooperative_groups.h>
namespace cg = cooperative_groups;

typedef unsigned short bf16_t;
typedef short bf16x8 __attribute__((ext_vector_type(8)));
typedef float f32x4 __attribute__((ext_vector_type(4)));
typedef unsigned u32x4 __attribute__((ext_vector_type(4)));

constexpr int NB = 8, SEQ = 2048, DM = 1024, T = NB * SEQ, NL = 2;
constexpr int NP = 3584;
constexpr int NIN = 3340;
constexpr int C_AQ = 0, C_AF = 256, C_AI = 512, C_AG = 768, C_BQ = 1024, C_BK = 1280, C_BV = 1536, C_CX = 1792, C_CG = 2048,
              C_DQ = 2304, C_DK = 2560, C_DV = 2816, C_DZ = 3072, C_GATE = 3328;
constexpr int MEMLEN = 256;
constexpr int NEXP = 32, DEXP = 256;
constexpr float EPS = 1e-6f;

constexpr size_t al256(size_t x) { return (x + 255) & ~(size_t)255; }
constexpr size_t SZ_WIN = (size_t)NP * 1024 * 2, SZ_WOUT = (size_t)1024 * 1024 * 2, SZ_WMQ = (size_t)256 * 1024 * 2, SZ_WMKV = (size_t)512 * 1024 * 2,
                 SZ_WMO = (size_t)1024 * 256 * 2, SZ_WGU = (size_t)32 * 512 * 1024 * 2, SZ_WDN = (size_t)32 * 1024 * 256 * 2;
constexpr size_t OFF_WIN = 0;
constexpr size_t OFF_WOUT = OFF_WIN + NL * SZ_WIN;
constexpr size_t OFF_WMQ = OFF_WOUT + NL * SZ_WOUT;
constexpr size_t OFF_WMKV = OFF_WMQ + NL * SZ_WMQ;
constexpr size_t OFF_WMO = OFF_WMKV + NL * SZ_WMKV;
constexpr size_t OFF_WGU = OFF_WMO + NL * SZ_WMO;
constexpr size_t OFF_WDN = OFF_WGU + NL * SZ_WGU;
constexpr size_t OFF_HN = OFF_WDN + NL * SZ_WDN;
constexpr size_t OFF_PROJ = OFF_HN + (size_t)T * 1024 * 2;
constexpr size_t OFF_GATES = OFF_PROJ + (size_t)T * NP * 2;
constexpr size_t OFF_Y = OFF_GATES + (size_t)T * 16 * 4;
constexpr size_t OFF_XB = OFF_Y + (size_t)T * 1024 * 2;
constexpr size_t OFF_QM = OFF_XB + (size_t)T * 1024 * 4;
constexpr size_t OFF_OM = OFF_QM + (size_t)T * 256 * 2;
constexpr size_t OFF_KVM = OFF_OM + (size_t)T * 256 * 2;
constexpr size_t OFF_MEMN = OFF_KVM + (size_t)NL * 2048 * 512 * 2;
constexpr size_t OFF_FOXC = OFF_MEMN + (size_t)2048 * 1024 * 2;
constexpr size_t OFF_LRUA = OFF_FOXC + (size_t)NB * 4 * SEQ * 4;
constexpr size_t OFF_LRUU = OFF_LRUA + (size_t)T * 256 * 4;
constexpr size_t OFF_CNT = OFF_LRUU + (size_t)T * 256 * 4;
constexpr size_t OFF_LIST = OFF_CNT + 256;
constexpr size_t OFF_PGATE = OFF_LIST + (size_t)NEXP * T * 4;
constexpr size_t OFF_HL = OFF_PGATE + (size_t)2 * T * 4;
constexpr size_t OFF_HD = OFF_HL + (size_t)1024 * 4096 * 4;
constexpr size_t OFF_GDN = OFF_HD + (size_t)1024 * 64 * 4;
constexpr size_t OFF_GLAST = OFF_GDN + (size_t)1024 * 5 * 4096 * 2;
constexpr size_t OFF_LSUM = OFF_GLAST + 4096;
constexpr size_t OFF_HS = OFF_LSUM + (size_t)2 * 256 * 256 * 4;
constexpr size_t OFF_LCAR = OFF_HS + (size_t)1024 * 4096 * 2;
constexpr size_t OFF_CTL = OFF_LCAR + (size_t)256 * 256 * 4;
constexpr size_t CTL_BYTES = 16384;
constexpr int CTL_CNT_WORD = 3584;
constexpr size_t OFF_END = OFF_CTL + CTL_BYTES;
constexpr size_t OFF_ACT = OFF_PROJ;
constexpr size_t OFF_EO = OFF_PROJ + (size_t)2 * T * 256 * 2;
static_assert(OFF_EO + (size_t)2 * T * 1024 * 2 <= OFF_GATES, "overlay fits");

__device__ __forceinline__ int tid_opaque() { int t = threadIdx.x; asm volatile("" : "+v"(t)); return t; }
#define TIDX tid_opaque()
__device__ __forceinline__ float bf2f(bf16_t v) { return __uint_as_float(((unsigned)v) << 16); }
typedef __bf16 bf16x2_t __attribute__((ext_vector_type(2)));
__device__ __forceinline__ bf16_t f2bf(float f) { return __builtin_bit_cast(unsigned short, (__bf16)f); }
__device__ __forceinline__ unsigned pk2(float lo, float hi) { bf16x2_t v = {(__bf16)lo, (__bf16)hi}; return __builtin_bit_cast(unsigned, v); }
__device__ __forceinline__ float sigmoidf_(float x) { return 1.f / (1.f + __expf(-x)); }
__device__ __forceinline__ float siluf_(float x) { return x / (1.f + __expf(-x)); }
__device__ __forceinline__ float softplusf_(float x) { return x > 20.f ? x : log1pf(__expf(x)); }
__device__ __forceinline__ float logsigmoidf_(float x) { return x < 0.f ? x - log1pf(__expf(x)) : -log1pf(__expf(-x)); }
__device__ __forceinline__ float geluf_(float x) { float u = 0.7978845608028654f * (x + 0.044715f * x * x * x); return 0.5f * x * (1.f + tanhf(u)); }
__device__ __forceinline__ float wave_sum(float v) {
#pragma unroll
    for (int o = 1; o < 64; o <<= 1) v += __shfl_xor(v, o);
    return v;
}
__device__ __forceinline__ float rdlane(float v, int l) { return __int_as_float(__builtin_amdgcn_readlane(__float_as_int(v), l)); }

#define PROBE_MASK 0
#define GSYNC() xcd_barrier(xb)
#define REP(bit, ...) do { __VA_ARGS__; if (PROBE_MASK & (bit)) { GSYNC(); __VA_ARGS__; } } while (0)
constexpr int NTHR = 512;
constexpr int LDS_BYTES = 147456;
enum { I_X = 0, I_MEM, I_NORM_MIX, I_W_IN, I_HGRN_LB, I_FOX_FB, I_LRU_CONV_W, I_LRU_CONV_B, I_LRU_WA, I_LRU_BA, I_LRU_WX, I_LRU_BX, I_LRU_LAM, I_GDN_CONV_W, I_GDN_A_LOG,
       I_GDN_DT_BIAS, I_MIX_GAIN, I_W_OUT, I_NORM_MEM, I_NORM_MEMKV, I_W_MQ, I_W_MKV, I_W_MO, I_NORM_FFN, I_W_RG, I_B_RG, I_W_RE, I_B_RE, I_W_E_GU, I_W_E_DN, I_NORM_FINAL, N_INPUTS };
struct Params { const float* in[N_INPUTS]; float* out; char* ws; };
static_assert(sizeof(Params) == 8 * (N_INPUTS + 2), "no padding");

#define BLK_LOOP(it, n) for (int it = (int)blockIdx.x; it < (n); it += (int)gridDim.x)

__device__ __forceinline__ int rowmap_fn(int mode, int n) {
    if (mode == 1) {
        if (n < 1792) return n;
        if (n < 1796) return C_GATE + (n - 1792);
        if (n < 3076) return n - 4;
        if (n < 3084) return C_GATE + 4 + (n - 3076);
        return n - 12;
    } else if (mode == 2) {
        int j = n & 255; return (j >> 4) * 32 + ((n >= 256) ? 16 : 0) + (j & 15);
    }
    return n;
}
__device__ __forceinline__ void convT_tile(float* tile  , const float* __restrict__ src, int K, int N, bf16_t* __restrict__ dst, int mode, int ntn, int idx) {
    const int n0 = (idx % ntn) * 64, k0 = (idx / ntn) * 64;
    const int tid = TIDX;
    __syncthreads();
#pragma unroll
    for (int i = 0; i < 2; ++i) {
        const int k = (tid >> 4) + 32 * i, n = n0 + (tid & 15) * 4;
        f32x4 v = (f32x4){0.f, 0.f, 0.f, 0.f};
        if (n + 3 < N) v = *(const f32x4*)(src + (size_t)(k0 + k) * N + n);
        else { for (int e = 0; e < 4; ++e) if (n + e < N) v[e] = src[(size_t)(k0 + k) * N + n + e]; }
#pragma unroll
        for (int e = 0; e < 4; ++e) tile[k * 65 + (tid & 15) * 4 + e] = v[e];
    }
    __syncthreads();
    const int nl = tid >> 3, k8 = (tid & 7) * 8, n = n0 + nl;
    if (n < N) {
        const int r = rowmap_fn(mode, n);
        u32x4 o;
#pragma unroll
        for (int j = 0; j < 4; ++j) o[j] = pk2(tile[(k8 + 2 * j) * 65 + nl], tile[(k8 + 2 * j + 1) * 65 + nl]);
        *(u32x4*)(dst + (size_t)r * K + k0 + k8) = o;
    }
}
__device__ __forceinline__ void rms_row_bf16(const float* __restrict__ xrow, const float* __restrict__ g, bf16_t* __restrict__ orow, int lane) {
    const f32x4* xr = (const f32x4*)xrow + lane;
    f32x4 v[4]; float s = 0.f;
#pragma unroll
    for (int j = 0; j < 4; ++j) { v[j] = xr[64 * j]; s += v[j].x * v[j].x + v[j].y * v[j].y + v[j].z * v[j].z + v[j].w * v[j].w; }
    const float rinv = rsqrtf(wave_sum(s) * (1.f / 1024.f) + EPS);
#pragma unroll
    for (int j = 0; j < 4; ++j) {
        const f32x4 gg = ((const f32x4*)g)[lane + 64 * j];
        uint2 o; o.x = pk2(v[j].x * rinv * gg.x, v[j].y * rinv * gg.y); o.y = pk2(v[j].z * rinv * gg.z, v[j].w * rinv * gg.w);
        *(uint2*)(orow + (lane + 64 * j) * 4) = o;
    }
}

constexpr int CT_PER_LAYER = 53 * 16 + 256 + 64 + 128 + 64;
constexpr int CT_GU = 64 * 128, CT_DN = 64 * 64;
constexpr int CT_TOTAL = NL * CT_PER_LAYER + CT_GU + CT_DN;

__device__ __forceinline__ void phase0(const Params& P, char* smem) {
    char* ws = P.ws;
    float* tile = (float*)smem;
    BLK_LOOP(it, CT_TOTAL) {
        int r = it;
        if (r < NL * CT_PER_LAYER) {
            const int l = r / CT_PER_LAYER; r -= l * CT_PER_LAYER;
            if (r < 848) { convT_tile(tile, P.in[I_W_IN] + (size_t)l * 1024 * NIN, 1024, NIN, (bf16_t*)(ws + OFF_WIN) + (size_t)l * NP * 1024, 1, 53, r); continue; } r -= 848;
            if (r < 256) { convT_tile(tile, P.in[I_W_OUT] + (size_t)l * 1024 * 1024, 1024, 1024, (bf16_t*)(ws + OFF_WOUT) + (size_t)l * 1024 * 1024, 0, 16, r); continue; } r -= 256;
            if (r < 64) { convT_tile(tile, P.in[I_W_MQ] + (size_t)l * 1024 * 256, 1024, 256, (bf16_t*)(ws + OFF_WMQ) + (size_t)l * 256 * 1024, 0, 4, r); continue; } r -= 64;
            if (r < 128) { convT_tile(tile, P.in[I_W_MKV] + (size_t)l * 1024 * 512, 1024, 512, (bf16_t*)(ws + OFF_WMKV) + (size_t)l * 512 * 1024, 0, 8, r); continue; } r -= 128;
            convT_tile(tile, P.in[I_W_MO] + (size_t)l * 256 * 1024, 256, 1024, (bf16_t*)(ws + OFF_WMO) + (size_t)l * 1024 * 256, 0, 16, r); continue;
        }
        r -= NL * CT_PER_LAYER;
        if (r < CT_GU) { const int m = r >> 7; convT_tile(tile, P.in[I_W_E_GU] + (size_t)m * 1024 * 512, 1024, 512, (bf16_t*)(ws + OFF_WGU) + (size_t)m * 512 * 1024, 2, 8, r & 127); continue; }
        r -= CT_GU;
        { const int m = r >> 6; convT_tile(tile, P.in[I_W_E_DN] + (size_t)m * 256 * 1024, 256, 1024, (bf16_t*)(ws + OFF_WDN) + (size_t)m * 1024 * 256, 0, 16, r & 63); }
    }
    for (int i = blockIdx.x * NTHR + TIDX; i < NL * (NP - NIN) * 512; i += gridDim.x * NTHR) {
        const int l = i / ((NP - NIN) * 512), w = i % ((NP - NIN) * 512);
        ((unsigned*)((bf16_t*)(ws + OFF_WIN) + (size_t)l * NP * 1024 + (size_t)NIN * 1024))[w] = 0u;
    }
    const int gw = blockIdx.x * 8 + (TIDX >> 6), ngw = gridDim.x * 8, lane = TIDX & 63;
    for (int row = gw; row < T + NL * 2048; row += ngw) {
        if (row < T) rms_row_bf16(P.in[I_X] + (size_t)row * 1024, P.in[I_NORM_MIX], (bf16_t*)(ws + OFF_HN) + (size_t)row * 1024, lane);
        else { const int r2 = row - T, l = r2 >> 11, rr = r2 & 2047;
               rms_row_bf16(P.in[I_MEM] + (size_t)rr * 1024, P.in[I_NORM_MEMKV] + l * 1024, (bf16_t*)(ws + OFF_MEMN) + (size_t)r2 * 1024, lane); }
    }
}

constexpr int GLD = 72;
constexpr int GEMM_LDS = (256 + 128) * GLD * 2;
template <class RowPtr>
__device__ __forceinline__ void gemm_tile(char* smem, RowPtr rowptr, const bf16_t* __restrict__ Bt, int ldb, int n0, int K, f32x4 (&acc)[4][4]) {
    bf16_t* sA = (bf16_t*)smem; bf16_t* sB = sA + 256 * GLD;
    const int tid = TIDX, lane = tid & 63, wave = tid >> 6, wm = wave >> 1, wn = wave & 1;
    const u32x4* ga[4]; const u32x4* gb[2];
#pragma unroll
    for (int i = 0; i < 4; ++i) { const int c = tid + i * 512, r = c >> 3, ch = c & 7; ga[i] = (const u32x4*)(rowptr(r) + ch * 8); }
#pragma unroll
    for (int i = 0; i < 2; ++i) { const int c = tid + i * 512, r = c >> 3, ch = c & 7; gb[i] = (const u32x4*)(Bt + (size_t)(n0 + r) * ldb + ch * 8); }
#pragma unroll
    for (int m = 0; m < 4; ++m)
#pragma unroll
        for (int n = 0; n < 4; ++n) acc[m][n] = (f32x4){0.f, 0.f, 0.f, 0.f};
    u32x4 ra[4], rb[2];
#pragma unroll
    for (int i = 0; i < 4; ++i) ra[i] = ga[i][0];
#pragma unroll
    for (int i = 0; i < 2; ++i) rb[i] = gb[i][0];
    const int nk = K / 64;
    for (int kt = 0; kt < nk; ++kt) {
        __syncthreads();
#pragma unroll
        for (int i = 0; i < 4; ++i) { const int c = tid + i * 512, r = c >> 3, ch = c & 7; *(u32x4*)(sA + r * GLD + ch * 8) = ra[i]; }
#pragma unroll
        for (int i = 0; i < 2; ++i) { const int c = tid + i * 512, r = c >> 3, ch = c & 7; *(u32x4*)(sB + r * GLD + ch * 8) = rb[i]; }
        __syncthreads();
        if (kt + 1 < nk) {
#pragma unroll
            for (int i = 0; i < 4; ++i) ra[i] = ga[i][(kt + 1) * 8];
#pragma unroll
            for (int i = 0; i < 2; ++i) rb[i] = gb[i][(kt + 1) * 8];
        }
#pragma unroll
        for (int kk = 0; kk < 2; ++kk) {
            bf16x8 af[4], bfr[4];
#pragma unroll
            for (int m = 0; m < 4; ++m) af[m] = *(const bf16x8*)(sA + (wm * 64 + m * 16 + (lane & 15)) * GLD + kk * 32 + (lane >> 4) * 8);
#pragma unroll
            for (int n = 0; n < 4; ++n) bfr[n] = *(const bf16x8*)(sB + (wn * 64 + n * 16 + (lane & 15)) * GLD + kk * 32 + (lane >> 4) * 8);
#pragma unroll
            for (int m = 0; m < 4; ++m)
#pragma unroll
                for (int n = 0; n < 4; ++n) acc[m][n] = __builtin_amdgcn_mfma_f32_16x16x32_bf16(bfr[n], af[m], acc[m][n], 0, 0, 0);
        }
    }
}
struct RowDirect { const bf16_t* A; int lda; int m0; __device__ __forceinline__ const bf16_t* operator()(int r) const { return A + (size_t)(m0 + r) * lda; } };
enum { EPI_INPROJ = 0, EPI_RESID = 1, EPI_BF16 = 2 };

__device__ __forceinline__ int vcu_id() { const int G = gridDim.x, bx = blockIdx.x; return (G % 8 == 0) ? (bx % 8) * (G / 8) + bx / 8 : bx; }

template <int EPI>
__device__ __forceinline__ void gemm_phase(char* smem, const bf16_t* A, int lda, const bf16_t* Bt, int ldb, int M, int N, int K, void* out, int ldo, const float* resid, float* gates, int idx0 = -1, int stride = 0) {
    const int ntn = N / 128, ntiles = (M / 256) * ntn;
    if (stride == 0) { idx0 = vcu_id(); stride = gridDim.x; }
    if (idx0 < 0) return;
    const int lane = TIDX & 63, wave = TIDX >> 6, wm = wave >> 1, wn = wave & 1;
    for (int tIdx = idx0; tIdx < ntiles; tIdx += stride) {
        const int m0 = (tIdx / ntn) * 256, n0 = (tIdx % ntn) * 128;
        f32x4 acc[4][4];
        RowDirect rp{A, lda, m0};
        gemm_tile(smem, rp, Bt, ldb, n0, K, acc);
#pragma unroll
        for (int m = 0; m < 4; ++m)
#pragma unroll
            for (int n = 0; n < 4; ++n) {
                const int row = m0 + wm * 64 + m * 16 + (lane & 15), col = n0 + wn * 64 + n * 16 + (lane >> 4) * 4;
                const f32x4 v = acc[m][n];
                if (EPI == EPI_INPROJ) {
                    uint2 o; o.x = pk2(v.x, v.y); o.y = pk2(v.z, v.w);
                    *(uint2*)((bf16_t*)out + (size_t)row * ldo + col) = o;
                    if (col >= C_GATE && col < C_GATE + 16) *(f32x4*)(gates + (size_t)row * 16 + (col - C_GATE)) = v;
                } else if (EPI == EPI_RESID) {
                    const f32x4 r = *(const f32x4*)(resid + (size_t)row * ldo + col);
                    *(f32x4*)((float*)out + (size_t)row * ldo + col) = r + v;
                } else {
                    uint2 o; o.x = pk2(v.x, v.y); o.y = pk2(v.z, v.w);
                    *(uint2*)((bf16_t*)out + (size_t)row * ldo + col) = o;
                }
            }
    }
}


namespace pg8 {
#define PG8_LAS __attribute__((address_space(3)))
typedef unsigned short bf16_t;
typedef short bf16x8 __attribute__((ext_vector_type(8)));
typedef float f32x4 __attribute__((ext_vector_type(4)));
typedef unsigned u32x4 __attribute__((ext_vector_type(4)));
constexpr int BM = 256, BK = 64, HALF = 128, HTB = HALF * BK * 2  , STAGE_BYTES = 8 * HTB, NXCD = 8, WGM = 8;

__host__ __device__ __forceinline__ int lds_byte(int r, int c) { const int st = (r >> 4) * 2 + (c >> 5), rr = r & 15, cc = c & 31, ob = rr * 64 + cc * 2; return st * 1024 + (ob ^ (((ob >> 9) & 1) << 5)); }
__host__ __device__ __forceinline__ void stage_rc(int b, int& R, int& C) { const int st = b / 1024, sb = b % 1024, swz = sb ^ (((sb >> 9) & 1) << 5); R = (st >> 1) * 16 + swz / 64; C = (st & 1) * 32 + (swz % 64) / 2; }
__host__ __device__ __forceinline__ int perm32(int rho) { const int n = rho >> 4, i = rho & 15; return 8 * (i >> 2) + 4 * n + (i & 3); }

struct Unit { int pm, pn; };
struct Gemm { const bf16_t* A; const bf16_t* Bt; int M, N, K; };

struct StaticOrder {
    int nM, nN, nwg, G, c;
    __host__ __device__ void init(int M, int N, int G_, int c_) { nM = M / BM; nN = N / BM; nwg = nM * nN; G = G_; c = c_; }
    __host__ __device__ bool next(int i, Unit& u) const {
        const long L = (long)i * G + c; if (L >= nwg) return false;
        int wgid = (int)L; { const int q = nwg / NXCD, r = nwg % NXCD, xcd = wgid % NXCD, off = wgid / NXCD; wgid = (xcd < r ? xcd * (q + 1) : r * (q + 1) + (xcd - r) * q) + off; }
        const int nig = WGM * nN, gid = wgid / nig, fm = gid * WGM, gsz = (nM - fm) < WGM ? (nM - fm) : WGM;
        u.pm = fm + ((wgid % nig) % gsz); u.pn = (wgid % nig) / gsz; return true;
    }
    __device__ __forceinline__ void a_ready(const Unit&) const {}
    __device__ __forceinline__ void done(const Unit&) const {}
};
__device__ __forceinline__ unsigned cvt_pk_bf16(float lo, float hi) { unsigned r; asm volatile("v_cvt_pk_bf16_f32 %0, %1, %2" : "=v"(r) : "v"(lo), "v"(hi)); return r; }
typedef float f32x2 __attribute__((ext_vector_type(2)));

struct EpiInProj {
    static constexpr bool PERM = true, AFTER_DRAIN = false;
    bf16_t* O; int ldc; float* gates; int gate_col;
    __device__ __forceinline__ void operator()(const f32x4 (&acc)[2][2][4][2], const Unit& u, int wr, int wc, int fr, int fq) const {
        const int row0 = u.pm * BM + wr * 64 + fr, col0 = u.pn * BM + wc * 32 + 8 * fq;
#pragma unroll
        for (int ai = 0; ai < 2; ++ai)
#pragma unroll
            for (int m = 0; m < 4; ++m) {
                const int row = row0 + ai * HALF + m * 16;
                bf16_t* rowp = O + (size_t)row * ldc + col0;
#pragma unroll
                for (int bj = 0; bj < 2; ++bj) {
                    const f32x4 v0 = acc[ai][bj][m][0], v1 = acc[ai][bj][m][1];
                    u32x4 w; w.x = cvt_pk_bf16(v0[0], v0[1]); w.y = cvt_pk_bf16(v0[2], v0[3]); w.z = cvt_pk_bf16(v1[0], v1[1]); w.w = cvt_pk_bf16(v1[2], v1[3]);
                    *(u32x4*)(rowp + bj * HALF) = w;
                    const int gc = col0 + bj * HALF - gate_col;
                    if (gates && gc >= 0 && gc < 16) { *(f32x4*)(gates + (size_t)row * 16 + gc) = v0; *(f32x4*)(gates + (size_t)row * 16 + gc + 4) = v1; }
                }
            }
    }
};
struct EpiResid {
    static constexpr bool PERM = false, AFTER_DRAIN = false;
    const float* base; float* out; int ldc;
    __device__ __forceinline__ void operator()(const f32x4 (&acc)[2][2][4][2], const Unit& u, int wr, int wc, int fr, int fq) const {
        const int col0 = u.pn * BM + wc * 32 + 4 * fq;
#pragma unroll
        for (int ai = 0; ai < 2; ++ai)
#pragma unroll
            for (int m = 0; m < 4; ++m) {
                const size_t off = (size_t)(u.pm * BM + ai * HALF + wr * 64 + m * 16 + fr) * ldc + col0;
#pragma unroll
                for (int bj = 0; bj < 2; ++bj)
#pragma unroll
                    for (int n = 0; n < 2; ++n) { const f32x4 bs = *(const f32x4*)(base + off + bj * HALF + n * 16); *(f32x4*)(out + off + bj * HALF + n * 16) = bs + acc[ai][bj][m][n]; }
                if (m & 1) asm volatile("" ::: "memory");
            }
    }
};

template <class Epi, class Sched, bool ALIGN_EPI = false, bool SP2 = false>
__device__ __forceinline__ void gemm_phase(PG8_LAS unsigned char* lds, const Gemm g, const Sched& S, const Epi& E) {
    const int tid = TIDX, wid = __builtin_amdgcn_readfirstlane(tid >> 6), lane = tid & 63, wr = wid >> 2, wc = wid & 3, fr = lane & 15, fq = lane >> 4;
    const int K = g.K, nt = K / BK;
    unsigned voffA[2], voffB[2];
#pragma unroll
    for (int i = 0; i < 2; ++i) { int R, C; stage_rc(tid * 16 + i * 8192, R, C); const int Rb = Epi::PERM ? ((R & ~31) + perm32(R & 31)) : R;
        voffA[i] = (unsigned)(R * K + C) * 2u; voffB[i] = (unsigned)(Rb * K + C) * 2u; }
    const size_t kstep = (size_t)(BK * 2);
    const size_t hstep = (size_t)HALF * K * 2;
    const size_t tstep = 2 * hstep;
    const unsigned ldsw = (unsigned)wid * 1024u;
    const int aoff = lds_byte(wr * 64 + fr, fq * 8), boff = lds_byte(wc * 32 + fr, fq * 8);
#define PG8_SA(b, h) (((b) * 2 + (h)) * HTB)
#define PG8_SB(b, h) ((4 + (b) * 2 + (h)) * HTB)
#define PG8_STAGE(bufoff, gbase, voff) do { _Pragma("unroll") for (int _i = 0; _i < 2; ++_i) \
        __builtin_amdgcn_global_load_lds((const unsigned*)((const char*)(gbase) + (voff)[_i]), (PG8_LAS unsigned*)(lds + (bufoff) + ldsw + _i * 8192), 16, 0, 0); } while (0)
#define PG8_LDA(dst, b, h) do { _Pragma("unroll") for (int m = 0; m < 4; ++m) _Pragma("unroll") for (int k = 0; k < 2; ++k) dst[m][k] = *(const PG8_LAS bf16x8*)(lds + PG8_SA(b, h) + aoff + m * 2048 + k * 1024); } while (0)
#define PG8_LDB(dst, b, h) do { _Pragma("unroll") for (int n = 0; n < 2; ++n) _Pragma("unroll") for (int k = 0; k < 2; ++k) dst[n][k] = *(const PG8_LAS bf16x8*)(lds + PG8_SB(b, h) + boff + n * 2048 + k * 1024); } while (0)
#define PG8_MMA(ai, bj, At, Bt) do { __builtin_amdgcn_s_setprio(1); _Pragma("unroll") for (int m = 0; m < 4; ++m) _Pragma("unroll") for (int n = 0; n < 2; ++n) _Pragma("unroll") for (int k = 0; k < 2; ++k) \
        acc[ai][bj][m][n] = __builtin_amdgcn_mfma_f32_16x16x32_bf16(Bt[n][k], At[m][k], acc[ai][bj][m][n], 0, 0, 0); __builtin_amdgcn_s_setprio(0); } while (0)
#define PG8_WAIT_V(n) asm volatile("s_waitcnt vmcnt(" #n ")" ::: "memory")
#define PG8_WAIT_L(n) asm volatile("s_waitcnt lgkmcnt(" #n ")" ::: "memory")
#define PG8_BAR __builtin_amdgcn_s_barrier()
#define PG8_SCHED __builtin_amdgcn_sched_barrier(0)
    Unit cur, nxt; int ui = 0;
    if (!S.next(0, cur)) return;
    f32x4 acc[2][2][4][2];
#pragma unroll
    for (int a = 0; a < 2; ++a)
#pragma unroll
        for (int b = 0; b < 2; ++b)
#pragma unroll
            for (int m = 0; m < 4; ++m)
#pragma unroll
                for (int n = 0; n < 2; ++n) acc[a][b][m][n] = (f32x4){0.f, 0.f, 0.f, 0.f};
    bf16x8 At[4][2], B0[2][2], B1[2][2];
    const char* cA = (const char*)g.A + (size_t)cur.pm * tstep; const char* cB = (const char*)g.Bt + (size_t)cur.pn * tstep;
    S.a_ready(cur);
    if constexpr (SP2) {
        PG8_STAGE(PG8_SB(0, 0), cB, voffB); PG8_STAGE(PG8_SB(0, 1), cB + hstep, voffB); PG8_STAGE(PG8_SA(0, 0), cA, voffA); PG8_STAGE(PG8_SA(0, 1), cA + hstep, voffA);
        if (wr == 1) PG8_BAR;
        PG8_WAIT_V(2); PG8_BAR;
        PG8_STAGE(PG8_SB(1, 0), cB + kstep, voffB); PG8_STAGE(PG8_SA(1, 0), cA + kstep, voffA); PG8_STAGE(PG8_SB(1, 1), cB + hstep + kstep, voffB);
        PG8_WAIT_V(6); PG8_BAR;
    } else {
        PG8_STAGE(PG8_SB(0, 0), cB, voffB); PG8_STAGE(PG8_SA(0, 0), cA, voffA); PG8_STAGE(PG8_SB(0, 1), cB + hstep, voffB); PG8_STAGE(PG8_SA(0, 1), cA + hstep, voffA);
        if (wr == 1) PG8_BAR;
        PG8_WAIT_V(4); PG8_BAR;
        PG8_STAGE(PG8_SB(1, 0), cB + kstep, voffB); PG8_STAGE(PG8_SA(1, 0), cA + kstep, voffA); PG8_STAGE(PG8_SB(1, 1), cB + hstep + kstep, voffB);
        PG8_WAIT_V(6); PG8_BAR;
    }
    for (;;) {
        const bool has_next = S.next(ui + 1, nxt);
        const char* nA = has_next ? (const char*)g.A + (size_t)nxt.pm * tstep : cA; const char* nB = has_next ? (const char*)g.Bt + (size_t)nxt.pn * tstep : cB;
        for (int t = 0; t < nt; t += 2) {
            const bool last = (t == nt - 2);
            const char* a1 = cA + (size_t)(t + 1) * kstep;
            const char* a2 = last ? nA : cA + (size_t)(t + 2) * kstep; const char* b2 = last ? nB : cB + (size_t)(t + 2) * kstep;
            const char* a3 = a2 + kstep; const char* b3 = b2 + kstep;
            if (last && has_next) S.a_ready(nxt);
            if constexpr (SP2) {
            PG8_LDB(B0, 0, 0); PG8_LDB(B1, 0, 1); PG8_SCHED; PG8_LDA(At, 0, 0); PG8_STAGE(PG8_SA(1, 1), a1 + hstep, voffA);
            PG8_WAIT_V(8); PG8_WAIT_L(0); PG8_BAR; PG8_MMA(0, 0, At, B0); PG8_MMA(0, 1, At, B1); PG8_BAR; PG8_SCHED;
            PG8_LDA(At, 0, 1); PG8_STAGE(PG8_SB(0, 0), b2, voffB); PG8_STAGE(PG8_SB(0, 1), b2 + hstep, voffB); PG8_STAGE(PG8_SA(0, 0), a2, voffA);
            PG8_WAIT_V(8); PG8_WAIT_L(0); PG8_BAR; PG8_MMA(1, 0, At, B0); PG8_MMA(1, 1, At, B1); PG8_BAR; PG8_SCHED;
            PG8_LDB(B0, 1, 0); PG8_LDB(B1, 1, 1); PG8_SCHED; PG8_LDA(At, 1, 0); PG8_STAGE(PG8_SA(0, 1), a2 + hstep, voffA);
            PG8_WAIT_V(8); PG8_WAIT_L(0); PG8_BAR; PG8_MMA(0, 0, At, B0); PG8_MMA(0, 1, At, B1); PG8_BAR; PG8_SCHED;
            PG8_LDA(At, 1, 1); PG8_STAGE(PG8_SB(1, 0), b3, voffB); PG8_STAGE(PG8_SB(1, 1), b3 + hstep, voffB); PG8_STAGE(PG8_SA(1, 0), a3, voffA);
            PG8_WAIT_V(8); PG8_WAIT_L(0); PG8_BAR; PG8_MMA(1, 0, At, B0); PG8_MMA(1, 1, At, B1); PG8_BAR; PG8_SCHED;
            } else {
            PG8_LDB(B0, 0, 0); PG8_SCHED; PG8_LDA(At, 0, 0); PG8_STAGE(PG8_SA(1, 1), a1 + hstep, voffA);
            PG8_WAIT_L(8); PG8_BAR; PG8_WAIT_L(0); PG8_MMA(0, 0, At, B0); PG8_BAR; PG8_SCHED;
            PG8_LDB(B1, 0, 1); PG8_STAGE(PG8_SB(0, 0), b2, voffB);
            PG8_BAR; PG8_WAIT_L(0); PG8_MMA(0, 1, At, B1); PG8_BAR;
            PG8_LDA(At, 0, 1); PG8_STAGE(PG8_SA(0, 0), a2, voffA);
            PG8_BAR; PG8_WAIT_L(0); PG8_MMA(1, 0, At, B0); PG8_BAR; PG8_SCHED;
            PG8_STAGE(PG8_SB(0, 1), b2 + hstep, voffB);
            PG8_WAIT_V(6); PG8_BAR; PG8_MMA(1, 1, At, B1); PG8_BAR;
            PG8_LDB(B0, 1, 0); PG8_SCHED; PG8_LDA(At, 1, 0); PG8_STAGE(PG8_SA(0, 1), a2 + hstep, voffA);
            PG8_WAIT_L(8); PG8_BAR; PG8_WAIT_L(0); PG8_MMA(0, 0, At, B0); PG8_BAR; PG8_SCHED;
            PG8_LDB(B1, 1, 1); PG8_STAGE(PG8_SB(1, 0), b3, voffB);
            PG8_BAR; PG8_WAIT_L(0); PG8_MMA(0, 1, At, B1); PG8_BAR;
            PG8_LDA(At, 1, 1); PG8_STAGE(PG8_SA(1, 0), a3, voffA);
            PG8_BAR; PG8_WAIT_L(0); PG8_MMA(1, 0, At, B0); PG8_BAR; PG8_SCHED;
            PG8_STAGE(PG8_SB(1, 1), b3 + hstep, voffB);
            PG8_WAIT_V(6); PG8_BAR; PG8_MMA(1, 1, At, B1); PG8_BAR;
            }
        }
        if constexpr (ALIGN_EPI) { if (wr == 0) PG8_BAR; }
        if constexpr (!Epi::AFTER_DRAIN) { E(acc, cur, wr, wc, fr, fq); S.done(cur); }
        if (!has_next) break;
#pragma unroll
        for (int a = 0; a < 2; ++a)
#pragma unroll
            for (int b = 0; b < 2; ++b)
#pragma unroll
                for (int m = 0; m < 4; ++m)
#pragma unroll
                    for (int n = 0; n < 2; ++n) acc[a][b][m][n] = (f32x4){0.f, 0.f, 0.f, 0.f};
        cur = nxt; cA = nA; cB = nB; ++ui;
        if constexpr (ALIGN_EPI) { if (wr == 1) PG8_BAR; }
    }
    PG8_WAIT_V(0);
    if constexpr (!ALIGN_EPI) { if (wr == 0) PG8_BAR; }
    PG8_BAR;
    if constexpr (Epi::AFTER_DRAIN) { E.fused(acc, cur, wr, wc, fr, fq, lds, wid, lane); S.done(cur); }
#undef PG8_SA
#undef PG8_SB
#undef PG8_STAGE
#undef PG8_LDA
#undef PG8_LDB
#undef PG8_MMA
#undef PG8_WAIT_V
#undef PG8_WAIT_L
#undef PG8_BAR
#undef PG8_SCHED
}
}

struct RowGather { const bf16_t* A; int lda; const int* ids; int shift; __device__ __forceinline__ const bf16_t* operator()(int r) const { return A + (size_t)(ids[r] >> shift) * lda; } };
template <int STAGE>
__device__ __forceinline__ void moe_phase(char* smem, const bf16_t* A, int lda, const bf16_t* Wt, size_t wstride, int ldb, int K, const int* cnt, const int* list, const float* pgate, bf16_t* out) {
    int* ids = (int*)(smem + GEMM_LDS);
    int* tpre = ids + 256;
    constexpr int NTN = (STAGE == 1) ? 4 : 8;
    __syncthreads();
    if (TIDX == 0) { int a = 0; for (int i = 0; i < NEXP; ++i) { tpre[i] = a; a += (cnt[i] + 255) >> 8; } tpre[NEXP] = a; }
    __syncthreads();
    const int ntiles = tpre[NEXP] * NTN;
    const int lane = TIDX & 63, wave = TIDX >> 6, wm = wave >> 1, wn = wave & 1;
    for (int tIdx = vcu_id(); tIdx < ntiles; tIdx += gridDim.x) {
        const int mtg = tIdx / NTN, n0 = (tIdx % NTN) * 128;
        int e = 0;
        for (int i = 1; i < NEXP; ++i) if (tpre[i] <= mtg) e = i;
        const int mt = mtg - tpre[e];
        const int cn = cnt[e];
        __syncthreads();
        if (TIDX < 256) { const int pos = mt * 256 + TIDX; ids[TIDX] = list[(size_t)e * T + (pos < cn ? pos : cn - 1)]; }
        __syncthreads();
        f32x4 acc[4][4];
        RowGather rp{A, lda, ids, STAGE == 1 ? 1 : 0};
        gemm_tile(smem, rp, Wt + (size_t)e * wstride, ldb, n0, K, acc);
#pragma unroll
        for (int m = 0; m < 4; ++m) {
            const int rl = wm * 64 + m * 16 + (lane & 15);
            if (mt * 256 + rl >= cn) continue;
            const int pid = ids[rl];
            if (STAGE == 1) {
                const float gt = pgate[pid];
#pragma unroll
                for (int np = 0; np < 2; ++np) {
                    const f32x4 g = acc[m][2 * np], u = acc[m][2 * np + 1];
                    const int j = (n0 + wn * 64 + np * 32) / 2 + (lane >> 4) * 4;
                    uint2 o; o.x = pk2(siluf_(g.x) * u.x * gt, siluf_(g.y) * u.y * gt); o.y = pk2(siluf_(g.z) * u.z * gt, siluf_(g.w) * u.w * gt);
                    *(uint2*)(out + (size_t)pid * DEXP + j) = o;
                }
            } else {
#pragma unroll
                for (int n = 0; n < 4; ++n) {
                    const f32x4 v = acc[m][n]; const int col = n0 + wn * 64 + n * 16 + (lane >> 4) * 4;
                    uint2 o; o.x = pk2(v.x, v.y); o.y = pk2(v.z, v.w);
                    *(uint2*)(out + (size_t)pid * 1024 + col) = o;
                }
            }
        }
    }
}

__device__ __forceinline__ void hgrn2_naive(const bf16_t* __restrict__ proj, const float* __restrict__ hgrn_lb, int layer, const float* __restrict__ mix_gain, bf16_t* __restrict__ y, int bh, int lane) {
    const int b = bh >> 2, h = bh & 3;
    float lbk = 0.f;
    if (layer == 1) { float a0 = hgrn_lb[h * 64 + lane], a1 = hgrn_lb[256 + h * 64 + lane]; lbk = 1.f / (1.f + __expf(a0 - a1)); }
    const float mg = mix_gain[C_AQ + h * 64 + lane];
    float S[64];
#pragma unroll
    for (int k = 0; k < 64; ++k) S[k] = 0.f;
    for (int t = 0; t < SEQ; ++t) {
        const bf16_t* pr = proj + (size_t)(b * SEQ + t) * NP + h * 64 + lane;
        const float qk = siluf_(bf2f(pr[C_AQ]));
        const float sg = sigmoidf_(bf2f(pr[C_AF]));
        const float f = lbk + (1.f - lbk) * sg, kk = (1.f - lbk) * (1.f - sg);
        const float iv = bf2f(pr[C_AI]);
        const float gv = bf2f(pr[C_AG]);
        float o = 0.f;
#pragma unroll
        for (int k = 0; k < 64; ++k) { S[k] = rdlane(f, k) * S[k] + rdlane(kk, k) * iv; o += rdlane(qk, k) * S[k]; }
        const float ms = wave_sum(o * o) * (1.f / 64.f);
        const float yv = o * rsqrtf(ms + EPS) * siluf_(gv) * mg;
        y[(size_t)(b * SEQ + t) * 1024 + 0 + h * 64 + lane] = f2bf(yv);
    }
}
__device__ __forceinline__ void gdn_naive(const bf16_t* __restrict__ proj, const float* __restrict__ gates, const float* __restrict__ conv_w  ,
                                          const float* __restrict__ a_log, const float* __restrict__ dt_bias, const float* __restrict__ mix_gain, bf16_t* __restrict__ y, int bh, int lane) {
    const int b = bh >> 2, h = bh & 3;
    float wq[4], wk[4], wv[4];
#pragma unroll
    for (int j = 0; j < 4; ++j) { wq[j] = conv_w[j * 768 + h * 64 + lane]; wk[j] = conv_w[j * 768 + 256 + h * 64 + lane]; wv[j] = conv_w[j * 768 + 512 + h * 64 + lane]; }
    float xq[3] = {0.f, 0.f, 0.f}, xk[3] = {0.f, 0.f, 0.f}, xv[3] = {0.f, 0.f, 0.f};
    const float Aexp = __expf(a_log[h]), dtb = dt_bias[h];
    const float mg = mix_gain[768 + h * 64 + lane];
    float S[64];
#pragma unroll
    for (int k = 0; k < 64; ++k) S[k] = 0.f;
    for (int t = 0; t < SEQ; ++t) {
        const size_t row = (size_t)(b * SEQ + t);
        const bf16_t* pr = proj + row * NP + h * 64 + lane;
        const float q0 = bf2f(pr[C_DQ]), k0 = bf2f(pr[C_DK]), v0 = bf2f(pr[C_DV]), zv = bf2f(pr[C_DZ]);
        float q = siluf_(wq[0] * xq[0] + wq[1] * xq[1] + wq[2] * xq[2] + wq[3] * q0);
        float k = siluf_(wk[0] * xk[0] + wk[1] * xk[1] + wk[2] * xk[2] + wk[3] * k0);
        float v = siluf_(wv[0] * xv[0] + wv[1] * xv[1] + wv[2] * xv[2] + wv[3] * v0);
        xq[0] = xq[1]; xq[1] = xq[2]; xq[2] = q0; xk[0] = xk[1]; xk[1] = xk[2]; xk[2] = k0; xv[0] = xv[1]; xv[1] = xv[2]; xv[2] = v0;
        q = q * rsqrtf(wave_sum(q * q) + EPS) * 0.125f;
        k = k * rsqrtf(wave_sum(k * k) + EPS);
        const float beta = sigmoidf_(gates[row * 16 + 4 + h]);
        const float g = -Aexp * softplusf_(gates[row * 16 + 8 + h] + dtb);
        const float eg = __expf(g);
        float r = 0.f;
#pragma unroll
        for (int i = 0; i < 64; ++i) { S[i] *= eg; r += rdlane(k, i) * S[i]; }
        const float dlt = beta * (v - r);
        float o = 0.f;
#pragma unroll
        for (int i = 0; i < 64; ++i) { S[i] += rdlane(k, i) * dlt; o += rdlane(q, i) * S[i]; }
        const float ms = wave_sum(o * o) * (1.f / 64.f);
        const float yv = o * rsqrtf(ms + EPS) * siluf_(zv) * mg;
        y[row * 1024 + 768 + h * 64 + lane] = f2bf(yv);
    }
}
__device__ __forceinline__ void fox_cumsum(const float* __restrict__ gates, const float* __restrict__ fb, float* __restrict__ cc, int bh, int lane) {
    const int b = bh >> 2, h = bh & 3;
    const float bias = fb[h];
    float carry = 0.f;
    for (int t0 = 0; t0 < SEQ; t0 += 64) {
        float v = logsigmoidf_(gates[(size_t)(b * SEQ + t0 + lane) * 16 + h] + bias);
#pragma unroll
        for (int o = 1; o < 64; o <<= 1) { float n = __shfl_up(v, o); if (lane >= o) v += n; }
        v += carry;
        cc[(size_t)(b * 4 + h) * SEQ + t0 + lane] = v;
        carry = __shfl(v, 63);
    }
}
__device__ __forceinline__ void lru_prep_task(float* xc  , const bf16_t* __restrict__ proj, const float* __restrict__ conv_w, const float* __restrict__ conv_b,
                                              const float* __restrict__ w_a, const float* __restrict__ b_a, const float* __restrict__ w_x, const float* __restrict__ b_x,
                                              const float* __restrict__ lam, float* __restrict__ a_out, float* __restrict__ u_out, int task, bool active) {
    const int c = TIDX & 255, t0 = task * 16;
    if (active) {
        const float w0 = conv_w[c], w1 = conv_w[256 + c], w2 = conv_w[512 + c], w3 = conv_w[768 + c], cb = conv_b[c];
        for (int i = 0; i < 16; ++i) {
            const int t = t0 + i, s = t & (SEQ - 1);
            const bf16_t* pr = proj + (size_t)t * NP + C_CX + c;
            float acc = cb + w3 * bf2f(pr[0]);
            if (s >= 1) acc += w2 * bf2f(pr[-(ptrdiff_t)NP]);
            if (s >= 2) acc += w1 * bf2f(pr[-(ptrdiff_t)2 * NP]);
            if (s >= 3) acc += w0 * bf2f(pr[-(ptrdiff_t)3 * NP]);
            xc[i * 256 + c] = acc;
        }
    }
    __syncthreads();
    if (active) {
        const int h = c >> 6, jj = c & 63;
        float ra[16], rx[16];
#pragma unroll
        for (int i = 0; i < 16; ++i) { ra[i] = 0.f; rx[i] = 0.f; }
        for (int k = 0; k < 64; ++k) {
            const float wa = w_a[(h * 64 + k) * 64 + jj], wx = w_x[(h * 64 + k) * 64 + jj];
#pragma unroll
            for (int i = 0; i < 16; ++i) { const float xv = xc[i * 256 + h * 64 + k]; ra[i] += xv * wa; rx[i] += xv * wx; }
        }
        const float ba = b_a[c], bx = b_x[c], sp = softplusf_(-lam[c]);
#pragma unroll
        for (int i = 0; i < 16; ++i) {
            const float r = sigmoidf_(ra[i] + ba), ig = sigmoidf_(rx[i] + bx);
            const float log_a = -8.f * r * sp;
            const float a = __expf(log_a);
            const float u = sqrtf(-expm1f(2.f * log_a)) * (ig * xc[i * 256 + c]);
            a_out[(size_t)(t0 + i) * 256 + c] = a; u_out[(size_t)(t0 + i) * 256 + c] = u;
        }
    }
    __syncthreads();
}
__device__ __forceinline__ void lru_scan_task(const float* __restrict__ a_in, const float* __restrict__ u_in, const bf16_t* __restrict__ proj, const float* __restrict__ mix_gain, bf16_t* __restrict__ y, int b) {
    const int c = TIDX;
    const float mg = mix_gain[512 + c];
    float hst = 0.f;
    for (int t = 0; t < SEQ; ++t) {
        const size_t row = (size_t)(b * SEQ + t);
        hst = a_in[row * 256 + c] * hst + u_in[row * 256 + c];
        const float yv = hst * geluf_(bf2f(proj[row * NP + C_CG + c]));
        const float ms = wave_sum(yv * yv) * (1.f / 64.f);
        y[row * 1024 + 512 + c] = f2bf(yv * rsqrtf(ms + EPS) * mg);
    }
}

typedef short s16x4 __attribute__((ext_vector_type(4)));
#define LDS_AS __attribute__((address_space(3)))
__device__ __forceinline__ bf16x8 frag_rm(const bf16_t* tile, int ld, int r0, int k0, int lane) { return *(const bf16x8*)(tile + (r0 + (lane & 15)) * ld + k0 + (lane >> 4) * 8); }
__device__ __forceinline__ s16x4 tr4(const bf16_t* tile, int ld, int rbase, int c0, int lane) {
    const bf16_t* p = tile + (rbase + ((lane & 15) >> 2)) * ld + c0 + 4 * (lane & 3);
    return __builtin_amdgcn_ds_read_tr16_b64_v4i16((LDS_AS s16x4*)p);
}
__device__ __forceinline__ bf16x8 frag_cm(const bf16_t* tile, int ld, int k0, int c0, int lane) {
    const s16x4 lo = tr4(tile, ld, k0 + (lane >> 4) * 8, c0, lane), hi = tr4(tile, ld, k0 + (lane >> 4) * 8 + 4, c0, lane);
    return (bf16x8){lo[0], lo[1], lo[2], lo[3], hi[0], hi[1], hi[2], hi[3]};
}
#define MFMA16(a, b, c) __builtin_amdgcn_mfma_f32_16x16x32_bf16((a), (b), (c), 0, 0, 0)
constexpr int TLD = 72;


#define XB_TMO      128
#define XB_XCNT(j)  (256  + 64 * (j))
#define XB_XSUB(j)  (1280 + 64 * (j))
#define XB_XGEN(j)  (2304 + 64 * (j))
#define XB_TOP      3328
#define XB_TOPGEN   3392
#define XCD_BAR_WORDS 3456
#define XB_SPIN_CAP (1u << 18)
__device__ __forceinline__ unsigned xb_ld(unsigned* p)              { return __hip_atomic_load(p, __ATOMIC_RELAXED, __HIP_MEMORY_SCOPE_AGENT); }
__device__ __forceinline__ unsigned xb_add(unsigned* p, unsigned v) { return __hip_atomic_fetch_add(p, v, __ATOMIC_RELAXED, __HIP_MEMORY_SCOPE_AGENT); }
__device__ __forceinline__ unsigned xb_xcc_id() { return (unsigned)__builtin_amdgcn_s_getreg((3 << 11) | 20) & 0xFu; }
#define XB_SPIN(cond, bar) do { unsigned _sp = 0; while (cond) { __builtin_amdgcn_s_sleep(1); \
    if ((++_sp & 255u) == 0u) { if (xb_ld(&(bar)[XB_TMO])) break; if (_sp > XB_SPIN_CAP) { atomicAdd(&(bar)[XB_TMO], 1u); break; } } } } while (0)
struct XcdBarrier { unsigned* bar; unsigned x; volatile LDS_AS unsigned* st; };
__device__ __forceinline__ XcdBarrier xcd_barrier_post(unsigned* bar, volatile LDS_AS unsigned* st) {
    XcdBarrier b; b.bar = bar; b.x = xb_xcc_id(); b.st = st;
    if (TIDX == 0) (void)xb_add(&bar[XB_XCNT(b.x)], 1u);
    return b;
}
__device__ __forceinline__ void xcd_barrier_complete(unsigned* bar, unsigned x, unsigned& nloc, unsigned& nx) {
    const unsigned G = gridDim.x * gridDim.y * gridDim.z;
    unsigned sum, cnt, mine, sp = 0u;
    for (;;) {
        sum = 0u; cnt = 0u; mine = 0u;
#pragma unroll
        for (unsigned j = 0; j < 16; ++j) { const unsigned c = xb_ld(&bar[XB_XCNT(j)]); sum += c; cnt += (c > 0u) ? 1u : 0u; mine = (j == x) ? c : mine; }
        if (sum == G) break;
        __builtin_amdgcn_s_sleep(1);
        if ((++sp & 255u) == 0u) { if (xb_ld(&bar[XB_TMO])) break; if (sp > XB_SPIN_CAP) { atomicAdd(&bar[XB_TMO], 1u); break; } }
    }
    nloc = mine > 0u ? mine : 1u; nx = cnt > 0u ? cnt : 1u;
}
__device__ __forceinline__ void xcd_barrier(const XcdBarrier& b) {
    asm volatile("s_waitcnt vmcnt(0)" ::: "memory");
    __syncthreads();
    if (TIDX == 0) {
        unsigned* bar = b.bar;
        __builtin_amdgcn_s_waitcnt(0);
        unsigned nloc = b.st[0], nx = b.st[1];
        if (nloc == 0u) { xcd_barrier_complete(bar, b.x, nloc, nx); b.st[0] = nloc; b.st[1] = nx; }
        const unsigned old = xb_add(&bar[XB_XSUB(b.x)], 1u);
        const unsigned gen = old / nloc;
        if (old + 1u == (gen + 1u) * nloc) {
            __builtin_amdgcn_fence(__ATOMIC_RELEASE, "agent");
            asm volatile("s_waitcnt vmcnt(0)" ::: "memory");
            const unsigned og = xb_add(&bar[XB_TOP], 1u);
            const unsigned tg = og / nx;
            if (og + 1u == (tg + 1u) * nx) xb_add(&bar[XB_TOPGEN], 1u);
            else XB_SPIN(xb_ld(&bar[XB_TOPGEN]) == tg, bar);
            __builtin_amdgcn_fence(__ATOMIC_ACQUIRE, "agent");
            xb_add(&bar[XB_XGEN(b.x)], 1u);
            asm volatile("s_waitcnt vmcnt(0)" ::: "memory");
        } else {
            XB_SPIN(xb_ld(&bar[XB_XGEN(b.x)]) == gen, bar);
            __builtin_amdgcn_fence(__ATOMIC_ACQUIRE, "agent");
            asm volatile("s_waitcnt vmcnt(0)" ::: "memory");
        }
    }
    __syncthreads();
}

template <bool MASK>
__device__ __forceinline__ void attn_compute_t(const bf16_t* cK, const bf16_t* cV, const float* cC, const bf16x8 (&qf)[2], f32x4 (&oacc)[4], float& mrun, float& lrun,
                                               float ct2, float scale2, int kt, int tq, int lane, int g) {
    f32x4 sacc[4];
#pragma unroll
    for (int n = 0; n < 4; ++n) {
        sacc[n] = (f32x4){0.f, 0.f, 0.f, 0.f};
#pragma unroll
        for (int kk = 0; kk < 2; ++kk) sacc[n] = MFMA16(frag_rm(cK, TLD, n * 16, kk * 32, lane), qf[kk], sacc[n]);
    }
    float mx = -INFINITY;
#pragma unroll
    for (int n = 0; n < 4; ++n) {
        const f32x4 cs = *(const f32x4*)(cC + n * 16 + 4 * g);
#pragma unroll
        for (int r = 0; r < 4; ++r) {
            float v = sacc[n][r] * scale2 + (ct2 - cs[r]);
            if (MASK) { if (kt * 64 + n * 16 + 4 * g + r > tq) v = -INFINITY; }
            sacc[n][r] = v; mx = fmaxf(mx, v);
        }
    }
    mx = fmaxf(mx, __shfl_xor(mx, 16)); mx = fmaxf(mx, __shfl_xor(mx, 32));
    const float mnew = fmaxf(mrun, mx);
    const float corr = __builtin_amdgcn_exp2f(mrun - mnew);
    float rs = 0.f;
#pragma unroll
    for (int n = 0; n < 4; ++n)
#pragma unroll
        for (int r = 0; r < 4; ++r) { const float p = __builtin_amdgcn_exp2f(sacc[n][r] - mnew); sacc[n][r] = p; rs += p; }
    rs += __shfl_xor(rs, 16); rs += __shfl_xor(rs, 32);
    lrun = lrun * corr + rs; mrun = mnew;
    bf16x8 pf[2];
#pragma unroll
    for (int kk = 0; kk < 2; ++kk) {
        const u32x4 pk = (u32x4){pk2(sacc[2 * kk][0], sacc[2 * kk][1]), pk2(sacc[2 * kk][2], sacc[2 * kk][3]), pk2(sacc[2 * kk + 1][0], sacc[2 * kk + 1][1]), pk2(sacc[2 * kk + 1][2], sacc[2 * kk + 1][3])};
        pf[kk] = __builtin_bit_cast(bf16x8, pk);
    }
#pragma unroll
    for (int n2 = 0; n2 < 4; ++n2) {
        oacc[n2] = oacc[n2] * corr;
#pragma unroll
        for (int kk = 0; kk < 2; ++kk) {
            const s16x4 lo = tr4(cV, TLD, (2 * kk) * 16 + 4 * g, n2 * 16, lane), hi = tr4(cV, TLD, (2 * kk + 1) * 16 + 4 * g, n2 * 16, lane);
            const bf16x8 vf = (bf16x8){lo[0], lo[1], lo[2], lo[3], hi[0], hi[1], hi[2], hi[3]};
            oacc[n2] = MFMA16(vf, pf[kk], oacc[n2]);
        }
    }
}
__device__ __forceinline__ void attn_compute(const bf16_t* cK, const bf16_t* cV, const float* cC, const bf16x8 (&qf)[2], f32x4 (&oacc)[4], float& mrun, float& lrun,
                                             float ct2, float scale2, int causal, int kt, int q0, int tq, int wave, int lane, int g) {
    const int r0 = q0 + wave * 16;
    if (causal && (kt * 64 > r0 + 15)) return;
    if (causal && (kt * 64 + 63 > r0)) attn_compute_t<true>(cK, cV, cC, qf, oacc, mrun, lrun, ct2, scale2, kt, tq, lane, g);
    else attn_compute_t<false>(cK, cV, cC, qf, oacc, mrun, lrun, ct2, scale2, kt, tq, lane, g);
}

__device__ __forceinline__ void attn_task(char* smem, const bf16_t* __restrict__ Q, int ldq, const bf16_t* __restrict__ Kp, int ldk, const bf16_t* __restrict__ Vp, int ldv, const float* __restrict__ bias,
                                          int nq_per_b, int nk_per_b, int causal, float scale, bf16_t* __restrict__ O, int ldo, const float* __restrict__ gain, int rms, int task) {
    bf16_t* sK = (bf16_t*)smem;
    bf16_t* sV = sK + 2 * 64 * TLD;
    float* sC = (float*)(sV + 2 * 64 * TLD);
    const int tid = TIDX, lane = tid & 63, wave = tid >> 6, g = lane >> 4, li = lane & 15;
    const int nqt = nq_per_b / 128;
    const int qt = task % nqt, h = (task / nqt) & 3, b = task / (nqt * 4);
    const int q0 = qt * 128, tq = q0 + wave * 16 + li;
    const size_t qrow = (size_t)b * nq_per_b + tq;
    bf16x8 qf[2];
#pragma unroll
    for (int kk = 0; kk < 2; ++kk) qf[kk] = *(const bf16x8*)(Q + qrow * ldq + h * 64 + kk * 32 + g * 8);
    constexpr float LOG2E = 1.4426950408889634f;
    const float ct = bias ? bias[(size_t)(b * 4 + h) * nq_per_b + tq] * LOG2E : 0.f;
    const float scale2 = scale * LOG2E;
    const int nkt = causal ? (q0 + 128) / 64 : nk_per_b / 64;
    const int sr = tid >> 3, sc = tid & 7;
    const bf16_t* kg = Kp + ((size_t)b * nk_per_b + sr) * ldk + h * 64 + sc * 8;
    const bf16_t* vg = Vp + ((size_t)b * nk_per_b + sr) * ldv + h * 64 + sc * 8;
    const float* cg_ = bias ? bias + (size_t)(b * 4 + h) * nk_per_b : nullptr;
    u32x4 rkA, rvA, rkB, rvB; float rcA = 0.f, rcB = 0.f;
    {   const u32x4 rk = *(const u32x4*)kg, rv = *(const u32x4*)vg; const float rc = (cg_ && tid < 64) ? cg_[tid] * LOG2E : 0.f;
        __syncthreads();
        *(u32x4*)(sK + sr * TLD + sc * 8) = rk; *(u32x4*)(sV + sr * TLD + sc * 8) = rv; if (tid < 64) sC[tid] = rc; }
    rkA = *(const u32x4*)(kg + (size_t)64 * ldk); rvA = *(const u32x4*)(vg + (size_t)64 * ldv); rcA = (cg_ && tid < 64) ? cg_[64 + tid] * LOG2E : 0.f;
    __syncthreads();
    f32x4 oacc[4];
#pragma unroll
    for (int n = 0; n < 4; ++n) oacc[n] = (f32x4){0.f, 0.f, 0.f, 0.f};
    float mrun = -INFINITY, lrun = 0.f;
#define ATTN_ITER(kt, LK, LV, LC, WK, WV, WC) { \
        const int buf = (kt) & 1; \
        if ((kt) + 2 < nkt) { LK = *(const u32x4*)(kg + (size_t)((kt) + 2) * 64 * ldk); LV = *(const u32x4*)(vg + (size_t)((kt) + 2) * 64 * ldv); LC = (cg_ && tid < 64) ? cg_[((kt) + 2) * 64 + tid] * LOG2E : 0.f; } \
        attn_compute(sK + buf * 64 * TLD, sV + buf * 64 * TLD, sC + buf * 64, qf, oacc, mrun, lrun, ct, scale2, causal, (kt), q0, tq, wave, lane, g); \
        if ((kt) + 1 < nkt) { const int nb = buf ^ 1; *(u32x4*)(sK + nb * 64 * TLD + sr * TLD + sc * 8) = WK; *(u32x4*)(sV + nb * 64 * TLD + sr * TLD + sc * 8) = WV; if (tid < 64) sC[nb * 64 + tid] = WC; } \
        __syncthreads(); }
    for (int kt = 0; kt < nkt; kt += 2) {
        ATTN_ITER(kt, rkB, rvB, rcB, rkA, rvA, rcA)
        ATTN_ITER(kt + 1, rkA, rvA, rcA, rkB, rvB, rcB)
    }
#undef ATTN_ITER
    const float inv = 1.f / lrun;
    float ms = 0.f;
#pragma unroll
    for (int n = 0; n < 4; ++n) { oacc[n] = oacc[n] * inv; ms += oacc[n][0] * oacc[n][0] + oacc[n][1] * oacc[n][1] + oacc[n][2] * oacc[n][2] + oacc[n][3] * oacc[n][3]; }
    ms += __shfl_xor(ms, 16); ms += __shfl_xor(ms, 32);
    const float rinv = rms ? rsqrtf(ms * (1.f / 64.f) + EPS) : 1.f;
#pragma unroll
    for (int n = 0; n < 4; ++n) {
        const int d = n * 16 + 4 * g;
        f32x4 gg = (f32x4){1.f, 1.f, 1.f, 1.f};
        if (gain) gg = *(const f32x4*)(gain + h * 64 + d);
        uint2 o; o.x = pk2(oacc[n][0] * rinv * gg[0], oacc[n][1] * rinv * gg[1]); o.y = pk2(oacc[n][2] * rinv * gg[2], oacc[n][3] * rinv * gg[3]);
        *(uint2*)(O + qrow * ldo + h * 64 + d) = o;
    }
}


__device__ __forceinline__ void hgrn_scan(float* LF  , float* SEGT  , const bf16_t* __restrict__ prow  , const float* __restrict__ hgrn_lb, int layer, int h, float (&kk)[8]) {
    const int tid = TIDX, t = tid >> 3, k8 = (tid & 7) * 8;
    const u32x4 raw = *(const u32x4*)(prow + (size_t)t * NP + C_AF + k8);
#pragma unroll
    for (int j = 0; j < 8; ++j) {
        const float fl = __uint_as_float((j & 1) ? (raw[j >> 1] & 0xffff0000u) : (raw[j >> 1] << 16));
        float lbk = 0.f;
        if (layer == 1) { const float a0 = hgrn_lb[h * 64 + k8 + j], a1 = hgrn_lb[256 + h * 64 + k8 + j]; lbk = 1.f / (1.f + __expf(a0 - a1)); }
        const float sg = sigmoidf_(fl);
        const float f = lbk + (1.f - lbk) * sg;
        kk[j] = (1.f - lbk) * (1.f - sg);
        LF[t * 65 + k8 + j] = __logf(f);
    }
    __syncthreads();
    { const int k = tid & 63, seg = tid >> 6; float run = 0.f;
#pragma unroll
      for (int i = 0; i < 8; ++i) { run += LF[(seg * 8 + i) * 65 + k]; LF[(seg * 8 + i) * 65 + k] = run; }
      SEGT[seg * 64 + k] = run; }
    __syncthreads();
    { const int k = tid & 63, seg = tid >> 6; float off = 0.f;
      for (int s2 = 0; s2 < seg; ++s2) off += SEGT[s2 * 64 + k];
#pragma unroll
      for (int i = 0; i < 8; ++i) LF[(seg * 8 + i) * 65 + k] += off; }
    __syncthreads();
}
__device__ __forceinline__ float bfx(const u32x4& raw, int j) { return __uint_as_float((j & 1) ? (raw[j >> 1] & 0xffff0000u) : (raw[j >> 1] << 16)); }

__device__ __forceinline__ void hgrn_local_task(char* smem, const bf16_t* __restrict__ proj, const float* __restrict__ hgrn_lb, int layer, float* __restrict__ HL, float* __restrict__ HD, int ch) {
    float* LF = (float*)smem; float* SEGT = LF + 64 * 65;
    bf16_t* sKd = (bf16_t*)(SEGT + 8 * 64); bf16_t* sV = sKd + 64 * TLD;
    const int tid = TIDX, lane = tid & 63, wave = tid >> 6, g = lane >> 4, li = lane & 15;
    const int bh = ch >> 5, n = ch & 31, b = bh >> 2, h = bh & 3;
    const bf16_t* prow = proj + (size_t)(b * SEQ + n * 64) * NP + h * 64;
    const int t = tid >> 3, k8 = (tid & 7) * 8;
    __syncthreads();
    *(u32x4*)(sV + t * TLD + k8) = *(const u32x4*)(prow + (size_t)t * NP + C_AI + k8);
    float kk[8];
    hgrn_scan(LF, SEGT, prow, hgrn_lb, layer, h, kk);
    { u32x4 o;
#pragma unroll
      for (int j = 0; j < 8; j += 2) {
          const float e0 = kk[j] * __expf(LF[63 * 65 + k8 + j] - LF[t * 65 + k8 + j]), e1 = kk[j + 1] * __expf(LF[63 * 65 + k8 + j + 1] - LF[t * 65 + k8 + j + 1]);
          o[j >> 1] = pk2(e0, e1);
      }
      *(u32x4*)(sKd + t * TLD + k8) = o; }
    if (tid < 64) HD[(size_t)ch * 64 + tid] = __expf(LF[63 * 65 + tid]);
    __syncthreads();
#pragma unroll
    for (int i = 0; i < 2; ++i) {
        const int idx = wave * 2 + i, vt = idx >> 2, kt = idx & 3;
        f32x4 acc = (f32x4){0.f, 0.f, 0.f, 0.f};
#pragma unroll
        for (int ks = 0; ks < 2; ++ks) acc = MFMA16(frag_cm(sV, TLD, ks * 32, vt * 16, lane), frag_cm(sKd, TLD, ks * 32, kt * 16, lane), acc);
        *(f32x4*)(HL + (size_t)ch * 4096 + (kt * 16 + li) * 64 + vt * 16 + 4 * g) = acc;
    }
}

__device__ __forceinline__ void hgrn_out_task(char* smem, const bf16_t* __restrict__ proj, const float* __restrict__ hgrn_lb, int layer, const bf16_t* __restrict__ HS,
                                              const float* __restrict__ mix_gain, bf16_t* __restrict__ y, int ch) {
    float* LF = (float*)smem; float* SEGT = LF + 64 * 65; float* sMS = SEGT + 8 * 64;
    bf16_t* sST = (bf16_t*)(sMS + 128); bf16_t* sQ0 = sST + 64 * TLD; bf16_t* sQm = sQ0 + 64 * TLD; bf16_t* sKm = sQm + 64 * TLD; bf16_t* sV = sKm + 64 * TLD; bf16_t* sA = sV + 64 * TLD;
    const int tid = TIDX, lane = tid & 63, wave = tid >> 6, g = lane >> 4, li = lane & 15;
    const int bh = ch >> 5, n = ch & 31, b = bh >> 2, h = bh & 3;
    const bf16_t* prow = proj + (size_t)(b * SEQ + n * 64) * NP + h * 64;
    const int t = tid >> 3, k8 = (tid & 7) * 8;
    __syncthreads();
    *(u32x4*)(sST + t * TLD + k8) = *(const u32x4*)(HS + (size_t)ch * 4096 + t * 64 + k8);
    const u32x4 qraw = *(const u32x4*)(prow + (size_t)t * NP + C_AQ + k8);
    *(u32x4*)(sV + t * TLD + k8) = *(const u32x4*)(prow + (size_t)t * NP + C_AI + k8);
    float kk[8];
    hgrn_scan(LF, SEGT, prow, hgrn_lb, layer, h, kk);
    { u32x4 o0, om, ok;
#pragma unroll
      for (int j = 0; j < 8; j += 2) {
          float q0v[2], qmv[2], kmv[2];
#pragma unroll
          for (int e = 0; e < 2; ++e) {
              const float bt = LF[t * 65 + k8 + j + e], r = LF[31 * 65 + k8 + j + e], q = siluf_(bfx(qraw, j + e));
              q0v[e] = q * __expf(bt); qmv[e] = q * __expf(bt - r); kmv[e] = kk[j + e] * __expf(r - bt);
          }
          o0[j >> 1] = pk2(q0v[0], q0v[1]); om[j >> 1] = pk2(qmv[0], qmv[1]); ok[j >> 1] = pk2(kmv[0], kmv[1]);
      }
      *(u32x4*)(sQ0 + t * TLD + k8) = o0; *(u32x4*)(sQm + t * TLD + k8) = om; *(u32x4*)(sKm + t * TLD + k8) = ok; }
    __syncthreads();
#pragma unroll
    for (int i = 0; i < 2; ++i) {
        const int idx = wave * 2 + i, tt = idx >> 2, st = idx & 3;
        f32x4 acc = (f32x4){0.f, 0.f, 0.f, 0.f};
#pragma unroll
        for (int ks = 0; ks < 2; ++ks) acc = MFMA16(frag_rm(sKm, TLD, st * 16, ks * 32, lane), frag_rm(sQm, TLD, tt * 16, ks * 32, lane), acc);
        const int tq = tt * 16 + li, s0 = st * 16 + 4 * g;
        uint2 o; o.x = pk2(s0 <= tq ? acc[0] : 0.f, s0 + 1 <= tq ? acc[1] : 0.f); o.y = pk2(s0 + 2 <= tq ? acc[2] : 0.f, s0 + 3 <= tq ? acc[3] : 0.f);
        *(uint2*)(sA + tq * TLD + s0) = o;
    }
    __syncthreads();
    { const int tt = wave >> 1;
      f32x4 oacc[2]; float ms = 0.f;
#pragma unroll
      for (int i = 0; i < 2; ++i) {
          const int vt = (wave & 1) * 2 + i;
          f32x4 acc = (f32x4){0.f, 0.f, 0.f, 0.f};
#pragma unroll
          for (int ks = 0; ks < 2; ++ks) acc = MFMA16(frag_cm(sST, TLD, ks * 32, vt * 16, lane), frag_rm(sQ0, TLD, tt * 16, ks * 32, lane), acc);
#pragma unroll
          for (int ks = 0; ks < 2; ++ks) acc = MFMA16(frag_cm(sV, TLD, ks * 32, vt * 16, lane), frag_rm(sA, TLD, tt * 16, ks * 32, lane), acc);
          oacc[i] = acc; ms += acc[0] * acc[0] + acc[1] * acc[1] + acc[2] * acc[2] + acc[3] * acc[3];
      }
      ms += __shfl_xor(ms, 16); ms += __shfl_xor(ms, 32);
      if (g == 0) sMS[(tt * 16 + li) * 2 + (wave & 1)] = ms;
      __syncthreads();
      const int tq = tt * 16 + li;
      const float rinv = rsqrtf((sMS[tq * 2] + sMS[tq * 2 + 1]) * (1.f / 64.f) + EPS);
      const size_t row = (size_t)(b * SEQ + n * 64 + tq);
#pragma unroll
      for (int i = 0; i < 2; ++i) {
          const int v0 = ((wave & 1) * 2 + i) * 16 + 4 * g;
          const uint2 graw = *(const uint2*)(proj + row * NP + C_AG + h * 64 + v0);
          const f32x4 mgv = *(const f32x4*)(mix_gain + C_AQ + h * 64 + v0);
          const float g0 = __uint_as_float(graw.x << 16), g1 = __uint_as_float(graw.x & 0xffff0000u), g2 = __uint_as_float(graw.y << 16), g3 = __uint_as_float(graw.y & 0xffff0000u);
          uint2 o; o.x = pk2(oacc[i][0] * rinv * siluf_(g0) * mgv[0], oacc[i][1] * rinv * siluf_(g1) * mgv[1]);
          o.y = pk2(oacc[i][2] * rinv * siluf_(g2) * mgv[2], oacc[i][3] * rinv * siluf_(g3) * mgv[3]);
          *(uint2*)(y + row * 1024 + h * 64 + v0) = o;
      }
    }
}


__device__ __forceinline__ void gdn_prep_task(char* smem, const bf16_t* __restrict__ proj, const float* __restrict__ gates, const float* __restrict__ conv_w  ,
                                              const float* __restrict__ a_log, const float* __restrict__ dt_bias, bf16_t* __restrict__ gt_all, float* __restrict__ glast, int ch) {
    float* sG = (float*)smem; float* sBeta = sG + 64;
    float* RHS = sBeta + 64;
    float* sM = RHS + 64 * 132;
    bf16_t* sK = (bf16_t*)(sM + 64 * 68); bf16_t* sQ = sK + 64 * TLD;
    const int tid = TIDX, lane = tid & 63, wave = tid >> 6, g = lane >> 4, li = lane & 15;
    const int bh = ch >> 5, n = ch & 31, b = bh >> 2, h = bh & 3;
    const int t = tid >> 3, d8 = (tid & 7) * 8;
    const size_t row0 = (size_t)(b * SEQ + n * 64);
    bf16_t* gt = gt_all + (size_t)ch * 5 * 4096;
    __syncthreads();
    float qn[8], kn[8], vv[8];
    {
        const int spos = n * 64 + t;
#pragma unroll
        for (int sec = 0; sec < 3; ++sec) {
            const int col = (sec == 0 ? C_DQ : (sec == 1 ? C_DK : C_DV)) + h * 64 + d8;
            float acc[8];
#pragma unroll
            for (int e = 0; e < 8; ++e) acc[e] = 0.f;
#pragma unroll
            for (int j = 0; j < 4; ++j) {
                if (spos - (3 - j) >= 0) {
                    const u32x4 raw = *(const u32x4*)(proj + (row0 + t - (3 - j)) * NP + col);
                    const f32x4 w0 = *(const f32x4*)(conv_w + j * 768 + sec * 256 + h * 64 + d8), w1 = *(const f32x4*)(conv_w + j * 768 + sec * 256 + h * 64 + d8 + 4);
#pragma unroll
                    for (int e = 0; e < 8; ++e) acc[e] += (e < 4 ? w0[e] : w1[e - 4]) * bfx(raw, e);
                }
            }
#pragma unroll
            for (int e = 0; e < 8; ++e) { const float sv = siluf_(acc[e]); if (sec == 0) qn[e] = sv; else if (sec == 1) kn[e] = sv; else vv[e] = sv; }
        }
        float sq = 0.f, sk = 0.f;
#pragma unroll
        for (int e = 0; e < 8; ++e) { sq += qn[e] * qn[e]; sk += kn[e] * kn[e]; }
        sq += __shfl_xor(sq, 1); sq += __shfl_xor(sq, 2); sq += __shfl_xor(sq, 4);
        sk += __shfl_xor(sk, 1); sk += __shfl_xor(sk, 2); sk += __shfl_xor(sk, 4);
        const float rq = rsqrtf(sq + EPS) * 0.125f, rk = rsqrtf(sk + EPS);
#pragma unroll
        for (int e = 0; e < 8; ++e) { qn[e] *= rq; kn[e] *= rk; }
    }
    if ((tid & 7) == 0) {
        const float* gr = gates + (row0 + t) * 16;
        sBeta[t] = sigmoidf_(gr[4 + h]);
        sG[t] = -__expf(a_log[h]) * softplusf_(gr[8 + h] + dt_bias[h]);
    }
    __syncthreads();
    if (wave == 0) {
        float v = sG[lane];
#pragma unroll
        for (int o = 1; o < 64; o <<= 1) { const float nb = __shfl_up(v, o); if (lane >= o) v += nb; }
        sG[lane] = v;
    }
    __syncthreads();
    {
        const float Gt = sG[t], Gl = sG[63], bt = sBeta[t];
        const float eG = __expf(Gt), eD = __expf(Gl - Gt);
        u32x4 ok, oq, oqd, okd;
#pragma unroll
        for (int e = 0; e < 8; e += 2) {
            ok[e >> 1] = pk2(kn[e], kn[e + 1]); oq[e >> 1] = pk2(qn[e], qn[e + 1]);
            oqd[e >> 1] = pk2(qn[e] * eG, qn[e + 1] * eG); okd[e >> 1] = pk2(kn[e] * eD, kn[e + 1] * eD);
        }
        *(u32x4*)(sK + t * TLD + d8) = ok; *(u32x4*)(sQ + t * TLD + d8) = oq;
        *(u32x4*)(gt + 2 * 4096 + t * 64 + d8) = oqd; *(u32x4*)(gt + 3 * 4096 + t * 64 + d8) = okd;
#pragma unroll
        for (int e = 0; e < 8; ++e) { RHS[t * 132 + d8 + e] = vv[e] * bt; RHS[t * 132 + 64 + d8 + e] = kn[e] * bt * eG; }
        if (tid == 0) glast[ch] = __expf(Gl);
    }
    __syncthreads();
#pragma unroll
    for (int i = 0; i < 2; ++i) {
        const int idx = wave * 2 + i, tt = idx >> 2, st = idx & 3;
        f32x4 am = (f32x4){0.f, 0.f, 0.f, 0.f}, aq = (f32x4){0.f, 0.f, 0.f, 0.f};
#pragma unroll
        for (int ks = 0; ks < 2; ++ks) {
            const bf16x8 kfs = frag_rm(sK, TLD, st * 16, ks * 32, lane), kft = frag_rm(sK, TLD, tt * 16, ks * 32, lane);
            am = MFMA16(kft, kfs, am);
            aq = MFMA16(kfs, frag_rm(sQ, TLD, tt * 16, ks * 32, lane), aq);
        }
        {   const int sx = st * 16 + li, t0 = tt * 16 + 4 * g; const float Gs = sG[sx];
            f32x4 mo;
#pragma unroll
            for (int r = 0; r < 4; ++r) { const int tq = t0 + r; mo[r] = (sx < tq) ? sBeta[tq] * am[r] * __expf(sG[tq] - Gs) : 0.f; }
            *(f32x4*)(sM + sx * 68 + t0) = mo; }
        {   const int tq = tt * 16 + li, s0 = st * 16 + 4 * g; const float Gt = sG[tq];
            float ao[4];
#pragma unroll
            for (int r = 0; r < 4; ++r) { const int sx = s0 + r; ao[r] = (sx <= tq) ? aq[r] * __expf(Gt - sG[sx]) : 0.f; }
            uint2 o; o.x = pk2(ao[0], ao[1]); o.y = pk2(ao[2], ao[3]);
            *(uint2*)(gt + 4 * 4096 + tq * 64 + s0) = o; }
    }
    __syncthreads();
    if (tid < 128) {
        float acc[64];
#pragma unroll
        for (int i = 0; i < 64; ++i) acc[i] = RHS[i * 132 + tid];
#pragma unroll
        for (int half = 0; half < 2; ++half) {
            const int base = half * 32;
            if (half == 1) {
#pragma unroll
                for (int sx = 0; sx < 32; sx += 2) {
                    f32x4 r0[8], r1[8];
#pragma unroll
                    for (int c = 0; c < 8; ++c) { r0[c] = *(const f32x4*)(sM + sx * 68 + 32 + c * 4); r1[c] = *(const f32x4*)(sM + (sx + 1) * 68 + 32 + c * 4); }
                    const float x0 = acc[sx], x1 = acc[sx + 1];
#pragma unroll
                    for (int tq = 0; tq < 32; ++tq) { acc[32 + tq] -= r0[tq >> 2][tq & 3] * x0; acc[32 + tq] -= r1[tq >> 2][tq & 3] * x1; }
                }
            }
            f32x4 cur[8];
#pragma unroll
            for (int c = 0; c < 8; ++c) cur[c] = *(const f32x4*)(sM + base * 68 + base + c * 4);
#pragma unroll
            for (int sx = 0; sx < 31; ++sx) {
                f32x4 nxt[8];
#pragma unroll
                for (int c = (sx + 2) >> 2; c < 8; ++c) nxt[c] = *(const f32x4*)(sM + (base + sx + 1) * 68 + base + c * 4);
                const float xs = acc[base + sx];
#pragma unroll
                for (int tq = sx + 1; tq < 32; ++tq) acc[base + tq] -= cur[tq >> 2][tq & 3] * xs;
#pragma unroll
                for (int c = (sx + 2) >> 2; c < 8; ++c) cur[c] = nxt[c];
            }
        }
        if (tid < 64) {
#pragma unroll
            for (int tt = 0; tt < 64; ++tt) gt[tt * 64 + tid] = f2bf(acc[tt]);
        } else {
#pragma unroll
            for (int tt = 0; tt < 64; ++tt) gt[4096 + tt * 64 + (tid - 64)] = f2bf(-acc[tt]);
        }
    }
}

__device__ __forceinline__ void gdn_scan_task(char* smem, const bf16_t* __restrict__ gt_all, const float* __restrict__ glast, const bf16_t* __restrict__ proj, const float* __restrict__ mix_gain,
                                              bf16_t* __restrict__ y, int bh) {
    bf16_t* sT = (bf16_t*)smem;
    bf16_t* sST = sT + 2 * 5 * 64 * TLD;
    bf16_t* sVn = sST + 2 * 64 * TLD;
    const int tid = TIDX, lane = tid & 63, wave = tid >> 6, g = lane >> 4, li = lane & 15;
    const int b = bh >> 2, h = bh & 3;
    const int sr = tid >> 3, sc8 = (tid & 7) * 8;
    const bf16_t* gsrc = gt_all + (size_t)bh * 32 * 5 * 4096 + sr * 64 + sc8;
    __syncthreads();
    u32x4 regs[5];
#pragma unroll
    for (int i = 0; i < 5; ++i) regs[i] = *(const u32x4*)(gsrc + i * 4096);
#pragma unroll
    for (int i = 0; i < 5; ++i) *(u32x4*)(sT + i * 64 * TLD + sr * TLD + sc8) = regs[i];
    *(u32x4*)(sST + sr * TLD + sc8) = (u32x4){0u, 0u, 0u, 0u};
    f32x4 sacc[4];
#pragma unroll
    for (int i = 0; i < 4; ++i) sacc[i] = (f32x4){0.f, 0.f, 0.f, 0.f};
    __syncthreads();
    for (int n = 0; n < 32; ++n) {
        const int buf = n & 1;
        const bf16_t* cT = sT + buf * 5 * 64 * TLD;
        const bf16_t* sU = cT; const bf16_t* sWn = cT + 64 * TLD; const bf16_t* sQd = cT + 2 * 64 * TLD; const bf16_t* sKd = cT + 3 * 64 * TLD; const bf16_t* sAq = cT + 4 * 64 * TLD;
        const bf16_t* cST = sST + buf * 64 * TLD; bf16_t* nST = sST + (buf ^ 1) * 64 * TLD;
        if (n + 1 < 32) {
#pragma unroll
            for (int i = 0; i < 5; ++i) regs[i] = *(const u32x4*)(gsrc + (size_t)(n + 1) * 5 * 4096 + i * 4096);
        }
        const size_t rowz = (size_t)(b * SEQ + n * 64 + (wave & 3) * 16 + li);
        uint2 zraw[4];
        if (wave < 4) {
#pragma unroll
            for (int vt = 0; vt < 4; ++vt) zraw[vt] = *(const uint2*)(proj + rowz * NP + C_DZ + h * 64 + vt * 16 + 4 * g);
        }
#pragma unroll
        for (int i = 0; i < 2; ++i) {
            const int idx = wave * 2 + i, tt = idx >> 2, vt = idx & 3;
            const int tq = tt * 16 + li, v0 = vt * 16 + 4 * g;
            const uint2 uraw = *(const uint2*)(sU + tq * TLD + v0);
            f32x4 acc = (f32x4){__uint_as_float(uraw.x << 16), __uint_as_float(uraw.x & 0xffff0000u), __uint_as_float(uraw.y << 16), __uint_as_float(uraw.y & 0xffff0000u)};
#pragma unroll
            for (int ks = 0; ks < 2; ++ks) acc = MFMA16(frag_rm(cST, TLD, vt * 16, ks * 32, lane), frag_rm(sWn, TLD, tt * 16, ks * 32, lane), acc);
            uint2 o; o.x = pk2(acc[0], acc[1]); o.y = pk2(acc[2], acc[3]);
            *(uint2*)(sVn + tq * TLD + v0) = o;
        }
        __syncthreads();
        if (wave < 4) {
            const int tt = wave;
            f32x4 oacc[4]; float ms = 0.f;
#pragma unroll
            for (int vt = 0; vt < 4; ++vt) {
                f32x4 acc = (f32x4){0.f, 0.f, 0.f, 0.f};
#pragma unroll
                for (int ks = 0; ks < 2; ++ks) acc = MFMA16(frag_rm(cST, TLD, vt * 16, ks * 32, lane), frag_rm(sQd, TLD, tt * 16, ks * 32, lane), acc);
#pragma unroll
                for (int ks = 0; ks < 2; ++ks) acc = MFMA16(frag_cm(sVn, TLD, ks * 32, vt * 16, lane), frag_rm(sAq, TLD, tt * 16, ks * 32, lane), acc);
                oacc[vt] = acc; ms += acc[0] * acc[0] + acc[1] * acc[1] + acc[2] * acc[2] + acc[3] * acc[3];
            }
            ms += __shfl_xor(ms, 16); ms += __shfl_xor(ms, 32);
            const float rinv = rsqrtf(ms * (1.f / 64.f) + EPS);
#pragma unroll
            for (int vt = 0; vt < 4; ++vt) {
                const int v0 = vt * 16 + 4 * g;
                const f32x4 mgv = *(const f32x4*)(mix_gain + 768 + h * 64 + v0);
                const float z0 = __uint_as_float(zraw[vt].x << 16), z1 = __uint_as_float(zraw[vt].x & 0xffff0000u), z2 = __uint_as_float(zraw[vt].y << 16), z3 = __uint_as_float(zraw[vt].y & 0xffff0000u);
                uint2 o; o.x = pk2(oacc[vt][0] * rinv * siluf_(z0) * mgv[0], oacc[vt][1] * rinv * siluf_(z1) * mgv[1]);
                o.y = pk2(oacc[vt][2] * rinv * siluf_(z2) * mgv[2], oacc[vt][3] * rinv * siluf_(z3) * mgv[3]);
                *(uint2*)(y + rowz * 1024 + 768 + h * 64 + v0) = o;
            }
        } else {
            const int kt = wave - 4;
            const float gl = glast[bh * 32 + n];
#pragma unroll
            for (int vt = 0; vt < 4; ++vt) {
                f32x4 acc = sacc[vt] * gl;
#pragma unroll
                for (int ks = 0; ks < 2; ++ks) acc = MFMA16(frag_cm(sKd, TLD, ks * 32, kt * 16, lane), frag_cm(sVn, TLD, ks * 32, vt * 16, lane), acc);
                sacc[vt] = acc;
                uint2 o; o.x = pk2(acc[0], acc[1]); o.y = pk2(acc[2], acc[3]);
                *(uint2*)(nST + (vt * 16 + li) * TLD + kt * 16 + 4 * g) = o;
            }
        }
        if (n + 1 < 32) {
            bf16_t* nT = sT + (buf ^ 1) * 5 * 64 * TLD;
#pragma unroll
            for (int i = 0; i < 5; ++i) *(u32x4*)(nT + i * 64 * TLD + sr * TLD + sc8) = regs[i];
        }
        __syncthreads();
    }
}


constexpr int XLD = 264;
__device__ __forceinline__ void lru_local_task(char* smem, const bf16_t* __restrict__ proj, const float* __restrict__ conv_w, const float* __restrict__ conv_b,
                                               const float* __restrict__ w_a, const float* __restrict__ b_a, const float* __restrict__ w_x, const float* __restrict__ b_x,
                                               const float* __restrict__ lam, float* __restrict__ hl_out, float* __restrict__ ac_out, float* __restrict__ lsum, int task) {
    bf16_t* sX = (bf16_t*)smem;
    bf16_t* sW = sX + 64 * XLD;
    float* sAa = (float*)(sW + 2 * 64 * TLD);
    float* sU = sAa + 64 * 65;
    float* sSegA = sU + 64 * 65; float* sSegH = sSegA + 8 * 64;
    const int tid = TIDX, lane = tid & 63, wave = tid >> 6, g = lane >> 4, li = lane & 15;
    const int b = task >> 5, n = task & 31;
    const size_t row0 = (size_t)(b * SEQ + n * 64);
    const int t = tid >> 3;
    __syncthreads();
    {
        const int spos = n * 64 + t;
#pragma unroll
        for (int i = 0; i < 4; ++i) {
            const int c8 = ((tid & 7) + 8 * i) * 8;
            float acc[8];
            { const f32x4 cb0 = *(const f32x4*)(conv_b + c8), cb1 = *(const f32x4*)(conv_b + c8 + 4);
#pragma unroll
              for (int e = 0; e < 8; ++e) acc[e] = e < 4 ? cb0[e] : cb1[e - 4]; }
#pragma unroll
            for (int j = 0; j < 4; ++j) {
                if (spos - (3 - j) >= 0) {
                    const u32x4 raw = *(const u32x4*)(proj + (row0 + t - (3 - j)) * NP + C_CX + c8);
                    const f32x4 w0 = *(const f32x4*)(conv_w + j * 256 + c8), w1 = *(const f32x4*)(conv_w + j * 256 + c8 + 4);
#pragma unroll
                    for (int e = 0; e < 8; ++e) acc[e] += (e < 4 ? w0[e] : w1[e - 4]) * bfx(raw, e);
                }
            }
            u32x4 o; o[0] = pk2(acc[0], acc[1]); o[1] = pk2(acc[2], acc[3]); o[2] = pk2(acc[4], acc[5]); o[3] = pk2(acc[6], acc[7]);
            *(u32x4*)(sX + t * XLD + c8) = o;
        }
    }
    for (int hh = 0; hh < 4; ++hh) {
        {
            const int i = tid >> 3, j8 = (tid & 7) * 8;
#pragma unroll
            for (int m = 0; m < 2; ++m) {
                const float* src = (m == 0 ? w_a : w_x) + (size_t)hh * 4096 + i * 64 + j8;
                const f32x4 v0 = *(const f32x4*)src, v1 = *(const f32x4*)(src + 4);
                u32x4 o; o[0] = pk2(v0[0], v0[1]); o[1] = pk2(v0[2], v0[3]); o[2] = pk2(v1[0], v1[1]); o[3] = pk2(v1[2], v1[3]);
                *(u32x4*)(sW + m * 64 * TLD + i * TLD + j8) = o;
            }
        }
        __syncthreads();
#pragma unroll
        for (int i2 = 0; i2 < 2; ++i2) {
            const int idx = wave * 2 + i2, tt = idx >> 2, jt = idx & 3;
            f32x4 ra = (f32x4){0.f, 0.f, 0.f, 0.f}, rx = (f32x4){0.f, 0.f, 0.f, 0.f};
#pragma unroll
            for (int ks = 0; ks < 2; ++ks) {
                const bf16x8 xf = frag_rm(sX + hh * 64, XLD, tt * 16, ks * 32, lane);
                ra = MFMA16(frag_cm(sW, TLD, ks * 32, jt * 16, lane), xf, ra);
                rx = MFMA16(frag_cm(sW + 64 * TLD, TLD, ks * 32, jt * 16, lane), xf, rx);
            }
            const int tq = tt * 16 + li, cl = jt * 16 + 4 * g, c = hh * 64 + cl;
            const f32x4 ba = *(const f32x4*)(b_a + c), bx = *(const f32x4*)(b_x + c), lm = *(const f32x4*)(lam + c);
            const uint2 xraw = *(const uint2*)(sX + tq * XLD + c);
            const float xc[4] = {__uint_as_float(xraw.x << 16), __uint_as_float(xraw.x & 0xffff0000u), __uint_as_float(xraw.y << 16), __uint_as_float(xraw.y & 0xffff0000u)};
#pragma unroll
            for (int r = 0; r < 4; ++r) {
                const float rr = sigmoidf_(ra[r] + ba[r]), ig = sigmoidf_(rx[r] + bx[r]);
                const float log_a = -8.f * rr * softplusf_(-lm[r]);
                sAa[tq * 65 + cl + r] = __expf(log_a);
                sU[tq * 65 + cl + r] = sqrtf(-expm1f(2.f * log_a)) * (ig * xc[r]);
            }
        }
        __syncthreads();
        const int cl = tid & 63, seg = tid >> 6;
        float Al[8], Hl[8];
        { float A = 1.f, H = 0.f;
#pragma unroll
          for (int i = 0; i < 8; ++i) { const float a = sAa[(seg * 8 + i) * 65 + cl], u = sU[(seg * 8 + i) * 65 + cl]; H = a * H + u; A *= a; Al[i] = A; Hl[i] = H; }
          sSegA[seg * 64 + cl] = A; sSegH[seg * 64 + cl] = H; }
        __syncthreads();
        { float Ac = 1.f, Hc = 0.f;
          for (int s2 = 0; s2 < seg; ++s2) { const float a = sSegA[s2 * 64 + cl]; Hc = a * Hc + sSegH[s2 * 64 + cl]; Ac *= a; }
#pragma unroll
          for (int i = 0; i < 8; ++i) {
              const size_t o = (row0 + seg * 8 + i) * 256 + hh * 64 + cl;
              const float hv = Hl[i] + Al[i] * Hc, av = Al[i] * Ac;
              hl_out[o] = hv; ac_out[o] = av;
              if (seg == 7 && i == 7) { lsum[(size_t)task * 256 + hh * 64 + cl] = av; lsum[(size_t)(256 + task) * 256 + hh * 64 + cl] = hv; }
          } }
        __syncthreads();
    }
}
__device__ __forceinline__ void lru_out_task(const float* __restrict__ hl_in, const float* __restrict__ ac_in, const float* __restrict__ lsum, const bf16_t* __restrict__ proj,
                                             const float* __restrict__ mix_gain, bf16_t* __restrict__ y, int task) {
    const int b = task >> 5, n = task & 31, c = TIDX & 255, half = TIDX >> 8;
    const float Hc = lsum[(size_t)task * 256 + c];
    const float mg = mix_gain[512 + c];
    const size_t row0 = (size_t)(b * SEQ + n * 64 + half * 32);
#pragma unroll 4
    for (int i = 0; i < 32; ++i) {
        const size_t row = row0 + i;
        const float hv = hl_in[row * 256 + c] + ac_in[row * 256 + c] * Hc;
        const float yv = hv * geluf_(bf2f(proj[row * NP + C_CG + c]));
        const float ms = wave_sum(yv * yv) * (1.f / 64.f);
        y[row * 1024 + 512 + c] = f2bf(yv * rsqrtf(ms + EPS) * mg);
    }
}


__device__ __forceinline__ void state_scan_phase(const float* __restrict__ HL, const float* __restrict__ HD, bf16_t* __restrict__ HS, const float* __restrict__ lsum, float* __restrict__ lcar) {
    const int bx = blockIdx.x, tid = TIDX;
    for (int u = bx; u < 128 + 4; u += gridDim.x) {
        if (u < 128) {
            const int gid = u * NTHR + tid, bh = gid >> 11, v = gid & 63, kp = (gid >> 6) & 31;
            const float* Lb = HL + (size_t)bh * 32 * 4096 + (2 * kp) * 64 + v; const float* Db = HD + (size_t)bh * 32 * 64 + 2 * kp;
            bf16_t* Sb = HS + (size_t)bh * 32 * 4096 + (2 * kp) * 64 + v;
            float S0 = 0.f, S1 = 0.f;
            for (int n0 = 0; n0 < 32; n0 += 8) {
                float l0[8], l1[8], d0[8], d1[8];
#pragma unroll
                for (int i = 0; i < 8; ++i) { l0[i] = Lb[(size_t)(n0 + i) * 4096]; l1[i] = Lb[(size_t)(n0 + i) * 4096 + 64]; d0[i] = Db[(n0 + i) * 64]; d1[i] = Db[(n0 + i) * 64 + 1]; }
#pragma unroll
                for (int i = 0; i < 8; ++i) {
                    Sb[(size_t)(n0 + i) * 4096] = f2bf(S0); Sb[(size_t)(n0 + i) * 4096 + 64] = f2bf(S1);
                    S0 = d0[i] * S0 + l0[i]; S1 = d1[i] * S1 + l1[i];
                }
            }
        } else {
            const int gid = (u - 128) * NTHR + tid, b = gid >> 8, c = gid & 255;
            float A[32], H[32];
#pragma unroll
            for (int n = 0; n < 32; ++n) { A[n] = lsum[(size_t)(b * 32 + n) * 256 + c]; H[n] = lsum[(size_t)(256 + b * 32 + n) * 256 + c]; }
            float Hc = 0.f;
#pragma unroll
            for (int n = 0; n < 32; ++n) { lcar[(size_t)(b * 32 + n) * 256 + c] = Hc; Hc = A[n] * Hc + H[n]; }
        }
    }
}

__device__ __forceinline__ void router_phase(char* smem, const float* __restrict__ x, const float* __restrict__ g, const float* __restrict__ w_rg, const float* __restrict__ b_rg,
                                             const float* __restrict__ w_re, const float* __restrict__ b_re, bf16_t* __restrict__ hn, int* __restrict__ cnt, int* __restrict__ list, float* __restrict__ pgate) {
    float* sXg = (float*)smem;
    float* sWr = sXg + 64 * 132;
    float* sLog = sWr + 128 * 40;
    float* sRinv = sLog + 64 * 40;
    const int tid = TIDX;
    BLK_LOOP(tile, T / 64) {
        const int t0 = tile * 64;
        const int stok = tid >> 3;
        const int ctok = tid & 63, eg = tid >> 6;
        float acc[5] = {0.f, 0.f, 0.f, 0.f, 0.f};
        float ss = 0.f;
        for (int kc = 0; kc < 8; ++kc) {
            __syncthreads();
#pragma unroll
            for (int i = 0; i < 4; ++i) {
                const int col = ((tid & 7) + 8 * i) * 4;
                const f32x4 xv = *(const f32x4*)(x + (size_t)(t0 + stok) * 1024 + kc * 128 + col);
                const f32x4 gv = *(const f32x4*)(g + kc * 128 + col);
                ss += xv[0] * xv[0] + xv[1] * xv[1] + xv[2] * xv[2] + xv[3] * xv[3];
                *(f32x4*)(sXg + stok * 132 + col) = xv * gv;
            }
            for (int idx = tid; idx < 128 * 40; idx += NTHR) {
                const int k = idx / 40, e = idx - k * 40;
                float wv = 0.f;
                if (e < 4) wv = w_rg[(size_t)(kc * 128 + k) * 4 + e]; else if (e < 36) wv = w_re[(size_t)(kc * 128 + k) * 32 + (e - 4)];
                sWr[idx] = wv;
            }
            __syncthreads();
#pragma unroll 2
            for (int k4 = 0; k4 < 128; k4 += 4) {
                const f32x4 hv = *(const f32x4*)(sXg + ctok * 132 + k4);
#pragma unroll
                for (int kk = 0; kk < 4; ++kk) {
                    const float* wp = sWr + (k4 + kk) * 40 + eg * 5;
#pragma unroll
                    for (int j = 0; j < 5; ++j) acc[j] += hv[kk] * wp[j];
                }
            }
        }
        ss += __shfl_xor(ss, 1); ss += __shfl_xor(ss, 2); ss += __shfl_xor(ss, 4);
        if ((tid & 7) == 0) sRinv[stok] = rsqrtf(ss * (1.f / 1024.f) + EPS);
#pragma unroll
        for (int j = 0; j < 5; ++j) sLog[ctok * 40 + eg * 5 + j] = acc[j];
        __syncthreads();
        if (tid < 64) {
            const int t = t0 + tid; const float rinv = sRinv[tid];
            float lg[4];
#pragma unroll
            for (int i = 0; i < 4; ++i) lg[i] = sLog[tid * 40 + i] * rinv + b_rg[i];
            int gs = 0; float gm = lg[0];
#pragma unroll
            for (int i = 1; i < 4; ++i) if (lg[i] > gm) { gm = lg[i]; gs = i; }
            float den = 0.f;
#pragma unroll
            for (int i = 0; i < 4; ++i) den += __expf(lg[i] - gm);
            const float pg = 1.f / den;
            int i0 = 0, i1 = -1; float m0 = -INFINITY, m1 = -INFINITY;
            for (int i = 0; i < 8; ++i) {
                const float v = sLog[tid * 40 + 4 + gs * 8 + i] * rinv + b_re[gs * 8 + i];
                if (v > m0) { m1 = m0; i1 = i0; m0 = v; i0 = i; } else if (v > m1) { m1 = v; i1 = i; }
            }
            const float e1 = __expf(m1 - m0); const float w0 = 1.f / (1.f + e1), w1 = e1 / (1.f + e1);
            const int ex0 = gs * 8 + i0, ex1 = gs * 8 + i1;
            const int pos0 = atomicAdd(&cnt[ex0], 1); list[(size_t)ex0 * T + pos0] = 2 * t; pgate[2 * t] = pg * w0;
            const int pos1 = atomicAdd(&cnt[ex1], 1); list[(size_t)ex1 * T + pos1] = 2 * t + 1; pgate[2 * t + 1] = pg * w1;
        }
        {
            const float rinv = sRinv[stok];
#pragma unroll 4
            for (int i = 0; i < 32; ++i) {
                const int col = ((tid & 7) + 8 * i) * 4;
                const f32x4 xv = *(const f32x4*)(x + (size_t)(t0 + stok) * 1024 + col);
                const f32x4 gv = *(const f32x4*)(g + col);
                uint2 o; o.x = pk2(xv[0] * gv[0] * rinv, xv[1] * gv[1] * rinv); o.y = pk2(xv[2] * gv[2] * rinv, xv[3] * gv[3] * rinv);
                *(uint2*)(hn + (size_t)(t0 + stok) * 1024 + col) = o;
            }
        }
    }
}

__device__ __forceinline__ void combine_phase(const float* x2, const bf16_t* __restrict__ eo, const float* __restrict__ g, float* xout, bf16_t* __restrict__ hn, int mode) {
    const int lane = TIDX & 63;
    for (int t = blockIdx.x * 8 + (TIDX >> 6); t < T; t += gridDim.x * 8) {
        f32x4 v[4]; float s = 0.f;
#pragma unroll
        for (int j = 0; j < 4; ++j) {
            const int c = (lane + 64 * j) * 4;
            v[j] = *(const f32x4*)(x2 + (size_t)t * 1024 + c);
            const uint2 e0 = *(const uint2*)(eo + (size_t)(2 * t) * 1024 + c), e1 = *(const uint2*)(eo + (size_t)(2 * t + 1) * 1024 + c);
            v[j].x += __uint_as_float(e0.x << 16) + __uint_as_float(e1.x << 16);
            v[j].y += __uint_as_float(e0.x & 0xffff0000u) + __uint_as_float(e1.x & 0xffff0000u);
            v[j].z += __uint_as_float(e0.y << 16) + __uint_as_float(e1.y << 16);
            v[j].w += __uint_as_float(e0.y & 0xffff0000u) + __uint_as_float(e1.y & 0xffff0000u);
            s += v[j].x * v[j].x + v[j].y * v[j].y + v[j].z * v[j].z + v[j].w * v[j].w;
        }
        const float rinv = rsqrtf(wave_sum(s) * (1.f / 1024.f) + EPS);
#pragma unroll
        for (int j = 0; j < 4; ++j) {
            const int c = (lane + 64 * j) * 4;
            const f32x4 gg = *(const f32x4*)(g + c);
            const f32x4 hv = v[j] * rinv * gg;
            if (mode == 0) {
                *(f32x4*)(xout + (size_t)t * 1024 + c) = v[j];
                uint2 o; o.x = pk2(hv.x, hv.y); o.y = pk2(hv.z, hv.w);
                *(uint2*)(hn + (size_t)t * 1024 + c) = o;
            } else {
                *(f32x4*)(xout + (size_t)t * 1024 + c) = hv;
            }
        }
    }
}

template <int l>
__device__ __forceinline__ void layer_body(const Params& P, char* smem, const XcdBarrier& xb, const float* xcur) {
    char* ws = P.ws;
    bf16_t* Wt_in = (bf16_t*)(ws + OFF_WIN); bf16_t* Wt_out = (bf16_t*)(ws + OFF_WOUT); bf16_t* Wt_mq = (bf16_t*)(ws + OFF_WMQ); bf16_t* Wt_mkv = (bf16_t*)(ws + OFF_WMKV);
    bf16_t* Wt_mo = (bf16_t*)(ws + OFF_WMO); bf16_t* Wt_gu = (bf16_t*)(ws + OFF_WGU); bf16_t* Wt_dn = (bf16_t*)(ws + OFF_WDN);
    bf16_t* hn = (bf16_t*)(ws + OFF_HN); bf16_t* proj = (bf16_t*)(ws + OFF_PROJ); float* gates = (float*)(ws + OFF_GATES); bf16_t* y = (bf16_t*)(ws + OFF_Y);
    float* XA = P.out; float* XB = (float*)(ws + OFF_XB);
    bf16_t* qm = (bf16_t*)(ws + OFF_QM); bf16_t* om = (bf16_t*)(ws + OFF_OM); bf16_t* kvm = (bf16_t*)(ws + OFF_KVM); bf16_t* memn = (bf16_t*)(ws + OFF_MEMN);
    float* foxc = (float*)(ws + OFF_FOXC); float* lrua = (float*)(ws + OFF_LRUA); float* lruu = (float*)(ws + OFF_LRUU);
    int* cnt_all = (int*)(ws + OFF_CTL) + CTL_CNT_WORD; int* list = (int*)(ws + OFF_LIST); float* pgate = (float*)(ws + OFF_PGATE);
    bf16_t* act = (bf16_t*)(ws + OFF_ACT); bf16_t* eo = (bf16_t*)(ws + OFF_EO);
    const int wave = TIDX >> 6, lane = TIDX & 63;


        float* x1 = (l == 0) ? XA : XB;
        float* x2 = (l == 0) ? XB : XA;
        int* cnt = cnt_all + 32 * l;
        const float* mg = P.in[I_MIX_GAIN] + l * 1024;
        REP(2, { pg8::Gemm g{hn, Wt_in + (size_t)l * NP * 1024, T, NP, 1024}; pg8::StaticOrder S; S.init(T, NP, (int)gridDim.x, (int)blockIdx.x);
                 pg8::EpiInProj E{proj, NP, gates, C_GATE};
                 pg8::gemm_phase<pg8::EpiInProj, pg8::StaticOrder, true, true>((PG8_LAS unsigned char*)smem, g, S, E); });
        if (l == 0) for (int l2 = 0; l2 < NL; ++l2)
            gemm_phase<EPI_BF16>(smem, memn + (size_t)l2 * 2048 * 1024, 1024, Wt_mkv + (size_t)l2 * 512 * 1024, 1024, 2048, 512, 1024, kvm + (size_t)l2 * 2048 * 512, 512, nullptr, nullptr,
                                 (gridDim.x >= 192) ? ((int)blockIdx.x - 128 - 32 * l2) : (int)blockIdx.x, (gridDim.x >= 192) ? 4096 : (int)gridDim.x);
        GSYNC();
        REP(4,         {
            const int bx = blockIdx.x;
            bf16_t* gtiles = (bf16_t*)(ws + OFF_GDN); float* glast = (float*)(ws + OFF_GLAST);
            if (bx < 32 && wave == 1) fox_cumsum(gates, P.in[I_FOX_FB] + l * 4, foxc, bx, lane);
            BLK_LOOP(ch, 1024) gdn_prep_task(smem, proj, gates, P.in[I_GDN_CONV_W] + l * 4 * 768, P.in[I_GDN_A_LOG] + l * 4, P.in[I_GDN_DT_BIAS] + l * 4, gtiles, glast, ch);
            BLK_LOOP(ch, 1024) hgrn_local_task(smem, proj, P.in[I_HGRN_LB], l, (float*)(ws + OFF_HL), (float*)(ws + OFF_HD), ch);
            BLK_LOOP(task, 256) lru_local_task(smem, proj, P.in[I_LRU_CONV_W] + l * 1024, P.in[I_LRU_CONV_B] + l * 256, P.in[I_LRU_WA] + l * 16384, P.in[I_LRU_BA] + l * 256,
                                               P.in[I_LRU_WX] + l * 16384, P.in[I_LRU_BX] + l * 256, P.in[I_LRU_LAM] + l * 256, lrua, lruu, (float*)(ws + OFF_LSUM), task);
        });
        GSYNC();
        state_scan_phase((const float*)(ws + OFF_HL), (const float*)(ws + OFF_HD), (bf16_t*)(ws + OFF_HS), (const float*)(ws + OFF_LSUM), (float*)(ws + OFF_LCAR));
        GSYNC();
        REP(8,         {
            const int natt = (SEQ / 128) * 4 * NB;
            const int bx = blockIdx.x, nfree = (int)gridDim.x - 32;
            if (bx < 32) gdn_scan_task(smem, (const bf16_t*)(ws + OFF_GDN), (const float*)(ws + OFF_GLAST), proj, mg, y, bx);
            else {
                for (int r = 0; r * nfree < natt; ++r) {
                    const int i = r * nfree + ((r & 1) ? (nfree - 1 - (bx - 32)) : (bx - 32));
                    if (i >= natt) continue;
                    const int qt = 15 - (i >> 5), bh = i & 31;
                    attn_task(smem, proj + C_BQ, NP, proj + C_BK, NP, proj + C_BV, NP, foxc, SEQ, SEQ, 1, 0.125f, y + 256, 1024, mg + 256, 1, (bh * 16) + qt);
                }
                for (int i = bx - 32; i < 1024; i += nfree) {
                    const int ch = (i & 31) * 32 + (31 - (i >> 5));
                    hgrn_out_task(smem, proj, P.in[I_HGRN_LB], l, (const bf16_t*)(ws + OFF_HS), mg, y, ch);
                }
                for (int i = bx - 32; i < 256; i += nfree) lru_out_task(lrua, lruu, (const float*)(ws + OFF_LCAR), proj, mg, y, i);
            }
        });
        GSYNC();
        REP(16, { pg8::Gemm g{y, Wt_out + (size_t)l * 1024 * 1024, T, 1024, 1024}; pg8::StaticOrder S; S.init(T, 1024, (int)gridDim.x, (int)blockIdx.x);
                  pg8::EpiResid E{xcur, x1, 1024};
                  pg8::gemm_phase<pg8::EpiResid, pg8::StaticOrder, true, true>((PG8_LAS unsigned char*)smem, g, S, E); });
        GSYNC();
        REP(32, for (int row = blockIdx.x * 8 + wave; row < T; row += gridDim.x * 8) rms_row_bf16(x1 + (size_t)row * 1024, P.in[I_NORM_MEM] + l * 1024, hn + (size_t)row * 1024, lane));
        GSYNC();
        REP(64, gemm_phase<EPI_BF16>(smem, hn, 1024, Wt_mq + (size_t)l * 256 * 1024, 1024, T, 256, 1024, qm, 256, nullptr, nullptr));
        GSYNC();
        { const bf16_t* kv = kvm + (size_t)l * 2048 * 512;
          REP(128, BLK_LOOP(task, (SEQ / 128) * 4 * NB) attn_task(smem, qm, 256, kv, 512, kv + 256, 512, nullptr, SEQ, MEMLEN, 0, 0.125f, om, 256, nullptr, 0, task)); }
        GSYNC();
        REP(256, { pg8::Gemm g{om, Wt_mo + (size_t)l * 1024 * 256, T, 1024, 256}; pg8::StaticOrder S; S.init(T, 1024, (int)gridDim.x, (int)blockIdx.x);
                   pg8::EpiResid E{x1, x2, 1024};
                   pg8::gemm_phase<pg8::EpiResid, pg8::StaticOrder, true, true>((PG8_LAS unsigned char*)smem, g, S, E); });
        GSYNC();
        router_phase(smem, x2, P.in[I_NORM_FFN] + l * 1024, P.in[I_W_RG] + l * 4096, P.in[I_B_RG] + l * 4, P.in[I_W_RE] + l * 32768, P.in[I_B_RE] + l * 32, hn, cnt, list, pgate);
        GSYNC();
        REP(512, moe_phase<1>(smem, hn, 1024, Wt_gu + (size_t)l * 32 * 512 * 1024, (size_t)512 * 1024, 1024, 1024, cnt, list, pgate, act));
        GSYNC();
        REP(1024, moe_phase<2>(smem, act, 256, Wt_dn + (size_t)l * 32 * 1024 * 256, (size_t)1024 * 256, 256, 256, cnt, list, pgate, eo));
        if (PROBE_MASK & 2048) { for (int i = 0; i < 10; ++i) GSYNC(); }
        GSYNC();
        if (l == 0) { combine_phase(x2, eo, P.in[I_NORM_MIX] + 1024, XA, hn, 0); GSYNC(); }
        else combine_phase(x2, eo, P.in[I_NORM_FINAL], P.out, hn, 1);
}
__global__ void __launch_bounds__(NTHR, 2) mega_kernel(Params P) {
    extern __shared__ __attribute__((aligned(16))) char smem[];
    volatile LDS_AS unsigned* st = (volatile LDS_AS unsigned*)(smem + LDS_BYTES - 16);
    if (TIDX < 4) st[TIDX] = 0u;
    __syncthreads();
    const XcdBarrier xb = xcd_barrier_post((unsigned*)(P.ws + OFF_CTL), st);
    phase0(P, smem);
    GSYNC();
    layer_body<0>(P, smem, xb, P.in[I_X]);
    layer_body<1>(P, smem, xb, P.out);
}

extern "C" void kernel_launch(void* const* d_in, const int* in_sizes, int n_in, void* d_out, int out_size, void* d_ws, size_t ws_size, hipStream_t stream) {
    static int grid_blocks = 0;
    if (grid_blocks == 0) {
        if (n_in != N_INPUTS || ws_size < OFF_END || out_size != T * 1024) { fprintf(stderr, "kernel_launch: unexpected sizes n_in=%d ws=%zu out=%d (need ws >= %zu)\n", n_in, ws_size, out_size, (size_t)OFF_END); grid_blocks = -1; return; }
        int dev = 0, cus = 0, per_cu = 0;
        if (hipGetDevice(&dev) != hipSuccess || hipDeviceGetAttribute(&cus, hipDeviceAttributeMultiprocessorCount, dev) != hipSuccess) { fprintf(stderr, "kernel_launch: device query failed\n"); grid_blocks = -1; return; }
        if (hipFuncSetAttribute((const void*)mega_kernel, hipFuncAttributeMaxDynamicSharedMemorySize, LDS_BYTES) != hipSuccess) { fprintf(stderr, "kernel_launch: hipFuncSetAttribute failed\n"); grid_blocks = -1; return; }
        if (hipOccupancyMaxActiveBlocksPerMultiprocessor(&per_cu, (const void*)mega_kernel, NTHR, LDS_BYTES) != hipSuccess || per_cu < 1) { fprintf(stderr, "kernel_launch: occupancy query says %d blocks/CU\n", per_cu); grid_blocks = -1; return; }
        grid_blocks = cus;
        fprintf(stderr, "kernel_launch: cus=%d per_cu=%d grid=%d\n", cus, per_cu, grid_blocks);
    }
    if (grid_blocks < 0) return;
    if (hipMemsetAsync((char*)d_ws + OFF_CTL, 0, CTL_BYTES, stream) != hipSuccess) { fprintf(stderr, "kernel_launch: memset failed\n"); return; }
    Params p; memset(&p, 0, sizeof p);
    for (int i = 0; i < N_INPUTS; ++i) p.in[i] = (const float*)d_in[i];
    p.out = (float*)d_out; p.ws = (char*)d_ws;
    void* args[] = {&p};
    hipError_t e = hipLaunchCooperativeKernel((const void*)mega_kernel, dim3(grid_blocks), dim3(NTHR), args, LDS_BYTES, stream);
    if (e != hipSuccess) fprintf(stderr, "kernel_launch: cooperative launch failed: %s (grid %d)\n", hipGetErrorString(e), grid_blocks);
}
```

```cpp
#include <hip/hip_runtime.h>
#include <stdint.h>
#include <stdio.h>
#include <string.h>
#include <hip/hip_cooperative_groups.h>
namespace cg = cooperative_groups;

typedef unsigned short bf16_t;
typedef short bf16x8 __attribute__((ext_vector_type(8)));
typedef float f32x4 __attribute__((ext_vector_type(4)));
typedef unsigned u32x4 __attribute__((ext_vector_type(4)));

constexpr int NB = 8, SEQ = 2048, DM = 1024, T = NB * SEQ, NL = 2;
constexpr int NP = 3584;
constexpr int NIN = 3340;
constexpr int C_AQ = 0, C_AF = 256, C_AI = 512, C_AG = 768, C_BQ = 1024, C_BK = 1280, C_BV = 1536, C_CX = 1792, C_CG = 2048,
              C_DQ = 2304, C_DK = 2560, C_DV = 2816, C_DZ = 3072, C_GATE = 3328;
constexpr int MEMLEN = 256;
constexpr int NEXP = 32, DEXP = 256;
constexpr float EPS = 1e-6f;

constexpr size_t al256(size_t x) { return (x + 255) & ~(size_t)255; }
constexpr size_t SZ_WIN = (size_t)NP * 1024 * 2, SZ_WOUT = (size_t)1024 * 1024 * 2, SZ_WMQ = (size_t)256 * 1024 * 2, SZ_WMKV = (size_t)512 * 1024 * 2,
                 SZ_WMO = (size_t)1024 * 256 * 2, SZ_WGU = (size_t)32 * 512 * 1024 * 2, SZ_WDN = (size_t)32 * 1024 * 256 * 2;
constexpr size_t OFF_WIN = 0;
constexpr size_t OFF_WOUT = OFF_WIN + NL * SZ_WIN;
constexpr size_t OFF_WMQ = OFF_WOUT + NL * SZ_WOUT;
constexpr size_t OFF_WMKV = OFF_WMQ + NL * SZ_WMQ;
constexpr size_t OFF_WMO = OFF_WMKV + NL * SZ_WMKV;
constexpr size_t OFF_WGU = OFF_WMO + NL * SZ_WMO;
constexpr size_t OFF_WDN = OFF_WGU + NL * SZ_WGU;
constexpr size_t OFF_HN = OFF_WDN + NL * SZ_WDN;
constexpr size_t OFF_PROJ = OFF_HN + (size_t)T * 1024 * 2;
constexpr size_t OFF_GATES = OFF_PROJ + (size_t)T * NP * 2;
constexpr size_t OFF_Y = OFF_GATES + (size_t)T * 16 * 4;
constexpr size_t OFF_XB = OFF_Y + (size_t)T * 1024 * 2;
constexpr size_t OFF_QM = OFF_XB + (size_t)T * 1024 * 4;
constexpr size_t OFF_OM = OFF_QM + (size_t)T * 256 * 2;
constexpr size_t OFF_KVM = OFF_OM + (size_t)T * 256 * 2;
constexpr size_t OFF_MEMN = OFF_KVM + (size_t)NL * 2048 * 512 * 2;
constexpr size_t OFF_FOXC = OFF_MEMN + (size_t)2048 * 1024 * 2;
constexpr size_t OFF_LRUA = OFF_FOXC + (size_t)NB * 4 * SEQ * 4;
constexpr size_t OFF_LRUU = OFF_LRUA + (size_t)T * 256 * 4;
constexpr size_t OFF_CNT = OFF_LRUU + (size_t)T * 256 * 4;
constexpr size_t OFF_LIST = OFF_CNT + 256;
constexpr size_t OFF_PGATE = OFF_LIST + (size_t)NEXP * T * 4;
constexpr size_t OFF_HL = OFF_PGATE + (size_t)2 * T * 4;
constexpr size_t OFF_HD = OFF_HL + (size_t)1024 * 4096 * 4;
constexpr size_t OFF_GDN = OFF_HD + (size_t)1024 * 64 * 4;
constexpr size_t OFF_GLAST = OFF_GDN + (size_t)1024 * 5 * 4096 * 2;
constexpr size_t OFF_LSUM = OFF_GLAST + 4096;
constexpr size_t OFF_HS = OFF_LSUM + (size_t)2 * 256 * 256 * 4;
constexpr size_t OFF_LCAR = OFF_HS + (size_t)1024 * 4096 * 2;
constexpr size_t OFF_PSS = OFF_LCAR + (size_t)256 * 256 * 4;
constexpr size_t OFF_WR = OFF_PSS + (size_t)T * 16 * 4;
constexpr size_t OFF_CTL = OFF_WR + (size_t)NL * 2 * 48 * 1024 * 2;
constexpr size_t CTL_BYTES = 16384;
constexpr int CTL_CNT_WORD = 3584;
constexpr size_t OFF_END = OFF_CTL + CTL_BYTES;
constexpr size_t OFF_ACT = OFF_PROJ;
constexpr size_t OFF_EO = OFF_PROJ + (size_t)2 * T * 256 * 2;
static_assert(OFF_EO + (size_t)2 * T * 1024 * 2 <= OFF_GATES, "overlay fits");

__device__ __forceinline__ int tid_opaque() { int t = threadIdx.x; asm volatile("" : "+v"(t)); return t; }
#define TIDX tid_opaque()
__device__ __forceinline__ float bf2f(bf16_t v) { return __uint_as_float(((unsigned)v) << 16); }
typedef __bf16 bf16x2_t __attribute__((ext_vector_type(2)));
__device__ __forceinline__ bf16_t f2bf(float f) { return __builtin_bit_cast(unsigned short, (__bf16)f); }
__device__ __forceinline__ unsigned pk2(float lo, float hi) { bf16x2_t v = {(__bf16)lo, (__bf16)hi}; return __builtin_bit_cast(unsigned, v); }
__device__ __forceinline__ float sigmoidf_(float x) { return 1.f / (1.f + __expf(-x)); }
__device__ __forceinline__ float siluf_(float x) { return x / (1.f + __expf(-x)); }
__device__ __forceinline__ float softplusf_(float x) { return x > 20.f ? x : log1pf(__expf(x)); }
__device__ __forceinline__ float logsigmoidf_(float x) { return x < 0.f ? x - log1pf(__expf(x)) : -log1pf(__expf(-x)); }
__device__ __forceinline__ float geluf_(float x) { float u = 0.7978845608028654f * (x + 0.044715f * x * x * x); return 0.5f * x * (1.f + tanhf(u)); }
__device__ __forceinline__ float wave_sum(float v) {
#pragma unroll
    for (int o = 1; o < 64; o <<= 1) v += __shfl_xor(v, o);
    return v;
}
__device__ __forceinline__ float rdlane(float v, int l) { return __int_as_float(__builtin_amdgcn_readlane(__float_as_int(v), l)); }

#define PROBE_MASK 0
#define GSYNC() xcd_barrier(xb)
#define REP(bit, ...) do { __VA_ARGS__; if (PROBE_MASK & (bit)) { GSYNC(); __VA_ARGS__; } } while (0)
constexpr int NTHR = 512;
constexpr int LDS_BYTES = 147456;
enum { I_X = 0, I_MEM, I_NORM_MIX, I_W_IN, I_HGRN_LB, I_FOX_FB, I_LRU_CONV_W, I_LRU_CONV_B, I_LRU_WA, I_LRU_BA, I_LRU_WX, I_LRU_BX, I_LRU_LAM, I_GDN_CONV_W, I_GDN_A_LOG,
       I_GDN_DT_BIAS, I_MIX_GAIN, I_W_OUT, I_NORM_MEM, I_NORM_MEMKV, I_W_MQ, I_W_MKV, I_W_MO, I_NORM_FFN, I_W_RG, I_B_RG, I_W_RE, I_B_RE, I_W_E_GU, I_W_E_DN, I_NORM_FINAL, N_INPUTS };
struct Params { const float* in[N_INPUTS]; float* out; char* ws; };
static_assert(sizeof(Params) == 8 * (N_INPUTS + 2), "no padding");

#define BLK_LOOP(it, n) for (int it = (int)blockIdx.x; it < (n); it += (int)gridDim.x)


__device__ __forceinline__ float rinv_from_pss(const float* __restrict__ pss, size_t row) {
    const f32x4 a = *(const f32x4*)(pss + row * 16), b = *(const f32x4*)(pss + row * 16 + 4), c = *(const f32x4*)(pss + row * 16 + 8), d = *(const f32x4*)(pss + row * 16 + 12);
    const float sm = ((a[0] + a[1]) + (a[2] + a[3])) + ((b[0] + b[1]) + (b[2] + b[3])) + ((c[0] + c[1]) + (c[2] + c[3])) + ((d[0] + d[1]) + (d[2] + d[3]));
    return rsqrtf(sm * (1.f / 1024.f) + EPS);
}

__device__ __forceinline__ int rowmap_fn(int mode, int n) {
    if (mode == 1) {
        if (n < 1792) return n;
        if (n < 1796) return C_GATE + (n - 1792);
        if (n < 3076) return n - 4;
        if (n < 3084) return C_GATE + 4 + (n - 3076);
        return n - 12;
    } else if (mode == 2) {
        int j = n & 255; return (j >> 4) * 32 + ((n >= 256) ? 16 : 0) + (j & 15);
    }
    return n;
}
__device__ __forceinline__ void convT_tile(float* tile  , const float* __restrict__ src, int K, int N, bf16_t* __restrict__ dst, int mode, int ntn, int idx) {
    const int n0 = (idx % ntn) * 64, k0 = (idx / ntn) * 64;
    const int tid = TIDX;
    __syncthreads();
#pragma unroll
    for (int i = 0; i < 2; ++i) {
        const int k = (tid >> 4) + 32 * i, n = n0 + (tid & 15) * 4;
        f32x4 v = (f32x4){0.f, 0.f, 0.f, 0.f};
        if (n + 3 < N) v = *(const f32x4*)(src + (size_t)(k0 + k) * N + n);
        else { for (int e = 0; e < 4; ++e) if (n + e < N) v[e] = src[(size_t)(k0 + k) * N + n + e]; }
#pragma unroll
        for (int e = 0; e < 4; ++e) tile[k * 65 + (tid & 15) * 4 + e] = v[e];
    }
    __syncthreads();
    const int nl = tid >> 3, k8 = (tid & 7) * 8, n = n0 + nl;
    if (n < N) {
        const int r = rowmap_fn(mode, n);
        u32x4 o;
#pragma unroll
        for (int j = 0; j < 4; ++j) o[j] = pk2(tile[(k8 + 2 * j) * 65 + nl], tile[(k8 + 2 * j + 1) * 65 + nl]);
        *(u32x4*)(dst + (size_t)r * K + k0 + k8) = o;
    }
}
__device__ __forceinline__ void rms_row_bf16(const float* __restrict__ xrow, const float* __restrict__ g, bf16_t* __restrict__ orow, int lane) {
    const f32x4* xr = (const f32x4*)xrow + lane;
    f32x4 v[4]; float s = 0.f;
#pragma unroll
    for (int j = 0; j < 4; ++j) { v[j] = xr[64 * j]; s += v[j].x * v[j].x + v[j].y * v[j].y + v[j].z * v[j].z + v[j].w * v[j].w; }
    const float rinv = rsqrtf(wave_sum(s) * (1.f / 1024.f) + EPS);
#pragma unroll
    for (int j = 0; j < 4; ++j) {
        const f32x4 gg = ((const f32x4*)g)[lane + 64 * j];
        uint2 o; o.x = pk2(v[j].x * rinv * gg.x, v[j].y * rinv * gg.y); o.y = pk2(v[j].z * rinv * gg.z, v[j].w * rinv * gg.w);
        *(uint2*)(orow + (lane + 64 * j) * 4) = o;
    }
}

constexpr int CT_PER_LAYER = 53 * 16 + 256 + 64 + 128 + 64;
constexpr int CT_GU = 64 * 128, CT_DN = 64 * 64;
constexpr int CT_TOTAL = NL * CT_PER_LAYER + CT_GU + CT_DN;

__device__ __forceinline__ void phase0(const Params& P, char* smem) {
    char* ws = P.ws;
    float* tile = (float*)smem;
    BLK_LOOP(it, CT_TOTAL) {
        int r = it;
        if (r < NL * CT_PER_LAYER) {
            const int l = r / CT_PER_LAYER; r -= l * CT_PER_LAYER;
            if (r < 848) { convT_tile(tile, P.in[I_W_IN] + (size_t)l * 1024 * NIN, 1024, NIN, (bf16_t*)(ws + OFF_WIN) + (size_t)l * NP * 1024, 1, 53, r); continue; } r -= 848;
            if (r < 256) { convT_tile(tile, P.in[I_W_OUT] + (size_t)l * 1024 * 1024, 1024, 1024, (bf16_t*)(ws + OFF_WOUT) + (size_t)l * 1024 * 1024, 0, 16, r); continue; } r -= 256;
            if (r < 64) { convT_tile(tile, P.in[I_W_MQ] + (size_t)l * 1024 * 256, 1024, 256, (bf16_t*)(ws + OFF_WMQ) + (size_t)l * 256 * 1024, 0, 4, r); continue; } r -= 64;
            if (r < 128) { convT_tile(tile, P.in[I_W_MKV] + (size_t)l * 1024 * 512, 1024, 512, (bf16_t*)(ws + OFF_WMKV) + (size_t)l * 512 * 1024, 0, 8, r); continue; } r -= 128;
            convT_tile(tile, P.in[I_W_MO] + (size_t)l * 256 * 1024, 256, 1024, (bf16_t*)(ws + OFF_WMO) + (size_t)l * 1024 * 256, 0, 16, r); continue;
        }
        r -= NL * CT_PER_LAYER;
        if (r < CT_GU) { const int m = r >> 7; convT_tile(tile, P.in[I_W_E_GU] + (size_t)m * 1024 * 512, 1024, 512, (bf16_t*)(ws + OFF_WGU) + (size_t)m * 512 * 1024, 2, 8, r & 127); continue; }
        r -= CT_GU;
        { const int m = r >> 6; convT_tile(tile, P.in[I_W_E_DN] + (size_t)m * 256 * 1024, 256, 1024, (bf16_t*)(ws + OFF_WDN) + (size_t)m * 1024 * 256, 0, 16, r & 63); }
    }
    for (int i = blockIdx.x * NTHR + TIDX; i < NL * (NP - NIN) * 512; i += gridDim.x * NTHR) {
        const int l = i / ((NP - NIN) * 512), w = i % ((NP - NIN) * 512);
        ((unsigned*)((bf16_t*)(ws + OFF_WIN) + (size_t)l * NP * 1024 + (size_t)NIN * 1024))[w] = 0u;
    }
    for (int i = blockIdx.x * NTHR + TIDX; i < NL * 48 * 1024; i += gridDim.x * NTHR) {
        const int l = i / (48 * 1024), r = (i / 1024) % 48, k = i & 1023;
        float w = 0.f;
        if (r < 4) w = P.in[I_W_RG][(size_t)l * 4096 + k * 4 + r]; else if (r < 36) w = P.in[I_W_RE][(size_t)l * 32768 + k * 32 + (r - 4)];
        const bf16_t hi = f2bf(w); const bf16_t lo = f2bf(w - bf2f(hi));
        bf16_t* wr = (bf16_t*)(ws + OFF_WR) + (size_t)l * 2 * 48 * 1024;
        wr[r * 1024 + k] = hi; wr[48 * 1024 + r * 1024 + k] = lo;
    }
    const int gw = blockIdx.x * 8 + (TIDX >> 6), ngw = gridDim.x * 8, lane = TIDX & 63;
    for (int row = gw; row < T + NL * 2048; row += ngw) {
        if (row < T) rms_row_bf16(P.in[I_X] + (size_t)row * 1024, P.in[I_NORM_MIX], (bf16_t*)(ws + OFF_HN) + (size_t)row * 1024, lane);
        else { const int r2 = row - T, l = r2 >> 11, rr = r2 & 2047;
               rms_row_bf16(P.in[I_MEM] + (size_t)rr * 1024, P.in[I_NORM_MEMKV] + l * 1024, (bf16_t*)(ws + OFF_MEMN) + (size_t)r2 * 1024, lane); }
    }
}

constexpr int GLD = 72;
constexpr int GEMM_LDS = (256 + 128) * GLD * 2;
template <class RowPtr>
__device__ __forceinline__ void gemm_tile(char* smem, RowPtr rowptr, const bf16_t* __restrict__ Bt, int ldb, int n0, int K, f32x4 (&acc)[4][4]) {
    bf16_t* sA = (bf16_t*)smem; bf16_t* sB = sA + 256 * GLD;
    const int tid = TIDX, lane = tid & 63, wave = tid >> 6, wm = wave >> 1, wn = wave & 1;
    const u32x4* ga[4]; const u32x4* gb[2];
#pragma unroll
    for (int i = 0; i < 4; ++i) { const int c = tid + i * 512, r = c >> 3, ch = c & 7; ga[i] = (const u32x4*)(rowptr(r) + ch * 8); }
#pragma unroll
    for (int i = 0; i < 2; ++i) { const int c = tid + i * 512, r = c >> 3, ch = c & 7; gb[i] = (const u32x4*)(Bt + (size_t)(n0 + r) * ldb + ch * 8); }
#pragma unroll
    for (int m = 0; m < 4; ++m)
#pragma unroll
        for (int n = 0; n < 4; ++n) acc[m][n] = (f32x4){0.f, 0.f, 0.f, 0.f};
    u32x4 ra[4], rb[2];
#pragma unroll
    for (int i = 0; i < 4; ++i) ra[i] = ga[i][0];
#pragma unroll
    for (int i = 0; i < 2; ++i) rb[i] = gb[i][0];
    const int nk = K / 64;
    for (int kt = 0; kt < nk; ++kt) {
        __syncthreads();
#pragma unroll
        for (int i = 0; i < 4; ++i) { const int c = tid + i * 512, r = c >> 3, ch = c & 7; *(u32x4*)(sA + r * GLD + ch * 8) = ra[i]; }
#pragma unroll
        for (int i = 0; i < 2; ++i) { const int c = tid + i * 512, r = c >> 3, ch = c & 7; *(u32x4*)(sB + r * GLD + ch * 8) = rb[i]; }
        __syncthreads();
        if (kt + 1 < nk) {
#pragma unroll
            for (int i = 0; i < 4; ++i) ra[i] = ga[i][(kt + 1) * 8];
#pragma unroll
            for (int i = 0; i < 2; ++i) rb[i] = gb[i][(kt + 1) * 8];
        }
#pragma unroll
        for (int kk = 0; kk < 2; ++kk) {
            bf16x8 af[4], bfr[4];
#pragma unroll
            for (int m = 0; m < 4; ++m) af[m] = *(const bf16x8*)(sA + (wm * 64 + m * 16 + (lane & 15)) * GLD + kk * 32 + (lane >> 4) * 8);
#pragma unroll
            for (int n = 0; n < 4; ++n) bfr[n] = *(const bf16x8*)(sB + (wn * 64 + n * 16 + (lane & 15)) * GLD + kk * 32 + (lane >> 4) * 8);
#pragma unroll
            for (int m = 0; m < 4; ++m)
#pragma unroll
                for (int n = 0; n < 4; ++n) acc[m][n] = __builtin_amdgcn_mfma_f32_16x16x32_bf16(bfr[n], af[m], acc[m][n], 0, 0, 0);
        }
    }
}
struct RowDirect { const bf16_t* A; int lda; int m0; __device__ __forceinline__ const bf16_t* operator()(int r) const { return A + (size_t)(m0 + r) * lda; } };
enum { EPI_INPROJ = 0, EPI_RESID = 1, EPI_BF16 = 2, EPI_BF16_RS = 3 };

__device__ __forceinline__ int vcu_id() { const int G = gridDim.x, bx = blockIdx.x; return (G % 8 == 0) ? (bx % 8) * (G / 8) + bx / 8 : bx; }

template <int EPI>
__device__ __forceinline__ void gemm_phase(char* smem, const bf16_t* A, int lda, const bf16_t* Bt, int ldb, int M, int N, int K, void* out, int ldo, const float* resid, float* gates, int idx0 = -1, int stride = 0) {
    const int ntn = N / 128, ntiles = (M / 256) * ntn;
    if (stride == 0) { idx0 = vcu_id(); stride = gridDim.x; }
    if (idx0 < 0) return;
    const int lane = TIDX & 63, wave = TIDX >> 6, wm = wave >> 1, wn = wave & 1;
    for (int tIdx = idx0; tIdx < ntiles; tIdx += stride) {
        const int m0 = (tIdx / ntn) * 256, n0 = (tIdx % ntn) * 128;
        f32x4 acc[4][4];
        RowDirect rp{A, lda, m0};
        gemm_tile(smem, rp, Bt, ldb, n0, K, acc);
#pragma unroll
        for (int m = 0; m < 4; ++m)
#pragma unroll
            for (int n = 0; n < 4; ++n) {
                const int row = m0 + wm * 64 + m * 16 + (lane & 15), col = n0 + wn * 64 + n * 16 + (lane >> 4) * 4;
                const f32x4 v = acc[m][n];
                if (EPI == EPI_INPROJ) {
                    uint2 o; o.x = pk2(v.x, v.y); o.y = pk2(v.z, v.w);
                    *(uint2*)((bf16_t*)out + (size_t)row * ldo + col) = o;
                    if (col >= C_GATE && col < C_GATE + 16) *(f32x4*)(gates + (size_t)row * 16 + (col - C_GATE)) = v;
                } else if (EPI == EPI_RESID) {
                    const f32x4 r = *(const f32x4*)(resid + (size_t)row * ldo + col);
                    *(f32x4*)((float*)out + (size_t)row * ldo + col) = r + v;
                } else if (EPI == EPI_BF16_RS) {
                    const float ri = rinv_from_pss(resid, (size_t)row);
                    uint2 o; o.x = pk2(v.x * ri, v.y * ri); o.y = pk2(v.z * ri, v.w * ri);
                    *(uint2*)((bf16_t*)out + (size_t)row * ldo + col) = o;
                } else {
                    uint2 o; o.x = pk2(v.x, v.y); o.y = pk2(v.z, v.w);
                    *(uint2*)((bf16_t*)out + (size_t)row * ldo + col) = o;
                }
            }
    }
}


namespace pg8 {
#define PG8_LAS __attribute__((address_space(3)))
typedef unsigned short bf16_t;
typedef short bf16x8 __attribute__((ext_vector_type(8)));
typedef float f32x4 __attribute__((ext_vector_type(4)));
typedef unsigned u32x4 __attribute__((ext_vector_type(4)));
constexpr int BM = 256, BK = 64, HALF = 128, HTB = HALF * BK * 2  , STAGE_BYTES = 8 * HTB, NXCD = 8, WGM = 8;

__host__ __device__ __forceinline__ int lds_byte(int r, int c) { const int st = (r >> 4) * 2 + (c >> 5), rr = r & 15, cc = c & 31, ob = rr * 64 + cc * 2; return st * 1024 + (ob ^ (((ob >> 9) & 1) << 5)); }
__host__ __device__ __forceinline__ void stage_rc(int b, int& R, int& C) { const int st = b / 1024, sb = b % 1024, swz = sb ^ (((sb >> 9) & 1) << 5); R = (st >> 1) * 16 + swz / 64; C = (st & 1) * 32 + (swz % 64) / 2; }
__host__ __device__ __forceinline__ int perm32(int rho) { const int n = rho >> 4, i = rho & 15; return 8 * (i >> 2) + 4 * n + (i & 3); }

struct Unit { int pm, pn; };
struct Gemm { const bf16_t* A; const bf16_t* Bt; int M, N, K; };

struct StaticOrder {
    int nM, nN, nwg, G, c;
    __host__ __device__ void init(int M, int N, int G_, int c_) { nM = M / BM; nN = N / BM; nwg = nM * nN; G = G_; c = c_; }
    __host__ __device__ bool next(int i, Unit& u) const {
        const long L = (long)i * G + c; if (L >= nwg) return false;
        int wgid = (int)L; { const int q = nwg / NXCD, r = nwg % NXCD, xcd = wgid % NXCD, off = wgid / NXCD; wgid = (xcd < r ? xcd * (q + 1) : r * (q + 1) + (xcd - r) * q) + off; }
        const int nig = WGM * nN, gid = wgid / nig, fm = gid * WGM, gsz = (nM - fm) < WGM ? (nM - fm) : WGM;
        u.pm = fm + ((wgid % nig) % gsz); u.pn = (wgid % nig) / gsz; return true;
    }
    __device__ __forceinline__ void a_ready(const Unit&) const {}
    __device__ __forceinline__ void done(const Unit&) const {}
};
__device__ __forceinline__ unsigned cvt_pk_bf16(float lo, float hi) { unsigned r; asm volatile("v_cvt_pk_bf16_f32 %0, %1, %2" : "=v"(r) : "v"(lo), "v"(hi)); return r; }
typedef float f32x2 __attribute__((ext_vector_type(2)));

struct EpiInProj {
    static constexpr bool PERM = true, AFTER_DRAIN = false;
    bf16_t* O; int ldc; float* gates; int gate_col;
    __device__ __forceinline__ void operator()(const f32x4 (&acc)[2][2][4][2], const Unit& u, int wr, int wc, int fr, int fq) const {
        const int row0 = u.pm * BM + wr * 64 + fr, col0 = u.pn * BM + wc * 32 + 8 * fq;
#pragma unroll
        for (int ai = 0; ai < 2; ++ai)
#pragma unroll
            for (int m = 0; m < 4; ++m) {
                const int row = row0 + ai * HALF + m * 16;
                bf16_t* rowp = O + (size_t)row * ldc + col0;
#pragma unroll
                for (int bj = 0; bj < 2; ++bj) {
                    const f32x4 v0 = acc[ai][bj][m][0], v1 = acc[ai][bj][m][1];
                    u32x4 w; w.x = cvt_pk_bf16(v0[0], v0[1]); w.y = cvt_pk_bf16(v0[2], v0[3]); w.z = cvt_pk_bf16(v1[0], v1[1]); w.w = cvt_pk_bf16(v1[2], v1[3]);
                    *(u32x4*)(rowp + bj * HALF) = w;
                    const int gc = col0 + bj * HALF - gate_col;
                    if (gates && gc >= 0 && gc < 16) { *(f32x4*)(gates + (size_t)row * 16 + gc) = v0; *(f32x4*)(gates + (size_t)row * 16 + gc + 4) = v1; }
                }
            }
    }
};
struct EpiResid {
    static constexpr bool PERM = false, AFTER_DRAIN = false;
    const float* base; float* out; int ldc;
    __device__ __forceinline__ void operator()(const f32x4 (&acc)[2][2][4][2], const Unit& u, int wr, int wc, int fr, int fq) const {
        const int col0 = u.pn * BM + wc * 32 + 4 * fq;
#pragma unroll
        for (int ai = 0; ai < 2; ++ai)
#pragma unroll
            for (int m = 0; m < 4; ++m) {
                const size_t off = (size_t)(u.pm * BM + ai * HALF + wr * 64 + m * 16 + fr) * ldc + col0;
#pragma unroll
                for (int bj = 0; bj < 2; ++bj)
#pragma unroll
                    for (int n = 0; n < 2; ++n) { const f32x4 bs = *(const f32x4*)(base + off + bj * HALF + n * 16); *(f32x4*)(out + off + bj * HALF + n * 16) = bs + acc[ai][bj][m][n]; }
                if (m & 1) asm volatile("" ::: "memory");
            }
    }
};

struct EpiResidNorm {
    static constexpr bool PERM = false, AFTER_DRAIN = false;
    const float* base; float* out; int ldc; const float* gn; bf16_t* xg; float* pss;
    __device__ __forceinline__ void operator()(const f32x4 (&acc)[2][2][4][2], const Unit& u, int wr, int wc, int fr, int fq) const {
        const int col0 = u.pn * BM + wc * 32 + 4 * fq;
        f32x4 gv[2][2];
#pragma unroll
        for (int bj = 0; bj < 2; ++bj)
#pragma unroll
            for (int n = 0; n < 2; ++n) gv[bj][n] = *(const f32x4*)(gn + col0 + bj * HALF + n * 16);
#pragma unroll
        for (int ai = 0; ai < 2; ++ai)
#pragma unroll
            for (int m = 0; m < 4; ++m) {
                const int row = u.pm * BM + ai * HALF + wr * 64 + m * 16 + fr;
                const size_t off = (size_t)row * ldc + col0;
                float ss = 0.f;
#pragma unroll
                for (int bj = 0; bj < 2; ++bj)
#pragma unroll
                    for (int n = 0; n < 2; ++n) {
                        const f32x4 bs = *(const f32x4*)(base + off + bj * HALF + n * 16);
                        const f32x4 o = bs + acc[ai][bj][m][n];
                        *(f32x4*)(out + off + bj * HALF + n * 16) = o;
                        ss += (o[0] * o[0] + o[1] * o[1]) + (o[2] * o[2] + o[3] * o[3]);
                        const f32x4 og = o * gv[bj][n];
                        uint2 w; w.x = cvt_pk_bf16(og[0], og[1]); w.y = cvt_pk_bf16(og[2], og[3]);
                        *(uint2*)(xg + off + bj * HALF + n * 16) = w;
                    }
                ss += __shfl_xor(ss, 16); ss += __shfl_xor(ss, 32);
                if (fq == 0) pss[(size_t)row * 16 + u.pn * 4 + wc] = ss;
                if (m & 1) asm volatile("" ::: "memory");
            }
    }
};
template <class Epi, class Sched, bool ALIGN_EPI = false, bool SP2 = false>
__device__ __forceinline__ void gemm_phase(PG8_LAS unsigned char* lds, const Gemm g, const Sched& S, const Epi& E) {
    const int tid = TIDX, wid = __builtin_amdgcn_readfirstlane(tid >> 6), lane = tid & 63, wr = wid >> 2, wc = wid & 3, fr = lane & 15, fq = lane >> 4;
    const int K = g.K, nt = K / BK;
    unsigned voffA[2], voffB[2];
#pragma unroll
    for (int i = 0; i < 2; ++i) { int R, C; stage_rc(tid * 16 + i * 8192, R, C); const int Rb = Epi::PERM ? ((R & ~31) + perm32(R & 31)) : R;
        voffA[i] = (unsigned)(R * K + C) * 2u; voffB[i] = (unsigned)(Rb * K + C) * 2u; }
    const size_t kstep = (size_t)(BK * 2);
    const size_t hstep = (size_t)HALF * K * 2;
    const size_t tstep = 2 * hstep;
    const unsigned ldsw = (unsigned)wid * 1024u;
    const int aoff = lds_byte(wr * 64 + fr, fq * 8), boff = lds_byte(wc * 32 + fr, fq * 8);
#define PG8_SA(b, h) (((b) * 2 + (h)) * HTB)
#define PG8_SB(b, h) ((4 + (b) * 2 + (h)) * HTB)
#define PG8_STAGE(bufoff, gbase, voff) do { _Pragma("unroll") for (int _i = 0; _i < 2; ++_i) \
        __builtin_amdgcn_global_load_lds((const unsigned*)((const char*)(gbase) + (voff)[_i]), (PG8_LAS unsigned*)(lds + (bufoff) + ldsw + _i * 8192), 16, 0, 0); } while (0)
#define PG8_LDA(dst, b, h) do { _Pragma("unroll") for (int m = 0; m < 4; ++m) _Pragma("unroll") for (int k = 0; k < 2; ++k) dst[m][k] = *(const PG8_LAS bf16x8*)(lds + PG8_SA(b, h) + aoff + m * 2048 + k * 1024); } while (0)
#define PG8_LDB(dst, b, h) do { _Pragma("unroll") for (int n = 0; n < 2; ++n) _Pragma("unroll") for (int k = 0; k < 2; ++k) dst[n][k] = *(const PG8_LAS bf16x8*)(lds + PG8_SB(b, h) + boff + n * 2048 + k * 1024); } while (0)
#define PG8_MMA(ai, bj, At, Bt) do { __builtin_amdgcn_s_setprio(1); _Pragma("unroll") for (int m = 0; m < 4; ++m) _Pragma("unroll") for (int n = 0; n < 2; ++n) _Pragma("unroll") for (int k = 0; k < 2; ++k) \
        acc[ai][bj][m][n] = __builtin_amdgcn_mfma_f32_16x16x32_bf16(Bt[n][k], At[m][k], acc[ai][bj][m][n], 0, 0, 0); __builtin_amdgcn_s_setprio(0); } while (0)
#define PG8_WAIT_V(n) asm volatile("s_waitcnt vmcnt(" #n ")" ::: "memory")
#define PG8_WAIT_L(n) asm volatile("s_waitcnt lgkmcnt(" #n ")" ::: "memory")
#define PG8_BAR __builtin_amdgcn_s_barrier()
#define PG8_SCHED __builtin_amdgcn_sched_barrier(0)
    Unit cur, nxt; int ui = 0;
    if (!S.next(0, cur)) return;
    f32x4 acc[2][2][4][2];
#pragma unroll
    for (int a = 0; a < 2; ++a)
#pragma unroll
        for (int b = 0; b < 2; ++b)
#pragma unroll
            for (int m = 0; m < 4; ++m)
#pragma unroll
                for (int n = 0; n < 2; ++n) acc[a][b][m][n] = (f32x4){0.f, 0.f, 0.f, 0.f};
    bf16x8 At[4][2], B0[2][2], B1[2][2];
    const char* cA = (const char*)g.A + (size_t)cur.pm * tstep; const char* cB = (const char*)g.Bt + (size_t)cur.pn * tstep;
    S.a_ready(cur);
    if constexpr (SP2) {
        PG8_STAGE(PG8_SB(0, 0), cB, voffB); PG8_STAGE(PG8_SB(0, 1), cB + hstep, voffB); PG8_STAGE(PG8_SA(0, 0), cA, voffA); PG8_STAGE(PG8_SA(0, 1), cA + hstep, voffA);
        if (wr == 1) PG8_BAR;
        PG8_WAIT_V(2); PG8_BAR;
        PG8_STAGE(PG8_SB(1, 0), cB + kstep, voffB); PG8_STAGE(PG8_SA(1, 0), cA + kstep, voffA); PG8_STAGE(PG8_SB(1, 1), cB + hstep + kstep, voffB);
        PG8_WAIT_V(6); PG8_BAR;
    } else {
        PG8_STAGE(PG8_SB(0, 0), cB, voffB); PG8_STAGE(PG8_SA(0, 0), cA, voffA); PG8_STAGE(PG8_SB(0, 1), cB + hstep, voffB); PG8_STAGE(PG8_SA(0, 1), cA + hstep, voffA);
        if (wr == 1) PG8_BAR;
        PG8_WAIT_V(4); PG8_BAR;
        PG8_STAGE(PG8_SB(1, 0), cB + kstep, voffB); PG8_STAGE(PG8_SA(1, 0), cA + kstep, voffA); PG8_STAGE(PG8_SB(1, 1), cB + hstep + kstep, voffB);
        PG8_WAIT_V(6); PG8_BAR;
    }
    for (;;) {
        const bool has_next = S.next(ui + 1, nxt);
        const char* nA = has_next ? (const char*)g.A + (size_t)nxt.pm * tstep : cA; const char* nB = has_next ? (const char*)g.Bt + (size_t)nxt.pn * tstep : cB;
        for (int t = 0; t < nt; t += 2) {
            const bool last = (t == nt - 2);
            const char* a1 = cA + (size_t)(t + 1) * kstep;
            const char* a2 = last ? nA : cA + (size_t)(t + 2) * kstep; const char* b2 = last ? nB : cB + (size_t)(t + 2) * kstep;
            const char* a3 = a2 + kstep; const char* b3 = b2 + kstep;
            if (last && has_next) S.a_ready(nxt);
            if constexpr (SP2) {
            PG8_LDB(B0, 0, 0); PG8_LDB(B1, 0, 1); PG8_SCHED; PG8_LDA(At, 0, 0); PG8_STAGE(PG8_SA(1, 1), a1 + hstep, voffA);
            PG8_WAIT_V(8); PG8_WAIT_L(0); PG8_BAR; PG8_MMA(0, 0, At, B0); PG8_MMA(0, 1, At, B1); PG8_BAR; PG8_SCHED;
            PG8_LDA(At, 0, 1); PG8_STAGE(PG8_SB(0, 0), b2, voffB); PG8_STAGE(PG8_SB(0, 1), b2 + hstep, voffB); PG8_STAGE(PG8_SA(0, 0), a2, voffA);
            PG8_WAIT_V(8); PG8_WAIT_L(0); PG8_BAR; PG8_MMA(1, 0, At, B0); PG8_MMA(1, 1, At, B1); PG8_BAR; PG8_SCHED;
            PG8_LDB(B0, 1, 0); PG8_LDB(B1, 1, 1); PG8_SCHED; PG8_LDA(At, 1, 0); PG8_STAGE(PG8_SA(0, 1), a2 + hstep, voffA);
            PG8_WAIT_V(8); PG8_WAIT_L(0); PG8_BAR; PG8_MMA(0, 0, At, B0); PG8_MMA(0, 1, At, B1); PG8_BAR; PG8_SCHED;
            PG8_LDA(At, 1, 1); PG8_STAGE(PG8_SB(1, 0), b3, voffB); PG8_STAGE(PG8_SB(1, 1), b3 + hstep, voffB); PG8_STAGE(PG8_SA(1, 0), a3, voffA);
            PG8_WAIT_V(8); PG8_WAIT_L(0); PG8_BAR; PG8_MMA(1, 0, At, B0); PG8_MMA(1, 1, At, B1); PG8_BAR; PG8_SCHED;
            } else {
            PG8_LDB(B0, 0, 0); PG8_SCHED; PG8_LDA(At, 0, 0); PG8_STAGE(PG8_SA(1, 1), a1 + hstep, voffA);
            PG8_WAIT_L(8); PG8_BAR; PG8_WAIT_L(0); PG8_MMA(0, 0, At, B0); PG8_BAR; PG8_SCHED;
            PG8_LDB(B1, 0, 1); PG8_STAGE(PG8_SB(0, 0), b2, voffB);
            PG8_BAR; PG8_WAIT_L(0); PG8_MMA(0, 1, At, B1); PG8_BAR;
            PG8_LDA(At, 0, 1); PG8_STAGE(PG8_SA(0, 0), a2, voffA);
            PG8_BAR; PG8_WAIT_L(0); PG8_MMA(1, 0, At, B0); PG8_BAR; PG8_SCHED;
            PG8_STAGE(PG8_SB(0, 1), b2 + hstep, voffB);
            PG8_WAIT_V(6); PG8_BAR; PG8_MMA(1, 1, At, B1); PG8_BAR;
            PG8_LDB(B0, 1, 0); PG8_SCHED; PG8_LDA(At, 1, 0); PG8_STAGE(PG8_SA(0, 1), a2 + hstep, voffA);
            PG8_WAIT_L(8); PG8_BAR; PG8_WAIT_L(0); PG8_MMA(0, 0, At, B0); PG8_BAR; PG8_SCHED;
            PG8_LDB(B1, 1, 1); PG8_STAGE(PG8_SB(1, 0), b3, voffB);
            PG8_BAR; PG8_WAIT_L(0); PG8_MMA(0, 1, At, B1); PG8_BAR;
            PG8_LDA(At, 1, 1); PG8_STAGE(PG8_SA(1, 0), a3, voffA);
            PG8_BAR; PG8_WAIT_L(0); PG8_MMA(1, 0, At, B0); PG8_BAR; PG8_SCHED;
            PG8_STAGE(PG8_SB(1, 1), b3 + hstep, voffB);
            PG8_WAIT_V(6); PG8_BAR; PG8_MMA(1, 1, At, B1); PG8_BAR;
            }
        }
        if constexpr (ALIGN_EPI) { if (wr == 0) PG8_BAR; }
        if constexpr (!Epi::AFTER_DRAIN) { E(acc, cur, wr, wc, fr, fq); S.done(cur); }
        if (!has_next) break;
#pragma unroll
        for (int a = 0; a < 2; ++a)
#pragma unroll
            for (int b = 0; b < 2; ++b)
#pragma unroll
                for (int m = 0; m < 4; ++m)
#pragma unroll
                    for (int n = 0; n < 2; ++n) acc[a][b][m][n] = (f32x4){0.f, 0.f, 0.f, 0.f};
        cur = nxt; cA = nA; cB = nB; ++ui;
        if constexpr (ALIGN_EPI) { if (wr == 1) PG8_BAR; }
    }
    PG8_WAIT_V(0);
    if constexpr (!ALIGN_EPI) { if (wr == 0) PG8_BAR; }
    PG8_BAR;
    if constexpr (Epi::AFTER_DRAIN) { E.fused(acc, cur, wr, wc, fr, fq, lds, wid, lane); S.done(cur); }
#undef PG8_SA
#undef PG8_SB
#undef PG8_STAGE
#undef PG8_LDA
#undef PG8_LDB
#undef PG8_MMA
#undef PG8_WAIT_V
#undef PG8_WAIT_L
#undef PG8_BAR
#undef PG8_SCHED
}
}

struct RowGather { const bf16_t* A; int lda; const int* ids; int shift; __device__ __forceinline__ const bf16_t* operator()(int r) const { return A + (size_t)(ids[r] >> shift) * lda; } };
template <int STAGE>
__device__ __forceinline__ void moe_phase(char* smem, const bf16_t* A, int lda, const bf16_t* Wt, size_t wstride, int ldb, int K, const int* cnt, const int* list, const float* pgate, bf16_t* out, const float* pss) {
    int* ids = (int*)(smem + GEMM_LDS);
    int* tpre = ids + 256;
    constexpr int NTN = (STAGE == 1) ? 4 : 8;
    __syncthreads();
    if (TIDX == 0) { int a = 0; for (int i = 0; i < NEXP; ++i) { tpre[i] = a; a += (cnt[i] + 255) >> 8; } tpre[NEXP] = a; }
    __syncthreads();
    const int ntiles = tpre[NEXP] * NTN;
    const int lane = TIDX & 63, wave = TIDX >> 6, wm = wave >> 1, wn = wave & 1;
    for (int tIdx = vcu_id(); tIdx < ntiles; tIdx += gridDim.x) {
        const int mtg = tIdx / NTN, n0 = (tIdx % NTN) * 128;
        int e = 0;
        for (int i = 1; i < NEXP; ++i) if (tpre[i] <= mtg) e = i;
        const int mt = mtg - tpre[e];
        const int cn = cnt[e];
        __syncthreads();
        if (TIDX < 256) { const int pos = mt * 256 + TIDX; ids[TIDX] = list[(size_t)e * T + (pos < cn ? pos : cn - 1)]; }
        __syncthreads();
        f32x4 acc[4][4];
        RowGather rp{A, lda, ids, STAGE == 1 ? 1 : 0};
        gemm_tile(smem, rp, Wt + (size_t)e * wstride, ldb, n0, K, acc);
#pragma unroll
        for (int m = 0; m < 4; ++m) {
            const int rl = wm * 64 + m * 16 + (lane & 15);
            if (mt * 256 + rl >= cn) continue;
            const int pid = ids[rl];
            if (STAGE == 1) {
                const float gt = pgate[pid], ri = rinv_from_pss(pss, (size_t)(pid >> 1));
#pragma unroll
                for (int np = 0; np < 2; ++np) {
                    const f32x4 g = acc[m][2 * np], u = acc[m][2 * np + 1];
                    const int j = (n0 + wn * 64 + np * 32) / 2 + (lane >> 4) * 4;
                    const f32x4 gs = g * ri; const float ug = ri * gt;
                    uint2 o; o.x = pk2(siluf_(gs.x) * u.x * ug, siluf_(gs.y) * u.y * ug); o.y = pk2(siluf_(gs.z) * u.z * ug, siluf_(gs.w) * u.w * ug);
                    *(uint2*)(out + (size_t)pid * DEXP + j) = o;
                }
            } else {
#pragma unroll
                for (int n = 0; n < 4; ++n) {
                    const f32x4 v = acc[m][n]; const int col = n0 + wn * 64 + n * 16 + (lane >> 4) * 4;
                    uint2 o; o.x = pk2(v.x, v.y); o.y = pk2(v.z, v.w);
                    *(uint2*)(out + (size_t)pid * 1024 + col) = o;
                }
            }
        }
    }
}

__device__ __forceinline__ void hgrn2_naive(const bf16_t* __restrict__ proj, const float* __restrict__ hgrn_lb, int layer, const float* __restrict__ mix_gain, bf16_t* __restrict__ y, int bh, int lane) {
    const int b = bh >> 2, h = bh & 3;
    float lbk = 0.f;
    if (layer == 1) { float a0 = hgrn_lb[h * 64 + lane], a1 = hgrn_lb[256 + h * 64 + lane]; lbk = 1.f / (1.f + __expf(a0 - a1)); }
    const float mg = mix_gain[C_AQ + h * 64 + lane];
    float S[64];
#pragma unroll
    for (int k = 0; k < 64; ++k) S[k] = 0.f;
    for (int t = 0; t < SEQ; ++t) {
        const bf16_t* pr = proj + (size_t)(b * SEQ + t) * NP + h * 64 + lane;
        const float qk = siluf_(bf2f(pr[C_AQ]));
        const float sg = sigmoidf_(bf2f(pr[C_AF]));
        const float f = lbk + (1.f - lbk) * sg, kk = (1.f - lbk) * (1.f - sg);
        const float iv = bf2f(pr[C_AI]);
        const float gv = bf2f(pr[C_AG]);
        float o = 0.f;
#pragma unroll
        for (int k = 0; k < 64; ++k) { S[k] = rdlane(f, k) * S[k] + rdlane(kk, k) * iv; o += rdlane(qk, k) * S[k]; }
        const float ms = wave_sum(o * o) * (1.f / 64.f);
        const float yv = o * rsqrtf(ms + EPS) * siluf_(gv) * mg;
        y[(size_t)(b * SEQ + t) * 1024 + 0 + h * 64 + lane] = f2bf(yv);
    }
}
__device__ __forceinline__ void gdn_naive(const bf16_t* __restrict__ proj, const float* __restrict__ gates, const float* __restrict__ conv_w  ,
                                          const float* __restrict__ a_log, const float* __restrict__ dt_bias, const float* __restrict__ mix_gain, bf16_t* __restrict__ y, int bh, int lane) {
    const int b = bh >> 2, h = bh & 3;
    float wq[4], wk[4], wv[4];
#pragma unroll
    for (int j = 0; j < 4; ++j) { wq[j] = conv_w[j * 768 + h * 64 + lane]; wk[j] = conv_w[j * 768 + 256 + h * 64 + lane]; wv[j] = conv_w[j * 768 + 512 + h * 64 + lane]; }
    float xq[3] = {0.f, 0.f, 0.f}, xk[3] = {0.f, 0.f, 0.f}, xv[3] = {0.f, 0.f, 0.f};
    const float Aexp = __expf(a_log[h]), dtb = dt_bias[h];
    const float mg = mix_gain[768 + h * 64 + lane];
    float S[64];
#pragma unroll
    for (int k = 0; k < 64; ++k) S[k] = 0.f;
    for (int t = 0; t < SEQ; ++t) {
        const size_t row = (size_t)(b * SEQ + t);
        const bf16_t* pr = proj + row * NP + h * 64 + lane;
        const float q0 = bf2f(pr[C_DQ]), k0 = bf2f(pr[C_DK]), v0 = bf2f(pr[C_DV]), zv = bf2f(pr[C_DZ]);
        float q = siluf_(wq[0] * xq[0] + wq[1] * xq[1] + wq[2] * xq[2] + wq[3] * q0);
        float k = siluf_(wk[0] * xk[0] + wk[1] * xk[1] + wk[2] * xk[2] + wk[3] * k0);
        float v = siluf_(wv[0] * xv[0] + wv[1] * xv[1] + wv[2] * xv[2] + wv[3] * v0);
        xq[0] = xq[1]; xq[1] = xq[2]; xq[2] = q0; xk[0] = xk[1]; xk[1] = xk[2]; xk[2] = k0; xv[0] = xv[1]; xv[1] = xv[2]; xv[2] = v0;
        q = q * rsqrtf(wave_sum(q * q) + EPS) * 0.125f;
        k = k * rsqrtf(wave_sum(k * k) + EPS);
        const float beta = sigmoidf_(gates[row * 16 + 4 + h]);
        const float g = -Aexp * softplusf_(gates[row * 16 + 8 + h] + dtb);
        const float eg = __expf(g);
        float r = 0.f;
#pragma unroll
        for (int i = 0; i < 64; ++i) { S[i] *= eg; r += rdlane(k, i) * S[i]; }
        const float dlt = beta * (v - r);
        float o = 0.f;
#pragma unroll
        for (int i = 0; i < 64; ++i) { S[i] += rdlane(k, i) * dlt; o += rdlane(q, i) * S[i]; }
        const float ms = wave_sum(o * o) * (1.f / 64.f);
        const float yv = o * rsqrtf(ms + EPS) * siluf_(zv) * mg;
        y[row * 1024 + 768 + h * 64 + lane] = f2bf(yv);
    }
}
__device__ __forceinline__ void fox_cumsum(const float* __restrict__ gates, const float* __restrict__ fb, float* __restrict__ cc, int bh, int lane) {
    const int b = bh >> 2, h = bh & 3;
    const float bias = fb[h];
    float carry = 0.f;
    for (int t0 = 0; t0 < SEQ; t0 += 64) {
        float v = logsigmoidf_(gates[(size_t)(b * SEQ + t0 + lane) * 16 + h] + bias);
#pragma unroll
        for (int o = 1; o < 64; o <<= 1) { float n = __shfl_up(v, o); if (lane >= o) v += n; }
        v += carry;
        cc[(size_t)(b * 4 + h) * SEQ + t0 + lane] = v;
        carry = __shfl(v, 63);
    }
}
__device__ __forceinline__ void lru_prep_task(float* xc  , const bf16_t* __restrict__ proj, const float* __restrict__ conv_w, const float* __restrict__ conv_b,
                                              const float* __restrict__ w_a, const float* __restrict__ b_a, const float* __restrict__ w_x, const float* __restrict__ b_x,
                                              const float* __restrict__ lam, float* __restrict__ a_out, float* __restrict__ u_out, int task, bool active) {
    const int c = TIDX & 255, t0 = task * 16;
    if (active) {
        const float w0 = conv_w[c], w1 = conv_w[256 + c], w2 = conv_w[512 + c], w3 = conv_w[768 + c], cb = conv_b[c];
        for (int i = 0; i < 16; ++i) {
            const int t = t0 + i, s = t & (SEQ - 1);
            const bf16_t* pr = proj + (size_t)t * NP + C_CX + c;
            float acc = cb + w3 * bf2f(pr[0]);
            if (s >= 1) acc += w2 * bf2f(pr[-(ptrdiff_t)NP]);
            if (s >= 2) acc += w1 * bf2f(pr[-(ptrdiff_t)2 * NP]);
            if (s >= 3) acc += w0 * bf2f(pr[-(ptrdiff_t)3 * NP]);
            xc[i * 256 + c] = acc;
        }
    }
    __syncthreads();
    if (active) {
        const int h = c >> 6, jj = c & 63;
        float ra[16], rx[16];
#pragma unroll
        for (int i = 0; i < 16; ++i) { ra[i] = 0.f; rx[i] = 0.f; }
        for (int k = 0; k < 64; ++k) {
            const float wa = w_a[(h * 64 + k) * 64 + jj], wx = w_x[(h * 64 + k) * 64 + jj];
#pragma unroll
            for (int i = 0; i < 16; ++i) { const float xv = xc[i * 256 + h * 64 + k]; ra[i] += xv * wa; rx[i] += xv * wx; }
        }
        const float ba = b_a[c], bx = b_x[c], sp = softplusf_(-lam[c]);
#pragma unroll
        for (int i = 0; i < 16; ++i) {
            const float r = sigmoidf_(ra[i] + ba), ig = sigmoidf_(rx[i] + bx);
            const float log_a = -8.f * r * sp;
            const float a = __expf(log_a);
            const float u = sqrtf(-expm1f(2.f * log_a)) * (ig * xc[i * 256 + c]);
            a_out[(size_t)(t0 + i) * 256 + c] = a; u_out[(size_t)(t0 + i) * 256 + c] = u;
        }
    }
    __syncthreads();
}
__device__ __forceinline__ void lru_scan_task(const float* __restrict__ a_in, const float* __restrict__ u_in, const bf16_t* __restrict__ proj, const float* __restrict__ mix_gain, bf16_t* __restrict__ y, int b) {
    const int c = TIDX;
    const float mg = mix_gain[512 + c];
    float hst = 0.f;
    for (int t = 0; t < SEQ; ++t) {
        const size_t row = (size_t)(b * SEQ + t);
        hst = a_in[row * 256 + c] * hst + u_in[row * 256 + c];
        const float yv = hst * geluf_(bf2f(proj[row * NP + C_CG + c]));
        const float ms = wave_sum(yv * yv) * (1.f / 64.f);
        y[row * 1024 + 512 + c] = f2bf(yv * rsqrtf(ms + EPS) * mg);
    }
}

typedef short s16x4 __attribute__((ext_vector_type(4)));
#define LDS_AS __attribute__((address_space(3)))
__device__ __forceinline__ bf16x8 frag_rm(const bf16_t* tile, int ld, int r0, int k0, int lane) { return *(const bf16x8*)(tile + (r0 + (lane & 15)) * ld + k0 + (lane >> 4) * 8); }
__device__ __forceinline__ s16x4 tr4(const bf16_t* tile, int ld, int rbase, int c0, int lane) {
    const bf16_t* p = tile + (rbase + ((lane & 15) >> 2)) * ld + c0 + 4 * (lane & 3);
    return __builtin_amdgcn_ds_read_tr16_b64_v4i16((LDS_AS s16x4*)p);
}
__device__ __forceinline__ bf16x8 frag_cm(const bf16_t* tile, int ld, int k0, int c0, int lane) {
    const s16x4 lo = tr4(tile, ld, k0 + (lane >> 4) * 8, c0, lane), hi = tr4(tile, ld, k0 + (lane >> 4) * 8 + 4, c0, lane);
    return (bf16x8){lo[0], lo[1], lo[2], lo[3], hi[0], hi[1], hi[2], hi[3]};
}
#define MFMA16(a, b, c) __builtin_amdgcn_mfma_f32_16x16x32_bf16((a), (b), (c), 0, 0, 0)
constexpr int TLD = 72;


#define XB_TMO      128
#define XB_XCNT(j)  (256  + 64 * (j))
#define XB_XSUB(j)  (1280 + 64 * (j))
#define XB_XGEN(j)  (2304 + 64 * (j))
#define XB_TOP      3328
#define XB_TOPGEN   3392
#define XCD_BAR_WORDS 3456
#define XB_SPIN_CAP (1u << 18)
__device__ __forceinline__ unsigned xb_ld(unsigned* p)              { return __hip_atomic_load(p, __ATOMIC_RELAXED, __HIP_MEMORY_SCOPE_AGENT); }
__device__ __forceinline__ unsigned xb_add(unsigned* p, unsigned v) { return __hip_atomic_fetch_add(p, v, __ATOMIC_RELAXED, __HIP_MEMORY_SCOPE_AGENT); }
__device__ __forceinline__ unsigned xb_xcc_id() { return (unsigned)__builtin_amdgcn_s_getreg((3 << 11) | 20) & 0xFu; }
#define XB_SPIN(cond, bar) do { unsigned _sp = 0; while (cond) { __builtin_amdgcn_s_sleep(1); \
    if ((++_sp & 255u) == 0u) { if (xb_ld(&(bar)[XB_TMO])) break; if (_sp > XB_SPIN_CAP) { atomicAdd(&(bar)[XB_TMO], 1u); break; } } } } while (0)
struct XcdBarrier { unsigned* bar; unsigned x; volatile LDS_AS unsigned* st; };
__device__ __forceinline__ XcdBarrier xcd_barrier_post(unsigned* bar, volatile LDS_AS unsigned* st) {
    XcdBarrier b; b.bar = bar; b.x = xb_xcc_id(); b.st = st;
    if (TIDX == 0) (void)xb_add(&bar[XB_XCNT(b.x)], 1u);
    return b;
}
__device__ __forceinline__ void xcd_barrier_complete(unsigned* bar, unsigned x, unsigned& nloc, unsigned& nx) {
    const unsigned G = gridDim.x * gridDim.y * gridDim.z;
    unsigned sum, cnt, mine, sp = 0u;
    for (;;) {
        sum = 0u; cnt = 0u; mine = 0u;
#pragma unroll
        for (unsigned j = 0; j < 16; ++j) { const unsigned c = xb_ld(&bar[XB_XCNT(j)]); sum += c; cnt += (c > 0u) ? 1u : 0u; mine = (j == x) ? c : mine; }
        if (sum == G) break;
        __builtin_amdgcn_s_sleep(1);
        if ((++sp & 255u) == 0u) { if (xb_ld(&bar[XB_TMO])) break; if (sp > XB_SPIN_CAP) { atomicAdd(&bar[XB_TMO], 1u); break; } }
    }
    nloc = mine > 0u ? mine : 1u; nx = cnt > 0u ? cnt : 1u;
}
__device__ __forceinline__ void xcd_barrier(const XcdBarrier& b) {
    asm volatile("s_waitcnt vmcnt(0)" ::: "memory");
    __syncthreads();
    if (TIDX == 0) {
        unsigned* bar = b.bar;
        __builtin_amdgcn_s_waitcnt(0);
        unsigned nloc = b.st[0], nx = b.st[1];
        if (nloc == 0u) { xcd_barrier_complete(bar, b.x, nloc, nx); b.st[0] = nloc; b.st[1] = nx; }
        const unsigned old = xb_add(&bar[XB_XSUB(b.x)], 1u);
        const unsigned gen = old / nloc;
        if (old + 1u == (gen + 1u) * nloc) {
            __builtin_amdgcn_fence(__ATOMIC_RELEASE, "agent");
            asm volatile("s_waitcnt vmcnt(0)" ::: "memory");
            const unsigned og = xb_add(&bar[XB_TOP], 1u);
            const unsigned tg = og / nx;
            if (og + 1u == (tg + 1u) * nx) xb_add(&bar[XB_TOPGEN], 1u);
            else XB_SPIN(xb_ld(&bar[XB_TOPGEN]) == tg, bar);
            __builtin_amdgcn_fence(__ATOMIC_ACQUIRE, "agent");
            xb_add(&bar[XB_XGEN(b.x)], 1u);
            asm volatile("s_waitcnt vmcnt(0)" ::: "memory");
        } else {
            XB_SPIN(xb_ld(&bar[XB_XGEN(b.x)]) == gen, bar);
            __builtin_amdgcn_fence(__ATOMIC_ACQUIRE, "agent");
            asm volatile("s_waitcnt vmcnt(0)" ::: "memory");
        }
    }
    __syncthreads();
}

template <bool MASK>
__device__ __forceinline__ void attn_compute_t(const bf16_t* cK, const bf16_t* cV, const float* cC, const bf16x8 (&qf)[2], f32x4 (&oacc)[4], float& mrun, float& lrun,
                                               float ct2, float scale2, int kt, int tq, int lane, int g) {
    f32x4 sacc[4];
#pragma unroll
    for (int n = 0; n < 4; ++n) {
        sacc[n] = (f32x4){0.f, 0.f, 0.f, 0.f};
#pragma unroll
        for (int kk = 0; kk < 2; ++kk) sacc[n] = MFMA16(frag_rm(cK, TLD, n * 16, kk * 32, lane), qf[kk], sacc[n]);
    }
    float mx = -INFINITY;
#pragma unroll
    for (int n = 0; n < 4; ++n) {
        const f32x4 cs = *(const f32x4*)(cC + n * 16 + 4 * g);
#pragma unroll
        for (int r = 0; r < 4; ++r) {
            float v = sacc[n][r] * scale2 + (ct2 - cs[r]);
            if (MASK) { if (kt * 64 + n * 16 + 4 * g + r > tq) v = -INFINITY; }
            sacc[n][r] = v; mx = fmaxf(mx, v);
        }
    }
    mx = fmaxf(mx, __shfl_xor(mx, 16)); mx = fmaxf(mx, __shfl_xor(mx, 32));
    const float mnew = fmaxf(mrun, mx);
    const float corr = __builtin_amdgcn_exp2f(mrun - mnew);
    float rs = 0.f;
#pragma unroll
    for (int n = 0; n < 4; ++n)
#pragma unroll
        for (int r = 0; r < 4; ++r) { const float p = __builtin_amdgcn_exp2f(sacc[n][r] - mnew); sacc[n][r] = p; rs += p; }
    rs += __shfl_xor(rs, 16); rs += __shfl_xor(rs, 32);
    lrun = lrun * corr + rs; mrun = mnew;
    bf16x8 pf[2];
#pragma unroll
    for (int kk = 0; kk < 2; ++kk) {
        const u32x4 pk = (u32x4){pk2(sacc[2 * kk][0], sacc[2 * kk][1]), pk2(sacc[2 * kk][2], sacc[2 * kk][3]), pk2(sacc[2 * kk + 1][0], sacc[2 * kk + 1][1]), pk2(sacc[2 * kk + 1][2], sacc[2 * kk + 1][3])};
        pf[kk] = __builtin_bit_cast(bf16x8, pk);
    }
#pragma unroll
    for (int n2 = 0; n2 < 4; ++n2) {
        oacc[n2] = oacc[n2] * corr;
#pragma unroll
        for (int kk = 0; kk < 2; ++kk) {
            const s16x4 lo = tr4(cV, TLD, (2 * kk) * 16 + 4 * g, n2 * 16, lane), hi = tr4(cV, TLD, (2 * kk + 1) * 16 + 4 * g, n2 * 16, lane);
            const bf16x8 vf = (bf16x8){lo[0], lo[1], lo[2], lo[3], hi[0], hi[1], hi[2], hi[3]};
            oacc[n2] = MFMA16(vf, pf[kk], oacc[n2]);
        }
    }
}
__device__ __forceinline__ void attn_compute(const bf16_t* cK, const bf16_t* cV, const float* cC, const bf16x8 (&qf)[2], f32x4 (&oacc)[4], float& mrun, float& lrun,
                                             float ct2, float scale2, int causal, int kt, int q0, int tq, int wave, int lane, int g) {
    const int r0 = q0 + wave * 16;
    if (causal && (kt * 64 > r0 + 15)) return;
    if (causal && (kt * 64 + 63 > r0)) attn_compute_t<true>(cK, cV, cC, qf, oacc, mrun, lrun, ct2, scale2, kt, tq, lane, g);
    else attn_compute_t<false>(cK, cV, cC, qf, oacc, mrun, lrun, ct2, scale2, kt, tq, lane, g);
}

__device__ __forceinline__ void attn_task(char* smem, const bf16_t* __restrict__ Q, int ldq, const bf16_t* __restrict__ Kp, int ldk, const bf16_t* __restrict__ Vp, int ldv, const float* __restrict__ bias,
                                          int nq_per_b, int nk_per_b, int causal, float scale, bf16_t* __restrict__ O, int ldo, const float* __restrict__ gain, int rms, int task) {
    bf16_t* sK = (bf16_t*)smem;
    bf16_t* sV = sK + 2 * 64 * TLD;
    float* sC = (float*)(sV + 2 * 64 * TLD);
    const int tid = TIDX, lane = tid & 63, wave = tid >> 6, g = lane >> 4, li = lane & 15;
    const int nqt = nq_per_b / 128;
    const int qt = task % nqt, h = (task / nqt) & 3, b = task / (nqt * 4);
    const int q0 = qt * 128, tq = q0 + wave * 16 + li;
    const size_t qrow = (size_t)b * nq_per_b + tq;
    bf16x8 qf[2];
#pragma unroll
    for (int kk = 0; kk < 2; ++kk) qf[kk] = *(const bf16x8*)(Q + qrow * ldq + h * 64 + kk * 32 + g * 8);
    constexpr float LOG2E = 1.4426950408889634f;
    const float ct = bias ? bias[(size_t)(b * 4 + h) * nq_per_b + tq] * LOG2E : 0.f;
    const float scale2 = scale * LOG2E;
    const int nkt = causal ? (q0 + 128) / 64 : nk_per_b / 64;
    const int sr = tid >> 3, sc = tid & 7;
    const bf16_t* kg = Kp + ((size_t)b * nk_per_b + sr) * ldk + h * 64 + sc * 8;
    const bf16_t* vg = Vp + ((size_t)b * nk_per_b + sr) * ldv + h * 64 + sc * 8;
    const float* cg_ = bias ? bias + (size_t)(b * 4 + h) * nk_per_b : nullptr;
    u32x4 rkA, rvA, rkB, rvB; float rcA = 0.f, rcB = 0.f;
    {   const u32x4 rk = *(const u32x4*)kg, rv = *(const u32x4*)vg; const float rc = (cg_ && tid < 64) ? cg_[tid] * LOG2E : 0.f;
        __syncthreads();
        *(u32x4*)(sK + sr * TLD + sc * 8) = rk; *(u32x4*)(sV + sr * TLD + sc * 8) = rv; if (tid < 64) sC[tid] = rc; }
    rkA = *(const u32x4*)(kg + (size_t)64 * ldk); rvA = *(const u32x4*)(vg + (size_t)64 * ldv); rcA = (cg_ && tid < 64) ? cg_[64 + tid] * LOG2E : 0.f;
    __syncthreads();
    f32x4 oacc[4];
#pragma unroll
    for (int n = 0; n < 4; ++n) oacc[n] = (f32x4){0.f, 0.f, 0.f, 0.f};
    float mrun = -INFINITY, lrun = 0.f;
#define ATTN_ITER(kt, LK, LV, LC, WK, WV, WC) { \
        const int buf = (kt) & 1; \
        if ((kt) + 2 < nkt) { LK = *(const u32x4*)(kg + (size_t)((kt) + 2) * 64 * ldk); LV = *(const u32x4*)(vg + (size_t)((kt) + 2) * 64 * ldv); LC = (cg_ && tid < 64) ? cg_[((kt) + 2) * 64 + tid] * LOG2E : 0.f; } \
        attn_compute(sK + buf * 64 * TLD, sV + buf * 64 * TLD, sC + buf * 64, qf, oacc, mrun, lrun, ct, scale2, causal, (kt), q0, tq, wave, lane, g); \
        if ((kt) + 1 < nkt) { const int nb = buf ^ 1; *(u32x4*)(sK + nb * 64 * TLD + sr * TLD + sc * 8) = WK; *(u32x4*)(sV + nb * 64 * TLD + sr * TLD + sc * 8) = WV; if (tid < 64) sC[nb * 64 + tid] = WC; } \
        __syncthreads(); }
    for (int kt = 0; kt < nkt; kt += 2) {
        ATTN_ITER(kt, rkB, rvB, rcB, rkA, rvA, rcA)
        ATTN_ITER(kt + 1, rkA, rvA, rcA, rkB, rvB, rcB)
    }
#undef ATTN_ITER
    const float inv = 1.f / lrun;
    float ms = 0.f;
#pragma unroll
    for (int n = 0; n < 4; ++n) { oacc[n] = oacc[n] * inv; ms += oacc[n][0] * oacc[n][0] + oacc[n][1] * oacc[n][1] + oacc[n][2] * oacc[n][2] + oacc[n][3] * oacc[n][3]; }
    ms += __shfl_xor(ms, 16); ms += __shfl_xor(ms, 32);
    const float rinv = rms ? rsqrtf(ms * (1.f / 64.f) + EPS) : 1.f;
#pragma unroll
    for (int n = 0; n < 4; ++n) {
        const int d = n * 16 + 4 * g;
        f32x4 gg = (f32x4){1.f, 1.f, 1.f, 1.f};
        if (gain) gg = *(const f32x4*)(gain + h * 64 + d);
        uint2 o; o.x = pk2(oacc[n][0] * rinv * gg[0], oacc[n][1] * rinv * gg[1]); o.y = pk2(oacc[n][2] * rinv * gg[2], oacc[n][3] * rinv * gg[3]);
        *(uint2*)(O + qrow * ldo + h * 64 + d) = o;
    }
}


__device__ __forceinline__ void hgrn_scan(float* LF  , float* SEGT  , const bf16_t* __restrict__ prow  , const float* __restrict__ hgrn_lb, int layer, int h, float (&kk)[8]) {
    const int tid = TIDX, t = tid >> 3, k8 = (tid & 7) * 8;
    const u32x4 raw = *(const u32x4*)(prow + (size_t)t * NP + C_AF + k8);
#pragma unroll
    for (int j = 0; j < 8; ++j) {
        const float fl = __uint_as_float((j & 1) ? (raw[j >> 1] & 0xffff0000u) : (raw[j >> 1] << 16));
        float lbk = 0.f;
        if (layer == 1) { const float a0 = hgrn_lb[h * 64 + k8 + j], a1 = hgrn_lb[256 + h * 64 + k8 + j]; lbk = 1.f / (1.f + __expf(a0 - a1)); }
        const float sg = sigmoidf_(fl);
        const float f = lbk + (1.f - lbk) * sg;
        kk[j] = (1.f - lbk) * (1.f - sg);
        LF[t * 65 + k8 + j] = __logf(f);
    }
    __syncthreads();
    { const int k = tid & 63, seg = tid >> 6; float run = 0.f;
#pragma unroll
      for (int i = 0; i < 8; ++i) { run += LF[(seg * 8 + i) * 65 + k]; LF[(seg * 8 + i) * 65 + k] = run; }
      SEGT[seg * 64 + k] = run; }
    __syncthreads();
    { const int k = tid & 63, seg = tid >> 6; float off = 0.f;
      for (int s2 = 0; s2 < seg; ++s2) off += SEGT[s2 * 64 + k];
#pragma unroll
      for (int i = 0; i < 8; ++i) LF[(seg * 8 + i) * 65 + k] += off; }
    __syncthreads();
}
__device__ __forceinline__ float bfx(const u32x4& raw, int j) { return __uint_as_float((j & 1) ? (raw[j >> 1] & 0xffff0000u) : (raw[j >> 1] << 16)); }

__device__ __forceinline__ void hgrn_local_task(char* smem, const bf16_t* __restrict__ proj, const float* __restrict__ hgrn_lb, int layer, float* __restrict__ HL, float* __restrict__ HD, int ch) {
    float* LF = (float*)smem; float* SEGT = LF + 64 * 65;
    bf16_t* sKd = (bf16_t*)(SEGT + 8 * 64); bf16_t* sV = sKd + 64 * TLD;
    const int tid = TIDX, lane = tid & 63, wave = tid >> 6, g = lane >> 4, li = lane & 15;
    const int bh = ch >> 5, n = ch & 31, b = bh >> 2, h = bh & 3;
    const bf16_t* prow = proj + (size_t)(b * SEQ + n * 64) * NP + h * 64;
    const int t = tid >> 3, k8 = (tid & 7) * 8;
    __syncthreads();
    *(u32x4*)(sV + t * TLD + k8) = *(const u32x4*)(prow + (size_t)t * NP + C_AI + k8);
    float kk[8];
    hgrn_scan(LF, SEGT, prow, hgrn_lb, layer, h, kk);
    { u32x4 o;
#pragma unroll
      for (int j = 0; j < 8; j += 2) {
          const float e0 = kk[j] * __expf(LF[63 * 65 + k8 + j] - LF[t * 65 + k8 + j]), e1 = kk[j + 1] * __expf(LF[63 * 65 + k8 + j + 1] - LF[t * 65 + k8 + j + 1]);
          o[j >> 1] = pk2(e0, e1);
      }
      *(u32x4*)(sKd + t * TLD + k8) = o; }
    if (tid < 64) HD[(size_t)ch * 64 + tid] = __expf(LF[63 * 65 + tid]);
    __syncthreads();
#pragma unroll
    for (int i = 0; i < 2; ++i) {
        const int idx = wave * 2 + i, vt = idx >> 2, kt = idx & 3;
        f32x4 acc = (f32x4){0.f, 0.f, 0.f, 0.f};
#pragma unroll
        for (int ks = 0; ks < 2; ++ks) acc = MFMA16(frag_cm(sV, TLD, ks * 32, vt * 16, lane), frag_cm(sKd, TLD, ks * 32, kt * 16, lane), acc);
        *(f32x4*)(HL + (size_t)ch * 4096 + (kt * 16 + li) * 64 + vt * 16 + 4 * g) = acc;
    }
}

__device__ __forceinline__ void hgrn_out_task(char* smem, const bf16_t* __restrict__ proj, const float* __restrict__ hgrn_lb, int layer, const bf16_t* __restrict__ HS,
                                              const float* __restrict__ mix_gain, bf16_t* __restrict__ y, int ch) {
    float* LF = (float*)smem; float* SEGT = LF + 64 * 65; float* sMS = SEGT + 8 * 64;
    bf16_t* sST = (bf16_t*)(sMS + 128); bf16_t* sQ0 = sST + 64 * TLD; bf16_t* sQm = sQ0 + 64 * TLD; bf16_t* sKm = sQm + 64 * TLD; bf16_t* sV = sKm + 64 * TLD; bf16_t* sA = sV + 64 * TLD;
    const int tid = TIDX, lane = tid & 63, wave = tid >> 6, g = lane >> 4, li = lane & 15;
    const int bh = ch >> 5, n = ch & 31, b = bh >> 2, h = bh & 3;
    const bf16_t* prow = proj + (size_t)(b * SEQ + n * 64) * NP + h * 64;
    const int t = tid >> 3, k8 = (tid & 7) * 8;
    __syncthreads();
    *(u32x4*)(sST + t * TLD + k8) = *(const u32x4*)(HS + (size_t)ch * 4096 + t * 64 + k8);
    const u32x4 qraw = *(const u32x4*)(prow + (size_t)t * NP + C_AQ + k8);
    *(u32x4*)(sV + t * TLD + k8) = *(const u32x4*)(prow + (size_t)t * NP + C_AI + k8);
    float kk[8];
    hgrn_scan(LF, SEGT, prow, hgrn_lb, layer, h, kk);
    { u32x4 o0, om, ok;
#pragma unroll
      for (int j = 0; j < 8; j += 2) {
          float q0v[2], qmv[2], kmv[2];
#pragma unroll
          for (int e = 0; e < 2; ++e) {
              const float bt = LF[t * 65 + k8 + j + e], r = LF[31 * 65 + k8 + j + e], q = siluf_(bfx(qraw, j + e));
              q0v[e] = q * __expf(bt); qmv[e] = q * __expf(bt - r); kmv[e] = kk[j + e] * __expf(r - bt);
          }
          o0[j >> 1] = pk2(q0v[0], q0v[1]); om[j >> 1] = pk2(qmv[0], qmv[1]); ok[j >> 1] = pk2(kmv[0], kmv[1]);
      }
      *(u32x4*)(sQ0 + t * TLD + k8) = o0; *(u32x4*)(sQm + t * TLD + k8) = om; *(u32x4*)(sKm + t * TLD + k8) = ok; }
    __syncthreads();
#pragma unroll
    for (int i = 0; i < 2; ++i) {
        const int idx = wave * 2 + i, tt = idx >> 2, st = idx & 3;
        f32x4 acc = (f32x4){0.f, 0.f, 0.f, 0.f};
#pragma unroll
        for (int ks = 0; ks < 2; ++ks) acc = MFMA16(frag_rm(sKm, TLD, st * 16, ks * 32, lane), frag_rm(sQm, TLD, tt * 16, ks * 32, lane), acc);
        const int tq = tt * 16 + li, s0 = st * 16 + 4 * g;
        uint2 o; o.x = pk2(s0 <= tq ? acc[0] : 0.f, s0 + 1 <= tq ? acc[1] : 0.f); o.y = pk2(s0 + 2 <= tq ? acc[2] : 0.f, s0 + 3 <= tq ? acc[3] : 0.f);
        *(uint2*)(sA + tq * TLD + s0) = o;
    }
    __syncthreads();
    { const int tt = wave >> 1;
      f32x4 oacc[2]; float ms = 0.f;
#pragma unroll
      for (int i = 0; i < 2; ++i) {
          const int vt = (wave & 1) * 2 + i;
          f32x4 acc = (f32x4){0.f, 0.f, 0.f, 0.f};
#pragma unroll
          for (int ks = 0; ks < 2; ++ks) acc = MFMA16(frag_cm(sST, TLD, ks * 32, vt * 16, lane), frag_rm(sQ0, TLD, tt * 16, ks * 32, lane), acc);
#pragma unroll
          for (int ks = 0; ks < 2; ++ks) acc = MFMA16(frag_cm(sV, TLD, ks * 32, vt * 16, lane), frag_rm(sA, TLD, tt * 16, ks * 32, lane), acc);
          oacc[i] = acc; ms += acc[0] * acc[0] + acc[1] * acc[1] + acc[2] * acc[2] + acc[3] * acc[3];
      }
      ms += __shfl_xor(ms, 16); ms += __shfl_xor(ms, 32);
      if (g == 0) sMS[(tt * 16 + li) * 2 + (wave & 1)] = ms;
      __syncthreads();
      const int tq = tt * 16 + li;
      const float rinv = rsqrtf((sMS[tq * 2] + sMS[tq * 2 + 1]) * (1.f / 64.f) + EPS);
      const size_t row = (size_t)(b * SEQ + n * 64 + tq);
#pragma unroll
      for (int i = 0; i < 2; ++i) {
          const int v0 = ((wave & 1) * 2 + i) * 16 + 4 * g;
          const uint2 graw = *(const uint2*)(proj + row * NP + C_AG + h * 64 + v0);
          const f32x4 mgv = *(const f32x4*)(mix_gain + C_AQ + h * 64 + v0);
          const float g0 = __uint_as_float(graw.x << 16), g1 = __uint_as_float(graw.x & 0xffff0000u), g2 = __uint_as_float(graw.y << 16), g3 = __uint_as_float(graw.y & 0xffff0000u);
          uint2 o; o.x = pk2(oacc[i][0] * rinv * siluf_(g0) * mgv[0], oacc[i][1] * rinv * siluf_(g1) * mgv[1]);
          o.y = pk2(oacc[i][2] * rinv * siluf_(g2) * mgv[2], oacc[i][3] * rinv * siluf_(g3) * mgv[3]);
          *(uint2*)(y + row * 1024 + h * 64 + v0) = o;
      }
    }
}


__device__ __forceinline__ void gdn_prep_task(char* smem, const bf16_t* __restrict__ proj, const float* __restrict__ gates, const float* __restrict__ conv_w  ,
                                              const float* __restrict__ a_log, const float* __restrict__ dt_bias, bf16_t* __restrict__ gt_all, float* __restrict__ glast, int ch) {
    float* sG = (float*)smem; float* sBeta = sG + 64;
    float* RHS = sBeta + 64;
    float* sM = RHS + 64 * 132;
    bf16_t* sK = (bf16_t*)(sM + 64 * 68); bf16_t* sQ = sK + 64 * TLD;
    const int tid = TIDX, lane = tid & 63, wave = tid >> 6, g = lane >> 4, li = lane & 15;
    const int bh = ch >> 5, n = ch & 31, b = bh >> 2, h = bh & 3;
    const int t = tid >> 3, d8 = (tid & 7) * 8;
    const size_t row0 = (size_t)(b * SEQ + n * 64);
    bf16_t* gt = gt_all + (size_t)ch * 5 * 4096;
    __syncthreads();
    float qn[8], kn[8], vv[8];
    {
        const int spos = n * 64 + t;
#pragma unroll
        for (int sec = 0; sec < 3; ++sec) {
            const int col = (sec == 0 ? C_DQ : (sec == 1 ? C_DK : C_DV)) + h * 64 + d8;
            float acc[8];
#pragma unroll
            for (int e = 0; e < 8; ++e) acc[e] = 0.f;
#pragma unroll
            for (int j = 0; j < 4; ++j) {
                if (spos - (3 - j) >= 0) {
                    const u32x4 raw = *(const u32x4*)(proj + (row0 + t - (3 - j)) * NP + col);
                    const f32x4 w0 = *(const f32x4*)(conv_w + j * 768 + sec * 256 + h * 64 + d8), w1 = *(const f32x4*)(conv_w + j * 768 + sec * 256 + h * 64 + d8 + 4);
#pragma unroll
                    for (int e = 0; e < 8; ++e) acc[e] += (e < 4 ? w0[e] : w1[e - 4]) * bfx(raw, e);
                }
            }
#pragma unroll
            for (int e = 0; e < 8; ++e) { const float sv = siluf_(acc[e]); if (sec == 0) qn[e] = sv; else if (sec == 1) kn[e] = sv; else vv[e] = sv; }
        }
        float sq = 0.f, sk = 0.f;
#pragma unroll
        for (int e = 0; e < 8; ++e) { sq += qn[e] * qn[e]; sk += kn[e] * kn[e]; }
        sq += __shfl_xor(sq, 1); sq += __shfl_xor(sq, 2); sq += __shfl_xor(sq, 4);
        sk += __shfl_xor(sk, 1); sk += __shfl_xor(sk, 2); sk += __shfl_xor(sk, 4);
        const float rq = rsqrtf(sq + EPS) * 0.125f, rk = rsqrtf(sk + EPS);
#pragma unroll
        for (int e = 0; e < 8; ++e) { qn[e] *= rq; kn[e] *= rk; }
    }
    if ((tid & 7) == 0) {
        const float* gr = gates + (row0 + t) * 16;
        sBeta[t] = sigmoidf_(gr[4 + h]);
        sG[t] = -__expf(a_log[h]) * softplusf_(gr[8 + h] + dt_bias[h]);
    }
    __syncthreads();
    if (wave == 0) {
        float v = sG[lane];
#pragma unroll
        for (int o = 1; o < 64; o <<= 1) { const float nb = __shfl_up(v, o); if (lane >= o) v += nb; }
        sG[lane] = v;
    }
    __syncthreads();
    {
        const float Gt = sG[t], Gl = sG[63], bt = sBeta[t];
        const float eG = __expf(Gt), eD = __expf(Gl - Gt);
        u32x4 ok, oq, oqd, okd;
#pragma unroll
        for (int e = 0; e < 8; e += 2) {
            ok[e >> 1] = pk2(kn[e], kn[e + 1]); oq[e >> 1] = pk2(qn[e], qn[e + 1]);
            oqd[e >> 1] = pk2(qn[e] * eG, qn[e + 1] * eG); okd[e >> 1] = pk2(kn[e] * eD, kn[e + 1] * eD);
        }
        *(u32x4*)(sK + t * TLD + d8) = ok; *(u32x4*)(sQ + t * TLD + d8) = oq;
        *(u32x4*)(gt + 2 * 4096 + t * 64 + d8) = oqd; *(u32x4*)(gt + 3 * 4096 + t * 64 + d8) = okd;
#pragma unroll
        for (int e = 0; e < 8; ++e) { RHS[t * 132 + d8 + e] = vv[e] * bt; RHS[t * 132 + 64 + d8 + e] = kn[e] * bt * eG; }
        if (tid == 0) glast[ch] = __expf(Gl);
    }
    __syncthreads();
#pragma unroll
    for (int i = 0; i < 2; ++i) {
        const int idx = wave * 2 + i, tt = idx >> 2, st = idx & 3;
        f32x4 am = (f32x4){0.f, 0.f, 0.f, 0.f}, aq = (f32x4){0.f, 0.f, 0.f, 0.f};
#pragma unroll
        for (int ks = 0; ks < 2; ++ks) {
            const bf16x8 kfs = frag_rm(sK, TLD, st * 16, ks * 32, lane), kft = frag_rm(sK, TLD, tt * 16, ks * 32, lane);
            am = MFMA16(kft, kfs, am);
            aq = MFMA16(kfs, frag_rm(sQ, TLD, tt * 16, ks * 32, lane), aq);
        }
        {   const int sx = st * 16 + li, t0 = tt * 16 + 4 * g; const float Gs = sG[sx];
            f32x4 mo;
#pragma unroll
            for (int r = 0; r < 4; ++r) { const int tq = t0 + r; mo[r] = (sx < tq) ? sBeta[tq] * am[r] * __expf(sG[tq] - Gs) : 0.f; }
            *(f32x4*)(sM + sx * 68 + t0) = mo; }
        {   const int tq = tt * 16 + li, s0 = st * 16 + 4 * g; const float Gt = sG[tq];
            float ao[4];
#pragma unroll
            for (int r = 0; r < 4; ++r) { const int sx = s0 + r; ao[r] = (sx <= tq) ? aq[r] * __expf(Gt - sG[sx]) : 0.f; }
            uint2 o; o.x = pk2(ao[0], ao[1]); o.y = pk2(ao[2], ao[3]);
            *(uint2*)(gt + 4 * 4096 + tq * 64 + s0) = o; }
    }
    __syncthreads();
    if (tid < 128) {
        float acc[64];
#pragma unroll
        for (int i = 0; i < 64; ++i) acc[i] = RHS[i * 132 + tid];
#pragma unroll
        for (int half = 0; half < 2; ++half) {
            const int base = half * 32;
            if (half == 1) {
#pragma unroll
                for (int sx = 0; sx < 32; sx += 2) {
                    f32x4 r0[8], r1[8];
#pragma unroll
                    for (int c = 0; c < 8; ++c) { r0[c] = *(const f32x4*)(sM + sx * 68 + 32 + c * 4); r1[c] = *(const f32x4*)(sM + (sx + 1) * 68 + 32 + c * 4); }
                    const float x0 = acc[sx], x1 = acc[sx + 1];
#pragma unroll
                    for (int tq = 0; tq < 32; ++tq) { acc[32 + tq] -= r0[tq >> 2][tq & 3] * x0; acc[32 + tq] -= r1[tq >> 2][tq & 3] * x1; }
                }
            }
            f32x4 cur[8];
#pragma unroll
            for (int c = 0; c < 8; ++c) cur[c] = *(const f32x4*)(sM + base * 68 + base + c * 4);
#pragma unroll
            for (int sx = 0; sx < 31; ++sx) {
                f32x4 nxt[8];
#pragma unroll
                for (int c = (sx + 2) >> 2; c < 8; ++c) nxt[c] = *(const f32x4*)(sM + (base + sx + 1) * 68 + base + c * 4);
                const float xs = acc[base + sx];
#pragma unroll
                for (int tq = sx + 1; tq < 32; ++tq) acc[base + tq] -= cur[tq >> 2][tq & 3] * xs;
#pragma unroll
                for (int c = (sx + 2) >> 2; c < 8; ++c) cur[c] = nxt[c];
            }
        }
        if (tid < 64) {
#pragma unroll
            for (int tt = 0; tt < 64; ++tt) gt[tt * 64 + tid] = f2bf(acc[tt]);
        } else {
#pragma unroll
            for (int tt = 0; tt < 64; ++tt) gt[4096 + tt * 64 + (tid - 64)] = f2bf(-acc[tt]);
        }
    }
}

__device__ __forceinline__ void gdn_scan_task(char* smem, const bf16_t* __restrict__ gt_all, const float* __restrict__ glast, const bf16_t* __restrict__ proj, const float* __restrict__ mix_gain,
                                              bf16_t* __restrict__ y, int bh) {
    bf16_t* sT = (bf16_t*)smem;
    bf16_t* sST = sT + 2 * 5 * 64 * TLD;
    bf16_t* sVn = sST + 2 * 64 * TLD;
    const int tid = TIDX, lane = tid & 63, wave = tid >> 6, g = lane >> 4, li = lane & 15;
    const int b = bh >> 2, h = bh & 3;
    const int sr = tid >> 3, sc8 = (tid & 7) * 8;
    const bf16_t* gsrc = gt_all + (size_t)bh * 32 * 5 * 4096 + sr * 64 + sc8;
    __syncthreads();
    u32x4 regs[5];
#pragma unroll
    for (int i = 0; i < 5; ++i) regs[i] = *(const u32x4*)(gsrc + i * 4096);
#pragma unroll
    for (int i = 0; i < 5; ++i) *(u32x4*)(sT + i * 64 * TLD + sr * TLD + sc8) = regs[i];
    *(u32x4*)(sST + sr * TLD + sc8) = (u32x4){0u, 0u, 0u, 0u};
    f32x4 sacc[4];
#pragma unroll
    for (int i = 0; i < 4; ++i) sacc[i] = (f32x4){0.f, 0.f, 0.f, 0.f};
    __syncthreads();
    for (int n = 0; n < 32; ++n) {
        const int buf = n & 1;
        const bf16_t* cT = sT + buf * 5 * 64 * TLD;
        const bf16_t* sU = cT; const bf16_t* sWn = cT + 64 * TLD; const bf16_t* sQd = cT + 2 * 64 * TLD; const bf16_t* sKd = cT + 3 * 64 * TLD; const bf16_t* sAq = cT + 4 * 64 * TLD;
        const bf16_t* cST = sST + buf * 64 * TLD; bf16_t* nST = sST + (buf ^ 1) * 64 * TLD;
        if (n + 1 < 32) {
#pragma unroll
            for (int i = 0; i < 5; ++i) regs[i] = *(const u32x4*)(gsrc + (size_t)(n + 1) * 5 * 4096 + i * 4096);
        }
        const size_t rowz = (size_t)(b * SEQ + n * 64 + (wave & 3) * 16 + li);
        uint2 zraw[4];
        if (wave < 4) {
#pragma unroll
            for (int vt = 0; vt < 4; ++vt) zraw[vt] = *(const uint2*)(proj + rowz * NP + C_DZ + h * 64 + vt * 16 + 4 * g);
        }
#pragma unroll
        for (int i = 0; i < 2; ++i) {
            const int idx = wave * 2 + i, tt = idx >> 2, vt = idx & 3;
            const int tq = tt * 16 + li, v0 = vt * 16 + 4 * g;
            const uint2 uraw = *(const uint2*)(sU + tq * TLD + v0);
            f32x4 acc = (f32x4){__uint_as_float(uraw.x << 16), __uint_as_float(uraw.x & 0xffff0000u), __uint_as_float(uraw.y << 16), __uint_as_float(uraw.y & 0xffff0000u)};
#pragma unroll
            for (int ks = 0; ks < 2; ++ks) acc = MFMA16(frag_rm(cST, TLD, vt * 16, ks * 32, lane), frag_rm(sWn, TLD, tt * 16, ks * 32, lane), acc);
            uint2 o; o.x = pk2(acc[0], acc[1]); o.y = pk2(acc[2], acc[3]);
            *(uint2*)(sVn + tq * TLD + v0) = o;
        }
        __syncthreads();
        if (wave < 4) {
            const int tt = wave;
            f32x4 oacc[4]; float ms = 0.f;
#pragma unroll
            for (int vt = 0; vt < 4; ++vt) {
                f32x4 acc = (f32x4){0.f, 0.f, 0.f, 0.f};
#pragma unroll
                for (int ks = 0; ks < 2; ++ks) acc = MFMA16(frag_rm(cST, TLD, vt * 16, ks * 32, lane), frag_rm(sQd, TLD, tt * 16, ks * 32, lane), acc);
#pragma unroll
                for (int ks = 0; ks < 2; ++ks) acc = MFMA16(frag_cm(sVn, TLD, ks * 32, vt * 16, lane), frag_rm(sAq, TLD, tt * 16, ks * 32, lane), acc);
                oacc[vt] = acc; ms += acc[0] * acc[0] + acc[1] * acc[1] + acc[2] * acc[2] + acc[3] * acc[3];
            }
            ms += __shfl_xor(ms, 16); ms += __shfl_xor(ms, 32);
            const float rinv = rsqrtf(ms * (1.f / 64.f) + EPS);
#pragma unroll
            for (int vt = 0; vt < 4; ++vt) {
                const int v0 = vt * 16 + 4 * g;
                const f32x4 mgv = *(const f32x4*)(mix_gain + 768 + h * 64 + v0);
                const float z0 = __uint_as_float(zraw[vt].x << 16), z1 = __uint_as_float(zraw[vt].x & 0xffff0000u), z2 = __uint_as_float(zraw[vt].y << 16), z3 = __uint_as_float(zraw[vt].y & 0xffff0000u);
                uint2 o; o.x = pk2(oacc[vt][0] * rinv * siluf_(z0) * mgv[0], oacc[vt][1] * rinv * siluf_(z1) * mgv[1]);
                o.y = pk2(oacc[vt][2] * rinv * siluf_(z2) * mgv[2], oacc[vt][3] * rinv * siluf_(z3) * mgv[3]);
                *(uint2*)(y + rowz * 1024 + 768 + h * 64 + v0) = o;
            }
        } else {
            const int kt = wave - 4;
            const float gl = glast[bh * 32 + n];
#pragma unroll
            for (int vt = 0; vt < 4; ++vt) {
                f32x4 acc = sacc[vt] * gl;
#pragma unroll
                for (int ks = 0; ks < 2; ++ks) acc = MFMA16(frag_cm(sKd, TLD, ks * 32, kt * 16, lane), frag_cm(sVn, TLD, ks * 32, vt * 16, lane), acc);
                sacc[vt] = acc;
                uint2 o; o.x = pk2(acc[0], acc[1]); o.y = pk2(acc[2], acc[3]);
                *(uint2*)(nST + (vt * 16 + li) * TLD + kt * 16 + 4 * g) = o;
            }
        }
        if (n + 1 < 32) {
            bf16_t* nT = sT + (buf ^ 1) * 5 * 64 * TLD;
#pragma unroll
            for (int i = 0; i < 5; ++i) *(u32x4*)(nT + i * 64 * TLD + sr * TLD + sc8) = regs[i];
        }
        __syncthreads();
    }
}


constexpr int XLD = 264;
__device__ __forceinline__ void lru_local_task(char* smem, const bf16_t* __restrict__ proj, const float* __restrict__ conv_w, const float* __restrict__ conv_b,
                                               const float* __restrict__ w_a, const float* __restrict__ b_a, const float* __restrict__ w_x, const float* __restrict__ b_x,
                                               const float* __restrict__ lam, float* __restrict__ hl_out, float* __restrict__ ac_out, float* __restrict__ lsum, int task) {
    bf16_t* sX = (bf16_t*)smem;
    bf16_t* sW = sX + 64 * XLD;
    float* sAa = (float*)(sW + 2 * 64 * TLD);
    float* sU = sAa + 64 * 65;
    float* sSegA = sU + 64 * 65; float* sSegH = sSegA + 8 * 64;
    const int tid = TIDX, lane = tid & 63, wave = tid >> 6, g = lane >> 4, li = lane & 15;
    const int b = task >> 5, n = task & 31;
    const size_t row0 = (size_t)(b * SEQ + n * 64);
    const int t = tid >> 3;
    __syncthreads();
    {
        const int spos = n * 64 + t;
#pragma unroll
        for (int i = 0; i < 4; ++i) {
            const int c8 = ((tid & 7) + 8 * i) * 8;
            float acc[8];
            { const f32x4 cb0 = *(const f32x4*)(conv_b + c8), cb1 = *(const f32x4*)(conv_b + c8 + 4);
#pragma unroll
              for (int e = 0; e < 8; ++e) acc[e] = e < 4 ? cb0[e] : cb1[e - 4]; }
#pragma unroll
            for (int j = 0; j < 4; ++j) {
                if (spos - (3 - j) >= 0) {
                    const u32x4 raw = *(const u32x4*)(proj + (row0 + t - (3 - j)) * NP + C_CX + c8);
                    const f32x4 w0 = *(const f32x4*)(conv_w + j * 256 + c8), w1 = *(const f32x4*)(conv_w + j * 256 + c8 + 4);
#pragma unroll
                    for (int e = 0; e < 8; ++e) acc[e] += (e < 4 ? w0[e] : w1[e - 4]) * bfx(raw, e);
                }
            }
            u32x4 o; o[0] = pk2(acc[0], acc[1]); o[1] = pk2(acc[2], acc[3]); o[2] = pk2(acc[4], acc[5]); o[3] = pk2(acc[6], acc[7]);
            *(u32x4*)(sX + t * XLD + c8) = o;
        }
    }
    for (int hh = 0; hh < 4; ++hh) {
        {
            const int i = tid >> 3, j8 = (tid & 7) * 8;
#pragma unroll
            for (int m = 0; m < 2; ++m) {
                const float* src = (m == 0 ? w_a : w_x) + (size_t)hh * 4096 + i * 64 + j8;
                const f32x4 v0 = *(const f32x4*)src, v1 = *(const f32x4*)(src + 4);
                u32x4 o; o[0] = pk2(v0[0], v0[1]); o[1] = pk2(v0[2], v0[3]); o[2] = pk2(v1[0], v1[1]); o[3] = pk2(v1[2], v1[3]);
                *(u32x4*)(sW + m * 64 * TLD + i * TLD + j8) = o;
            }
        }
        __syncthreads();
#pragma unroll
        for (int i2 = 0; i2 < 2; ++i2) {
            const int idx = wave * 2 + i2, tt = idx >> 2, jt = idx & 3;
            f32x4 ra = (f32x4){0.f, 0.f, 0.f, 0.f}, rx = (f32x4){0.f, 0.f, 0.f, 0.f};
#pragma unroll
            for (int ks = 0; ks < 2; ++ks) {
                const bf16x8 xf = frag_rm(sX + hh * 64, XLD, tt * 16, ks * 32, lane);
                ra = MFMA16(frag_cm(sW, TLD, ks * 32, jt * 16, lane), xf, ra);
                rx = MFMA16(frag_cm(sW + 64 * TLD, TLD, ks * 32, jt * 16, lane), xf, rx);
            }
            const int tq = tt * 16 + li, cl = jt * 16 + 4 * g, c = hh * 64 + cl;
            const f32x4 ba = *(const f32x4*)(b_a + c), bx = *(const f32x4*)(b_x + c), lm = *(const f32x4*)(lam + c);
            const uint2 xraw = *(const uint2*)(sX + tq * XLD + c);
            const float xc[4] = {__uint_as_float(xraw.x << 16), __uint_as_float(xraw.x & 0xffff0000u), __uint_as_float(xraw.y << 16), __uint_as_float(xraw.y & 0xffff0000u)};
#pragma unroll
            for (int r = 0; r < 4; ++r) {
                const float rr = sigmoidf_(ra[r] + ba[r]), ig = sigmoidf_(rx[r] + bx[r]);
                const float log_a = -8.f * rr * softplusf_(-lm[r]);
                sAa[tq * 65 + cl + r] = __expf(log_a);
                sU[tq * 65 + cl + r] = sqrtf(-expm1f(2.f * log_a)) * (ig * xc[r]);
            }
        }
        __syncthreads();
        const int cl = tid & 63, seg = tid >> 6;
        float Al[8], Hl[8];
        { float A = 1.f, H = 0.f;
#pragma unroll
          for (int i = 0; i < 8; ++i) { const float a = sAa[(seg * 8 + i) * 65 + cl], u = sU[(seg * 8 + i) * 65 + cl]; H = a * H + u; A *= a; Al[i] = A; Hl[i] = H; }
          sSegA[seg * 64 + cl] = A; sSegH[seg * 64 + cl] = H; }
        __syncthreads();
        { float Ac = 1.f, Hc = 0.f;
          for (int s2 = 0; s2 < seg; ++s2) { const float a = sSegA[s2 * 64 + cl]; Hc = a * Hc + sSegH[s2 * 64 + cl]; Ac *= a; }
#pragma unroll
          for (int i = 0; i < 8; ++i) {
              const size_t o = (row0 + seg * 8 + i) * 256 + hh * 64 + cl;
              const float hv = Hl[i] + Al[i] * Hc, av = Al[i] * Ac;
              hl_out[o] = hv; ac_out[o] = av;
              if (seg == 7 && i == 7) { lsum[(size_t)task * 256 + hh * 64 + cl] = av; lsum[(size_t)(256 + task) * 256 + hh * 64 + cl] = hv; }
          } }
        __syncthreads();
    }
}
__device__ __forceinline__ void lru_out_task(const float* __restrict__ hl_in, const float* __restrict__ ac_in, const float* __restrict__ lsum, const bf16_t* __restrict__ proj,
                                             const float* __restrict__ mix_gain, bf16_t* __restrict__ y, int task) {
    const int b = task >> 5, n = task & 31, c = TIDX & 255, half = TIDX >> 8;
    const float Hc = lsum[(size_t)task * 256 + c];
    const float mg = mix_gain[512 + c];
    const size_t row0 = (size_t)(b * SEQ + n * 64 + half * 32);
#pragma unroll 4
    for (int i = 0; i < 32; ++i) {
        const size_t row = row0 + i;
        const float hv = hl_in[row * 256 + c] + ac_in[row * 256 + c] * Hc;
        const float yv = hv * geluf_(bf2f(proj[row * NP + C_CG + c]));
        const float ms = wave_sum(yv * yv) * (1.f / 64.f);
        y[row * 1024 + 512 + c] = f2bf(yv * rsqrtf(ms + EPS) * mg);
    }
}


__device__ __forceinline__ void state_scan_phase(const float* __restrict__ HL, const float* __restrict__ HD, bf16_t* __restrict__ HS, const float* __restrict__ lsum, float* __restrict__ lcar) {
    const int bx = blockIdx.x, tid = TIDX;
    for (int u = bx; u < 128 + 4; u += gridDim.x) {
        if (u < 128) {
            const int gid = u * NTHR + tid, bh = gid >> 11, v = gid & 63, kp = (gid >> 6) & 31;
            const float* Lb = HL + (size_t)bh * 32 * 4096 + (2 * kp) * 64 + v; const float* Db = HD + (size_t)bh * 32 * 64 + 2 * kp;
            bf16_t* Sb = HS + (size_t)bh * 32 * 4096 + (2 * kp) * 64 + v;
            float S0 = 0.f, S1 = 0.f;
            for (int n0 = 0; n0 < 32; n0 += 8) {
                float l0[8], l1[8], d0[8], d1[8];
#pragma unroll
                for (int i = 0; i < 8; ++i) { l0[i] = Lb[(size_t)(n0 + i) * 4096]; l1[i] = Lb[(size_t)(n0 + i) * 4096 + 64]; d0[i] = Db[(n0 + i) * 64]; d1[i] = Db[(n0 + i) * 64 + 1]; }
#pragma unroll
                for (int i = 0; i < 8; ++i) {
                    Sb[(size_t)(n0 + i) * 4096] = f2bf(S0); Sb[(size_t)(n0 + i) * 4096 + 64] = f2bf(S1);
                    S0 = d0[i] * S0 + l0[i]; S1 = d1[i] * S1 + l1[i];
                }
            }
        } else {
            const int gid = (u - 128) * NTHR + tid, b = gid >> 8, c = gid & 255;
            float A[32], H[32];
#pragma unroll
            for (int n = 0; n < 32; ++n) { A[n] = lsum[(size_t)(b * 32 + n) * 256 + c]; H[n] = lsum[(size_t)(256 + b * 32 + n) * 256 + c]; }
            float Hc = 0.f;
#pragma unroll
            for (int n = 0; n < 32; ++n) { lcar[(size_t)(b * 32 + n) * 256 + c] = Hc; Hc = A[n] * Hc + H[n]; }
        }
    }
}

__device__ __forceinline__ void router_phase(char* smem, const float* __restrict__ x, const float* __restrict__ g, const bf16_t* __restrict__ wr  , const float* __restrict__ b_rg,
                                             const float* __restrict__ b_re, const float* __restrict__ pss, int* __restrict__ cnt, int* __restrict__ list, float* __restrict__ pgate) {
    bf16_t* sXh = (bf16_t*)smem;
    bf16_t* sXl = sXh + 64 * TLD;
    float* sLog = (float*)(sXl + 64 * TLD);
    const int tid = TIDX, lane = tid & 63, wave = tid >> 6, gq = lane >> 4, li = lane & 15;
    const int mt = wave & 3, kh = wave >> 2;
    const int stok = tid >> 3, c8 = (tid & 7) * 8;
    BLK_LOOP(tile, T / 64) {
        const int t0 = tile * 64;
        f32x4 acc[3];
#pragma unroll
        for (int n = 0; n < 3; ++n) acc[n] = (f32x4){0.f, 0.f, 0.f, 0.f};
        const float* xp = x + (size_t)(t0 + stok) * 1024 + c8;
        const bf16_t* wp = wr + (size_t)li * 1024 + kh * 32 + gq * 8;
        f32x4 x0 = *(const f32x4*)xp, x1 = *(const f32x4*)(xp + 4);
        u32x4 wh[3], wl[3];
#pragma unroll
        for (int n = 0; n < 3; ++n) { wh[n] = *(const u32x4*)(wp + n * 16 * 1024); wl[n] = *(const u32x4*)(wp + 48 * 1024 + n * 16 * 1024); }
        for (int kc = 0; kc < 16; ++kc) {
            const f32x4 g0 = *(const f32x4*)(g + kc * 64 + c8), g1 = *(const f32x4*)(g + kc * 64 + c8 + 4);
            const f32x4 v0 = x0 * g0, v1 = x1 * g1;
            u32x4 oh, ol;
#pragma unroll
            for (int j = 0; j < 2; ++j) {
                const unsigned h0 = pk2(v0[2 * j], v0[2 * j + 1]), h1 = pk2(v1[2 * j], v1[2 * j + 1]);
                oh[j] = h0; oh[2 + j] = h1;
                ol[j] = pk2(v0[2 * j] - __uint_as_float(h0 << 16), v0[2 * j + 1] - __uint_as_float(h0 & 0xffff0000u));
                ol[2 + j] = pk2(v1[2 * j] - __uint_as_float(h1 << 16), v1[2 * j + 1] - __uint_as_float(h1 & 0xffff0000u));
            }
            __syncthreads();
            *(u32x4*)(sXh + stok * TLD + c8) = oh; *(u32x4*)(sXl + stok * TLD + c8) = ol;
            __syncthreads();
            u32x4 cwh[3], cwl[3];
#pragma unroll
            for (int n = 0; n < 3; ++n) { cwh[n] = wh[n]; cwl[n] = wl[n]; }
            if (kc + 1 < 16) {
                x0 = *(const f32x4*)(xp + (kc + 1) * 64); x1 = *(const f32x4*)(xp + (kc + 1) * 64 + 4);
#pragma unroll
                for (int n = 0; n < 3; ++n) { wh[n] = *(const u32x4*)(wp + n * 16 * 1024 + (kc + 1) * 64); wl[n] = *(const u32x4*)(wp + 48 * 1024 + n * 16 * 1024 + (kc + 1) * 64); }
            }
            const bf16x8 xh = frag_rm(sXh, TLD, mt * 16, kh * 32, lane), xl = frag_rm(sXl, TLD, mt * 16, kh * 32, lane);
#pragma unroll
            for (int n = 0; n < 3; ++n) {
                const bf16x8 fh = __builtin_bit_cast(bf16x8, cwh[n]), fl = __builtin_bit_cast(bf16x8, cwl[n]);
                acc[n] = MFMA16(fh, xh, acc[n]);
                acc[n] = MFMA16(fl, xh, acc[n]);
                acc[n] = MFMA16(fh, xl, acc[n]);
            }
        }
#pragma unroll
        for (int n = 0; n < 3; ++n) *(f32x4*)(sLog + (kh * 64 + mt * 16 + li) * 48 + n * 16 + 4 * gq) = acc[n];
        __syncthreads();
        if (tid < 64) {
            const int t = t0 + tid; const float rinv = rinv_from_pss(pss, (size_t)t);
            const float* l0 = sLog + tid * 48; const float* l1 = sLog + (64 + tid) * 48;
            float lg[4];
#pragma unroll
            for (int i = 0; i < 4; ++i) lg[i] = (l0[i] + l1[i]) * rinv + b_rg[i];
            int gs = 0; float gm = lg[0];
#pragma unroll
            for (int i = 1; i < 4; ++i) if (lg[i] > gm) { gm = lg[i]; gs = i; }
            float den = 0.f;
#pragma unroll
            for (int i = 0; i < 4; ++i) den += __expf(lg[i] - gm);
            const float pg = 1.f / den;
            int i0 = 0, i1 = -1; float m0 = -INFINITY, m1 = -INFINITY;
            for (int i = 0; i < 8; ++i) {
                const float v = (l0[4 + gs * 8 + i] + l1[4 + gs * 8 + i]) * rinv + b_re[gs * 8 + i];
                if (v > m0) { m1 = m0; i1 = i0; m0 = v; i0 = i; } else if (v > m1) { m1 = v; i1 = i; }
            }
            const float e1 = __expf(m1 - m0); const float w0 = 1.f / (1.f + e1), w1 = e1 / (1.f + e1);
            const int ex0 = gs * 8 + i0, ex1 = gs * 8 + i1;
            const int pos0 = atomicAdd(&cnt[ex0], 1); list[(size_t)ex0 * T + pos0] = 2 * t; pgate[2 * t] = pg * w0;
            const int pos1 = atomicAdd(&cnt[ex1], 1); list[(size_t)ex1 * T + pos1] = 2 * t + 1; pgate[2 * t + 1] = pg * w1;
        }
        __syncthreads();
    }
}

__device__ __forceinline__ void combine_phase(const float* x2, const bf16_t* __restrict__ eo, const float* __restrict__ g, float* xout, bf16_t* __restrict__ hn, int mode) {
    const int lane = TIDX & 63;
    for (int t = blockIdx.x * 8 + (TIDX >> 6); t < T; t += gridDim.x * 8) {
        f32x4 v[4]; float s = 0.f;
#pragma unroll
        for (int j = 0; j < 4; ++j) {
            const int c = (lane + 64 * j) * 4;
            v[j] = *(const f32x4*)(x2 + (size_t)t * 1024 + c);
            const uint2 e0 = *(const uint2*)(eo + (size_t)(2 * t) * 1024 + c), e1 = *(const uint2*)(eo + (size_t)(2 * t + 1) * 1024 + c);
            v[j].x += __uint_as_float(e0.x << 16) + __uint_as_float(e1.x << 16);
            v[j].y += __uint_as_float(e0.x & 0xffff0000u) + __uint_as_float(e1.x & 0xffff0000u);
            v[j].z += __uint_as_float(e0.y << 16) + __uint_as_float(e1.y << 16);
            v[j].w += __uint_as_float(e0.y & 0xffff0000u) + __uint_as_float(e1.y & 0xffff0000u);
            s += v[j].x * v[j].x + v[j].y * v[j].y + v[j].z * v[j].z + v[j].w * v[j].w;
        }
        const float rinv = rsqrtf(wave_sum(s) * (1.f / 1024.f) + EPS);
#pragma unroll
        for (int j = 0; j < 4; ++j) {
            const int c = (lane + 64 * j) * 4;
            const f32x4 gg = *(const f32x4*)(g + c);
            const f32x4 hv = v[j] * rinv * gg;
            if (mode == 0) {
                *(f32x4*)(xout + (size_t)t * 1024 + c) = v[j];
                uint2 o; o.x = pk2(hv.x, hv.y); o.y = pk2(hv.z, hv.w);
                *(uint2*)(hn + (size_t)t * 1024 + c) = o;
            } else {
                *(f32x4*)(xout + (size_t)t * 1024 + c) = hv;
            }
        }
    }
}

template <int l>
__device__ __forceinline__ void layer_body(const Params& P, char* smem, const XcdBarrier& xb, const float* xcur) {
    char* ws = P.ws;
    bf16_t* Wt_in = (bf16_t*)(ws + OFF_WIN); bf16_t* Wt_out = (bf16_t*)(ws + OFF_WOUT); bf16_t* Wt_mq = (bf16_t*)(ws + OFF_WMQ); bf16_t* Wt_mkv = (bf16_t*)(ws + OFF_WMKV);
    bf16_t* Wt_mo = (bf16_t*)(ws + OFF_WMO); bf16_t* Wt_gu = (bf16_t*)(ws + OFF_WGU); bf16_t* Wt_dn = (bf16_t*)(ws + OFF_WDN);
    bf16_t* hn = (bf16_t*)(ws + OFF_HN); bf16_t* proj = (bf16_t*)(ws + OFF_PROJ); float* gates = (float*)(ws + OFF_GATES); bf16_t* y = (bf16_t*)(ws + OFF_Y);
    float* XA = P.out; float* XB = (float*)(ws + OFF_XB);
    bf16_t* qm = (bf16_t*)(ws + OFF_QM); bf16_t* om = (bf16_t*)(ws + OFF_OM); bf16_t* kvm = (bf16_t*)(ws + OFF_KVM); bf16_t* memn = (bf16_t*)(ws + OFF_MEMN);
    float* foxc = (float*)(ws + OFF_FOXC); float* lrua = (float*)(ws + OFF_LRUA); float* lruu = (float*)(ws + OFF_LRUU);
    int* cnt_all = (int*)(ws + OFF_CTL) + CTL_CNT_WORD; int* list = (int*)(ws + OFF_LIST); float* pgate = (float*)(ws + OFF_PGATE);
    bf16_t* act = (bf16_t*)(ws + OFF_ACT); bf16_t* eo = (bf16_t*)(ws + OFF_EO); float* pss = (float*)(ws + OFF_PSS);
    const int wave = TIDX >> 6, lane = TIDX & 63;


        float* x1 = (l == 0) ? XA : XB;
        float* x2 = (l == 0) ? XB : XA;
        int* cnt = cnt_all + 32 * l;
        const float* mg = P.in[I_MIX_GAIN] + l * 1024;
        REP(2, { pg8::Gemm g{hn, Wt_in + (size_t)l * NP * 1024, T, NP, 1024}; pg8::StaticOrder S; S.init(T, NP, (int)gridDim.x, (int)blockIdx.x);
                 pg8::EpiInProj E{proj, NP, gates, C_GATE};
                 pg8::gemm_phase<pg8::EpiInProj, pg8::StaticOrder, true, true>((PG8_LAS unsigned char*)smem, g, S, E); });
        if (l == 0) for (int l2 = 0; l2 < NL; ++l2)
            gemm_phase<EPI_BF16>(smem, memn + (size_t)l2 * 2048 * 1024, 1024, Wt_mkv + (size_t)l2 * 512 * 1024, 1024, 2048, 512, 1024, kvm + (size_t)l2 * 2048 * 512, 512, nullptr, nullptr,
                                 (gridDim.x >= 192) ? ((int)blockIdx.x - 128 - 32 * l2) : (int)blockIdx.x, (gridDim.x >= 192) ? 4096 : (int)gridDim.x);
        GSYNC();
        REP(4,         {
            const int bx = blockIdx.x;
            bf16_t* gtiles = (bf16_t*)(ws + OFF_GDN); float* glast = (float*)(ws + OFF_GLAST);
            if (bx < 32 && wave == 1) fox_cumsum(gates, P.in[I_FOX_FB] + l * 4, foxc, bx, lane);
            BLK_LOOP(ch, 1024) gdn_prep_task(smem, proj, gates, P.in[I_GDN_CONV_W] + l * 4 * 768, P.in[I_GDN_A_LOG] + l * 4, P.in[I_GDN_DT_BIAS] + l * 4, gtiles, glast, ch);
            BLK_LOOP(ch, 1024) hgrn_local_task(smem, proj, P.in[I_HGRN_LB], l, (float*)(ws + OFF_HL), (float*)(ws + OFF_HD), ch);
            BLK_LOOP(task, 256) lru_local_task(smem, proj, P.in[I_LRU_CONV_W] + l * 1024, P.in[I_LRU_CONV_B] + l * 256, P.in[I_LRU_WA] + l * 16384, P.in[I_LRU_BA] + l * 256,
                                               P.in[I_LRU_WX] + l * 16384, P.in[I_LRU_BX] + l * 256, P.in[I_LRU_LAM] + l * 256, lrua, lruu, (float*)(ws + OFF_LSUM), task);
        });
        GSYNC();
        state_scan_phase((const float*)(ws + OFF_HL), (const float*)(ws + OFF_HD), (bf16_t*)(ws + OFF_HS), (const float*)(ws + OFF_LSUM), (float*)(ws + OFF_LCAR));
        GSYNC();
        REP(8,         {
            const int natt = (SEQ / 128) * 4 * NB;
            const int bx = blockIdx.x, nfree = (int)gridDim.x - 32;
            if (bx < 32) gdn_scan_task(smem, (const bf16_t*)(ws + OFF_GDN), (const float*)(ws + OFF_GLAST), proj, mg, y, bx);
            else {
                for (int r = 0; r * nfree < natt; ++r) {
                    const int i = r * nfree + ((r & 1) ? (nfree - 1 - (bx - 32)) : (bx - 32));
                    if (i >= natt) continue;
                    const int qt = 15 - (i >> 5), bh = i & 31;
                    attn_task(smem, proj + C_BQ, NP, proj + C_BK, NP, proj + C_BV, NP, foxc, SEQ, SEQ, 1, 0.125f, y + 256, 1024, mg + 256, 1, (bh * 16) + qt);
                }
                for (int i = bx - 32; i < 1024; i += nfree) {
                    const int ch = (i & 31) * 32 + (31 - (i >> 5));
                    hgrn_out_task(smem, proj, P.in[I_HGRN_LB], l, (const bf16_t*)(ws + OFF_HS), mg, y, ch);
                }
                for (int i = bx - 32; i < 256; i += nfree) lru_out_task(lrua, lruu, (const float*)(ws + OFF_LCAR), proj, mg, y, i);
            }
        });
        GSYNC();
        REP(16, { pg8::Gemm g{y, Wt_out + (size_t)l * 1024 * 1024, T, 1024, 1024}; pg8::StaticOrder S; S.init(T, 1024, (int)gridDim.x, (int)blockIdx.x);
                  pg8::EpiResidNorm E{xcur, x1, 1024, P.in[I_NORM_MEM] + l * 1024, hn, pss};
                  pg8::gemm_phase<pg8::EpiResidNorm, pg8::StaticOrder, true, true>((PG8_LAS unsigned char*)smem, g, S, E); });
        GSYNC();
        REP(64, gemm_phase<EPI_BF16_RS>(smem, hn, 1024, Wt_mq + (size_t)l * 256 * 1024, 1024, T, 256, 1024, qm, 256, pss, nullptr));
        GSYNC();
        { const bf16_t* kv = kvm + (size_t)l * 2048 * 512;
          REP(128, BLK_LOOP(task, (SEQ / 128) * 4 * NB) attn_task(smem, qm, 256, kv, 512, kv + 256, 512, nullptr, SEQ, MEMLEN, 0, 0.125f, om, 256, nullptr, 0, task)); }
        GSYNC();
        REP(256, { pg8::Gemm g{om, Wt_mo + (size_t)l * 1024 * 256, T, 1024, 256}; pg8::StaticOrder S; S.init(T, 1024, (int)gridDim.x, (int)blockIdx.x);
                   pg8::EpiResidNorm E{x1, x2, 1024, P.in[I_NORM_FFN] + l * 1024, hn, pss};
                   pg8::gemm_phase<pg8::EpiResidNorm, pg8::StaticOrder, true, true>((PG8_LAS unsigned char*)smem, g, S, E); });
        GSYNC();
        router_phase(smem, x2, P.in[I_NORM_FFN] + l * 1024, (const bf16_t*)(ws + OFF_WR) + (size_t)l * 2 * 48 * 1024, P.in[I_B_RG] + l * 4, P.in[I_B_RE] + l * 32, pss, cnt, list, pgate);
        GSYNC();
        REP(512, moe_phase<1>(smem, hn, 1024, Wt_gu + (size_t)l * 32 * 512 * 1024, (size_t)512 * 1024, 1024, 1024, cnt, list, pgate, act, pss));
        GSYNC();
        REP(1024, moe_phase<2>(smem, act, 256, Wt_dn + (size_t)l * 32 * 1024 * 256, (size_t)1024 * 256, 256, 256, cnt, list, pgate, eo, pss));
        if (PROBE_MASK & 2048) { for (int i = 0; i < 10; ++i) GSYNC(); }
        GSYNC();
        if (l == 0) { combine_phase(x2, eo, P.in[I_NORM_MIX] + 1024, XA, hn, 0); GSYNC(); }
        else combine_phase(x2, eo, P.in[I_NORM_FINAL], P.out, hn, 1);
}
__global__ void __launch_bounds__(NTHR, 2) mega_kernel(Params P) {
    extern __shared__ __attribute__((aligned(16))) char smem[];
    volatile LDS_AS unsigned* st = (volatile LDS_AS unsigned*)(smem + LDS_BYTES - 16);
    if (TIDX < 4) st[TIDX] = 0u;
    __syncthreads();
    const XcdBarrier xb = xcd_barrier_post((unsigned*)(P.ws + OFF_CTL), st);
    phase0(P, smem);
    GSYNC();
    layer_body<0>(P, smem, xb, P.in[I_X]);
    layer_body<1>(P, smem, xb, P.out);
}

extern "C" void kernel_launch(void* const* d_in, const int* in_sizes, int n_in, void* d_out, int out_size, void* d_ws, size_t ws_size, hipStream_t stream) {
    static int grid_blocks = 0;
    if (grid_blocks == 0) {
        if (n_in != N_INPUTS || ws_size < OFF_END || out_size != T * 1024) { fprintf(stderr, "kernel_launch: unexpected sizes n_in=%d ws=%zu out=%d (need ws >= %zu)\n", n_in, ws_size, out_size, (size_t)OFF_END); grid_blocks = -1; return; }
        int dev = 0, cus = 0, per_cu = 0;
        if (hipGetDevice(&dev) != hipSuccess || hipDeviceGetAttribute(&cus, hipDeviceAttributeMultiprocessorCount, dev) != hipSuccess) { fprintf(stderr, "kernel_launch: device query failed\n"); grid_blocks = -1; return; }
        if (hipFuncSetAttribute((const void*)mega_kernel, hipFuncAttributeMaxDynamicSharedMemorySize, LDS_BYTES) != hipSuccess) { fprintf(stderr, "kernel_launch: hipFuncSetAttribute failed\n"); grid_blocks = -1; return; }
        if (hipOccupancyMaxActiveBlocksPerMultiprocessor(&per_cu, (const void*)mega_kernel, NTHR, LDS_BYTES) != hipSuccess || per_cu < 1) { fprintf(stderr, "kernel_launch: occupancy query says %d blocks/CU\n", per_cu); grid_blocks = -1; return; }
        grid_blocks = cus;
        fprintf(stderr, "kernel_launch: cus=%d per_cu=%d grid=%d\n", cus, per_cu, grid_blocks);
    }
    if (grid_blocks < 0) return;
    if (hipMemsetAsync((char*)d_ws + OFF_CTL, 0, CTL_BYTES, stream) != hipSuccess) { fprintf(stderr, "kernel_launch: memset failed\n"); return; }
    Params p; memset(&p, 0, sizeof p);
    for (int i = 0; i < N_INPUTS; ++i) p.in[i] = (const float*)d_in[i];
    p.out = (float*)d_out; p.ws = (char*)d_ws;
    void* args[] = {&p};
    hipError_t e = hipLaunchCooperativeKernel((const void*)mega_kernel, dim3(grid_blocks), dim3(NTHR), args, LDS_BYTES, stream);
    if (e != hipSuccess) fprintf(stderr, "kernel_launch: cooperative launch failed: %s (grid %d)\n", hipGetErrorString(e), grid_blocks);
}
```

```cpp
#include <hip/hip_runtime.h>
#include <stdint.h>
#include <stdio.h>
#include <string.h>
#include <hip/hip_cooperative_groups.h>
namespace cg = cooperative_groups;

typedef unsigned short bf16_t;
typedef short bf16x8 __attribute__((ext_vector_type(8)));
typedef float f32x4 __attribute__((ext_vector_type(4)));
typedef unsigned u32x4 __attribute__((ext_vector_type(4)));

constexpr int NB = 8, SEQ = 2048, DM = 1024, T = NB * SEQ, NL = 2;
constexpr int NP = 3584;
constexpr int NIN = 3340;
constexpr int C_AQ = 0, C_AF = 256, C_AI = 512, C_AG = 768, C_BQ = 1024, C_BK = 1280, C_BV = 1536, C_CX = 1792, C_CG = 2048,
              C_DQ = 2304, C_DK = 2560, C_DV = 2816, C_DZ = 3072, C_GATE = 3328;
constexpr int MEMLEN = 256;
constexpr int NEXP = 32, DEXP = 256;
constexpr float EPS = 1e-6f;

constexpr size_t al256(size_t x) { return (x + 255) & ~(size_t)255; }
constexpr size_t SZ_WIN = (size_t)NP * 1024 * 2, SZ_WOUT = (size_t)1024 * 1024 * 2, SZ_WMQ = (size_t)256 * 1024 * 2, SZ_WMKV = (size_t)512 * 1024 * 2,
                 SZ_WMO = (size_t)1024 * 256 * 2, SZ_WGU = (size_t)32 * 512 * 1024 * 2, SZ_WDN = (size_t)32 * 1024 * 256 * 2;
constexpr size_t OFF_WIN = 0;
constexpr size_t OFF_WOUT = OFF_WIN + NL * SZ_WIN;
constexpr size_t OFF_WMQ = OFF_WOUT + NL * SZ_WOUT;
constexpr size_t OFF_WMKV = OFF_WMQ + NL * SZ_WMQ;
constexpr size_t OFF_WMO = OFF_WMKV + NL * SZ_WMKV;
constexpr size_t OFF_WGU = OFF_WMO + NL * SZ_WMO;
constexpr size_t OFF_WDN = OFF_WGU + NL * SZ_WGU;
constexpr size_t OFF_HN = OFF_WDN + NL * SZ_WDN;
constexpr size_t OFF_PROJ = OFF_HN + (size_t)T * 1024 * 2;
constexpr size_t OFF_GATES = OFF_PROJ + (size_t)T * NP * 2;
constexpr size_t OFF_Y = OFF_GATES + (size_t)T * 16 * 4;
constexpr size_t OFF_XB = OFF_Y + (size_t)T * 1024 * 2;
constexpr size_t OFF_QM = OFF_XB + (size_t)T * 1024 * 4;
constexpr size_t OFF_OM = OFF_QM + (size_t)T * 256 * 2;
constexpr size_t OFF_KVM = OFF_OM + (size_t)T * 256 * 2;
constexpr size_t OFF_MEMN = OFF_KVM + (size_t)NL * 2048 * 512 * 2;
constexpr size_t OFF_FOXC = OFF_MEMN + (size_t)2048 * 1024 * 2;
constexpr size_t OFF_LRUA = OFF_FOXC + (size_t)NB * 4 * SEQ * 4;
constexpr size_t OFF_LRUU = OFF_LRUA + (size_t)T * 256 * 4;
constexpr size_t OFF_CNT = OFF_LRUU + (size_t)T * 256 * 4;
constexpr size_t OFF_LIST = OFF_CNT + 256;
constexpr size_t OFF_PGATE = OFF_LIST + (size_t)NEXP * T * 4;
constexpr size_t OFF_HL = OFF_PGATE + (size_t)2 * T * 4;
constexpr size_t OFF_HD = OFF_HL + (size_t)1024 * 4096 * 4;
constexpr size_t OFF_GDN = OFF_HD + (size_t)1024 * 64 * 4;
constexpr size_t OFF_GLAST = OFF_GDN + (size_t)1024 * 5 * 4096 * 2;
constexpr size_t OFF_LSUM = OFF_GLAST + 4096;
constexpr size_t OFF_HS = OFF_LSUM + (size_t)2 * 256 * 256 * 4;
constexpr size_t OFF_LCAR = OFF_HS + (size_t)1024 * 4096 * 2;
constexpr size_t OFF_PSS = OFF_LCAR + (size_t)256 * 256 * 4;
constexpr size_t OFF_WR = OFF_PSS + (size_t)T * 16 * 4;
constexpr size_t OFF_CTL = OFF_WR + (size_t)NL * 2 * 48 * 1024 * 2;
constexpr size_t CTL_BYTES = 32768;
constexpr int CTL_CNT_WORD = 4096;
constexpr int CNT_STRIDE = 64;
constexpr size_t OFF_END = OFF_CTL + CTL_BYTES;
constexpr size_t OFF_ACT = OFF_PROJ;
constexpr size_t OFF_EO = OFF_PROJ + (size_t)2 * T * 256 * 2;
static_assert(OFF_EO + (size_t)2 * T * 1024 * 2 <= OFF_GATES, "overlay fits");

__device__ __forceinline__ int tid_opaque() { int t = threadIdx.x; asm volatile("" : "+v"(t)); return t; }
#define TIDX tid_opaque()
__device__ __forceinline__ float bf2f(bf16_t v) { return __uint_as_float(((unsigned)v) << 16); }
typedef __bf16 bf16x2_t __attribute__((ext_vector_type(2)));
__device__ __forceinline__ bf16_t f2bf(float f) { return __builtin_bit_cast(unsigned short, (__bf16)f); }
__device__ __forceinline__ unsigned pk2(float lo, float hi) { bf16x2_t v = {(__bf16)lo, (__bf16)hi}; return __builtin_bit_cast(unsigned, v); }
__device__ __forceinline__ float sigmoidf_(float x) { return 1.f / (1.f + __expf(-x)); }
__device__ __forceinline__ float siluf_(float x) { return x / (1.f + __expf(-x)); }
__device__ __forceinline__ float softplusf_(float x) { return x > 20.f ? x : log1pf(__expf(x)); }
__device__ __forceinline__ float logsigmoidf_(float x) { return x < 0.f ? x - log1pf(__expf(x)) : -log1pf(__expf(-x)); }
__device__ __forceinline__ float geluf_(float x) { float u = 0.7978845608028654f * (x + 0.044715f * x * x * x); return 0.5f * x * (1.f + tanhf(u)); }
__device__ __forceinline__ float wave_sum(float v) {
#pragma unroll
    for (int o = 1; o < 64; o <<= 1) v += __shfl_xor(v, o);
    return v;
}
__device__ __forceinline__ float rdlane(float v, int l) { return __int_as_float(__builtin_amdgcn_readlane(__float_as_int(v), l)); }

#define PROBE_MASK 0
#define GSYNC() xcd_barrier(xb)
#define REP(bit, ...) do { __VA_ARGS__; if (PROBE_MASK & (bit)) { GSYNC(); __VA_ARGS__; } } while (0)
constexpr int NTHR = 512;
constexpr int LDS_BYTES = 147456;
enum { I_X = 0, I_MEM, I_NORM_MIX, I_W_IN, I_HGRN_LB, I_FOX_FB, I_LRU_CONV_W, I_LRU_CONV_B, I_LRU_WA, I_LRU_BA, I_LRU_WX, I_LRU_BX, I_LRU_LAM, I_GDN_CONV_W, I_GDN_A_LOG,
       I_GDN_DT_BIAS, I_MIX_GAIN, I_W_OUT, I_NORM_MEM, I_NORM_MEMKV, I_W_MQ, I_W_MKV, I_W_MO, I_NORM_FFN, I_W_RG, I_B_RG, I_W_RE, I_B_RE, I_W_E_GU, I_W_E_DN, I_NORM_FINAL, N_INPUTS };
struct Params { const float* in[N_INPUTS]; float* out; char* ws; };
static_assert(sizeof(Params) == 8 * (N_INPUTS + 2), "no padding");

#define BLK_LOOP(it, n) for (int it = (int)blockIdx.x; it < (n); it += (int)gridDim.x)


__device__ __forceinline__ float rinv_from_pss(const float* __restrict__ pss, size_t row) {
    const f32x4 a = *(const f32x4*)(pss + row * 16), b = *(const f32x4*)(pss + row * 16 + 4), c = *(const f32x4*)(pss + row * 16 + 8), d = *(const f32x4*)(pss + row * 16 + 12);
    const float sm = ((a[0] + a[1]) + (a[2] + a[3])) + ((b[0] + b[1]) + (b[2] + b[3])) + ((c[0] + c[1]) + (c[2] + c[3])) + ((d[0] + d[1]) + (d[2] + d[3]));
    return rsqrtf(sm * (1.f / 1024.f) + EPS);
}

__device__ __forceinline__ int rowmap_fn(int mode, int n) {
    if (mode == 1) {
        if (n < 1792) return n;
        if (n < 1796) return C_GATE + (n - 1792);
        if (n < 3076) return n - 4;
        if (n < 3084) return C_GATE + 4 + (n - 3076);
        return n - 12;
    } else if (mode == 2) {
        int j = n & 255; return (j >> 4) * 32 + ((n >= 256) ? 16 : 0) + (j & 15);
    }
    return n;
}
__device__ __forceinline__ void convT_tile(float* tile  , const float* __restrict__ src, int K, int N, bf16_t* __restrict__ dst, int mode, int ntn, int idx) {
    const int n0 = (idx % ntn) * 64, k0 = (idx / ntn) * 64;
    const int tid = TIDX;
    __syncthreads();
#pragma unroll
    for (int i = 0; i < 2; ++i) {
        const int k = (tid >> 4) + 32 * i, n = n0 + (tid & 15) * 4;
        f32x4 v = (f32x4){0.f, 0.f, 0.f, 0.f};
        if (n + 3 < N) v = *(const f32x4*)(src + (size_t)(k0 + k) * N + n);
        else { for (int e = 0; e < 4; ++e) if (n + e < N) v[e] = src[(size_t)(k0 + k) * N + n + e]; }
#pragma unroll
        for (int e = 0; e < 4; ++e) tile[k * 65 + (tid & 15) * 4 + e] = v[e];
    }
    __syncthreads();
    const int nl = tid >> 3, k8 = (tid & 7) * 8, n = n0 + nl;
    if (n < N) {
        const int r = rowmap_fn(mode, n);
        u32x4 o;
#pragma unroll
        for (int j = 0; j < 4; ++j) o[j] = pk2(tile[(k8 + 2 * j) * 65 + nl], tile[(k8 + 2 * j + 1) * 65 + nl]);
        *(u32x4*)(dst + (size_t)r * K + k0 + k8) = o;
    }
}
__device__ __forceinline__ void rms_row_bf16(const float* __restrict__ xrow, const float* __restrict__ g, bf16_t* __restrict__ orow, int lane) {
    const f32x4* xr = (const f32x4*)xrow + lane;
    f32x4 v[4]; float s = 0.f;
#pragma unroll
    for (int j = 0; j < 4; ++j) { v[j] = xr[64 * j]; s += v[j].x * v[j].x + v[j].y * v[j].y + v[j].z * v[j].z + v[j].w * v[j].w; }
    const float rinv = rsqrtf(wave_sum(s) * (1.f / 1024.f) + EPS);
#pragma unroll
    for (int j = 0; j < 4; ++j) {
        const f32x4 gg = ((const f32x4*)g)[lane + 64 * j];
        uint2 o; o.x = pk2(v[j].x * rinv * gg.x, v[j].y * rinv * gg.y); o.y = pk2(v[j].z * rinv * gg.z, v[j].w * rinv * gg.w);
        *(uint2*)(orow + (lane + 64 * j) * 4) = o;
    }
}

constexpr int CT_PER_LAYER = 53 * 16 + 256 + 64 + 128 + 64;
constexpr int CT_GU = 64 * 128, CT_DN = 64 * 64;
constexpr int CT_TOTAL = NL * CT_PER_LAYER + CT_GU + CT_DN;

__device__ __forceinline__ void phase0(const Params& P, char* smem) {
    char* ws = P.ws;
    float* tile = (float*)smem;
    BLK_LOOP(it, CT_TOTAL) {
        int r = it;
        if (r < NL * CT_PER_LAYER) {
            const int l = r / CT_PER_LAYER; r -= l * CT_PER_LAYER;
            if (r < 848) { convT_tile(tile, P.in[I_W_IN] + (size_t)l * 1024 * NIN, 1024, NIN, (bf16_t*)(ws + OFF_WIN) + (size_t)l * NP * 1024, 1, 53, r); continue; } r -= 848;
            if (r < 256) { convT_tile(tile, P.in[I_W_OUT] + (size_t)l * 1024 * 1024, 1024, 1024, (bf16_t*)(ws + OFF_WOUT) + (size_t)l * 1024 * 1024, 0, 16, r); continue; } r -= 256;
            if (r < 64) { convT_tile(tile, P.in[I_W_MQ] + (size_t)l * 1024 * 256, 1024, 256, (bf16_t*)(ws + OFF_WMQ) + (size_t)l * 256 * 1024, 0, 4, r); continue; } r -= 64;
            if (r < 128) { convT_tile(tile, P.in[I_W_MKV] + (size_t)l * 1024 * 512, 1024, 512, (bf16_t*)(ws + OFF_WMKV) + (size_t)l * 512 * 1024, 0, 8, r); continue; } r -= 128;
            convT_tile(tile, P.in[I_W_MO] + (size_t)l * 256 * 1024, 256, 1024, (bf16_t*)(ws + OFF_WMO) + (size_t)l * 1024 * 256, 0, 16, r); continue;
        }
        r -= NL * CT_PER_LAYER;
        if (r < CT_GU) { const int m = r >> 7; convT_tile(tile, P.in[I_W_E_GU] + (size_t)m * 1024 * 512, 1024, 512, (bf16_t*)(ws + OFF_WGU) + (size_t)m * 512 * 1024, 2, 8, r & 127); continue; }
        r -= CT_GU;
        { const int m = r >> 6; convT_tile(tile, P.in[I_W_E_DN] + (size_t)m * 256 * 1024, 256, 1024, (bf16_t*)(ws + OFF_WDN) + (size_t)m * 1024 * 256, 0, 16, r & 63); }
    }
    for (int i = blockIdx.x * NTHR + TIDX; i < NL * (NP - NIN) * 512; i += gridDim.x * NTHR) {
        const int l = i / ((NP - NIN) * 512), w = i % ((NP - NIN) * 512);
        ((unsigned*)((bf16_t*)(ws + OFF_WIN) + (size_t)l * NP * 1024 + (size_t)NIN * 1024))[w] = 0u;
    }
    for (int i = blockIdx.x * NTHR + TIDX; i < NL * 48 * 1024; i += gridDim.x * NTHR) {
        const int l = i / (48 * 1024), r = (i / 1024) % 48, k = i & 1023;
        float w = 0.f;
        if (r < 4) w = P.in[I_W_RG][(size_t)l * 4096 + k * 4 + r]; else if (r < 36) w = P.in[I_W_RE][(size_t)l * 32768 + k * 32 + (r - 4)];
        const bf16_t hi = f2bf(w); const bf16_t lo = f2bf(w - bf2f(hi));
        bf16_t* wr = (bf16_t*)(ws + OFF_WR) + (size_t)l * 2 * 48 * 1024;
        wr[r * 1024 + k] = hi; wr[48 * 1024 + r * 1024 + k] = lo;
    }
    const int gw = blockIdx.x * 8 + (TIDX >> 6), ngw = gridDim.x * 8, lane = TIDX & 63;
    for (int row = gw; row < T + NL * 2048; row += ngw) {
        if (row < T) rms_row_bf16(P.in[I_X] + (size_t)row * 1024, P.in[I_NORM_MIX], (bf16_t*)(ws + OFF_HN) + (size_t)row * 1024, lane);
        else { const int r2 = row - T, l = r2 >> 11, rr = r2 & 2047;
               rms_row_bf16(P.in[I_MEM] + (size_t)rr * 1024, P.in[I_NORM_MEMKV] + l * 1024, (bf16_t*)(ws + OFF_MEMN) + (size_t)r2 * 1024, lane); }
    }
}

constexpr int GLD = 72;
constexpr int GEMM_LDS = (256 + 128) * GLD * 2;
template <class RowPtr>
__device__ __forceinline__ void gemm_tile(char* smem, RowPtr rowptr, const bf16_t* __restrict__ Bt, int ldb, int n0, int K, f32x4 (&acc)[4][4]) {
    bf16_t* sA = (bf16_t*)smem; bf16_t* sB = sA + 256 * GLD;
    const int tid = TIDX, lane = tid & 63, wave = tid >> 6, wm = wave >> 1, wn = wave & 1;
    const u32x4* ga[4]; const u32x4* gb[2];
#pragma unroll
    for (int i = 0; i < 4; ++i) { const int c = tid + i * 512, r = c >> 3, ch = c & 7; ga[i] = (const u32x4*)(rowptr(r) + ch * 8); }
#pragma unroll
    for (int i = 0; i < 2; ++i) { const int c = tid + i * 512, r = c >> 3, ch = c & 7; gb[i] = (const u32x4*)(Bt + (size_t)(n0 + r) * ldb + ch * 8); }
#pragma unroll
    for (int m = 0; m < 4; ++m)
#pragma unroll
        for (int n = 0; n < 4; ++n) acc[m][n] = (f32x4){0.f, 0.f, 0.f, 0.f};
    u32x4 ra[4], rb[2];
#pragma unroll
    for (int i = 0; i < 4; ++i) ra[i] = ga[i][0];
#pragma unroll
    for (int i = 0; i < 2; ++i) rb[i] = gb[i][0];
    const int nk = K / 64;
    for (int kt = 0; kt < nk; ++kt) {
        __syncthreads();
#pragma unroll
        for (int i = 0; i < 4; ++i) { const int c = tid + i * 512, r = c >> 3, ch = c & 7; *(u32x4*)(sA + r * GLD + ch * 8) = ra[i]; }
#pragma unroll
        for (int i = 0; i < 2; ++i) { const int c = tid + i * 512, r = c >> 3, ch = c & 7; *(u32x4*)(sB + r * GLD + ch * 8) = rb[i]; }
        __syncthreads();
        if (kt + 1 < nk) {
#pragma unroll
            for (int i = 0; i < 4; ++i) ra[i] = ga[i][(kt + 1) * 8];
#pragma unroll
            for (int i = 0; i < 2; ++i) rb[i] = gb[i][(kt + 1) * 8];
        }
#pragma unroll
        for (int kk = 0; kk < 2; ++kk) {
            bf16x8 af[4], bfr[4];
#pragma unroll
            for (int m = 0; m < 4; ++m) af[m] = *(const bf16x8*)(sA + (wm * 64 + m * 16 + (lane & 15)) * GLD + kk * 32 + (lane >> 4) * 8);
#pragma unroll
            for (int n = 0; n < 4; ++n) bfr[n] = *(const bf16x8*)(sB + (wn * 64 + n * 16 + (lane & 15)) * GLD + kk * 32 + (lane >> 4) * 8);
#pragma unroll
            for (int m = 0; m < 4; ++m)
#pragma unroll
                for (int n = 0; n < 4; ++n) acc[m][n] = __builtin_amdgcn_mfma_f32_16x16x32_bf16(bfr[n], af[m], acc[m][n], 0, 0, 0);
        }
    }
}
struct RowDirect { const bf16_t* A; int lda; int m0; __device__ __forceinline__ const bf16_t* operator()(int r) const { return A + (size_t)(m0 + r) * lda; } };
enum { EPI_INPROJ = 0, EPI_RESID = 1, EPI_BF16 = 2, EPI_BF16_RS = 3 };

__device__ __forceinline__ int vcu_id() { const int G = gridDim.x, bx = blockIdx.x; return (G % 8 == 0) ? (bx % 8) * (G / 8) + bx / 8 : bx; }

template <int EPI>
__device__ __forceinline__ void gemm_phase(char* smem, const bf16_t* A, int lda, const bf16_t* Bt, int ldb, int M, int N, int K, void* out, int ldo, const float* resid, float* gates, int idx0 = -1, int stride = 0) {
    const int ntn = N / 128, ntiles = (M / 256) * ntn;
    if (stride == 0) { idx0 = vcu_id(); stride = gridDim.x; }
    if (idx0 < 0) return;
    const int lane = TIDX & 63, wave = TIDX >> 6, wm = wave >> 1, wn = wave & 1;
    for (int tIdx = idx0; tIdx < ntiles; tIdx += stride) {
        const int m0 = (tIdx / ntn) * 256, n0 = (tIdx % ntn) * 128;
        f32x4 acc[4][4];
        RowDirect rp{A, lda, m0};
        gemm_tile(smem, rp, Bt, ldb, n0, K, acc);
#pragma unroll
        for (int m = 0; m < 4; ++m)
#pragma unroll
            for (int n = 0; n < 4; ++n) {
                const int row = m0 + wm * 64 + m * 16 + (lane & 15), col = n0 + wn * 64 + n * 16 + (lane >> 4) * 4;
                const f32x4 v = acc[m][n];
                if (EPI == EPI_INPROJ) {
                    uint2 o; o.x = pk2(v.x, v.y); o.y = pk2(v.z, v.w);
                    *(uint2*)((bf16_t*)out + (size_t)row * ldo + col) = o;
                    if (col >= C_GATE && col < C_GATE + 16) *(f32x4*)(gates + (size_t)row * 16 + (col - C_GATE)) = v;
                } else if (EPI == EPI_RESID) {
                    const f32x4 r = *(const f32x4*)(resid + (size_t)row * ldo + col);
                    *(f32x4*)((float*)out + (size_t)row * ldo + col) = r + v;
                } else if (EPI == EPI_BF16_RS) {
                    const float ri = rinv_from_pss(resid, (size_t)row);
                    uint2 o; o.x = pk2(v.x * ri, v.y * ri); o.y = pk2(v.z * ri, v.w * ri);
                    *(uint2*)((bf16_t*)out + (size_t)row * ldo + col) = o;
                } else {
                    uint2 o; o.x = pk2(v.x, v.y); o.y = pk2(v.z, v.w);
                    *(uint2*)((bf16_t*)out + (size_t)row * ldo + col) = o;
                }
            }
    }
}


namespace pg8 {
#define PG8_LAS __attribute__((address_space(3)))
typedef unsigned short bf16_t;
typedef short bf16x8 __attribute__((ext_vector_type(8)));
typedef float f32x4 __attribute__((ext_vector_type(4)));
typedef unsigned u32x4 __attribute__((ext_vector_type(4)));
constexpr int BM = 256, BK = 64, HALF = 128, HTB = HALF * BK * 2  , STAGE_BYTES = 8 * HTB, NXCD = 8, WGM = 8;

__host__ __device__ __forceinline__ int lds_byte(int r, int c) { const int st = (r >> 4) * 2 + (c >> 5), rr = r & 15, cc = c & 31, ob = rr * 64 + cc * 2; return st * 1024 + (ob ^ (((ob >> 9) & 1) << 5)); }
__host__ __device__ __forceinline__ void stage_rc(int b, int& R, int& C) { const int st = b / 1024, sb = b % 1024, swz = sb ^ (((sb >> 9) & 1) << 5); R = (st >> 1) * 16 + swz / 64; C = (st & 1) * 32 + (swz % 64) / 2; }
__host__ __device__ __forceinline__ int perm32(int rho) { const int n = rho >> 4, i = rho & 15; return 8 * (i >> 2) + 4 * n + (i & 3); }

struct Unit { int pm, pn; };
struct Gemm { const bf16_t* A; const bf16_t* Bt; int M, N, K; };

struct StaticOrder {
    int nM, nN, nwg, G, c;
    __host__ __device__ void init(int M, int N, int G_, int c_) { nM = M / BM; nN = N / BM; nwg = nM * nN; G = G_; c = c_; }
    __host__ __device__ bool next(int i, Unit& u) const {
        const long L = (long)i * G + c; if (L >= nwg) return false;
        int wgid = (int)L; { const int q = nwg / NXCD, r = nwg % NXCD, xcd = wgid % NXCD, off = wgid / NXCD; wgid = (xcd < r ? xcd * (q + 1) : r * (q + 1) + (xcd - r) * q) + off; }
        const int nig = WGM * nN, gid = wgid / nig, fm = gid * WGM, gsz = (nM - fm) < WGM ? (nM - fm) : WGM;
        u.pm = fm + ((wgid % nig) % gsz); u.pn = (wgid % nig) / gsz; return true;
    }
    __device__ __forceinline__ void a_ready(const Unit&) const {}
    __device__ __forceinline__ void done(const Unit&) const {}
};
__device__ __forceinline__ unsigned cvt_pk_bf16(float lo, float hi) { unsigned r; asm volatile("v_cvt_pk_bf16_f32 %0, %1, %2" : "=v"(r) : "v"(lo), "v"(hi)); return r; }
typedef float f32x2 __attribute__((ext_vector_type(2)));

struct EpiInProj {
    static constexpr bool PERM = true, AFTER_DRAIN = false;
    bf16_t* O; int ldc; float* gates; int gate_col;
    __device__ __forceinline__ void operator()(const f32x4 (&acc)[2][2][4][2], const Unit& u, int wr, int wc, int fr, int fq) const {
        const int row0 = u.pm * BM + wr * 64 + fr, col0 = u.pn * BM + wc * 32 + 8 * fq;
#pragma unroll
        for (int ai = 0; ai < 2; ++ai)
#pragma unroll
            for (int m = 0; m < 4; ++m) {
                const int row = row0 + ai * HALF + m * 16;
                bf16_t* rowp = O + (size_t)row * ldc + col0;
#pragma unroll
                for (int bj = 0; bj < 2; ++bj) {
                    const f32x4 v0 = acc[ai][bj][m][0], v1 = acc[ai][bj][m][1];
                    u32x4 w; w.x = cvt_pk_bf16(v0[0], v0[1]); w.y = cvt_pk_bf16(v0[2], v0[3]); w.z = cvt_pk_bf16(v1[0], v1[1]); w.w = cvt_pk_bf16(v1[2], v1[3]);
                    *(u32x4*)(rowp + bj * HALF) = w;
                    const int gc = col0 + bj * HALF - gate_col;
                    if (gates && gc >= 0 && gc < 16) { *(f32x4*)(gates + (size_t)row * 16 + gc) = v0; *(f32x4*)(gates + (size_t)row * 16 + gc + 4) = v1; }
                }
            }
    }
};
struct EpiResid {
    static constexpr bool PERM = false, AFTER_DRAIN = false;
    const float* base; float* out; int ldc;
    __device__ __forceinline__ void operator()(const f32x4 (&acc)[2][2][4][2], const Unit& u, int wr, int wc, int fr, int fq) const {
        const int col0 = u.pn * BM + wc * 32 + 4 * fq;
#pragma unroll
        for (int ai = 0; ai < 2; ++ai)
#pragma unroll
            for (int m = 0; m < 4; ++m) {
                const size_t off = (size_t)(u.pm * BM + ai * HALF + wr * 64 + m * 16 + fr) * ldc + col0;
#pragma unroll
                for (int bj = 0; bj < 2; ++bj)
#pragma unroll
                    for (int n = 0; n < 2; ++n) { const f32x4 bs = *(const f32x4*)(base + off + bj * HALF + n * 16); *(f32x4*)(out + off + bj * HALF + n * 16) = bs + acc[ai][bj][m][n]; }
                if (m & 1) asm volatile("" ::: "memory");
            }
    }
};

struct EpiResidNorm {
    static constexpr bool PERM = false, AFTER_DRAIN = false;
    const float* base; float* out; int ldc; const float* gn; bf16_t* xg; float* pss;
    __device__ __forceinline__ void operator()(const f32x4 (&acc)[2][2][4][2], const Unit& u, int wr, int wc, int fr, int fq) const {
        const int col0 = u.pn * BM + wc * 32 + 4 * fq;
        f32x4 gv[2][2];
#pragma unroll
        for (int bj = 0; bj < 2; ++bj)
#pragma unroll
            for (int n = 0; n < 2; ++n) gv[bj][n] = *(const f32x4*)(gn + col0 + bj * HALF + n * 16);
#pragma unroll
        for (int ai = 0; ai < 2; ++ai)
#pragma unroll
            for (int m = 0; m < 4; ++m) {
                const int row = u.pm * BM + ai * HALF + wr * 64 + m * 16 + fr;
                const size_t off = (size_t)row * ldc + col0;
                float ss = 0.f;
#pragma unroll
                for (int bj = 0; bj < 2; ++bj)
#pragma unroll
                    for (int n = 0; n < 2; ++n) {
                        const f32x4 bs = *(const f32x4*)(base + off + bj * HALF + n * 16);
                        const f32x4 o = bs + acc[ai][bj][m][n];
                        *(f32x4*)(out + off + bj * HALF + n * 16) = o;
                        ss += (o[0] * o[0] + o[1] * o[1]) + (o[2] * o[2] + o[3] * o[3]);
                        const f32x4 og = o * gv[bj][n];
                        uint2 w; w.x = cvt_pk_bf16(og[0], og[1]); w.y = cvt_pk_bf16(og[2], og[3]);
                        *(uint2*)(xg + off + bj * HALF + n * 16) = w;
                    }
                ss += __shfl_xor(ss, 16); ss += __shfl_xor(ss, 32);
                if (fq == 0) pss[(size_t)row * 16 + u.pn * 4 + wc] = ss;
                if (m & 1) asm volatile("" ::: "memory");
            }
    }
};
template <class Epi, class Sched, bool ALIGN_EPI = false, bool SP2 = false>
__device__ __forceinline__ void gemm_phase(PG8_LAS unsigned char* lds, const Gemm g, const Sched& S, const Epi& E) {
    const int tid = TIDX, wid = __builtin_amdgcn_readfirstlane(tid >> 6), lane = tid & 63, wr = wid >> 2, wc = wid & 3, fr = lane & 15, fq = lane >> 4;
    const int K = g.K, nt = K / BK;
    unsigned voffA[2], voffB[2];
#pragma unroll
    for (int i = 0; i < 2; ++i) { int R, C; stage_rc(tid * 16 + i * 8192, R, C); const int Rb = Epi::PERM ? ((R & ~31) + perm32(R & 31)) : R;
        voffA[i] = (unsigned)(R * K + C) * 2u; voffB[i] = (unsigned)(Rb * K + C) * 2u; }
    const size_t kstep = (size_t)(BK * 2);
    const size_t hstep = (size_t)HALF * K * 2;
    const size_t tstep = 2 * hstep;
    const unsigned ldsw = (unsigned)wid * 1024u;
    const int aoff = lds_byte(wr * 64 + fr, fq * 8), boff = lds_byte(wc * 32 + fr, fq * 8);
#define PG8_SA(b, h) (((b) * 2 + (h)) * HTB)
#define PG8_SB(b, h) ((4 + (b) * 2 + (h)) * HTB)
#define PG8_STAGE(bufoff, gbase, voff) do { _Pragma("unroll") for (int _i = 0; _i < 2; ++_i) \
        __builtin_amdgcn_global_load_lds((const unsigned*)((const char*)(gbase) + (voff)[_i]), (PG8_LAS unsigned*)(lds + (bufoff) + ldsw + _i * 8192), 16, 0, 0); } while (0)
#define PG8_LDA(dst, b, h) do { _Pragma("unroll") for (int m = 0; m < 4; ++m) _Pragma("unroll") for (int k = 0; k < 2; ++k) dst[m][k] = *(const PG8_LAS bf16x8*)(lds + PG8_SA(b, h) + aoff + m * 2048 + k * 1024); } while (0)
#define PG8_LDB(dst, b, h) do { _Pragma("unroll") for (int n = 0; n < 2; ++n) _Pragma("unroll") for (int k = 0; k < 2; ++k) dst[n][k] = *(const PG8_LAS bf16x8*)(lds + PG8_SB(b, h) + boff + n * 2048 + k * 1024); } while (0)
#define PG8_MMA(ai, bj, At, Bt) do { __builtin_amdgcn_s_setprio(1); _Pragma("unroll") for (int m = 0; m < 4; ++m) _Pragma("unroll") for (int n = 0; n < 2; ++n) _Pragma("unroll") for (int k = 0; k < 2; ++k) \
        acc[ai][bj][m][n] = __builtin_amdgcn_mfma_f32_16x16x32_bf16(Bt[n][k], At[m][k], acc[ai][bj][m][n], 0, 0, 0); __builtin_amdgcn_s_setprio(0); } while (0)
#define PG8_WAIT_V(n) asm volatile("s_waitcnt vmcnt(" #n ")" ::: "memory")
#define PG8_WAIT_L(n) asm volatile("s_waitcnt lgkmcnt(" #n ")" ::: "memory")
#define PG8_BAR __builtin_amdgcn_s_barrier()
#define PG8_SCHED __builtin_amdgcn_sched_barrier(0)
    Unit cur, nxt; int ui = 0;
    if (!S.next(0, cur)) return;
    f32x4 acc[2][2][4][2];
#pragma unroll
    for (int a = 0; a < 2; ++a)
#pragma unroll
        for (int b = 0; b < 2; ++b)
#pragma unroll
            for (int m = 0; m < 4; ++m)
#pragma unroll
                for (int n = 0; n < 2; ++n) acc[a][b][m][n] = (f32x4){0.f, 0.f, 0.f, 0.f};
    bf16x8 At[4][2], B0[2][2], B1[2][2];
    const char* cA = (const char*)g.A + (size_t)cur.pm * tstep; const char* cB = (const char*)g.Bt + (size_t)cur.pn * tstep;
    S.a_ready(cur);
    if constexpr (SP2) {
        PG8_STAGE(PG8_SB(0, 0), cB, voffB); PG8_STAGE(PG8_SB(0, 1), cB + hstep, voffB); PG8_STAGE(PG8_SA(0, 0), cA, voffA); PG8_STAGE(PG8_SA(0, 1), cA + hstep, voffA);
        if (wr == 1) PG8_BAR;
        PG8_WAIT_V(2); PG8_BAR;
        PG8_STAGE(PG8_SB(1, 0), cB + kstep, voffB); PG8_STAGE(PG8_SA(1, 0), cA + kstep, voffA); PG8_STAGE(PG8_SB(1, 1), cB + hstep + kstep, voffB);
        PG8_WAIT_V(6); PG8_BAR;
    } else {
        PG8_STAGE(PG8_SB(0, 0), cB, voffB); PG8_STAGE(PG8_SA(0, 0), cA, voffA); PG8_STAGE(PG8_SB(0, 1), cB + hstep, voffB); PG8_STAGE(PG8_SA(0, 1), cA + hstep, voffA);
        if (wr == 1) PG8_BAR;
        PG8_WAIT_V(4); PG8_BAR;
        PG8_STAGE(PG8_SB(1, 0), cB + kstep, voffB); PG8_STAGE(PG8_SA(1, 0), cA + kstep, voffA); PG8_STAGE(PG8_SB(1, 1), cB + hstep + kstep, voffB);
        PG8_WAIT_V(6); PG8_BAR;
    }
    for (;;) {
        const bool has_next = S.next(ui + 1, nxt);
        const char* nA = has_next ? (const char*)g.A + (size_t)nxt.pm * tstep : cA; const char* nB = has_next ? (const char*)g.Bt + (size_t)nxt.pn * tstep : cB;
        for (int t = 0; t < nt; t += 2) {
            const bool last = (t == nt - 2);
            const char* a1 = cA + (size_t)(t + 1) * kstep;
            const char* a2 = last ? nA : cA + (size_t)(t + 2) * kstep; const char* b2 = last ? nB : cB + (size_t)(t + 2) * kstep;
            const char* a3 = a2 + kstep; const char* b3 = b2 + kstep;
            if (last && has_next) S.a_ready(nxt);
            if constexpr (SP2) {
            PG8_LDB(B0, 0, 0); PG8_LDB(B1, 0, 1); PG8_SCHED; PG8_LDA(At, 0, 0); PG8_STAGE(PG8_SA(1, 1), a1 + hstep, voffA);
            PG8_WAIT_V(8); PG8_WAIT_L(0); PG8_BAR; PG8_MMA(0, 0, At, B0); PG8_MMA(0, 1, At, B1); PG8_BAR; PG8_SCHED;
            PG8_LDA(At, 0, 1); PG8_STAGE(PG8_SB(0, 0), b2, voffB); PG8_STAGE(PG8_SB(0, 1), b2 + hstep, voffB); PG8_STAGE(PG8_SA(0, 0), a2, voffA);
            PG8_WAIT_V(8); PG8_WAIT_L(0); PG8_BAR; PG8_MMA(1, 0, At, B0); PG8_MMA(1, 1, At, B1); PG8_BAR; PG8_SCHED;
            PG8_LDB(B0, 1, 0); PG8_LDB(B1, 1, 1); PG8_SCHED; PG8_LDA(At, 1, 0); PG8_STAGE(PG8_SA(0, 1), a2 + hstep, voffA);
            PG8_WAIT_V(8); PG8_WAIT_L(0); PG8_BAR; PG8_MMA(0, 0, At, B0); PG8_MMA(0, 1, At, B1); PG8_BAR; PG8_SCHED;
            PG8_LDA(At, 1, 1); PG8_STAGE(PG8_SB(1, 0), b3, voffB); PG8_STAGE(PG8_SB(1, 1), b3 + hstep, voffB); PG8_STAGE(PG8_SA(1, 0), a3, voffA);
            PG8_WAIT_V(8); PG8_WAIT_L(0); PG8_BAR; PG8_MMA(1, 0, At, B0); PG8_MMA(1, 1, At, B1); PG8_BAR; PG8_SCHED;
            } else {
            PG8_LDB(B0, 0, 0); PG8_SCHED; PG8_LDA(At, 0, 0); PG8_STAGE(PG8_SA(1, 1), a1 + hstep, voffA);
            PG8_WAIT_L(8); PG8_BAR; PG8_WAIT_L(0); PG8_MMA(0, 0, At, B0); PG8_BAR; PG8_SCHED;
            PG8_LDB(B1, 0, 1); PG8_STAGE(PG8_SB(0, 0), b2, voffB);
            PG8_BAR; PG8_WAIT_L(0); PG8_MMA(0, 1, At, B1); PG8_BAR;
            PG8_LDA(At, 0, 1); PG8_STAGE(PG8_SA(0, 0), a2, voffA);
            PG8_BAR; PG8_WAIT_L(0); PG8_MMA(1, 0, At, B0); PG8_BAR; PG8_SCHED;
            PG8_STAGE(PG8_SB(0, 1), b2 + hstep, voffB);
            PG8_WAIT_V(6); PG8_BAR; PG8_MMA(1, 1, At, B1); PG8_BAR;
            PG8_LDB(B0, 1, 0); PG8_SCHED; PG8_LDA(At, 1, 0); PG8_STAGE(PG8_SA(0, 1), a2 + hstep, voffA);
            PG8_WAIT_L(8); PG8_BAR; PG8_WAIT_L(0); PG8_MMA(0, 0, At, B0); PG8_BAR; PG8_SCHED;
            PG8_LDB(B1, 1, 1); PG8_STAGE(PG8_SB(1, 0), b3, voffB);
            PG8_BAR; PG8_WAIT_L(0); PG8_MMA(0, 1, At, B1); PG8_BAR;
            PG8_LDA(At, 1, 1); PG8_STAGE(PG8_SA(1, 0), a3, voffA);
            PG8_BAR; PG8_WAIT_L(0); PG8_MMA(1, 0, At, B0); PG8_BAR; PG8_SCHED;
            PG8_STAGE(PG8_SB(1, 1), b3 + hstep, voffB);
            PG8_WAIT_V(6); PG8_BAR; PG8_MMA(1, 1, At, B1); PG8_BAR;
            }
        }
        if constexpr (ALIGN_EPI) { if (wr == 0) PG8_BAR; }
        if constexpr (!Epi::AFTER_DRAIN) { E(acc, cur, wr, wc, fr, fq); S.done(cur); }
        if (!has_next) break;
#pragma unroll
        for (int a = 0; a < 2; ++a)
#pragma unroll
            for (int b = 0; b < 2; ++b)
#pragma unroll
                for (int m = 0; m < 4; ++m)
#pragma unroll
                    for (int n = 0; n < 2; ++n) acc[a][b][m][n] = (f32x4){0.f, 0.f, 0.f, 0.f};
        cur = nxt; cA = nA; cB = nB; ++ui;
        if constexpr (ALIGN_EPI) { if (wr == 1) PG8_BAR; }
    }
    PG8_WAIT_V(0);
    if constexpr (!ALIGN_EPI) { if (wr == 0) PG8_BAR; }
    PG8_BAR;
    if constexpr (Epi::AFTER_DRAIN) { E.fused(acc, cur, wr, wc, fr, fq, lds, wid, lane); S.done(cur); }
#undef PG8_SA
#undef PG8_SB
#undef PG8_STAGE
#undef PG8_LDA
#undef PG8_LDB
#undef PG8_MMA
#undef PG8_WAIT_V
#undef PG8_WAIT_L
#undef PG8_BAR
#undef PG8_SCHED
}
}

struct RowGather { const bf16_t* A; int lda; const int* ids; int shift; __device__ __forceinline__ const bf16_t* operator()(int r) const { return A + (size_t)(ids[r] >> shift) * lda; } };
template <int STAGE>
__device__ __forceinline__ void moe_phase(char* smem, const bf16_t* A, int lda, const bf16_t* Wt, size_t wstride, int ldb, int K, const int* cnt, const int* list, const float* pgate, bf16_t* out, const float* pss) {
    int* ids = (int*)(smem + GEMM_LDS);
    int* tpre = ids + 256;
    constexpr int NTN = (STAGE == 1) ? 4 : 8;
    __syncthreads();
    if (TIDX < 64) {
        const int ln = TIDX; int nt = (ln < NEXP) ? ((cnt[ln * CNT_STRIDE] + 255) >> 8) : 0; int inc = nt;
#pragma unroll
        for (int o = 1; o < 64; o <<= 1) { const int nb = __shfl_up(inc, o); if (ln >= o) inc += nb; }
        if (ln <= NEXP) tpre[ln] = inc - nt;
    }
    __syncthreads();
    const int ntiles = tpre[NEXP] * NTN;
    const int lane = TIDX & 63, wave = TIDX >> 6, wm = wave >> 1, wn = wave & 1;
    for (int tIdx = vcu_id(); tIdx < ntiles; tIdx += gridDim.x) {
        const int mtg = tIdx / NTN, n0 = (tIdx % NTN) * 128;
        int e = 0;
        for (int i = 1; i < NEXP; ++i) if (tpre[i] <= mtg) e = i;
        const int mt = mtg - tpre[e];
        const int cn = cnt[e * CNT_STRIDE];
        __syncthreads();
        if (TIDX < 256) { const int pos = mt * 256 + TIDX; ids[TIDX] = list[(size_t)e * T + (pos < cn ? pos : cn - 1)]; }
        __syncthreads();
        f32x4 acc[4][4];
        RowGather rp{A, lda, ids, STAGE == 1 ? 1 : 0};
        gemm_tile(smem, rp, Wt + (size_t)e * wstride, ldb, n0, K, acc);
#pragma unroll
        for (int m = 0; m < 4; ++m) {
            const int rl = wm * 64 + m * 16 + (lane & 15);
            if (mt * 256 + rl >= cn) continue;
            const int pid = ids[rl];
            if (STAGE == 1) {
                const float gt = pgate[pid], ri = rinv_from_pss(pss, (size_t)(pid >> 1));
#pragma unroll
                for (int np = 0; np < 2; ++np) {
                    const f32x4 g = acc[m][2 * np], u = acc[m][2 * np + 1];
                    const int j = (n0 + wn * 64 + np * 32) / 2 + (lane >> 4) * 4;
                    const f32x4 gs = g * ri; const float ug = ri * gt;
                    uint2 o; o.x = pk2(siluf_(gs.x) * u.x * ug, siluf_(gs.y) * u.y * ug); o.y = pk2(siluf_(gs.z) * u.z * ug, siluf_(gs.w) * u.w * ug);
                    *(uint2*)(out + (size_t)pid * DEXP + j) = o;
                }
            } else {
#pragma unroll
                for (int n = 0; n < 4; ++n) {
                    const f32x4 v = acc[m][n]; const int col = n0 + wn * 64 + n * 16 + (lane >> 4) * 4;
                    uint2 o; o.x = pk2(v.x, v.y); o.y = pk2(v.z, v.w);
                    *(uint2*)(out + (size_t)pid * 1024 + col) = o;
                }
            }
        }
    }
}

__device__ __forceinline__ void hgrn2_naive(const bf16_t* __restrict__ proj, const float* __restrict__ hgrn_lb, int layer, const float* __restrict__ mix_gain, bf16_t* __restrict__ y, int bh, int lane) {
    const int b = bh >> 2, h = bh & 3;
    float lbk = 0.f;
    if (layer == 1) { float a0 = hgrn_lb[h * 64 + lane], a1 = hgrn_lb[256 + h * 64 + lane]; lbk = 1.f / (1.f + __expf(a0 - a1)); }
    const float mg = mix_gain[C_AQ + h * 64 + lane];
    float S[64];
#pragma unroll
    for (int k = 0; k < 64; ++k) S[k] = 0.f;
    for (int t = 0; t < SEQ; ++t) {
        const bf16_t* pr = proj + (size_t)(b * SEQ + t) * NP + h * 64 + lane;
        const float qk = siluf_(bf2f(pr[C_AQ]));
        const float sg = sigmoidf_(bf2f(pr[C_AF]));
        const float f = lbk + (1.f - lbk) * sg, kk = (1.f - lbk) * (1.f - sg);
        const float iv = bf2f(pr[C_AI]);
        const float gv = bf2f(pr[C_AG]);
        float o = 0.f;
#pragma unroll
        for (int k = 0; k < 64; ++k) { S[k] = rdlane(f, k) * S[k] + rdlane(kk, k) * iv; o += rdlane(qk, k) * S[k]; }
        const float ms = wave_sum(o * o) * (1.f / 64.f);
        const float yv = o * rsqrtf(ms + EPS) * siluf_(gv) * mg;
        y[(size_t)(b * SEQ + t) * 1024 + 0 + h * 64 + lane] = f2bf(yv);
    }
}
__device__ __forceinline__ void gdn_naive(const bf16_t* __restrict__ proj, const float* __restrict__ gates, const float* __restrict__ conv_w  ,
                                          const float* __restrict__ a_log, const float* __restrict__ dt_bias, const float* __restrict__ mix_gain, bf16_t* __restrict__ y, int bh, int lane) {
    const int b = bh >> 2, h = bh & 3;
    float wq[4], wk[4], wv[4];
#pragma unroll
    for (int j = 0; j < 4; ++j) { wq[j] = conv_w[j * 768 + h * 64 + lane]; wk[j] = conv_w[j * 768 + 256 + h * 64 + lane]; wv[j] = conv_w[j * 768 + 512 + h * 64 + lane]; }
    float xq[3] = {0.f, 0.f, 0.f}, xk[3] = {0.f, 0.f, 0.f}, xv[3] = {0.f, 0.f, 0.f};
    const float Aexp = __expf(a_log[h]), dtb = dt_bias[h];
    const float mg = mix_gain[768 + h * 64 + lane];
    float S[64];
#pragma unroll
    for (int k = 0; k < 64; ++k) S[k] = 0.f;
    for (int t = 0; t < SEQ; ++t) {
        const size_t row = (size_t)(b * SEQ + t);
        const bf16_t* pr = proj + row * NP + h * 64 + lane;
        const float q0 = bf2f(pr[C_DQ]), k0 = bf2f(pr[C_DK]), v0 = bf2f(pr[C_DV]), zv = bf2f(pr[C_DZ]);
        float q = siluf_(wq[0] * xq[0] + wq[1] * xq[1] + wq[2] * xq[2] + wq[3] * q0);
        float k = siluf_(wk[0] * xk[0] + wk[1] * xk[1] + wk[2] * xk[2] + wk[3] * k0);
        float v = siluf_(wv[0] * xv[0] + wv[1] * xv[1] + wv[2] * xv[2] + wv[3] * v0);
        xq[0] = xq[1]; xq[1] = xq[2]; xq[2] = q0; xk[0] = xk[1]; xk[1] = xk[2]; xk[2] = k0; xv[0] = xv[1]; xv[1] = xv[2]; xv[2] = v0;
        q = q * rsqrtf(wave_sum(q * q) + EPS) * 0.125f;
        k = k * rsqrtf(wave_sum(k * k) + EPS);
        const float beta = sigmoidf_(gates[row * 16 + 4 + h]);
        const float g = -Aexp * softplusf_(gates[row * 16 + 8 + h] + dtb);
        const float eg = __expf(g);
        float r = 0.f;
#pragma unroll
        for (int i = 0; i < 64; ++i) { S[i] *= eg; r += rdlane(k, i) * S[i]; }
        const float dlt = beta * (v - r);
        float o = 0.f;
#pragma unroll
        for (int i = 0; i < 64; ++i) { S[i] += rdlane(k, i) * dlt; o += rdlane(q, i) * S[i]; }
        const float ms = wave_sum(o * o) * (1.f / 64.f);
        const float yv = o * rsqrtf(ms + EPS) * siluf_(zv) * mg;
        y[row * 1024 + 768 + h * 64 + lane] = f2bf(yv);
    }
}
__device__ __forceinline__ void fox_cumsum(const float* __restrict__ gates, const float* __restrict__ fb, float* __restrict__ cc, int bh, int lane) {
    const int b = bh >> 2, h = bh & 3;
    const float bias = fb[h];
    float v[32];
#pragma unroll
    for (int i = 0; i < 32; ++i) v[i] = gates[(size_t)(b * SEQ + lane * 32 + i) * 16 + h];
    float run = 0.f;
#pragma unroll
    for (int i = 0; i < 32; ++i) { run += logsigmoidf_(v[i] + bias); v[i] = run; }
    float tot = run;
#pragma unroll
    for (int o = 1; o < 64; o <<= 1) { const float nb = __shfl_up(tot, o); if (lane >= o) tot += nb; }
    const float off = tot - run;
    float* dst = cc + (size_t)(b * 4 + h) * SEQ + lane * 32;
#pragma unroll
    for (int i = 0; i < 32; i += 4) *(f32x4*)(dst + i) = (f32x4){v[i] + off, v[i + 1] + off, v[i + 2] + off, v[i + 3] + off};
}
__device__ __forceinline__ void lru_prep_task(float* xc  , const bf16_t* __restrict__ proj, const float* __restrict__ conv_w, const float* __restrict__ conv_b,
                                              const float* __restrict__ w_a, const float* __restrict__ b_a, const float* __restrict__ w_x, const float* __restrict__ b_x,
                                              const float* __restrict__ lam, float* __restrict__ a_out, float* __restrict__ u_out, int task, bool active) {
    const int c = TIDX & 255, t0 = task * 16;
    if (active) {
        const float w0 = conv_w[c], w1 = conv_w[256 + c], w2 = conv_w[512 + c], w3 = conv_w[768 + c], cb = conv_b[c];
        for (int i = 0; i < 16; ++i) {
            const int t = t0 + i, s = t & (SEQ - 1);
            const bf16_t* pr = proj + (size_t)t * NP + C_CX + c;
            float acc = cb + w3 * bf2f(pr[0]);
            if (s >= 1) acc += w2 * bf2f(pr[-(ptrdiff_t)NP]);
            if (s >= 2) acc += w1 * bf2f(pr[-(ptrdiff_t)2 * NP]);
            if (s >= 3) acc += w0 * bf2f(pr[-(ptrdiff_t)3 * NP]);
            xc[i * 256 + c] = acc;
        }
    }
    __syncthreads();
    if (active) {
        const int h = c >> 6, jj = c & 63;
        float ra[16], rx[16];
#pragma unroll
        for (int i = 0; i < 16; ++i) { ra[i] = 0.f; rx[i] = 0.f; }
        for (int k = 0; k < 64; ++k) {
            const float wa = w_a[(h * 64 + k) * 64 + jj], wx = w_x[(h * 64 + k) * 64 + jj];
#pragma unroll
            for (int i = 0; i < 16; ++i) { const float xv = xc[i * 256 + h * 64 + k]; ra[i] += xv * wa; rx[i] += xv * wx; }
        }
        const float ba = b_a[c], bx = b_x[c], sp = softplusf_(-lam[c]);
#pragma unroll
        for (int i = 0; i < 16; ++i) {
            const float r = sigmoidf_(ra[i] + ba), ig = sigmoidf_(rx[i] + bx);
            const float log_a = -8.f * r * sp;
            const float a = __expf(log_a);
            const float u = sqrtf(-expm1f(2.f * log_a)) * (ig * xc[i * 256 + c]);
            a_out[(size_t)(t0 + i) * 256 + c] = a; u_out[(size_t)(t0 + i) * 256 + c] = u;
        }
    }
    __syncthreads();
}
__device__ __forceinline__ void lru_scan_task(const float* __restrict__ a_in, const float* __restrict__ u_in, const bf16_t* __restrict__ proj, const float* __restrict__ mix_gain, bf16_t* __restrict__ y, int b) {
    const int c = TIDX;
    const float mg = mix_gain[512 + c];
    float hst = 0.f;
    for (int t = 0; t < SEQ; ++t) {
        const size_t row = (size_t)(b * SEQ + t);
        hst = a_in[row * 256 + c] * hst + u_in[row * 256 + c];
        const float yv = hst * geluf_(bf2f(proj[row * NP + C_CG + c]));
        const float ms = wave_sum(yv * yv) * (1.f / 64.f);
        y[row * 1024 + 512 + c] = f2bf(yv * rsqrtf(ms + EPS) * mg);
    }
}

typedef short s16x4 __attribute__((ext_vector_type(4)));
#define LDS_AS __attribute__((address_space(3)))
__device__ __forceinline__ bf16x8 frag_rm(const bf16_t* tile, int ld, int r0, int k0, int lane) { return *(const bf16x8*)(tile + (r0 + (lane & 15)) * ld + k0 + (lane >> 4) * 8); }
__device__ __forceinline__ s16x4 tr4(const bf16_t* tile, int ld, int rbase, int c0, int lane) {
    const bf16_t* p = tile + (rbase + ((lane & 15) >> 2)) * ld + c0 + 4 * (lane & 3);
    return __builtin_amdgcn_ds_read_tr16_b64_v4i16((LDS_AS s16x4*)p);
}
__device__ __forceinline__ bf16x8 frag_cm(const bf16_t* tile, int ld, int k0, int c0, int lane) {
    const s16x4 lo = tr4(tile, ld, k0 + (lane >> 4) * 8, c0, lane), hi = tr4(tile, ld, k0 + (lane >> 4) * 8 + 4, c0, lane);
    return (bf16x8){lo[0], lo[1], lo[2], lo[3], hi[0], hi[1], hi[2], hi[3]};
}
#define MFMA16(a, b, c) __builtin_amdgcn_mfma_f32_16x16x32_bf16((a), (b), (c), 0, 0, 0)
constexpr int TLD = 72;


#define XB_TMO      128
#define XB_XCNT(j)  (256  + 64 * (j))
#define XB_XSUB(j)  (1280 + 64 * (j))
#define XB_XGEN(j)  (2304 + 64 * (j))
#define XB_TOP      3328
#define XB_TOPGEN   3392
#define XCD_BAR_WORDS 3456
#define XB_SPIN_CAP (1u << 18)
__device__ __forceinline__ unsigned xb_ld(unsigned* p)              { return __hip_atomic_load(p, __ATOMIC_RELAXED, __HIP_MEMORY_SCOPE_AGENT); }
__device__ __forceinline__ unsigned xb_add(unsigned* p, unsigned v) { return __hip_atomic_fetch_add(p, v, __ATOMIC_RELAXED, __HIP_MEMORY_SCOPE_AGENT); }
__device__ __forceinline__ unsigned xb_xcc_id() { return (unsigned)__builtin_amdgcn_s_getreg((3 << 11) | 20) & 0xFu; }
#define XB_SPIN(cond, bar) do { unsigned _sp = 0; while (cond) { __builtin_amdgcn_s_sleep(1); \
    if ((++_sp & 255u) == 0u) { if (xb_ld(&(bar)[XB_TMO])) break; if (_sp > XB_SPIN_CAP) { atomicAdd(&(bar)[XB_TMO], 1u); break; } } } } while (0)
struct XcdBarrier { unsigned* bar; unsigned x; volatile LDS_AS unsigned* st; };
__device__ __forceinline__ XcdBarrier xcd_barrier_post(unsigned* bar, volatile LDS_AS unsigned* st) {
    XcdBarrier b; b.bar = bar; b.x = xb_xcc_id(); b.st = st;
    if (TIDX == 0) (void)xb_add(&bar[XB_XCNT(b.x)], 1u);
    return b;
}
__device__ __forceinline__ void xcd_barrier_complete(unsigned* bar, unsigned x, unsigned& nloc, unsigned& nx) {
    const unsigned G = gridDim.x * gridDim.y * gridDim.z;
    unsigned sum, cnt, mine, sp = 0u;
    for (;;) {
        sum = 0u; cnt = 0u; mine = 0u;
#pragma unroll
        for (unsigned j = 0; j < 16; ++j) { const unsigned c = xb_ld(&bar[XB_XCNT(j)]); sum += c; cnt += (c > 0u) ? 1u : 0u; mine = (j == x) ? c : mine; }
        if (sum == G) break;
        __builtin_amdgcn_s_sleep(1);
        if ((++sp & 255u) == 0u) { if (xb_ld(&bar[XB_TMO])) break; if (sp > XB_SPIN_CAP) { atomicAdd(&bar[XB_TMO], 1u); break; } }
    }
    nloc = mine > 0u ? mine : 1u; nx = cnt > 0u ? cnt : 1u;
}
__device__ __forceinline__ void xcd_barrier(const XcdBarrier& b) {
    asm volatile("s_waitcnt vmcnt(0)" ::: "memory");
    __syncthreads();
    if (TIDX == 0) {
        unsigned* bar = b.bar;
        __builtin_amdgcn_s_waitcnt(0);
        unsigned nloc = b.st[0], nx = b.st[1];
        if (nloc == 0u) { xcd_barrier_complete(bar, b.x, nloc, nx); b.st[0] = nloc; b.st[1] = nx; }
        const unsigned old = xb_add(&bar[XB_XSUB(b.x)], 1u);
        const unsigned gen = old / nloc;
        if (old + 1u == (gen + 1u) * nloc) {
            __builtin_amdgcn_fence(__ATOMIC_RELEASE, "agent");
            asm volatile("s_waitcnt vmcnt(0)" ::: "memory");
            const unsigned og = xb_add(&bar[XB_TOP], 1u);
            const unsigned tg = og / nx;
            if (og + 1u == (tg + 1u) * nx) xb_add(&bar[XB_TOPGEN], 1u);
            else XB_SPIN(xb_ld(&bar[XB_TOPGEN]) == tg, bar);
            __builtin_amdgcn_fence(__ATOMIC_ACQUIRE, "agent");
            xb_add(&bar[XB_XGEN(b.x)], 1u);
            asm volatile("s_waitcnt vmcnt(0)" ::: "memory");
        } else {
            XB_SPIN(xb_ld(&bar[XB_XGEN(b.x)]) == gen, bar);
            __builtin_amdgcn_fence(__ATOMIC_ACQUIRE, "agent");
            asm volatile("s_waitcnt vmcnt(0)" ::: "memory");
        }
    }
    __syncthreads();
}

template <bool MASK>
__device__ __forceinline__ void attn_compute_t(const bf16_t* cK, const bf16_t* cV, const float* cC, const bf16x8 (&qf)[2], f32x4 (&oacc)[4], float& mrun, float& lrun,
                                               float ct2, float scale2, int kt, int tq, int lane, int g) {
    f32x4 sacc[4];
#pragma unroll
    for (int n = 0; n < 4; ++n) {
        sacc[n] = (f32x4){0.f, 0.f, 0.f, 0.f};
#pragma unroll
        for (int kk = 0; kk < 2; ++kk) sacc[n] = MFMA16(frag_rm(cK, TLD, n * 16, kk * 32, lane), qf[kk], sacc[n]);
    }
    float mx = -INFINITY;
#pragma unroll
    for (int n = 0; n < 4; ++n) {
        const f32x4 cs = *(const f32x4*)(cC + n * 16 + 4 * g);
#pragma unroll
        for (int r = 0; r < 4; ++r) {
            float v = sacc[n][r] * scale2 + (ct2 - cs[r]);
            if (MASK) { if (kt * 64 + n * 16 + 4 * g + r > tq) v = -INFINITY; }
            sacc[n][r] = v; mx = fmaxf(mx, v);
        }
    }
    mx = fmaxf(mx, __shfl_xor(mx, 16)); mx = fmaxf(mx, __shfl_xor(mx, 32));
    const float mnew = fmaxf(mrun, mx);
    const float corr = __builtin_amdgcn_exp2f(mrun - mnew);
    float rs = 0.f;
#pragma unroll
    for (int n = 0; n < 4; ++n)
#pragma unroll
        for (int r = 0; r < 4; ++r) { const float p = __builtin_amdgcn_exp2f(sacc[n][r] - mnew); sacc[n][r] = p; rs += p; }
    rs += __shfl_xor(rs, 16); rs += __shfl_xor(rs, 32);
    lrun = lrun * corr + rs; mrun = mnew;
    bf16x8 pf[2];
#pragma unroll
    for (int kk = 0; kk < 2; ++kk) {
        const u32x4 pk = (u32x4){pk2(sacc[2 * kk][0], sacc[2 * kk][1]), pk2(sacc[2 * kk][2], sacc[2 * kk][3]), pk2(sacc[2 * kk + 1][0], sacc[2 * kk + 1][1]), pk2(sacc[2 * kk + 1][2], sacc[2 * kk + 1][3])};
        pf[kk] = __builtin_bit_cast(bf16x8, pk);
    }
#pragma unroll
    for (int n2 = 0; n2 < 4; ++n2) {
        oacc[n2] = oacc[n2] * corr;
#pragma unroll
        for (int kk = 0; kk < 2; ++kk) {
            const s16x4 lo = tr4(cV, TLD, (2 * kk) * 16 + 4 * g, n2 * 16, lane), hi = tr4(cV, TLD, (2 * kk + 1) * 16 + 4 * g, n2 * 16, lane);
            const bf16x8 vf = (bf16x8){lo[0], lo[1], lo[2], lo[3], hi[0], hi[1], hi[2], hi[3]};
            oacc[n2] = MFMA16(vf, pf[kk], oacc[n2]);
        }
    }
}
__device__ __forceinline__ void attn_compute(const bf16_t* cK, const bf16_t* cV, const float* cC, const bf16x8 (&qf)[2], f32x4 (&oacc)[4], float& mrun, float& lrun,
                                             float ct2, float scale2, int causal, int kt, int q0, int tq, int wave, int lane, int g) {
    const int r0 = q0 + wave * 16;
    if (causal && (kt * 64 > r0 + 15)) return;
    if (causal && (kt * 64 + 63 > r0)) attn_compute_t<true>(cK, cV, cC, qf, oacc, mrun, lrun, ct2, scale2, kt, tq, lane, g);
    else attn_compute_t<false>(cK, cV, cC, qf, oacc, mrun, lrun, ct2, scale2, kt, tq, lane, g);
}

__device__ __forceinline__ void attn_task(char* smem, const bf16_t* __restrict__ Q, int ldq, const bf16_t* __restrict__ Kp, int ldk, const bf16_t* __restrict__ Vp, int ldv, const float* __restrict__ bias,
                                          int nq_per_b, int nk_per_b, int causal, float scale, bf16_t* __restrict__ O, int ldo, const float* __restrict__ gain, int rms, int task) {
    bf16_t* sK = (bf16_t*)smem;
    bf16_t* sV = sK + 2 * 64 * TLD;
    float* sC = (float*)(sV + 2 * 64 * TLD);
    const int tid = TIDX, lane = tid & 63, wave = tid >> 6, g = lane >> 4, li = lane & 15;
    const int nqt = nq_per_b / 128;
    const int qt = task % nqt, h = (task / nqt) & 3, b = task / (nqt * 4);
    const int q0 = qt * 128, tq = q0 + wave * 16 + li;
    const size_t qrow = (size_t)b * nq_per_b + tq;
    bf16x8 qf[2];
#pragma unroll
    for (int kk = 0; kk < 2; ++kk) qf[kk] = *(const bf16x8*)(Q + qrow * ldq + h * 64 + kk * 32 + g * 8);
    constexpr float LOG2E = 1.4426950408889634f;
    const float ct = bias ? bias[(size_t)(b * 4 + h) * nq_per_b + tq] * LOG2E : 0.f;
    const float scale2 = scale * LOG2E;
    const int nkt = causal ? (q0 + 128) / 64 : nk_per_b / 64;
    const int sr = tid >> 3, sc = tid & 7;
    const bf16_t* kg = Kp + ((size_t)b * nk_per_b + sr) * ldk + h * 64 + sc * 8;
    const bf16_t* vg = Vp + ((size_t)b * nk_per_b + sr) * ldv + h * 64 + sc * 8;
    const float* cg_ = bias ? bias + (size_t)(b * 4 + h) * nk_per_b : nullptr;
    u32x4 rkA, rvA, rkB, rvB; float rcA = 0.f, rcB = 0.f;
    {   const u32x4 rk = *(const u32x4*)kg, rv = *(const u32x4*)vg; const float rc = (cg_ && tid < 64) ? cg_[tid] * LOG2E : 0.f;
        __syncthreads();
        *(u32x4*)(sK + sr * TLD + sc * 8) = rk; *(u32x4*)(sV + sr * TLD + sc * 8) = rv; if (tid < 64) sC[tid] = rc; }
    rkA = *(const u32x4*)(kg + (size_t)64 * ldk); rvA = *(const u32x4*)(vg + (size_t)64 * ldv); rcA = (cg_ && tid < 64) ? cg_[64 + tid] * LOG2E : 0.f;
    __syncthreads();
    f32x4 oacc[4];
#pragma unroll
    for (int n = 0; n < 4; ++n) oacc[n] = (f32x4){0.f, 0.f, 0.f, 0.f};
    float mrun = -INFINITY, lrun = 0.f;
#define ATTN_ITER(kt, LK, LV, LC, WK, WV, WC) { \
        const int buf = (kt) & 1; \
        if ((kt) + 2 < nkt) { LK = *(const u32x4*)(kg + (size_t)((kt) + 2) * 64 * ldk); LV = *(const u32x4*)(vg + (size_t)((kt) + 2) * 64 * ldv); LC = (cg_ && tid < 64) ? cg_[((kt) + 2) * 64 + tid] * LOG2E : 0.f; } \
        attn_compute(sK + buf * 64 * TLD, sV + buf * 64 * TLD, sC + buf * 64, qf, oacc, mrun, lrun, ct, scale2, causal, (kt), q0, tq, wave, lane, g); \
        if ((kt) + 1 < nkt) { const int nb = buf ^ 1; *(u32x4*)(sK + nb * 64 * TLD + sr * TLD + sc * 8) = WK; *(u32x4*)(sV + nb * 64 * TLD + sr * TLD + sc * 8) = WV; if (tid < 64) sC[nb * 64 + tid] = WC; } \
        __syncthreads(); }
    for (int kt = 0; kt < nkt; kt += 2) {
        ATTN_ITER(kt, rkB, rvB, rcB, rkA, rvA, rcA)
        ATTN_ITER(kt + 1, rkA, rvA, rcA, rkB, rvB, rcB)
    }
#undef ATTN_ITER
    const float inv = 1.f / lrun;
    float ms = 0.f;
#pragma unroll
    for (int n = 0; n < 4; ++n) { oacc[n] = oacc[n] * inv; ms += oacc[n][0] * oacc[n][0] + oacc[n][1] * oacc[n][1] + oacc[n][2] * oacc[n][2] + oacc[n][3] * oacc[n][3]; }
    ms += __shfl_xor(ms, 16); ms += __shfl_xor(ms, 32);
    const float rinv = rms ? rsqrtf(ms * (1.f / 64.f) + EPS) : 1.f;
#pragma unroll
    for (int n = 0; n < 4; ++n) {
        const int d = n * 16 + 4 * g;
        f32x4 gg = (f32x4){1.f, 1.f, 1.f, 1.f};
        if (gain) gg = *(const f32x4*)(gain + h * 64 + d);
        uint2 o; o.x = pk2(oacc[n][0] * rinv * gg[0], oacc[n][1] * rinv * gg[1]); o.y = pk2(oacc[n][2] * rinv * gg[2], oacc[n][3] * rinv * gg[3]);
        *(uint2*)(O + qrow * ldo + h * 64 + d) = o;
    }
}


__device__ __forceinline__ void hgrn_scan(float* LF  , float* SEGT  , const bf16_t* __restrict__ prow  , const float* __restrict__ hgrn_lb, int layer, int h, float (&kk)[8]) {
    const int tid = TIDX, t = tid >> 3, k8 = (tid & 7) * 8;
    const u32x4 raw = *(const u32x4*)(prow + (size_t)t * NP + C_AF + k8);
#pragma unroll
    for (int j = 0; j < 8; ++j) {
        const float fl = __uint_as_float((j & 1) ? (raw[j >> 1] & 0xffff0000u) : (raw[j >> 1] << 16));
        float lbk = 0.f;
        if (layer == 1) { const float a0 = hgrn_lb[h * 64 + k8 + j], a1 = hgrn_lb[256 + h * 64 + k8 + j]; lbk = 1.f / (1.f + __expf(a0 - a1)); }
        const float sg = sigmoidf_(fl);
        const float f = lbk + (1.f - lbk) * sg;
        kk[j] = (1.f - lbk) * (1.f - sg);
        LF[t * 65 + k8 + j] = __logf(f);
    }
    __syncthreads();
    { const int k = tid & 63, seg = tid >> 6; float run = 0.f;
#pragma unroll
      for (int i = 0; i < 8; ++i) { run += LF[(seg * 8 + i) * 65 + k]; LF[(seg * 8 + i) * 65 + k] = run; }
      SEGT[seg * 64 + k] = run; }
    __syncthreads();
    { const int k = tid & 63, seg = tid >> 6; float off = 0.f;
      for (int s2 = 0; s2 < seg; ++s2) off += SEGT[s2 * 64 + k];
#pragma unroll
      for (int i = 0; i < 8; ++i) LF[(seg * 8 + i) * 65 + k] += off; }
    __syncthreads();
}
__device__ __forceinline__ float bfx(const u32x4& raw, int j) { return __uint_as_float((j & 1) ? (raw[j >> 1] & 0xffff0000u) : (raw[j >> 1] << 16)); }

__device__ __forceinline__ void hgrn_local_task(char* smem, const bf16_t* __restrict__ proj, const float* __restrict__ hgrn_lb, int layer, float* __restrict__ HL, float* __restrict__ HD, int ch) {
    float* LF = (float*)smem; float* SEGT = LF + 64 * 65;
    bf16_t* sKd = (bf16_t*)(SEGT + 8 * 64); bf16_t* sV = sKd + 64 * TLD;
    const int tid = TIDX, lane = tid & 63, wave = tid >> 6, g = lane >> 4, li = lane & 15;
    const int bh = ch >> 5, n = ch & 31, b = bh >> 2, h = bh & 3;
    const bf16_t* prow = proj + (size_t)(b * SEQ + n * 64) * NP + h * 64;
    const int t = tid >> 3, k8 = (tid & 7) * 8;
    __syncthreads();
    *(u32x4*)(sV + t * TLD + k8) = *(const u32x4*)(prow + (size_t)t * NP + C_AI + k8);
    float kk[8];
    hgrn_scan(LF, SEGT, prow, hgrn_lb, layer, h, kk);
    { u32x4 o;
#pragma unroll
      for (int j = 0; j < 8; j += 2) {
          const float e0 = kk[j] * __expf(LF[63 * 65 + k8 + j] - LF[t * 65 + k8 + j]), e1 = kk[j + 1] * __expf(LF[63 * 65 + k8 + j + 1] - LF[t * 65 + k8 + j + 1]);
          o[j >> 1] = pk2(e0, e1);
      }
      *(u32x4*)(sKd + t * TLD + k8) = o; }
    if (tid < 64) HD[(size_t)ch * 64 + tid] = __expf(LF[63 * 65 + tid]);
    __syncthreads();
#pragma unroll
    for (int i = 0; i < 2; ++i) {
        const int idx = wave * 2 + i, vt = idx >> 2, kt = idx & 3;
        f32x4 acc = (f32x4){0.f, 0.f, 0.f, 0.f};
#pragma unroll
        for (int ks = 0; ks < 2; ++ks) acc = MFMA16(frag_cm(sV, TLD, ks * 32, vt * 16, lane), frag_cm(sKd, TLD, ks * 32, kt * 16, lane), acc);
        *(f32x4*)(HL + (size_t)ch * 4096 + (kt * 16 + li) * 64 + vt * 16 + 4 * g) = acc;
    }
}

__device__ __forceinline__ void hgrn_out_task(char* smem, const bf16_t* __restrict__ proj, const float* __restrict__ hgrn_lb, int layer, const bf16_t* __restrict__ HS,
                                              const float* __restrict__ mix_gain, bf16_t* __restrict__ y, int ch) {
    float* LF = (float*)smem; float* SEGT = LF + 64 * 65; float* sMS = SEGT + 8 * 64;
    bf16_t* sST = (bf16_t*)(sMS + 128); bf16_t* sQ0 = sST + 64 * TLD; bf16_t* sQm = sQ0 + 64 * TLD; bf16_t* sKm = sQm + 64 * TLD; bf16_t* sV = sKm + 64 * TLD; bf16_t* sA = sV + 64 * TLD;
    const int tid = TIDX, lane = tid & 63, wave = tid >> 6, g = lane >> 4, li = lane & 15;
    const int bh = ch >> 5, n = ch & 31, b = bh >> 2, h = bh & 3;
    const bf16_t* prow = proj + (size_t)(b * SEQ + n * 64) * NP + h * 64;
    const int t = tid >> 3, k8 = (tid & 7) * 8;
    __syncthreads();
    *(u32x4*)(sST + t * TLD + k8) = *(const u32x4*)(HS + (size_t)ch * 4096 + t * 64 + k8);
    const u32x4 qraw = *(const u32x4*)(prow + (size_t)t * NP + C_AQ + k8);
    *(u32x4*)(sV + t * TLD + k8) = *(const u32x4*)(prow + (size_t)t * NP + C_AI + k8);
    float kk[8];
    hgrn_scan(LF, SEGT, prow, hgrn_lb, layer, h, kk);
    { u32x4 o0, om, ok;
#pragma unroll
      for (int j = 0; j < 8; j += 2) {
          float q0v[2], qmv[2], kmv[2];
#pragma unroll
          for (int e = 0; e < 2; ++e) {
              const float bt = LF[t * 65 + k8 + j + e], r = LF[31 * 65 + k8 + j + e], q = siluf_(bfx(qraw, j + e));
              q0v[e] = q * __expf(bt); qmv[e] = q * __expf(bt - r); kmv[e] = kk[j + e] * __expf(r - bt);
          }
          o0[j >> 1] = pk2(q0v[0], q0v[1]); om[j >> 1] = pk2(qmv[0], qmv[1]); ok[j >> 1] = pk2(kmv[0], kmv[1]);
      }
      *(u32x4*)(sQ0 + t * TLD + k8) = o0; *(u32x4*)(sQm + t * TLD + k8) = om; *(u32x4*)(sKm + t * TLD + k8) = ok; }
    __syncthreads();
#pragma unroll
    for (int i = 0; i < 2; ++i) {
        const int idx = wave * 2 + i, tt = idx >> 2, st = idx & 3;
        f32x4 acc = (f32x4){0.f, 0.f, 0.f, 0.f};
#pragma unroll
        for (int ks = 0; ks < 2; ++ks) acc = MFMA16(frag_rm(sKm, TLD, st * 16, ks * 32, lane), frag_rm(sQm, TLD, tt * 16, ks * 32, lane), acc);
        const int tq = tt * 16 + li, s0 = st * 16 + 4 * g;
        uint2 o; o.x = pk2(s0 <= tq ? acc[0] : 0.f, s0 + 1 <= tq ? acc[1] : 0.f); o.y = pk2(s0 + 2 <= tq ? acc[2] : 0.f, s0 + 3 <= tq ? acc[3] : 0.f);
        *(uint2*)(sA + tq * TLD + s0) = o;
    }
    __syncthreads();
    { const int tt = wave >> 1;
      f32x4 oacc[2]; float ms = 0.f;
#pragma unroll
      for (int i = 0; i < 2; ++i) {
          const int vt = (wave & 1) * 2 + i;
          f32x4 acc = (f32x4){0.f, 0.f, 0.f, 0.f};
#pragma unroll
          for (int ks = 0; ks < 2; ++ks) acc = MFMA16(frag_cm(sST, TLD, ks * 32, vt * 16, lane), frag_rm(sQ0, TLD, tt * 16, ks * 32, lane), acc);
#pragma unroll
          for (int ks = 0; ks < 2; ++ks) acc = MFMA16(frag_cm(sV, TLD, ks * 32, vt * 16, lane), frag_rm(sA, TLD, tt * 16, ks * 32, lane), acc);
          oacc[i] = acc; ms += acc[0] * acc[0] + acc[1] * acc[1] + acc[2] * acc[2] + acc[3] * acc[3];
      }
      ms += __shfl_xor(ms, 16); ms += __shfl_xor(ms, 32);
      if (g == 0) sMS[(tt * 16 + li) * 2 + (wave & 1)] = ms;
      __syncthreads();
      const int tq = tt * 16 + li;
      const float rinv = rsqrtf((sMS[tq * 2] + sMS[tq * 2 + 1]) * (1.f / 64.f) + EPS);
      const size_t row = (size_t)(b * SEQ + n * 64 + tq);
#pragma unroll
      for (int i = 0; i < 2; ++i) {
          const int v0 = ((wave & 1) * 2 + i) * 16 + 4 * g;
          const uint2 graw = *(const uint2*)(proj + row * NP + C_AG + h * 64 + v0);
          const f32x4 mgv = *(const f32x4*)(mix_gain + C_AQ + h * 64 + v0);
          const float g0 = __uint_as_float(graw.x << 16), g1 = __uint_as_float(graw.x & 0xffff0000u), g2 = __uint_as_float(graw.y << 16), g3 = __uint_as_float(graw.y & 0xffff0000u);
          uint2 o; o.x = pk2(oacc[i][0] * rinv * siluf_(g0) * mgv[0], oacc[i][1] * rinv * siluf_(g1) * mgv[1]);
          o.y = pk2(oacc[i][2] * rinv * siluf_(g2) * mgv[2], oacc[i][3] * rinv * siluf_(g3) * mgv[3]);
          *(uint2*)(y + row * 1024 + h * 64 + v0) = o;
      }
    }
}


__device__ __forceinline__ void gdn_prep_task(char* smem, const bf16_t* __restrict__ proj, const float* __restrict__ gates, const float* __restrict__ conv_w  ,
                                              const float* __restrict__ a_log, const float* __restrict__ dt_bias, bf16_t* __restrict__ gt_all, float* __restrict__ glast, int ch) {
    float* sG = (float*)smem; float* sBeta = sG + 64;
    float* RHS = sBeta + 64;
    float* sM = RHS + 64 * 132;
    bf16_t* sK = (bf16_t*)(sM + 64 * 68); bf16_t* sQ = sK + 64 * TLD;
    const int tid = TIDX, lane = tid & 63, wave = tid >> 6, g = lane >> 4, li = lane & 15;
    const int bh = ch >> 5, n = ch & 31, b = bh >> 2, h = bh & 3;
    const int t = tid >> 3, d8 = (tid & 7) * 8;
    const size_t row0 = (size_t)(b * SEQ + n * 64);
    bf16_t* gt = gt_all + (size_t)ch * 5 * 4096;
    __syncthreads();
    float qn[8], kn[8], vv[8];
    {
        const int spos = n * 64 + t;
#pragma unroll
        for (int sec = 0; sec < 3; ++sec) {
            const int col = (sec == 0 ? C_DQ : (sec == 1 ? C_DK : C_DV)) + h * 64 + d8;
            float acc[8];
#pragma unroll
            for (int e = 0; e < 8; ++e) acc[e] = 0.f;
#pragma unroll
            for (int j = 0; j < 4; ++j) {
                if (spos - (3 - j) >= 0) {
                    const u32x4 raw = *(const u32x4*)(proj + (row0 + t - (3 - j)) * NP + col);
                    const f32x4 w0 = *(const f32x4*)(conv_w + j * 768 + sec * 256 + h * 64 + d8), w1 = *(const f32x4*)(conv_w + j * 768 + sec * 256 + h * 64 + d8 + 4);
#pragma unroll
                    for (int e = 0; e < 8; ++e) acc[e] += (e < 4 ? w0[e] : w1[e - 4]) * bfx(raw, e);
                }
            }
#pragma unroll
            for (int e = 0; e < 8; ++e) { const float sv = siluf_(acc[e]); if (sec == 0) qn[e] = sv; else if (sec == 1) kn[e] = sv; else vv[e] = sv; }
        }
        float sq = 0.f, sk = 0.f;
#pragma unroll
        for (int e = 0; e < 8; ++e) { sq += qn[e] * qn[e]; sk += kn[e] * kn[e]; }
        sq += __shfl_xor(sq, 1); sq += __shfl_xor(sq, 2); sq += __shfl_xor(sq, 4);
        sk += __shfl_xor(sk, 1); sk += __shfl_xor(sk, 2); sk += __shfl_xor(sk, 4);
        const float rq = rsqrtf(sq + EPS) * 0.125f, rk = rsqrtf(sk + EPS);
#pragma unroll
        for (int e = 0; e < 8; ++e) { qn[e] *= rq; kn[e] *= rk; }
    }
    if ((tid & 7) == 0) {
        const float* gr = gates + (row0 + t) * 16;
        sBeta[t] = sigmoidf_(gr[4 + h]);
        sG[t] = -__expf(a_log[h]) * softplusf_(gr[8 + h] + dt_bias[h]);
    }
    __syncthreads();
    if (wave == 0) {
        float v = sG[lane];
#pragma unroll
        for (int o = 1; o < 64; o <<= 1) { const float nb = __shfl_up(v, o); if (lane >= o) v += nb; }
        sG[lane] = v;
    }
    __syncthreads();
    {
        const float Gt = sG[t], Gl = sG[63], bt = sBeta[t];
        const float eG = __expf(Gt), eD = __expf(Gl - Gt);
        u32x4 ok, oq, oqd, okd;
#pragma unroll
        for (int e = 0; e < 8; e += 2) {
            ok[e >> 1] = pk2(kn[e], kn[e + 1]); oq[e >> 1] = pk2(qn[e], qn[e + 1]);
            oqd[e >> 1] = pk2(qn[e] * eG, qn[e + 1] * eG); okd[e >> 1] = pk2(kn[e] * eD, kn[e + 1] * eD);
        }
        *(u32x4*)(sK + t * TLD + d8) = ok; *(u32x4*)(sQ + t * TLD + d8) = oq;
        *(u32x4*)(gt + 2 * 4096 + t * 64 + d8) = oqd; *(u32x4*)(gt + 3 * 4096 + t * 64 + d8) = okd;
#pragma unroll
        for (int e = 0; e < 8; ++e) { RHS[t * 132 + d8 + e] = vv[e] * bt; RHS[t * 132 + 64 + d8 + e] = kn[e] * bt * eG; }
        if (tid == 0) glast[ch] = __expf(Gl);
    }
    __syncthreads();
#pragma unroll
    for (int i = 0; i < 2; ++i) {
        const int idx = wave * 2 + i, tt = idx >> 2, st = idx & 3;
        f32x4 am = (f32x4){0.f, 0.f, 0.f, 0.f}, aq = (f32x4){0.f, 0.f, 0.f, 0.f};
#pragma unroll
        for (int ks = 0; ks < 2; ++ks) {
            const bf16x8 kfs = frag_rm(sK, TLD, st * 16, ks * 32, lane), kft = frag_rm(sK, TLD, tt * 16, ks * 32, lane);
            am = MFMA16(kft, kfs, am);
            aq = MFMA16(kfs, frag_rm(sQ, TLD, tt * 16, ks * 32, lane), aq);
        }
        {   const int sx = st * 16 + li, t0 = tt * 16 + 4 * g; const float Gs = sG[sx];
            f32x4 mo;
#pragma unroll
            for (int r = 0; r < 4; ++r) { const int tq = t0 + r; mo[r] = (sx < tq) ? sBeta[tq] * am[r] * __expf(sG[tq] - Gs) : 0.f; }
            *(f32x4*)(sM + sx * 68 + t0) = mo; }
        {   const int tq = tt * 16 + li, s0 = st * 16 + 4 * g; const float Gt = sG[tq];
            float ao[4];
#pragma unroll
            for (int r = 0; r < 4; ++r) { const int sx = s0 + r; ao[r] = (sx <= tq) ? aq[r] * __expf(Gt - sG[sx]) : 0.f; }
            uint2 o; o.x = pk2(ao[0], ao[1]); o.y = pk2(ao[2], ao[3]);
            *(uint2*)(gt + 4 * 4096 + tq * 64 + s0) = o; }
    }
    __syncthreads();
    if (tid < 128) {
        float acc[64];
#pragma unroll
        for (int i = 0; i < 64; ++i) acc[i] = RHS[i * 132 + tid];
#pragma unroll
        for (int half = 0; half < 2; ++half) {
            const int base = half * 32;
            if (half == 1) {
#pragma unroll
                for (int sx = 0; sx < 32; sx += 2) {
                    f32x4 r0[8], r1[8];
#pragma unroll
                    for (int c = 0; c < 8; ++c) { r0[c] = *(const f32x4*)(sM + sx * 68 + 32 + c * 4); r1[c] = *(const f32x4*)(sM + (sx + 1) * 68 + 32 + c * 4); }
                    const float x0 = acc[sx], x1 = acc[sx + 1];
#pragma unroll
                    for (int tq = 0; tq < 32; ++tq) { acc[32 + tq] -= r0[tq >> 2][tq & 3] * x0; acc[32 + tq] -= r1[tq >> 2][tq & 3] * x1; }
                }
            }
            f32x4 cur[8];
#pragma unroll
            for (int c = 0; c < 8; ++c) cur[c] = *(const f32x4*)(sM + base * 68 + base + c * 4);
#pragma unroll
            for (int sx = 0; sx < 31; ++sx) {
                f32x4 nxt[8];
#pragma unroll
                for (int c = (sx + 2) >> 2; c < 8; ++c) nxt[c] = *(const f32x4*)(sM + (base + sx + 1) * 68 + base + c * 4);
                const float xs = acc[base + sx];
#pragma unroll
                for (int tq = sx + 1; tq < 32; ++tq) acc[base + tq] -= cur[tq >> 2][tq & 3] * xs;
#pragma unroll
                for (int c = (sx + 2) >> 2; c < 8; ++c) cur[c] = nxt[c];
            }
        }
        if (tid < 64) {
#pragma unroll
            for (int tt = 0; tt < 64; ++tt) gt[tt * 64 + tid] = f2bf(acc[tt]);
        } else {
#pragma unroll
            for (int tt = 0; tt < 64; ++tt) gt[4096 + tt * 64 + (tid - 64)] = f2bf(-acc[tt]);
        }
    }
}

__device__ __forceinline__ void gdn_scan_task(char* smem, const bf16_t* __restrict__ gt_all, const float* __restrict__ glast, const bf16_t* __restrict__ proj, const float* __restrict__ mix_gain,
                                              bf16_t* __restrict__ y, int bh) {
    bf16_t* sT = (bf16_t*)smem;
    bf16_t* sST = sT + 2 * 5 * 64 * TLD;
    bf16_t* sVn = sST + 2 * 64 * TLD;
    const int tid = TIDX, lane = tid & 63, wave = tid >> 6, g = lane >> 4, li = lane & 15;
    const int b = bh >> 2, h = bh & 3;
    const int sr = tid >> 3, sc8 = (tid & 7) * 8;
    const bf16_t* gsrc = gt_all + (size_t)bh * 32 * 5 * 4096 + sr * 64 + sc8;
    __syncthreads();
    u32x4 regs[5];
#pragma unroll
    for (int i = 0; i < 5; ++i) regs[i] = *(const u32x4*)(gsrc + i * 4096);
#pragma unroll
    for (int i = 0; i < 5; ++i) *(u32x4*)(sT + i * 64 * TLD + sr * TLD + sc8) = regs[i];
    *(u32x4*)(sST + sr * TLD + sc8) = (u32x4){0u, 0u, 0u, 0u};
    f32x4 sacc[4];
#pragma unroll
    for (int i = 0; i < 4; ++i) sacc[i] = (f32x4){0.f, 0.f, 0.f, 0.f};
    __syncthreads();
    for (int n = 0; n < 32; ++n) {
        const int buf = n & 1;
        const bf16_t* cT = sT + buf * 5 * 64 * TLD;
        const bf16_t* sU = cT; const bf16_t* sWn = cT + 64 * TLD; const bf16_t* sQd = cT + 2 * 64 * TLD; const bf16_t* sKd = cT + 3 * 64 * TLD; const bf16_t* sAq = cT + 4 * 64 * TLD;
        const bf16_t* cST = sST + buf * 64 * TLD; bf16_t* nST = sST + (buf ^ 1) * 64 * TLD;
        if (n + 1 < 32) {
#pragma unroll
            for (int i = 0; i < 5; ++i) regs[i] = *(const u32x4*)(gsrc + (size_t)(n + 1) * 5 * 4096 + i * 4096);
        }
        const size_t rowz = (size_t)(b * SEQ + n * 64 + (wave & 3) * 16 + li);
        uint2 zraw[4];
        if (wave < 4) {
#pragma unroll
            for (int vt = 0; vt < 4; ++vt) zraw[vt] = *(const uint2*)(proj + rowz * NP + C_DZ + h * 64 + vt * 16 + 4 * g);
        }
#pragma unroll
        for (int i = 0; i < 2; ++i) {
            const int idx = wave * 2 + i, tt = idx >> 2, vt = idx & 3;
            const int tq = tt * 16 + li, v0 = vt * 16 + 4 * g;
            const uint2 uraw = *(const uint2*)(sU + tq * TLD + v0);
            f32x4 acc = (f32x4){__uint_as_float(uraw.x << 16), __uint_as_float(uraw.x & 0xffff0000u), __uint_as_float(uraw.y << 16), __uint_as_float(uraw.y & 0xffff0000u)};
#pragma unroll
            for (int ks = 0; ks < 2; ++ks) acc = MFMA16(frag_rm(cST, TLD, vt * 16, ks * 32, lane), frag_rm(sWn, TLD, tt * 16, ks * 32, lane), acc);
            uint2 o; o.x = pk2(acc[0], acc[1]); o.y = pk2(acc[2], acc[3]);
            *(uint2*)(sVn + tq * TLD + v0) = o;
        }
        __syncthreads();
        if (wave < 4) {
            const int tt = wave;
            f32x4 oacc[4]; float ms = 0.f;
#pragma unroll
            for (int vt = 0; vt < 4; ++vt) {
                f32x4 acc = (f32x4){0.f, 0.f, 0.f, 0.f};
#pragma unroll
                for (int ks = 0; ks < 2; ++ks) acc = MFMA16(frag_rm(cST, TLD, vt * 16, ks * 32, lane), frag_rm(sQd, TLD, tt * 16, ks * 32, lane), acc);
#pragma unroll
                for (int ks = 0; ks < 2; ++ks) acc = MFMA16(frag_cm(sVn, TLD, ks * 32, vt * 16, lane), frag_rm(sAq, TLD, tt * 16, ks * 32, lane), acc);
                oacc[vt] = acc; ms += acc[0] * acc[0] + acc[1] * acc[1] + acc[2] * acc[2] + acc[3] * acc[3];
            }
            ms += __shfl_xor(ms, 16); ms += __shfl_xor(ms, 32);
            const float rinv = rsqrtf(ms * (1.f / 64.f) + EPS);
#pragma unroll
            for (int vt = 0; vt < 4; ++vt) {
                const int v0 = vt * 16 + 4 * g;
                const f32x4 mgv = *(const f32x4*)(mix_gain + 768 + h * 64 + v0);
                const float z0 = __uint_as_float(zraw[vt].x << 16), z1 = __uint_as_float(zraw[vt].x & 0xffff0000u), z2 = __uint_as_float(zraw[vt].y << 16), z3 = __uint_as_float(zraw[vt].y & 0xffff0000u);
                uint2 o; o.x = pk2(oacc[vt][0] * rinv * siluf_(z0) * mgv[0], oacc[vt][1] * rinv * siluf_(z1) * mgv[1]);
                o.y = pk2(oacc[vt][2] * rinv * siluf_(z2) * mgv[2], oacc[vt][3] * rinv * siluf_(z3) * mgv[3]);
                *(uint2*)(y + rowz * 1024 + 768 + h * 64 + v0) = o;
            }
        } else {
            const int kt = wave - 4;
            const float gl = glast[bh * 32 + n];
#pragma unroll
            for (int vt = 0; vt < 4; ++vt) {
                f32x4 acc = sacc[vt] * gl;
#pragma unroll
                for (int ks = 0; ks < 2; ++ks) acc = MFMA16(frag_cm(sKd, TLD, ks * 32, kt * 16, lane), frag_cm(sVn, TLD, ks * 32, vt * 16, lane), acc);
                sacc[vt] = acc;
                uint2 o; o.x = pk2(acc[0], acc[1]); o.y = pk2(acc[2], acc[3]);
                *(uint2*)(nST + (vt * 16 + li) * TLD + kt * 16 + 4 * g) = o;
            }
        }
        if (n + 1 < 32) {
            bf16_t* nT = sT + (buf ^ 1) * 5 * 64 * TLD;
#pragma unroll
            for (int i = 0; i < 5; ++i) *(u32x4*)(nT + i * 64 * TLD + sr * TLD + sc8) = regs[i];
        }
        __syncthreads();
    }
}


constexpr int XLD = 264;
__device__ __forceinline__ void lru_local_task(char* smem, const bf16_t* __restrict__ proj, const float* __restrict__ conv_w, const float* __restrict__ conv_b,
                                               const float* __restrict__ w_a, const float* __restrict__ b_a, const float* __restrict__ w_x, const float* __restrict__ b_x,
                                               const float* __restrict__ lam, float* __restrict__ hl_out, float* __restrict__ ac_out, float* __restrict__ lsum, int task) {
    bf16_t* sX = (bf16_t*)smem;
    bf16_t* sW = sX + 64 * XLD;
    float* sAa = (float*)(sW + 2 * 64 * TLD);
    float* sU = sAa + 64 * 65;
    float* sSegA = sU + 64 * 65; float* sSegH = sSegA + 8 * 64;
    const int tid = TIDX, lane = tid & 63, wave = tid >> 6, g = lane >> 4, li = lane & 15;
    const int b = task >> 5, n = task & 31;
    const size_t row0 = (size_t)(b * SEQ + n * 64);
    const int t = tid >> 3;
    __syncthreads();
    {
        const int spos = n * 64 + t;
#pragma unroll
        for (int i = 0; i < 4; ++i) {
            const int c8 = ((tid & 7) + 8 * i) * 8;
            float acc[8];
            { const f32x4 cb0 = *(const f32x4*)(conv_b + c8), cb1 = *(const f32x4*)(conv_b + c8 + 4);
#pragma unroll
              for (int e = 0; e < 8; ++e) acc[e] = e < 4 ? cb0[e] : cb1[e - 4]; }
#pragma unroll
            for (int j = 0; j < 4; ++j) {
                if (spos - (3 - j) >= 0) {
                    const u32x4 raw = *(const u32x4*)(proj + (row0 + t - (3 - j)) * NP + C_CX + c8);
                    const f32x4 w0 = *(const f32x4*)(conv_w + j * 256 + c8), w1 = *(const f32x4*)(conv_w + j * 256 + c8 + 4);
#pragma unroll
                    for (int e = 0; e < 8; ++e) acc[e] += (e < 4 ? w0[e] : w1[e - 4]) * bfx(raw, e);
                }
            }
            u32x4 o; o[0] = pk2(acc[0], acc[1]); o[1] = pk2(acc[2], acc[3]); o[2] = pk2(acc[4], acc[5]); o[3] = pk2(acc[6], acc[7]);
            *(u32x4*)(sX + t * XLD + c8) = o;
        }
    }
    for (int hh = 0; hh < 4; ++hh) {
        {
            const int i = tid >> 3, j8 = (tid & 7) * 8;
#pragma unroll
            for (int m = 0; m < 2; ++m) {
                const float* src = (m == 0 ? w_a : w_x) + (size_t)hh * 4096 + i * 64 + j8;
                const f32x4 v0 = *(const f32x4*)src, v1 = *(const f32x4*)(src + 4);
                u32x4 o; o[0] = pk2(v0[0], v0[1]); o[1] = pk2(v0[2], v0[3]); o[2] = pk2(v1[0], v1[1]); o[3] = pk2(v1[2], v1[3]);
                *(u32x4*)(sW + m * 64 * TLD + i * TLD + j8) = o;
            }
        }
        __syncthreads();
#pragma unroll
        for (int i2 = 0; i2 < 2; ++i2) {
            const int idx = wave * 2 + i2, tt = idx >> 2, jt = idx & 3;
            f32x4 ra = (f32x4){0.f, 0.f, 0.f, 0.f}, rx = (f32x4){0.f, 0.f, 0.f, 0.f};
#pragma unroll
            for (int ks = 0; ks < 2; ++ks) {
                const bf16x8 xf = frag_rm(sX + hh * 64, XLD, tt * 16, ks * 32, lane);
                ra = MFMA16(frag_cm(sW, TLD, ks * 32, jt * 16, lane), xf, ra);
                rx = MFMA16(frag_cm(sW + 64 * TLD, TLD, ks * 32, jt * 16, lane), xf, rx);
            }
            const int tq = tt * 16 + li, cl = jt * 16 + 4 * g, c = hh * 64 + cl;
            const f32x4 ba = *(const f32x4*)(b_a + c), bx = *(const f32x4*)(b_x + c), lm = *(const f32x4*)(lam + c);
            const uint2 xraw = *(const uint2*)(sX + tq * XLD + c);
            const float xc[4] = {__uint_as_float(xraw.x << 16), __uint_as_float(xraw.x & 0xffff0000u), __uint_as_float(xraw.y << 16), __uint_as_float(xraw.y & 0xffff0000u)};
#pragma unroll
            for (int r = 0; r < 4; ++r) {
                const float rr = sigmoidf_(ra[r] + ba[r]), ig = sigmoidf_(rx[r] + bx[r]);
                const float log_a = -8.f * rr * softplusf_(-lm[r]);
                sAa[tq * 65 + cl + r] = __expf(log_a);
                sU[tq * 65 + cl + r] = sqrtf(-expm1f(2.f * log_a)) * (ig * xc[r]);
            }
        }
        __syncthreads();
        const int cl = tid & 63, seg = tid >> 6;
        float Al[8], Hl[8];
        { float A = 1.f, H = 0.f;
#pragma unroll
          for (int i = 0; i < 8; ++i) { const float a = sAa[(seg * 8 + i) * 65 + cl], u = sU[(seg * 8 + i) * 65 + cl]; H = a * H + u; A *= a; Al[i] = A; Hl[i] = H; }
          sSegA[seg * 64 + cl] = A; sSegH[seg * 64 + cl] = H; }
        __syncthreads();
        { float Ac = 1.f, Hc = 0.f;
          for (int s2 = 0; s2 < seg; ++s2) { const float a = sSegA[s2 * 64 + cl]; Hc = a * Hc + sSegH[s2 * 64 + cl]; Ac *= a; }
#pragma unroll
          for (int i = 0; i < 8; ++i) {
              const size_t o = (row0 + seg * 8 + i) * 256 + hh * 64 + cl;
              const float hv = Hl[i] + Al[i] * Hc, av = Al[i] * Ac;
              hl_out[o] = hv; ac_out[o] = av;
              if (seg == 7 && i == 7) { lsum[(size_t)task * 256 + hh * 64 + cl] = av; lsum[(size_t)(256 + task) * 256 + hh * 64 + cl] = hv; }
          } }
        __syncthreads();
    }
}
__device__ __forceinline__ void lru_out_task(const float* __restrict__ hl_in, const float* __restrict__ ac_in, const float* __restrict__ lsum, const bf16_t* __restrict__ proj,
                                             const float* __restrict__ mix_gain, bf16_t* __restrict__ y, int task) {
    const int b = task >> 5, n = task & 31, c = TIDX & 255, half = TIDX >> 8;
    const float Hc = lsum[(size_t)task * 256 + c];
    const float mg = mix_gain[512 + c];
    const size_t row0 = (size_t)(b * SEQ + n * 64 + half * 32);
#pragma unroll 4
    for (int i = 0; i < 32; ++i) {
        const size_t row = row0 + i;
        const float hv = hl_in[row * 256 + c] + ac_in[row * 256 + c] * Hc;
        const float yv = hv * geluf_(bf2f(proj[row * NP + C_CG + c]));
        const float ms = wave_sum(yv * yv) * (1.f / 64.f);
        y[row * 1024 + 512 + c] = f2bf(yv * rsqrtf(ms + EPS) * mg);
    }
}


__device__ __forceinline__ void state_scan_phase(const float* __restrict__ HL, const float* __restrict__ HD, bf16_t* __restrict__ HS, const float* __restrict__ lsum, float* __restrict__ lcar) {
    const int bx = blockIdx.x, tid = TIDX;
    for (int u = bx; u < 128 + 4; u += gridDim.x) {
        if (u < 128) {
            const int gid = u * NTHR + tid, bh = gid >> 11, v = gid & 63, kp = (gid >> 6) & 31;
            const float* Lb = HL + (size_t)bh * 32 * 4096 + (2 * kp) * 64 + v; const float* Db = HD + (size_t)bh * 32 * 64 + 2 * kp;
            bf16_t* Sb = HS + (size_t)bh * 32 * 4096 + (2 * kp) * 64 + v;
            float S0 = 0.f, S1 = 0.f;
            for (int n0 = 0; n0 < 32; n0 += 8) {
                float l0[8], l1[8], d0[8], d1[8];
#pragma unroll
                for (int i = 0; i < 8; ++i) { l0[i] = Lb[(size_t)(n0 + i) * 4096]; l1[i] = Lb[(size_t)(n0 + i) * 4096 + 64]; d0[i] = Db[(n0 + i) * 64]; d1[i] = Db[(n0 + i) * 64 + 1]; }
#pragma unroll
                for (int i = 0; i < 8; ++i) {
                    Sb[(size_t)(n0 + i) * 4096] = f2bf(S0); Sb[(size_t)(n0 + i) * 4096 + 64] = f2bf(S1);
                    S0 = d0[i] * S0 + l0[i]; S1 = d1[i] * S1 + l1[i];
                }
            }
        } else {
            const int gid = (u - 128) * NTHR + tid, b = gid >> 8, c = gid & 255;
            float A[32], H[32];
#pragma unroll
            for (int n = 0; n < 32; ++n) { A[n] = lsum[(size_t)(b * 32 + n) * 256 + c]; H[n] = lsum[(size_t)(256 + b * 32 + n) * 256 + c]; }
            float Hc = 0.f;
#pragma unroll
            for (int n = 0; n < 32; ++n) { lcar[(size_t)(b * 32 + n) * 256 + c] = Hc; Hc = A[n] * Hc + H[n]; }
        }
    }
}

__device__ __forceinline__ void router_phase(char* smem, const float* __restrict__ x, const float* __restrict__ g, const bf16_t* __restrict__ wr  , const float* __restrict__ b_rg,
                                             const float* __restrict__ b_re, const float* __restrict__ pss, int* __restrict__ cnt, int* __restrict__ list, float* __restrict__ pgate) {
    bf16_t* sXh = (bf16_t*)smem;
    bf16_t* sXl = sXh + 64 * TLD;
    float* sLog = (float*)(sXl + 64 * TLD);
    const int tid = TIDX, lane = tid & 63, wave = tid >> 6, gq = lane >> 4, li = lane & 15;
    const int mt = wave & 3, kh = wave >> 2;
    const int stok = tid >> 3, c8 = (tid & 7) * 8;
    BLK_LOOP(tile, T / 64) {
        const int t0 = tile * 64;
        f32x4 acc[3];
#pragma unroll
        for (int n = 0; n < 3; ++n) acc[n] = (f32x4){0.f, 0.f, 0.f, 0.f};
        const float* xp = x + (size_t)(t0 + stok) * 1024 + c8;
        const bf16_t* wp = wr + (size_t)li * 1024 + kh * 32 + gq * 8;
        f32x4 x0 = *(const f32x4*)xp, x1 = *(const f32x4*)(xp + 4);
        u32x4 wh[3], wl[3];
#pragma unroll
        for (int n = 0; n < 3; ++n) { wh[n] = *(const u32x4*)(wp + n * 16 * 1024); wl[n] = *(const u32x4*)(wp + 48 * 1024 + n * 16 * 1024); }
        for (int kc = 0; kc < 16; ++kc) {
            const f32x4 g0 = *(const f32x4*)(g + kc * 64 + c8), g1 = *(const f32x4*)(g + kc * 64 + c8 + 4);
            const f32x4 v0 = x0 * g0, v1 = x1 * g1;
            u32x4 oh, ol;
#pragma unroll
            for (int j = 0; j < 2; ++j) {
                const unsigned h0 = pk2(v0[2 * j], v0[2 * j + 1]), h1 = pk2(v1[2 * j], v1[2 * j + 1]);
                oh[j] = h0; oh[2 + j] = h1;
                ol[j] = pk2(v0[2 * j] - __uint_as_float(h0 << 16), v0[2 * j + 1] - __uint_as_float(h0 & 0xffff0000u));
                ol[2 + j] = pk2(v1[2 * j] - __uint_as_float(h1 << 16), v1[2 * j + 1] - __uint_as_float(h1 & 0xffff0000u));
            }
            __syncthreads();
            *(u32x4*)(sXh + stok * TLD + c8) = oh; *(u32x4*)(sXl + stok * TLD + c8) = ol;
            __syncthreads();
            u32x4 cwh[3], cwl[3];
#pragma unroll
            for (int n = 0; n < 3; ++n) { cwh[n] = wh[n]; cwl[n] = wl[n]; }
            if (kc + 1 < 16) {
                x0 = *(const f32x4*)(xp + (kc + 1) * 64); x1 = *(const f32x4*)(xp + (kc + 1) * 64 + 4);
#pragma unroll
                for (int n = 0; n < 3; ++n) { wh[n] = *(const u32x4*)(wp + n * 16 * 1024 + (kc + 1) * 64); wl[n] = *(const u32x4*)(wp + 48 * 1024 + n * 16 * 1024 + (kc + 1) * 64); }
            }
            const bf16x8 xh = frag_rm(sXh, TLD, mt * 16, kh * 32, lane), xl = frag_rm(sXl, TLD, mt * 16, kh * 32, lane);
#pragma unroll
            for (int n = 0; n < 3; ++n) {
                const bf16x8 fh = __builtin_bit_cast(bf16x8, cwh[n]), fl = __builtin_bit_cast(bf16x8, cwl[n]);
                acc[n] = MFMA16(fh, xh, acc[n]);
                acc[n] = MFMA16(fl, xh, acc[n]);
                acc[n] = MFMA16(fh, xl, acc[n]);
            }
        }
#pragma unroll
        for (int n = 0; n < 3; ++n) *(f32x4*)(sLog + (kh * 64 + mt * 16 + li) * 48 + n * 16 + 4 * gq) = acc[n];
        __syncthreads();
        int* sCnt = (int*)(sLog + 2 * 64 * 48);
        if (tid < 64) sCnt[tid] = 0;
        __syncthreads();
        int ex0 = 0, ex1 = 0, lr0 = 0, lr1 = 0; float gw0 = 0.f, gw1 = 0.f;
        if (tid < 64) {
            const float rinv = rinv_from_pss(pss, (size_t)(t0 + tid));
            const float* l0 = sLog + tid * 48; const float* l1 = sLog + (64 + tid) * 48;
            float lg[4];
#pragma unroll
            for (int i = 0; i < 4; ++i) lg[i] = (l0[i] + l1[i]) * rinv + b_rg[i];
            int gs = 0; float gm = lg[0];
#pragma unroll
            for (int i = 1; i < 4; ++i) if (lg[i] > gm) { gm = lg[i]; gs = i; }
            float den = 0.f;
#pragma unroll
            for (int i = 0; i < 4; ++i) den += __expf(lg[i] - gm);
            const float pg = 1.f / den;
            int i0 = 0, i1 = -1; float m0 = -INFINITY, m1 = -INFINITY;
            for (int i = 0; i < 8; ++i) {
                const float v = (l0[4 + gs * 8 + i] + l1[4 + gs * 8 + i]) * rinv + b_re[gs * 8 + i];
                if (v > m0) { m1 = m0; i1 = i0; m0 = v; i0 = i; } else if (v > m1) { m1 = v; i1 = i; }
            }
            const float e1 = __expf(m1 - m0);
            gw0 = pg / (1.f + e1); gw1 = pg * e1 / (1.f + e1);
            ex0 = gs * 8 + i0; ex1 = gs * 8 + i1;
            lr0 = atomicAdd(&sCnt[ex0], 1); lr1 = atomicAdd(&sCnt[ex1], 1);
        }
        __syncthreads();
        if (tid < 32) { const int c = sCnt[tid]; sCnt[32 + tid] = c ? atomicAdd(&cnt[tid * CNT_STRIDE], c) : 0; }
        __syncthreads();
        if (tid < 64) {
            const int t = t0 + tid;
            list[(size_t)ex0 * T + sCnt[32 + ex0] + lr0] = 2 * t; pgate[2 * t] = gw0;
            list[(size_t)ex1 * T + sCnt[32 + ex1] + lr1] = 2 * t + 1; pgate[2 * t + 1] = gw1;
        }
        __syncthreads();
    }
}

__device__ __forceinline__ void combine_phase(const float* x2, const bf16_t* __restrict__ eo, const float* __restrict__ g, float* xout, bf16_t* __restrict__ hn, int mode) {
    const int lane = TIDX & 63;
    for (int t = blockIdx.x * 8 + (TIDX >> 6); t < T; t += gridDim.x * 8) {
        f32x4 v[4]; float s = 0.f;
#pragma unroll
        for (int j = 0; j < 4; ++j) {
            const int c = (lane + 64 * j) * 4;
            v[j] = *(const f32x4*)(x2 + (size_t)t * 1024 + c);
            const uint2 e0 = *(const uint2*)(eo + (size_t)(2 * t) * 1024 + c), e1 = *(const uint2*)(eo + (size_t)(2 * t + 1) * 1024 + c);
            v[j].x += __uint_as_float(e0.x << 16) + __uint_as_float(e1.x << 16);
            v[j].y += __uint_as_float(e0.x & 0xffff0000u) + __uint_as_float(e1.x & 0xffff0000u);
            v[j].z += __uint_as_float(e0.y << 16) + __uint_as_float(e1.y << 16);
            v[j].w += __uint_as_float(e0.y & 0xffff0000u) + __uint_as_float(e1.y & 0xffff0000u);
            s += v[j].x * v[j].x + v[j].y * v[j].y + v[j].z * v[j].z + v[j].w * v[j].w;
        }
        const float rinv = rsqrtf(wave_sum(s) * (1.f / 1024.f) + EPS);
#pragma unroll
        for (int j = 0; j < 4; ++j) {
            const int c = (lane + 64 * j) * 4;
            const f32x4 gg = *(const f32x4*)(g + c);
            const f32x4 hv = v[j] * rinv * gg;
            if (mode == 0) {
                *(f32x4*)(xout + (size_t)t * 1024 + c) = v[j];
                uint2 o; o.x = pk2(hv.x, hv.y); o.y = pk2(hv.z, hv.w);
                *(uint2*)(hn + (size_t)t * 1024 + c) = o;
            } else {
                *(f32x4*)(xout + (size_t)t * 1024 + c) = hv;
            }
        }
    }
}

template <int l>
__device__ __forceinline__ void layer_body(const Params& P, char* smem, const XcdBarrier& xb, const float* xcur) {
    char* ws = P.ws;
    bf16_t* Wt_in = (bf16_t*)(ws + OFF_WIN); bf16_t* Wt_out = (bf16_t*)(ws + OFF_WOUT); bf16_t* Wt_mq = (bf16_t*)(ws + OFF_WMQ); bf16_t* Wt_mkv = (bf16_t*)(ws + OFF_WMKV);
    bf16_t* Wt_mo = (bf16_t*)(ws + OFF_WMO); bf16_t* Wt_gu = (bf16_t*)(ws + OFF_WGU); bf16_t* Wt_dn = (bf16_t*)(ws + OFF_WDN);
    bf16_t* hn = (bf16_t*)(ws + OFF_HN); bf16_t* proj = (bf16_t*)(ws + OFF_PROJ); float* gates = (float*)(ws + OFF_GATES); bf16_t* y = (bf16_t*)(ws + OFF_Y);
    float* XA = P.out; float* XB = (float*)(ws + OFF_XB);
    bf16_t* qm = (bf16_t*)(ws + OFF_QM); bf16_t* om = (bf16_t*)(ws + OFF_OM); bf16_t* kvm = (bf16_t*)(ws + OFF_KVM); bf16_t* memn = (bf16_t*)(ws + OFF_MEMN);
    float* foxc = (float*)(ws + OFF_FOXC); float* lrua = (float*)(ws + OFF_LRUA); float* lruu = (float*)(ws + OFF_LRUU);
    int* cnt_all = (int*)(ws + OFF_CTL) + CTL_CNT_WORD; int* list = (int*)(ws + OFF_LIST); float* pgate = (float*)(ws + OFF_PGATE);
    bf16_t* act = (bf16_t*)(ws + OFF_ACT); bf16_t* eo = (bf16_t*)(ws + OFF_EO); float* pss = (float*)(ws + OFF_PSS);
    const int wave = TIDX >> 6, lane = TIDX & 63;


        float* x1 = (l == 0) ? XA : XB;
        float* x2 = (l == 0) ? XB : XA;
        int* cnt = cnt_all + 32 * CNT_STRIDE * l;
        const float* mg = P.in[I_MIX_GAIN] + l * 1024;
        REP(2, { pg8::Gemm g{hn, Wt_in + (size_t)l * NP * 1024, T, NP, 1024}; pg8::StaticOrder S; S.init(T, NP, (int)gridDim.x, (int)blockIdx.x);
                 pg8::EpiInProj E{proj, NP, gates, C_GATE};
                 pg8::gemm_phase<pg8::EpiInProj, pg8::StaticOrder, true, true>((PG8_LAS unsigned char*)smem, g, S, E); });
        if (l == 0) for (int l2 = 0; l2 < NL; ++l2)
            gemm_phase<EPI_BF16>(smem, memn + (size_t)l2 * 2048 * 1024, 1024, Wt_mkv + (size_t)l2 * 512 * 1024, 1024, 2048, 512, 1024, kvm + (size_t)l2 * 2048 * 512, 512, nullptr, nullptr,
                                 (gridDim.x >= 192) ? ((int)blockIdx.x - 128 - 32 * l2) : (int)blockIdx.x, (gridDim.x >= 192) ? 4096 : (int)gridDim.x);
        GSYNC();
        REP(4,         {
            const int bx = blockIdx.x;
            bf16_t* gtiles = (bf16_t*)(ws + OFF_GDN); float* glast = (float*)(ws + OFF_GLAST);
            if (bx < 32 && wave == 1) fox_cumsum(gates, P.in[I_FOX_FB] + l * 4, foxc, bx, lane);
            BLK_LOOP(ch, 1024) gdn_prep_task(smem, proj, gates, P.in[I_GDN_CONV_W] + l * 4 * 768, P.in[I_GDN_A_LOG] + l * 4, P.in[I_GDN_DT_BIAS] + l * 4, gtiles, glast, ch);
            BLK_LOOP(ch, 1024) hgrn_local_task(smem, proj, P.in[I_HGRN_LB], l, (float*)(ws + OFF_HL), (float*)(ws + OFF_HD), ch);
            BLK_LOOP(task, 256) lru_local_task(smem, proj, P.in[I_LRU_CONV_W] + l * 1024, P.in[I_LRU_CONV_B] + l * 256, P.in[I_LRU_WA] + l * 16384, P.in[I_LRU_BA] + l * 256,
                                               P.in[I_LRU_WX] + l * 16384, P.in[I_LRU_BX] + l * 256, P.in[I_LRU_LAM] + l * 256, lrua, lruu, (float*)(ws + OFF_LSUM), task);
        });
        GSYNC();
        state_scan_phase((const float*)(ws + OFF_HL), (const float*)(ws + OFF_HD), (bf16_t*)(ws + OFF_HS), (const float*)(ws + OFF_LSUM), (float*)(ws + OFF_LCAR));
        GSYNC();
        REP(8,         {
            const int natt = (SEQ / 128) * 4 * NB;
            const int bx = blockIdx.x, nfree = (int)gridDim.x - 32;
            if (bx < 32) gdn_scan_task(smem, (const bf16_t*)(ws + OFF_GDN), (const float*)(ws + OFF_GLAST), proj, mg, y, bx);
            else {
                for (int r = 0; r * nfree < natt; ++r) {
                    const int i = r * nfree + ((r & 1) ? (nfree - 1 - (bx - 32)) : (bx - 32));
                    if (i >= natt) continue;
                    const int qt = 15 - (i >> 5), bh = i & 31;
                    attn_task(smem, proj + C_BQ, NP, proj + C_BK, NP, proj + C_BV, NP, foxc, SEQ, SEQ, 1, 0.125f, y + 256, 1024, mg + 256, 1, (bh * 16) + qt);
                }
                for (int i = bx - 32; i < 1024; i += nfree) {
                    const int ch = (i & 31) * 32 + (31 - (i >> 5));
                    hgrn_out_task(smem, proj, P.in[I_HGRN_LB], l, (const bf16_t*)(ws + OFF_HS), mg, y, ch);
                }
                for (int i = bx - 32; i < 256; i += nfree) lru_out_task(lrua, lruu, (const float*)(ws + OFF_LCAR), proj, mg, y, i);
            }
        });
        GSYNC();
        REP(16, { pg8::Gemm g{y, Wt_out + (size_t)l * 1024 * 1024, T, 1024, 1024}; pg8::StaticOrder S; S.init(T, 1024, (int)gridDim.x, (int)blockIdx.x);
                  pg8::EpiResidNorm E{xcur, x1, 1024, P.in[I_NORM_MEM] + l * 1024, hn, pss};
                  pg8::gemm_phase<pg8::EpiResidNorm, pg8::StaticOrder, true, true>((PG8_LAS unsigned char*)smem, g, S, E); });
        GSYNC();
        REP(64, gemm_phase<EPI_BF16_RS>(smem, hn, 1024, Wt_mq + (size_t)l * 256 * 1024, 1024, T, 256, 1024, qm, 256, pss, nullptr));
        GSYNC();
        { const bf16_t* kv = kvm + (size_t)l * 2048 * 512;
          REP(128, BLK_LOOP(task, (SEQ / 128) * 4 * NB) attn_task(smem, qm, 256, kv, 512, kv + 256, 512, nullptr, SEQ, MEMLEN, 0, 0.125f, om, 256, nullptr, 0, task)); }
        GSYNC();
        REP(256, { pg8::Gemm g{om, Wt_mo + (size_t)l * 1024 * 256, T, 1024, 256}; pg8::StaticOrder S; S.init(T, 1024, (int)gridDim.x, (int)blockIdx.x);
                   pg8::EpiResidNorm E{x1, x2, 1024, P.in[I_NORM_FFN] + l * 1024, hn, pss};
                   pg8::gemm_phase<pg8::EpiResidNorm, pg8::StaticOrder, true, true>((PG8_LAS unsigned char*)smem, g, S, E); });
        GSYNC();
        router_phase(smem, x2, P.in[I_NORM_FFN] + l * 1024, (const bf16_t*)(ws + OFF_WR) + (size_t)l * 2 * 48 * 1024, P.in[I_B_RG] + l * 4, P.in[I_B_RE] + l * 32, pss, cnt, list, pgate);
        GSYNC();
        REP(512, moe_phase<1>(smem, hn, 1024, Wt_gu + (size_t)l * 32 * 512 * 1024, (size_t)512 * 1024, 1024, 1024, cnt, list, pgate, act, pss));
        GSYNC();
        REP(1024, moe_phase<2>(smem, act, 256, Wt_dn + (size_t)l * 32 * 1024 * 256, (size_t)1024 * 256, 256, 256, cnt, list, pgate, eo, pss));
        if (PROBE_MASK & 2048) { for (int i = 0; i < 10; ++i) GSYNC(); }
        GSYNC();
        if (l == 0) { combine_phase(x2, eo, P.in[I_NORM_MIX] + 1024, XA, hn, 0); GSYNC(); }
        else combine_phase(x2, eo, P.in[I_NORM_FINAL], P.out, hn, 1);
}
__global__ void __launch_bounds__(NTHR, 2) mega_kernel(Params P) {
    extern __shared__ __attribute__((aligned(16))) char smem[];
    volatile LDS_AS unsigned* st = (volatile LDS_AS unsigned*)(smem + LDS_BYTES - 16);
    if (TIDX < 4) st[TIDX] = 0u;
    __syncthreads();
    const XcdBarrier xb = xcd_barrier_post((unsigned*)(P.ws + OFF_CTL), st);
    phase0(P, smem);
    GSYNC();
    layer_body<0>(P, smem, xb, P.in[I_X]);
    layer_body<1>(P, smem, xb, P.out);
}

extern "C" void kernel_launch(void* const* d_in, const int* in_sizes, int n_in, void* d_out, int out_size, void* d_ws, size_t ws_size, hipStream_t stream) {
    static int grid_blocks = 0;
    if (grid_blocks == 0) {
        if (n_in != N_INPUTS || ws_size < OFF_END || out_size != T * 1024) { fprintf(stderr, "kernel_launch: unexpected sizes n_in=%d ws=%zu out=%d (need ws >= %zu)\n", n_in, ws_size, out_size, (size_t)OFF_END); grid_blocks = -1; return; }
        int dev = 0, cus = 0, per_cu = 0;
        if (hipGetDevice(&dev) != hipSuccess || hipDeviceGetAttribute(&cus, hipDeviceAttributeMultiprocessorCount, dev) != hipSuccess) { fprintf(stderr, "kernel_launch: device query failed\n"); grid_blocks = -1; return; }
        if (hipFuncSetAttribute((const void*)mega_kernel, hipFuncAttributeMaxDynamicSharedMemorySize, LDS_BYTES) != hipSuccess) { fprintf(stderr, "kernel_launch: hipFuncSetAttribute failed\n"); grid_blocks = -1; return; }
        if (hipOccupancyMaxActiveBlocksPerMultiprocessor(&per_cu, (const void*)mega_kernel, NTHR, LDS_BYTES) != hipSuccess || per_cu < 1) { fprintf(stderr, "kernel_launch: occupancy query says %d blocks/CU\n", per_cu); grid_blocks = -1; return; }
        grid_blocks = cus;
        fprintf(stderr, "kernel_launch: cus=%d per_cu=%d grid=%d\n", cus, per_cu, grid_blocks);
    }
    if (grid_blocks < 0) return;
    if (hipMemsetAsync((char*)d_ws + OFF_CTL, 0, CTL_BYTES, stream) != hipSuccess) { fprintf(stderr, "kernel_launch: memset failed\n"); return; }
    Params p; memset(&p, 0, sizeof p);
    for (int i = 0; i < N_INPUTS; ++i) p.in[i] = (const float*)d_in[i];
    p.out = (float*)d_out; p.ws = (char*)d_ws;
    void* args[] = {&p};
    hipError_t e = hipLaunchCooperativeKernel((const void*)mega_kernel, dim3(grid_blocks), dim3(NTHR), args, LDS_BYTES, stream);
    if (e != hipSuccess) fprintf(stderr, "kernel_launch: cooperative launch failed: %s (grid %d)\n", hipGetErrorString(e), grid_blocks);
}
```

```cpp
#include <hip/hip_runtime.h>
#include <stdint.h>
#include <stdio.h>
#include <string.h>
#include <hip/hip_cooperative_groups.h>
namespace cg = cooperative_groups;

typedef unsigned short bf16_t;
typedef short bf16x8 __attribute__((ext_vector_type(8)));
typedef float f32x4 __attribute__((ext_vector_type(4)));
typedef unsigned u32x4 __attribute__((ext_vector_type(4)));

constexpr int NB = 8, SEQ = 2048, DM = 1024, T = NB * SEQ, NL = 2;
constexpr int NP = 3584;
constexpr int NIN = 3340;
constexpr int C_AQ = 0, C_AF = 256, C_AI = 512, C_AG = 768, C_BQ = 1024, C_BK = 1280, C_BV = 1536, C_CX = 1792, C_CG = 2048,
              C_DQ = 2304, C_DK = 2560, C_DV = 2816, C_DZ = 3072, C_GATE = 3328;
constexpr int MEMLEN = 256;
constexpr int NEXP = 32, DEXP = 256;
constexpr float EPS = 1e-6f;

constexpr size_t al256(size_t x) { return (x + 255) & ~(size_t)255; }
constexpr size_t SZ_WIN = (size_t)NP * 1024 * 2, SZ_WOUT = (size_t)1024 * 1024 * 2, SZ_WMQ = (size_t)256 * 1024 * 2, SZ_WMKV = (size_t)512 * 1024 * 2,
                 SZ_WMO = (size_t)1024 * 256 * 2, SZ_WGU = (size_t)32 * 512 * 1024 * 2, SZ_WDN = (size_t)32 * 1024 * 256 * 2;
constexpr size_t OFF_WIN = 0;
constexpr size_t OFF_WOUT = OFF_WIN + NL * SZ_WIN;
constexpr size_t OFF_WMQ = OFF_WOUT + NL * SZ_WOUT;
constexpr size_t OFF_WMKV = OFF_WMQ + NL * SZ_WMQ;
constexpr size_t OFF_WMO = OFF_WMKV + NL * SZ_WMKV;
constexpr size_t OFF_WGU = OFF_WMO + NL * SZ_WMO;
constexpr size_t OFF_WDN = OFF_WGU + NL * SZ_WGU;
constexpr size_t OFF_HN = OFF_WDN + NL * SZ_WDN;
constexpr size_t OFF_PROJ = OFF_HN + (size_t)T * 1024 * 2;
constexpr size_t OFF_GATES = OFF_PROJ + (size_t)T * NP * 2;
constexpr size_t OFF_Y = OFF_GATES + (size_t)T * 16 * 4;
constexpr size_t OFF_XB = OFF_Y + (size_t)T * 1024 * 2;
constexpr size_t OFF_QM = OFF_XB + (size_t)T * 1024 * 4;
constexpr size_t OFF_OM = OFF_QM + (size_t)T * 256 * 2;
constexpr size_t OFF_KVM = OFF_OM + (size_t)T * 256 * 2;
constexpr size_t OFF_MEMN = OFF_KVM + (size_t)NL * 2048 * 512 * 2;
constexpr size_t OFF_FOXC = OFF_MEMN + (size_t)2048 * 1024 * 2;
constexpr size_t OFF_LRUA = OFF_FOXC + (size_t)NB * 4 * SEQ * 4;
constexpr size_t OFF_LRUU = OFF_LRUA + (size_t)T * 256 * 4;
constexpr size_t OFF_CNT = OFF_LRUU + (size_t)T * 256 * 4;
constexpr size_t OFF_LIST = OFF_CNT + 256;
constexpr size_t OFF_PGATE = OFF_LIST + (size_t)NEXP * T * 4;
constexpr size_t OFF_HL = OFF_PGATE + (size_t)2 * T * 4;
constexpr size_t OFF_HD = OFF_HL + (size_t)1024 * 4096 * 4;
constexpr size_t OFF_GDN = OFF_HD + (size_t)1024 * 64 * 4;
constexpr size_t OFF_GLAST = OFF_GDN + (size_t)1024 * 5 * 4096 * 2;
constexpr size_t OFF_LSUM = OFF_GLAST + 4096;
constexpr size_t OFF_HS = OFF_LSUM + (size_t)2 * 256 * 256 * 4;
constexpr size_t OFF_LCAR = OFF_HS + (size_t)1024 * 4096 * 2;
constexpr size_t OFF_PSS = OFF_LCAR + (size_t)256 * 256 * 4;
constexpr size_t OFF_WR = OFF_PSS + (size_t)T * 16 * 4;
constexpr size_t OFF_CTL = OFF_WR + (size_t)NL * 2 * 48 * 1024 * 2;
constexpr size_t CTL_BYTES = 32768;
constexpr int CTL_CNT_WORD = 4096;
constexpr int CNT_STRIDE = 64;
constexpr size_t OFF_END = OFF_CTL + CTL_BYTES;
constexpr size_t OFF_ACT = OFF_PROJ;
constexpr size_t OFF_EO = OFF_PROJ + (size_t)2 * T * 256 * 2;
static_assert(OFF_EO + (size_t)2 * T * 1024 * 2 <= OFF_GATES, "overlay fits");

__device__ __forceinline__ int tid_opaque() { int t = threadIdx.x; asm volatile("" : "+v"(t)); return t; }
#define TIDX tid_opaque()
__device__ __forceinline__ float bf2f(bf16_t v) { return __uint_as_float(((unsigned)v) << 16); }
typedef __bf16 bf16x2_t __attribute__((ext_vector_type(2)));
__device__ __forceinline__ bf16_t f2bf(float f) { return __builtin_bit_cast(unsigned short, (__bf16)f); }
__device__ __forceinline__ unsigned pk2(float lo, float hi) { bf16x2_t v = {(__bf16)lo, (__bf16)hi}; return __builtin_bit_cast(unsigned, v); }
__device__ __forceinline__ float sigmoidf_(float x) { return 1.f / (1.f + __expf(-x)); }
__device__ __forceinline__ float siluf_(float x) { return x / (1.f + __expf(-x)); }
__device__ __forceinline__ float softplusf_(float x) { return x > 20.f ? x : log1pf(__expf(x)); }
__device__ __forceinline__ float logsigmoidf_(float x) { return x < 0.f ? x - log1pf(__expf(x)) : -log1pf(__expf(-x)); }
__device__ __forceinline__ float geluf_(float x) { float u = 0.7978845608028654f * (x + 0.044715f * x * x * x); return 0.5f * x * (1.f + tanhf(u)); }
__device__ __forceinline__ float wave_sum(float v) {
#pragma unroll
    for (int o = 1; o < 64; o <<= 1) v += __shfl_xor(v, o);
    return v;
}
__device__ __forceinline__ float rdlane(float v, int l) { return __int_as_float(__builtin_amdgcn_readlane(__float_as_int(v), l)); }

#define PROBE_MASK 0
#define GSYNC() xcd_barrier(xb)
#define REP(bit, ...) do { __VA_ARGS__; if (PROBE_MASK & (bit)) { GSYNC(); __VA_ARGS__; } } while (0)
constexpr int NTHR = 512;
constexpr int LDS_BYTES = 147456;
enum { I_X = 0, I_MEM, I_NORM_MIX, I_W_IN, I_HGRN_LB, I_FOX_FB, I_LRU_CONV_W, I_LRU_CONV_B, I_LRU_WA, I_LRU_BA, I_LRU_WX, I_LRU_BX, I_LRU_LAM, I_GDN_CONV_W, I_GDN_A_LOG,
       I_GDN_DT_BIAS, I_MIX_GAIN, I_W_OUT, I_NORM_MEM, I_NORM_MEMKV, I_W_MQ, I_W_MKV, I_W_MO, I_NORM_FFN, I_W_RG, I_B_RG, I_W_RE, I_B_RE, I_W_E_GU, I_W_E_DN, I_NORM_FINAL, N_INPUTS };
struct Params { const float* in[N_INPUTS]; float* out; char* ws; };
static_assert(sizeof(Params) == 8 * (N_INPUTS + 2), "no padding");

#define BLK_LOOP(it, n) for (int it = (int)blockIdx.x; it < (n); it += (int)gridDim.x)


__device__ __forceinline__ float rinv_from_pss(const float* __restrict__ pss, size_t row) {
    const f32x4 a = *(const f32x4*)(pss + row * 16), b = *(const f32x4*)(pss + row * 16 + 4), c = *(const f32x4*)(pss + row * 16 + 8), d = *(const f32x4*)(pss + row * 16 + 12);
    const float sm = ((a[0] + a[1]) + (a[2] + a[3])) + ((b[0] + b[1]) + (b[2] + b[3])) + ((c[0] + c[1]) + (c[2] + c[3])) + ((d[0] + d[1]) + (d[2] + d[3]));
    return rsqrtf(sm * (1.f / 1024.f) + EPS);
}

__device__ __forceinline__ int rowmap_fn(int mode, int n) {
    if (mode == 1) {
        if (n < 1792) return n;
        if (n < 1796) return C_GATE + (n - 1792);
        if (n < 3076) return n - 4;
        if (n < 3084) return C_GATE + 4 + (n - 3076);
        return n - 12;
    } else if (mode == 2) {
        int j = n & 255; return (j >> 4) * 32 + ((n >= 256) ? 16 : 0) + (j & 15);
    }
    return n;
}
__device__ __forceinline__ void convT_tile(float* tile  , const float* __restrict__ src, int K, int N, bf16_t* __restrict__ dst, int mode, int ntn, int idx) {
    const int n0 = (idx % ntn) * 64, k0 = (idx / ntn) * 64;
    const int tid = TIDX;
    __syncthreads();
#pragma unroll
    for (int i = 0; i < 2; ++i) {
        const int k = (tid >> 4) + 32 * i, n = n0 + (tid & 15) * 4;
        f32x4 v = (f32x4){0.f, 0.f, 0.f, 0.f};
        if (n + 3 < N) v = *(const f32x4*)(src + (size_t)(k0 + k) * N + n);
        else { for (int e = 0; e < 4; ++e) if (n + e < N) v[e] = src[(size_t)(k0 + k) * N + n + e]; }
#pragma unroll
        for (int e = 0; e < 4; ++e) tile[k * 65 + (tid & 15) * 4 + e] = v[e];
    }
    __syncthreads();
    const int nl = tid >> 3, k8 = (tid & 7) * 8, n = n0 + nl;
    if (n < N) {
        const int r = rowmap_fn(mode, n);
        u32x4 o;
#pragma unroll
        for (int j = 0; j < 4; ++j) o[j] = pk2(tile[(k8 + 2 * j) * 65 + nl], tile[(k8 + 2 * j + 1) * 65 + nl]);
        *(u32x4*)(dst + (size_t)r * K + k0 + k8) = o;
    }
}
__device__ __forceinline__ void rms_row_bf16(const float* __restrict__ xrow, const float* __restrict__ g, bf16_t* __restrict__ orow, int lane) {
    const f32x4* xr = (const f32x4*)xrow + lane;
    f32x4 v[4]; float s = 0.f;
#pragma unroll
    for (int j = 0; j < 4; ++j) { v[j] = xr[64 * j]; s += v[j].x * v[j].x + v[j].y * v[j].y + v[j].z * v[j].z + v[j].w * v[j].w; }
    const float rinv = rsqrtf(wave_sum(s) * (1.f / 1024.f) + EPS);
#pragma unroll
    for (int j = 0; j < 4; ++j) {
        const f32x4 gg = ((const f32x4*)g)[lane + 64 * j];
        uint2 o; o.x = pk2(v[j].x * rinv * gg.x, v[j].y * rinv * gg.y); o.y = pk2(v[j].z * rinv * gg.z, v[j].w * rinv * gg.w);
        *(uint2*)(orow + (lane + 64 * j) * 4) = o;
    }
}

constexpr int CT_PER_LAYER = 53 * 16 + 256 + 64 + 128 + 64;
constexpr int CT_GU = 64 * 128, CT_DN = 64 * 64;
constexpr int CT_TOTAL = NL * CT_PER_LAYER + CT_GU + CT_DN;

__device__ __forceinline__ void phase0(const Params& P, char* smem) {
    char* ws = P.ws;
    float* tile = (float*)smem;
    BLK_LOOP(it, CT_TOTAL) {
        int r = it;
        if (r < NL * CT_PER_LAYER) {
            const int l = r / CT_PER_LAYER; r -= l * CT_PER_LAYER;
            if (r < 848) { convT_tile(tile, P.in[I_W_IN] + (size_t)l * 1024 * NIN, 1024, NIN, (bf16_t*)(ws + OFF_WIN) + (size_t)l * NP * 1024, 1, 53, r); continue; } r -= 848;
            if (r < 256) { convT_tile(tile, P.in[I_W_OUT] + (size_t)l * 1024 * 1024, 1024, 1024, (bf16_t*)(ws + OFF_WOUT) + (size_t)l * 1024 * 1024, 0, 16, r); continue; } r -= 256;
            if (r < 64) { convT_tile(tile, P.in[I_W_MQ] + (size_t)l * 1024 * 256, 1024, 256, (bf16_t*)(ws + OFF_WMQ) + (size_t)l * 256 * 1024, 0, 4, r); continue; } r -= 64;
            if (r < 128) { convT_tile(tile, P.in[I_W_MKV] + (size_t)l * 1024 * 512, 1024, 512, (bf16_t*)(ws + OFF_WMKV) + (size_t)l * 512 * 1024, 0, 8, r); continue; } r -= 128;
            convT_tile(tile, P.in[I_W_MO] + (size_t)l * 256 * 1024, 256, 1024, (bf16_t*)(ws + OFF_WMO) + (size_t)l * 1024 * 256, 0, 16, r); continue;
        }
        r -= NL * CT_PER_LAYER;
        if (r < CT_GU) { const int m = r >> 7; convT_tile(tile, P.in[I_W_E_GU] + (size_t)m * 1024 * 512, 1024, 512, (bf16_t*)(ws + OFF_WGU) + (size_t)m * 512 * 1024, 2, 8, r & 127); continue; }
        r -= CT_GU;
        { const int m = r >> 6; convT_tile(tile, P.in[I_W_E_DN] + (size_t)m * 256 * 1024, 256, 1024, (bf16_t*)(ws + OFF_WDN) + (size_t)m * 1024 * 256, 0, 16, r & 63); }
    }
    for (int i = blockIdx.x * NTHR + TIDX; i < NL * (NP - NIN) * 512; i += gridDim.x * NTHR) {
        const int l = i / ((NP - NIN) * 512), w = i % ((NP - NIN) * 512);
        ((unsigned*)((bf16_t*)(ws + OFF_WIN) + (size_t)l * NP * 1024 + (size_t)NIN * 1024))[w] = 0u;
    }
    for (int i = blockIdx.x * NTHR + TIDX; i < NL * 48 * 1024; i += gridDim.x * NTHR) {
        const int l = i / (48 * 1024), r = (i / 1024) % 48, k = i & 1023;
        float w = 0.f;
        if (r < 4) w = P.in[I_W_RG][(size_t)l * 4096 + k * 4 + r]; else if (r < 36) w = P.in[I_W_RE][(size_t)l * 32768 + k * 32 + (r - 4)];
        const bf16_t hi = f2bf(w); const bf16_t lo = f2bf(w - bf2f(hi));
        bf16_t* wr = (bf16_t*)(ws + OFF_WR) + (size_t)l * 2 * 48 * 1024;
        wr[r * 1024 + k] = hi; wr[48 * 1024 + r * 1024 + k] = lo;
    }
    const int gw = blockIdx.x * 8 + (TIDX >> 6), ngw = gridDim.x * 8, lane = TIDX & 63;
    for (int row = gw; row < T + NL * 2048; row += ngw) {
        if (row < T) rms_row_bf16(P.in[I_X] + (size_t)row * 1024, P.in[I_NORM_MIX], (bf16_t*)(ws + OFF_HN) + (size_t)row * 1024, lane);
        else { const int r2 = row - T, l = r2 >> 11, rr = r2 & 2047;
               rms_row_bf16(P.in[I_MEM] + (size_t)rr * 1024, P.in[I_NORM_MEMKV] + l * 1024, (bf16_t*)(ws + OFF_MEMN) + (size_t)r2 * 1024, lane); }
    }
}

constexpr int GLD = 72;
constexpr int GEMM_STAGE = (256 + 128) * GLD * 2;
constexpr int GEMM_LDS = 2 * GEMM_STAGE;
template <class RowPtr>
__device__ __forceinline__ void gemm_tile(char* smem, RowPtr rowptr, const bf16_t* __restrict__ Bt, int ldb, int n0, int K, f32x4 (&acc)[4][4]) {
    const int tid = TIDX, lane = tid & 63, wave = tid >> 6, wm = wave >> 1, wn = wave & 1;
    const u32x4* ga[4]; const u32x4* gb[2];
#pragma unroll
    for (int i = 0; i < 4; ++i) { const int c = tid + i * 512, r = c >> 3, ch = c & 7; ga[i] = (const u32x4*)(rowptr(r) + ch * 8); }
#pragma unroll
    for (int i = 0; i < 2; ++i) { const int c = tid + i * 512, r = c >> 3, ch = c & 7; gb[i] = (const u32x4*)(Bt + (size_t)(n0 + r) * ldb + ch * 8); }
#pragma unroll
    for (int m = 0; m < 4; ++m)
#pragma unroll
        for (int n = 0; n < 4; ++n) acc[m][n] = (f32x4){0.f, 0.f, 0.f, 0.f};
    const int nk = K / 64;
    u32x4 raA[4], rbA[2], raB[4], rbB[2];
#define GT_LOAD(RA, RB, kt) { _Pragma("unroll") for (int i = 0; i < 4; ++i) RA[i] = ga[i][(kt) * 8]; _Pragma("unroll") for (int i = 0; i < 2; ++i) RB[i] = gb[i][(kt) * 8]; }
#define GT_STORE(RA, RB, buf) { bf16_t* dA = (bf16_t*)(smem + (buf) * GEMM_STAGE); bf16_t* dB = dA + 256 * GLD; \
        _Pragma("unroll") for (int i = 0; i < 4; ++i) { const int c = tid + i * 512, r = c >> 3, ch = c & 7; *(u32x4*)(dA + r * GLD + ch * 8) = RA[i]; } \
        _Pragma("unroll") for (int i = 0; i < 2; ++i) { const int c = tid + i * 512, r = c >> 3, ch = c & 7; *(u32x4*)(dB + r * GLD + ch * 8) = RB[i]; } }
#define GT_COMPUTE(buf) { const bf16_t* sA = (const bf16_t*)(smem + (buf) * GEMM_STAGE); const bf16_t* sB = sA + 256 * GLD; \
        _Pragma("unroll") for (int kk = 0; kk < 2; ++kk) { bf16x8 af[4], bfr[4]; \
            _Pragma("unroll") for (int m = 0; m < 4; ++m) af[m] = *(const bf16x8*)(sA + (wm * 64 + m * 16 + (lane & 15)) * GLD + kk * 32 + (lane >> 4) * 8); \
            _Pragma("unroll") for (int n = 0; n < 4; ++n) bfr[n] = *(const bf16x8*)(sB + (wn * 64 + n * 16 + (lane & 15)) * GLD + kk * 32 + (lane >> 4) * 8); \
            _Pragma("unroll") for (int m = 0; m < 4; ++m) _Pragma("unroll") for (int n = 0; n < 4; ++n) acc[m][n] = __builtin_amdgcn_mfma_f32_16x16x32_bf16(bfr[n], af[m], acc[m][n], 0, 0, 0); } }
    GT_LOAD(raA, rbA, 0)
    GT_LOAD(raB, rbB, 1)
    __syncthreads();
    GT_STORE(raA, rbA, 0)
    __syncthreads();
    for (int kt = 0; kt < nk; kt += 2) {
        if (kt + 2 < nk) GT_LOAD(raA, rbA, kt + 2)
        GT_COMPUTE(0)
        GT_STORE(raB, rbB, 1)
        __syncthreads();
        if (kt + 3 < nk) GT_LOAD(raB, rbB, kt + 3)
        GT_COMPUTE(1)
        if (kt + 2 < nk) GT_STORE(raA, rbA, 0)
        __syncthreads();
    }
#undef GT_LOAD
#undef GT_STORE
#undef GT_COMPUTE
}
struct RowDirect { const bf16_t* A; int lda; int m0; __device__ __forceinline__ const bf16_t* operator()(int r) const { return A + (size_t)(m0 + r) * lda; } };
enum { EPI_INPROJ = 0, EPI_RESID = 1, EPI_BF16 = 2, EPI_BF16_RS = 3 };

__device__ __forceinline__ int vcu_id() { const int G = gridDim.x, bx = blockIdx.x; return (G % 8 == 0) ? (bx % 8) * (G / 8) + bx / 8 : bx; }

template <int EPI>
__device__ __forceinline__ void gemm_phase(char* smem, const bf16_t* A, int lda, const bf16_t* Bt, int ldb, int M, int N, int K, void* out, int ldo, const float* resid, float* gates, int idx0 = -1, int stride = 0) {
    const int ntn = N / 128, ntiles = (M / 256) * ntn;
    if (stride == 0) { idx0 = vcu_id(); stride = gridDim.x; }
    if (idx0 < 0) return;
    const int lane = TIDX & 63, wave = TIDX >> 6, wm = wave >> 1, wn = wave & 1;
    for (int tIdx = idx0; tIdx < ntiles; tIdx += stride) {
        const int m0 = (tIdx / ntn) * 256, n0 = (tIdx % ntn) * 128;
        f32x4 acc[4][4];
        RowDirect rp{A, lda, m0};
        gemm_tile(smem, rp, Bt, ldb, n0, K, acc);
        float rsc[4] = {1.f, 1.f, 1.f, 1.f};
        if (EPI == EPI_BF16_RS) {
#pragma unroll
            for (int m = 0; m < 4; ++m) rsc[m] = rinv_from_pss(resid, (size_t)(m0 + wm * 64 + m * 16 + (lane & 15)));
        }
#pragma unroll
        for (int m = 0; m < 4; ++m)
#pragma unroll
            for (int n = 0; n < 4; ++n) {
                const int row = m0 + wm * 64 + m * 16 + (lane & 15), col = n0 + wn * 64 + n * 16 + (lane >> 4) * 4;
                const f32x4 v = acc[m][n];
                if (EPI == EPI_INPROJ) {
                    uint2 o; o.x = pk2(v.x, v.y); o.y = pk2(v.z, v.w);
                    *(uint2*)((bf16_t*)out + (size_t)row * ldo + col) = o;
                    if (col >= C_GATE && col < C_GATE + 16) *(f32x4*)(gates + (size_t)row * 16 + (col - C_GATE)) = v;
                } else if (EPI == EPI_RESID) {
                    const f32x4 r = *(const f32x4*)(resid + (size_t)row * ldo + col);
                    *(f32x4*)((float*)out + (size_t)row * ldo + col) = r + v;
                } else if (EPI == EPI_BF16_RS) {
                    const float ri = rsc[m];
                    uint2 o; o.x = pk2(v.x * ri, v.y * ri); o.y = pk2(v.z * ri, v.w * ri);
                    *(uint2*)((bf16_t*)out + (size_t)row * ldo + col) = o;
                } else {
                    uint2 o; o.x = pk2(v.x, v.y); o.y = pk2(v.z, v.w);
                    *(uint2*)((bf16_t*)out + (size_t)row * ldo + col) = o;
                }
            }
    }
}


namespace pg8 {
#define PG8_LAS __attribute__((address_space(3)))
typedef unsigned short bf16_t;
typedef short bf16x8 __attribute__((ext_vector_type(8)));
typedef float f32x4 __attribute__((ext_vector_type(4)));
typedef unsigned u32x4 __attribute__((ext_vector_type(4)));
constexpr int BM = 256, BK = 64, HALF = 128, HTB = HALF * BK * 2  , STAGE_BYTES = 8 * HTB, NXCD = 8, WGM = 8;

__host__ __device__ __forceinline__ int lds_byte(int r, int c) { const int st = (r >> 4) * 2 + (c >> 5), rr = r & 15, cc = c & 31, ob = rr * 64 + cc * 2; return st * 1024 + (ob ^ (((ob >> 9) & 1) << 5)); }
__host__ __device__ __forceinline__ void stage_rc(int b, int& R, int& C) { const int st = b / 1024, sb = b % 1024, swz = sb ^ (((sb >> 9) & 1) << 5); R = (st >> 1) * 16 + swz / 64; C = (st & 1) * 32 + (swz % 64) / 2; }
__host__ __device__ __forceinline__ int perm32(int rho) { const int n = rho >> 4, i = rho & 15; return 8 * (i >> 2) + 4 * n + (i & 3); }

struct Unit { int pm, pn; };
struct Gemm { const bf16_t* A; const bf16_t* Bt; int M, N, K; };

struct StaticOrder {
    int nM, nN, nwg, G, c;
    __host__ __device__ void init(int M, int N, int G_, int c_) { nM = M / BM; nN = N / BM; nwg = nM * nN; G = G_; c = c_; }
    __host__ __device__ bool next(int i, Unit& u) const {
        const long L = (long)i * G + c; if (L >= nwg) return false;
        int wgid = (int)L; { const int q = nwg / NXCD, r = nwg % NXCD, xcd = wgid % NXCD, off = wgid / NXCD; wgid = (xcd < r ? xcd * (q + 1) : r * (q + 1) + (xcd - r) * q) + off; }
        const int nig = WGM * nN, gid = wgid / nig, fm = gid * WGM, gsz = (nM - fm) < WGM ? (nM - fm) : WGM;
        u.pm = fm + ((wgid % nig) % gsz); u.pn = (wgid % nig) / gsz; return true;
    }
    __device__ __forceinline__ void a_ready(const Unit&) const {}
    __device__ __forceinline__ void done(const Unit&) const {}
};
__device__ __forceinline__ unsigned cvt_pk_bf16(float lo, float hi) { unsigned r; asm volatile("v_cvt_pk_bf16_f32 %0, %1, %2" : "=v"(r) : "v"(lo), "v"(hi)); return r; }
typedef float f32x2 __attribute__((ext_vector_type(2)));

struct EpiInProj {
    static constexpr bool PERM = true, AFTER_DRAIN = false;
    bf16_t* O; int ldc; float* gates; int gate_col;
    __device__ __forceinline__ void operator()(const f32x4 (&acc)[2][2][4][2], const Unit& u, int wr, int wc, int fr, int fq) const {
        const int row0 = u.pm * BM + wr * 64 + fr, col0 = u.pn * BM + wc * 32 + 8 * fq;
#pragma unroll
        for (int ai = 0; ai < 2; ++ai)
#pragma unroll
            for (int m = 0; m < 4; ++m) {
                const int row = row0 + ai * HALF + m * 16;
                bf16_t* rowp = O + (size_t)row * ldc + col0;
#pragma unroll
                for (int bj = 0; bj < 2; ++bj) {
                    const f32x4 v0 = acc[ai][bj][m][0], v1 = acc[ai][bj][m][1];
                    u32x4 w; w.x = cvt_pk_bf16(v0[0], v0[1]); w.y = cvt_pk_bf16(v0[2], v0[3]); w.z = cvt_pk_bf16(v1[0], v1[1]); w.w = cvt_pk_bf16(v1[2], v1[3]);
                    *(u32x4*)(rowp + bj * HALF) = w;
                    const int gc = col0 + bj * HALF - gate_col;
                    if (gates && gc >= 0 && gc < 16) { *(f32x4*)(gates + (size_t)row * 16 + gc) = v0; *(f32x4*)(gates + (size_t)row * 16 + gc + 4) = v1; }
                }
            }
    }
};
struct EpiResid {
    static constexpr bool PERM = false, AFTER_DRAIN = false;
    const float* base; float* out; int ldc;
    __device__ __forceinline__ void operator()(const f32x4 (&acc)[2][2][4][2], const Unit& u, int wr, int wc, int fr, int fq) const {
        const int col0 = u.pn * BM + wc * 32 + 4 * fq;
#pragma unroll
        for (int ai = 0; ai < 2; ++ai)
#pragma unroll
            for (int m = 0; m < 4; ++m) {
                const size_t off = (size_t)(u.pm * BM + ai * HALF + wr * 64 + m * 16 + fr) * ldc + col0;
#pragma unroll
                for (int bj = 0; bj < 2; ++bj)
#pragma unroll
                    for (int n = 0; n < 2; ++n) { const f32x4 bs = *(const f32x4*)(base + off + bj * HALF + n * 16); *(f32x4*)(out + off + bj * HALF + n * 16) = bs + acc[ai][bj][m][n]; }
                if (m & 1) asm volatile("" ::: "memory");
            }
    }
};

struct EpiResidNorm {
    static constexpr bool PERM = false, AFTER_DRAIN = false;
    const float* base; float* out; int ldc; const float* gn; bf16_t* xg; float* pss;
    __device__ __forceinline__ void operator()(const f32x4 (&acc)[2][2][4][2], const Unit& u, int wr, int wc, int fr, int fq) const {
        const int col0 = u.pn * BM + wc * 32 + 4 * fq;
        f32x4 gv[2][2];
#pragma unroll
        for (int bj = 0; bj < 2; ++bj)
#pragma unroll
            for (int n = 0; n < 2; ++n) gv[bj][n] = *(const f32x4*)(gn + col0 + bj * HALF + n * 16);
#pragma unroll
        for (int ai = 0; ai < 2; ++ai)
#pragma unroll
            for (int m = 0; m < 4; ++m) {
                const int row = u.pm * BM + ai * HALF + wr * 64 + m * 16 + fr;
                const size_t off = (size_t)row * ldc + col0;
                float ss = 0.f;
#pragma unroll
                for (int bj = 0; bj < 2; ++bj)
#pragma unroll
                    for (int n = 0; n < 2; ++n) {
                        const f32x4 bs = *(const f32x4*)(base + off + bj * HALF + n * 16);
                        const f32x4 o = bs + acc[ai][bj][m][n];
                        *(f32x4*)(out + off + bj * HALF + n * 16) = o;
                        ss += (o[0] * o[0] + o[1] * o[1]) + (o[2] * o[2] + o[3] * o[3]);
                        const f32x4 og = o * gv[bj][n];
                        uint2 w; w.x = cvt_pk_bf16(og[0], og[1]); w.y = cvt_pk_bf16(og[2], og[3]);
                        *(uint2*)(xg + off + bj * HALF + n * 16) = w;
                    }
                ss += __shfl_xor(ss, 16); ss += __shfl_xor(ss, 32);
                if (fq == 0) pss[(size_t)row * 16 + u.pn * 4 + wc] = ss;
                if (m & 1) asm volatile("" ::: "memory");
            }
    }
};
template <class Epi, class Sched, bool ALIGN_EPI = false, bool SP2 = false>
__device__ __forceinline__ void gemm_phase(PG8_LAS unsigned char* lds, const Gemm g, const Sched& S, const Epi& E) {
    const int tid = TIDX, wid = __builtin_amdgcn_readfirstlane(tid >> 6), lane = tid & 63, wr = wid >> 2, wc = wid & 3, fr = lane & 15, fq = lane >> 4;
    const int K = g.K, nt = K / BK;
    unsigned voffA[2], voffB[2];
#pragma unroll
    for (int i = 0; i < 2; ++i) { int R, C; stage_rc(tid * 16 + i * 8192, R, C); const int Rb = Epi::PERM ? ((R & ~31) + perm32(R & 31)) : R;
        voffA[i] = (unsigned)(R * K + C) * 2u; voffB[i] = (unsigned)(Rb * K + C) * 2u; }
    const size_t kstep = (size_t)(BK * 2);
    const size_t hstep = (size_t)HALF * K * 2;
    const size_t tstep = 2 * hstep;
    const unsigned ldsw = (unsigned)wid * 1024u;
    const int aoff = lds_byte(wr * 64 + fr, fq * 8), boff = lds_byte(wc * 32 + fr, fq * 8);
#define PG8_SA(b, h) (((b) * 2 + (h)) * HTB)
#define PG8_SB(b, h) ((4 + (b) * 2 + (h)) * HTB)
#define PG8_STAGE(bufoff, gbase, voff) do { _Pragma("unroll") for (int _i = 0; _i < 2; ++_i) \
        __builtin_amdgcn_global_load_lds((const unsigned*)((const char*)(gbase) + (voff)[_i]), (PG8_LAS unsigned*)(lds + (bufoff) + ldsw + _i * 8192), 16, 0, 0); } while (0)
#define PG8_LDA(dst, b, h) do { _Pragma("unroll") for (int m = 0; m < 4; ++m) _Pragma("unroll") for (int k = 0; k < 2; ++k) dst[m][k] = *(const PG8_LAS bf16x8*)(lds + PG8_SA(b, h) + aoff + m * 2048 + k * 1024); } while (0)
#define PG8_LDB(dst, b, h) do { _Pragma("unroll") for (int n = 0; n < 2; ++n) _Pragma("unroll") for (int k = 0; k < 2; ++k) dst[n][k] = *(const PG8_LAS bf16x8*)(lds + PG8_SB(b, h) + boff + n * 2048 + k * 1024); } while (0)
#define PG8_MMA(ai, bj, At, Bt) do { __builtin_amdgcn_s_setprio(1); _Pragma("unroll") for (int m = 0; m < 4; ++m) _Pragma("unroll") for (int n = 0; n < 2; ++n) _Pragma("unroll") for (int k = 0; k < 2; ++k) \
        acc[ai][bj][m][n] = __builtin_amdgcn_mfma_f32_16x16x32_bf16(Bt[n][k], At[m][k], acc[ai][bj][m][n], 0, 0, 0); __builtin_amdgcn_s_setprio(0); } while (0)
#define PG8_WAIT_V(n) asm volatile("s_waitcnt vmcnt(" #n ")" ::: "memory")
#define PG8_WAIT_L(n) asm volatile("s_waitcnt lgkmcnt(" #n ")" ::: "memory")
#define PG8_BAR __builtin_amdgcn_s_barrier()
#define PG8_SCHED __builtin_amdgcn_sched_barrier(0)
    Unit cur, nxt; int ui = 0;
    if (!S.next(0, cur)) return;
    f32x4 acc[2][2][4][2];
#pragma unroll
    for (int a = 0; a < 2; ++a)
#pragma unroll
        for (int b = 0; b < 2; ++b)
#pragma unroll
            for (int m = 0; m < 4; ++m)
#pragma unroll
                for (int n = 0; n < 2; ++n) acc[a][b][m][n] = (f32x4){0.f, 0.f, 0.f, 0.f};
    bf16x8 At[4][2], B0[2][2], B1[2][2];
    const char* cA = (const char*)g.A + (size_t)cur.pm * tstep; const char* cB = (const char*)g.Bt + (size_t)cur.pn * tstep;
    S.a_ready(cur);
    if constexpr (SP2) {
        PG8_STAGE(PG8_SB(0, 0), cB, voffB); PG8_STAGE(PG8_SB(0, 1), cB + hstep, voffB); PG8_STAGE(PG8_SA(0, 0), cA, voffA); PG8_STAGE(PG8_SA(0, 1), cA + hstep, voffA);
        if (wr == 1) PG8_BAR;
        PG8_WAIT_V(2); PG8_BAR;
        PG8_STAGE(PG8_SB(1, 0), cB + kstep, voffB); PG8_STAGE(PG8_SA(1, 0), cA + kstep, voffA); PG8_STAGE(PG8_SB(1, 1), cB + hstep + kstep, voffB);
        PG8_WAIT_V(6); PG8_BAR;
    } else {
        PG8_STAGE(PG8_SB(0, 0), cB, voffB); PG8_STAGE(PG8_SA(0, 0), cA, voffA); PG8_STAGE(PG8_SB(0, 1), cB + hstep, voffB); PG8_STAGE(PG8_SA(0, 1), cA + hstep, voffA);
        if (wr == 1) PG8_BAR;
        PG8_WAIT_V(4); PG8_BAR;
        PG8_STAGE(PG8_SB(1, 0), cB + kstep, voffB); PG8_STAGE(PG8_SA(1, 0), cA + kstep, voffA); PG8_STAGE(PG8_SB(1, 1), cB + hstep + kstep, voffB);
        PG8_WAIT_V(6); PG8_BAR;
    }
    for (;;) {
        const bool has_next = S.next(ui + 1, nxt);
        const char* nA = has_next ? (const char*)g.A + (size_t)nxt.pm * tstep : cA; const char* nB = has_next ? (const char*)g.Bt + (size_t)nxt.pn * tstep : cB;
        for (int t = 0; t < nt; t += 2) {
            const bool last = (t == nt - 2);
            const char* a1 = cA + (size_t)(t + 1) * kstep;
            const char* a2 = last ? nA : cA + (size_t)(t + 2) * kstep; const char* b2 = last ? nB : cB + (size_t)(t + 2) * kstep;
            const char* a3 = a2 + kstep; const char* b3 = b2 + kstep;
            if (last && has_next) S.a_ready(nxt);
            if constexpr (SP2) {
            PG8_LDB(B0, 0, 0); PG8_LDB(B1, 0, 1); PG8_SCHED; PG8_LDA(At, 0, 0); PG8_STAGE(PG8_SA(1, 1), a1 + hstep, voffA);
            PG8_WAIT_V(8); PG8_WAIT_L(0); PG8_BAR; PG8_MMA(0, 0, At, B0); PG8_MMA(0, 1, At, B1); PG8_BAR; PG8_SCHED;
            PG8_LDA(At, 0, 1); PG8_STAGE(PG8_SB(0, 0), b2, voffB); PG8_STAGE(PG8_SB(0, 1), b2 + hstep, voffB); PG8_STAGE(PG8_SA(0, 0), a2, voffA);
            PG8_WAIT_V(8); PG8_WAIT_L(0); PG8_BAR; PG8_MMA(1, 0, At, B0); PG8_MMA(1, 1, At, B1); PG8_BAR; PG8_SCHED;
            PG8_LDB(B0, 1, 0); PG8_LDB(B1, 1, 1); PG8_SCHED; PG8_LDA(At, 1, 0); PG8_STAGE(PG8_SA(0, 1), a2 + hstep, voffA);
            PG8_WAIT_V(8); PG8_WAIT_L(0); PG8_BAR; PG8_MMA(0, 0, At, B0); PG8_MMA(0, 1, At, B1); PG8_BAR; PG8_SCHED;
            PG8_LDA(At, 1, 1); PG8_STAGE(PG8_SB(1, 0), b3, voffB); PG8_STAGE(PG8_SB(1, 1), b3 + hstep, voffB); PG8_STAGE(PG8_SA(1, 0), a3, voffA);
            PG8_WAIT_V(8); PG8_WAIT_L(0); PG8_BAR; PG8_MMA(1, 0, At, B0); PG8_MMA(1, 1, At, B1); PG8_BAR; PG8_SCHED;
            } else {
            PG8_LDB(B0, 0, 0); PG8_SCHED; PG8_LDA(At, 0, 0); PG8_STAGE(PG8_SA(1, 1), a1 + hstep, voffA);
            PG8_WAIT_L(8); PG8_BAR; PG8_WAIT_L(0); PG8_MMA(0, 0, At, B0); PG8_BAR; PG8_SCHED;
            PG8_LDB(B1, 0, 1); PG8_STAGE(PG8_SB(0, 0), b2, voffB);
            PG8_BAR; PG8_WAIT_L(0); PG8_MMA(0, 1, At, B1); PG8_BAR;
            PG8_LDA(At, 0, 1); PG8_STAGE(PG8_SA(0, 0), a2, voffA);
            PG8_BAR; PG8_WAIT_L(0); PG8_MMA(1, 0, At, B0); PG8_BAR; PG8_SCHED;
            PG8_STAGE(PG8_SB(0, 1), b2 + hstep, voffB);
            PG8_WAIT_V(6); PG8_BAR; PG8_MMA(1, 1, At, B1); PG8_BAR;
            PG8_LDB(B0, 1, 0); PG8_SCHED; PG8_LDA(At, 1, 0); PG8_STAGE(PG8_SA(0, 1), a2 + hstep, voffA);
            PG8_WAIT_L(8); PG8_BAR; PG8_WAIT_L(0); PG8_MMA(0, 0, At, B0); PG8_BAR; PG8_SCHED;
            PG8_LDB(B1, 1, 1); PG8_STAGE(PG8_SB(1, 0), b3, voffB);
            PG8_BAR; PG8_WAIT_L(0); PG8_MMA(0, 1, At, B1); PG8_BAR;
            PG8_LDA(At, 1, 1); PG8_STAGE(PG8_SA(1, 0), a3, voffA);
            PG8_BAR; PG8_WAIT_L(0); PG8_MMA(1, 0, At, B0); PG8_BAR; PG8_SCHED;
            PG8_STAGE(PG8_SB(1, 1), b3 + hstep, voffB);
            PG8_WAIT_V(6); PG8_BAR; PG8_MMA(1, 1, At, B1); PG8_BAR;
            }
        }
        if constexpr (ALIGN_EPI) { if (wr == 0) PG8_BAR; }
        if constexpr (!Epi::AFTER_DRAIN) { E(acc, cur, wr, wc, fr, fq); S.done(cur); }
        if (!has_next) break;
#pragma unroll
        for (int a = 0; a < 2; ++a)
#pragma unroll
            for (int b = 0; b < 2; ++b)
#pragma unroll
                for (int m = 0; m < 4; ++m)
#pragma unroll
                    for (int n = 0; n < 2; ++n) acc[a][b][m][n] = (f32x4){0.f, 0.f, 0.f, 0.f};
        cur = nxt; cA = nA; cB = nB; ++ui;
        if constexpr (ALIGN_EPI) { if (wr == 1) PG8_BAR; }
    }
    PG8_WAIT_V(0);
    if constexpr (!ALIGN_EPI) { if (wr == 0) PG8_BAR; }
    PG8_BAR;
    if constexpr (Epi::AFTER_DRAIN) { E.fused(acc, cur, wr, wc, fr, fq, lds, wid, lane); S.done(cur); }
#undef PG8_SA
#undef PG8_SB
#undef PG8_STAGE
#undef PG8_LDA
#undef PG8_LDB
#undef PG8_MMA
#undef PG8_WAIT_V
#undef PG8_WAIT_L
#undef PG8_BAR
#undef PG8_SCHED
}
}

struct RowGather { const bf16_t* A; int lda; const int* ids; int shift; __device__ __forceinline__ const bf16_t* operator()(int r) const { return A + (size_t)(ids[r] >> shift) * lda; } };
template <int STAGE>
__device__ __forceinline__ void moe_phase(char* smem, const bf16_t* A, int lda, const bf16_t* Wt, size_t wstride, int ldb, int K, const int* cnt, const int* list, const float* pgate, bf16_t* out, const float* pss) {
    int* ids = (int*)(smem + GEMM_LDS);
    int* tpre = ids + 256;
    constexpr int NTN = (STAGE == 1) ? 4 : 8;
    __syncthreads();
    if (TIDX < 64) {
        const int ln = TIDX; int nt = (ln < NEXP) ? ((cnt[ln * CNT_STRIDE] + 255) >> 8) : 0; int inc = nt;
#pragma unroll
        for (int o = 1; o < 64; o <<= 1) { const int nb = __shfl_up(inc, o); if (ln >= o) inc += nb; }
        if (ln <= NEXP) tpre[ln] = inc - nt;
    }
    __syncthreads();
    const int ntiles = tpre[NEXP] * NTN;
    const int lane = TIDX & 63, wave = TIDX >> 6, wm = wave >> 1, wn = wave & 1;
    for (int tIdx = vcu_id(); tIdx < ntiles; tIdx += gridDim.x) {
        const int mtg = tIdx / NTN, n0 = (tIdx % NTN) * 128;
        int e = 0;
        for (int i = 1; i < NEXP; ++i) if (tpre[i] <= mtg) e = i;
        const int mt = mtg - tpre[e];
        const int cn = cnt[e * CNT_STRIDE];
        __syncthreads();
        if (TIDX < 256) { const int pos = mt * 256 + TIDX; ids[TIDX] = list[(size_t)e * T + (pos < cn ? pos : cn - 1)]; }
        __syncthreads();
        f32x4 acc[4][4];
        RowGather rp{A, lda, ids, STAGE == 1 ? 1 : 0};
        gemm_tile(smem, rp, Wt + (size_t)e * wstride, ldb, n0, K, acc);
#pragma unroll
        for (int m = 0; m < 4; ++m) {
            const int rl = wm * 64 + m * 16 + (lane & 15);
            if (mt * 256 + rl >= cn) continue;
            const int pid = ids[rl];
            if (STAGE == 1) {
                const float gt = pgate[pid], ri = rinv_from_pss(pss, (size_t)(pid >> 1));
#pragma unroll
                for (int np = 0; np < 2; ++np) {
                    const f32x4 g = acc[m][2 * np], u = acc[m][2 * np + 1];
                    const int j = (n0 + wn * 64 + np * 32) / 2 + (lane >> 4) * 4;
                    const f32x4 gs = g * ri; const float ug = ri * gt;
                    uint2 o; o.x = pk2(siluf_(gs.x) * u.x * ug, siluf_(gs.y) * u.y * ug); o.y = pk2(siluf_(gs.z) * u.z * ug, siluf_(gs.w) * u.w * ug);
                    *(uint2*)(out + (size_t)pid * DEXP + j) = o;
                }
            } else {
#pragma unroll
                for (int n = 0; n < 4; ++n) {
                    const f32x4 v = acc[m][n]; const int col = n0 + wn * 64 + n * 16 + (lane >> 4) * 4;
                    uint2 o; o.x = pk2(v.x, v.y); o.y = pk2(v.z, v.w);
                    *(uint2*)(out + (size_t)pid * 1024 + col) = o;
                }
            }
        }
    }
}

__device__ __forceinline__ void hgrn2_naive(const bf16_t* __restrict__ proj, const float* __restrict__ hgrn_lb, int layer, const float* __restrict__ mix_gain, bf16_t* __restrict__ y, int bh, int lane) {
    const int b = bh >> 2, h = bh & 3;
    float lbk = 0.f;
    if (layer == 1) { float a0 = hgrn_lb[h * 64 + lane], a1 = hgrn_lb[256 + h * 64 + lane]; lbk = 1.f / (1.f + __expf(a0 - a1)); }
    const float mg = mix_gain[C_AQ + h * 64 + lane];
    float S[64];
#pragma unroll
    for (int k = 0; k < 64; ++k) S[k] = 0.f;
    for (int t = 0; t < SEQ; ++t) {
        const bf16_t* pr = proj + (size_t)(b * SEQ + t) * NP + h * 64 + lane;
        const float qk = siluf_(bf2f(pr[C_AQ]));
        const float sg = sigmoidf_(bf2f(pr[C_AF]));
        const float f = lbk + (1.f - lbk) * sg, kk = (1.f - lbk) * (1.f - sg);
        const float iv = bf2f(pr[C_AI]);
        const float gv = bf2f(pr[C_AG]);
        float o = 0.f;
#pragma unroll
        for (int k = 0; k < 64; ++k) { S[k] = rdlane(f, k) * S[k] + rdlane(kk, k) * iv; o += rdlane(qk, k) * S[k]; }
        const float ms = wave_sum(o * o) * (1.f / 64.f);
        const float yv = o * rsqrtf(ms + EPS) * siluf_(gv) * mg;
        y[(size_t)(b * SEQ + t) * 1024 + 0 + h * 64 + lane] = f2bf(yv);
    }
}
__device__ __forceinline__ void gdn_naive(const bf16_t* __restrict__ proj, const float* __restrict__ gates, const float* __restrict__ conv_w  ,
                                          const float* __restrict__ a_log, const float* __restrict__ dt_bias, const float* __restrict__ mix_gain, bf16_t* __restrict__ y, int bh, int lane) {
    const int b = bh >> 2, h = bh & 3;
    float wq[4], wk[4], wv[4];
#pragma unroll
    for (int j = 0; j < 4; ++j) { wq[j] = conv_w[j * 768 + h * 64 + lane]; wk[j] = conv_w[j * 768 + 256 + h * 64 + lane]; wv[j] = conv_w[j * 768 + 512 + h * 64 + lane]; }
    float xq[3] = {0.f, 0.f, 0.f}, xk[3] = {0.f, 0.f, 0.f}, xv[3] = {0.f, 0.f, 0.f};
    const float Aexp = __expf(a_log[h]), dtb = dt_bias[h];
    const float mg = mix_gain[768 + h * 64 + lane];
    float S[64];
#pragma unroll
    for (int k = 0; k < 64; ++k) S[k] = 0.f;
    for (int t = 0; t < SEQ; ++t) {
        const size_t row = (size_t)(b * SEQ + t);
        const bf16_t* pr = proj + row * NP + h * 64 + lane;
        const float q0 = bf2f(pr[C_DQ]), k0 = bf2f(pr[C_DK]), v0 = bf2f(pr[C_DV]), zv = bf2f(pr[C_DZ]);
        float q = siluf_(wq[0] * xq[0] + wq[1] * xq[1] + wq[2] * xq[2] + wq[3] * q0);
        float k = siluf_(wk[0] * xk[0] + wk[1] * xk[1] + wk[2] * xk[2] + wk[3] * k0);
        float v = siluf_(wv[0] * xv[0] + wv[1] * xv[1] + wv[2] * xv[2] + wv[3] * v0);
        xq[0] = xq[1]; xq[1] = xq[2]; xq[2] = q0; xk[0] = xk[1]; xk[1] = xk[2]; xk[2] = k0; xv[0] = xv[1]; xv[1] = xv[2]; xv[2] = v0;
        q = q * rsqrtf(wave_sum(q * q) + EPS) * 0.125f;
        k = k * rsqrtf(wave_sum(k * k) + EPS);
        const float beta = sigmoidf_(gates[row * 16 + 4 + h]);
        const float g = -Aexp * softplusf_(gates[row * 16 + 8 + h] + dtb);
        const float eg = __expf(g);
        float r = 0.f;
#pragma unroll
        for (int i = 0; i < 64; ++i) { S[i] *= eg; r += rdlane(k, i) * S[i]; }
        const float dlt = beta * (v - r);
        float o = 0.f;
#pragma unroll
        for (int i = 0; i < 64; ++i) { S[i] += rdlane(k, i) * dlt; o += rdlane(q, i) * S[i]; }
        const float ms = wave_sum(o * o) * (1.f / 64.f);
        const float yv = o * rsqrtf(ms + EPS) * siluf_(zv) * mg;
        y[row * 1024 + 768 + h * 64 + lane] = f2bf(yv);
    }
}
__device__ __forceinline__ void fox_cumsum(const float* __restrict__ gates, const float* __restrict__ fb, float* __restrict__ cc, int bh, int lane) {
    const int b = bh >> 2, h = bh & 3;
    const float bias = fb[h];
    float v[32];
#pragma unroll
    for (int i = 0; i < 32; ++i) v[i] = gates[(size_t)(b * SEQ + lane * 32 + i) * 16 + h];
    float run = 0.f;
#pragma unroll
    for (int i = 0; i < 32; ++i) { run += logsigmoidf_(v[i] + bias); v[i] = run; }
    float tot = run;
#pragma unroll
    for (int o = 1; o < 64; o <<= 1) { const float nb = __shfl_up(tot, o); if (lane >= o) tot += nb; }
    const float off = tot - run;
    float* dst = cc + (size_t)(b * 4 + h) * SEQ + lane * 32;
#pragma unroll
    for (int i = 0; i < 32; i += 4) *(f32x4*)(dst + i) = (f32x4){v[i] + off, v[i + 1] + off, v[i + 2] + off, v[i + 3] + off};
}
__device__ __forceinline__ void lru_prep_task(float* xc  , const bf16_t* __restrict__ proj, const float* __restrict__ conv_w, const float* __restrict__ conv_b,
                                              const float* __restrict__ w_a, const float* __restrict__ b_a, const float* __restrict__ w_x, const float* __restrict__ b_x,
                                              const float* __restrict__ lam, float* __restrict__ a_out, float* __restrict__ u_out, int task, bool active) {
    const int c = TIDX & 255, t0 = task * 16;
    if (active) {
        const float w0 = conv_w[c], w1 = conv_w[256 + c], w2 = conv_w[512 + c], w3 = conv_w[768 + c], cb = conv_b[c];
        for (int i = 0; i < 16; ++i) {
            const int t = t0 + i, s = t & (SEQ - 1);
            const bf16_t* pr = proj + (size_t)t * NP + C_CX + c;
            float acc = cb + w3 * bf2f(pr[0]);
            if (s >= 1) acc += w2 * bf2f(pr[-(ptrdiff_t)NP]);
            if (s >= 2) acc += w1 * bf2f(pr[-(ptrdiff_t)2 * NP]);
            if (s >= 3) acc += w0 * bf2f(pr[-(ptrdiff_t)3 * NP]);
            xc[i * 256 + c] = acc;
        }
    }
    __syncthreads();
    if (active) {
        const int h = c >> 6, jj = c & 63;
        float ra[16], rx[16];
#pragma unroll
        for (int i = 0; i < 16; ++i) { ra[i] = 0.f; rx[i] = 0.f; }
        for (int k = 0; k < 64; ++k) {
            const float wa = w_a[(h * 64 + k) * 64 + jj], wx = w_x[(h * 64 + k) * 64 + jj];
#pragma unroll
            for (int i = 0; i < 16; ++i) { const float xv = xc[i * 256 + h * 64 + k]; ra[i] += xv * wa; rx[i] += xv * wx; }
        }
        const float ba = b_a[c], bx = b_x[c], sp = softplusf_(-lam[c]);
#pragma unroll
        for (int i = 0; i < 16; ++i) {
            const float r = sigmoidf_(ra[i] + ba), ig = sigmoidf_(rx[i] + bx);
            const float log_a = -8.f * r * sp;
            const float a = __expf(log_a);
            const float u = sqrtf(-expm1f(2.f * log_a)) * (ig * xc[i * 256 + c]);
            a_out[(size_t)(t0 + i) * 256 + c] = a; u_out[(size_t)(t0 + i) * 256 + c] = u;
        }
    }
    __syncthreads();
}
__device__ __forceinline__ void lru_scan_task(const float* __restrict__ a_in, const float* __restrict__ u_in, const bf16_t* __restrict__ proj, const float* __restrict__ mix_gain, bf16_t* __restrict__ y, int b) {
    const int c = TIDX;
    const float mg = mix_gain[512 + c];
    float hst = 0.f;
    for (int t = 0; t < SEQ; ++t) {
        const size_t row = (size_t)(b * SEQ + t);
        hst = a_in[row * 256 + c] * hst + u_in[row * 256 + c];
        const float yv = hst * geluf_(bf2f(proj[row * NP + C_CG + c]));
        const float ms = wave_sum(yv * yv) * (1.f / 64.f);
        y[row * 1024 + 512 + c] = f2bf(yv * rsqrtf(ms + EPS) * mg);
    }
}

typedef short s16x4 __attribute__((ext_vector_type(4)));
#define LDS_AS __attribute__((address_space(3)))
__device__ __forceinline__ bf16x8 frag_rm(const bf16_t* tile, int ld, int r0, int k0, int lane) { return *(const bf16x8*)(tile + (r0 + (lane & 15)) * ld + k0 + (lane >> 4) * 8); }
__device__ __forceinline__ s16x4 tr4(const bf16_t* tile, int ld, int rbase, int c0, int lane) {
    const bf16_t* p = tile + (rbase + ((lane & 15) >> 2)) * ld + c0 + 4 * (lane & 3);
    return __builtin_amdgcn_ds_read_tr16_b64_v4i16((LDS_AS s16x4*)p);
}
__device__ __forceinline__ bf16x8 frag_cm(const bf16_t* tile, int ld, int k0, int c0, int lane) {
    const s16x4 lo = tr4(tile, ld, k0 + (lane >> 4) * 8, c0, lane), hi = tr4(tile, ld, k0 + (lane >> 4) * 8 + 4, c0, lane);
    return (bf16x8){lo[0], lo[1], lo[2], lo[3], hi[0], hi[1], hi[2], hi[3]};
}
#define MFMA16(a, b, c) __builtin_amdgcn_mfma_f32_16x16x32_bf16((a), (b), (c), 0, 0, 0)
constexpr int TLD = 72;


#define XB_TMO      128
#define XB_XCNT(j)  (256  + 64 * (j))
#define XB_XSUB(j)  (1280 + 64 * (j))
#define XB_XGEN(j)  (2304 + 64 * (j))
#define XB_TOP      3328
#define XB_TOPGEN   3392
#define XCD_BAR_WORDS 3456
#define XB_SPIN_CAP (1u << 18)
__device__ __forceinline__ unsigned xb_ld(unsigned* p)              { return __hip_atomic_load(p, __ATOMIC_RELAXED, __HIP_MEMORY_SCOPE_AGENT); }
__device__ __forceinline__ unsigned xb_add(unsigned* p, unsigned v) { return __hip_atomic_fetch_add(p, v, __ATOMIC_RELAXED, __HIP_MEMORY_SCOPE_AGENT); }
__device__ __forceinline__ unsigned xb_xcc_id() { return (unsigned)__builtin_amdgcn_s_getreg((3 << 11) | 20) & 0xFu; }
#define XB_SPIN(cond, bar) do { unsigned _sp = 0; while (cond) { __builtin_amdgcn_s_sleep(1); \
    if ((++_sp & 255u) == 0u) { if (xb_ld(&(bar)[XB_TMO])) break; if (_sp > XB_SPIN_CAP) { atomicAdd(&(bar)[XB_TMO], 1u); break; } } } } while (0)
struct XcdBarrier { unsigned* bar; unsigned x; volatile LDS_AS unsigned* st; };
__device__ __forceinline__ XcdBarrier xcd_barrier_post(unsigned* bar, volatile LDS_AS unsigned* st) {
    XcdBarrier b; b.bar = bar; b.x = xb_xcc_id(); b.st = st;
    if (TIDX == 0) (void)xb_add(&bar[XB_XCNT(b.x)], 1u);
    return b;
}
__device__ __forceinline__ void xcd_barrier_complete(unsigned* bar, unsigned x, unsigned& nloc, unsigned& nx) {
    const unsigned G = gridDim.x * gridDim.y * gridDim.z;
    unsigned sum, cnt, mine, sp = 0u;
    for (;;) {
        sum = 0u; cnt = 0u; mine = 0u;
#pragma unroll
        for (unsigned j = 0; j < 16; ++j) { const unsigned c = xb_ld(&bar[XB_XCNT(j)]); sum += c; cnt += (c > 0u) ? 1u : 0u; mine = (j == x) ? c : mine; }
        if (sum == G) break;
        __builtin_amdgcn_s_sleep(1);
        if ((++sp & 255u) == 0u) { if (xb_ld(&bar[XB_TMO])) break; if (sp > XB_SPIN_CAP) { atomicAdd(&bar[XB_TMO], 1u); break; } }
    }
    nloc = mine > 0u ? mine : 1u; nx = cnt > 0u ? cnt : 1u;
}
__device__ __forceinline__ void xcd_barrier(const XcdBarrier& b) {
    asm volatile("s_waitcnt vmcnt(0)" ::: "memory");
    __syncthreads();
    if (TIDX == 0) {
        unsigned* bar = b.bar;
        __builtin_amdgcn_s_waitcnt(0);
        unsigned nloc = b.st[0], nx = b.st[1];
        if (nloc == 0u) { xcd_barrier_complete(bar, b.x, nloc, nx); b.st[0] = nloc; b.st[1] = nx; }
        const unsigned old = xb_add(&bar[XB_XSUB(b.x)], 1u);
        const unsigned gen = old / nloc;
        if (old + 1u == (gen + 1u) * nloc) {
            __builtin_amdgcn_fence(__ATOMIC_RELEASE, "agent");
            asm volatile("s_waitcnt vmcnt(0)" ::: "memory");
            const unsigned og = xb_add(&bar[XB_TOP], 1u);
            const unsigned tg = og / nx;
            if (og + 1u == (tg + 1u) * nx) xb_add(&bar[XB_TOPGEN], 1u);
            else XB_SPIN(xb_ld(&bar[XB_TOPGEN]) == tg, bar);
            __builtin_amdgcn_fence(__ATOMIC_ACQUIRE, "agent");
            xb_add(&bar[XB_XGEN(b.x)], 1u);
            asm volatile("s_waitcnt vmcnt(0)" ::: "memory");
        } else {
            XB_SPIN(xb_ld(&bar[XB_XGEN(b.x)]) == gen, bar);
            __builtin_amdgcn_fence(__ATOMIC_ACQUIRE, "agent");
            asm volatile("s_waitcnt vmcnt(0)" ::: "memory");
        }
    }
    __syncthreads();
}

template <bool MASK>
__device__ __forceinline__ void attn_compute_t(const bf16_t* cK, const bf16_t* cV, const float* cC, const bf16x8 (&qf)[2], f32x4 (&oacc)[4], float& mrun, float& lrun,
                                               float ct2, float scale2, int kt, int tq, int lane, int g) {
    f32x4 sacc[4];
#pragma unroll
    for (int n = 0; n < 4; ++n) {
        sacc[n] = (f32x4){0.f, 0.f, 0.f, 0.f};
#pragma unroll
        for (int kk = 0; kk < 2; ++kk) sacc[n] = MFMA16(frag_rm(cK, TLD, n * 16, kk * 32, lane), qf[kk], sacc[n]);
    }
    float mx = -INFINITY;
#pragma unroll
    for (int n = 0; n < 4; ++n) {
        const f32x4 cs = *(const f32x4*)(cC + n * 16 + 4 * g);
#pragma unroll
        for (int r = 0; r < 4; ++r) {
            float v = sacc[n][r] * scale2 + (ct2 - cs[r]);
            if (MASK) { if (kt * 64 + n * 16 + 4 * g + r > tq) v = -INFINITY; }
            sacc[n][r] = v; mx = fmaxf(mx, v);
        }
    }
    mx = fmaxf(mx, __shfl_xor(mx, 16)); mx = fmaxf(mx, __shfl_xor(mx, 32));
    const float mnew = fmaxf(mrun, mx);
    const float corr = __builtin_amdgcn_exp2f(mrun - mnew);
    float rs = 0.f;
#pragma unroll
    for (int n = 0; n < 4; ++n)
#pragma unroll
        for (int r = 0; r < 4; ++r) { const float p = __builtin_amdgcn_exp2f(sacc[n][r] - mnew); sacc[n][r] = p; rs += p; }
    rs += __shfl_xor(rs, 16); rs += __shfl_xor(rs, 32);
    lrun = lrun * corr + rs; mrun = mnew;
    bf16x8 pf[2];
#pragma unroll
    for (int kk = 0; kk < 2; ++kk) {
        const u32x4 pk = (u32x4){pk2(sacc[2 * kk][0], sacc[2 * kk][1]), pk2(sacc[2 * kk][2], sacc[2 * kk][3]), pk2(sacc[2 * kk + 1][0], sacc[2 * kk + 1][1]), pk2(sacc[2 * kk + 1][2], sacc[2 * kk + 1][3])};
        pf[kk] = __builtin_bit_cast(bf16x8, pk);
    }
#pragma unroll
    for (int n2 = 0; n2 < 4; ++n2) {
        oacc[n2] = oacc[n2] * corr;
#pragma unroll
        for (int kk = 0; kk < 2; ++kk) {
            const s16x4 lo = tr4(cV, TLD, (2 * kk) * 16 + 4 * g, n2 * 16, lane), hi = tr4(cV, TLD, (2 * kk + 1) * 16 + 4 * g, n2 * 16, lane);
            const bf16x8 vf = (bf16x8){lo[0], lo[1], lo[2], lo[3], hi[0], hi[1], hi[2], hi[3]};
            oacc[n2] = MFMA16(vf, pf[kk], oacc[n2]);
        }
    }
}
__device__ __forceinline__ void attn_compute(const bf16_t* cK, const bf16_t* cV, const float* cC, const bf16x8 (&qf)[2], f32x4 (&oacc)[4], float& mrun, float& lrun,
                                             float ct2, float scale2, int causal, int kt, int q0, int tq, int wave, int lane, int g) {
    const int r0 = q0 + wave * 16;
    if (causal && (kt * 64 > r0 + 15)) return;
    if (causal && (kt * 64 + 63 > r0)) attn_compute_t<true>(cK, cV, cC, qf, oacc, mrun, lrun, ct2, scale2, kt, tq, lane, g);
    else attn_compute_t<false>(cK, cV, cC, qf, oacc, mrun, lrun, ct2, scale2, kt, tq, lane, g);
}

__device__ __forceinline__ void attn_task(char* smem, const bf16_t* __restrict__ Q, int ldq, const bf16_t* __restrict__ Kp, int ldk, const bf16_t* __restrict__ Vp, int ldv, const float* __restrict__ bias,
                                          int nq_per_b, int nk_per_b, int causal, float scale, bf16_t* __restrict__ O, int ldo, const float* __restrict__ gain, int rms, int task) {
    bf16_t* sK = (bf16_t*)smem;
    bf16_t* sV = sK + 2 * 64 * TLD;
    float* sC = (float*)(sV + 2 * 64 * TLD);
    const int tid = TIDX, lane = tid & 63, wave = tid >> 6, g = lane >> 4, li = lane & 15;
    const int nqt = nq_per_b / 128;
    const int qt = task % nqt, h = (task / nqt) & 3, b = task / (nqt * 4);
    const int q0 = qt * 128, tq = q0 + wave * 16 + li;
    const size_t qrow = (size_t)b * nq_per_b + tq;
    bf16x8 qf[2];
#pragma unroll
    for (int kk = 0; kk < 2; ++kk) qf[kk] = *(const bf16x8*)(Q + qrow * ldq + h * 64 + kk * 32 + g * 8);
    constexpr float LOG2E = 1.4426950408889634f;
    const float ct = bias ? bias[(size_t)(b * 4 + h) * nq_per_b + tq] * LOG2E : 0.f;
    const float scale2 = scale * LOG2E;
    const int nkt = causal ? (q0 + 128) / 64 : nk_per_b / 64;
    const int sr = tid >> 3, sc = tid & 7;
    const bf16_t* kg = Kp + ((size_t)b * nk_per_b + sr) * ldk + h * 64 + sc * 8;
    const bf16_t* vg = Vp + ((size_t)b * nk_per_b + sr) * ldv + h * 64 + sc * 8;
    const float* cg_ = bias ? bias + (size_t)(b * 4 + h) * nk_per_b : nullptr;
    u32x4 rkA, rvA, rkB, rvB; float rcA = 0.f, rcB = 0.f;
    {   const u32x4 rk = *(const u32x4*)kg, rv = *(const u32x4*)vg; const float rc = (cg_ && tid < 64) ? cg_[tid] * LOG2E : 0.f;
        __syncthreads();
        *(u32x4*)(sK + sr * TLD + sc * 8) = rk; *(u32x4*)(sV + sr * TLD + sc * 8) = rv; if (tid < 64) sC[tid] = rc; }
    rkA = *(const u32x4*)(kg + (size_t)64 * ldk); rvA = *(const u32x4*)(vg + (size_t)64 * ldv); rcA = (cg_ && tid < 64) ? cg_[64 + tid] * LOG2E : 0.f;
    __syncthreads();
    f32x4 oacc[4];
#pragma unroll
    for (int n = 0; n < 4; ++n) oacc[n] = (f32x4){0.f, 0.f, 0.f, 0.f};
    float mrun = -INFINITY, lrun = 0.f;
#define ATTN_ITER(kt, LK, LV, LC, WK, WV, WC) { \
        const int buf = (kt) & 1; \
        if ((kt) + 2 < nkt) { LK = *(const u32x4*)(kg + (size_t)((kt) + 2) * 64 * ldk); LV = *(const u32x4*)(vg + (size_t)((kt) + 2) * 64 * ldv); LC = (cg_ && tid < 64) ? cg_[((kt) + 2) * 64 + tid] * LOG2E : 0.f; } \
        attn_compute(sK + buf * 64 * TLD, sV + buf * 64 * TLD, sC + buf * 64, qf, oacc, mrun, lrun, ct, scale2, causal, (kt), q0, tq, wave, lane, g); \
        if ((kt) + 1 < nkt) { const int nb = buf ^ 1; *(u32x4*)(sK + nb * 64 * TLD + sr * TLD + sc * 8) = WK; *(u32x4*)(sV + nb * 64 * TLD + sr * TLD + sc * 8) = WV; if (tid < 64) sC[nb * 64 + tid] = WC; } \
        __syncthreads(); }
    for (int kt = 0; kt < nkt; kt += 2) {
        ATTN_ITER(kt, rkB, rvB, rcB, rkA, rvA, rcA)
        ATTN_ITER(kt + 1, rkA, rvA, rcA, rkB, rvB, rcB)
    }
#undef ATTN_ITER
    const float inv = 1.f / lrun;
    float ms = 0.f;
#pragma unroll
    for (int n = 0; n < 4; ++n) { oacc[n] = oacc[n] * inv; ms += oacc[n][0] * oacc[n][0] + oacc[n][1] * oacc[n][1] + oacc[n][2] * oacc[n][2] + oacc[n][3] * oacc[n][3]; }
    ms += __shfl_xor(ms, 16); ms += __shfl_xor(ms, 32);
    const float rinv = rms ? rsqrtf(ms * (1.f / 64.f) + EPS) : 1.f;
#pragma unroll
    for (int n = 0; n < 4; ++n) {
        const int d = n * 16 + 4 * g;
        f32x4 gg = (f32x4){1.f, 1.f, 1.f, 1.f};
        if (gain) gg = *(const f32x4*)(gain + h * 64 + d);
        uint2 o; o.x = pk2(oacc[n][0] * rinv * gg[0], oacc[n][1] * rinv * gg[1]); o.y = pk2(oacc[n][2] * rinv * gg[2], oacc[n][3] * rinv * gg[3]);
        *(uint2*)(O + qrow * ldo + h * 64 + d) = o;
    }
}


__device__ __forceinline__ void hgrn_scan(float* LF  , float* SEGT  , const bf16_t* __restrict__ prow  , const float* __restrict__ hgrn_lb, int layer, int h, float (&kk)[8]) {
    const int tid = TIDX, t = tid >> 3, k8 = (tid & 7) * 8;
    const u32x4 raw = *(const u32x4*)(prow + (size_t)t * NP + C_AF + k8);
#pragma unroll
    for (int j = 0; j < 8; ++j) {
        const float fl = __uint_as_float((j & 1) ? (raw[j >> 1] & 0xffff0000u) : (raw[j >> 1] << 16));
        float lbk = 0.f;
        if (layer == 1) { const float a0 = hgrn_lb[h * 64 + k8 + j], a1 = hgrn_lb[256 + h * 64 + k8 + j]; lbk = 1.f / (1.f + __expf(a0 - a1)); }
        const float sg = sigmoidf_(fl);
        const float f = lbk + (1.f - lbk) * sg;
        kk[j] = (1.f - lbk) * (1.f - sg);
        LF[t * 65 + k8 + j] = __logf(f);
    }
    __syncthreads();
    { const int k = tid & 63, seg = tid >> 6; float run = 0.f;
#pragma unroll
      for (int i = 0; i < 8; ++i) { run += LF[(seg * 8 + i) * 65 + k]; LF[(seg * 8 + i) * 65 + k] = run; }
      SEGT[seg * 64 + k] = run; }
    __syncthreads();
    { const int k = tid & 63, seg = tid >> 6; float off = 0.f;
      for (int s2 = 0; s2 < seg; ++s2) off += SEGT[s2 * 64 + k];
#pragma unroll
      for (int i = 0; i < 8; ++i) LF[(seg * 8 + i) * 65 + k] += off; }
    __syncthreads();
}
__device__ __forceinline__ float bfx(const u32x4& raw, int j) { return __uint_as_float((j & 1) ? (raw[j >> 1] & 0xffff0000u) : (raw[j >> 1] << 16)); }

__device__ __forceinline__ void hgrn_local_task(char* smem, const bf16_t* __restrict__ proj, const float* __restrict__ hgrn_lb, int layer, float* __restrict__ HL, float* __restrict__ HD, int ch) {
    float* LF = (float*)smem; float* SEGT = LF + 64 * 65;
    bf16_t* sKd = (bf16_t*)(SEGT + 8 * 64); bf16_t* sV = sKd + 64 * TLD;
    const int tid = TIDX, lane = tid & 63, wave = tid >> 6, g = lane >> 4, li = lane & 15;
    const int bh = ch >> 5, n = ch & 31, b = bh >> 2, h = bh & 3;
    const bf16_t* prow = proj + (size_t)(b * SEQ + n * 64) * NP + h * 64;
    const int t = tid >> 3, k8 = (tid & 7) * 8;
    __syncthreads();
    *(u32x4*)(sV + t * TLD + k8) = *(const u32x4*)(prow + (size_t)t * NP + C_AI + k8);
    float kk[8];
    hgrn_scan(LF, SEGT, prow, hgrn_lb, layer, h, kk);
    { u32x4 o;
#pragma unroll
      for (int j = 0; j < 8; j += 2) {
          const float e0 = kk[j] * __expf(LF[63 * 65 + k8 + j] - LF[t * 65 + k8 + j]), e1 = kk[j + 1] * __expf(LF[63 * 65 + k8 + j + 1] - LF[t * 65 + k8 + j + 1]);
          o[j >> 1] = pk2(e0, e1);
      }
      *(u32x4*)(sKd + t * TLD + k8) = o; }
    if (tid < 64) HD[(size_t)ch * 64 + tid] = __expf(LF[63 * 65 + tid]);
    __syncthreads();
#pragma unroll
    for (int i = 0; i < 2; ++i) {
        const int idx = wave * 2 + i, vt = idx >> 2, kt = idx & 3;
        f32x4 acc = (f32x4){0.f, 0.f, 0.f, 0.f};
#pragma unroll
        for (int ks = 0; ks < 2; ++ks) acc = MFMA16(frag_cm(sV, TLD, ks * 32, vt * 16, lane), frag_cm(sKd, TLD, ks * 32, kt * 16, lane), acc);
        *(f32x4*)(HL + (size_t)ch * 4096 + (kt * 16 + li) * 64 + vt * 16 + 4 * g) = acc;
    }
}

__device__ __forceinline__ void hgrn_out_task(char* smem, const bf16_t* __restrict__ proj, const float* __restrict__ hgrn_lb, int layer, const bf16_t* __restrict__ HS,
                                              const float* __restrict__ mix_gain, bf16_t* __restrict__ y, int ch) {
    float* LF = (float*)smem; float* SEGT = LF + 64 * 65; float* sMS = SEGT + 8 * 64;
    bf16_t* sST = (bf16_t*)(sMS + 128); bf16_t* sQ0 = sST + 64 * TLD; bf16_t* sQm = sQ0 + 64 * TLD; bf16_t* sKm = sQm + 64 * TLD; bf16_t* sV = sKm + 64 * TLD; bf16_t* sA = sV + 64 * TLD;
    const int tid = TIDX, lane = tid & 63, wave = tid >> 6, g = lane >> 4, li = lane & 15;
    const int bh = ch >> 5, n = ch & 31, b = bh >> 2, h = bh & 3;
    const bf16_t* prow = proj + (size_t)(b * SEQ + n * 64) * NP + h * 64;
    const int t = tid >> 3, k8 = (tid & 7) * 8;
    __syncthreads();
    *(u32x4*)(sST + t * TLD + k8) = *(const u32x4*)(HS + (size_t)ch * 4096 + t * 64 + k8);
    const u32x4 qraw = *(const u32x4*)(prow + (size_t)t * NP + C_AQ + k8);
    *(u32x4*)(sV + t * TLD + k8) = *(const u32x4*)(prow + (size_t)t * NP + C_AI + k8);
    float kk[8];
    hgrn_scan(LF, SEGT, prow, hgrn_lb, layer, h, kk);
    { u32x4 o0, om, ok;
#pragma unroll
      for (int j = 0; j < 8; j += 2) {
          float q0v[2], qmv[2], kmv[2];
#pragma unroll
          for (int e = 0; e < 2; ++e) {
              const float bt = LF[t * 65 + k8 + j + e], r = LF[31 * 65 + k8 + j + e], q = siluf_(bfx(qraw, j + e));
              q0v[e] = q * __expf(bt); qmv[e] = q * __expf(bt - r); kmv[e] = kk[j + e] * __expf(r - bt);
          }
          o0[j >> 1] = pk2(q0v[0], q0v[1]); om[j >> 1] = pk2(qmv[0], qmv[1]); ok[j >> 1] = pk2(kmv[0], kmv[1]);
      }
      *(u32x4*)(sQ0 + t * TLD + k8) = o0; *(u32x4*)(sQm + t * TLD + k8) = om; *(u32x4*)(sKm + t * TLD + k8) = ok; }
    __syncthreads();
#pragma unroll
    for (int i = 0; i < 2; ++i) {
        const int idx = wave * 2 + i, tt = idx >> 2, st = idx & 3;
        f32x4 acc = (f32x4){0.f, 0.f, 0.f, 0.f};
#pragma unroll
        for (int ks = 0; ks < 2; ++ks) acc = MFMA16(frag_rm(sKm, TLD, st * 16, ks * 32, lane), frag_rm(sQm, TLD, tt * 16, ks * 32, lane), acc);
        const int tq = tt * 16 + li, s0 = st * 16 + 4 * g;
        uint2 o; o.x = pk2(s0 <= tq ? acc[0] : 0.f, s0 + 1 <= tq ? acc[1] : 0.f); o.y = pk2(s0 + 2 <= tq ? acc[2] : 0.f, s0 + 3 <= tq ? acc[3] : 0.f);
        *(uint2*)(sA + tq * TLD + s0) = o;
    }
    __syncthreads();
    { const int tt = wave >> 1;
      f32x4 oacc[2]; float ms = 0.f;
#pragma unroll
      for (int i = 0; i < 2; ++i) {
          const int vt = (wave & 1) * 2 + i;
          f32x4 acc = (f32x4){0.f, 0.f, 0.f, 0.f};
#pragma unroll
          for (int ks = 0; ks < 2; ++ks) acc = MFMA16(frag_cm(sST, TLD, ks * 32, vt * 16, lane), frag_rm(sQ0, TLD, tt * 16, ks * 32, lane), acc);
#pragma unroll
          for (int ks = 0; ks < 2; ++ks) acc = MFMA16(frag_cm(sV, TLD, ks * 32, vt * 16, lane), frag_rm(sA, TLD, tt * 16, ks * 32, lane), acc);
          oacc[i] = acc; ms += acc[0] * acc[0] + acc[1] * acc[1] + acc[2] * acc[2] + acc[3] * acc[3];
      }
      ms += __shfl_xor(ms, 16); ms += __shfl_xor(ms, 32);
      if (g == 0) sMS[(tt * 16 + li) * 2 + (wave & 1)] = ms;
      __syncthreads();
      const int tq = tt * 16 + li;
      const float rinv = rsqrtf((sMS[tq * 2] + sMS[tq * 2 + 1]) * (1.f / 64.f) + EPS);
      const size_t row = (size_t)(b * SEQ + n * 64 + tq);
#pragma unroll
      for (int i = 0; i < 2; ++i) {
          const int v0 = ((wave & 1) * 2 + i) * 16 + 4 * g;
          const uint2 graw = *(const uint2*)(proj + row * NP + C_AG + h * 64 + v0);
          const f32x4 mgv = *(const f32x4*)(mix_gain + C_AQ + h * 64 + v0);
          const float g0 = __uint_as_float(graw.x << 16), g1 = __uint_as_float(graw.x & 0xffff0000u), g2 = __uint_as_float(graw.y << 16), g3 = __uint_as_float(graw.y & 0xffff0000u);
          uint2 o; o.x = pk2(oacc[i][0] * rinv * siluf_(g0) * mgv[0], oacc[i][1] * rinv * siluf_(g1) * mgv[1]);
          o.y = pk2(oacc[i][2] * rinv * siluf_(g2) * mgv[2], oacc[i][3] * rinv * siluf_(g3) * mgv[3]);
          *(uint2*)(y + row * 1024 + h * 64 + v0) = o;
      }
    }
}


__device__ __forceinline__ void gdn_prep_task(char* smem, const bf16_t* __restrict__ proj, const float* __restrict__ gates, const float* __restrict__ conv_w  ,
                                              const float* __restrict__ a_log, const float* __restrict__ dt_bias, bf16_t* __restrict__ gt_all, float* __restrict__ glast, int ch) {
    float* sG = (float*)smem; float* sBeta = sG + 64;
    float* RHS = sBeta + 64;
    float* sM = RHS + 64 * 132;
    bf16_t* sK = (bf16_t*)(sM + 64 * 68); bf16_t* sQ = sK + 64 * TLD;
    const int tid = TIDX, lane = tid & 63, wave = tid >> 6, g = lane >> 4, li = lane & 15;
    const int bh = ch >> 5, n = ch & 31, b = bh >> 2, h = bh & 3;
    const int t = tid >> 3, d8 = (tid & 7) * 8;
    const size_t row0 = (size_t)(b * SEQ + n * 64);
    bf16_t* gt = gt_all + (size_t)ch * 5 * 4096;
    __syncthreads();
    float qn[8], kn[8], vv[8];
    {
        const int spos = n * 64 + t;
#pragma unroll
        for (int sec = 0; sec < 3; ++sec) {
            const int col = (sec == 0 ? C_DQ : (sec == 1 ? C_DK : C_DV)) + h * 64 + d8;
            float acc[8];
#pragma unroll
            for (int e = 0; e < 8; ++e) acc[e] = 0.f;
#pragma unroll
            for (int j = 0; j < 4; ++j) {
                if (spos - (3 - j) >= 0) {
                    const u32x4 raw = *(const u32x4*)(proj + (row0 + t - (3 - j)) * NP + col);
                    const f32x4 w0 = *(const f32x4*)(conv_w + j * 768 + sec * 256 + h * 64 + d8), w1 = *(const f32x4*)(conv_w + j * 768 + sec * 256 + h * 64 + d8 + 4);
#pragma unroll
                    for (int e = 0; e < 8; ++e) acc[e] += (e < 4 ? w0[e] : w1[e - 4]) * bfx(raw, e);
                }
            }
#pragma unroll
            for (int e = 0; e < 8; ++e) { const float sv = siluf_(acc[e]); if (sec == 0) qn[e] = sv; else if (sec == 1) kn[e] = sv; else vv[e] = sv; }
        }
        float sq = 0.f, sk = 0.f;
#pragma unroll
        for (int e = 0; e < 8; ++e) { sq += qn[e] * qn[e]; sk += kn[e] * kn[e]; }
        sq += __shfl_xor(sq, 1); sq += __shfl_xor(sq, 2); sq += __shfl_xor(sq, 4);
        sk += __shfl_xor(sk, 1); sk += __shfl_xor(sk, 2); sk += __shfl_xor(sk, 4);
        const float rq = rsqrtf(sq + EPS) * 0.125f, rk = rsqrtf(sk + EPS);
#pragma unroll
        for (int e = 0; e < 8; ++e) { qn[e] *= rq; kn[e] *= rk; }
    }
    if ((tid & 7) == 0) {
        const float* gr = gates + (row0 + t) * 16;
        sBeta[t] = sigmoidf_(gr[4 + h]);
        sG[t] = -__expf(a_log[h]) * softplusf_(gr[8 + h] + dt_bias[h]);
    }
    __syncthreads();
    if (wave == 0) {
        float v = sG[lane];
#pragma unroll
        for (int o = 1; o < 64; o <<= 1) { const float nb = __shfl_up(v, o); if (lane >= o) v += nb; }
        sG[lane] = v;
    }
    __syncthreads();
    {
        const float Gt = sG[t], Gl = sG[63], bt = sBeta[t];
        const float eG = __expf(Gt), eD = __expf(Gl - Gt);
        u32x4 ok, oq, oqd, okd;
#pragma unroll
        for (int e = 0; e < 8; e += 2) {
            ok[e >> 1] = pk2(kn[e], kn[e + 1]); oq[e >> 1] = pk2(qn[e], qn[e + 1]);
            oqd[e >> 1] = pk2(qn[e] * eG, qn[e + 1] * eG); okd[e >> 1] = pk2(kn[e] * eD, kn[e + 1] * eD);
        }
        *(u32x4*)(sK + t * TLD + d8) = ok; *(u32x4*)(sQ + t * TLD + d8) = oq;
        *(u32x4*)(gt + 2 * 4096 + t * 64 + d8) = oqd; *(u32x4*)(gt + 3 * 4096 + t * 64 + d8) = okd;
#pragma unroll
        for (int e = 0; e < 8; ++e) { RHS[t * 132 + d8 + e] = vv[e] * bt; RHS[t * 132 + 64 + d8 + e] = kn[e] * bt * eG; }
        if (tid == 0) glast[ch] = __expf(Gl);
    }
    __syncthreads();
#pragma unroll
    for (int i = 0; i < 2; ++i) {
        const int idx = wave * 2 + i, tt = idx >> 2, st = idx & 3;
        f32x4 am = (f32x4){0.f, 0.f, 0.f, 0.f}, aq = (f32x4){0.f, 0.f, 0.f, 0.f};
#pragma unroll
        for (int ks = 0; ks < 2; ++ks) {
            const bf16x8 kfs = frag_rm(sK, TLD, st * 16, ks * 32, lane), kft = frag_rm(sK, TLD, tt * 16, ks * 32, lane);
            am = MFMA16(kft, kfs, am);
            aq = MFMA16(kfs, frag_rm(sQ, TLD, tt * 16, ks * 32, lane), aq);
        }
        {   const int sx = st * 16 + li, t0 = tt * 16 + 4 * g; const float Gs = sG[sx];
            f32x4 mo;
#pragma unroll
            for (int r = 0; r < 4; ++r) { const int tq = t0 + r; mo[r] = (sx < tq) ? sBeta[tq] * am[r] * __expf(sG[tq] - Gs) : 0.f; }
            *(f32x4*)(sM + sx * 68 + t0) = mo; }
        {   const int tq = tt * 16 + li, s0 = st * 16 + 4 * g; const float Gt = sG[tq];
            float ao[4];
#pragma unroll
            for (int r = 0; r < 4; ++r) { const int sx = s0 + r; ao[r] = (sx <= tq) ? aq[r] * __expf(Gt - sG[sx]) : 0.f; }
            uint2 o; o.x = pk2(ao[0], ao[1]); o.y = pk2(ao[2], ao[3]);
            *(uint2*)(gt + 4 * 4096 + tq * 64 + s0) = o; }
    }
    __syncthreads();
    if (tid < 128) {
        float acc[64];
#pragma unroll
        for (int i = 0; i < 64; ++i) acc[i] = RHS[i * 132 + tid];
#pragma unroll
        for (int half = 0; half < 2; ++half) {
            const int base = half * 32;
            if (half == 1) {
#pragma unroll
                for (int sx = 0; sx < 32; sx += 2) {
                    f32x4 r0[8], r1[8];
#pragma unroll
                    for (int c = 0; c < 8; ++c) { r0[c] = *(const f32x4*)(sM + sx * 68 + 32 + c * 4); r1[c] = *(const f32x4*)(sM + (sx + 1) * 68 + 32 + c * 4); }
                    const float x0 = acc[sx], x1 = acc[sx + 1];
#pragma unroll
                    for (int tq = 0; tq < 32; ++tq) { acc[32 + tq] -= r0[tq >> 2][tq & 3] * x0; acc[32 + tq] -= r1[tq >> 2][tq & 3] * x1; }
                }
            }
            f32x4 cur[8];
#pragma unroll
            for (int c = 0; c < 8; ++c) cur[c] = *(const f32x4*)(sM + base * 68 + base + c * 4);
#pragma unroll
            for (int sx = 0; sx < 31; ++sx) {
                f32x4 nxt[8];
#pragma unroll
                for (int c = (sx + 2) >> 2; c < 8; ++c) nxt[c] = *(const f32x4*)(sM + (base + sx + 1) * 68 + base + c * 4);
                const float xs = acc[base + sx];
#pragma unroll
                for (int tq = sx + 1; tq < 32; ++tq) acc[base + tq] -= cur[tq >> 2][tq & 3] * xs;
#pragma unroll
                for (int c = (sx + 2) >> 2; c < 8; ++c) cur[c] = nxt[c];
            }
        }
        if (tid < 64) {
#pragma unroll
            for (int tt = 0; tt < 64; ++tt) gt[tt * 64 + tid] = f2bf(acc[tt]);
        } else {
#pragma unroll
            for (int tt = 0; tt < 64; ++tt) gt[4096 + tt * 64 + (tid - 64)] = f2bf(-acc[tt]);
        }
    }
}

__device__ __forceinline__ void gdn_scan_task(char* smem, const bf16_t* __restrict__ gt_all, const float* __restrict__ glast, const bf16_t* __restrict__ proj, const float* __restrict__ mix_gain,
                                              bf16_t* __restrict__ y, int bh) {
    bf16_t* sT = (bf16_t*)smem;
    bf16_t* sST = sT + 2 * 5 * 64 * TLD;
    bf16_t* sVn = sST + 2 * 64 * TLD;
    const int tid = TIDX, lane = tid & 63, wave = tid >> 6, g = lane >> 4, li = lane & 15;
    const int b = bh >> 2, h = bh & 3;
    const int sr = tid >> 3, sc8 = (tid & 7) * 8;
    const bf16_t* gsrc = gt_all + (size_t)bh * 32 * 5 * 4096 + sr * 64 + sc8;
    __syncthreads();
    u32x4 regs[5];
#pragma unroll
    for (int i = 0; i < 5; ++i) regs[i] = *(const u32x4*)(gsrc + i * 4096);
#pragma unroll
    for (int i = 0; i < 5; ++i) *(u32x4*)(sT + i * 64 * TLD + sr * TLD + sc8) = regs[i];
    *(u32x4*)(sST + sr * TLD + sc8) = (u32x4){0u, 0u, 0u, 0u};
    f32x4 sacc[4];
#pragma unroll
    for (int i = 0; i < 4; ++i) sacc[i] = (f32x4){0.f, 0.f, 0.f, 0.f};
    __syncthreads();
    for (int n = 0; n < 32; ++n) {
        const int buf = n & 1;
        const bf16_t* cT = sT + buf * 5 * 64 * TLD;
        const bf16_t* sU = cT; const bf16_t* sWn = cT + 64 * TLD; const bf16_t* sQd = cT + 2 * 64 * TLD; const bf16_t* sKd = cT + 3 * 64 * TLD; const bf16_t* sAq = cT + 4 * 64 * TLD;
        const bf16_t* cST = sST + buf * 64 * TLD; bf16_t* nST = sST + (buf ^ 1) * 64 * TLD;
        if (n + 1 < 32) {
#pragma unroll
            for (int i = 0; i < 5; ++i) regs[i] = *(const u32x4*)(gsrc + (size_t)(n + 1) * 5 * 4096 + i * 4096);
        }
        const size_t rowz = (size_t)(b * SEQ + n * 64 + (wave & 3) * 16 + li);
        uint2 zraw[4];
        if (wave < 4) {
#pragma unroll
            for (int vt = 0; vt < 4; ++vt) zraw[vt] = *(const uint2*)(proj + rowz * NP + C_DZ + h * 64 + vt * 16 + 4 * g);
        }
#pragma unroll
        for (int i = 0; i < 2; ++i) {
            const int idx = wave * 2 + i, tt = idx >> 2, vt = idx & 3;
            const int tq = tt * 16 + li, v0 = vt * 16 + 4 * g;
            const uint2 uraw = *(const uint2*)(sU + tq * TLD + v0);
            f32x4 acc = (f32x4){__uint_as_float(uraw.x << 16), __uint_as_float(uraw.x & 0xffff0000u), __uint_as_float(uraw.y << 16), __uint_as_float(uraw.y & 0xffff0000u)};
#pragma unroll
            for (int ks = 0; ks < 2; ++ks) acc = MFMA16(frag_rm(cST, TLD, vt * 16, ks * 32, lane), frag_rm(sWn, TLD, tt * 16, ks * 32, lane), acc);
            uint2 o; o.x = pk2(acc[0], acc[1]); o.y = pk2(acc[2], acc[3]);
            *(uint2*)(sVn + tq * TLD + v0) = o;
        }
        __syncthreads();
        if (wave < 4) {
            const int tt = wave;
            f32x4 oacc[4]; float ms = 0.f;
#pragma unroll
            for (int vt = 0; vt < 4; ++vt) {
                f32x4 acc = (f32x4){0.f, 0.f, 0.f, 0.f};
#pragma unroll
                for (int ks = 0; ks < 2; ++ks) acc = MFMA16(frag_rm(cST, TLD, vt * 16, ks * 32, lane), frag_rm(sQd, TLD, tt * 16, ks * 32, lane), acc);
#pragma unroll
                for (int ks = 0; ks < 2; ++ks) acc = MFMA16(frag_cm(sVn, TLD, ks * 32, vt * 16, lane), frag_rm(sAq, TLD, tt * 16, ks * 32, lane), acc);
                oacc[vt] = acc; ms += acc[0] * acc[0] + acc[1] * acc[1] + acc[2] * acc[2] + acc[3] * acc[3];
            }
            ms += __shfl_xor(ms, 16); ms += __shfl_xor(ms, 32);
            const float rinv = rsqrtf(ms * (1.f / 64.f) + EPS);
#pragma unroll
            for (int vt = 0; vt < 4; ++vt) {
                const int v0 = vt * 16 + 4 * g;
                const f32x4 mgv = *(const f32x4*)(mix_gain + 768 + h * 64 + v0);
                const float z0 = __uint_as_float(zraw[vt].x << 16), z1 = __uint_as_float(zraw[vt].x & 0xffff0000u), z2 = __uint_as_float(zraw[vt].y << 16), z3 = __uint_as_float(zraw[vt].y & 0xffff0000u);
                uint2 o; o.x = pk2(oacc[vt][0] * rinv * siluf_(z0) * mgv[0], oacc[vt][1] * rinv * siluf_(z1) * mgv[1]);
                o.y = pk2(oacc[vt][2] * rinv * siluf_(z2) * mgv[2], oacc[vt][3] * rinv * siluf_(z3) * mgv[3]);
                *(uint2*)(y + rowz * 1024 + 768 + h * 64 + v0) = o;
            }
        } else {
            const int kt = wave - 4;
            const float gl = glast[bh * 32 + n];
#pragma unroll
            for (int vt = 0; vt < 4; ++vt) {
                f32x4 acc = sacc[vt] * gl;
#pragma unroll
                for (int ks = 0; ks < 2; ++ks) acc = MFMA16(frag_cm(sKd, TLD, ks * 32, kt * 16, lane), frag_cm(sVn, TLD, ks * 32, vt * 16, lane), acc);
                sacc[vt] = acc;
                uint2 o; o.x = pk2(acc[0], acc[1]); o.y = pk2(acc[2], acc[3]);
                *(uint2*)(nST + (vt * 16 + li) * TLD + kt * 16 + 4 * g) = o;
            }
        }
        if (n + 1 < 32) {
            bf16_t* nT = sT + (buf ^ 1) * 5 * 64 * TLD;
#pragma unroll
            for (int i = 0; i < 5; ++i) *(u32x4*)(nT + i * 64 * TLD + sr * TLD + sc8) = regs[i];
        }
        __syncthreads();
    }
}


constexpr int XLD = 264;
__device__ __forceinline__ void lru_local_task(char* smem, const bf16_t* __restrict__ proj, const float* __restrict__ conv_w, const float* __restrict__ conv_b,
                                               const float* __restrict__ w_a, const float* __restrict__ b_a, const float* __restrict__ w_x, const float* __restrict__ b_x,
                                               const float* __restrict__ lam, float* __restrict__ hl_out, float* __restrict__ ac_out, float* __restrict__ lsum, int task) {
    bf16_t* sX = (bf16_t*)smem;
    bf16_t* sW = sX + 64 * XLD;
    float* sAa = (float*)(sW + 2 * 64 * TLD);
    float* sU = sAa + 64 * 65;
    float* sSegA = sU + 64 * 65; float* sSegH = sSegA + 8 * 64;
    const int tid = TIDX, lane = tid & 63, wave = tid >> 6, g = lane >> 4, li = lane & 15;
    const int b = task >> 5, n = task & 31;
    const size_t row0 = (size_t)(b * SEQ + n * 64);
    const int t = tid >> 3;
    __syncthreads();
    {
        const int spos = n * 64 + t;
#pragma unroll
        for (int i = 0; i < 4; ++i) {
            const int c8 = ((tid & 7) + 8 * i) * 8;
            float acc[8];
            { const f32x4 cb0 = *(const f32x4*)(conv_b + c8), cb1 = *(const f32x4*)(conv_b + c8 + 4);
#pragma unroll
              for (int e = 0; e < 8; ++e) acc[e] = e < 4 ? cb0[e] : cb1[e - 4]; }
#pragma unroll
            for (int j = 0; j < 4; ++j) {
                if (spos - (3 - j) >= 0) {
                    const u32x4 raw = *(const u32x4*)(proj + (row0 + t - (3 - j)) * NP + C_CX + c8);
                    const f32x4 w0 = *(const f32x4*)(conv_w + j * 256 + c8), w1 = *(const f32x4*)(conv_w + j * 256 + c8 + 4);
#pragma unroll
                    for (int e = 0; e < 8; ++e) acc[e] += (e < 4 ? w0[e] : w1[e - 4]) * bfx(raw, e);
                }
            }
            u32x4 o; o[0] = pk2(acc[0], acc[1]); o[1] = pk2(acc[2], acc[3]); o[2] = pk2(acc[4], acc[5]); o[3] = pk2(acc[6], acc[7]);
            *(u32x4*)(sX + t * XLD + c8) = o;
        }
    }
    for (int hh = 0; hh < 4; ++hh) {
        {
            const int i = tid >> 3, j8 = (tid & 7) * 8;
#pragma unroll
            for (int m = 0; m < 2; ++m) {
                const float* src = (m == 0 ? w_a : w_x) + (size_t)hh * 4096 + i * 64 + j8;
                const f32x4 v0 = *(const f32x4*)src, v1 = *(const f32x4*)(src + 4);
                u32x4 o; o[0] = pk2(v0[0], v0[1]); o[1] = pk2(v0[2], v0[3]); o[2] = pk2(v1[0], v1[1]); o[3] = pk2(v1[2], v1[3]);
                *(u32x4*)(sW + m * 64 * TLD + i * TLD + j8) = o;
            }
        }
        __syncthreads();
#pragma unroll
        for (int i2 = 0; i2 < 2; ++i2) {
            const int idx = wave * 2 + i2, tt = idx >> 2, jt = idx & 3;
            f32x4 ra = (f32x4){0.f, 0.f, 0.f, 0.f}, rx = (f32x4){0.f, 0.f, 0.f, 0.f};
#pragma unroll
            for (int ks = 0; ks < 2; ++ks) {
                const bf16x8 xf = frag_rm(sX + hh * 64, XLD, tt * 16, ks * 32, lane);
                ra = MFMA16(frag_cm(sW, TLD, ks * 32, jt * 16, lane), xf, ra);
                rx = MFMA16(frag_cm(sW + 64 * TLD, TLD, ks * 32, jt * 16, lane), xf, rx);
            }
            const int tq = tt * 16 + li, cl = jt * 16 + 4 * g, c = hh * 64 + cl;
            const f32x4 ba = *(const f32x4*)(b_a + c), bx = *(const f32x4*)(b_x + c), lm = *(const f32x4*)(lam + c);
            const uint2 xraw = *(const uint2*)(sX + tq * XLD + c);
            const float xc[4] = {__uint_as_float(xraw.x << 16), __uint_as_float(xraw.x & 0xffff0000u), __uint_as_float(xraw.y << 16), __uint_as_float(xraw.y & 0xffff0000u)};
#pragma unroll
            for (int r = 0; r < 4; ++r) {
                const float rr = sigmoidf_(ra[r] + ba[r]), ig = sigmoidf_(rx[r] + bx[r]);
                const float log_a = -8.f * rr * softplusf_(-lm[r]);
                sAa[tq * 65 + cl + r] = __expf(log_a);
                sU[tq * 65 + cl + r] = sqrtf(-expm1f(2.f * log_a)) * (ig * xc[r]);
            }
        }
        __syncthreads();
        const int cl = tid & 63, seg = tid >> 6;
        float Al[8], Hl[8];
        { float A = 1.f, H = 0.f;
#pragma unroll
          for (int i = 0; i < 8; ++i) { const float a = sAa[(seg * 8 + i) * 65 + cl], u = sU[(seg * 8 + i) * 65 + cl]; H = a * H + u; A *= a; Al[i] = A; Hl[i] = H; }
          sSegA[seg * 64 + cl] = A; sSegH[seg * 64 + cl] = H; }
        __syncthreads();
        { float Ac = 1.f, Hc = 0.f;
          for (int s2 = 0; s2 < seg; ++s2) { const float a = sSegA[s2 * 64 + cl]; Hc = a * Hc + sSegH[s2 * 64 + cl]; Ac *= a; }
#pragma unroll
          for (int i = 0; i < 8; ++i) {
              const size_t o = (row0 + seg * 8 + i) * 256 + hh * 64 + cl;
              const float hv = Hl[i] + Al[i] * Hc, av = Al[i] * Ac;
              hl_out[o] = hv; ac_out[o] = av;
              if (seg == 7 && i == 7) { lsum[(size_t)task * 256 + hh * 64 + cl] = av; lsum[(size_t)(256 + task) * 256 + hh * 64 + cl] = hv; }
          } }
        __syncthreads();
    }
}
__device__ __forceinline__ void lru_out_task(const float* __restrict__ hl_in, const float* __restrict__ ac_in, const float* __restrict__ lsum, const bf16_t* __restrict__ proj,
                                             const float* __restrict__ mix_gain, bf16_t* __restrict__ y, int task) {
    const int b = task >> 5, n = task & 31, c = TIDX & 255, half = TIDX >> 8;
    const float Hc = lsum[(size_t)task * 256 + c];
    const float mg = mix_gain[512 + c];
    const size_t row0 = (size_t)(b * SEQ + n * 64 + half * 32);
#pragma unroll 4
    for (int i = 0; i < 32; ++i) {
        const size_t row = row0 + i;
        const float hv = hl_in[row * 256 + c] + ac_in[row * 256 + c] * Hc;
        const float yv = hv * geluf_(bf2f(proj[row * NP + C_CG + c]));
        const float ms = wave_sum(yv * yv) * (1.f / 64.f);
        y[row * 1024 + 512 + c] = f2bf(yv * rsqrtf(ms + EPS) * mg);
    }
}


__device__ __forceinline__ void state_scan_phase(const float* __restrict__ HL, const float* __restrict__ HD, bf16_t* __restrict__ HS, const float* __restrict__ lsum, float* __restrict__ lcar) {
    const int bx = blockIdx.x, tid = TIDX;
    for (int u = bx; u < 128 + 4; u += gridDim.x) {
        if (u < 128) {
            const int gid = u * NTHR + tid, bh = gid >> 11, v = gid & 63, kp = (gid >> 6) & 31;
            const float* Lb = HL + (size_t)bh * 32 * 4096 + (2 * kp) * 64 + v; const float* Db = HD + (size_t)bh * 32 * 64 + 2 * kp;
            bf16_t* Sb = HS + (size_t)bh * 32 * 4096 + (2 * kp) * 64 + v;
            float S0 = 0.f, S1 = 0.f;
            for (int n0 = 0; n0 < 32; n0 += 8) {
                float l0[8], l1[8], d0[8], d1[8];
#pragma unroll
                for (int i = 0; i < 8; ++i) { l0[i] = Lb[(size_t)(n0 + i) * 4096]; l1[i] = Lb[(size_t)(n0 + i) * 4096 + 64]; d0[i] = Db[(n0 + i) * 64]; d1[i] = Db[(n0 + i) * 64 + 1]; }
#pragma unroll
                for (int i = 0; i < 8; ++i) {
                    Sb[(size_t)(n0 + i) * 4096] = f2bf(S0); Sb[(size_t)(n0 + i) * 4096 + 64] = f2bf(S1);
                    S0 = d0[i] * S0 + l0[i]; S1 = d1[i] * S1 + l1[i];
                }
            }
        } else {
            const int gid = (u - 128) * NTHR + tid, b = gid >> 8, c = gid & 255;
            float A[32], H[32];
#pragma unroll
            for (int n = 0; n < 32; ++n) { A[n] = lsum[(size_t)(b * 32 + n) * 256 + c]; H[n] = lsum[(size_t)(256 + b * 32 + n) * 256 + c]; }
            float Hc = 0.f;
#pragma unroll
            for (int n = 0; n < 32; ++n) { lcar[(size_t)(b * 32 + n) * 256 + c] = Hc; Hc = A[n] * Hc + H[n]; }
        }
    }
}

__device__ __forceinline__ void router_phase(char* smem, const float* __restrict__ x, const float* __restrict__ g, const bf16_t* __restrict__ wr  , const float* __restrict__ b_rg,
                                             const float* __restrict__ b_re, const float* __restrict__ pss, int* __restrict__ cnt, int* __restrict__ list, float* __restrict__ pgate) {
    bf16_t* sXh = (bf16_t*)smem;
    bf16_t* sXl = sXh + 64 * TLD;
    float* sLog = (float*)(sXl + 64 * TLD);
    const int tid = TIDX, lane = tid & 63, wave = tid >> 6, gq = lane >> 4, li = lane & 15;
    const int mt = wave & 3, kh = wave >> 2;
    const int stok = tid >> 3, c8 = (tid & 7) * 8;
    BLK_LOOP(tile, T / 64) {
        const int t0 = tile * 64;
        f32x4 acc[3];
#pragma unroll
        for (int n = 0; n < 3; ++n) acc[n] = (f32x4){0.f, 0.f, 0.f, 0.f};
        const float* xp = x + (size_t)(t0 + stok) * 1024 + c8;
        const bf16_t* wp = wr + (size_t)li * 1024 + kh * 32 + gq * 8;
        f32x4 x0 = *(const f32x4*)xp, x1 = *(const f32x4*)(xp + 4);
        u32x4 wh[3], wl[3];
#pragma unroll
        for (int n = 0; n < 3; ++n) { wh[n] = *(const u32x4*)(wp + n * 16 * 1024); wl[n] = *(const u32x4*)(wp + 48 * 1024 + n * 16 * 1024); }
        for (int kc = 0; kc < 16; ++kc) {
            const f32x4 g0 = *(const f32x4*)(g + kc * 64 + c8), g1 = *(const f32x4*)(g + kc * 64 + c8 + 4);
            const f32x4 v0 = x0 * g0, v1 = x1 * g1;
            u32x4 oh, ol;
#pragma unroll
            for (int j = 0; j < 2; ++j) {
                const unsigned h0 = pk2(v0[2 * j], v0[2 * j + 1]), h1 = pk2(v1[2 * j], v1[2 * j + 1]);
                oh[j] = h0; oh[2 + j] = h1;
                ol[j] = pk2(v0[2 * j] - __uint_as_float(h0 << 16), v0[2 * j + 1] - __uint_as_float(h0 & 0xffff0000u));
                ol[2 + j] = pk2(v1[2 * j] - __uint_as_float(h1 << 16), v1[2 * j + 1] - __uint_as_float(h1 & 0xffff0000u));
            }
            __syncthreads();
            *(u32x4*)(sXh + stok * TLD + c8) = oh; *(u32x4*)(sXl + stok * TLD + c8) = ol;
            __syncthreads();
            u32x4 cwh[3], cwl[3];
#pragma unroll
            for (int n = 0; n < 3; ++n) { cwh[n] = wh[n]; cwl[n] = wl[n]; }
            if (kc + 1 < 16) {
                x0 = *(const f32x4*)(xp + (kc + 1) * 64); x1 = *(const f32x4*)(xp + (kc + 1) * 64 + 4);
#pragma unroll
                for (int n = 0; n < 3; ++n) { wh[n] = *(const u32x4*)(wp + n * 16 * 1024 + (kc + 1) * 64); wl[n] = *(const u32x4*)(wp + 48 * 1024 + n * 16 * 1024 + (kc + 1) * 64); }
            }
            const bf16x8 xh = frag_rm(sXh, TLD, mt * 16, kh * 32, lane), xl = frag_rm(sXl, TLD, mt * 16, kh * 32, lane);
#pragma unroll
            for (int n = 0; n < 3; ++n) {
                const bf16x8 fh = __builtin_bit_cast(bf16x8, cwh[n]), fl = __builtin_bit_cast(bf16x8, cwl[n]);
                acc[n] = MFMA16(fh, xh, acc[n]);
                acc[n] = MFMA16(fl, xh, acc[n]);
                acc[n] = MFMA16(fh, xl, acc[n]);
            }
        }
#pragma unroll
        for (int n = 0; n < 3; ++n) *(f32x4*)(sLog + (kh * 64 + mt * 16 + li) * 48 + n * 16 + 4 * gq) = acc[n];
        __syncthreads();
        int* sCnt = (int*)(sLog + 2 * 64 * 48);
        if (tid < 64) sCnt[tid] = 0;
        __syncthreads();
        int ex0 = 0, ex1 = 0, lr0 = 0, lr1 = 0; float gw0 = 0.f, gw1 = 0.f;
        if (tid < 64) {
            const float rinv = rinv_from_pss(pss, (size_t)(t0 + tid));
            const float* l0 = sLog + tid * 48; const float* l1 = sLog + (64 + tid) * 48;
            float lg[4];
#pragma unroll
            for (int i = 0; i < 4; ++i) lg[i] = (l0[i] + l1[i]) * rinv + b_rg[i];
            int gs = 0; float gm = lg[0];
#pragma unroll
            for (int i = 1; i < 4; ++i) if (lg[i] > gm) { gm = lg[i]; gs = i; }
            float den = 0.f;
#pragma unroll
            for (int i = 0; i < 4; ++i) den += __expf(lg[i] - gm);
            const float pg = 1.f / den;
            int i0 = 0, i1 = -1; float m0 = -INFINITY, m1 = -INFINITY;
            for (int i = 0; i < 8; ++i) {
                const float v = (l0[4 + gs * 8 + i] + l1[4 + gs * 8 + i]) * rinv + b_re[gs * 8 + i];
                if (v > m0) { m1 = m0; i1 = i0; m0 = v; i0 = i; } else if (v > m1) { m1 = v; i1 = i; }
            }
            const float e1 = __expf(m1 - m0);
            gw0 = pg / (1.f + e1); gw1 = pg * e1 / (1.f + e1);
            ex0 = gs * 8 + i0; ex1 = gs * 8 + i1;
            lr0 = atomicAdd(&sCnt[ex0], 1); lr1 = atomicAdd(&sCnt[ex1], 1);
        }
        __syncthreads();
        if (tid < 32) { const int c = sCnt[tid]; sCnt[32 + tid] = c ? atomicAdd(&cnt[tid * CNT_STRIDE], c) : 0; }
        __syncthreads();
        if (tid < 64) {
            const int t = t0 + tid;
            list[(size_t)ex0 * T + sCnt[32 + ex0] + lr0] = 2 * t; pgate[2 * t] = gw0;
            list[(size_t)ex1 * T + sCnt[32 + ex1] + lr1] = 2 * t + 1; pgate[2 * t + 1] = gw1;
        }
        __syncthreads();
    }
}

__device__ __forceinline__ void combine_phase(const float* x2, const bf16_t* __restrict__ eo, const float* __restrict__ g, float* xout, bf16_t* __restrict__ hn, int mode) {
    const int lane = TIDX & 63;
    for (int t = blockIdx.x * 8 + (TIDX >> 6); t < T; t += gridDim.x * 8) {
        f32x4 v[4]; float s = 0.f;
#pragma unroll
        for (int j = 0; j < 4; ++j) {
            const int c = (lane + 64 * j) * 4;
            v[j] = *(const f32x4*)(x2 + (size_t)t * 1024 + c);
            const uint2 e0 = *(const uint2*)(eo + (size_t)(2 * t) * 1024 + c), e1 = *(const uint2*)(eo + (size_t)(2 * t + 1) * 1024 + c);
            v[j].x += __uint_as_float(e0.x << 16) + __uint_as_float(e1.x << 16);
            v[j].y += __uint_as_float(e0.x & 0xffff0000u) + __uint_as_float(e1.x & 0xffff0000u);
            v[j].z += __uint_as_float(e0.y << 16) + __uint_as_float(e1.y << 16);
            v[j].w += __uint_as_float(e0.y & 0xffff0000u) + __uint_as_float(e1.y & 0xffff0000u);
            s += v[j].x * v[j].x + v[j].y * v[j].y + v[j].z * v[j].z + v[j].w * v[j].w;
        }
        const float rinv = rsqrtf(wave_sum(s) * (1.f / 1024.f) + EPS);
#pragma unroll
        for (int j = 0; j < 4; ++j) {
            const int c = (lane + 64 * j) * 4;
            const f32x4 gg = *(const f32x4*)(g + c);
            const f32x4 hv = v[j] * rinv * gg;
            if (mode == 0) {
                *(f32x4*)(xout + (size_t)t * 1024 + c) = v[j];
                uint2 o; o.x = pk2(hv.x, hv.y); o.y = pk2(hv.z, hv.w);
                *(uint2*)(hn + (size_t)t * 1024 + c) = o;
            } else {
                *(f32x4*)(xout + (size_t)t * 1024 + c) = hv;
            }
        }
    }
}

template <int l>
__device__ __forceinline__ void layer_body(const Params& P, char* smem, const XcdBarrier& xb, const float* xcur) {
    char* ws = P.ws;
    bf16_t* Wt_in = (bf16_t*)(ws + OFF_WIN); bf16_t* Wt_out = (bf16_t*)(ws + OFF_WOUT); bf16_t* Wt_mq = (bf16_t*)(ws + OFF_WMQ); bf16_t* Wt_mkv = (bf16_t*)(ws + OFF_WMKV);
    bf16_t* Wt_mo = (bf16_t*)(ws + OFF_WMO); bf16_t* Wt_gu = (bf16_t*)(ws + OFF_WGU); bf16_t* Wt_dn = (bf16_t*)(ws + OFF_WDN);
    bf16_t* hn = (bf16_t*)(ws + OFF_HN); bf16_t* proj = (bf16_t*)(ws + OFF_PROJ); float* gates = (float*)(ws + OFF_GATES); bf16_t* y = (bf16_t*)(ws + OFF_Y);
    float* XA = P.out; float* XB = (float*)(ws + OFF_XB);
    bf16_t* qm = (bf16_t*)(ws + OFF_QM); bf16_t* om = (bf16_t*)(ws + OFF_OM); bf16_t* kvm = (bf16_t*)(ws + OFF_KVM); bf16_t* memn = (bf16_t*)(ws + OFF_MEMN);
    float* foxc = (float*)(ws + OFF_FOXC); float* lrua = (float*)(ws + OFF_LRUA); float* lruu = (float*)(ws + OFF_LRUU);
    int* cnt_all = (int*)(ws + OFF_CTL) + CTL_CNT_WORD; int* list = (int*)(ws + OFF_LIST); float* pgate = (float*)(ws + OFF_PGATE);
    bf16_t* act = (bf16_t*)(ws + OFF_ACT); bf16_t* eo = (bf16_t*)(ws + OFF_EO); float* pss = (float*)(ws + OFF_PSS);
    const int wave = TIDX >> 6, lane = TIDX & 63;


        float* x1 = (l == 0) ? XA : XB;
        float* x2 = (l == 0) ? XB : XA;
        int* cnt = cnt_all + 32 * CNT_STRIDE * l;
        const float* mg = P.in[I_MIX_GAIN] + l * 1024;
        REP(2, { pg8::Gemm g{hn, Wt_in + (size_t)l * NP * 1024, T, NP, 1024}; pg8::StaticOrder S; S.init(T, NP, (int)gridDim.x, (int)blockIdx.x);
                 pg8::EpiInProj E{proj, NP, gates, C_GATE};
                 pg8::gemm_phase<pg8::EpiInProj, pg8::StaticOrder, true, true>((PG8_LAS unsigned char*)smem, g, S, E); });
        if (l == 0) for (int l2 = 0; l2 < NL; ++l2)
            gemm_phase<EPI_BF16>(smem, memn + (size_t)l2 * 2048 * 1024, 1024, Wt_mkv + (size_t)l2 * 512 * 1024, 1024, 2048, 512, 1024, kvm + (size_t)l2 * 2048 * 512, 512, nullptr, nullptr,
                                 (gridDim.x >= 192) ? ((int)blockIdx.x - 128 - 32 * l2) : (int)blockIdx.x, (gridDim.x >= 192) ? 4096 : (int)gridDim.x);
        GSYNC();
        REP(4,         {
            const int bx = blockIdx.x;
            bf16_t* gtiles = (bf16_t*)(ws + OFF_GDN); float* glast = (float*)(ws + OFF_GLAST);
            if (bx < 32 && wave == 1) fox_cumsum(gates, P.in[I_FOX_FB] + l * 4, foxc, bx, lane);
            BLK_LOOP(ch, 1024) gdn_prep_task(smem, proj, gates, P.in[I_GDN_CONV_W] + l * 4 * 768, P.in[I_GDN_A_LOG] + l * 4, P.in[I_GDN_DT_BIAS] + l * 4, gtiles, glast, ch);
            BLK_LOOP(ch, 1024) hgrn_local_task(smem, proj, P.in[I_HGRN_LB], l, (float*)(ws + OFF_HL), (float*)(ws + OFF_HD), ch);
            BLK_LOOP(task, 256) lru_local_task(smem, proj, P.in[I_LRU_CONV_W] + l * 1024, P.in[I_LRU_CONV_B] + l * 256, P.in[I_LRU_WA] + l * 16384, P.in[I_LRU_BA] + l * 256,
                                               P.in[I_LRU_WX] + l * 16384, P.in[I_LRU_BX] + l * 256, P.in[I_LRU_LAM] + l * 256, lrua, lruu, (float*)(ws + OFF_LSUM), task);
        });
        GSYNC();
        state_scan_phase((const float*)(ws + OFF_HL), (const float*)(ws + OFF_HD), (bf16_t*)(ws + OFF_HS), (const float*)(ws + OFF_LSUM), (float*)(ws + OFF_LCAR));
        GSYNC();
        REP(8,         {
            const int natt = (SEQ / 128) * 4 * NB;
            const int bx = blockIdx.x, nfree = (int)gridDim.x - 32;
            if (bx < 32) gdn_scan_task(smem, (const bf16_t*)(ws + OFF_GDN), (const float*)(ws + OFF_GLAST), proj, mg, y, bx);
            else {
                for (int r = 0; r * nfree < natt; ++r) {
                    const int i = r * nfree + ((r & 1) ? (nfree - 1 - (bx - 32)) : (bx - 32));
                    if (i >= natt) continue;
                    const int qt = 15 - (i >> 5), bh = i & 31;
                    attn_task(smem, proj + C_BQ, NP, proj + C_BK, NP, proj + C_BV, NP, foxc, SEQ, SEQ, 1, 0.125f, y + 256, 1024, mg + 256, 1, (bh * 16) + qt);
                }
                for (int i = bx - 32; i < 1024; i += nfree) {
                    const int ch = (i & 31) * 32 + (31 - (i >> 5));
                    hgrn_out_task(smem, proj, P.in[I_HGRN_LB], l, (const bf16_t*)(ws + OFF_HS), mg, y, ch);
                }
                for (int i = bx - 32; i < 256; i += nfree) lru_out_task(lrua, lruu, (const float*)(ws + OFF_LCAR), proj, mg, y, i);
            }
        });
        GSYNC();
        REP(16, { pg8::Gemm g{y, Wt_out + (size_t)l * 1024 * 1024, T, 1024, 1024}; pg8::StaticOrder S; S.init(T, 1024, (int)gridDim.x, (int)blockIdx.x);
                  pg8::EpiResidNorm E{xcur, x1, 1024, P.in[I_NORM_MEM] + l * 1024, hn, pss};
                  pg8::gemm_phase<pg8::EpiResidNorm, pg8::StaticOrder, true, true>((PG8_LAS unsigned char*)smem, g, S, E); });
        GSYNC();
        REP(64, gemm_phase<EPI_BF16_RS>(smem, hn, 1024, Wt_mq + (size_t)l * 256 * 1024, 1024, T, 256, 1024, qm, 256, pss, nullptr));
        GSYNC();
        { const bf16_t* kv = kvm + (size_t)l * 2048 * 512;
          REP(128, BLK_LOOP(task, (SEQ / 128) * 4 * NB) attn_task(smem, qm, 256, kv, 512, kv + 256, 512, nullptr, SEQ, MEMLEN, 0, 0.125f, om, 256, nullptr, 0, task)); }
        GSYNC();
        REP(256, { pg8::Gemm g{om, Wt_mo + (size_t)l * 1024 * 256, T, 1024, 256}; pg8::StaticOrder S; S.init(T, 1024, (int)gridDim.x, (int)blockIdx.x);
                   pg8::EpiResidNorm E{x1, x2, 1024, P.in[I_NORM_FFN] + l * 1024, hn, pss};
                   pg8::gemm_phase<pg8::EpiResidNorm, pg8::StaticOrder, true, true>((PG8_LAS unsigned char*)smem, g, S, E); });
        GSYNC();
        router_phase(smem, x2, P.in[I_NORM_FFN] + l * 1024, (const bf16_t*)(ws + OFF_WR) + (size_t)l * 2 * 48 * 1024, P.in[I_B_RG] + l * 4, P.in[I_B_RE] + l * 32, pss, cnt, list, pgate);
        GSYNC();
        REP(512, moe_phase<1>(smem, hn, 1024, Wt_gu + (size_t)l * 32 * 512 * 1024, (size_t)512 * 1024, 1024, 1024, cnt, list, pgate, act, pss));
        GSYNC();
        REP(1024, moe_phase<2>(smem, act, 256, Wt_dn + (size_t)l * 32 * 1024 * 256, (size_t)1024 * 256, 256, 256, cnt, list, pgate, eo, pss));
        if (PROBE_MASK & 2048) { for (int i = 0; i < 10; ++i) GSYNC(); }
        GSYNC();
        if (l == 0) { combine_phase(x2, eo, P.in[I_NORM_MIX] + 1024, XA, hn, 0); GSYNC(); }
        else combine_phase(x2, eo, P.in[I_NORM_FINAL], P.out, hn, 1);
}
__global__ void __launch_bounds__(NTHR, 2) mega_kernel(Params P) {
    extern __shared__ __attribute__((aligned(16))) char smem[];
    volatile LDS_AS unsigned* st = (volatile LDS_AS unsigned*)(smem + LDS_BYTES - 16);
    if (TIDX < 4) st[TIDX] = 0u;
    __syncthreads();
    const XcdBarrier xb = xcd_barrier_post((unsigned*)(P.ws + OFF_CTL), st);
    phase0(P, smem);
    GSYNC();
    layer_body<0>(P, smem, xb, P.in[I_X]);
    layer_body<1>(P, smem, xb, P.out);
}

extern "C" void kernel_launch(void* const* d_in, const int* in_sizes, int n_in, void* d_out, int out_size, void* d_ws, size_t ws_size, hipStream_t stream) {
    static int grid_blocks = 0;
    if (grid_blocks == 0) {
        if (n_in != N_INPUTS || ws_size < OFF_END || out_size != T * 1024) { fprintf(stderr, "kernel_launch: unexpected sizes n_in=%d ws=%zu out=%d (need ws >= %zu)\n", n_in, ws_size, out_size, (size_t)OFF_END); grid_blocks = -1; return; }
        int dev = 0, cus = 0, per_cu = 0;
        if (hipGetDevice(&dev) != hipSuccess || hipDeviceGetAttribute(&cus, hipDeviceAttributeMultiprocessorCount, dev) != hipSuccess) { fprintf(stderr, "kernel_launch: device query failed\n"); grid_blocks = -1; return; }
        if (hipFuncSetAttribute((const void*)mega_kernel, hipFuncAttributeMaxDynamicSharedMemorySize, LDS_BYTES) != hipSuccess) { fprintf(stderr, "kernel_launch: hipFuncSetAttribute failed\n"); grid_blocks = -1; return; }
        if (hipOccupancyMaxActiveBlocksPerMultiprocessor(&per_cu, (const void*)mega_kernel, NTHR, LDS_BYTES) != hipSuccess || per_cu < 1) { fprintf(stderr, "kernel_launch: occupancy query says %d blocks/CU\n", per_cu); grid_blocks = -1; return; }
        grid_blocks = cus;
        fprintf(stderr, "kernel_launch: cus=%d per_cu=%d grid=%d\n", cus, per_cu, grid_blocks);
    }
    if (grid_blocks < 0) return;
    if (hipMemsetAsync((char*)d_ws + OFF_CTL, 0, CTL_BYTES, stream) != hipSuccess) { fprintf(stderr, "kernel_launch: memset failed\n"); return; }
    Params p; memset(&p, 0, sizeof p);
    for (int i = 0; i < N_INPUTS; ++i) p.in[i] = (const float*)d_in[i];
    p.out = (float*)d_out; p.ws = (char*)d_ws;
    void* args[] = {&p};
    hipError_t e = hipLaunchCooperativeKernel((const void*)mega_kernel, dim3(grid_blocks), dim3(NTHR), args, LDS_BYTES, stream);
    if (e != hipSuccess) fprintf(stderr, "kernel_launch: cooperative launch failed: %s (grid %d)\n", hipGetErrorString(e), grid_blocks);
}
```

```cpp
#include <hip/hip_runtime.h>
#include <stdint.h>
#include <stdio.h>
#include <string.h>
#include <hip/hip_cooperative_groups.h>
namespace cg = cooperative_groups;

typedef unsigned short bf16_t;
typedef short bf16x8 __attribute__((ext_vector_type(8)));
typedef float f32x4 __attribute__((ext_vector_type(4)));
typedef unsigned u32x4 __attribute__((ext_vector_type(4)));

constexpr int NB = 8, SEQ = 2048, DM = 1024, T = NB * SEQ, NL = 2;
constexpr int NP = 3584;
constexpr int NIN = 3340;
constexpr int C_AQ = 0, C_AF = 256, C_AI = 512, C_AG = 768, C_BQ = 1024, C_BK = 1280, C_BV = 1536, C_CX = 1792, C_CG = 2048,
              C_DQ = 2304, C_DK = 2560, C_DV = 2816, C_DZ = 3072, C_GATE = 3328;
constexpr int MEMLEN = 256;
constexpr int NEXP = 32, DEXP = 256;
constexpr float EPS = 1e-6f;

constexpr size_t al256(size_t x) { return (x + 255) & ~(size_t)255; }
constexpr size_t SZ_WIN = (size_t)NP * 1024 * 2, SZ_WOUT = (size_t)1024 * 1024 * 2, SZ_WMQ = (size_t)256 * 1024 * 2, SZ_WMKV = (size_t)512 * 1024 * 2,
                 SZ_WMO = (size_t)1024 * 256 * 2, SZ_WGU = (size_t)32 * 512 * 1024 * 2, SZ_WDN = (size_t)32 * 1024 * 256 * 2;
constexpr size_t OFF_WIN = 0;
constexpr size_t OFF_WOUT = OFF_WIN + NL * SZ_WIN;
constexpr size_t OFF_WMQ = OFF_WOUT + NL * SZ_WOUT;
constexpr size_t OFF_WMKV = OFF_WMQ + NL * SZ_WMQ;
constexpr size_t OFF_WMO = OFF_WMKV + NL * SZ_WMKV;
constexpr size_t OFF_WGU = OFF_WMO + NL * SZ_WMO;
constexpr size_t OFF_WDN = OFF_WGU + NL * SZ_WGU;
constexpr size_t OFF_HN = OFF_WDN + NL * SZ_WDN;
constexpr size_t OFF_PROJ = OFF_HN + (size_t)T * 1024 * 2;
constexpr size_t OFF_GATES = OFF_PROJ + (size_t)T * NP * 2;
constexpr size_t OFF_Y = OFF_GATES + (size_t)T * 16 * 4;
constexpr size_t OFF_XB = OFF_Y + (size_t)T * 1024 * 2;
constexpr size_t OFF_QM = OFF_XB + (size_t)T * 1024 * 4;
constexpr size_t OFF_OM = OFF_QM + (size_t)T * 256 * 2;
constexpr size_t OFF_KVM = OFF_OM + (size_t)T * 256 * 2;
constexpr size_t OFF_MEMN = OFF_KVM + (size_t)NL * 2048 * 512 * 2;
constexpr size_t OFF_FOXC = OFF_MEMN + (size_t)2048 * 1024 * 2;
constexpr size_t OFF_LRUA = OFF_FOXC + (size_t)NB * 4 * SEQ * 4;
constexpr size_t OFF_LRUU = OFF_LRUA + (size_t)T * 256 * 4;
constexpr size_t OFF_CNT = OFF_LRUU + (size_t)T * 256 * 4;
constexpr size_t OFF_LIST = OFF_CNT + 256;
constexpr size_t OFF_PGATE = OFF_LIST + (size_t)NEXP * T * 4;
constexpr size_t OFF_HL = OFF_PGATE + (size_t)2 * T * 4;
constexpr size_t OFF_HD = OFF_HL + (size_t)1024 * 4096 * 4;
constexpr size_t OFF_GDN = OFF_HD + (size_t)1024 * 64 * 4;
constexpr size_t OFF_GLAST = OFF_GDN + (size_t)1024 * 5 * 4096 * 2;
constexpr size_t OFF_LSUM = OFF_GLAST + 4096;
constexpr size_t OFF_HS = OFF_LSUM + (size_t)2 * 256 * 256 * 4;
constexpr size_t OFF_LCAR = OFF_HS + (size_t)1024 * 4096 * 2;
constexpr size_t OFF_PSS = OFF_LCAR + (size_t)256 * 256 * 4;
constexpr size_t OFF_WR = OFF_PSS + (size_t)T * 16 * 4;
constexpr size_t OFF_CTL = OFF_WR + (size_t)NL * 2 * 48 * 1024 * 2;
constexpr size_t CTL_BYTES = 32768;
constexpr int CTL_CNT_WORD = 4096;
constexpr int CNT_STRIDE = 64;
constexpr size_t OFF_END = OFF_CTL + CTL_BYTES;
constexpr size_t OFF_ACT = OFF_PROJ;
constexpr size_t OFF_EO = OFF_PROJ + (size_t)2 * T * 256 * 2;
static_assert(OFF_EO + (size_t)2 * T * 1024 * 2 <= OFF_GATES, "overlay fits");

__device__ __forceinline__ int tid_opaque() { int t = threadIdx.x; asm volatile("" : "+v"(t)); return t; }
#define TIDX tid_opaque()
__device__ __forceinline__ float bf2f(bf16_t v) { return __uint_as_float(((unsigned)v) << 16); }
typedef __bf16 bf16x2_t __attribute__((ext_vector_type(2)));
__device__ __forceinline__ bf16_t f2bf(float f) { return __builtin_bit_cast(unsigned short, (__bf16)f); }
__device__ __forceinline__ unsigned pk2(float lo, float hi) { bf16x2_t v = {(__bf16)lo, (__bf16)hi}; return __builtin_bit_cast(unsigned, v); }
__device__ __forceinline__ float sigmoidf_(float x) { return 1.f / (1.f + __expf(-x)); }
__device__ __forceinline__ float siluf_(float x) { return x / (1.f + __expf(-x)); }
__device__ __forceinline__ float softplusf_(float x) { return x > 20.f ? x : log1pf(__expf(x)); }
__device__ __forceinline__ float logsigmoidf_(float x) { return x < 0.f ? x - log1pf(__expf(x)) : -log1pf(__expf(-x)); }
__device__ __forceinline__ float geluf_(float x) { float u = 0.7978845608028654f * (x + 0.044715f * x * x * x); return 0.5f * x * (1.f + tanhf(u)); }
__device__ __forceinline__ float wave_sum(float v) {
#pragma unroll
    for (int o = 1; o < 64; o <<= 1) v += __shfl_xor(v, o);
    return v;
}
__device__ __forceinline__ float rdlane(float v, int l) { return __int_as_float(__builtin_amdgcn_readlane(__float_as_int(v), l)); }

#define PROBE_MASK 0
#define GSYNC() xcd_barrier(xb)
#define REP(bit, ...) do { __VA_ARGS__; if (PROBE_MASK & (bit)) { GSYNC(); __VA_ARGS__; } } while (0)
constexpr int NTHR = 512;
constexpr int LDS_BYTES = 147456;
enum { I_X = 0, I_MEM, I_NORM_MIX, I_W_IN, I_HGRN_LB, I_FOX_FB, I_LRU_CONV_W, I_LRU_CONV_B, I_LRU_WA, I_LRU_BA, I_LRU_WX, I_LRU_BX, I_LRU_LAM, I_GDN_CONV_W, I_GDN_A_LOG,
       I_GDN_DT_BIAS, I_MIX_GAIN, I_W_OUT, I_NORM_MEM, I_NORM_MEMKV, I_W_MQ, I_W_MKV, I_W_MO, I_NORM_FFN, I_W_RG, I_B_RG, I_W_RE, I_B_RE, I_W_E_GU, I_W_E_DN, I_NORM_FINAL, N_INPUTS };
struct Params { const float* in[N_INPUTS]; float* out; char* ws; };
static_assert(sizeof(Params) == 8 * (N_INPUTS + 2), "no padding");

#define BLK_LOOP(it, n) for (int it = (int)blockIdx.x; it < (n); it += (int)gridDim.x)


__device__ __forceinline__ float rinv_from_pss(const float* __restrict__ pss, size_t row) {
    const f32x4 a = *(const f32x4*)(pss + row * 16), b = *(const f32x4*)(pss + row * 16 + 4), c = *(const f32x4*)(pss + row * 16 + 8), d = *(const f32x4*)(pss + row * 16 + 12);
    const float sm = ((a[0] + a[1]) + (a[2] + a[3])) + ((b[0] + b[1]) + (b[2] + b[3])) + ((c[0] + c[1]) + (c[2] + c[3])) + ((d[0] + d[1]) + (d[2] + d[3]));
    return rsqrtf(sm * (1.f / 1024.f) + EPS);
}

__device__ __forceinline__ int rowmap_fn(int mode, int n) {
    if (mode == 1) {
        if (n < 1792) return n;
        if (n < 1796) return C_GATE + (n - 1792);
        if (n < 3076) return n - 4;
        if (n < 3084) return C_GATE + 4 + (n - 3076);
        return n - 12;
    } else if (mode == 2) {
        int j = n & 255; return (j >> 4) * 32 + ((n >= 256) ? 16 : 0) + (j & 15);
    }
    return n;
}
__device__ __forceinline__ void convT_tile(float* tile  , const float* __restrict__ src, int K, int N, bf16_t* __restrict__ dst, int mode, int ntn, int idx) {
    const int n0 = (idx % ntn) * 64, k0 = (idx / ntn) * 64;
    const int tid = TIDX;
    __syncthreads();
#pragma unroll
    for (int i = 0; i < 2; ++i) {
        const int k = (tid >> 4) + 32 * i, n = n0 + (tid & 15) * 4;
        f32x4 v = (f32x4){0.f, 0.f, 0.f, 0.f};
        if (n + 3 < N) v = *(const f32x4*)(src + (size_t)(k0 + k) * N + n);
        else { for (int e = 0; e < 4; ++e) if (n + e < N) v[e] = src[(size_t)(k0 + k) * N + n + e]; }
#pragma unroll
        for (int e = 0; e < 4; ++e) tile[k * 65 + (tid & 15) * 4 + e] = v[e];
    }
    __syncthreads();
    const int nl = tid >> 3, k8 = (tid & 7) * 8, n = n0 + nl;
    if (n < N) {
        const int r = rowmap_fn(mode, n);
        u32x4 o;
#pragma unroll
        for (int j = 0; j < 4; ++j) o[j] = pk2(tile[(k8 + 2 * j) * 65 + nl], tile[(k8 + 2 * j + 1) * 65 + nl]);
        *(u32x4*)(dst + (size_t)r * K + k0 + k8) = o;
    }
}
__device__ __forceinline__ void rms_row_bf16(const float* __restrict__ xrow, const float* __restrict__ g, bf16_t* __restrict__ orow, int lane) {
    const f32x4* xr = (const f32x4*)xrow + lane;
    f32x4 v[4]; float s = 0.f;
#pragma unroll
    for (int j = 0; j < 4; ++j) { v[j] = xr[64 * j]; s += v[j].x * v[j].x + v[j].y * v[j].y + v[j].z * v[j].z + v[j].w * v[j].w; }
    const float rinv = rsqrtf(wave_sum(s) * (1.f / 1024.f) + EPS);
#pragma unroll
    for (int j = 0; j < 4; ++j) {
        const f32x4 gg = ((const f32x4*)g)[lane + 64 * j];
        uint2 o; o.x = pk2(v[j].x * rinv * gg.x, v[j].y * rinv * gg.y); o.y = pk2(v[j].z * rinv * gg.z, v[j].w * rinv * gg.w);
        *(uint2*)(orow + (lane + 64 * j) * 4) = o;
    }
}

constexpr int CT_PER_LAYER = 53 * 16 + 256 + 64 + 128 + 64;
constexpr int CT_GU = 64 * 128, CT_DN = 64 * 64;
constexpr int CT_TOTAL = NL * CT_PER_LAYER + CT_GU + CT_DN;

__device__ __forceinline__ void phase0(const Params& P, char* smem) {
    char* ws = P.ws;
    float* tile = (float*)smem;
    BLK_LOOP(it, CT_TOTAL) {
        int r = it;
        if (r < NL * CT_PER_LAYER) {
            const int l = r / CT_PER_LAYER; r -= l * CT_PER_LAYER;
            if (r < 848) { convT_tile(tile, P.in[I_W_IN] + (size_t)l * 1024 * NIN, 1024, NIN, (bf16_t*)(ws + OFF_WIN) + (size_t)l * NP * 1024, 1, 53, r); continue; } r -= 848;
            if (r < 256) { convT_tile(tile, P.in[I_W_OUT] + (size_t)l * 1024 * 1024, 1024, 1024, (bf16_t*)(ws + OFF_WOUT) + (size_t)l * 1024 * 1024, 0, 16, r); continue; } r -= 256;
            if (r < 64) { convT_tile(tile, P.in[I_W_MQ] + (size_t)l * 1024 * 256, 1024, 256, (bf16_t*)(ws + OFF_WMQ) + (size_t)l * 256 * 1024, 0, 4, r); continue; } r -= 64;
            if (r < 128) { convT_tile(tile, P.in[I_W_MKV] + (size_t)l * 1024 * 512, 1024, 512, (bf16_t*)(ws + OFF_WMKV) + (size_t)l * 512 * 1024, 0, 8, r); continue; } r -= 128;
            convT_tile(tile, P.in[I_W_MO] + (size_t)l * 256 * 1024, 256, 1024, (bf16_t*)(ws + OFF_WMO) + (size_t)l * 1024 * 256, 0, 16, r); continue;
        }
        r -= NL * CT_PER_LAYER;
        if (r < CT_GU) { const int m = r >> 7; convT_tile(tile, P.in[I_W_E_GU] + (size_t)m * 1024 * 512, 1024, 512, (bf16_t*)(ws + OFF_WGU) + (size_t)m * 512 * 1024, 2, 8, r & 127); continue; }
        r -= CT_GU;
        { const int m = r >> 6; convT_tile(tile, P.in[I_W_E_DN] + (size_t)m * 256 * 1024, 256, 1024, (bf16_t*)(ws + OFF_WDN) + (size_t)m * 1024 * 256, 0, 16, r & 63); }
    }
    for (int i = blockIdx.x * NTHR + TIDX; i < NL * (NP - NIN) * 512; i += gridDim.x * NTHR) {
        const int l = i / ((NP - NIN) * 512), w = i % ((NP - NIN) * 512);
        ((unsigned*)((bf16_t*)(ws + OFF_WIN) + (size_t)l * NP * 1024 + (size_t)NIN * 1024))[w] = 0u;
    }
    for (int i = blockIdx.x * NTHR + TIDX; i < NL * 48 * 1024; i += gridDim.x * NTHR) {
        const int l = i / (48 * 1024), r = (i / 1024) % 48, k = i & 1023;
        float w = 0.f;
        if (r < 4) w = P.in[I_W_RG][(size_t)l * 4096 + k * 4 + r]; else if (r < 36) w = P.in[I_W_RE][(size_t)l * 32768 + k * 32 + (r - 4)];
        const bf16_t hi = f2bf(w); const bf16_t lo = f2bf(w - bf2f(hi));
        bf16_t* wr = (bf16_t*)(ws + OFF_WR) + (size_t)l * 2 * 48 * 1024;
        wr[r * 1024 + k] = hi; wr[48 * 1024 + r * 1024 + k] = lo;
    }
    const int gw = blockIdx.x * 8 + (TIDX >> 6), ngw = gridDim.x * 8, lane = TIDX & 63;
    for (int row = gw; row < T + NL * 2048; row += ngw) {
        if (row < T) rms_row_bf16(P.in[I_X] + (size_t)row * 1024, P.in[I_NORM_MIX], (bf16_t*)(ws + OFF_HN) + (size_t)row * 1024, lane);
        else { const int r2 = row - T, l = r2 >> 11, rr = r2 & 2047;
               rms_row_bf16(P.in[I_MEM] + (size_t)rr * 1024, P.in[I_NORM_MEMKV] + l * 1024, (bf16_t*)(ws + OFF_MEMN) + (size_t)r2 * 1024, lane); }
    }
}

constexpr int GLD = 72;
constexpr int GEMM_STAGE = (256 + 128) * GLD * 2;
constexpr int GEMM_LDS = 2 * GEMM_STAGE;
template <class RowPtr>
__device__ __forceinline__ void gemm_tile(char* smem, RowPtr rowptr, const bf16_t* __restrict__ Bt, int ldb, int n0, int K, f32x4 (&acc)[4][4]) {
    const int tid = TIDX, lane = tid & 63, wave = tid >> 6, wm = wave >> 1, wn = wave & 1;
    const u32x4* ga[4]; const u32x4* gb[2];
#pragma unroll
    for (int i = 0; i < 4; ++i) { const int c = tid + i * 512, r = c >> 3, ch = c & 7; ga[i] = (const u32x4*)(rowptr(r) + ch * 8); }
#pragma unroll
    for (int i = 0; i < 2; ++i) { const int c = tid + i * 512, r = c >> 3, ch = c & 7; gb[i] = (const u32x4*)(Bt + (size_t)(n0 + r) * ldb + ch * 8); }
#pragma unroll
    for (int m = 0; m < 4; ++m)
#pragma unroll
        for (int n = 0; n < 4; ++n) acc[m][n] = (f32x4){0.f, 0.f, 0.f, 0.f};
    const int nk = K / 64;
    u32x4 raA[4], rbA[2], raB[4], rbB[2];
#define GT_LOAD(RA, RB, kt) { _Pragma("unroll") for (int i = 0; i < 4; ++i) RA[i] = ga[i][(kt) * 8]; _Pragma("unroll") for (int i = 0; i < 2; ++i) RB[i] = gb[i][(kt) * 8]; }
#define GT_STORE(RA, RB, buf) { bf16_t* dA = (bf16_t*)(smem + (buf) * GEMM_STAGE); bf16_t* dB = dA + 256 * GLD; \
        _Pragma("unroll") for (int i = 0; i < 4; ++i) { const int c = tid + i * 512, r = c >> 3, ch = c & 7; *(u32x4*)(dA + r * GLD + ch * 8) = RA[i]; } \
        _Pragma("unroll") for (int i = 0; i < 2; ++i) { const int c = tid + i * 512, r = c >> 3, ch = c & 7; *(u32x4*)(dB + r * GLD + ch * 8) = RB[i]; } }
#define GT_COMPUTE(buf) { const bf16_t* sA = (const bf16_t*)(smem + (buf) * GEMM_STAGE); const bf16_t* sB = sA + 256 * GLD; \
        _Pragma("unroll") for (int kk = 0; kk < 2; ++kk) { bf16x8 af[4], bfr[4]; \
            _Pragma("unroll") for (int m = 0; m < 4; ++m) af[m] = *(const bf16x8*)(sA + (wm * 64 + m * 16 + (lane & 15)) * GLD + kk * 32 + (lane >> 4) * 8); \
            _Pragma("unroll") for (int n = 0; n < 4; ++n) bfr[n] = *(const bf16x8*)(sB + (wn * 64 + n * 16 + (lane & 15)) * GLD + kk * 32 + (lane >> 4) * 8); \
            _Pragma("unroll") for (int m = 0; m < 4; ++m) _Pragma("unroll") for (int n = 0; n < 4; ++n) acc[m][n] = __builtin_amdgcn_mfma_f32_16x16x32_bf16(bfr[n], af[m], acc[m][n], 0, 0, 0); } }
    GT_LOAD(raA, rbA, 0)
    GT_LOAD(raB, rbB, 1)
    __syncthreads();
    GT_STORE(raA, rbA, 0)
    __syncthreads();
    for (int kt = 0; kt < nk; kt += 2) {
        if (kt + 2 < nk) GT_LOAD(raA, rbA, kt + 2)
        GT_COMPUTE(0)
        GT_STORE(raB, rbB, 1)
        __syncthreads();
        if (kt + 3 < nk) GT_LOAD(raB, rbB, kt + 3)
        GT_COMPUTE(1)
        if (kt + 2 < nk) GT_STORE(raA, rbA, 0)
        __syncthreads();
    }
#undef GT_LOAD
#undef GT_STORE
#undef GT_COMPUTE
}
struct RowDirect { const bf16_t* A; int lda; int m0; __device__ __forceinline__ const bf16_t* operator()(int r) const { return A + (size_t)(m0 + r) * lda; } };
enum { EPI_INPROJ = 0, EPI_RESID = 1, EPI_BF16 = 2, EPI_BF16_RS = 3, EPI_RESID_NORM = 4 };

__device__ __forceinline__ int vcu_id() { const int G = gridDim.x, bx = blockIdx.x; return (G % 8 == 0) ? (bx % 8) * (G / 8) + bx / 8 : bx; }

template <int EPI>
__device__ __forceinline__ void gemm_phase(char* smem, const bf16_t* A, int lda, const bf16_t* Bt, int ldb, int M, int N, int K, void* out, int ldo, const float* resid, float* gates, int idx0 = -1, int stride = 0, bf16_t* xg = nullptr, const float* gn = nullptr) {
    const int ntn = N / 128, ntiles = (M / 256) * ntn;
    if (stride == 0) { idx0 = vcu_id(); stride = gridDim.x; }
    if (idx0 < 0) return;
    const int lane = TIDX & 63, wave = TIDX >> 6, wm = wave >> 1, wn = wave & 1;
    for (int tIdx = idx0; tIdx < ntiles; tIdx += stride) {
        const int m0 = (tIdx / ntn) * 256, n0 = (tIdx % ntn) * 128;
        f32x4 acc[4][4];
        RowDirect rp{A, lda, m0};
        gemm_tile(smem, rp, Bt, ldb, n0, K, acc);
        float rsc[4] = {1.f, 1.f, 1.f, 1.f};
        if (EPI == EPI_BF16_RS) {
#pragma unroll
            for (int m = 0; m < 4; ++m) rsc[m] = rinv_from_pss(resid, (size_t)(m0 + wm * 64 + m * 16 + (lane & 15)));
        }
        if (EPI == EPI_RESID_NORM) {
#pragma unroll
            for (int m = 0; m < 4; ++m) {
                const int row = m0 + wm * 64 + m * 16 + (lane & 15);
                float ss = 0.f;
#pragma unroll
                for (int n = 0; n < 4; ++n) {
                    const int col = n0 + wn * 64 + n * 16 + (lane >> 4) * 4;
                    const f32x4 o = *(const f32x4*)(resid + (size_t)row * ldo + col) + acc[m][n];
                    *(f32x4*)((float*)out + (size_t)row * ldo + col) = o;
                    ss += (o[0] * o[0] + o[1] * o[1]) + (o[2] * o[2] + o[3] * o[3]);
                    const f32x4 og = o * *(const f32x4*)(gn + col);
                    uint2 w; w.x = pk2(og[0], og[1]); w.y = pk2(og[2], og[3]);
                    *(uint2*)(xg + (size_t)row * ldo + col) = w;
                }
                ss += __shfl_xor(ss, 16); ss += __shfl_xor(ss, 32);
                if ((lane >> 4) == 0) gates[(size_t)row * 16 + (n0 >> 7) * 2 + wn] = ss;
            }
            continue;
        }
#pragma unroll
        for (int m = 0; m < 4; ++m)
#pragma unroll
            for (int n = 0; n < 4; ++n) {
                const int row = m0 + wm * 64 + m * 16 + (lane & 15), col = n0 + wn * 64 + n * 16 + (lane >> 4) * 4;
                const f32x4 v = acc[m][n];
                if (EPI == EPI_INPROJ) {
                    uint2 o; o.x = pk2(v.x, v.y); o.y = pk2(v.z, v.w);
                    *(uint2*)((bf16_t*)out + (size_t)row * ldo + col) = o;
                    if (col >= C_GATE && col < C_GATE + 16) *(f32x4*)(gates + (size_t)row * 16 + (col - C_GATE)) = v;
                } else if (EPI == EPI_RESID) {
                    const f32x4 r = *(const f32x4*)(resid + (size_t)row * ldo + col);
                    *(f32x4*)((float*)out + (size_t)row * ldo + col) = r + v;
                } else if (EPI == EPI_BF16_RS) {
                    const float ri = rsc[m];
                    uint2 o; o.x = pk2(v.x * ri, v.y * ri); o.y = pk2(v.z * ri, v.w * ri);
                    *(uint2*)((bf16_t*)out + (size_t)row * ldo + col) = o;
                } else {
                    uint2 o; o.x = pk2(v.x, v.y); o.y = pk2(v.z, v.w);
                    *(uint2*)((bf16_t*)out + (size_t)row * ldo + col) = o;
                }
            }
    }
}


namespace pg8 {
#define PG8_LAS __attribute__((address_space(3)))
typedef unsigned short bf16_t;
typedef short bf16x8 __attribute__((ext_vector_type(8)));
typedef float f32x4 __attribute__((ext_vector_type(4)));
typedef unsigned u32x4 __attribute__((ext_vector_type(4)));
constexpr int BM = 256, BK = 64, HALF = 128, HTB = HALF * BK * 2  , STAGE_BYTES = 8 * HTB, NXCD = 8, WGM = 8;

__host__ __device__ __forceinline__ int lds_byte(int r, int c) { const int st = (r >> 4) * 2 + (c >> 5), rr = r & 15, cc = c & 31, ob = rr * 64 + cc * 2; return st * 1024 + (ob ^ (((ob >> 9) & 1) << 5)); }
__host__ __device__ __forceinline__ void stage_rc(int b, int& R, int& C) { const int st = b / 1024, sb = b % 1024, swz = sb ^ (((sb >> 9) & 1) << 5); R = (st >> 1) * 16 + swz / 64; C = (st & 1) * 32 + (swz % 64) / 2; }
__host__ __device__ __forceinline__ int perm32(int rho) { const int n = rho >> 4, i = rho & 15; return 8 * (i >> 2) + 4 * n + (i & 3); }

struct Unit { int pm, pn; };
struct Gemm { const bf16_t* A; const bf16_t* Bt; int M, N, K; };

struct StaticOrder {
    int nM, nN, nwg, G, c;
    __host__ __device__ void init(int M, int N, int G_, int c_) { nM = M / BM; nN = N / BM; nwg = nM * nN; G = G_; c = c_; }
    __host__ __device__ bool next(int i, Unit& u) const {
        const long L = (long)i * G + c; if (L >= nwg) return false;
        int wgid = (int)L; { const int q = nwg / NXCD, r = nwg % NXCD, xcd = wgid % NXCD, off = wgid / NXCD; wgid = (xcd < r ? xcd * (q + 1) : r * (q + 1) + (xcd - r) * q) + off; }
        const int nig = WGM * nN, gid = wgid / nig, fm = gid * WGM, gsz = (nM - fm) < WGM ? (nM - fm) : WGM;
        u.pm = fm + ((wgid % nig) % gsz); u.pn = (wgid % nig) / gsz; return true;
    }
    __device__ __forceinline__ void a_ready(const Unit&) const {}
    __device__ __forceinline__ void done(const Unit&) const {}
};
__device__ __forceinline__ unsigned cvt_pk_bf16(float lo, float hi) { unsigned r; asm volatile("v_cvt_pk_bf16_f32 %0, %1, %2" : "=v"(r) : "v"(lo), "v"(hi)); return r; }
typedef float f32x2 __attribute__((ext_vector_type(2)));

struct EpiInProj {
    static constexpr bool PERM = true, AFTER_DRAIN = false;
    bf16_t* O; int ldc; float* gates; int gate_col;
    __device__ __forceinline__ void operator()(const f32x4 (&acc)[2][2][4][2], const Unit& u, int wr, int wc, int fr, int fq) const {
        const int row0 = u.pm * BM + wr * 64 + fr, col0 = u.pn * BM + wc * 32 + 8 * fq;
#pragma unroll
        for (int ai = 0; ai < 2; ++ai)
#pragma unroll
            for (int m = 0; m < 4; ++m) {
                const int row = row0 + ai * HALF + m * 16;
                bf16_t* rowp = O + (size_t)row * ldc + col0;
#pragma unroll
                for (int bj = 0; bj < 2; ++bj) {
                    const f32x4 v0 = acc[ai][bj][m][0], v1 = acc[ai][bj][m][1];
                    u32x4 w; w.x = cvt_pk_bf16(v0[0], v0[1]); w.y = cvt_pk_bf16(v0[2], v0[3]); w.z = cvt_pk_bf16(v1[0], v1[1]); w.w = cvt_pk_bf16(v1[2], v1[3]);
                    *(u32x4*)(rowp + bj * HALF) = w;
                    const int gc = col0 + bj * HALF - gate_col;
                    if (gates && gc >= 0 && gc < 16) { *(f32x4*)(gates + (size_t)row * 16 + gc) = v0; *(f32x4*)(gates + (size_t)row * 16 + gc + 4) = v1; }
                }
            }
    }
};
struct EpiResid {
    static constexpr bool PERM = false, AFTER_DRAIN = false;
    const float* base; float* out; int ldc;
    __device__ __forceinline__ void operator()(const f32x4 (&acc)[2][2][4][2], const Unit& u, int wr, int wc, int fr, int fq) const {
        const int col0 = u.pn * BM + wc * 32 + 4 * fq;
#pragma unroll
        for (int ai = 0; ai < 2; ++ai)
#pragma unroll
            for (int m = 0; m < 4; ++m) {
                const size_t off = (size_t)(u.pm * BM + ai * HALF + wr * 64 + m * 16 + fr) * ldc + col0;
#pragma unroll
                for (int bj = 0; bj < 2; ++bj)
#pragma unroll
                    for (int n = 0; n < 2; ++n) { const f32x4 bs = *(const f32x4*)(base + off + bj * HALF + n * 16); *(f32x4*)(out + off + bj * HALF + n * 16) = bs + acc[ai][bj][m][n]; }
                if (m & 1) asm volatile("" ::: "memory");
            }
    }
};

struct EpiResidNorm {
    static constexpr bool PERM = false, AFTER_DRAIN = false;
    const float* base; float* out; int ldc; const float* gn; bf16_t* xg; float* pss;
    __device__ __forceinline__ void operator()(const f32x4 (&acc)[2][2][4][2], const Unit& u, int wr, int wc, int fr, int fq) const {
        const int col0 = u.pn * BM + wc * 32 + 4 * fq;
        f32x4 gv[2][2];
#pragma unroll
        for (int bj = 0; bj < 2; ++bj)
#pragma unroll
            for (int n = 0; n < 2; ++n) gv[bj][n] = *(const f32x4*)(gn + col0 + bj * HALF + n * 16);
#pragma unroll
        for (int ai = 0; ai < 2; ++ai)
#pragma unroll
            for (int m = 0; m < 4; ++m) {
                const int row = u.pm * BM + ai * HALF + wr * 64 + m * 16 + fr;
                const size_t off = (size_t)row * ldc + col0;
                float ss = 0.f;
#pragma unroll
                for (int bj = 0; bj < 2; ++bj)
#pragma unroll
                    for (int n = 0; n < 2; ++n) {
                        const f32x4 bs = *(const f32x4*)(base + off + bj * HALF + n * 16);
                        const f32x4 o = bs + acc[ai][bj][m][n];
                        *(f32x4*)(out + off + bj * HALF + n * 16) = o;
                        ss += (o[0] * o[0] + o[1] * o[1]) + (o[2] * o[2] + o[3] * o[3]);
                        const f32x4 og = o * gv[bj][n];
                        uint2 w; w.x = cvt_pk_bf16(og[0], og[1]); w.y = cvt_pk_bf16(og[2], og[3]);
                        *(uint2*)(xg + off + bj * HALF + n * 16) = w;
                    }
                ss += __shfl_xor(ss, 16); ss += __shfl_xor(ss, 32);
                if (fq == 0) pss[(size_t)row * 16 + u.pn * 4 + wc] = ss;
                if (m & 1) asm volatile("" ::: "memory");
            }
    }
};
template <class Epi, class Sched, bool ALIGN_EPI = false, bool SP2 = false>
__device__ __forceinline__ void gemm_phase(PG8_LAS unsigned char* lds, const Gemm g, const Sched& S, const Epi& E) {
    const int tid = TIDX, wid = __builtin_amdgcn_readfirstlane(tid >> 6), lane = tid & 63, wr = wid >> 2, wc = wid & 3, fr = lane & 15, fq = lane >> 4;
    const int K = g.K, nt = K / BK;
    unsigned voffA[2], voffB[2];
#pragma unroll
    for (int i = 0; i < 2; ++i) { int R, C; stage_rc(tid * 16 + i * 8192, R, C); const int Rb = Epi::PERM ? ((R & ~31) + perm32(R & 31)) : R;
        voffA[i] = (unsigned)(R * K + C) * 2u; voffB[i] = (unsigned)(Rb * K + C) * 2u; }
    const size_t kstep = (size_t)(BK * 2);
    const size_t hstep = (size_t)HALF * K * 2;
    const size_t tstep = 2 * hstep;
    const unsigned ldsw = (unsigned)wid * 1024u;
    const int aoff = lds_byte(wr * 64 + fr, fq * 8), boff = lds_byte(wc * 32 + fr, fq * 8);
#define PG8_SA(b, h) (((b) * 2 + (h)) * HTB)
#define PG8_SB(b, h) ((4 + (b) * 2 + (h)) * HTB)
#define PG8_STAGE(bufoff, gbase, voff) do { _Pragma("unroll") for (int _i = 0; _i < 2; ++_i) \
        __builtin_amdgcn_global_load_lds((const unsigned*)((const char*)(gbase) + (voff)[_i]), (PG8_LAS unsigned*)(lds + (bufoff) + ldsw + _i * 8192), 16, 0, 0); } while (0)
#define PG8_LDA(dst, b, h) do { _Pragma("unroll") for (int m = 0; m < 4; ++m) _Pragma("unroll") for (int k = 0; k < 2; ++k) dst[m][k] = *(const PG8_LAS bf16x8*)(lds + PG8_SA(b, h) + aoff + m * 2048 + k * 1024); } while (0)
#define PG8_LDB(dst, b, h) do { _Pragma("unroll") for (int n = 0; n < 2; ++n) _Pragma("unroll") for (int k = 0; k < 2; ++k) dst[n][k] = *(const PG8_LAS bf16x8*)(lds + PG8_SB(b, h) + boff + n * 2048 + k * 1024); } while (0)
#define PG8_MMA(ai, bj, At, Bt) do { __builtin_amdgcn_s_setprio(1); _Pragma("unroll") for (int m = 0; m < 4; ++m) _Pragma("unroll") for (int n = 0; n < 2; ++n) _Pragma("unroll") for (int k = 0; k < 2; ++k) \
        acc[ai][bj][m][n] = __builtin_amdgcn_mfma_f32_16x16x32_bf16(Bt[n][k], At[m][k], acc[ai][bj][m][n], 0, 0, 0); __builtin_amdgcn_s_setprio(0); } while (0)
#define PG8_WAIT_V(n) asm volatile("s_waitcnt vmcnt(" #n ")" ::: "memory")
#define PG8_WAIT_L(n) asm volatile("s_waitcnt lgkmcnt(" #n ")" ::: "memory")
#define PG8_BAR __builtin_amdgcn_s_barrier()
#define PG8_SCHED __builtin_amdgcn_sched_barrier(0)
    Unit cur, nxt; int ui = 0;
    if (!S.next(0, cur)) return;
    f32x4 acc[2][2][4][2];
#pragma unroll
    for (int a = 0; a < 2; ++a)
#pragma unroll
        for (int b = 0; b < 2; ++b)
#pragma unroll
            for (int m = 0; m < 4; ++m)
#pragma unroll
                for (int n = 0; n < 2; ++n) acc[a][b][m][n] = (f32x4){0.f, 0.f, 0.f, 0.f};
    bf16x8 At[4][2], B0[2][2], B1[2][2];
    const char* cA = (const char*)g.A + (size_t)cur.pm * tstep; const char* cB = (const char*)g.Bt + (size_t)cur.pn * tstep;
    S.a_ready(cur);
    if constexpr (SP2) {
        PG8_STAGE(PG8_SB(0, 0), cB, voffB); PG8_STAGE(PG8_SB(0, 1), cB + hstep, voffB); PG8_STAGE(PG8_SA(0, 0), cA, voffA); PG8_STAGE(PG8_SA(0, 1), cA + hstep, voffA);
        if (wr == 1) PG8_BAR;
        PG8_WAIT_V(2); PG8_BAR;
        PG8_STAGE(PG8_SB(1, 0), cB + kstep, voffB); PG8_STAGE(PG8_SA(1, 0), cA + kstep, voffA); PG8_STAGE(PG8_SB(1, 1), cB + hstep + kstep, voffB);
        PG8_WAIT_V(6); PG8_BAR;
    } else {
        PG8_STAGE(PG8_SB(0, 0), cB, voffB); PG8_STAGE(PG8_SA(0, 0), cA, voffA); PG8_STAGE(PG8_SB(0, 1), cB + hstep, voffB); PG8_STAGE(PG8_SA(0, 1), cA + hstep, voffA);
        if (wr == 1) PG8_BAR;
        PG8_WAIT_V(4); PG8_BAR;
        PG8_STAGE(PG8_SB(1, 0), cB + kstep, voffB); PG8_STAGE(PG8_SA(1, 0), cA + kstep, voffA); PG8_STAGE(PG8_SB(1, 1), cB + hstep + kstep, voffB);
        PG8_WAIT_V(6); PG8_BAR;
    }
    for (;;) {
        const bool has_next = S.next(ui + 1, nxt);
        const char* nA = has_next ? (const char*)g.A + (size_t)nxt.pm * tstep : cA; const char* nB = has_next ? (const char*)g.Bt + (size_t)nxt.pn * tstep : cB;
        for (int t = 0; t < nt; t += 2) {
            const bool last = (t == nt - 2);
            const char* a1 = cA + (size_t)(t + 1) * kstep;
            const char* a2 = last ? nA : cA + (size_t)(t + 2) * kstep; const char* b2 = last ? nB : cB + (size_t)(t + 2) * kstep;
            const char* a3 = a2 + kstep; const char* b3 = b2 + kstep;
            if (last && has_next) S.a_ready(nxt);
            if constexpr (SP2) {
            PG8_LDB(B0, 0, 0); PG8_LDB(B1, 0, 1); PG8_SCHED; PG8_LDA(At, 0, 0); PG8_STAGE(PG8_SA(1, 1), a1 + hstep, voffA);
            PG8_WAIT_V(8); PG8_WAIT_L(0); PG8_BAR; PG8_MMA(0, 0, At, B0); PG8_MMA(0, 1, At, B1); PG8_BAR; PG8_SCHED;
            PG8_LDA(At, 0, 1); PG8_STAGE(PG8_SB(0, 0), b2, voffB); PG8_STAGE(PG8_SB(0, 1), b2 + hstep, voffB); PG8_STAGE(PG8_SA(0, 0), a2, voffA);
            PG8_WAIT_V(8); PG8_WAIT_L(0); PG8_BAR; PG8_MMA(1, 0, At, B0); PG8_MMA(1, 1, At, B1); PG8_BAR; PG8_SCHED;
            PG8_LDB(B0, 1, 0); PG8_LDB(B1, 1, 1); PG8_SCHED; PG8_LDA(At, 1, 0); PG8_STAGE(PG8_SA(0, 1), a2 + hstep, voffA);
            PG8_WAIT_V(8); PG8_WAIT_L(0); PG8_BAR; PG8_MMA(0, 0, At, B0); PG8_MMA(0, 1, At, B1); PG8_BAR; PG8_SCHED;
            PG8_LDA(At, 1, 1); PG8_STAGE(PG8_SB(1, 0), b3, voffB); PG8_STAGE(PG8_SB(1, 1), b3 + hstep, voffB); PG8_STAGE(PG8_SA(1, 0), a3, voffA);
            PG8_WAIT_V(8); PG8_WAIT_L(0); PG8_BAR; PG8_MMA(1, 0, At, B0); PG8_MMA(1, 1, At, B1); PG8_BAR; PG8_SCHED;
            } else {
            PG8_LDB(B0, 0, 0); PG8_SCHED; PG8_LDA(At, 0, 0); PG8_STAGE(PG8_SA(1, 1), a1 + hstep, voffA);
            PG8_WAIT_L(8); PG8_BAR; PG8_WAIT_L(0); PG8_MMA(0, 0, At, B0); PG8_BAR; PG8_SCHED;
            PG8_LDB(B1, 0, 1); PG8_STAGE(PG8_SB(0, 0), b2, voffB);
            PG8_BAR; PG8_WAIT_L(0); PG8_MMA(0, 1, At, B1); PG8_BAR;
            PG8_LDA(At, 0, 1); PG8_STAGE(PG8_SA(0, 0), a2, voffA);
            PG8_BAR; PG8_WAIT_L(0); PG8_MMA(1, 0, At, B0); PG8_BAR; PG8_SCHED;
            PG8_STAGE(PG8_SB(0, 1), b2 + hstep, voffB);
            PG8_WAIT_V(6); PG8_BAR; PG8_MMA(1, 1, At, B1); PG8_BAR;
            PG8_LDB(B0, 1, 0); PG8_SCHED; PG8_LDA(At, 1, 0); PG8_STAGE(PG8_SA(0, 1), a2 + hstep, voffA);
            PG8_WAIT_L(8); PG8_BAR; PG8_WAIT_L(0); PG8_MMA(0, 0, At, B0); PG8_BAR; PG8_SCHED;
            PG8_LDB(B1, 1, 1); PG8_STAGE(PG8_SB(1, 0), b3, voffB);
            PG8_BAR; PG8_WAIT_L(0); PG8_MMA(0, 1, At, B1); PG8_BAR;
            PG8_LDA(At, 1, 1); PG8_STAGE(PG8_SA(1, 0), a3, voffA);
            PG8_BAR; PG8_WAIT_L(0); PG8_MMA(1, 0, At, B0); PG8_BAR; PG8_SCHED;
            PG8_STAGE(PG8_SB(1, 1), b3 + hstep, voffB);
            PG8_WAIT_V(6); PG8_BAR; PG8_MMA(1, 1, At, B1); PG8_BAR;
            }
        }
        if constexpr (ALIGN_EPI) { if (wr == 0) PG8_BAR; }
        if constexpr (!Epi::AFTER_DRAIN) { E(acc, cur, wr, wc, fr, fq); S.done(cur); }
        if (!has_next) break;
#pragma unroll
        for (int a = 0; a < 2; ++a)
#pragma unroll
            for (int b = 0; b < 2; ++b)
#pragma unroll
                for (int m = 0; m < 4; ++m)
#pragma unroll
                    for (int n = 0; n < 2; ++n) acc[a][b][m][n] = (f32x4){0.f, 0.f, 0.f, 0.f};
        cur = nxt; cA = nA; cB = nB; ++ui;
        if constexpr (ALIGN_EPI) { if (wr == 1) PG8_BAR; }
    }
    PG8_WAIT_V(0);
    if constexpr (!ALIGN_EPI) { if (wr == 0) PG8_BAR; }
    PG8_BAR;
    if constexpr (Epi::AFTER_DRAIN) { E.fused(acc, cur, wr, wc, fr, fq, lds, wid, lane); S.done(cur); }
#undef PG8_SA
#undef PG8_SB
#undef PG8_STAGE
#undef PG8_LDA
#undef PG8_LDB
#undef PG8_MMA
#undef PG8_WAIT_V
#undef PG8_WAIT_L
#undef PG8_BAR
#undef PG8_SCHED
}
}

struct RowGather { const bf16_t* A; int lda; const int* ids; int shift; __device__ __forceinline__ const bf16_t* operator()(int r) const { return A + (size_t)(ids[r] >> shift) * lda; } };
template <int STAGE>
__device__ __forceinline__ void moe_phase(char* smem, const bf16_t* A, int lda, const bf16_t* Wt, size_t wstride, int ldb, int K, const int* cnt, const int* list, const float* pgate, bf16_t* out, const float* pss) {
    int* ids = (int*)(smem + GEMM_LDS);
    int* tpre = ids + 256;
    constexpr int NTN = (STAGE == 1) ? 4 : 8;
    __syncthreads();
    if (TIDX < 64) {
        const int ln = TIDX; int nt = (ln < NEXP) ? ((cnt[ln * CNT_STRIDE] + 255) >> 8) : 0; int inc = nt;
#pragma unroll
        for (int o = 1; o < 64; o <<= 1) { const int nb = __shfl_up(inc, o); if (ln >= o) inc += nb; }
        if (ln <= NEXP) tpre[ln] = inc - nt;
    }
    __syncthreads();
    const int ntiles = tpre[NEXP] * NTN;
    const int lane = TIDX & 63, wave = TIDX >> 6, wm = wave >> 1, wn = wave & 1;
    for (int tIdx = vcu_id(); tIdx < ntiles; tIdx += gridDim.x) {
        const int mtg = tIdx / NTN, n0 = (tIdx % NTN) * 128;
        int e = 0;
        for (int i = 1; i < NEXP; ++i) if (tpre[i] <= mtg) e = i;
        const int mt = mtg - tpre[e];
        const int cn = cnt[e * CNT_STRIDE];
        __syncthreads();
        if (TIDX < 256) { const int pos = mt * 256 + TIDX; ids[TIDX] = list[(size_t)e * T + (pos < cn ? pos : cn - 1)]; }
        __syncthreads();
        f32x4 acc[4][4];
        RowGather rp{A, lda, ids, STAGE == 1 ? 1 : 0};
        gemm_tile(smem, rp, Wt + (size_t)e * wstride, ldb, n0, K, acc);
#pragma unroll
        for (int m = 0; m < 4; ++m) {
            const int rl = wm * 64 + m * 16 + (lane & 15);
            if (mt * 256 + rl >= cn) continue;
            const int pid = ids[rl];
            if (STAGE == 1) {
                const float gt = pgate[pid], ri = rinv_from_pss(pss, (size_t)(pid >> 1));
#pragma unroll
                for (int np = 0; np < 2; ++np) {
                    const f32x4 g = acc[m][2 * np], u = acc[m][2 * np + 1];
                    const int j = (n0 + wn * 64 + np * 32) / 2 + (lane >> 4) * 4;
                    const f32x4 gs = g * ri; const float ug = ri * gt;
                    uint2 o; o.x = pk2(siluf_(gs.x) * u.x * ug, siluf_(gs.y) * u.y * ug); o.y = pk2(siluf_(gs.z) * u.z * ug, siluf_(gs.w) * u.w * ug);
                    *(uint2*)(out + (size_t)pid * DEXP + j) = o;
                }
            } else {
#pragma unroll
                for (int n = 0; n < 4; ++n) {
                    const f32x4 v = acc[m][n]; const int col = n0 + wn * 64 + n * 16 + (lane >> 4) * 4;
                    uint2 o; o.x = pk2(v.x, v.y); o.y = pk2(v.z, v.w);
                    *(uint2*)(out + (size_t)pid * 1024 + col) = o;
                }
            }
        }
    }
}

__device__ __forceinline__ void hgrn2_naive(const bf16_t* __restrict__ proj, const float* __restrict__ hgrn_lb, int layer, const float* __restrict__ mix_gain, bf16_t* __restrict__ y, int bh, int lane) {
    const int b = bh >> 2, h = bh & 3;
    float lbk = 0.f;
    if (layer == 1) { float a0 = hgrn_lb[h * 64 + lane], a1 = hgrn_lb[256 + h * 64 + lane]; lbk = 1.f / (1.f + __expf(a0 - a1)); }
    const float mg = mix_gain[C_AQ + h * 64 + lane];
    float S[64];
#pragma unroll
    for (int k = 0; k < 64; ++k) S[k] = 0.f;
    for (int t = 0; t < SEQ; ++t) {
        const bf16_t* pr = proj + (size_t)(b * SEQ + t) * NP + h * 64 + lane;
        const float qk = siluf_(bf2f(pr[C_AQ]));
        const float sg = sigmoidf_(bf2f(pr[C_AF]));
        const float f = lbk + (1.f - lbk) * sg, kk = (1.f - lbk) * (1.f - sg);
        const float iv = bf2f(pr[C_AI]);
        const float gv = bf2f(pr[C_AG]);
        float o = 0.f;
#pragma unroll
        for (int k = 0; k < 64; ++k) { S[k] = rdlane(f, k) * S[k] + rdlane(kk, k) * iv; o += rdlane(qk, k) * S[k]; }
        const float ms = wave_sum(o * o) * (1.f / 64.f);
        const float yv = o * rsqrtf(ms + EPS) * siluf_(gv) * mg;
        y[(size_t)(b * SEQ + t) * 1024 + 0 + h * 64 + lane] = f2bf(yv);
    }
}
__device__ __forceinline__ void gdn_naive(const bf16_t* __restrict__ proj, const float* __restrict__ gates, const float* __restrict__ conv_w  ,
                                          const float* __restrict__ a_log, const float* __restrict__ dt_bias, const float* __restrict__ mix_gain, bf16_t* __restrict__ y, int bh, int lane) {
    const int b = bh >> 2, h = bh & 3;
    float wq[4], wk[4], wv[4];
#pragma unroll
    for (int j = 0; j < 4; ++j) { wq[j] = conv_w[j * 768 + h * 64 + lane]; wk[j] = conv_w[j * 768 + 256 + h * 64 + lane]; wv[j] = conv_w[j * 768 + 512 + h * 64 + lane]; }
    float xq[3] = {0.f, 0.f, 0.f}, xk[3] = {0.f, 0.f, 0.f}, xv[3] = {0.f, 0.f, 0.f};
    const float Aexp = __expf(a_log[h]), dtb = dt_bias[h];
    const float mg = mix_gain[768 + h * 64 + lane];
    float S[64];
#pragma unroll
    for (int k = 0; k < 64; ++k) S[k] = 0.f;
    for (int t = 0; t < SEQ; ++t) {
        const size_t row = (size_t)(b * SEQ + t);
        const bf16_t* pr = proj + row * NP + h * 64 + lane;
        const float q0 = bf2f(pr[C_DQ]), k0 = bf2f(pr[C_DK]), v0 = bf2f(pr[C_DV]), zv = bf2f(pr[C_DZ]);
        float q = siluf_(wq[0] * xq[0] + wq[1] * xq[1] + wq[2] * xq[2] + wq[3] * q0);
        float k = siluf_(wk[0] * xk[0] + wk[1] * xk[1] + wk[2] * xk[2] + wk[3] * k0);
        float v = siluf_(wv[0] * xv[0] + wv[1] * xv[1] + wv[2] * xv[2] + wv[3] * v0);
        xq[0] = xq[1]; xq[1] = xq[2]; xq[2] = q0; xk[0] = xk[1]; xk[1] = xk[2]; xk[2] = k0; xv[0] = xv[1]; xv[1] = xv[2]; xv[2] = v0;
        q = q * rsqrtf(wave_sum(q * q) + EPS) * 0.125f;
        k = k * rsqrtf(wave_sum(k * k) + EPS);
        const float beta = sigmoidf_(gates[row * 16 + 4 + h]);
        const float g = -Aexp * softplusf_(gates[row * 16 + 8 + h] + dtb);
        const float eg = __expf(g);
        float r = 0.f;
#pragma unroll
        for (int i = 0; i < 64; ++i) { S[i] *= eg; r += rdlane(k, i) * S[i]; }
        const float dlt = beta * (v - r);
        float o = 0.f;
#pragma unroll
        for (int i = 0; i < 64; ++i) { S[i] += rdlane(k, i) * dlt; o += rdlane(q, i) * S[i]; }
        const float ms = wave_sum(o * o) * (1.f / 64.f);
        const float yv = o * rsqrtf(ms + EPS) * siluf_(zv) * mg;
        y[row * 1024 + 768 + h * 64 + lane] = f2bf(yv);
    }
}
__device__ __forceinline__ void fox_cumsum(const float* __restrict__ gates, const float* __restrict__ fb, float* __restrict__ cc, int bh, int lane) {
    const int b = bh >> 2, h = bh & 3;
    const float bias = fb[h];
    float v[32];
#pragma unroll
    for (int i = 0; i < 32; ++i) v[i] = gates[(size_t)(b * SEQ + lane * 32 + i) * 16 + h];
    float run = 0.f;
#pragma unroll
    for (int i = 0; i < 32; ++i) { run += logsigmoidf_(v[i] + bias); v[i] = run; }
    float tot = run;
#pragma unroll
    for (int o = 1; o < 64; o <<= 1) { const float nb = __shfl_up(tot, o); if (lane >= o) tot += nb; }
    const float off = tot - run;
    float* dst = cc + (size_t)(b * 4 + h) * SEQ + lane * 32;
#pragma unroll
    for (int i = 0; i < 32; i += 4) *(f32x4*)(dst + i) = (f32x4){v[i] + off, v[i + 1] + off, v[i + 2] + off, v[i + 3] + off};
}
__device__ __forceinline__ void lru_prep_task(float* xc  , const bf16_t* __restrict__ proj, const float* __restrict__ conv_w, const float* __restrict__ conv_b,
                                              const float* __restrict__ w_a, const float* __restrict__ b_a, const float* __restrict__ w_x, const float* __restrict__ b_x,
                                              const float* __restrict__ lam, float* __restrict__ a_out, float* __restrict__ u_out, int task, bool active) {
    const int c = TIDX & 255, t0 = task * 16;
    if (active) {
        const float w0 = conv_w[c], w1 = conv_w[256 + c], w2 = conv_w[512 + c], w3 = conv_w[768 + c], cb = conv_b[c];
        for (int i = 0; i < 16; ++i) {
            const int t = t0 + i, s = t & (SEQ - 1);
            const bf16_t* pr = proj + (size_t)t * NP + C_CX + c;
            float acc = cb + w3 * bf2f(pr[0]);
            if (s >= 1) acc += w2 * bf2f(pr[-(ptrdiff_t)NP]);
            if (s >= 2) acc += w1 * bf2f(pr[-(ptrdiff_t)2 * NP]);
            if (s >= 3) acc += w0 * bf2f(pr[-(ptrdiff_t)3 * NP]);
            xc[i * 256 + c] = acc;
        }
    }
    __syncthreads();
    if (active) {
        const int h = c >> 6, jj = c & 63;
        float ra[16], rx[16];
#pragma unroll
        for (int i = 0; i < 16; ++i) { ra[i] = 0.f; rx[i] = 0.f; }
        for (int k = 0; k < 64; ++k) {
            const float wa = w_a[(h * 64 + k) * 64 + jj], wx = w_x[(h * 64 + k) * 64 + jj];
#pragma unroll
            for (int i = 0; i < 16; ++i) { const float xv = xc[i * 256 + h * 64 + k]; ra[i] += xv * wa; rx[i] += xv * wx; }
        }
        const float ba = b_a[c], bx = b_x[c], sp = softplusf_(-lam[c]);
#pragma unroll
        for (int i = 0; i < 16; ++i) {
            const float r = sigmoidf_(ra[i] + ba), ig = sigmoidf_(rx[i] + bx);
            const float log_a = -8.f * r * sp;
            const float a = __expf(log_a);
            const float u = sqrtf(-expm1f(2.f * log_a)) * (ig * xc[i * 256 + c]);
            a_out[(size_t)(t0 + i) * 256 + c] = a; u_out[(size_t)(t0 + i) * 256 + c] = u;
        }
    }
    __syncthreads();
}
__device__ __forceinline__ void lru_scan_task(const float* __restrict__ a_in, const float* __restrict__ u_in, const bf16_t* __restrict__ proj, const float* __restrict__ mix_gain, bf16_t* __restrict__ y, int b) {
    const int c = TIDX;
    const float mg = mix_gain[512 + c];
    float hst = 0.f;
    for (int t = 0; t < SEQ; ++t) {
        const size_t row = (size_t)(b * SEQ + t);
        hst = a_in[row * 256 + c] * hst + u_in[row * 256 + c];
        const float yv = hst * geluf_(bf2f(proj[row * NP + C_CG + c]));
        const float ms = wave_sum(yv * yv) * (1.f / 64.f);
        y[row * 1024 + 512 + c] = f2bf(yv * rsqrtf(ms + EPS) * mg);
    }
}

typedef short s16x4 __attribute__((ext_vector_type(4)));
#define LDS_AS __attribute__((address_space(3)))
__device__ __forceinline__ bf16x8 frag_rm(const bf16_t* tile, int ld, int r0, int k0, int lane) { return *(const bf16x8*)(tile + (r0 + (lane & 15)) * ld + k0 + (lane >> 4) * 8); }
__device__ __forceinline__ s16x4 tr4(const bf16_t* tile, int ld, int rbase, int c0, int lane) {
    const bf16_t* p = tile + (rbase + ((lane & 15) >> 2)) * ld + c0 + 4 * (lane & 3);
    return __builtin_amdgcn_ds_read_tr16_b64_v4i16((LDS_AS s16x4*)p);
}
__device__ __forceinline__ bf16x8 frag_cm(const bf16_t* tile, int ld, int k0, int c0, int lane) {
    const s16x4 lo = tr4(tile, ld, k0 + (lane >> 4) * 8, c0, lane), hi = tr4(tile, ld, k0 + (lane >> 4) * 8 + 4, c0, lane);
    return (bf16x8){lo[0], lo[1], lo[2], lo[3], hi[0], hi[1], hi[2], hi[3]};
}
#define MFMA16(a, b, c) __builtin_amdgcn_mfma_f32_16x16x32_bf16((a), (b), (c), 0, 0, 0)
constexpr int TLD = 72;


#define XB_TMO      128
#define XB_XCNT(j)  (256  + 64 * (j))
#define XB_XSUB(j)  (1280 + 64 * (j))
#define XB_XGEN(j)  (2304 + 64 * (j))
#define XB_TOP      3328
#define XB_TOPGEN   3392
#define XCD_BAR_WORDS 3456
#define XB_SPIN_CAP (1u << 18)
__device__ __forceinline__ unsigned xb_ld(unsigned* p)              { return __hip_atomic_load(p, __ATOMIC_RELAXED, __HIP_MEMORY_SCOPE_AGENT); }
__device__ __forceinline__ unsigned xb_add(unsigned* p, unsigned v) { return __hip_atomic_fetch_add(p, v, __ATOMIC_RELAXED, __HIP_MEMORY_SCOPE_AGENT); }
__device__ __forceinline__ unsigned xb_xcc_id() { return (unsigned)__builtin_amdgcn_s_getreg((3 << 11) | 20) & 0xFu; }
#define XB_SPIN(cond, bar) do { unsigned _sp = 0; while (cond) { __builtin_amdgcn_s_sleep(1); \
    if ((++_sp & 255u) == 0u) { if (xb_ld(&(bar)[XB_TMO])) break; if (_sp > XB_SPIN_CAP) { atomicAdd(&(bar)[XB_TMO], 1u); break; } } } } while (0)
struct XcdBarrier { unsigned* bar; unsigned x; volatile LDS_AS unsigned* st; };
__device__ __forceinline__ XcdBarrier xcd_barrier_post(unsigned* bar, volatile LDS_AS unsigned* st) {
    XcdBarrier b; b.bar = bar; b.x = xb_xcc_id(); b.st = st;
    if (TIDX == 0) (void)xb_add(&bar[XB_XCNT(b.x)], 1u);
    return b;
}
__device__ __forceinline__ void xcd_barrier_complete(unsigned* bar, unsigned x, unsigned& nloc, unsigned& nx) {
    const unsigned G = gridDim.x * gridDim.y * gridDim.z;
    unsigned sum, cnt, mine, sp = 0u;
    for (;;) {
        sum = 0u; cnt = 0u; mine = 0u;
#pragma unroll
        for (unsigned j = 0; j < 16; ++j) { const unsigned c = xb_ld(&bar[XB_XCNT(j)]); sum += c; cnt += (c > 0u) ? 1u : 0u; mine = (j == x) ? c : mine; }
        if (sum == G) break;
        __builtin_amdgcn_s_sleep(1);
        if ((++sp & 255u) == 0u) { if (xb_ld(&bar[XB_TMO])) break; if (sp > XB_SPIN_CAP) { atomicAdd(&bar[XB_TMO], 1u); break; } }
    }
    nloc = mine > 0u ? mine : 1u; nx = cnt > 0u ? cnt : 1u;
}
__device__ __forceinline__ void xcd_barrier(const XcdBarrier& b) {
    asm volatile("s_waitcnt vmcnt(0)" ::: "memory");
    __syncthreads();
    if (TIDX == 0) {
        unsigned* bar = b.bar;
        __builtin_amdgcn_s_waitcnt(0);
        unsigned nloc = b.st[0], nx = b.st[1];
        if (nloc == 0u) { xcd_barrier_complete(bar, b.x, nloc, nx); b.st[0] = nloc; b.st[1] = nx; }
        const unsigned old = xb_add(&bar[XB_XSUB(b.x)], 1u);
        const unsigned gen = old / nloc;
        if (old + 1u == (gen + 1u) * nloc) {
            __builtin_amdgcn_fence(__ATOMIC_RELEASE, "agent");
            asm volatile("s_waitcnt vmcnt(0)" ::: "memory");
            const unsigned og = xb_add(&bar[XB_TOP], 1u);
            const unsigned tg = og / nx;
            if (og + 1u == (tg + 1u) * nx) xb_add(&bar[XB_TOPGEN], 1u);
            else XB_SPIN(xb_ld(&bar[XB_TOPGEN]) == tg, bar);
            __builtin_amdgcn_fence(__ATOMIC_ACQUIRE, "agent");
            xb_add(&bar[XB_XGEN(b.x)], 1u);
            asm volatile("s_waitcnt vmcnt(0)" ::: "memory");
        } else {
            XB_SPIN(xb_ld(&bar[XB_XGEN(b.x)]) == gen, bar);
            __builtin_amdgcn_fence(__ATOMIC_ACQUIRE, "agent");
            asm volatile("s_waitcnt vmcnt(0)" ::: "memory");
        }
    }
    __syncthreads();
}

template <bool MASK>
__device__ __forceinline__ void attn_compute_t(const bf16_t* cK, const bf16_t* cV, const float* cC, const bf16x8 (&qf)[2], f32x4 (&oacc)[4], float& mrun, float& lrun,
                                               float ct2, float scale2, int kt, int tq, int lane, int g) {
    f32x4 sacc[4];
#pragma unroll
    for (int n = 0; n < 4; ++n) {
        sacc[n] = (f32x4){0.f, 0.f, 0.f, 0.f};
#pragma unroll
        for (int kk = 0; kk < 2; ++kk) sacc[n] = MFMA16(frag_rm(cK, TLD, n * 16, kk * 32, lane), qf[kk], sacc[n]);
    }
    float mx = -INFINITY;
#pragma unroll
    for (int n = 0; n < 4; ++n) {
        const f32x4 cs = *(const f32x4*)(cC + n * 16 + 4 * g);
#pragma unroll
        for (int r = 0; r < 4; ++r) {
            float v = sacc[n][r] * scale2 + (ct2 - cs[r]);
            if (MASK) { if (kt * 64 + n * 16 + 4 * g + r > tq) v = -INFINITY; }
            sacc[n][r] = v; mx = fmaxf(mx, v);
        }
    }
    mx = fmaxf(mx, __shfl_xor(mx, 16)); mx = fmaxf(mx, __shfl_xor(mx, 32));
    const float mnew = fmaxf(mrun, mx);
    const float corr = __builtin_amdgcn_exp2f(mrun - mnew);
    float rs = 0.f;
#pragma unroll
    for (int n = 0; n < 4; ++n)
#pragma unroll
        for (int r = 0; r < 4; ++r) { const float p = __builtin_amdgcn_exp2f(sacc[n][r] - mnew); sacc[n][r] = p; rs += p; }
    rs += __shfl_xor(rs, 16); rs += __shfl_xor(rs, 32);
    lrun = lrun * corr + rs; mrun = mnew;
    bf16x8 pf[2];
#pragma unroll
    for (int kk = 0; kk < 2; ++kk) {
        const u32x4 pk = (u32x4){pk2(sacc[2 * kk][0], sacc[2 * kk][1]), pk2(sacc[2 * kk][2], sacc[2 * kk][3]), pk2(sacc[2 * kk + 1][0], sacc[2 * kk + 1][1]), pk2(sacc[2 * kk + 1][2], sacc[2 * kk + 1][3])};
        pf[kk] = __builtin_bit_cast(bf16x8, pk);
    }
#pragma unroll
    for (int n2 = 0; n2 < 4; ++n2) {
        oacc[n2] = oacc[n2] * corr;
#pragma unroll
        for (int kk = 0; kk < 2; ++kk) {
            const s16x4 lo = tr4(cV, TLD, (2 * kk) * 16 + 4 * g, n2 * 16, lane), hi = tr4(cV, TLD, (2 * kk + 1) * 16 + 4 * g, n2 * 16, lane);
            const bf16x8 vf = (bf16x8){lo[0], lo[1], lo[2], lo[3], hi[0], hi[1], hi[2], hi[3]};
            oacc[n2] = MFMA16(vf, pf[kk], oacc[n2]);
        }
    }
}
__device__ __forceinline__ void attn_compute(const bf16_t* cK, const bf16_t* cV, const float* cC, const bf16x8 (&qf)[2], f32x4 (&oacc)[4], float& mrun, float& lrun,
                                             float ct2, float scale2, int causal, int kt, int q0, int tq, int wave, int lane, int g) {
    const int r0 = q0 + wave * 16;
    if (causal && (kt * 64 > r0 + 15)) return;
    if (causal && (kt * 64 + 63 > r0)) attn_compute_t<true>(cK, cV, cC, qf, oacc, mrun, lrun, ct2, scale2, kt, tq, lane, g);
    else attn_compute_t<false>(cK, cV, cC, qf, oacc, mrun, lrun, ct2, scale2, kt, tq, lane, g);
}

__device__ __forceinline__ void attn_task(char* smem, const bf16_t* __restrict__ Q, int ldq, const bf16_t* __restrict__ Kp, int ldk, const bf16_t* __restrict__ Vp, int ldv, const float* __restrict__ bias,
                                          int nq_per_b, int nk_per_b, int causal, float scale, bf16_t* __restrict__ O, int ldo, const float* __restrict__ gain, int rms, int task) {
    bf16_t* sK = (bf16_t*)smem;
    bf16_t* sV = sK + 2 * 64 * TLD;
    float* sC = (float*)(sV + 2 * 64 * TLD);
    const int tid = TIDX, lane = tid & 63, wave = tid >> 6, g = lane >> 4, li = lane & 15;
    const int nqt = nq_per_b / 128;
    const int qt = task % nqt, h = (task / nqt) & 3, b = task / (nqt * 4);
    const int q0 = qt * 128, tq = q0 + wave * 16 + li;
    const size_t qrow = (size_t)b * nq_per_b + tq;
    bf16x8 qf[2];
#pragma unroll
    for (int kk = 0; kk < 2; ++kk) qf[kk] = *(const bf16x8*)(Q + qrow * ldq + h * 64 + kk * 32 + g * 8);
    constexpr float LOG2E = 1.4426950408889634f;
    const float ct = bias ? bias[(size_t)(b * 4 + h) * nq_per_b + tq] * LOG2E : 0.f;
    const float scale2 = scale * LOG2E;
    const int nkt = causal ? (q0 + 128) / 64 : nk_per_b / 64;
    const int sr = tid >> 3, sc = tid & 7;
    const bf16_t* kg = Kp + ((size_t)b * nk_per_b + sr) * ldk + h * 64 + sc * 8;
    const bf16_t* vg = Vp + ((size_t)b * nk_per_b + sr) * ldv + h * 64 + sc * 8;
    const float* cg_ = bias ? bias + (size_t)(b * 4 + h) * nk_per_b : nullptr;
    u32x4 rkA, rvA, rkB, rvB; float rcA = 0.f, rcB = 0.f;
    {   const u32x4 rk = *(const u32x4*)kg, rv = *(const u32x4*)vg; const float rc = (cg_ && tid < 64) ? cg_[tid] * LOG2E : 0.f;
        __syncthreads();
        *(u32x4*)(sK + sr * TLD + sc * 8) = rk; *(u32x4*)(sV + sr * TLD + sc * 8) = rv; if (tid < 64) sC[tid] = rc; }
    rkA = *(const u32x4*)(kg + (size_t)64 * ldk); rvA = *(const u32x4*)(vg + (size_t)64 * ldv); rcA = (cg_ && tid < 64) ? cg_[64 + tid] * LOG2E : 0.f;
    __syncthreads();
    f32x4 oacc[4];
#pragma unroll
    for (int n = 0; n < 4; ++n) oacc[n] = (f32x4){0.f, 0.f, 0.f, 0.f};
    float mrun = -INFINITY, lrun = 0.f;
#define ATTN_ITER(kt, LK, LV, LC, WK, WV, WC) { \
        const int buf = (kt) & 1; \
        if ((kt) + 2 < nkt) { LK = *(const u32x4*)(kg + (size_t)((kt) + 2) * 64 * ldk); LV = *(const u32x4*)(vg + (size_t)((kt) + 2) * 64 * ldv); LC = (cg_ && tid < 64) ? cg_[((kt) + 2) * 64 + tid] * LOG2E : 0.f; } \
        attn_compute(sK + buf * 64 * TLD, sV + buf * 64 * TLD, sC + buf * 64, qf, oacc, mrun, lrun, ct, scale2, causal, (kt), q0, tq, wave, lane, g); \
        if ((kt) + 1 < nkt) { const int nb = buf ^ 1; *(u32x4*)(sK + nb * 64 * TLD + sr * TLD + sc * 8) = WK; *(u32x4*)(sV + nb * 64 * TLD + sr * TLD + sc * 8) = WV; if (tid < 64) sC[nb * 64 + tid] = WC; } \
        __syncthreads(); }
    for (int kt = 0; kt < nkt; kt += 2) {
        ATTN_ITER(kt, rkB, rvB, rcB, rkA, rvA, rcA)
        ATTN_ITER(kt + 1, rkA, rvA, rcA, rkB, rvB, rcB)
    }
#undef ATTN_ITER
    const float inv = 1.f / lrun;
    float ms = 0.f;
#pragma unroll
    for (int n = 0; n < 4; ++n) { oacc[n] = oacc[n] * inv; ms += oacc[n][0] * oacc[n][0] + oacc[n][1] * oacc[n][1] + oacc[n][2] * oacc[n][2] + oacc[n][3] * oacc[n][3]; }
    ms += __shfl_xor(ms, 16); ms += __shfl_xor(ms, 32);
    const float rinv = rms ? rsqrtf(ms * (1.f / 64.f) + EPS) : 1.f;
#pragma unroll
    for (int n = 0; n < 4; ++n) {
        const int d = n * 16 + 4 * g;
        f32x4 gg = (f32x4){1.f, 1.f, 1.f, 1.f};
        if (gain) gg = *(const f32x4*)(gain + h * 64 + d);
        uint2 o; o.x = pk2(oacc[n][0] * rinv * gg[0], oacc[n][1] * rinv * gg[1]); o.y = pk2(oacc[n][2] * rinv * gg[2], oacc[n][3] * rinv * gg[3]);
        *(uint2*)(O + qrow * ldo + h * 64 + d) = o;
    }
}


__device__ __forceinline__ void hgrn_scan(float* LF  , float* SEGT  , const bf16_t* __restrict__ prow  , const float* __restrict__ hgrn_lb, int layer, int h, float (&kk)[8]) {
    const int tid = TIDX, t = tid >> 3, k8 = (tid & 7) * 8;
    const u32x4 raw = *(const u32x4*)(prow + (size_t)t * NP + C_AF + k8);
#pragma unroll
    for (int j = 0; j < 8; ++j) {
        const float fl = __uint_as_float((j & 1) ? (raw[j >> 1] & 0xffff0000u) : (raw[j >> 1] << 16));
        float lbk = 0.f;
        if (layer == 1) { const float a0 = hgrn_lb[h * 64 + k8 + j], a1 = hgrn_lb[256 + h * 64 + k8 + j]; lbk = 1.f / (1.f + __expf(a0 - a1)); }
        const float sg = sigmoidf_(fl);
        const float f = lbk + (1.f - lbk) * sg;
        kk[j] = (1.f - lbk) * (1.f - sg);
        LF[t * 65 + k8 + j] = __logf(f);
    }
    __syncthreads();
    { const int k = tid & 63, seg = tid >> 6; float run = 0.f;
#pragma unroll
      for (int i = 0; i < 8; ++i) { run += LF[(seg * 8 + i) * 65 + k]; LF[(seg * 8 + i) * 65 + k] = run; }
      SEGT[seg * 64 + k] = run; }
    __syncthreads();
    { const int k = tid & 63, seg = tid >> 6; float off = 0.f;
      for (int s2 = 0; s2 < seg; ++s2) off += SEGT[s2 * 64 + k];
#pragma unroll
      for (int i = 0; i < 8; ++i) LF[(seg * 8 + i) * 65 + k] += off; }
    __syncthreads();
}
__device__ __forceinline__ float bfx(const u32x4& raw, int j) { return __uint_as_float((j & 1) ? (raw[j >> 1] & 0xffff0000u) : (raw[j >> 1] << 16)); }

__device__ __forceinline__ void hgrn_local_task(char* smem, const bf16_t* __restrict__ proj, const float* __restrict__ hgrn_lb, int layer, float* __restrict__ HL, float* __restrict__ HD, int ch) {
    float* LF = (float*)smem; float* SEGT = LF + 64 * 65;
    bf16_t* sKd = (bf16_t*)(SEGT + 8 * 64); bf16_t* sV = sKd + 64 * TLD;
    const int tid = TIDX, lane = tid & 63, wave = tid >> 6, g = lane >> 4, li = lane & 15;
    const int bh = ch >> 5, n = ch & 31, b = bh >> 2, h = bh & 3;
    const bf16_t* prow = proj + (size_t)(b * SEQ + n * 64) * NP + h * 64;
    const int t = tid >> 3, k8 = (tid & 7) * 8;
    __syncthreads();
    *(u32x4*)(sV + t * TLD + k8) = *(const u32x4*)(prow + (size_t)t * NP + C_AI + k8);
    float kk[8];
    hgrn_scan(LF, SEGT, prow, hgrn_lb, layer, h, kk);
    { u32x4 o;
#pragma unroll
      for (int j = 0; j < 8; j += 2) {
          const float e0 = kk[j] * __expf(LF[63 * 65 + k8 + j] - LF[t * 65 + k8 + j]), e1 = kk[j + 1] * __expf(LF[63 * 65 + k8 + j + 1] - LF[t * 65 + k8 + j + 1]);
          o[j >> 1] = pk2(e0, e1);
      }
      *(u32x4*)(sKd + t * TLD + k8) = o; }
    if (tid < 64) HD[(size_t)ch * 64 + tid] = __expf(LF[63 * 65 + tid]);
    __syncthreads();
#pragma unroll
    for (int i = 0; i < 2; ++i) {
        const int idx = wave * 2 + i, vt = idx >> 2, kt = idx & 3;
        f32x4 acc = (f32x4){0.f, 0.f, 0.f, 0.f};
#pragma unroll
        for (int ks = 0; ks < 2; ++ks) acc = MFMA16(frag_cm(sV, TLD, ks * 32, vt * 16, lane), frag_cm(sKd, TLD, ks * 32, kt * 16, lane), acc);
        *(f32x4*)(HL + (size_t)ch * 4096 + (kt * 16 + li) * 64 + vt * 16 + 4 * g) = acc;
    }
}

__device__ __forceinline__ void hgrn_out_task(char* smem, const bf16_t* __restrict__ proj, const float* __restrict__ hgrn_lb, int layer, const bf16_t* __restrict__ HS,
                                              const float* __restrict__ mix_gain, bf16_t* __restrict__ y, int ch) {
    float* LF = (float*)smem; float* SEGT = LF + 64 * 65; float* sMS = SEGT + 8 * 64;
    bf16_t* sST = (bf16_t*)(sMS + 128); bf16_t* sQ0 = sST + 64 * TLD; bf16_t* sQm = sQ0 + 64 * TLD; bf16_t* sKm = sQm + 64 * TLD; bf16_t* sV = sKm + 64 * TLD; bf16_t* sA = sV + 64 * TLD;
    const int tid = TIDX, lane = tid & 63, wave = tid >> 6, g = lane >> 4, li = lane & 15;
    const int bh = ch >> 5, n = ch & 31, b = bh >> 2, h = bh & 3;
    const bf16_t* prow = proj + (size_t)(b * SEQ + n * 64) * NP + h * 64;
    const int t = tid >> 3, k8 = (tid & 7) * 8;
    __syncthreads();
    *(u32x4*)(sST + t * TLD + k8) = *(const u32x4*)(HS + (size_t)ch * 4096 + t * 64 + k8);
    const u32x4 qraw = *(const u32x4*)(prow + (size_t)t * NP + C_AQ + k8);
    *(u32x4*)(sV + t * TLD + k8) = *(const u32x4*)(prow + (size_t)t * NP + C_AI + k8);
    float kk[8];
    hgrn_scan(LF, SEGT, prow, hgrn_lb, layer, h, kk);
    { u32x4 o0, om, ok;
#pragma unroll
      for (int j = 0; j < 8; j += 2) {
          float q0v[2], qmv[2], kmv[2];
#pragma unroll
          for (int e = 0; e < 2; ++e) {
              const float bt = LF[t * 65 + k8 + j + e], r = LF[31 * 65 + k8 + j + e], q = siluf_(bfx(qraw, j + e));
              q0v[e] = q * __expf(bt); qmv[e] = q * __expf(bt - r); kmv[e] = kk[j + e] * __expf(r - bt);
          }
          o0[j >> 1] = pk2(q0v[0], q0v[1]); om[j >> 1] = pk2(qmv[0], qmv[1]); ok[j >> 1] = pk2(kmv[0], kmv[1]);
      }
      *(u32x4*)(sQ0 + t * TLD + k8) = o0; *(u32x4*)(sQm + t * TLD + k8) = om; *(u32x4*)(sKm + t * TLD + k8) = ok; }
    __syncthreads();
#pragma unroll
    for (int i = 0; i < 2; ++i) {
        const int idx = wave * 2 + i, tt = idx >> 2, st = idx & 3;
        f32x4 acc = (f32x4){0.f, 0.f, 0.f, 0.f};
#pragma unroll
        for (int ks = 0; ks < 2; ++ks) acc = MFMA16(frag_rm(sKm, TLD, st * 16, ks * 32, lane), frag_rm(sQm, TLD, tt * 16, ks * 32, lane), acc);
        const int tq = tt * 16 + li, s0 = st * 16 + 4 * g;
        uint2 o; o.x = pk2(s0 <= tq ? acc[0] : 0.f, s0 + 1 <= tq ? acc[1] : 0.f); o.y = pk2(s0 + 2 <= tq ? acc[2] : 0.f, s0 + 3 <= tq ? acc[3] : 0.f);
        *(uint2*)(sA + tq * TLD + s0) = o;
    }
    __syncthreads();
    { const int tt = wave >> 1;
      f32x4 oacc[2]; float ms = 0.f;
#pragma unroll
      for (int i = 0; i < 2; ++i) {
          const int vt = (wave & 1) * 2 + i;
          f32x4 acc = (f32x4){0.f, 0.f, 0.f, 0.f};
#pragma unroll
          for (int ks = 0; ks < 2; ++ks) acc = MFMA16(frag_cm(sST, TLD, ks * 32, vt * 16, lane), frag_rm(sQ0, TLD, tt * 16, ks * 32, lane), acc);
#pragma unroll
          for (int ks = 0; ks < 2; ++ks) acc = MFMA16(frag_cm(sV, TLD, ks * 32, vt * 16, lane), frag_rm(sA, TLD, tt * 16, ks * 32, lane), acc);
          oacc[i] = acc; ms += acc[0] * acc[0] + acc[1] * acc[1] + acc[2] * acc[2] + acc[3] * acc[3];
      }
      ms += __shfl_xor(ms, 16); ms += __shfl_xor(ms, 32);
      if (g == 0) sMS[(tt * 16 + li) * 2 + (wave & 1)] = ms;
      __syncthreads();
      const int tq = tt * 16 + li;
      const float rinv = rsqrtf((sMS[tq * 2] + sMS[tq * 2 + 1]) * (1.f / 64.f) + EPS);
      const size_t row = (size_t)(b * SEQ + n * 64 + tq);
#pragma unroll
      for (int i = 0; i < 2; ++i) {
          const int v0 = ((wave & 1) * 2 + i) * 16 + 4 * g;
          const uint2 graw = *(const uint2*)(proj + row * NP + C_AG + h * 64 + v0);
          const f32x4 mgv = *(const f32x4*)(mix_gain + C_AQ + h * 64 + v0);
          const float g0 = __uint_as_float(graw.x << 16), g1 = __uint_as_float(graw.x & 0xffff0000u), g2 = __uint_as_float(graw.y << 16), g3 = __uint_as_float(graw.y & 0xffff0000u);
          uint2 o; o.x = pk2(oacc[i][0] * rinv * siluf_(g0) * mgv[0], oacc[i][1] * rinv * siluf_(g1) * mgv[1]);
          o.y = pk2(oacc[i][2] * rinv * siluf_(g2) * mgv[2], oacc[i][3] * rinv * siluf_(g3) * mgv[3]);
          *(uint2*)(y + row * 1024 + h * 64 + v0) = o;
      }
    }
}


__device__ __forceinline__ void gdn_prep_task(char* smem, const bf16_t* __restrict__ proj, const float* __restrict__ gates, const float* __restrict__ conv_w  ,
                                              const float* __restrict__ a_log, const float* __restrict__ dt_bias, bf16_t* __restrict__ gt_all, float* __restrict__ glast, int ch) {
    float* sG = (float*)smem; float* sBeta = sG + 64;
    float* RHS = sBeta + 64;
    float* sM = RHS + 64 * 132;
    bf16_t* sK = (bf16_t*)(sM + 64 * 68); bf16_t* sQ = sK + 64 * TLD;
    const int tid = TIDX, lane = tid & 63, wave = tid >> 6, g = lane >> 4, li = lane & 15;
    const int bh = ch >> 5, n = ch & 31, b = bh >> 2, h = bh & 3;
    const int t = tid >> 3, d8 = (tid & 7) * 8;
    const size_t row0 = (size_t)(b * SEQ + n * 64);
    bf16_t* gt = gt_all + (size_t)ch * 5 * 4096;
    __syncthreads();
    float qn[8], kn[8], vv[8];
    {
        const int spos = n * 64 + t;
#pragma unroll
        for (int sec = 0; sec < 3; ++sec) {
            const int col = (sec == 0 ? C_DQ : (sec == 1 ? C_DK : C_DV)) + h * 64 + d8;
            float acc[8];
#pragma unroll
            for (int e = 0; e < 8; ++e) acc[e] = 0.f;
#pragma unroll
            for (int j = 0; j < 4; ++j) {
                if (spos - (3 - j) >= 0) {
                    const u32x4 raw = *(const u32x4*)(proj + (row0 + t - (3 - j)) * NP + col);
                    const f32x4 w0 = *(const f32x4*)(conv_w + j * 768 + sec * 256 + h * 64 + d8), w1 = *(const f32x4*)(conv_w + j * 768 + sec * 256 + h * 64 + d8 + 4);
#pragma unroll
                    for (int e = 0; e < 8; ++e) acc[e] += (e < 4 ? w0[e] : w1[e - 4]) * bfx(raw, e);
                }
            }
#pragma unroll
            for (int e = 0; e < 8; ++e) { const float sv = siluf_(acc[e]); if (sec == 0) qn[e] = sv; else if (sec == 1) kn[e] = sv; else vv[e] = sv; }
        }
        float sq = 0.f, sk = 0.f;
#pragma unroll
        for (int e = 0; e < 8; ++e) { sq += qn[e] * qn[e]; sk += kn[e] * kn[e]; }
        sq += __shfl_xor(sq, 1); sq += __shfl_xor(sq, 2); sq += __shfl_xor(sq, 4);
        sk += __shfl_xor(sk, 1); sk += __shfl_xor(sk, 2); sk += __shfl_xor(sk, 4);
        const float rq = rsqrtf(sq + EPS) * 0.125f, rk = rsqrtf(sk + EPS);
#pragma unroll
        for (int e = 0; e < 8; ++e) { qn[e] *= rq; kn[e] *= rk; }
    }
    if ((tid & 7) == 0) {
        const float* gr = gates + (row0 + t) * 16;
        sBeta[t] = sigmoidf_(gr[4 + h]);
        sG[t] = -__expf(a_log[h]) * softplusf_(gr[8 + h] + dt_bias[h]);
    }
    __syncthreads();
    if (wave == 0) {
        float v = sG[lane];
#pragma unroll
        for (int o = 1; o < 64; o <<= 1) { const float nb = __shfl_up(v, o); if (lane >= o) v += nb; }
        sG[lane] = v;
    }
    __syncthreads();
    {
        const float Gt = sG[t], Gl = sG[63], bt = sBeta[t];
        const float eG = __expf(Gt), eD = __expf(Gl - Gt);
        u32x4 ok, oq, oqd, okd;
#pragma unroll
        for (int e = 0; e < 8; e += 2) {
            ok[e >> 1] = pk2(kn[e], kn[e + 1]); oq[e >> 1] = pk2(qn[e], qn[e + 1]);
            oqd[e >> 1] = pk2(qn[e] * eG, qn[e + 1] * eG); okd[e >> 1] = pk2(kn[e] * eD, kn[e + 1] * eD);
        }
        *(u32x4*)(sK + t * TLD + d8) = ok; *(u32x4*)(sQ + t * TLD + d8) = oq;
        *(u32x4*)(gt + 2 * 4096 + t * 64 + d8) = oqd; *(u32x4*)(gt + 3 * 4096 + t * 64 + d8) = okd;
#pragma unroll
        for (int e = 0; e < 8; ++e) { RHS[t * 132 + d8 + e] = vv[e] * bt; RHS[t * 132 + 64 + d8 + e] = kn[e] * bt * eG; }
        if (tid == 0) glast[ch] = __expf(Gl);
    }
    __syncthreads();
#pragma unroll
    for (int i = 0; i < 2; ++i) {
        const int idx = wave * 2 + i, tt = idx >> 2, st = idx & 3;
        f32x4 am = (f32x4){0.f, 0.f, 0.f, 0.f}, aq = (f32x4){0.f, 0.f, 0.f, 0.f};
#pragma unroll
        for (int ks = 0; ks < 2; ++ks) {
            const bf16x8 kfs = frag_rm(sK, TLD, st * 16, ks * 32, lane), kft = frag_rm(sK, TLD, tt * 16, ks * 32, lane);
            am = MFMA16(kft, kfs, am);
            aq = MFMA16(kfs, frag_rm(sQ, TLD, tt * 16, ks * 32, lane), aq);
        }
        {   const int sx = st * 16 + li, t0 = tt * 16 + 4 * g; const float Gs = sG[sx];
            f32x4 mo;
#pragma unroll
            for (int r = 0; r < 4; ++r) { const int tq = t0 + r; mo[r] = (sx < tq) ? sBeta[tq] * am[r] * __expf(sG[tq] - Gs) : 0.f; }
            *(f32x4*)(sM + sx * 68 + t0) = mo; }
        {   const int tq = tt * 16 + li, s0 = st * 16 + 4 * g; const float Gt = sG[tq];
            float ao[4];
#pragma unroll
            for (int r = 0; r < 4; ++r) { const int sx = s0 + r; ao[r] = (sx <= tq) ? aq[r] * __expf(Gt - sG[sx]) : 0.f; }
            uint2 o; o.x = pk2(ao[0], ao[1]); o.y = pk2(ao[2], ao[3]);
            *(uint2*)(gt + 4 * 4096 + tq * 64 + s0) = o; }
    }
    __syncthreads();
    if (tid < 128) {
        float acc[64];
#pragma unroll
        for (int i = 0; i < 64; ++i) acc[i] = RHS[i * 132 + tid];
#pragma unroll
        for (int half = 0; half < 2; ++half) {
            const int base = half * 32;
            if (half == 1) {
#pragma unroll
                for (int sx = 0; sx < 32; sx += 2) {
                    f32x4 r0[8], r1[8];
#pragma unroll
                    for (int c = 0; c < 8; ++c) { r0[c] = *(const f32x4*)(sM + sx * 68 + 32 + c * 4); r1[c] = *(const f32x4*)(sM + (sx + 1) * 68 + 32 + c * 4); }
                    const float x0 = acc[sx], x1 = acc[sx + 1];
#pragma unroll
                    for (int tq = 0; tq < 32; ++tq) { acc[32 + tq] -= r0[tq >> 2][tq & 3] * x0; acc[32 + tq] -= r1[tq >> 2][tq & 3] * x1; }
                }
            }
            f32x4 cur[8];
#pragma unroll
            for (int c = 0; c < 8; ++c) cur[c] = *(const f32x4*)(sM + base * 68 + base + c * 4);
#pragma unroll
            for (int sx = 0; sx < 31; ++sx) {
                f32x4 nxt[8];
#pragma unroll
                for (int c = (sx + 2) >> 2; c < 8; ++c) nxt[c] = *(const f32x4*)(sM + (base + sx + 1) * 68 + base + c * 4);
                const float xs = acc[base + sx];
#pragma unroll
                for (int tq = sx + 1; tq < 32; ++tq) acc[base + tq] -= cur[tq >> 2][tq & 3] * xs;
#pragma unroll
                for (int c = (sx + 2) >> 2; c < 8; ++c) cur[c] = nxt[c];
            }
        }
        if (tid < 64) {
#pragma unroll
            for (int tt = 0; tt < 64; ++tt) gt[tt * 64 + tid] = f2bf(acc[tt]);
        } else {
#pragma unroll
            for (int tt = 0; tt < 64; ++tt) gt[4096 + tt * 64 + (tid - 64)] = f2bf(-acc[tt]);
        }
    }
}

__device__ __forceinline__ void gdn_scan_task(char* smem, const bf16_t* __restrict__ gt_all, const float* __restrict__ glast, const bf16_t* __restrict__ proj, const float* __restrict__ mix_gain,
                                              bf16_t* __restrict__ y, int bh) {
    bf16_t* sT = (bf16_t*)smem;
    bf16_t* sST = sT + 2 * 5 * 64 * TLD;
    bf16_t* sVn = sST + 2 * 64 * TLD;
    const int tid = TIDX, lane = tid & 63, wave = tid >> 6, g = lane >> 4, li = lane & 15;
    const int b = bh >> 2, h = bh & 3;
    const int sr = tid >> 3, sc8 = (tid & 7) * 8;
    const bf16_t* gsrc = gt_all + (size_t)bh * 32 * 5 * 4096 + sr * 64 + sc8;
    __syncthreads();
    u32x4 regs[5];
#pragma unroll
    for (int i = 0; i < 5; ++i) regs[i] = *(const u32x4*)(gsrc + i * 4096);
#pragma unroll
    for (int i = 0; i < 5; ++i) *(u32x4*)(sT + i * 64 * TLD + sr * TLD + sc8) = regs[i];
    *(u32x4*)(sST + sr * TLD + sc8) = (u32x4){0u, 0u, 0u, 0u};
    f32x4 sacc[4];
#pragma unroll
    for (int i = 0; i < 4; ++i) sacc[i] = (f32x4){0.f, 0.f, 0.f, 0.f};
    __syncthreads();
    for (int n = 0; n < 32; ++n) {
        const int buf = n & 1;
        const bf16_t* cT = sT + buf * 5 * 64 * TLD;
        const bf16_t* sU = cT; const bf16_t* sWn = cT + 64 * TLD; const bf16_t* sQd = cT + 2 * 64 * TLD; const bf16_t* sKd = cT + 3 * 64 * TLD; const bf16_t* sAq = cT + 4 * 64 * TLD;
        const bf16_t* cST = sST + buf * 64 * TLD; bf16_t* nST = sST + (buf ^ 1) * 64 * TLD;
        if (n + 1 < 32) {
#pragma unroll
            for (int i = 0; i < 5; ++i) regs[i] = *(const u32x4*)(gsrc + (size_t)(n + 1) * 5 * 4096 + i * 4096);
        }
        const size_t rowz = (size_t)(b * SEQ + n * 64 + (wave & 3) * 16 + li);
        uint2 zraw[4];
        if (wave < 4) {
#pragma unroll
            for (int vt = 0; vt < 4; ++vt) zraw[vt] = *(const uint2*)(proj + rowz * NP + C_DZ + h * 64 + vt * 16 + 4 * g);
        }
#pragma unroll
        for (int i = 0; i < 2; ++i) {
            const int idx = wave * 2 + i, tt = idx >> 2, vt = idx & 3;
            const int tq = tt * 16 + li, v0 = vt * 16 + 4 * g;
            const uint2 uraw = *(const uint2*)(sU + tq * TLD + v0);
            f32x4 acc = (f32x4){__uint_as_float(uraw.x << 16), __uint_as_float(uraw.x & 0xffff0000u), __uint_as_float(uraw.y << 16), __uint_as_float(uraw.y & 0xffff0000u)};
#pragma unroll
            for (int ks = 0; ks < 2; ++ks) acc = MFMA16(frag_rm(cST, TLD, vt * 16, ks * 32, lane), frag_rm(sWn, TLD, tt * 16, ks * 32, lane), acc);
            uint2 o; o.x = pk2(acc[0], acc[1]); o.y = pk2(acc[2], acc[3]);
            *(uint2*)(sVn + tq * TLD + v0) = o;
        }
        __syncthreads();
        if (wave < 4) {
            const int tt = wave;
            f32x4 oacc[4]; float ms = 0.f;
#pragma unroll
            for (int vt = 0; vt < 4; ++vt) {
                f32x4 acc = (f32x4){0.f, 0.f, 0.f, 0.f};
#pragma unroll
                for (int ks = 0; ks < 2; ++ks) acc = MFMA16(frag_rm(cST, TLD, vt * 16, ks * 32, lane), frag_rm(sQd, TLD, tt * 16, ks * 32, lane), acc);
#pragma unroll
                for (int ks = 0; ks < 2; ++ks) acc = MFMA16(frag_cm(sVn, TLD, ks * 32, vt * 16, lane), frag_rm(sAq, TLD, tt * 16, ks * 32, lane), acc);
                oacc[vt] = acc; ms += acc[0] * acc[0] + acc[1] * acc[1] + acc[2] * acc[2] + acc[3] * acc[3];
            }
            ms += __shfl_xor(ms, 16); ms += __shfl_xor(ms, 32);
            const float rinv = rsqrtf(ms * (1.f / 64.f) + EPS);
#pragma unroll
            for (int vt = 0; vt < 4; ++vt) {
                const int v0 = vt * 16 + 4 * g;
                const f32x4 mgv = *(const f32x4*)(mix_gain + 768 + h * 64 + v0);
                const float z0 = __uint_as_float(zraw[vt].x << 16), z1 = __uint_as_float(zraw[vt].x & 0xffff0000u), z2 = __uint_as_float(zraw[vt].y << 16), z3 = __uint_as_float(zraw[vt].y & 0xffff0000u);
                uint2 o; o.x = pk2(oacc[vt][0] * rinv * siluf_(z0) * mgv[0], oacc[vt][1] * rinv * siluf_(z1) * mgv[1]);
                o.y = pk2(oacc[vt][2] * rinv * siluf_(z2) * mgv[2], oacc[vt][3] * rinv * siluf_(z3) * mgv[3]);
                *(uint2*)(y + rowz * 1024 + 768 + h * 64 + v0) = o;
            }
        } else {
            const int kt = wave - 4;
            const float gl = glast[bh * 32 + n];
#pragma unroll
            for (int vt = 0; vt < 4; ++vt) {
                f32x4 acc = sacc[vt] * gl;
#pragma unroll
                for (int ks = 0; ks < 2; ++ks) acc = MFMA16(frag_cm(sKd, TLD, ks * 32, kt * 16, lane), frag_cm(sVn, TLD, ks * 32, vt * 16, lane), acc);
                sacc[vt] = acc;
                uint2 o; o.x = pk2(acc[0], acc[1]); o.y = pk2(acc[2], acc[3]);
                *(uint2*)(nST + (vt * 16 + li) * TLD + kt * 16 + 4 * g) = o;
            }
        }
        if (n + 1 < 32) {
            bf16_t* nT = sT + (buf ^ 1) * 5 * 64 * TLD;
#pragma unroll
            for (int i = 0; i < 5; ++i) *(u32x4*)(nT + i * 64 * TLD + sr * TLD + sc8) = regs[i];
        }
        __syncthreads();
    }
}


constexpr int XLD = 264;
__device__ __forceinline__ void lru_local_task(char* smem, const bf16_t* __restrict__ proj, const float* __restrict__ conv_w, const float* __restrict__ conv_b,
                                               const float* __restrict__ w_a, const float* __restrict__ b_a, const float* __restrict__ w_x, const float* __restrict__ b_x,
                                               const float* __restrict__ lam, float* __restrict__ hl_out, float* __restrict__ ac_out, float* __restrict__ lsum, int task) {
    bf16_t* sX = (bf16_t*)smem;
    bf16_t* sW = sX + 64 * XLD;
    const int tid = TIDX, lane = tid & 63, wave = tid >> 6, g = lane >> 4, li = lane & 15;
    const int b = task >> 5, n = task & 31;
    const size_t row0 = (size_t)(b * SEQ + n * 64);
    const int t = tid >> 3;
    __syncthreads();
    {
        const int i = tid >> 3, j8 = (tid & 7) * 8;
#pragma unroll
        for (int mat = 0; mat < 8; ++mat) {
            const float* src = ((mat & 1) ? w_x : w_a) + (size_t)(mat >> 1) * 4096 + i * 64 + j8;
            const f32x4 v0 = *(const f32x4*)src, v1 = *(const f32x4*)(src + 4);
            u32x4 o; o[0] = pk2(v0[0], v0[1]); o[1] = pk2(v0[2], v0[3]); o[2] = pk2(v1[0], v1[1]); o[3] = pk2(v1[2], v1[3]);
            *(u32x4*)(sW + mat * 64 * TLD + i * TLD + j8) = o;
        }
    }
    {
        const int spos = n * 64 + t;
#pragma unroll
        for (int i = 0; i < 4; ++i) {
            const int c8 = ((tid & 7) + 8 * i) * 8;
            float acc[8];
            { const f32x4 cb0 = *(const f32x4*)(conv_b + c8), cb1 = *(const f32x4*)(conv_b + c8 + 4);
#pragma unroll
              for (int e = 0; e < 8; ++e) acc[e] = e < 4 ? cb0[e] : cb1[e - 4]; }
#pragma unroll
            for (int j = 0; j < 4; ++j) {
                if (spos - (3 - j) >= 0) {
                    const u32x4 raw = *(const u32x4*)(proj + (row0 + t - (3 - j)) * NP + C_CX + c8);
                    const f32x4 w0 = *(const f32x4*)(conv_w + j * 256 + c8), w1 = *(const f32x4*)(conv_w + j * 256 + c8 + 4);
#pragma unroll
                    for (int e = 0; e < 8; ++e) acc[e] += (e < 4 ? w0[e] : w1[e - 4]) * bfx(raw, e);
                }
            }
            u32x4 o; o[0] = pk2(acc[0], acc[1]); o[1] = pk2(acc[2], acc[3]); o[2] = pk2(acc[4], acc[5]); o[3] = pk2(acc[6], acc[7]);
            *(u32x4*)(sX + t * XLD + c8) = o;
        }
    }
    __syncthreads();
    const int hh = wave >> 1;
#pragma unroll
    for (int j2 = 0; j2 < 2; ++j2) {
        const int jt = (wave & 1) * 2 + j2, cl = jt * 16 + 4 * g, c = hh * 64 + cl;
        f32x4 ra[4], rx[4];
#pragma unroll
        for (int tt = 0; tt < 4; ++tt) { ra[tt] = (f32x4){0.f, 0.f, 0.f, 0.f}; rx[tt] = (f32x4){0.f, 0.f, 0.f, 0.f}; }
#pragma unroll
        for (int ks = 0; ks < 2; ++ks) {
            const bf16x8 wa = frag_cm(sW + (hh * 2) * 64 * TLD, TLD, ks * 32, jt * 16, lane), wx = frag_cm(sW + (hh * 2 + 1) * 64 * TLD, TLD, ks * 32, jt * 16, lane);
#pragma unroll
            for (int tt = 0; tt < 4; ++tt) {
                const bf16x8 xf = frag_rm(sX + hh * 64, XLD, tt * 16, ks * 32, lane);
                ra[tt] = MFMA16(wa, xf, ra[tt]);
                rx[tt] = MFMA16(wx, xf, rx[tt]);
            }
        }
        const f32x4 ba = *(const f32x4*)(b_a + c), bx = *(const f32x4*)(b_x + c), lm = *(const f32x4*)(lam + c);
        float sp[4];
#pragma unroll
        for (int r = 0; r < 4; ++r) sp[r] = softplusf_(-lm[r]);
        f32x4 cA = (f32x4){1.f, 1.f, 1.f, 1.f}, cH = (f32x4){0.f, 0.f, 0.f, 0.f};
#pragma unroll
        for (int tt = 0; tt < 4; ++tt) {
            const int tq = tt * 16 + li;
            const uint2 xraw = *(const uint2*)(sX + tq * XLD + c);
            const float xc[4] = {__uint_as_float(xraw.x << 16), __uint_as_float(xraw.x & 0xffff0000u), __uint_as_float(xraw.y << 16), __uint_as_float(xraw.y & 0xffff0000u)};
            f32x4 A, H;
#pragma unroll
            for (int r = 0; r < 4; ++r) {
                const float rr = sigmoidf_(ra[tt][r] + ba[r]), ig = sigmoidf_(rx[tt][r] + bx[r]);
                const float log_a = -8.f * rr * sp[r];
                A[r] = __expf(log_a);
                H[r] = sqrtf(-expm1f(2.f * log_a)) * (ig * xc[r]);
            }
#pragma unroll
            for (int o = 1; o < 16; o <<= 1) {
#pragma unroll
                for (int r = 0; r < 4; ++r) {
                    const float pA = __shfl_up(A[r], o, 16), pH = __shfl_up(H[r], o, 16);
                    if (li >= o) { H[r] = A[r] * pH + H[r]; A[r] = A[r] * pA; }
                }
            }
            const f32x4 Hf = H + A * cH, Af = A * cA;
            const size_t oidx = (row0 + tq) * 256 + c;
            *(f32x4*)(hl_out + oidx) = Hf; *(f32x4*)(ac_out + oidx) = Af;
#pragma unroll
            for (int r = 0; r < 4; ++r) { cH[r] = __shfl(Hf[r], 15, 16); cA[r] = __shfl(Af[r], 15, 16); }
            if (tt == 3 && li == 15) { *(f32x4*)(lsum + (size_t)task * 256 + c) = Af; *(f32x4*)(lsum + (size_t)(256 + task) * 256 + c) = Hf; }
        }
    }
}
__device__ __forceinline__ void lru_out_task(const float* __restrict__ hl_in, const float* __restrict__ ac_in, const float* __restrict__ lsum, const bf16_t* __restrict__ proj,
                                             const float* __restrict__ mix_gain, bf16_t* __restrict__ y, int task) {
    const int b = task >> 5, n = task & 31, c = TIDX & 255, half = TIDX >> 8;
    const float Hc = lsum[(size_t)task * 256 + c];
    const float mg = mix_gain[512 + c];
    const size_t row0 = (size_t)(b * SEQ + n * 64 + half * 32);
#pragma unroll
    for (int i0 = 0; i0 < 32; i0 += 16) {
        float hv[16], av[16]; bf16_t gv[16];
#pragma unroll
        for (int i = 0; i < 16; ++i) { const size_t row = row0 + i0 + i; hv[i] = hl_in[row * 256 + c]; av[i] = ac_in[row * 256 + c]; gv[i] = proj[row * NP + C_CG + c]; }
#pragma unroll
        for (int i = 0; i < 16; ++i) {
            const size_t row = row0 + i0 + i;
            const float yv = (hv[i] + av[i] * Hc) * geluf_(bf2f(gv[i]));
            const float ms = wave_sum(yv * yv) * (1.f / 64.f);
            y[row * 1024 + 512 + c] = f2bf(yv * rsqrtf(ms + EPS) * mg);
        }
    }
}


__device__ __forceinline__ void state_scan_phase(const float* __restrict__ HL, const float* __restrict__ HD, bf16_t* __restrict__ HS, const float* __restrict__ lsum, float* __restrict__ lcar) {
    const int bx = blockIdx.x, tid = TIDX;
    for (int u = bx; u < 128 + 4; u += gridDim.x) {
        if (u < 128) {
            const int gid = u * NTHR + tid, bh = gid >> 11, v = gid & 63, kp = (gid >> 6) & 31;
            const float* Lb = HL + (size_t)bh * 32 * 4096 + (2 * kp) * 64 + v; const float* Db = HD + (size_t)bh * 32 * 64 + 2 * kp;
            bf16_t* Sb = HS + (size_t)bh * 32 * 4096 + (2 * kp) * 64 + v;
            float S0 = 0.f, S1 = 0.f;
            for (int n0 = 0; n0 < 32; n0 += 8) {
                float l0[8], l1[8], d0[8], d1[8];
#pragma unroll
                for (int i = 0; i < 8; ++i) { l0[i] = Lb[(size_t)(n0 + i) * 4096]; l1[i] = Lb[(size_t)(n0 + i) * 4096 + 64]; d0[i] = Db[(n0 + i) * 64]; d1[i] = Db[(n0 + i) * 64 + 1]; }
#pragma unroll
                for (int i = 0; i < 8; ++i) {
                    Sb[(size_t)(n0 + i) * 4096] = f2bf(S0); Sb[(size_t)(n0 + i) * 4096 + 64] = f2bf(S1);
                    S0 = d0[i] * S0 + l0[i]; S1 = d1[i] * S1 + l1[i];
                }
            }
        } else {
            const int gid = (u - 128) * NTHR + tid, b = gid >> 8, c = gid & 255;
            float A[32], H[32];
#pragma unroll
            for (int n = 0; n < 32; ++n) { A[n] = lsum[(size_t)(b * 32 + n) * 256 + c]; H[n] = lsum[(size_t)(256 + b * 32 + n) * 256 + c]; }
            float Hc = 0.f;
#pragma unroll
            for (int n = 0; n < 32; ++n) { lcar[(size_t)(b * 32 + n) * 256 + c] = Hc; Hc = A[n] * Hc + H[n]; }
        }
    }
}

__device__ __forceinline__ void router_phase(char* smem, const float* __restrict__ x, const float* __restrict__ g, const bf16_t* __restrict__ wr  , const float* __restrict__ b_rg,
                                             const float* __restrict__ b_re, const float* __restrict__ pss, int* __restrict__ cnt, int* __restrict__ list, float* __restrict__ pgate) {
    bf16_t* sXh = (bf16_t*)smem;
    bf16_t* sXl = sXh + 64 * TLD;
    float* sLog = (float*)(sXl + 64 * TLD);
    const int tid = TIDX, lane = tid & 63, wave = tid >> 6, gq = lane >> 4, li = lane & 15;
    const int mt = wave & 3, kh = wave >> 2;
    const int stok = tid >> 3, c8 = (tid & 7) * 8;
    BLK_LOOP(tile, T / 64) {
        const int t0 = tile * 64;
        f32x4 acc[3];
#pragma unroll
        for (int n = 0; n < 3; ++n) acc[n] = (f32x4){0.f, 0.f, 0.f, 0.f};
        const float* xp = x + (size_t)(t0 + stok) * 1024 + c8;
        const bf16_t* wp = wr + (size_t)li * 1024 + kh * 32 + gq * 8;
        f32x4 x0 = *(const f32x4*)xp, x1 = *(const f32x4*)(xp + 4);
        u32x4 wh[3], wl[3];
#pragma unroll
        for (int n = 0; n < 3; ++n) { wh[n] = *(const u32x4*)(wp + n * 16 * 1024); wl[n] = *(const u32x4*)(wp + 48 * 1024 + n * 16 * 1024); }
        for (int kc = 0; kc < 16; ++kc) {
            const f32x4 g0 = *(const f32x4*)(g + kc * 64 + c8), g1 = *(const f32x4*)(g + kc * 64 + c8 + 4);
            const f32x4 v0 = x0 * g0, v1 = x1 * g1;
            u32x4 oh, ol;
#pragma unroll
            for (int j = 0; j < 2; ++j) {
                const unsigned h0 = pk2(v0[2 * j], v0[2 * j + 1]), h1 = pk2(v1[2 * j], v1[2 * j + 1]);
                oh[j] = h0; oh[2 + j] = h1;
                ol[j] = pk2(v0[2 * j] - __uint_as_float(h0 << 16), v0[2 * j + 1] - __uint_as_float(h0 & 0xffff0000u));
                ol[2 + j] = pk2(v1[2 * j] - __uint_as_float(h1 << 16), v1[2 * j + 1] - __uint_as_float(h1 & 0xffff0000u));
            }
            __syncthreads();
            *(u32x4*)(sXh + stok * TLD + c8) = oh; *(u32x4*)(sXl + stok * TLD + c8) = ol;
            __syncthreads();
            u32x4 cwh[3], cwl[3];
#pragma unroll
            for (int n = 0; n < 3; ++n) { cwh[n] = wh[n]; cwl[n] = wl[n]; }
            if (kc + 1 < 16) {
                x0 = *(const f32x4*)(xp + (kc + 1) * 64); x1 = *(const f32x4*)(xp + (kc + 1) * 64 + 4);
#pragma unroll
                for (int n = 0; n < 3; ++n) { wh[n] = *(const u32x4*)(wp + n * 16 * 1024 + (kc + 1) * 64); wl[n] = *(const u32x4*)(wp + 48 * 1024 + n * 16 * 1024 + (kc + 1) * 64); }
            }
            const bf16x8 xh = frag_rm(sXh, TLD, mt * 16, kh * 32, lane), xl = frag_rm(sXl, TLD, mt * 16, kh * 32, lane);
#pragma unroll
            for (int n = 0; n < 3; ++n) {
                const bf16x8 fh = __builtin_bit_cast(bf16x8, cwh[n]), fl = __builtin_bit_cast(bf16x8, cwl[n]);
                acc[n] = MFMA16(fh, xh, acc[n]);
                acc[n] = MFMA16(fl, xh, acc[n]);
                acc[n] = MFMA16(fh, xl, acc[n]);
            }
        }
#pragma unroll
        for (int n = 0; n < 3; ++n) *(f32x4*)(sLog + (kh * 64 + mt * 16 + li) * 48 + n * 16 + 4 * gq) = acc[n];
        __syncthreads();
        int* sCnt = (int*)(sLog + 2 * 64 * 48);
        if (tid < 64) sCnt[tid] = 0;
        __syncthreads();
        int ex0 = 0, ex1 = 0, lr0 = 0, lr1 = 0; float gw0 = 0.f, gw1 = 0.f;
        if (tid < 64) {
            const float rinv = rinv_from_pss(pss, (size_t)(t0 + tid));
            const float* l0 = sLog + tid * 48; const float* l1 = sLog + (64 + tid) * 48;
            float lg[4];
#pragma unroll
            for (int i = 0; i < 4; ++i) lg[i] = (l0[i] + l1[i]) * rinv + b_rg[i];
            int gs = 0; float gm = lg[0];
#pragma unroll
            for (int i = 1; i < 4; ++i) if (lg[i] > gm) { gm = lg[i]; gs = i; }
            float den = 0.f;
#pragma unroll
            for (int i = 0; i < 4; ++i) den += __expf(lg[i] - gm);
            const float pg = 1.f / den;
            int i0 = 0, i1 = -1; float m0 = -INFINITY, m1 = -INFINITY;
            for (int i = 0; i < 8; ++i) {
                const float v = (l0[4 + gs * 8 + i] + l1[4 + gs * 8 + i]) * rinv + b_re[gs * 8 + i];
                if (v > m0) { m1 = m0; i1 = i0; m0 = v; i0 = i; } else if (v > m1) { m1 = v; i1 = i; }
            }
            const float e1 = __expf(m1 - m0);
            gw0 = pg / (1.f + e1); gw1 = pg * e1 / (1.f + e1);
            ex0 = gs * 8 + i0; ex1 = gs * 8 + i1;
            lr0 = atomicAdd(&sCnt[ex0], 1); lr1 = atomicAdd(&sCnt[ex1], 1);
        }
        __syncthreads();
        if (tid < 32) { const int c = sCnt[tid]; sCnt[32 + tid] = c ? atomicAdd(&cnt[tid * CNT_STRIDE], c) : 0; }
        __syncthreads();
        if (tid < 64) {
            const int t = t0 + tid;
            list[(size_t)ex0 * T + sCnt[32 + ex0] + lr0] = 2 * t; pgate[2 * t] = gw0;
            list[(size_t)ex1 * T + sCnt[32 + ex1] + lr1] = 2 * t + 1; pgate[2 * t + 1] = gw1;
        }
        __syncthreads();
    }
}

__device__ __forceinline__ void combine_phase(const float* x2, const bf16_t* __restrict__ eo, const float* __restrict__ g, float* xout, bf16_t* __restrict__ hn, int mode) {
    const int lane = TIDX & 63;
    for (int t = blockIdx.x * 8 + (TIDX >> 6); t < T; t += gridDim.x * 8) {
        f32x4 v[4]; float s = 0.f;
#pragma unroll
        for (int j = 0; j < 4; ++j) {
            const int c = (lane + 64 * j) * 4;
            v[j] = *(const f32x4*)(x2 + (size_t)t * 1024 + c);
            const uint2 e0 = *(const uint2*)(eo + (size_t)(2 * t) * 1024 + c), e1 = *(const uint2*)(eo + (size_t)(2 * t + 1) * 1024 + c);
            v[j].x += __uint_as_float(e0.x << 16) + __uint_as_float(e1.x << 16);
            v[j].y += __uint_as_float(e0.x & 0xffff0000u) + __uint_as_float(e1.x & 0xffff0000u);
            v[j].z += __uint_as_float(e0.y << 16) + __uint_as_float(e1.y << 16);
            v[j].w += __uint_as_float(e0.y & 0xffff0000u) + __uint_as_float(e1.y & 0xffff0000u);
            s += v[j].x * v[j].x + v[j].y * v[j].y + v[j].z * v[j].z + v[j].w * v[j].w;
        }
        const float rinv = rsqrtf(wave_sum(s) * (1.f / 1024.f) + EPS);
#pragma unroll
        for (int j = 0; j < 4; ++j) {
            const int c = (lane + 64 * j) * 4;
            const f32x4 gg = *(const f32x4*)(g + c);
            const f32x4 hv = v[j] * rinv * gg;
            if (mode == 0) {
                *(f32x4*)(xout + (size_t)t * 1024 + c) = v[j];
                uint2 o; o.x = pk2(hv.x, hv.y); o.y = pk2(hv.z, hv.w);
                *(uint2*)(hn + (size_t)t * 1024 + c) = o;
            } else {
                *(f32x4*)(xout + (size_t)t * 1024 + c) = hv;
            }
        }
    }
}

template <int l>
__device__ __forceinline__ void layer_body(const Params& P, char* smem, const XcdBarrier& xb, const float* xcur) {
    char* ws = P.ws;
    bf16_t* Wt_in = (bf16_t*)(ws + OFF_WIN); bf16_t* Wt_out = (bf16_t*)(ws + OFF_WOUT); bf16_t* Wt_mq = (bf16_t*)(ws + OFF_WMQ); bf16_t* Wt_mkv = (bf16_t*)(ws + OFF_WMKV);
    bf16_t* Wt_mo = (bf16_t*)(ws + OFF_WMO); bf16_t* Wt_gu = (bf16_t*)(ws + OFF_WGU); bf16_t* Wt_dn = (bf16_t*)(ws + OFF_WDN);
    bf16_t* hn = (bf16_t*)(ws + OFF_HN); bf16_t* proj = (bf16_t*)(ws + OFF_PROJ); float* gates = (float*)(ws + OFF_GATES); bf16_t* y = (bf16_t*)(ws + OFF_Y);
    float* XA = P.out; float* XB = (float*)(ws + OFF_XB);
    bf16_t* qm = (bf16_t*)(ws + OFF_QM); bf16_t* om = (bf16_t*)(ws + OFF_OM); bf16_t* kvm = (bf16_t*)(ws + OFF_KVM); bf16_t* memn = (bf16_t*)(ws + OFF_MEMN);
    float* foxc = (float*)(ws + OFF_FOXC); float* lrua = (float*)(ws + OFF_LRUA); float* lruu = (float*)(ws + OFF_LRUU);
    int* cnt_all = (int*)(ws + OFF_CTL) + CTL_CNT_WORD; int* list = (int*)(ws + OFF_LIST); float* pgate = (float*)(ws + OFF_PGATE);
    bf16_t* act = (bf16_t*)(ws + OFF_ACT); bf16_t* eo = (bf16_t*)(ws + OFF_EO); float* pss = (float*)(ws + OFF_PSS);
    const int wave = TIDX >> 6, lane = TIDX & 63;


        float* x1 = (l == 0) ? XA : XB;
        float* x2 = (l == 0) ? XB : XA;
        int* cnt = cnt_all + 32 * CNT_STRIDE * l;
        const float* mg = P.in[I_MIX_GAIN] + l * 1024;
        REP(2, { pg8::Gemm g{hn, Wt_in + (size_t)l * NP * 1024, T, NP, 1024}; pg8::StaticOrder S; S.init(T, NP, (int)gridDim.x, (int)blockIdx.x);
                 pg8::EpiInProj E{proj, NP, gates, C_GATE};
                 pg8::gemm_phase<pg8::EpiInProj, pg8::StaticOrder, true, true>((PG8_LAS unsigned char*)smem, g, S, E); });
        if (l == 0) for (int l2 = 0; l2 < NL; ++l2)
            gemm_phase<EPI_BF16>(smem, memn + (size_t)l2 * 2048 * 1024, 1024, Wt_mkv + (size_t)l2 * 512 * 1024, 1024, 2048, 512, 1024, kvm + (size_t)l2 * 2048 * 512, 512, nullptr, nullptr,
                                 (gridDim.x >= 192) ? ((int)blockIdx.x - 128 - 32 * l2) : (int)blockIdx.x, (gridDim.x >= 192) ? 4096 : (int)gridDim.x);
        GSYNC();
        REP(4,         {
            const int bx = blockIdx.x;
            bf16_t* gtiles = (bf16_t*)(ws + OFF_GDN); float* glast = (float*)(ws + OFF_GLAST);
            if (bx < 32 && wave == 1) fox_cumsum(gates, P.in[I_FOX_FB] + l * 4, foxc, bx, lane);
            BLK_LOOP(ch, 1024) gdn_prep_task(smem, proj, gates, P.in[I_GDN_CONV_W] + l * 4 * 768, P.in[I_GDN_A_LOG] + l * 4, P.in[I_GDN_DT_BIAS] + l * 4, gtiles, glast, ch);
            BLK_LOOP(ch, 1024) hgrn_local_task(smem, proj, P.in[I_HGRN_LB], l, (float*)(ws + OFF_HL), (float*)(ws + OFF_HD), ch);
            BLK_LOOP(task, 256) lru_local_task(smem, proj, P.in[I_LRU_CONV_W] + l * 1024, P.in[I_LRU_CONV_B] + l * 256, P.in[I_LRU_WA] + l * 16384, P.in[I_LRU_BA] + l * 256,
                                               P.in[I_LRU_WX] + l * 16384, P.in[I_LRU_BX] + l * 256, P.in[I_LRU_LAM] + l * 256, lrua, lruu, (float*)(ws + OFF_LSUM), task);
        });
        GSYNC();
        state_scan_phase((const float*)(ws + OFF_HL), (const float*)(ws + OFF_HD), (bf16_t*)(ws + OFF_HS), (const float*)(ws + OFF_LSUM), (float*)(ws + OFF_LCAR));
        GSYNC();
        REP(8,         {
            const int natt = (SEQ / 128) * 4 * NB;
            const int bx = blockIdx.x, nfree = (int)gridDim.x - 32;
            if (bx < 32) gdn_scan_task(smem, (const bf16_t*)(ws + OFF_GDN), (const float*)(ws + OFF_GLAST), proj, mg, y, bx);
            else {
                for (int r = 0; r * nfree < natt; ++r) {
                    const int i = r * nfree + ((r & 1) ? (nfree - 1 - (bx - 32)) : (bx - 32));
                    if (i >= natt) continue;
                    const int qt = 15 - (i >> 5), bh = i & 31;
                    attn_task(smem, proj + C_BQ, NP, proj + C_BK, NP, proj + C_BV, NP, foxc, SEQ, SEQ, 1, 0.125f, y + 256, 1024, mg + 256, 1, (bh * 16) + qt);
                }
                for (int i = bx - 32; i < 1024; i += nfree) {
                    const int ch = (i & 31) * 32 + (31 - (i >> 5));
                    hgrn_out_task(smem, proj, P.in[I_HGRN_LB], l, (const bf16_t*)(ws + OFF_HS), mg, y, ch);
                }
                for (int i = bx - 32; i < 256; i += nfree) lru_out_task(lrua, lruu, (const float*)(ws + OFF_LCAR), proj, mg, y, i);
            }
        });
        GSYNC();
        REP(16, { pg8::Gemm g{y, Wt_out + (size_t)l * 1024 * 1024, T, 1024, 1024}; pg8::StaticOrder S; S.init(T, 1024, (int)gridDim.x, (int)blockIdx.x);
                  pg8::EpiResidNorm E{xcur, x1, 1024, P.in[I_NORM_MEM] + l * 1024, hn, pss};
                  pg8::gemm_phase<pg8::EpiResidNorm, pg8::StaticOrder, true, true>((PG8_LAS unsigned char*)smem, g, S, E); });
        GSYNC();
        REP(64, gemm_phase<EPI_BF16_RS>(smem, hn, 1024, Wt_mq + (size_t)l * 256 * 1024, 1024, T, 256, 1024, qm, 256, pss, nullptr));
        GSYNC();
        { const bf16_t* kv = kvm + (size_t)l * 2048 * 512;
          REP(128, BLK_LOOP(task, (SEQ / 128) * 4 * NB) attn_task(smem, qm, 256, kv, 512, kv + 256, 512, nullptr, SEQ, MEMLEN, 0, 0.125f, om, 256, nullptr, 0, task)); }
        GSYNC();
        REP(256, gemm_phase<EPI_RESID_NORM>(smem, om, 256, Wt_mo + (size_t)l * 1024 * 256, 256, T, 1024, 256, x2, 1024, x1, pss, -1, 0, hn, P.in[I_NORM_FFN] + l * 1024));
        GSYNC();
        router_phase(smem, x2, P.in[I_NORM_FFN] + l * 1024, (const bf16_t*)(ws + OFF_WR) + (size_t)l * 2 * 48 * 1024, P.in[I_B_RG] + l * 4, P.in[I_B_RE] + l * 32, pss, cnt, list, pgate);
        GSYNC();
        REP(512, moe_phase<1>(smem, hn, 1024, Wt_gu + (size_t)l * 32 * 512 * 1024, (size_t)512 * 1024, 1024, 1024, cnt, list, pgate, act, pss));
        GSYNC();
        REP(1024, moe_phase<2>(smem, act, 256, Wt_dn + (size_t)l * 32 * 1024 * 256, (size_t)1024 * 256, 256, 256, cnt, list, pgate, eo, pss));
        if (PROBE_MASK & 2048) { for (int i = 0; i < 10; ++i) GSYNC(); }
        GSYNC();
        if (l == 0) { combine_phase(x2, eo, P.in[I_NORM_MIX] + 1024, XA, hn, 0); GSYNC(); }
        else combine_phase(x2, eo, P.in[I_NORM_FINAL], P.out, hn, 1);
}
__global__ void __launch_bounds__(NTHR, 2) mega_kernel(Params P) {
    extern __shared__ __attribute__((aligned(16))) char smem[];
    volatile LDS_AS unsigned* st = (volatile LDS_AS unsigned*)(smem + LDS_BYTES - 16);
    if (TIDX < 4) st[TIDX] = 0u;
    __syncthreads();
    const XcdBarrier xb = xcd_barrier_post((unsigned*)(P.ws + OFF_CTL), st);
    phase0(P, smem);
    GSYNC();
    layer_body<0>(P, smem, xb, P.in[I_X]);
    layer_body<1>(P, smem, xb, P.out);
}

extern "C" void kernel_launch(void* const* d_in, const int* in_sizes, int n_in, void* d_out, int out_size, void* d_ws, size_t ws_size, hipStream_t stream) {
    static int grid_blocks = 0;
    if (grid_blocks == 0) {
        if (n_in != N_INPUTS || ws_size < OFF_END || out_size != T * 1024) { fprintf(stderr, "kernel_launch: unexpected sizes n_in=%d ws=%zu out=%d (need ws >= %zu)\n", n_in, ws_size, out_size, (size_t)OFF_END); grid_blocks = -1; return; }
        int dev = 0, cus = 0, per_cu = 0;
        if (hipGetDevice(&dev) != hipSuccess || hipDeviceGetAttribute(&cus, hipDeviceAttributeMultiprocessorCount, dev) != hipSuccess) { fprintf(stderr, "kernel_launch: device query failed\n"); grid_blocks = -1; return; }
        if (hipFuncSetAttribute((const void*)mega_kernel, hipFuncAttributeMaxDynamicSharedMemorySize, LDS_BYTES) != hipSuccess) { fprintf(stderr, "kernel_launch: hipFuncSetAttribute failed\n"); grid_blocks = -1; return; }
        if (hipOccupancyMaxActiveBlocksPerMultiprocessor(&per_cu, (const void*)mega_kernel, NTHR, LDS_BYTES) != hipSuccess || per_cu < 1) { fprintf(stderr, "kernel_launch: occupancy query says %d blocks/CU\n", per_cu); grid_blocks = -1; return; }
        grid_blocks = cus;
        fprintf(stderr, "kernel_launch: cus=%d per_cu=%d grid=%d\n", cus, per_cu, grid_blocks);
    }
    if (grid_blocks < 0) return;
    if (hipMemsetAsync((char*)d_ws + OFF_CTL, 0, CTL_BYTES, stream) != hipSuccess) { fprintf(stderr, "kernel_launch: memset failed\n"); return; }
    Params p; memset(&p, 0, sizeof p);
    for (int i = 0; i < N_INPUTS; ++i) p.in[i] = (const float*)d_in[i];
    p.out = (float*)d_out; p.ws = (char*)d_ws;
    void* args[] = {&p};
    hipError_t e = hipLaunchCooperativeKernel((const void*)mega_kernel, dim3(grid_blocks), dim3(NTHR), args, LDS_BYTES, stream);
    if (e != hipSuccess) fprintf(stderr, "kernel_launch: cooperative launch failed: %s (grid %d)\n", hipGetErrorString(e), grid_blocks);
}
```

```cpp
#include <hip/hip_runtime.h>
#include <stdint.h>
#include <stdio.h>
#include <string.h>
#include <hip/hip_cooperative_groups.h>
namespace cg = cooperative_groups;

typedef unsigned short bf16_t;
typedef short bf16x8 __attribute__((ext_vector_type(8)));
typedef float f32x4 __attribute__((ext_vector_type(4)));
typedef unsigned u32x4 __attribute__((ext_vector_type(4)));

constexpr int NB = 8, SEQ = 2048, DM = 1024, T = NB * SEQ, NL = 2;
constexpr int NP = 3584;
constexpr int NIN = 3340;
constexpr int C_AQ = 0, C_AF = 256, C_AI = 512, C_AG = 768, C_BQ = 1024, C_BK = 1280, C_BV = 1536, C_CX = 1792, C_CG = 2048,
              C_DQ = 2304, C_DK = 2560, C_DV = 2816, C_DZ = 3072, C_GATE = 3328;
constexpr int MEMLEN = 256;
constexpr int NEXP = 32, DEXP = 256;
constexpr float EPS = 1e-6f;

constexpr size_t al256(size_t x) { return (x + 255) & ~(size_t)255; }
constexpr size_t SZ_WIN = (size_t)NP * 1024 * 2, SZ_WOUT = (size_t)1024 * 1024 * 2, SZ_WMQ = (size_t)256 * 1024 * 2, SZ_WMKV = (size_t)512 * 1024 * 2,
                 SZ_WMO = (size_t)1024 * 256 * 2, SZ_WGU = (size_t)32 * 512 * 1024 * 2, SZ_WDN = (size_t)32 * 1024 * 256 * 2;
constexpr size_t OFF_WIN = 0;
constexpr size_t OFF_WOUT = OFF_WIN + NL * SZ_WIN;
constexpr size_t OFF_WMQ = OFF_WOUT + NL * SZ_WOUT;
constexpr size_t OFF_WMKV = OFF_WMQ + NL * SZ_WMQ;
constexpr size_t OFF_WMO = OFF_WMKV + NL * SZ_WMKV;
constexpr size_t OFF_WGU = OFF_WMO + NL * SZ_WMO;
constexpr size_t OFF_WDN = OFF_WGU + NL * SZ_WGU;
constexpr size_t OFF_HN = OFF_WDN + NL * SZ_WDN;
constexpr size_t OFF_PROJ = OFF_HN + (size_t)T * 1024 * 2;
constexpr size_t OFF_GATES = OFF_PROJ + (size_t)T * NP * 2;
constexpr size_t OFF_Y = OFF_GATES + (size_t)T * 16 * 4;
constexpr size_t OFF_XB = OFF_Y + (size_t)T * 1024 * 2;
constexpr size_t OFF_QM = OFF_XB + (size_t)T * 1024 * 4;
constexpr size_t OFF_OM = OFF_QM + (size_t)T * 256 * 2;
constexpr size_t OFF_KVM = OFF_OM + (size_t)T * 256 * 2;
constexpr size_t OFF_MEMN = OFF_KVM + (size_t)NL * 2048 * 512 * 2;
constexpr size_t OFF_FOXC = OFF_MEMN + (size_t)2048 * 1024 * 2;
constexpr size_t OFF_LRUA = OFF_FOXC + (size_t)NB * 4 * SEQ * 4;
constexpr size_t OFF_LRUU = OFF_LRUA + (size_t)T * 256 * 4;
constexpr size_t OFF_CNT = OFF_LRUU + (size_t)T * 256 * 4;
constexpr size_t OFF_LIST = OFF_CNT + 256;
constexpr size_t OFF_PGATE = OFF_LIST + (size_t)NEXP * T * 4;
constexpr size_t OFF_HL = OFF_PGATE + (size_t)2 * T * 4;
constexpr size_t OFF_HD = OFF_HL + (size_t)1024 * 4096 * 4;
constexpr size_t OFF_GDN = OFF_HD + (size_t)1024 * 64 * 4;
constexpr size_t OFF_GLAST = OFF_GDN + (size_t)1024 * 5 * 4096 * 2;
constexpr size_t OFF_LSUM = OFF_GLAST + 4096;
constexpr size_t OFF_HS = OFF_LSUM + (size_t)2 * 256 * 256 * 4;
constexpr size_t OFF_LCAR = OFF_HS + (size_t)1024 * 4096 * 2;
constexpr size_t OFF_PSS = OFF_LCAR + (size_t)256 * 256 * 4;
constexpr size_t OFF_WR = OFF_PSS + (size_t)T * 16 * 4;
constexpr size_t OFF_CTL = OFF_WR + (size_t)NL * 2 * 48 * 1024 * 2;
constexpr size_t CTL_BYTES = 32768;
constexpr int CTL_CNT_WORD = 4096;
constexpr int CNT_STRIDE = 64;
constexpr size_t OFF_END = OFF_CTL + CTL_BYTES;
constexpr size_t OFF_ACT = OFF_PROJ;
constexpr size_t OFF_EO = OFF_PROJ + (size_t)2 * T * 256 * 2;
static_assert(OFF_EO + (size_t)2 * T * 1024 * 2 <= OFF_GATES, "overlay fits");

__device__ __forceinline__ int tid_opaque() { int t = threadIdx.x; asm volatile("" : "+v"(t)); return t; }
#define TIDX tid_opaque()
__device__ __forceinline__ float bf2f(bf16_t v) { return __uint_as_float(((unsigned)v) << 16); }
typedef __bf16 bf16x2_t __attribute__((ext_vector_type(2)));
__device__ __forceinline__ bf16_t f2bf(float f) { return __builtin_bit_cast(unsigned short, (__bf16)f); }
__device__ __forceinline__ unsigned pk2(float lo, float hi) { bf16x2_t v = {(__bf16)lo, (__bf16)hi}; return __builtin_bit_cast(unsigned, v); }
__device__ __forceinline__ float sigmoidf_(float x) { return 1.f / (1.f + __expf(-x)); }
__device__ __forceinline__ float siluf_(float x) { return x / (1.f + __expf(-x)); }
__device__ __forceinline__ float softplusf_(float x) { return x > 20.f ? x : log1pf(__expf(x)); }
__device__ __forceinline__ float logsigmoidf_(float x) { return x < 0.f ? x - log1pf(__expf(x)) : -log1pf(__expf(-x)); }
__device__ __forceinline__ float geluf_(float x) { float u = 0.7978845608028654f * (x + 0.044715f * x * x * x); return 0.5f * x * (1.f + tanhf(u)); }
__device__ __forceinline__ float wave_sum(float v) {
#pragma unroll
    for (int o = 1; o < 64; o <<= 1) v += __shfl_xor(v, o);
    return v;
}
__device__ __forceinline__ float rdlane(float v, int l) { return __int_as_float(__builtin_amdgcn_readlane(__float_as_int(v), l)); }

#define PROBE_MASK 0
#define GSYNC() xcd_barrier(xb)
#define REP(bit, ...) do { __VA_ARGS__; if (PROBE_MASK & (bit)) { GSYNC(); __VA_ARGS__; } } while (0)
constexpr int NTHR = 512;
constexpr int LDS_BYTES = 147456;
enum { I_X = 0, I_MEM, I_NORM_MIX, I_W_IN, I_HGRN_LB, I_FOX_FB, I_LRU_CONV_W, I_LRU_CONV_B, I_LRU_WA, I_LRU_BA, I_LRU_WX, I_LRU_BX, I_LRU_LAM, I_GDN_CONV_W, I_GDN_A_LOG,
       I_GDN_DT_BIAS, I_MIX_GAIN, I_W_OUT, I_NORM_MEM, I_NORM_MEMKV, I_W_MQ, I_W_MKV, I_W_MO, I_NORM_FFN, I_W_RG, I_B_RG, I_W_RE, I_B_RE, I_W_E_GU, I_W_E_DN, I_NORM_FINAL, N_INPUTS };
struct Params { const float* in[N_INPUTS]; float* out; char* ws; };
static_assert(sizeof(Params) == 8 * (N_INPUTS + 2), "no padding");

#define BLK_LOOP(it, n) for (int it = (int)blockIdx.x; it < (n); it += (int)gridDim.x)


__device__ __forceinline__ float rinv_from_pss(const float* __restrict__ pss, size_t row) {
    const f32x4 a = *(const f32x4*)(pss + row * 16), b = *(const f32x4*)(pss + row * 16 + 4), c = *(const f32x4*)(pss + row * 16 + 8), d = *(const f32x4*)(pss + row * 16 + 12);
    const float sm = ((a[0] + a[1]) + (a[2] + a[3])) + ((b[0] + b[1]) + (b[2] + b[3])) + ((c[0] + c[1]) + (c[2] + c[3])) + ((d[0] + d[1]) + (d[2] + d[3]));
    return rsqrtf(sm * (1.f / 1024.f) + EPS);
}

__device__ __forceinline__ int rowmap_fn(int mode, int n) {
    if (mode == 1) {
        if (n < 1792) return n;
        if (n < 1796) return C_GATE + (n - 1792);
        if (n < 3076) return n - 4;
        if (n < 3084) return C_GATE + 4 + (n - 3076);
        return n - 12;
    } else if (mode == 2) {
        int j = n & 255; return (j >> 4) * 32 + ((n >= 256) ? 16 : 0) + (j & 15);
    }
    return n;
}
__device__ __forceinline__ void convT_tile(float* tile  , const float* __restrict__ src, int K, int N, bf16_t* __restrict__ dst, int mode, int ntn, int idx) {
    const int n0 = (idx % ntn) * 64, k0 = (idx / ntn) * 64;
    const int tid = TIDX;
    __syncthreads();
#pragma unroll
    for (int i = 0; i < 2; ++i) {
        const int k = (tid >> 4) + 32 * i, n = n0 + (tid & 15) * 4;
        f32x4 v = (f32x4){0.f, 0.f, 0.f, 0.f};
        if (n + 3 < N) v = *(const f32x4*)(src + (size_t)(k0 + k) * N + n);
        else { for (int e = 0; e < 4; ++e) if (n + e < N) v[e] = src[(size_t)(k0 + k) * N + n + e]; }
#pragma unroll
        for (int e = 0; e < 4; ++e) tile[k * 65 + (tid & 15) * 4 + e] = v[e];
    }
    __syncthreads();
    const int nl = tid >> 3, k8 = (tid & 7) * 8, n = n0 + nl;
    if (n < N) {
        const int r = rowmap_fn(mode, n);
        u32x4 o;
#pragma unroll
        for (int j = 0; j < 4; ++j) o[j] = pk2(tile[(k8 + 2 * j) * 65 + nl], tile[(k8 + 2 * j + 1) * 65 + nl]);
        *(u32x4*)(dst + (size_t)r * K + k0 + k8) = o;
    }
}
__device__ __forceinline__ void rms_row_bf16(const float* __restrict__ xrow, const float* __restrict__ g, bf16_t* __restrict__ orow, int lane) {
    const f32x4* xr = (const f32x4*)xrow + lane;
    f32x4 v[4]; float s = 0.f;
#pragma unroll
    for (int j = 0; j < 4; ++j) { v[j] = xr[64 * j]; s += v[j].x * v[j].x + v[j].y * v[j].y + v[j].z * v[j].z + v[j].w * v[j].w; }
    const float rinv = rsqrtf(wave_sum(s) * (1.f / 1024.f) + EPS);
#pragma unroll
    for (int j = 0; j < 4; ++j) {
        const f32x4 gg = ((const f32x4*)g)[lane + 64 * j];
        uint2 o; o.x = pk2(v[j].x * rinv * gg.x, v[j].y * rinv * gg.y); o.y = pk2(v[j].z * rinv * gg.z, v[j].w * rinv * gg.w);
        *(uint2*)(orow + (lane + 64 * j) * 4) = o;
    }
}

constexpr int CT_PER_LAYER = 53 * 16 + 256 + 64 + 128 + 64;
constexpr int CT_GU = 64 * 128, CT_DN = 64 * 64;
constexpr int CT_TOTAL = NL * CT_PER_LAYER + CT_GU + CT_DN;

__device__ __forceinline__ void phase0(const Params& P, char* smem) {
    char* ws = P.ws;
    float* tile = (float*)smem;
    BLK_LOOP(it, CT_TOTAL) {
        int r = it;
        if (r < NL * CT_PER_LAYER) {
            const int l = r / CT_PER_LAYER; r -= l * CT_PER_LAYER;
            if (r < 848) { convT_tile(tile, P.in[I_W_IN] + (size_t)l * 1024 * NIN, 1024, NIN, (bf16_t*)(ws + OFF_WIN) + (size_t)l * NP * 1024, 1, 53, r); continue; } r -= 848;
            if (r < 256) { convT_tile(tile, P.in[I_W_OUT] + (size_t)l * 1024 * 1024, 1024, 1024, (bf16_t*)(ws + OFF_WOUT) + (size_t)l * 1024 * 1024, 0, 16, r); continue; } r -= 256;
            if (r < 64) { convT_tile(tile, P.in[I_W_MQ] + (size_t)l * 1024 * 256, 1024, 256, (bf16_t*)(ws + OFF_WMQ) + (size_t)l * 256 * 1024, 0, 4, r); continue; } r -= 64;
            if (r < 128) { convT_tile(tile, P.in[I_W_MKV] + (size_t)l * 1024 * 512, 1024, 512, (bf16_t*)(ws + OFF_WMKV) + (size_t)l * 512 * 1024, 0, 8, r); continue; } r -= 128;
            convT_tile(tile, P.in[I_W_MO] + (size_t)l * 256 * 1024, 256, 1024, (bf16_t*)(ws + OFF_WMO) + (size_t)l * 1024 * 256, 0, 16, r); continue;
        }
        r -= NL * CT_PER_LAYER;
        if (r < CT_GU) { const int m = r >> 7; convT_tile(tile, P.in[I_W_E_GU] + (size_t)m * 1024 * 512, 1024, 512, (bf16_t*)(ws + OFF_WGU) + (size_t)m * 512 * 1024, 2, 8, r & 127); continue; }
        r -= CT_GU;
        { const int m = r >> 6; convT_tile(tile, P.in[I_W_E_DN] + (size_t)m * 256 * 1024, 256, 1024, (bf16_t*)(ws + OFF_WDN) + (size_t)m * 1024 * 256, 0, 16, r & 63); }
    }
    for (int i = blockIdx.x * NTHR + TIDX; i < NL * (NP - NIN) * 512; i += gridDim.x * NTHR) {
        const int l = i / ((NP - NIN) * 512), w = i % ((NP - NIN) * 512);
        ((unsigned*)((bf16_t*)(ws + OFF_WIN) + (size_t)l * NP * 1024 + (size_t)NIN * 1024))[w] = 0u;
    }
    for (int i = blockIdx.x * NTHR + TIDX; i < NL * 48 * 1024; i += gridDim.x * NTHR) {
        const int l = i / (48 * 1024), r = (i / 1024) % 48, k = i & 1023;
        float w = 0.f;
        if (r < 4) w = P.in[I_W_RG][(size_t)l * 4096 + k * 4 + r]; else if (r < 36) w = P.in[I_W_RE][(size_t)l * 32768 + k * 32 + (r - 4)];
        const bf16_t hi = f2bf(w); const bf16_t lo = f2bf(w - bf2f(hi));
        bf16_t* wr = (bf16_t*)(ws + OFF_WR) + (size_t)l * 2 * 48 * 1024;
        wr[r * 1024 + k] = hi; wr[48 * 1024 + r * 1024 + k] = lo;
    }
    const int gw = blockIdx.x * 8 + (TIDX >> 6), ngw = gridDim.x * 8, lane = TIDX & 63;
    for (int row = gw; row < T + NL * 2048; row += ngw) {
        if (row < T) rms_row_bf16(P.in[I_X] + (size_t)row * 1024, P.in[I_NORM_MIX], (bf16_t*)(ws + OFF_HN) + (size_t)row * 1024, lane);
        else { const int r2 = row - T, l = r2 >> 11, rr = r2 & 2047;
               rms_row_bf16(P.in[I_MEM] + (size_t)rr * 1024, P.in[I_NORM_MEMKV] + l * 1024, (bf16_t*)(ws + OFF_MEMN) + (size_t)r2 * 1024, lane); }
    }
}

constexpr int GLD = 72;
constexpr int GEMM_STAGE = (256 + 128) * GLD * 2;
constexpr int GEMM_LDS = 2 * GEMM_STAGE;
template <class RowPtr>
__device__ __forceinline__ void gemm_tile(char* smem, RowPtr rowptr, const bf16_t* __restrict__ Bt, int ldb, int n0, int K, f32x4 (&acc)[4][4]) {
    const int tid = TIDX, lane = tid & 63, wave = tid >> 6, wm = wave >> 1, wn = wave & 1;
    const u32x4* ga[4]; const u32x4* gb[2];
#pragma unroll
    for (int i = 0; i < 4; ++i) { const int c = tid + i * 512, r = c >> 3, ch = c & 7; ga[i] = (const u32x4*)(rowptr(r) + ch * 8); }
#pragma unroll
    for (int i = 0; i < 2; ++i) { const int c = tid + i * 512, r = c >> 3, ch = c & 7; gb[i] = (const u32x4*)(Bt + (size_t)(n0 + r) * ldb + ch * 8); }
#pragma unroll
    for (int m = 0; m < 4; ++m)
#pragma unroll
        for (int n = 0; n < 4; ++n) acc[m][n] = (f32x4){0.f, 0.f, 0.f, 0.f};
    const int nk = K / 64;
    u32x4 raA[4], rbA[2], raB[4], rbB[2];
#define GT_LOAD(RA, RB, kt) { _Pragma("unroll") for (int i = 0; i < 4; ++i) RA[i] = ga[i][(kt) * 8]; _Pragma("unroll") for (int i = 0; i < 2; ++i) RB[i] = gb[i][(kt) * 8]; }
#define GT_STORE(RA, RB, buf) { bf16_t* dA = (bf16_t*)(smem + (buf) * GEMM_STAGE); bf16_t* dB = dA + 256 * GLD; \
        _Pragma("unroll") for (int i = 0; i < 4; ++i) { const int c = tid + i * 512, r = c >> 3, ch = c & 7; *(u32x4*)(dA + r * GLD + ch * 8) = RA[i]; } \
        _Pragma("unroll") for (int i = 0; i < 2; ++i) { const int c = tid + i * 512, r = c >> 3, ch = c & 7; *(u32x4*)(dB + r * GLD + ch * 8) = RB[i]; } }
#define GT_COMPUTE(buf) { const bf16_t* sA = (const bf16_t*)(smem + (buf) * GEMM_STAGE); const bf16_t* sB = sA + 256 * GLD; \
        _Pragma("unroll") for (int kk = 0; kk < 2; ++kk) { bf16x8 af[4], bfr[4]; \
            _Pragma("unroll") for (int m = 0; m < 4; ++m) af[m] = *(const bf16x8*)(sA + (wm * 64 + m * 16 + (lane & 15)) * GLD + kk * 32 + (lane >> 4) * 8); \
            _Pragma("unroll") for (int n = 0; n < 4; ++n) bfr[n] = *(const bf16x8*)(sB + (wn * 64 + n * 16 + (lane & 15)) * GLD + kk * 32 + (lane >> 4) * 8); \
            _Pragma("unroll") for (int m = 0; m < 4; ++m) _Pragma("unroll") for (int n = 0; n < 4; ++n) acc[m][n] = __builtin_amdgcn_mfma_f32_16x16x32_bf16(bfr[n], af[m], acc[m][n], 0, 0, 0); } }
    GT_LOAD(raA, rbA, 0)
    GT_LOAD(raB, rbB, 1)
    __syncthreads();
    GT_STORE(raA, rbA, 0)
    __syncthreads();
    for (int kt = 0; kt < nk; kt += 2) {
        if (kt + 2 < nk) GT_LOAD(raA, rbA, kt + 2)
        GT_COMPUTE(0)
        GT_STORE(raB, rbB, 1)
        __syncthreads();
        if (kt + 3 < nk) GT_LOAD(raB, rbB, kt + 3)
        GT_COMPUTE(1)
        if (kt + 2 < nk) GT_STORE(raA, rbA, 0)
        __syncthreads();
    }
#undef GT_LOAD
#undef GT_STORE
#undef GT_COMPUTE
}
struct RowDirect { const bf16_t* A; int lda; int m0; __device__ __forceinline__ const bf16_t* operator()(int r) const { return A + (size_t)(m0 + r) * lda; } };
enum { EPI_INPROJ = 0, EPI_RESID = 1, EPI_BF16 = 2, EPI_BF16_RS = 3, EPI_RESID_NORM = 4 };

__device__ __forceinline__ int vcu_id() { const int G = gridDim.x, bx = blockIdx.x; return (G % 8 == 0) ? (bx % 8) * (G / 8) + bx / 8 : bx; }

template <int EPI>
__device__ __forceinline__ void gemm_phase(char* smem, const bf16_t* A, int lda, const bf16_t* Bt, int ldb, int M, int N, int K, void* out, int ldo, const float* resid, float* gates, int idx0 = -1, int stride = 0, bf16_t* xg = nullptr, const float* gn = nullptr) {
    const int ntn = N / 128, ntiles = (M / 256) * ntn;
    if (stride == 0) { idx0 = vcu_id(); stride = gridDim.x; }
    if (idx0 < 0) return;
    const int lane = TIDX & 63, wave = TIDX >> 6, wm = wave >> 1, wn = wave & 1;
    for (int tIdx = idx0; tIdx < ntiles; tIdx += stride) {
        const int m0 = (tIdx / ntn) * 256, n0 = (tIdx % ntn) * 128;
        f32x4 acc[4][4];
        RowDirect rp{A, lda, m0};
        gemm_tile(smem, rp, Bt, ldb, n0, K, acc);
        float rsc[4] = {1.f, 1.f, 1.f, 1.f};
        if (EPI == EPI_BF16_RS) {
#pragma unroll
            for (int m = 0; m < 4; ++m) rsc[m] = rinv_from_pss(resid, (size_t)(m0 + wm * 64 + m * 16 + (lane & 15)));
        }
        if (EPI == EPI_RESID_NORM) {
#pragma unroll
            for (int m = 0; m < 4; ++m) {
                const int row = m0 + wm * 64 + m * 16 + (lane & 15);
                float ss = 0.f;
#pragma unroll
                for (int n = 0; n < 4; ++n) {
                    const int col = n0 + wn * 64 + n * 16 + (lane >> 4) * 4;
                    const f32x4 o = *(const f32x4*)(resid + (size_t)row * ldo + col) + acc[m][n];
                    *(f32x4*)((float*)out + (size_t)row * ldo + col) = o;
                    ss += (o[0] * o[0] + o[1] * o[1]) + (o[2] * o[2] + o[3] * o[3]);
                    const f32x4 og = o * *(const f32x4*)(gn + col);
                    uint2 w; w.x = pk2(og[0], og[1]); w.y = pk2(og[2], og[3]);
                    *(uint2*)(xg + (size_t)row * ldo + col) = w;
                }
                ss += __shfl_xor(ss, 16); ss += __shfl_xor(ss, 32);
                if ((lane >> 4) == 0) gates[(size_t)row * 16 + (n0 >> 7) * 2 + wn] = ss;
            }
            continue;
        }
#pragma unroll
        for (int m = 0; m < 4; ++m)
#pragma unroll
            for (int n = 0; n < 4; ++n) {
                const int row = m0 + wm * 64 + m * 16 + (lane & 15), col = n0 + wn * 64 + n * 16 + (lane >> 4) * 4;
                const f32x4 v = acc[m][n];
                if (EPI == EPI_INPROJ) {
                    uint2 o; o.x = pk2(v.x, v.y); o.y = pk2(v.z, v.w);
                    *(uint2*)((bf16_t*)out + (size_t)row * ldo + col) = o;
                    if (col >= C_GATE && col < C_GATE + 16) *(f32x4*)(gates + (size_t)row * 16 + (col - C_GATE)) = v;
                } else if (EPI == EPI_RESID) {
                    const f32x4 r = *(const f32x4*)(resid + (size_t)row * ldo + col);
                    *(f32x4*)((float*)out + (size_t)row * ldo + col) = r + v;
                } else if (EPI == EPI_BF16_RS) {
                    const float ri = rsc[m];
                    uint2 o; o.x = pk2(v.x * ri, v.y * ri); o.y = pk2(v.z * ri, v.w * ri);
                    *(uint2*)((bf16_t*)out + (size_t)row * ldo + col) = o;
                } else {
                    uint2 o; o.x = pk2(v.x, v.y); o.y = pk2(v.z, v.w);
                    *(uint2*)((bf16_t*)out + (size_t)row * ldo + col) = o;
                }
            }
    }
}


namespace pg8 {
#define PG8_LAS __attribute__((address_space(3)))
typedef unsigned short bf16_t;
typedef short bf16x8 __attribute__((ext_vector_type(8)));
typedef float f32x4 __attribute__((ext_vector_type(4)));
typedef unsigned u32x4 __attribute__((ext_vector_type(4)));
constexpr int BM = 256, BK = 64, HALF = 128, HTB = HALF * BK * 2  , STAGE_BYTES = 8 * HTB, NXCD = 8, WGM = 8;

__host__ __device__ __forceinline__ int lds_byte(int r, int c) { const int st = (r >> 4) * 2 + (c >> 5), rr = r & 15, cc = c & 31, ob = rr * 64 + cc * 2; return st * 1024 + (ob ^ (((ob >> 9) & 1) << 5)); }
__host__ __device__ __forceinline__ void stage_rc(int b, int& R, int& C) { const int st = b / 1024, sb = b % 1024, swz = sb ^ (((sb >> 9) & 1) << 5); R = (st >> 1) * 16 + swz / 64; C = (st & 1) * 32 + (swz % 64) / 2; }
__host__ __device__ __forceinline__ int perm32(int rho) { const int n = rho >> 4, i = rho & 15; return 8 * (i >> 2) + 4 * n + (i & 3); }

struct Unit { int pm, pn; };
struct Gemm { const bf16_t* A; const bf16_t* Bt; int M, N, K; };

struct StaticOrder {
    int nM, nN, nwg, G, c;
    __host__ __device__ void init(int M, int N, int G_, int c_) { nM = M / BM; nN = N / BM; nwg = nM * nN; G = G_; c = c_; }
    __host__ __device__ bool next(int i, Unit& u) const {
        const long L = (long)i * G + c; if (L >= nwg) return false;
        int wgid = (int)L; { const int q = nwg / NXCD, r = nwg % NXCD, xcd = wgid % NXCD, off = wgid / NXCD; wgid = (xcd < r ? xcd * (q + 1) : r * (q + 1) + (xcd - r) * q) + off; }
        const int nig = WGM * nN, gid = wgid / nig, fm = gid * WGM, gsz = (nM - fm) < WGM ? (nM - fm) : WGM;
        u.pm = fm + ((wgid % nig) % gsz); u.pn = (wgid % nig) / gsz; return true;
    }
    __device__ __forceinline__ void a_ready(const Unit&) const {}
    __device__ __forceinline__ void done(const Unit&) const {}
};
__device__ __forceinline__ unsigned cvt_pk_bf16(float lo, float hi) { unsigned r; asm volatile("v_cvt_pk_bf16_f32 %0, %1, %2" : "=v"(r) : "v"(lo), "v"(hi)); return r; }
typedef float f32x2 __attribute__((ext_vector_type(2)));

struct EpiInProj {
    static constexpr bool PERM = true, AFTER_DRAIN = false;
    bf16_t* O; int ldc; float* gates; int gate_col;
    __device__ __forceinline__ void operator()(const f32x4 (&acc)[2][2][4][2], const Unit& u, int wr, int wc, int fr, int fq) const {
        const int row0 = u.pm * BM + wr * 64 + fr, col0 = u.pn * BM + wc * 32 + 8 * fq;
#pragma unroll
        for (int ai = 0; ai < 2; ++ai)
#pragma unroll
            for (int m = 0; m < 4; ++m) {
                const int row = row0 + ai * HALF + m * 16;
                bf16_t* rowp = O + (size_t)row * ldc + col0;
#pragma unroll
                for (int bj = 0; bj < 2; ++bj) {
                    const f32x4 v0 = acc[ai][bj][m][0], v1 = acc[ai][bj][m][1];
                    u32x4 w; w.x = cvt_pk_bf16(v0[0], v0[1]); w.y = cvt_pk_bf16(v0[2], v0[3]); w.z = cvt_pk_bf16(v1[0], v1[1]); w.w = cvt_pk_bf16(v1[2], v1[3]);
                    *(u32x4*)(rowp + bj * HALF) = w;
                    const int gc = col0 + bj * HALF - gate_col;
                    if (gates && gc >= 0 && gc < 16) { *(f32x4*)(gates + (size_t)row * 16 + gc) = v0; *(f32x4*)(gates + (size_t)row * 16 + gc + 4) = v1; }
                }
            }
    }
};
struct EpiResid {
    static constexpr bool PERM = false, AFTER_DRAIN = false;
    const float* base; float* out; int ldc;
    __device__ __forceinline__ void operator()(const f32x4 (&acc)[2][2][4][2], const Unit& u, int wr, int wc, int fr, int fq) const {
        const int col0 = u.pn * BM + wc * 32 + 4 * fq;
#pragma unroll
        for (int ai = 0; ai < 2; ++ai)
#pragma unroll
            for (int m = 0; m < 4; ++m) {
                const size_t off = (size_t)(u.pm * BM + ai * HALF + wr * 64 + m * 16 + fr) * ldc + col0;
#pragma unroll
                for (int bj = 0; bj < 2; ++bj)
#pragma unroll
                    for (int n = 0; n < 2; ++n) { const f32x4 bs = *(const f32x4*)(base + off + bj * HALF + n * 16); *(f32x4*)(out + off + bj * HALF + n * 16) = bs + acc[ai][bj][m][n]; }
                if (m & 1) asm volatile("" ::: "memory");
            }
    }
};

struct EpiResidNorm {
    static constexpr bool PERM = false, AFTER_DRAIN = false;
    const float* base; float* out; int ldc; const float* gn; bf16_t* xg; float* pss;
    __device__ __forceinline__ void operator()(const f32x4 (&acc)[2][2][4][2], const Unit& u, int wr, int wc, int fr, int fq) const {
        const int col0 = u.pn * BM + wc * 32 + 4 * fq;
        f32x4 gv[2][2];
#pragma unroll
        for (int bj = 0; bj < 2; ++bj)
#pragma unroll
            for (int n = 0; n < 2; ++n) gv[bj][n] = *(const f32x4*)(gn + col0 + bj * HALF + n * 16);
#pragma unroll
        for (int ai = 0; ai < 2; ++ai)
#pragma unroll
            for (int m = 0; m < 4; ++m) {
                const int row = u.pm * BM + ai * HALF + wr * 64 + m * 16 + fr;
                const size_t off = (size_t)row * ldc + col0;
                float ss = 0.f;
#pragma unroll
                for (int bj = 0; bj < 2; ++bj)
#pragma unroll
                    for (int n = 0; n < 2; ++n) {
                        const f32x4 bs = *(const f32x4*)(base + off + bj * HALF + n * 16);
                        const f32x4 o = bs + acc[ai][bj][m][n];
                        *(f32x4*)(out + off + bj * HALF + n * 16) = o;
                        ss += (o[0] * o[0] + o[1] * o[1]) + (o[2] * o[2] + o[3] * o[3]);
                        const f32x4 og = o * gv[bj][n];
                        uint2 w; w.x = cvt_pk_bf16(og[0], og[1]); w.y = cvt_pk_bf16(og[2], og[3]);
                        *(uint2*)(xg + off + bj * HALF + n * 16) = w;
                    }
                ss += __shfl_xor(ss, 16); ss += __shfl_xor(ss, 32);
                if (fq == 0) pss[(size_t)row * 16 + u.pn * 4 + wc] = ss;
                if (m & 1) asm volatile("" ::: "memory");
            }
    }
};
template <class Epi, class Sched, bool ALIGN_EPI = false, bool SP2 = false>
__device__ __forceinline__ void gemm_phase(PG8_LAS unsigned char* lds, const Gemm g, const Sched& S, const Epi& E) {
    const int tid = TIDX, wid = __builtin_amdgcn_readfirstlane(tid >> 6), lane = tid & 63, wr = wid >> 2, wc = wid & 3, fr = lane & 15, fq = lane >> 4;
    const int K = g.K, nt = K / BK;
    unsigned voffA[2], voffB[2];
#pragma unroll
    for (int i = 0; i < 2; ++i) { int R, C; stage_rc(tid * 16 + i * 8192, R, C); const int Rb = Epi::PERM ? ((R & ~31) + perm32(R & 31)) : R;
        voffA[i] = (unsigned)(R * K + C) * 2u; voffB[i] = (unsigned)(Rb * K + C) * 2u; }
    const size_t kstep = (size_t)(BK * 2);
    const size_t hstep = (size_t)HALF * K * 2;
    const size_t tstep = 2 * hstep;
    const unsigned ldsw = (unsigned)wid * 1024u;
    const int aoff = lds_byte(wr * 64 + fr, fq * 8), boff = lds_byte(wc * 32 + fr, fq * 8);
#define PG8_SA(b, h) (((b) * 2 + (h)) * HTB)
#define PG8_SB(b, h) ((4 + (b) * 2 + (h)) * HTB)
#define PG8_STAGE(bufoff, gbase, voff) do { _Pragma("unroll") for (int _i = 0; _i < 2; ++_i) \
        __builtin_amdgcn_global_load_lds((const unsigned*)((const char*)(gbase) + (voff)[_i]), (PG8_LAS unsigned*)(lds + (bufoff) + ldsw + _i * 8192), 16, 0, 0); } while (0)
#define PG8_LDA(dst, b, h) do { _Pragma("unroll") for (int m = 0; m < 4; ++m) _Pragma("unroll") for (int k = 0; k < 2; ++k) dst[m][k] = *(const PG8_LAS bf16x8*)(lds + PG8_SA(b, h) + aoff + m * 2048 + k * 1024); } while (0)
#define PG8_LDB(dst, b, h) do { _Pragma("unroll") for (int n = 0; n < 2; ++n) _Pragma("unroll") for (int k = 0; k < 2; ++k) dst[n][k] = *(const PG8_LAS bf16x8*)(lds + PG8_SB(b, h) + boff + n * 2048 + k * 1024); } while (0)
#define PG8_MMA(ai, bj, At, Bt) do { __builtin_amdgcn_s_setprio(1); _Pragma("unroll") for (int m = 0; m < 4; ++m) _Pragma("unroll") for (int n = 0; n < 2; ++n) _Pragma("unroll") for (int k = 0; k < 2; ++k) \
        acc[ai][bj][m][n] = __builtin_amdgcn_mfma_f32_16x16x32_bf16(Bt[n][k], At[m][k], acc[ai][bj][m][n], 0, 0, 0); __builtin_amdgcn_s_setprio(0); } while (0)
#define PG8_WAIT_V(n) asm volatile("s_waitcnt vmcnt(" #n ")" ::: "memory")
#define PG8_WAIT_L(n) asm volatile("s_waitcnt lgkmcnt(" #n ")" ::: "memory")
#define PG8_BAR __builtin_amdgcn_s_barrier()
#define PG8_SCHED __builtin_amdgcn_sched_barrier(0)
    Unit cur, nxt; int ui = 0;
    if (!S.next(0, cur)) return;
    f32x4 acc[2][2][4][2];
#pragma unroll
    for (int a = 0; a < 2; ++a)
#pragma unroll
        for (int b = 0; b < 2; ++b)
#pragma unroll
            for (int m = 0; m < 4; ++m)
#pragma unroll
                for (int n = 0; n < 2; ++n) acc[a][b][m][n] = (f32x4){0.f, 0.f, 0.f, 0.f};
    bf16x8 At[4][2], B0[2][2], B1[2][2];
    const char* cA = (const char*)g.A + (size_t)cur.pm * tstep; const char* cB = (const char*)g.Bt + (size_t)cur.pn * tstep;
    S.a_ready(cur);
    if constexpr (SP2) {
        PG8_STAGE(PG8_SB(0, 0), cB, voffB); PG8_STAGE(PG8_SB(0, 1), cB + hstep, voffB); PG8_STAGE(PG8_SA(0, 0), cA, voffA); PG8_STAGE(PG8_SA(0, 1), cA + hstep, voffA);
        if (wr == 1) PG8_BAR;
        PG8_WAIT_V(2); PG8_BAR;
        PG8_STAGE(PG8_SB(1, 0), cB + kstep, voffB); PG8_STAGE(PG8_SA(1, 0), cA + kstep, voffA); PG8_STAGE(PG8_SB(1, 1), cB + hstep + kstep, voffB);
        PG8_WAIT_V(6); PG8_BAR;
    } else {
        PG8_STAGE(PG8_SB(0, 0), cB, voffB); PG8_STAGE(PG8_SA(0, 0), cA, voffA); PG8_STAGE(PG8_SB(0, 1), cB + hstep, voffB); PG8_STAGE(PG8_SA(0, 1), cA + hstep, voffA);
        if (wr == 1) PG8_BAR;
        PG8_WAIT_V(4); PG8_BAR;
        PG8_STAGE(PG8_SB(1, 0), cB + kstep, voffB); PG8_STAGE(PG8_SA(1, 0), cA + kstep, voffA); PG8_STAGE(PG8_SB(1, 1), cB + hstep + kstep, voffB);
        PG8_WAIT_V(6); PG8_BAR;
    }
    for (;;) {
        const bool has_next = S.next(ui + 1, nxt);
        const char* nA = has_next ? (const char*)g.A + (size_t)nxt.pm * tstep : cA; const char* nB = has_next ? (const char*)g.Bt + (size_t)nxt.pn * tstep : cB;
        for (int t = 0; t < nt; t += 2) {
            const bool last = (t == nt - 2);
            const char* a1 = cA + (size_t)(t + 1) * kstep;
            const char* a2 = last ? nA : cA + (size_t)(t + 2) * kstep; const char* b2 = last ? nB : cB + (size_t)(t + 2) * kstep;
            const char* a3 = a2 + kstep; const char* b3 = b2 + kstep;
            if (last && has_next) S.a_ready(nxt);
            if constexpr (SP2) {
            PG8_LDB(B0, 0, 0); PG8_LDB(B1, 0, 1); PG8_SCHED; PG8_LDA(At, 0, 0); PG8_STAGE(PG8_SA(1, 1), a1 + hstep, voffA);
            PG8_WAIT_V(8); PG8_WAIT_L(0); PG8_BAR; PG8_MMA(0, 0, At, B0); PG8_MMA(0, 1, At, B1); PG8_BAR; PG8_SCHED;
            PG8_LDA(At, 0, 1); PG8_STAGE(PG8_SB(0, 0), b2, voffB); PG8_STAGE(PG8_SB(0, 1), b2 + hstep, voffB); PG8_STAGE(PG8_SA(0, 0), a2, voffA);
            PG8_WAIT_V(8); PG8_WAIT_L(0); PG8_BAR; PG8_MMA(1, 0, At, B0); PG8_MMA(1, 1, At, B1); PG8_BAR; PG8_SCHED;
            PG8_LDB(B0, 1, 0); PG8_LDB(B1, 1, 1); PG8_SCHED; PG8_LDA(At, 1, 0); PG8_STAGE(PG8_SA(0, 1), a2 + hstep, voffA);
            PG8_WAIT_V(8); PG8_WAIT_L(0); PG8_BAR; PG8_MMA(0, 0, At, B0); PG8_MMA(0, 1, At, B1); PG8_BAR; PG8_SCHED;
            PG8_LDA(At, 1, 1); PG8_STAGE(PG8_SB(1, 0), b3, voffB); PG8_STAGE(PG8_SB(1, 1), b3 + hstep, voffB); PG8_STAGE(PG8_SA(1, 0), a3, voffA);
            PG8_WAIT_V(8); PG8_WAIT_L(0); PG8_BAR; PG8_MMA(1, 0, At, B0); PG8_MMA(1, 1, At, B1); PG8_BAR; PG8_SCHED;
            } else {
            PG8_LDB(B0, 0, 0); PG8_SCHED; PG8_LDA(At, 0, 0); PG8_STAGE(PG8_SA(1, 1), a1 + hstep, voffA);
            PG8_WAIT_L(8); PG8_BAR; PG8_WAIT_L(0); PG8_MMA(0, 0, At, B0); PG8_BAR; PG8_SCHED;
            PG8_LDB(B1, 0, 1); PG8_STAGE(PG8_SB(0, 0), b2, voffB);
            PG8_BAR; PG8_WAIT_L(0); PG8_MMA(0, 1, At, B1); PG8_BAR;
            PG8_LDA(At, 0, 1); PG8_STAGE(PG8_SA(0, 0), a2, voffA);
            PG8_BAR; PG8_WAIT_L(0); PG8_MMA(1, 0, At, B0); PG8_BAR; PG8_SCHED;
            PG8_STAGE(PG8_SB(0, 1), b2 + hstep, voffB);
            PG8_WAIT_V(6); PG8_BAR; PG8_MMA(1, 1, At, B1); PG8_BAR;
            PG8_LDB(B0, 1, 0); PG8_SCHED; PG8_LDA(At, 1, 0); PG8_STAGE(PG8_SA(0, 1), a2 + hstep, voffA);
            PG8_WAIT_L(8); PG8_BAR; PG8_WAIT_L(0); PG8_MMA(0, 0, At, B0); PG8_BAR; PG8_SCHED;
            PG8_LDB(B1, 1, 1); PG8_STAGE(PG8_SB(1, 0), b3, voffB);
            PG8_BAR; PG8_WAIT_L(0); PG8_MMA(0, 1, At, B1); PG8_BAR;
            PG8_LDA(At, 1, 1); PG8_STAGE(PG8_SA(1, 0), a3, voffA);
            PG8_BAR; PG8_WAIT_L(0); PG8_MMA(1, 0, At, B0); PG8_BAR; PG8_SCHED;
            PG8_STAGE(PG8_SB(1, 1), b3 + hstep, voffB);
            PG8_WAIT_V(6); PG8_BAR; PG8_MMA(1, 1, At, B1); PG8_BAR;
            }
        }
        if constexpr (ALIGN_EPI) { if (wr == 0) PG8_BAR; }
        if constexpr (!Epi::AFTER_DRAIN) { E(acc, cur, wr, wc, fr, fq); S.done(cur); }
        if (!has_next) break;
#pragma unroll
        for (int a = 0; a < 2; ++a)
#pragma unroll
            for (int b = 0; b < 2; ++b)
#pragma unroll
                for (int m = 0; m < 4; ++m)
#pragma unroll
                    for (int n = 0; n < 2; ++n) acc[a][b][m][n] = (f32x4){0.f, 0.f, 0.f, 0.f};
        cur = nxt; cA = nA; cB = nB; ++ui;
        if constexpr (ALIGN_EPI) { if (wr == 1) PG8_BAR; }
    }
    PG8_WAIT_V(0);
    if constexpr (!ALIGN_EPI) { if (wr == 0) PG8_BAR; }
    PG8_BAR;
    if constexpr (Epi::AFTER_DRAIN) { E.fused(acc, cur, wr, wc, fr, fq, lds, wid, lane); S.done(cur); }
#undef PG8_SA
#undef PG8_SB
#undef PG8_STAGE
#undef PG8_LDA
#undef PG8_LDB
#undef PG8_MMA
#undef PG8_WAIT_V
#undef PG8_WAIT_L
#undef PG8_BAR
#undef PG8_SCHED
}
}

struct RowGather { const bf16_t* A; int lda; const int* ids; int shift; __device__ __forceinline__ const bf16_t* operator()(int r) const { return A + (size_t)(ids[r] >> shift) * lda; } };
template <int STAGE>
__device__ __forceinline__ void moe_phase(char* smem, const bf16_t* A, int lda, const bf16_t* Wt, size_t wstride, int ldb, int K, const int* cnt, const int* list, const float* pgate, bf16_t* out, const float* pss) {
    int* ids = (int*)(smem + GEMM_LDS);
    int* tpre = ids + 256;
    constexpr int NTN = (STAGE == 1) ? 4 : 8;
    __syncthreads();
    if (TIDX < 64) {
        const int ln = TIDX; int nt = (ln < NEXP) ? ((cnt[ln * CNT_STRIDE] + 255) >> 8) : 0; int inc = nt;
#pragma unroll
        for (int o = 1; o < 64; o <<= 1) { const int nb = __shfl_up(inc, o); if (ln >= o) inc += nb; }
        if (ln <= NEXP) tpre[ln] = inc - nt;
    }
    __syncthreads();
    const int ntiles = tpre[NEXP] * NTN;
    const int lane = TIDX & 63, wave = TIDX >> 6, wm = wave >> 1, wn = wave & 1;
    for (int tIdx = vcu_id(); tIdx < ntiles; tIdx += gridDim.x) {
        const int mtg = tIdx / NTN, n0 = (tIdx % NTN) * 128;
        int e = 0;
        for (int i = 1; i < NEXP; ++i) if (tpre[i] <= mtg) e = i;
        const int mt = mtg - tpre[e];
        const int cn = cnt[e * CNT_STRIDE];
        __syncthreads();
        if (TIDX < 256) { const int pos = mt * 256 + TIDX; ids[TIDX] = list[(size_t)e * T + (pos < cn ? pos : cn - 1)]; }
        __syncthreads();
        f32x4 acc[4][4];
        RowGather rp{A, lda, ids, STAGE == 1 ? 1 : 0};
        gemm_tile(smem, rp, Wt + (size_t)e * wstride, ldb, n0, K, acc);
#pragma unroll
        for (int m = 0; m < 4; ++m) {
            const int rl = wm * 64 + m * 16 + (lane & 15);
            if (mt * 256 + rl >= cn) continue;
            const int pid = ids[rl];
            if (STAGE == 1) {
                const float gt = pgate[pid], ri = rinv_from_pss(pss, (size_t)(pid >> 1));
#pragma unroll
                for (int np = 0; np < 2; ++np) {
                    const f32x4 g = acc[m][2 * np], u = acc[m][2 * np + 1];
                    const int j = (n0 + wn * 64 + np * 32) / 2 + (lane >> 4) * 4;
                    const f32x4 gs = g * ri; const float ug = ri * gt;
                    uint2 o; o.x = pk2(siluf_(gs.x) * u.x * ug, siluf_(gs.y) * u.y * ug); o.y = pk2(siluf_(gs.z) * u.z * ug, siluf_(gs.w) * u.w * ug);
                    *(uint2*)(out + (size_t)pid * DEXP + j) = o;
                }
            } else {
#pragma unroll
                for (int n = 0; n < 4; ++n) {
                    const f32x4 v = acc[m][n]; const int col = n0 + wn * 64 + n * 16 + (lane >> 4) * 4;
                    uint2 o; o.x = pk2(v.x, v.y); o.y = pk2(v.z, v.w);
                    *(uint2*)(out + (size_t)pid * 1024 + col) = o;
                }
            }
        }
    }
}

__device__ __forceinline__ void hgrn2_naive(const bf16_t* __restrict__ proj, const float* __restrict__ hgrn_lb, int layer, const float* __restrict__ mix_gain, bf16_t* __restrict__ y, int bh, int lane) {
    const int b = bh >> 2, h = bh & 3;
    float lbk = 0.f;
    if (layer == 1) { float a0 = hgrn_lb[h * 64 + lane], a1 = hgrn_lb[256 + h * 64 + lane]; lbk = 1.f / (1.f + __expf(a0 - a1)); }
    const float mg = mix_gain[C_AQ + h * 64 + lane];
    float S[64];
#pragma unroll
    for (int k = 0; k < 64; ++k) S[k] = 0.f;
    for (int t = 0; t < SEQ; ++t) {
        const bf16_t* pr = proj + (size_t)(b * SEQ + t) * NP + h * 64 + lane;
        const float qk = siluf_(bf2f(pr[C_AQ]));
        const float sg = sigmoidf_(bf2f(pr[C_AF]));
        const float f = lbk + (1.f - lbk) * sg, kk = (1.f - lbk) * (1.f - sg);
        const float iv = bf2f(pr[C_AI]);
        const float gv = bf2f(pr[C_AG]);
        float o = 0.f;
#pragma unroll
        for (int k = 0; k < 64; ++k) { S[k] = rdlane(f, k) * S[k] + rdlane(kk, k) * iv; o += rdlane(qk, k) * S[k]; }
        const float ms = wave_sum(o * o) * (1.f / 64.f);
        const float yv = o * rsqrtf(ms + EPS) * siluf_(gv) * mg;
        y[(size_t)(b * SEQ + t) * 1024 + 0 + h * 64 + lane] = f2bf(yv);
    }
}
__device__ __forceinline__ void gdn_naive(const bf16_t* __restrict__ proj, const float* __restrict__ gates, const float* __restrict__ conv_w  ,
                                          const float* __restrict__ a_log, const float* __restrict__ dt_bias, const float* __restrict__ mix_gain, bf16_t* __restrict__ y, int bh, int lane) {
    const int b = bh >> 2, h = bh & 3;
    float wq[4], wk[4], wv[4];
#pragma unroll
    for (int j = 0; j < 4; ++j) { wq[j] = conv_w[j * 768 + h * 64 + lane]; wk[j] = conv_w[j * 768 + 256 + h * 64 + lane]; wv[j] = conv_w[j * 768 + 512 + h * 64 + lane]; }
    float xq[3] = {0.f, 0.f, 0.f}, xk[3] = {0.f, 0.f, 0.f}, xv[3] = {0.f, 0.f, 0.f};
    const float Aexp = __expf(a_log[h]), dtb = dt_bias[h];
    const float mg = mix_gain[768 + h * 64 + lane];
    float S[64];
#pragma unroll
    for (int k = 0; k < 64; ++k) S[k] = 0.f;
    for (int t = 0; t < SEQ; ++t) {
        const size_t row = (size_t)(b * SEQ + t);
        const bf16_t* pr = proj + row * NP + h * 64 + lane;
        const float q0 = bf2f(pr[C_DQ]), k0 = bf2f(pr[C_DK]), v0 = bf2f(pr[C_DV]), zv = bf2f(pr[C_DZ]);
        float q = siluf_(wq[0] * xq[0] + wq[1] * xq[1] + wq[2] * xq[2] + wq[3] * q0);
        float k = siluf_(wk[0] * xk[0] + wk[1] * xk[1] + wk[2] * xk[2] + wk[3] * k0);
        float v = siluf_(wv[0] * xv[0] + wv[1] * xv[1] + wv[2] * xv[2] + wv[3] * v0);
        xq[0] = xq[1]; xq[1] = xq[2]; xq[2] = q0; xk[0] = xk[1]; xk[1] = xk[2]; xk[2] = k0; xv[0] = xv[1]; xv[1] = xv[2]; xv[2] = v0;
        q = q * rsqrtf(wave_sum(q * q) + EPS) * 0.125f;
        k = k * rsqrtf(wave_sum(k * k) + EPS);
        const float beta = sigmoidf_(gates[row * 16 + 4 + h]);
        const float g = -Aexp * softplusf_(gates[row * 16 + 8 + h] + dtb);
        const float eg = __expf(g);
        float r = 0.f;
#pragma unroll
        for (int i = 0; i < 64; ++i) { S[i] *= eg; r += rdlane(k, i) * S[i]; }
        const float dlt = beta * (v - r);
        float o = 0.f;
#pragma unroll
        for (int i = 0; i < 64; ++i) { S[i] += rdlane(k, i) * dlt; o += rdlane(q, i) * S[i]; }
        const float ms = wave_sum(o * o) * (1.f / 64.f);
        const float yv = o * rsqrtf(ms + EPS) * siluf_(zv) * mg;
        y[row * 1024 + 768 + h * 64 + lane] = f2bf(yv);
    }
}
__device__ __forceinline__ void fox_cumsum(const float* __restrict__ gates, const float* __restrict__ fb, float* __restrict__ cc, int bh, int lane) {
    const int b = bh >> 2, h = bh & 3;
    const float bias = fb[h];
    float v[32];
#pragma unroll
    for (int i = 0; i < 32; ++i) v[i] = gates[(size_t)(b * SEQ + lane * 32 + i) * 16 + h];
    float run = 0.f;
#pragma unroll
    for (int i = 0; i < 32; ++i) { run += logsigmoidf_(v[i] + bias); v[i] = run; }
    float tot = run;
#pragma unroll
    for (int o = 1; o < 64; o <<= 1) { const float nb = __shfl_up(tot, o); if (lane >= o) tot += nb; }
    const float off = tot - run;
    float* dst = cc + (size_t)(b * 4 + h) * SEQ + lane * 32;
#pragma unroll
    for (int i = 0; i < 32; i += 4) *(f32x4*)(dst + i) = (f32x4){v[i] + off, v[i + 1] + off, v[i + 2] + off, v[i + 3] + off};
}
__device__ __forceinline__ void lru_prep_task(float* xc  , const bf16_t* __restrict__ proj, const float* __restrict__ conv_w, const float* __restrict__ conv_b,
                                              const float* __restrict__ w_a, const float* __restrict__ b_a, const float* __restrict__ w_x, const float* __restrict__ b_x,
                                              const float* __restrict__ lam, float* __restrict__ a_out, float* __restrict__ u_out, int task, bool active) {
    const int c = TIDX & 255, t0 = task * 16;
    if (active) {
        const float w0 = conv_w[c], w1 = conv_w[256 + c], w2 = conv_w[512 + c], w3 = conv_w[768 + c], cb = conv_b[c];
        for (int i = 0; i < 16; ++i) {
            const int t = t0 + i, s = t & (SEQ - 1);
            const bf16_t* pr = proj + (size_t)t * NP + C_CX + c;
            float acc = cb + w3 * bf2f(pr[0]);
            if (s >= 1) acc += w2 * bf2f(pr[-(ptrdiff_t)NP]);
            if (s >= 2) acc += w1 * bf2f(pr[-(ptrdiff_t)2 * NP]);
            if (s >= 3) acc += w0 * bf2f(pr[-(ptrdiff_t)3 * NP]);
            xc[i * 256 + c] = acc;
        }
    }
    __syncthreads();
    if (active) {
        const int h = c >> 6, jj = c & 63;
        float ra[16], rx[16];
#pragma unroll
        for (int i = 0; i < 16; ++i) { ra[i] = 0.f; rx[i] = 0.f; }
        for (int k = 0; k < 64; ++k) {
            const float wa = w_a[(h * 64 + k) * 64 + jj], wx = w_x[(h * 64 + k) * 64 + jj];
#pragma unroll
            for (int i = 0; i < 16; ++i) { const float xv = xc[i * 256 + h * 64 + k]; ra[i] += xv * wa; rx[i] += xv * wx; }
        }
        const float ba = b_a[c], bx = b_x[c], sp = softplusf_(-lam[c]);
#pragma unroll
        for (int i = 0; i < 16; ++i) {
            const float r = sigmoidf_(ra[i] + ba), ig = sigmoidf_(rx[i] + bx);
            const float log_a = -8.f * r * sp;
            const float a = __expf(log_a);
            const float u = sqrtf(-expm1f(2.f * log_a)) * (ig * xc[i * 256 + c]);
            a_out[(size_t)(t0 + i) * 256 + c] = a; u_out[(size_t)(t0 + i) * 256 + c] = u;
        }
    }
    __syncthreads();
}
__device__ __forceinline__ void lru_scan_task(const float* __restrict__ a_in, const float* __restrict__ u_in, const bf16_t* __restrict__ proj, const float* __restrict__ mix_gain, bf16_t* __restrict__ y, int b) {
    const int c = TIDX;
    const float mg = mix_gain[512 + c];
    float hst = 0.f;
    for (int t = 0; t < SEQ; ++t) {
        const size_t row = (size_t)(b * SEQ + t);
        hst = a_in[row * 256 + c] * hst + u_in[row * 256 + c];
        const float yv = hst * geluf_(bf2f(proj[row * NP + C_CG + c]));
        const float ms = wave_sum(yv * yv) * (1.f / 64.f);
        y[row * 1024 + 512 + c] = f2bf(yv * rsqrtf(ms + EPS) * mg);
    }
}

typedef short s16x4 __attribute__((ext_vector_type(4)));
#define LDS_AS __attribute__((address_space(3)))
__device__ __forceinline__ bf16x8 frag_rm(const bf16_t* tile, int ld, int r0, int k0, int lane) { return *(const bf16x8*)(tile + (r0 + (lane & 15)) * ld + k0 + (lane >> 4) * 8); }
__device__ __forceinline__ s16x4 tr4(const bf16_t* tile, int ld, int rbase, int c0, int lane) {
    const bf16_t* p = tile + (rbase + ((lane & 15) >> 2)) * ld + c0 + 4 * (lane & 3);
    return __builtin_amdgcn_ds_read_tr16_b64_v4i16((LDS_AS s16x4*)p);
}
__device__ __forceinline__ bf16x8 frag_cm(const bf16_t* tile, int ld, int k0, int c0, int lane) {
    const s16x4 lo = tr4(tile, ld, k0 + (lane >> 4) * 8, c0, lane), hi = tr4(tile, ld, k0 + (lane >> 4) * 8 + 4, c0, lane);
    return (bf16x8){lo[0], lo[1], lo[2], lo[3], hi[0], hi[1], hi[2], hi[3]};
}
#define MFMA16(a, b, c) __builtin_amdgcn_mfma_f32_16x16x32_bf16((a), (b), (c), 0, 0, 0)
constexpr int TLD = 72;


#define XB_TMO      128
#define XB_XCNT(j)  (256  + 64 * (j))
#define XB_XSUB(j)  (1280 + 64 * (j))
#define XB_XGEN(j)  (2304 + 64 * (j))
#define XB_TOP      3328
#define XB_TOPGEN   3392
#define XCD_BAR_WORDS 3456
#define XB_SPIN_CAP (1u << 18)
__device__ __forceinline__ unsigned xb_ld(unsigned* p)              { return __hip_atomic_load(p, __ATOMIC_RELAXED, __HIP_MEMORY_SCOPE_AGENT); }
__device__ __forceinline__ unsigned xb_add(unsigned* p, unsigned v) { return __hip_atomic_fetch_add(p, v, __ATOMIC_RELAXED, __HIP_MEMORY_SCOPE_AGENT); }
__device__ __forceinline__ unsigned xb_xcc_id() { return (unsigned)__builtin_amdgcn_s_getreg((3 << 11) | 20) & 0xFu; }
#define XB_SPIN(cond, bar) do { unsigned _sp = 0; while (cond) { __builtin_amdgcn_s_sleep(1); \
    if ((++_sp & 255u) == 0u) { if (xb_ld(&(bar)[XB_TMO])) break; if (_sp > XB_SPIN_CAP) { atomicAdd(&(bar)[XB_TMO], 1u); break; } } } } while (0)
struct XcdBarrier { unsigned* bar; unsigned x; volatile LDS_AS unsigned* st; };
__device__ __forceinline__ XcdBarrier xcd_barrier_post(unsigned* bar, volatile LDS_AS unsigned* st) {
    XcdBarrier b; b.bar = bar; b.x = xb_xcc_id(); b.st = st;
    if (TIDX == 0) (void)xb_add(&bar[XB_XCNT(b.x)], 1u);
    return b;
}
__device__ __forceinline__ void xcd_barrier_complete(unsigned* bar, unsigned x, unsigned& nloc, unsigned& nx) {
    const unsigned G = gridDim.x * gridDim.y * gridDim.z;
    unsigned sum, cnt, mine, sp = 0u;
    for (;;) {
        sum = 0u; cnt = 0u; mine = 0u;
#pragma unroll
        for (unsigned j = 0; j < 16; ++j) { const unsigned c = xb_ld(&bar[XB_XCNT(j)]); sum += c; cnt += (c > 0u) ? 1u : 0u; mine = (j == x) ? c : mine; }
        if (sum == G) break;
        __builtin_amdgcn_s_sleep(1);
        if ((++sp & 255u) == 0u) { if (xb_ld(&bar[XB_TMO])) break; if (sp > XB_SPIN_CAP) { atomicAdd(&bar[XB_TMO], 1u); break; } }
    }
    nloc = mine > 0u ? mine : 1u; nx = cnt > 0u ? cnt : 1u;
}
__device__ __forceinline__ void xcd_barrier(const XcdBarrier& b) {
    asm volatile("s_waitcnt vmcnt(0)" ::: "memory");
    __syncthreads();
    if (TIDX == 0) {
        unsigned* bar = b.bar;
        __builtin_amdgcn_s_waitcnt(0);
        unsigned nloc = b.st[0], nx = b.st[1];
        if (nloc == 0u) { xcd_barrier_complete(bar, b.x, nloc, nx); b.st[0] = nloc; b.st[1] = nx; }
        const unsigned old = xb_add(&bar[XB_XSUB(b.x)], 1u);
        const unsigned gen = old / nloc;
        if (old + 1u == (gen + 1u) * nloc) {
            __builtin_amdgcn_fence(__ATOMIC_RELEASE, "agent");
            asm volatile("s_waitcnt vmcnt(0)" ::: "memory");
            const unsigned og = xb_add(&bar[XB_TOP], 1u);
            const unsigned tg = og / nx;
            if (og + 1u == (tg + 1u) * nx) xb_add(&bar[XB_TOPGEN], 1u);
            else XB_SPIN(xb_ld(&bar[XB_TOPGEN]) == tg, bar);
            __builtin_amdgcn_fence(__ATOMIC_ACQUIRE, "agent");
            xb_add(&bar[XB_XGEN(b.x)], 1u);
            asm volatile("s_waitcnt vmcnt(0)" ::: "memory");
        } else {
            XB_SPIN(xb_ld(&bar[XB_XGEN(b.x)]) == gen, bar);
            __builtin_amdgcn_fence(__ATOMIC_ACQUIRE, "agent");
            asm volatile("s_waitcnt vmcnt(0)" ::: "memory");
        }
    }
    __syncthreads();
}

template <bool MASK>
__device__ __forceinline__ void attn_compute_t(const bf16_t* cK, const bf16_t* cV, const float* cC, const bf16x8 (&qf)[2], f32x4 (&oacc)[4], float& mrun, float& lrun,
                                               float ct2, float scale2, int kt, int tq, int lane, int g) {
    f32x4 sacc[4];
#pragma unroll
    for (int n = 0; n < 4; ++n) {
        sacc[n] = (f32x4){0.f, 0.f, 0.f, 0.f};
#pragma unroll
        for (int kk = 0; kk < 2; ++kk) sacc[n] = MFMA16(frag_rm(cK, TLD, n * 16, kk * 32, lane), qf[kk], sacc[n]);
    }
    float mx = -INFINITY;
#pragma unroll
    for (int n = 0; n < 4; ++n) {
        const f32x4 cs = *(const f32x4*)(cC + n * 16 + 4 * g);
#pragma unroll
        for (int r = 0; r < 4; ++r) {
            float v = sacc[n][r] * scale2 + (ct2 - cs[r]);
            if (MASK) { if (kt * 64 + n * 16 + 4 * g + r > tq) v = -INFINITY; }
            sacc[n][r] = v; mx = fmaxf(mx, v);
        }
    }
    mx = fmaxf(mx, __shfl_xor(mx, 16)); mx = fmaxf(mx, __shfl_xor(mx, 32));
    const float mnew = fmaxf(mrun, mx);
    const float corr = __builtin_amdgcn_exp2f(mrun - mnew);
    float rs = 0.f;
#pragma unroll
    for (int n = 0; n < 4; ++n)
#pragma unroll
        for (int r = 0; r < 4; ++r) { const float p = __builtin_amdgcn_exp2f(sacc[n][r] - mnew); sacc[n][r] = p; rs += p; }
    rs += __shfl_xor(rs, 16); rs += __shfl_xor(rs, 32);
    lrun = lrun * corr + rs; mrun = mnew;
    bf16x8 pf[2];
#pragma unroll
    for (int kk = 0; kk < 2; ++kk) {
        const u32x4 pk = (u32x4){pk2(sacc[2 * kk][0], sacc[2 * kk][1]), pk2(sacc[2 * kk][2], sacc[2 * kk][3]), pk2(sacc[2 * kk + 1][0], sacc[2 * kk + 1][1]), pk2(sacc[2 * kk + 1][2], sacc[2 * kk + 1][3])};
        pf[kk] = __builtin_bit_cast(bf16x8, pk);
    }
#pragma unroll
    for (int n2 = 0; n2 < 4; ++n2) {
        oacc[n2] = oacc[n2] * corr;
#pragma unroll
        for (int kk = 0; kk < 2; ++kk) {
            const s16x4 lo = tr4(cV, TLD, (2 * kk) * 16 + 4 * g, n2 * 16, lane), hi = tr4(cV, TLD, (2 * kk + 1) * 16 + 4 * g, n2 * 16, lane);
            const bf16x8 vf = (bf16x8){lo[0], lo[1], lo[2], lo[3], hi[0], hi[1], hi[2], hi[3]};
            oacc[n2] = MFMA16(vf, pf[kk], oacc[n2]);
        }
    }
}
__device__ __forceinline__ void attn_compute(const bf16_t* cK, const bf16_t* cV, const float* cC, const bf16x8 (&qf)[2], f32x4 (&oacc)[4], float& mrun, float& lrun,
                                             float ct2, float scale2, int causal, int kt, int q0, int tq, int wave, int lane, int g) {
    const int r0 = q0 + wave * 16;
    if (causal && (kt * 64 > r0 + 15)) return;
    if (causal && (kt * 64 + 63 > r0)) attn_compute_t<true>(cK, cV, cC, qf, oacc, mrun, lrun, ct2, scale2, kt, tq, lane, g);
    else attn_compute_t<false>(cK, cV, cC, qf, oacc, mrun, lrun, ct2, scale2, kt, tq, lane, g);
}

__device__ __forceinline__ void attn_task(char* smem, const bf16_t* __restrict__ Q, int ldq, const bf16_t* __restrict__ Kp, int ldk, const bf16_t* __restrict__ Vp, int ldv, const float* __restrict__ bias,
                                          int nq_per_b, int nk_per_b, int causal, float scale, bf16_t* __restrict__ O, int ldo, const float* __restrict__ gain, int rms, int task) {
    bf16_t* sK = (bf16_t*)smem;
    bf16_t* sV = sK + 2 * 64 * TLD;
    float* sC = (float*)(sV + 2 * 64 * TLD);
    const int tid = TIDX, lane = tid & 63, wave = tid >> 6, g = lane >> 4, li = lane & 15;
    const int nqt = nq_per_b / 128;
    const int qt = task % nqt, h = (task / nqt) & 3, b = task / (nqt * 4);
    const int q0 = qt * 128, tq = q0 + wave * 16 + li;
    const size_t qrow = (size_t)b * nq_per_b + tq;
    bf16x8 qf[2];
#pragma unroll
    for (int kk = 0; kk < 2; ++kk) qf[kk] = *(const bf16x8*)(Q + qrow * ldq + h * 64 + kk * 32 + g * 8);
    constexpr float LOG2E = 1.4426950408889634f;
    const float ct = bias ? bias[(size_t)(b * 4 + h) * nq_per_b + tq] * LOG2E : 0.f;
    const float scale2 = scale * LOG2E;
    const int nkt = causal ? (q0 + 128) / 64 : nk_per_b / 64;
    const int sr = tid >> 3, sc = tid & 7;
    const bf16_t* kg = Kp + ((size_t)b * nk_per_b + sr) * ldk + h * 64 + sc * 8;
    const bf16_t* vg = Vp + ((size_t)b * nk_per_b + sr) * ldv + h * 64 + sc * 8;
    const float* cg_ = bias ? bias + (size_t)(b * 4 + h) * nk_per_b : nullptr;
    u32x4 rkA, rvA, rkB, rvB; float rcA = 0.f, rcB = 0.f;
    {   const u32x4 rk = *(const u32x4*)kg, rv = *(const u32x4*)vg; const float rc = (cg_ && tid < 64) ? cg_[tid] * LOG2E : 0.f;
        __syncthreads();
        *(u32x4*)(sK + sr * TLD + sc * 8) = rk; *(u32x4*)(sV + sr * TLD + sc * 8) = rv; if (tid < 64) sC[tid] = rc; }
    rkA = *(const u32x4*)(kg + (size_t)64 * ldk); rvA = *(const u32x4*)(vg + (size_t)64 * ldv); rcA = (cg_ && tid < 64) ? cg_[64 + tid] * LOG2E : 0.f;
    __syncthreads();
    f32x4 oacc[4];
#pragma unroll
    for (int n = 0; n < 4; ++n) oacc[n] = (f32x4){0.f, 0.f, 0.f, 0.f};
    float mrun = -INFINITY, lrun = 0.f;
#define ATTN_ITER(kt, LK, LV, LC, WK, WV, WC) { \
        const int buf = (kt) & 1; \
        if ((kt) + 2 < nkt) { LK = *(const u32x4*)(kg + (size_t)((kt) + 2) * 64 * ldk); LV = *(const u32x4*)(vg + (size_t)((kt) + 2) * 64 * ldv); LC = (cg_ && tid < 64) ? cg_[((kt) + 2) * 64 + tid] * LOG2E : 0.f; } \
        attn_compute(sK + buf * 64 * TLD, sV + buf * 64 * TLD, sC + buf * 64, qf, oacc, mrun, lrun, ct, scale2, causal, (kt), q0, tq, wave, lane, g); \
        if ((kt) + 1 < nkt) { const int nb = buf ^ 1; *(u32x4*)(sK + nb * 64 * TLD + sr * TLD + sc * 8) = WK; *(u32x4*)(sV + nb * 64 * TLD + sr * TLD + sc * 8) = WV; if (tid < 64) sC[nb * 64 + tid] = WC; } \
        __syncthreads(); }
    for (int kt = 0; kt < nkt; kt += 2) {
        ATTN_ITER(kt, rkB, rvB, rcB, rkA, rvA, rcA)
        ATTN_ITER(kt + 1, rkA, rvA, rcA, rkB, rvB, rcB)
    }
#undef ATTN_ITER
    const float inv = 1.f / lrun;
    float ms = 0.f;
#pragma unroll
    for (int n = 0; n < 4; ++n) { oacc[n] = oacc[n] * inv; ms += oacc[n][0] * oacc[n][0] + oacc[n][1] * oacc[n][1] + oacc[n][2] * oacc[n][2] + oacc[n][3] * oacc[n][3]; }
    ms += __shfl_xor(ms, 16); ms += __shfl_xor(ms, 32);
    const float rinv = rms ? rsqrtf(ms * (1.f / 64.f) + EPS) : 1.f;
#pragma unroll
    for (int n = 0; n < 4; ++n) {
        const int d = n * 16 + 4 * g;
        f32x4 gg = (f32x4){1.f, 1.f, 1.f, 1.f};
        if (gain) gg = *(const f32x4*)(gain + h * 64 + d);
        uint2 o; o.x = pk2(oacc[n][0] * rinv * gg[0], oacc[n][1] * rinv * gg[1]); o.y = pk2(oacc[n][2] * rinv * gg[2], oacc[n][3] * rinv * gg[3]);
        *(uint2*)(O + qrow * ldo + h * 64 + d) = o;
    }
}


__device__ __forceinline__ void hgrn_scan(float* LF  , float* SEGT  , const bf16_t* __restrict__ prow  , const float* __restrict__ hgrn_lb, int layer, int h, float (&kk)[8]) {
    const int tid = TIDX, t = tid >> 3, k8 = (tid & 7) * 8;
    const u32x4 raw = *(const u32x4*)(prow + (size_t)t * NP + C_AF + k8);
#pragma unroll
    for (int j = 0; j < 8; ++j) {
        const float fl = __uint_as_float((j & 1) ? (raw[j >> 1] & 0xffff0000u) : (raw[j >> 1] << 16));
        float lbk = 0.f;
        if (layer == 1) { const float a0 = hgrn_lb[h * 64 + k8 + j], a1 = hgrn_lb[256 + h * 64 + k8 + j]; lbk = 1.f / (1.f + __expf(a0 - a1)); }
        const float sg = sigmoidf_(fl);
        const float f = lbk + (1.f - lbk) * sg;
        kk[j] = (1.f - lbk) * (1.f - sg);
        LF[t * 65 + k8 + j] = __logf(f);
    }
    __syncthreads();
    { const int k = tid & 63, seg = tid >> 6; float run = 0.f;
#pragma unroll
      for (int i = 0; i < 8; ++i) { run += LF[(seg * 8 + i) * 65 + k]; LF[(seg * 8 + i) * 65 + k] = run; }
      SEGT[seg * 64 + k] = run; }
    __syncthreads();
    { const int k = tid & 63, seg = tid >> 6; float off = 0.f;
      for (int s2 = 0; s2 < seg; ++s2) off += SEGT[s2 * 64 + k];
#pragma unroll
      for (int i = 0; i < 8; ++i) LF[(seg * 8 + i) * 65 + k] += off; }
    __syncthreads();
}
__device__ __forceinline__ float bfx(const u32x4& raw, int j) { return __uint_as_float((j & 1) ? (raw[j >> 1] & 0xffff0000u) : (raw[j >> 1] << 16)); }

__device__ __forceinline__ void hgrn_local_task(char* smem, const bf16_t* __restrict__ proj, const float* __restrict__ hgrn_lb, int layer, float* __restrict__ HL, float* __restrict__ HD, int ch) {
    float* LF = (float*)smem; float* SEGT = LF + 64 * 65;
    bf16_t* sKd = (bf16_t*)(SEGT + 8 * 64); bf16_t* sV = sKd + 64 * TLD;
    const int tid = TIDX, lane = tid & 63, wave = tid >> 6, g = lane >> 4, li = lane & 15;
    const int bh = ch >> 5, n = ch & 31, b = bh >> 2, h = bh & 3;
    const bf16_t* prow = proj + (size_t)(b * SEQ + n * 64) * NP + h * 64;
    const int t = tid >> 3, k8 = (tid & 7) * 8;
    __syncthreads();
    *(u32x4*)(sV + t * TLD + k8) = *(const u32x4*)(prow + (size_t)t * NP + C_AI + k8);
    float kk[8];
    hgrn_scan(LF, SEGT, prow, hgrn_lb, layer, h, kk);
    { u32x4 o;
#pragma unroll
      for (int j = 0; j < 8; j += 2) {
          const float e0 = kk[j] * __expf(LF[63 * 65 + k8 + j] - LF[t * 65 + k8 + j]), e1 = kk[j + 1] * __expf(LF[63 * 65 + k8 + j + 1] - LF[t * 65 + k8 + j + 1]);
          o[j >> 1] = pk2(e0, e1);
      }
      *(u32x4*)(sKd + t * TLD + k8) = o; }
    if (tid < 64) HD[(size_t)ch * 64 + tid] = __expf(LF[63 * 65 + tid]);
    __syncthreads();
#pragma unroll
    for (int i = 0; i < 2; ++i) {
        const int idx = wave * 2 + i, vt = idx >> 2, kt = idx & 3;
        f32x4 acc = (f32x4){0.f, 0.f, 0.f, 0.f};
#pragma unroll
        for (int ks = 0; ks < 2; ++ks) acc = MFMA16(frag_cm(sV, TLD, ks * 32, vt * 16, lane), frag_cm(sKd, TLD, ks * 32, kt * 16, lane), acc);
        *(f32x4*)(HL + (size_t)ch * 4096 + (kt * 16 + li) * 64 + vt * 16 + 4 * g) = acc;
    }
}

__device__ __forceinline__ void hgrn_out_task(char* smem, const bf16_t* __restrict__ proj, const float* __restrict__ hgrn_lb, int layer, const bf16_t* __restrict__ HS,
                                              const float* __restrict__ mix_gain, bf16_t* __restrict__ y, int ch) {
    float* LF = (float*)smem; float* SEGT = LF + 64 * 65; float* sMS = SEGT + 8 * 64;
    bf16_t* sST = (bf16_t*)(sMS + 128); bf16_t* sQ0 = sST + 64 * TLD; bf16_t* sQm = sQ0 + 64 * TLD; bf16_t* sKm = sQm + 64 * TLD; bf16_t* sV = sKm + 64 * TLD; bf16_t* sA = sV + 64 * TLD;
    const int tid = TIDX, lane = tid & 63, wave = tid >> 6, g = lane >> 4, li = lane & 15;
    const int bh = ch >> 5, n = ch & 31, b = bh >> 2, h = bh & 3;
    const bf16_t* prow = proj + (size_t)(b * SEQ + n * 64) * NP + h * 64;
    const int t = tid >> 3, k8 = (tid & 7) * 8;
    __syncthreads();
    *(u32x4*)(sST + t * TLD + k8) = *(const u32x4*)(HS + (size_t)ch * 4096 + t * 64 + k8);
    const u32x4 qraw = *(const u32x4*)(prow + (size_t)t * NP + C_AQ + k8);
    *(u32x4*)(sV + t * TLD + k8) = *(const u32x4*)(prow + (size_t)t * NP + C_AI + k8);
    float kk[8];
    hgrn_scan(LF, SEGT, prow, hgrn_lb, layer, h, kk);
    { u32x4 o0, om, ok;
#pragma unroll
      for (int j = 0; j < 8; j += 2) {
          float q0v[2], qmv[2], kmv[2];
#pragma unroll
          for (int e = 0; e < 2; ++e) {
              const float bt = LF[t * 65 + k8 + j + e], r = LF[31 * 65 + k8 + j + e], q = siluf_(bfx(qraw, j + e));
              q0v[e] = q * __expf(bt); qmv[e] = q * __expf(bt - r); kmv[e] = kk[j + e] * __expf(r - bt);
          }
          o0[j >> 1] = pk2(q0v[0], q0v[1]); om[j >> 1] = pk2(qmv[0], qmv[1]); ok[j >> 1] = pk2(kmv[0], kmv[1]);
      }
      *(u32x4*)(sQ0 + t * TLD + k8) = o0; *(u32x4*)(sQm + t * TLD + k8) = om; *(u32x4*)(sKm + t * TLD + k8) = ok; }
    __syncthreads();
#pragma unroll
    for (int i = 0; i < 2; ++i) {
        const int idx = wave * 2 + i, tt = idx >> 2, st = idx & 3;
        f32x4 acc = (f32x4){0.f, 0.f, 0.f, 0.f};
#pragma unroll
        for (int ks = 0; ks < 2; ++ks) acc = MFMA16(frag_rm(sKm, TLD, st * 16, ks * 32, lane), frag_rm(sQm, TLD, tt * 16, ks * 32, lane), acc);
        const int tq = tt * 16 + li, s0 = st * 16 + 4 * g;
        uint2 o; o.x = pk2(s0 <= tq ? acc[0] : 0.f, s0 + 1 <= tq ? acc[1] : 0.f); o.y = pk2(s0 + 2 <= tq ? acc[2] : 0.f, s0 + 3 <= tq ? acc[3] : 0.f);
        *(uint2*)(sA + tq * TLD + s0) = o;
    }
    __syncthreads();
    { const int tt = wave >> 1;
      f32x4 oacc[2]; float ms = 0.f;
#pragma unroll
      for (int i = 0; i < 2; ++i) {
          const int vt = (wave & 1) * 2 + i;
          f32x4 acc = (f32x4){0.f, 0.f, 0.f, 0.f};
#pragma unroll
          for (int ks = 0; ks < 2; ++ks) acc = MFMA16(frag_cm(sST, TLD, ks * 32, vt * 16, lane), frag_rm(sQ0, TLD, tt * 16, ks * 32, lane), acc);
#pragma unroll
          for (int ks = 0; ks < 2; ++ks) acc = MFMA16(frag_cm(sV, TLD, ks * 32, vt * 16, lane), frag_rm(sA, TLD, tt * 16, ks * 32, lane), acc);
          oacc[i] = acc; ms += acc[0] * acc[0] + acc[1] * acc[1] + acc[2] * acc[2] + acc[3] * acc[3];
      }
      ms += __shfl_xor(ms, 16); ms += __shfl_xor(ms, 32);
      if (g == 0) sMS[(tt * 16 + li) * 2 + (wave & 1)] = ms;
      __syncthreads();
      const int tq = tt * 16 + li;
      const float rinv = rsqrtf((sMS[tq * 2] + sMS[tq * 2 + 1]) * (1.f / 64.f) + EPS);
      const size_t row = (size_t)(b * SEQ + n * 64 + tq);
#pragma unroll
      for (int i = 0; i < 2; ++i) {
          const int v0 = ((wave & 1) * 2 + i) * 16 + 4 * g;
          const uint2 graw = *(const uint2*)(proj + row * NP + C_AG + h * 64 + v0);
          const f32x4 mgv = *(const f32x4*)(mix_gain + C_AQ + h * 64 + v0);
          const float g0 = __uint_as_float(graw.x << 16), g1 = __uint_as_float(graw.x & 0xffff0000u), g2 = __uint_as_float(graw.y << 16), g3 = __uint_as_float(graw.y & 0xffff0000u);
          uint2 o; o.x = pk2(oacc[i][0] * rinv * siluf_(g0) * mgv[0], oacc[i][1] * rinv * siluf_(g1) * mgv[1]);
          o.y = pk2(oacc[i][2] * rinv * siluf_(g2) * mgv[2], oacc[i][3] * rinv * siluf_(g3) * mgv[3]);
          *(uint2*)(y + row * 1024 + h * 64 + v0) = o;
      }
    }
}


constexpr int GP_BYTES = (128 + 64 * 132 + 64 * 68) * 4 + 2 * 64 * TLD * 2;
__device__ __forceinline__ void gdn_prep_pair(char* smem, const bf16_t* __restrict__ proj, const float* __restrict__ gates, const float* __restrict__ conv_w  ,
                                              const float* __restrict__ a_log, const float* __restrict__ dt_bias, bf16_t* __restrict__ gt_all, float* __restrict__ glast, int ch0) {
#define GP_SG(sub) ((float*)(smem + (sub) * GP_BYTES))
#define GP_SBETA(sub) (GP_SG(sub) + 64)
#define GP_RHS(sub) (GP_SG(sub) + 128)
#define GP_SM(sub) (GP_RHS(sub) + 64 * 132)
#define GP_SK(sub) ((bf16_t*)(GP_SM(sub) + 64 * 68))
#define GP_SQ(sub) (GP_SK(sub) + 64 * TLD)
    const int tid = TIDX, lane = tid & 63, wave = tid >> 6, g = lane >> 4, li = lane & 15;
    const int bh = ch0 >> 5, n0 = ch0 & 31, b = bh >> 2, h = bh & 3;
    const int t = tid >> 3, d8 = (tid & 7) * 8;
    __syncthreads();
    float qn[2][8], kn[2][8], vv[2][8];
#pragma unroll
    for (int sub = 0; sub < 2; ++sub) {
        const int n = n0 + sub; const size_t row0 = (size_t)(b * SEQ + n * 64);
        const int spos = n * 64 + t;
#pragma unroll
        for (int sec = 0; sec < 3; ++sec) {
            const int col = (sec == 0 ? C_DQ : (sec == 1 ? C_DK : C_DV)) + h * 64 + d8;
            float acc[8];
#pragma unroll
            for (int e = 0; e < 8; ++e) acc[e] = 0.f;
#pragma unroll
            for (int j = 0; j < 4; ++j) {
                if (spos - (3 - j) >= 0) {
                    const u32x4 raw = *(const u32x4*)(proj + (row0 + t - (3 - j)) * NP + col);
                    const f32x4 w0 = *(const f32x4*)(conv_w + j * 768 + sec * 256 + h * 64 + d8), w1 = *(const f32x4*)(conv_w + j * 768 + sec * 256 + h * 64 + d8 + 4);
#pragma unroll
                    for (int e = 0; e < 8; ++e) acc[e] += (e < 4 ? w0[e] : w1[e - 4]) * bfx(raw, e);
                }
            }
#pragma unroll
            for (int e = 0; e < 8; ++e) { const float sv = siluf_(acc[e]); if (sec == 0) qn[sub][e] = sv; else if (sec == 1) kn[sub][e] = sv; else vv[sub][e] = sv; }
        }
        float sq = 0.f, sk = 0.f;
#pragma unroll
        for (int e = 0; e < 8; ++e) { sq += qn[sub][e] * qn[sub][e]; sk += kn[sub][e] * kn[sub][e]; }
        sq += __shfl_xor(sq, 1); sq += __shfl_xor(sq, 2); sq += __shfl_xor(sq, 4);
        sk += __shfl_xor(sk, 1); sk += __shfl_xor(sk, 2); sk += __shfl_xor(sk, 4);
        const float rq = rsqrtf(sq + EPS) * 0.125f, rk = rsqrtf(sk + EPS);
#pragma unroll
        for (int e = 0; e < 8; ++e) { qn[sub][e] *= rq; kn[sub][e] *= rk; }
        if ((tid & 7) == 0) {
            const float* gr = gates + (row0 + t) * 16;
            GP_SBETA(sub)[t] = sigmoidf_(gr[4 + h]);
            GP_SG(sub)[t] = -__expf(a_log[h]) * softplusf_(gr[8 + h] + dt_bias[h]);
        }
    }
    __syncthreads();
    if (wave < 2) {
        float* sG = GP_SG(wave);
        float v = sG[lane];
#pragma unroll
        for (int o = 1; o < 64; o <<= 1) { const float nb = __shfl_up(v, o); if (lane >= o) v += nb; }
        sG[lane] = v;
    }
    __syncthreads();
#pragma unroll
    for (int sub = 0; sub < 2; ++sub) {
        const int ch = ch0 + sub; bf16_t* gt = gt_all + (size_t)ch * 5 * 4096;
        float* sG = GP_SG(sub); float* RHS = GP_RHS(sub);
        const float Gt = sG[t], Gl = sG[63], bt = GP_SBETA(sub)[t];
        const float eG = __expf(Gt), eD = __expf(Gl - Gt);
        u32x4 ok, oq, oqd, okd;
#pragma unroll
        for (int e = 0; e < 8; e += 2) {
            ok[e >> 1] = pk2(kn[sub][e], kn[sub][e + 1]); oq[e >> 1] = pk2(qn[sub][e], qn[sub][e + 1]);
            oqd[e >> 1] = pk2(qn[sub][e] * eG, qn[sub][e + 1] * eG); okd[e >> 1] = pk2(kn[sub][e] * eD, kn[sub][e + 1] * eD);
        }
        *(u32x4*)(GP_SK(sub) + t * TLD + d8) = ok; *(u32x4*)(GP_SQ(sub) + t * TLD + d8) = oq;
        *(u32x4*)(gt + 2 * 4096 + t * 64 + d8) = oqd; *(u32x4*)(gt + 3 * 4096 + t * 64 + d8) = okd;
#pragma unroll
        for (int e = 0; e < 8; ++e) { RHS[t * 132 + d8 + e] = vv[sub][e] * bt; RHS[t * 132 + 64 + d8 + e] = kn[sub][e] * bt * eG; }
        if (tid == 0) glast[ch] = __expf(Gl);
    }
    __syncthreads();
#pragma unroll
    for (int i = 0; i < 4; ++i) {
        const int idx = wave * 4 + i, sub = idx >> 4, tt = (idx >> 2) & 3, st = idx & 3;
        const bf16_t* sK = GP_SK(sub); const bf16_t* sQ = GP_SQ(sub); const float* sG = GP_SG(sub); const float* sBeta = GP_SBETA(sub); float* sM = GP_SM(sub);
        bf16_t* gt = gt_all + (size_t)(ch0 + sub) * 5 * 4096;
        f32x4 am = (f32x4){0.f, 0.f, 0.f, 0.f}, aq = (f32x4){0.f, 0.f, 0.f, 0.f};
#pragma unroll
        for (int ks = 0; ks < 2; ++ks) {
            const bf16x8 kfs = frag_rm(sK, TLD, st * 16, ks * 32, lane), kft = frag_rm(sK, TLD, tt * 16, ks * 32, lane);
            am = MFMA16(kft, kfs, am);
            aq = MFMA16(kfs, frag_rm(sQ, TLD, tt * 16, ks * 32, lane), aq);
        }
        {   const int sx = st * 16 + li, t0 = tt * 16 + 4 * g; const float Gs = sG[sx];
            f32x4 mo;
#pragma unroll
            for (int r = 0; r < 4; ++r) { const int tq = t0 + r; mo[r] = (sx < tq) ? sBeta[tq] * am[r] * __expf(sG[tq] - Gs) : 0.f; }
            *(f32x4*)(sM + sx * 68 + t0) = mo; }
        {   const int tq = tt * 16 + li, s0 = st * 16 + 4 * g; const float Gt = sG[tq];
            float ao[4];
#pragma unroll
            for (int r = 0; r < 4; ++r) { const int sx = s0 + r; ao[r] = (sx <= tq) ? aq[r] * __expf(Gt - sG[sx]) : 0.f; }
            uint2 o; o.x = pk2(ao[0], ao[1]); o.y = pk2(ao[2], ao[3]);
            *(uint2*)(gt + 4 * 4096 + tq * 64 + s0) = o; }
    }
    __syncthreads();
    if (tid < 256) {
        const int sub = tid >> 7, col = tid & 127;
        const float* RHS = GP_RHS(sub); const float* sM = GP_SM(sub);
        bf16_t* gt = gt_all + (size_t)(ch0 + sub) * 5 * 4096;
        float acc[64];
#pragma unroll
        for (int i = 0; i < 64; ++i) acc[i] = RHS[i * 132 + col];
#pragma unroll
        for (int half = 0; half < 2; ++half) {
            const int base = half * 32;
            if (half == 1) {
#pragma unroll
                for (int sx = 0; sx < 32; sx += 2) {
                    f32x4 r0[8], r1[8];
#pragma unroll
                    for (int c = 0; c < 8; ++c) { r0[c] = *(const f32x4*)(sM + sx * 68 + 32 + c * 4); r1[c] = *(const f32x4*)(sM + (sx + 1) * 68 + 32 + c * 4); }
                    const float x0 = acc[sx], x1 = acc[sx + 1];
#pragma unroll
                    for (int tq = 0; tq < 32; ++tq) { acc[32 + tq] -= r0[tq >> 2][tq & 3] * x0; acc[32 + tq] -= r1[tq >> 2][tq & 3] * x1; }
                }
            }
            f32x4 cur[8];
#pragma unroll
            for (int c = 0; c < 8; ++c) cur[c] = *(const f32x4*)(sM + base * 68 + base + c * 4);
#pragma unroll
            for (int sx = 0; sx < 31; ++sx) {
                f32x4 nxt[8];
#pragma unroll
                for (int c = (sx + 2) >> 2; c < 8; ++c) nxt[c] = *(const f32x4*)(sM + (base + sx + 1) * 68 + base + c * 4);
                const float xs = acc[base + sx];
#pragma unroll
                for (int tq = sx + 1; tq < 32; ++tq) acc[base + tq] -= cur[tq >> 2][tq & 3] * xs;
#pragma unroll
                for (int c = (sx + 2) >> 2; c < 8; ++c) cur[c] = nxt[c];
            }
        }
        if (col < 64) {
#pragma unroll
            for (int tt = 0; tt < 64; ++tt) gt[tt * 64 + col] = f2bf(acc[tt]);
        } else {
#pragma unroll
            for (int tt = 0; tt < 64; ++tt) gt[4096 + tt * 64 + (col - 64)] = f2bf(-acc[tt]);
        }
    }
#undef GP_SG
#undef GP_SBETA
#undef GP_RHS
#undef GP_SM
#undef GP_SK
#undef GP_SQ
}

__device__ __forceinline__ void gdn_scan_task(char* smem, const bf16_t* __restrict__ gt_all, const float* __restrict__ glast, const bf16_t* __restrict__ proj, const float* __restrict__ mix_gain,
                                              bf16_t* __restrict__ y, int bh) {
    bf16_t* sT = (bf16_t*)smem;
    bf16_t* sST = sT + 2 * 5 * 64 * TLD;
    bf16_t* sVn = sST + 2 * 64 * TLD;
    const int tid = TIDX, lane = tid & 63, wave = tid >> 6, g = lane >> 4, li = lane & 15;
    const int b = bh >> 2, h = bh & 3;
    const int sr = tid >> 3, sc8 = (tid & 7) * 8;
    const bf16_t* gsrc = gt_all + (size_t)bh * 32 * 5 * 4096 + sr * 64 + sc8;
    __syncthreads();
    u32x4 regs[5];
#pragma unroll
    for (int i = 0; i < 5; ++i) regs[i] = *(const u32x4*)(gsrc + i * 4096);
#pragma unroll
    for (int i = 0; i < 5; ++i) *(u32x4*)(sT + i * 64 * TLD + sr * TLD + sc8) = regs[i];
    *(u32x4*)(sST + sr * TLD + sc8) = (u32x4){0u, 0u, 0u, 0u};
    f32x4 sacc[4];
#pragma unroll
    for (int i = 0; i < 4; ++i) sacc[i] = (f32x4){0.f, 0.f, 0.f, 0.f};
    __syncthreads();
    for (int n = 0; n < 32; ++n) {
        const int buf = n & 1;
        const bf16_t* cT = sT + buf * 5 * 64 * TLD;
        const bf16_t* sU = cT; const bf16_t* sWn = cT + 64 * TLD; const bf16_t* sQd = cT + 2 * 64 * TLD; const bf16_t* sKd = cT + 3 * 64 * TLD; const bf16_t* sAq = cT + 4 * 64 * TLD;
        const bf16_t* cST = sST + buf * 64 * TLD; bf16_t* nST = sST + (buf ^ 1) * 64 * TLD;
        if (n + 1 < 32) {
#pragma unroll
            for (int i = 0; i < 5; ++i) regs[i] = *(const u32x4*)(gsrc + (size_t)(n + 1) * 5 * 4096 + i * 4096);
        }
        const size_t rowz = (size_t)(b * SEQ + n * 64 + (wave & 3) * 16 + li);
        uint2 zraw[4];
        if (wave < 4) {
#pragma unroll
            for (int vt = 0; vt < 4; ++vt) zraw[vt] = *(const uint2*)(proj + rowz * NP + C_DZ + h * 64 + vt * 16 + 4 * g);
        }
#pragma unroll
        for (int i = 0; i < 2; ++i) {
            const int idx = wave * 2 + i, tt = idx >> 2, vt = idx & 3;
            const int tq = tt * 16 + li, v0 = vt * 16 + 4 * g;
            const uint2 uraw = *(const uint2*)(sU + tq * TLD + v0);
            f32x4 acc = (f32x4){__uint_as_float(uraw.x << 16), __uint_as_float(uraw.x & 0xffff0000u), __uint_as_float(uraw.y << 16), __uint_as_float(uraw.y & 0xffff0000u)};
#pragma unroll
            for (int ks = 0; ks < 2; ++ks) acc = MFMA16(frag_rm(cST, TLD, vt * 16, ks * 32, lane), frag_rm(sWn, TLD, tt * 16, ks * 32, lane), acc);
            uint2 o; o.x = pk2(acc[0], acc[1]); o.y = pk2(acc[2], acc[3]);
            *(uint2*)(sVn + tq * TLD + v0) = o;
        }
        __syncthreads();
        if (wave < 4) {
            const int tt = wave;
            f32x4 oacc[4]; float ms = 0.f;
#pragma unroll
            for (int vt = 0; vt < 4; ++vt) {
                f32x4 acc = (f32x4){0.f, 0.f, 0.f, 0.f};
#pragma unroll
                for (int ks = 0; ks < 2; ++ks) acc = MFMA16(frag_rm(cST, TLD, vt * 16, ks * 32, lane), frag_rm(sQd, TLD, tt * 16, ks * 32, lane), acc);
#pragma unroll
                for (int ks = 0; ks < 2; ++ks) acc = MFMA16(frag_cm(sVn, TLD, ks * 32, vt * 16, lane), frag_rm(sAq, TLD, tt * 16, ks * 32, lane), acc);
                oacc[vt] = acc; ms += acc[0] * acc[0] + acc[1] * acc[1] + acc[2] * acc[2] + acc[3] * acc[3];
            }
            ms += __shfl_xor(ms, 16); ms += __shfl_xor(ms, 32);
            const float rinv = rsqrtf(ms * (1.f / 64.f) + EPS);
#pragma unroll
            for (int vt = 0; vt < 4; ++vt) {
                const int v0 = vt * 16 + 4 * g;
                const f32x4 mgv = *(const f32x4*)(mix_gain + 768 + h * 64 + v0);
                const float z0 = __uint_as_float(zraw[vt].x << 16), z1 = __uint_as_float(zraw[vt].x & 0xffff0000u), z2 = __uint_as_float(zraw[vt].y << 16), z3 = __uint_as_float(zraw[vt].y & 0xffff0000u);
                uint2 o; o.x = pk2(oacc[vt][0] * rinv * siluf_(z0) * mgv[0], oacc[vt][1] * rinv * siluf_(z1) * mgv[1]);
                o.y = pk2(oacc[vt][2] * rinv * siluf_(z2) * mgv[2], oacc[vt][3] * rinv * siluf_(z3) * mgv[3]);
                *(uint2*)(y + rowz * 1024 + 768 + h * 64 + v0) = o;
            }
        } else {
            const int kt = wave - 4;
            const float gl = glast[bh * 32 + n];
#pragma unroll
            for (int vt = 0; vt < 4; ++vt) {
                f32x4 acc = sacc[vt] * gl;
#pragma unroll
                for (int ks = 0; ks < 2; ++ks) acc = MFMA16(frag_cm(sKd, TLD, ks * 32, kt * 16, lane), frag_cm(sVn, TLD, ks * 32, vt * 16, lane), acc);
                sacc[vt] = acc;
                uint2 o; o.x = pk2(acc[0], acc[1]); o.y = pk2(acc[2], acc[3]);
                *(uint2*)(nST + (vt * 16 + li) * TLD + kt * 16 + 4 * g) = o;
            }
        }
        if (n + 1 < 32) {
            bf16_t* nT = sT + (buf ^ 1) * 5 * 64 * TLD;
#pragma unroll
            for (int i = 0; i < 5; ++i) *(u32x4*)(nT + i * 64 * TLD + sr * TLD + sc8) = regs[i];
        }
        __syncthreads();
    }
}


constexpr int XLD = 264;
__device__ __forceinline__ void lru_local_task(char* smem, const bf16_t* __restrict__ proj, const float* __restrict__ conv_w, const float* __restrict__ conv_b,
                                               const float* __restrict__ w_a, const float* __restrict__ b_a, const float* __restrict__ w_x, const float* __restrict__ b_x,
                                               const float* __restrict__ lam, float* __restrict__ hl_out, float* __restrict__ ac_out, float* __restrict__ lsum, int task) {
    bf16_t* sX = (bf16_t*)smem;
    bf16_t* sW = sX + 64 * XLD;
    const int tid = TIDX, lane = tid & 63, wave = tid >> 6, g = lane >> 4, li = lane & 15;
    const int b = task >> 5, n = task & 31;
    const size_t row0 = (size_t)(b * SEQ + n * 64);
    const int t = tid >> 3;
    __syncthreads();
    {
        const int i = tid >> 3, j8 = (tid & 7) * 8;
#pragma unroll
        for (int mat = 0; mat < 8; ++mat) {
            const float* src = ((mat & 1) ? w_x : w_a) + (size_t)(mat >> 1) * 4096 + i * 64 + j8;
            const f32x4 v0 = *(const f32x4*)src, v1 = *(const f32x4*)(src + 4);
            u32x4 o; o[0] = pk2(v0[0], v0[1]); o[1] = pk2(v0[2], v0[3]); o[2] = pk2(v1[0], v1[1]); o[3] = pk2(v1[2], v1[3]);
            *(u32x4*)(sW + mat * 64 * TLD + i * TLD + j8) = o;
        }
    }
    {
        const int spos = n * 64 + t;
#pragma unroll
        for (int i = 0; i < 4; ++i) {
            const int c8 = ((tid & 7) + 8 * i) * 8;
            float acc[8];
            { const f32x4 cb0 = *(const f32x4*)(conv_b + c8), cb1 = *(const f32x4*)(conv_b + c8 + 4);
#pragma unroll
              for (int e = 0; e < 8; ++e) acc[e] = e < 4 ? cb0[e] : cb1[e - 4]; }
#pragma unroll
            for (int j = 0; j < 4; ++j) {
                if (spos - (3 - j) >= 0) {
                    const u32x4 raw = *(const u32x4*)(proj + (row0 + t - (3 - j)) * NP + C_CX + c8);
                    const f32x4 w0 = *(const f32x4*)(conv_w + j * 256 + c8), w1 = *(const f32x4*)(conv_w + j * 256 + c8 + 4);
#pragma unroll
                    for (int e = 0; e < 8; ++e) acc[e] += (e < 4 ? w0[e] : w1[e - 4]) * bfx(raw, e);
                }
            }
            u32x4 o; o[0] = pk2(acc[0], acc[1]); o[1] = pk2(acc[2], acc[3]); o[2] = pk2(acc[4], acc[5]); o[3] = pk2(acc[6], acc[7]);
            *(u32x4*)(sX + t * XLD + c8) = o;
        }
    }
    __syncthreads();
    const int hh = wave >> 1;
#pragma unroll
    for (int j2 = 0; j2 < 2; ++j2) {
        const int jt = (wave & 1) * 2 + j2, cl = jt * 16 + 4 * g, c = hh * 64 + cl;
        f32x4 ra[4], rx[4];
#pragma unroll
        for (int tt = 0; tt < 4; ++tt) { ra[tt] = (f32x4){0.f, 0.f, 0.f, 0.f}; rx[tt] = (f32x4){0.f, 0.f, 0.f, 0.f}; }
#pragma unroll
        for (int ks = 0; ks < 2; ++ks) {
            const bf16x8 wa = frag_cm(sW + (hh * 2) * 64 * TLD, TLD, ks * 32, jt * 16, lane), wx = frag_cm(sW + (hh * 2 + 1) * 64 * TLD, TLD, ks * 32, jt * 16, lane);
#pragma unroll
            for (int tt = 0; tt < 4; ++tt) {
                const bf16x8 xf = frag_rm(sX + hh * 64, XLD, tt * 16, ks * 32, lane);
                ra[tt] = MFMA16(wa, xf, ra[tt]);
                rx[tt] = MFMA16(wx, xf, rx[tt]);
            }
        }
        const f32x4 ba = *(const f32x4*)(b_a + c), bx = *(const f32x4*)(b_x + c), lm = *(const f32x4*)(lam + c);
        float sp[4];
#pragma unroll
        for (int r = 0; r < 4; ++r) sp[r] = softplusf_(-lm[r]);
        f32x4 cA = (f32x4){1.f, 1.f, 1.f, 1.f}, cH = (f32x4){0.f, 0.f, 0.f, 0.f};
#pragma unroll
        for (int tt = 0; tt < 4; ++tt) {
            const int tq = tt * 16 + li;
            const uint2 xraw = *(const uint2*)(sX + tq * XLD + c);
            const float xc[4] = {__uint_as_float(xraw.x << 16), __uint_as_float(xraw.x & 0xffff0000u), __uint_as_float(xraw.y << 16), __uint_as_float(xraw.y & 0xffff0000u)};
            f32x4 A, H;
#pragma unroll
            for (int r = 0; r < 4; ++r) {
                const float rr = sigmoidf_(ra[tt][r] + ba[r]), ig = sigmoidf_(rx[tt][r] + bx[r]);
                const float log_a = -8.f * rr * sp[r];
                A[r] = __expf(log_a);
                H[r] = sqrtf(-expm1f(2.f * log_a)) * (ig * xc[r]);
            }
#pragma unroll
            for (int o = 1; o < 16; o <<= 1) {
#pragma unroll
                for (int r = 0; r < 4; ++r) {
                    const float pA = __shfl_up(A[r], o, 16), pH = __shfl_up(H[r], o, 16);
                    if (li >= o) { H[r] = A[r] * pH + H[r]; A[r] = A[r] * pA; }
                }
            }
            const f32x4 Hf = H + A * cH, Af = A * cA;
            const size_t oidx = (row0 + tq) * 256 + c;
            *(f32x4*)(hl_out + oidx) = Hf; *(f32x4*)(ac_out + oidx) = Af;
#pragma unroll
            for (int r = 0; r < 4; ++r) { cH[r] = __shfl(Hf[r], 15, 16); cA[r] = __shfl(Af[r], 15, 16); }
            if (tt == 3 && li == 15) { *(f32x4*)(lsum + (size_t)task * 256 + c) = Af; *(f32x4*)(lsum + (size_t)(256 + task) * 256 + c) = Hf; }
        }
    }
}
__device__ __forceinline__ void lru_out_task(const float* __restrict__ hl_in, const float* __restrict__ ac_in, const float* __restrict__ lsum, const bf16_t* __restrict__ proj,
                                             const float* __restrict__ mix_gain, bf16_t* __restrict__ y, int task) {
    const int b = task >> 5, n = task & 31, c = TIDX & 255, half = TIDX >> 8;
    const float Hc = lsum[(size_t)task * 256 + c];
    const float mg = mix_gain[512 + c];
    const size_t row0 = (size_t)(b * SEQ + n * 64 + half * 32);
#pragma unroll
    for (int i0 = 0; i0 < 32; i0 += 16) {
        float hv[16], av[16]; bf16_t gv[16];
#pragma unroll
        for (int i = 0; i < 16; ++i) { const size_t row = row0 + i0 + i; hv[i] = hl_in[row * 256 + c]; av[i] = ac_in[row * 256 + c]; gv[i] = proj[row * NP + C_CG + c]; }
#pragma unroll
        for (int i = 0; i < 16; ++i) {
            const size_t row = row0 + i0 + i;
            const float yv = (hv[i] + av[i] * Hc) * geluf_(bf2f(gv[i]));
            const float ms = wave_sum(yv * yv) * (1.f / 64.f);
            y[row * 1024 + 512 + c] = f2bf(yv * rsqrtf(ms + EPS) * mg);
        }
    }
}


__device__ __forceinline__ void state_scan_phase(const float* __restrict__ HL, const float* __restrict__ HD, bf16_t* __restrict__ HS, const float* __restrict__ lsum, float* __restrict__ lcar) {
    const int bx = blockIdx.x, tid = TIDX;
    for (int u = bx; u < 128 + 4; u += gridDim.x) {
        if (u < 128) {
            const int gid = u * NTHR + tid, bh = gid >> 11, v = gid & 63, kp = (gid >> 6) & 31;
            const float* Lb = HL + (size_t)bh * 32 * 4096 + (2 * kp) * 64 + v; const float* Db = HD + (size_t)bh * 32 * 64 + 2 * kp;
            bf16_t* Sb = HS + (size_t)bh * 32 * 4096 + (2 * kp) * 64 + v;
            float S0 = 0.f, S1 = 0.f;
            for (int n0 = 0; n0 < 32; n0 += 8) {
                float l0[8], l1[8], d0[8], d1[8];
#pragma unroll
                for (int i = 0; i < 8; ++i) { l0[i] = Lb[(size_t)(n0 + i) * 4096]; l1[i] = Lb[(size_t)(n0 + i) * 4096 + 64]; d0[i] = Db[(n0 + i) * 64]; d1[i] = Db[(n0 + i) * 64 + 1]; }
#pragma unroll
                for (int i = 0; i < 8; ++i) {
                    Sb[(size_t)(n0 + i) * 4096] = f2bf(S0); Sb[(size_t)(n0 + i) * 4096 + 64] = f2bf(S1);
                    S0 = d0[i] * S0 + l0[i]; S1 = d1[i] * S1 + l1[i];
                }
            }
        } else {
            const int gid = (u - 128) * NTHR + tid, b = gid >> 8, c = gid & 255;
            float A[32], H[32];
#pragma unroll
            for (int n = 0; n < 32; ++n) { A[n] = lsum[(size_t)(b * 32 + n) * 256 + c]; H[n] = lsum[(size_t)(256 + b * 32 + n) * 256 + c]; }
            float Hc = 0.f;
#pragma unroll
            for (int n = 0; n < 32; ++n) { lcar[(size_t)(b * 32 + n) * 256 + c] = Hc; Hc = A[n] * Hc + H[n]; }
        }
    }
}

__device__ __forceinline__ void router_phase(char* smem, const float* __restrict__ x, const float* __restrict__ g, const bf16_t* __restrict__ wr  , const float* __restrict__ b_rg,
                                             const float* __restrict__ b_re, const float* __restrict__ pss, int* __restrict__ cnt, int* __restrict__ list, float* __restrict__ pgate) {
    bf16_t* sXh = (bf16_t*)smem;
    bf16_t* sXl = sXh + 64 * TLD;
    float* sLog = (float*)(sXl + 64 * TLD);
    const int tid = TIDX, lane = tid & 63, wave = tid >> 6, gq = lane >> 4, li = lane & 15;
    const int mt = wave & 3, kh = wave >> 2;
    const int stok = tid >> 3, c8 = (tid & 7) * 8;
    BLK_LOOP(tile, T / 64) {
        const int t0 = tile * 64;
        f32x4 acc[3];
#pragma unroll
        for (int n = 0; n < 3; ++n) acc[n] = (f32x4){0.f, 0.f, 0.f, 0.f};
        const float* xp = x + (size_t)(t0 + stok) * 1024 + c8;
        const bf16_t* wp = wr + (size_t)li * 1024 + kh * 32 + gq * 8;
        f32x4 x0 = *(const f32x4*)xp, x1 = *(const f32x4*)(xp + 4);
        u32x4 wh[3], wl[3];
#pragma unroll
        for (int n = 0; n < 3; ++n) { wh[n] = *(const u32x4*)(wp + n * 16 * 1024); wl[n] = *(const u32x4*)(wp + 48 * 1024 + n * 16 * 1024); }
        for (int kc = 0; kc < 16; ++kc) {
            const f32x4 g0 = *(const f32x4*)(g + kc * 64 + c8), g1 = *(const f32x4*)(g + kc * 64 + c8 + 4);
            const f32x4 v0 = x0 * g0, v1 = x1 * g1;
            u32x4 oh, ol;
#pragma unroll
            for (int j = 0; j < 2; ++j) {
                const unsigned h0 = pk2(v0[2 * j], v0[2 * j + 1]), h1 = pk2(v1[2 * j], v1[2 * j + 1]);
                oh[j] = h0; oh[2 + j] = h1;
                ol[j] = pk2(v0[2 * j] - __uint_as_float(h0 << 16), v0[2 * j + 1] - __uint_as_float(h0 & 0xffff0000u));
                ol[2 + j] = pk2(v1[2 * j] - __uint_as_float(h1 << 16), v1[2 * j + 1] - __uint_as_float(h1 & 0xffff0000u));
            }
            __syncthreads();
            *(u32x4*)(sXh + stok * TLD + c8) = oh; *(u32x4*)(sXl + stok * TLD + c8) = ol;
            __syncthreads();
            u32x4 cwh[3], cwl[3];
#pragma unroll
            for (int n = 0; n < 3; ++n) { cwh[n] = wh[n]; cwl[n] = wl[n]; }
            if (kc + 1 < 16) {
                x0 = *(const f32x4*)(xp + (kc + 1) * 64); x1 = *(const f32x4*)(xp + (kc + 1) * 64 + 4);
#pragma unroll
                for (int n = 0; n < 3; ++n) { wh[n] = *(const u32x4*)(wp + n * 16 * 1024 + (kc + 1) * 64); wl[n] = *(const u32x4*)(wp + 48 * 1024 + n * 16 * 1024 + (kc + 1) * 64); }
            }
            const bf16x8 xh = frag_rm(sXh, TLD, mt * 16, kh * 32, lane), xl = frag_rm(sXl, TLD, mt * 16, kh * 32, lane);
#pragma unroll
            for (int n = 0; n < 3; ++n) {
                const bf16x8 fh = __builtin_bit_cast(bf16x8, cwh[n]), fl = __builtin_bit_cast(bf16x8, cwl[n]);
                acc[n] = MFMA16(fh, xh, acc[n]);
                acc[n] = MFMA16(fl, xh, acc[n]);
                acc[n] = MFMA16(fh, xl, acc[n]);
            }
        }
#pragma unroll
        for (int n = 0; n < 3; ++n) *(f32x4*)(sLog + (kh * 64 + mt * 16 + li) * 48 + n * 16 + 4 * gq) = acc[n];
        __syncthreads();
        int* sCnt = (int*)(sLog + 2 * 64 * 48);
        if (tid < 64) sCnt[tid] = 0;
        __syncthreads();
        int ex0 = 0, ex1 = 0, lr0 = 0, lr1 = 0; float gw0 = 0.f, gw1 = 0.f;
        if (tid < 64) {
            const float rinv = rinv_from_pss(pss, (size_t)(t0 + tid));
            const float* l0 = sLog + tid * 48; const float* l1 = sLog + (64 + tid) * 48;
            float lg[4];
#pragma unroll
            for (int i = 0; i < 4; ++i) lg[i] = (l0[i] + l1[i]) * rinv + b_rg[i];
            int gs = 0; float gm = lg[0];
#pragma unroll
            for (int i = 1; i < 4; ++i) if (lg[i] > gm) { gm = lg[i]; gs = i; }
            float den = 0.f;
#pragma unroll
            for (int i = 0; i < 4; ++i) den += __expf(lg[i] - gm);
            const float pg = 1.f / den;
            int i0 = 0, i1 = -1; float m0 = -INFINITY, m1 = -INFINITY;
            for (int i = 0; i < 8; ++i) {
                const float v = (l0[4 + gs * 8 + i] + l1[4 + gs * 8 + i]) * rinv + b_re[gs * 8 + i];
                if (v > m0) { m1 = m0; i1 = i0; m0 = v; i0 = i; } else if (v > m1) { m1 = v; i1 = i; }
            }
            const float e1 = __expf(m1 - m0);
            gw0 = pg / (1.f + e1); gw1 = pg * e1 / (1.f + e1);
            ex0 = gs * 8 + i0; ex1 = gs * 8 + i1;
            lr0 = atomicAdd(&sCnt[ex0], 1); lr1 = atomicAdd(&sCnt[ex1], 1);
        }
        __syncthreads();
        if (tid < 32) { const int c = sCnt[tid]; sCnt[32 + tid] = c ? atomicAdd(&cnt[tid * CNT_STRIDE], c) : 0; }
        __syncthreads();
        if (tid < 64) {
            const int t = t0 + tid;
            list[(size_t)ex0 * T + sCnt[32 + ex0] + lr0] = 2 * t; pgate[2 * t] = gw0;
            list[(size_t)ex1 * T + sCnt[32 + ex1] + lr1] = 2 * t + 1; pgate[2 * t + 1] = gw1;
        }
        __syncthreads();
    }
}

__device__ __forceinline__ void combine_phase(const float* x2, const bf16_t* __restrict__ eo, const float* __restrict__ g, float* xout, bf16_t* __restrict__ hn, int mode) {
    const int lane = TIDX & 63;
    for (int t = blockIdx.x * 8 + (TIDX >> 6); t < T; t += gridDim.x * 8) {
        f32x4 v[4]; float s = 0.f;
#pragma unroll
        for (int j = 0; j < 4; ++j) {
            const int c = (lane + 64 * j) * 4;
            v[j] = *(const f32x4*)(x2 + (size_t)t * 1024 + c);
            const uint2 e0 = *(const uint2*)(eo + (size_t)(2 * t) * 1024 + c), e1 = *(const uint2*)(eo + (size_t)(2 * t + 1) * 1024 + c);
            v[j].x += __uint_as_float(e0.x << 16) + __uint_as_float(e1.x << 16);
            v[j].y += __uint_as_float(e0.x & 0xffff0000u) + __uint_as_float(e1.x & 0xffff0000u);
            v[j].z += __uint_as_float(e0.y << 16) + __uint_as_float(e1.y << 16);
            v[j].w += __uint_as_float(e0.y & 0xffff0000u) + __uint_as_float(e1.y & 0xffff0000u);
            s += v[j].x * v[j].x + v[j].y * v[j].y + v[j].z * v[j].z + v[j].w * v[j].w;
        }
        const float rinv = rsqrtf(wave_sum(s) * (1.f / 1024.f) + EPS);
#pragma unroll
        for (int j = 0; j < 4; ++j) {
            const int c = (lane + 64 * j) * 4;
            const f32x4 gg = *(const f32x4*)(g + c);
            const f32x4 hv = v[j] * rinv * gg;
            if (mode == 0) {
                *(f32x4*)(xout + (size_t)t * 1024 + c) = v[j];
                uint2 o; o.x = pk2(hv.x, hv.y); o.y = pk2(hv.z, hv.w);
                *(uint2*)(hn + (size_t)t * 1024 + c) = o;
            } else {
                *(f32x4*)(xout + (size_t)t * 1024 + c) = hv;
            }
        }
    }
}

template <int l>
__device__ __forceinline__ void layer_body(const Params& P, char* smem, const XcdBarrier& xb, const float* xcur) {
    char* ws = P.ws;
    bf16_t* Wt_in = (bf16_t*)(ws + OFF_WIN); bf16_t* Wt_out = (bf16_t*)(ws + OFF_WOUT); bf16_t* Wt_mq = (bf16_t*)(ws + OFF_WMQ); bf16_t* Wt_mkv = (bf16_t*)(ws + OFF_WMKV);
    bf16_t* Wt_mo = (bf16_t*)(ws + OFF_WMO); bf16_t* Wt_gu = (bf16_t*)(ws + OFF_WGU); bf16_t* Wt_dn = (bf16_t*)(ws + OFF_WDN);
    bf16_t* hn = (bf16_t*)(ws + OFF_HN); bf16_t* proj = (bf16_t*)(ws + OFF_PROJ); float* gates = (float*)(ws + OFF_GATES); bf16_t* y = (bf16_t*)(ws + OFF_Y);
    float* XA = P.out; float* XB = (float*)(ws + OFF_XB);
    bf16_t* qm = (bf16_t*)(ws + OFF_QM); bf16_t* om = (bf16_t*)(ws + OFF_OM); bf16_t* kvm = (bf16_t*)(ws + OFF_KVM); bf16_t* memn = (bf16_t*)(ws + OFF_MEMN);
    float* foxc = (float*)(ws + OFF_FOXC); float* lrua = (float*)(ws + OFF_LRUA); float* lruu = (float*)(ws + OFF_LRUU);
    int* cnt_all = (int*)(ws + OFF_CTL) + CTL_CNT_WORD; int* list = (int*)(ws + OFF_LIST); float* pgate = (float*)(ws + OFF_PGATE);
    bf16_t* act = (bf16_t*)(ws + OFF_ACT); bf16_t* eo = (bf16_t*)(ws + OFF_EO); float* pss = (float*)(ws + OFF_PSS);
    const int wave = TIDX >> 6, lane = TIDX & 63;


        float* x1 = (l == 0) ? XA : XB;
        float* x2 = (l == 0) ? XB : XA;
        int* cnt = cnt_all + 32 * CNT_STRIDE * l;
        const float* mg = P.in[I_MIX_GAIN] + l * 1024;
        REP(2, { pg8::Gemm g{hn, Wt_in + (size_t)l * NP * 1024, T, NP, 1024}; pg8::StaticOrder S; S.init(T, NP, (int)gridDim.x, (int)blockIdx.x);
                 pg8::EpiInProj E{proj, NP, gates, C_GATE};
                 pg8::gemm_phase<pg8::EpiInProj, pg8::StaticOrder, true, true>((PG8_LAS unsigned char*)smem, g, S, E); });
        if (l == 0) for (int l2 = 0; l2 < NL; ++l2)
            gemm_phase<EPI_BF16>(smem, memn + (size_t)l2 * 2048 * 1024, 1024, Wt_mkv + (size_t)l2 * 512 * 1024, 1024, 2048, 512, 1024, kvm + (size_t)l2 * 2048 * 512, 512, nullptr, nullptr,
                                 (gridDim.x >= 192) ? ((int)blockIdx.x - 128 - 32 * l2) : (int)blockIdx.x, (gridDim.x >= 192) ? 4096 : (int)gridDim.x);
        GSYNC();
        REP(4,         {
            const int bx = blockIdx.x;
            bf16_t* gtiles = (bf16_t*)(ws + OFF_GDN); float* glast = (float*)(ws + OFF_GLAST);
            if (bx < 32 && wave == 1) fox_cumsum(gates, P.in[I_FOX_FB] + l * 4, foxc, bx, lane);
            BLK_LOOP(cp, 512) gdn_prep_pair(smem, proj, gates, P.in[I_GDN_CONV_W] + l * 4 * 768, P.in[I_GDN_A_LOG] + l * 4, P.in[I_GDN_DT_BIAS] + l * 4, gtiles, glast, 2 * cp);
            BLK_LOOP(ch, 1024) hgrn_local_task(smem, proj, P.in[I_HGRN_LB], l, (float*)(ws + OFF_HL), (float*)(ws + OFF_HD), ch);
            BLK_LOOP(task, 256) lru_local_task(smem, proj, P.in[I_LRU_CONV_W] + l * 1024, P.in[I_LRU_CONV_B] + l * 256, P.in[I_LRU_WA] + l * 16384, P.in[I_LRU_BA] + l * 256,
                                               P.in[I_LRU_WX] + l * 16384, P.in[I_LRU_BX] + l * 256, P.in[I_LRU_LAM] + l * 256, lrua, lruu, (float*)(ws + OFF_LSUM), task);
        });
        GSYNC();
        state_scan_phase((const float*)(ws + OFF_HL), (const float*)(ws + OFF_HD), (bf16_t*)(ws + OFF_HS), (const float*)(ws + OFF_LSUM), (float*)(ws + OFF_LCAR));
        GSYNC();
        REP(8,         {
            const int natt = (SEQ / 128) * 4 * NB;
            const int bx = blockIdx.x, nfree = (int)gridDim.x - 32;
            if (bx < 32) gdn_scan_task(smem, (const bf16_t*)(ws + OFF_GDN), (const float*)(ws + OFF_GLAST), proj, mg, y, bx);
            else {
                for (int r = 0; r * nfree < natt; ++r) {
                    const int i = r * nfree + ((r & 1) ? (nfree - 1 - (bx - 32)) : (bx - 32));
                    if (i >= natt) continue;
                    const int qt = 15 - (i >> 5), bh = i & 31;
                    attn_task(smem, proj + C_BQ, NP, proj + C_BK, NP, proj + C_BV, NP, foxc, SEQ, SEQ, 1, 0.125f, y + 256, 1024, mg + 256, 1, (bh * 16) + qt);
                }
                for (int i = bx - 32; i < 1024; i += nfree) {
                    const int ch = (i & 31) * 32 + (31 - (i >> 5));
                    hgrn_out_task(smem, proj, P.in[I_HGRN_LB], l, (const bf16_t*)(ws + OFF_HS), mg, y, ch);
                }
                for (int i = bx - 32; i < 256; i += nfree) lru_out_task(lrua, lruu, (const float*)(ws + OFF_LCAR), proj, mg, y, i);
            }
        });
        GSYNC();
        REP(16, { pg8::Gemm g{y, Wt_out + (size_t)l * 1024 * 1024, T, 1024, 1024}; pg8::StaticOrder S; S.init(T, 1024, (int)gridDim.x, (int)blockIdx.x);
                  pg8::EpiResidNorm E{xcur, x1, 1024, P.in[I_NORM_MEM] + l * 1024, hn, pss};
                  pg8::gemm_phase<pg8::EpiResidNorm, pg8::StaticOrder, true, true>((PG8_LAS unsigned char*)smem, g, S, E); });
        GSYNC();
        REP(64, gemm_phase<EPI_BF16_RS>(smem, hn, 1024, Wt_mq + (size_t)l * 256 * 1024, 1024, T, 256, 1024, qm, 256, pss, nullptr));
        GSYNC();
        { const bf16_t* kv = kvm + (size_t)l * 2048 * 512;
          REP(128, BLK_LOOP(task, (SEQ / 128) * 4 * NB) attn_task(smem, qm, 256, kv, 512, kv + 256, 512, nullptr, SEQ, MEMLEN, 0, 0.125f, om, 256, nullptr, 0, task)); }
        GSYNC();
        REP(256, gemm_phase<EPI_RESID_NORM>(smem, om, 256, Wt_mo + (size_t)l * 1024 * 256, 256, T, 1024, 256, x2, 1024, x1, pss, -1, 0, hn, P.in[I_NORM_FFN] + l * 1024));
        GSYNC();
        router_phase(smem, x2, P.in[I_NORM_FFN] + l * 1024, (const bf16_t*)(ws + OFF_WR) + (size_t)l * 2 * 48 * 1024, P.in[I_B_RG] + l * 4, P.in[I_B_RE] + l * 32, pss, cnt, list, pgate);
        GSYNC();
        REP(512, moe_phase<1>(smem, hn, 1024, Wt_gu + (size_t)l * 32 * 512 * 1024, (size_t)512 * 1024, 1024, 1024, cnt, list, pgate, act, pss));
        GSYNC();
        REP(1024, moe_phase<2>(smem, act, 256, Wt_dn + (size_t)l * 32 * 1024 * 256, (size_t)1024 * 256, 256, 256, cnt, list, pgate, eo, pss));
        if (PROBE_MASK & 2048) { for (int i = 0; i < 10; ++i) GSYNC(); }
        GSYNC();
        if (l == 0) { combine_phase(x2, eo, P.in[I_NORM_MIX] + 1024, XA, hn, 0); GSYNC(); }
        else combine_phase(x2, eo, P.in[I_NORM_FINAL], P.out, hn, 1);
}
__global__ void __launch_bounds__(NTHR, 2) mega_kernel(Params P) {
    extern __shared__ __attribute__((aligned(16))) char smem[];
    volatile LDS_AS unsigned* st = (volatile LDS_AS unsigned*)(smem + LDS_BYTES - 16);
    if (TIDX < 4) st[TIDX] = 0u;
    __syncthreads();
    const XcdBarrier xb = xcd_barrier_post((unsigned*)(P.ws + OFF_CTL), st);
    phase0(P, smem);
    GSYNC();
    layer_body<0>(P, smem, xb, P.in[I_X]);
    layer_body<1>(P, smem, xb, P.out);
}

extern "C" void kernel_launch(void* const* d_in, const int* in_sizes, int n_in, void* d_out, int out_size, void* d_ws, size_t ws_size, hipStream_t stream) {
    static int grid_blocks = 0;
    if (grid_blocks == 0) {
        if (n_in != N_INPUTS || ws_size < OFF_END || out_size != T * 1024) { fprintf(stderr, "kernel_launch: unexpected sizes n_in=%d ws=%zu out=%d (need ws >= %zu)\n", n_in, ws_size, out_size, (size_t)OFF_END); grid_blocks = -1; return; }
        int dev = 0, cus = 0, per_cu = 0;
        if (hipGetDevice(&dev) != hipSuccess || hipDeviceGetAttribute(&cus, hipDeviceAttributeMultiprocessorCount, dev) != hipSuccess) { fprintf(stderr, "kernel_launch: device query failed\n"); grid_blocks = -1; return; }
        if (hipFuncSetAttribute((const void*)mega_kernel, hipFuncAttributeMaxDynamicSharedMemorySize, LDS_BYTES) != hipSuccess) { fprintf(stderr, "kernel_launch: hipFuncSetAttribute failed\n"); grid_blocks = -1; return; }
        if (hipOccupancyMaxActiveBlocksPerMultiprocessor(&per_cu, (const void*)mega_kernel, NTHR, LDS_BYTES) != hipSuccess || per_cu < 1) { fprintf(stderr, "kernel_launch: occupancy query says %d blocks/CU\n", per_cu); grid_blocks = -1; return; }
        grid_blocks = cus;
        fprintf(stderr, "kernel_launch: cus=%d per_cu=%d grid=%d\n", cus, per_cu, grid_blocks);
    }
    if (grid_blocks < 0) return;
    if (hipMemsetAsync((char*)d_ws + OFF_CTL, 0, CTL_BYTES, stream) != hipSuccess) { fprintf(stderr, "kernel_launch: memset failed\n"); return; }
    Params p; memset(&p, 0, sizeof p);
    for (int i = 0; i < N_INPUTS; ++i) p.in[i] = (const float*)d_in[i];
    p.out = (float*)d_out; p.ws = (char*)d_ws;
    void* args[] = {&p};
    hipError_t e = hipLaunchCooperativeKernel((const void*)mega_kernel, dim3(grid_blocks), dim3(NTHR), args, LDS_BYTES, stream);
    if (e != hipSuccess) fprintf(stderr, "kernel_launch: cooperative launch failed: %s (grid %d)\n", hipGetErrorString(e), grid_blocks);
}
```

```cpp
#include <hip/hip_runtime.h>
#include <stdint.h>
#include <stdio.h>
#include <string.h>
#include <hip/hip_cooperative_groups.h>
namespace cg = cooperative_groups;

typedef unsigned short bf16_t;
typedef short bf16x8 __attribute__((ext_vector_type(8)));
typedef float f32x4 __attribute__((ext_vector_type(4)));
typedef unsigned u32x4 __attribute__((ext_vector_type(4)));

constexpr int NB = 8, SEQ = 2048, DM = 1024, T = NB * SEQ, NL = 2;
constexpr int NP = 3584;
constexpr int NIN = 3340;
constexpr int C_AQ = 0, C_AF = 256, C_AI = 512, C_AG = 768, C_BQ = 1024, C_BK = 1280, C_BV = 1536, C_CX = 1792, C_CG = 2048,
              C_DQ = 2304, C_DK = 2560, C_DV = 2816, C_DZ = 3072, C_GATE = 3328;
constexpr int MEMLEN = 256;
constexpr int NEXP = 32, DEXP = 256;
constexpr float EPS = 1e-6f;

constexpr size_t al256(size_t x) { return (x + 255) & ~(size_t)255; }
constexpr size_t SZ_WIN = (size_t)NP * 1024 * 2, SZ_WOUT = (size_t)1024 * 1024 * 2, SZ_WMQ = (size_t)256 * 1024 * 2, SZ_WMKV = (size_t)512 * 1024 * 2,
                 SZ_WMO = (size_t)1024 * 256 * 2, SZ_WGU = (size_t)32 * 512 * 1024 * 2, SZ_WDN = (size_t)32 * 1024 * 256 * 2;
constexpr size_t OFF_WIN = 0;
constexpr size_t OFF_WOUT = OFF_WIN + NL * SZ_WIN;
constexpr size_t OFF_WMQ = OFF_WOUT + NL * SZ_WOUT;
constexpr size_t OFF_WMKV = OFF_WMQ + NL * SZ_WMQ;
constexpr size_t OFF_WMO = OFF_WMKV + NL * SZ_WMKV;
constexpr size_t OFF_WGU = OFF_WMO + NL * SZ_WMO;
constexpr size_t OFF_WDN = OFF_WGU + NL * SZ_WGU;
constexpr size_t OFF_HN = OFF_WDN + NL * SZ_WDN;
constexpr size_t OFF_PROJ = OFF_HN + (size_t)T * 1024 * 2;
constexpr size_t OFF_GATES = OFF_PROJ + (size_t)T * NP * 2;
constexpr size_t OFF_Y = OFF_GATES + (size_t)T * 16 * 4;
constexpr size_t OFF_XB = OFF_Y + (size_t)T * 1024 * 2;
constexpr size_t OFF_QM = OFF_XB + (size_t)T * 1024 * 4;
constexpr size_t OFF_OM = OFF_QM + (size_t)T * 256 * 2;
constexpr size_t OFF_KVM = OFF_OM + (size_t)T * 256 * 2;
constexpr size_t OFF_MEMN = OFF_KVM + (size_t)NL * 2048 * 512 * 2;
constexpr size_t OFF_FOXC = OFF_MEMN + (size_t)2048 * 1024 * 2;
constexpr size_t OFF_LRUA = OFF_FOXC + (size_t)NB * 4 * SEQ * 4;
constexpr size_t OFF_LRUU = OFF_LRUA + (size_t)T * 256 * 4;
constexpr size_t OFF_CNT = OFF_LRUU + (size_t)T * 256 * 4;
constexpr size_t OFF_LIST = OFF_CNT + 256;
constexpr size_t OFF_PGATE = OFF_LIST + (size_t)NEXP * T * 4;
constexpr size_t OFF_HL = OFF_PGATE + (size_t)2 * T * 4;
constexpr size_t OFF_HD = OFF_HL + (size_t)1024 * 4096 * 4;
constexpr size_t OFF_GDN = OFF_HD + (size_t)1024 * 64 * 4;
constexpr size_t OFF_GLAST = OFF_GDN + (size_t)1024 * 5 * 4096 * 2;
constexpr size_t OFF_LSUM = OFF_GLAST + 4096;
constexpr size_t OFF_HS = OFF_LSUM + (size_t)2 * 256 * 256 * 4;
constexpr size_t OFF_LCAR = OFF_HS + (size_t)1024 * 4096 * 2;
constexpr size_t OFF_PSS = OFF_LCAR + (size_t)256 * 256 * 4;
constexpr size_t OFF_WR = OFF_PSS + (size_t)T * 16 * 4;
constexpr size_t OFF_CTL = OFF_WR + (size_t)NL * 2 * 48 * 1024 * 2;
constexpr size_t CTL_BYTES = 32768;
constexpr int CTL_CNT_WORD = 4096;
constexpr int CNT_STRIDE = 64;
constexpr size_t OFF_END = OFF_CTL + CTL_BYTES;
constexpr size_t OFF_ACT = OFF_PROJ;
constexpr size_t OFF_EO = OFF_PROJ + (size_t)2 * T * 256 * 2;
static_assert(OFF_EO + (size_t)2 * T * 1024 * 2 <= OFF_GATES, "overlay fits");

__device__ __forceinline__ int tid_opaque() { int t = threadIdx.x; asm volatile("" : "+v"(t)); return t; }
#define TIDX tid_opaque()
__device__ __forceinline__ float bf2f(bf16_t v) { return __uint_as_float(((unsigned)v) << 16); }
typedef __bf16 bf16x2_t __attribute__((ext_vector_type(2)));
__device__ __forceinline__ bf16_t f2bf(float f) { return __builtin_bit_cast(unsigned short, (__bf16)f); }
__device__ __forceinline__ unsigned pk2(float lo, float hi) { bf16x2_t v = {(__bf16)lo, (__bf16)hi}; return __builtin_bit_cast(unsigned, v); }
__device__ __forceinline__ float sigmoidf_(float x) { return 1.f / (1.f + __expf(-x)); }
__device__ __forceinline__ float siluf_(float x) { return x / (1.f + __expf(-x)); }
__device__ __forceinline__ float softplusf_(float x) { return x > 20.f ? x : log1pf(__expf(x)); }
__device__ __forceinline__ float logsigmoidf_(float x) { return x < 0.f ? x - log1pf(__expf(x)) : -log1pf(__expf(-x)); }
__device__ __forceinline__ float geluf_(float x) { float u = 0.7978845608028654f * (x + 0.044715f * x * x * x); return 0.5f * x * (1.f + tanhf(u)); }
__device__ __forceinline__ float wave_sum(float v) {
#pragma unroll
    for (int o = 1; o < 64; o <<= 1) v += __shfl_xor(v, o);
    return v;
}
__device__ __forceinline__ float rdlane(float v, int l) { return __int_as_float(__builtin_amdgcn_readlane(__float_as_int(v), l)); }

#define PROBE_MASK 0
#define GSYNC() xcd_barrier(xb)
#define REP(bit, ...) do { __VA_ARGS__; if (PROBE_MASK & (bit)) { GSYNC(); __VA_ARGS__; } } while (0)
constexpr int NTHR = 512;
constexpr int LDS_BYTES = 147456;
enum { I_X = 0, I_MEM, I_NORM_MIX, I_W_IN, I_HGRN_LB, I_FOX_FB, I_LRU_CONV_W, I_LRU_CONV_B, I_LRU_WA, I_LRU_BA, I_LRU_WX, I_LRU_BX, I_LRU_LAM, I_GDN_CONV_W, I_GDN_A_LOG,
       I_GDN_DT_BIAS, I_MIX_GAIN, I_W_OUT, I_NORM_MEM, I_NORM_MEMKV, I_W_MQ, I_W_MKV, I_W_MO, I_NORM_FFN, I_W_RG, I_B_RG, I_W_RE, I_B_RE, I_W_E_GU, I_W_E_DN, I_NORM_FINAL, N_INPUTS };
struct Params { const float* in[N_INPUTS]; float* out; char* ws; };
static_assert(sizeof(Params) == 8 * (N_INPUTS + 2), "no padding");

#define BLK_LOOP(it, n) for (int it = (int)blockIdx.x; it < (n); it += (int)gridDim.x)


__device__ __forceinline__ float rinv_from_pss(const float* __restrict__ pss, size_t row) {
    const f32x4 a = *(const f32x4*)(pss + row * 16), b = *(const f32x4*)(pss + row * 16 + 4), c = *(const f32x4*)(pss + row * 16 + 8), d = *(const f32x4*)(pss + row * 16 + 12);
    const float sm = ((a[0] + a[1]) + (a[2] + a[3])) + ((b[0] + b[1]) + (b[2] + b[3])) + ((c[0] + c[1]) + (c[2] + c[3])) + ((d[0] + d[1]) + (d[2] + d[3]));
    return rsqrtf(sm * (1.f / 1024.f) + EPS);
}

__device__ __forceinline__ int rowmap_fn(int mode, int n) {
    if (mode == 1) {
        if (n < 1792) return n;
        if (n < 1796) return C_GATE + (n - 1792);
        if (n < 3076) return n - 4;
        if (n < 3084) return C_GATE + 4 + (n - 3076);
        return n - 12;
    } else if (mode == 2) {
        int j = n & 255; return (j >> 4) * 32 + ((n >= 256) ? 16 : 0) + (j & 15);
    }
    return n;
}
__device__ __forceinline__ void convT_tile(float* tile  , const float* __restrict__ src, int K, int N, bf16_t* __restrict__ dst, int mode, int ntn, int idx) {
    const int n0 = (idx % ntn) * 64, k0 = (idx / ntn) * 64;
    const int tid = TIDX;
    __syncthreads();
#pragma unroll
    for (int i = 0; i < 2; ++i) {
        const int k = (tid >> 4) + 32 * i, n = n0 + (tid & 15) * 4;
        f32x4 v = (f32x4){0.f, 0.f, 0.f, 0.f};
        if (n + 3 < N) v = *(const f32x4*)(src + (size_t)(k0 + k) * N + n);
        else { for (int e = 0; e < 4; ++e) if (n + e < N) v[e] = src[(size_t)(k0 + k) * N + n + e]; }
#pragma unroll
        for (int e = 0; e < 4; ++e) tile[k * 65 + (tid & 15) * 4 + e] = v[e];
    }
    __syncthreads();
    const int nl = tid >> 3, k8 = (tid & 7) * 8, n = n0 + nl;
    if (n < N) {
        const int r = rowmap_fn(mode, n);
        u32x4 o;
#pragma unroll
        for (int j = 0; j < 4; ++j) o[j] = pk2(tile[(k8 + 2 * j) * 65 + nl], tile[(k8 + 2 * j + 1) * 65 + nl]);
        *(u32x4*)(dst + (size_t)r * K + k0 + k8) = o;
    }
}
__device__ __forceinline__ void rms_row_bf16(const float* __restrict__ xrow, const float* __restrict__ g, bf16_t* __restrict__ orow, int lane) {
    const f32x4* xr = (const f32x4*)xrow + lane;
    f32x4 v[4]; float s = 0.f;
#pragma unroll
    for (int j = 0; j < 4; ++j) { v[j] = xr[64 * j]; s += v[j].x * v[j].x + v[j].y * v[j].y + v[j].z * v[j].z + v[j].w * v[j].w; }
    const float rinv = rsqrtf(wave_sum(s) * (1.f / 1024.f) + EPS);
#pragma unroll
    for (int j = 0; j < 4; ++j) {
        const f32x4 gg = ((const f32x4*)g)[lane + 64 * j];
        uint2 o; o.x = pk2(v[j].x * rinv * gg.x, v[j].y * rinv * gg.y); o.y = pk2(v[j].z * rinv * gg.z, v[j].w * rinv * gg.w);
        *(uint2*)(orow + (lane + 64 * j) * 4) = o;
    }
}

constexpr int CT_PER_LAYER = 53 * 16 + 256 + 64 + 128 + 64;
constexpr int CT_GU = 64 * 128, CT_DN = 64 * 64;
constexpr int CT_TOTAL = NL * CT_PER_LAYER + CT_GU + CT_DN;

__device__ __forceinline__ void phase0(const Params& P, char* smem) {
    char* ws = P.ws;
    float* tile = (float*)smem;
    BLK_LOOP(it, CT_TOTAL) {
        int r = it;
        if (r < NL * CT_PER_LAYER) {
            const int l = r / CT_PER_LAYER; r -= l * CT_PER_LAYER;
            if (r < 848) { convT_tile(tile, P.in[I_W_IN] + (size_t)l * 1024 * NIN, 1024, NIN, (bf16_t*)(ws + OFF_WIN) + (size_t)l * NP * 1024, 1, 53, r); continue; } r -= 848;
            if (r < 256) { convT_tile(tile, P.in[I_W_OUT] + (size_t)l * 1024 * 1024, 1024, 1024, (bf16_t*)(ws + OFF_WOUT) + (size_t)l * 1024 * 1024, 0, 16, r); continue; } r -= 256;
            if (r < 64) { convT_tile(tile, P.in[I_W_MQ] + (size_t)l * 1024 * 256, 1024, 256, (bf16_t*)(ws + OFF_WMQ) + (size_t)l * 256 * 1024, 0, 4, r); continue; } r -= 64;
            if (r < 128) { convT_tile(tile, P.in[I_W_MKV] + (size_t)l * 1024 * 512, 1024, 512, (bf16_t*)(ws + OFF_WMKV) + (size_t)l * 512 * 1024, 0, 8, r); continue; } r -= 128;
            convT_tile(tile, P.in[I_W_MO] + (size_t)l * 256 * 1024, 256, 1024, (bf16_t*)(ws + OFF_WMO) + (size_t)l * 1024 * 256, 0, 16, r); continue;
        }
        r -= NL * CT_PER_LAYER;
        if (r < CT_GU) { const int m = r >> 7; convT_tile(tile, P.in[I_W_E_GU] + (size_t)m * 1024 * 512, 1024, 512, (bf16_t*)(ws + OFF_WGU) + (size_t)m * 512 * 1024, 2, 8, r & 127); continue; }
        r -= CT_GU;
        { const int m = r >> 6; convT_tile(tile, P.in[I_W_E_DN] + (size_t)m * 256 * 1024, 256, 1024, (bf16_t*)(ws + OFF_WDN) + (size_t)m * 1024 * 256, 0, 16, r & 63); }
    }
    for (int i = blockIdx.x * NTHR + TIDX; i < NL * (NP - NIN) * 512; i += gridDim.x * NTHR) {
        const int l = i / ((NP - NIN) * 512), w = i % ((NP - NIN) * 512);
        ((unsigned*)((bf16_t*)(ws + OFF_WIN) + (size_t)l * NP * 1024 + (size_t)NIN * 1024))[w] = 0u;
    }
    for (int i = blockIdx.x * NTHR + TIDX; i < NL * 48 * 1024; i += gridDim.x * NTHR) {
        const int l = i / (48 * 1024), r = (i / 1024) % 48, k = i & 1023;
        float w = 0.f;
        if (r < 4) w = P.in[I_W_RG][(size_t)l * 4096 + k * 4 + r]; else if (r < 36) w = P.in[I_W_RE][(size_t)l * 32768 + k * 32 + (r - 4)];
        const bf16_t hi = f2bf(w); const bf16_t lo = f2bf(w - bf2f(hi));
        bf16_t* wr = (bf16_t*)(ws + OFF_WR) + (size_t)l * 2 * 48 * 1024;
        wr[r * 1024 + k] = hi; wr[48 * 1024 + r * 1024 + k] = lo;
    }
    const int gw = blockIdx.x * 8 + (TIDX >> 6), ngw = gridDim.x * 8, lane = TIDX & 63;
    for (int row = gw; row < T + NL * 2048; row += ngw) {
        if (row < T) rms_row_bf16(P.in[I_X] + (size_t)row * 1024, P.in[I_NORM_MIX], (bf16_t*)(ws + OFF_HN) + (size_t)row * 1024, lane);
        else { const int r2 = row - T, l = r2 >> 11, rr = r2 & 2047;
               rms_row_bf16(P.in[I_MEM] + (size_t)rr * 1024, P.in[I_NORM_MEMKV] + l * 1024, (bf16_t*)(ws + OFF_MEMN) + (size_t)r2 * 1024, lane); }
    }
}

constexpr int GLD = 72;
constexpr int GEMM_STAGE = (256 + 128) * GLD * 2;
constexpr int GEMM_LDS = 2 * GEMM_STAGE;
template <class RowPtr>
__device__ __forceinline__ void gemm_tile(char* smem, RowPtr rowptr, const bf16_t* __restrict__ Bt, int ldb, int n0, int K, f32x4 (&acc)[4][4]) {
    const int tid = TIDX, lane = tid & 63, wave = tid >> 6, wm = wave >> 1, wn = wave & 1;
    const u32x4* ga[4]; const u32x4* gb[2];
#pragma unroll
    for (int i = 0; i < 4; ++i) { const int c = tid + i * 512, r = c >> 3, ch = c & 7; ga[i] = (const u32x4*)(rowptr(r) + ch * 8); }
#pragma unroll
    for (int i = 0; i < 2; ++i) { const int c = tid + i * 512, r = c >> 3, ch = c & 7; gb[i] = (const u32x4*)(Bt + (size_t)(n0 + r) * ldb + ch * 8); }
#pragma unroll
    for (int m = 0; m < 4; ++m)
#pragma unroll
        for (int n = 0; n < 4; ++n) acc[m][n] = (f32x4){0.f, 0.f, 0.f, 0.f};
    const int nk = K / 64;
    u32x4 raA[4], rbA[2], raB[4], rbB[2];
#define GT_LOAD(RA, RB, kt) { _Pragma("unroll") for (int i = 0; i < 4; ++i) RA[i] = ga[i][(kt) * 8]; _Pragma("unroll") for (int i = 0; i < 2; ++i) RB[i] = gb[i][(kt) * 8]; }
#define GT_STORE(RA, RB, buf) { bf16_t* dA = (bf16_t*)(smem + (buf) * GEMM_STAGE); bf16_t* dB = dA + 256 * GLD; \
        _Pragma("unroll") for (int i = 0; i < 4; ++i) { const int c = tid + i * 512, r = c >> 3, ch = c & 7; *(u32x4*)(dA + r * GLD + ch * 8) = RA[i]; } \
        _Pragma("unroll") for (int i = 0; i < 2; ++i) { const int c = tid + i * 512, r = c >> 3, ch = c & 7; *(u32x4*)(dB + r * GLD + ch * 8) = RB[i]; } }
#define GT_COMPUTE(buf) { const bf16_t* sA = (const bf16_t*)(smem + (buf) * GEMM_STAGE); const bf16_t* sB = sA + 256 * GLD; \
        _Pragma("unroll") for (int kk = 0; kk < 2; ++kk) { bf16x8 af[4], bfr[4]; \
            _Pragma("unroll") for (int m = 0; m < 4; ++m) af[m] = *(const bf16x8*)(sA + (wm * 64 + m * 16 + (lane & 15)) * GLD + kk * 32 + (lane >> 4) * 8); \
            _Pragma("unroll") for (int n = 0; n < 4; ++n) bfr[n] = *(const bf16x8*)(sB + (wn * 64 + n * 16 + (lane & 15)) * GLD + kk * 32 + (lane >> 4) * 8); \
            _Pragma("unroll") for (int m = 0; m < 4; ++m) _Pragma("unroll") for (int n = 0; n < 4; ++n) acc[m][n] = __builtin_amdgcn_mfma_f32_16x16x32_bf16(bfr[n], af[m], acc[m][n], 0, 0, 0); } }
    GT_LOAD(raA, rbA, 0)
    GT_LOAD(raB, rbB, 1)
    __syncthreads();
    GT_STORE(raA, rbA, 0)
    __syncthreads();
    for (int kt = 0; kt < nk; kt += 2) {
        if (kt + 2 < nk) GT_LOAD(raA, rbA, kt + 2)
        GT_COMPUTE(0)
        GT_STORE(raB, rbB, 1)
        __syncthreads();
        if (kt + 3 < nk) GT_LOAD(raB, rbB, kt + 3)
        GT_COMPUTE(1)
        if (kt + 2 < nk) GT_STORE(raA, rbA, 0)
        __syncthreads();
    }
#undef GT_LOAD
#undef GT_STORE
#undef GT_COMPUTE
}
struct RowDirect { const bf16_t* A; int lda; int m0; __device__ __forceinline__ const bf16_t* operator()(int r) const { return A + (size_t)(m0 + r) * lda; } };
enum { EPI_INPROJ = 0, EPI_RESID = 1, EPI_BF16 = 2, EPI_BF16_RS = 3, EPI_RESID_NORM = 4 };

__device__ __forceinline__ int vcu_id() { const int G = gridDim.x, bx = blockIdx.x; return (G % 8 == 0) ? (bx % 8) * (G / 8) + bx / 8 : bx; }

template <int EPI>
__device__ __forceinline__ void gemm_phase(char* smem, const bf16_t* A, int lda, const bf16_t* Bt, int ldb, int M, int N, int K, void* out, int ldo, const float* resid, float* gates, int idx0 = -1, int stride = 0, bf16_t* xg = nullptr, const float* gn = nullptr) {
    const int ntn = N / 128, ntiles = (M / 256) * ntn;
    if (stride == 0) { idx0 = vcu_id(); stride = gridDim.x; }
    if (idx0 < 0) return;
    const int lane = TIDX & 63, wave = TIDX >> 6, wm = wave >> 1, wn = wave & 1;
    for (int tIdx = idx0; tIdx < ntiles; tIdx += stride) {
        const int m0 = (tIdx / ntn) * 256, n0 = (tIdx % ntn) * 128;
        f32x4 acc[4][4];
        RowDirect rp{A, lda, m0};
        gemm_tile(smem, rp, Bt, ldb, n0, K, acc);
        float rsc[4] = {1.f, 1.f, 1.f, 1.f};
        if (EPI == EPI_BF16_RS) {
#pragma unroll
            for (int m = 0; m < 4; ++m) rsc[m] = rinv_from_pss(resid, (size_t)(m0 + wm * 64 + m * 16 + (lane & 15)));
        }
        if (EPI == EPI_RESID_NORM) {
#pragma unroll
            for (int m = 0; m < 4; ++m) {
                const int row = m0 + wm * 64 + m * 16 + (lane & 15);
                float ss = 0.f;
#pragma unroll
                for (int n = 0; n < 4; ++n) {
                    const int col = n0 + wn * 64 + n * 16 + (lane >> 4) * 4;
                    const f32x4 o = *(const f32x4*)(resid + (size_t)row * ldo + col) + acc[m][n];
                    *(f32x4*)((float*)out + (size_t)row * ldo + col) = o;
                    ss += (o[0] * o[0] + o[1] * o[1]) + (o[2] * o[2] + o[3] * o[3]);
                    const f32x4 og = o * *(const f32x4*)(gn + col);
                    uint2 w; w.x = pk2(og[0], og[1]); w.y = pk2(og[2], og[3]);
                    *(uint2*)(xg + (size_t)row * ldo + col) = w;
                }
                ss += __shfl_xor(ss, 16); ss += __shfl_xor(ss, 32);
                if ((lane >> 4) == 0) gates[(size_t)row * 16 + (n0 >> 7) * 2 + wn] = ss;
            }
            continue;
        }
#pragma unroll
        for (int m = 0; m < 4; ++m)
#pragma unroll
            for (int n = 0; n < 4; ++n) {
                const int row = m0 + wm * 64 + m * 16 + (lane & 15), col = n0 + wn * 64 + n * 16 + (lane >> 4) * 4;
                const f32x4 v = acc[m][n];
                if (EPI == EPI_INPROJ) {
                    uint2 o; o.x = pk2(v.x, v.y); o.y = pk2(v.z, v.w);
                    *(uint2*)((bf16_t*)out + (size_t)row * ldo + col) = o;
                    if (col >= C_GATE && col < C_GATE + 16) *(f32x4*)(gates + (size_t)row * 16 + (col - C_GATE)) = v;
                } else if (EPI == EPI_RESID) {
                    const f32x4 r = *(const f32x4*)(resid + (size_t)row * ldo + col);
                    *(f32x4*)((float*)out + (size_t)row * ldo + col) = r + v;
                } else if (EPI == EPI_BF16_RS) {
                    const float ri = rsc[m];
                    uint2 o; o.x = pk2(v.x * ri, v.y * ri); o.y = pk2(v.z * ri, v.w * ri);
                    *(uint2*)((bf16_t*)out + (size_t)row * ldo + col) = o;
                } else {
                    uint2 o; o.x = pk2(v.x, v.y); o.y = pk2(v.z, v.w);
                    *(uint2*)((bf16_t*)out + (size_t)row * ldo + col) = o;
                }
            }
    }
}


namespace pg8 {
#define PG8_LAS __attribute__((address_space(3)))
typedef unsigned short bf16_t;
typedef short bf16x8 __attribute__((ext_vector_type(8)));
typedef float f32x4 __attribute__((ext_vector_type(4)));
typedef unsigned u32x4 __attribute__((ext_vector_type(4)));
constexpr int BM = 256, BK = 64, HALF = 128, HTB = HALF * BK * 2  , STAGE_BYTES = 8 * HTB, NXCD = 8, WGM = 8;

__host__ __device__ __forceinline__ int lds_byte(int r, int c) { const int st = (r >> 4) * 2 + (c >> 5), rr = r & 15, cc = c & 31, ob = rr * 64 + cc * 2; return st * 1024 + (ob ^ (((ob >> 9) & 1) << 5)); }
__host__ __device__ __forceinline__ void stage_rc(int b, int& R, int& C) { const int st = b / 1024, sb = b % 1024, swz = sb ^ (((sb >> 9) & 1) << 5); R = (st >> 1) * 16 + swz / 64; C = (st & 1) * 32 + (swz % 64) / 2; }
__host__ __device__ __forceinline__ int perm32(int rho) { const int n = rho >> 4, i = rho & 15; return 8 * (i >> 2) + 4 * n + (i & 3); }

struct Unit { int pm, pn; };
struct Gemm { const bf16_t* A; const bf16_t* Bt; int M, N, K; };

struct StaticOrder {
    int nM, nN, nwg, G, c;
    __host__ __device__ void init(int M, int N, int G_, int c_) { nM = M / BM; nN = N / BM; nwg = nM * nN; G = G_; c = c_; }
    __host__ __device__ bool next(int i, Unit& u) const {
        const long L = (long)i * G + c; if (L >= nwg) return false;
        int wgid = (int)L; { const int q = nwg / NXCD, r = nwg % NXCD, xcd = wgid % NXCD, off = wgid / NXCD; wgid = (xcd < r ? xcd * (q + 1) : r * (q + 1) + (xcd - r) * q) + off; }
        const int nig = WGM * nN, gid = wgid / nig, fm = gid * WGM, gsz = (nM - fm) < WGM ? (nM - fm) : WGM;
        u.pm = fm + ((wgid % nig) % gsz); u.pn = (wgid % nig) / gsz; return true;
    }
    __device__ __forceinline__ void a_ready(const Unit&) const {}
    __device__ __forceinline__ void done(const Unit&) const {}
};
__device__ __forceinline__ unsigned cvt_pk_bf16(float lo, float hi) { unsigned r; asm volatile("v_cvt_pk_bf16_f32 %0, %1, %2" : "=v"(r) : "v"(lo), "v"(hi)); return r; }
typedef float f32x2 __attribute__((ext_vector_type(2)));

struct EpiInProj {
    static constexpr bool PERM = true, AFTER_DRAIN = false;
    bf16_t* O; int ldc; float* gates; int gate_col;
    __device__ __forceinline__ void operator()(const f32x4 (&acc)[2][2][4][2], const Unit& u, int wr, int wc, int fr, int fq) const {
        const int row0 = u.pm * BM + wr * 64 + fr, col0 = u.pn * BM + wc * 32 + 8 * fq;
#pragma unroll
        for (int ai = 0; ai < 2; ++ai)
#pragma unroll
            for (int m = 0; m < 4; ++m) {
                const int row = row0 + ai * HALF + m * 16;
                bf16_t* rowp = O + (size_t)row * ldc + col0;
#pragma unroll
                for (int bj = 0; bj < 2; ++bj) {
                    const f32x4 v0 = acc[ai][bj][m][0], v1 = acc[ai][bj][m][1];
                    u32x4 w; w.x = cvt_pk_bf16(v0[0], v0[1]); w.y = cvt_pk_bf16(v0[2], v0[3]); w.z = cvt_pk_bf16(v1[0], v1[1]); w.w = cvt_pk_bf16(v1[2], v1[3]);
                    *(u32x4*)(rowp + bj * HALF) = w;
                    const int gc = col0 + bj * HALF - gate_col;
                    if (gates && gc >= 0 && gc < 16) { *(f32x4*)(gates + (size_t)row * 16 + gc) = v0; *(f32x4*)(gates + (size_t)row * 16 + gc + 4) = v1; }
                }
            }
    }
};
struct EpiResid {
    static constexpr bool PERM = false, AFTER_DRAIN = false;
    const float* base; float* out; int ldc;
    __device__ __forceinline__ void operator()(const f32x4 (&acc)[2][2][4][2], const Unit& u, int wr, int wc, int fr, int fq) const {
        const int col0 = u.pn * BM + wc * 32 + 4 * fq;
#pragma unroll
        for (int ai = 0; ai < 2; ++ai)
#pragma unroll
            for (int m = 0; m < 4; ++m) {
                const size_t off = (size_t)(u.pm * BM + ai * HALF + wr * 64 + m * 16 + fr) * ldc + col0;
#pragma unroll
                for (int bj = 0; bj < 2; ++bj)
#pragma unroll
                    for (int n = 0; n < 2; ++n) { const f32x4 bs = *(const f32x4*)(base + off + bj * HALF + n * 16); *(f32x4*)(out + off + bj * HALF + n * 16) = bs + acc[ai][bj][m][n]; }
                if (m & 1) asm volatile("" ::: "memory");
            }
    }
};

struct EpiResidNorm {
    static constexpr bool PERM = false, AFTER_DRAIN = false;
    const float* base; float* out; int ldc; const float* gn; bf16_t* xg; float* pss;
    __device__ __forceinline__ void operator()(const f32x4 (&acc)[2][2][4][2], const Unit& u, int wr, int wc, int fr, int fq) const {
        const int col0 = u.pn * BM + wc * 32 + 4 * fq;
        f32x4 gv[2][2];
#pragma unroll
        for (int bj = 0; bj < 2; ++bj)
#pragma unroll
            for (int n = 0; n < 2; ++n) gv[bj][n] = *(const f32x4*)(gn + col0 + bj * HALF + n * 16);
#pragma unroll
        for (int ai = 0; ai < 2; ++ai)
#pragma unroll
            for (int m = 0; m < 4; ++m) {
                const int row = u.pm * BM + ai * HALF + wr * 64 + m * 16 + fr;
                const size_t off = (size_t)row * ldc + col0;
                float ss = 0.f;
#pragma unroll
                for (int bj = 0; bj < 2; ++bj)
#pragma unroll
                    for (int n = 0; n < 2; ++n) {
                        const f32x4 bs = *(const f32x4*)(base + off + bj * HALF + n * 16);
                        const f32x4 o = bs + acc[ai][bj][m][n];
                        *(f32x4*)(out + off + bj * HALF + n * 16) = o;
                        ss += (o[0] * o[0] + o[1] * o[1]) + (o[2] * o[2] + o[3] * o[3]);
                        const f32x4 og = o * gv[bj][n];
                        uint2 w; w.x = cvt_pk_bf16(og[0], og[1]); w.y = cvt_pk_bf16(og[2], og[3]);
                        *(uint2*)(xg + off + bj * HALF + n * 16) = w;
                    }
                ss += __shfl_xor(ss, 16); ss += __shfl_xor(ss, 32);
                if (fq == 0) pss[(size_t)row * 16 + u.pn * 4 + wc] = ss;
                if (m & 1) asm volatile("" ::: "memory");
            }
    }
};
template <class Epi, class Sched, bool ALIGN_EPI = false, bool SP2 = false>
__device__ __forceinline__ void gemm_phase(PG8_LAS unsigned char* lds, const Gemm g, const Sched& S, const Epi& E) {
    const int tid = TIDX, wid = __builtin_amdgcn_readfirstlane(tid >> 6), lane = tid & 63, wr = wid >> 2, wc = wid & 3, fr = lane & 15, fq = lane >> 4;
    const int K = g.K, nt = K / BK;
    unsigned voffA[2], voffB[2];
#pragma unroll
    for (int i = 0; i < 2; ++i) { int R, C; stage_rc(tid * 16 + i * 8192, R, C); const int Rb = Epi::PERM ? ((R & ~31) + perm32(R & 31)) : R;
        voffA[i] = (unsigned)(R * K + C) * 2u; voffB[i] = (unsigned)(Rb * K + C) * 2u; }
    const size_t kstep = (size_t)(BK * 2);
    const size_t hstep = (size_t)HALF * K * 2;
    const size_t tstep = 2 * hstep;
    const unsigned ldsw = (unsigned)wid * 1024u;
    const int aoff = lds_byte(wr * 64 + fr, fq * 8), boff = lds_byte(wc * 32 + fr, fq * 8);
#define PG8_SA(b, h) (((b) * 2 + (h)) * HTB)
#define PG8_SB(b, h) ((4 + (b) * 2 + (h)) * HTB)
#define PG8_STAGE(bufoff, gbase, voff) do { _Pragma("unroll") for (int _i = 0; _i < 2; ++_i) \
        __builtin_amdgcn_global_load_lds((const unsigned*)((const char*)(gbase) + (voff)[_i]), (PG8_LAS unsigned*)(lds + (bufoff) + ldsw + _i * 8192), 16, 0, 0); } while (0)
#define PG8_LDA(dst, b, h) do { _Pragma("unroll") for (int m = 0; m < 4; ++m) _Pragma("unroll") for (int k = 0; k < 2; ++k) dst[m][k] = *(const PG8_LAS bf16x8*)(lds + PG8_SA(b, h) + aoff + m * 2048 + k * 1024); } while (0)
#define PG8_LDB(dst, b, h) do { _Pragma("unroll") for (int n = 0; n < 2; ++n) _Pragma("unroll") for (int k = 0; k < 2; ++k) dst[n][k] = *(const PG8_LAS bf16x8*)(lds + PG8_SB(b, h) + boff + n * 2048 + k * 1024); } while (0)
#define PG8_MMA(ai, bj, At, Bt) do { __builtin_amdgcn_s_setprio(1); _Pragma("unroll") for (int m = 0; m < 4; ++m) _Pragma("unroll") for (int n = 0; n < 2; ++n) _Pragma("unroll") for (int k = 0; k < 2; ++k) \
        acc[ai][bj][m][n] = __builtin_amdgcn_mfma_f32_16x16x32_bf16(Bt[n][k], At[m][k], acc[ai][bj][m][n], 0, 0, 0); __builtin_amdgcn_s_setprio(0); } while (0)
#define PG8_WAIT_V(n) asm volatile("s_waitcnt vmcnt(" #n ")" ::: "memory")
#define PG8_WAIT_L(n) asm volatile("s_waitcnt lgkmcnt(" #n ")" ::: "memory")
#define PG8_BAR __builtin_amdgcn_s_barrier()
#define PG8_SCHED __builtin_amdgcn_sched_barrier(0)
    Unit cur, nxt; int ui = 0;
    if (!S.next(0, cur)) return;
    f32x4 acc[2][2][4][2];
#pragma unroll
    for (int a = 0; a < 2; ++a)
#pragma unroll
        for (int b = 0; b < 2; ++b)
#pragma unroll
            for (int m = 0; m < 4; ++m)
#pragma unroll
                for (int n = 0; n < 2; ++n) acc[a][b][m][n] = (f32x4){0.f, 0.f, 0.f, 0.f};
    bf16x8 At[4][2], B0[2][2], B1[2][2];
    const char* cA = (const char*)g.A + (size_t)cur.pm * tstep; const char* cB = (const char*)g.Bt + (size_t)cur.pn * tstep;
    S.a_ready(cur);
    if constexpr (SP2) {
        PG8_STAGE(PG8_SB(0, 0), cB, voffB); PG8_STAGE(PG8_SB(0, 1), cB + hstep, voffB); PG8_STAGE(PG8_SA(0, 0), cA, voffA); PG8_STAGE(PG8_SA(0, 1), cA + hstep, voffA);
        if (wr == 1) PG8_BAR;
        PG8_WAIT_V(2); PG8_BAR;
        PG8_STAGE(PG8_SB(1, 0), cB + kstep, voffB); PG8_STAGE(PG8_SA(1, 0), cA + kstep, voffA); PG8_STAGE(PG8_SB(1, 1), cB + hstep + kstep, voffB);
        PG8_WAIT_V(6); PG8_BAR;
    } else {
        PG8_STAGE(PG8_SB(0, 0), cB, voffB); PG8_STAGE(PG8_SA(0, 0), cA, voffA); PG8_STAGE(PG8_SB(0, 1), cB + hstep, voffB); PG8_STAGE(PG8_SA(0, 1), cA + hstep, voffA);
        if (wr == 1) PG8_BAR;
        PG8_WAIT_V(4); PG8_BAR;
        PG8_STAGE(PG8_SB(1, 0), cB + kstep, voffB); PG8_STAGE(PG8_SA(1, 0), cA + kstep, voffA); PG8_STAGE(PG8_SB(1, 1), cB + hstep + kstep, voffB);
        PG8_WAIT_V(6); PG8_BAR;
    }
    for (;;) {
        const bool has_next = S.next(ui + 1, nxt);
        const char* nA = has_next ? (const char*)g.A + (size_t)nxt.pm * tstep : cA; const char* nB = has_next ? (const char*)g.Bt + (size_t)nxt.pn * tstep : cB;
        for (int t = 0; t < nt; t += 2) {
            const bool last = (t == nt - 2);
            const char* a1 = cA + (size_t)(t + 1) * kstep;
            const char* a2 = last ? nA : cA + (size_t)(t + 2) * kstep; const char* b2 = last ? nB : cB + (size_t)(t + 2) * kstep;
            const char* a3 = a2 + kstep; const char* b3 = b2 + kstep;
            if (last && has_next) S.a_ready(nxt);
            if constexpr (SP2) {
            PG8_LDB(B0, 0, 0); PG8_LDB(B1, 0, 1); PG8_SCHED; PG8_LDA(At, 0, 0); PG8_STAGE(PG8_SA(1, 1), a1 + hstep, voffA);
            PG8_WAIT_V(8); PG8_WAIT_L(0); PG8_BAR; PG8_MMA(0, 0, At, B0); PG8_MMA(0, 1, At, B1); PG8_BAR; PG8_SCHED;
            PG8_LDA(At, 0, 1); PG8_STAGE(PG8_SB(0, 0), b2, voffB); PG8_STAGE(PG8_SB(0, 1), b2 + hstep, voffB); PG8_STAGE(PG8_SA(0, 0), a2, voffA);
            PG8_WAIT_V(8); PG8_WAIT_L(0); PG8_BAR; PG8_MMA(1, 0, At, B0); PG8_MMA(1, 1, At, B1); PG8_BAR; PG8_SCHED;
            PG8_LDB(B0, 1, 0); PG8_LDB(B1, 1, 1); PG8_SCHED; PG8_LDA(At, 1, 0); PG8_STAGE(PG8_SA(0, 1), a2 + hstep, voffA);
            PG8_WAIT_V(8); PG8_WAIT_L(0); PG8_BAR; PG8_MMA(0, 0, At, B0); PG8_MMA(0, 1, At, B1); PG8_BAR; PG8_SCHED;
            PG8_LDA(At, 1, 1); PG8_STAGE(PG8_SB(1, 0), b3, voffB); PG8_STAGE(PG8_SB(1, 1), b3 + hstep, voffB); PG8_STAGE(PG8_SA(1, 0), a3, voffA);
            PG8_WAIT_V(8); PG8_WAIT_L(0); PG8_BAR; PG8_MMA(1, 0, At, B0); PG8_MMA(1, 1, At, B1); PG8_BAR; PG8_SCHED;
            } else {
            PG8_LDB(B0, 0, 0); PG8_SCHED; PG8_LDA(At, 0, 0); PG8_STAGE(PG8_SA(1, 1), a1 + hstep, voffA);
            PG8_WAIT_L(8); PG8_BAR; PG8_WAIT_L(0); PG8_MMA(0, 0, At, B0); PG8_BAR; PG8_SCHED;
            PG8_LDB(B1, 0, 1); PG8_STAGE(PG8_SB(0, 0), b2, voffB);
            PG8_BAR; PG8_WAIT_L(0); PG8_MMA(0, 1, At, B1); PG8_BAR;
            PG8_LDA(At, 0, 1); PG8_STAGE(PG8_SA(0, 0), a2, voffA);
            PG8_BAR; PG8_WAIT_L(0); PG8_MMA(1, 0, At, B0); PG8_BAR; PG8_SCHED;
            PG8_STAGE(PG8_SB(0, 1), b2 + hstep, voffB);
            PG8_WAIT_V(6); PG8_BAR; PG8_MMA(1, 1, At, B1); PG8_BAR;
            PG8_LDB(B0, 1, 0); PG8_SCHED; PG8_LDA(At, 1, 0); PG8_STAGE(PG8_SA(0, 1), a2 + hstep, voffA);
            PG8_WAIT_L(8); PG8_BAR; PG8_WAIT_L(0); PG8_MMA(0, 0, At, B0); PG8_BAR; PG8_SCHED;
            PG8_LDB(B1, 1, 1); PG8_STAGE(PG8_SB(1, 0), b3, voffB);
            PG8_BAR; PG8_WAIT_L(0); PG8_MMA(0, 1, At, B1); PG8_BAR;
            PG8_LDA(At, 1, 1); PG8_STAGE(PG8_SA(1, 0), a3, voffA);
            PG8_BAR; PG8_WAIT_L(0); PG8_MMA(1, 0, At, B0); PG8_BAR; PG8_SCHED;
            PG8_STAGE(PG8_SB(1, 1), b3 + hstep, voffB);
            PG8_WAIT_V(6); PG8_BAR; PG8_MMA(1, 1, At, B1); PG8_BAR;
            }
        }
        if constexpr (ALIGN_EPI) { if (wr == 0) PG8_BAR; }
        if constexpr (!Epi::AFTER_DRAIN) { E(acc, cur, wr, wc, fr, fq); S.done(cur); }
        if (!has_next) break;
#pragma unroll
        for (int a = 0; a < 2; ++a)
#pragma unroll
            for (int b = 0; b < 2; ++b)
#pragma unroll
                for (int m = 0; m < 4; ++m)
#pragma unroll
                    for (int n = 0; n < 2; ++n) acc[a][b][m][n] = (f32x4){0.f, 0.f, 0.f, 0.f};
        cur = nxt; cA = nA; cB = nB; ++ui;
        if constexpr (ALIGN_EPI) { if (wr == 1) PG8_BAR; }
    }
    PG8_WAIT_V(0);
    if constexpr (!ALIGN_EPI) { if (wr == 0) PG8_BAR; }
    PG8_BAR;
    if constexpr (Epi::AFTER_DRAIN) { E.fused(acc, cur, wr, wc, fr, fq, lds, wid, lane); S.done(cur); }
#undef PG8_SA
#undef PG8_SB
#undef PG8_STAGE
#undef PG8_LDA
#undef PG8_LDB
#undef PG8_MMA
#undef PG8_WAIT_V
#undef PG8_WAIT_L
#undef PG8_BAR
#undef PG8_SCHED
}
}

struct RowGather { const bf16_t* A; int lda; const int* ids; int shift; __device__ __forceinline__ const bf16_t* operator()(int r) const { return A + (size_t)(ids[r] >> shift) * lda; } };
template <int STAGE>
__device__ __forceinline__ void moe_phase(char* smem, const bf16_t* A, int lda, const bf16_t* Wt, size_t wstride, int ldb, int K, const int* cnt, const int* list, const float* pgate, bf16_t* out, const float* pss) {
    int* ids = (int*)(smem + GEMM_LDS);
    int* tpre = ids + 256;
    constexpr int NTN = (STAGE == 1) ? 4 : 8;
    __syncthreads();
    if (TIDX < 64) {
        const int ln = TIDX; int nt = (ln < NEXP) ? ((cnt[ln * CNT_STRIDE] + 255) >> 8) : 0; int inc = nt;
#pragma unroll
        for (int o = 1; o < 64; o <<= 1) { const int nb = __shfl_up(inc, o); if (ln >= o) inc += nb; }
        if (ln <= NEXP) tpre[ln] = inc - nt;
    }
    __syncthreads();
    const int ntiles = tpre[NEXP] * NTN;
    const int lane = TIDX & 63, wave = TIDX >> 6, wm = wave >> 1, wn = wave & 1;
    for (int tIdx = vcu_id(); tIdx < ntiles; tIdx += gridDim.x) {
        const int mtg = tIdx / NTN, n0 = (tIdx % NTN) * 128;
        int e = 0;
        for (int i = 1; i < NEXP; ++i) if (tpre[i] <= mtg) e = i;
        const int mt = mtg - tpre[e];
        const int cn = cnt[e * CNT_STRIDE];
        __syncthreads();
        if (TIDX < 256) { const int pos = mt * 256 + TIDX; ids[TIDX] = list[(size_t)e * T + (pos < cn ? pos : cn - 1)]; }
        __syncthreads();
        f32x4 acc[4][4];
        RowGather rp{A, lda, ids, STAGE == 1 ? 1 : 0};
        gemm_tile(smem, rp, Wt + (size_t)e * wstride, ldb, n0, K, acc);
#pragma unroll
        for (int m = 0; m < 4; ++m) {
            const int rl = wm * 64 + m * 16 + (lane & 15);
            if (mt * 256 + rl >= cn) continue;
            const int pid = ids[rl];
            if (STAGE == 1) {
                const float gt = pgate[pid], ri = rinv_from_pss(pss, (size_t)(pid >> 1));
#pragma unroll
                for (int np = 0; np < 2; ++np) {
                    const f32x4 g = acc[m][2 * np], u = acc[m][2 * np + 1];
                    const int j = (n0 + wn * 64 + np * 32) / 2 + (lane >> 4) * 4;
                    const f32x4 gs = g * ri; const float ug = ri * gt;
                    uint2 o; o.x = pk2(siluf_(gs.x) * u.x * ug, siluf_(gs.y) * u.y * ug); o.y = pk2(siluf_(gs.z) * u.z * ug, siluf_(gs.w) * u.w * ug);
                    *(uint2*)(out + (size_t)pid * DEXP + j) = o;
                }
            } else {
#pragma unroll
                for (int n = 0; n < 4; ++n) {
                    const f32x4 v = acc[m][n]; const int col = n0 + wn * 64 + n * 16 + (lane >> 4) * 4;
                    uint2 o; o.x = pk2(v.x, v.y); o.y = pk2(v.z, v.w);
                    *(uint2*)(out + (size_t)pid * 1024 + col) = o;
                }
            }
        }
    }
}

__device__ __forceinline__ void hgrn2_naive(const bf16_t* __restrict__ proj, const float* __restrict__ hgrn_lb, int layer, const float* __restrict__ mix_gain, bf16_t* __restrict__ y, int bh, int lane) {
    const int b = bh >> 2, h = bh & 3;
    float lbk = 0.f;
    if (layer == 1) { float a0 = hgrn_lb[h * 64 + lane], a1 = hgrn_lb[256 + h * 64 + lane]; lbk = 1.f / (1.f + __expf(a0 - a1)); }
    const float mg = mix_gain[C_AQ + h * 64 + lane];
    float S[64];
#pragma unroll
    for (int k = 0; k < 64; ++k) S[k] = 0.f;
    for (int t = 0; t < SEQ; ++t) {
        const bf16_t* pr = proj + (size_t)(b * SEQ + t) * NP + h * 64 + lane;
        const float qk = siluf_(bf2f(pr[C_AQ]));
        const float sg = sigmoidf_(bf2f(pr[C_AF]));
        const float f = lbk + (1.f - lbk) * sg, kk = (1.f - lbk) * (1.f - sg);
        const float iv = bf2f(pr[C_AI]);
        const float gv = bf2f(pr[C_AG]);
        float o = 0.f;
#pragma unroll
        for (int k = 0; k < 64; ++k) { S[k] = rdlane(f, k) * S[k] + rdlane(kk, k) * iv; o += rdlane(qk, k) * S[k]; }
        const float ms = wave_sum(o * o) * (1.f / 64.f);
        const float yv = o * rsqrtf(ms + EPS) * siluf_(gv) * mg;
        y[(size_t)(b * SEQ + t) * 1024 + 0 + h * 64 + lane] = f2bf(yv);
    }
}
__device__ __forceinline__ void gdn_naive(const bf16_t* __restrict__ proj, const float* __restrict__ gates, const float* __restrict__ conv_w  ,
                                          const float* __restrict__ a_log, const float* __restrict__ dt_bias, const float* __restrict__ mix_gain, bf16_t* __restrict__ y, int bh, int lane) {
    const int b = bh >> 2, h = bh & 3;
    float wq[4], wk[4], wv[4];
#pragma unroll
    for (int j = 0; j < 4; ++j) { wq[j] = conv_w[j * 768 + h * 64 + lane]; wk[j] = conv_w[j * 768 + 256 + h * 64 + lane]; wv[j] = conv_w[j * 768 + 512 + h * 64 + lane]; }
    float xq[3] = {0.f, 0.f, 0.f}, xk[3] = {0.f, 0.f, 0.f}, xv[3] = {0.f, 0.f, 0.f};
    const float Aexp = __expf(a_log[h]), dtb = dt_bias[h];
    const float mg = mix_gain[768 + h * 64 + lane];
    float S[64];
#pragma unroll
    for (int k = 0; k < 64; ++k) S[k] = 0.f;
    for (int t = 0; t < SEQ; ++t) {
        const size_t row = (size_t)(b * SEQ + t);
        const bf16_t* pr = proj + row * NP + h * 64 + lane;
        const float q0 = bf2f(pr[C_DQ]), k0 = bf2f(pr[C_DK]), v0 = bf2f(pr[C_DV]), zv = bf2f(pr[C_DZ]);
        float q = siluf_(wq[0] * xq[0] + wq[1] * xq[1] + wq[2] * xq[2] + wq[3] * q0);
        float k = siluf_(wk[0] * xk[0] + wk[1] * xk[1] + wk[2] * xk[2] + wk[3] * k0);
        float v = siluf_(wv[0] * xv[0] + wv[1] * xv[1] + wv[2] * xv[2] + wv[3] * v0);
        xq[0] = xq[1]; xq[1] = xq[2]; xq[2] = q0; xk[0] = xk[1]; xk[1] = xk[2]; xk[2] = k0; xv[0] = xv[1]; xv[1] = xv[2]; xv[2] = v0;
        q = q * rsqrtf(wave_sum(q * q) + EPS) * 0.125f;
        k = k * rsqrtf(wave_sum(k * k) + EPS);
        const float beta = sigmoidf_(gates[row * 16 + 4 + h]);
        const float g = -Aexp * softplusf_(gates[row * 16 + 8 + h] + dtb);
        const float eg = __expf(g);
        float r = 0.f;
#pragma unroll
        for (int i = 0; i < 64; ++i) { S[i] *= eg; r += rdlane(k, i) * S[i]; }
        const float dlt = beta * (v - r);
        float o = 0.f;
#pragma unroll
        for (int i = 0; i < 64; ++i) { S[i] += rdlane(k, i) * dlt; o += rdlane(q, i) * S[i]; }
        const float ms = wave_sum(o * o) * (1.f / 64.f);
        const float yv = o * rsqrtf(ms + EPS) * siluf_(zv) * mg;
        y[row * 1024 + 768 + h * 64 + lane] = f2bf(yv);
    }
}
__device__ __forceinline__ void fox_cumsum(const float* __restrict__ gates, const float* __restrict__ fb, float* __restrict__ cc, int bh, int lane) {
    const int b = bh >> 2, h = bh & 3;
    const float bias = fb[h];
    float v[32];
#pragma unroll
    for (int i = 0; i < 32; ++i) v[i] = gates[(size_t)(b * SEQ + lane * 32 + i) * 16 + h];
    float run = 0.f;
#pragma unroll
    for (int i = 0; i < 32; ++i) { run += logsigmoidf_(v[i] + bias); v[i] = run; }
    float tot = run;
#pragma unroll
    for (int o = 1; o < 64; o <<= 1) { const float nb = __shfl_up(tot, o); if (lane >= o) tot += nb; }
    const float off = tot - run;
    float* dst = cc + (size_t)(b * 4 + h) * SEQ + lane * 32;
#pragma unroll
    for (int i = 0; i < 32; i += 4) *(f32x4*)(dst + i) = (f32x4){v[i] + off, v[i + 1] + off, v[i + 2] + off, v[i + 3] + off};
}
__device__ __forceinline__ void lru_prep_task(float* xc  , const bf16_t* __restrict__ proj, const float* __restrict__ conv_w, const float* __restrict__ conv_b,
                                              const float* __restrict__ w_a, const float* __restrict__ b_a, const float* __restrict__ w_x, const float* __restrict__ b_x,
                                              const float* __restrict__ lam, float* __restrict__ a_out, float* __restrict__ u_out, int task, bool active) {
    const int c = TIDX & 255, t0 = task * 16;
    if (active) {
        const float w0 = conv_w[c], w1 = conv_w[256 + c], w2 = conv_w[512 + c], w3 = conv_w[768 + c], cb = conv_b[c];
        for (int i = 0; i < 16; ++i) {
            const int t = t0 + i, s = t & (SEQ - 1);
            const bf16_t* pr = proj + (size_t)t * NP + C_CX + c;
            float acc = cb + w3 * bf2f(pr[0]);
            if (s >= 1) acc += w2 * bf2f(pr[-(ptrdiff_t)NP]);
            if (s >= 2) acc += w1 * bf2f(pr[-(ptrdiff_t)2 * NP]);
            if (s >= 3) acc += w0 * bf2f(pr[-(ptrdiff_t)3 * NP]);
            xc[i * 256 + c] = acc;
        }
    }
    __syncthreads();
    if (active) {
        const int h = c >> 6, jj = c & 63;
        float ra[16], rx[16];
#pragma unroll
        for (int i = 0; i < 16; ++i) { ra[i] = 0.f; rx[i] = 0.f; }
        for (int k = 0; k < 64; ++k) {
            const float wa = w_a[(h * 64 + k) * 64 + jj], wx = w_x[(h * 64 + k) * 64 + jj];
#pragma unroll
            for (int i = 0; i < 16; ++i) { const float xv = xc[i * 256 + h * 64 + k]; ra[i] += xv * wa; rx[i] += xv * wx; }
        }
        const float ba = b_a[c], bx = b_x[c], sp = softplusf_(-lam[c]);
#pragma unroll
        for (int i = 0; i < 16; ++i) {
            const float r = sigmoidf_(ra[i] + ba), ig = sigmoidf_(rx[i] + bx);
            const float log_a = -8.f * r * sp;
            const float a = __expf(log_a);
            const float u = sqrtf(-expm1f(2.f * log_a)) * (ig * xc[i * 256 + c]);
            a_out[(size_t)(t0 + i) * 256 + c] = a; u_out[(size_t)(t0 + i) * 256 + c] = u;
        }
    }
    __syncthreads();
}
__device__ __forceinline__ void lru_scan_task(const float* __restrict__ a_in, const float* __restrict__ u_in, const bf16_t* __restrict__ proj, const float* __restrict__ mix_gain, bf16_t* __restrict__ y, int b) {
    const int c = TIDX;
    const float mg = mix_gain[512 + c];
    float hst = 0.f;
    for (int t = 0; t < SEQ; ++t) {
        const size_t row = (size_t)(b * SEQ + t);
        hst = a_in[row * 256 + c] * hst + u_in[row * 256 + c];
        const float yv = hst * geluf_(bf2f(proj[row * NP + C_CG + c]));
        const float ms = wave_sum(yv * yv) * (1.f / 64.f);
        y[row * 1024 + 512 + c] = f2bf(yv * rsqrtf(ms + EPS) * mg);
    }
}

typedef short s16x4 __attribute__((ext_vector_type(4)));
#define LDS_AS __attribute__((address_space(3)))
__device__ __forceinline__ bf16x8 frag_rm(const bf16_t* tile, int ld, int r0, int k0, int lane) { return *(const bf16x8*)(tile + (r0 + (lane & 15)) * ld + k0 + (lane >> 4) * 8); }
__device__ __forceinline__ s16x4 tr4(const bf16_t* tile, int ld, int rbase, int c0, int lane) {
    const bf16_t* p = tile + (rbase + ((lane & 15) >> 2)) * ld + c0 + 4 * (lane & 3);
    return __builtin_amdgcn_ds_read_tr16_b64_v4i16((LDS_AS s16x4*)p);
}
__device__ __forceinline__ bf16x8 frag_cm(const bf16_t* tile, int ld, int k0, int c0, int lane) {
    const s16x4 lo = tr4(tile, ld, k0 + (lane >> 4) * 8, c0, lane), hi = tr4(tile, ld, k0 + (lane >> 4) * 8 + 4, c0, lane);
    return (bf16x8){lo[0], lo[1], lo[2], lo[3], hi[0], hi[1], hi[2], hi[3]};
}
#define MFMA16(a, b, c) __builtin_amdgcn_mfma_f32_16x16x32_bf16((a), (b), (c), 0, 0, 0)
constexpr int TLD = 72;


#define XB_TMO      128
#define XB_XCNT(j)  (256  + 64 * (j))
#define XB_XSUB(j)  (1280 + 64 * (j))
#define XB_XGEN(j)  (2304 + 64 * (j))
#define XB_TOP      3328
#define XB_TOPGEN   3392
#define XCD_BAR_WORDS 3456
#define XB_SPIN_CAP (1u << 18)
__device__ __forceinline__ unsigned xb_ld(unsigned* p)              { return __hip_atomic_load(p, __ATOMIC_RELAXED, __HIP_MEMORY_SCOPE_AGENT); }
__device__ __forceinline__ unsigned xb_add(unsigned* p, unsigned v) { return __hip_atomic_fetch_add(p, v, __ATOMIC_RELAXED, __HIP_MEMORY_SCOPE_AGENT); }
__device__ __forceinline__ unsigned xb_xcc_id() { return (unsigned)__builtin_amdgcn_s_getreg((3 << 11) | 20) & 0xFu; }
#define XB_SPIN(cond, bar) do { unsigned _sp = 0; while (cond) { __builtin_amdgcn_s_sleep(1); \
    if ((++_sp & 255u) == 0u) { if (xb_ld(&(bar)[XB_TMO])) break; if (_sp > XB_SPIN_CAP) { atomicAdd(&(bar)[XB_TMO], 1u); break; } } } } while (0)
struct XcdBarrier { unsigned* bar; unsigned x; volatile LDS_AS unsigned* st; };
__device__ __forceinline__ XcdBarrier xcd_barrier_post(unsigned* bar, volatile LDS_AS unsigned* st) {
    XcdBarrier b; b.bar = bar; b.x = xb_xcc_id(); b.st = st;
    if (TIDX == 0) (void)xb_add(&bar[XB_XCNT(b.x)], 1u);
    return b;
}
__device__ __forceinline__ void xcd_barrier_complete(unsigned* bar, unsigned x, unsigned& nloc, unsigned& nx) {
    const unsigned G = gridDim.x * gridDim.y * gridDim.z;
    unsigned sum, cnt, mine, sp = 0u;
    for (;;) {
        sum = 0u; cnt = 0u; mine = 0u;
#pragma unroll
        for (unsigned j = 0; j < 16; ++j) { const unsigned c = xb_ld(&bar[XB_XCNT(j)]); sum += c; cnt += (c > 0u) ? 1u : 0u; mine = (j == x) ? c : mine; }
        if (sum == G) break;
        __builtin_amdgcn_s_sleep(1);
        if ((++sp & 255u) == 0u) { if (xb_ld(&bar[XB_TMO])) break; if (sp > XB_SPIN_CAP) { atomicAdd(&bar[XB_TMO], 1u); break; } }
    }
    nloc = mine > 0u ? mine : 1u; nx = cnt > 0u ? cnt : 1u;
}
__device__ __forceinline__ void xcd_barrier(const XcdBarrier& b) {
    asm volatile("s_waitcnt vmcnt(0)" ::: "memory");
    __syncthreads();
    if (TIDX == 0) {
        unsigned* bar = b.bar;
        __builtin_amdgcn_s_waitcnt(0);
        unsigned nloc = b.st[0], nx = b.st[1];
        if (nloc == 0u) { xcd_barrier_complete(bar, b.x, nloc, nx); b.st[0] = nloc; b.st[1] = nx; }
        const unsigned old = xb_add(&bar[XB_XSUB(b.x)], 1u);
        const unsigned gen = old / nloc;
        if (old + 1u == (gen + 1u) * nloc) {
            __builtin_amdgcn_fence(__ATOMIC_RELEASE, "agent");
            asm volatile("s_waitcnt vmcnt(0)" ::: "memory");
            const unsigned og = xb_add(&bar[XB_TOP], 1u);
            const unsigned tg = og / nx;
            if (og + 1u == (tg + 1u) * nx) xb_add(&bar[XB_TOPGEN], 1u);
            else XB_SPIN(xb_ld(&bar[XB_TOPGEN]) == tg, bar);
            __builtin_amdgcn_fence(__ATOMIC_ACQUIRE, "agent");
            xb_add(&bar[XB_XGEN(b.x)], 1u);
            asm volatile("s_waitcnt vmcnt(0)" ::: "memory");
        } else {
            XB_SPIN(xb_ld(&bar[XB_XGEN(b.x)]) == gen, bar);
            __builtin_amdgcn_fence(__ATOMIC_ACQUIRE, "agent");
            asm volatile("s_waitcnt vmcnt(0)" ::: "memory");
        }
    }
    __syncthreads();
}

template <bool MASK, int NS>
__device__ __forceinline__ void attn_compute_t(const bf16_t* cK, const bf16_t* cV, const float* cC, const bf16x8 (&qf)[2], f32x4 (&oacc)[4], float& mrun, float& lrun,
                                               float ct2, float scale2, int key0, int tq, int lane, int g) {
    f32x4 sacc[4 * NS];
#pragma unroll
    for (int n = 0; n < 4 * NS; ++n) {
        sacc[n] = (f32x4){0.f, 0.f, 0.f, 0.f};
#pragma unroll
        for (int kk = 0; kk < 2; ++kk) sacc[n] = MFMA16(frag_rm(cK, TLD, n * 16, kk * 32, lane), qf[kk], sacc[n]);
    }
    float mx = -INFINITY;
#pragma unroll
    for (int n = 0; n < 4 * NS; ++n) {
        const f32x4 cs = *(const f32x4*)(cC + n * 16 + 4 * g);
#pragma unroll
        for (int r = 0; r < 4; ++r) {
            float v = sacc[n][r] * scale2 + (ct2 - cs[r]);
            if (MASK) { if (key0 + n * 16 + 4 * g + r > tq) v = -INFINITY; }
            sacc[n][r] = v; mx = fmaxf(mx, v);
        }
    }
    mx = fmaxf(mx, __shfl_xor(mx, 16)); mx = fmaxf(mx, __shfl_xor(mx, 32));
    const float mnew = fmaxf(mrun, mx);
    const float corr = __builtin_amdgcn_exp2f(mrun - mnew);
    float rs = 0.f;
#pragma unroll
    for (int n = 0; n < 4 * NS; ++n)
#pragma unroll
        for (int r = 0; r < 4; ++r) { const float p = __builtin_amdgcn_exp2f(sacc[n][r] - mnew); sacc[n][r] = p; rs += p; }
    rs += __shfl_xor(rs, 16); rs += __shfl_xor(rs, 32);
    lrun = lrun * corr + rs; mrun = mnew;
    bf16x8 pf[2 * NS];
#pragma unroll
    for (int kk = 0; kk < 2 * NS; ++kk) {
        const u32x4 pk = (u32x4){pk2(sacc[2 * kk][0], sacc[2 * kk][1]), pk2(sacc[2 * kk][2], sacc[2 * kk][3]), pk2(sacc[2 * kk + 1][0], sacc[2 * kk + 1][1]), pk2(sacc[2 * kk + 1][2], sacc[2 * kk + 1][3])};
        pf[kk] = __builtin_bit_cast(bf16x8, pk);
    }
#pragma unroll
    for (int n2 = 0; n2 < 4; ++n2) {
        oacc[n2] = oacc[n2] * corr;
#pragma unroll
        for (int kk = 0; kk < 2 * NS; ++kk) {
            const s16x4 lo = tr4(cV, TLD, (2 * kk) * 16 + 4 * g, n2 * 16, lane), hi = tr4(cV, TLD, (2 * kk + 1) * 16 + 4 * g, n2 * 16, lane);
            const bf16x8 vf = (bf16x8){lo[0], lo[1], lo[2], lo[3], hi[0], hi[1], hi[2], hi[3]};
            oacc[n2] = MFMA16(vf, pf[kk], oacc[n2]);
        }
    }
}
__device__ __forceinline__ void attn_compute(const bf16_t* cK, const bf16_t* cV, const float* cC, const bf16x8 (&qf)[2], f32x4 (&oacc)[4], float& mrun, float& lrun,
                                             float ct2, float scale2, int causal, int key0, int r0, int tq, int lane, int g) {
    if (!causal || key0 + 127 <= r0) { attn_compute_t<false, 2>(cK, cV, cC, qf, oacc, mrun, lrun, ct2, scale2, key0, tq, lane, g); return; }
    if (key0 > r0 + 15) return;
    if (key0 + 64 > r0 + 15) attn_compute_t<true, 1>(cK, cV, cC, qf, oacc, mrun, lrun, ct2, scale2, key0, tq, lane, g);
    else attn_compute_t<true, 2>(cK, cV, cC, qf, oacc, mrun, lrun, ct2, scale2, key0, tq, lane, g);
}

__device__ __forceinline__ void attn_task(char* smem, const bf16_t* __restrict__ Q, int ldq, const bf16_t* __restrict__ Kp, int ldk, const bf16_t* __restrict__ Vp, int ldv, const float* __restrict__ bias,
                                          int nq_per_b, int nk_per_b, int causal, float scale, bf16_t* __restrict__ O, int ldo, const float* __restrict__ gain, int rms, int task) {
    constexpr int KT = 128;
    bf16_t* sK = (bf16_t*)smem;
    bf16_t* sV = sK + 2 * KT * TLD;
    float* sC = (float*)(sV + 2 * KT * TLD);
    const int tid = TIDX, lane = tid & 63, wave = tid >> 6, g = lane >> 4, li = lane & 15;
    const int nqt = nq_per_b / 128;
    const int qt = task % nqt, h = (task / nqt) & 3, b = task / (nqt * 4);
    const int q0 = qt * 128, r0 = q0 + wave * 16, tq = r0 + li;
    const size_t qrow = (size_t)b * nq_per_b + tq;
    bf16x8 qf[2];
#pragma unroll
    for (int kk = 0; kk < 2; ++kk) qf[kk] = *(const bf16x8*)(Q + qrow * ldq + h * 64 + kk * 32 + g * 8);
    constexpr float LOG2E = 1.4426950408889634f;
    const float ct = bias ? bias[(size_t)(b * 4 + h) * nq_per_b + tq] * LOG2E : 0.f;
    const float scale2 = scale * LOG2E;
    const int nkt = causal ? (q0 + 128) / KT : nk_per_b / KT;
    const int sr = tid >> 3, sc = tid & 7;
    const bf16_t* kg = Kp + ((size_t)b * nk_per_b + sr) * ldk + h * 64 + sc * 8;
    const bf16_t* vg = Vp + ((size_t)b * nk_per_b + sr) * ldv + h * 64 + sc * 8;
    const float* cg_ = bias ? bias + (size_t)(b * 4 + h) * nk_per_b : nullptr;
    u32x4 rkA[2], rvA[2], rkB[2], rvB[2]; float rcA = 0.f, rcB = 0.f;
#define AT_LOAD(RK, RV, RC, kt) { _Pragma("unroll") for (int i = 0; i < 2; ++i) { RK[i] = *(const u32x4*)(kg + (size_t)((kt) * KT + i * 64) * ldk); RV[i] = *(const u32x4*)(vg + (size_t)((kt) * KT + i * 64) * ldv); } \
        RC = (cg_ && tid < KT) ? cg_[(kt) * KT + tid] * LOG2E : 0.f; }
#define AT_STORE(RK, RV, RC, buf) { _Pragma("unroll") for (int i = 0; i < 2; ++i) { *(u32x4*)(sK + ((buf) * KT + sr + i * 64) * TLD + sc * 8) = RK[i]; *(u32x4*)(sV + ((buf) * KT + sr + i * 64) * TLD + sc * 8) = RV[i]; } \
        if (tid < KT) sC[(buf) * KT + tid] = RC; }
#define AT_COMPUTE(buf, kt) attn_compute(sK + (buf) * KT * TLD, sV + (buf) * KT * TLD, sC + (buf) * KT, qf, oacc, mrun, lrun, ct, scale2, causal, (kt) * KT, r0, tq, lane, g)
    AT_LOAD(rkA, rvA, rcA, 0)
    if (nkt > 1) AT_LOAD(rkB, rvB, rcB, 1)
    __syncthreads();
    AT_STORE(rkA, rvA, rcA, 0)
    __syncthreads();
    f32x4 oacc[4];
#pragma unroll
    for (int n = 0; n < 4; ++n) oacc[n] = (f32x4){0.f, 0.f, 0.f, 0.f};
    float mrun = -INFINITY, lrun = 0.f;
    for (int kt = 0; kt < nkt; kt += 2) {
        if (kt + 2 < nkt) AT_LOAD(rkA, rvA, rcA, kt + 2)
        AT_COMPUTE(0, kt);
        if (kt + 1 < nkt) AT_STORE(rkB, rvB, rcB, 1)
        __syncthreads();
        if (kt + 1 < nkt) {
            if (kt + 3 < nkt) AT_LOAD(rkB, rvB, rcB, kt + 3)
            AT_COMPUTE(1, kt + 1);
            if (kt + 2 < nkt) AT_STORE(rkA, rvA, rcA, 0)
            __syncthreads();
        }
    }
#undef AT_LOAD
#undef AT_STORE
#undef AT_COMPUTE
    const float inv = 1.f / lrun;
    float ms = 0.f;
#pragma unroll
    for (int n = 0; n < 4; ++n) { oacc[n] = oacc[n] * inv; ms += oacc[n][0] * oacc[n][0] + oacc[n][1] * oacc[n][1] + oacc[n][2] * oacc[n][2] + oacc[n][3] * oacc[n][3]; }
    ms += __shfl_xor(ms, 16); ms += __shfl_xor(ms, 32);
    const float rinv = rms ? rsqrtf(ms * (1.f / 64.f) + EPS) : 1.f;
#pragma unroll
    for (int n = 0; n < 4; ++n) {
        const int d = n * 16 + 4 * g;
        f32x4 gg = (f32x4){1.f, 1.f, 1.f, 1.f};
        if (gain) gg = *(const f32x4*)(gain + h * 64 + d);
        uint2 o; o.x = pk2(oacc[n][0] * rinv * gg[0], oacc[n][1] * rinv * gg[1]); o.y = pk2(oacc[n][2] * rinv * gg[2], oacc[n][3] * rinv * gg[3]);
        *(uint2*)(O + qrow * ldo + h * 64 + d) = o;
    }
}


__device__ __forceinline__ void hgrn_scan(float* LF  , float* SEGT  , const bf16_t* __restrict__ prow  , const float* __restrict__ hgrn_lb, int layer, int h, float (&kk)[8]) {
    const int tid = TIDX, t = tid >> 3, k8 = (tid & 7) * 8;
    const u32x4 raw = *(const u32x4*)(prow + (size_t)t * NP + C_AF + k8);
#pragma unroll
    for (int j = 0; j < 8; ++j) {
        const float fl = __uint_as_float((j & 1) ? (raw[j >> 1] & 0xffff0000u) : (raw[j >> 1] << 16));
        float lbk = 0.f;
        if (layer == 1) { const float a0 = hgrn_lb[h * 64 + k8 + j], a1 = hgrn_lb[256 + h * 64 + k8 + j]; lbk = 1.f / (1.f + __expf(a0 - a1)); }
        const float sg = sigmoidf_(fl);
        const float f = lbk + (1.f - lbk) * sg;
        kk[j] = (1.f - lbk) * (1.f - sg);
        LF[t * 65 + k8 + j] = __logf(f);
    }
    __syncthreads();
    { const int k = tid & 63, seg = tid >> 6; float run = 0.f;
#pragma unroll
      for (int i = 0; i < 8; ++i) { run += LF[(seg * 8 + i) * 65 + k]; LF[(seg * 8 + i) * 65 + k] = run; }
      SEGT[seg * 64 + k] = run; }
    __syncthreads();
    { const int k = tid & 63, seg = tid >> 6; float off = 0.f;
      for (int s2 = 0; s2 < seg; ++s2) off += SEGT[s2 * 64 + k];
#pragma unroll
      for (int i = 0; i < 8; ++i) LF[(seg * 8 + i) * 65 + k] += off; }
    __syncthreads();
}
__device__ __forceinline__ float bfx(const u32x4& raw, int j) { return __uint_as_float((j & 1) ? (raw[j >> 1] & 0xffff0000u) : (raw[j >> 1] << 16)); }

__device__ __forceinline__ void hgrn_local_task(char* smem, const bf16_t* __restrict__ proj, const float* __restrict__ hgrn_lb, int layer, float* __restrict__ HL, float* __restrict__ HD, int ch) {
    float* LF = (float*)smem; float* SEGT = LF + 64 * 65;
    bf16_t* sKd = (bf16_t*)(SEGT + 8 * 64); bf16_t* sV = sKd + 64 * TLD;
    const int tid = TIDX, lane = tid & 63, wave = tid >> 6, g = lane >> 4, li = lane & 15;
    const int bh = ch >> 5, n = ch & 31, b = bh >> 2, h = bh & 3;
    const bf16_t* prow = proj + (size_t)(b * SEQ + n * 64) * NP + h * 64;
    const int t = tid >> 3, k8 = (tid & 7) * 8;
    __syncthreads();
    *(u32x4*)(sV + t * TLD + k8) = *(const u32x4*)(prow + (size_t)t * NP + C_AI + k8);
    float kk[8];
    hgrn_scan(LF, SEGT, prow, hgrn_lb, layer, h, kk);
    { u32x4 o;
#pragma unroll
      for (int j = 0; j < 8; j += 2) {
          const float e0 = kk[j] * __expf(LF[63 * 65 + k8 + j] - LF[t * 65 + k8 + j]), e1 = kk[j + 1] * __expf(LF[63 * 65 + k8 + j + 1] - LF[t * 65 + k8 + j + 1]);
          o[j >> 1] = pk2(e0, e1);
      }
      *(u32x4*)(sKd + t * TLD + k8) = o; }
    if (tid < 64) HD[(size_t)ch * 64 + tid] = __expf(LF[63 * 65 + tid]);
    __syncthreads();
#pragma unroll
    for (int i = 0; i < 2; ++i) {
        const int idx = wave * 2 + i, vt = idx >> 2, kt = idx & 3;
        f32x4 acc = (f32x4){0.f, 0.f, 0.f, 0.f};
#pragma unroll
        for (int ks = 0; ks < 2; ++ks) acc = MFMA16(frag_cm(sV, TLD, ks * 32, vt * 16, lane), frag_cm(sKd, TLD, ks * 32, kt * 16, lane), acc);
        *(f32x4*)(HL + (size_t)ch * 4096 + (kt * 16 + li) * 64 + vt * 16 + 4 * g) = acc;
    }
}

__device__ __forceinline__ void hgrn_out_task(char* smem, const bf16_t* __restrict__ proj, const float* __restrict__ hgrn_lb, int layer, const bf16_t* __restrict__ HS,
                                              const float* __restrict__ mix_gain, bf16_t* __restrict__ y, int ch) {
    float* LF = (float*)smem; float* SEGT = LF + 64 * 65; float* sMS = SEGT + 8 * 64;
    bf16_t* sST = (bf16_t*)(sMS + 128); bf16_t* sQ0 = sST + 64 * TLD; bf16_t* sQm = sQ0 + 64 * TLD; bf16_t* sKm = sQm + 64 * TLD; bf16_t* sV = sKm + 64 * TLD; bf16_t* sA = sV + 64 * TLD;
    const int tid = TIDX, lane = tid & 63, wave = tid >> 6, g = lane >> 4, li = lane & 15;
    const int bh = ch >> 5, n = ch & 31, b = bh >> 2, h = bh & 3;
    const bf16_t* prow = proj + (size_t)(b * SEQ + n * 64) * NP + h * 64;
    const int t = tid >> 3, k8 = (tid & 7) * 8;
    __syncthreads();
    *(u32x4*)(sST + t * TLD + k8) = *(const u32x4*)(HS + (size_t)ch * 4096 + t * 64 + k8);
    const u32x4 qraw = *(const u32x4*)(prow + (size_t)t * NP + C_AQ + k8);
    *(u32x4*)(sV + t * TLD + k8) = *(const u32x4*)(prow + (size_t)t * NP + C_AI + k8);
    float kk[8];
    hgrn_scan(LF, SEGT, prow, hgrn_lb, layer, h, kk);
    { u32x4 o0, om, ok;
#pragma unroll
      for (int j = 0; j < 8; j += 2) {
          float q0v[2], qmv[2], kmv[2];
#pragma unroll
          for (int e = 0; e < 2; ++e) {
              const float bt = LF[t * 65 + k8 + j + e], r = LF[31 * 65 + k8 + j + e], q = siluf_(bfx(qraw, j + e));
              q0v[e] = q * __expf(bt); qmv[e] = q * __expf(bt - r); kmv[e] = kk[j + e] * __expf(r - bt);
          }
          o0[j >> 1] = pk2(q0v[0], q0v[1]); om[j >> 1] = pk2(qmv[0], qmv[1]); ok[j >> 1] = pk2(kmv[0], kmv[1]);
      }
      *(u32x4*)(sQ0 + t * TLD + k8) = o0; *(u32x4*)(sQm + t * TLD + k8) = om; *(u32x4*)(sKm + t * TLD + k8) = ok; }
    __syncthreads();
#pragma unroll
    for (int i = 0; i < 2; ++i) {
        const int idx = wave * 2 + i, tt = idx >> 2, st = idx & 3;
        f32x4 acc = (f32x4){0.f, 0.f, 0.f, 0.f};
#pragma unroll
        for (int ks = 0; ks < 2; ++ks) acc = MFMA16(frag_rm(sKm, TLD, st * 16, ks * 32, lane), frag_rm(sQm, TLD, tt * 16, ks * 32, lane), acc);
        const int tq = tt * 16 + li, s0 = st * 16 + 4 * g;
        uint2 o; o.x = pk2(s0 <= tq ? acc[0] : 0.f, s0 + 1 <= tq ? acc[1] : 0.f); o.y = pk2(s0 + 2 <= tq ? acc[2] : 0.f, s0 + 3 <= tq ? acc[3] : 0.f);
        *(uint2*)(sA + tq * TLD + s0) = o;
    }
    __syncthreads();
    { const int tt = wave >> 1;
      f32x4 oacc[2]; float ms = 0.f;
#pragma unroll
      for (int i = 0; i < 2; ++i) {
          const int vt = (wave & 1) * 2 + i;
          f32x4 acc = (f32x4){0.f, 0.f, 0.f, 0.f};
#pragma unroll
          for (int ks = 0; ks < 2; ++ks) acc = MFMA16(frag_cm(sST, TLD, ks * 32, vt * 16, lane), frag_rm(sQ0, TLD, tt * 16, ks * 32, lane), acc);
#pragma unroll
          for (int ks = 0; ks < 2; ++ks) acc = MFMA16(frag_cm(sV, TLD, ks * 32, vt * 16, lane), frag_rm(sA, TLD, tt * 16, ks * 32, lane), acc);
          oacc[i] = acc; ms += acc[0] * acc[0] + acc[1] * acc[1] + acc[2] * acc[2] + acc[3] * acc[3];
      }
      ms += __shfl_xor(ms, 16); ms += __shfl_xor(ms, 32);
      if (g == 0) sMS[(tt * 16 + li) * 2 + (wave & 1)] = ms;
      __syncthreads();
      const int tq = tt * 16 + li;
      const float rinv = rsqrtf((sMS[tq * 2] + sMS[tq * 2 + 1]) * (1.f / 64.f) + EPS);
      const size_t row = (size_t)(b * SEQ + n * 64 + tq);
#pragma unroll
      for (int i = 0; i < 2; ++i) {
          const int v0 = ((wave & 1) * 2 + i) * 16 + 4 * g;
          const uint2 graw = *(const uint2*)(proj + row * NP + C_AG + h * 64 + v0);
          const f32x4 mgv = *(const f32x4*)(mix_gain + C_AQ + h * 64 + v0);
          const float g0 = __uint_as_float(graw.x << 16), g1 = __uint_as_float(graw.x & 0xffff0000u), g2 = __uint_as_float(graw.y << 16), g3 = __uint_as_float(graw.y & 0xffff0000u);
          uint2 o; o.x = pk2(oacc[i][0] * rinv * siluf_(g0) * mgv[0], oacc[i][1] * rinv * siluf_(g1) * mgv[1]);
          o.y = pk2(oacc[i][2] * rinv * siluf_(g2) * mgv[2], oacc[i][3] * rinv * siluf_(g3) * mgv[3]);
          *(uint2*)(y + row * 1024 + h * 64 + v0) = o;
      }
    }
}


constexpr int GP_BYTES = (128 + 64 * 132 + 64 * 68) * 4 + 2 * 64 * TLD * 2;
__device__ __forceinline__ void gdn_prep_pair(char* smem, const bf16_t* __restrict__ proj, const float* __restrict__ gates, const float* __restrict__ conv_w  ,
                                              const float* __restrict__ a_log, const float* __restrict__ dt_bias, bf16_t* __restrict__ gt_all, float* __restrict__ glast, int ch0) {
#define GP_SG(sub) ((float*)(smem + (sub) * GP_BYTES))
#define GP_SBETA(sub) (GP_SG(sub) + 64)
#define GP_RHS(sub) (GP_SG(sub) + 128)
#define GP_SM(sub) (GP_RHS(sub) + 64 * 132)
#define GP_SK(sub) ((bf16_t*)(GP_SM(sub) + 64 * 68))
#define GP_SQ(sub) (GP_SK(sub) + 64 * TLD)
    const int tid = TIDX, lane = tid & 63, wave = tid >> 6, g = lane >> 4, li = lane & 15;
    const int bh = ch0 >> 5, n0 = ch0 & 31, b = bh >> 2, h = bh & 3;
    const int t = tid >> 3, d8 = (tid & 7) * 8;
    __syncthreads();
    float qn[2][8], kn[2][8], vv[2][8];
#pragma unroll
    for (int sub = 0; sub < 2; ++sub) {
        const int n = n0 + sub; const size_t row0 = (size_t)(b * SEQ + n * 64);
        const int spos = n * 64 + t;
#pragma unroll
        for (int sec = 0; sec < 3; ++sec) {
            const int col = (sec == 0 ? C_DQ : (sec == 1 ? C_DK : C_DV)) + h * 64 + d8;
            float acc[8];
#pragma unroll
            for (int e = 0; e < 8; ++e) acc[e] = 0.f;
#pragma unroll
            for (int j = 0; j < 4; ++j) {
                if (spos - (3 - j) >= 0) {
                    const u32x4 raw = *(const u32x4*)(proj + (row0 + t - (3 - j)) * NP + col);
                    const f32x4 w0 = *(const f32x4*)(conv_w + j * 768 + sec * 256 + h * 64 + d8), w1 = *(const f32x4*)(conv_w + j * 768 + sec * 256 + h * 64 + d8 + 4);
#pragma unroll
                    for (int e = 0; e < 8; ++e) acc[e] += (e < 4 ? w0[e] : w1[e - 4]) * bfx(raw, e);
                }
            }
#pragma unroll
            for (int e = 0; e < 8; ++e) { const float sv = siluf_(acc[e]); if (sec == 0) qn[sub][e] = sv; else if (sec == 1) kn[sub][e] = sv; else vv[sub][e] = sv; }
        }
        float sq = 0.f, sk = 0.f;
#pragma unroll
        for (int e = 0; e < 8; ++e) { sq += qn[sub][e] * qn[sub][e]; sk += kn[sub][e] * kn[sub][e]; }
        sq += __shfl_xor(sq, 1); sq += __shfl_xor(sq, 2); sq += __shfl_xor(sq, 4);
        sk += __shfl_xor(sk, 1); sk += __shfl_xor(sk, 2); sk += __shfl_xor(sk, 4);
        const float rq = rsqrtf(sq + EPS) * 0.125f, rk = rsqrtf(sk + EPS);
#pragma unroll
        for (int e = 0; e < 8; ++e) { qn[sub][e] *= rq; kn[sub][e] *= rk; }
        if ((tid & 7) == 0) {
            const float* gr = gates + (row0 + t) * 16;
            GP_SBETA(sub)[t] = sigmoidf_(gr[4 + h]);
            GP_SG(sub)[t] = -__expf(a_log[h]) * softplusf_(gr[8 + h] + dt_bias[h]);
        }
    }
    __syncthreads();
    if (wave < 2) {
        float* sG = GP_SG(wave);
        float v = sG[lane];
#pragma unroll
        for (int o = 1; o < 64; o <<= 1) { const float nb = __shfl_up(v, o); if (lane >= o) v += nb; }
        sG[lane] = v;
    }
    __syncthreads();
#pragma unroll
    for (int sub = 0; sub < 2; ++sub) {
        const int ch = ch0 + sub; bf16_t* gt = gt_all + (size_t)ch * 5 * 4096;
        float* sG = GP_SG(sub); float* RHS = GP_RHS(sub);
        const float Gt = sG[t], Gl = sG[63], bt = GP_SBETA(sub)[t];
        const float eG = __expf(Gt), eD = __expf(Gl - Gt);
        u32x4 ok, oq, oqd, okd;
#pragma unroll
        for (int e = 0; e < 8; e += 2) {
            ok[e >> 1] = pk2(kn[sub][e], kn[sub][e + 1]); oq[e >> 1] = pk2(qn[sub][e], qn[sub][e + 1]);
            oqd[e >> 1] = pk2(qn[sub][e] * eG, qn[sub][e + 1] * eG); okd[e >> 1] = pk2(kn[sub][e] * eD, kn[sub][e + 1] * eD);
        }
        *(u32x4*)(GP_SK(sub) + t * TLD + d8) = ok; *(u32x4*)(GP_SQ(sub) + t * TLD + d8) = oq;
        *(u32x4*)(gt + 2 * 4096 + t * 64 + d8) = oqd; *(u32x4*)(gt + 3 * 4096 + t * 64 + d8) = okd;
#pragma unroll
        for (int e = 0; e < 8; ++e) { RHS[t * 132 + d8 + e] = vv[sub][e] * bt; RHS[t * 132 + 64 + d8 + e] = kn[sub][e] * bt * eG; }
        if (tid == 0) glast[ch] = __expf(Gl);
    }
    __syncthreads();
#pragma unroll
    for (int i = 0; i < 4; ++i) {
        const int idx = wave * 4 + i, sub = idx >> 4, tt = (idx >> 2) & 3, st = idx & 3;
        const bf16_t* sK = GP_SK(sub); const bf16_t* sQ = GP_SQ(sub); const float* sG = GP_SG(sub); const float* sBeta = GP_SBETA(sub); float* sM = GP_SM(sub);
        bf16_t* gt = gt_all + (size_t)(ch0 + sub) * 5 * 4096;
        f32x4 am = (f32x4){0.f, 0.f, 0.f, 0.f}, aq = (f32x4){0.f, 0.f, 0.f, 0.f};
#pragma unroll
        for (int ks = 0; ks < 2; ++ks) {
            const bf16x8 kfs = frag_rm(sK, TLD, st * 16, ks * 32, lane), kft = frag_rm(sK, TLD, tt * 16, ks * 32, lane);
            am = MFMA16(kft, kfs, am);
            aq = MFMA16(kfs, frag_rm(sQ, TLD, tt * 16, ks * 32, lane), aq);
        }
        {   const int sx = st * 16 + li, t0 = tt * 16 + 4 * g; const float Gs = sG[sx];
            f32x4 mo;
#pragma unroll
            for (int r = 0; r < 4; ++r) { const int tq = t0 + r; mo[r] = (sx < tq) ? sBeta[tq] * am[r] * __expf(sG[tq] - Gs) : 0.f; }
            *(f32x4*)(sM + sx * 68 + t0) = mo; }
        {   const int tq = tt * 16 + li, s0 = st * 16 + 4 * g; const float Gt = sG[tq];
            float ao[4];
#pragma unroll
            for (int r = 0; r < 4; ++r) { const int sx = s0 + r; ao[r] = (sx <= tq) ? aq[r] * __expf(Gt - sG[sx]) : 0.f; }
            uint2 o; o.x = pk2(ao[0], ao[1]); o.y = pk2(ao[2], ao[3]);
            *(uint2*)(gt + 4 * 4096 + tq * 64 + s0) = o; }
    }
    __syncthreads();
    if (tid < 256) {
        const int sub = tid >> 7, col = tid & 127;
        const float* RHS = GP_RHS(sub); const float* sM = GP_SM(sub);
        bf16_t* gt = gt_all + (size_t)(ch0 + sub) * 5 * 4096;
        float acc[64];
#pragma unroll
        for (int i = 0; i < 64; ++i) acc[i] = RHS[i * 132 + col];
#pragma unroll
        for (int half = 0; half < 2; ++half) {
            const int base = half * 32;
            if (half == 1) {
#pragma unroll
                for (int sx = 0; sx < 32; sx += 2) {
                    f32x4 r0[8], r1[8];
#pragma unroll
                    for (int c = 0; c < 8; ++c) { r0[c] = *(const f32x4*)(sM + sx * 68 + 32 + c * 4); r1[c] = *(const f32x4*)(sM + (sx + 1) * 68 + 32 + c * 4); }
                    const float x0 = acc[sx], x1 = acc[sx + 1];
#pragma unroll
                    for (int tq = 0; tq < 32; ++tq) { acc[32 + tq] -= r0[tq >> 2][tq & 3] * x0; acc[32 + tq] -= r1[tq >> 2][tq & 3] * x1; }
                }
            }
            f32x4 cur[8];
#pragma unroll
            for (int c = 0; c < 8; ++c) cur[c] = *(const f32x4*)(sM + base * 68 + base + c * 4);
#pragma unroll
            for (int sx = 0; sx < 31; ++sx) {
                f32x4 nxt[8];
#pragma unroll
                for (int c = (sx + 2) >> 2; c < 8; ++c) nxt[c] = *(const f32x4*)(sM + (base + sx + 1) * 68 + base + c * 4);
                const float xs = acc[base + sx];
#pragma unroll
                for (int tq = sx + 1; tq < 32; ++tq) acc[base + tq] -= cur[tq >> 2][tq & 3] * xs;
#pragma unroll
                for (int c = (sx + 2) >> 2; c < 8; ++c) cur[c] = nxt[c];
            }
        }
        if (col < 64) {
#pragma unroll
            for (int tt = 0; tt < 64; ++tt) gt[tt * 64 + col] = f2bf(acc[tt]);
        } else {
#pragma unroll
            for (int tt = 0; tt < 64; ++tt) gt[4096 + tt * 64 + (col - 64)] = f2bf(-acc[tt]);
        }
    }
#undef GP_SG
#undef GP_SBETA
#undef GP_RHS
#undef GP_SM
#undef GP_SK
#undef GP_SQ
}

__device__ __forceinline__ void gdn_scan_task(char* smem, const bf16_t* __restrict__ gt_all, const float* __restrict__ glast, const bf16_t* __restrict__ proj, const float* __restrict__ mix_gain,
                                              bf16_t* __restrict__ y, int bh) {
    bf16_t* sT = (bf16_t*)smem;
    bf16_t* sST = sT + 2 * 5 * 64 * TLD;
    bf16_t* sVn = sST + 2 * 64 * TLD;
    const int tid = TIDX, lane = tid & 63, wave = tid >> 6, g = lane >> 4, li = lane & 15;
    const int b = bh >> 2, h = bh & 3;
    const int sr = tid >> 3, sc8 = (tid & 7) * 8;
    const bf16_t* gsrc = gt_all + (size_t)bh * 32 * 5 * 4096 + sr * 64 + sc8;
    __syncthreads();
    u32x4 regs[5];
#pragma unroll
    for (int i = 0; i < 5; ++i) regs[i] = *(const u32x4*)(gsrc + i * 4096);
#pragma unroll
    for (int i = 0; i < 5; ++i) *(u32x4*)(sT + i * 64 * TLD + sr * TLD + sc8) = regs[i];
    *(u32x4*)(sST + sr * TLD + sc8) = (u32x4){0u, 0u, 0u, 0u};
    f32x4 sacc[4];
#pragma unroll
    for (int i = 0; i < 4; ++i) sacc[i] = (f32x4){0.f, 0.f, 0.f, 0.f};
    __syncthreads();
    for (int n = 0; n < 32; ++n) {
        const int buf = n & 1;
        const bf16_t* cT = sT + buf * 5 * 64 * TLD;
        const bf16_t* sU = cT; const bf16_t* sWn = cT + 64 * TLD; const bf16_t* sQd = cT + 2 * 64 * TLD; const bf16_t* sKd = cT + 3 * 64 * TLD; const bf16_t* sAq = cT + 4 * 64 * TLD;
        const bf16_t* cST = sST + buf * 64 * TLD; bf16_t* nST = sST + (buf ^ 1) * 64 * TLD;
        if (n + 1 < 32) {
#pragma unroll
            for (int i = 0; i < 5; ++i) regs[i] = *(const u32x4*)(gsrc + (size_t)(n + 1) * 5 * 4096 + i * 4096);
        }
        const size_t rowz = (size_t)(b * SEQ + n * 64 + (wave & 3) * 16 + li);
        uint2 zraw[4];
        if (wave < 4) {
#pragma unroll
            for (int vt = 0; vt < 4; ++vt) zraw[vt] = *(const uint2*)(proj + rowz * NP + C_DZ + h * 64 + vt * 16 + 4 * g);
        }
#pragma unroll
        for (int i = 0; i < 2; ++i) {
            const int idx = wave * 2 + i, tt = idx >> 2, vt = idx & 3;
            const int tq = tt * 16 + li, v0 = vt * 16 + 4 * g;
            const uint2 uraw = *(const uint2*)(sU + tq * TLD + v0);
            f32x4 acc = (f32x4){__uint_as_float(uraw.x << 16), __uint_as_float(uraw.x & 0xffff0000u), __uint_as_float(uraw.y << 16), __uint_as_float(uraw.y & 0xffff0000u)};
#pragma unroll
            for (int ks = 0; ks < 2; ++ks) acc = MFMA16(frag_rm(cST, TLD, vt * 16, ks * 32, lane), frag_rm(sWn, TLD, tt * 16, ks * 32, lane), acc);
            uint2 o; o.x = pk2(acc[0], acc[1]); o.y = pk2(acc[2], acc[3]);
            *(uint2*)(sVn + tq * TLD + v0) = o;
        }
        __syncthreads();
        if (wave < 4) {
            const int tt = wave;
            f32x4 oacc[4]; float ms = 0.f;
#pragma unroll
            for (int vt = 0; vt < 4; ++vt) {
                f32x4 acc = (f32x4){0.f, 0.f, 0.f, 0.f};
#pragma unroll
                for (int ks = 0; ks < 2; ++ks) acc = MFMA16(frag_rm(cST, TLD, vt * 16, ks * 32, lane), frag_rm(sQd, TLD, tt * 16, ks * 32, lane), acc);
#pragma unroll
                for (int ks = 0; ks < 2; ++ks) acc = MFMA16(frag_cm(sVn, TLD, ks * 32, vt * 16, lane), frag_rm(sAq, TLD, tt * 16, ks * 32, lane), acc);
                oacc[vt] = acc; ms += acc[0] * acc[0] + acc[1] * acc[1] + acc[2] * acc[2] + acc[3] * acc[3];
            }
            ms += __shfl_xor(ms, 16); ms += __shfl_xor(ms, 32);
            const float rinv = rsqrtf(ms * (1.f / 64.f) + EPS);
#pragma unroll
            for (int vt = 0; vt < 4; ++vt) {
                const int v0 = vt * 16 + 4 * g;
                const f32x4 mgv = *(const f32x4*)(mix_gain + 768 + h * 64 + v0);
                const float z0 = __uint_as_float(zraw[vt].x << 16), z1 = __uint_as_float(zraw[vt].x & 0xffff0000u), z2 = __uint_as_float(zraw[vt].y << 16), z3 = __uint_as_float(zraw[vt].y & 0xffff0000u);
                uint2 o; o.x = pk2(oacc[vt][0] * rinv * siluf_(z0) * mgv[0], oacc[vt][1] * rinv * siluf_(z1) * mgv[1]);
                o.y = pk2(oacc[vt][2] * rinv * siluf_(z2) * mgv[2], oacc[vt][3] * rinv * siluf_(z3) * mgv[3]);
                *(uint2*)(y + rowz * 1024 + 768 + h * 64 + v0) = o;
            }
        } else {
            const int kt = wave - 4;
            const float gl = glast[bh * 32 + n];
#pragma unroll
            for (int vt = 0; vt < 4; ++vt) {
                f32x4 acc = sacc[vt] * gl;
#pragma unroll
                for (int ks = 0; ks < 2; ++ks) acc = MFMA16(frag_cm(sKd, TLD, ks * 32, kt * 16, lane), frag_cm(sVn, TLD, ks * 32, vt * 16, lane), acc);
                sacc[vt] = acc;
                uint2 o; o.x = pk2(acc[0], acc[1]); o.y = pk2(acc[2], acc[3]);
                *(uint2*)(nST + (vt * 16 + li) * TLD + kt * 16 + 4 * g) = o;
            }
        }
        if (n + 1 < 32) {
            bf16_t* nT = sT + (buf ^ 1) * 5 * 64 * TLD;
#pragma unroll
            for (int i = 0; i < 5; ++i) *(u32x4*)(nT + i * 64 * TLD + sr * TLD + sc8) = regs[i];
        }
        __syncthreads();
    }
}


constexpr int XLD = 264;
__device__ __forceinline__ void lru_local_task(char* smem, const bf16_t* __restrict__ proj, const float* __restrict__ conv_w, const float* __restrict__ conv_b,
                                               const float* __restrict__ w_a, const float* __restrict__ b_a, const float* __restrict__ w_x, const float* __restrict__ b_x,
                                               const float* __restrict__ lam, float* __restrict__ hl_out, float* __restrict__ ac_out, float* __restrict__ lsum, int task) {
    bf16_t* sX = (bf16_t*)smem;
    bf16_t* sW = sX + 64 * XLD;
    const int tid = TIDX, lane = tid & 63, wave = tid >> 6, g = lane >> 4, li = lane & 15;
    const int b = task >> 5, n = task & 31;
    const size_t row0 = (size_t)(b * SEQ + n * 64);
    const int t = tid >> 3;
    __syncthreads();
    {
        const int i = tid >> 3, j8 = (tid & 7) * 8;
#pragma unroll
        for (int mat = 0; mat < 8; ++mat) {
            const float* src = ((mat & 1) ? w_x : w_a) + (size_t)(mat >> 1) * 4096 + i * 64 + j8;
            const f32x4 v0 = *(const f32x4*)src, v1 = *(const f32x4*)(src + 4);
            u32x4 o; o[0] = pk2(v0[0], v0[1]); o[1] = pk2(v0[2], v0[3]); o[2] = pk2(v1[0], v1[1]); o[3] = pk2(v1[2], v1[3]);
            *(u32x4*)(sW + mat * 64 * TLD + i * TLD + j8) = o;
        }
    }
    {
        const int spos = n * 64 + t;
#pragma unroll
        for (int i = 0; i < 4; ++i) {
            const int c8 = ((tid & 7) + 8 * i) * 8;
            float acc[8];
            { const f32x4 cb0 = *(const f32x4*)(conv_b + c8), cb1 = *(const f32x4*)(conv_b + c8 + 4);
#pragma unroll
              for (int e = 0; e < 8; ++e) acc[e] = e < 4 ? cb0[e] : cb1[e - 4]; }
#pragma unroll
            for (int j = 0; j < 4; ++j) {
                if (spos - (3 - j) >= 0) {
                    const u32x4 raw = *(const u32x4*)(proj + (row0 + t - (3 - j)) * NP + C_CX + c8);
                    const f32x4 w0 = *(const f32x4*)(conv_w + j * 256 + c8), w1 = *(const f32x4*)(conv_w + j * 256 + c8 + 4);
#pragma unroll
                    for (int e = 0; e < 8; ++e) acc[e] += (e < 4 ? w0[e] : w1[e - 4]) * bfx(raw, e);
                }
            }
            u32x4 o; o[0] = pk2(acc[0], acc[1]); o[1] = pk2(acc[2], acc[3]); o[2] = pk2(acc[4], acc[5]); o[3] = pk2(acc[6], acc[7]);
            *(u32x4*)(sX + t * XLD + c8) = o;
        }
    }
    __syncthreads();
    const int hh = wave >> 1;
#pragma unroll
    for (int j2 = 0; j2 < 2; ++j2) {
        const int jt = (wave & 1) * 2 + j2, cl = jt * 16 + 4 * g, c = hh * 64 + cl;
        f32x4 ra[4], rx[4];
#pragma unroll
        for (int tt = 0; tt < 4; ++tt) { ra[tt] = (f32x4){0.f, 0.f, 0.f, 0.f}; rx[tt] = (f32x4){0.f, 0.f, 0.f, 0.f}; }
#pragma unroll
        for (int ks = 0; ks < 2; ++ks) {
            const bf16x8 wa = frag_cm(sW + (hh * 2) * 64 * TLD, TLD, ks * 32, jt * 16, lane), wx = frag_cm(sW + (hh * 2 + 1) * 64 * TLD, TLD, ks * 32, jt * 16, lane);
#pragma unroll
            for (int tt = 0; tt < 4; ++tt) {
                const bf16x8 xf = frag_rm(sX + hh * 64, XLD, tt * 16, ks * 32, lane);
                ra[tt] = MFMA16(wa, xf, ra[tt]);
                rx[tt] = MFMA16(wx, xf, rx[tt]);
            }
        }
        const f32x4 ba = *(const f32x4*)(b_a + c), bx = *(const f32x4*)(b_x + c), lm = *(const f32x4*)(lam + c);
        float sp[4];
#pragma unroll
        for (int r = 0; r < 4; ++r) sp[r] = softplusf_(-lm[r]);
        f32x4 cA = (f32x4){1.f, 1.f, 1.f, 1.f}, cH = (f32x4){0.f, 0.f, 0.f, 0.f};
#pragma unroll
        for (int tt = 0; tt < 4; ++tt) {
            const int tq = tt * 16 + li;
            const uint2 xraw = *(const uint2*)(sX + tq * XLD + c);
            const float xc[4] = {__uint_as_float(xraw.x << 16), __uint_as_float(xraw.x & 0xffff0000u), __uint_as_float(xraw.y << 16), __uint_as_float(xraw.y & 0xffff0000u)};
            f32x4 A, H;
#pragma unroll
            for (int r = 0; r < 4; ++r) {
                const float rr = sigmoidf_(ra[tt][r] + ba[r]), ig = sigmoidf_(rx[tt][r] + bx[r]);
                const float log_a = -8.f * rr * sp[r];
                A[r] = __expf(log_a);
                H[r] = sqrtf(-expm1f(2.f * log_a)) * (ig * xc[r]);
            }
#pragma unroll
            for (int o = 1; o < 16; o <<= 1) {
#pragma unroll
                for (int r = 0; r < 4; ++r) {
                    const float pA = __shfl_up(A[r], o, 16), pH = __shfl_up(H[r], o, 16);
                    if (li >= o) { H[r] = A[r] * pH + H[r]; A[r] = A[r] * pA; }
                }
            }
            const f32x4 Hf = H + A * cH, Af = A * cA;
            const size_t oidx = (row0 + tq) * 256 + c;
            *(f32x4*)(hl_out + oidx) = Hf; *(f32x4*)(ac_out + oidx) = Af;
#pragma unroll
            for (int r = 0; r < 4; ++r) { cH[r] = __shfl(Hf[r], 15, 16); cA[r] = __shfl(Af[r], 15, 16); }
            if (tt == 3 && li == 15) { *(f32x4*)(lsum + (size_t)task * 256 + c) = Af; *(f32x4*)(lsum + (size_t)(256 + task) * 256 + c) = Hf; }
        }
    }
}
__device__ __forceinline__ void lru_out_task(const float* __restrict__ hl_in, const float* __restrict__ ac_in, const float* __restrict__ lsum, const bf16_t* __restrict__ proj,
                                             const float* __restrict__ mix_gain, bf16_t* __restrict__ y, int task) {
    const int b = task >> 5, n = task & 31, c = TIDX & 255, half = TIDX >> 8;
    const float Hc = lsum[(size_t)task * 256 + c];
    const float mg = mix_gain[512 + c];
    const size_t row0 = (size_t)(b * SEQ + n * 64 + half * 32);
#pragma unroll
    for (int i0 = 0; i0 < 32; i0 += 16) {
        float hv[16], av[16]; bf16_t gv[16];
#pragma unroll
        for (int i = 0; i < 16; ++i) { const size_t row = row0 + i0 + i; hv[i] = hl_in[row * 256 + c]; av[i] = ac_in[row * 256 + c]; gv[i] = proj[row * NP + C_CG + c]; }
#pragma unroll
        for (int i = 0; i < 16; ++i) {
            const size_t row = row0 + i0 + i;
            const float yv = (hv[i] + av[i] * Hc) * geluf_(bf2f(gv[i]));
            const float ms = wave_sum(yv * yv) * (1.f / 64.f);
            y[row * 1024 + 512 + c] = f2bf(yv * rsqrtf(ms + EPS) * mg);
        }
    }
}


__device__ __forceinline__ void state_scan_phase(const float* __restrict__ HL, const float* __restrict__ HD, bf16_t* __restrict__ HS, const float* __restrict__ lsum, float* __restrict__ lcar) {
    const int bx = blockIdx.x, tid = TIDX;
    for (int u = bx; u < 128 + 4; u += gridDim.x) {
        if (u < 128) {
            const int gid = u * NTHR + tid, bh = gid >> 11, v = gid & 63, kp = (gid >> 6) & 31;
            const float* Lb = HL + (size_t)bh * 32 * 4096 + (2 * kp) * 64 + v; const float* Db = HD + (size_t)bh * 32 * 64 + 2 * kp;
            bf16_t* Sb = HS + (size_t)bh * 32 * 4096 + (2 * kp) * 64 + v;
            float S0 = 0.f, S1 = 0.f;
            for (int n0 = 0; n0 < 32; n0 += 8) {
                float l0[8], l1[8], d0[8], d1[8];
#pragma unroll
                for (int i = 0; i < 8; ++i) { l0[i] = Lb[(size_t)(n0 + i) * 4096]; l1[i] = Lb[(size_t)(n0 + i) * 4096 + 64]; d0[i] = Db[(n0 + i) * 64]; d1[i] = Db[(n0 + i) * 64 + 1]; }
#pragma unroll
                for (int i = 0; i < 8; ++i) {
                    Sb[(size_t)(n0 + i) * 4096] = f2bf(S0); Sb[(size_t)(n0 + i) * 4096 + 64] = f2bf(S1);
                    S0 = d0[i] * S0 + l0[i]; S1 = d1[i] * S1 + l1[i];
                }
            }
        } else {
            const int gid = (u - 128) * NTHR + tid, b = gid >> 8, c = gid & 255;
            float A[32], H[32];
#pragma unroll
            for (int n = 0; n < 32; ++n) { A[n] = lsum[(size_t)(b * 32 + n) * 256 + c]; H[n] = lsum[(size_t)(256 + b * 32 + n) * 256 + c]; }
            float Hc = 0.f;
#pragma unroll
            for (int n = 0; n < 32; ++n) { lcar[(size_t)(b * 32 + n) * 256 + c] = Hc; Hc = A[n] * Hc + H[n]; }
        }
    }
}

__device__ __forceinline__ void router_phase(char* smem, const float* __restrict__ x, const float* __restrict__ g, const bf16_t* __restrict__ wr  , const float* __restrict__ b_rg,
                                             const float* __restrict__ b_re, const float* __restrict__ pss, int* __restrict__ cnt, int* __restrict__ list, float* __restrict__ pgate) {
    bf16_t* sXh = (bf16_t*)smem;
    bf16_t* sXl = sXh + 64 * TLD;
    float* sLog = (float*)(sXl + 64 * TLD);
    const int tid = TIDX, lane = tid & 63, wave = tid >> 6, gq = lane >> 4, li = lane & 15;
    const int mt = wave & 3, kh = wave >> 2;
    const int stok = tid >> 3, c8 = (tid & 7) * 8;
    BLK_LOOP(tile, T / 64) {
        const int t0 = tile * 64;
        f32x4 acc[3];
#pragma unroll
        for (int n = 0; n < 3; ++n) acc[n] = (f32x4){0.f, 0.f, 0.f, 0.f};
        const float* xp = x + (size_t)(t0 + stok) * 1024 + c8;
        const bf16_t* wp = wr + (size_t)li * 1024 + kh * 32 + gq * 8;
        f32x4 x0 = *(const f32x4*)xp, x1 = *(const f32x4*)(xp + 4);
        u32x4 wh[3], wl[3];
#pragma unroll
        for (int n = 0; n < 3; ++n) { wh[n] = *(const u32x4*)(wp + n * 16 * 1024); wl[n] = *(const u32x4*)(wp + 48 * 1024 + n * 16 * 1024); }
        for (int kc = 0; kc < 16; ++kc) {
            const f32x4 g0 = *(const f32x4*)(g + kc * 64 + c8), g1 = *(const f32x4*)(g + kc * 64 + c8 + 4);
            const f32x4 v0 = x0 * g0, v1 = x1 * g1;
            u32x4 oh, ol;
#pragma unroll
            for (int j = 0; j < 2; ++j) {
                const unsigned h0 = pk2(v0[2 * j], v0[2 * j + 1]), h1 = pk2(v1[2 * j], v1[2 * j + 1]);
                oh[j] = h0; oh[2 + j] = h1;
                ol[j] = pk2(v0[2 * j] - __uint_as_float(h0 << 16), v0[2 * j + 1] - __uint_as_float(h0 & 0xffff0000u));
                ol[2 + j] = pk2(v1[2 * j] - __uint_as_float(h1 << 16), v1[2 * j + 1] - __uint_as_float(h1 & 0xffff0000u));
            }
            __syncthreads();
            *(u32x4*)(sXh + stok * TLD + c8) = oh; *(u32x4*)(sXl + stok * TLD + c8) = ol;
            __syncthreads();
            u32x4 cwh[3], cwl[3];
#pragma unroll
            for (int n = 0; n < 3; ++n) { cwh[n] = wh[n]; cwl[n] = wl[n]; }
            if (kc + 1 < 16) {
                x0 = *(const f32x4*)(xp + (kc + 1) * 64); x1 = *(const f32x4*)(xp + (kc + 1) * 64 + 4);
#pragma unroll
                for (int n = 0; n < 3; ++n) { wh[n] = *(const u32x4*)(wp + n * 16 * 1024 + (kc + 1) * 64); wl[n] = *(const u32x4*)(wp + 48 * 1024 + n * 16 * 1024 + (kc + 1) * 64); }
            }
            const bf16x8 xh = frag_rm(sXh, TLD, mt * 16, kh * 32, lane), xl = frag_rm(sXl, TLD, mt * 16, kh * 32, lane);
#pragma unroll
            for (int n = 0; n < 3; ++n) {
                const bf16x8 fh = __builtin_bit_cast(bf16x8, cwh[n]), fl = __builtin_bit_cast(bf16x8, cwl[n]);
                acc[n] = MFMA16(fh, xh, acc[n]);
                acc[n] = MFMA16(fl, xh, acc[n]);
                acc[n] = MFMA16(fh, xl, acc[n]);
            }
        }
#pragma unroll
        for (int n = 0; n < 3; ++n) *(f32x4*)(sLog + (kh * 64 + mt * 16 + li) * 48 + n * 16 + 4 * gq) = acc[n];
        __syncthreads();
        int* sCnt = (int*)(sLog + 2 * 64 * 48);
        if (tid < 64) sCnt[tid] = 0;
        __syncthreads();
        int ex0 = 0, ex1 = 0, lr0 = 0, lr1 = 0; float gw0 = 0.f, gw1 = 0.f;
        if (tid < 64) {
            const float rinv = rinv_from_pss(pss, (size_t)(t0 + tid));
            const float* l0 = sLog + tid * 48; const float* l1 = sLog + (64 + tid) * 48;
            float lg[4];
#pragma unroll
            for (int i = 0; i < 4; ++i) lg[i] = (l0[i] + l1[i]) * rinv + b_rg[i];
            int gs = 0; float gm = lg[0];
#pragma unroll
            for (int i = 1; i < 4; ++i) if (lg[i] > gm) { gm = lg[i]; gs = i; }
            float den = 0.f;
#pragma unroll
            for (int i = 0; i < 4; ++i) den += __expf(lg[i] - gm);
            const float pg = 1.f / den;
            int i0 = 0, i1 = -1; float m0 = -INFINITY, m1 = -INFINITY;
            for (int i = 0; i < 8; ++i) {
                const float v = (l0[4 + gs * 8 + i] + l1[4 + gs * 8 + i]) * rinv + b_re[gs * 8 + i];
                if (v > m0) { m1 = m0; i1 = i0; m0 = v; i0 = i; } else if (v > m1) { m1 = v; i1 = i; }
            }
            const float e1 = __expf(m1 - m0);
            gw0 = pg / (1.f + e1); gw1 = pg * e1 / (1.f + e1);
            ex0 = gs * 8 + i0; ex1 = gs * 8 + i1;
            lr0 = atomicAdd(&sCnt[ex0], 1); lr1 = atomicAdd(&sCnt[ex1], 1);
        }
        __syncthreads();
        if (tid < 32) { const int c = sCnt[tid]; sCnt[32 + tid] = c ? atomicAdd(&cnt[tid * CNT_STRIDE], c) : 0; }
        __syncthreads();
        if (tid < 64) {
            const int t = t0 + tid;
            list[(size_t)ex0 * T + sCnt[32 + ex0] + lr0] = 2 * t; pgate[2 * t] = gw0;
            list[(size_t)ex1 * T + sCnt[32 + ex1] + lr1] = 2 * t + 1; pgate[2 * t + 1] = gw1;
        }
        __syncthreads();
    }
}

__device__ __forceinline__ void combine_phase(const float* x2, const bf16_t* __restrict__ eo, const float* __restrict__ g, float* xout, bf16_t* __restrict__ hn, int mode) {
    const int lane = TIDX & 63;
    for (int t = blockIdx.x * 8 + (TIDX >> 6); t < T; t += gridDim.x * 8) {
        f32x4 v[4]; float s = 0.f;
#pragma unroll
        for (int j = 0; j < 4; ++j) {
            const int c = (lane + 64 * j) * 4;
            v[j] = *(const f32x4*)(x2 + (size_t)t * 1024 + c);
            const uint2 e0 = *(const uint2*)(eo + (size_t)(2 * t) * 1024 + c), e1 = *(const uint2*)(eo + (size_t)(2 * t + 1) * 1024 + c);
            v[j].x += __uint_as_float(e0.x << 16) + __uint_as_float(e1.x << 16);
            v[j].y += __uint_as_float(e0.x & 0xffff0000u) + __uint_as_float(e1.x & 0xffff0000u);
            v[j].z += __uint_as_float(e0.y << 16) + __uint_as_float(e1.y << 16);
            v[j].w += __uint_as_float(e0.y & 0xffff0000u) + __uint_as_float(e1.y & 0xffff0000u);
            s += v[j].x * v[j].x + v[j].y * v[j].y + v[j].z * v[j].z + v[j].w * v[j].w;
        }
        const float rinv = rsqrtf(wave_sum(s) * (1.f / 1024.f) + EPS);
#pragma unroll
        for (int j = 0; j < 4; ++j) {
            const int c = (lane + 64 * j) * 4;
            const f32x4 gg = *(const f32x4*)(g + c);
            const f32x4 hv = v[j] * rinv * gg;
            if (mode == 0) {
                *(f32x4*)(xout + (size_t)t * 1024 + c) = v[j];
                uint2 o; o.x = pk2(hv.x, hv.y); o.y = pk2(hv.z, hv.w);
                *(uint2*)(hn + (size_t)t * 1024 + c) = o;
            } else {
                *(f32x4*)(xout + (size_t)t * 1024 + c) = hv;
            }
        }
    }
}

template <int l>
__device__ __forceinline__ void layer_body(const Params& P, char* smem, const XcdBarrier& xb, const float* xcur) {
    char* ws = P.ws;
    bf16_t* Wt_in = (bf16_t*)(ws + OFF_WIN); bf16_t* Wt_out = (bf16_t*)(ws + OFF_WOUT); bf16_t* Wt_mq = (bf16_t*)(ws + OFF_WMQ); bf16_t* Wt_mkv = (bf16_t*)(ws + OFF_WMKV);
    bf16_t* Wt_mo = (bf16_t*)(ws + OFF_WMO); bf16_t* Wt_gu = (bf16_t*)(ws + OFF_WGU); bf16_t* Wt_dn = (bf16_t*)(ws + OFF_WDN);
    bf16_t* hn = (bf16_t*)(ws + OFF_HN); bf16_t* proj = (bf16_t*)(ws + OFF_PROJ); float* gates = (float*)(ws + OFF_GATES); bf16_t* y = (bf16_t*)(ws + OFF_Y);
    float* XA = P.out; float* XB = (float*)(ws + OFF_XB);
    bf16_t* qm = (bf16_t*)(ws + OFF_QM); bf16_t* om = (bf16_t*)(ws + OFF_OM); bf16_t* kvm = (bf16_t*)(ws + OFF_KVM); bf16_t* memn = (bf16_t*)(ws + OFF_MEMN);
    float* foxc = (float*)(ws + OFF_FOXC); float* lrua = (float*)(ws + OFF_LRUA); float* lruu = (float*)(ws + OFF_LRUU);
    int* cnt_all = (int*)(ws + OFF_CTL) + CTL_CNT_WORD; int* list = (int*)(ws + OFF_LIST); float* pgate = (float*)(ws + OFF_PGATE);
    bf16_t* act = (bf16_t*)(ws + OFF_ACT); bf16_t* eo = (bf16_t*)(ws + OFF_EO); float* pss = (float*)(ws + OFF_PSS);
    const int wave = TIDX >> 6, lane = TIDX & 63;


        float* x1 = (l == 0) ? XA : XB;
        float* x2 = (l == 0) ? XB : XA;
        int* cnt = cnt_all + 32 * CNT_STRIDE * l;
        const float* mg = P.in[I_MIX_GAIN] + l * 1024;
        REP(2, { pg8::Gemm g{hn, Wt_in + (size_t)l * NP * 1024, T, NP, 1024}; pg8::StaticOrder S; S.init(T, NP, (int)gridDim.x, (int)blockIdx.x);
                 pg8::EpiInProj E{proj, NP, gates, C_GATE};
                 pg8::gemm_phase<pg8::EpiInProj, pg8::StaticOrder, true, true>((PG8_LAS unsigned char*)smem, g, S, E); });
        if (l == 0) for (int l2 = 0; l2 < NL; ++l2)
            gemm_phase<EPI_BF16>(smem, memn + (size_t)l2 * 2048 * 1024, 1024, Wt_mkv + (size_t)l2 * 512 * 1024, 1024, 2048, 512, 1024, kvm + (size_t)l2 * 2048 * 512, 512, nullptr, nullptr,
                                 (gridDim.x >= 192) ? ((int)blockIdx.x - 128 - 32 * l2) : (int)blockIdx.x, (gridDim.x >= 192) ? 4096 : (int)gridDim.x);
        GSYNC();
        REP(4,         {
            const int bx = blockIdx.x;
            bf16_t* gtiles = (bf16_t*)(ws + OFF_GDN); float* glast = (float*)(ws + OFF_GLAST);
            if (bx < 32 && wave == 1) fox_cumsum(gates, P.in[I_FOX_FB] + l * 4, foxc, bx, lane);
            BLK_LOOP(cp, 512) gdn_prep_pair(smem, proj, gates, P.in[I_GDN_CONV_W] + l * 4 * 768, P.in[I_GDN_A_LOG] + l * 4, P.in[I_GDN_DT_BIAS] + l * 4, gtiles, glast, 2 * cp);
            BLK_LOOP(ch, 1024) hgrn_local_task(smem, proj, P.in[I_HGRN_LB], l, (float*)(ws + OFF_HL), (float*)(ws + OFF_HD), ch);
            BLK_LOOP(task, 256) lru_local_task(smem, proj, P.in[I_LRU_CONV_W] + l * 1024, P.in[I_LRU_CONV_B] + l * 256, P.in[I_LRU_WA] + l * 16384, P.in[I_LRU_BA] + l * 256,
                                               P.in[I_LRU_WX] + l * 16384, P.in[I_LRU_BX] + l * 256, P.in[I_LRU_LAM] + l * 256, lrua, lruu, (float*)(ws + OFF_LSUM), task);
        });
        GSYNC();
        state_scan_phase((const float*)(ws + OFF_HL), (const float*)(ws + OFF_HD), (bf16_t*)(ws + OFF_HS), (const float*)(ws + OFF_LSUM), (float*)(ws + OFF_LCAR));
        GSYNC();
        REP(8,         {
            const int natt = (SEQ / 128) * 4 * NB;
            const int bx = blockIdx.x, nfree = (int)gridDim.x - 32;
            if (bx < 32) gdn_scan_task(smem, (const bf16_t*)(ws + OFF_GDN), (const float*)(ws + OFF_GLAST), proj, mg, y, bx);
            else {
                for (int r = 0; r * nfree < natt; ++r) {
                    const int i = r * nfree + ((r & 1) ? (nfree - 1 - (bx - 32)) : (bx - 32));
                    if (i >= natt) continue;
                    const int qt = 15 - (i >> 5), bh = i & 31;
                    attn_task(smem, proj + C_BQ, NP, proj + C_BK, NP, proj + C_BV, NP, foxc, SEQ, SEQ, 1, 0.125f, y + 256, 1024, mg + 256, 1, (bh * 16) + qt);
                }
                for (int i = bx - 32; i < 1024; i += nfree) {
                    const int ch = (i & 31) * 32 + (31 - (i >> 5));
                    hgrn_out_task(smem, proj, P.in[I_HGRN_LB], l, (const bf16_t*)(ws + OFF_HS), mg, y, ch);
                }
                for (int i = bx - 32; i < 256; i += nfree) lru_out_task(lrua, lruu, (const float*)(ws + OFF_LCAR), proj, mg, y, i);
            }
        });
        GSYNC();
        REP(16, { pg8::Gemm g{y, Wt_out + (size_t)l * 1024 * 1024, T, 1024, 1024}; pg8::StaticOrder S; S.init(T, 1024, (int)gridDim.x, (int)blockIdx.x);
                  pg8::EpiResidNorm E{xcur, x1, 1024, P.in[I_NORM_MEM] + l * 1024, hn, pss};
                  pg8::gemm_phase<pg8::EpiResidNorm, pg8::StaticOrder, true, true>((PG8_LAS unsigned char*)smem, g, S, E); });
        GSYNC();
        REP(64, gemm_phase<EPI_BF16_RS>(smem, hn, 1024, Wt_mq + (size_t)l * 256 * 1024, 1024, T, 256, 1024, qm, 256, pss, nullptr));
        GSYNC();
        { const bf16_t* kv = kvm + (size_t)l * 2048 * 512;
          REP(128, BLK_LOOP(task, (SEQ / 128) * 4 * NB) attn_task(smem, qm, 256, kv, 512, kv + 256, 512, nullptr, SEQ, MEMLEN, 0, 0.125f, om, 256, nullptr, 0, task)); }
        GSYNC();
        REP(256, gemm_phase<EPI_RESID_NORM>(smem, om, 256, Wt_mo + (size_t)l * 1024 * 256, 256, T, 1024, 256, x2, 1024, x1, pss, -1, 0, hn, P.in[I_NORM_FFN] + l * 1024));
        GSYNC();
        router_phase(smem, x2, P.in[I_NORM_FFN] + l * 1024, (const bf16_t*)(ws + OFF_WR) + (size_t)l * 2 * 48 * 1024, P.in[I_B_RG] + l * 4, P.in[I_B_RE] + l * 32, pss, cnt, list, pgate);
        GSYNC();
        REP(512, moe_phase<1>(smem, hn, 1024, Wt_gu + (size_t)l * 32 * 512 * 1024, (size_t)512 * 1024, 1024, 1024, cnt, list, pgate, act, pss));
        GSYNC();
        REP(1024, moe_phase<2>(smem, act, 256, Wt_dn + (size_t)l * 32 * 1024 * 256, (size_t)1024 * 256, 256, 256, cnt, list, pgate, eo, pss));
        if (PROBE_MASK & 2048) { for (int i = 0; i < 10; ++i) GSYNC(); }
        GSYNC();
        if (l == 0) { combine_phase(x2, eo, P.in[I_NORM_MIX] + 1024, XA, hn, 0); GSYNC(); }
        else combine_phase(x2, eo, P.in[I_NORM_FINAL], P.out, hn, 1);
}
__global__ void __launch_bounds__(NTHR, 2) mega_kernel(Params P) {
    extern __shared__ __attribute__((aligned(16))) char smem[];
    volatile LDS_AS unsigned* st = (volatile LDS_AS unsigned*)(smem + LDS_BYTES - 16);
    if (TIDX < 4) st[TIDX] = 0u;
    __syncthreads();
    const XcdBarrier xb = xcd_barrier_post((unsigned*)(P.ws + OFF_CTL), st);
    phase0(P, smem);
    GSYNC();
    layer_body<0>(P, smem, xb, P.in[I_X]);
    layer_body<1>(P, smem, xb, P.out);
}

extern "C" void kernel_launch(void* const* d_in, const int* in_sizes, int n_in, void* d_out, int out_size, void* d_ws, size_t ws_size, hipStream_t stream) {
    static int grid_blocks = 0;
    if (grid_blocks == 0) {
        if (n_in != N_INPUTS || ws_size < OFF_END || out_size != T * 1024) { fprintf(stderr, "kernel_launch: unexpected sizes n_in=%d ws=%zu out=%d (need ws >= %zu)\n", n_in, ws_size, out_size, (size_t)OFF_END); grid_blocks = -1; return; }
        int dev = 0, cus = 0, per_cu = 0;
        if (hipGetDevice(&dev) != hipSuccess || hipDeviceGetAttribute(&cus, hipDeviceAttributeMultiprocessorCount, dev) != hipSuccess) { fprintf(stderr, "kernel_launch: device query failed\n"); grid_blocks = -1; return; }
        if (hipFuncSetAttribute((const void*)mega_kernel, hipFuncAttributeMaxDynamicSharedMemorySize, LDS_BYTES) != hipSuccess) { fprintf(stderr, "kernel_launch: hipFuncSetAttribute failed\n"); grid_blocks = -1; return; }
        if (hipOccupancyMaxActiveBlocksPerMultiprocessor(&per_cu, (const void*)mega_kernel, NTHR, LDS_BYTES) != hipSuccess || per_cu < 1) { fprintf(stderr, "kernel_launch: occupancy query says %d blocks/CU\n", per_cu); grid_blocks = -1; return; }
        grid_blocks = cus;
        fprintf(stderr, "kernel_launch: cus=%d per_cu=%d grid=%d\n", cus, per_cu, grid_blocks);
    }
    if (grid_blocks < 0) return;
    if (hipMemsetAsync((char*)d_ws + OFF_CTL, 0, CTL_BYTES, stream) != hipSuccess) { fprintf(stderr, "kernel_launch: memset failed\n"); return; }
    Params p; memset(&p, 0, sizeof p);
    for (int i = 0; i < N_INPUTS; ++i) p.in[i] = (const float*)d_in[i];
    p.out = (float*)d_out; p.ws = (char*)d_ws;
    void* args[] = {&p};
    hipError_t e = hipLaunchCooperativeKernel((const void*)mega_kernel, dim3(grid_blocks), dim3(NTHR), args, LDS_BYTES, stream);
    if (e != hipSuccess) fprintf(stderr, "kernel_launch: cooperative launch failed: %s (grid %d)\n", hipGetErrorString(e), grid_blocks);
}
```

```cpp
#include <hip/hip_runtime.h>
#include <stdint.h>
#include <stdio.h>
#include <string.h>
#include <hip/hip_cooperative_groups.h>
namespace cg = cooperative_groups;

typedef unsigned short bf16_t;
typedef short bf16x8 __attribute__((ext_vector_type(8)));
typedef float f32x4 __attribute__((ext_vector_type(4)));
typedef unsigned u32x4 __attribute__((ext_vector_type(4)));

constexpr int NB = 8, SEQ = 2048, DM = 1024, T = NB * SEQ, NL = 2;
constexpr int NP = 3584;
constexpr int NIN = 3340;
constexpr int C_AQ = 0, C_AF = 256, C_AI = 512, C_AG = 768, C_BQ = 1024, C_BK = 1280, C_BV = 1536, C_CX = 1792, C_CG = 2048,
              C_DQ = 2304, C_DK = 2560, C_DV = 2816, C_DZ = 3072, C_GATE = 3328;
constexpr int MEMLEN = 256;
constexpr int NEXP = 32, DEXP = 256;
constexpr float EPS = 1e-6f;

constexpr size_t al256(size_t x) { return (x + 255) & ~(size_t)255; }
constexpr size_t SZ_WIN = (size_t)NP * 1024 * 2, SZ_WOUT = (size_t)1024 * 1024 * 2, SZ_WMQ = (size_t)256 * 1024 * 2, SZ_WMKV = (size_t)512 * 1024 * 2,
                 SZ_WMO = (size_t)1024 * 256 * 2, SZ_WGU = (size_t)32 * 512 * 1024 * 2, SZ_WDN = (size_t)32 * 1024 * 256 * 2;
constexpr size_t OFF_WIN = 0;
constexpr size_t OFF_WOUT = OFF_WIN + NL * SZ_WIN;
constexpr size_t OFF_WMQ = OFF_WOUT + NL * SZ_WOUT;
constexpr size_t OFF_WMKV = OFF_WMQ + NL * SZ_WMQ;
constexpr size_t OFF_WMO = OFF_WMKV + NL * SZ_WMKV;
constexpr size_t OFF_WGU = OFF_WMO + NL * SZ_WMO;
constexpr size_t OFF_WDN = OFF_WGU + NL * SZ_WGU;
constexpr size_t OFF_HN = OFF_WDN + NL * SZ_WDN;
constexpr size_t OFF_PROJ = OFF_HN + (size_t)T * 1024 * 2;
constexpr size_t OFF_GATES = OFF_PROJ + (size_t)T * NP * 2;
constexpr size_t OFF_Y = OFF_GATES + (size_t)T * 16 * 4;
constexpr size_t OFF_XB = OFF_Y + (size_t)T * 1024 * 2;
constexpr size_t OFF_QM = OFF_XB + (size_t)T * 1024 * 4;
constexpr size_t OFF_OM = OFF_QM + (size_t)T * 256 * 2;
constexpr size_t OFF_KVM = OFF_OM + (size_t)T * 256 * 2;
constexpr size_t OFF_MEMN = OFF_KVM + (size_t)NL * 2048 * 512 * 2;
constexpr size_t OFF_FOXC = OFF_MEMN + (size_t)2048 * 1024 * 2;
constexpr size_t OFF_LRUA = OFF_FOXC + (size_t)NB * 4 * SEQ * 4;
constexpr size_t OFF_LRUU = OFF_LRUA + (size_t)T * 256 * 4;
constexpr size_t OFF_CNT = OFF_LRUU + (size_t)T * 256 * 4;
constexpr size_t OFF_LIST = OFF_CNT + 256;
constexpr size_t OFF_PGATE = OFF_LIST + (size_t)NEXP * T * 4;
constexpr size_t OFF_HL = OFF_PGATE + (size_t)2 * T * 4;
constexpr size_t OFF_HD = OFF_HL + (size_t)1024 * 4096 * 4;
constexpr size_t OFF_GDN = OFF_HD + (size_t)1024 * 64 * 4;
constexpr size_t OFF_GLAST = OFF_GDN + (size_t)1024 * 5 * 4096 * 2;
constexpr size_t OFF_LSUM = OFF_GLAST + 4096;
constexpr size_t OFF_HS = OFF_LSUM + (size_t)2 * 256 * 256 * 4;
constexpr size_t OFF_LCAR = OFF_HS + (size_t)1024 * 4096 * 2;
constexpr size_t OFF_PSS = OFF_LCAR + (size_t)256 * 256 * 4;
constexpr size_t OFF_WR = OFF_PSS + (size_t)T * 16 * 4;
constexpr size_t OFF_CTL = OFF_WR + (size_t)NL * 2 * 48 * 1024 * 2;
constexpr size_t CTL_BYTES = 32768;
constexpr int CTL_CNT_WORD = 4096;
constexpr int CNT_STRIDE = 64;
constexpr size_t OFF_END = OFF_CTL + CTL_BYTES;
constexpr size_t OFF_ACT = OFF_PROJ;
constexpr size_t OFF_EO = OFF_PROJ + (size_t)2 * T * 256 * 2;
static_assert(OFF_EO + (size_t)2 * T * 1024 * 2 <= OFF_GATES, "overlay fits");

__device__ __forceinline__ int tid_opaque() { int t = threadIdx.x; asm volatile("" : "+v"(t)); return t; }
#define TIDX tid_opaque()
__device__ __forceinline__ float bf2f(bf16_t v) { return __uint_as_float(((unsigned)v) << 16); }
typedef __bf16 bf16x2_t __attribute__((ext_vector_type(2)));
__device__ __forceinline__ bf16_t f2bf(float f) { return __builtin_bit_cast(unsigned short, (__bf16)f); }
__device__ __forceinline__ unsigned pk2(float lo, float hi) { bf16x2_t v = {(__bf16)lo, (__bf16)hi}; return __builtin_bit_cast(unsigned, v); }
__device__ __forceinline__ float sigmoidf_(float x) { return 1.f / (1.f + __expf(-x)); }
__device__ __forceinline__ float siluf_(float x) { return x / (1.f + __expf(-x)); }
__device__ __forceinline__ float softplusf_(float x) { return x > 20.f ? x : log1pf(__expf(x)); }
__device__ __forceinline__ float logsigmoidf_(float x) { return x < 0.f ? x - log1pf(__expf(x)) : -log1pf(__expf(-x)); }
__device__ __forceinline__ float geluf_(float x) { float u = 0.7978845608028654f * (x + 0.044715f * x * x * x); return 0.5f * x * (1.f + tanhf(u)); }
__device__ __forceinline__ float wave_sum(float v) {
#pragma unroll
    for (int o = 1; o < 64; o <<= 1) v += __shfl_xor(v, o);
    return v;
}
__device__ __forceinline__ float rdlane(float v, int l) { return __int_as_float(__builtin_amdgcn_readlane(__float_as_int(v), l)); }

#define PROBE_MASK 0
#define GSYNC() xcd_barrier(xb)
#define REP(bit, ...) do { __VA_ARGS__; if (PROBE_MASK & (bit)) { GSYNC(); __VA_ARGS__; } } while (0)
constexpr int NTHR = 512;
constexpr int LDS_BYTES = 147456;
enum { I_X = 0, I_MEM, I_NORM_MIX, I_W_IN, I_HGRN_LB, I_FOX_FB, I_LRU_CONV_W, I_LRU_CONV_B, I_LRU_WA, I_LRU_BA, I_LRU_WX, I_LRU_BX, I_LRU_LAM, I_GDN_CONV_W, I_GDN_A_LOG,
       I_GDN_DT_BIAS, I_MIX_GAIN, I_W_OUT, I_NORM_MEM, I_NORM_MEMKV, I_W_MQ, I_W_MKV, I_W_MO, I_NORM_FFN, I_W_RG, I_B_RG, I_W_RE, I_B_RE, I_W_E_GU, I_W_E_DN, I_NORM_FINAL, N_INPUTS };
struct Params { const float* in[N_INPUTS]; float* out; char* ws; };
static_assert(sizeof(Params) == 8 * (N_INPUTS + 2), "no padding");

#define BLK_LOOP(it, n) for (int it = (int)blockIdx.x; it < (n); it += (int)gridDim.x)


__device__ __forceinline__ float rinv_from_pss(const float* __restrict__ pss, size_t row) {
    const f32x4 a = *(const f32x4*)(pss + row * 16), b = *(const f32x4*)(pss + row * 16 + 4), c = *(const f32x4*)(pss + row * 16 + 8), d = *(const f32x4*)(pss + row * 16 + 12);
    const float sm = ((a[0] + a[1]) + (a[2] + a[3])) + ((b[0] + b[1]) + (b[2] + b[3])) + ((c[0] + c[1]) + (c[2] + c[3])) + ((d[0] + d[1]) + (d[2] + d[3]));
    return rsqrtf(sm * (1.f / 1024.f) + EPS);
}

__device__ __forceinline__ int rowmap_fn(int mode, int n) {
    if (mode == 1) {
        if (n < 1792) return n;
        if (n < 1796) return C_GATE + (n - 1792);
        if (n < 3076) return n - 4;
        if (n < 3084) return C_GATE + 4 + (n - 3076);
        return n - 12;
    } else if (mode == 2) {
        int j = n & 255; return (j >> 4) * 32 + ((n >= 256) ? 16 : 0) + (j & 15);
    }
    return n;
}
__device__ __forceinline__ void convT_tile(float* tile  , const float* __restrict__ src, int K, int N, bf16_t* __restrict__ dst, int mode, int ntn, int idx) {
    const int n0 = (idx % ntn) * 64, k0 = (idx / ntn) * 64;
    const int tid = TIDX;
    __syncthreads();
#pragma unroll
    for (int i = 0; i < 2; ++i) {
        const int k = (tid >> 4) + 32 * i, n = n0 + (tid & 15) * 4;
        f32x4 v = (f32x4){0.f, 0.f, 0.f, 0.f};
        if (n + 3 < N) v = *(const f32x4*)(src + (size_t)(k0 + k) * N + n);
        else { for (int e = 0; e < 4; ++e) if (n + e < N) v[e] = src[(size_t)(k0 + k) * N + n + e]; }
#pragma unroll
        for (int e = 0; e < 4; ++e) tile[k * 65 + (tid & 15) * 4 + e] = v[e];
    }
    __syncthreads();
    const int nl = tid >> 3, k8 = (tid & 7) * 8, n = n0 + nl;
    if (n < N) {
        const int r = rowmap_fn(mode, n);
        u32x4 o;
#pragma unroll
        for (int j = 0; j < 4; ++j) o[j] = pk2(tile[(k8 + 2 * j) * 65 + nl], tile[(k8 + 2 * j + 1) * 65 + nl]);
        *(u32x4*)(dst + (size_t)r * K + k0 + k8) = o;
    }
}
__device__ __forceinline__ void rms_row_bf16(const float* __restrict__ xrow, const float* __restrict__ g, bf16_t* __restrict__ orow, int lane) {
    const f32x4* xr = (const f32x4*)xrow + lane;
    f32x4 v[4]; float s = 0.f;
#pragma unroll
    for (int j = 0; j < 4; ++j) { v[j] = xr[64 * j]; s += v[j].x * v[j].x + v[j].y * v[j].y + v[j].z * v[j].z + v[j].w * v[j].w; }
    const float rinv = rsqrtf(wave_sum(s) * (1.f / 1024.f) + EPS);
#pragma unroll
    for (int j = 0; j < 4; ++j) {
        const f32x4 gg = ((const f32x4*)g)[lane + 64 * j];
        uint2 o; o.x = pk2(v[j].x * rinv * gg.x, v[j].y * rinv * gg.y); o.y = pk2(v[j].z * rinv * gg.z, v[j].w * rinv * gg.w);
        *(uint2*)(orow + (lane + 64 * j) * 4) = o;
    }
}

constexpr int CT_PER_LAYER = 53 * 16 + 256 + 64 + 128 + 64;
constexpr int CT_GU = 64 * 128, CT_DN = 64 * 64;
constexpr int CT_TOTAL = NL * CT_PER_LAYER + CT_GU + CT_DN;

__device__ __forceinline__ void phase0(const Params& P, char* smem) {
    char* ws = P.ws;
    float* tile = (float*)smem;
    BLK_LOOP(it, CT_TOTAL) {
        int r = it;
        if (r < NL * CT_PER_LAYER) {
            const int l = r / CT_PER_LAYER; r -= l * CT_PER_LAYER;
            if (r < 848) { convT_tile(tile, P.in[I_W_IN] + (size_t)l * 1024 * NIN, 1024, NIN, (bf16_t*)(ws + OFF_WIN) + (size_t)l * NP * 1024, 1, 53, r); continue; } r -= 848;
            if (r < 256) { convT_tile(tile, P.in[I_W_OUT] + (size_t)l * 1024 * 1024, 1024, 1024, (bf16_t*)(ws + OFF_WOUT) + (size_t)l * 1024 * 1024, 0, 16, r); continue; } r -= 256;
            if (r < 64) { convT_tile(tile, P.in[I_W_MQ] + (size_t)l * 1024 * 256, 1024, 256, (bf16_t*)(ws + OFF_WMQ) + (size_t)l * 256 * 1024, 0, 4, r); continue; } r -= 64;
            if (r < 128) { convT_tile(tile, P.in[I_W_MKV] + (size_t)l * 1024 * 512, 1024, 512, (bf16_t*)(ws + OFF_WMKV) + (size_t)l * 512 * 1024, 0, 8, r); continue; } r -= 128;
            convT_tile(tile, P.in[I_W_MO] + (size_t)l * 256 * 1024, 256, 1024, (bf16_t*)(ws + OFF_WMO) + (size_t)l * 1024 * 256, 0, 16, r); continue;
        }
        r -= NL * CT_PER_LAYER;
        if (r < CT_GU) { const int m = r >> 7; convT_tile(tile, P.in[I_W_E_GU] + (size_t)m * 1024 * 512, 1024, 512, (bf16_t*)(ws + OFF_WGU) + (size_t)m * 512 * 1024, 2, 8, r & 127); continue; }
        r -= CT_GU;
        { const int m = r >> 6; convT_tile(tile, P.in[I_W_E_DN] + (size_t)m * 256 * 1024, 256, 1024, (bf16_t*)(ws + OFF_WDN) + (size_t)m * 1024 * 256, 0, 16, r & 63); }
    }
    for (int i = blockIdx.x * NTHR + TIDX; i < NL * (NP - NIN) * 512; i += gridDim.x * NTHR) {
        const int l = i / ((NP - NIN) * 512), w = i % ((NP - NIN) * 512);
        ((unsigned*)((bf16_t*)(ws + OFF_WIN) + (size_t)l * NP * 1024 + (size_t)NIN * 1024))[w] = 0u;
    }
    for (int i = blockIdx.x * NTHR + TIDX; i < NL * 48 * 1024; i += gridDim.x * NTHR) {
        const int l = i / (48 * 1024), r = (i / 1024) % 48, k = i & 1023;
        float w = 0.f;
        if (r < 4) w = P.in[I_W_RG][(size_t)l * 4096 + k * 4 + r]; else if (r < 36) w = P.in[I_W_RE][(size_t)l * 32768 + k * 32 + (r - 4)];
        const bf16_t hi = f2bf(w); const bf16_t lo = f2bf(w - bf2f(hi));
        bf16_t* wr = (bf16_t*)(ws + OFF_WR) + (size_t)l * 2 * 48 * 1024;
        wr[r * 1024 + k] = hi; wr[48 * 1024 + r * 1024 + k] = lo;
    }
    const int gw = blockIdx.x * 8 + (TIDX >> 6), ngw = gridDim.x * 8, lane = TIDX & 63;
    for (int row = gw; row < T + NL * 2048; row += ngw) {
        if (row < T) rms_row_bf16(P.in[I_X] + (size_t)row * 1024, P.in[I_NORM_MIX], (bf16_t*)(ws + OFF_HN) + (size_t)row * 1024, lane);
        else { const int r2 = row - T, l = r2 >> 11, rr = r2 & 2047;
               rms_row_bf16(P.in[I_MEM] + (size_t)rr * 1024, P.in[I_NORM_MEMKV] + l * 1024, (bf16_t*)(ws + OFF_MEMN) + (size_t)r2 * 1024, lane); }
    }
}

constexpr int GLD = 72;
constexpr int GEMM_STAGE = (256 + 128) * GLD * 2;
constexpr int GEMM_LDS = 2 * GEMM_STAGE;
template <class RowPtr>
__device__ __forceinline__ void gemm_tile(char* smem, RowPtr rowptr, const bf16_t* __restrict__ Bt, int ldb, int n0, int K, f32x4 (&acc)[4][4]) {
    const int tid = TIDX, lane = tid & 63, wave = tid >> 6, wm = wave >> 1, wn = wave & 1;
    const u32x4* ga[4]; const u32x4* gb[2];
#pragma unroll
    for (int i = 0; i < 4; ++i) { const int c = tid + i * 512, r = c >> 3, ch = c & 7; ga[i] = (const u32x4*)(rowptr(r) + ch * 8); }
#pragma unroll
    for (int i = 0; i < 2; ++i) { const int c = tid + i * 512, r = c >> 3, ch = c & 7; gb[i] = (const u32x4*)(Bt + (size_t)(n0 + r) * ldb + ch * 8); }
#pragma unroll
    for (int m = 0; m < 4; ++m)
#pragma unroll
        for (int n = 0; n < 4; ++n) acc[m][n] = (f32x4){0.f, 0.f, 0.f, 0.f};
    const int nk = K / 64;
    u32x4 raA[4], rbA[2], raB[4], rbB[2];
#define GT_LOAD(RA, RB, kt) { _Pragma("unroll") for (int i = 0; i < 4; ++i) RA[i] = ga[i][(kt) * 8]; _Pragma("unroll") for (int i = 0; i < 2; ++i) RB[i] = gb[i][(kt) * 8]; }
#define GT_STORE(RA, RB, buf) { bf16_t* dA = (bf16_t*)(smem + (buf) * GEMM_STAGE); bf16_t* dB = dA + 256 * GLD; \
        _Pragma("unroll") for (int i = 0; i < 4; ++i) { const int c = tid + i * 512, r = c >> 3, ch = c & 7; *(u32x4*)(dA + r * GLD + ch * 8) = RA[i]; } \
        _Pragma("unroll") for (int i = 0; i < 2; ++i) { const int c = tid + i * 512, r = c >> 3, ch = c & 7; *(u32x4*)(dB + r * GLD + ch * 8) = RB[i]; } }
#define GT_COMPUTE(buf) { const bf16_t* sA = (const bf16_t*)(smem + (buf) * GEMM_STAGE); const bf16_t* sB = sA + 256 * GLD; \
        _Pragma("unroll") for (int kk = 0; kk < 2; ++kk) { bf16x8 af[4], bfr[4]; \
            _Pragma("unroll") for (int m = 0; m < 4; ++m) af[m] = *(const bf16x8*)(sA + (wm * 64 + m * 16 + (lane & 15)) * GLD + kk * 32 + (lane >> 4) * 8); \
            _Pragma("unroll") for (int n = 0; n < 4; ++n) bfr[n] = *(const bf16x8*)(sB + (wn * 64 + n * 16 + (lane & 15)) * GLD + kk * 32 + (lane >> 4) * 8); \
            _Pragma("unroll") for (int m = 0; m < 4; ++m) _Pragma("unroll") for (int n = 0; n < 4; ++n) acc[m][n] = __builtin_amdgcn_mfma_f32_16x16x32_bf16(bfr[n], af[m], acc[m][n], 0, 0, 0); } }
    GT_LOAD(raA, rbA, 0)
    GT_LOAD(raB, rbB, 1)
    __syncthreads();
    GT_STORE(raA, rbA, 0)
    __syncthreads();
    for (int kt = 0; kt < nk; kt += 2) {
        if (kt + 2 < nk) GT_LOAD(raA, rbA, kt + 2)
        GT_COMPUTE(0)
        GT_STORE(raB, rbB, 1)
        __syncthreads();
        if (kt + 3 < nk) GT_LOAD(raB, rbB, kt + 3)
        GT_COMPUTE(1)
        if (kt + 2 < nk) GT_STORE(raA, rbA, 0)
        __syncthreads();
    }
#undef GT_LOAD
#undef GT_STORE
#undef GT_COMPUTE
}
struct RowDirect { const bf16_t* A; int lda; int m0; __device__ __forceinline__ const bf16_t* operator()(int r) const { return A + (size_t)(m0 + r) * lda; } };
enum { EPI_INPROJ = 0, EPI_RESID = 1, EPI_BF16 = 2, EPI_BF16_RS = 3, EPI_RESID_NORM = 4 };

__device__ __forceinline__ int vcu_id() { const int G = gridDim.x, bx = blockIdx.x; return (G % 8 == 0) ? (bx % 8) * (G / 8) + bx / 8 : bx; }

template <int EPI>
__device__ __forceinline__ void gemm_phase(char* smem, const bf16_t* A, int lda, const bf16_t* Bt, int ldb, int M, int N, int K, void* out, int ldo, const float* resid, float* gates, int idx0 = -1, int stride = 0, bf16_t* xg = nullptr, const float* gn = nullptr) {
    const int ntn = N / 128, ntiles = (M / 256) * ntn;
    if (stride == 0) { idx0 = vcu_id(); stride = gridDim.x; }
    if (idx0 < 0) return;
    const int lane = TIDX & 63, wave = TIDX >> 6, wm = wave >> 1, wn = wave & 1;
    for (int tIdx = idx0; tIdx < ntiles; tIdx += stride) {
        const int m0 = (tIdx / ntn) * 256, n0 = (tIdx % ntn) * 128;
        f32x4 acc[4][4];
        RowDirect rp{A, lda, m0};
        gemm_tile(smem, rp, Bt, ldb, n0, K, acc);
        float rsc[4] = {1.f, 1.f, 1.f, 1.f};
        if (EPI == EPI_BF16_RS) {
#pragma unroll
            for (int m = 0; m < 4; ++m) rsc[m] = rinv_from_pss(resid, (size_t)(m0 + wm * 64 + m * 16 + (lane & 15)));
        }
        if (EPI == EPI_RESID_NORM) {
#pragma unroll
            for (int m = 0; m < 4; ++m) {
                const int row = m0 + wm * 64 + m * 16 + (lane & 15);
                float ss = 0.f;
#pragma unroll
                for (int n = 0; n < 4; ++n) {
                    const int col = n0 + wn * 64 + n * 16 + (lane >> 4) * 4;
                    const f32x4 o = *(const f32x4*)(resid + (size_t)row * ldo + col) + acc[m][n];
                    *(f32x4*)((float*)out + (size_t)row * ldo + col) = o;
                    ss += (o[0] * o[0] + o[1] * o[1]) + (o[2] * o[2] + o[3] * o[3]);
                    const f32x4 og = o * *(const f32x4*)(gn + col);
                    uint2 w; w.x = pk2(og[0], og[1]); w.y = pk2(og[2], og[3]);
                    *(uint2*)(xg + (size_t)row * ldo + col) = w;
                }
                ss += __shfl_xor(ss, 16); ss += __shfl_xor(ss, 32);
                if ((lane >> 4) == 0) gates[(size_t)row * 16 + (n0 >> 7) * 2 + wn] = ss;
            }
            continue;
        }
#pragma unroll
        for (int m = 0; m < 4; ++m)
#pragma unroll
            for (int n = 0; n < 4; ++n) {
                const int row = m0 + wm * 64 + m * 16 + (lane & 15), col = n0 + wn * 64 + n * 16 + (lane >> 4) * 4;
                const f32x4 v = acc[m][n];
                if (EPI == EPI_INPROJ) {
                    uint2 o; o.x = pk2(v.x, v.y); o.y = pk2(v.z, v.w);
                    *(uint2*)((bf16_t*)out + (size_t)row * ldo + col) = o;
                    if (col >= C_GATE && col < C_GATE + 16) *(f32x4*)(gates + (size_t)row * 16 + (col - C_GATE)) = v;
                } else if (EPI == EPI_RESID) {
                    const f32x4 r = *(const f32x4*)(resid + (size_t)row * ldo + col);
                    *(f32x4*)((float*)out + (size_t)row * ldo + col) = r + v;
                } else if (EPI == EPI_BF16_RS) {
                    const float ri = rsc[m];
                    uint2 o; o.x = pk2(v.x * ri, v.y * ri); o.y = pk2(v.z * ri, v.w * ri);
                    *(uint2*)((bf16_t*)out + (size_t)row * ldo + col) = o;
                } else {
                    uint2 o; o.x = pk2(v.x, v.y); o.y = pk2(v.z, v.w);
                    *(uint2*)((bf16_t*)out + (size_t)row * ldo + col) = o;
                }
            }
    }
}


namespace pg8 {
#define PG8_LAS __attribute__((address_space(3)))
typedef unsigned short bf16_t;
typedef short bf16x8 __attribute__((ext_vector_type(8)));
typedef float f32x4 __attribute__((ext_vector_type(4)));
typedef unsigned u32x4 __attribute__((ext_vector_type(4)));
constexpr int BM = 256, BK = 64, HALF = 128, HTB = HALF * BK * 2  , STAGE_BYTES = 8 * HTB, NXCD = 8, WGM = 8;

__host__ __device__ __forceinline__ int lds_byte(int r, int c) { const int st = (r >> 4) * 2 + (c >> 5), rr = r & 15, cc = c & 31, ob = rr * 64 + cc * 2; return st * 1024 + (ob ^ (((ob >> 9) & 1) << 5)); }
__host__ __device__ __forceinline__ void stage_rc(int b, int& R, int& C) { const int st = b / 1024, sb = b % 1024, swz = sb ^ (((sb >> 9) & 1) << 5); R = (st >> 1) * 16 + swz / 64; C = (st & 1) * 32 + (swz % 64) / 2; }
__host__ __device__ __forceinline__ int perm32(int rho) { const int n = rho >> 4, i = rho & 15; return 8 * (i >> 2) + 4 * n + (i & 3); }

struct Unit { int pm, pn; };
struct Gemm { const bf16_t* A; const bf16_t* Bt; int M, N, K; };

struct StaticOrder {
    int nM, nN, nwg, G, c;
    __host__ __device__ void init(int M, int N, int G_, int c_) { nM = M / BM; nN = N / BM; nwg = nM * nN; G = G_; c = c_; }
    __host__ __device__ bool next(int i, Unit& u) const {
        const long L = (long)i * G + c; if (L >= nwg) return false;
        int wgid = (int)L; { const int q = nwg / NXCD, r = nwg % NXCD, xcd = wgid % NXCD, off = wgid / NXCD; wgid = (xcd < r ? xcd * (q + 1) : r * (q + 1) + (xcd - r) * q) + off; }
        const int nig = WGM * nN, gid = wgid / nig, fm = gid * WGM, gsz = (nM - fm) < WGM ? (nM - fm) : WGM;
        u.pm = fm + ((wgid % nig) % gsz); u.pn = (wgid % nig) / gsz; return true;
    }
    __device__ __forceinline__ void a_ready(const Unit&) const {}
    __device__ __forceinline__ void done(const Unit&) const {}
};
__device__ __forceinline__ unsigned cvt_pk_bf16(float lo, float hi) { unsigned r; asm volatile("v_cvt_pk_bf16_f32 %0, %1, %2" : "=v"(r) : "v"(lo), "v"(hi)); return r; }
typedef float f32x2 __attribute__((ext_vector_type(2)));

struct EpiInProj {
    static constexpr bool PERM = true, AFTER_DRAIN = false;
    bf16_t* O; int ldc; float* gates; int gate_col;
    __device__ __forceinline__ void operator()(const f32x4 (&acc)[2][2][4][2], const Unit& u, int wr, int wc, int fr, int fq) const {
        const int row0 = u.pm * BM + wr * 64 + fr, col0 = u.pn * BM + wc * 32 + 8 * fq;
#pragma unroll
        for (int ai = 0; ai < 2; ++ai)
#pragma unroll
            for (int m = 0; m < 4; ++m) {
                const int row = row0 + ai * HALF + m * 16;
                bf16_t* rowp = O + (size_t)row * ldc + col0;
#pragma unroll
                for (int bj = 0; bj < 2; ++bj) {
                    const f32x4 v0 = acc[ai][bj][m][0], v1 = acc[ai][bj][m][1];
                    u32x4 w; w.x = cvt_pk_bf16(v0[0], v0[1]); w.y = cvt_pk_bf16(v0[2], v0[3]); w.z = cvt_pk_bf16(v1[0], v1[1]); w.w = cvt_pk_bf16(v1[2], v1[3]);
                    *(u32x4*)(rowp + bj * HALF) = w;
                    const int gc = col0 + bj * HALF - gate_col;
                    if (gates && gc >= 0 && gc < 16) { *(f32x4*)(gates + (size_t)row * 16 + gc) = v0; *(f32x4*)(gates + (size_t)row * 16 + gc + 4) = v1; }
                }
            }
    }
};
struct EpiResid {
    static constexpr bool PERM = false, AFTER_DRAIN = false;
    const float* base; float* out; int ldc;
    __device__ __forceinline__ void operator()(const f32x4 (&acc)[2][2][4][2], const Unit& u, int wr, int wc, int fr, int fq) const {
        const int col0 = u.pn * BM + wc * 32 + 4 * fq;
#pragma unroll
        for (int ai = 0; ai < 2; ++ai)
#pragma unroll
            for (int m = 0; m < 4; ++m) {
                const size_t off = (size_t)(u.pm * BM + ai * HALF + wr * 64 + m * 16 + fr) * ldc + col0;
#pragma unroll
                for (int bj = 0; bj < 2; ++bj)
#pragma unroll
                    for (int n = 0; n < 2; ++n) { const f32x4 bs = *(const f32x4*)(base + off + bj * HALF + n * 16); *(f32x4*)(out + off + bj * HALF + n * 16) = bs + acc[ai][bj][m][n]; }
                if (m & 1) asm volatile("" ::: "memory");
            }
    }
};

struct EpiResidNorm {
    static constexpr bool PERM = false, AFTER_DRAIN = false;
    const float* base; float* out; int ldc; const float* gn; bf16_t* xg; float* pss;
    __device__ __forceinline__ void operator()(const f32x4 (&acc)[2][2][4][2], const Unit& u, int wr, int wc, int fr, int fq) const {
        const int col0 = u.pn * BM + wc * 32 + 4 * fq;
        f32x4 gv[2][2];
#pragma unroll
        for (int bj = 0; bj < 2; ++bj)
#pragma unroll
            for (int n = 0; n < 2; ++n) gv[bj][n] = *(const f32x4*)(gn + col0 + bj * HALF + n * 16);
#pragma unroll
        for (int ai = 0; ai < 2; ++ai)
#pragma unroll
            for (int m = 0; m < 4; ++m) {
                const int row = u.pm * BM + ai * HALF + wr * 64 + m * 16 + fr;
                const size_t off = (size_t)row * ldc + col0;
                float ss = 0.f;
#pragma unroll
                for (int bj = 0; bj < 2; ++bj)
#pragma unroll
                    for (int n = 0; n < 2; ++n) {
                        const f32x4 bs = *(const f32x4*)(base + off + bj * HALF + n * 16);
                        const f32x4 o = bs + acc[ai][bj][m][n];
                        *(f32x4*)(out + off + bj * HALF + n * 16) = o;
                        ss += (o[0] * o[0] + o[1] * o[1]) + (o[2] * o[2] + o[3] * o[3]);
                        const f32x4 og = o * gv[bj][n];
                        uint2 w; w.x = cvt_pk_bf16(og[0], og[1]); w.y = cvt_pk_bf16(og[2], og[3]);
                        *(uint2*)(xg + off + bj * HALF + n * 16) = w;
                    }
                ss += __shfl_xor(ss, 16); ss += __shfl_xor(ss, 32);
                if (fq == 0) pss[(size_t)row * 16 + u.pn * 4 + wc] = ss;
                if (m & 1) asm volatile("" ::: "memory");
            }
    }
};
template <class Epi, class Sched, bool ALIGN_EPI = false, bool SP2 = false>
__device__ __forceinline__ void gemm_phase(PG8_LAS unsigned char* lds, const Gemm g, const Sched& S, const Epi& E) {
    const int tid = TIDX, wid = __builtin_amdgcn_readfirstlane(tid >> 6), lane = tid & 63, wr = wid >> 2, wc = wid & 3, fr = lane & 15, fq = lane >> 4;
    const int K = g.K, nt = K / BK;
    unsigned voffA[2], voffB[2];
#pragma unroll
    for (int i = 0; i < 2; ++i) { int R, C; stage_rc(tid * 16 + i * 8192, R, C); const int Rb = Epi::PERM ? ((R & ~31) + perm32(R & 31)) : R;
        voffA[i] = (unsigned)(R * K + C) * 2u; voffB[i] = (unsigned)(Rb * K + C) * 2u; }
    const size_t kstep = (size_t)(BK * 2);
    const size_t hstep = (size_t)HALF * K * 2;
    const size_t tstep = 2 * hstep;
    const unsigned ldsw = (unsigned)wid * 1024u;
    const int aoff = lds_byte(wr * 64 + fr, fq * 8), boff = lds_byte(wc * 32 + fr, fq * 8);
#define PG8_SA(b, h) (((b) * 2 + (h)) * HTB)
#define PG8_SB(b, h) ((4 + (b) * 2 + (h)) * HTB)
#define PG8_STAGE(bufoff, gbase, voff) do { _Pragma("unroll") for (int _i = 0; _i < 2; ++_i) \
        __builtin_amdgcn_global_load_lds((const unsigned*)((const char*)(gbase) + (voff)[_i]), (PG8_LAS unsigned*)(lds + (bufoff) + ldsw + _i * 8192), 16, 0, 0); } while (0)
#define PG8_LDA(dst, b, h) do { _Pragma("unroll") for (int m = 0; m < 4; ++m) _Pragma("unroll") for (int k = 0; k < 2; ++k) dst[m][k] = *(const PG8_LAS bf16x8*)(lds + PG8_SA(b, h) + aoff + m * 2048 + k * 1024); } while (0)
#define PG8_LDB(dst, b, h) do { _Pragma("unroll") for (int n = 0; n < 2; ++n) _Pragma("unroll") for (int k = 0; k < 2; ++k) dst[n][k] = *(const PG8_LAS bf16x8*)(lds + PG8_SB(b, h) + boff + n * 2048 + k * 1024); } while (0)
#define PG8_MMA(ai, bj, At, Bt) do { __builtin_amdgcn_s_setprio(1); _Pragma("unroll") for (int m = 0; m < 4; ++m) _Pragma("unroll") for (int n = 0; n < 2; ++n) _Pragma("unroll") for (int k = 0; k < 2; ++k) \
        acc[ai][bj][m][n] = __builtin_amdgcn_mfma_f32_16x16x32_bf16(Bt[n][k], At[m][k], acc[ai][bj][m][n], 0, 0, 0); __builtin_amdgcn_s_setprio(0); } while (0)
#define PG8_WAIT_V(n) asm volatile("s_waitcnt vmcnt(" #n ")" ::: "memory")
#define PG8_WAIT_L(n) asm volatile("s_waitcnt lgkmcnt(" #n ")" ::: "memory")
#define PG8_BAR __builtin_amdgcn_s_barrier()
#define PG8_SCHED __builtin_amdgcn_sched_barrier(0)
    Unit cur, nxt; int ui = 0;
    if (!S.next(0, cur)) return;
    f32x4 acc[2][2][4][2];
#pragma unroll
    for (int a = 0; a < 2; ++a)
#pragma unroll
        for (int b = 0; b < 2; ++b)
#pragma unroll
            for (int m = 0; m < 4; ++m)
#pragma unroll
                for (int n = 0; n < 2; ++n) acc[a][b][m][n] = (f32x4){0.f, 0.f, 0.f, 0.f};
    bf16x8 At[4][2], B0[2][2], B1[2][2];
    const char* cA = (const char*)g.A + (size_t)cur.pm * tstep; const char* cB = (const char*)g.Bt + (size_t)cur.pn * tstep;
    S.a_ready(cur);
    if constexpr (SP2) {
        PG8_STAGE(PG8_SB(0, 0), cB, voffB); PG8_STAGE(PG8_SB(0, 1), cB + hstep, voffB); PG8_STAGE(PG8_SA(0, 0), cA, voffA); PG8_STAGE(PG8_SA(0, 1), cA + hstep, voffA);
        if (wr == 1) PG8_BAR;
        PG8_WAIT_V(2); PG8_BAR;
        PG8_STAGE(PG8_SB(1, 0), cB + kstep, voffB); PG8_STAGE(PG8_SA(1, 0), cA + kstep, voffA); PG8_STAGE(PG8_SB(1, 1), cB + hstep + kstep, voffB);
        PG8_WAIT_V(6); PG8_BAR;
    } else {
        PG8_STAGE(PG8_SB(0, 0), cB, voffB); PG8_STAGE(PG8_SA(0, 0), cA, voffA); PG8_STAGE(PG8_SB(0, 1), cB + hstep, voffB); PG8_STAGE(PG8_SA(0, 1), cA + hstep, voffA);
        if (wr == 1) PG8_BAR;
        PG8_WAIT_V(4); PG8_BAR;
        PG8_STAGE(PG8_SB(1, 0), cB + kstep, voffB); PG8_STAGE(PG8_SA(1, 0), cA + kstep, voffA); PG8_STAGE(PG8_SB(1, 1), cB + hstep + kstep, voffB);
        PG8_WAIT_V(6); PG8_BAR;
    }
    for (;;) {
        const bool has_next = S.next(ui + 1, nxt);
        const char* nA = has_next ? (const char*)g.A + (size_t)nxt.pm * tstep : cA; const char* nB = has_next ? (const char*)g.Bt + (size_t)nxt.pn * tstep : cB;
        for (int t = 0; t < nt; t += 2) {
            const bool last = (t == nt - 2);
            const char* a1 = cA + (size_t)(t + 1) * kstep;
            const char* a2 = last ? nA : cA + (size_t)(t + 2) * kstep; const char* b2 = last ? nB : cB + (size_t)(t + 2) * kstep;
            const char* a3 = a2 + kstep; const char* b3 = b2 + kstep;
            if (last && has_next) S.a_ready(nxt);
            if constexpr (SP2) {
            PG8_LDB(B0, 0, 0); PG8_LDB(B1, 0, 1); PG8_SCHED; PG8_LDA(At, 0, 0); PG8_STAGE(PG8_SA(1, 1), a1 + hstep, voffA);
            PG8_WAIT_V(8); PG8_WAIT_L(0); PG8_BAR; PG8_MMA(0, 0, At, B0); PG8_MMA(0, 1, At, B1); PG8_BAR; PG8_SCHED;
            PG8_LDA(At, 0, 1); PG8_STAGE(PG8_SB(0, 0), b2, voffB); PG8_STAGE(PG8_SB(0, 1), b2 + hstep, voffB); PG8_STAGE(PG8_SA(0, 0), a2, voffA);
            PG8_WAIT_V(8); PG8_WAIT_L(0); PG8_BAR; PG8_MMA(1, 0, At, B0); PG8_MMA(1, 1, At, B1); PG8_BAR; PG8_SCHED;
            PG8_LDB(B0, 1, 0); PG8_LDB(B1, 1, 1); PG8_SCHED; PG8_LDA(At, 1, 0); PG8_STAGE(PG8_SA(0, 1), a2 + hstep, voffA);
            PG8_WAIT_V(8); PG8_WAIT_L(0); PG8_BAR; PG8_MMA(0, 0, At, B0); PG8_MMA(0, 1, At, B1); PG8_BAR; PG8_SCHED;
            PG8_LDA(At, 1, 1); PG8_STAGE(PG8_SB(1, 0), b3, voffB); PG8_STAGE(PG8_SB(1, 1), b3 + hstep, voffB); PG8_STAGE(PG8_SA(1, 0), a3, voffA);
            PG8_WAIT_V(8); PG8_WAIT_L(0); PG8_BAR; PG8_MMA(1, 0, At, B0); PG8_MMA(1, 1, At, B1); PG8_BAR; PG8_SCHED;
            } else {
            PG8_LDB(B0, 0, 0); PG8_SCHED; PG8_LDA(At, 0, 0); PG8_STAGE(PG8_SA(1, 1), a1 + hstep, voffA);
            PG8_WAIT_L(8); PG8_BAR; PG8_WAIT_L(0); PG8_MMA(0, 0, At, B0); PG8_BAR; PG8_SCHED;
            PG8_LDB(B1, 0, 1); PG8_STAGE(PG8_SB(0, 0), b2, voffB);
            PG8_BAR; PG8_WAIT_L(0); PG8_MMA(0, 1, At, B1); PG8_BAR;
            PG8_LDA(At, 0, 1); PG8_STAGE(PG8_SA(0, 0), a2, voffA);
            PG8_BAR; PG8_WAIT_L(0); PG8_MMA(1, 0, At, B0); PG8_BAR; PG8_SCHED;
            PG8_STAGE(PG8_SB(0, 1), b2 + hstep, voffB);
            PG8_WAIT_V(6); PG8_BAR; PG8_MMA(1, 1, At, B1); PG8_BAR;
            PG8_LDB(B0, 1, 0); PG8_SCHED; PG8_LDA(At, 1, 0); PG8_STAGE(PG8_SA(0, 1), a2 + hstep, voffA);
            PG8_WAIT_L(8); PG8_BAR; PG8_WAIT_L(0); PG8_MMA(0, 0, At, B0); PG8_BAR; PG8_SCHED;
            PG8_LDB(B1, 1, 1); PG8_STAGE(PG8_SB(1, 0), b3, voffB);
            PG8_BAR; PG8_WAIT_L(0); PG8_MMA(0, 1, At, B1); PG8_BAR;
            PG8_LDA(At, 1, 1); PG8_STAGE(PG8_SA(1, 0), a3, voffA);
            PG8_BAR; PG8_WAIT_L(0); PG8_MMA(1, 0, At, B0); PG8_BAR; PG8_SCHED;
            PG8_STAGE(PG8_SB(1, 1), b3 + hstep, voffB);
            PG8_WAIT_V(6); PG8_BAR; PG8_MMA(1, 1, At, B1); PG8_BAR;
            }
        }
        if constexpr (ALIGN_EPI) { if (wr == 0) PG8_BAR; }
        if constexpr (!Epi::AFTER_DRAIN) { E(acc, cur, wr, wc, fr, fq); S.done(cur); }
        if (!has_next) break;
#pragma unroll
        for (int a = 0; a < 2; ++a)
#pragma unroll
            for (int b = 0; b < 2; ++b)
#pragma unroll
                for (int m = 0; m < 4; ++m)
#pragma unroll
                    for (int n = 0; n < 2; ++n) acc[a][b][m][n] = (f32x4){0.f, 0.f, 0.f, 0.f};
        cur = nxt; cA = nA; cB = nB; ++ui;
        if constexpr (ALIGN_EPI) { if (wr == 1) PG8_BAR; }
    }
    PG8_WAIT_V(0);
    if constexpr (!ALIGN_EPI) { if (wr == 0) PG8_BAR; }
    PG8_BAR;
    if constexpr (Epi::AFTER_DRAIN) { E.fused(acc, cur, wr, wc, fr, fq, lds, wid, lane); S.done(cur); }
#undef PG8_SA
#undef PG8_SB
#undef PG8_STAGE
#undef PG8_LDA
#undef PG8_LDB
#undef PG8_MMA
#undef PG8_WAIT_V
#undef PG8_WAIT_L
#undef PG8_BAR
#undef PG8_SCHED
}
}

struct RowGather { const bf16_t* A; int lda; const int* ids; int shift; __device__ __forceinline__ const bf16_t* operator()(int r) const { return A + (size_t)(ids[r] >> shift) * lda; } };
template <int STAGE>
__device__ __forceinline__ void moe_phase(char* smem, const bf16_t* A, int lda, const bf16_t* Wt, size_t wstride, int ldb, int K, const int* cnt, const int* list, const float* pgate, bf16_t* out, const float* pss) {
    int* ids = (int*)(smem + GEMM_LDS);
    int* tpre = ids + 256;
    constexpr int NTN = (STAGE == 1) ? 4 : 8;
    __syncthreads();
    if (TIDX < 64) {
        const int ln = TIDX; int nt = (ln < NEXP) ? ((cnt[ln * CNT_STRIDE] + 255) >> 8) : 0; int inc = nt;
#pragma unroll
        for (int o = 1; o < 64; o <<= 1) { const int nb = __shfl_up(inc, o); if (ln >= o) inc += nb; }
        if (ln <= NEXP) tpre[ln] = inc - nt;
    }
    __syncthreads();
    const int ntiles = tpre[NEXP] * NTN;
    const int lane = TIDX & 63, wave = TIDX >> 6, wm = wave >> 1, wn = wave & 1;
    for (int tIdx = vcu_id(); tIdx < ntiles; tIdx += gridDim.x) {
        const int mtg = tIdx / NTN, n0 = (tIdx % NTN) * 128;
        int e = 0;
        for (int i = 1; i < NEXP; ++i) if (tpre[i] <= mtg) e = i;
        const int mt = mtg - tpre[e];
        const int cn = cnt[e * CNT_STRIDE];
        __syncthreads();
        if (TIDX < 256) { const int pos = mt * 256 + TIDX; ids[TIDX] = list[(size_t)e * T + (pos < cn ? pos : cn - 1)]; }
        __syncthreads();
        f32x4 acc[4][4];
        RowGather rp{A, lda, ids, STAGE == 1 ? 1 : 0};
        gemm_tile(smem, rp, Wt + (size_t)e * wstride, ldb, n0, K, acc);
#pragma unroll
        for (int m = 0; m < 4; ++m) {
            const int rl = wm * 64 + m * 16 + (lane & 15);
            if (mt * 256 + rl >= cn) continue;
            const int pid = ids[rl];
            if (STAGE == 1) {
                const float gt = pgate[pid], ri = rinv_from_pss(pss, (size_t)(pid >> 1));
#pragma unroll
                for (int np = 0; np < 2; ++np) {
                    const f32x4 g = acc[m][2 * np], u = acc[m][2 * np + 1];
                    const int j = (n0 + wn * 64 + np * 32) / 2 + (lane >> 4) * 4;
                    const f32x4 gs = g * ri; const float ug = ri * gt;
                    uint2 o; o.x = pk2(siluf_(gs.x) * u.x * ug, siluf_(gs.y) * u.y * ug); o.y = pk2(siluf_(gs.z) * u.z * ug, siluf_(gs.w) * u.w * ug);
                    *(uint2*)(out + (size_t)pid * DEXP + j) = o;
                }
            } else {
#pragma unroll
                for (int n = 0; n < 4; ++n) {
                    const f32x4 v = acc[m][n]; const int col = n0 + wn * 64 + n * 16 + (lane >> 4) * 4;
                    uint2 o; o.x = pk2(v.x, v.y); o.y = pk2(v.z, v.w);
                    *(uint2*)(out + (size_t)pid * 1024 + col) = o;
                }
            }
        }
    }
}

__device__ __forceinline__ void hgrn2_naive(const bf16_t* __restrict__ proj, const float* __restrict__ hgrn_lb, int layer, const float* __restrict__ mix_gain, bf16_t* __restrict__ y, int bh, int lane) {
    const int b = bh >> 2, h = bh & 3;
    float lbk = 0.f;
    if (layer == 1) { float a0 = hgrn_lb[h * 64 + lane], a1 = hgrn_lb[256 + h * 64 + lane]; lbk = 1.f / (1.f + __expf(a0 - a1)); }
    const float mg = mix_gain[C_AQ + h * 64 + lane];
    float S[64];
#pragma unroll
    for (int k = 0; k < 64; ++k) S[k] = 0.f;
    for (int t = 0; t < SEQ; ++t) {
        const bf16_t* pr = proj + (size_t)(b * SEQ + t) * NP + h * 64 + lane;
        const float qk = siluf_(bf2f(pr[C_AQ]));
        const float sg = sigmoidf_(bf2f(pr[C_AF]));
        const float f = lbk + (1.f - lbk) * sg, kk = (1.f - lbk) * (1.f - sg);
        const float iv = bf2f(pr[C_AI]);
        const float gv = bf2f(pr[C_AG]);
        float o = 0.f;
#pragma unroll
        for (int k = 0; k < 64; ++k) { S[k] = rdlane(f, k) * S[k] + rdlane(kk, k) * iv; o += rdlane(qk, k) * S[k]; }
        const float ms = wave_sum(o * o) * (1.f / 64.f);
        const float yv = o * rsqrtf(ms + EPS) * siluf_(gv) * mg;
        y[(size_t)(b * SEQ + t) * 1024 + 0 + h * 64 + lane] = f2bf(yv);
    }
}
__device__ __forceinline__ void gdn_naive(const bf16_t* __restrict__ proj, const float* __restrict__ gates, const float* __restrict__ conv_w  ,
                                          const float* __restrict__ a_log, const float* __restrict__ dt_bias, const float* __restrict__ mix_gain, bf16_t* __restrict__ y, int bh, int lane) {
    const int b = bh >> 2, h = bh & 3;
    float wq[4], wk[4], wv[4];
#pragma unroll
    for (int j = 0; j < 4; ++j) { wq[j] = conv_w[j * 768 + h * 64 + lane]; wk[j] = conv_w[j * 768 + 256 + h * 64 + lane]; wv[j] = conv_w[j * 768 + 512 + h * 64 + lane]; }
    float xq[3] = {0.f, 0.f, 0.f}, xk[3] = {0.f, 0.f, 0.f}, xv[3] = {0.f, 0.f, 0.f};
    const float Aexp = __expf(a_log[h]), dtb = dt_bias[h];
    const float mg = mix_gain[768 + h * 64 + lane];
    float S[64];
#pragma unroll
    for (int k = 0; k < 64; ++k) S[k] = 0.f;
    for (int t = 0; t < SEQ; ++t) {
        const size_t row = (size_t)(b * SEQ + t);
        const bf16_t* pr = proj + row * NP + h * 64 + lane;
        const float q0 = bf2f(pr[C_DQ]), k0 = bf2f(pr[C_DK]), v0 = bf2f(pr[C_DV]), zv = bf2f(pr[C_DZ]);
        float q = siluf_(wq[0] * xq[0] + wq[1] * xq[1] + wq[2] * xq[2] + wq[3] * q0);
        float k = siluf_(wk[0] * xk[0] + wk[1] * xk[1] + wk[2] * xk[2] + wk[3] * k0);
        float v = siluf_(wv[0] * xv[0] + wv[1] * xv[1] + wv[2] * xv[2] + wv[3] * v0);
        xq[0] = xq[1]; xq[1] = xq[2]; xq[2] = q0; xk[0] = xk[1]; xk[1] = xk[2]; xk[2] = k0; xv[0] = xv[1]; xv[1] = xv[2]; xv[2] = v0;
        q = q * rsqrtf(wave_sum(q * q) + EPS) * 0.125f;
        k = k * rsqrtf(wave_sum(k * k) + EPS);
        const float beta = sigmoidf_(gates[row * 16 + 4 + h]);
        const float g = -Aexp * softplusf_(gates[row * 16 + 8 + h] + dtb);
        const float eg = __expf(g);
        float r = 0.f;
#pragma unroll
        for (int i = 0; i < 64; ++i) { S[i] *= eg; r += rdlane(k, i) * S[i]; }
        const float dlt = beta * (v - r);
        float o = 0.f;
#pragma unroll
        for (int i = 0; i < 64; ++i) { S[i] += rdlane(k, i) * dlt; o += rdlane(q, i) * S[i]; }
        const float ms = wave_sum(o * o) * (1.f / 64.f);
        const float yv = o * rsqrtf(ms + EPS) * siluf_(zv) * mg;
        y[row * 1024 + 768 + h * 64 + lane] = f2bf(yv);
    }
}
__device__ __forceinline__ void fox_cumsum(const float* __restrict__ gates, const float* __restrict__ fb, float* __restrict__ cc, int bh, int lane) {
    const int b = bh >> 2, h = bh & 3;
    const float bias = fb[h];
    float v[32];
#pragma unroll
    for (int i = 0; i < 32; ++i) v[i] = gates[(size_t)(b * SEQ + lane * 32 + i) * 16 + h];
    float run = 0.f;
#pragma unroll
    for (int i = 0; i < 32; ++i) { run += logsigmoidf_(v[i] + bias); v[i] = run; }
    float tot = run;
#pragma unroll
    for (int o = 1; o < 64; o <<= 1) { const float nb = __shfl_up(tot, o); if (lane >= o) tot += nb; }
    const float off = tot - run;
    float* dst = cc + (size_t)(b * 4 + h) * SEQ + lane * 32;
#pragma unroll
    for (int i = 0; i < 32; i += 4) *(f32x4*)(dst + i) = (f32x4){v[i] + off, v[i + 1] + off, v[i + 2] + off, v[i + 3] + off};
}
__device__ __forceinline__ void lru_prep_task(float* xc  , const bf16_t* __restrict__ proj, const float* __restrict__ conv_w, const float* __restrict__ conv_b,
                                              const float* __restrict__ w_a, const float* __restrict__ b_a, const float* __restrict__ w_x, const float* __restrict__ b_x,
                                              const float* __restrict__ lam, float* __restrict__ a_out, float* __restrict__ u_out, int task, bool active) {
    const int c = TIDX & 255, t0 = task * 16;
    if (active) {
        const float w0 = conv_w[c], w1 = conv_w[256 + c], w2 = conv_w[512 + c], w3 = conv_w[768 + c], cb = conv_b[c];
        for (int i = 0; i < 16; ++i) {
            const int t = t0 + i, s = t & (SEQ - 1);
            const bf16_t* pr = proj + (size_t)t * NP + C_CX + c;
            float acc = cb + w3 * bf2f(pr[0]);
            if (s >= 1) acc += w2 * bf2f(pr[-(ptrdiff_t)NP]);
            if (s >= 2) acc += w1 * bf2f(pr[-(ptrdiff_t)2 * NP]);
            if (s >= 3) acc += w0 * bf2f(pr[-(ptrdiff_t)3 * NP]);
            xc[i * 256 + c] = acc;
        }
    }
    __syncthreads();
    if (active) {
        const int h = c >> 6, jj = c & 63;
        float ra[16], rx[16];
#pragma unroll
        for (int i = 0; i < 16; ++i) { ra[i] = 0.f; rx[i] = 0.f; }
        for (int k = 0; k < 64; ++k) {
            const float wa = w_a[(h * 64 + k) * 64 + jj], wx = w_x[(h * 64 + k) * 64 + jj];
#pragma unroll
            for (int i = 0; i < 16; ++i) { const float xv = xc[i * 256 + h * 64 + k]; ra[i] += xv * wa; rx[i] += xv * wx; }
        }
        const float ba = b_a[c], bx = b_x[c], sp = softplusf_(-lam[c]);
#pragma unroll
        for (int i = 0; i < 16; ++i) {
            const float r = sigmoidf_(ra[i] + ba), ig = sigmoidf_(rx[i] + bx);
            const float log_a = -8.f * r * sp;
            const float a = __expf(log_a);
            const float u = sqrtf(-expm1f(2.f * log_a)) * (ig * xc[i * 256 + c]);
            a_out[(size_t)(t0 + i) * 256 + c] = a; u_out[(size_t)(t0 + i) * 256 + c] = u;
        }
    }
    __syncthreads();
}
__device__ __forceinline__ void lru_scan_task(const float* __restrict__ a_in, const float* __restrict__ u_in, const bf16_t* __restrict__ proj, const float* __restrict__ mix_gain, bf16_t* __restrict__ y, int b) {
    const int c = TIDX;
    const float mg = mix_gain[512 + c];
    float hst = 0.f;
    for (int t = 0; t < SEQ; ++t) {
        const size_t row = (size_t)(b * SEQ + t);
        hst = a_in[row * 256 + c] * hst + u_in[row * 256 + c];
        const float yv = hst * geluf_(bf2f(proj[row * NP + C_CG + c]));
        const float ms = wave_sum(yv * yv) * (1.f / 64.f);
        y[row * 1024 + 512 + c] = f2bf(yv * rsqrtf(ms + EPS) * mg);
    }
}

typedef short s16x4 __attribute__((ext_vector_type(4)));
#define LDS_AS __attribute__((address_space(3)))
__device__ __forceinline__ bf16x8 frag_rm(const bf16_t* tile, int ld, int r0, int k0, int lane) { return *(const bf16x8*)(tile + (r0 + (lane & 15)) * ld + k0 + (lane >> 4) * 8); }
__device__ __forceinline__ s16x4 tr4(const bf16_t* tile, int ld, int rbase, int c0, int lane) {
    const bf16_t* p = tile + (rbase + ((lane & 15) >> 2)) * ld + c0 + 4 * (lane & 3);
    return __builtin_amdgcn_ds_read_tr16_b64_v4i16((LDS_AS s16x4*)p);
}
__device__ __forceinline__ bf16x8 frag_cm(const bf16_t* tile, int ld, int k0, int c0, int lane) {
    const s16x4 lo = tr4(tile, ld, k0 + (lane >> 4) * 8, c0, lane), hi = tr4(tile, ld, k0 + (lane >> 4) * 8 + 4, c0, lane);
    return (bf16x8){lo[0], lo[1], lo[2], lo[3], hi[0], hi[1], hi[2], hi[3]};
}
#define MFMA16(a, b, c) __builtin_amdgcn_mfma_f32_16x16x32_bf16((a), (b), (c), 0, 0, 0)
constexpr int TLD = 72;


#define XB_TMO      128
#define XB_XCNT(j)  (256  + 64 * (j))
#define XB_XSUB(j)  (1280 + 64 * (j))
#define XB_XGEN(j)  (2304 + 64 * (j))
#define XB_TOP      3328
#define XB_TOPGEN   3392
#define XCD_BAR_WORDS 3456
#define XB_SPIN_CAP (1u << 18)
__device__ __forceinline__ unsigned xb_ld(unsigned* p)              { return __hip_atomic_load(p, __ATOMIC_RELAXED, __HIP_MEMORY_SCOPE_AGENT); }
__device__ __forceinline__ unsigned xb_add(unsigned* p, unsigned v) { return __hip_atomic_fetch_add(p, v, __ATOMIC_RELAXED, __HIP_MEMORY_SCOPE_AGENT); }
__device__ __forceinline__ unsigned xb_xcc_id() { return (unsigned)__builtin_amdgcn_s_getreg((3 << 11) | 20) & 0xFu; }
#define XB_SPIN(cond, bar) do { unsigned _sp = 0; while (cond) { __builtin_amdgcn_s_sleep(1); \
    if ((++_sp & 255u) == 0u) { if (xb_ld(&(bar)[XB_TMO])) break; if (_sp > XB_SPIN_CAP) { atomicAdd(&(bar)[XB_TMO], 1u); break; } } } } while (0)
struct XcdBarrier { unsigned* bar; unsigned x; volatile LDS_AS unsigned* st; };
__device__ __forceinline__ XcdBarrier xcd_barrier_post(unsigned* bar, volatile LDS_AS unsigned* st) {
    XcdBarrier b; b.bar = bar; b.x = xb_xcc_id(); b.st = st;
    if (TIDX == 0) (void)xb_add(&bar[XB_XCNT(b.x)], 1u);
    return b;
}
__device__ __forceinline__ void xcd_barrier_complete(unsigned* bar, unsigned x, unsigned& nloc, unsigned& nx) {
    const unsigned G = gridDim.x * gridDim.y * gridDim.z;
    unsigned sum, cnt, mine, sp = 0u;
    for (;;) {
        sum = 0u; cnt = 0u; mine = 0u;
#pragma unroll
        for (unsigned j = 0; j < 16; ++j) { const unsigned c = xb_ld(&bar[XB_XCNT(j)]); sum += c; cnt += (c > 0u) ? 1u : 0u; mine = (j == x) ? c : mine; }
        if (sum == G) break;
        __builtin_amdgcn_s_sleep(1);
        if ((++sp & 255u) == 0u) { if (xb_ld(&bar[XB_TMO])) break; if (sp > XB_SPIN_CAP) { atomicAdd(&bar[XB_TMO], 1u); break; } }
    }
    nloc = mine > 0u ? mine : 1u; nx = cnt > 0u ? cnt : 1u;
}
__device__ __forceinline__ void xcd_barrier(const XcdBarrier& b) {
    asm volatile("s_waitcnt vmcnt(0)" ::: "memory");
    __syncthreads();
    if (TIDX == 0) {
        unsigned* bar = b.bar;
        __builtin_amdgcn_s_waitcnt(0);
        unsigned nloc = b.st[0], nx = b.st[1];
        if (nloc == 0u) { xcd_barrier_complete(bar, b.x, nloc, nx); b.st[0] = nloc; b.st[1] = nx; }
        const unsigned old = xb_add(&bar[XB_XSUB(b.x)], 1u);
        const unsigned gen = old / nloc;
        if (old + 1u == (gen + 1u) * nloc) {
            __builtin_amdgcn_fence(__ATOMIC_RELEASE, "agent");
            asm volatile("s_waitcnt vmcnt(0)" ::: "memory");
            const unsigned og = xb_add(&bar[XB_TOP], 1u);
            const unsigned tg = og / nx;
            if (og + 1u == (tg + 1u) * nx) xb_add(&bar[XB_TOPGEN], 1u);
            else XB_SPIN(xb_ld(&bar[XB_TOPGEN]) == tg, bar);
            __builtin_amdgcn_fence(__ATOMIC_ACQUIRE, "agent");
            xb_add(&bar[XB_XGEN(b.x)], 1u);
            asm volatile("s_waitcnt vmcnt(0)" ::: "memory");
        } else {
            XB_SPIN(xb_ld(&bar[XB_XGEN(b.x)]) == gen, bar);
            __builtin_amdgcn_fence(__ATOMIC_ACQUIRE, "agent");
            asm volatile("s_waitcnt vmcnt(0)" ::: "memory");
        }
    }
    __syncthreads();
}

template <bool MASK, int NS>
__device__ __forceinline__ void attn_compute_t(const bf16_t* cK, const bf16_t* cV, const float* cC, const bf16x8 (&qf)[2], f32x4 (&oacc)[4], float& mrun, float& lrun,
                                               float ct2, float scale2, int key0, int tq, int lane, int g) {
    f32x4 sacc[4 * NS];
#pragma unroll
    for (int n = 0; n < 4 * NS; ++n) {
        sacc[n] = (f32x4){0.f, 0.f, 0.f, 0.f};
#pragma unroll
        for (int kk = 0; kk < 2; ++kk) sacc[n] = MFMA16(frag_rm(cK, TLD, n * 16, kk * 32, lane), qf[kk], sacc[n]);
    }
    float mx = -INFINITY;
#pragma unroll
    for (int n = 0; n < 4 * NS; ++n) {
        const f32x4 cs = *(const f32x4*)(cC + n * 16 + 4 * g);
#pragma unroll
        for (int r = 0; r < 4; ++r) {
            float v = sacc[n][r] * scale2 + (ct2 - cs[r]);
            if (MASK) { if (key0 + n * 16 + 4 * g + r > tq) v = -INFINITY; }
            sacc[n][r] = v; mx = fmaxf(mx, v);
        }
    }
    mx = fmaxf(mx, __shfl_xor(mx, 16)); mx = fmaxf(mx, __shfl_xor(mx, 32));
    const float mnew = fmaxf(mrun, mx);
    const float corr = __builtin_amdgcn_exp2f(mrun - mnew);
    float rs = 0.f;
#pragma unroll
    for (int n = 0; n < 4 * NS; ++n)
#pragma unroll
        for (int r = 0; r < 4; ++r) { const float p = __builtin_amdgcn_exp2f(sacc[n][r] - mnew); sacc[n][r] = p; rs += p; }
    rs += __shfl_xor(rs, 16); rs += __shfl_xor(rs, 32);
    lrun = lrun * corr + rs; mrun = mnew;
    bf16x8 pf[2 * NS];
#pragma unroll
    for (int kk = 0; kk < 2 * NS; ++kk) {
        const u32x4 pk = (u32x4){pk2(sacc[2 * kk][0], sacc[2 * kk][1]), pk2(sacc[2 * kk][2], sacc[2 * kk][3]), pk2(sacc[2 * kk + 1][0], sacc[2 * kk + 1][1]), pk2(sacc[2 * kk + 1][2], sacc[2 * kk + 1][3])};
        pf[kk] = __builtin_bit_cast(bf16x8, pk);
    }
#pragma unroll
    for (int n2 = 0; n2 < 4; ++n2) {
        oacc[n2] = oacc[n2] * corr;
#pragma unroll
        for (int kk = 0; kk < 2 * NS; ++kk) {
            const s16x4 lo = tr4(cV, TLD, (2 * kk) * 16 + 4 * g, n2 * 16, lane), hi = tr4(cV, TLD, (2 * kk + 1) * 16 + 4 * g, n2 * 16, lane);
            const bf16x8 vf = (bf16x8){lo[0], lo[1], lo[2], lo[3], hi[0], hi[1], hi[2], hi[3]};
            oacc[n2] = MFMA16(vf, pf[kk], oacc[n2]);
        }
    }
}
__device__ __forceinline__ void attn_compute(const bf16_t* cK, const bf16_t* cV, const float* cC, const bf16x8 (&qf)[2], f32x4 (&oacc)[4], float& mrun, float& lrun,
                                             float ct2, float scale2, int causal, int key0, int r0, int tq, int lane, int g) {
    if (!causal || key0 + 127 <= r0) { attn_compute_t<false, 2>(cK, cV, cC, qf, oacc, mrun, lrun, ct2, scale2, key0, tq, lane, g); return; }
    if (key0 > r0 + 15) return;
    if (key0 + 64 > r0 + 15) attn_compute_t<true, 1>(cK, cV, cC, qf, oacc, mrun, lrun, ct2, scale2, key0, tq, lane, g);
    else attn_compute_t<true, 2>(cK, cV, cC, qf, oacc, mrun, lrun, ct2, scale2, key0, tq, lane, g);
}

__device__ __forceinline__ void attn_task(char* smem, const bf16_t* __restrict__ Q, int ldq, const bf16_t* __restrict__ Kp, int ldk, const bf16_t* __restrict__ Vp, int ldv, const float* __restrict__ bias,
                                          int nq_per_b, int nk_per_b, int causal, float scale, bf16_t* __restrict__ O, int ldo, const float* __restrict__ gain, int rms, int task) {
    constexpr int KT = 128;
    bf16_t* sK = (bf16_t*)smem;
    bf16_t* sV = sK + 2 * KT * TLD;
    float* sC = (float*)(sV + 2 * KT * TLD);
    const int tid = TIDX, lane = tid & 63, wave = tid >> 6, g = lane >> 4, li = lane & 15;
    const int nqt = nq_per_b / 128;
    const int qt = task % nqt, h = (task / nqt) & 3, b = task / (nqt * 4);
    const int q0 = qt * 128, r0 = q0 + wave * 16, tq = r0 + li;
    const size_t qrow = (size_t)b * nq_per_b + tq;
    bf16x8 qf[2];
#pragma unroll
    for (int kk = 0; kk < 2; ++kk) qf[kk] = *(const bf16x8*)(Q + qrow * ldq + h * 64 + kk * 32 + g * 8);
    constexpr float LOG2E = 1.4426950408889634f;
    const float ct = bias ? bias[(size_t)(b * 4 + h) * nq_per_b + tq] * LOG2E : 0.f;
    const float scale2 = scale * LOG2E;
    const int nkt = causal ? (q0 + 128) / KT : nk_per_b / KT;
    const int sr = tid >> 3, sc = tid & 7;
    const bf16_t* kg = Kp + ((size_t)b * nk_per_b + sr) * ldk + h * 64 + sc * 8;
    const bf16_t* vg = Vp + ((size_t)b * nk_per_b + sr) * ldv + h * 64 + sc * 8;
    const float* cg_ = bias ? bias + (size_t)(b * 4 + h) * nk_per_b : nullptr;
    u32x4 rkA[2], rvA[2], rkB[2], rvB[2]; float rcA = 0.f, rcB = 0.f;
#define AT_LOAD(RK, RV, RC, kt) { _Pragma("unroll") for (int i = 0; i < 2; ++i) { RK[i] = *(const u32x4*)(kg + (size_t)((kt) * KT + i * 64) * ldk); RV[i] = *(const u32x4*)(vg + (size_t)((kt) * KT + i * 64) * ldv); } \
        RC = (cg_ && tid < KT) ? cg_[(kt) * KT + tid] * LOG2E : 0.f; }
#define AT_STORE(RK, RV, RC, buf) { _Pragma("unroll") for (int i = 0; i < 2; ++i) { *(u32x4*)(sK + ((buf) * KT + sr + i * 64) * TLD + sc * 8) = RK[i]; *(u32x4*)(sV + ((buf) * KT + sr + i * 64) * TLD + sc * 8) = RV[i]; } \
        if (tid < KT) sC[(buf) * KT + tid] = RC; }
#define AT_COMPUTE(buf, kt) attn_compute(sK + (buf) * KT * TLD, sV + (buf) * KT * TLD, sC + (buf) * KT, qf, oacc, mrun, lrun, ct, scale2, causal, (kt) * KT, r0, tq, lane, g)
    AT_LOAD(rkA, rvA, rcA, 0)
    if (nkt > 1) AT_LOAD(rkB, rvB, rcB, 1)
    __syncthreads();
    AT_STORE(rkA, rvA, rcA, 0)
    __syncthreads();
    f32x4 oacc[4];
#pragma unroll
    for (int n = 0; n < 4; ++n) oacc[n] = (f32x4){0.f, 0.f, 0.f, 0.f};
    float mrun = -INFINITY, lrun = 0.f;
    for (int kt = 0; kt < nkt; kt += 2) {
        if (kt + 2 < nkt) AT_LOAD(rkA, rvA, rcA, kt + 2)
        AT_COMPUTE(0, kt);
        if (kt + 1 < nkt) AT_STORE(rkB, rvB, rcB, 1)
        __syncthreads();
        if (kt + 1 < nkt) {
            if (kt + 3 < nkt) AT_LOAD(rkB, rvB, rcB, kt + 3)
            AT_COMPUTE(1, kt + 1);
            if (kt + 2 < nkt) AT_STORE(rkA, rvA, rcA, 0)
            __syncthreads();
        }
    }
#undef AT_LOAD
#undef AT_STORE
#undef AT_COMPUTE
    const float inv = 1.f / lrun;
    float ms = 0.f;
#pragma unroll
    for (int n = 0; n < 4; ++n) { oacc[n] = oacc[n] * inv; ms += oacc[n][0] * oacc[n][0] + oacc[n][1] * oacc[n][1] + oacc[n][2] * oacc[n][2] + oacc[n][3] * oacc[n][3]; }
    ms += __shfl_xor(ms, 16); ms += __shfl_xor(ms, 32);
    const float rinv = rms ? rsqrtf(ms * (1.f / 64.f) + EPS) : 1.f;
#pragma unroll
    for (int n = 0; n < 4; ++n) {
        const int d = n * 16 + 4 * g;
        f32x4 gg = (f32x4){1.f, 1.f, 1.f, 1.f};
        if (gain) gg = *(const f32x4*)(gain + h * 64 + d);
        uint2 o; o.x = pk2(oacc[n][0] * rinv * gg[0], oacc[n][1] * rinv * gg[1]); o.y = pk2(oacc[n][2] * rinv * gg[2], oacc[n][3] * rinv * gg[3]);
        *(uint2*)(O + qrow * ldo + h * 64 + d) = o;
    }
}


__device__ __forceinline__ void hgrn_scan(float* LF  , float* SEGT  , const bf16_t* __restrict__ prow  , const float* __restrict__ hgrn_lb, int layer, int h, float (&kk)[8]) {
    const int tid = TIDX, t = tid >> 3, k8 = (tid & 7) * 8;
    const u32x4 raw = *(const u32x4*)(prow + (size_t)t * NP + C_AF + k8);
#pragma unroll
    for (int j = 0; j < 8; ++j) {
        const float fl = __uint_as_float((j & 1) ? (raw[j >> 1] & 0xffff0000u) : (raw[j >> 1] << 16));
        float lbk = 0.f;
        if (layer == 1) { const float a0 = hgrn_lb[h * 64 + k8 + j], a1 = hgrn_lb[256 + h * 64 + k8 + j]; lbk = 1.f / (1.f + __expf(a0 - a1)); }
        const float sg = sigmoidf_(fl);
        const float f = lbk + (1.f - lbk) * sg;
        kk[j] = (1.f - lbk) * (1.f - sg);
        LF[t * 65 + k8 + j] = __logf(f);
    }
    __syncthreads();
    { const int k = tid & 63, seg = tid >> 6; float run = 0.f;
#pragma unroll
      for (int i = 0; i < 8; ++i) { run += LF[(seg * 8 + i) * 65 + k]; LF[(seg * 8 + i) * 65 + k] = run; }
      SEGT[seg * 64 + k] = run; }
    __syncthreads();
    { const int k = tid & 63, seg = tid >> 6; float off = 0.f;
      for (int s2 = 0; s2 < seg; ++s2) off += SEGT[s2 * 64 + k];
#pragma unroll
      for (int i = 0; i < 8; ++i) LF[(seg * 8 + i) * 65 + k] += off; }
    __syncthreads();
}
__device__ __forceinline__ float bfx(const u32x4& raw, int j) { return __uint_as_float((j & 1) ? (raw[j >> 1] & 0xffff0000u) : (raw[j >> 1] << 16)); }

__device__ __forceinline__ void hgrn_local_task(char* smem, const bf16_t* __restrict__ proj, const float* __restrict__ hgrn_lb, int layer, float* __restrict__ HL, float* __restrict__ HD, int ch) {
    float* LF = (float*)smem; float* SEGT = LF + 64 * 65;
    bf16_t* sKd = (bf16_t*)(SEGT + 8 * 64); bf16_t* sV = sKd + 64 * TLD;
    const int tid = TIDX, lane = tid & 63, wave = tid >> 6, g = lane >> 4, li = lane & 15;
    const int bh = ch >> 5, n = ch & 31, b = bh >> 2, h = bh & 3;
    const bf16_t* prow = proj + (size_t)(b * SEQ + n * 64) * NP + h * 64;
    const int t = tid >> 3, k8 = (tid & 7) * 8;
    __syncthreads();
    *(u32x4*)(sV + t * TLD + k8) = *(const u32x4*)(prow + (size_t)t * NP + C_AI + k8);
    float kk[8];
    hgrn_scan(LF, SEGT, prow, hgrn_lb, layer, h, kk);
    { u32x4 o;
#pragma unroll
      for (int j = 0; j < 8; j += 2) {
          const float e0 = kk[j] * __expf(LF[63 * 65 + k8 + j] - LF[t * 65 + k8 + j]), e1 = kk[j + 1] * __expf(LF[63 * 65 + k8 + j + 1] - LF[t * 65 + k8 + j + 1]);
          o[j >> 1] = pk2(e0, e1);
      }
      *(u32x4*)(sKd + t * TLD + k8) = o; }
    if (tid < 64) HD[(size_t)ch * 64 + tid] = __expf(LF[63 * 65 + tid]);
    __syncthreads();
#pragma unroll
    for (int i = 0; i < 2; ++i) {
        const int idx = wave * 2 + i, vt = idx >> 2, kt = idx & 3;
        f32x4 acc = (f32x4){0.f, 0.f, 0.f, 0.f};
#pragma unroll
        for (int ks = 0; ks < 2; ++ks) acc = MFMA16(frag_cm(sV, TLD, ks * 32, vt * 16, lane), frag_cm(sKd, TLD, ks * 32, kt * 16, lane), acc);
        *(f32x4*)(HL + (size_t)ch * 4096 + (kt * 16 + li) * 64 + vt * 16 + 4 * g) = acc;
    }
}

__device__ __forceinline__ void hgrn_out_task(char* smem, const bf16_t* __restrict__ proj, const float* __restrict__ hgrn_lb, int layer, const bf16_t* __restrict__ HS,
                                              const float* __restrict__ mix_gain, bf16_t* __restrict__ y, int ch) {
    float* LF = (float*)smem; float* SEGT = LF + 64 * 65; float* sMS = SEGT + 8 * 64;
    bf16_t* sST = (bf16_t*)(sMS + 128); bf16_t* sQ0 = sST + 64 * TLD; bf16_t* sQm = sQ0 + 64 * TLD; bf16_t* sKm = sQm + 64 * TLD; bf16_t* sV = sKm + 64 * TLD; bf16_t* sA = sV + 64 * TLD;
    const int tid = TIDX, lane = tid & 63, wave = tid >> 6, g = lane >> 4, li = lane & 15;
    const int bh = ch >> 5, n = ch & 31, b = bh >> 2, h = bh & 3;
    const bf16_t* prow = proj + (size_t)(b * SEQ + n * 64) * NP + h * 64;
    const int t = tid >> 3, k8 = (tid & 7) * 8;
    __syncthreads();
    *(u32x4*)(sST + t * TLD + k8) = *(const u32x4*)(HS + (size_t)ch * 4096 + t * 64 + k8);
    const u32x4 qraw = *(const u32x4*)(prow + (size_t)t * NP + C_AQ + k8);
    *(u32x4*)(sV + t * TLD + k8) = *(const u32x4*)(prow + (size_t)t * NP + C_AI + k8);
    float kk[8];
    hgrn_scan(LF, SEGT, prow, hgrn_lb, layer, h, kk);
    { u32x4 o0, om, ok;
#pragma unroll
      for (int j = 0; j < 8; j += 2) {
          float q0v[2], qmv[2], kmv[2];
#pragma unroll
          for (int e = 0; e < 2; ++e) {
              const float bt = LF[t * 65 + k8 + j + e], r = LF[31 * 65 + k8 + j + e], q = siluf_(bfx(qraw, j + e));
              q0v[e] = q * __expf(bt); qmv[e] = q * __expf(bt - r); kmv[e] = kk[j + e] * __expf(r - bt);
          }
          o0[j >> 1] = pk2(q0v[0], q0v[1]); om[j >> 1] = pk2(qmv[0], qmv[1]); ok[j >> 1] = pk2(kmv[0], kmv[1]);
      }
      *(u32x4*)(sQ0 + t * TLD + k8) = o0; *(u32x4*)(sQm + t * TLD + k8) = om; *(u32x4*)(sKm + t * TLD + k8) = ok; }
    __syncthreads();
#pragma unroll
    for (int i = 0; i < 2; ++i) {
        const int idx = wave * 2 + i, tt = idx >> 2, st = idx & 3;
        f32x4 acc = (f32x4){0.f, 0.f, 0.f, 0.f};
#pragma unroll
        for (int ks = 0; ks < 2; ++ks) acc = MFMA16(frag_rm(sKm, TLD, st * 16, ks * 32, lane), frag_rm(sQm, TLD, tt * 16, ks * 32, lane), acc);
        const int tq = tt * 16 + li, s0 = st * 16 + 4 * g;
        uint2 o; o.x = pk2(s0 <= tq ? acc[0] : 0.f, s0 + 1 <= tq ? acc[1] : 0.f); o.y = pk2(s0 + 2 <= tq ? acc[2] : 0.f, s0 + 3 <= tq ? acc[3] : 0.f);
        *(uint2*)(sA + tq * TLD + s0) = o;
    }
    __syncthreads();
    { const int tt = wave >> 1;
      f32x4 oacc[2]; float ms = 0.f;
#pragma unroll
      for (int i = 0; i < 2; ++i) {
          const int vt = (wave & 1) * 2 + i;
          f32x4 acc = (f32x4){0.f, 0.f, 0.f, 0.f};
#pragma unroll
          for (int ks = 0; ks < 2; ++ks) acc = MFMA16(frag_cm(sST, TLD, ks * 32, vt * 16, lane), frag_rm(sQ0, TLD, tt * 16, ks * 32, lane), acc);
#pragma unroll
          for (int ks = 0; ks < 2; ++ks) acc = MFMA16(frag_cm(sV, TLD, ks * 32, vt * 16, lane), frag_rm(sA, TLD, tt * 16, ks * 32, lane), acc);
          oacc[i] = acc; ms += acc[0] * acc[0] + acc[1] * acc[1] + acc[2] * acc[2] + acc[3] * acc[3];
      }
      ms += __shfl_xor(ms, 16); ms += __shfl_xor(ms, 32);
      if (g == 0) sMS[(tt * 16 + li) * 2 + (wave & 1)] = ms;
      __syncthreads();
      const int tq = tt * 16 + li;
      const float rinv = rsqrtf((sMS[tq * 2] + sMS[tq * 2 + 1]) * (1.f / 64.f) + EPS);
      const size_t row = (size_t)(b * SEQ + n * 64 + tq);
#pragma unroll
      for (int i = 0; i < 2; ++i) {
          const int v0 = ((wave & 1) * 2 + i) * 16 + 4 * g;
          const uint2 graw = *(const uint2*)(proj + row * NP + C_AG + h * 64 + v0);
          const f32x4 mgv = *(const f32x4*)(mix_gain + C_AQ + h * 64 + v0);
          const float g0 = __uint_as_float(graw.x << 16), g1 = __uint_as_float(graw.x & 0xffff0000u), g2 = __uint_as_float(graw.y << 16), g3 = __uint_as_float(graw.y & 0xffff0000u);
          uint2 o; o.x = pk2(oacc[i][0] * rinv * siluf_(g0) * mgv[0], oacc[i][1] * rinv * siluf_(g1) * mgv[1]);
          o.y = pk2(oacc[i][2] * rinv * siluf_(g2) * mgv[2], oacc[i][3] * rinv * siluf_(g3) * mgv[3]);
          *(uint2*)(y + row * 1024 + h * 64 + v0) = o;
      }
    }
}


constexpr int GP_BYTES = (128 + 64 * 132 + 64 * 68) * 4 + 2 * 64 * TLD * 2;
__device__ __forceinline__ void gdn_prep_pair(char* smem, const bf16_t* __restrict__ proj, const float* __restrict__ gates, const float* __restrict__ conv_w  ,
                                              const float* __restrict__ a_log, const float* __restrict__ dt_bias, bf16_t* __restrict__ gt_all, float* __restrict__ glast, int ch0) {
#define GP_SG(sub) ((float*)(smem + (sub) * GP_BYTES))
#define GP_SBETA(sub) (GP_SG(sub) + 64)
#define GP_RHS(sub) (GP_SG(sub) + 128)
#define GP_SM(sub) (GP_RHS(sub) + 64 * 132)
#define GP_SK(sub) ((bf16_t*)(GP_SM(sub) + 64 * 68))
#define GP_SQ(sub) (GP_SK(sub) + 64 * TLD)
    const int tid = TIDX, lane = tid & 63, wave = tid >> 6, g = lane >> 4, li = lane & 15;
    const int bh = ch0 >> 5, n0 = ch0 & 31, b = bh >> 2, h = bh & 3;
    const int t = tid >> 3, d8 = (tid & 7) * 8;
    __syncthreads();
    float qn[2][8], kn[2][8], vv[2][8];
#pragma unroll
    for (int sub = 0; sub < 2; ++sub) {
        const int n = n0 + sub; const size_t row0 = (size_t)(b * SEQ + n * 64);
        const int spos = n * 64 + t;
#pragma unroll
        for (int sec = 0; sec < 3; ++sec) {
            const int col = (sec == 0 ? C_DQ : (sec == 1 ? C_DK : C_DV)) + h * 64 + d8;
            float acc[8];
#pragma unroll
            for (int e = 0; e < 8; ++e) acc[e] = 0.f;
#pragma unroll
            for (int j = 0; j < 4; ++j) {
                if (spos - (3 - j) >= 0) {
                    const u32x4 raw = *(const u32x4*)(proj + (row0 + t - (3 - j)) * NP + col);
                    const f32x4 w0 = *(const f32x4*)(conv_w + j * 768 + sec * 256 + h * 64 + d8), w1 = *(const f32x4*)(conv_w + j * 768 + sec * 256 + h * 64 + d8 + 4);
#pragma unroll
                    for (int e = 0; e < 8; ++e) acc[e] += (e < 4 ? w0[e] : w1[e - 4]) * bfx(raw, e);
                }
            }
#pragma unroll
            for (int e = 0; e < 8; ++e) { const float sv = siluf_(acc[e]); if (sec == 0) qn[sub][e] = sv; else if (sec == 1) kn[sub][e] = sv; else vv[sub][e] = sv; }
        }
        float sq = 0.f, sk = 0.f;
#pragma unroll
        for (int e = 0; e < 8; ++e) { sq += qn[sub][e] * qn[sub][e]; sk += kn[sub][e] * kn[sub][e]; }
        sq += __shfl_xor(sq, 1); sq += __shfl_xor(sq, 2); sq += __shfl_xor(sq, 4);
        sk += __shfl_xor(sk, 1); sk += __shfl_xor(sk, 2); sk += __shfl_xor(sk, 4);
        const float rq = rsqrtf(sq + EPS) * 0.125f, rk = rsqrtf(sk + EPS);
#pragma unroll
        for (int e = 0; e < 8; ++e) { qn[sub][e] *= rq; kn[sub][e] *= rk; }
        if ((tid & 7) == 0) {
            const float* gr = gates + (row0 + t) * 16;
            GP_SBETA(sub)[t] = sigmoidf_(gr[4 + h]);
            GP_SG(sub)[t] = -__expf(a_log[h]) * softplusf_(gr[8 + h] + dt_bias[h]);
        }
    }
    __syncthreads();
    if (wave < 2) {
        float* sG = GP_SG(wave);
        float v = sG[lane];
#pragma unroll
        for (int o = 1; o < 64; o <<= 1) { const float nb = __shfl_up(v, o); if (lane >= o) v += nb; }
        sG[lane] = v;
    }
    __syncthreads();
#pragma unroll
    for (int sub = 0; sub < 2; ++sub) {
        const int ch = ch0 + sub; bf16_t* gt = gt_all + (size_t)ch * 5 * 4096;
        float* sG = GP_SG(sub); float* RHS = GP_RHS(sub);
        const float Gt = sG[t], Gl = sG[63], bt = GP_SBETA(sub)[t];
        const float eG = __expf(Gt), eD = __expf(Gl - Gt);
        u32x4 ok, oq, oqd, okd;
#pragma unroll
        for (int e = 0; e < 8; e += 2) {
            ok[e >> 1] = pk2(kn[sub][e], kn[sub][e + 1]); oq[e >> 1] = pk2(qn[sub][e], qn[sub][e + 1]);
            oqd[e >> 1] = pk2(qn[sub][e] * eG, qn[sub][e + 1] * eG); okd[e >> 1] = pk2(kn[sub][e] * eD, kn[sub][e + 1] * eD);
        }
        *(u32x4*)(GP_SK(sub) + t * TLD + d8) = ok; *(u32x4*)(GP_SQ(sub) + t * TLD + d8) = oq;
        *(u32x4*)(gt + 2 * 4096 + t * 64 + d8) = oqd; *(u32x4*)(gt + 3 * 4096 + t * 64 + d8) = okd;
#pragma unroll
        for (int e = 0; e < 8; ++e) { RHS[t * 132 + d8 + e] = vv[sub][e] * bt; RHS[t * 132 + 64 + d8 + e] = kn[sub][e] * bt * eG; }
        if (tid == 0) glast[ch] = __expf(Gl);
    }
    __syncthreads();
#pragma unroll
    for (int i = 0; i < 4; ++i) {
        const int idx = wave * 4 + i, sub = idx >> 4, tt = (idx >> 2) & 3, st = idx & 3;
        const bf16_t* sK = GP_SK(sub); const bf16_t* sQ = GP_SQ(sub); const float* sG = GP_SG(sub); const float* sBeta = GP_SBETA(sub); float* sM = GP_SM(sub);
        bf16_t* gt = gt_all + (size_t)(ch0 + sub) * 5 * 4096;
        f32x4 am = (f32x4){0.f, 0.f, 0.f, 0.f}, aq = (f32x4){0.f, 0.f, 0.f, 0.f};
#pragma unroll
        for (int ks = 0; ks < 2; ++ks) {
            const bf16x8 kfs = frag_rm(sK, TLD, st * 16, ks * 32, lane), kft = frag_rm(sK, TLD, tt * 16, ks * 32, lane);
            am = MFMA16(kft, kfs, am);
            aq = MFMA16(kfs, frag_rm(sQ, TLD, tt * 16, ks * 32, lane), aq);
        }
        {   const int sx = st * 16 + li, t0 = tt * 16 + 4 * g; const float Gs = sG[sx];
            f32x4 mo;
#pragma unroll
            for (int r = 0; r < 4; ++r) { const int tq = t0 + r; mo[r] = (sx < tq) ? sBeta[tq] * am[r] * __expf(sG[tq] - Gs) : 0.f; }
            *(f32x4*)(sM + sx * 68 + t0) = mo; }
        {   const int tq = tt * 16 + li, s0 = st * 16 + 4 * g; const float Gt = sG[tq];
            float ao[4];
#pragma unroll
            for (int r = 0; r < 4; ++r) { const int sx = s0 + r; ao[r] = (sx <= tq) ? aq[r] * __expf(Gt - sG[sx]) : 0.f; }
            uint2 o; o.x = pk2(ao[0], ao[1]); o.y = pk2(ao[2], ao[3]);
            *(uint2*)(gt + 4 * 4096 + tq * 64 + s0) = o; }
    }
    __syncthreads();
    if (tid < 256) {
        const int sub = tid >> 7, col = tid & 127;
        const float* RHS = GP_RHS(sub); const float* sM = GP_SM(sub);
        bf16_t* gt = gt_all + (size_t)(ch0 + sub) * 5 * 4096;
        float acc[64];
#pragma unroll
        for (int i = 0; i < 64; ++i) acc[i] = RHS[i * 132 + col];
#pragma unroll
        for (int half = 0; half < 2; ++half) {
            const int base = half * 32;
            if (half == 1) {
#pragma unroll
                for (int sx = 0; sx < 32; sx += 2) {
                    f32x4 r0[8], r1[8];
#pragma unroll
                    for (int c = 0; c < 8; ++c) { r0[c] = *(const f32x4*)(sM + sx * 68 + 32 + c * 4); r1[c] = *(const f32x4*)(sM + (sx + 1) * 68 + 32 + c * 4); }
                    const float x0 = acc[sx], x1 = acc[sx + 1];
#pragma unroll
                    for (int tq = 0; tq < 32; ++tq) { acc[32 + tq] -= r0[tq >> 2][tq & 3] * x0; acc[32 + tq] -= r1[tq >> 2][tq & 3] * x1; }
                }
            }
            f32x4 cur[8];
#pragma unroll
            for (int c = 0; c < 8; ++c) cur[c] = *(const f32x4*)(sM + base * 68 + base + c * 4);
#pragma unroll
            for (int sx = 0; sx < 31; ++sx) {
                f32x4 nxt[8];
#pragma unroll
                for (int c = (sx + 2) >> 2; c < 8; ++c) nxt[c] = *(const f32x4*)(sM + (base + sx + 1) * 68 + base + c * 4);
                const float xs = acc[base + sx];
#pragma unroll
                for (int tq = sx + 1; tq < 32; ++tq) acc[base + tq] -= cur[tq >> 2][tq & 3] * xs;
#pragma unroll
                for (int c = (sx + 2) >> 2; c < 8; ++c) cur[c] = nxt[c];
            }
        }
        if (col < 64) {
#pragma unroll
            for (int tt = 0; tt < 64; ++tt) gt[tt * 64 + col] = f2bf(acc[tt]);
        } else {
#pragma unroll
            for (int tt = 0; tt < 64; ++tt) gt[4096 + tt * 64 + (col - 64)] = f2bf(-acc[tt]);
        }
    }
#undef GP_SG
#undef GP_SBETA
#undef GP_RHS
#undef GP_SM
#undef GP_SK
#undef GP_SQ
}

__device__ __forceinline__ void gdn_scan_step(bf16_t* sT, bf16_t* sST, bf16_t* sVn, f32x4 (&sacc)[4], const uint2 (&zraw)[4], const float* __restrict__ glast, const float* __restrict__ mix_gain,
                                              bf16_t* __restrict__ y, int bh, int n, int tid) {
    const int lane = tid & 63, wave = tid >> 6, g = lane >> 4, li = lane & 15;
    const int b = bh >> 2, h = bh & 3;
    const int buf = n & 1;
        const bf16_t* cT = sT + buf * 5 * 64 * TLD;
        const bf16_t* sU = cT; const bf16_t* sWn = cT + 64 * TLD; const bf16_t* sQd = cT + 2 * 64 * TLD; const bf16_t* sKd = cT + 3 * 64 * TLD; const bf16_t* sAq = cT + 4 * 64 * TLD;
        const bf16_t* cST = sST + buf * 64 * TLD; bf16_t* nST = sST + (buf ^ 1) * 64 * TLD;
        const size_t rowz = (size_t)(b * SEQ + n * 64 + (wave & 3) * 16 + li);
#pragma unroll
        for (int i = 0; i < 2; ++i) {
            const int idx = wave * 2 + i, tt = idx >> 2, vt = idx & 3;
            const int tq = tt * 16 + li, v0 = vt * 16 + 4 * g;
            const uint2 uraw = *(const uint2*)(sU + tq * TLD + v0);
            f32x4 acc = (f32x4){__uint_as_float(uraw.x << 16), __uint_as_float(uraw.x & 0xffff0000u), __uint_as_float(uraw.y << 16), __uint_as_float(uraw.y & 0xffff0000u)};
#pragma unroll
            for (int ks = 0; ks < 2; ++ks) acc = MFMA16(frag_rm(cST, TLD, vt * 16, ks * 32, lane), frag_rm(sWn, TLD, tt * 16, ks * 32, lane), acc);
            uint2 o; o.x = pk2(acc[0], acc[1]); o.y = pk2(acc[2], acc[3]);
            *(uint2*)(sVn + tq * TLD + v0) = o;
        }
        __syncthreads();
        if (wave < 4) {
            const int tt = wave;
            f32x4 oacc[4]; float ms = 0.f;
#pragma unroll
            for (int vt = 0; vt < 4; ++vt) {
                f32x4 acc = (f32x4){0.f, 0.f, 0.f, 0.f};
#pragma unroll
                for (int ks = 0; ks < 2; ++ks) acc = MFMA16(frag_rm(cST, TLD, vt * 16, ks * 32, lane), frag_rm(sQd, TLD, tt * 16, ks * 32, lane), acc);
#pragma unroll
                for (int ks = 0; ks < 2; ++ks) acc = MFMA16(frag_cm(sVn, TLD, ks * 32, vt * 16, lane), frag_rm(sAq, TLD, tt * 16, ks * 32, lane), acc);
                oacc[vt] = acc; ms += acc[0] * acc[0] + acc[1] * acc[1] + acc[2] * acc[2] + acc[3] * acc[3];
            }
            ms += __shfl_xor(ms, 16); ms += __shfl_xor(ms, 32);
            const float rinv = rsqrtf(ms * (1.f / 64.f) + EPS);
#pragma unroll
            for (int vt = 0; vt < 4; ++vt) {
                const int v0 = vt * 16 + 4 * g;
                const f32x4 mgv = *(const f32x4*)(mix_gain + 768 + h * 64 + v0);
                const float z0 = __uint_as_float(zraw[vt].x << 16), z1 = __uint_as_float(zraw[vt].x & 0xffff0000u), z2 = __uint_as_float(zraw[vt].y << 16), z3 = __uint_as_float(zraw[vt].y & 0xffff0000u);
                uint2 o; o.x = pk2(oacc[vt][0] * rinv * siluf_(z0) * mgv[0], oacc[vt][1] * rinv * siluf_(z1) * mgv[1]);
                o.y = pk2(oacc[vt][2] * rinv * siluf_(z2) * mgv[2], oacc[vt][3] * rinv * siluf_(z3) * mgv[3]);
                *(uint2*)(y + rowz * 1024 + 768 + h * 64 + v0) = o;
            }
        } else {
            const int kt = wave - 4;
            const float gl = glast[bh * 32 + n];
#pragma unroll
            for (int vt = 0; vt < 4; ++vt) {
                f32x4 acc = sacc[vt] * gl;
#pragma unroll
                for (int ks = 0; ks < 2; ++ks) acc = MFMA16(frag_cm(sKd, TLD, ks * 32, kt * 16, lane), frag_cm(sVn, TLD, ks * 32, vt * 16, lane), acc);
                sacc[vt] = acc;
                uint2 o; o.x = pk2(acc[0], acc[1]); o.y = pk2(acc[2], acc[3]);
                *(uint2*)(nST + (vt * 16 + li) * TLD + kt * 16 + 4 * g) = o;
            }
        }
}

__device__ __forceinline__ void gdn_scan_task(char* smem, const bf16_t* __restrict__ gt_all, const float* __restrict__ glast, const bf16_t* __restrict__ proj, const float* __restrict__ mix_gain,
                                              bf16_t* __restrict__ y, int bh) {
    bf16_t* sT = (bf16_t*)smem;
    bf16_t* sST = sT + 2 * 5 * 64 * TLD;
    bf16_t* sVn = sST + 2 * 64 * TLD;
    const int tid = TIDX, lane = tid & 63, wave = tid >> 6, g = lane >> 4, li = lane & 15;
    const int b = bh >> 2, h = bh & 3;
    const int sr = tid >> 3, sc8 = (tid & 7) * 8;
    const bf16_t* gsrc = gt_all + (size_t)bh * 32 * 5 * 4096 + sr * 64 + sc8;
    __syncthreads();
    u32x4 rs0[5], rs1[5], rs2[5], rs3[5];
#define GS_LOAD(RS, n) { _Pragma("unroll") for (int i = 0; i < 5; ++i) RS[i] = *(const u32x4*)(gsrc + (size_t)(n) * 5 * 4096 + i * 4096); }
#define GS_STORE(RS, buf) { bf16_t* nT = sT + (buf) * 5 * 64 * TLD; _Pragma("unroll") for (int i = 0; i < 5; ++i) *(u32x4*)(nT + i * 64 * TLD + sr * TLD + sc8) = RS[i]; }
#define GS_ZLOAD(Z, n) { if (wave < 4) { const size_t rz = (size_t)(b * SEQ + (n) * 64 + (wave & 3) * 16 + li); _Pragma("unroll") for (int vt = 0; vt < 4; ++vt) Z[vt] = *(const uint2*)(proj + rz * NP + C_DZ + h * 64 + vt * 16 + 4 * g); } }
    GS_LOAD(rs0, 0) GS_LOAD(rs1, 1) GS_LOAD(rs2, 2) GS_LOAD(rs3, 3)
    uint2 zraw[4], znext[4];
    GS_ZLOAD(zraw, 0)
    GS_STORE(rs0, 0)
    *(u32x4*)(sST + sr * TLD + sc8) = (u32x4){0u, 0u, 0u, 0u};
    f32x4 sacc[4];
#pragma unroll
    for (int i = 0; i < 4; ++i) sacc[i] = (f32x4){0.f, 0.f, 0.f, 0.f};
    __syncthreads();
#define GS_STEP(n, LSET, SSET) { \
        if ((n) + 4 < 32) GS_LOAD(LSET, (n) + 4) \
        if ((n) + 1 < 32) GS_ZLOAD(znext, (n) + 1) \
        gdn_scan_step(sT, sST, sVn, sacc, zraw, glast, mix_gain, y, bh, (n), tid); \
        if ((n) + 1 < 32) GS_STORE(SSET, ((n) + 1) & 1) \
        _Pragma("unroll") for (int vt = 0; vt < 4; ++vt) zraw[vt] = znext[vt]; \
        __syncthreads(); }
    for (int n = 0; n < 32; n += 4) {
        GS_STEP(n, rs0, rs1)
        GS_STEP(n + 1, rs1, rs2)
        GS_STEP(n + 2, rs2, rs3)
        GS_STEP(n + 3, rs3, rs0)
    }
#undef GS_LOAD
#undef GS_STORE
#undef GS_ZLOAD
#undef GS_STEP
}


constexpr int XLD = 264;
__device__ __forceinline__ void lru_local_task(char* smem, const bf16_t* __restrict__ proj, const float* __restrict__ conv_w, const float* __restrict__ conv_b,
                                               const float* __restrict__ w_a, const float* __restrict__ b_a, const float* __restrict__ w_x, const float* __restrict__ b_x,
                                               const float* __restrict__ lam, float* __restrict__ hl_out, float* __restrict__ ac_out, float* __restrict__ lsum, int task) {
    bf16_t* sX = (bf16_t*)smem;
    bf16_t* sW = sX + 64 * XLD;
    const int tid = TIDX, lane = tid & 63, wave = tid >> 6, g = lane >> 4, li = lane & 15;
    const int b = task >> 5, n = task & 31;
    const size_t row0 = (size_t)(b * SEQ + n * 64);
    const int t = tid >> 3;
    __syncthreads();
    {
        const int i = tid >> 3, j8 = (tid & 7) * 8;
#pragma unroll
        for (int mat = 0; mat < 8; ++mat) {
            const float* src = ((mat & 1) ? w_x : w_a) + (size_t)(mat >> 1) * 4096 + i * 64 + j8;
            const f32x4 v0 = *(const f32x4*)src, v1 = *(const f32x4*)(src + 4);
            u32x4 o; o[0] = pk2(v0[0], v0[1]); o[1] = pk2(v0[2], v0[3]); o[2] = pk2(v1[0], v1[1]); o[3] = pk2(v1[2], v1[3]);
            *(u32x4*)(sW + mat * 64 * TLD + i * TLD + j8) = o;
        }
    }
    {
        const int spos = n * 64 + t;
#pragma unroll
        for (int i = 0; i < 4; ++i) {
            const int c8 = ((tid & 7) + 8 * i) * 8;
            float acc[8];
            { const f32x4 cb0 = *(const f32x4*)(conv_b + c8), cb1 = *(const f32x4*)(conv_b + c8 + 4);
#pragma unroll
              for (int e = 0; e < 8; ++e) acc[e] = e < 4 ? cb0[e] : cb1[e - 4]; }
#pragma unroll
            for (int j = 0; j < 4; ++j) {
                if (spos - (3 - j) >= 0) {
                    const u32x4 raw = *(const u32x4*)(proj + (row0 + t - (3 - j)) * NP + C_CX + c8);
                    const f32x4 w0 = *(const f32x4*)(conv_w + j * 256 + c8), w1 = *(const f32x4*)(conv_w + j * 256 + c8 + 4);
#pragma unroll
                    for (int e = 0; e < 8; ++e) acc[e] += (e < 4 ? w0[e] : w1[e - 4]) * bfx(raw, e);
                }
            }
            u32x4 o; o[0] = pk2(acc[0], acc[1]); o[1] = pk2(acc[2], acc[3]); o[2] = pk2(acc[4], acc[5]); o[3] = pk2(acc[6], acc[7]);
            *(u32x4*)(sX + t * XLD + c8) = o;
        }
    }
    __syncthreads();
    const int hh = wave >> 1;
#pragma unroll
    for (int j2 = 0; j2 < 2; ++j2) {
        const int jt = (wave & 1) * 2 + j2, cl = jt * 16 + 4 * g, c = hh * 64 + cl;
        f32x4 ra[4], rx[4];
#pragma unroll
        for (int tt = 0; tt < 4; ++tt) { ra[tt] = (f32x4){0.f, 0.f, 0.f, 0.f}; rx[tt] = (f32x4){0.f, 0.f, 0.f, 0.f}; }
#pragma unroll
        for (int ks = 0; ks < 2; ++ks) {
            const bf16x8 wa = frag_cm(sW + (hh * 2) * 64 * TLD, TLD, ks * 32, jt * 16, lane), wx = frag_cm(sW + (hh * 2 + 1) * 64 * TLD, TLD, ks * 32, jt * 16, lane);
#pragma unroll
            for (int tt = 0; tt < 4; ++tt) {
                const bf16x8 xf = frag_rm(sX + hh * 64, XLD, tt * 16, ks * 32, lane);
                ra[tt] = MFMA16(wa, xf, ra[tt]);
                rx[tt] = MFMA16(wx, xf, rx[tt]);
            }
        }
        const f32x4 ba = *(const f32x4*)(b_a + c), bx = *(const f32x4*)(b_x + c), lm = *(const f32x4*)(lam + c);
        float sp[4];
#pragma unroll
        for (int r = 0; r < 4; ++r) sp[r] = softplusf_(-lm[r]);
        f32x4 cA = (f32x4){1.f, 1.f, 1.f, 1.f}, cH = (f32x4){0.f, 0.f, 0.f, 0.f};
#pragma unroll
        for (int tt = 0; tt < 4; ++tt) {
            const int tq = tt * 16 + li;
            const uint2 xraw = *(const uint2*)(sX + tq * XLD + c);
            const float xc[4] = {__uint_as_float(xraw.x << 16), __uint_as_float(xraw.x & 0xffff0000u), __uint_as_float(xraw.y << 16), __uint_as_float(xraw.y & 0xffff0000u)};
            f32x4 A, H;
#pragma unroll
            for (int r = 0; r < 4; ++r) {
                const float rr = sigmoidf_(ra[tt][r] + ba[r]), ig = sigmoidf_(rx[tt][r] + bx[r]);
                const float log_a = -8.f * rr * sp[r];
                A[r] = __expf(log_a);
                H[r] = sqrtf(-expm1f(2.f * log_a)) * (ig * xc[r]);
            }
#pragma unroll
            for (int o = 1; o < 16; o <<= 1) {
#pragma unroll
                for (int r = 0; r < 4; ++r) {
                    const float pA = __shfl_up(A[r], o, 16), pH = __shfl_up(H[r], o, 16);
                    if (li >= o) { H[r] = A[r] * pH + H[r]; A[r] = A[r] * pA; }
                }
            }
            const f32x4 Hf = H + A * cH, Af = A * cA;
            const size_t oidx = (row0 + tq) * 256 + c;
            *(f32x4*)(hl_out + oidx) = Hf; *(f32x4*)(ac_out + oidx) = Af;
#pragma unroll
            for (int r = 0; r < 4; ++r) { cH[r] = __shfl(Hf[r], 15, 16); cA[r] = __shfl(Af[r], 15, 16); }
            if (tt == 3 && li == 15) { *(f32x4*)(lsum + (size_t)task * 256 + c) = Af; *(f32x4*)(lsum + (size_t)(256 + task) * 256 + c) = Hf; }
        }
    }
}
__device__ __forceinline__ void lru_out_task(const float* __restrict__ hl_in, const float* __restrict__ ac_in, const float* __restrict__ lsum, const bf16_t* __restrict__ proj,
                                             const float* __restrict__ mix_gain, bf16_t* __restrict__ y, int task) {
    const int b = task >> 5, n = task & 31, c = TIDX & 255, half = TIDX >> 8;
    const float Hc = lsum[(size_t)task * 256 + c];
    const float mg = mix_gain[512 + c];
    const size_t row0 = (size_t)(b * SEQ + n * 64 + half * 32);
#pragma unroll
    for (int i0 = 0; i0 < 32; i0 += 16) {
        float hv[16], av[16]; bf16_t gv[16];
#pragma unroll
        for (int i = 0; i < 16; ++i) { const size_t row = row0 + i0 + i; hv[i] = hl_in[row * 256 + c]; av[i] = ac_in[row * 256 + c]; gv[i] = proj[row * NP + C_CG + c]; }
#pragma unroll
        for (int i = 0; i < 16; ++i) {
            const size_t row = row0 + i0 + i;
            const float yv = (hv[i] + av[i] * Hc) * geluf_(bf2f(gv[i]));
            const float ms = wave_sum(yv * yv) * (1.f / 64.f);
            y[row * 1024 + 512 + c] = f2bf(yv * rsqrtf(ms + EPS) * mg);
        }
    }
}


__device__ __forceinline__ void state_scan_phase(const float* __restrict__ HL, const float* __restrict__ HD, bf16_t* __restrict__ HS, const float* __restrict__ lsum, float* __restrict__ lcar) {
    const int bx = blockIdx.x, tid = TIDX;
    for (int u = bx; u < 128 + 4; u += gridDim.x) {
        if (u < 128) {
            const int gid = u * NTHR + tid, bh = gid >> 11, v = gid & 63, kp = (gid >> 6) & 31;
            const float* Lb = HL + (size_t)bh * 32 * 4096 + (2 * kp) * 64 + v; const float* Db = HD + (size_t)bh * 32 * 64 + 2 * kp;
            bf16_t* Sb = HS + (size_t)bh * 32 * 4096 + (2 * kp) * 64 + v;
            float S0 = 0.f, S1 = 0.f;
            for (int n0 = 0; n0 < 32; n0 += 8) {
                float l0[8], l1[8], d0[8], d1[8];
#pragma unroll
                for (int i = 0; i < 8; ++i) { l0[i] = Lb[(size_t)(n0 + i) * 4096]; l1[i] = Lb[(size_t)(n0 + i) * 4096 + 64]; d0[i] = Db[(n0 + i) * 64]; d1[i] = Db[(n0 + i) * 64 + 1]; }
#pragma unroll
                for (int i = 0; i < 8; ++i) {
                    Sb[(size_t)(n0 + i) * 4096] = f2bf(S0); Sb[(size_t)(n0 + i) * 4096 + 64] = f2bf(S1);
                    S0 = d0[i] * S0 + l0[i]; S1 = d1[i] * S1 + l1[i];
                }
            }
        } else {
            const int gid = (u - 128) * NTHR + tid, b = gid >> 8, c = gid & 255;
            float A[32], H[32];
#pragma unroll
            for (int n = 0; n < 32; ++n) { A[n] = lsum[(size_t)(b * 32 + n) * 256 + c]; H[n] = lsum[(size_t)(256 + b * 32 + n) * 256 + c]; }
            float Hc = 0.f;
#pragma unroll
            for (int n = 0; n < 32; ++n) { lcar[(size_t)(b * 32 + n) * 256 + c] = Hc; Hc = A[n] * Hc + H[n]; }
        }
    }
}

__device__ __forceinline__ void router_phase(char* smem, const float* __restrict__ x, const float* __restrict__ g, const bf16_t* __restrict__ wr  , const float* __restrict__ b_rg,
                                             const float* __restrict__ b_re, const float* __restrict__ pss, int* __restrict__ cnt, int* __restrict__ list, float* __restrict__ pgate) {
    bf16_t* sXh = (bf16_t*)smem;
    bf16_t* sXl = sXh + 64 * TLD;
    float* sLog = (float*)(sXl + 64 * TLD);
    const int tid = TIDX, lane = tid & 63, wave = tid >> 6, gq = lane >> 4, li = lane & 15;
    const int mt = wave & 3, kh = wave >> 2;
    const int stok = tid >> 3, c8 = (tid & 7) * 8;
    BLK_LOOP(tile, T / 64) {
        const int t0 = tile * 64;
        f32x4 acc[3];
#pragma unroll
        for (int n = 0; n < 3; ++n) acc[n] = (f32x4){0.f, 0.f, 0.f, 0.f};
        const float* xp = x + (size_t)(t0 + stok) * 1024 + c8;
        const bf16_t* wp = wr + (size_t)li * 1024 + kh * 32 + gq * 8;
        f32x4 x0 = *(const f32x4*)xp, x1 = *(const f32x4*)(xp + 4);
        u32x4 wh[3], wl[3];
#pragma unroll
        for (int n = 0; n < 3; ++n) { wh[n] = *(const u32x4*)(wp + n * 16 * 1024); wl[n] = *(const u32x4*)(wp + 48 * 1024 + n * 16 * 1024); }
        for (int kc = 0; kc < 16; ++kc) {
            const f32x4 g0 = *(const f32x4*)(g + kc * 64 + c8), g1 = *(const f32x4*)(g + kc * 64 + c8 + 4);
            const f32x4 v0 = x0 * g0, v1 = x1 * g1;
            u32x4 oh, ol;
#pragma unroll
            for (int j = 0; j < 2; ++j) {
                const unsigned h0 = pk2(v0[2 * j], v0[2 * j + 1]), h1 = pk2(v1[2 * j], v1[2 * j + 1]);
                oh[j] = h0; oh[2 + j] = h1;
                ol[j] = pk2(v0[2 * j] - __uint_as_float(h0 << 16), v0[2 * j + 1] - __uint_as_float(h0 & 0xffff0000u));
                ol[2 + j] = pk2(v1[2 * j] - __uint_as_float(h1 << 16), v1[2 * j + 1] - __uint_as_float(h1 & 0xffff0000u));
            }
            __syncthreads();
            *(u32x4*)(sXh + stok * TLD + c8) = oh; *(u32x4*)(sXl + stok * TLD + c8) = ol;
            __syncthreads();
            u32x4 cwh[3], cwl[3];
#pragma unroll
            for (int n = 0; n < 3; ++n) { cwh[n] = wh[n]; cwl[n] = wl[n]; }
            if (kc + 1 < 16) {
                x0 = *(const f32x4*)(xp + (kc + 1) * 64); x1 = *(const f32x4*)(xp + (kc + 1) * 64 + 4);
#pragma unroll
                for (int n = 0; n < 3; ++n) { wh[n] = *(const u32x4*)(wp + n * 16 * 1024 + (kc + 1) * 64); wl[n] = *(const u32x4*)(wp + 48 * 1024 + n * 16 * 1024 + (kc + 1) * 64); }
            }
            const bf16x8 xh = frag_rm(sXh, TLD, mt * 16, kh * 32, lane), xl = frag_rm(sXl, TLD, mt * 16, kh * 32, lane);
#pragma unroll
            for (int n = 0; n < 3; ++n) {
                const bf16x8 fh = __builtin_bit_cast(bf16x8, cwh[n]), fl = __builtin_bit_cast(bf16x8, cwl[n]);
                acc[n] = MFMA16(fh, xh, acc[n]);
                acc[n] = MFMA16(fl, xh, acc[n]);
                acc[n] = MFMA16(fh, xl, acc[n]);
            }
        }
#pragma unroll
        for (int n = 0; n < 3; ++n) *(f32x4*)(sLog + (kh * 64 + mt * 16 + li) * 48 + n * 16 + 4 * gq) = acc[n];
        __syncthreads();
        int* sCnt = (int*)(sLog + 2 * 64 * 48);
        if (tid < 64) sCnt[tid] = 0;
        __syncthreads();
        int ex0 = 0, ex1 = 0, lr0 = 0, lr1 = 0; float gw0 = 0.f, gw1 = 0.f;
        if (tid < 64) {
            const float rinv = rinv_from_pss(pss, (size_t)(t0 + tid));
            const float* l0 = sLog + tid * 48; const float* l1 = sLog + (64 + tid) * 48;
            float lg[4];
#pragma unroll
            for (int i = 0; i < 4; ++i) lg[i] = (l0[i] + l1[i]) * rinv + b_rg[i];
            int gs = 0; float gm = lg[0];
#pragma unroll
            for (int i = 1; i < 4; ++i) if (lg[i] > gm) { gm = lg[i]; gs = i; }
            float den = 0.f;
#pragma unroll
            for (int i = 0; i < 4; ++i) den += __expf(lg[i] - gm);
            const float pg = 1.f / den;
            int i0 = 0, i1 = -1; float m0 = -INFINITY, m1 = -INFINITY;
            for (int i = 0; i < 8; ++i) {
                const float v = (l0[4 + gs * 8 + i] + l1[4 + gs * 8 + i]) * rinv + b_re[gs * 8 + i];
                if (v > m0) { m1 = m0; i1 = i0; m0 = v; i0 = i; } else if (v > m1) { m1 = v; i1 = i; }
            }
            const float e1 = __expf(m1 - m0);
            gw0 = pg / (1.f + e1); gw1 = pg * e1 / (1.f + e1);
            ex0 = gs * 8 + i0; ex1 = gs * 8 + i1;
            lr0 = atomicAdd(&sCnt[ex0], 1); lr1 = atomicAdd(&sCnt[ex1], 1);
        }
        __syncthreads();
        if (tid < 32) { const int c = sCnt[tid]; sCnt[32 + tid] = c ? atomicAdd(&cnt[tid * CNT_STRIDE], c) : 0; }
        __syncthreads();
        if (tid < 64) {
            const int t = t0 + tid;
            list[(size_t)ex0 * T + sCnt[32 + ex0] + lr0] = 2 * t; pgate[2 * t] = gw0;
            list[(size_t)ex1 * T + sCnt[32 + ex1] + lr1] = 2 * t + 1; pgate[2 * t + 1] = gw1;
        }
        __syncthreads();
    }
}

__device__ __forceinline__ void combine_phase(const float* x2, const bf16_t* __restrict__ eo, const float* __restrict__ g, float* xout, bf16_t* __restrict__ hn, int mode) {
    const int lane = TIDX & 63;
    for (int t = blockIdx.x * 8 + (TIDX >> 6); t < T; t += gridDim.x * 8) {
        f32x4 v[4]; float s = 0.f;
#pragma unroll
        for (int j = 0; j < 4; ++j) {
            const int c = (lane + 64 * j) * 4;
            v[j] = *(const f32x4*)(x2 + (size_t)t * 1024 + c);
            const uint2 e0 = *(const uint2*)(eo + (size_t)(2 * t) * 1024 + c), e1 = *(const uint2*)(eo + (size_t)(2 * t + 1) * 1024 + c);
            v[j].x += __uint_as_float(e0.x << 16) + __uint_as_float(e1.x << 16);
            v[j].y += __uint_as_float(e0.x & 0xffff0000u) + __uint_as_float(e1.x & 0xffff0000u);
            v[j].z += __uint_as_float(e0.y << 16) + __uint_as_float(e1.y << 16);
            v[j].w += __uint_as_float(e0.y & 0xffff0000u) + __uint_as_float(e1.y & 0xffff0000u);
            s += v[j].x * v[j].x + v[j].y * v[j].y + v[j].z * v[j].z + v[j].w * v[j].w;
        }
        const float rinv = rsqrtf(wave_sum(s) * (1.f / 1024.f) + EPS);
#pragma unroll
        for (int j = 0; j < 4; ++j) {
            const int c = (lane + 64 * j) * 4;
            const f32x4 gg = *(const f32x4*)(g + c);
            const f32x4 hv = v[j] * rinv * gg;
            if (mode == 0) {
                *(f32x4*)(xout + (size_t)t * 1024 + c) = v[j];
                uint2 o; o.x = pk2(hv.x, hv.y); o.y = pk2(hv.z, hv.w);
                *(uint2*)(hn + (size_t)t * 1024 + c) = o;
            } else {
                *(f32x4*)(xout + (size_t)t * 1024 + c) = hv;
            }
        }
    }
}

template <int l>
__device__ __forceinline__ void layer_body(const Params& P, char* smem, const XcdBarrier& xb, const float* xcur) {
    char* ws = P.ws;
    bf16_t* Wt_in = (bf16_t*)(ws + OFF_WIN); bf16_t* Wt_out = (bf16_t*)(ws + OFF_WOUT); bf16_t* Wt_mq = (bf16_t*)(ws + OFF_WMQ); bf16_t* Wt_mkv = (bf16_t*)(ws + OFF_WMKV);
    bf16_t* Wt_mo = (bf16_t*)(ws + OFF_WMO); bf16_t* Wt_gu = (bf16_t*)(ws + OFF_WGU); bf16_t* Wt_dn = (bf16_t*)(ws + OFF_WDN);
    bf16_t* hn = (bf16_t*)(ws + OFF_HN); bf16_t* proj = (bf16_t*)(ws + OFF_PROJ); float* gates = (float*)(ws + OFF_GATES); bf16_t* y = (bf16_t*)(ws + OFF_Y);
    float* XA = P.out; float* XB = (float*)(ws + OFF_XB);
    bf16_t* qm = (bf16_t*)(ws + OFF_QM); bf16_t* om = (bf16_t*)(ws + OFF_OM); bf16_t* kvm = (bf16_t*)(ws + OFF_KVM); bf16_t* memn = (bf16_t*)(ws + OFF_MEMN);
    float* foxc = (float*)(ws + OFF_FOXC); float* lrua = (float*)(ws + OFF_LRUA); float* lruu = (float*)(ws + OFF_LRUU);
    int* cnt_all = (int*)(ws + OFF_CTL) + CTL_CNT_WORD; int* list = (int*)(ws + OFF_LIST); float* pgate = (float*)(ws + OFF_PGATE);
    bf16_t* act = (bf16_t*)(ws + OFF_ACT); bf16_t* eo = (bf16_t*)(ws + OFF_EO); float* pss = (float*)(ws + OFF_PSS);
    const int wave = TIDX >> 6, lane = TIDX & 63;


        float* x1 = (l == 0) ? XA : XB;
        float* x2 = (l == 0) ? XB : XA;
        int* cnt = cnt_all + 32 * CNT_STRIDE * l;
        const float* mg = P.in[I_MIX_GAIN] + l * 1024;
        REP(2, { pg8::Gemm g{hn, Wt_in + (size_t)l * NP * 1024, T, NP, 1024}; pg8::StaticOrder S; S.init(T, NP, (int)gridDim.x, (int)blockIdx.x);
                 pg8::EpiInProj E{proj, NP, gates, C_GATE};
                 pg8::gemm_phase<pg8::EpiInProj, pg8::StaticOrder, true, true>((PG8_LAS unsigned char*)smem, g, S, E); });
        if (l == 0) for (int l2 = 0; l2 < NL; ++l2)
            gemm_phase<EPI_BF16>(smem, memn + (size_t)l2 * 2048 * 1024, 1024, Wt_mkv + (size_t)l2 * 512 * 1024, 1024, 2048, 512, 1024, kvm + (size_t)l2 * 2048 * 512, 512, nullptr, nullptr,
                                 (gridDim.x >= 192) ? ((int)blockIdx.x - 128 - 32 * l2) : (int)blockIdx.x, (gridDim.x >= 192) ? 4096 : (int)gridDim.x);
        GSYNC();
        REP(4,         {
            const int bx = blockIdx.x;
            bf16_t* gtiles = (bf16_t*)(ws + OFF_GDN); float* glast = (float*)(ws + OFF_GLAST);
            if (bx < 32 && wave == 1) fox_cumsum(gates, P.in[I_FOX_FB] + l * 4, foxc, bx, lane);
            BLK_LOOP(cp, 512) gdn_prep_pair(smem, proj, gates, P.in[I_GDN_CONV_W] + l * 4 * 768, P.in[I_GDN_A_LOG] + l * 4, P.in[I_GDN_DT_BIAS] + l * 4, gtiles, glast, 2 * cp);
            BLK_LOOP(ch, 1024) hgrn_local_task(smem, proj, P.in[I_HGRN_LB], l, (float*)(ws + OFF_HL), (float*)(ws + OFF_HD), ch);
            BLK_LOOP(task, 256) lru_local_task(smem, proj, P.in[I_LRU_CONV_W] + l * 1024, P.in[I_LRU_CONV_B] + l * 256, P.in[I_LRU_WA] + l * 16384, P.in[I_LRU_BA] + l * 256,
                                               P.in[I_LRU_WX] + l * 16384, P.in[I_LRU_BX] + l * 256, P.in[I_LRU_LAM] + l * 256, lrua, lruu, (float*)(ws + OFF_LSUM), task);
        });
        GSYNC();
        state_scan_phase((const float*)(ws + OFF_HL), (const float*)(ws + OFF_HD), (bf16_t*)(ws + OFF_HS), (const float*)(ws + OFF_LSUM), (float*)(ws + OFF_LCAR));
        GSYNC();
        REP(8,         {
            const int natt = (SEQ / 128) * 4 * NB;
            const int bx = blockIdx.x, nfree = (int)gridDim.x - 32;
            if (bx < 32) gdn_scan_task(smem, (const bf16_t*)(ws + OFF_GDN), (const float*)(ws + OFF_GLAST), proj, mg, y, bx);
            else {
                for (int r = 0; r * nfree < natt; ++r) {
                    const int i = r * nfree + ((r & 1) ? (nfree - 1 - (bx - 32)) : (bx - 32));
                    if (i >= natt) continue;
                    const int qt = 15 - (i >> 5), bh = i & 31;
                    attn_task(smem, proj + C_BQ, NP, proj + C_BK, NP, proj + C_BV, NP, foxc, SEQ, SEQ, 1, 0.125f, y + 256, 1024, mg + 256, 1, (bh * 16) + qt);
                }
                for (int i = bx - 32; i < 1024; i += nfree) {
                    const int ch = (i & 31) * 32 + (31 - (i >> 5));
                    hgrn_out_task(smem, proj, P.in[I_HGRN_LB], l, (const bf16_t*)(ws + OFF_HS), mg, y, ch);
                }
                for (int i = bx - 32; i < 256; i += nfree) lru_out_task(lrua, lruu, (const float*)(ws + OFF_LCAR), proj, mg, y, i);
            }
        });
        GSYNC();
        REP(16, { pg8::Gemm g{y, Wt_out + (size_t)l * 1024 * 1024, T, 1024, 1024}; pg8::StaticOrder S; S.init(T, 1024, (int)gridDim.x, (int)blockIdx.x);
                  pg8::EpiResidNorm E{xcur, x1, 1024, P.in[I_NORM_MEM] + l * 1024, hn, pss};
                  pg8::gemm_phase<pg8::EpiResidNorm, pg8::StaticOrder, true, true>((PG8_LAS unsigned char*)smem, g, S, E); });
        GSYNC();
        REP(64, gemm_phase<EPI_BF16_RS>(smem, hn, 1024, Wt_mq + (size_t)l * 256 * 1024, 1024, T, 256, 1024, qm, 256, pss, nullptr));
        GSYNC();
        { const bf16_t* kv = kvm + (size_t)l * 2048 * 512;
          REP(128, BLK_LOOP(task, (SEQ / 128) * 4 * NB) attn_task(smem, qm, 256, kv, 512, kv + 256, 512, nullptr, SEQ, MEMLEN, 0, 0.125f, om, 256, nullptr, 0, task)); }
        GSYNC();
        REP(256, gemm_phase<EPI_RESID_NORM>(smem, om, 256, Wt_mo + (size_t)l * 1024 * 256, 256, T, 1024, 256, x2, 1024, x1, pss, -1, 0, hn, P.in[I_NORM_FFN] + l * 1024));
        GSYNC();
        router_phase(smem, x2, P.in[I_NORM_FFN] + l * 1024, (const bf16_t*)(ws + OFF_WR) + (size_t)l * 2 * 48 * 1024, P.in[I_B_RG] + l * 4, P.in[I_B_RE] + l * 32, pss, cnt, list, pgate);
        GSYNC();
        REP(512, moe_phase<1>(smem, hn, 1024, Wt_gu + (size_t)l * 32 * 512 * 1024, (size_t)512 * 1024, 1024, 1024, cnt, list, pgate, act, pss));
        GSYNC();
        REP(1024, moe_phase<2>(smem, act, 256, Wt_dn + (size_t)l * 32 * 1024 * 256, (size_t)1024 * 256, 256, 256, cnt, list, pgate, eo, pss));
        if (PROBE_MASK & 2048) { for (int i = 0; i < 10; ++i) GSYNC(); }
        GSYNC();
        if (l == 0) { combine_phase(x2, eo, P.in[I_NORM_MIX] + 1024, XA, hn, 0); GSYNC(); }
        else combine_phase(x2, eo, P.in[I_NORM_FINAL], P.out, hn, 1);
}
__global__ void __launch_bounds__(NTHR, 2) mega_kernel(Params P) {
    extern __shared__ __attribute__((aligned(16))) char smem[];
    volatile LDS_AS unsigned* st = (volatile LDS_AS unsigned*)(smem + LDS_BYTES - 16);
    if (TIDX < 4) st[TIDX] = 0u;
    __syncthreads();
    const XcdBarrier xb = xcd_barrier_post((unsigned*)(P.ws + OFF_CTL), st);
    phase0(P, smem);
    GSYNC();
    layer_body<0>(P, smem, xb, P.in[I_X]);
    layer_body<1>(P, smem, xb, P.out);
}

extern "C" void kernel_launch(void* const* d_in, const int* in_sizes, int n_in, void* d_out, int out_size, void* d_ws, size_t ws_size, hipStream_t stream) {
    static int grid_blocks = 0;
    if (grid_blocks == 0) {
        if (n_in != N_INPUTS || ws_size < OFF_END || out_size != T * 1024) { fprintf(stderr, "kernel_launch: unexpected sizes n_in=%d ws=%zu out=%d (need ws >= %zu)\n", n_in, ws_size, out_size, (size_t)OFF_END); grid_blocks = -1; return; }
        int dev = 0, cus = 0, per_cu = 0;
        if (hipGetDevice(&dev) != hipSuccess || hipDeviceGetAttribute(&cus, hipDeviceAttributeMultiprocessorCount, dev) != hipSuccess) { fprintf(stderr, "kernel_launch: device query failed\n"); grid_blocks = -1; return; }
        if (hipFuncSetAttribute((const void*)mega_kernel, hipFuncAttributeMaxDynamicSharedMemorySize, LDS_BYTES) != hipSuccess) { fprintf(stderr, "kernel_launch: hipFuncSetAttribute failed\n"); grid_blocks = -1; return; }
        if (hipOccupancyMaxActiveBlocksPerMultiprocessor(&per_cu, (const void*)mega_kernel, NTHR, LDS_BYTES) != hipSuccess || per_cu < 1) { fprintf(stderr, "kernel_launch: occupancy query says %d blocks/CU\n", per_cu); grid_blocks = -1; return; }
        grid_blocks = cus;
        fprintf(stderr, "kernel_launch: cus=%d per_cu=%d grid=%d\n", cus, per_cu, grid_blocks);
    }
    if (grid_blocks < 0) return;
    if (hipMemsetAsync((char*)d_ws + OFF_CTL, 0, CTL_BYTES, stream) != hipSuccess) { fprintf(stderr, "kernel_launch: memset failed\n"); return; }
    Params p; memset(&p, 0, sizeof p);
    for (int i = 0; i < N_INPUTS; ++i) p.in[i] = (const float*)d_in[i];
    p.out = (float*)d_out; p.ws = (char*)d_ws;
    void* args[] = {&p};
    hipError_t e = hipLaunchCooperativeKernel((const void*)mega_kernel, dim3(grid_blocks), dim3(NTHR), args, LDS_BYTES, stream);
    if (e != hipSuccess) fprintf(stderr, "kernel_launch: cooperative launch failed: %s (grid %d)\n", hipGetErrorString(e), grid_blocks);
}
```

```cpp
#include <hip/hip_runtime.h>
#include <stdint.h>
#include <stdio.h>
#include <string.h>
#include <hip/hip_cooperative_groups.h>
namespace cg = cooperative_groups;

typedef unsigned short bf16_t;
typedef short bf16x8 __attribute__((ext_vector_type(8)));
typedef float f32x4 __attribute__((ext_vector_type(4)));
typedef unsigned u32x4 __attribute__((ext_vector_type(4)));

constexpr int NB = 8, SEQ = 2048, DM = 1024, T = NB * SEQ, NL = 2;
constexpr int NP = 3584;
constexpr int NIN = 3340;
constexpr int C_AQ = 0, C_AF = 256, C_AI = 512, C_AG = 768, C_BQ = 1024, C_BK = 1280, C_BV = 1536, C_CX = 1792, C_CG = 2048,
              C_DQ = 2304, C_DK = 2560, C_DV = 2816, C_DZ = 3072, C_GATE = 3328;
constexpr int MEMLEN = 256;
constexpr int NEXP = 32, DEXP = 256;
constexpr float EPS = 1e-6f;

constexpr size_t al256(size_t x) { return (x + 255) & ~(size_t)255; }
constexpr size_t SZ_WIN = (size_t)NP * 1024 * 2, SZ_WOUT = (size_t)1024 * 1024 * 2, SZ_WMQ = (size_t)256 * 1024 * 2, SZ_WMKV = (size_t)512 * 1024 * 2,
                 SZ_WMO = (size_t)1024 * 256 * 2, SZ_WGU = (size_t)32 * 512 * 1024 * 2, SZ_WDN = (size_t)32 * 1024 * 256 * 2;
constexpr size_t OFF_WIN = 0;
constexpr size_t OFF_WOUT = OFF_WIN + NL * SZ_WIN;
constexpr size_t OFF_WMQ = OFF_WOUT + NL * SZ_WOUT;
constexpr size_t OFF_WMKV = OFF_WMQ + NL * SZ_WMQ;
constexpr size_t OFF_WMO = OFF_WMKV + NL * SZ_WMKV;
constexpr size_t OFF_WGU = OFF_WMO + NL * SZ_WMO;
constexpr size_t OFF_WDN = OFF_WGU + NL * SZ_WGU;
constexpr size_t OFF_HN = OFF_WDN + NL * SZ_WDN;
constexpr size_t OFF_PROJ = OFF_HN + (size_t)T * 1024 * 2;
constexpr size_t OFF_GATES = OFF_PROJ + (size_t)T * NP * 2;
constexpr size_t OFF_Y = OFF_GATES + (size_t)T * 16 * 4;
constexpr size_t OFF_XB = OFF_Y + (size_t)T * 1024 * 2;
constexpr size_t OFF_QM = OFF_XB + (size_t)T * 1024 * 4;
constexpr size_t OFF_OM = OFF_QM + (size_t)T * 256 * 2;
constexpr size_t OFF_KVM = OFF_OM + (size_t)T * 256 * 2;
constexpr size_t OFF_MEMN = OFF_KVM + (size_t)NL * 2048 * 512 * 2;
constexpr size_t OFF_FOXC = OFF_MEMN + (size_t)2048 * 1024 * 2;
constexpr size_t OFF_LRUA = OFF_FOXC + (size_t)NB * 4 * SEQ * 4;
constexpr size_t OFF_LRUU = OFF_LRUA + (size_t)T * 256 * 4;
constexpr size_t OFF_CNT = OFF_LRUU + (size_t)T * 256 * 4;
constexpr size_t OFF_LIST = OFF_CNT + 256;
constexpr size_t OFF_PGATE = OFF_LIST + (size_t)NEXP * T * 4;
constexpr size_t OFF_HL = OFF_PGATE + (size_t)2 * T * 4;
constexpr size_t OFF_HD = OFF_HL + (size_t)1024 * 4096 * 4;
constexpr size_t OFF_GDN = OFF_HD + (size_t)1024 * 64 * 4;
constexpr size_t OFF_GLAST = OFF_GDN + (size_t)1024 * 5 * 4096 * 2;
constexpr size_t OFF_LSUM = OFF_GLAST + 4096;
constexpr size_t OFF_HS = OFF_LSUM + (size_t)2 * 256 * 256 * 4;
constexpr size_t OFF_LCAR = OFF_HS + (size_t)1024 * 4096 * 2;
constexpr size_t OFF_PSS = OFF_LCAR + (size_t)256 * 256 * 4;
constexpr size_t OFF_WR = OFF_PSS + (size_t)T * 16 * 4;
constexpr size_t OFF_CTL = OFF_WR + (size_t)NL * 2 * 48 * 1024 * 2;
constexpr size_t CTL_BYTES = 32768;
constexpr int CTL_CNT_WORD = 4096;
constexpr int CNT_STRIDE = 64;
constexpr size_t OFF_END = OFF_CTL + CTL_BYTES;
constexpr size_t OFF_ACT = OFF_PROJ;
constexpr size_t OFF_EO = OFF_PROJ + (size_t)2 * T * 256 * 2;
static_assert(OFF_EO + (size_t)2 * T * 1024 * 2 <= OFF_GATES, "overlay fits");

__device__ __forceinline__ int tid_opaque() { int t = threadIdx.x; asm volatile("" : "+v"(t)); return t; }
#define TIDX tid_opaque()
__device__ __forceinline__ float bf2f(bf16_t v) { return __uint_as_float(((unsigned)v) << 16); }
typedef __bf16 bf16x2_t __attribute__((ext_vector_type(2)));
__device__ __forceinline__ bf16_t f2bf(float f) { return __builtin_bit_cast(unsigned short, (__bf16)f); }
__device__ __forceinline__ unsigned pk2(float lo, float hi) { bf16x2_t v = {(__bf16)lo, (__bf16)hi}; return __builtin_bit_cast(unsigned, v); }
__device__ __forceinline__ float sigmoidf_(float x) { return 1.f / (1.f + __expf(-x)); }
__device__ __forceinline__ float siluf_(float x) { return x / (1.f + __expf(-x)); }
__device__ __forceinline__ float softplusf_(float x) { return x > 20.f ? x : log1pf(__expf(x)); }
__device__ __forceinline__ float logsigmoidf_(float x) { return x < 0.f ? x - log1pf(__expf(x)) : -log1pf(__expf(-x)); }
__device__ __forceinline__ float geluf_(float x) { float u = 0.7978845608028654f * (x + 0.044715f * x * x * x); return 0.5f * x * (1.f + tanhf(u)); }
__device__ __forceinline__ float wave_sum(float v) {
#pragma unroll
    for (int o = 1; o < 64; o <<= 1) v += __shfl_xor(v, o);
    return v;
}
__device__ __forceinline__ float rdlane(float v, int l) { return __int_as_float(__builtin_amdgcn_readlane(__float_as_int(v), l)); }

#define PROBE_MASK 0
#define GSYNC() xcd_barrier(xb)
#define REP(bit, ...) do { __VA_ARGS__; if (PROBE_MASK & (bit)) { GSYNC(); __VA_ARGS__; } } while (0)
constexpr int NTHR = 512;
constexpr int LDS_BYTES = 147456;
enum { I_X = 0, I_MEM, I_NORM_MIX, I_W_IN, I_HGRN_LB, I_FOX_FB, I_LRU_CONV_W, I_LRU_CONV_B, I_LRU_WA, I_LRU_BA, I_LRU_WX, I_LRU_BX, I_LRU_LAM, I_GDN_CONV_W, I_GDN_A_LOG,
       I_GDN_DT_BIAS, I_MIX_GAIN, I_W_OUT, I_NORM_MEM, I_NORM_MEMKV, I_W_MQ, I_W_MKV, I_W_MO, I_NORM_FFN, I_W_RG, I_B_RG, I_W_RE, I_B_RE, I_W_E_GU, I_W_E_DN, I_NORM_FINAL, N_INPUTS };
struct Params { const float* in[N_INPUTS]; float* out; char* ws; };
static_assert(sizeof(Params) == 8 * (N_INPUTS + 2), "no padding");

#define BLK_LOOP(it, n) for (int it = (int)blockIdx.x; it < (n); it += (int)gridDim.x)


__device__ __forceinline__ float rinv_from_pss(const float* __restrict__ pss, size_t row) {
    const f32x4 a = *(const f32x4*)(pss + row * 16), b = *(const f32x4*)(pss + row * 16 + 4), c = *(const f32x4*)(pss + row * 16 + 8), d = *(const f32x4*)(pss + row * 16 + 12);
    const float sm = ((a[0] + a[1]) + (a[2] + a[3])) + ((b[0] + b[1]) + (b[2] + b[3])) + ((c[0] + c[1]) + (c[2] + c[3])) + ((d[0] + d[1]) + (d[2] + d[3]));
    return rsqrtf(sm * (1.f / 1024.f) + EPS);
}

__device__ __forceinline__ int rowmap_fn(int mode, int n) {
    if (mode == 1) {
        if (n < 1792) return n;
        if (n < 1796) return C_GATE + (n - 1792);
        if (n < 3076) return n - 4;
        if (n < 3084) return C_GATE + 4 + (n - 3076);
        return n - 12;
    } else if (mode == 2) {
        int j = n & 255; return (j >> 4) * 32 + ((n >= 256) ? 16 : 0) + (j & 15);
    }
    return n;
}
__device__ __forceinline__ void convT_tile(float* tile  , const float* __restrict__ src, int K, int N, bf16_t* __restrict__ dst, int mode, int ntn, int idx) {
    const int n0 = (idx % ntn) * 64, k0 = (idx / ntn) * 64;
    const int tid = TIDX;
    __syncthreads();
#pragma unroll
    for (int i = 0; i < 2; ++i) {
        const int k = (tid >> 4) + 32 * i, n = n0 + (tid & 15) * 4;
        f32x4 v = (f32x4){0.f, 0.f, 0.f, 0.f};
        if (n + 3 < N) v = *(const f32x4*)(src + (size_t)(k0 + k) * N + n);
        else { for (int e = 0; e < 4; ++e) if (n + e < N) v[e] = src[(size_t)(k0 + k) * N + n + e]; }
#pragma unroll
        for (int e = 0; e < 4; ++e) tile[k * 65 + (tid & 15) * 4 + e] = v[e];
    }
    __syncthreads();
    const int nl = tid >> 3, k8 = (tid & 7) * 8, n = n0 + nl;
    if (n < N) {
        const int r = rowmap_fn(mode, n);
        u32x4 o;
#pragma unroll
        for (int j = 0; j < 4; ++j) o[j] = pk2(tile[(k8 + 2 * j) * 65 + nl], tile[(k8 + 2 * j + 1) * 65 + nl]);
        *(u32x4*)(dst + (size_t)r * K + k0 + k8) = o;
    }
}
__device__ __forceinline__ void rms_row_bf16(const float* __restrict__ xrow, const float* __restrict__ g, bf16_t* __restrict__ orow, int lane) {
    const f32x4* xr = (const f32x4*)xrow + lane;
    f32x4 v[4]; float s = 0.f;
#pragma unroll
    for (int j = 0; j < 4; ++j) { v[j] = xr[64 * j]; s += v[j].x * v[j].x + v[j].y * v[j].y + v[j].z * v[j].z + v[j].w * v[j].w; }
    const float rinv = rsqrtf(wave_sum(s) * (1.f / 1024.f) + EPS);
#pragma unroll
    for (int j = 0; j < 4; ++j) {
        const f32x4 gg = ((const f32x4*)g)[lane + 64 * j];
        uint2 o; o.x = pk2(v[j].x * rinv * gg.x, v[j].y * rinv * gg.y); o.y = pk2(v[j].z * rinv * gg.z, v[j].w * rinv * gg.w);
        *(uint2*)(orow + (lane + 64 * j) * 4) = o;
    }
}

constexpr int CT_PER_LAYER = 53 * 16 + 256 + 64 + 128 + 64;
constexpr int CT_GU = 64 * 128, CT_DN = 64 * 64;
constexpr int CT_TOTAL = NL * CT_PER_LAYER + CT_GU + CT_DN;

__device__ __forceinline__ void phase0(const Params& P, char* smem) {
    char* ws = P.ws;
    float* tile = (float*)smem;
    BLK_LOOP(it, CT_TOTAL) {
        int r = it;
        if (r < NL * CT_PER_LAYER) {
            const int l = r / CT_PER_LAYER; r -= l * CT_PER_LAYER;
            if (r < 848) { convT_tile(tile, P.in[I_W_IN] + (size_t)l * 1024 * NIN, 1024, NIN, (bf16_t*)(ws + OFF_WIN) + (size_t)l * NP * 1024, 1, 53, r); continue; } r -= 848;
            if (r < 256) { convT_tile(tile, P.in[I_W_OUT] + (size_t)l * 1024 * 1024, 1024, 1024, (bf16_t*)(ws + OFF_WOUT) + (size_t)l * 1024 * 1024, 0, 16, r); continue; } r -= 256;
            if (r < 64) { convT_tile(tile, P.in[I_W_MQ] + (size_t)l * 1024 * 256, 1024, 256, (bf16_t*)(ws + OFF_WMQ) + (size_t)l * 256 * 1024, 0, 4, r); continue; } r -= 64;
            if (r < 128) { convT_tile(tile, P.in[I_W_MKV] + (size_t)l * 1024 * 512, 1024, 512, (bf16_t*)(ws + OFF_WMKV) + (size_t)l * 512 * 1024, 0, 8, r); continue; } r -= 128;
            convT_tile(tile, P.in[I_W_MO] + (size_t)l * 256 * 1024, 256, 1024, (bf16_t*)(ws + OFF_WMO) + (size_t)l * 1024 * 256, 0, 16, r); continue;
        }
        r -= NL * CT_PER_LAYER;
        if (r < CT_GU) { const int m = r >> 7; convT_tile(tile, P.in[I_W_E_GU] + (size_t)m * 1024 * 512, 1024, 512, (bf16_t*)(ws + OFF_WGU) + (size_t)m * 512 * 1024, 2, 8, r & 127); continue; }
        r -= CT_GU;
        { const int m = r >> 6; convT_tile(tile, P.in[I_W_E_DN] + (size_t)m * 256 * 1024, 256, 1024, (bf16_t*)(ws + OFF_WDN) + (size_t)m * 1024 * 256, 0, 16, r & 63); }
    }
    for (int i = blockIdx.x * NTHR + TIDX; i < NL * (NP - NIN) * 512; i += gridDim.x * NTHR) {
        const int l = i / ((NP - NIN) * 512), w = i % ((NP - NIN) * 512);
        ((unsigned*)((bf16_t*)(ws + OFF_WIN) + (size_t)l * NP * 1024 + (size_t)NIN * 1024))[w] = 0u;
    }
    for (int i = blockIdx.x * NTHR + TIDX; i < NL * 48 * 1024; i += gridDim.x * NTHR) {
        const int l = i / (48 * 1024), r = (i / 1024) % 48, k = i & 1023;
        float w = 0.f;
        if (r < 4) w = P.in[I_W_RG][(size_t)l * 4096 + k * 4 + r]; else if (r < 36) w = P.in[I_W_RE][(size_t)l * 32768 + k * 32 + (r - 4)];
        const bf16_t hi = f2bf(w); const bf16_t lo = f2bf(w - bf2f(hi));
        bf16_t* wr = (bf16_t*)(ws + OFF_WR) + (size_t)l * 2 * 48 * 1024;
        wr[r * 1024 + k] = hi; wr[48 * 1024 + r * 1024 + k] = lo;
    }
    const int gw = blockIdx.x * 8 + (TIDX >> 6), ngw = gridDim.x * 8, lane = TIDX & 63;
    for (int row = gw; row < T + NL * 2048; row += ngw) {
        if (row < T) rms_row_bf16(P.in[I_X] + (size_t)row * 1024, P.in[I_NORM_MIX], (bf16_t*)(ws + OFF_HN) + (size_t)row * 1024, lane);
        else { const int r2 = row - T, l = r2 >> 11, rr = r2 & 2047;
               rms_row_bf16(P.in[I_MEM] + (size_t)rr * 1024, P.in[I_NORM_MEMKV] + l * 1024, (bf16_t*)(ws + OFF_MEMN) + (size_t)r2 * 1024, lane); }
    }
}

constexpr int GLD = 72;
constexpr int GEMM_STAGE = (256 + 128) * GLD * 2;
constexpr int GEMM_LDS = 2 * GEMM_STAGE;
template <class RowPtr>
__device__ __forceinline__ void gemm_tile(char* smem, RowPtr rowptr, const bf16_t* __restrict__ Bt, int ldb, int n0, int K, f32x4 (&acc)[4][4]) {
    const int tid = TIDX, lane = tid & 63, wave = tid >> 6, wm = wave >> 1, wn = wave & 1;
    const u32x4* ga[4]; const u32x4* gb[2];
#pragma unroll
    for (int i = 0; i < 4; ++i) { const int c = tid + i * 512, r = c >> 3, ch = c & 7; ga[i] = (const u32x4*)(rowptr(r) + ch * 8); }
#pragma unroll
    for (int i = 0; i < 2; ++i) { const int c = tid + i * 512, r = c >> 3, ch = c & 7; gb[i] = (const u32x4*)(Bt + (size_t)(n0 + r) * ldb + ch * 8); }
#pragma unroll
    for (int m = 0; m < 4; ++m)
#pragma unroll
        for (int n = 0; n < 4; ++n) acc[m][n] = (f32x4){0.f, 0.f, 0.f, 0.f};
    const int nk = K / 64;
    u32x4 raA[4], rbA[2], raB[4], rbB[2];
#define GT_LOAD(RA, RB, kt) { _Pragma("unroll") for (int i = 0; i < 4; ++i) RA[i] = ga[i][(kt) * 8]; _Pragma("unroll") for (int i = 0; i < 2; ++i) RB[i] = gb[i][(kt) * 8]; }
#define GT_STORE(RA, RB, buf) { bf16_t* dA = (bf16_t*)(smem + (buf) * GEMM_STAGE); bf16_t* dB = dA + 256 * GLD; \
        _Pragma("unroll") for (int i = 0; i < 4; ++i) { const int c = tid + i * 512, r = c >> 3, ch = c & 7; *(u32x4*)(dA + r * GLD + ch * 8) = RA[i]; } \
        _Pragma("unroll") for (int i = 0; i < 2; ++i) { const int c = tid + i * 512, r = c >> 3, ch = c & 7; *(u32x4*)(dB + r * GLD + ch * 8) = RB[i]; } }
#define GT_COMPUTE(buf) { const bf16_t* sA = (const bf16_t*)(smem + (buf) * GEMM_STAGE); const bf16_t* sB = sA + 256 * GLD; \
        _Pragma("unroll") for (int kk = 0; kk < 2; ++kk) { bf16x8 af[4], bfr[4]; \
            _Pragma("unroll") for (int m = 0; m < 4; ++m) af[m] = *(const bf16x8*)(sA + (wm * 64 + m * 16 + (lane & 15)) * GLD + kk * 32 + (lane >> 4) * 8); \
            _Pragma("unroll") for (int n = 0; n < 4; ++n) bfr[n] = *(const bf16x8*)(sB + (wn * 64 + n * 16 + (lane & 15)) * GLD + kk * 32 + (lane >> 4) * 8); \
            _Pragma("unroll") for (int m = 0; m < 4; ++m) _Pragma("unroll") for (int n = 0; n < 4; ++n) acc[m][n] = __builtin_amdgcn_mfma_f32_16x16x32_bf16(bfr[n], af[m], acc[m][n], 0, 0, 0); } }
    GT_LOAD(raA, rbA, 0)
    GT_LOAD(raB, rbB, 1)
    __syncthreads();
    GT_STORE(raA, rbA, 0)
    __syncthreads();
    for (int kt = 0; kt < nk; kt += 2) {
        if (kt + 2 < nk) GT_LOAD(raA, rbA, kt + 2)
        GT_COMPUTE(0)
        GT_STORE(raB, rbB, 1)
        __syncthreads();
        if (kt + 3 < nk) GT_LOAD(raB, rbB, kt + 3)
        GT_COMPUTE(1)
        if (kt + 2 < nk) GT_STORE(raA, rbA, 0)
        __syncthreads();
    }
#undef GT_LOAD
#undef GT_STORE
#undef GT_COMPUTE
}
struct RowDirect { const bf16_t* A; int lda; int m0; __device__ __forceinline__ const bf16_t* operator()(int r) const { return A + (size_t)(m0 + r) * lda; } };
enum { EPI_INPROJ = 0, EPI_RESID = 1, EPI_BF16 = 2, EPI_BF16_RS = 3, EPI_RESID_NORM = 4 };

__device__ __forceinline__ int vcu_id() { const int G = gridDim.x, bx = blockIdx.x; return (G % 8 == 0) ? (bx % 8) * (G / 8) + bx / 8 : bx; }

template <int EPI>
__device__ __forceinline__ void gemm_phase(char* smem, const bf16_t* A, int lda, const bf16_t* Bt, int ldb, int M, int N, int K, void* out, int ldo, const float* resid, float* gates, int idx0 = -1, int stride = 0, bf16_t* xg = nullptr, const float* gn = nullptr) {
    const int ntn = N / 128, ntiles = (M / 256) * ntn;
    if (stride == 0) { idx0 = vcu_id(); stride = gridDim.x; }
    if (idx0 < 0) return;
    const int lane = TIDX & 63, wave = TIDX >> 6, wm = wave >> 1, wn = wave & 1;
    for (int tIdx = idx0; tIdx < ntiles; tIdx += stride) {
        const int m0 = (tIdx / ntn) * 256, n0 = (tIdx % ntn) * 128;
        f32x4 acc[4][4];
        RowDirect rp{A, lda, m0};
        gemm_tile(smem, rp, Bt, ldb, n0, K, acc);
        float rsc[4] = {1.f, 1.f, 1.f, 1.f};
        if (EPI == EPI_BF16_RS) {
#pragma unroll
            for (int m = 0; m < 4; ++m) rsc[m] = rinv_from_pss(resid, (size_t)(m0 + wm * 64 + m * 16 + (lane & 15)));
        }
        if (EPI == EPI_RESID_NORM) {
#pragma unroll
            for (int m = 0; m < 4; ++m) {
                const int row = m0 + wm * 64 + m * 16 + (lane & 15);
                float ss = 0.f;
#pragma unroll
                for (int n = 0; n < 4; ++n) {
                    const int col = n0 + wn * 64 + n * 16 + (lane >> 4) * 4;
                    const f32x4 o = *(const f32x4*)(resid + (size_t)row * ldo + col) + acc[m][n];
                    *(f32x4*)((float*)out + (size_t)row * ldo + col) = o;
                    ss += (o[0] * o[0] + o[1] * o[1]) + (o[2] * o[2] + o[3] * o[3]);
                    const f32x4 og = o * *(const f32x4*)(gn + col);
                    uint2 w; w.x = pk2(og[0], og[1]); w.y = pk2(og[2], og[3]);
                    *(uint2*)(xg + (size_t)row * ldo + col) = w;
                }
                ss += __shfl_xor(ss, 16); ss += __shfl_xor(ss, 32);
                if ((lane >> 4) == 0) gates[(size_t)row * 16 + (n0 >> 7) * 2 + wn] = ss;
            }
            continue;
        }
#pragma unroll
        for (int m = 0; m < 4; ++m)
#pragma unroll
            for (int n = 0; n < 4; ++n) {
                const int row = m0 + wm * 64 + m * 16 + (lane & 15), col = n0 + wn * 64 + n * 16 + (lane >> 4) * 4;
                const f32x4 v = acc[m][n];
                if (EPI == EPI_INPROJ) {
                    uint2 o; o.x = pk2(v.x, v.y); o.y = pk2(v.z, v.w);
                    *(uint2*)((bf16_t*)out + (size_t)row * ldo + col) = o;
                    if (col >= C_GATE && col < C_GATE + 16) *(f32x4*)(gates + (size_t)row * 16 + (col - C_GATE)) = v;
                } else if (EPI == EPI_RESID) {
                    const f32x4 r = *(const f32x4*)(resid + (size_t)row * ldo + col);
                    *(f32x4*)((float*)out + (size_t)row * ldo + col) = r + v;
                } else if (EPI == EPI_BF16_RS) {
                    const float ri = rsc[m];
                    uint2 o; o.x = pk2(v.x * ri, v.y * ri); o.y = pk2(v.z * ri, v.w * ri);
                    *(uint2*)((bf16_t*)out + (size_t)row * ldo + col) = o;
                } else {
                    uint2 o; o.x = pk2(v.x, v.y); o.y = pk2(v.z, v.w);
                    *(uint2*)((bf16_t*)out + (size_t)row * ldo + col) = o;
                }
            }
    }
}


namespace pg8 {
#define PG8_LAS __attribute__((address_space(3)))
typedef unsigned short bf16_t;
typedef short bf16x8 __attribute__((ext_vector_type(8)));
typedef float f32x4 __attribute__((ext_vector_type(4)));
typedef unsigned u32x4 __attribute__((ext_vector_type(4)));
constexpr int BM = 256, BK = 64, HALF = 128, HTB = HALF * BK * 2  , STAGE_BYTES = 8 * HTB, NXCD = 8, WGM = 8;

__host__ __device__ __forceinline__ int lds_byte(int r, int c) { const int st = (r >> 4) * 2 + (c >> 5), rr = r & 15, cc = c & 31, ob = rr * 64 + cc * 2; return st * 1024 + (ob ^ (((ob >> 9) & 1) << 5)); }
__host__ __device__ __forceinline__ void stage_rc(int b, int& R, int& C) { const int st = b / 1024, sb = b % 1024, swz = sb ^ (((sb >> 9) & 1) << 5); R = (st >> 1) * 16 + swz / 64; C = (st & 1) * 32 + (swz % 64) / 2; }
__host__ __device__ __forceinline__ int perm32(int rho) { const int n = rho >> 4, i = rho & 15; return 8 * (i >> 2) + 4 * n + (i & 3); }

struct Unit { int pm, pn; };
struct Gemm { const bf16_t* A; const bf16_t* Bt; int M, N, K; };

struct StaticOrder {
    int nM, nN, nwg, G, c;
    __host__ __device__ void init(int M, int N, int G_, int c_) { nM = M / BM; nN = N / BM; nwg = nM * nN; G = G_; c = c_; }
    __host__ __device__ bool next(int i, Unit& u) const {
        const long L = (long)i * G + c; if (L >= nwg) return false;
        int wgid = (int)L; { const int q = nwg / NXCD, r = nwg % NXCD, xcd = wgid % NXCD, off = wgid / NXCD; wgid = (xcd < r ? xcd * (q + 1) : r * (q + 1) + (xcd - r) * q) + off; }
        const int nig = WGM * nN, gid = wgid / nig, fm = gid * WGM, gsz = (nM - fm) < WGM ? (nM - fm) : WGM;
        u.pm = fm + ((wgid % nig) % gsz); u.pn = (wgid % nig) / gsz; return true;
    }
    __device__ __forceinline__ void a_ready(const Unit&) const {}
    __device__ __forceinline__ void done(const Unit&) const {}
};
__device__ __forceinline__ unsigned cvt_pk_bf16(float lo, float hi) { unsigned r; asm volatile("v_cvt_pk_bf16_f32 %0, %1, %2" : "=v"(r) : "v"(lo), "v"(hi)); return r; }
typedef float f32x2 __attribute__((ext_vector_type(2)));

struct EpiInProj {
    static constexpr bool PERM = true, AFTER_DRAIN = false;
    bf16_t* O; int ldc; float* gates; int gate_col;
    __device__ __forceinline__ void operator()(const f32x4 (&acc)[2][2][4][2], const Unit& u, int wr, int wc, int fr, int fq) const {
        const int row0 = u.pm * BM + wr * 64 + fr, col0 = u.pn * BM + wc * 32 + 8 * fq;
#pragma unroll
        for (int ai = 0; ai < 2; ++ai)
#pragma unroll
            for (int m = 0; m < 4; ++m) {
                const int row = row0 + ai * HALF + m * 16;
                bf16_t* rowp = O + (size_t)row * ldc + col0;
#pragma unroll
                for (int bj = 0; bj < 2; ++bj) {
                    const f32x4 v0 = acc[ai][bj][m][0], v1 = acc[ai][bj][m][1];
                    u32x4 w; w.x = cvt_pk_bf16(v0[0], v0[1]); w.y = cvt_pk_bf16(v0[2], v0[3]); w.z = cvt_pk_bf16(v1[0], v1[1]); w.w = cvt_pk_bf16(v1[2], v1[3]);
                    *(u32x4*)(rowp + bj * HALF) = w;
                    const int gc = col0 + bj * HALF - gate_col;
                    if (gates && gc >= 0 && gc < 16) { *(f32x4*)(gates + (size_t)row * 16 + gc) = v0; *(f32x4*)(gates + (size_t)row * 16 + gc + 4) = v1; }
                }
            }
    }
};
struct EpiResid {
    static constexpr bool PERM = false, AFTER_DRAIN = false;
    const float* base; float* out; int ldc;
    __device__ __forceinline__ void operator()(const f32x4 (&acc)[2][2][4][2], const Unit& u, int wr, int wc, int fr, int fq) const {
        const int col0 = u.pn * BM + wc * 32 + 4 * fq;
#pragma unroll
        for (int ai = 0; ai < 2; ++ai)
#pragma unroll
            for (int m = 0; m < 4; ++m) {
                const size_t off = (size_t)(u.pm * BM + ai * HALF + wr * 64 + m * 16 + fr) * ldc + col0;
#pragma unroll
                for (int bj = 0; bj < 2; ++bj)
#pragma unroll
                    for (int n = 0; n < 2; ++n) { const f32x4 bs = *(const f32x4*)(base + off + bj * HALF + n * 16); *(f32x4*)(out + off + bj * HALF + n * 16) = bs + acc[ai][bj][m][n]; }
                if (m & 1) asm volatile("" ::: "memory");
            }
    }
};

struct EpiResidNorm {
    static constexpr bool PERM = false, AFTER_DRAIN = false;
    const float* base; float* out; int ldc; const float* gn; bf16_t* xg; float* pss;
    __device__ __forceinline__ void operator()(const f32x4 (&acc)[2][2][4][2], const Unit& u, int wr, int wc, int fr, int fq) const {
        const int col0 = u.pn * BM + wc * 32 + 4 * fq;
        f32x4 gv[2][2];
#pragma unroll
        for (int bj = 0; bj < 2; ++bj)
#pragma unroll
            for (int n = 0; n < 2; ++n) gv[bj][n] = *(const f32x4*)(gn + col0 + bj * HALF + n * 16);
#pragma unroll
        for (int ai = 0; ai < 2; ++ai)
#pragma unroll
            for (int m = 0; m < 4; ++m) {
                const int row = u.pm * BM + ai * HALF + wr * 64 + m * 16 + fr;
                const size_t off = (size_t)row * ldc + col0;
                float ss = 0.f;
#pragma unroll
                for (int bj = 0; bj < 2; ++bj)
#pragma unroll
                    for (int n = 0; n < 2; ++n) {
                        const f32x4 bs = *(const f32x4*)(base + off + bj * HALF + n * 16);
                        const f32x4 o = bs + acc[ai][bj][m][n];
                        *(f32x4*)(out + off + bj * HALF + n * 16) = o;
                        ss += (o[0] * o[0] + o[1] * o[1]) + (o[2] * o[2] + o[3] * o[3]);
                        const f32x4 og = o * gv[bj][n];
                        uint2 w; w.x = cvt_pk_bf16(og[0], og[1]); w.y = cvt_pk_bf16(og[2], og[3]);
                        *(uint2*)(xg + off + bj * HALF + n * 16) = w;
                    }
                ss += __shfl_xor(ss, 16); ss += __shfl_xor(ss, 32);
                if (fq == 0) pss[(size_t)row * 16 + u.pn * 4 + wc] = ss;
                if (m & 1) asm volatile("" ::: "memory");
            }
    }
};
template <class Epi, class Sched, bool ALIGN_EPI = false, bool SP2 = false>
__device__ __forceinline__ void gemm_phase(PG8_LAS unsigned char* lds, const Gemm g, const Sched& S, const Epi& E) {
    const int tid = TIDX, wid = __builtin_amdgcn_readfirstlane(tid >> 6), lane = tid & 63, wr = wid >> 2, wc = wid & 3, fr = lane & 15, fq = lane >> 4;
    const int K = g.K, nt = K / BK;
    unsigned voffA[2], voffB[2];
#pragma unroll
    for (int i = 0; i < 2; ++i) { int R, C; stage_rc(tid * 16 + i * 8192, R, C); const int Rb = Epi::PERM ? ((R & ~31) + perm32(R & 31)) : R;
        voffA[i] = (unsigned)(R * K + C) * 2u; voffB[i] = (unsigned)(Rb * K + C) * 2u; }
    const size_t kstep = (size_t)(BK * 2);
    const size_t hstep = (size_t)HALF * K * 2;
    const size_t tstep = 2 * hstep;
    const unsigned ldsw = (unsigned)wid * 1024u;
    const int aoff = lds_byte(wr * 64 + fr, fq * 8), boff = lds_byte(wc * 32 + fr, fq * 8);
#define PG8_SA(b, h) (((b) * 2 + (h)) * HTB)
#define PG8_SB(b, h) ((4 + (b) * 2 + (h)) * HTB)
#define PG8_STAGE(bufoff, gbase, voff) do { _Pragma("unroll") for (int _i = 0; _i < 2; ++_i) \
        __builtin_amdgcn_global_load_lds((const unsigned*)((const char*)(gbase) + (voff)[_i]), (PG8_LAS unsigned*)(lds + (bufoff) + ldsw + _i * 8192), 16, 0, 0); } while (0)
#define PG8_LDA(dst, b, h) do { _Pragma("unroll") for (int m = 0; m < 4; ++m) _Pragma("unroll") for (int k = 0; k < 2; ++k) dst[m][k] = *(const PG8_LAS bf16x8*)(lds + PG8_SA(b, h) + aoff + m * 2048 + k * 1024); } while (0)
#define PG8_LDB(dst, b, h) do { _Pragma("unroll") for (int n = 0; n < 2; ++n) _Pragma("unroll") for (int k = 0; k < 2; ++k) dst[n][k] = *(const PG8_LAS bf16x8*)(lds + PG8_SB(b, h) + boff + n * 2048 + k * 1024); } while (0)
#define PG8_MMA(ai, bj, At, Bt) do { __builtin_amdgcn_s_setprio(1); _Pragma("unroll") for (int m = 0; m < 4; ++m) _Pragma("unroll") for (int n = 0; n < 2; ++n) _Pragma("unroll") for (int k = 0; k < 2; ++k) \
        acc[ai][bj][m][n] = __builtin_amdgcn_mfma_f32_16x16x32_bf16(Bt[n][k], At[m][k], acc[ai][bj][m][n], 0, 0, 0); __builtin_amdgcn_s_setprio(0); } while (0)
#define PG8_WAIT_V(n) asm volatile("s_waitcnt vmcnt(" #n ")" ::: "memory")
#define PG8_WAIT_L(n) asm volatile("s_waitcnt lgkmcnt(" #n ")" ::: "memory")
#define PG8_BAR __builtin_amdgcn_s_barrier()
#define PG8_SCHED __builtin_amdgcn_sched_barrier(0)
    Unit cur, nxt; int ui = 0;
    if (!S.next(0, cur)) return;
    f32x4 acc[2][2][4][2];
#pragma unroll
    for (int a = 0; a < 2; ++a)
#pragma unroll
        for (int b = 0; b < 2; ++b)
#pragma unroll
            for (int m = 0; m < 4; ++m)
#pragma unroll
                for (int n = 0; n < 2; ++n) acc[a][b][m][n] = (f32x4){0.f, 0.f, 0.f, 0.f};
    bf16x8 At[4][2], B0[2][2], B1[2][2];
    const char* cA = (const char*)g.A + (size_t)cur.pm * tstep; const char* cB = (const char*)g.Bt + (size_t)cur.pn * tstep;
    S.a_ready(cur);
    if constexpr (SP2) {
        PG8_STAGE(PG8_SB(0, 0), cB, voffB); PG8_STAGE(PG8_SB(0, 1), cB + hstep, voffB); PG8_STAGE(PG8_SA(0, 0), cA, voffA); PG8_STAGE(PG8_SA(0, 1), cA + hstep, voffA);
        if (wr == 1) PG8_BAR;
        PG8_WAIT_V(2); PG8_BAR;
        PG8_STAGE(PG8_SB(1, 0), cB + kstep, voffB); PG8_STAGE(PG8_SA(1, 0), cA + kstep, voffA); PG8_STAGE(PG8_SB(1, 1), cB + hstep + kstep, voffB);
        PG8_WAIT_V(6); PG8_BAR;
    } else {
        PG8_STAGE(PG8_SB(0, 0), cB, voffB); PG8_STAGE(PG8_SA(0, 0), cA, voffA); PG8_STAGE(PG8_SB(0, 1), cB + hstep, voffB); PG8_STAGE(PG8_SA(0, 1), cA + hstep, voffA);
        if (wr == 1) PG8_BAR;
        PG8_WAIT_V(4); PG8_BAR;
        PG8_STAGE(PG8_SB(1, 0), cB + kstep, voffB); PG8_STAGE(PG8_SA(1, 0), cA + kstep, voffA); PG8_STAGE(PG8_SB(1, 1), cB + hstep + kstep, voffB);
        PG8_WAIT_V(6); PG8_BAR;
    }
    for (;;) {
        const bool has_next = S.next(ui + 1, nxt);
        const char* nA = has_next ? (const char*)g.A + (size_t)nxt.pm * tstep : cA; const char* nB = has_next ? (const char*)g.Bt + (size_t)nxt.pn * tstep : cB;
        for (int t = 0; t < nt; t += 2) {
            const bool last = (t == nt - 2);
            const char* a1 = cA + (size_t)(t + 1) * kstep;
            const char* a2 = last ? nA : cA + (size_t)(t + 2) * kstep; const char* b2 = last ? nB : cB + (size_t)(t + 2) * kstep;
            const char* a3 = a2 + kstep; const char* b3 = b2 + kstep;
            if (last && has_next) S.a_ready(nxt);
            if constexpr (SP2) {
            PG8_LDB(B0, 0, 0); PG8_LDB(B1, 0, 1); PG8_SCHED; PG8_LDA(At, 0, 0); PG8_STAGE(PG8_SA(1, 1), a1 + hstep, voffA);
            PG8_WAIT_V(8); PG8_WAIT_L(0); PG8_BAR; PG8_MMA(0, 0, At, B0); PG8_MMA(0, 1, At, B1); PG8_BAR; PG8_SCHED;
            PG8_LDA(At, 0, 1); PG8_STAGE(PG8_SB(0, 0), b2, voffB); PG8_STAGE(PG8_SB(0, 1), b2 + hstep, voffB); PG8_STAGE(PG8_SA(0, 0), a2, voffA);
            PG8_WAIT_V(8); PG8_WAIT_L(0); PG8_BAR; PG8_MMA(1, 0, At, B0); PG8_MMA(1, 1, At, B1); PG8_BAR; PG8_SCHED;
            PG8_LDB(B0, 1, 0); PG8_LDB(B1, 1, 1); PG8_SCHED; PG8_LDA(At, 1, 0); PG8_STAGE(PG8_SA(0, 1), a2 + hstep, voffA);
            PG8_WAIT_V(8); PG8_WAIT_L(0); PG8_BAR; PG8_MMA(0, 0, At, B0); PG8_MMA(0, 1, At, B1); PG8_BAR; PG8_SCHED;
            PG8_LDA(At, 1, 1); PG8_STAGE(PG8_SB(1, 0), b3, voffB); PG8_STAGE(PG8_SB(1, 1), b3 + hstep, voffB); PG8_STAGE(PG8_SA(1, 0), a3, voffA);
            PG8_WAIT_V(8); PG8_WAIT_L(0); PG8_BAR; PG8_MMA(1, 0, At, B0); PG8_MMA(1, 1, At, B1); PG8_BAR; PG8_SCHED;
            } else {
            PG8_LDB(B0, 0, 0); PG8_SCHED; PG8_LDA(At, 0, 0); PG8_STAGE(PG8_SA(1, 1), a1 + hstep, voffA);
            PG8_WAIT_L(8); PG8_BAR; PG8_WAIT_L(0); PG8_MMA(0, 0, At, B0); PG8_BAR; PG8_SCHED;
            PG8_LDB(B1, 0, 1); PG8_STAGE(PG8_SB(0, 0), b2, voffB);
            PG8_BAR; PG8_WAIT_L(0); PG8_MMA(0, 1, At, B1); PG8_BAR;
            PG8_LDA(At, 0, 1); PG8_STAGE(PG8_SA(0, 0), a2, voffA);
            PG8_BAR; PG8_WAIT_L(0); PG8_MMA(1, 0, At, B0); PG8_BAR; PG8_SCHED;
            PG8_STAGE(PG8_SB(0, 1), b2 + hstep, voffB);
            PG8_WAIT_V(6); PG8_BAR; PG8_MMA(1, 1, At, B1); PG8_BAR;
            PG8_LDB(B0, 1, 0); PG8_SCHED; PG8_LDA(At, 1, 0); PG8_STAGE(PG8_SA(0, 1), a2 + hstep, voffA);
            PG8_WAIT_L(8); PG8_BAR; PG8_WAIT_L(0); PG8_MMA(0, 0, At, B0); PG8_BAR; PG8_SCHED;
            PG8_LDB(B1, 1, 1); PG8_STAGE(PG8_SB(1, 0), b3, voffB);
            PG8_BAR; PG8_WAIT_L(0); PG8_MMA(0, 1, At, B1); PG8_BAR;
            PG8_LDA(At, 1, 1); PG8_STAGE(PG8_SA(1, 0), a3, voffA);
            PG8_BAR; PG8_WAIT_L(0); PG8_MMA(1, 0, At, B0); PG8_BAR; PG8_SCHED;
            PG8_STAGE(PG8_SB(1, 1), b3 + hstep, voffB);
            PG8_WAIT_V(6); PG8_BAR; PG8_MMA(1, 1, At, B1); PG8_BAR;
            }
        }
        if constexpr (ALIGN_EPI) { if (wr == 0) PG8_BAR; }
        if constexpr (!Epi::AFTER_DRAIN) { E(acc, cur, wr, wc, fr, fq); S.done(cur); }
        if (!has_next) break;
#pragma unroll
        for (int a = 0; a < 2; ++a)
#pragma unroll
            for (int b = 0; b < 2; ++b)
#pragma unroll
                for (int m = 0; m < 4; ++m)
#pragma unroll
                    for (int n = 0; n < 2; ++n) acc[a][b][m][n] = (f32x4){0.f, 0.f, 0.f, 0.f};
        cur = nxt; cA = nA; cB = nB; ++ui;
        if constexpr (ALIGN_EPI) { if (wr == 1) PG8_BAR; }
    }
    PG8_WAIT_V(0);
    if constexpr (!ALIGN_EPI) { if (wr == 0) PG8_BAR; }
    PG8_BAR;
    if constexpr (Epi::AFTER_DRAIN) { E.fused(acc, cur, wr, wc, fr, fq, lds, wid, lane); S.done(cur); }
#undef PG8_SA
#undef PG8_SB
#undef PG8_STAGE
#undef PG8_LDA
#undef PG8_LDB
#undef PG8_MMA
#undef PG8_WAIT_V
#undef PG8_WAIT_L
#undef PG8_BAR
#undef PG8_SCHED
}
}

struct RowGather { const bf16_t* A; int lda; const int* ids; int shift; __device__ __forceinline__ const bf16_t* operator()(int r) const { return A + (size_t)(ids[r] >> shift) * lda; } };
template <int STAGE>
__device__ __forceinline__ void moe_phase(char* smem, const bf16_t* A, int lda, const bf16_t* Wt, size_t wstride, int ldb, int K, const int* cnt, const int* list, const float* pgate, bf16_t* out, const float* pss) {
    int* ids = (int*)(smem + GEMM_LDS);
    int* tpre = ids + 256;
    constexpr int NTN = (STAGE == 1) ? 4 : 8;
    __syncthreads();
    if (TIDX < 64) {
        const int ln = TIDX; int nt = (ln < NEXP) ? ((cnt[ln * CNT_STRIDE] + 255) >> 8) : 0; int inc = nt;
#pragma unroll
        for (int o = 1; o < 64; o <<= 1) { const int nb = __shfl_up(inc, o); if (ln >= o) inc += nb; }
        if (ln <= NEXP) tpre[ln] = inc - nt;
    }
    __syncthreads();
    const int ntiles = tpre[NEXP] * NTN;
    const int lane = TIDX & 63, wave = TIDX >> 6, wm = wave >> 1, wn = wave & 1;
    for (int tIdx = vcu_id(); tIdx < ntiles; tIdx += gridDim.x) {
        const int mtg = tIdx / NTN, n0 = (tIdx % NTN) * 128;
        int e = 0;
        for (int i = 1; i < NEXP; ++i) if (tpre[i] <= mtg) e = i;
        const int mt = mtg - tpre[e];
        const int cn = cnt[e * CNT_STRIDE];
        __syncthreads();
        if (TIDX < 256) { const int pos = mt * 256 + TIDX; ids[TIDX] = list[(size_t)e * T + (pos < cn ? pos : cn - 1)]; }
        __syncthreads();
        f32x4 acc[4][4];
        RowGather rp{A, lda, ids, STAGE == 1 ? 1 : 0};
        gemm_tile(smem, rp, Wt + (size_t)e * wstride, ldb, n0, K, acc);
#pragma unroll
        for (int m = 0; m < 4; ++m) {
            const int rl = wm * 64 + m * 16 + (lane & 15);
            if (mt * 256 + rl >= cn) continue;
            const int pid = ids[rl];
            if (STAGE == 1) {
                const float gt = pgate[pid], ri = rinv_from_pss(pss, (size_t)(pid >> 1));
#pragma unroll
                for (int np = 0; np < 2; ++np) {
                    const f32x4 g = acc[m][2 * np], u = acc[m][2 * np + 1];
                    const int j = (n0 + wn * 64 + np * 32) / 2 + (lane >> 4) * 4;
                    const f32x4 gs = g * ri; const float ug = ri * gt;
                    uint2 o; o.x = pk2(siluf_(gs.x) * u.x * ug, siluf_(gs.y) * u.y * ug); o.y = pk2(siluf_(gs.z) * u.z * ug, siluf_(gs.w) * u.w * ug);
                    *(uint2*)(out + (size_t)pid * DEXP + j) = o;
                }
            } else {
#pragma unroll
                for (int n = 0; n < 4; ++n) {
                    const f32x4 v = acc[m][n]; const int col = n0 + wn * 64 + n * 16 + (lane >> 4) * 4;
                    uint2 o; o.x = pk2(v.x, v.y); o.y = pk2(v.z, v.w);
                    *(uint2*)(out + (size_t)pid * 1024 + col) = o;
                }
            }
        }
    }
}

__device__ __forceinline__ void hgrn2_naive(const bf16_t* __restrict__ proj, const float* __restrict__ hgrn_lb, int layer, const float* __restrict__ mix_gain, bf16_t* __restrict__ y, int bh, int lane) {
    const int b = bh >> 2, h = bh & 3;
    float lbk = 0.f;
    if (layer == 1) { float a0 = hgrn_lb[h * 64 + lane], a1 = hgrn_lb[256 + h * 64 + lane]; lbk = 1.f / (1.f + __expf(a0 - a1)); }
    const float mg = mix_gain[C_AQ + h * 64 + lane];
    float S[64];
#pragma unroll
    for (int k = 0; k < 64; ++k) S[k] = 0.f;
    for (int t = 0; t < SEQ; ++t) {
        const bf16_t* pr = proj + (size_t)(b * SEQ + t) * NP + h * 64 + lane;
        const float qk = siluf_(bf2f(pr[C_AQ]));
        const float sg = sigmoidf_(bf2f(pr[C_AF]));
        const float f = lbk + (1.f - lbk) * sg, kk = (1.f - lbk) * (1.f - sg);
        const float iv = bf2f(pr[C_AI]);
        const float gv = bf2f(pr[C_AG]);
        float o = 0.f;
#pragma unroll
        for (int k = 0; k < 64; ++k) { S[k] = rdlane(f, k) * S[k] + rdlane(kk, k) * iv; o += rdlane(qk, k) * S[k]; }
        const float ms = wave_sum(o * o) * (1.f / 64.f);
        const float yv = o * rsqrtf(ms + EPS) * siluf_(gv) * mg;
        y[(size_t)(b * SEQ + t) * 1024 + 0 + h * 64 + lane] = f2bf(yv);
    }
}
__device__ __forceinline__ void gdn_naive(const bf16_t* __restrict__ proj, const float* __restrict__ gates, const float* __restrict__ conv_w  ,
                                          const float* __restrict__ a_log, const float* __restrict__ dt_bias, const float* __restrict__ mix_gain, bf16_t* __restrict__ y, int bh, int lane) {
    const int b = bh >> 2, h = bh & 3;
    float wq[4], wk[4], wv[4];
#pragma unroll
    for (int j = 0; j < 4; ++j) { wq[j] = conv_w[j * 768 + h * 64 + lane]; wk[j] = conv_w[j * 768 + 256 + h * 64 + lane]; wv[j] = conv_w[j * 768 + 512 + h * 64 + lane]; }
    float xq[3] = {0.f, 0.f, 0.f}, xk[3] = {0.f, 0.f, 0.f}, xv[3] = {0.f, 0.f, 0.f};
    const float Aexp = __expf(a_log[h]), dtb = dt_bias[h];
    const float mg = mix_gain[768 + h * 64 + lane];
    float S[64];
#pragma unroll
    for (int k = 0; k < 64; ++k) S[k] = 0.f;
    for (int t = 0; t < SEQ; ++t) {
        const size_t row = (size_t)(b * SEQ + t);
        const bf16_t* pr = proj + row * NP + h * 64 + lane;
        const float q0 = bf2f(pr[C_DQ]), k0 = bf2f(pr[C_DK]), v0 = bf2f(pr[C_DV]), zv = bf2f(pr[C_DZ]);
        float q = siluf_(wq[0] * xq[0] + wq[1] * xq[1] + wq[2] * xq[2] + wq[3] * q0);
        float k = siluf_(wk[0] * xk[0] + wk[1] * xk[1] + wk[2] * xk[2] + wk[3] * k0);
        float v = siluf_(wv[0] * xv[0] + wv[1] * xv[1] + wv[2] * xv[2] + wv[3] * v0);
        xq[0] = xq[1]; xq[1] = xq[2]; xq[2] = q0; xk[0] = xk[1]; xk[1] = xk[2]; xk[2] = k0; xv[0] = xv[1]; xv[1] = xv[2]; xv[2] = v0;
        q = q * rsqrtf(wave_sum(q * q) + EPS) * 0.125f;
        k = k * rsqrtf(wave_sum(k * k) + EPS);
        const float beta = sigmoidf_(gates[row * 16 + 4 + h]);
        const float g = -Aexp * softplusf_(gates[row * 16 + 8 + h] + dtb);
        const float eg = __expf(g);
        float r = 0.f;
#pragma unroll
        for (int i = 0; i < 64; ++i) { S[i] *= eg; r += rdlane(k, i) * S[i]; }
        const float dlt = beta * (v - r);
        float o = 0.f;
#pragma unroll
        for (int i = 0; i < 64; ++i) { S[i] += rdlane(k, i) * dlt; o += rdlane(q, i) * S[i]; }
        const float ms = wave_sum(o * o) * (1.f / 64.f);
        const float yv = o * rsqrtf(ms + EPS) * siluf_(zv) * mg;
        y[row * 1024 + 768 + h * 64 + lane] = f2bf(yv);
    }
}
__device__ __forceinline__ void fox_cumsum(const float* __restrict__ gates, const float* __restrict__ fb, float* __restrict__ cc, int bh, int lane) {
    const int b = bh >> 2, h = bh & 3;
    const float bias = fb[h];
    float v[32];
#pragma unroll
    for (int i = 0; i < 32; ++i) v[i] = gates[(size_t)(b * SEQ + lane * 32 + i) * 16 + h];
    float run = 0.f;
#pragma unroll
    for (int i = 0; i < 32; ++i) { run += logsigmoidf_(v[i] + bias); v[i] = run; }
    float tot = run;
#pragma unroll
    for (int o = 1; o < 64; o <<= 1) { const float nb = __shfl_up(tot, o); if (lane >= o) tot += nb; }
    const float off = tot - run;
    float* dst = cc + (size_t)(b * 4 + h) * SEQ + lane * 32;
#pragma unroll
    for (int i = 0; i < 32; i += 4) *(f32x4*)(dst + i) = (f32x4){v[i] + off, v[i + 1] + off, v[i + 2] + off, v[i + 3] + off};
}
__device__ __forceinline__ void lru_prep_task(float* xc  , const bf16_t* __restrict__ proj, const float* __restrict__ conv_w, const float* __restrict__ conv_b,
                                              const float* __restrict__ w_a, const float* __restrict__ b_a, const float* __restrict__ w_x, const float* __restrict__ b_x,
                                              const float* __restrict__ lam, float* __restrict__ a_out, float* __restrict__ u_out, int task, bool active) {
    const int c = TIDX & 255, t0 = task * 16;
    if (active) {
        const float w0 = conv_w[c], w1 = conv_w[256 + c], w2 = conv_w[512 + c], w3 = conv_w[768 + c], cb = conv_b[c];
        for (int i = 0; i < 16; ++i) {
            const int t = t0 + i, s = t & (SEQ - 1);
            const bf16_t* pr = proj + (size_t)t * NP + C_CX + c;
            float acc = cb + w3 * bf2f(pr[0]);
            if (s >= 1) acc += w2 * bf2f(pr[-(ptrdiff_t)NP]);
            if (s >= 2) acc += w1 * bf2f(pr[-(ptrdiff_t)2 * NP]);
            if (s >= 3) acc += w0 * bf2f(pr[-(ptrdiff_t)3 * NP]);
            xc[i * 256 + c] = acc;
        }
    }
    __syncthreads();
    if (active) {
        const int h = c >> 6, jj = c & 63;
        float ra[16], rx[16];
#pragma unroll
        for (int i = 0; i < 16; ++i) { ra[i] = 0.f; rx[i] = 0.f; }
        for (int k = 0; k < 64; ++k) {
            const float wa = w_a[(h * 64 + k) * 64 + jj], wx = w_x[(h * 64 + k) * 64 + jj];
#pragma unroll
            for (int i = 0; i < 16; ++i) { const float xv = xc[i * 256 + h * 64 + k]; ra[i] += xv * wa; rx[i] += xv * wx; }
        }
        const float ba = b_a[c], bx = b_x[c], sp = softplusf_(-lam[c]);
#pragma unroll
        for (int i = 0; i < 16; ++i) {
            const float r = sigmoidf_(ra[i] + ba), ig = sigmoidf_(rx[i] + bx);
            const float log_a = -8.f * r * sp;
            const float a = __expf(log_a);
            const float u = sqrtf(-expm1f(2.f * log_a)) * (ig * xc[i * 256 + c]);
            a_out[(size_t)(t0 + i) * 256 + c] = a; u_out[(size_t)(t0 + i) * 256 + c] = u;
        }
    }
    __syncthreads();
}
__device__ __forceinline__ void lru_scan_task(const float* __restrict__ a_in, const float* __restrict__ u_in, const bf16_t* __restrict__ proj, const float* __restrict__ mix_gain, bf16_t* __restrict__ y, int b) {
    const int c = TIDX;
    const float mg = mix_gain[512 + c];
    float hst = 0.f;
    for (int t = 0; t < SEQ; ++t) {
        const size_t row = (size_t)(b * SEQ + t);
        hst = a_in[row * 256 + c] * hst + u_in[row * 256 + c];
        const float yv = hst * geluf_(bf2f(proj[row * NP + C_CG + c]));
        const float ms = wave_sum(yv * yv) * (1.f / 64.f);
        y[row * 1024 + 512 + c] = f2bf(yv * rsqrtf(ms + EPS) * mg);
    }
}

typedef short s16x4 __attribute__((ext_vector_type(4)));
#define LDS_AS __attribute__((address_space(3)))
__device__ __forceinline__ bf16x8 frag_rm(const bf16_t* tile, int ld, int r0, int k0, int lane) { return *(const bf16x8*)(tile + (r0 + (lane & 15)) * ld + k0 + (lane >> 4) * 8); }
__device__ __forceinline__ s16x4 tr4(const bf16_t* tile, int ld, int rbase, int c0, int lane) {
    const bf16_t* p = tile + (rbase + ((lane & 15) >> 2)) * ld + c0 + 4 * (lane & 3);
    return __builtin_amdgcn_ds_read_tr16_b64_v4i16((LDS_AS s16x4*)p);
}
__device__ __forceinline__ bf16x8 frag_cm(const bf16_t* tile, int ld, int k0, int c0, int lane) {
    const s16x4 lo = tr4(tile, ld, k0 + (lane >> 4) * 8, c0, lane), hi = tr4(tile, ld, k0 + (lane >> 4) * 8 + 4, c0, lane);
    return (bf16x8){lo[0], lo[1], lo[2], lo[3], hi[0], hi[1], hi[2], hi[3]};
}
#define MFMA16(a, b, c) __builtin_amdgcn_mfma_f32_16x16x32_bf16((a), (b), (c), 0, 0, 0)
constexpr int TLD = 72;


#define XB_TMO      128
#define XB_XCNT(j)  (256  + 64 * (j))
#define XB_XSUB(j)  (1280 + 64 * (j))
#define XB_XGEN(j)  (2304 + 64 * (j))
#define XB_TOP      3328
#define XB_TOPGEN   3392
#define XCD_BAR_WORDS 3456
#define XB_SPIN_CAP (1u << 18)
__device__ __forceinline__ unsigned xb_ld(unsigned* p)              { return __hip_atomic_load(p, __ATOMIC_RELAXED, __HIP_MEMORY_SCOPE_AGENT); }
__device__ __forceinline__ unsigned xb_add(unsigned* p, unsigned v) { return __hip_atomic_fetch_add(p, v, __ATOMIC_RELAXED, __HIP_MEMORY_SCOPE_AGENT); }
__device__ __forceinline__ unsigned xb_xcc_id() { return (unsigned)__builtin_amdgcn_s_getreg((3 << 11) | 20) & 0xFu; }
#define XB_SPIN(cond, bar) do { unsigned _sp = 0; while (cond) { __builtin_amdgcn_s_sleep(1); \
    if ((++_sp & 255u) == 0u) { if (xb_ld(&(bar)[XB_TMO])) break; if (_sp > XB_SPIN_CAP) { atomicAdd(&(bar)[XB_TMO], 1u); break; } } } } while (0)
struct XcdBarrier { unsigned* bar; unsigned x; volatile LDS_AS unsigned* st; };
__device__ __forceinline__ XcdBarrier xcd_barrier_post(unsigned* bar, volatile LDS_AS unsigned* st) {
    XcdBarrier b; b.bar = bar; b.x = xb_xcc_id(); b.st = st;
    if (TIDX == 0) (void)xb_add(&bar[XB_XCNT(b.x)], 1u);
    return b;
}
__device__ __forceinline__ void xcd_barrier_complete(unsigned* bar, unsigned x, unsigned& nloc, unsigned& nx) {
    const unsigned G = gridDim.x * gridDim.y * gridDim.z;
    unsigned sum, cnt, mine, sp = 0u;
    for (;;) {
        sum = 0u; cnt = 0u; mine = 0u;
#pragma unroll
        for (unsigned j = 0; j < 16; ++j) { const unsigned c = xb_ld(&bar[XB_XCNT(j)]); sum += c; cnt += (c > 0u) ? 1u : 0u; mine = (j == x) ? c : mine; }
        if (sum == G) break;
        __builtin_amdgcn_s_sleep(1);
        if ((++sp & 255u) == 0u) { if (xb_ld(&bar[XB_TMO])) break; if (sp > XB_SPIN_CAP) { atomicAdd(&bar[XB_TMO], 1u); break; } }
    }
    nloc = mine > 0u ? mine : 1u; nx = cnt > 0u ? cnt : 1u;
}
__device__ __forceinline__ void xcd_barrier(const XcdBarrier& b) {
    asm volatile("s_waitcnt vmcnt(0)" ::: "memory");
    __syncthreads();
    if (TIDX == 0) {
        unsigned* bar = b.bar;
        __builtin_amdgcn_s_waitcnt(0);
        unsigned nloc = b.st[0], nx = b.st[1];
        if (nloc == 0u) { xcd_barrier_complete(bar, b.x, nloc, nx); b.st[0] = nloc; b.st[1] = nx; }
        const unsigned old = xb_add(&bar[XB_XSUB(b.x)], 1u);
        const unsigned gen = old / nloc;
        if (old + 1u == (gen + 1u) * nloc) {
            __builtin_amdgcn_fence(__ATOMIC_RELEASE, "agent");
            asm volatile("s_waitcnt vmcnt(0)" ::: "memory");
            const unsigned og = xb_add(&bar[XB_TOP], 1u);
            const unsigned tg = og / nx;
            if (og + 1u == (tg + 1u) * nx) xb_add(&bar[XB_TOPGEN], 1u);
            else XB_SPIN(xb_ld(&bar[XB_TOPGEN]) == tg, bar);
            __builtin_amdgcn_fence(__ATOMIC_ACQUIRE, "agent");
            xb_add(&bar[XB_XGEN(b.x)], 1u);
            asm volatile("s_waitcnt vmcnt(0)" ::: "memory");
        } else {
            XB_SPIN(xb_ld(&bar[XB_XGEN(b.x)]) == gen, bar);
            __builtin_amdgcn_fence(__ATOMIC_ACQUIRE, "agent");
            asm volatile("s_waitcnt vmcnt(0)" ::: "memory");
        }
    }
    __syncthreads();
}

template <bool MASK, int NS>
__device__ __forceinline__ void attn_compute_t(const bf16_t* cK, const bf16_t* cV, const float* cC, const bf16x8 (&qf)[2], f32x4 (&oacc)[4], float& mrun, float& lrun,
                                               float ct2, float scale2, int key0, int tq, int lane, int g) {
    f32x4 sacc[4 * NS];
#pragma unroll
    for (int n = 0; n < 4 * NS; ++n) {
        sacc[n] = (f32x4){0.f, 0.f, 0.f, 0.f};
#pragma unroll
        for (int kk = 0; kk < 2; ++kk) sacc[n] = MFMA16(frag_rm(cK, TLD, n * 16, kk * 32, lane), qf[kk], sacc[n]);
    }
    float mx = -INFINITY;
#pragma unroll
    for (int n = 0; n < 4 * NS; ++n) {
        const f32x4 cs = *(const f32x4*)(cC + n * 16 + 4 * g);
#pragma unroll
        for (int r = 0; r < 4; ++r) {
            float v = sacc[n][r] * scale2 + (ct2 - cs[r]);
            if (MASK) { if (key0 + n * 16 + 4 * g + r > tq) v = -INFINITY; }
            sacc[n][r] = v; mx = fmaxf(mx, v);
        }
    }
    mx = fmaxf(mx, __shfl_xor(mx, 16)); mx = fmaxf(mx, __shfl_xor(mx, 32));
    const float mnew = fmaxf(mrun, mx);
    const float corr = __builtin_amdgcn_exp2f(mrun - mnew);
    float rs = 0.f;
#pragma unroll
    for (int n = 0; n < 4 * NS; ++n)
#pragma unroll
        for (int r = 0; r < 4; ++r) { const float p = __builtin_amdgcn_exp2f(sacc[n][r] - mnew); sacc[n][r] = p; rs += p; }
    rs += __shfl_xor(rs, 16); rs += __shfl_xor(rs, 32);
    lrun = lrun * corr + rs; mrun = mnew;
    bf16x8 pf[2 * NS];
#pragma unroll
    for (int kk = 0; kk < 2 * NS; ++kk) {
        const u32x4 pk = (u32x4){pk2(sacc[2 * kk][0], sacc[2 * kk][1]), pk2(sacc[2 * kk][2], sacc[2 * kk][3]), pk2(sacc[2 * kk + 1][0], sacc[2 * kk + 1][1]), pk2(sacc[2 * kk + 1][2], sacc[2 * kk + 1][3])};
        pf[kk] = __builtin_bit_cast(bf16x8, pk);
    }
#pragma unroll
    for (int n2 = 0; n2 < 4; ++n2) {
        oacc[n2] = oacc[n2] * corr;
#pragma unroll
        for (int kk = 0; kk < 2 * NS; ++kk) {
            const s16x4 lo = tr4(cV, TLD, (2 * kk) * 16 + 4 * g, n2 * 16, lane), hi = tr4(cV, TLD, (2 * kk + 1) * 16 + 4 * g, n2 * 16, lane);
            const bf16x8 vf = (bf16x8){lo[0], lo[1], lo[2], lo[3], hi[0], hi[1], hi[2], hi[3]};
            oacc[n2] = MFMA16(vf, pf[kk], oacc[n2]);
        }
    }
}
__device__ __forceinline__ void attn_compute(const bf16_t* cK, const bf16_t* cV, const float* cC, const bf16x8 (&qf)[2], f32x4 (&oacc)[4], float& mrun, float& lrun,
                                             float ct2, float scale2, int causal, int key0, int r0, int tq, int lane, int g) {
    if (!causal || key0 + 127 <= r0) { attn_compute_t<false, 2>(cK, cV, cC, qf, oacc, mrun, lrun, ct2, scale2, key0, tq, lane, g); return; }
    if (key0 > r0 + 15) return;
    if (key0 + 64 > r0 + 15) attn_compute_t<true, 1>(cK, cV, cC, qf, oacc, mrun, lrun, ct2, scale2, key0, tq, lane, g);
    else attn_compute_t<true, 2>(cK, cV, cC, qf, oacc, mrun, lrun, ct2, scale2, key0, tq, lane, g);
}

__device__ __forceinline__ void attn_task(char* smem, const bf16_t* __restrict__ Q, int ldq, const bf16_t* __restrict__ Kp, int ldk, const bf16_t* __restrict__ Vp, int ldv, const float* __restrict__ bias,
                                          int nq_per_b, int nk_per_b, int causal, float scale, bf16_t* __restrict__ O, int ldo, const float* __restrict__ gain, int rms, int task) {
    constexpr int KT = 128;
    bf16_t* sK = (bf16_t*)smem;
    bf16_t* sV = sK + 2 * KT * TLD;
    float* sC = (float*)(sV + 2 * KT * TLD);
    const int tid = TIDX, lane = tid & 63, wave = tid >> 6, g = lane >> 4, li = lane & 15;
    const int nqt = nq_per_b / 128;
    const int qt = task % nqt, h = (task / nqt) & 3, b = task / (nqt * 4);
    const int q0 = qt * 128, r0 = q0 + wave * 16, tq = r0 + li;
    const size_t qrow = (size_t)b * nq_per_b + tq;
    bf16x8 qf[2];
#pragma unroll
    for (int kk = 0; kk < 2; ++kk) qf[kk] = *(const bf16x8*)(Q + qrow * ldq + h * 64 + kk * 32 + g * 8);
    constexpr float LOG2E = 1.4426950408889634f;
    const float ct = bias ? bias[(size_t)(b * 4 + h) * nq_per_b + tq] * LOG2E : 0.f;
    const float scale2 = scale * LOG2E;
    const int nkt = causal ? (q0 + 128) / KT : nk_per_b / KT;
    const int sr = tid >> 3, sc = tid & 7;
    const bf16_t* kg = Kp + ((size_t)b * nk_per_b + sr) * ldk + h * 64 + sc * 8;
    const bf16_t* vg = Vp + ((size_t)b * nk_per_b + sr) * ldv + h * 64 + sc * 8;
    const float* cg_ = bias ? bias + (size_t)(b * 4 + h) * nk_per_b : nullptr;
    u32x4 rkA[2], rvA[2], rkB[2], rvB[2]; float rcA = 0.f, rcB = 0.f;
#define AT_LOAD(RK, RV, RC, kt) { _Pragma("unroll") for (int i = 0; i < 2; ++i) { RK[i] = *(const u32x4*)(kg + (size_t)((kt) * KT + i * 64) * ldk); RV[i] = *(const u32x4*)(vg + (size_t)((kt) * KT + i * 64) * ldv); } \
        RC = (cg_ && tid < KT) ? cg_[(kt) * KT + tid] * LOG2E : 0.f; }
#define AT_STORE(RK, RV, RC, buf) { _Pragma("unroll") for (int i = 0; i < 2; ++i) { *(u32x4*)(sK + ((buf) * KT + sr + i * 64) * TLD + sc * 8) = RK[i]; *(u32x4*)(sV + ((buf) * KT + sr + i * 64) * TLD + sc * 8) = RV[i]; } \
        if (tid < KT) sC[(buf) * KT + tid] = RC; }
#define AT_COMPUTE(buf, kt) attn_compute(sK + (buf) * KT * TLD, sV + (buf) * KT * TLD, sC + (buf) * KT, qf, oacc, mrun, lrun, ct, scale2, causal, (kt) * KT, r0, tq, lane, g)
    AT_LOAD(rkA, rvA, rcA, 0)
    if (nkt > 1) AT_LOAD(rkB, rvB, rcB, 1)
    __syncthreads();
    AT_STORE(rkA, rvA, rcA, 0)
    __syncthreads();
    f32x4 oacc[4];
#pragma unroll
    for (int n = 0; n < 4; ++n) oacc[n] = (f32x4){0.f, 0.f, 0.f, 0.f};
    float mrun = -INFINITY, lrun = 0.f;
    for (int kt = 0; kt < nkt; kt += 2) {
        if (kt + 2 < nkt) AT_LOAD(rkA, rvA, rcA, kt + 2)
        AT_COMPUTE(0, kt);
        if (kt + 1 < nkt) AT_STORE(rkB, rvB, rcB, 1)
        __syncthreads();
        if (kt + 1 < nkt) {
            if (kt + 3 < nkt) AT_LOAD(rkB, rvB, rcB, kt + 3)
            AT_COMPUTE(1, kt + 1);
            if (kt + 2 < nkt) AT_STORE(rkA, rvA, rcA, 0)
            __syncthreads();
        }
    }
#undef AT_LOAD
#undef AT_STORE
#undef AT_COMPUTE
    const float inv = 1.f / lrun;
    float ms = 0.f;
#pragma unroll
    for (int n = 0; n < 4; ++n) { oacc[n] = oacc[n] * inv; ms += oacc[n][0] * oacc[n][0] + oacc[n][1] * oacc[n][1] + oacc[n][2] * oacc[n][2] + oacc[n][3] * oacc[n][3]; }
    ms += __shfl_xor(ms, 16); ms += __shfl_xor(ms, 32);
    const float rinv = rms ? rsqrtf(ms * (1.f / 64.f) + EPS) : 1.f;
#pragma unroll
    for (int n = 0; n < 4; ++n) {
        const int d = n * 16 + 4 * g;
        f32x4 gg = (f32x4){1.f, 1.f, 1.f, 1.f};
        if (gain) gg = *(const f32x4*)(gain + h * 64 + d);
        uint2 o; o.x = pk2(oacc[n][0] * rinv * gg[0], oacc[n][1] * rinv * gg[1]); o.y = pk2(oacc[n][2] * rinv * gg[2], oacc[n][3] * rinv * gg[3]);
        *(uint2*)(O + qrow * ldo + h * 64 + d) = o;
    }
}


__device__ __forceinline__ void hgrn_scan(float* LF  , float* SEGT  , const bf16_t* __restrict__ prow  , const float* __restrict__ hgrn_lb, int layer, int h, float (&kk)[8]) {
    const int tid = TIDX, t = tid >> 3, k8 = (tid & 7) * 8;
    const u32x4 raw = *(const u32x4*)(prow + (size_t)t * NP + C_AF + k8);
#pragma unroll
    for (int j = 0; j < 8; ++j) {
        const float fl = __uint_as_float((j & 1) ? (raw[j >> 1] & 0xffff0000u) : (raw[j >> 1] << 16));
        float lbk = 0.f;
        if (layer == 1) { const float a0 = hgrn_lb[h * 64 + k8 + j], a1 = hgrn_lb[256 + h * 64 + k8 + j]; lbk = 1.f / (1.f + __expf(a0 - a1)); }
        const float sg = sigmoidf_(fl);
        const float f = lbk + (1.f - lbk) * sg;
        kk[j] = (1.f - lbk) * (1.f - sg);
        LF[t * 65 + k8 + j] = __logf(f);
    }
    __syncthreads();
    { const int k = tid & 63, seg = tid >> 6; float run = 0.f;
#pragma unroll
      for (int i = 0; i < 8; ++i) { run += LF[(seg * 8 + i) * 65 + k]; LF[(seg * 8 + i) * 65 + k] = run; }
      SEGT[seg * 64 + k] = run; }
    __syncthreads();
    { const int k = tid & 63, seg = tid >> 6; float off = 0.f;
      for (int s2 = 0; s2 < seg; ++s2) off += SEGT[s2 * 64 + k];
#pragma unroll
      for (int i = 0; i < 8; ++i) LF[(seg * 8 + i) * 65 + k] += off; }
    __syncthreads();
}
__device__ __forceinline__ float bfx(const u32x4& raw, int j) { return __uint_as_float((j & 1) ? (raw[j >> 1] & 0xffff0000u) : (raw[j >> 1] << 16)); }

__device__ __forceinline__ void hgrn_local_task(char* smem, const bf16_t* __restrict__ proj, const float* __restrict__ hgrn_lb, int layer, float* __restrict__ HL, float* __restrict__ HD, int ch) {
    float* LF = (float*)smem; float* SEGT = LF + 64 * 65;
    bf16_t* sKd = (bf16_t*)(SEGT + 8 * 64); bf16_t* sV = sKd + 64 * TLD;
    const int tid = TIDX, lane = tid & 63, wave = tid >> 6, g = lane >> 4, li = lane & 15;
    const int bh = ch >> 5, n = ch & 31, b = bh >> 2, h = bh & 3;
    const bf16_t* prow = proj + (size_t)(b * SEQ + n * 64) * NP + h * 64;
    const int t = tid >> 3, k8 = (tid & 7) * 8;
    __syncthreads();
    *(u32x4*)(sV + t * TLD + k8) = *(const u32x4*)(prow + (size_t)t * NP + C_AI + k8);
    float kk[8];
    hgrn_scan(LF, SEGT, prow, hgrn_lb, layer, h, kk);
    { u32x4 o;
#pragma unroll
      for (int j = 0; j < 8; j += 2) {
          const float e0 = kk[j] * __expf(LF[63 * 65 + k8 + j] - LF[t * 65 + k8 + j]), e1 = kk[j + 1] * __expf(LF[63 * 65 + k8 + j + 1] - LF[t * 65 + k8 + j + 1]);
          o[j >> 1] = pk2(e0, e1);
      }
      *(u32x4*)(sKd + t * TLD + k8) = o; }
    if (tid < 64) HD[(size_t)ch * 64 + tid] = __expf(LF[63 * 65 + tid]);
    __syncthreads();
#pragma unroll
    for (int i = 0; i < 2; ++i) {
        const int idx = wave * 2 + i, vt = idx >> 2, kt = idx & 3;
        f32x4 acc = (f32x4){0.f, 0.f, 0.f, 0.f};
#pragma unroll
        for (int ks = 0; ks < 2; ++ks) acc = MFMA16(frag_cm(sV, TLD, ks * 32, vt * 16, lane), frag_cm(sKd, TLD, ks * 32, kt * 16, lane), acc);
        *(f32x4*)(HL + (size_t)ch * 4096 + (kt * 16 + li) * 64 + vt * 16 + 4 * g) = acc;
    }
}

__device__ __forceinline__ void hgrn_out_task(char* smem, const bf16_t* __restrict__ proj, const float* __restrict__ hgrn_lb, int layer, const bf16_t* __restrict__ HS,
                                              const float* __restrict__ mix_gain, bf16_t* __restrict__ y, int ch) {
    float* LF = (float*)smem; float* SEGT = LF + 64 * 65; float* sMS = SEGT + 8 * 64;
    bf16_t* sST = (bf16_t*)(sMS + 128); bf16_t* sQ0 = sST + 64 * TLD; bf16_t* sQm = sQ0 + 64 * TLD; bf16_t* sKm = sQm + 64 * TLD; bf16_t* sV = sKm + 64 * TLD; bf16_t* sA = sV + 64 * TLD;
    const int tid = TIDX, lane = tid & 63, wave = tid >> 6, g = lane >> 4, li = lane & 15;
    const int bh = ch >> 5, n = ch & 31, b = bh >> 2, h = bh & 3;
    const bf16_t* prow = proj + (size_t)(b * SEQ + n * 64) * NP + h * 64;
    const int t = tid >> 3, k8 = (tid & 7) * 8;
    __syncthreads();
    *(u32x4*)(sST + t * TLD + k8) = *(const u32x4*)(HS + (size_t)ch * 4096 + t * 64 + k8);
    const u32x4 qraw = *(const u32x4*)(prow + (size_t)t * NP + C_AQ + k8);
    *(u32x4*)(sV + t * TLD + k8) = *(const u32x4*)(prow + (size_t)t * NP + C_AI + k8);
    float kk[8];
    hgrn_scan(LF, SEGT, prow, hgrn_lb, layer, h, kk);
    { u32x4 o0, om, ok;
#pragma unroll
      for (int j = 0; j < 8; j += 2) {
          float q0v[2], qmv[2], kmv[2];
#pragma unroll
          for (int e = 0; e < 2; ++e) {
              const float bt = LF[t * 65 + k8 + j + e], r = LF[31 * 65 + k8 + j + e], q = siluf_(bfx(qraw, j + e));
              q0v[e] = q * __expf(bt); qmv[e] = q * __expf(bt - r); kmv[e] = kk[j + e] * __expf(r - bt);
          }
          o0[j >> 1] = pk2(q0v[0], q0v[1]); om[j >> 1] = pk2(qmv[0], qmv[1]); ok[j >> 1] = pk2(kmv[0], kmv[1]);
      }
      *(u32x4*)(sQ0 + t * TLD + k8) = o0; *(u32x4*)(sQm + t * TLD + k8) = om; *(u32x4*)(sKm + t * TLD + k8) = ok; }
    __syncthreads();
#pragma unroll
    for (int i = 0; i < 2; ++i) {
        const int idx = wave * 2 + i, tt = idx >> 2, st = idx & 3;
        f32x4 acc = (f32x4){0.f, 0.f, 0.f, 0.f};
#pragma unroll
        for (int ks = 0; ks < 2; ++ks) acc = MFMA16(frag_rm(sKm, TLD, st * 16, ks * 32, lane), frag_rm(sQm, TLD, tt * 16, ks * 32, lane), acc);
        const int tq = tt * 16 + li, s0 = st * 16 + 4 * g;
        uint2 o; o.x = pk2(s0 <= tq ? acc[0] : 0.f, s0 + 1 <= tq ? acc[1] : 0.f); o.y = pk2(s0 + 2 <= tq ? acc[2] : 0.f, s0 + 3 <= tq ? acc[3] : 0.f);
        *(uint2*)(sA + tq * TLD + s0) = o;
    }
    __syncthreads();
    { const int tt = wave >> 1;
      f32x4 oacc[2]; float ms = 0.f;
#pragma unroll
      for (int i = 0; i < 2; ++i) {
          const int vt = (wave & 1) * 2 + i;
          f32x4 acc = (f32x4){0.f, 0.f, 0.f, 0.f};
#pragma unroll
          for (int ks = 0; ks < 2; ++ks) acc = MFMA16(frag_cm(sST, TLD, ks * 32, vt * 16, lane), frag_rm(sQ0, TLD, tt * 16, ks * 32, lane), acc);
#pragma unroll
          for (int ks = 0; ks < 2; ++ks) acc = MFMA16(frag_cm(sV, TLD, ks * 32, vt * 16, lane), frag_rm(sA, TLD, tt * 16, ks * 32, lane), acc);
          oacc[i] = acc; ms += acc[0] * acc[0] + acc[1] * acc[1] + acc[2] * acc[2] + acc[3] * acc[3];
      }
      ms += __shfl_xor(ms, 16); ms += __shfl_xor(ms, 32);
      if (g == 0) sMS[(tt * 16 + li) * 2 + (wave & 1)] = ms;
      __syncthreads();
      const int tq = tt * 16 + li;
      const float rinv = rsqrtf((sMS[tq * 2] + sMS[tq * 2 + 1]) * (1.f / 64.f) + EPS);
      const size_t row = (size_t)(b * SEQ + n * 64 + tq);
#pragma unroll
      for (int i = 0; i < 2; ++i) {
          const int v0 = ((wave & 1) * 2 + i) * 16 + 4 * g;
          const uint2 graw = *(const uint2*)(proj + row * NP + C_AG + h * 64 + v0);
          const f32x4 mgv = *(const f32x4*)(mix_gain + C_AQ + h * 64 + v0);
          const float g0 = __uint_as_float(graw.x << 16), g1 = __uint_as_float(graw.x & 0xffff0000u), g2 = __uint_as_float(graw.y << 16), g3 = __uint_as_float(graw.y & 0xffff0000u);
          uint2 o; o.x = pk2(oacc[i][0] * rinv * siluf_(g0) * mgv[0], oacc[i][1] * rinv * siluf_(g1) * mgv[1]);
          o.y = pk2(oacc[i][2] * rinv * siluf_(g2) * mgv[2], oacc[i][3] * rinv * siluf_(g3) * mgv[3]);
          *(uint2*)(y + row * 1024 + h * 64 + v0) = o;
      }
    }
}


constexpr int GP_BYTES = (128 + 64 * 132 + 64 * 68) * 4 + 2 * 64 * TLD * 2;
__device__ __forceinline__ void gdn_prep_pair(char* smem, const bf16_t* __restrict__ proj, const float* __restrict__ gates, const float* __restrict__ conv_w  ,
                                              const float* __restrict__ a_log, const float* __restrict__ dt_bias, bf16_t* __restrict__ gt_all, float* __restrict__ glast, int ch0) {
#define GP_SG(sub) ((float*)(smem + (sub) * GP_BYTES))
#define GP_SBETA(sub) (GP_SG(sub) + 64)
#define GP_RHS(sub) (GP_SG(sub) + 128)
#define GP_SM(sub) (GP_RHS(sub) + 64 * 132)
#define GP_SK(sub) ((bf16_t*)(GP_SM(sub) + 64 * 68))
#define GP_SQ(sub) (GP_SK(sub) + 64 * TLD)
    const int tid = TIDX, lane = tid & 63, wave = tid >> 6, g = lane >> 4, li = lane & 15;
    const int bh = ch0 >> 5, n0 = ch0 & 31, b = bh >> 2, h = bh & 3;
    const int t = tid >> 3, d8 = (tid & 7) * 8;
    __syncthreads();
    float qn[2][8], kn[2][8], vv[2][8];
#pragma unroll
    for (int sub = 0; sub < 2; ++sub) {
        const int n = n0 + sub; const size_t row0 = (size_t)(b * SEQ + n * 64);
        const int spos = n * 64 + t;
#pragma unroll
        for (int sec = 0; sec < 3; ++sec) {
            const int col = (sec == 0 ? C_DQ : (sec == 1 ? C_DK : C_DV)) + h * 64 + d8;
            float acc[8];
#pragma unroll
            for (int e = 0; e < 8; ++e) acc[e] = 0.f;
#pragma unroll
            for (int j = 0; j < 4; ++j) {
                if (spos - (3 - j) >= 0) {
                    const u32x4 raw = *(const u32x4*)(proj + (row0 + t - (3 - j)) * NP + col);
                    const f32x4 w0 = *(const f32x4*)(conv_w + j * 768 + sec * 256 + h * 64 + d8), w1 = *(const f32x4*)(conv_w + j * 768 + sec * 256 + h * 64 + d8 + 4);
#pragma unroll
                    for (int e = 0; e < 8; ++e) acc[e] += (e < 4 ? w0[e] : w1[e - 4]) * bfx(raw, e);
                }
            }
#pragma unroll
            for (int e = 0; e < 8; ++e) { const float sv = siluf_(acc[e]); if (sec == 0) qn[sub][e] = sv; else if (sec == 1) kn[sub][e] = sv; else vv[sub][e] = sv; }
        }
        float sq = 0.f, sk = 0.f;
#pragma unroll
        for (int e = 0; e < 8; ++e) { sq += qn[sub][e] * qn[sub][e]; sk += kn[sub][e] * kn[sub][e]; }
        sq += __shfl_xor(sq, 1); sq += __shfl_xor(sq, 2); sq += __shfl_xor(sq, 4);
        sk += __shfl_xor(sk, 1); sk += __shfl_xor(sk, 2); sk += __shfl_xor(sk, 4);
        const float rq = rsqrtf(sq + EPS) * 0.125f, rk = rsqrtf(sk + EPS);
#pragma unroll
        for (int e = 0; e < 8; ++e) { qn[sub][e] *= rq; kn[sub][e] *= rk; }
        if ((tid & 7) == 0) {
            const float* gr = gates + (row0 + t) * 16;
            GP_SBETA(sub)[t] = sigmoidf_(gr[4 + h]);
            GP_SG(sub)[t] = -__expf(a_log[h]) * softplusf_(gr[8 + h] + dt_bias[h]);
        }
    }
    __syncthreads();
    if (wave < 2) {
        float* sG = GP_SG(wave);
        float v = sG[lane];
#pragma unroll
        for (int o = 1; o < 64; o <<= 1) { const float nb = __shfl_up(v, o); if (lane >= o) v += nb; }
        sG[lane] = v;
    }
    __syncthreads();
#pragma unroll
    for (int sub = 0; sub < 2; ++sub) {
        const int ch = ch0 + sub; bf16_t* gt = gt_all + (size_t)ch * 5 * 4096;
        float* sG = GP_SG(sub); float* RHS = GP_RHS(sub);
        const float Gt = sG[t], Gl = sG[63], bt = GP_SBETA(sub)[t];
        const float eG = __expf(Gt), eD = __expf(Gl - Gt);
        u32x4 ok, oq, oqd, okd;
#pragma unroll
        for (int e = 0; e < 8; e += 2) {
            ok[e >> 1] = pk2(kn[sub][e], kn[sub][e + 1]); oq[e >> 1] = pk2(qn[sub][e], qn[sub][e + 1]);
            oqd[e >> 1] = pk2(qn[sub][e] * eG, qn[sub][e + 1] * eG); okd[e >> 1] = pk2(kn[sub][e] * eD, kn[sub][e + 1] * eD);
        }
        *(u32x4*)(GP_SK(sub) + t * TLD + d8) = ok; *(u32x4*)(GP_SQ(sub) + t * TLD + d8) = oq;
        *(u32x4*)(gt + 2 * 4096 + t * 64 + d8) = oqd; *(u32x4*)(gt + 3 * 4096 + t * 64 + d8) = okd;
#pragma unroll
        for (int e = 0; e < 8; ++e) { RHS[t * 132 + d8 + e] = vv[sub][e] * bt; RHS[t * 132 + 64 + d8 + e] = kn[sub][e] * bt * eG; }
        if (tid == 0) glast[ch] = __expf(Gl);
    }
    __syncthreads();
#pragma unroll
    for (int i = 0; i < 4; ++i) {
        const int idx = wave * 4 + i, sub = idx >> 4, tt = (idx >> 2) & 3, st = idx & 3;
        const bf16_t* sK = GP_SK(sub); const bf16_t* sQ = GP_SQ(sub); const float* sG = GP_SG(sub); const float* sBeta = GP_SBETA(sub); float* sM = GP_SM(sub);
        bf16_t* gt = gt_all + (size_t)(ch0 + sub) * 5 * 4096;
        f32x4 am = (f32x4){0.f, 0.f, 0.f, 0.f}, aq = (f32x4){0.f, 0.f, 0.f, 0.f};
#pragma unroll
        for (int ks = 0; ks < 2; ++ks) {
            const bf16x8 kfs = frag_rm(sK, TLD, st * 16, ks * 32, lane), kft = frag_rm(sK, TLD, tt * 16, ks * 32, lane);
            am = MFMA16(kft, kfs, am);
            aq = MFMA16(kfs, frag_rm(sQ, TLD, tt * 16, ks * 32, lane), aq);
        }
        {   const int sx = st * 16 + li, t0 = tt * 16 + 4 * g; const float Gs = sG[sx];
            f32x4 mo;
#pragma unroll
            for (int r = 0; r < 4; ++r) { const int tq = t0 + r; mo[r] = (sx < tq) ? sBeta[tq] * am[r] * __expf(sG[tq] - Gs) : 0.f; }
            *(f32x4*)(sM + sx * 68 + t0) = mo; }
        {   const int tq = tt * 16 + li, s0 = st * 16 + 4 * g; const float Gt = sG[tq];
            float ao[4];
#pragma unroll
            for (int r = 0; r < 4; ++r) { const int sx = s0 + r; ao[r] = (sx <= tq) ? aq[r] * __expf(Gt - sG[sx]) : 0.f; }
            uint2 o; o.x = pk2(ao[0], ao[1]); o.y = pk2(ao[2], ao[3]);
            *(uint2*)(gt + 4 * 4096 + tq * 64 + s0) = o; }
    }
    __syncthreads();
    if (tid < 256) {
        const int sub = tid >> 7, col = tid & 127;
        const float* RHS = GP_RHS(sub); const float* sM = GP_SM(sub);
        bf16_t* gt = gt_all + (size_t)(ch0 + sub) * 5 * 4096;
        float acc[64];
#pragma unroll
        for (int i = 0; i < 64; ++i) acc[i] = RHS[i * 132 + col];
#pragma unroll
        for (int half = 0; half < 2; ++half) {
            const int base = half * 32;
            if (half == 1) {
#pragma unroll
                for (int sx = 0; sx < 32; sx += 2) {
                    f32x4 r0[8], r1[8];
#pragma unroll
                    for (int c = 0; c < 8; ++c) { r0[c] = *(const f32x4*)(sM + sx * 68 + 32 + c * 4); r1[c] = *(const f32x4*)(sM + (sx + 1) * 68 + 32 + c * 4); }
                    const float x0 = acc[sx], x1 = acc[sx + 1];
#pragma unroll
                    for (int tq = 0; tq < 32; ++tq) { acc[32 + tq] -= r0[tq >> 2][tq & 3] * x0; acc[32 + tq] -= r1[tq >> 2][tq & 3] * x1; }
                }
            }
            f32x4 cur[8];
#pragma unroll
            for (int c = 0; c < 8; ++c) cur[c] = *(const f32x4*)(sM + base * 68 + base + c * 4);
#pragma unroll
            for (int sx = 0; sx < 31; ++sx) {
                f32x4 nxt[8];
#pragma unroll
                for (int c = (sx + 2) >> 2; c < 8; ++c) nxt[c] = *(const f32x4*)(sM + (base + sx + 1) * 68 + base + c * 4);
                const float xs = acc[base + sx];
#pragma unroll
                for (int tq = sx + 1; tq < 32; ++tq) acc[base + tq] -= cur[tq >> 2][tq & 3] * xs;
#pragma unroll
                for (int c = (sx + 2) >> 2; c < 8; ++c) cur[c] = nxt[c];
            }
        }
        if (col < 64) {
#pragma unroll
            for (int tt = 0; tt < 64; ++tt) gt[tt * 64 + col] = f2bf(acc[tt]);
        } else {
#pragma unroll
            for (int tt = 0; tt < 64; ++tt) gt[4096 + tt * 64 + (col - 64)] = f2bf(-acc[tt]);
        }
    }
#undef GP_SG
#undef GP_SBETA
#undef GP_RHS
#undef GP_SM
#undef GP_SK
#undef GP_SQ
}

__device__ __forceinline__ void gdn_scan_step(bf16_t* sT, bf16_t* sST, bf16_t* sVn, f32x4 (&sacc)[4], const uint2 (&zraw)[4], float glv, const float* __restrict__ mix_gain,
                                              bf16_t* __restrict__ y, int bh, int n, int tid) {
    const int lane = tid & 63, wave = tid >> 6, g = lane >> 4, li = lane & 15;
    const int b = bh >> 2, h = bh & 3;
    const int buf = n & 1;
        const bf16_t* cT = sT + buf * 5 * 64 * TLD;
        const bf16_t* sU = cT; const bf16_t* sWn = cT + 64 * TLD; const bf16_t* sQd = cT + 2 * 64 * TLD; const bf16_t* sKd = cT + 3 * 64 * TLD; const bf16_t* sAq = cT + 4 * 64 * TLD;
        const bf16_t* cST = sST + buf * 64 * TLD; bf16_t* nST = sST + (buf ^ 1) * 64 * TLD;
        const size_t rowz = (size_t)(b * SEQ + n * 64 + (wave & 3) * 16 + li);
#pragma unroll
        for (int i = 0; i < 2; ++i) {
            const int idx = wave * 2 + i, tt = idx >> 2, vt = idx & 3;
            const int tq = tt * 16 + li, v0 = vt * 16 + 4 * g;
            const uint2 uraw = *(const uint2*)(sU + tq * TLD + v0);
            f32x4 acc = (f32x4){__uint_as_float(uraw.x << 16), __uint_as_float(uraw.x & 0xffff0000u), __uint_as_float(uraw.y << 16), __uint_as_float(uraw.y & 0xffff0000u)};
#pragma unroll
            for (int ks = 0; ks < 2; ++ks) acc = MFMA16(frag_rm(cST, TLD, vt * 16, ks * 32, lane), frag_rm(sWn, TLD, tt * 16, ks * 32, lane), acc);
            uint2 o; o.x = pk2(acc[0], acc[1]); o.y = pk2(acc[2], acc[3]);
            *(uint2*)(sVn + tq * TLD + v0) = o;
        }
        __syncthreads();
        if (wave < 4) {
            const int tt = wave;
            f32x4 oacc[4]; float ms = 0.f;
#pragma unroll
            for (int vt = 0; vt < 4; ++vt) {
                f32x4 acc = (f32x4){0.f, 0.f, 0.f, 0.f};
#pragma unroll
                for (int ks = 0; ks < 2; ++ks) acc = MFMA16(frag_rm(cST, TLD, vt * 16, ks * 32, lane), frag_rm(sQd, TLD, tt * 16, ks * 32, lane), acc);
#pragma unroll
                for (int ks = 0; ks < 2; ++ks) acc = MFMA16(frag_cm(sVn, TLD, ks * 32, vt * 16, lane), frag_rm(sAq, TLD, tt * 16, ks * 32, lane), acc);
                oacc[vt] = acc; ms += acc[0] * acc[0] + acc[1] * acc[1] + acc[2] * acc[2] + acc[3] * acc[3];
            }
            ms += __shfl_xor(ms, 16); ms += __shfl_xor(ms, 32);
            const float rinv = rsqrtf(ms * (1.f / 64.f) + EPS);
#pragma unroll
            for (int vt = 0; vt < 4; ++vt) {
                const int v0 = vt * 16 + 4 * g;
                const f32x4 mgv = *(const f32x4*)(mix_gain + 768 + h * 64 + v0);
                const float z0 = __uint_as_float(zraw[vt].x << 16), z1 = __uint_as_float(zraw[vt].x & 0xffff0000u), z2 = __uint_as_float(zraw[vt].y << 16), z3 = __uint_as_float(zraw[vt].y & 0xffff0000u);
                uint2 o; o.x = pk2(oacc[vt][0] * rinv * siluf_(z0) * mgv[0], oacc[vt][1] * rinv * siluf_(z1) * mgv[1]);
                o.y = pk2(oacc[vt][2] * rinv * siluf_(z2) * mgv[2], oacc[vt][3] * rinv * siluf_(z3) * mgv[3]);
                *(uint2*)(y + rowz * 1024 + 768 + h * 64 + v0) = o;
            }
        } else {
            const int kt = wave - 4;
            const float gl = __shfl(glv, n);
#pragma unroll
            for (int vt = 0; vt < 4; ++vt) {
                f32x4 acc = sacc[vt] * gl;
#pragma unroll
                for (int ks = 0; ks < 2; ++ks) acc = MFMA16(frag_cm(sKd, TLD, ks * 32, kt * 16, lane), frag_cm(sVn, TLD, ks * 32, vt * 16, lane), acc);
                sacc[vt] = acc;
                uint2 o; o.x = pk2(acc[0], acc[1]); o.y = pk2(acc[2], acc[3]);
                *(uint2*)(nST + (vt * 16 + li) * TLD + kt * 16 + 4 * g) = o;
            }
        }
}

__device__ __forceinline__ void gdn_scan_task(char* smem, const bf16_t* __restrict__ gt_all, const float* __restrict__ glast, const bf16_t* __restrict__ proj, const float* __restrict__ mix_gain,
                                              bf16_t* __restrict__ y, int bh) {
    bf16_t* sT = (bf16_t*)smem;
    bf16_t* sST = sT + 2 * 5 * 64 * TLD;
    bf16_t* sVn = sST + 2 * 64 * TLD;
    const int tid = TIDX, lane = tid & 63, wave = tid >> 6, g = lane >> 4, li = lane & 15;
    const int b = bh >> 2, h = bh & 3;
    const int sr = tid >> 3, sc8 = (tid & 7) * 8;
    const bf16_t* gsrc = gt_all + (size_t)bh * 32 * 5 * 4096 + sr * 64 + sc8;
    __syncthreads();
    u32x4 rs0[5], rs1[5], rs2[5], rs3[5];
#define GS_LOAD(RS, n) { _Pragma("unroll") for (int i = 0; i < 5; ++i) RS[i] = *(const u32x4*)(gsrc + (size_t)(n) * 5 * 4096 + i * 4096); }
#define GS_STORE(RS, buf) { bf16_t* nT = sT + (buf) * 5 * 64 * TLD; _Pragma("unroll") for (int i = 0; i < 5; ++i) *(u32x4*)(nT + i * 64 * TLD + sr * TLD + sc8) = RS[i]; }
#define GS_ZLOAD(Z, n) { if (wave < 4) { const size_t rz = (size_t)(b * SEQ + (n) * 64 + (wave & 3) * 16 + li); _Pragma("unroll") for (int vt = 0; vt < 4; ++vt) Z[vt] = *(const uint2*)(proj + rz * NP + C_DZ + h * 64 + vt * 16 + 4 * g); } }
    GS_LOAD(rs0, 0) GS_LOAD(rs1, 1) GS_LOAD(rs2, 2) GS_LOAD(rs3, 3)
    const float glv = glast[bh * 32 + (lane & 31)];
    uint2 zraw[4], znext[4];
    GS_ZLOAD(zraw, 0)
    GS_STORE(rs0, 0)
    *(u32x4*)(sST + sr * TLD + sc8) = (u32x4){0u, 0u, 0u, 0u};
    f32x4 sacc[4];
#pragma unroll
    for (int i = 0; i < 4; ++i) sacc[i] = (f32x4){0.f, 0.f, 0.f, 0.f};
    __syncthreads();
#define GS_STEP(n, LSET, SSET) { \
        if ((n) + 4 < 32) GS_LOAD(LSET, (n) + 4) \
        if ((n) + 1 < 32) GS_ZLOAD(znext, (n) + 1) \
        gdn_scan_step(sT, sST, sVn, sacc, zraw, glv, mix_gain, y, bh, (n), tid); \
        if ((n) + 1 < 32) GS_STORE(SSET, ((n) + 1) & 1) \
        _Pragma("unroll") for (int vt = 0; vt < 4; ++vt) zraw[vt] = znext[vt]; \
        __syncthreads(); }
    for (int n = 0; n < 32; n += 4) {
        GS_STEP(n, rs0, rs1)
        GS_STEP(n + 1, rs1, rs2)
        GS_STEP(n + 2, rs2, rs3)
        GS_STEP(n + 3, rs3, rs0)
    }
#undef GS_LOAD
#undef GS_STORE
#undef GS_ZLOAD
#undef GS_STEP
}


constexpr int XLD = 264;
__device__ __forceinline__ void lru_local_task(char* smem, const bf16_t* __restrict__ proj, const float* __restrict__ conv_w, const float* __restrict__ conv_b,
                                               const float* __restrict__ w_a, const float* __restrict__ b_a, const float* __restrict__ w_x, const float* __restrict__ b_x,
                                               const float* __restrict__ lam, float* __restrict__ hl_out, float* __restrict__ ac_out, float* __restrict__ lsum, int task) {
    bf16_t* sX = (bf16_t*)smem;
    bf16_t* sW = sX + 64 * XLD;
    const int tid = TIDX, lane = tid & 63, wave = tid >> 6, g = lane >> 4, li = lane & 15;
    const int b = task >> 5, n = task & 31;
    const size_t row0 = (size_t)(b * SEQ + n * 64);
    const int t = tid >> 3;
    __syncthreads();
    {
        const int i = tid >> 3, j8 = (tid & 7) * 8;
#pragma unroll
        for (int mat = 0; mat < 8; ++mat) {
            const float* src = ((mat & 1) ? w_x : w_a) + (size_t)(mat >> 1) * 4096 + i * 64 + j8;
            const f32x4 v0 = *(const f32x4*)src, v1 = *(const f32x4*)(src + 4);
            u32x4 o; o[0] = pk2(v0[0], v0[1]); o[1] = pk2(v0[2], v0[3]); o[2] = pk2(v1[0], v1[1]); o[3] = pk2(v1[2], v1[3]);
            *(u32x4*)(sW + mat * 64 * TLD + i * TLD + j8) = o;
        }
    }
    {
        const int spos = n * 64 + t;
#pragma unroll
        for (int i = 0; i < 4; ++i) {
            const int c8 = ((tid & 7) + 8 * i) * 8;
            float acc[8];
            { const f32x4 cb0 = *(const f32x4*)(conv_b + c8), cb1 = *(const f32x4*)(conv_b + c8 + 4);
#pragma unroll
              for (int e = 0; e < 8; ++e) acc[e] = e < 4 ? cb0[e] : cb1[e - 4]; }
#pragma unroll
            for (int j = 0; j < 4; ++j) {
                if (spos - (3 - j) >= 0) {
                    const u32x4 raw = *(const u32x4*)(proj + (row0 + t - (3 - j)) * NP + C_CX + c8);
                    const f32x4 w0 = *(const f32x4*)(conv_w + j * 256 + c8), w1 = *(const f32x4*)(conv_w + j * 256 + c8 + 4);
#pragma unroll
                    for (int e = 0; e < 8; ++e) acc[e] += (e < 4 ? w0[e] : w1[e - 4]) * bfx(raw, e);
                }
            }
            u32x4 o; o[0] = pk2(acc[0], acc[1]); o[1] = pk2(acc[2], acc[3]); o[2] = pk2(acc[4], acc[5]); o[3] = pk2(acc[6], acc[7]);
            *(u32x4*)(sX + t * XLD + c8) = o;
        }
    }
    __syncthreads();
    const int hh = wave >> 1;
#pragma unroll
    for (int j2 = 0; j2 < 2; ++j2) {
        const int jt = (wave & 1) * 2 + j2, cl = jt * 16 + 4 * g, c = hh * 64 + cl;
        f32x4 ra[4], rx[4];
#pragma unroll
        for (int tt = 0; tt < 4; ++tt) { ra[tt] = (f32x4){0.f, 0.f, 0.f, 0.f}; rx[tt] = (f32x4){0.f, 0.f, 0.f, 0.f}; }
#pragma unroll
        for (int ks = 0; ks < 2; ++ks) {
            const bf16x8 wa = frag_cm(sW + (hh * 2) * 64 * TLD, TLD, ks * 32, jt * 16, lane), wx = frag_cm(sW + (hh * 2 + 1) * 64 * TLD, TLD, ks * 32, jt * 16, lane);
#pragma unroll
            for (int tt = 0; tt < 4; ++tt) {
                const bf16x8 xf = frag_rm(sX + hh * 64, XLD, tt * 16, ks * 32, lane);
                ra[tt] = MFMA16(wa, xf, ra[tt]);
                rx[tt] = MFMA16(wx, xf, rx[tt]);
            }
        }
        const f32x4 ba = *(const f32x4*)(b_a + c), bx = *(const f32x4*)(b_x + c), lm = *(const f32x4*)(lam + c);
        float sp[4];
#pragma unroll
        for (int r = 0; r < 4; ++r) sp[r] = softplusf_(-lm[r]);
        f32x4 cA = (f32x4){1.f, 1.f, 1.f, 1.f}, cH = (f32x4){0.f, 0.f, 0.f, 0.f};
#pragma unroll
        for (int tt = 0; tt < 4; ++tt) {
            const int tq = tt * 16 + li;
            const uint2 xraw = *(const uint2*)(sX + tq * XLD + c);
            const float xc[4] = {__uint_as_float(xraw.x << 16), __uint_as_float(xraw.x & 0xffff0000u), __uint_as_float(xraw.y << 16), __uint_as_float(xraw.y & 0xffff0000u)};
            f32x4 A, H;
#pragma unroll
            for (int r = 0; r < 4; ++r) {
                const float rr = sigmoidf_(ra[tt][r] + ba[r]), ig = sigmoidf_(rx[tt][r] + bx[r]);
                const float log_a = -8.f * rr * sp[r];
                A[r] = __expf(log_a);
                H[r] = sqrtf(-expm1f(2.f * log_a)) * (ig * xc[r]);
            }
#pragma unroll
            for (int o = 1; o < 16; o <<= 1) {
#pragma unroll
                for (int r = 0; r < 4; ++r) {
                    const float pA = __shfl_up(A[r], o, 16), pH = __shfl_up(H[r], o, 16);
                    if (li >= o) { H[r] = A[r] * pH + H[r]; A[r] = A[r] * pA; }
                }
            }
            const f32x4 Hf = H + A * cH, Af = A * cA;
            const size_t oidx = (row0 + tq) * 256 + c;
            *(f32x4*)(hl_out + oidx) = Hf; *(f32x4*)(ac_out + oidx) = Af;
#pragma unroll
            for (int r = 0; r < 4; ++r) { cH[r] = __shfl(Hf[r], 15, 16); cA[r] = __shfl(Af[r], 15, 16); }
            if (tt == 3 && li == 15) { *(f32x4*)(lsum + (size_t)task * 256 + c) = Af; *(f32x4*)(lsum + (size_t)(256 + task) * 256 + c) = Hf; }
        }
    }
}
__device__ __forceinline__ void lru_out_task(const float* __restrict__ hl_in, const float* __restrict__ ac_in, const float* __restrict__ lsum, const bf16_t* __restrict__ proj,
                                             const float* __restrict__ mix_gain, bf16_t* __restrict__ y, int task) {
    const int b = task >> 5, n = task & 31, c = TIDX & 255, half = TIDX >> 8;
    const float Hc = lsum[(size_t)task * 256 + c];
    const float mg = mix_gain[512 + c];
    const size_t row0 = (size_t)(b * SEQ + n * 64 + half * 32);
#pragma unroll
    for (int i0 = 0; i0 < 32; i0 += 16) {
        float hv[16], av[16]; bf16_t gv[16];
#pragma unroll
        for (int i = 0; i < 16; ++i) { const size_t row = row0 + i0 + i; hv[i] = hl_in[row * 256 + c]; av[i] = ac_in[row * 256 + c]; gv[i] = proj[row * NP + C_CG + c]; }
#pragma unroll
        for (int i = 0; i < 16; ++i) {
            const size_t row = row0 + i0 + i;
            const float yv = (hv[i] + av[i] * Hc) * geluf_(bf2f(gv[i]));
            const float ms = wave_sum(yv * yv) * (1.f / 64.f);
            y[row * 1024 + 512 + c] = f2bf(yv * rsqrtf(ms + EPS) * mg);
        }
    }
}


__device__ __forceinline__ void state_scan_phase(const float* __restrict__ HL, const float* __restrict__ HD, bf16_t* __restrict__ HS, const float* __restrict__ lsum, float* __restrict__ lcar) {
    const int bx = blockIdx.x, tid = TIDX;
    for (int u = bx; u < 128 + 4; u += gridDim.x) {
        if (u < 128) {
            const int gid = u * NTHR + tid, bh = gid >> 11, v = gid & 63, kp = (gid >> 6) & 31;
            const float* Lb = HL + (size_t)bh * 32 * 4096 + (2 * kp) * 64 + v; const float* Db = HD + (size_t)bh * 32 * 64 + 2 * kp;
            bf16_t* Sb = HS + (size_t)bh * 32 * 4096 + (2 * kp) * 64 + v;
            float S0 = 0.f, S1 = 0.f;
            for (int n0 = 0; n0 < 32; n0 += 8) {
                float l0[8], l1[8], d0[8], d1[8];
#pragma unroll
                for (int i = 0; i < 8; ++i) { l0[i] = Lb[(size_t)(n0 + i) * 4096]; l1[i] = Lb[(size_t)(n0 + i) * 4096 + 64]; d0[i] = Db[(n0 + i) * 64]; d1[i] = Db[(n0 + i) * 64 + 1]; }
#pragma unroll
                for (int i = 0; i < 8; ++i) {
                    Sb[(size_t)(n0 + i) * 4096] = f2bf(S0); Sb[(size_t)(n0 + i) * 4096 + 64] = f2bf(S1);
                    S0 = d0[i] * S0 + l0[i]; S1 = d1[i] * S1 + l1[i];
                }
            }
        } else {
            const int gid = (u - 128) * NTHR + tid, b = gid >> 8, c = gid & 255;
            float A[32], H[32];
#pragma unroll
            for (int n = 0; n < 32; ++n) { A[n] = lsum[(size_t)(b * 32 + n) * 256 + c]; H[n] = lsum[(size_t)(256 + b * 32 + n) * 256 + c]; }
            float Hc = 0.f;
#pragma unroll
            for (int n = 0; n < 32; ++n) { lcar[(size_t)(b * 32 + n) * 256 + c] = Hc; Hc = A[n] * Hc + H[n]; }
        }
    }
}


__device__ __forceinline__ void middle_task(char* smem, const bf16_t* xg1  , const float* pss_in, const bf16_t* __restrict__ Wq_t  , const bf16_t* __restrict__ kv  ,
                                            const bf16_t* __restrict__ Wmo_t  , const float* __restrict__ x1, float* __restrict__ x2, const float* __restrict__ gn, bf16_t* xg2, float* pss_out, int tile) {
    constexpr int QLD = 264;
    bf16_t* sQ = (bf16_t*)(smem + 92160);
    float* sZ = (float*)(smem + 92160 + 64 * QLD * 2);
    const int tid = TIDX, lane = tid & 63, wave = tid >> 6, g = lane >> 4, li = lane & 15;
    const int r0 = tile * 64, b = r0 >> 11;
    __syncthreads();
    if (tid < 64) sZ[tid] = 0.f;
    {
        const int sr = tid >> 3, sc8 = (tid & 7) * 8;
        const bf16_t* ga = xg1 + (size_t)(r0 + sr) * 1024 + sc8;
        const bf16_t* gb = Wq_t + (size_t)sr * 1024 + sc8;
        const int mt = wave & 3, nh = wave >> 2;
        f32x4 acc[8];
#pragma unroll
        for (int n = 0; n < 8; ++n) acc[n] = (f32x4){0.f, 0.f, 0.f, 0.f};
        u32x4 rA[5], rB[5];
#define MA_LOAD(R, kc) { R[0] = *(const u32x4*)(ga + (kc) * 64); _Pragma("unroll") for (int i = 0; i < 4; ++i) R[1 + i] = *(const u32x4*)(gb + (size_t)(i * 64) * 1024 + (kc) * 64); }
#define MA_STORE(R, buf) { bf16_t* dA = (bf16_t*)(smem + (buf) * 46080); bf16_t* dB = dA + 64 * TLD; *(u32x4*)(dA + sr * TLD + sc8) = R[0]; \
        _Pragma("unroll") for (int i = 0; i < 4; ++i) *(u32x4*)(dB + (sr + i * 64) * TLD + sc8) = R[1 + i]; }
#define MA_COMPUTE(buf) { const bf16_t* cA = (const bf16_t*)(smem + (buf) * 46080); const bf16_t* cB = cA + 64 * TLD; \
        _Pragma("unroll") for (int ks = 0; ks < 2; ++ks) { const bf16x8 af = frag_rm(cA, TLD, mt * 16, ks * 32, lane); \
            _Pragma("unroll") for (int n = 0; n < 8; ++n) acc[n] = MFMA16(frag_rm(cB, TLD, nh * 128 + n * 16, ks * 32, lane), af, acc[n]); } }
        MA_LOAD(rA, 0) MA_LOAD(rB, 1)
        MA_STORE(rA, 0)
        __syncthreads();
        for (int kc = 0; kc < 16; kc += 2) {
            if (kc + 2 < 16) MA_LOAD(rA, kc + 2)
            MA_COMPUTE(0)
            MA_STORE(rB, 1)
            __syncthreads();
            if (kc + 3 < 16) MA_LOAD(rB, kc + 3)
            MA_COMPUTE(1)
            if (kc + 2 < 16) MA_STORE(rA, 0)
            __syncthreads();
        }
#undef MA_LOAD
#undef MA_STORE
#undef MA_COMPUTE
        const float ri = rinv_from_pss(pss_in, (size_t)(r0 + mt * 16 + li));
#pragma unroll
        for (int n = 0; n < 8; ++n) { uint2 o; o.x = pk2(acc[n][0] * ri, acc[n][1] * ri); o.y = pk2(acc[n][2] * ri, acc[n][3] * ri);
            *(uint2*)(sQ + (mt * 16 + li) * QLD + nh * 128 + n * 16 + 4 * g) = o; }
    }
    __syncthreads();
    {
        const int head = wave >> 1, mt0 = (wave & 1) * 2;
        bf16x8 qf[2][2];
#pragma unroll
        for (int m = 0; m < 2; ++m)
#pragma unroll
            for (int ks = 0; ks < 2; ++ks) qf[m][ks] = frag_rm(sQ + head * 64, QLD, (mt0 + m) * 16, ks * 32, lane);
        bf16_t* sK = (bf16_t*)smem;
        bf16_t* sV = sK + 4 * 64 * TLD;
        const int sr = tid >> 3, sc8 = (tid & 7) * 8;
        const bf16_t* kvg = kv + (size_t)(b * MEMLEN + sr) * 512 + sc8;
        u32x4 rk[4], rv[4];
#define MB_LOAD(kt) { _Pragma("unroll") for (int hh = 0; hh < 4; ++hh) { rk[hh] = *(const u32x4*)(kvg + (size_t)((kt) * 64) * 512 + hh * 64); rv[hh] = *(const u32x4*)(kvg + (size_t)((kt) * 64) * 512 + 256 + hh * 64); } }
        MB_LOAD(0)
        f32x4 oacc[2][4]; float mrun[2] = {-INFINITY, -INFINITY}, lrun[2] = {0.f, 0.f};
#pragma unroll
        for (int m = 0; m < 2; ++m)
#pragma unroll
            for (int n = 0; n < 4; ++n) oacc[m][n] = (f32x4){0.f, 0.f, 0.f, 0.f};
        constexpr float SC2 = 0.125f * 1.4426950408889634f;
        for (int kt = 0; kt < 4; ++kt) {
            __syncthreads();
#pragma unroll
            for (int hh = 0; hh < 4; ++hh) { *(u32x4*)(sK + (hh * 64 + sr) * TLD + sc8) = rk[hh]; *(u32x4*)(sV + (hh * 64 + sr) * TLD + sc8) = rv[hh]; }
            __syncthreads();
            if (kt + 1 < 4) MB_LOAD(kt + 1)
#pragma unroll
            for (int m = 0; m < 2; ++m)
                attn_compute_t<false, 1>(sK + head * 64 * TLD, sV + head * 64 * TLD, sZ, qf[m], oacc[m], mrun[m], lrun[m], 0.f, SC2, 0, 0, lane, g);
        }
#undef MB_LOAD
#pragma unroll
        for (int m = 0; m < 2; ++m) {
            const float inv = 1.f / lrun[m];
#pragma unroll
            for (int n = 0; n < 4; ++n) { uint2 o; o.x = pk2(oacc[m][n][0] * inv, oacc[m][n][1] * inv); o.y = pk2(oacc[m][n][2] * inv, oacc[m][n][3] * inv);
                *(uint2*)(sQ + ((mt0 + m) * 16 + li) * QLD + head * 64 + n * 16 + 4 * g) = o; }
        }
    }
    __syncthreads();
    {
        float ssum[4] = {0.f, 0.f, 0.f, 0.f};
        for (int nq = 0; nq < 4; ++nq) {
            const int c0 = wave * 128 + nq * 32;
            const bf16_t* wg = Wmo_t + (size_t)(c0 + li) * 256 + g * 8;
            f32x4 acc[4][2];
#pragma unroll
            for (int m = 0; m < 4; ++m)
#pragma unroll
                for (int n = 0; n < 2; ++n) acc[m][n] = (f32x4){0.f, 0.f, 0.f, 0.f};
            u32x4 bw[8][2];
#pragma unroll
            for (int ks = 0; ks < 8; ++ks)
#pragma unroll
                for (int n = 0; n < 2; ++n) bw[ks][n] = *(const u32x4*)(wg + (size_t)(n * 16) * 256 + ks * 32);
#pragma unroll
            for (int ks = 0; ks < 8; ++ks) {
                if (ks & 1) asm volatile("" ::: "memory");
#pragma unroll
                for (int m = 0; m < 4; ++m) {
                    const bf16x8 af = frag_rm(sQ, QLD, m * 16, ks * 32, lane);
#pragma unroll
                    for (int n = 0; n < 2; ++n) acc[m][n] = MFMA16(__builtin_bit_cast(bf16x8, bw[ks][n]), af, acc[m][n]);
                }
            }
#pragma unroll
            for (int m = 0; m < 4; ++m) {
                const size_t row = (size_t)(r0 + m * 16 + li);
#pragma unroll
                for (int n = 0; n < 2; ++n) {
                    const int col = c0 + n * 16 + 4 * g;
                    const f32x4 o = *(const f32x4*)(x1 + row * 1024 + col) + acc[m][n];
                    *(f32x4*)(x2 + row * 1024 + col) = o;
                    ssum[m] += (o[0] * o[0] + o[1] * o[1]) + (o[2] * o[2] + o[3] * o[3]);
                    const f32x4 og = o * *(const f32x4*)(gn + col);
                    uint2 w; w.x = pk2(og[0], og[1]); w.y = pk2(og[2], og[3]);
                    *(uint2*)(xg2 + row * 1024 + col) = w;
                }
            }
        }
#pragma unroll
        for (int m = 0; m < 4; ++m) {
            float ss = ssum[m]; ss += __shfl_xor(ss, 16); ss += __shfl_xor(ss, 32);
            if (g == 0) { pss_out[(size_t)(r0 + m * 16 + li) * 16 + wave] = ss; pss_out[(size_t)(r0 + m * 16 + li) * 16 + 8 + wave] = 0.f; }
        }
    }
}

__device__ __forceinline__ void router_phase(char* smem, const float* __restrict__ x, const float* __restrict__ g, const bf16_t* __restrict__ wr  , const float* __restrict__ b_rg,
                                             const float* __restrict__ b_re, const float* __restrict__ pss, int* __restrict__ cnt, int* __restrict__ list, float* __restrict__ pgate) {
    bf16_t* sXh = (bf16_t*)smem;
    bf16_t* sXl = sXh + 64 * TLD;
    float* sLog = (float*)(sXl + 64 * TLD);
    const int tid = TIDX, lane = tid & 63, wave = tid >> 6, gq = lane >> 4, li = lane & 15;
    const int mt = wave & 3, kh = wave >> 2;
    const int stok = tid >> 3, c8 = (tid & 7) * 8;
    BLK_LOOP(tile, T / 64) {
        const int t0 = tile * 64;
        f32x4 acc[3];
#pragma unroll
        for (int n = 0; n < 3; ++n) acc[n] = (f32x4){0.f, 0.f, 0.f, 0.f};
        const float* xp = x + (size_t)(t0 + stok) * 1024 + c8;
        const bf16_t* wp = wr + (size_t)li * 1024 + kh * 32 + gq * 8;
        f32x4 x0 = *(const f32x4*)xp, x1 = *(const f32x4*)(xp + 4);
        u32x4 wh[3], wl[3];
#pragma unroll
        for (int n = 0; n < 3; ++n) { wh[n] = *(const u32x4*)(wp + n * 16 * 1024); wl[n] = *(const u32x4*)(wp + 48 * 1024 + n * 16 * 1024); }
        for (int kc = 0; kc < 16; ++kc) {
            const f32x4 g0 = *(const f32x4*)(g + kc * 64 + c8), g1 = *(const f32x4*)(g + kc * 64 + c8 + 4);
            const f32x4 v0 = x0 * g0, v1 = x1 * g1;
            u32x4 oh, ol;
#pragma unroll
            for (int j = 0; j < 2; ++j) {
                const unsigned h0 = pk2(v0[2 * j], v0[2 * j + 1]), h1 = pk2(v1[2 * j], v1[2 * j + 1]);
                oh[j] = h0; oh[2 + j] = h1;
                ol[j] = pk2(v0[2 * j] - __uint_as_float(h0 << 16), v0[2 * j + 1] - __uint_as_float(h0 & 0xffff0000u));
                ol[2 + j] = pk2(v1[2 * j] - __uint_as_float(h1 << 16), v1[2 * j + 1] - __uint_as_float(h1 & 0xffff0000u));
            }
            __syncthreads();
            *(u32x4*)(sXh + stok * TLD + c8) = oh; *(u32x4*)(sXl + stok * TLD + c8) = ol;
            __syncthreads();
            u32x4 cwh[3], cwl[3];
#pragma unroll
            for (int n = 0; n < 3; ++n) { cwh[n] = wh[n]; cwl[n] = wl[n]; }
            if (kc + 1 < 16) {
                x0 = *(const f32x4*)(xp + (kc + 1) * 64); x1 = *(const f32x4*)(xp + (kc + 1) * 64 + 4);
#pragma unroll
                for (int n = 0; n < 3; ++n) { wh[n] = *(const u32x4*)(wp + n * 16 * 1024 + (kc + 1) * 64); wl[n] = *(const u32x4*)(wp + 48 * 1024 + n * 16 * 1024 + (kc + 1) * 64); }
            }
            const bf16x8 xh = frag_rm(sXh, TLD, mt * 16, kh * 32, lane), xl = frag_rm(sXl, TLD, mt * 16, kh * 32, lane);
#pragma unroll
            for (int n = 0; n < 3; ++n) {
                const bf16x8 fh = __builtin_bit_cast(bf16x8, cwh[n]), fl = __builtin_bit_cast(bf16x8, cwl[n]);
                acc[n] = MFMA16(fh, xh, acc[n]);
                acc[n] = MFMA16(fl, xh, acc[n]);
                acc[n] = MFMA16(fh, xl, acc[n]);
            }
        }
#pragma unroll
        for (int n = 0; n < 3; ++n) *(f32x4*)(sLog + (kh * 64 + mt * 16 + li) * 48 + n * 16 + 4 * gq) = acc[n];
        __syncthreads();
        int* sCnt = (int*)(sLog + 2 * 64 * 48);
        if (tid < 64) sCnt[tid] = 0;
        __syncthreads();
        int ex0 = 0, ex1 = 0, lr0 = 0, lr1 = 0; float gw0 = 0.f, gw1 = 0.f;
        if (tid < 64) {
            const float rinv = rinv_from_pss(pss, (size_t)(t0 + tid));
            const float* l0 = sLog + tid * 48; const float* l1 = sLog + (64 + tid) * 48;
            float lg[4];
#pragma unroll
            for (int i = 0; i < 4; ++i) lg[i] = (l0[i] + l1[i]) * rinv + b_rg[i];
            int gs = 0; float gm = lg[0];
#pragma unroll
            for (int i = 1; i < 4; ++i) if (lg[i] > gm) { gm = lg[i]; gs = i; }
            float den = 0.f;
#pragma unroll
            for (int i = 0; i < 4; ++i) den += __expf(lg[i] - gm);
            const float pg = 1.f / den;
            int i0 = 0, i1 = -1; float m0 = -INFINITY, m1 = -INFINITY;
            for (int i = 0; i < 8; ++i) {
                const float v = (l0[4 + gs * 8 + i] + l1[4 + gs * 8 + i]) * rinv + b_re[gs * 8 + i];
                if (v > m0) { m1 = m0; i1 = i0; m0 = v; i0 = i; } else if (v > m1) { m1 = v; i1 = i; }
            }
            const float e1 = __expf(m1 - m0);
            gw0 = pg / (1.f + e1); gw1 = pg * e1 / (1.f + e1);
            ex0 = gs * 8 + i0; ex1 = gs * 8 + i1;
            lr0 = atomicAdd(&sCnt[ex0], 1); lr1 = atomicAdd(&sCnt[ex1], 1);
        }
        __syncthreads();
        if (tid < 32) { const int c = sCnt[tid]; sCnt[32 + tid] = c ? atomicAdd(&cnt[tid * CNT_STRIDE], c) : 0; }
        __syncthreads();
        if (tid < 64) {
            const int t = t0 + tid;
            list[(size_t)ex0 * T + sCnt[32 + ex0] + lr0] = 2 * t; pgate[2 * t] = gw0;
            list[(size_t)ex1 * T + sCnt[32 + ex1] + lr1] = 2 * t + 1; pgate[2 * t + 1] = gw1;
        }
        __syncthreads();
    }
}

__device__ __forceinline__ void combine_phase(const float* x2, const bf16_t* __restrict__ eo, const float* __restrict__ g, float* xout, bf16_t* __restrict__ hn, int mode) {
    const int lane = TIDX & 63;
    for (int t = blockIdx.x * 8 + (TIDX >> 6); t < T; t += gridDim.x * 8) {
        f32x4 v[4]; float s = 0.f;
#pragma unroll
        for (int j = 0; j < 4; ++j) {
            const int c = (lane + 64 * j) * 4;
            v[j] = *(const f32x4*)(x2 + (size_t)t * 1024 + c);
            const uint2 e0 = *(const uint2*)(eo + (size_t)(2 * t) * 1024 + c), e1 = *(const uint2*)(eo + (size_t)(2 * t + 1) * 1024 + c);
            v[j].x += __uint_as_float(e0.x << 16) + __uint_as_float(e1.x << 16);
            v[j].y += __uint_as_float(e0.x & 0xffff0000u) + __uint_as_float(e1.x & 0xffff0000u);
            v[j].z += __uint_as_float(e0.y << 16) + __uint_as_float(e1.y << 16);
            v[j].w += __uint_as_float(e0.y & 0xffff0000u) + __uint_as_float(e1.y & 0xffff0000u);
            s += v[j].x * v[j].x + v[j].y * v[j].y + v[j].z * v[j].z + v[j].w * v[j].w;
        }
        const float rinv = rsqrtf(wave_sum(s) * (1.f / 1024.f) + EPS);
#pragma unroll
        for (int j = 0; j < 4; ++j) {
            const int c = (lane + 64 * j) * 4;
            const f32x4 gg = *(const f32x4*)(g + c);
            const f32x4 hv = v[j] * rinv * gg;
            if (mode == 0) {
                *(f32x4*)(xout + (size_t)t * 1024 + c) = v[j];
                uint2 o; o.x = pk2(hv.x, hv.y); o.y = pk2(hv.z, hv.w);
                *(uint2*)(hn + (size_t)t * 1024 + c) = o;
            } else {
                *(f32x4*)(xout + (size_t)t * 1024 + c) = hv;
            }
        }
    }
}

template <int l>
__device__ __forceinline__ void layer_body(const Params& P, char* smem, const XcdBarrier& xb, const float* xcur) {
    char* ws = P.ws;
    bf16_t* Wt_in = (bf16_t*)(ws + OFF_WIN); bf16_t* Wt_out = (bf16_t*)(ws + OFF_WOUT); bf16_t* Wt_mq = (bf16_t*)(ws + OFF_WMQ); bf16_t* Wt_mkv = (bf16_t*)(ws + OFF_WMKV);
    bf16_t* Wt_mo = (bf16_t*)(ws + OFF_WMO); bf16_t* Wt_gu = (bf16_t*)(ws + OFF_WGU); bf16_t* Wt_dn = (bf16_t*)(ws + OFF_WDN);
    bf16_t* hn = (bf16_t*)(ws + OFF_HN); bf16_t* proj = (bf16_t*)(ws + OFF_PROJ); float* gates = (float*)(ws + OFF_GATES); bf16_t* y = (bf16_t*)(ws + OFF_Y);
    float* XA = P.out; float* XB = (float*)(ws + OFF_XB);
    bf16_t* qm = (bf16_t*)(ws + OFF_QM); bf16_t* om = (bf16_t*)(ws + OFF_OM); bf16_t* kvm = (bf16_t*)(ws + OFF_KVM); bf16_t* memn = (bf16_t*)(ws + OFF_MEMN);
    float* foxc = (float*)(ws + OFF_FOXC); float* lrua = (float*)(ws + OFF_LRUA); float* lruu = (float*)(ws + OFF_LRUU);
    int* cnt_all = (int*)(ws + OFF_CTL) + CTL_CNT_WORD; int* list = (int*)(ws + OFF_LIST); float* pgate = (float*)(ws + OFF_PGATE);
    bf16_t* act = (bf16_t*)(ws + OFF_ACT); bf16_t* eo = (bf16_t*)(ws + OFF_EO); float* pss = (float*)(ws + OFF_PSS);
    const int wave = TIDX >> 6, lane = TIDX & 63;


        float* x1 = (l == 0) ? XA : XB;
        float* x2 = (l == 0) ? XB : XA;
        int* cnt = cnt_all + 32 * CNT_STRIDE * l;
        const float* mg = P.in[I_MIX_GAIN] + l * 1024;
        REP(2, { pg8::Gemm g{hn, Wt_in + (size_t)l * NP * 1024, T, NP, 1024}; pg8::StaticOrder S; S.init(T, NP, (int)gridDim.x, (int)blockIdx.x);
                 pg8::EpiInProj E{proj, NP, gates, C_GATE};
                 pg8::gemm_phase<pg8::EpiInProj, pg8::StaticOrder, true, true>((PG8_LAS unsigned char*)smem, g, S, E); });
        if (l == 0) for (int l2 = 0; l2 < NL; ++l2)
            gemm_phase<EPI_BF16>(smem, memn + (size_t)l2 * 2048 * 1024, 1024, Wt_mkv + (size_t)l2 * 512 * 1024, 1024, 2048, 512, 1024, kvm + (size_t)l2 * 2048 * 512, 512, nullptr, nullptr,
                                 (gridDim.x >= 192) ? ((int)blockIdx.x - 128 - 32 * l2) : (int)blockIdx.x, (gridDim.x >= 192) ? 4096 : (int)gridDim.x);
        GSYNC();
        REP(4,         {
            const int bx = blockIdx.x;
            bf16_t* gtiles = (bf16_t*)(ws + OFF_GDN); float* glast = (float*)(ws + OFF_GLAST);
            if (bx < 32 && wave == 1) fox_cumsum(gates, P.in[I_FOX_FB] + l * 4, foxc, bx, lane);
            BLK_LOOP(cp, 512) gdn_prep_pair(smem, proj, gates, P.in[I_GDN_CONV_W] + l * 4 * 768, P.in[I_GDN_A_LOG] + l * 4, P.in[I_GDN_DT_BIAS] + l * 4, gtiles, glast, 2 * cp);
            BLK_LOOP(ch, 1024) hgrn_local_task(smem, proj, P.in[I_HGRN_LB], l, (float*)(ws + OFF_HL), (float*)(ws + OFF_HD), ch);
            BLK_LOOP(task, 256) lru_local_task(smem, proj, P.in[I_LRU_CONV_W] + l * 1024, P.in[I_LRU_CONV_B] + l * 256, P.in[I_LRU_WA] + l * 16384, P.in[I_LRU_BA] + l * 256,
                                               P.in[I_LRU_WX] + l * 16384, P.in[I_LRU_BX] + l * 256, P.in[I_LRU_LAM] + l * 256, lrua, lruu, (float*)(ws + OFF_LSUM), task);
        });
        GSYNC();
        state_scan_phase((const float*)(ws + OFF_HL), (const float*)(ws + OFF_HD), (bf16_t*)(ws + OFF_HS), (const float*)(ws + OFF_LSUM), (float*)(ws + OFF_LCAR));
        GSYNC();
        REP(8,         {
            const int natt = (SEQ / 128) * 4 * NB;
            const int bx = blockIdx.x, nfree = (int)gridDim.x - 32;
            if (bx < 32) gdn_scan_task(smem, (const bf16_t*)(ws + OFF_GDN), (const float*)(ws + OFF_GLAST), proj, mg, y, bx);
            else {
                for (int r = 0; r * nfree < natt; ++r) {
                    const int i = r * nfree + ((r & 1) ? (nfree - 1 - (bx - 32)) : (bx - 32));
                    if (i >= natt) continue;
                    const int qt = 15 - (i >> 5), bh = i & 31;
                    attn_task(smem, proj + C_BQ, NP, proj + C_BK, NP, proj + C_BV, NP, foxc, SEQ, SEQ, 1, 0.125f, y + 256, 1024, mg + 256, 1, (bh * 16) + qt);
                }
                for (int i = bx - 32; i < 1024; i += nfree) {
                    const int ch = (i & 31) * 32 + (31 - (i >> 5));
                    hgrn_out_task(smem, proj, P.in[I_HGRN_LB], l, (const bf16_t*)(ws + OFF_HS), mg, y, ch);
                }
                for (int i = bx - 32; i < 256; i += nfree) lru_out_task(lrua, lruu, (const float*)(ws + OFF_LCAR), proj, mg, y, i);
            }
        });
        GSYNC();
        REP(16, { pg8::Gemm g{y, Wt_out + (size_t)l * 1024 * 1024, T, 1024, 1024}; pg8::StaticOrder S; S.init(T, 1024, (int)gridDim.x, (int)blockIdx.x);
                  pg8::EpiResidNorm E{xcur, x1, 1024, P.in[I_NORM_MEM] + l * 1024, hn, pss};
                  pg8::gemm_phase<pg8::EpiResidNorm, pg8::StaticOrder, true, true>((PG8_LAS unsigned char*)smem, g, S, E); });
        GSYNC();
        REP(64, BLK_LOOP(tile, T / 64) middle_task(smem, hn, pss, Wt_mq + (size_t)l * 256 * 1024, kvm + (size_t)l * 2048 * 512, Wt_mo + (size_t)l * 1024 * 256, x1, x2, P.in[I_NORM_FFN] + l * 1024, hn, pss, tile));
        GSYNC();
        router_phase(smem, x2, P.in[I_NORM_FFN] + l * 1024, (const bf16_t*)(ws + OFF_WR) + (size_t)l * 2 * 48 * 1024, P.in[I_B_RG] + l * 4, P.in[I_B_RE] + l * 32, pss, cnt, list, pgate);
        GSYNC();
        REP(512, moe_phase<1>(smem, hn, 1024, Wt_gu + (size_t)l * 32 * 512 * 1024, (size_t)512 * 1024, 1024, 1024, cnt, list, pgate, act, pss));
        GSYNC();
        REP(1024, moe_phase<2>(smem, act, 256, Wt_dn + (size_t)l * 32 * 1024 * 256, (size_t)1024 * 256, 256, 256, cnt, list, pgate, eo, pss));
        if (PROBE_MASK & 2048) { for (int i = 0; i < 10; ++i) GSYNC(); }
        GSYNC();
        if (l == 0) { combine_phase(x2, eo, P.in[I_NORM_MIX] + 1024, XA, hn, 0); GSYNC(); }
        else combine_phase(x2, eo, P.in[I_NORM_FINAL], P.out, hn, 1);
}
__global__ void __launch_bounds__(NTHR, 2) mega_kernel(Params P) {
    extern __shared__ __attribute__((aligned(16))) char smem[];
    volatile LDS_AS unsigned* st = (volatile LDS_AS unsigned*)(smem + LDS_BYTES - 16);
    if (TIDX < 4) st[TIDX] = 0u;
    __syncthreads();
    const XcdBarrier xb = xcd_barrier_post((unsigned*)(P.ws + OFF_CTL), st);
    phase0(P, smem);
    GSYNC();
    layer_body<0>(P, smem, xb, P.in[I_X]);
    layer_body<1>(P, smem, xb, P.out);
}

extern "C" void kernel_launch(void* const* d_in, const int* in_sizes, int n_in, void* d_out, int out_size, void* d_ws, size_t ws_size, hipStream_t stream) {
    static int grid_blocks = 0;
    if (grid_blocks == 0) {
        if (n_in != N_INPUTS || ws_size < OFF_END || out_size != T * 1024) { fprintf(stderr, "kernel_launch: unexpected sizes n_in=%d ws=%zu out=%d (need ws >= %zu)\n", n_in, ws_size, out_size, (size_t)OFF_END); grid_blocks = -1; return; }
        int dev = 0, cus = 0, per_cu = 0;
        if (hipGetDevice(&dev) != hipSuccess || hipDeviceGetAttribute(&cus, hipDeviceAttributeMultiprocessorCount, dev) != hipSuccess) { fprintf(stderr, "kernel_launch: device query failed\n"); grid_blocks = -1; return; }
        if (hipFuncSetAttribute((const void*)mega_kernel, hipFuncAttributeMaxDynamicSharedMemorySize, LDS_BYTES) != hipSuccess) { fprintf(stderr, "kernel_launch: hipFuncSetAttribute failed\n"); grid_blocks = -1; return; }
        if (hipOccupancyMaxActiveBlocksPerMultiprocessor(&per_cu, (const void*)mega_kernel, NTHR, LDS_BYTES) != hipSuccess || per_cu < 1) { fprintf(stderr, "kernel_launch: occupancy query says %d blocks/CU\n", per_cu); grid_blocks = -1; return; }
        grid_blocks = cus;
        fprintf(stderr, "kernel_launch: cus=%d per_cu=%d grid=%d\n", cus, per_cu, grid_blocks);
    }
    if (grid_blocks < 0) return;
    if (hipMemsetAsync((char*)d_ws + OFF_CTL, 0, CTL_BYTES, stream) != hipSuccess) { fprintf(stderr, "kernel_launch: memset failed\n"); return; }
    Params p; memset(&p, 0, sizeof p);
    for (int i = 0; i < N_INPUTS; ++i) p.in[i] = (const float*)d_in[i];
    p.out = (float*)d_out; p.ws = (char*)d_ws;
    void* args[] = {&p};
    hipError_t e = hipLaunchCooperativeKernel((const void*)mega_kernel, dim3(grid_blocks), dim3(NTHR), args, LDS_BYTES, stream);
    if (e != hipSuccess) fprintf(stderr, "kernel_launch: cooperative launch failed: %s (grid %d)\n", hipGetErrorString(e), grid_blocks);
}
```

```cpp
#include <hip/hip_runtime.h>
#include <stdint.h>
#include <stdio.h>
#include <string.h>
#include <hip/hip_cooperative_groups.h>
namespace cg = cooperative_groups;

typedef unsigned short bf16_t;
typedef short bf16x8 __attribute__((ext_vector_type(8)));
typedef float f32x4 __attribute__((ext_vector_type(4)));
typedef unsigned u32x4 __attribute__((ext_vector_type(4)));

constexpr int NB = 8, SEQ = 2048, DM = 1024, T = NB * SEQ, NL = 2;
constexpr int NP = 3584;
constexpr int NIN = 3340;
constexpr int C_AQ = 0, C_AF = 256, C_AI = 512, C_AG = 768, C_BQ = 1024, C_BK = 1280, C_BV = 1536, C_CX = 1792, C_CG = 2048,
              C_DQ = 2304, C_DK = 2560, C_DV = 2816, C_DZ = 3072, C_GATE = 3328;
constexpr int MEMLEN = 256;
constexpr int NEXP = 32, DEXP = 256;
constexpr float EPS = 1e-6f;

constexpr size_t al256(size_t x) { return (x + 255) & ~(size_t)255; }
constexpr size_t SZ_WIN = (size_t)NP * 1024 * 2, SZ_WOUT = (size_t)1024 * 1024 * 2, SZ_WMQ = (size_t)256 * 1024 * 2, SZ_WMKV = (size_t)512 * 1024 * 2,
                 SZ_WMO = (size_t)1024 * 256 * 2, SZ_WGU = (size_t)32 * 512 * 1024 * 2, SZ_WDN = (size_t)32 * 1024 * 256 * 2;
constexpr size_t OFF_WIN = 0;
constexpr size_t OFF_WOUT = OFF_WIN + NL * SZ_WIN;
constexpr size_t OFF_WMQ = OFF_WOUT + NL * SZ_WOUT;
constexpr size_t OFF_WMKV = OFF_WMQ + NL * SZ_WMQ;
constexpr size_t OFF_WMO = OFF_WMKV + NL * SZ_WMKV;
constexpr size_t OFF_WGU = OFF_WMO + NL * SZ_WMO;
constexpr size_t OFF_WDN = OFF_WGU + NL * SZ_WGU;
constexpr size_t OFF_HN = OFF_WDN + NL * SZ_WDN;
constexpr size_t OFF_PROJ = OFF_HN + (size_t)T * 1024 * 2;
constexpr size_t OFF_GATES = OFF_PROJ + (size_t)T * NP * 2;
constexpr size_t OFF_Y = OFF_GATES + (size_t)T * 16 * 4;
constexpr size_t OFF_XB = OFF_Y + (size_t)T * 1024 * 2;
constexpr size_t OFF_QM = OFF_XB + (size_t)T * 1024 * 4;
constexpr size_t OFF_OM = OFF_QM + (size_t)T * 256 * 2;
constexpr size_t OFF_KVM = OFF_OM + (size_t)T * 256 * 2;
constexpr size_t OFF_MEMN = OFF_KVM + (size_t)NL * 2048 * 512 * 2;
constexpr size_t OFF_FOXC = OFF_MEMN + (size_t)2048 * 1024 * 2;
constexpr size_t OFF_LRUA = OFF_FOXC + (size_t)NB * 4 * SEQ * 4;
constexpr size_t OFF_LRUU = OFF_LRUA + (size_t)T * 256 * 4;
constexpr size_t OFF_CNT = OFF_LRUU + (size_t)T * 256 * 4;
constexpr size_t OFF_LIST = OFF_CNT + 256;
constexpr size_t OFF_PGATE = OFF_LIST + (size_t)NEXP * T * 4;
constexpr size_t OFF_HL = OFF_PGATE + (size_t)2 * T * 4;
constexpr size_t OFF_HD = OFF_HL + (size_t)1024 * 4096 * 4;
constexpr size_t OFF_GDN = OFF_HD + (size_t)1024 * 64 * 4;
constexpr size_t OFF_GLAST = OFF_GDN + (size_t)1024 * 5 * 4096 * 2;
constexpr size_t OFF_LSUM = OFF_GLAST + 4096;
constexpr size_t OFF_HS = OFF_LSUM + (size_t)2 * 256 * 256 * 4;
constexpr size_t OFF_LCAR = OFF_HS + (size_t)1024 * 4096 * 2;
constexpr size_t OFF_PSS = OFF_LCAR + (size_t)256 * 256 * 4;
constexpr size_t OFF_WR = OFF_PSS + (size_t)T * 16 * 4;
constexpr size_t OFF_CTL = OFF_WR + (size_t)NL * 2 * 48 * 1024 * 2;
constexpr size_t CTL_BYTES = 32768;
constexpr int CTL_CNT_WORD = 4096;
constexpr int CNT_STRIDE = 64;
constexpr size_t OFF_END = OFF_CTL + CTL_BYTES;
constexpr size_t OFF_ACT = OFF_PROJ;
constexpr size_t OFF_EO = OFF_PROJ + (size_t)2 * T * 256 * 2;
static_assert(OFF_EO + (size_t)2 * T * 1024 * 2 <= OFF_GATES, "overlay fits");

__device__ __forceinline__ int tid_opaque() { int t = threadIdx.x; asm volatile("" : "+v"(t)); return t; }
#define TIDX tid_opaque()
__device__ __forceinline__ float bf2f(bf16_t v) { return __uint_as_float(((unsigned)v) << 16); }
typedef __bf16 bf16x2_t __attribute__((ext_vector_type(2)));
__device__ __forceinline__ bf16_t f2bf(float f) { return __builtin_bit_cast(unsigned short, (__bf16)f); }
__device__ __forceinline__ unsigned pk2(float lo, float hi) { bf16x2_t v = {(__bf16)lo, (__bf16)hi}; return __builtin_bit_cast(unsigned, v); }
__device__ __forceinline__ float sigmoidf_(float x) { return 1.f / (1.f + __expf(-x)); }
__device__ __forceinline__ float siluf_(float x) { return x / (1.f + __expf(-x)); }
__device__ __forceinline__ float softplusf_(float x) { return x > 20.f ? x : log1pf(__expf(x)); }
__device__ __forceinline__ float logsigmoidf_(float x) { return x < 0.f ? x - log1pf(__expf(x)) : -log1pf(__expf(-x)); }
__device__ __forceinline__ float geluf_(float x) { float u = 0.7978845608028654f * (x + 0.044715f * x * x * x); return 0.5f * x * (1.f + tanhf(u)); }
__device__ __forceinline__ float wave_sum(float v) {
#pragma unroll
    for (int o = 1; o < 64; o <<= 1) v += __shfl_xor(v, o);
    return v;
}
__device__ __forceinline__ float rdlane(float v, int l) { return __int_as_float(__builtin_amdgcn_readlane(__float_as_int(v), l)); }

#define PROBE_MASK 0
#define GSYNC() xcd_barrier(xb)
#define REP(bit, ...) do { __VA_ARGS__; if (PROBE_MASK & (bit)) { GSYNC(); __VA_ARGS__; } } while (0)
constexpr int NTHR = 512;
constexpr int LDS_BYTES = 147456;
enum { I_X = 0, I_MEM, I_NORM_MIX, I_W_IN, I_HGRN_LB, I_FOX_FB, I_LRU_CONV_W, I_LRU_CONV_B, I_LRU_WA, I_LRU_BA, I_LRU_WX, I_LRU_BX, I_LRU_LAM, I_GDN_CONV_W, I_GDN_A_LOG,
       I_GDN_DT_BIAS, I_MIX_GAIN, I_W_OUT, I_NORM_MEM, I_NORM_MEMKV, I_W_MQ, I_W_MKV, I_W_MO, I_NORM_FFN, I_W_RG, I_B_RG, I_W_RE, I_B_RE, I_W_E_GU, I_W_E_DN, I_NORM_FINAL, N_INPUTS };
struct Params { const float* in[N_INPUTS]; float* out; char* ws; };
static_assert(sizeof(Params) == 8 * (N_INPUTS + 2), "no padding");

#define BLK_LOOP(it, n) for (int it = (int)blockIdx.x; it < (n); it += (int)gridDim.x)


__device__ __forceinline__ float rinv_from_pss(const float* __restrict__ pss, size_t row) {
    const f32x4 a = *(const f32x4*)(pss + row * 16), b = *(const f32x4*)(pss + row * 16 + 4), c = *(const f32x4*)(pss + row * 16 + 8), d = *(const f32x4*)(pss + row * 16 + 12);
    const float sm = ((a[0] + a[1]) + (a[2] + a[3])) + ((b[0] + b[1]) + (b[2] + b[3])) + ((c[0] + c[1]) + (c[2] + c[3])) + ((d[0] + d[1]) + (d[2] + d[3]));
    return rsqrtf(sm * (1.f / 1024.f) + EPS);
}

__device__ __forceinline__ int rowmap_fn(int mode, int n) {
    if (mode == 1) {
        if (n < 1792) return n;
        if (n < 1796) return C_GATE + (n - 1792);
        if (n < 3076) return n - 4;
        if (n < 3084) return C_GATE + 4 + (n - 3076);
        return n - 12;
    } else if (mode == 2) {
        int j = n & 255; return (j >> 4) * 32 + ((n >= 256) ? 16 : 0) + (j & 15);
    }
    return n;
}
__device__ __forceinline__ void convT_tile(float* tile  , const float* __restrict__ src, int K, int N, bf16_t* __restrict__ dst, int mode, int ntn, int idx) {
    const int n0 = (idx % ntn) * 64, k0 = (idx / ntn) * 64;
    const int tid = TIDX;
    __syncthreads();
#pragma unroll
    for (int i = 0; i < 2; ++i) {
        const int k = (tid >> 4) + 32 * i, n = n0 + (tid & 15) * 4;
        f32x4 v = (f32x4){0.f, 0.f, 0.f, 0.f};
        if (n + 3 < N) v = *(const f32x4*)(src + (size_t)(k0 + k) * N + n);
        else { for (int e = 0; e < 4; ++e) if (n + e < N) v[e] = src[(size_t)(k0 + k) * N + n + e]; }
#pragma unroll
        for (int e = 0; e < 4; ++e) tile[k * 65 + (tid & 15) * 4 + e] = v[e];
    }
    __syncthreads();
    const int nl = tid >> 3, k8 = (tid & 7) * 8, n = n0 + nl;
    if (n < N) {
        const int r = rowmap_fn(mode, n);
        u32x4 o;
#pragma unroll
        for (int j = 0; j < 4; ++j) o[j] = pk2(tile[(k8 + 2 * j) * 65 + nl], tile[(k8 + 2 * j + 1) * 65 + nl]);
        *(u32x4*)(dst + (size_t)r * K + k0 + k8) = o;
    }
}
__device__ __forceinline__ void rms_row_bf16(const float* __restrict__ xrow, const float* __restrict__ g, bf16_t* __restrict__ orow, int lane) {
    const f32x4* xr = (const f32x4*)xrow + lane;
    f32x4 v[4]; float s = 0.f;
#pragma unroll
    for (int j = 0; j < 4; ++j) { v[j] = xr[64 * j]; s += v[j].x * v[j].x + v[j].y * v[j].y + v[j].z * v[j].z + v[j].w * v[j].w; }
    const float rinv = rsqrtf(wave_sum(s) * (1.f / 1024.f) + EPS);
#pragma unroll
    for (int j = 0; j < 4; ++j) {
        const f32x4 gg = ((const f32x4*)g)[lane + 64 * j];
        uint2 o; o.x = pk2(v[j].x * rinv * gg.x, v[j].y * rinv * gg.y); o.y = pk2(v[j].z * rinv * gg.z, v[j].w * rinv * gg.w);
        *(uint2*)(orow + (lane + 64 * j) * 4) = o;
    }
}

constexpr int CT_PER_LAYER = 53 * 16 + 256 + 64 + 128 + 64;
constexpr int CT_GU = 64 * 128, CT_DN = 64 * 64;
constexpr int CT_TOTAL = NL * CT_PER_LAYER + CT_GU + CT_DN;

__device__ __forceinline__ void phase0(const Params& P, char* smem) {
    char* ws = P.ws;
    float* tile = (float*)smem;
    BLK_LOOP(it, CT_TOTAL) {
        int r = it;
        if (r < NL * CT_PER_LAYER) {
            const int l = r / CT_PER_LAYER; r -= l * CT_PER_LAYER;
            if (r < 848) { convT_tile(tile, P.in[I_W_IN] + (size_t)l * 1024 * NIN, 1024, NIN, (bf16_t*)(ws + OFF_WIN) + (size_t)l * NP * 1024, 1, 53, r); continue; } r -= 848;
            if (r < 256) { convT_tile(tile, P.in[I_W_OUT] + (size_t)l * 1024 * 1024, 1024, 1024, (bf16_t*)(ws + OFF_WOUT) + (size_t)l * 1024 * 1024, 0, 16, r); continue; } r -= 256;
            if (r < 64) { convT_tile(tile, P.in[I_W_MQ] + (size_t)l * 1024 * 256, 1024, 256, (bf16_t*)(ws + OFF_WMQ) + (size_t)l * 256 * 1024, 0, 4, r); continue; } r -= 64;
            if (r < 128) { convT_tile(tile, P.in[I_W_MKV] + (size_t)l * 1024 * 512, 1024, 512, (bf16_t*)(ws + OFF_WMKV) + (size_t)l * 512 * 1024, 0, 8, r); continue; } r -= 128;
            convT_tile(tile, P.in[I_W_MO] + (size_t)l * 256 * 1024, 256, 1024, (bf16_t*)(ws + OFF_WMO) + (size_t)l * 1024 * 256, 0, 16, r); continue;
        }
        r -= NL * CT_PER_LAYER;
        if (r < CT_GU) { const int m = r >> 7; convT_tile(tile, P.in[I_W_E_GU] + (size_t)m * 1024 * 512, 1024, 512, (bf16_t*)(ws + OFF_WGU) + (size_t)m * 512 * 1024, 2, 8, r & 127); continue; }
        r -= CT_GU;
        { const int m = r >> 6; convT_tile(tile, P.in[I_W_E_DN] + (size_t)m * 256 * 1024, 256, 1024, (bf16_t*)(ws + OFF_WDN) + (size_t)m * 1024 * 256, 0, 16, r & 63); }
    }
    for (int i = blockIdx.x * NTHR + TIDX; i < NL * (NP - NIN) * 512; i += gridDim.x * NTHR) {
        const int l = i / ((NP - NIN) * 512), w = i % ((NP - NIN) * 512);
        ((unsigned*)((bf16_t*)(ws + OFF_WIN) + (size_t)l * NP * 1024 + (size_t)NIN * 1024))[w] = 0u;
    }
    for (int i = blockIdx.x * NTHR + TIDX; i < NL * 48 * 1024; i += gridDim.x * NTHR) {
        const int l = i / (48 * 1024), r = (i / 1024) % 48, k = i & 1023;
        float w = 0.f;
        if (r < 4) w = P.in[I_W_RG][(size_t)l * 4096 + k * 4 + r]; else if (r < 36) w = P.in[I_W_RE][(size_t)l * 32768 + k * 32 + (r - 4)];
        const bf16_t hi = f2bf(w); const bf16_t lo = f2bf(w - bf2f(hi));
        bf16_t* wr = (bf16_t*)(ws + OFF_WR) + (size_t)l * 2 * 48 * 1024;
        wr[r * 1024 + k] = hi; wr[48 * 1024 + r * 1024 + k] = lo;
    }
    const int gw = blockIdx.x * 8 + (TIDX >> 6), ngw = gridDim.x * 8, lane = TIDX & 63;
    for (int row = gw; row < T + NL * 2048; row += ngw) {
        if (row < T) rms_row_bf16(P.in[I_X] + (size_t)row * 1024, P.in[I_NORM_MIX], (bf16_t*)(ws + OFF_HN) + (size_t)row * 1024, lane);
        else { const int r2 = row - T, l = r2 >> 11, rr = r2 & 2047;
               rms_row_bf16(P.in[I_MEM] + (size_t)rr * 1024, P.in[I_NORM_MEMKV] + l * 1024, (bf16_t*)(ws + OFF_MEMN) + (size_t)r2 * 1024, lane); }
    }
}

constexpr int GLD = 72;
constexpr int GEMM_STAGE = (256 + 128) * GLD * 2;
constexpr int GEMM_LDS = 2 * GEMM_STAGE;
template <class RowPtr>
__device__ __forceinline__ void gemm_tile(char* smem, RowPtr rowptr, const bf16_t* __restrict__ Bt, int ldb, int n0, int K, f32x4 (&acc)[4][4]) {
    const int tid = TIDX, lane = tid & 63, wave = tid >> 6, wm = wave >> 1, wn = wave & 1;
    const u32x4* ga[4]; const u32x4* gb[2];
#pragma unroll
    for (int i = 0; i < 4; ++i) { const int c = tid + i * 512, r = c >> 3, ch = c & 7; ga[i] = (const u32x4*)(rowptr(r) + ch * 8); }
#pragma unroll
    for (int i = 0; i < 2; ++i) { const int c = tid + i * 512, r = c >> 3, ch = c & 7; gb[i] = (const u32x4*)(Bt + (size_t)(n0 + r) * ldb + ch * 8); }
#pragma unroll
    for (int m = 0; m < 4; ++m)
#pragma unroll
        for (int n = 0; n < 4; ++n) acc[m][n] = (f32x4){0.f, 0.f, 0.f, 0.f};
    const int nk = K / 64;
    u32x4 raA[4], rbA[2], raB[4], rbB[2];
#define GT_LOAD(RA, RB, kt) { _Pragma("unroll") for (int i = 0; i < 4; ++i) RA[i] = ga[i][(kt) * 8]; _Pragma("unroll") for (int i = 0; i < 2; ++i) RB[i] = gb[i][(kt) * 8]; }
#define GT_STORE(RA, RB, buf) { bf16_t* dA = (bf16_t*)(smem + (buf) * GEMM_STAGE); bf16_t* dB = dA + 256 * GLD; \
        _Pragma("unroll") for (int i = 0; i < 4; ++i) { const int c = tid + i * 512, r = c >> 3, ch = c & 7; *(u32x4*)(dA + r * GLD + ch * 8) = RA[i]; } \
        _Pragma("unroll") for (int i = 0; i < 2; ++i) { const int c = tid + i * 512, r = c >> 3, ch = c & 7; *(u32x4*)(dB + r * GLD + ch * 8) = RB[i]; } }
#define GT_COMPUTE(buf) { const bf16_t* sA = (const bf16_t*)(smem + (buf) * GEMM_STAGE); const bf16_t* sB = sA + 256 * GLD; \
        _Pragma("unroll") for (int kk = 0; kk < 2; ++kk) { bf16x8 af[4], bfr[4]; \
            _Pragma("unroll") for (int m = 0; m < 4; ++m) af[m] = *(const bf16x8*)(sA + (wm * 64 + m * 16 + (lane & 15)) * GLD + kk * 32 + (lane >> 4) * 8); \
            _Pragma("unroll") for (int n = 0; n < 4; ++n) bfr[n] = *(const bf16x8*)(sB + (wn * 64 + n * 16 + (lane & 15)) * GLD + kk * 32 + (lane >> 4) * 8); \
            _Pragma("unroll") for (int m = 0; m < 4; ++m) _Pragma("unroll") for (int n = 0; n < 4; ++n) acc[m][n] = __builtin_amdgcn_mfma_f32_16x16x32_bf16(bfr[n], af[m], acc[m][n], 0, 0, 0); } }
    GT_LOAD(raA, rbA, 0)
    GT_LOAD(raB, rbB, 1)
    __syncthreads();
    GT_STORE(raA, rbA, 0)
    __syncthreads();
    for (int kt = 0; kt < nk; kt += 2) {
        if (kt + 2 < nk) GT_LOAD(raA, rbA, kt + 2)
        GT_COMPUTE(0)
        GT_STORE(raB, rbB, 1)
        __syncthreads();
        if (kt + 3 < nk) GT_LOAD(raB, rbB, kt + 3)
        GT_COMPUTE(1)
        if (kt + 2 < nk) GT_STORE(raA, rbA, 0)
        __syncthreads();
    }
#undef GT_LOAD
#undef GT_STORE
#undef GT_COMPUTE
}
struct RowDirect { const bf16_t* A; int lda; int m0; __device__ __forceinline__ const bf16_t* operator()(int r) const { return A + (size_t)(m0 + r) * lda; } };
enum { EPI_INPROJ = 0, EPI_RESID = 1, EPI_BF16 = 2, EPI_BF16_RS = 3, EPI_RESID_NORM = 4 };

__device__ __forceinline__ int vcu_id() { const int G = gridDim.x, bx = blockIdx.x; return (G % 8 == 0) ? (bx % 8) * (G / 8) + bx / 8 : bx; }

template <int EPI>
__device__ __forceinline__ void gemm_phase(char* smem, const bf16_t* A, int lda, const bf16_t* Bt, int ldb, int M, int N, int K, void* out, int ldo, const float* resid, float* gates, int idx0 = -1, int stride = 0, bf16_t* xg = nullptr, const float* gn = nullptr) {
    const int ntn = N / 128, ntiles = (M / 256) * ntn;
    if (stride == 0) { idx0 = vcu_id(); stride = gridDim.x; }
    if (idx0 < 0) return;
    const int lane = TIDX & 63, wave = TIDX >> 6, wm = wave >> 1, wn = wave & 1;
    for (int tIdx = idx0; tIdx < ntiles; tIdx += stride) {
        const int m0 = (tIdx / ntn) * 256, n0 = (tIdx % ntn) * 128;
        f32x4 acc[4][4];
        RowDirect rp{A, lda, m0};
        gemm_tile(smem, rp, Bt, ldb, n0, K, acc);
        float rsc[4] = {1.f, 1.f, 1.f, 1.f};
        if (EPI == EPI_BF16_RS) {
#pragma unroll
            for (int m = 0; m < 4; ++m) rsc[m] = rinv_from_pss(resid, (size_t)(m0 + wm * 64 + m * 16 + (lane & 15)));
        }
        if (EPI == EPI_RESID_NORM) {
#pragma unroll
            for (int m = 0; m < 4; ++m) {
                const int row = m0 + wm * 64 + m * 16 + (lane & 15);
                float ss = 0.f;
#pragma unroll
                for (int n = 0; n < 4; ++n) {
                    const int col = n0 + wn * 64 + n * 16 + (lane >> 4) * 4;
                    const f32x4 o = *(const f32x4*)(resid + (size_t)row * ldo + col) + acc[m][n];
                    *(f32x4*)((float*)out + (size_t)row * ldo + col) = o;
                    ss += (o[0] * o[0] + o[1] * o[1]) + (o[2] * o[2] + o[3] * o[3]);
                    const f32x4 og = o * *(const f32x4*)(gn + col);
                    uint2 w; w.x = pk2(og[0], og[1]); w.y = pk2(og[2], og[3]);
                    *(uint2*)(xg + (size_t)row * ldo + col) = w;
                }
                ss += __shfl_xor(ss, 16); ss += __shfl_xor(ss, 32);
                if ((lane >> 4) == 0) gates[(size_t)row * 16 + (n0 >> 7) * 2 + wn] = ss;
            }
            continue;
        }
#pragma unroll
        for (int m = 0; m < 4; ++m)
#pragma unroll
            for (int n = 0; n < 4; ++n) {
                const int row = m0 + wm * 64 + m * 16 + (lane & 15), col = n0 + wn * 64 + n * 16 + (lane >> 4) * 4;
                const f32x4 v = acc[m][n];
                if (EPI == EPI_INPROJ) {
                    uint2 o; o.x = pk2(v.x, v.y); o.y = pk2(v.z, v.w);
                    *(uint2*)((bf16_t*)out + (size_t)row * ldo + col) = o;
                    if (col >= C_GATE && col < C_GATE + 16) *(f32x4*)(gates + (size_t)row * 16 + (col - C_GATE)) = v;
                } else if (EPI == EPI_RESID) {
                    const f32x4 r = *(const f32x4*)(resid + (size_t)row * ldo + col);
                    *(f32x4*)((float*)out + (size_t)row * ldo + col) = r + v;
                } else if (EPI == EPI_BF16_RS) {
                    const float ri = rsc[m];
                    uint2 o; o.x = pk2(v.x * ri, v.y * ri); o.y = pk2(v.z * ri, v.w * ri);
                    *(uint2*)((bf16_t*)out + (size_t)row * ldo + col) = o;
                } else {
                    uint2 o; o.x = pk2(v.x, v.y); o.y = pk2(v.z, v.w);
                    *(uint2*)((bf16_t*)out + (size_t)row * ldo + col) = o;
                }
            }
    }
}


namespace pg8 {
#define PG8_LAS __attribute__((address_space(3)))
typedef unsigned short bf16_t;
typedef short bf16x8 __attribute__((ext_vector_type(8)));
typedef float f32x4 __attribute__((ext_vector_type(4)));
typedef unsigned u32x4 __attribute__((ext_vector_type(4)));
constexpr int BM = 256, BK = 64, HALF = 128, HTB = HALF * BK * 2  , STAGE_BYTES = 8 * HTB, NXCD = 8, WGM = 8;

__host__ __device__ __forceinline__ int lds_byte(int r, int c) { const int st = (r >> 4) * 2 + (c >> 5), rr = r & 15, cc = c & 31, ob = rr * 64 + cc * 2; return st * 1024 + (ob ^ (((ob >> 9) & 1) << 5)); }
__host__ __device__ __forceinline__ void stage_rc(int b, int& R, int& C) { const int st = b / 1024, sb = b % 1024, swz = sb ^ (((sb >> 9) & 1) << 5); R = (st >> 1) * 16 + swz / 64; C = (st & 1) * 32 + (swz % 64) / 2; }
__host__ __device__ __forceinline__ int perm32(int rho) { const int n = rho >> 4, i = rho & 15; return 8 * (i >> 2) + 4 * n + (i & 3); }

struct Unit { int pm, pn; };
struct Gemm { const bf16_t* A; const bf16_t* Bt; int M, N, K; };

struct StaticOrder {
    int nM, nN, nwg, G, c;
    __host__ __device__ void init(int M, int N, int G_, int c_) { nM = M / BM; nN = N / BM; nwg = nM * nN; G = G_; c = c_; }
    __host__ __device__ bool next(int i, Unit& u) const {
        const long L = (long)i * G + c; if (L >= nwg) return false;
        int wgid = (int)L; { const int q = nwg / NXCD, r = nwg % NXCD, xcd = wgid % NXCD, off = wgid / NXCD; wgid = (xcd < r ? xcd * (q + 1) : r * (q + 1) + (xcd - r) * q) + off; }
        const int nig = WGM * nN, gid = wgid / nig, fm = gid * WGM, gsz = (nM - fm) < WGM ? (nM - fm) : WGM;
        u.pm = fm + ((wgid % nig) % gsz); u.pn = (wgid % nig) / gsz; return true;
    }
    __device__ __forceinline__ void a_ready(const Unit&) const {}
    __device__ __forceinline__ void done(const Unit&) const {}
};
__device__ __forceinline__ unsigned cvt_pk_bf16(float lo, float hi) { unsigned r; asm volatile("v_cvt_pk_bf16_f32 %0, %1, %2" : "=v"(r) : "v"(lo), "v"(hi)); return r; }
typedef float f32x2 __attribute__((ext_vector_type(2)));

struct EpiInProj {
    static constexpr bool PERM = true, AFTER_DRAIN = false;
    bf16_t* O; int ldc; float* gates; int gate_col;
    __device__ __forceinline__ void operator()(const f32x4 (&acc)[2][2][4][2], const Unit& u, int wr, int wc, int fr, int fq) const {
        const int row0 = u.pm * BM + wr * 64 + fr, col0 = u.pn * BM + wc * 32 + 8 * fq;
#pragma unroll
        for (int ai = 0; ai < 2; ++ai)
#pragma unroll
            for (int m = 0; m < 4; ++m) {
                const int row = row0 + ai * HALF + m * 16;
                bf16_t* rowp = O + (size_t)row * ldc + col0;
#pragma unroll
                for (int bj = 0; bj < 2; ++bj) {
                    const f32x4 v0 = acc[ai][bj][m][0], v1 = acc[ai][bj][m][1];
                    u32x4 w; w.x = cvt_pk_bf16(v0[0], v0[1]); w.y = cvt_pk_bf16(v0[2], v0[3]); w.z = cvt_pk_bf16(v1[0], v1[1]); w.w = cvt_pk_bf16(v1[2], v1[3]);
                    *(u32x4*)(rowp + bj * HALF) = w;
                    const int gc = col0 + bj * HALF - gate_col;
                    if (gates && gc >= 0 && gc < 16) { *(f32x4*)(gates + (size_t)row * 16 + gc) = v0; *(f32x4*)(gates + (size_t)row * 16 + gc + 4) = v1; }
                }
            }
    }
};
struct EpiResid {
    static constexpr bool PERM = false, AFTER_DRAIN = false;
    const float* base; float* out; int ldc;
    __device__ __forceinline__ void operator()(const f32x4 (&acc)[2][2][4][2], const Unit& u, int wr, int wc, int fr, int fq) const {
        const int col0 = u.pn * BM + wc * 32 + 4 * fq;
#pragma unroll
        for (int ai = 0; ai < 2; ++ai)
#pragma unroll
            for (int m = 0; m < 4; ++m) {
                const size_t off = (size_t)(u.pm * BM + ai * HALF + wr * 64 + m * 16 + fr) * ldc + col0;
#pragma unroll
                for (int bj = 0; bj < 2; ++bj)
#pragma unroll
                    for (int n = 0; n < 2; ++n) { const f32x4 bs = *(const f32x4*)(base + off + bj * HALF + n * 16); *(f32x4*)(out + off + bj * HALF + n * 16) = bs + acc[ai][bj][m][n]; }
                if (m & 1) asm volatile("" ::: "memory");
            }
    }
};

struct EpiResidNorm {
    static constexpr bool PERM = false, AFTER_DRAIN = false;
    const float* base; float* out; int ldc; const float* gn; bf16_t* xg; float* pss;
    __device__ __forceinline__ void operator()(const f32x4 (&acc)[2][2][4][2], const Unit& u, int wr, int wc, int fr, int fq) const {
        const int col0 = u.pn * BM + wc * 32 + 4 * fq;
        f32x4 gv[2][2];
#pragma unroll
        for (int bj = 0; bj < 2; ++bj)
#pragma unroll
            for (int n = 0; n < 2; ++n) gv[bj][n] = *(const f32x4*)(gn + col0 + bj * HALF + n * 16);
#pragma unroll
        for (int ai = 0; ai < 2; ++ai)
#pragma unroll
            for (int m = 0; m < 4; ++m) {
                const int row = u.pm * BM + ai * HALF + wr * 64 + m * 16 + fr;
                const size_t off = (size_t)row * ldc + col0;
                float ss = 0.f;
#pragma unroll
                for (int bj = 0; bj < 2; ++bj)
#pragma unroll
                    for (int n = 0; n < 2; ++n) {
                        const f32x4 bs = *(const f32x4*)(base + off + bj * HALF + n * 16);
                        const f32x4 o = bs + acc[ai][bj][m][n];
                        *(f32x4*)(out + off + bj * HALF + n * 16) = o;
                        ss += (o[0] * o[0] + o[1] * o[1]) + (o[2] * o[2] + o[3] * o[3]);
                        const f32x4 og = o * gv[bj][n];
                        uint2 w; w.x = cvt_pk_bf16(og[0], og[1]); w.y = cvt_pk_bf16(og[2], og[3]);
                        *(uint2*)(xg + off + bj * HALF + n * 16) = w;
                    }
                ss += __shfl_xor(ss, 16); ss += __shfl_xor(ss, 32);
                if (fq == 0) pss[(size_t)row * 16 + u.pn * 4 + wc] = ss;
                if (m & 1) asm volatile("" ::: "memory");
            }
    }
};
template <class Epi, class Sched, bool ALIGN_EPI = false, bool SP2 = false>
__device__ __forceinline__ void gemm_phase(PG8_LAS unsigned char* lds, const Gemm g, const Sched& S, const Epi& E) {
    const int tid = TIDX, wid = __builtin_amdgcn_readfirstlane(tid >> 6), lane = tid & 63, wr = wid >> 2, wc = wid & 3, fr = lane & 15, fq = lane >> 4;
    const int K = g.K, nt = K / BK;
    unsigned voffA[2], voffB[2];
#pragma unroll
    for (int i = 0; i < 2; ++i) { int R, C; stage_rc(tid * 16 + i * 8192, R, C); const int Rb = Epi::PERM ? ((R & ~31) + perm32(R & 31)) : R;
        voffA[i] = (unsigned)(R * K + C) * 2u; voffB[i] = (unsigned)(Rb * K + C) * 2u; }
    const size_t kstep = (size_t)(BK * 2);
    const size_t hstep = (size_t)HALF * K * 2;
    const size_t tstep = 2 * hstep;
    const unsigned ldsw = (unsigned)wid * 1024u;
    const int aoff = lds_byte(wr * 64 + fr, fq * 8), boff = lds_byte(wc * 32 + fr, fq * 8);
#define PG8_SA(b, h) (((b) * 2 + (h)) * HTB)
#define PG8_SB(b, h) ((4 + (b) * 2 + (h)) * HTB)
#define PG8_STAGE(bufoff, gbase, voff) do { _Pragma("unroll") for (int _i = 0; _i < 2; ++_i) \
        __builtin_amdgcn_global_load_lds((const unsigned*)((const char*)(gbase) + (voff)[_i]), (PG8_LAS unsigned*)(lds + (bufoff) + ldsw + _i * 8192), 16, 0, 0); } while (0)
#define PG8_LDA(dst, b, h) do { _Pragma("unroll") for (int m = 0; m < 4; ++m) _Pragma("unroll") for (int k = 0; k < 2; ++k) dst[m][k] = *(const PG8_LAS bf16x8*)(lds + PG8_SA(b, h) + aoff + m * 2048 + k * 1024); } while (0)
#define PG8_LDB(dst, b, h) do { _Pragma("unroll") for (int n = 0; n < 2; ++n) _Pragma("unroll") for (int k = 0; k < 2; ++k) dst[n][k] = *(const PG8_LAS bf16x8*)(lds + PG8_SB(b, h) + boff + n * 2048 + k * 1024); } while (0)
#define PG8_MMA(ai, bj, At, Bt) do { __builtin_amdgcn_s_setprio(1); _Pragma("unroll") for (int m = 0; m < 4; ++m) _Pragma("unroll") for (int n = 0; n < 2; ++n) _Pragma("unroll") for (int k = 0; k < 2; ++k) \
        acc[ai][bj][m][n] = __builtin_amdgcn_mfma_f32_16x16x32_bf16(Bt[n][k], At[m][k], acc[ai][bj][m][n], 0, 0, 0); __builtin_amdgcn_s_setprio(0); } while (0)
#define PG8_WAIT_V(n) asm volatile("s_waitcnt vmcnt(" #n ")" ::: "memory")
#define PG8_WAIT_L(n) asm volatile("s_waitcnt lgkmcnt(" #n ")" ::: "memory")
#define PG8_BAR __builtin_amdgcn_s_barrier()
#define PG8_SCHED __builtin_amdgcn_sched_barrier(0)
    Unit cur, nxt; int ui = 0;
    if (!S.next(0, cur)) return;
    f32x4 acc[2][2][4][2];
#pragma unroll
    for (int a = 0; a < 2; ++a)
#pragma unroll
        for (int b = 0; b < 2; ++b)
#pragma unroll
            for (int m = 0; m < 4; ++m)
#pragma unroll
                for (int n = 0; n < 2; ++n) acc[a][b][m][n] = (f32x4){0.f, 0.f, 0.f, 0.f};
    bf16x8 At[4][2], B0[2][2], B1[2][2];
    const char* cA = (const char*)g.A + (size_t)cur.pm * tstep; const char* cB = (const char*)g.Bt + (size_t)cur.pn * tstep;
    S.a_ready(cur);
    if constexpr (SP2) {
        PG8_STAGE(PG8_SB(0, 0), cB, voffB); PG8_STAGE(PG8_SB(0, 1), cB + hstep, voffB); PG8_STAGE(PG8_SA(0, 0), cA, voffA); PG8_STAGE(PG8_SA(0, 1), cA + hstep, voffA);
        if (wr == 1) PG8_BAR;
        PG8_WAIT_V(2); PG8_BAR;
        PG8_STAGE(PG8_SB(1, 0), cB + kstep, voffB); PG8_STAGE(PG8_SA(1, 0), cA + kstep, voffA); PG8_STAGE(PG8_SB(1, 1), cB + hstep + kstep, voffB);
        PG8_WAIT_V(6); PG8_BAR;
    } else {
        PG8_STAGE(PG8_SB(0, 0), cB, voffB); PG8_STAGE(PG8_SA(0, 0), cA, voffA); PG8_STAGE(PG8_SB(0, 1), cB + hstep, voffB); PG8_STAGE(PG8_SA(0, 1), cA + hstep, voffA);
        if (wr == 1) PG8_BAR;
        PG8_WAIT_V(4); PG8_BAR;
        PG8_STAGE(PG8_SB(1, 0), cB + kstep, voffB); PG8_STAGE(PG8_SA(1, 0), cA + kstep, voffA); PG8_STAGE(PG8_SB(1, 1), cB + hstep + kstep, voffB);
        PG8_WAIT_V(6); PG8_BAR;
    }
    for (;;) {
        const bool has_next = S.next(ui + 1, nxt);
        const char* nA = has_next ? (const char*)g.A + (size_t)nxt.pm * tstep : cA; const char* nB = has_next ? (const char*)g.Bt + (size_t)nxt.pn * tstep : cB;
        for (int t = 0; t < nt; t += 2) {
            const bool last = (t == nt - 2);
            const char* a1 = cA + (size_t)(t + 1) * kstep;
            const char* a2 = last ? nA : cA + (size_t)(t + 2) * kstep; const char* b2 = last ? nB : cB + (size_t)(t + 2) * kstep;
            const char* a3 = a2 + kstep; const char* b3 = b2 + kstep;
            if (last && has_next) S.a_ready(nxt);
            if constexpr (SP2) {
            PG8_LDB(B0, 0, 0); PG8_LDB(B1, 0, 1); PG8_SCHED; PG8_LDA(At, 0, 0); PG8_STAGE(PG8_SA(1, 1), a1 + hstep, voffA);
            PG8_WAIT_V(8); PG8_WAIT_L(0); PG8_BAR; PG8_MMA(0, 0, At, B0); PG8_MMA(0, 1, At, B1); PG8_BAR; PG8_SCHED;
            PG8_LDA(At, 0, 1); PG8_STAGE(PG8_SB(0, 0), b2, voffB); PG8_STAGE(PG8_SB(0, 1), b2 + hstep, voffB); PG8_STAGE(PG8_SA(0, 0), a2, voffA);
            PG8_WAIT_V(8); PG8_WAIT_L(0); PG8_BAR; PG8_MMA(1, 0, At, B0); PG8_MMA(1, 1, At, B1); PG8_BAR; PG8_SCHED;
            PG8_LDB(B0, 1, 0); PG8_LDB(B1, 1, 1); PG8_SCHED; PG8_LDA(At, 1, 0); PG8_STAGE(PG8_SA(0, 1), a2 + hstep, voffA);
            PG8_WAIT_V(8); PG8_WAIT_L(0); PG8_BAR; PG8_MMA(0, 0, At, B0); PG8_MMA(0, 1, At, B1); PG8_BAR; PG8_SCHED;
            PG8_LDA(At, 1, 1); PG8_STAGE(PG8_SB(1, 0), b3, voffB); PG8_STAGE(PG8_SB(1, 1), b3 + hstep, voffB); PG8_STAGE(PG8_SA(1, 0), a3, voffA);
            PG8_WAIT_V(8); PG8_WAIT_L(0); PG8_BAR; PG8_MMA(1, 0, At, B0); PG8_MMA(1, 1, At, B1); PG8_BAR; PG8_SCHED;
            } else {
            PG8_LDB(B0, 0, 0); PG8_SCHED; PG8_LDA(At, 0, 0); PG8_STAGE(PG8_SA(1, 1), a1 + hstep, voffA);
            PG8_WAIT_L(8); PG8_BAR; PG8_WAIT_L(0); PG8_MMA(0, 0, At, B0); PG8_BAR; PG8_SCHED;
            PG8_LDB(B1, 0, 1); PG8_STAGE(PG8_SB(0, 0), b2, voffB);
            PG8_BAR; PG8_WAIT_L(0); PG8_MMA(0, 1, At, B1); PG8_BAR;
            PG8_LDA(At, 0, 1); PG8_STAGE(PG8_SA(0, 0), a2, voffA);
            PG8_BAR; PG8_WAIT_L(0); PG8_MMA(1, 0, At, B0); PG8_BAR; PG8_SCHED;
            PG8_STAGE(PG8_SB(0, 1), b2 + hstep, voffB);
            PG8_WAIT_V(6); PG8_BAR; PG8_MMA(1, 1, At, B1); PG8_BAR;
            PG8_LDB(B0, 1, 0); PG8_SCHED; PG8_LDA(At, 1, 0); PG8_STAGE(PG8_SA(0, 1), a2 + hstep, voffA);
            PG8_WAIT_L(8); PG8_BAR; PG8_WAIT_L(0); PG8_MMA(0, 0, At, B0); PG8_BAR; PG8_SCHED;
            PG8_LDB(B1, 1, 1); PG8_STAGE(PG8_SB(1, 0), b3, voffB);
            PG8_BAR; PG8_WAIT_L(0); PG8_MMA(0, 1, At, B1); PG8_BAR;
            PG8_LDA(At, 1, 1); PG8_STAGE(PG8_SA(1, 0), a3, voffA);
            PG8_BAR; PG8_WAIT_L(0); PG8_MMA(1, 0, At, B0); PG8_BAR; PG8_SCHED;
            PG8_STAGE(PG8_SB(1, 1), b3 + hstep, voffB);
            PG8_WAIT_V(6); PG8_BAR; PG8_MMA(1, 1, At, B1); PG8_BAR;
            }
        }
        if constexpr (ALIGN_EPI) { if (wr == 0) PG8_BAR; }
        if constexpr (!Epi::AFTER_DRAIN) { E(acc, cur, wr, wc, fr, fq); S.done(cur); }
        if (!has_next) break;
#pragma unroll
        for (int a = 0; a < 2; ++a)
#pragma unroll
            for (int b = 0; b < 2; ++b)
#pragma unroll
                for (int m = 0; m < 4; ++m)
#pragma unroll
                    for (int n = 0; n < 2; ++n) acc[a][b][m][n] = (f32x4){0.f, 0.f, 0.f, 0.f};
        cur = nxt; cA = nA; cB = nB; ++ui;
        if constexpr (ALIGN_EPI) { if (wr == 1) PG8_BAR; }
    }
    PG8_WAIT_V(0);
    if constexpr (!ALIGN_EPI) { if (wr == 0) PG8_BAR; }
    PG8_BAR;
    if constexpr (Epi::AFTER_DRAIN) { E.fused(acc, cur, wr, wc, fr, fq, lds, wid, lane); S.done(cur); }
#undef PG8_SA
#undef PG8_SB
#undef PG8_STAGE
#undef PG8_LDA
#undef PG8_LDB
#undef PG8_MMA
#undef PG8_WAIT_V
#undef PG8_WAIT_L
#undef PG8_BAR
#undef PG8_SCHED
}
}

struct RowGather { const bf16_t* A; int lda; const int* ids; int shift; __device__ __forceinline__ const bf16_t* operator()(int r) const { return A + (size_t)(ids[r] >> shift) * lda; } };
template <int STAGE>
__device__ __forceinline__ void moe_phase(char* smem, const bf16_t* A, int lda, const bf16_t* Wt, size_t wstride, int ldb, int K, const int* cnt, const int* list, const float* pgate, bf16_t* out, const float* pss) {
    int* ids = (int*)(smem + GEMM_LDS);
    int* tpre = ids + 256;
    constexpr int NTN = (STAGE == 1) ? 4 : 8;
    __syncthreads();
    if (TIDX < 64) {
        const int ln = TIDX; int nt = (ln < NEXP) ? ((cnt[ln * CNT_STRIDE] + 255) >> 8) : 0; int inc = nt;
#pragma unroll
        for (int o = 1; o < 64; o <<= 1) { const int nb = __shfl_up(inc, o); if (ln >= o) inc += nb; }
        if (ln <= NEXP) tpre[ln] = inc - nt;
    }
    __syncthreads();
    const int ntiles = tpre[NEXP] * NTN;
    const int lane = TIDX & 63, wave = TIDX >> 6, wm = wave >> 1, wn = wave & 1;
    for (int tIdx = vcu_id(); tIdx < ntiles; tIdx += gridDim.x) {
        const int mtg = tIdx / NTN, n0 = (tIdx % NTN) * 128;
        int e = 0;
        for (int i = 1; i < NEXP; ++i) if (tpre[i] <= mtg) e = i;
        const int mt = mtg - tpre[e];
        const int cn = cnt[e * CNT_STRIDE];
        __syncthreads();
        if (TIDX < 256) { const int pos = mt * 256 + TIDX; ids[TIDX] = list[(size_t)e * T + (pos < cn ? pos : cn - 1)]; }
        __syncthreads();
        f32x4 acc[4][4];
        RowGather rp{A, lda, ids, STAGE == 1 ? 1 : 0};
        gemm_tile(smem, rp, Wt + (size_t)e * wstride, ldb, n0, K, acc);
#pragma unroll
        for (int m = 0; m < 4; ++m) {
            const int rl = wm * 64 + m * 16 + (lane & 15);
            if (mt * 256 + rl >= cn) continue;
            const int pid = ids[rl];
            if (STAGE == 1) {
                const float gt = pgate[pid], ri = rinv_from_pss(pss, (size_t)(pid >> 1));
#pragma unroll
                for (int np = 0; np < 2; ++np) {
                    const f32x4 g = acc[m][2 * np], u = acc[m][2 * np + 1];
                    const int j = (n0 + wn * 64 + np * 32) / 2 + (lane >> 4) * 4;
                    const f32x4 gs = g * ri; const float ug = ri * gt;
                    uint2 o; o.x = pk2(siluf_(gs.x) * u.x * ug, siluf_(gs.y) * u.y * ug); o.y = pk2(siluf_(gs.z) * u.z * ug, siluf_(gs.w) * u.w * ug);
                    *(uint2*)(out + (size_t)pid * DEXP + j) = o;
                }
            } else {
#pragma unroll
                for (int n = 0; n < 4; ++n) {
                    const f32x4 v = acc[m][n]; const int col = n0 + wn * 64 + n * 16 + (lane >> 4) * 4;
                    uint2 o; o.x = pk2(v.x, v.y); o.y = pk2(v.z, v.w);
                    *(uint2*)(out + (size_t)pid * 1024 + col) = o;
                }
            }
        }
    }
}

__device__ __forceinline__ void hgrn2_naive(const bf16_t* __restrict__ proj, const float* __restrict__ hgrn_lb, int layer, const float* __restrict__ mix_gain, bf16_t* __restrict__ y, int bh, int lane) {
    const int b = bh >> 2, h = bh & 3;
    float lbk = 0.f;
    if (layer == 1) { float a0 = hgrn_lb[h * 64 + lane], a1 = hgrn_lb[256 + h * 64 + lane]; lbk = 1.f / (1.f + __expf(a0 - a1)); }
    const float mg = mix_gain[C_AQ + h * 64 + lane];
    float S[64];
#pragma unroll
    for (int k = 0; k < 64; ++k) S[k] = 0.f;
    for (int t = 0; t < SEQ; ++t) {
        const bf16_t* pr = proj + (size_t)(b * SEQ + t) * NP + h * 64 + lane;
        const float qk = siluf_(bf2f(pr[C_AQ]));
        const float sg = sigmoidf_(bf2f(pr[C_AF]));
        const float f = lbk + (1.f - lbk) * sg, kk = (1.f - lbk) * (1.f - sg);
        const float iv = bf2f(pr[C_AI]);
        const float gv = bf2f(pr[C_AG]);
        float o = 0.f;
#pragma unroll
        for (int k = 0; k < 64; ++k) { S[k] = rdlane(f, k) * S[k] + rdlane(kk, k) * iv; o += rdlane(qk, k) * S[k]; }
        const float ms = wave_sum(o * o) * (1.f / 64.f);
        const float yv = o * rsqrtf(ms + EPS) * siluf_(gv) * mg;
        y[(size_t)(b * SEQ + t) * 1024 + 0 + h * 64 + lane] = f2bf(yv);
    }
}
__device__ __forceinline__ void gdn_naive(const bf16_t* __restrict__ proj, const float* __restrict__ gates, const float* __restrict__ conv_w  ,
                                          const float* __restrict__ a_log, const float* __restrict__ dt_bias, const float* __restrict__ mix_gain, bf16_t* __restrict__ y, int bh, int lane) {
    const int b = bh >> 2, h = bh & 3;
    float wq[4], wk[4], wv[4];
#pragma unroll
    for (int j = 0; j < 4; ++j) { wq[j] = conv_w[j * 768 + h * 64 + lane]; wk[j] = conv_w[j * 768 + 256 + h * 64 + lane]; wv[j] = conv_w[j * 768 + 512 + h * 64 + lane]; }
    float xq[3] = {0.f, 0.f, 0.f}, xk[3] = {0.f, 0.f, 0.f}, xv[3] = {0.f, 0.f, 0.f};
    const float Aexp = __expf(a_log[h]), dtb = dt_bias[h];
    const float mg = mix_gain[768 + h * 64 + lane];
    float S[64];
#pragma unroll
    for (int k = 0; k < 64; ++k) S[k] = 0.f;
    for (int t = 0; t < SEQ; ++t) {
        const size_t row = (size_t)(b * SEQ + t);
        const bf16_t* pr = proj + row * NP + h * 64 + lane;
        const float q0 = bf2f(pr[C_DQ]), k0 = bf2f(pr[C_DK]), v0 = bf2f(pr[C_DV]), zv = bf2f(pr[C_DZ]);
        float q = siluf_(wq[0] * xq[0] + wq[1] * xq[1] + wq[2] * xq[2] + wq[3] * q0);
        float k = siluf_(wk[0] * xk[0] + wk[1] * xk[1] + wk[2] * xk[2] + wk[3] * k0);
        float v = siluf_(wv[0] * xv[0] + wv[1] * xv[1] + wv[2] * xv[2] + wv[3] * v0);
        xq[0] = xq[1]; xq[1] = xq[2]; xq[2] = q0; xk[0] = xk[1]; xk[1] = xk[2]; xk[2] = k0; xv[0] = xv[1]; xv[1] = xv[2]; xv[2] = v0;
        q = q * rsqrtf(wave_sum(q * q) + EPS) * 0.125f;
        k = k * rsqrtf(wave_sum(k * k) + EPS);
        const float beta = sigmoidf_(gates[row * 16 + 4 + h]);
        const float g = -Aexp * softplusf_(gates[row * 16 + 8 + h] + dtb);
        const float eg = __expf(g);
        float r = 0.f;
#pragma unroll
        for (int i = 0; i < 64; ++i) { S[i] *= eg; r += rdlane(k, i) * S[i]; }
        const float dlt = beta * (v - r);
        float o = 0.f;
#pragma unroll
        for (int i = 0; i < 64; ++i) { S[i] += rdlane(k, i) * dlt; o += rdlane(q, i) * S[i]; }
        const float ms = wave_sum(o * o) * (1.f / 64.f);
        const float yv = o * rsqrtf(ms + EPS) * siluf_(zv) * mg;
        y[row * 1024 + 768 + h * 64 + lane] = f2bf(yv);
    }
}
__device__ __forceinline__ void fox_cumsum(const float* __restrict__ gates, const float* __restrict__ fb, float* __restrict__ cc, int bh, int lane) {
    const int b = bh >> 2, h = bh & 3;
    const float bias = fb[h];
    float v[32];
#pragma unroll
    for (int i = 0; i < 32; ++i) v[i] = gates[(size_t)(b * SEQ + lane * 32 + i) * 16 + h];
    float run = 0.f;
#pragma unroll
    for (int i = 0; i < 32; ++i) { run += logsigmoidf_(v[i] + bias); v[i] = run; }
    float tot = run;
#pragma unroll
    for (int o = 1; o < 64; o <<= 1) { const float nb = __shfl_up(tot, o); if (lane >= o) tot += nb; }
    const float off = tot - run;
    float* dst = cc + (size_t)(b * 4 + h) * SEQ + lane * 32;
#pragma unroll
    for (int i = 0; i < 32; i += 4) *(f32x4*)(dst + i) = (f32x4){v[i] + off, v[i + 1] + off, v[i + 2] + off, v[i + 3] + off};
}
__device__ __forceinline__ void lru_prep_task(float* xc  , const bf16_t* __restrict__ proj, const float* __restrict__ conv_w, const float* __restrict__ conv_b,
                                              const float* __restrict__ w_a, const float* __restrict__ b_a, const float* __restrict__ w_x, const float* __restrict__ b_x,
                                              const float* __restrict__ lam, float* __restrict__ a_out, float* __restrict__ u_out, int task, bool active) {
    const int c = TIDX & 255, t0 = task * 16;
    if (active) {
        const float w0 = conv_w[c], w1 = conv_w[256 + c], w2 = conv_w[512 + c], w3 = conv_w[768 + c], cb = conv_b[c];
        for (int i = 0; i < 16; ++i) {
            const int t = t0 + i, s = t & (SEQ - 1);
            const bf16_t* pr = proj + (size_t)t * NP + C_CX + c;
            float acc = cb + w3 * bf2f(pr[0]);
            if (s >= 1) acc += w2 * bf2f(pr[-(ptrdiff_t)NP]);
            if (s >= 2) acc += w1 * bf2f(pr[-(ptrdiff_t)2 * NP]);
            if (s >= 3) acc += w0 * bf2f(pr[-(ptrdiff_t)3 * NP]);
            xc[i * 256 + c] = acc;
        }
    }
    __syncthreads();
    if (active) {
        const int h = c >> 6, jj = c & 63;
        float ra[16], rx[16];
#pragma unroll
        for (int i = 0; i < 16; ++i) { ra[i] = 0.f; rx[i] = 0.f; }
        for (int k = 0; k < 64; ++k) {
            const float wa = w_a[(h * 64 + k) * 64 + jj], wx = w_x[(h * 64 + k) * 64 + jj];
#pragma unroll
            for (int i = 0; i < 16; ++i) { const float xv = xc[i * 256 + h * 64 + k]; ra[i] += xv * wa; rx[i] += xv * wx; }
        }
        const float ba = b_a[c], bx = b_x[c], sp = softplusf_(-lam[c]);
#pragma unroll
        for (int i = 0; i < 16; ++i) {
            const float r = sigmoidf_(ra[i] + ba), ig = sigmoidf_(rx[i] + bx);
            const float log_a = -8.f * r * sp;
            const float a = __expf(log_a);
            const float u = sqrtf(-expm1f(2.f * log_a)) * (ig * xc[i * 256 + c]);
            a_out[(size_t)(t0 + i) * 256 + c] = a; u_out[(size_t)(t0 + i) * 256 + c] = u;
        }
    }
    __syncthreads();
}
__device__ __forceinline__ void lru_scan_task(const float* __restrict__ a_in, const float* __restrict__ u_in, const bf16_t* __restrict__ proj, const float* __restrict__ mix_gain, bf16_t* __restrict__ y, int b) {
    const int c = TIDX;
    const float mg = mix_gain[512 + c];
    float hst = 0.f;
    for (int t = 0; t < SEQ; ++t) {
        const size_t row = (size_t)(b * SEQ + t);
        hst = a_in[row * 256 + c] * hst + u_in[row * 256 + c];
        const float yv = hst * geluf_(bf2f(proj[row * NP + C_CG + c]));
        const float ms = wave_sum(yv * yv) * (1.f / 64.f);
        y[row * 1024 + 512 + c] = f2bf(yv * rsqrtf(ms + EPS) * mg);
    }
}

typedef short s16x4 __attribute__((ext_vector_type(4)));
#define LDS_AS __attribute__((address_space(3)))
__device__ __forceinline__ bf16x8 frag_rm(const bf16_t* tile, int ld, int r0, int k0, int lane) { return *(const bf16x8*)(tile + (r0 + (lane & 15)) * ld + k0 + (lane >> 4) * 8); }
__device__ __forceinline__ s16x4 tr4(const bf16_t* tile, int ld, int rbase, int c0, int lane) {
    const bf16_t* p = tile + (rbase + ((lane & 15) >> 2)) * ld + c0 + 4 * (lane & 3);
    return __builtin_amdgcn_ds_read_tr16_b64_v4i16((LDS_AS s16x4*)p);
}
__device__ __forceinline__ bf16x8 frag_cm(const bf16_t* tile, int ld, int k0, int c0, int lane) {
    const s16x4 lo = tr4(tile, ld, k0 + (lane >> 4) * 8, c0, lane), hi = tr4(tile, ld, k0 + (lane >> 4) * 8 + 4, c0, lane);
    return (bf16x8){lo[0], lo[1], lo[2], lo[3], hi[0], hi[1], hi[2], hi[3]};
}
#define MFMA16(a, b, c) __builtin_amdgcn_mfma_f32_16x16x32_bf16((a), (b), (c), 0, 0, 0)
constexpr int TLD = 72;


#define XB_TMO      128
#define XB_XCNT(j)  (256  + 64 * (j))
#define XB_XSUB(j)  (1280 + 64 * (j))
#define XB_XGEN(j)  (2304 + 64 * (j))
#define XB_TOP      3328
#define XB_TOPGEN   3392
#define XCD_BAR_WORDS 3456
#define XB_SPIN_CAP (1u << 18)
__device__ __forceinline__ unsigned xb_ld(unsigned* p)              { return __hip_atomic_load(p, __ATOMIC_RELAXED, __HIP_MEMORY_SCOPE_AGENT); }
__device__ __forceinline__ unsigned xb_add(unsigned* p, unsigned v) { return __hip_atomic_fetch_add(p, v, __ATOMIC_RELAXED, __HIP_MEMORY_SCOPE_AGENT); }
__device__ __forceinline__ unsigned xb_xcc_id() { return (unsigned)__builtin_amdgcn_s_getreg((3 << 11) | 20) & 0xFu; }
#define XB_SPIN(cond, bar) do { unsigned _sp = 0; while (cond) { __builtin_amdgcn_s_sleep(1); \
    if ((++_sp & 255u) == 0u) { if (xb_ld(&(bar)[XB_TMO])) break; if (_sp > XB_SPIN_CAP) { atomicAdd(&(bar)[XB_TMO], 1u); break; } } } } while (0)
struct XcdBarrier { unsigned* bar; unsigned x; volatile LDS_AS unsigned* st; };
__device__ __forceinline__ XcdBarrier xcd_barrier_post(unsigned* bar, volatile LDS_AS unsigned* st) {
    XcdBarrier b; b.bar = bar; b.x = xb_xcc_id(); b.st = st;
    if (TIDX == 0) (void)xb_add(&bar[XB_XCNT(b.x)], 1u);
    return b;
}
__device__ __forceinline__ void xcd_barrier_complete(unsigned* bar, unsigned x, unsigned& nloc, unsigned& nx) {
    const unsigned G = gridDim.x * gridDim.y * gridDim.z;
    unsigned sum, cnt, mine, sp = 0u;
    for (;;) {
        sum = 0u; cnt = 0u; mine = 0u;
#pragma unroll
        for (unsigned j = 0; j < 16; ++j) { const unsigned c = xb_ld(&bar[XB_XCNT(j)]); sum += c; cnt += (c > 0u) ? 1u : 0u; mine = (j == x) ? c : mine; }
        if (sum == G) break;
        __builtin_amdgcn_s_sleep(1);
        if ((++sp & 255u) == 0u) { if (xb_ld(&bar[XB_TMO])) break; if (sp > XB_SPIN_CAP) { atomicAdd(&bar[XB_TMO], 1u); break; } }
    }
    nloc = mine > 0u ? mine : 1u; nx = cnt > 0u ? cnt : 1u;
}
__device__ __forceinline__ void xcd_barrier(const XcdBarrier& b) {
    asm volatile("s_waitcnt vmcnt(0)" ::: "memory");
    __syncthreads();
    if (TIDX == 0) {
        unsigned* bar = b.bar;
        __builtin_amdgcn_s_waitcnt(0);
        unsigned nloc = b.st[0], nx = b.st[1];
        if (nloc == 0u) { xcd_barrier_complete(bar, b.x, nloc, nx); b.st[0] = nloc; b.st[1] = nx; }
        const unsigned old = xb_add(&bar[XB_XSUB(b.x)], 1u);
        const unsigned gen = old / nloc;
        if (old + 1u == (gen + 1u) * nloc) {
            __builtin_amdgcn_fence(__ATOMIC_RELEASE, "agent");
            asm volatile("s_waitcnt vmcnt(0)" ::: "memory");
            const unsigned og = xb_add(&bar[XB_TOP], 1u);
            const unsigned tg = og / nx;
            if (og + 1u == (tg + 1u) * nx) xb_add(&bar[XB_TOPGEN], 1u);
            else XB_SPIN(xb_ld(&bar[XB_TOPGEN]) == tg, bar);
            __builtin_amdgcn_fence(__ATOMIC_ACQUIRE, "agent");
            xb_add(&bar[XB_XGEN(b.x)], 1u);
            asm volatile("s_waitcnt vmcnt(0)" ::: "memory");
        } else {
            XB_SPIN(xb_ld(&bar[XB_XGEN(b.x)]) == gen, bar);
            __builtin_amdgcn_fence(__ATOMIC_ACQUIRE, "agent");
            asm volatile("s_waitcnt vmcnt(0)" ::: "memory");
        }
    }
    __syncthreads();
}

template <bool MASK, int NS>
__device__ __forceinline__ void attn_compute_t(const bf16_t* cK, const bf16_t* cV, const float* cC, const bf16x8 (&qf)[2], f32x4 (&oacc)[4], float& mrun, float& lrun,
                                               float ct2, float scale2, int key0, int tq, int lane, int g) {
    f32x4 sacc[4 * NS];
#pragma unroll
    for (int n = 0; n < 4 * NS; ++n) {
        sacc[n] = (f32x4){0.f, 0.f, 0.f, 0.f};
#pragma unroll
        for (int kk = 0; kk < 2; ++kk) sacc[n] = MFMA16(frag_rm(cK, TLD, n * 16, kk * 32, lane), qf[kk], sacc[n]);
    }
    float mx = -INFINITY;
#pragma unroll
    for (int n = 0; n < 4 * NS; ++n) {
        const f32x4 cs = *(const f32x4*)(cC + n * 16 + 4 * g);
#pragma unroll
        for (int r = 0; r < 4; ++r) {
            float v = sacc[n][r] * scale2 + (ct2 - cs[r]);
            if (MASK) { if (key0 + n * 16 + 4 * g + r > tq) v = -INFINITY; }
            sacc[n][r] = v; mx = fmaxf(mx, v);
        }
    }
    mx = fmaxf(mx, __shfl_xor(mx, 16)); mx = fmaxf(mx, __shfl_xor(mx, 32));
    const float mnew = fmaxf(mrun, mx);
    const float corr = __builtin_amdgcn_exp2f(mrun - mnew);
    float rs = 0.f;
#pragma unroll
    for (int n = 0; n < 4 * NS; ++n)
#pragma unroll
        for (int r = 0; r < 4; ++r) { const float p = __builtin_amdgcn_exp2f(sacc[n][r] - mnew); sacc[n][r] = p; rs += p; }
    rs += __shfl_xor(rs, 16); rs += __shfl_xor(rs, 32);
    lrun = lrun * corr + rs; mrun = mnew;
    bf16x8 pf[2 * NS];
#pragma unroll
    for (int kk = 0; kk < 2 * NS; ++kk) {
        const u32x4 pk = (u32x4){pk2(sacc[2 * kk][0], sacc[2 * kk][1]), pk2(sacc[2 * kk][2], sacc[2 * kk][3]), pk2(sacc[2 * kk + 1][0], sacc[2 * kk + 1][1]), pk2(sacc[2 * kk + 1][2], sacc[2 * kk + 1][3])};
        pf[kk] = __builtin_bit_cast(bf16x8, pk);
    }
#pragma unroll
    for (int n2 = 0; n2 < 4; ++n2) {
        oacc[n2] = oacc[n2] * corr;
#pragma unroll
        for (int kk = 0; kk < 2 * NS; ++kk) {
            const s16x4 lo = tr4(cV, TLD, (2 * kk) * 16 + 4 * g, n2 * 16, lane), hi = tr4(cV, TLD, (2 * kk + 1) * 16 + 4 * g, n2 * 16, lane);
            const bf16x8 vf = (bf16x8){lo[0], lo[1], lo[2], lo[3], hi[0], hi[1], hi[2], hi[3]};
            oacc[n2] = MFMA16(vf, pf[kk], oacc[n2]);
        }
    }
}
__device__ __forceinline__ void attn_compute(const bf16_t* cK, const bf16_t* cV, const float* cC, const bf16x8 (&qf)[2], f32x4 (&oacc)[4], float& mrun, float& lrun,
                                             float ct2, float scale2, int causal, int key0, int r0, int tq, int lane, int g) {
    if (!causal || key0 + 127 <= r0) { attn_compute_t<false, 2>(cK, cV, cC, qf, oacc, mrun, lrun, ct2, scale2, key0, tq, lane, g); return; }
    if (key0 > r0 + 15) return;
    if (key0 + 64 > r0 + 15) attn_compute_t<true, 1>(cK, cV, cC, qf, oacc, mrun, lrun, ct2, scale2, key0, tq, lane, g);
    else attn_compute_t<true, 2>(cK, cV, cC, qf, oacc, mrun, lrun, ct2, scale2, key0, tq, lane, g);
}

__device__ __forceinline__ void attn_task(char* smem, const bf16_t* __restrict__ Q, int ldq, const bf16_t* __restrict__ Kp, int ldk, const bf16_t* __restrict__ Vp, int ldv, const float* __restrict__ bias,
                                          int nq_per_b, int nk_per_b, int causal, float scale, bf16_t* __restrict__ O, int ldo, const float* __restrict__ gain, int rms, int task) {
    constexpr int KT = 128;
    bf16_t* sK = (bf16_t*)smem;
    bf16_t* sV = sK + 2 * KT * TLD;
    float* sC = (float*)(sV + 2 * KT * TLD);
    const int tid = TIDX, lane = tid & 63, wave = tid >> 6, g = lane >> 4, li = lane & 15;
    const int nqt = nq_per_b / 128;
    const int qt = task % nqt, h = (task / nqt) & 3, b = task / (nqt * 4);
    const int q0 = qt * 128, r0 = q0 + wave * 16, tq = r0 + li;
    const size_t qrow = (size_t)b * nq_per_b + tq;
    bf16x8 qf[2];
#pragma unroll
    for (int kk = 0; kk < 2; ++kk) qf[kk] = *(const bf16x8*)(Q + qrow * ldq + h * 64 + kk * 32 + g * 8);
    constexpr float LOG2E = 1.4426950408889634f;
    const float ct = bias ? bias[(size_t)(b * 4 + h) * nq_per_b + tq] * LOG2E : 0.f;
    const float scale2 = scale * LOG2E;
    const int nkt = causal ? (q0 + 128) / KT : nk_per_b / KT;
    const int sr = tid >> 3, sc = tid & 7;
    const bf16_t* kg = Kp + ((size_t)b * nk_per_b + sr) * ldk + h * 64 + sc * 8;
    const bf16_t* vg = Vp + ((size_t)b * nk_per_b + sr) * ldv + h * 64 + sc * 8;
    const float* cg_ = bias ? bias + (size_t)(b * 4 + h) * nk_per_b : nullptr;
    u32x4 rkA[2], rvA[2], rkB[2], rvB[2]; float rcA = 0.f, rcB = 0.f;
#define AT_LOAD(RK, RV, RC, kt) { _Pragma("unroll") for (int i = 0; i < 2; ++i) { RK[i] = *(const u32x4*)(kg + (size_t)((kt) * KT + i * 64) * ldk); RV[i] = *(const u32x4*)(vg + (size_t)((kt) * KT + i * 64) * ldv); } \
        RC = (cg_ && tid < KT) ? cg_[(kt) * KT + tid] * LOG2E : 0.f; }
#define AT_STORE(RK, RV, RC, buf) { _Pragma("unroll") for (int i = 0; i < 2; ++i) { *(u32x4*)(sK + ((buf) * KT + sr + i * 64) * TLD + sc * 8) = RK[i]; *(u32x4*)(sV + ((buf) * KT + sr + i * 64) * TLD + sc * 8) = RV[i]; } \
        if (tid < KT) sC[(buf) * KT + tid] = RC; }
#define AT_COMPUTE(buf, kt) attn_compute(sK + (buf) * KT * TLD, sV + (buf) * KT * TLD, sC + (buf) * KT, qf, oacc, mrun, lrun, ct, scale2, causal, (kt) * KT, r0, tq, lane, g)
    AT_LOAD(rkA, rvA, rcA, 0)
    if (nkt > 1) AT_LOAD(rkB, rvB, rcB, 1)
    __syncthreads();
    AT_STORE(rkA, rvA, rcA, 0)
    __syncthreads();
    f32x4 oacc[4];
#pragma unroll
    for (int n = 0; n < 4; ++n) oacc[n] = (f32x4){0.f, 0.f, 0.f, 0.f};
    float mrun = -INFINITY, lrun = 0.f;
    for (int kt = 0; kt < nkt; kt += 2) {
        if (kt + 2 < nkt) AT_LOAD(rkA, rvA, rcA, kt + 2)
        AT_COMPUTE(0, kt);
        if (kt + 1 < nkt) AT_STORE(rkB, rvB, rcB, 1)
        __syncthreads();
        if (kt + 1 < nkt) {
            if (kt + 3 < nkt) AT_LOAD(rkB, rvB, rcB, kt + 3)
            AT_COMPUTE(1, kt + 1);
            if (kt + 2 < nkt) AT_STORE(rkA, rvA, rcA, 0)
            __syncthreads();
        }
    }
#undef AT_LOAD
#undef AT_STORE
#undef AT_COMPUTE
    const float inv = 1.f / lrun;
    float ms = 0.f;
#pragma unroll
    for (int n = 0; n < 4; ++n) { oacc[n] = oacc[n] * inv; ms += oacc[n][0] * oacc[n][0] + oacc[n][1] * oacc[n][1] + oacc[n][2] * oacc[n][2] + oacc[n][3] * oacc[n][3]; }
    ms += __shfl_xor(ms, 16); ms += __shfl_xor(ms, 32);
    const float rinv = rms ? rsqrtf(ms * (1.f / 64.f) + EPS) : 1.f;
#pragma unroll
    for (int n = 0; n < 4; ++n) {
        const int d = n * 16 + 4 * g;
        f32x4 gg = (f32x4){1.f, 1.f, 1.f, 1.f};
        if (gain) gg = *(const f32x4*)(gain + h * 64 + d);
        uint2 o; o.x = pk2(oacc[n][0] * rinv * gg[0], oacc[n][1] * rinv * gg[1]); o.y = pk2(oacc[n][2] * rinv * gg[2], oacc[n][3] * rinv * gg[3]);
        *(uint2*)(O + qrow * ldo + h * 64 + d) = o;
    }
}


__device__ __forceinline__ void hgrn_scan(float* LF  , float* SEGT  , const bf16_t* __restrict__ prow  , const float* __restrict__ hgrn_lb, int layer, int h, float (&kk)[8]) {
    const int tid = TIDX, t = tid >> 3, k8 = (tid & 7) * 8;
    const u32x4 raw = *(const u32x4*)(prow + (size_t)t * NP + C_AF + k8);
#pragma unroll
    for (int j = 0; j < 8; ++j) {
        const float fl = __uint_as_float((j & 1) ? (raw[j >> 1] & 0xffff0000u) : (raw[j >> 1] << 16));
        float lbk = 0.f;
        if (layer == 1) { const float a0 = hgrn_lb[h * 64 + k8 + j], a1 = hgrn_lb[256 + h * 64 + k8 + j]; lbk = 1.f / (1.f + __expf(a0 - a1)); }
        const float sg = sigmoidf_(fl);
        const float f = lbk + (1.f - lbk) * sg;
        kk[j] = (1.f - lbk) * (1.f - sg);
        LF[t * 65 + k8 + j] = __logf(f);
    }
    __syncthreads();
    { const int k = tid & 63, seg = tid >> 6; float run = 0.f;
#pragma unroll
      for (int i = 0; i < 8; ++i) { run += LF[(seg * 8 + i) * 65 + k]; LF[(seg * 8 + i) * 65 + k] = run; }
      SEGT[seg * 64 + k] = run; }
    __syncthreads();
    { const int k = tid & 63, seg = tid >> 6; float off = 0.f;
      for (int s2 = 0; s2 < seg; ++s2) off += SEGT[s2 * 64 + k];
#pragma unroll
      for (int i = 0; i < 8; ++i) LF[(seg * 8 + i) * 65 + k] += off; }
    __syncthreads();
}
__device__ __forceinline__ float bfx(const u32x4& raw, int j) { return __uint_as_float((j & 1) ? (raw[j >> 1] & 0xffff0000u) : (raw[j >> 1] << 16)); }

__device__ __forceinline__ void hgrn_local_task(char* smem, const bf16_t* __restrict__ proj, const float* __restrict__ hgrn_lb, int layer, float* __restrict__ HL, float* __restrict__ HD, int ch) {
    float* LF = (float*)smem; float* SEGT = LF + 64 * 65;
    bf16_t* sKd = (bf16_t*)(SEGT + 8 * 64); bf16_t* sV = sKd + 64 * TLD;
    const int tid = TIDX, lane = tid & 63, wave = tid >> 6, g = lane >> 4, li = lane & 15;
    const int bh = ch >> 5, n = ch & 31, b = bh >> 2, h = bh & 3;
    const bf16_t* prow = proj + (size_t)(b * SEQ + n * 64) * NP + h * 64;
    const int t = tid >> 3, k8 = (tid & 7) * 8;
    __syncthreads();
    *(u32x4*)(sV + t * TLD + k8) = *(const u32x4*)(prow + (size_t)t * NP + C_AI + k8);
    float kk[8];
    hgrn_scan(LF, SEGT, prow, hgrn_lb, layer, h, kk);
    { u32x4 o;
#pragma unroll
      for (int j = 0; j < 8; j += 2) {
          const float e0 = kk[j] * __expf(LF[63 * 65 + k8 + j] - LF[t * 65 + k8 + j]), e1 = kk[j + 1] * __expf(LF[63 * 65 + k8 + j + 1] - LF[t * 65 + k8 + j + 1]);
          o[j >> 1] = pk2(e0, e1);
      }
      *(u32x4*)(sKd + t * TLD + k8) = o; }
    if (tid < 64) HD[(size_t)ch * 64 + tid] = __expf(LF[63 * 65 + tid]);
    __syncthreads();
#pragma unroll
    for (int i = 0; i < 2; ++i) {
        const int idx = wave * 2 + i, vt = idx >> 2, kt = idx & 3;
        f32x4 acc = (f32x4){0.f, 0.f, 0.f, 0.f};
#pragma unroll
        for (int ks = 0; ks < 2; ++ks) acc = MFMA16(frag_cm(sV, TLD, ks * 32, vt * 16, lane), frag_cm(sKd, TLD, ks * 32, kt * 16, lane), acc);
        *(f32x4*)(HL + (size_t)ch * 4096 + (kt * 16 + li) * 64 + vt * 16 + 4 * g) = acc;
    }
}

__device__ __forceinline__ void hgrn_out_task(char* smem, const bf16_t* __restrict__ proj, const float* __restrict__ hgrn_lb, int layer, const bf16_t* __restrict__ HS,
                                              const float* __restrict__ mix_gain, bf16_t* __restrict__ y, int ch) {
    float* LF = (float*)smem; float* SEGT = LF + 64 * 65; float* sMS = SEGT + 8 * 64;
    bf16_t* sST = (bf16_t*)(sMS + 128); bf16_t* sQ0 = sST + 64 * TLD; bf16_t* sQm = sQ0 + 64 * TLD; bf16_t* sKm = sQm + 64 * TLD; bf16_t* sV = sKm + 64 * TLD; bf16_t* sA = sV + 64 * TLD;
    const int tid = TIDX, lane = tid & 63, wave = tid >> 6, g = lane >> 4, li = lane & 15;
    const int bh = ch >> 5, n = ch & 31, b = bh >> 2, h = bh & 3;
    const bf16_t* prow = proj + (size_t)(b * SEQ + n * 64) * NP + h * 64;
    const int t = tid >> 3, k8 = (tid & 7) * 8;
    __syncthreads();
    *(u32x4*)(sST + t * TLD + k8) = *(const u32x4*)(HS + (size_t)ch * 4096 + t * 64 + k8);
    const u32x4 qraw = *(const u32x4*)(prow + (size_t)t * NP + C_AQ + k8);
    *(u32x4*)(sV + t * TLD + k8) = *(const u32x4*)(prow + (size_t)t * NP + C_AI + k8);
    float kk[8];
    hgrn_scan(LF, SEGT, prow, hgrn_lb, layer, h, kk);
    { u32x4 o0, om, ok;
#pragma unroll
      for (int j = 0; j < 8; j += 2) {
          float q0v[2], qmv[2], kmv[2];
#pragma unroll
          for (int e = 0; e < 2; ++e) {
              const float bt = LF[t * 65 + k8 + j + e], r = LF[31 * 65 + k8 + j + e], q = siluf_(bfx(qraw, j + e));
              q0v[e] = q * __expf(bt); qmv[e] = q * __expf(bt - r); kmv[e] = kk[j + e] * __expf(r - bt);
          }
          o0[j >> 1] = pk2(q0v[0], q0v[1]); om[j >> 1] = pk2(qmv[0], qmv[1]); ok[j >> 1] = pk2(kmv[0], kmv[1]);
      }
      *(u32x4*)(sQ0 + t * TLD + k8) = o0; *(u32x4*)(sQm + t * TLD + k8) = om; *(u32x4*)(sKm + t * TLD + k8) = ok; }
    __syncthreads();
#pragma unroll
    for (int i = 0; i < 2; ++i) {
        const int idx = wave * 2 + i, tt = idx >> 2, st = idx & 3;
        f32x4 acc = (f32x4){0.f, 0.f, 0.f, 0.f};
#pragma unroll
        for (int ks = 0; ks < 2; ++ks) acc = MFMA16(frag_rm(sKm, TLD, st * 16, ks * 32, lane), frag_rm(sQm, TLD, tt * 16, ks * 32, lane), acc);
        const int tq = tt * 16 + li, s0 = st * 16 + 4 * g;
        uint2 o; o.x = pk2(s0 <= tq ? acc[0] : 0.f, s0 + 1 <= tq ? acc[1] : 0.f); o.y = pk2(s0 + 2 <= tq ? acc[2] : 0.f, s0 + 3 <= tq ? acc[3] : 0.f);
        *(uint2*)(sA + tq * TLD + s0) = o;
    }
    __syncthreads();
    { const int tt = wave >> 1;
      f32x4 oacc[2]; float ms = 0.f;
#pragma unroll
      for (int i = 0; i < 2; ++i) {
          const int vt = (wave & 1) * 2 + i;
          f32x4 acc = (f32x4){0.f, 0.f, 0.f, 0.f};
#pragma unroll
          for (int ks = 0; ks < 2; ++ks) acc = MFMA16(frag_cm(sST, TLD, ks * 32, vt * 16, lane), frag_rm(sQ0, TLD, tt * 16, ks * 32, lane), acc);
#pragma unroll
          for (int ks = 0; ks < 2; ++ks) acc = MFMA16(frag_cm(sV, TLD, ks * 32, vt * 16, lane), frag_rm(sA, TLD, tt * 16, ks * 32, lane), acc);
          oacc[i] = acc; ms += acc[0] * acc[0] + acc[1] * acc[1] + acc[2] * acc[2] + acc[3] * acc[3];
      }
      ms += __shfl_xor(ms, 16); ms += __shfl_xor(ms, 32);
      if (g == 0) sMS[(tt * 16 + li) * 2 + (wave & 1)] = ms;
      __syncthreads();
      const int tq = tt * 16 + li;
      const float rinv = rsqrtf((sMS[tq * 2] + sMS[tq * 2 + 1]) * (1.f / 64.f) + EPS);
      const size_t row = (size_t)(b * SEQ + n * 64 + tq);
#pragma unroll
      for (int i = 0; i < 2; ++i) {
          const int v0 = ((wave & 1) * 2 + i) * 16 + 4 * g;
          const uint2 graw = *(const uint2*)(proj + row * NP + C_AG + h * 64 + v0);
          const f32x4 mgv = *(const f32x4*)(mix_gain + C_AQ + h * 64 + v0);
          const float g0 = __uint_as_float(graw.x << 16), g1 = __uint_as_float(graw.x & 0xffff0000u), g2 = __uint_as_float(graw.y << 16), g3 = __uint_as_float(graw.y & 0xffff0000u);
          uint2 o; o.x = pk2(oacc[i][0] * rinv * siluf_(g0) * mgv[0], oacc[i][1] * rinv * siluf_(g1) * mgv[1]);
          o.y = pk2(oacc[i][2] * rinv * siluf_(g2) * mgv[2], oacc[i][3] * rinv * siluf_(g3) * mgv[3]);
          *(uint2*)(y + row * 1024 + h * 64 + v0) = o;
      }
    }
}


constexpr int GP_BYTES = (128 + 64 * 132 + 64 * 68) * 4 + 2 * 64 * TLD * 2;
__device__ __forceinline__ void gdn_prep_pair(char* smem, const bf16_t* __restrict__ proj, const float* __restrict__ gates, const float* __restrict__ conv_w  ,
                                              const float* __restrict__ a_log, const float* __restrict__ dt_bias, bf16_t* __restrict__ gt_all, float* __restrict__ glast, int ch0) {
#define GP_SG(sub) ((float*)(smem + (sub) * GP_BYTES))
#define GP_SBETA(sub) (GP_SG(sub) + 64)
#define GP_RHS(sub) (GP_SG(sub) + 128)
#define GP_SM(sub) (GP_RHS(sub) + 64 * 132)
#define GP_SK(sub) ((bf16_t*)(GP_SM(sub) + 64 * 68))
#define GP_SQ(sub) (GP_SK(sub) + 64 * TLD)
    const int tid = TIDX, lane = tid & 63, wave = tid >> 6, g = lane >> 4, li = lane & 15;
    const int bh = ch0 >> 5, n0 = ch0 & 31, b = bh >> 2, h = bh & 3;
    const int t = tid >> 3, d8 = (tid & 7) * 8;
    __syncthreads();
    float qn[2][8], kn[2][8], vv[2][8];
#pragma unroll
    for (int sub = 0; sub < 2; ++sub) {
        const int n = n0 + sub; const size_t row0 = (size_t)(b * SEQ + n * 64);
        const int spos = n * 64 + t;
#pragma unroll
        for (int sec = 0; sec < 3; ++sec) {
            const int col = (sec == 0 ? C_DQ : (sec == 1 ? C_DK : C_DV)) + h * 64 + d8;
            float acc[8];
#pragma unroll
            for (int e = 0; e < 8; ++e) acc[e] = 0.f;
#pragma unroll
            for (int j = 0; j < 4; ++j) {
                if (spos - (3 - j) >= 0) {
                    const u32x4 raw = *(const u32x4*)(proj + (row0 + t - (3 - j)) * NP + col);
                    const f32x4 w0 = *(const f32x4*)(conv_w + j * 768 + sec * 256 + h * 64 + d8), w1 = *(const f32x4*)(conv_w + j * 768 + sec * 256 + h * 64 + d8 + 4);
#pragma unroll
                    for (int e = 0; e < 8; ++e) acc[e] += (e < 4 ? w0[e] : w1[e - 4]) * bfx(raw, e);
                }
            }
#pragma unroll
            for (int e = 0; e < 8; ++e) { const float sv = siluf_(acc[e]); if (sec == 0) qn[sub][e] = sv; else if (sec == 1) kn[sub][e] = sv; else vv[sub][e] = sv; }
        }
        float sq = 0.f, sk = 0.f;
#pragma unroll
        for (int e = 0; e < 8; ++e) { sq += qn[sub][e] * qn[sub][e]; sk += kn[sub][e] * kn[sub][e]; }
        sq += __shfl_xor(sq, 1); sq += __shfl_xor(sq, 2); sq += __shfl_xor(sq, 4);
        sk += __shfl_xor(sk, 1); sk += __shfl_xor(sk, 2); sk += __shfl_xor(sk, 4);
        const float rq = rsqrtf(sq + EPS) * 0.125f, rk = rsqrtf(sk + EPS);
#pragma unroll
        for (int e = 0; e < 8; ++e) { qn[sub][e] *= rq; kn[sub][e] *= rk; }
        if ((tid & 7) == 0) {
            const float* gr = gates + (row0 + t) * 16;
            GP_SBETA(sub)[t] = sigmoidf_(gr[4 + h]);
            GP_SG(sub)[t] = -__expf(a_log[h]) * softplusf_(gr[8 + h] + dt_bias[h]);
        }
    }
    __syncthreads();
    if (wave < 2) {
        float* sG = GP_SG(wave);
        float v = sG[lane];
#pragma unroll
        for (int o = 1; o < 64; o <<= 1) { const float nb = __shfl_up(v, o); if (lane >= o) v += nb; }
        sG[lane] = v;
    }
    __syncthreads();
#pragma unroll
    for (int sub = 0; sub < 2; ++sub) {
        const int ch = ch0 + sub; bf16_t* gt = gt_all + (size_t)ch * 5 * 4096;
        float* sG = GP_SG(sub); float* RHS = GP_RHS(sub);
        const float Gt = sG[t], Gl = sG[63], bt = GP_SBETA(sub)[t];
        const float eG = __expf(Gt), eD = __expf(Gl - Gt);
        u32x4 ok, oq, oqd, okd;
#pragma unroll
        for (int e = 0; e < 8; e += 2) {
            ok[e >> 1] = pk2(kn[sub][e], kn[sub][e + 1]); oq[e >> 1] = pk2(qn[sub][e], qn[sub][e + 1]);
            oqd[e >> 1] = pk2(qn[sub][e] * eG, qn[sub][e + 1] * eG); okd[e >> 1] = pk2(kn[sub][e] * eD, kn[sub][e + 1] * eD);
        }
        *(u32x4*)(GP_SK(sub) + t * TLD + d8) = ok; *(u32x4*)(GP_SQ(sub) + t * TLD + d8) = oq;
        *(u32x4*)(gt + 2 * 4096 + t * 64 + d8) = oqd; *(u32x4*)(gt + 3 * 4096 + t * 64 + d8) = okd;
#pragma unroll
        for (int e = 0; e < 8; ++e) { RHS[t * 132 + d8 + e] = vv[sub][e] * bt; RHS[t * 132 + 64 + d8 + e] = kn[sub][e] * bt * eG; }
        if (tid == 0) glast[ch] = __expf(Gl);
    }
    __syncthreads();
#pragma unroll
    for (int i = 0; i < 4; ++i) {
        const int idx = wave * 4 + i, sub = idx >> 4, tt = (idx >> 2) & 3, st = idx & 3;
        const bf16_t* sK = GP_SK(sub); const bf16_t* sQ = GP_SQ(sub); const float* sG = GP_SG(sub); const float* sBeta = GP_SBETA(sub); float* sM = GP_SM(sub);
        bf16_t* gt = gt_all + (size_t)(ch0 + sub) * 5 * 4096;
        f32x4 am = (f32x4){0.f, 0.f, 0.f, 0.f}, aq = (f32x4){0.f, 0.f, 0.f, 0.f};
#pragma unroll
        for (int ks = 0; ks < 2; ++ks) {
            const bf16x8 kfs = frag_rm(sK, TLD, st * 16, ks * 32, lane), kft = frag_rm(sK, TLD, tt * 16, ks * 32, lane);
            am = MFMA16(kft, kfs, am);
            aq = MFMA16(kfs, frag_rm(sQ, TLD, tt * 16, ks * 32, lane), aq);
        }
        {   const int sx = st * 16 + li, t0 = tt * 16 + 4 * g; const float Gs = sG[sx];
            f32x4 mo;
#pragma unroll
            for (int r = 0; r < 4; ++r) { const int tq = t0 + r; mo[r] = (sx < tq) ? sBeta[tq] * am[r] * __expf(sG[tq] - Gs) : 0.f; }
            *(f32x4*)(sM + sx * 68 + t0) = mo; }
        {   const int tq = tt * 16 + li, s0 = st * 16 + 4 * g; const float Gt = sG[tq];
            float ao[4];
#pragma unroll
            for (int r = 0; r < 4; ++r) { const int sx = s0 + r; ao[r] = (sx <= tq) ? aq[r] * __expf(Gt - sG[sx]) : 0.f; }
            uint2 o; o.x = pk2(ao[0], ao[1]); o.y = pk2(ao[2], ao[3]);
            *(uint2*)(gt + 4 * 4096 + tq * 64 + s0) = o; }
    }
    __syncthreads();
    if (tid < 256) {
        const int sub = tid >> 7, col = tid & 127;
        const float* RHS = GP_RHS(sub); const float* sM = GP_SM(sub);
        bf16_t* gt = gt_all + (size_t)(ch0 + sub) * 5 * 4096;
        float acc[64];
#pragma unroll
        for (int i = 0; i < 64; ++i) acc[i] = RHS[i * 132 + col];
#pragma unroll
        for (int half = 0; half < 2; ++half) {
            const int base = half * 32;
            if (half == 1) {
#pragma unroll
                for (int sx = 0; sx < 32; sx += 2) {
                    f32x4 r0[8], r1[8];
#pragma unroll
                    for (int c = 0; c < 8; ++c) { r0[c] = *(const f32x4*)(sM + sx * 68 + 32 + c * 4); r1[c] = *(const f32x4*)(sM + (sx + 1) * 68 + 32 + c * 4); }
                    const float x0 = acc[sx], x1 = acc[sx + 1];
#pragma unroll
                    for (int tq = 0; tq < 32; ++tq) { acc[32 + tq] -= r0[tq >> 2][tq & 3] * x0; acc[32 + tq] -= r1[tq >> 2][tq & 3] * x1; }
                }
            }
            f32x4 cur[8];
#pragma unroll
            for (int c = 0; c < 8; ++c) cur[c] = *(const f32x4*)(sM + base * 68 + base + c * 4);
#pragma unroll
            for (int sx = 0; sx < 31; ++sx) {
                f32x4 nxt[8];
#pragma unroll
                for (int c = (sx + 2) >> 2; c < 8; ++c) nxt[c] = *(const f32x4*)(sM + (base + sx + 1) * 68 + base + c * 4);
                const float xs = acc[base + sx];
#pragma unroll
                for (int tq = sx + 1; tq < 32; ++tq) acc[base + tq] -= cur[tq >> 2][tq & 3] * xs;
#pragma unroll
                for (int c = (sx + 2) >> 2; c < 8; ++c) cur[c] = nxt[c];
            }
        }
        if (col < 64) {
#pragma unroll
            for (int tt = 0; tt < 64; ++tt) gt[tt * 64 + col] = f2bf(acc[tt]);
        } else {
#pragma unroll
            for (int tt = 0; tt < 64; ++tt) gt[4096 + tt * 64 + (col - 64)] = f2bf(-acc[tt]);
        }
    }
#undef GP_SG
#undef GP_SBETA
#undef GP_RHS
#undef GP_SM
#undef GP_SK
#undef GP_SQ
}

__device__ __forceinline__ void gdn_scan_step(bf16_t* sT, bf16_t* sST, bf16_t* sVn, f32x4 (&sacc)[4], const uint2 (&zraw)[4], float glv, const float* __restrict__ mix_gain,
                                              bf16_t* __restrict__ y, int bh, int n, int tid) {
    const int lane = tid & 63, wave = tid >> 6, g = lane >> 4, li = lane & 15;
    const int b = bh >> 2, h = bh & 3;
    const int buf = n & 1;
        const bf16_t* cT = sT + buf * 5 * 64 * TLD;
        const bf16_t* sU = cT; const bf16_t* sWn = cT + 64 * TLD; const bf16_t* sQd = cT + 2 * 64 * TLD; const bf16_t* sKd = cT + 3 * 64 * TLD; const bf16_t* sAq = cT + 4 * 64 * TLD;
        const bf16_t* cST = sST + buf * 64 * TLD; bf16_t* nST = sST + (buf ^ 1) * 64 * TLD;
        const size_t rowz = (size_t)(b * SEQ + n * 64 + (wave & 3) * 16 + li);
#pragma unroll
        for (int i = 0; i < 2; ++i) {
            const int idx = wave * 2 + i, tt = idx >> 2, vt = idx & 3;
            const int tq = tt * 16 + li, v0 = vt * 16 + 4 * g;
            const uint2 uraw = *(const uint2*)(sU + tq * TLD + v0);
            f32x4 acc = (f32x4){__uint_as_float(uraw.x << 16), __uint_as_float(uraw.x & 0xffff0000u), __uint_as_float(uraw.y << 16), __uint_as_float(uraw.y & 0xffff0000u)};
#pragma unroll
            for (int ks = 0; ks < 2; ++ks) acc = MFMA16(frag_rm(cST, TLD, vt * 16, ks * 32, lane), frag_rm(sWn, TLD, tt * 16, ks * 32, lane), acc);
            uint2 o; o.x = pk2(acc[0], acc[1]); o.y = pk2(acc[2], acc[3]);
            *(uint2*)(sVn + tq * TLD + v0) = o;
        }
        __syncthreads();
        if (wave < 4) {
            const int tt = wave;
            f32x4 oacc[4]; float ms = 0.f;
#pragma unroll
            for (int vt = 0; vt < 4; ++vt) {
                f32x4 acc = (f32x4){0.f, 0.f, 0.f, 0.f};
#pragma unroll
                for (int ks = 0; ks < 2; ++ks) acc = MFMA16(frag_rm(cST, TLD, vt * 16, ks * 32, lane), frag_rm(sQd, TLD, tt * 16, ks * 32, lane), acc);
#pragma unroll
                for (int ks = 0; ks < 2; ++ks) acc = MFMA16(frag_cm(sVn, TLD, ks * 32, vt * 16, lane), frag_rm(sAq, TLD, tt * 16, ks * 32, lane), acc);
                oacc[vt] = acc; ms += acc[0] * acc[0] + acc[1] * acc[1] + acc[2] * acc[2] + acc[3] * acc[3];
            }
            ms += __shfl_xor(ms, 16); ms += __shfl_xor(ms, 32);
            const float rinv = rsqrtf(ms * (1.f / 64.f) + EPS);
#pragma unroll
            for (int vt = 0; vt < 4; ++vt) {
                const int v0 = vt * 16 + 4 * g;
                const f32x4 mgv = *(const f32x4*)(mix_gain + 768 + h * 64 + v0);
                const float z0 = __uint_as_float(zraw[vt].x << 16), z1 = __uint_as_float(zraw[vt].x & 0xffff0000u), z2 = __uint_as_float(zraw[vt].y << 16), z3 = __uint_as_float(zraw[vt].y & 0xffff0000u);
                uint2 o; o.x = pk2(oacc[vt][0] * rinv * siluf_(z0) * mgv[0], oacc[vt][1] * rinv * siluf_(z1) * mgv[1]);
                o.y = pk2(oacc[vt][2] * rinv * siluf_(z2) * mgv[2], oacc[vt][3] * rinv * siluf_(z3) * mgv[3]);
                *(uint2*)(y + rowz * 1024 + 768 + h * 64 + v0) = o;
            }
        } else {
            const int kt = wave - 4;
            const float gl = __shfl(glv, n);
#pragma unroll
            for (int vt = 0; vt < 4; ++vt) {
                f32x4 acc = sacc[vt] * gl;
#pragma unroll
                for (int ks = 0; ks < 2; ++ks) acc = MFMA16(frag_cm(sKd, TLD, ks * 32, kt * 16, lane), frag_cm(sVn, TLD, ks * 32, vt * 16, lane), acc);
                sacc[vt] = acc;
                uint2 o; o.x = pk2(acc[0], acc[1]); o.y = pk2(acc[2], acc[3]);
                *(uint2*)(nST + (vt * 16 + li) * TLD + kt * 16 + 4 * g) = o;
            }
        }
}

__device__ __forceinline__ void gdn_scan_task(char* smem, const bf16_t* __restrict__ gt_all, const float* __restrict__ glast, const bf16_t* __restrict__ proj, const float* __restrict__ mix_gain,
                                              bf16_t* __restrict__ y, int bh) {
    bf16_t* sT = (bf16_t*)smem;
    bf16_t* sST = sT + 2 * 5 * 64 * TLD;
    bf16_t* sVn = sST + 2 * 64 * TLD;
    const int tid = TIDX, lane = tid & 63, wave = tid >> 6, g = lane >> 4, li = lane & 15;
    const int b = bh >> 2, h = bh & 3;
    const int sr = tid >> 3, sc8 = (tid & 7) * 8;
    const bf16_t* gsrc = gt_all + (size_t)bh * 32 * 5 * 4096 + sr * 64 + sc8;
    __syncthreads();
    u32x4 rs0[5], rs1[5], rs2[5], rs3[5];
#define GS_LOAD(RS, n) { _Pragma("unroll") for (int i = 0; i < 5; ++i) RS[i] = *(const u32x4*)(gsrc + (size_t)(n) * 5 * 4096 + i * 4096); }
#define GS_STORE(RS, buf) { bf16_t* nT = sT + (buf) * 5 * 64 * TLD; _Pragma("unroll") for (int i = 0; i < 5; ++i) *(u32x4*)(nT + i * 64 * TLD + sr * TLD + sc8) = RS[i]; }
#define GS_ZLOAD(Z, n) { if (wave < 4) { const size_t rz = (size_t)(b * SEQ + (n) * 64 + (wave & 3) * 16 + li); _Pragma("unroll") for (int vt = 0; vt < 4; ++vt) Z[vt] = *(const uint2*)(proj + rz * NP + C_DZ + h * 64 + vt * 16 + 4 * g); } }
    GS_LOAD(rs0, 0) GS_LOAD(rs1, 1) GS_LOAD(rs2, 2) GS_LOAD(rs3, 3)
    const float glv = glast[bh * 32 + (lane & 31)];
    uint2 zraw[4], znext[4];
    GS_ZLOAD(zraw, 0)
    GS_STORE(rs0, 0)
    *(u32x4*)(sST + sr * TLD + sc8) = (u32x4){0u, 0u, 0u, 0u};
    f32x4 sacc[4];
#pragma unroll
    for (int i = 0; i < 4; ++i) sacc[i] = (f32x4){0.f, 0.f, 0.f, 0.f};
    __syncthreads();
#define GS_STEP(n, LSET, SSET) { \
        if ((n) + 4 < 32) GS_LOAD(LSET, (n) + 4) \
        if ((n) + 1 < 32) GS_ZLOAD(znext, (n) + 1) \
        gdn_scan_step(sT, sST, sVn, sacc, zraw, glv, mix_gain, y, bh, (n), tid); \
        if ((n) + 1 < 32) GS_STORE(SSET, ((n) + 1) & 1) \
        _Pragma("unroll") for (int vt = 0; vt < 4; ++vt) zraw[vt] = znext[vt]; \
        __syncthreads(); }
    for (int n = 0; n < 32; n += 4) {
        GS_STEP(n, rs0, rs1)
        GS_STEP(n + 1, rs1, rs2)
        GS_STEP(n + 2, rs2, rs3)
        GS_STEP(n + 3, rs3, rs0)
    }
#undef GS_LOAD
#undef GS_STORE
#undef GS_ZLOAD
#undef GS_STEP
}


constexpr int XLD = 264;
__device__ __forceinline__ void lru_local_task(char* smem, const bf16_t* __restrict__ proj, const float* __restrict__ conv_w, const float* __restrict__ conv_b,
                                               const float* __restrict__ w_a, const float* __restrict__ b_a, const float* __restrict__ w_x, const float* __restrict__ b_x,
                                               const float* __restrict__ lam, float* __restrict__ hl_out, float* __restrict__ ac_out, float* __restrict__ lsum, int task) {
    bf16_t* sX = (bf16_t*)smem;
    bf16_t* sW = sX + 64 * XLD;
    const int tid = TIDX, lane = tid & 63, wave = tid >> 6, g = lane >> 4, li = lane & 15;
    const int b = task >> 5, n = task & 31;
    const size_t row0 = (size_t)(b * SEQ + n * 64);
    const int t = tid >> 3;
    __syncthreads();
    {
        const int i = tid >> 3, j8 = (tid & 7) * 8;
#pragma unroll
        for (int mat = 0; mat < 8; ++mat) {
            const float* src = ((mat & 1) ? w_x : w_a) + (size_t)(mat >> 1) * 4096 + i * 64 + j8;
            const f32x4 v0 = *(const f32x4*)src, v1 = *(const f32x4*)(src + 4);
            u32x4 o; o[0] = pk2(v0[0], v0[1]); o[1] = pk2(v0[2], v0[3]); o[2] = pk2(v1[0], v1[1]); o[3] = pk2(v1[2], v1[3]);
            *(u32x4*)(sW + mat * 64 * TLD + i * TLD + j8) = o;
        }
    }
    {
        const int spos = n * 64 + t;
#pragma unroll
        for (int i = 0; i < 4; ++i) {
            const int c8 = ((tid & 7) + 8 * i) * 8;
            float acc[8];
            { const f32x4 cb0 = *(const f32x4*)(conv_b + c8), cb1 = *(const f32x4*)(conv_b + c8 + 4);
#pragma unroll
              for (int e = 0; e < 8; ++e) acc[e] = e < 4 ? cb0[e] : cb1[e - 4]; }
#pragma unroll
            for (int j = 0; j < 4; ++j) {
                if (spos - (3 - j) >= 0) {
                    const u32x4 raw = *(const u32x4*)(proj + (row0 + t - (3 - j)) * NP + C_CX + c8);
                    const f32x4 w0 = *(const f32x4*)(conv_w + j * 256 + c8), w1 = *(const f32x4*)(conv_w + j * 256 + c8 + 4);
#pragma unroll
                    for (int e = 0; e < 8; ++e) acc[e] += (e < 4 ? w0[e] : w1[e - 4]) * bfx(raw, e);
                }
            }
            u32x4 o; o[0] = pk2(acc[0], acc[1]); o[1] = pk2(acc[2], acc[3]); o[2] = pk2(acc[4], acc[5]); o[3] = pk2(acc[6], acc[7]);
            *(u32x4*)(sX + t * XLD + c8) = o;
        }
    }
    __syncthreads();
    const int hh = wave >> 1;
#pragma unroll
    for (int j2 = 0; j2 < 2; ++j2) {
        const int jt = (wave & 1) * 2 + j2, cl = jt * 16 + 4 * g, c = hh * 64 + cl;
        f32x4 ra[4], rx[4];
#pragma unroll
        for (int tt = 0; tt < 4; ++tt) { ra[tt] = (f32x4){0.f, 0.f, 0.f, 0.f}; rx[tt] = (f32x4){0.f, 0.f, 0.f, 0.f}; }
#pragma unroll
        for (int ks = 0; ks < 2; ++ks) {
            const bf16x8 wa = frag_cm(sW + (hh * 2) * 64 * TLD, TLD, ks * 32, jt * 16, lane), wx = frag_cm(sW + (hh * 2 + 1) * 64 * TLD, TLD, ks * 32, jt * 16, lane);
#pragma unroll
            for (int tt = 0; tt < 4; ++tt) {
                const bf16x8 xf = frag_rm(sX + hh * 64, XLD, tt * 16, ks * 32, lane);
                ra[tt] = MFMA16(wa, xf, ra[tt]);
                rx[tt] = MFMA16(wx, xf, rx[tt]);
            }
        }
        const f32x4 ba = *(const f32x4*)(b_a + c), bx = *(const f32x4*)(b_x + c), lm = *(const f32x4*)(lam + c);
        float sp[4];
#pragma unroll
        for (int r = 0; r < 4; ++r) sp[r] = softplusf_(-lm[r]);
        f32x4 cA = (f32x4){1.f, 1.f, 1.f, 1.f}, cH = (f32x4){0.f, 0.f, 0.f, 0.f};
#pragma unroll
        for (int tt = 0; tt < 4; ++tt) {
            const int tq = tt * 16 + li;
            const uint2 xraw = *(const uint2*)(sX + tq * XLD + c);
            const float xc[4] = {__uint_as_float(xraw.x << 16), __uint_as_float(xraw.x & 0xffff0000u), __uint_as_float(xraw.y << 16), __uint_as_float(xraw.y & 0xffff0000u)};
            f32x4 A, H;
#pragma unroll
            for (int r = 0; r < 4; ++r) {
                const float rr = sigmoidf_(ra[tt][r] + ba[r]), ig = sigmoidf_(rx[tt][r] + bx[r]);
                const float log_a = -8.f * rr * sp[r];
                A[r] = __expf(log_a);
                H[r] = sqrtf(-expm1f(2.f * log_a)) * (ig * xc[r]);
            }
#pragma unroll
            for (int o = 1; o < 16; o <<= 1) {
#pragma unroll
                for (int r = 0; r < 4; ++r) {
                    const float pA = __shfl_up(A[r], o, 16), pH = __shfl_up(H[r], o, 16);
                    if (li >= o) { H[r] = A[r] * pH + H[r]; A[r] = A[r] * pA; }
                }
            }
            const f32x4 Hf = H + A * cH, Af = A * cA;
            const size_t oidx = (row0 + tq) * 256 + c;
            *(f32x4*)(hl_out + oidx) = Hf; *(f32x4*)(ac_out + oidx) = Af;
#pragma unroll
            for (int r = 0; r < 4; ++r) { cH[r] = __shfl(Hf[r], 15, 16); cA[r] = __shfl(Af[r], 15, 16); }
            if (tt == 3 && li == 15) { *(f32x4*)(lsum + (size_t)task * 256 + c) = Af; *(f32x4*)(lsum + (size_t)(256 + task) * 256 + c) = Hf; }
        }
    }
}
__device__ __forceinline__ void lru_out_task(const float* __restrict__ hl_in, const float* __restrict__ ac_in, const float* __restrict__ lsum, const bf16_t* __restrict__ proj,
                                             const float* __restrict__ mix_gain, bf16_t* __restrict__ y, int task) {
    const int b = task >> 5, n = task & 31, c = TIDX & 255, half = TIDX >> 8;
    const float Hc = lsum[(size_t)task * 256 + c];
    const float mg = mix_gain[512 + c];
    const size_t row0 = (size_t)(b * SEQ + n * 64 + half * 32);
#pragma unroll
    for (int i0 = 0; i0 < 32; i0 += 16) {
        float hv[16], av[16]; bf16_t gv[16];
#pragma unroll
        for (int i = 0; i < 16; ++i) { const size_t row = row0 + i0 + i; hv[i] = hl_in[row * 256 + c]; av[i] = ac_in[row * 256 + c]; gv[i] = proj[row * NP + C_CG + c]; }
#pragma unroll
        for (int i = 0; i < 16; ++i) {
            const size_t row = row0 + i0 + i;
            const float yv = (hv[i] + av[i] * Hc) * geluf_(bf2f(gv[i]));
            const float ms = wave_sum(yv * yv) * (1.f / 64.f);
            y[row * 1024 + 512 + c] = f2bf(yv * rsqrtf(ms + EPS) * mg);
        }
    }
}


__device__ __forceinline__ void state_scan_phase(const float* __restrict__ HL, const float* __restrict__ HD, bf16_t* __restrict__ HS, const float* __restrict__ lsum, float* __restrict__ lcar) {
    const int bx = blockIdx.x, tid = TIDX;
    for (int u = bx; u < 128 + 4; u += gridDim.x) {
        if (u < 128) {
            const int gid = u * NTHR + tid, bh = gid >> 11, v = gid & 63, kp = (gid >> 6) & 31;
            const float* Lb = HL + (size_t)bh * 32 * 4096 + (2 * kp) * 64 + v; const float* Db = HD + (size_t)bh * 32 * 64 + 2 * kp;
            bf16_t* Sb = HS + (size_t)bh * 32 * 4096 + (2 * kp) * 64 + v;
            float S0 = 0.f, S1 = 0.f;
            for (int n0 = 0; n0 < 32; n0 += 8) {
                float l0[8], l1[8], d0[8], d1[8];
#pragma unroll
                for (int i = 0; i < 8; ++i) { l0[i] = Lb[(size_t)(n0 + i) * 4096]; l1[i] = Lb[(size_t)(n0 + i) * 4096 + 64]; d0[i] = Db[(n0 + i) * 64]; d1[i] = Db[(n0 + i) * 64 + 1]; }
#pragma unroll
                for (int i = 0; i < 8; ++i) {
                    Sb[(size_t)(n0 + i) * 4096] = f2bf(S0); Sb[(size_t)(n0 + i) * 4096 + 64] = f2bf(S1);
                    S0 = d0[i] * S0 + l0[i]; S1 = d1[i] * S1 + l1[i];
                }
            }
        } else {
            const int gid = (u - 128) * NTHR + tid, b = gid >> 8, c = gid & 255;
            float A[32], H[32];
#pragma unroll
            for (int n = 0; n < 32; ++n) { A[n] = lsum[(size_t)(b * 32 + n) * 256 + c]; H[n] = lsum[(size_t)(256 + b * 32 + n) * 256 + c]; }
            float Hc = 0.f;
#pragma unroll
            for (int n = 0; n < 32; ++n) { lcar[(size_t)(b * 32 + n) * 256 + c] = Hc; Hc = A[n] * Hc + H[n]; }
        }
    }
}


__device__ __forceinline__ void middle_task(char* smem, const bf16_t* xg1  , const float* pss_in, const bf16_t* __restrict__ Wq_t  , const bf16_t* __restrict__ kv  ,
                                            const bf16_t* __restrict__ Wmo_t  , const float* __restrict__ x1, float* __restrict__ x2, const float* __restrict__ gn, bf16_t* xg2, float* pss_out,
                                            const bf16_t* __restrict__ wr  , const float* __restrict__ b_rg, const float* __restrict__ b_re, int* __restrict__ cnt, int* __restrict__ list, float* __restrict__ pgate, int tile) {
    constexpr int QLD = 264;
    bf16_t* sQ = (bf16_t*)(smem + 92160);
    float* sZ = (float*)(smem + 92160 + 64 * QLD * 2);
    const int tid = TIDX, lane = tid & 63, wave = tid >> 6, g = lane >> 4, li = lane & 15;
    const int r0 = tile * 64, b = r0 >> 11;
    __syncthreads();
    if (tid < 64) sZ[tid] = 0.f;
    {
        const int sr = tid >> 3, sc8 = (tid & 7) * 8;
        const bf16_t* ga = xg1 + (size_t)(r0 + sr) * 1024 + sc8;
        const bf16_t* gb = Wq_t + (size_t)sr * 1024 + sc8;
        const int mt = wave & 3, nh = wave >> 2;
        f32x4 acc[8];
#pragma unroll
        for (int n = 0; n < 8; ++n) acc[n] = (f32x4){0.f, 0.f, 0.f, 0.f};
        u32x4 rA[5], rB[5];
#define MA_LOAD(R, kc) { R[0] = *(const u32x4*)(ga + (kc) * 64); _Pragma("unroll") for (int i = 0; i < 4; ++i) R[1 + i] = *(const u32x4*)(gb + (size_t)(i * 64) * 1024 + (kc) * 64); }
#define MA_STORE(R, buf) { bf16_t* dA = (bf16_t*)(smem + (buf) * 46080); bf16_t* dB = dA + 64 * TLD; *(u32x4*)(dA + sr * TLD + sc8) = R[0]; \
        _Pragma("unroll") for (int i = 0; i < 4; ++i) *(u32x4*)(dB + (sr + i * 64) * TLD + sc8) = R[1 + i]; }
#define MA_COMPUTE(buf) { const bf16_t* cA = (const bf16_t*)(smem + (buf) * 46080); const bf16_t* cB = cA + 64 * TLD; \
        _Pragma("unroll") for (int ks = 0; ks < 2; ++ks) { const bf16x8 af = frag_rm(cA, TLD, mt * 16, ks * 32, lane); \
            _Pragma("unroll") for (int n = 0; n < 8; ++n) acc[n] = MFMA16(frag_rm(cB, TLD, nh * 128 + n * 16, ks * 32, lane), af, acc[n]); } }
        MA_LOAD(rA, 0) MA_LOAD(rB, 1)
        MA_STORE(rA, 0)
        __syncthreads();
        for (int kc = 0; kc < 16; kc += 2) {
            if (kc + 2 < 16) MA_LOAD(rA, kc + 2)
            MA_COMPUTE(0)
            MA_STORE(rB, 1)
            __syncthreads();
            if (kc + 3 < 16) MA_LOAD(rB, kc + 3)
            MA_COMPUTE(1)
            if (kc + 2 < 16) MA_STORE(rA, 0)
            __syncthreads();
        }
#undef MA_LOAD
#undef MA_STORE
#undef MA_COMPUTE
        const float ri = rinv_from_pss(pss_in, (size_t)(r0 + mt * 16 + li));
#pragma unroll
        for (int n = 0; n < 8; ++n) { uint2 o; o.x = pk2(acc[n][0] * ri, acc[n][1] * ri); o.y = pk2(acc[n][2] * ri, acc[n][3] * ri);
            *(uint2*)(sQ + (mt * 16 + li) * QLD + nh * 128 + n * 16 + 4 * g) = o; }
    }
    __syncthreads();
    {
        const int head = wave >> 1, mt0 = (wave & 1) * 2;
        bf16x8 qf[2][2];
#pragma unroll
        for (int m = 0; m < 2; ++m)
#pragma unroll
            for (int ks = 0; ks < 2; ++ks) qf[m][ks] = frag_rm(sQ + head * 64, QLD, (mt0 + m) * 16, ks * 32, lane);
        bf16_t* sK = (bf16_t*)smem;
        bf16_t* sV = sK + 4 * 64 * TLD;
        const int sr = tid >> 3, sc8 = (tid & 7) * 8;
        const bf16_t* kvg = kv + (size_t)(b * MEMLEN + sr) * 512 + sc8;
        u32x4 rk[4], rv[4];
#define MB_LOAD(kt) { _Pragma("unroll") for (int hh = 0; hh < 4; ++hh) { rk[hh] = *(const u32x4*)(kvg + (size_t)((kt) * 64) * 512 + hh * 64); rv[hh] = *(const u32x4*)(kvg + (size_t)((kt) * 64) * 512 + 256 + hh * 64); } }
        MB_LOAD(0)
        f32x4 oacc[2][4]; float mrun[2] = {-INFINITY, -INFINITY}, lrun[2] = {0.f, 0.f};
#pragma unroll
        for (int m = 0; m < 2; ++m)
#pragma unroll
            for (int n = 0; n < 4; ++n) oacc[m][n] = (f32x4){0.f, 0.f, 0.f, 0.f};
        constexpr float SC2 = 0.125f * 1.4426950408889634f;
        for (int kt = 0; kt < 4; ++kt) {
            __syncthreads();
#pragma unroll
            for (int hh = 0; hh < 4; ++hh) { *(u32x4*)(sK + (hh * 64 + sr) * TLD + sc8) = rk[hh]; *(u32x4*)(sV + (hh * 64 + sr) * TLD + sc8) = rv[hh]; }
            __syncthreads();
            if (kt + 1 < 4) MB_LOAD(kt + 1)
#pragma unroll
            for (int m = 0; m < 2; ++m)
                attn_compute_t<false, 1>(sK + head * 64 * TLD, sV + head * 64 * TLD, sZ, qf[m], oacc[m], mrun[m], lrun[m], 0.f, SC2, 0, 0, lane, g);
        }
#undef MB_LOAD
#pragma unroll
        for (int m = 0; m < 2; ++m) {
            const float inv = 1.f / lrun[m];
#pragma unroll
            for (int n = 0; n < 4; ++n) { uint2 o; o.x = pk2(oacc[m][n][0] * inv, oacc[m][n][1] * inv); o.y = pk2(oacc[m][n][2] * inv, oacc[m][n][3] * inv);
                *(uint2*)(sQ + ((mt0 + m) * 16 + li) * QLD + head * 64 + n * 16 + 4 * g) = o; }
        }
    }
    __syncthreads();
    {
        constexpr int RLD = 264;
        bf16_t* sXh = (bf16_t*)smem;
        bf16_t* sXl = sXh + 64 * RLD;
        float* sLog = (float*)(sXl + 64 * RLD);
        float* sPart = sLog + 64 * 48;
        int* sCnt = (int*)(sPart + 64 * 8);
        float ssum[4] = {0.f, 0.f, 0.f, 0.f};
        const int rm = wave & 3, re0 = (wave < 4) ? 0 : 2, nre = (wave < 4) ? 2 : 1;
        f32x4 racc[2] = {(f32x4){0.f, 0.f, 0.f, 0.f}, (f32x4){0.f, 0.f, 0.f, 0.f}};
        for (int nq = 0; nq < 4; ++nq) {
            const int c0 = wave * 128 + nq * 32;
            const bf16_t* wg = Wmo_t + (size_t)(c0 + li) * 256 + g * 8;
            f32x4 acc[4][2];
#pragma unroll
            for (int m = 0; m < 4; ++m)
#pragma unroll
                for (int n = 0; n < 2; ++n) acc[m][n] = (f32x4){0.f, 0.f, 0.f, 0.f};
            u32x4 bw[8][2];
#pragma unroll
            for (int ks = 0; ks < 8; ++ks)
#pragma unroll
                for (int n = 0; n < 2; ++n) bw[ks][n] = *(const u32x4*)(wg + (size_t)(n * 16) * 256 + ks * 32);
#pragma unroll
            for (int ks = 0; ks < 8; ++ks) {
                if (ks & 1) asm volatile("" ::: "memory");
#pragma unroll
                for (int m = 0; m < 4; ++m) {
                    const bf16x8 af = frag_rm(sQ, QLD, m * 16, ks * 32, lane);
#pragma unroll
                    for (int n = 0; n < 2; ++n) acc[m][n] = MFMA16(__builtin_bit_cast(bf16x8, bw[ks][n]), af, acc[m][n]);
                }
            }
            __syncthreads();
#pragma unroll
            for (int m = 0; m < 4; ++m) {
                const size_t row = (size_t)(r0 + m * 16 + li);
#pragma unroll
                for (int n = 0; n < 2; ++n) {
                    const int col = c0 + n * 16 + 4 * g;
                    const f32x4 o = *(const f32x4*)(x1 + row * 1024 + col) + acc[m][n];
                    *(f32x4*)(x2 + row * 1024 + col) = o;
                    ssum[m] += (o[0] * o[0] + o[1] * o[1]) + (o[2] * o[2] + o[3] * o[3]);
                    const f32x4 og = o * *(const f32x4*)(gn + col);
                    uint2 wh; wh.x = pk2(og[0], og[1]); wh.y = pk2(og[2], og[3]);
                    *(uint2*)(xg2 + row * 1024 + col) = wh;
                    uint2 wl; wl.x = pk2(og[0] - __uint_as_float(wh.x << 16), og[1] - __uint_as_float(wh.x & 0xffff0000u)); wl.y = pk2(og[2] - __uint_as_float(wh.y << 16), og[3] - __uint_as_float(wh.y & 0xffff0000u));
                    const int lc = (m * 16 + li) * RLD + wave * 32 + n * 16 + 4 * g;
                    *(uint2*)(sXh + lc) = wh; *(uint2*)(sXl + lc) = wl;
                }
            }
            __syncthreads();
#pragma unroll 2
            for (int ks = 0; ks < 8; ++ks) {
                const bf16x8 xh = frag_rm(sXh, RLD, rm * 16, ks * 32, lane), xl = frag_rm(sXl, RLD, rm * 16, ks * 32, lane);
#pragma unroll
                for (int e = 0; e < 2; ++e) {
                    if (e < nre) {
                        const bf16_t* wp = wr + (size_t)((re0 + e) * 16 + li) * 1024 + ks * 128 + nq * 32 + g * 8;
                        const bf16x8 fh = *(const bf16x8*)wp, fl = *(const bf16x8*)(wp + 48 * 1024);
                        racc[e] = MFMA16(fh, xh, racc[e]); racc[e] = MFMA16(fl, xh, racc[e]); racc[e] = MFMA16(fh, xl, racc[e]);
                    }
                }
            }
        }
#pragma unroll
        for (int m = 0; m < 4; ++m) {
            float ss = ssum[m]; ss += __shfl_xor(ss, 16); ss += __shfl_xor(ss, 32);
            if (g == 0) { pss_out[(size_t)(r0 + m * 16 + li) * 16 + wave] = ss; pss_out[(size_t)(r0 + m * 16 + li) * 16 + 8 + wave] = 0.f; sPart[(m * 16 + li) * 8 + wave] = ss; }
        }
#pragma unroll
        for (int e = 0; e < 2; ++e) if (e < nre) *(f32x4*)(sLog + (rm * 16 + li) * 48 + (re0 + e) * 16 + 4 * g) = racc[e];
        if (tid < 64) sCnt[tid] = 0;
        __syncthreads();
        int ex0 = 0, ex1 = 0, lr0 = 0, lr1 = 0; float gw0 = 0.f, gw1 = 0.f;
        if (tid < 64) {
            const float* pp = sPart + tid * 8;
            const float rinv = rsqrtf((((pp[0] + pp[1]) + (pp[2] + pp[3])) + ((pp[4] + pp[5]) + (pp[6] + pp[7]))) * (1.f / 1024.f) + EPS);
            const float* l0 = sLog + tid * 48;
            float lg[4];
#pragma unroll
            for (int i = 0; i < 4; ++i) lg[i] = l0[i] * rinv + b_rg[i];
            int gs = 0; float gm = lg[0];
#pragma unroll
            for (int i = 1; i < 4; ++i) if (lg[i] > gm) { gm = lg[i]; gs = i; }
            float den = 0.f;
#pragma unroll
            for (int i = 0; i < 4; ++i) den += __expf(lg[i] - gm);
            const float pg = 1.f / den;
            int i0 = 0, i1 = -1; float m0 = -INFINITY, m1 = -INFINITY;
            for (int i = 0; i < 8; ++i) {
                const float v = l0[4 + gs * 8 + i] * rinv + b_re[gs * 8 + i];
                if (v > m0) { m1 = m0; i1 = i0; m0 = v; i0 = i; } else if (v > m1) { m1 = v; i1 = i; }
            }
            const float e1 = __expf(m1 - m0);
            gw0 = pg / (1.f + e1); gw1 = pg * e1 / (1.f + e1);
            ex0 = gs * 8 + i0; ex1 = gs * 8 + i1;
            lr0 = atomicAdd(&sCnt[ex0], 1); lr1 = atomicAdd(&sCnt[ex1], 1);
        }
        __syncthreads();
        if (tid < 32) { const int c = sCnt[tid]; sCnt[32 + tid] = c ? atomicAdd(&cnt[tid * CNT_STRIDE], c) : 0; }
        __syncthreads();
        if (tid < 64) {
            const int t = r0 + tid;
            list[(size_t)ex0 * T + sCnt[32 + ex0] + lr0] = 2 * t; pgate[2 * t] = gw0;
            list[(size_t)ex1 * T + sCnt[32 + ex1] + lr1] = 2 * t + 1; pgate[2 * t + 1] = gw1;
        }
    }
}

__device__ __forceinline__ void router_phase(char* smem, const float* __restrict__ x, const float* __restrict__ g, const bf16_t* __restrict__ wr  , const float* __restrict__ b_rg,
                                             const float* __restrict__ b_re, const float* __restrict__ pss, int* __restrict__ cnt, int* __restrict__ list, float* __restrict__ pgate) {
    bf16_t* sXh = (bf16_t*)smem;
    bf16_t* sXl = sXh + 64 * TLD;
    float* sLog = (float*)(sXl + 64 * TLD);
    const int tid = TIDX, lane = tid & 63, wave = tid >> 6, gq = lane >> 4, li = lane & 15;
    const int mt = wave & 3, kh = wave >> 2;
    const int stok = tid >> 3, c8 = (tid & 7) * 8;
    BLK_LOOP(tile, T / 64) {
        const int t0 = tile * 64;
        f32x4 acc[3];
#pragma unroll
        for (int n = 0; n < 3; ++n) acc[n] = (f32x4){0.f, 0.f, 0.f, 0.f};
        const float* xp = x + (size_t)(t0 + stok) * 1024 + c8;
        const bf16_t* wp = wr + (size_t)li * 1024 + kh * 32 + gq * 8;
        f32x4 x0 = *(const f32x4*)xp, x1 = *(const f32x4*)(xp + 4);
        u32x4 wh[3], wl[3];
#pragma unroll
        for (int n = 0; n < 3; ++n) { wh[n] = *(const u32x4*)(wp + n * 16 * 1024); wl[n] = *(const u32x4*)(wp + 48 * 1024 + n * 16 * 1024); }
        for (int kc = 0; kc < 16; ++kc) {
            const f32x4 g0 = *(const f32x4*)(g + kc * 64 + c8), g1 = *(const f32x4*)(g + kc * 64 + c8 + 4);
            const f32x4 v0 = x0 * g0, v1 = x1 * g1;
            u32x4 oh, ol;
#pragma unroll
            for (int j = 0; j < 2; ++j) {
                const unsigned h0 = pk2(v0[2 * j], v0[2 * j + 1]), h1 = pk2(v1[2 * j], v1[2 * j + 1]);
                oh[j] = h0; oh[2 + j] = h1;
                ol[j] = pk2(v0[2 * j] - __uint_as_float(h0 << 16), v0[2 * j + 1] - __uint_as_float(h0 & 0xffff0000u));
                ol[2 + j] = pk2(v1[2 * j] - __uint_as_float(h1 << 16), v1[2 * j + 1] - __uint_as_float(h1 & 0xffff0000u));
            }
            __syncthreads();
            *(u32x4*)(sXh + stok * TLD + c8) = oh; *(u32x4*)(sXl + stok * TLD + c8) = ol;
            __syncthreads();
            u32x4 cwh[3], cwl[3];
#pragma unroll
            for (int n = 0; n < 3; ++n) { cwh[n] = wh[n]; cwl[n] = wl[n]; }
            if (kc + 1 < 16) {
                x0 = *(const f32x4*)(xp + (kc + 1) * 64); x1 = *(const f32x4*)(xp + (kc + 1) * 64 + 4);
#pragma unroll
                for (int n = 0; n < 3; ++n) { wh[n] = *(const u32x4*)(wp + n * 16 * 1024 + (kc + 1) * 64); wl[n] = *(const u32x4*)(wp + 48 * 1024 + n * 16 * 1024 + (kc + 1) * 64); }
            }
            const bf16x8 xh = frag_rm(sXh, TLD, mt * 16, kh * 32, lane), xl = frag_rm(sXl, TLD, mt * 16, kh * 32, lane);
#pragma unroll
            for (int n = 0; n < 3; ++n) {
                const bf16x8 fh = __builtin_bit_cast(bf16x8, cwh[n]), fl = __builtin_bit_cast(bf16x8, cwl[n]);
                acc[n] = MFMA16(fh, xh, acc[n]);
                acc[n] = MFMA16(fl, xh, acc[n]);
                acc[n] = MFMA16(fh, xl, acc[n]);
            }
        }
#pragma unroll
        for (int n = 0; n < 3; ++n) *(f32x4*)(sLog + (kh * 64 + mt * 16 + li) * 48 + n * 16 + 4 * gq) = acc[n];
        __syncthreads();
        int* sCnt = (int*)(sLog + 2 * 64 * 48);
        if (tid < 64) sCnt[tid] = 0;
        __syncthreads();
        int ex0 = 0, ex1 = 0, lr0 = 0, lr1 = 0; float gw0 = 0.f, gw1 = 0.f;
        if (tid < 64) {
            const float rinv = rinv_from_pss(pss, (size_t)(t0 + tid));
            const float* l0 = sLog + tid * 48; const float* l1 = sLog + (64 + tid) * 48;
            float lg[4];
#pragma unroll
            for (int i = 0; i < 4; ++i) lg[i] = (l0[i] + l1[i]) * rinv + b_rg[i];
            int gs = 0; float gm = lg[0];
#pragma unroll
            for (int i = 1; i < 4; ++i) if (lg[i] > gm) { gm = lg[i]; gs = i; }
            float den = 0.f;
#pragma unroll
            for (int i = 0; i < 4; ++i) den += __expf(lg[i] - gm);
            const float pg = 1.f / den;
            int i0 = 0, i1 = -1; float m0 = -INFINITY, m1 = -INFINITY;
            for (int i = 0; i < 8; ++i) {
                const float v = (l0[4 + gs * 8 + i] + l1[4 + gs * 8 + i]) * rinv + b_re[gs * 8 + i];
                if (v > m0) { m1 = m0; i1 = i0; m0 = v; i0 = i; } else if (v > m1) { m1 = v; i1 = i; }
            }
            const float e1 = __expf(m1 - m0);
            gw0 = pg / (1.f + e1); gw1 = pg * e1 / (1.f + e1);
            ex0 = gs * 8 + i0; ex1 = gs * 8 + i1;
            lr0 = atomicAdd(&sCnt[ex0], 1); lr1 = atomicAdd(&sCnt[ex1], 1);
        }
        __syncthreads();
        if (tid < 32) { const int c = sCnt[tid]; sCnt[32 + tid] = c ? atomicAdd(&cnt[tid * CNT_STRIDE], c) : 0; }
        __syncthreads();
        if (tid < 64) {
            const int t = t0 + tid;
            list[(size_t)ex0 * T + sCnt[32 + ex0] + lr0] = 2 * t; pgate[2 * t] = gw0;
            list[(size_t)ex1 * T + sCnt[32 + ex1] + lr1] = 2 * t + 1; pgate[2 * t + 1] = gw1;
        }
        __syncthreads();
    }
}

__device__ __forceinline__ void combine_phase(const float* x2, const bf16_t* __restrict__ eo, const float* __restrict__ g, float* xout, bf16_t* __restrict__ hn, int mode) {
    const int lane = TIDX & 63;
    for (int t = blockIdx.x * 8 + (TIDX >> 6); t < T; t += gridDim.x * 8) {
        f32x4 v[4]; float s = 0.f;
#pragma unroll
        for (int j = 0; j < 4; ++j) {
            const int c = (lane + 64 * j) * 4;
            v[j] = *(const f32x4*)(x2 + (size_t)t * 1024 + c);
            const uint2 e0 = *(const uint2*)(eo + (size_t)(2 * t) * 1024 + c), e1 = *(const uint2*)(eo + (size_t)(2 * t + 1) * 1024 + c);
            v[j].x += __uint_as_float(e0.x << 16) + __uint_as_float(e1.x << 16);
            v[j].y += __uint_as_float(e0.x & 0xffff0000u) + __uint_as_float(e1.x & 0xffff0000u);
            v[j].z += __uint_as_float(e0.y << 16) + __uint_as_float(e1.y << 16);
            v[j].w += __uint_as_float(e0.y & 0xffff0000u) + __uint_as_float(e1.y & 0xffff0000u);
            s += v[j].x * v[j].x + v[j].y * v[j].y + v[j].z * v[j].z + v[j].w * v[j].w;
        }
        const float rinv = rsqrtf(wave_sum(s) * (1.f / 1024.f) + EPS);
#pragma unroll
        for (int j = 0; j < 4; ++j) {
            const int c = (lane + 64 * j) * 4;
            const f32x4 gg = *(const f32x4*)(g + c);
            const f32x4 hv = v[j] * rinv * gg;
            if (mode == 0) {
                *(f32x4*)(xout + (size_t)t * 1024 + c) = v[j];
                uint2 o; o.x = pk2(hv.x, hv.y); o.y = pk2(hv.z, hv.w);
                *(uint2*)(hn + (size_t)t * 1024 + c) = o;
            } else {
                *(f32x4*)(xout + (size_t)t * 1024 + c) = hv;
            }
        }
    }
}

template <int l>
__device__ __forceinline__ void layer_body(const Params& P, char* smem, const XcdBarrier& xb, const float* xcur) {
    char* ws = P.ws;
    bf16_t* Wt_in = (bf16_t*)(ws + OFF_WIN); bf16_t* Wt_out = (bf16_t*)(ws + OFF_WOUT); bf16_t* Wt_mq = (bf16_t*)(ws + OFF_WMQ); bf16_t* Wt_mkv = (bf16_t*)(ws + OFF_WMKV);
    bf16_t* Wt_mo = (bf16_t*)(ws + OFF_WMO); bf16_t* Wt_gu = (bf16_t*)(ws + OFF_WGU); bf16_t* Wt_dn = (bf16_t*)(ws + OFF_WDN);
    bf16_t* hn = (bf16_t*)(ws + OFF_HN); bf16_t* proj = (bf16_t*)(ws + OFF_PROJ); float* gates = (float*)(ws + OFF_GATES); bf16_t* y = (bf16_t*)(ws + OFF_Y);
    float* XA = P.out; float* XB = (float*)(ws + OFF_XB);
    bf16_t* qm = (bf16_t*)(ws + OFF_QM); bf16_t* om = (bf16_t*)(ws + OFF_OM); bf16_t* kvm = (bf16_t*)(ws + OFF_KVM); bf16_t* memn = (bf16_t*)(ws + OFF_MEMN);
    float* foxc = (float*)(ws + OFF_FOXC); float* lrua = (float*)(ws + OFF_LRUA); float* lruu = (float*)(ws + OFF_LRUU);
    int* cnt_all = (int*)(ws + OFF_CTL) + CTL_CNT_WORD; int* list = (int*)(ws + OFF_LIST); float* pgate = (float*)(ws + OFF_PGATE);
    bf16_t* act = (bf16_t*)(ws + OFF_ACT); bf16_t* eo = (bf16_t*)(ws + OFF_EO); float* pss = (float*)(ws + OFF_PSS);
    const int wave = TIDX >> 6, lane = TIDX & 63;


        float* x1 = (l == 0) ? XA : XB;
        float* x2 = (l == 0) ? XB : XA;
        int* cnt = cnt_all + 32 * CNT_STRIDE * l;
        const float* mg = P.in[I_MIX_GAIN] + l * 1024;
        REP(2, { pg8::Gemm g{hn, Wt_in + (size_t)l * NP * 1024, T, NP, 1024}; pg8::StaticOrder S; S.init(T, NP, (int)gridDim.x, (int)blockIdx.x);
                 pg8::EpiInProj E{proj, NP, gates, C_GATE};
                 pg8::gemm_phase<pg8::EpiInProj, pg8::StaticOrder, true, true>((PG8_LAS unsigned char*)smem, g, S, E); });
        if (l == 0) for (int l2 = 0; l2 < NL; ++l2)
            gemm_phase<EPI_BF16>(smem, memn + (size_t)l2 * 2048 * 1024, 1024, Wt_mkv + (size_t)l2 * 512 * 1024, 1024, 2048, 512, 1024, kvm + (size_t)l2 * 2048 * 512, 512, nullptr, nullptr,
                                 (gridDim.x >= 192) ? ((int)blockIdx.x - 128 - 32 * l2) : (int)blockIdx.x, (gridDim.x >= 192) ? 4096 : (int)gridDim.x);
        GSYNC();
        REP(4,         {
            const int bx = blockIdx.x;
            bf16_t* gtiles = (bf16_t*)(ws + OFF_GDN); float* glast = (float*)(ws + OFF_GLAST);
            if (bx < 32 && wave == 1) fox_cumsum(gates, P.in[I_FOX_FB] + l * 4, foxc, bx, lane);
            BLK_LOOP(cp, 512) gdn_prep_pair(smem, proj, gates, P.in[I_GDN_CONV_W] + l * 4 * 768, P.in[I_GDN_A_LOG] + l * 4, P.in[I_GDN_DT_BIAS] + l * 4, gtiles, glast, 2 * cp);
            BLK_LOOP(ch, 1024) hgrn_local_task(smem, proj, P.in[I_HGRN_LB], l, (float*)(ws + OFF_HL), (float*)(ws + OFF_HD), ch);
            BLK_LOOP(task, 256) lru_local_task(smem, proj, P.in[I_LRU_CONV_W] + l * 1024, P.in[I_LRU_CONV_B] + l * 256, P.in[I_LRU_WA] + l * 16384, P.in[I_LRU_BA] + l * 256,
                                               P.in[I_LRU_WX] + l * 16384, P.in[I_LRU_BX] + l * 256, P.in[I_LRU_LAM] + l * 256, lrua, lruu, (float*)(ws + OFF_LSUM), task);
        });
        GSYNC();
        state_scan_phase((const float*)(ws + OFF_HL), (const float*)(ws + OFF_HD), (bf16_t*)(ws + OFF_HS), (const float*)(ws + OFF_LSUM), (float*)(ws + OFF_LCAR));
        GSYNC();
        REP(8,         {
            const int natt = (SEQ / 128) * 4 * NB;
            const int bx = blockIdx.x, nfree = (int)gridDim.x - 32;
            if (bx < 32) gdn_scan_task(smem, (const bf16_t*)(ws + OFF_GDN), (const float*)(ws + OFF_GLAST), proj, mg, y, bx);
            else {
                for (int r = 0; r * nfree < natt; ++r) {
                    const int i = r * nfree + ((r & 1) ? (nfree - 1 - (bx - 32)) : (bx - 32));
                    if (i >= natt) continue;
                    const int qt = 15 - (i >> 5), bh = i & 31;
                    attn_task(smem, proj + C_BQ, NP, proj + C_BK, NP, proj + C_BV, NP, foxc, SEQ, SEQ, 1, 0.125f, y + 256, 1024, mg + 256, 1, (bh * 16) + qt);
                }
                for (int i = bx - 32; i < 1024; i += nfree) {
                    const int ch = (i & 31) * 32 + (31 - (i >> 5));
                    hgrn_out_task(smem, proj, P.in[I_HGRN_LB], l, (const bf16_t*)(ws + OFF_HS), mg, y, ch);
                }
                for (int i = bx - 32; i < 256; i += nfree) lru_out_task(lrua, lruu, (const float*)(ws + OFF_LCAR), proj, mg, y, i);
            }
        });
        GSYNC();
        REP(16, { pg8::Gemm g{y, Wt_out + (size_t)l * 1024 * 1024, T, 1024, 1024}; pg8::StaticOrder S; S.init(T, 1024, (int)gridDim.x, (int)blockIdx.x);
                  pg8::EpiResidNorm E{xcur, x1, 1024, P.in[I_NORM_MEM] + l * 1024, hn, pss};
                  pg8::gemm_phase<pg8::EpiResidNorm, pg8::StaticOrder, true, true>((PG8_LAS unsigned char*)smem, g, S, E); });
        GSYNC();
        REP(64, BLK_LOOP(tile, T / 64) middle_task(smem, hn, pss, Wt_mq + (size_t)l * 256 * 1024, kvm + (size_t)l * 2048 * 512, Wt_mo + (size_t)l * 1024 * 256, x1, x2, P.in[I_NORM_FFN] + l * 1024, hn, pss,
                                                            (const bf16_t*)(ws + OFF_WR) + (size_t)l * 2 * 48 * 1024, P.in[I_B_RG] + l * 4, P.in[I_B_RE] + l * 32, cnt, list, pgate, tile));
        GSYNC();
        REP(512, moe_phase<1>(smem, hn, 1024, Wt_gu + (size_t)l * 32 * 512 * 1024, (size_t)512 * 1024, 1024, 1024, cnt, list, pgate, act, pss));
        GSYNC();
        REP(1024, moe_phase<2>(smem, act, 256, Wt_dn + (size_t)l * 32 * 1024 * 256, (size_t)1024 * 256, 256, 256, cnt, list, pgate, eo, pss));
        if (PROBE_MASK & 2048) { for (int i = 0; i < 10; ++i) GSYNC(); }
        GSYNC();
        if (l == 0) { combine_phase(x2, eo, P.in[I_NORM_MIX] + 1024, XA, hn, 0); GSYNC(); }
        else combine_phase(x2, eo, P.in[I_NORM_FINAL], P.out, hn, 1);
}
__global__ void __launch_bounds__(NTHR, 2) mega_kernel(Params P) {
    extern __shared__ __attribute__((aligned(16))) char smem[];
    volatile LDS_AS unsigned* st = (volatile LDS_AS unsigned*)(smem + LDS_BYTES - 16);
    if (TIDX < 4) st[TIDX] = 0u;
    __syncthreads();
    const XcdBarrier xb = xcd_barrier_post((unsigned*)(P.ws + OFF_CTL), st);
    phase0(P, smem);
    GSYNC();
    layer_body<0>(P, smem, xb, P.in[I_X]);
    layer_body<1>(P, smem, xb, P.out);
}

extern "C" void kernel_launch(void* const* d_in, const int* in_sizes, int n_in, void* d_out, int out_size, void* d_ws, size_t ws_size, hipStream_t stream) {
    static int grid_blocks = 0;
    if (grid_blocks == 0) {
        if (n_in != N_INPUTS || ws_size < OFF_END || out_size != T * 1024) { fprintf(stderr, "kernel_launch: unexpected sizes n_in=%d ws=%zu out=%d (need ws >= %zu)\n", n_in, ws_size, out_size, (size_t)OFF_END); grid_blocks = -1; return; }
        int dev = 0, cus = 0, per_cu = 0;
        if (hipGetDevice(&dev) != hipSuccess || hipDeviceGetAttribute(&cus, hipDeviceAttributeMultiprocessorCount, dev) != hipSuccess) { fprintf(stderr, "kernel_launch: device query failed\n"); grid_blocks = -1; return; }
        if (hipFuncSetAttribute((const void*)mega_kernel, hipFuncAttributeMaxDynamicSharedMemorySize, LDS_BYTES) != hipSuccess) { fprintf(stderr, "kernel_launch: hipFuncSetAttribute failed\n"); grid_blocks = -1; return; }
        if (hipOccupancyMaxActiveBlocksPerMultiprocessor(&per_cu, (const void*)mega_kernel, NTHR, LDS_BYTES) != hipSuccess || per_cu < 1) { fprintf(stderr, "kernel_launch: occupancy query says %d blocks/CU\n", per_cu); grid_blocks = -1; return; }
        grid_blocks = cus;
        fprintf(stderr, "kernel_launch: cus=%d per_cu=%d grid=%d\n", cus, per_cu, grid_blocks);
    }
    if (grid_blocks < 0) return;
    if (hipMemsetAsync((char*)d_ws + OFF_CTL, 0, CTL_BYTES, stream) != hipSuccess) { fprintf(stderr, "kernel_launch: memset failed\n"); return; }
    Params p; memset(&p, 0, sizeof p);
    for (int i = 0; i < N_INPUTS; ++i) p.in[i] = (const float*)d_in[i];
    p.out = (float*)d_out; p.ws = (char*)d_ws;
    void* args[] = {&p};
    hipError_t e = hipLaunchCooperativeKernel((const void*)mega_kernel, dim3(grid_blocks), dim3(NTHR), args, LDS_BYTES, stream);
    if (e != hipSuccess) fprintf(stderr, "kernel_launch: cooperative launch failed: %s (grid %d)\n", hipGetErrorString(e), grid_blocks);
}
```

```cpp
#include <hip/hip_runtime.h>
#include <stdint.h>
#include <stdio.h>
#include <string.h>
#include <hip/hip_cooperative_groups.h>
namespace cg = cooperative_groups;

typedef unsigned short bf16_t;
typedef short bf16x8 __attribute__((ext_vector_type(8)));
typedef float f32x4 __attribute__((ext_vector_type(4)));
typedef unsigned u32x4 __attribute__((ext_vector_type(4)));

constexpr int NB = 8, SEQ = 2048, DM = 1024, T = NB * SEQ, NL = 2;
constexpr int NP = 3584;
constexpr int NIN = 3340;
constexpr int C_AQ = 0, C_AF = 256, C_AI = 512, C_AG = 768, C_BQ = 1024, C_BK = 1280, C_BV = 1536, C_CX = 1792, C_CG = 2048,
              C_DQ = 2304, C_DK = 2560, C_DV = 2816, C_DZ = 3072, C_GATE = 3328;
constexpr int MEMLEN = 256;
constexpr int NEXP = 32, DEXP = 256;
constexpr float EPS = 1e-6f;

constexpr size_t al256(size_t x) { return (x + 255) & ~(size_t)255; }
constexpr size_t SZ_WIN = (size_t)NP * 1024 * 2, SZ_WOUT = (size_t)1024 * 1024 * 2, SZ_WMQ = (size_t)256 * 1024 * 2, SZ_WMKV = (size_t)512 * 1024 * 2,
                 SZ_WMO = (size_t)1024 * 256 * 2, SZ_WGU = (size_t)32 * 512 * 1024 * 2, SZ_WDN = (size_t)32 * 1024 * 256 * 2;
constexpr size_t OFF_WIN = 0;
constexpr size_t OFF_WOUT = OFF_WIN + NL * SZ_WIN;
constexpr size_t OFF_WMQ = OFF_WOUT + NL * SZ_WOUT;
constexpr size_t OFF_WMKV = OFF_WMQ + NL * SZ_WMQ;
constexpr size_t OFF_WMO = OFF_WMKV + NL * SZ_WMKV;
constexpr size_t OFF_WGU = OFF_WMO + NL * SZ_WMO;
constexpr size_t OFF_WDN = OFF_WGU + NL * SZ_WGU;
constexpr size_t OFF_HN = OFF_WDN + NL * SZ_WDN;
constexpr size_t OFF_PROJ = OFF_HN + (size_t)T * 1024 * 2;
constexpr size_t OFF_GATES = OFF_PROJ + (size_t)T * NP * 2;
constexpr size_t OFF_Y = OFF_GATES + (size_t)T * 16 * 4;
constexpr size_t OFF_XB = OFF_Y + (size_t)T * 1024 * 2;
constexpr size_t OFF_QM = OFF_XB + (size_t)T * 1024 * 4;
constexpr size_t OFF_OM = OFF_QM + (size_t)T * 256 * 2;
constexpr size_t OFF_KVM = OFF_OM + (size_t)T * 256 * 2;
constexpr size_t OFF_MEMN = OFF_KVM + (size_t)NL * 2048 * 512 * 2;
constexpr size_t OFF_FOXC = OFF_MEMN + (size_t)2048 * 1024 * 2;
constexpr size_t OFF_LRUA = OFF_FOXC + (size_t)NB * 4 * SEQ * 4;
constexpr size_t OFF_LRUU = OFF_LRUA + (size_t)T * 256 * 4;
constexpr size_t OFF_CNT = OFF_LRUU + (size_t)T * 256 * 4;
constexpr size_t OFF_LIST = OFF_CNT + 256;
constexpr size_t OFF_PGATE = OFF_LIST + (size_t)NEXP * T * 4;
constexpr size_t OFF_HL = OFF_PGATE + (size_t)2 * T * 4;
constexpr size_t OFF_HD = OFF_HL + (size_t)1024 * 4096 * 4;
constexpr size_t OFF_GDN = OFF_HD + (size_t)1024 * 64 * 4;
constexpr size_t OFF_GLAST = OFF_GDN + (size_t)1024 * 5 * 4096 * 2;
constexpr size_t OFF_LSUM = OFF_GLAST + 4096;
constexpr size_t OFF_HS = OFF_LSUM + (size_t)2 * 256 * 256 * 4;
constexpr size_t OFF_LCAR = OFF_HS + (size_t)1024 * 4096 * 2;
constexpr size_t OFF_PSS = OFF_LCAR + (size_t)256 * 256 * 4;
constexpr size_t OFF_WR = OFF_PSS + (size_t)T * 16 * 4;
constexpr size_t OFF_CTL = OFF_WR + (size_t)NL * 2 * 48 * 1024 * 2;
constexpr size_t CTL_BYTES = 32768;
constexpr int CTL_CNT_WORD = 4096;
constexpr int CNT_STRIDE = 64;
constexpr size_t OFF_END = OFF_CTL + CTL_BYTES;
constexpr size_t OFF_ACT = OFF_PROJ;
constexpr size_t OFF_EO = OFF_PROJ + (size_t)2 * T * 256 * 2;
static_assert(OFF_EO + (size_t)2 * T * 1024 * 2 <= OFF_GATES, "overlay fits");

__device__ __forceinline__ int tid_opaque() { int t = threadIdx.x; asm volatile("" : "+v"(t)); return t; }
#define TIDX tid_opaque()
__device__ __forceinline__ float bf2f(bf16_t v) { return __uint_as_float(((unsigned)v) << 16); }
typedef __bf16 bf16x2_t __attribute__((ext_vector_type(2)));
__device__ __forceinline__ bf16_t f2bf(float f) { return __builtin_bit_cast(unsigned short, (__bf16)f); }
__device__ __forceinline__ unsigned pk2(float lo, float hi) { bf16x2_t v = {(__bf16)lo, (__bf16)hi}; return __builtin_bit_cast(unsigned, v); }
__device__ __forceinline__ float sigmoidf_(float x) { return 1.f / (1.f + __expf(-x)); }
__device__ __forceinline__ float siluf_(float x) { return x / (1.f + __expf(-x)); }
__device__ __forceinline__ float softplusf_(float x) { return x > 20.f ? x : log1pf(__expf(x)); }
__device__ __forceinline__ float logsigmoidf_(float x) { return x < 0.f ? x - log1pf(__expf(x)) : -log1pf(__expf(-x)); }
__device__ __forceinline__ float geluf_(float x) { float u = 0.7978845608028654f * (x + 0.044715f * x * x * x); return 0.5f * x * (1.f + tanhf(u)); }
__device__ __forceinline__ float wave_sum(float v) {
#pragma unroll
    for (int o = 1; o < 64; o <<= 1) v += __shfl_xor(v, o);
    return v;
}
__device__ __forceinline__ float rdlane(float v, int l) { return __int_as_float(__builtin_amdgcn_readlane(__float_as_int(v), l)); }

#define PROBE_MASK 0
#define PROBE_TS -1
#define PROBE_K 4
#define TS_STAMP() do { if (PROBE_TS >= 0 && blockIdx.x == 0 && TIDX == 0) { volatile unsigned long long* ts_ = (volatile unsigned long long*)(smem + LDS_BYTES - 1024); volatile unsigned* tc_ = (volatile unsigned*)(smem + LDS_BYTES - 1032); \
        const unsigned k_ = tc_[0]; ts_[k_] = __builtin_amdgcn_s_memrealtime(); tc_[0] = k_ + 1; } } while (0)
#define GSYNC() do { xcd_barrier(xb); TS_STAMP(); } while (0)
#define REP(bit, ...) do { __VA_ARGS__; if (PROBE_MASK & (bit)) { GSYNC(); __VA_ARGS__; } } while (0)
constexpr int NTHR = 512;
constexpr int LDS_BYTES = 147456;
enum { I_X = 0, I_MEM, I_NORM_MIX, I_W_IN, I_HGRN_LB, I_FOX_FB, I_LRU_CONV_W, I_LRU_CONV_B, I_LRU_WA, I_LRU_BA, I_LRU_WX, I_LRU_BX, I_LRU_LAM, I_GDN_CONV_W, I_GDN_A_LOG,
       I_GDN_DT_BIAS, I_MIX_GAIN, I_W_OUT, I_NORM_MEM, I_NORM_MEMKV, I_W_MQ, I_W_MKV, I_W_MO, I_NORM_FFN, I_W_RG, I_B_RG, I_W_RE, I_B_RE, I_W_E_GU, I_W_E_DN, I_NORM_FINAL, N_INPUTS };
struct Params { const float* in[N_INPUTS]; float* out; char* ws; };
static_assert(sizeof(Params) == 8 * (N_INPUTS + 2), "no padding");

#define BLK_LOOP(it, n) for (int it = (int)blockIdx.x; it < (n); it += (int)gridDim.x)


__device__ __forceinline__ float rinv_from_pss(const float* __restrict__ pss, size_t row) {
    const f32x4 a = *(const f32x4*)(pss + row * 16), b = *(const f32x4*)(pss + row * 16 + 4), c = *(const f32x4*)(pss + row * 16 + 8), d = *(const f32x4*)(pss + row * 16 + 12);
    const float sm = ((a[0] + a[1]) + (a[2] + a[3])) + ((b[0] + b[1]) + (b[2] + b[3])) + ((c[0] + c[1]) + (c[2] + c[3])) + ((d[0] + d[1]) + (d[2] + d[3]));
    return rsqrtf(sm * (1.f / 1024.f) + EPS);
}

__device__ __forceinline__ int rowmap_fn(int mode, int n) {
    if (mode == 1) {
        if (n < 1792) return n;
        if (n < 1796) return C_GATE + (n - 1792);
        if (n < 3076) return n - 4;
        if (n < 3084) return C_GATE + 4 + (n - 3076);
        return n - 12;
    } else if (mode == 2) {
        int j = n & 255; return (j >> 4) * 32 + ((n >= 256) ? 16 : 0) + (j & 15);
    }
    return n;
}
constexpr int CT_PER_LAYER = 53 * 16 + 256 + 64 + 128 + 64;
constexpr int CT_GU = 64 * 128, CT_DN = 64 * 64;
constexpr int CT_TOTAL = NL * CT_PER_LAYER + CT_GU + CT_DN;

struct CtJob { const float* src; bf16_t* dst; int K, N, mode, ntn, idx; };
__device__ __forceinline__ CtJob ct_decode(const Params& P, int it) {
    char* ws = P.ws; CtJob j; int r = it;
    const int l = r / CT_PER_LAYER; r -= l * CT_PER_LAYER;
    if (r < 848) { j.src = P.in[I_W_IN] + (size_t)l * 1024 * NIN; j.dst = (bf16_t*)(ws + OFF_WIN) + (size_t)l * NP * 1024; j.K = 1024; j.N = NIN; j.mode = 1; j.ntn = 53; j.idx = r; return j; } r -= 848;
    if (r < 256) { j.src = P.in[I_W_OUT] + (size_t)l * 1024 * 1024; j.dst = (bf16_t*)(ws + OFF_WOUT) + (size_t)l * 1024 * 1024; j.K = 1024; j.N = 1024; j.mode = 0; j.ntn = 16; j.idx = r; return j; } r -= 256;
    if (r < 64) { j.src = P.in[I_W_MQ] + (size_t)l * 1024 * 256; j.dst = (bf16_t*)(ws + OFF_WMQ) + (size_t)l * 256 * 1024; j.K = 1024; j.N = 256; j.mode = 0; j.ntn = 4; j.idx = r; return j; } r -= 64;
    if (r < 128) { j.src = P.in[I_W_MKV] + (size_t)l * 1024 * 512; j.dst = (bf16_t*)(ws + OFF_WMKV) + (size_t)l * 512 * 1024; j.K = 1024; j.N = 512; j.mode = 0; j.ntn = 8; j.idx = r; return j; } r -= 128;
    j.src = P.in[I_W_MO] + (size_t)l * 256 * 1024; j.dst = (bf16_t*)(ws + OFF_WMO) + (size_t)l * 1024 * 256; j.K = 256; j.N = 1024; j.mode = 0; j.ntn = 16; j.idx = r; return j;
}
__device__ __forceinline__ CtJob ct_decode_all(const Params& P, int it) {
    if (it < NL * CT_PER_LAYER) return ct_decode(P, it);
    char* ws = P.ws; CtJob j; int r = it - NL * CT_PER_LAYER;
    if (r < CT_GU) { const int m = r >> 7; j.src = P.in[I_W_E_GU] + (size_t)m * 1024 * 512; j.dst = (bf16_t*)(ws + OFF_WGU) + (size_t)m * 512 * 1024; j.K = 1024; j.N = 512; j.mode = 2; j.ntn = 8; j.idx = r & 127; return j; }
    r -= CT_GU;
    { const int m = r >> 6; j.src = P.in[I_W_E_DN] + (size_t)m * 256 * 1024; j.dst = (bf16_t*)(ws + OFF_WDN) + (size_t)m * 1024 * 256; j.K = 256; j.N = 1024; j.mode = 0; j.ntn = 16; j.idx = r & 63; return j; }
}
__device__ __forceinline__ void ct_load(const CtJob& j, int tid, f32x4 (&v)[2]) {
    const int n0 = (j.idx % j.ntn) * 64, k0 = (j.idx / j.ntn) * 64;
#pragma unroll
    for (int i = 0; i < 2; ++i) {
        const int k = (tid >> 4) + 32 * i, n = n0 + (tid & 15) * 4;
        v[i] = (f32x4){0.f, 0.f, 0.f, 0.f};
        if (n + 3 < j.N) v[i] = __builtin_nontemporal_load((const f32x4*)(j.src + (size_t)(k0 + k) * j.N + n));
        else { for (int e = 0; e < 4; ++e) if (n + e < j.N) v[i][e] = j.src[(size_t)(k0 + k) * j.N + n + e]; }
    }
}
__device__ __forceinline__ void ct_store(float* tile  , const CtJob& j, int tid, const f32x4 (&v)[2]) {
    const int n0 = (j.idx % j.ntn) * 64, k0 = (j.idx / j.ntn) * 64;
    __syncthreads();
#pragma unroll
    for (int i = 0; i < 2; ++i) {
        const int k = (tid >> 4) + 32 * i;
#pragma unroll
        for (int e = 0; e < 4; ++e) tile[k * 65 + (tid & 15) * 4 + e] = v[i][e];
    }
    __syncthreads();
    const int nl = tid >> 3, k8 = (tid & 7) * 8, n = n0 + nl;
    if (n < j.N) {
        const int r = rowmap_fn(j.mode, n);
        u32x4 o;
#pragma unroll
        for (int q = 0; q < 4; ++q) o[q] = pk2(tile[(k8 + 2 * q) * 65 + nl], tile[(k8 + 2 * q + 1) * 65 + nl]);
        *(u32x4*)(j.dst + (size_t)r * j.K + k0 + k8) = o;
    }
}
__device__ __forceinline__ void rms_row_bf16(const float* __restrict__ xrow, const float* __restrict__ g, bf16_t* __restrict__ orow, int lane) {
    const f32x4* xr = (const f32x4*)xrow + lane;
    f32x4 v[4]; float s = 0.f;
#pragma unroll
    for (int j = 0; j < 4; ++j) { v[j] = xr[64 * j]; s += v[j].x * v[j].x + v[j].y * v[j].y + v[j].z * v[j].z + v[j].w * v[j].w; }
    const float rinv = rsqrtf(wave_sum(s) * (1.f / 1024.f) + EPS);
#pragma unroll
    for (int j = 0; j < 4; ++j) {
        const f32x4 gg = ((const f32x4*)g)[lane + 64 * j];
        uint2 o; o.x = pk2(v[j].x * rinv * gg.x, v[j].y * rinv * gg.y); o.y = pk2(v[j].z * rinv * gg.z, v[j].w * rinv * gg.w);
        *(uint2*)(orow + (lane + 64 * j) * 4) = o;
    }
}

__device__ __forceinline__ void phase0(const Params& P, char* smem) {
    char* ws = P.ws;
    float* tile = (float*)smem;
    {
        const int tid = TIDX;
        int it = (int)blockIdx.x;
        f32x4 vcur[2], vnxt[2];
        CtJob jc, jn;
        if (it < CT_TOTAL) { jc = ct_decode_all(P, it); ct_load(jc, tid, vcur); }
        for (; it < CT_TOTAL; it += (int)gridDim.x) {
            const int nx = it + (int)gridDim.x;
            if (nx < CT_TOTAL) { jn = ct_decode_all(P, nx); ct_load(jn, tid, vnxt); }
            ct_store(tile, jc, tid, vcur);
            jc = jn; vcur[0] = vnxt[0]; vcur[1] = vnxt[1];
        }
    }
    for (int i = blockIdx.x * NTHR + TIDX; i < NL * (NP - NIN) * 512; i += gridDim.x * NTHR) {
        const int l = i / ((NP - NIN) * 512), w = i % ((NP - NIN) * 512);
        ((unsigned*)((bf16_t*)(ws + OFF_WIN) + (size_t)l * NP * 1024 + (size_t)NIN * 1024))[w] = 0u;
    }
    for (int i = blockIdx.x * NTHR + TIDX; i < NL * 48 * 1024; i += gridDim.x * NTHR) {
        const int l = i / (48 * 1024), r = (i / 1024) % 48, k = i & 1023;
        float w = 0.f;
        if (r < 4) w = P.in[I_W_RG][(size_t)l * 4096 + k * 4 + r]; else if (r < 36) w = P.in[I_W_RE][(size_t)l * 32768 + k * 32 + (r - 4)];
        const bf16_t hi = f2bf(w); const bf16_t lo = f2bf(w - bf2f(hi));
        bf16_t* wr = (bf16_t*)(ws + OFF_WR) + (size_t)l * 2 * 48 * 1024;
        wr[r * 1024 + k] = hi; wr[48 * 1024 + r * 1024 + k] = lo;
    }
    const int gw = blockIdx.x * 8 + (TIDX >> 6), ngw = gridDim.x * 8, lane = TIDX & 63;
    for (int row = gw; row < T + NL * 2048; row += ngw) {
        if (row < T) rms_row_bf16(P.in[I_X] + (size_t)row * 1024, P.in[I_NORM_MIX], (bf16_t*)(ws + OFF_HN) + (size_t)row * 1024, lane);
        else { const int r2 = row - T, l = r2 >> 11, rr = r2 & 2047;
               rms_row_bf16(P.in[I_MEM] + (size_t)rr * 1024, P.in[I_NORM_MEMKV] + l * 1024, (bf16_t*)(ws + OFF_MEMN) + (size_t)r2 * 1024, lane); }
    }
}

constexpr int GLD = 72;
constexpr int GEMM_STAGE = (256 + 128) * GLD * 2;
constexpr int GEMM_LDS = 2 * GEMM_STAGE;
template <class RowPtr>
__device__ __forceinline__ void gemm_tile(char* smem, RowPtr rowptr, const bf16_t* __restrict__ Bt, int ldb, int n0, int K, f32x4 (&acc)[4][4]) {
    const int tid = TIDX, lane = tid & 63, wave = tid >> 6, wm = wave >> 1, wn = wave & 1;
    const u32x4* ga[4]; const u32x4* gb[2];
#pragma unroll
    for (int i = 0; i < 4; ++i) { const int c = tid + i * 512, r = c >> 3, ch = c & 7; ga[i] = (const u32x4*)(rowptr(r) + ch * 8); }
#pragma unroll
    for (int i = 0; i < 2; ++i) { const int c = tid + i * 512, r = c >> 3, ch = c & 7; gb[i] = (const u32x4*)(Bt + (size_t)(n0 + r) * ldb + ch * 8); }
#pragma unroll
    for (int m = 0; m < 4; ++m)
#pragma unroll
        for (int n = 0; n < 4; ++n) acc[m][n] = (f32x4){0.f, 0.f, 0.f, 0.f};
    const int nk = K / 64;
    u32x4 raA[4], rbA[2], raB[4], rbB[2];
#define GT_LOAD(RA, RB, kt) { _Pragma("unroll") for (int i = 0; i < 4; ++i) RA[i] = ga[i][(kt) * 8]; _Pragma("unroll") for (int i = 0; i < 2; ++i) RB[i] = gb[i][(kt) * 8]; }
#define GT_STORE(RA, RB, buf) { bf16_t* dA = (bf16_t*)(smem + (buf) * GEMM_STAGE); bf16_t* dB = dA + 256 * GLD; \
        _Pragma("unroll") for (int i = 0; i < 4; ++i) { const int c = tid + i * 512, r = c >> 3, ch = c & 7; *(u32x4*)(dA + r * GLD + ch * 8) = RA[i]; } \
        _Pragma("unroll") for (int i = 0; i < 2; ++i) { const int c = tid + i * 512, r = c >> 3, ch = c & 7; *(u32x4*)(dB + r * GLD + ch * 8) = RB[i]; } }
#define GT_COMPUTE(buf) { const bf16_t* sA = (const bf16_t*)(smem + (buf) * GEMM_STAGE); const bf16_t* sB = sA + 256 * GLD; \
        _Pragma("unroll") for (int kk = 0; kk < 2; ++kk) { bf16x8 af[4], bfr[4]; \
            _Pragma("unroll") for (int m = 0; m < 4; ++m) af[m] = *(const bf16x8*)(sA + (wm * 64 + m * 16 + (lane & 15)) * GLD + kk * 32 + (lane >> 4) * 8); \
            _Pragma("unroll") for (int n = 0; n < 4; ++n) bfr[n] = *(const bf16x8*)(sB + (wn * 64 + n * 16 + (lane & 15)) * GLD + kk * 32 + (lane >> 4) * 8); \
            _Pragma("unroll") for (int m = 0; m < 4; ++m) _Pragma("unroll") for (int n = 0; n < 4; ++n) acc[m][n] = __builtin_amdgcn_mfma_f32_16x16x32_bf16(bfr[n], af[m], acc[m][n], 0, 0, 0); } }
    GT_LOAD(raA, rbA, 0)
    GT_LOAD(raB, rbB, 1)
    __syncthreads();
    GT_STORE(raA, rbA, 0)
    __syncthreads();
    for (int kt = 0; kt < nk; kt += 2) {
        if (kt + 2 < nk) GT_LOAD(raA, rbA, kt + 2)
        GT_COMPUTE(0)
        GT_STORE(raB, rbB, 1)
        __syncthreads();
        if (kt + 3 < nk) GT_LOAD(raB, rbB, kt + 3)
        GT_COMPUTE(1)
        if (kt + 2 < nk) GT_STORE(raA, rbA, 0)
        __syncthreads();
    }
#undef GT_LOAD
#undef GT_STORE
#undef GT_COMPUTE
}
struct RowDirect { const bf16_t* A; int lda; int m0; __device__ __forceinline__ const bf16_t* operator()(int r) const { return A + (size_t)(m0 + r) * lda; } };
enum { EPI_INPROJ = 0, EPI_RESID = 1, EPI_BF16 = 2, EPI_BF16_RS = 3, EPI_RESID_NORM = 4 };

__device__ __forceinline__ int vcu_id() { const int G = gridDim.x, bx = blockIdx.x; return (G % 8 == 0) ? (bx % 8) * (G / 8) + bx / 8 : bx; }

template <int EPI>
__device__ __forceinline__ void gemm_phase(char* smem, const bf16_t* A, int lda, const bf16_t* Bt, int ldb, int M, int N, int K, void* out, int ldo, const float* resid, float* gates, int idx0 = -1, int stride = 0, bf16_t* xg = nullptr, const float* gn = nullptr) {
    const int ntn = N / 128, ntiles = (M / 256) * ntn;
    if (stride == 0) { idx0 = vcu_id(); stride = gridDim.x; }
    if (idx0 < 0) return;
    const int lane = TIDX & 63, wave = TIDX >> 6, wm = wave >> 1, wn = wave & 1;
    for (int tIdx = idx0; tIdx < ntiles; tIdx += stride) {
        const int m0 = (tIdx / ntn) * 256, n0 = (tIdx % ntn) * 128;
        f32x4 acc[4][4];
        RowDirect rp{A, lda, m0};
        gemm_tile(smem, rp, Bt, ldb, n0, K, acc);
        float rsc[4] = {1.f, 1.f, 1.f, 1.f};
        if (EPI == EPI_BF16_RS) {
#pragma unroll
            for (int m = 0; m < 4; ++m) rsc[m] = rinv_from_pss(resid, (size_t)(m0 + wm * 64 + m * 16 + (lane & 15)));
        }
        if (EPI == EPI_RESID_NORM) {
#pragma unroll
            for (int m = 0; m < 4; ++m) {
                const int row = m0 + wm * 64 + m * 16 + (lane & 15);
                float ss = 0.f;
#pragma unroll
                for (int n = 0; n < 4; ++n) {
                    const int col = n0 + wn * 64 + n * 16 + (lane >> 4) * 4;
                    const f32x4 o = *(const f32x4*)(resid + (size_t)row * ldo + col) + acc[m][n];
                    *(f32x4*)((float*)out + (size_t)row * ldo + col) = o;
                    ss += (o[0] * o[0] + o[1] * o[1]) + (o[2] * o[2] + o[3] * o[3]);
                    const f32x4 og = o * *(const f32x4*)(gn + col);
                    uint2 w; w.x = pk2(og[0], og[1]); w.y = pk2(og[2], og[3]);
                    *(uint2*)(xg + (size_t)row * ldo + col) = w;
                }
                ss += __shfl_xor(ss, 16); ss += __shfl_xor(ss, 32);
                if ((lane >> 4) == 0) gates[(size_t)row * 16 + (n0 >> 7) * 2 + wn] = ss;
            }
            continue;
        }
#pragma unroll
        for (int m = 0; m < 4; ++m)
#pragma unroll
            for (int n = 0; n < 4; ++n) {
                const int row = m0 + wm * 64 + m * 16 + (lane & 15), col = n0 + wn * 64 + n * 16 + (lane >> 4) * 4;
                const f32x4 v = acc[m][n];
                if (EPI == EPI_INPROJ) {
                    uint2 o; o.x = pk2(v.x, v.y); o.y = pk2(v.z, v.w);
                    *(uint2*)((bf16_t*)out + (size_t)row * ldo + col) = o;
                    if (col >= C_GATE && col < C_GATE + 16) *(f32x4*)(gates + (size_t)row * 16 + (col - C_GATE)) = v;
                } else if (EPI == EPI_RESID) {
                    const f32x4 r = *(const f32x4*)(resid + (size_t)row * ldo + col);
                    *(f32x4*)((float*)out + (size_t)row * ldo + col) = r + v;
                } else if (EPI == EPI_BF16_RS) {
                    const float ri = rsc[m];
                    uint2 o; o.x = pk2(v.x * ri, v.y * ri); o.y = pk2(v.z * ri, v.w * ri);
                    *(uint2*)((bf16_t*)out + (size_t)row * ldo + col) = o;
                } else {
                    uint2 o; o.x = pk2(v.x, v.y); o.y = pk2(v.z, v.w);
                    *(uint2*)((bf16_t*)out + (size_t)row * ldo + col) = o;
                }
            }
    }
}


namespace pg8 {
#define PG8_LAS __attribute__((address_space(3)))
typedef unsigned short bf16_t;
typedef short bf16x8 __attribute__((ext_vector_type(8)));
typedef float f32x4 __attribute__((ext_vector_type(4)));
typedef unsigned u32x4 __attribute__((ext_vector_type(4)));
constexpr int BM = 256, BK = 64, HALF = 128, HTB = HALF * BK * 2  , STAGE_BYTES = 8 * HTB, NXCD = 8, WGM = 8;

__host__ __device__ __forceinline__ int lds_byte(int r, int c) { const int st = (r >> 4) * 2 + (c >> 5), rr = r & 15, cc = c & 31, ob = rr * 64 + cc * 2; return st * 1024 + (ob ^ (((ob >> 9) & 1) << 5)); }
__host__ __device__ __forceinline__ void stage_rc(int b, int& R, int& C) { const int st = b / 1024, sb = b % 1024, swz = sb ^ (((sb >> 9) & 1) << 5); R = (st >> 1) * 16 + swz / 64; C = (st & 1) * 32 + (swz % 64) / 2; }
__host__ __device__ __forceinline__ int perm32(int rho) { const int n = rho >> 4, i = rho & 15; return 8 * (i >> 2) + 4 * n + (i & 3); }

struct Unit { int pm, pn; };
struct Gemm { const bf16_t* A; const bf16_t* Bt; int M, N, K; };

struct StaticOrder {
    int nM, nN, nwg, G, c;
    __host__ __device__ void init(int M, int N, int G_, int c_) { nM = M / BM; nN = N / BM; nwg = nM * nN; G = G_; c = c_; }
    __host__ __device__ bool next(int i, Unit& u) const {
        const long L = (long)i * G + c; if (L >= nwg) return false;
        int wgid = (int)L; { const int q = nwg / NXCD, r = nwg % NXCD, xcd = wgid % NXCD, off = wgid / NXCD; wgid = (xcd < r ? xcd * (q + 1) : r * (q + 1) + (xcd - r) * q) + off; }
        const int nig = WGM * nN, gid = wgid / nig, fm = gid * WGM, gsz = (nM - fm) < WGM ? (nM - fm) : WGM;
        u.pm = fm + ((wgid % nig) % gsz); u.pn = (wgid % nig) / gsz; return true;
    }
    __device__ __forceinline__ void a_ready(const Unit&) const {}
    __device__ __forceinline__ void done(const Unit&) const {}
};
__device__ __forceinline__ unsigned cvt_pk_bf16(float lo, float hi) { unsigned r; asm volatile("v_cvt_pk_bf16_f32 %0, %1, %2" : "=v"(r) : "v"(lo), "v"(hi)); return r; }
typedef float f32x2 __attribute__((ext_vector_type(2)));

struct EpiInProj {
    static constexpr bool PERM = true, AFTER_DRAIN = false;
    bf16_t* O; int ldc; float* gates; int gate_col;
    __device__ __forceinline__ void operator()(const f32x4 (&acc)[2][2][4][2], const Unit& u, int wr, int wc, int fr, int fq) const {
        const int row0 = u.pm * BM + wr * 64 + fr, col0 = u.pn * BM + wc * 32 + 8 * fq;
#pragma unroll
        for (int ai = 0; ai < 2; ++ai)
#pragma unroll
            for (int m = 0; m < 4; ++m) {
                const int row = row0 + ai * HALF + m * 16;
                bf16_t* rowp = O + (size_t)row * ldc + col0;
#pragma unroll
                for (int bj = 0; bj < 2; ++bj) {
                    const f32x4 v0 = acc[ai][bj][m][0], v1 = acc[ai][bj][m][1];
                    u32x4 w; w.x = cvt_pk_bf16(v0[0], v0[1]); w.y = cvt_pk_bf16(v0[2], v0[3]); w.z = cvt_pk_bf16(v1[0], v1[1]); w.w = cvt_pk_bf16(v1[2], v1[3]);
                    *(u32x4*)(rowp + bj * HALF) = w;
                    const int gc = col0 + bj * HALF - gate_col;
                    if (gates && gc >= 0 && gc < 16) { *(f32x4*)(gates + (size_t)row * 16 + gc) = v0; *(f32x4*)(gates + (size_t)row * 16 + gc + 4) = v1; }
                }
            }
    }
};
struct EpiResid {
    static constexpr bool PERM = false, AFTER_DRAIN = false;
    const float* base; float* out; int ldc;
    __device__ __forceinline__ void operator()(const f32x4 (&acc)[2][2][4][2], const Unit& u, int wr, int wc, int fr, int fq) const {
        const int col0 = u.pn * BM + wc * 32 + 4 * fq;
#pragma unroll
        for (int ai = 0; ai < 2; ++ai)
#pragma unroll
            for (int m = 0; m < 4; ++m) {
                const size_t off = (size_t)(u.pm * BM + ai * HALF + wr * 64 + m * 16 + fr) * ldc + col0;
#pragma unroll
                for (int bj = 0; bj < 2; ++bj)
#pragma unroll
                    for (int n = 0; n < 2; ++n) { const f32x4 bs = *(const f32x4*)(base + off + bj * HALF + n * 16); *(f32x4*)(out + off + bj * HALF + n * 16) = bs + acc[ai][bj][m][n]; }
                if (m & 1) asm volatile("" ::: "memory");
            }
    }
};

struct EpiResidNorm {
    static constexpr bool PERM = false, AFTER_DRAIN = false;
    const float* base; float* out; int ldc; const float* gn; bf16_t* xg; float* pss;
    __device__ __forceinline__ void operator()(const f32x4 (&acc)[2][2][4][2], const Unit& u, int wr, int wc, int fr, int fq) const {
        const int col0 = u.pn * BM + wc * 32 + 4 * fq;
        f32x4 gv[2][2];
#pragma unroll
        for (int bj = 0; bj < 2; ++bj)
#pragma unroll
            for (int n = 0; n < 2; ++n) gv[bj][n] = *(const f32x4*)(gn + col0 + bj * HALF + n * 16);
#pragma unroll
        for (int ai = 0; ai < 2; ++ai)
#pragma unroll
            for (int m = 0; m < 4; ++m) {
                const int row = u.pm * BM + ai * HALF + wr * 64 + m * 16 + fr;
                const size_t off = (size_t)row * ldc + col0;
                float ss = 0.f;
#pragma unroll
                for (int bj = 0; bj < 2; ++bj)
#pragma unroll
                    for (int n = 0; n < 2; ++n) {
                        const f32x4 bs = *(const f32x4*)(base + off + bj * HALF + n * 16);
                        const f32x4 o = bs + acc[ai][bj][m][n];
                        *(f32x4*)(out + off + bj * HALF + n * 16) = o;
                        ss += (o[0] * o[0] + o[1] * o[1]) + (o[2] * o[2] + o[3] * o[3]);
                        const f32x4 og = o * gv[bj][n];
                        uint2 w; w.x = cvt_pk_bf16(og[0], og[1]); w.y = cvt_pk_bf16(og[2], og[3]);
                        *(uint2*)(xg + off + bj * HALF + n * 16) = w;
                    }
                ss += __shfl_xor(ss, 16); ss += __shfl_xor(ss, 32);
                if (fq == 0) pss[(size_t)row * 16 + u.pn * 4 + wc] = ss;
                if (m & 1) asm volatile("" ::: "memory");
            }
    }
};
template <class Epi, class Sched, bool ALIGN_EPI = false, bool SP2 = false>
__device__ __forceinline__ void gemm_phase(PG8_LAS unsigned char* lds, const Gemm g, const Sched& S, const Epi& E) {
    const int tid = TIDX, wid = __builtin_amdgcn_readfirstlane(tid >> 6), lane = tid & 63, wr = wid >> 2, wc = wid & 3, fr = lane & 15, fq = lane >> 4;
    const int K = g.K, nt = K / BK;
    unsigned voffA[2], voffB[2];
#pragma unroll
    for (int i = 0; i < 2; ++i) { int R, C; stage_rc(tid * 16 + i * 8192, R, C); const int Rb = Epi::PERM ? ((R & ~31) + perm32(R & 31)) : R;
        voffA[i] = (unsigned)(R * K + C) * 2u; voffB[i] = (unsigned)(Rb * K + C) * 2u; }
    const size_t kstep = (size_t)(BK * 2);
    const size_t hstep = (size_t)HALF * K * 2;
    const size_t tstep = 2 * hstep;
    const unsigned ldsw = (unsigned)wid * 1024u;
    const int aoff = lds_byte(wr * 64 + fr, fq * 8), boff = lds_byte(wc * 32 + fr, fq * 8);
#define PG8_SA(b, h) (((b) * 2 + (h)) * HTB)
#define PG8_SB(b, h) ((4 + (b) * 2 + (h)) * HTB)
#define PG8_STAGE(bufoff, gbase, voff) do { _Pragma("unroll") for (int _i = 0; _i < 2; ++_i) \
        __builtin_amdgcn_global_load_lds((const unsigned*)((const char*)(gbase) + (voff)[_i]), (PG8_LAS unsigned*)(lds + (bufoff) + ldsw + _i * 8192), 16, 0, 0); } while (0)
#define PG8_LDA(dst, b, h) do { _Pragma("unroll") for (int m = 0; m < 4; ++m) _Pragma("unroll") for (int k = 0; k < 2; ++k) dst[m][k] = *(const PG8_LAS bf16x8*)(lds + PG8_SA(b, h) + aoff + m * 2048 + k * 1024); } while (0)
#define PG8_LDB(dst, b, h) do { _Pragma("unroll") for (int n = 0; n < 2; ++n) _Pragma("unroll") for (int k = 0; k < 2; ++k) dst[n][k] = *(const PG8_LAS bf16x8*)(lds + PG8_SB(b, h) + boff + n * 2048 + k * 1024); } while (0)
#define PG8_MMA(ai, bj, At, Bt) do { __builtin_amdgcn_s_setprio(1); _Pragma("unroll") for (int m = 0; m < 4; ++m) _Pragma("unroll") for (int n = 0; n < 2; ++n) _Pragma("unroll") for (int k = 0; k < 2; ++k) \
        acc[ai][bj][m][n] = __builtin_amdgcn_mfma_f32_16x16x32_bf16(Bt[n][k], At[m][k], acc[ai][bj][m][n], 0, 0, 0); __builtin_amdgcn_s_setprio(0); } while (0)
#define PG8_WAIT_V(n) asm volatile("s_waitcnt vmcnt(" #n ")" ::: "memory")
#define PG8_WAIT_L(n) asm volatile("s_waitcnt lgkmcnt(" #n ")" ::: "memory")
#define PG8_BAR __builtin_amdgcn_s_barrier()
#define PG8_SCHED __builtin_amdgcn_sched_barrier(0)
    Unit cur, nxt; int ui = 0;
    if (!S.next(0, cur)) return;
    f32x4 acc[2][2][4][2];
#pragma unroll
    for (int a = 0; a < 2; ++a)
#pragma unroll
        for (int b = 0; b < 2; ++b)
#pragma unroll
            for (int m = 0; m < 4; ++m)
#pragma unroll
                for (int n = 0; n < 2; ++n) acc[a][b][m][n] = (f32x4){0.f, 0.f, 0.f, 0.f};
    bf16x8 At[4][2], B0[2][2], B1[2][2];
    const char* cA = (const char*)g.A + (size_t)cur.pm * tstep; const char* cB = (const char*)g.Bt + (size_t)cur.pn * tstep;
    S.a_ready(cur);
    if constexpr (SP2) {
        PG8_STAGE(PG8_SB(0, 0), cB, voffB); PG8_STAGE(PG8_SB(0, 1), cB + hstep, voffB); PG8_STAGE(PG8_SA(0, 0), cA, voffA); PG8_STAGE(PG8_SA(0, 1), cA + hstep, voffA);
        if (wr == 1) PG8_BAR;
        PG8_WAIT_V(2); PG8_BAR;
        PG8_STAGE(PG8_SB(1, 0), cB + kstep, voffB); PG8_STAGE(PG8_SA(1, 0), cA + kstep, voffA); PG8_STAGE(PG8_SB(1, 1), cB + hstep + kstep, voffB);
        PG8_WAIT_V(6); PG8_BAR;
    } else {
        PG8_STAGE(PG8_SB(0, 0), cB, voffB); PG8_STAGE(PG8_SA(0, 0), cA, voffA); PG8_STAGE(PG8_SB(0, 1), cB + hstep, voffB); PG8_STAGE(PG8_SA(0, 1), cA + hstep, voffA);
        if (wr == 1) PG8_BAR;
        PG8_WAIT_V(4); PG8_BAR;
        PG8_STAGE(PG8_SB(1, 0), cB + kstep, voffB); PG8_STAGE(PG8_SA(1, 0), cA + kstep, voffA); PG8_STAGE(PG8_SB(1, 1), cB + hstep + kstep, voffB);
        PG8_WAIT_V(6); PG8_BAR;
    }
    for (;;) {
        const bool has_next = S.next(ui + 1, nxt);
        const char* nA = has_next ? (const char*)g.A + (size_t)nxt.pm * tstep : cA; const char* nB = has_next ? (const char*)g.Bt + (size_t)nxt.pn * tstep : cB;
        for (int t = 0; t < nt; t += 2) {
            const bool last = (t == nt - 2);
            const char* a1 = cA + (size_t)(t + 1) * kstep;
            const char* a2 = last ? nA : cA + (size_t)(t + 2) * kstep; const char* b2 = last ? nB : cB + (size_t)(t + 2) * kstep;
            const char* a3 = a2 + kstep; const char* b3 = b2 + kstep;
            if (last && has_next) S.a_ready(nxt);
            if constexpr (SP2) {
            PG8_LDB(B0, 0, 0); PG8_LDB(B1, 0, 1); PG8_SCHED; PG8_LDA(At, 0, 0); PG8_STAGE(PG8_SA(1, 1), a1 + hstep, voffA);
            PG8_WAIT_V(8); PG8_WAIT_L(0); PG8_BAR; PG8_MMA(0, 0, At, B0); PG8_MMA(0, 1, At, B1); PG8_BAR; PG8_SCHED;
            PG8_LDA(At, 0, 1); PG8_STAGE(PG8_SB(0, 0), b2, voffB); PG8_STAGE(PG8_SB(0, 1), b2 + hstep, voffB); PG8_STAGE(PG8_SA(0, 0), a2, voffA);
            PG8_WAIT_V(8); PG8_WAIT_L(0); PG8_BAR; PG8_MMA(1, 0, At, B0); PG8_MMA(1, 1, At, B1); PG8_BAR; PG8_SCHED;
            PG8_LDB(B0, 1, 0); PG8_LDB(B1, 1, 1); PG8_SCHED; PG8_LDA(At, 1, 0); PG8_STAGE(PG8_SA(0, 1), a2 + hstep, voffA);
            PG8_WAIT_V(8); PG8_WAIT_L(0); PG8_BAR; PG8_MMA(0, 0, At, B0); PG8_MMA(0, 1, At, B1); PG8_BAR; PG8_SCHED;
            PG8_LDA(At, 1, 1); PG8_STAGE(PG8_SB(1, 0), b3, voffB); PG8_STAGE(PG8_SB(1, 1), b3 + hstep, voffB); PG8_STAGE(PG8_SA(1, 0), a3, voffA);
            PG8_WAIT_V(8); PG8_WAIT_L(0); PG8_BAR; PG8_MMA(1, 0, At, B0); PG8_MMA(1, 1, At, B1); PG8_BAR; PG8_SCHED;
            } else {
            PG8_LDB(B0, 0, 0); PG8_SCHED; PG8_LDA(At, 0, 0); PG8_STAGE(PG8_SA(1, 1), a1 + hstep, voffA);
            PG8_WAIT_L(8); PG8_BAR; PG8_WAIT_L(0); PG8_MMA(0, 0, At, B0); PG8_BAR; PG8_SCHED;
            PG8_LDB(B1, 0, 1); PG8_STAGE(PG8_SB(0, 0), b2, voffB);
            PG8_BAR; PG8_WAIT_L(0); PG8_MMA(0, 1, At, B1); PG8_BAR;
            PG8_LDA(At, 0, 1); PG8_STAGE(PG8_SA(0, 0), a2, voffA);
            PG8_BAR; PG8_WAIT_L(0); PG8_MMA(1, 0, At, B0); PG8_BAR; PG8_SCHED;
            PG8_STAGE(PG8_SB(0, 1), b2 + hstep, voffB);
            PG8_WAIT_V(6); PG8_BAR; PG8_MMA(1, 1, At, B1); PG8_BAR;
            PG8_LDB(B0, 1, 0); PG8_SCHED; PG8_LDA(At, 1, 0); PG8_STAGE(PG8_SA(0, 1), a2 + hstep, voffA);
            PG8_WAIT_L(8); PG8_BAR; PG8_WAIT_L(0); PG8_MMA(0, 0, At, B0); PG8_BAR; PG8_SCHED;
            PG8_LDB(B1, 1, 1); PG8_STAGE(PG8_SB(1, 0), b3, voffB);
            PG8_BAR; PG8_WAIT_L(0); PG8_MMA(0, 1, At, B1); PG8_BAR;
            PG8_LDA(At, 1, 1); PG8_STAGE(PG8_SA(1, 0), a3, voffA);
            PG8_BAR; PG8_WAIT_L(0); PG8_MMA(1, 0, At, B0); PG8_BAR; PG8_SCHED;
            PG8_STAGE(PG8_SB(1, 1), b3 + hstep, voffB);
            PG8_WAIT_V(6); PG8_BAR; PG8_MMA(1, 1, At, B1); PG8_BAR;
            }
        }
        if constexpr (ALIGN_EPI) { if (wr == 0) PG8_BAR; }
        if constexpr (!Epi::AFTER_DRAIN) { E(acc, cur, wr, wc, fr, fq); S.done(cur); }
        if (!has_next) break;
#pragma unroll
        for (int a = 0; a < 2; ++a)
#pragma unroll
            for (int b = 0; b < 2; ++b)
#pragma unroll
                for (int m = 0; m < 4; ++m)
#pragma unroll
                    for (int n = 0; n < 2; ++n) acc[a][b][m][n] = (f32x4){0.f, 0.f, 0.f, 0.f};
        cur = nxt; cA = nA; cB = nB; ++ui;
        if constexpr (ALIGN_EPI) { if (wr == 1) PG8_BAR; }
    }
    PG8_WAIT_V(0);
    if constexpr (!ALIGN_EPI) { if (wr == 0) PG8_BAR; }
    PG8_BAR;
    if constexpr (Epi::AFTER_DRAIN) { E.fused(acc, cur, wr, wc, fr, fq, lds, wid, lane); S.done(cur); }
#undef PG8_SA
#undef PG8_SB
#undef PG8_STAGE
#undef PG8_LDA
#undef PG8_LDB
#undef PG8_MMA
#undef PG8_WAIT_V
#undef PG8_WAIT_L
#undef PG8_BAR
#undef PG8_SCHED
}
}

struct RowGather { const bf16_t* A; int lda; const int* ids; int shift; __device__ __forceinline__ const bf16_t* operator()(int r) const { return A + (size_t)(ids[r] >> shift) * lda; } };
template <int STAGE>
__device__ __forceinline__ void moe_phase(char* smem, const bf16_t* A, int lda, const bf16_t* Wt, size_t wstride, int ldb, int K, const int* cnt, const int* list, const float* pgate, bf16_t* out, const float* pss) {
    int* ids = (int*)(smem + GEMM_LDS);
    int* tpre = ids + 256;
    constexpr int NTN = (STAGE == 1) ? 4 : 8;
    __syncthreads();
    if (TIDX < 64) {
        const int ln = TIDX; int nt = (ln < NEXP) ? ((cnt[ln * CNT_STRIDE] + 255) >> 8) : 0; int inc = nt;
#pragma unroll
        for (int o = 1; o < 64; o <<= 1) { const int nb = __shfl_up(inc, o); if (ln >= o) inc += nb; }
        if (ln <= NEXP) tpre[ln] = inc - nt;
    }
    __syncthreads();
    const int ntiles = tpre[NEXP] * NTN;
    const int lane = TIDX & 63, wave = TIDX >> 6, wm = wave >> 1, wn = wave & 1;
    for (int tIdx = vcu_id(); tIdx < ntiles; tIdx += gridDim.x) {
        const int mtg = tIdx / NTN, n0 = (tIdx % NTN) * 128;
        int e = 0;
        for (int i = 1; i < NEXP; ++i) if (tpre[i] <= mtg) e = i;
        const int mt = mtg - tpre[e];
        const int cn = cnt[e * CNT_STRIDE];
        __syncthreads();
        if (TIDX < 256) { const int pos = mt * 256 + TIDX; ids[TIDX] = list[(size_t)e * T + (pos < cn ? pos : cn - 1)]; }
        __syncthreads();
        f32x4 acc[4][4];
        RowGather rp{A, lda, ids, STAGE == 1 ? 1 : 0};
        gemm_tile(smem, rp, Wt + (size_t)e * wstride, ldb, n0, K, acc);
#pragma unroll
        for (int m = 0; m < 4; ++m) {
            const int rl = wm * 64 + m * 16 + (lane & 15);
            if (mt * 256 + rl >= cn) continue;
            const int pid = ids[rl];
            if (STAGE == 1) {
                const float gt = pgate[pid], ri = rinv_from_pss(pss, (size_t)(pid >> 1));
#pragma unroll
                for (int np = 0; np < 2; ++np) {
                    const f32x4 g = acc[m][2 * np], u = acc[m][2 * np + 1];
                    const int j = (n0 + wn * 64 + np * 32) / 2 + (lane >> 4) * 4;
                    const f32x4 gs = g * ri; const float ug = ri * gt;
                    uint2 o; o.x = pk2(siluf_(gs.x) * u.x * ug, siluf_(gs.y) * u.y * ug); o.y = pk2(siluf_(gs.z) * u.z * ug, siluf_(gs.w) * u.w * ug);
                    *(uint2*)(out + (size_t)pid * DEXP + j) = o;
                }
            } else {
#pragma unroll
                for (int n = 0; n < 4; ++n) {
                    const f32x4 v = acc[m][n]; const int col = n0 + wn * 64 + n * 16 + (lane >> 4) * 4;
                    uint2 o; o.x = pk2(v.x, v.y); o.y = pk2(v.z, v.w);
                    *(uint2*)(out + (size_t)pid * 1024 + col) = o;
                }
            }
        }
    }
}

__device__ __forceinline__ void hgrn2_naive(const bf16_t* __restrict__ proj, const float* __restrict__ hgrn_lb, int layer, const float* __restrict__ mix_gain, bf16_t* __restrict__ y, int bh, int lane) {
    const int b = bh >> 2, h = bh & 3;
    float lbk = 0.f;
    if (layer == 1) { float a0 = hgrn_lb[h * 64 + lane], a1 = hgrn_lb[256 + h * 64 + lane]; lbk = 1.f / (1.f + __expf(a0 - a1)); }
    const float mg = mix_gain[C_AQ + h * 64 + lane];
    float S[64];
#pragma unroll
    for (int k = 0; k < 64; ++k) S[k] = 0.f;
    for (int t = 0; t < SEQ; ++t) {
        const bf16_t* pr = proj + (size_t)(b * SEQ + t) * NP + h * 64 + lane;
        const float qk = siluf_(bf2f(pr[C_AQ]));
        const float sg = sigmoidf_(bf2f(pr[C_AF]));
        const float f = lbk + (1.f - lbk) * sg, kk = (1.f - lbk) * (1.f - sg);
        const float iv = bf2f(pr[C_AI]);
        const float gv = bf2f(pr[C_AG]);
        float o = 0.f;
#pragma unroll
        for (int k = 0; k < 64; ++k) { S[k] = rdlane(f, k) * S[k] + rdlane(kk, k) * iv; o += rdlane(qk, k) * S[k]; }
        const float ms = wave_sum(o * o) * (1.f / 64.f);
        const float yv = o * rsqrtf(ms + EPS) * siluf_(gv) * mg;
        y[(size_t)(b * SEQ + t) * 1024 + 0 + h * 64 + lane] = f2bf(yv);
    }
}
__device__ __forceinline__ void gdn_naive(const bf16_t* __restrict__ proj, const float* __restrict__ gates, const float* __restrict__ conv_w  ,
                                          const float* __restrict__ a_log, const float* __restrict__ dt_bias, const float* __restrict__ mix_gain, bf16_t* __restrict__ y, int bh, int lane) {
    const int b = bh >> 2, h = bh & 3;
    float wq[4], wk[4], wv[4];
#pragma unroll
    for (int j = 0; j < 4; ++j) { wq[j] = conv_w[j * 768 + h * 64 + lane]; wk[j] = conv_w[j * 768 + 256 + h * 64 + lane]; wv[j] = conv_w[j * 768 + 512 + h * 64 + lane]; }
    float xq[3] = {0.f, 0.f, 0.f}, xk[3] = {0.f, 0.f, 0.f}, xv[3] = {0.f, 0.f, 0.f};
    const float Aexp = __expf(a_log[h]), dtb = dt_bias[h];
    const float mg = mix_gain[768 + h * 64 + lane];
    float S[64];
#pragma unroll
    for (int k = 0; k < 64; ++k) S[k] = 0.f;
    for (int t = 0; t < SEQ; ++t) {
        const size_t row = (size_t)(b * SEQ + t);
        const bf16_t* pr = proj + row * NP + h * 64 + lane;
        const float q0 = bf2f(pr[C_DQ]), k0 = bf2f(pr[C_DK]), v0 = bf2f(pr[C_DV]), zv = bf2f(pr[C_DZ]);
        float q = siluf_(wq[0] * xq[0] + wq[1] * xq[1] + wq[2] * xq[2] + wq[3] * q0);
        float k = siluf_(wk[0] * xk[0] + wk[1] * xk[1] + wk[2] * xk[2] + wk[3] * k0);
        float v = siluf_(wv[0] * xv[0] + wv[1] * xv[1] + wv[2] * xv[2] + wv[3] * v0);
        xq[0] = xq[1]; xq[1] = xq[2]; xq[2] = q0; xk[0] = xk[1]; xk[1] = xk[2]; xk[2] = k0; xv[0] = xv[1]; xv[1] = xv[2]; xv[2] = v0;
        q = q * rsqrtf(wave_sum(q * q) + EPS) * 0.125f;
        k = k * rsqrtf(wave_sum(k * k) + EPS);
        const float beta = sigmoidf_(gates[row * 16 + 4 + h]);
        const float g = -Aexp * softplusf_(gates[row * 16 + 8 + h] + dtb);
        const float eg = __expf(g);
        float r = 0.f;
#pragma unroll
        for (int i = 0; i < 64; ++i) { S[i] *= eg; r += rdlane(k, i) * S[i]; }
        const float dlt = beta * (v - r);
        float o = 0.f;
#pragma unroll
        for (int i = 0; i < 64; ++i) { S[i] += rdlane(k, i) * dlt; o += rdlane(q, i) * S[i]; }
        const float ms = wave_sum(o * o) * (1.f / 64.f);
        const float yv = o * rsqrtf(ms + EPS) * siluf_(zv) * mg;
        y[row * 1024 + 768 + h * 64 + lane] = f2bf(yv);
    }
}
__device__ __forceinline__ void fox_cumsum(const float* __restrict__ gates, const float* __restrict__ fb, float* __restrict__ cc, int bh, int lane) {
    const int b = bh >> 2, h = bh & 3;
    const float bias = fb[h];
    float v[32];
#pragma unroll
    for (int i = 0; i < 32; ++i) v[i] = gates[(size_t)(b * SEQ + lane * 32 + i) * 16 + h];
    float run = 0.f;
#pragma unroll
    for (int i = 0; i < 32; ++i) { run += logsigmoidf_(v[i] + bias); v[i] = run; }
    float tot = run;
#pragma unroll
    for (int o = 1; o < 64; o <<= 1) { const float nb = __shfl_up(tot, o); if (lane >= o) tot += nb; }
    const float off = tot - run;
    float* dst = cc + (size_t)(b * 4 + h) * SEQ + lane * 32;
#pragma unroll
    for (int i = 0; i < 32; i += 4) *(f32x4*)(dst + i) = (f32x4){v[i] + off, v[i + 1] + off, v[i + 2] + off, v[i + 3] + off};
}
__device__ __forceinline__ void lru_prep_task(float* xc  , const bf16_t* __restrict__ proj, const float* __restrict__ conv_w, const float* __restrict__ conv_b,
                                              const float* __restrict__ w_a, const float* __restrict__ b_a, const float* __restrict__ w_x, const float* __restrict__ b_x,
                                              const float* __restrict__ lam, float* __restrict__ a_out, float* __restrict__ u_out, int task, bool active) {
    const int c = TIDX & 255, t0 = task * 16;
    if (active) {
        const float w0 = conv_w[c], w1 = conv_w[256 + c], w2 = conv_w[512 + c], w3 = conv_w[768 + c], cb = conv_b[c];
        for (int i = 0; i < 16; ++i) {
            const int t = t0 + i, s = t & (SEQ - 1);
            const bf16_t* pr = proj + (size_t)t * NP + C_CX + c;
            float acc = cb + w3 * bf2f(pr[0]);
            if (s >= 1) acc += w2 * bf2f(pr[-(ptrdiff_t)NP]);
            if (s >= 2) acc += w1 * bf2f(pr[-(ptrdiff_t)2 * NP]);
            if (s >= 3) acc += w0 * bf2f(pr[-(ptrdiff_t)3 * NP]);
            xc[i * 256 + c] = acc;
        }
    }
    __syncthreads();
    if (active) {
        const int h = c >> 6, jj = c & 63;
        float ra[16], rx[16];
#pragma unroll
        for (int i = 0; i < 16; ++i) { ra[i] = 0.f; rx[i] = 0.f; }
        for (int k = 0; k < 64; ++k) {
            const float wa = w_a[(h * 64 + k) * 64 + jj], wx = w_x[(h * 64 + k) * 64 + jj];
#pragma unroll
            for (int i = 0; i < 16; ++i) { const float xv = xc[i * 256 + h * 64 + k]; ra[i] += xv * wa; rx[i] += xv * wx; }
        }
        const float ba = b_a[c], bx = b_x[c], sp = softplusf_(-lam[c]);
#pragma unroll
        for (int i = 0; i < 16; ++i) {
            const float r = sigmoidf_(ra[i] + ba), ig = sigmoidf_(rx[i] + bx);
            const float log_a = -8.f * r * sp;
            const float a = __expf(log_a);
            const float u = sqrtf(-expm1f(2.f * log_a)) * (ig * xc[i * 256 + c]);
            a_out[(size_t)(t0 + i) * 256 + c] = a; u_out[(size_t)(t0 + i) * 256 + c] = u;
        }
    }
    __syncthreads();
}
__device__ __forceinline__ void lru_scan_task(const float* __restrict__ a_in, const float* __restrict__ u_in, const bf16_t* __restrict__ proj, const float* __restrict__ mix_gain, bf16_t* __restrict__ y, int b) {
    const int c = TIDX;
    const float mg = mix_gain[512 + c];
    float hst = 0.f;
    for (int t = 0; t < SEQ; ++t) {
        const size_t row = (size_t)(b * SEQ + t);
        hst = a_in[row * 256 + c] * hst + u_in[row * 256 + c];
        const float yv = hst * geluf_(bf2f(proj[row * NP + C_CG + c]));
        const float ms = wave_sum(yv * yv) * (1.f / 64.f);
        y[row * 1024 + 512 + c] = f2bf(yv * rsqrtf(ms + EPS) * mg);
    }
}

typedef short s16x4 __attribute__((ext_vector_type(4)));
#define LDS_AS __attribute__((address_space(3)))
__device__ __forceinline__ bf16x8 frag_rm(const bf16_t* tile, int ld, int r0, int k0, int lane) { return *(const bf16x8*)(tile + (r0 + (lane & 15)) * ld + k0 + (lane >> 4) * 8); }
__device__ __forceinline__ s16x4 tr4(const bf16_t* tile, int ld, int rbase, int c0, int lane) {
    const bf16_t* p = tile + (rbase + ((lane & 15) >> 2)) * ld + c0 + 4 * (lane & 3);
    return __builtin_amdgcn_ds_read_tr16_b64_v4i16((LDS_AS s16x4*)p);
}
__device__ __forceinline__ bf16x8 frag_cm(const bf16_t* tile, int ld, int k0, int c0, int lane) {
    const s16x4 lo = tr4(tile, ld, k0 + (lane >> 4) * 8, c0, lane), hi = tr4(tile, ld, k0 + (lane >> 4) * 8 + 4, c0, lane);
    return (bf16x8){lo[0], lo[1], lo[2], lo[3], hi[0], hi[1], hi[2], hi[3]};
}
#define MFMA16(a, b, c) __builtin_amdgcn_mfma_f32_16x16x32_bf16((a), (b), (c), 0, 0, 0)
constexpr int TLD = 72;


#define XB_TMO      128
#define XB_XCNT(j)  (256  + 64 * (j))
#define XB_XSUB(j)  (1280 + 64 * (j))
#define XB_XGEN(j)  (2304 + 64 * (j))
#define XB_TOP      3328
#define XB_TOPGEN   3392
#define XCD_BAR_WORDS 3456
#define XB_SPIN_CAP (1u << 18)
__device__ __forceinline__ unsigned xb_ld(unsigned* p)              { return __hip_atomic_load(p, __ATOMIC_RELAXED, __HIP_MEMORY_SCOPE_AGENT); }
__device__ __forceinline__ unsigned xb_add(unsigned* p, unsigned v) { return __hip_atomic_fetch_add(p, v, __ATOMIC_RELAXED, __HIP_MEMORY_SCOPE_AGENT); }
__device__ __forceinline__ unsigned xb_xcc_id() { return (unsigned)__builtin_amdgcn_s_getreg((3 << 11) | 20) & 0xFu; }
#define XB_SPIN(cond, bar) do { unsigned _sp = 0; while (cond) { __builtin_amdgcn_s_sleep(1); \
    if ((++_sp & 255u) == 0u) { if (xb_ld(&(bar)[XB_TMO])) break; if (_sp > XB_SPIN_CAP) { atomicAdd(&(bar)[XB_TMO], 1u); break; } } } } while (0)
struct XcdBarrier { unsigned* bar; unsigned x; volatile LDS_AS unsigned* st; };
__device__ __forceinline__ XcdBarrier xcd_barrier_post(unsigned* bar, volatile LDS_AS unsigned* st) {
    XcdBarrier b; b.bar = bar; b.x = xb_xcc_id(); b.st = st;
    if (TIDX == 0) (void)xb_add(&bar[XB_XCNT(b.x)], 1u);
    return b;
}
__device__ __forceinline__ void xcd_barrier_complete(unsigned* bar, unsigned x, unsigned& nloc, unsigned& nx) {
    const unsigned G = gridDim.x * gridDim.y * gridDim.z;
    unsigned sum, cnt, mine, sp = 0u;
    for (;;) {
        sum = 0u; cnt = 0u; mine = 0u;
#pragma unroll
        for (unsigned j = 0; j < 16; ++j) { const unsigned c = xb_ld(&bar[XB_XCNT(j)]); sum += c; cnt += (c > 0u) ? 1u : 0u; mine = (j == x) ? c : mine; }
        if (sum == G) break;
        __builtin_amdgcn_s_sleep(1);
        if ((++sp & 255u) == 0u) { if (xb_ld(&bar[XB_TMO])) break; if (sp > XB_SPIN_CAP) { atomicAdd(&bar[XB_TMO], 1u); break; } }
    }
    nloc = mine > 0u ? mine : 1u; nx = cnt > 0u ? cnt : 1u;
}
__device__ __forceinline__ void xcd_barrier(const XcdBarrier& b) {
    asm volatile("s_waitcnt vmcnt(0)" ::: "memory");
    __syncthreads();
    if (TIDX == 0) {
        unsigned* bar = b.bar;
        __builtin_amdgcn_s_waitcnt(0);
        unsigned nloc = b.st[0], nx = b.st[1];
        if (nloc == 0u) { xcd_barrier_complete(bar, b.x, nloc, nx); b.st[0] = nloc; b.st[1] = nx; }
        const unsigned old = xb_add(&bar[XB_XSUB(b.x)], 1u);
        const unsigned gen = old / nloc;
        if (old + 1u == (gen + 1u) * nloc) {
            __builtin_amdgcn_fence(__ATOMIC_RELEASE, "agent");
            asm volatile("s_waitcnt vmcnt(0)" ::: "memory");
            const unsigned og = xb_add(&bar[XB_TOP], 1u);
            const unsigned tg = og / nx;
            if (og + 1u == (tg + 1u) * nx) xb_add(&bar[XB_TOPGEN], 1u);
            else XB_SPIN(xb_ld(&bar[XB_TOPGEN]) == tg, bar);
            __builtin_amdgcn_fence(__ATOMIC_ACQUIRE, "agent");
            xb_add(&bar[XB_XGEN(b.x)], 1u);
            asm volatile("s_waitcnt vmcnt(0)" ::: "memory");
        } else {
            XB_SPIN(xb_ld(&bar[XB_XGEN(b.x)]) == gen, bar);
            __builtin_amdgcn_fence(__ATOMIC_ACQUIRE, "agent");
            asm volatile("s_waitcnt vmcnt(0)" ::: "memory");
        }
    }
    __syncthreads();
}


__device__ __forceinline__ void flag_signal(unsigned* ctr, unsigned n) {
    asm volatile("s_waitcnt vmcnt(0)" ::: "memory");
    __syncthreads();
    if (TIDX == 0) {
        __builtin_amdgcn_fence(__ATOMIC_RELEASE, "agent");
        asm volatile("s_waitcnt vmcnt(0)" ::: "memory");
        (void)__hip_atomic_fetch_add(ctr, n, __ATOMIC_RELAXED, __HIP_MEMORY_SCOPE_AGENT);
    }
}
__device__ __forceinline__ void flag_wait(unsigned* ctr, unsigned target) {
    if (TIDX == 0) {
        unsigned sp = 0;
        while (__hip_atomic_load(ctr, __ATOMIC_RELAXED, __HIP_MEMORY_SCOPE_AGENT) < target) { __builtin_amdgcn_s_sleep(2); if (++sp > (1u << 22)) break; }
        __builtin_amdgcn_fence(__ATOMIC_ACQUIRE, "agent");
        asm volatile("s_waitcnt vmcnt(0)" ::: "memory");
    }
    __syncthreads();
}
constexpr int CTL_FLAG_WORD = 3520;

template <bool MASK, int NS>
__device__ __forceinline__ void attn_compute_t(const bf16_t* cK, const bf16_t* cV, const float* cC, const bf16x8 (&qf)[2], f32x4 (&oacc)[4], float& mrun, float& lrun,
                                               float ct2, float scale2, int key0, int tq, int lane, int g) {
    f32x4 sacc[4 * NS];
#pragma unroll
    for (int n = 0; n < 4 * NS; ++n) {
        sacc[n] = (f32x4){0.f, 0.f, 0.f, 0.f};
#pragma unroll
        for (int kk = 0; kk < 2; ++kk) sacc[n] = MFMA16(frag_rm(cK, TLD, n * 16, kk * 32, lane), qf[kk], sacc[n]);
    }
    float mx = -INFINITY;
#pragma unroll
    for (int n = 0; n < 4 * NS; ++n) {
        const f32x4 cs = *(const f32x4*)(cC + n * 16 + 4 * g);
#pragma unroll
        for (int r = 0; r < 4; ++r) {
            float v = sacc[n][r] * scale2 + (ct2 - cs[r]);
            if (MASK) { if (key0 + n * 16 + 4 * g + r > tq) v = -INFINITY; }
            sacc[n][r] = v; mx = fmaxf(mx, v);
        }
    }
    mx = fmaxf(mx, __shfl_xor(mx, 16)); mx = fmaxf(mx, __shfl_xor(mx, 32));
    const float mnew = fmaxf(mrun, mx);
    const float corr = __builtin_amdgcn_exp2f(mrun - mnew);
    float rs = 0.f;
#pragma unroll
    for (int n = 0; n < 4 * NS; ++n)
#pragma unroll
        for (int r = 0; r < 4; ++r) { const float p = __builtin_amdgcn_exp2f(sacc[n][r] - mnew); sacc[n][r] = p; rs += p; }
    rs += __shfl_xor(rs, 16); rs += __shfl_xor(rs, 32);
    lrun = lrun * corr + rs; mrun = mnew;
    bf16x8 pf[2 * NS];
#pragma unroll
    for (int kk = 0; kk < 2 * NS; ++kk) {
        const u32x4 pk = (u32x4){pk2(sacc[2 * kk][0], sacc[2 * kk][1]), pk2(sacc[2 * kk][2], sacc[2 * kk][3]), pk2(sacc[2 * kk + 1][0], sacc[2 * kk + 1][1]), pk2(sacc[2 * kk + 1][2], sacc[2 * kk + 1][3])};
        pf[kk] = __builtin_bit_cast(bf16x8, pk);
    }
#pragma unroll
    for (int n2 = 0; n2 < 4; ++n2) {
        oacc[n2] = oacc[n2] * corr;
#pragma unroll
        for (int kk = 0; kk < 2 * NS; ++kk) {
            const s16x4 lo = tr4(cV, TLD, (2 * kk) * 16 + 4 * g, n2 * 16, lane), hi = tr4(cV, TLD, (2 * kk + 1) * 16 + 4 * g, n2 * 16, lane);
            const bf16x8 vf = (bf16x8){lo[0], lo[1], lo[2], lo[3], hi[0], hi[1], hi[2], hi[3]};
            oacc[n2] = MFMA16(vf, pf[kk], oacc[n2]);
        }
    }
}
__device__ __forceinline__ void attn_compute(const bf16_t* cK, const bf16_t* cV, const float* cC, const bf16x8 (&qf)[2], f32x4 (&oacc)[4], float& mrun, float& lrun,
                                             float ct2, float scale2, int causal, int key0, int r0, int tq, int lane, int g) {
    if (!causal || key0 + 127 <= r0) { attn_compute_t<false, 2>(cK, cV, cC, qf, oacc, mrun, lrun, ct2, scale2, key0, tq, lane, g); return; }
    if (key0 > r0 + 15) return;
    if (key0 + 64 > r0 + 15) attn_compute_t<true, 1>(cK, cV, cC, qf, oacc, mrun, lrun, ct2, scale2, key0, tq, lane, g);
    else attn_compute_t<true, 2>(cK, cV, cC, qf, oacc, mrun, lrun, ct2, scale2, key0, tq, lane, g);
}

__device__ __forceinline__ void attn_task(char* smem, const bf16_t* __restrict__ Q, int ldq, const bf16_t* __restrict__ Kp, int ldk, const bf16_t* __restrict__ Vp, int ldv, const float* __restrict__ bias,
                                          int nq_per_b, int nk_per_b, int causal, float scale, bf16_t* __restrict__ O, int ldo, const float* __restrict__ gain, int rms, int task) {
    constexpr int KT = 128;
    bf16_t* sK = (bf16_t*)smem;
    bf16_t* sV = sK + 2 * KT * TLD;
    float* sC = (float*)(sV + 2 * KT * TLD);
    const int tid = TIDX, lane = tid & 63, wave = tid >> 6, g = lane >> 4, li = lane & 15;
    const int nqt = nq_per_b / 128;
    const int qt = task % nqt, h = (task / nqt) & 3, b = task / (nqt * 4);
    const int q0 = qt * 128, r0 = q0 + wave * 16, tq = r0 + li;
    const size_t qrow = (size_t)b * nq_per_b + tq;
    bf16x8 qf[2];
#pragma unroll
    for (int kk = 0; kk < 2; ++kk) qf[kk] = *(const bf16x8*)(Q + qrow * ldq + h * 64 + kk * 32 + g * 8);
    constexpr float LOG2E = 1.4426950408889634f;
    const float ct = bias ? bias[(size_t)(b * 4 + h) * nq_per_b + tq] * LOG2E : 0.f;
    const float scale2 = scale * LOG2E;
    const int nkt = causal ? (q0 + 128) / KT : nk_per_b / KT;
    const int sr = tid >> 3, sc = tid & 7;
    const bf16_t* kg = Kp + ((size_t)b * nk_per_b + sr) * ldk + h * 64 + sc * 8;
    const bf16_t* vg = Vp + ((size_t)b * nk_per_b + sr) * ldv + h * 64 + sc * 8;
    const float* cg_ = bias ? bias + (size_t)(b * 4 + h) * nk_per_b : nullptr;
    u32x4 rkA[2], rvA[2], rkB[2], rvB[2]; float rcA = 0.f, rcB = 0.f;
#define AT_LOAD(RK, RV, RC, kt) { _Pragma("unroll") for (int i = 0; i < 2; ++i) { RK[i] = *(const u32x4*)(kg + (size_t)((kt) * KT + i * 64) * ldk); RV[i] = *(const u32x4*)(vg + (size_t)((kt) * KT + i * 64) * ldv); } \
        RC = (cg_ && tid < KT) ? cg_[(kt) * KT + tid] * LOG2E : 0.f; }
#define AT_STORE(RK, RV, RC, buf) { _Pragma("unroll") for (int i = 0; i < 2; ++i) { *(u32x4*)(sK + ((buf) * KT + sr + i * 64) * TLD + sc * 8) = RK[i]; *(u32x4*)(sV + ((buf) * KT + sr + i * 64) * TLD + sc * 8) = RV[i]; } \
        if (tid < KT) sC[(buf) * KT + tid] = RC; }
#define AT_COMPUTE(buf, kt) attn_compute(sK + (buf) * KT * TLD, sV + (buf) * KT * TLD, sC + (buf) * KT, qf, oacc, mrun, lrun, ct, scale2, causal, (kt) * KT, r0, tq, lane, g)
    AT_LOAD(rkA, rvA, rcA, 0)
    if (nkt > 1) AT_LOAD(rkB, rvB, rcB, 1)
    __syncthreads();
    AT_STORE(rkA, rvA, rcA, 0)
    __syncthreads();
    f32x4 oacc[4];
#pragma unroll
    for (int n = 0; n < 4; ++n) oacc[n] = (f32x4){0.f, 0.f, 0.f, 0.f};
    float mrun = -INFINITY, lrun = 0.f;
    for (int kt = 0; kt < nkt; kt += 2) {
        if (kt + 2 < nkt) AT_LOAD(rkA, rvA, rcA, kt + 2)
        AT_COMPUTE(0, kt);
        if (kt + 1 < nkt) AT_STORE(rkB, rvB, rcB, 1)
        __syncthreads();
        if (kt + 1 < nkt) {
            if (kt + 3 < nkt) AT_LOAD(rkB, rvB, rcB, kt + 3)
            AT_COMPUTE(1, kt + 1);
            if (kt + 2 < nkt) AT_STORE(rkA, rvA, rcA, 0)
            __syncthreads();
        }
    }
#undef AT_LOAD
#undef AT_STORE
#undef AT_COMPUTE
    const float inv = 1.f / lrun;
    float ms = 0.f;
#pragma unroll
    for (int n = 0; n < 4; ++n) { oacc[n] = oacc[n] * inv; ms += oacc[n][0] * oacc[n][0] + oacc[n][1] * oacc[n][1] + oacc[n][2] * oacc[n][2] + oacc[n][3] * oacc[n][3]; }
    ms += __shfl_xor(ms, 16); ms += __shfl_xor(ms, 32);
    const float rinv = rms ? rsqrtf(ms * (1.f / 64.f) + EPS) : 1.f;
#pragma unroll
    for (int n = 0; n < 4; ++n) {
        const int d = n * 16 + 4 * g;
        f32x4 gg = (f32x4){1.f, 1.f, 1.f, 1.f};
        if (gain) gg = *(const f32x4*)(gain + h * 64 + d);
        uint2 o; o.x = pk2(oacc[n][0] * rinv * gg[0], oacc[n][1] * rinv * gg[1]); o.y = pk2(oacc[n][2] * rinv * gg[2], oacc[n][3] * rinv * gg[3]);
        *(uint2*)(O + qrow * ldo + h * 64 + d) = o;
    }
}


__device__ __forceinline__ void hgrn_scan(float* LF  , float* SEGT  , const bf16_t* __restrict__ prow  , const float* __restrict__ hgrn_lb, int layer, int h, float (&kk)[8]) {
    const int tid = TIDX, t = tid >> 3, k8 = (tid & 7) * 8;
    const u32x4 raw = *(const u32x4*)(prow + (size_t)t * NP + C_AF + k8);
#pragma unroll
    for (int j = 0; j < 8; ++j) {
        const float fl = __uint_as_float((j & 1) ? (raw[j >> 1] & 0xffff0000u) : (raw[j >> 1] << 16));
        float lbk = 0.f;
        if (layer == 1) { const float a0 = hgrn_lb[h * 64 + k8 + j], a1 = hgrn_lb[256 + h * 64 + k8 + j]; lbk = 1.f / (1.f + __expf(a0 - a1)); }
        const float sg = sigmoidf_(fl);
        const float f = lbk + (1.f - lbk) * sg;
        kk[j] = (1.f - lbk) * (1.f - sg);
        LF[t * 65 + k8 + j] = __logf(f);
    }
    __syncthreads();
    { const int k = tid & 63, seg = tid >> 6; float run = 0.f;
#pragma unroll
      for (int i = 0; i < 8; ++i) { run += LF[(seg * 8 + i) * 65 + k]; LF[(seg * 8 + i) * 65 + k] = run; }
      SEGT[seg * 64 + k] = run; }
    __syncthreads();
    { const int k = tid & 63, seg = tid >> 6; float off = 0.f;
      for (int s2 = 0; s2 < seg; ++s2) off += SEGT[s2 * 64 + k];
#pragma unroll
      for (int i = 0; i < 8; ++i) LF[(seg * 8 + i) * 65 + k] += off; }
    __syncthreads();
}
__device__ __forceinline__ float bfx(const u32x4& raw, int j) { return __uint_as_float((j & 1) ? (raw[j >> 1] & 0xffff0000u) : (raw[j >> 1] << 16)); }

__device__ __forceinline__ void hgrn_local_task(char* smem, const bf16_t* __restrict__ proj, const float* __restrict__ hgrn_lb, int layer, float* __restrict__ HL, float* __restrict__ HD, int ch) {
    float* LF = (float*)smem; float* SEGT = LF + 64 * 65;
    bf16_t* sKd = (bf16_t*)(SEGT + 8 * 64); bf16_t* sV = sKd + 64 * TLD;
    const int tid = TIDX, lane = tid & 63, wave = tid >> 6, g = lane >> 4, li = lane & 15;
    const int bh = ch >> 5, n = ch & 31, b = bh >> 2, h = bh & 3;
    const bf16_t* prow = proj + (size_t)(b * SEQ + n * 64) * NP + h * 64;
    const int t = tid >> 3, k8 = (tid & 7) * 8;
    __syncthreads();
    *(u32x4*)(sV + t * TLD + k8) = *(const u32x4*)(prow + (size_t)t * NP + C_AI + k8);
    float kk[8];
    hgrn_scan(LF, SEGT, prow, hgrn_lb, layer, h, kk);
    { u32x4 o;
#pragma unroll
      for (int j = 0; j < 8; j += 2) {
          const float e0 = kk[j] * __expf(LF[63 * 65 + k8 + j] - LF[t * 65 + k8 + j]), e1 = kk[j + 1] * __expf(LF[63 * 65 + k8 + j + 1] - LF[t * 65 + k8 + j + 1]);
          o[j >> 1] = pk2(e0, e1);
      }
      *(u32x4*)(sKd + t * TLD + k8) = o; }
    if (tid < 64) HD[(size_t)ch * 64 + tid] = __expf(LF[63 * 65 + tid]);
    __syncthreads();
#pragma unroll
    for (int i = 0; i < 2; ++i) {
        const int idx = wave * 2 + i, vt = idx >> 2, kt = idx & 3;
        f32x4 acc = (f32x4){0.f, 0.f, 0.f, 0.f};
#pragma unroll
        for (int ks = 0; ks < 2; ++ks) acc = MFMA16(frag_cm(sV, TLD, ks * 32, vt * 16, lane), frag_cm(sKd, TLD, ks * 32, kt * 16, lane), acc);
        *(f32x4*)(HL + (size_t)ch * 4096 + (kt * 16 + li) * 64 + vt * 16 + 4 * g) = acc;
    }
}

__device__ __forceinline__ void hgrn_out_task(char* smem, const bf16_t* __restrict__ proj, const float* __restrict__ hgrn_lb, int layer, const bf16_t* __restrict__ HS,
                                              const float* __restrict__ mix_gain, bf16_t* __restrict__ y, int ch) {
    float* LF = (float*)smem; float* SEGT = LF + 64 * 65; float* sMS = SEGT + 8 * 64;
    bf16_t* sST = (bf16_t*)(sMS + 128); bf16_t* sQ0 = sST + 64 * TLD; bf16_t* sQm = sQ0 + 64 * TLD; bf16_t* sKm = sQm + 64 * TLD; bf16_t* sV = sKm + 64 * TLD; bf16_t* sA = sV + 64 * TLD;
    const int tid = TIDX, lane = tid & 63, wave = tid >> 6, g = lane >> 4, li = lane & 15;
    const int bh = ch >> 5, n = ch & 31, b = bh >> 2, h = bh & 3;
    const bf16_t* prow = proj + (size_t)(b * SEQ + n * 64) * NP + h * 64;
    const int t = tid >> 3, k8 = (tid & 7) * 8;
    __syncthreads();
    *(u32x4*)(sST + t * TLD + k8) = *(const u32x4*)(HS + (size_t)ch * 4096 + t * 64 + k8);
    const u32x4 qraw = *(const u32x4*)(prow + (size_t)t * NP + C_AQ + k8);
    *(u32x4*)(sV + t * TLD + k8) = *(const u32x4*)(prow + (size_t)t * NP + C_AI + k8);
    float kk[8];
    hgrn_scan(LF, SEGT, prow, hgrn_lb, layer, h, kk);
    { u32x4 o0, om, ok;
#pragma unroll
      for (int j = 0; j < 8; j += 2) {
          float q0v[2], qmv[2], kmv[2];
#pragma unroll
          for (int e = 0; e < 2; ++e) {
              const float bt = LF[t * 65 + k8 + j + e], r = LF[31 * 65 + k8 + j + e], q = siluf_(bfx(qraw, j + e));
              q0v[e] = q * __expf(bt); qmv[e] = q * __expf(bt - r); kmv[e] = kk[j + e] * __expf(r - bt);
          }
          o0[j >> 1] = pk2(q0v[0], q0v[1]); om[j >> 1] = pk2(qmv[0], qmv[1]); ok[j >> 1] = pk2(kmv[0], kmv[1]);
      }
      *(u32x4*)(sQ0 + t * TLD + k8) = o0; *(u32x4*)(sQm + t * TLD + k8) = om; *(u32x4*)(sKm + t * TLD + k8) = ok; }
    __syncthreads();
#pragma unroll
    for (int i = 0; i < 2; ++i) {
        const int idx = wave * 2 + i, tt = idx >> 2, st = idx & 3;
        f32x4 acc = (f32x4){0.f, 0.f, 0.f, 0.f};
#pragma unroll
        for (int ks = 0; ks < 2; ++ks) acc = MFMA16(frag_rm(sKm, TLD, st * 16, ks * 32, lane), frag_rm(sQm, TLD, tt * 16, ks * 32, lane), acc);
        const int tq = tt * 16 + li, s0 = st * 16 + 4 * g;
        uint2 o; o.x = pk2(s0 <= tq ? acc[0] : 0.f, s0 + 1 <= tq ? acc[1] : 0.f); o.y = pk2(s0 + 2 <= tq ? acc[2] : 0.f, s0 + 3 <= tq ? acc[3] : 0.f);
        *(uint2*)(sA + tq * TLD + s0) = o;
    }
    __syncthreads();
    { const int tt = wave >> 1;
      f32x4 oacc[2]; float ms = 0.f;
#pragma unroll
      for (int i = 0; i < 2; ++i) {
          const int vt = (wave & 1) * 2 + i;
          f32x4 acc = (f32x4){0.f, 0.f, 0.f, 0.f};
#pragma unroll
          for (int ks = 0; ks < 2; ++ks) acc = MFMA16(frag_cm(sST, TLD, ks * 32, vt * 16, lane), frag_rm(sQ0, TLD, tt * 16, ks * 32, lane), acc);
#pragma unroll
          for (int ks = 0; ks < 2; ++ks) acc = MFMA16(frag_cm(sV, TLD, ks * 32, vt * 16, lane), frag_rm(sA, TLD, tt * 16, ks * 32, lane), acc);
          oacc[i] = acc; ms += acc[0] * acc[0] + acc[1] * acc[1] + acc[2] * acc[2] + acc[3] * acc[3];
      }
      ms += __shfl_xor(ms, 16); ms += __shfl_xor(ms, 32);
      if (g == 0) sMS[(tt * 16 + li) * 2 + (wave & 1)] = ms;
      __syncthreads();
      const int tq = tt * 16 + li;
      const float rinv = rsqrtf((sMS[tq * 2] + sMS[tq * 2 + 1]) * (1.f / 64.f) + EPS);
      const size_t row = (size_t)(b * SEQ + n * 64 + tq);
#pragma unroll
      for (int i = 0; i < 2; ++i) {
          const int v0 = ((wave & 1) * 2 + i) * 16 + 4 * g;
          const uint2 graw = *(const uint2*)(proj + row * NP + C_AG + h * 64 + v0);
          const f32x4 mgv = *(const f32x4*)(mix_gain + C_AQ + h * 64 + v0);
          const float g0 = __uint_as_float(graw.x << 16), g1 = __uint_as_float(graw.x & 0xffff0000u), g2 = __uint_as_float(graw.y << 16), g3 = __uint_as_float(graw.y & 0xffff0000u);
          uint2 o; o.x = pk2(oacc[i][0] * rinv * siluf_(g0) * mgv[0], oacc[i][1] * rinv * siluf_(g1) * mgv[1]);
          o.y = pk2(oacc[i][2] * rinv * siluf_(g2) * mgv[2], oacc[i][3] * rinv * siluf_(g3) * mgv[3]);
          *(uint2*)(y + row * 1024 + h * 64 + v0) = o;
      }
    }
}


constexpr int GP_BYTES = (128 + 64 * 132 + 64 * 68) * 4 + 2 * 64 * TLD * 2;
__device__ __forceinline__ void gdn_prep_pair(char* smem, const bf16_t* __restrict__ proj, const float* __restrict__ gates, const float* __restrict__ conv_w  ,
                                              const float* __restrict__ a_log, const float* __restrict__ dt_bias, bf16_t* __restrict__ gt_all, float* __restrict__ glast, int ch0) {
#define GP_SG(sub) ((float*)(smem + (sub) * GP_BYTES))
#define GP_SBETA(sub) (GP_SG(sub) + 64)
#define GP_RHS(sub) (GP_SG(sub) + 128)
#define GP_SM(sub) (GP_RHS(sub) + 64 * 132)
#define GP_SK(sub) ((bf16_t*)(GP_SM(sub) + 64 * 68))
#define GP_SQ(sub) (GP_SK(sub) + 64 * TLD)
    const int tid = TIDX, lane = tid & 63, wave = tid >> 6, g = lane >> 4, li = lane & 15;
    const int bh = ch0 >> 5, n0 = ch0 & 31, b = bh >> 2, h = bh & 3;
    const int t = tid >> 3, d8 = (tid & 7) * 8;
    __syncthreads();
    float qn[2][8], kn[2][8], vv[2][8];
#pragma unroll
    for (int sub = 0; sub < 2; ++sub) {
        const int n = n0 + sub; const size_t row0 = (size_t)(b * SEQ + n * 64);
        const int spos = n * 64 + t;
#pragma unroll
        for (int sec = 0; sec < 3; ++sec) {
            const int col = (sec == 0 ? C_DQ : (sec == 1 ? C_DK : C_DV)) + h * 64 + d8;
            float acc[8];
#pragma unroll
            for (int e = 0; e < 8; ++e) acc[e] = 0.f;
#pragma unroll
            for (int j = 0; j < 4; ++j) {
                if (spos - (3 - j) >= 0) {
                    const u32x4 raw = *(const u32x4*)(proj + (row0 + t - (3 - j)) * NP + col);
                    const f32x4 w0 = *(const f32x4*)(conv_w + j * 768 + sec * 256 + h * 64 + d8), w1 = *(const f32x4*)(conv_w + j * 768 + sec * 256 + h * 64 + d8 + 4);
#pragma unroll
                    for (int e = 0; e < 8; ++e) acc[e] += (e < 4 ? w0[e] : w1[e - 4]) * bfx(raw, e);
                }
            }
#pragma unroll
            for (int e = 0; e < 8; ++e) { const float sv = siluf_(acc[e]); if (sec == 0) qn[sub][e] = sv; else if (sec == 1) kn[sub][e] = sv; else vv[sub][e] = sv; }
        }
        float sq = 0.f, sk = 0.f;
#pragma unroll
        for (int e = 0; e < 8; ++e) { sq += qn[sub][e] * qn[sub][e]; sk += kn[sub][e] * kn[sub][e]; }
        sq += __shfl_xor(sq, 1); sq += __shfl_xor(sq, 2); sq += __shfl_xor(sq, 4);
        sk += __shfl_xor(sk, 1); sk += __shfl_xor(sk, 2); sk += __shfl_xor(sk, 4);
        const float rq = rsqrtf(sq + EPS) * 0.125f, rk = rsqrtf(sk + EPS);
#pragma unroll
        for (int e = 0; e < 8; ++e) { qn[sub][e] *= rq; kn[sub][e] *= rk; }
        if ((tid & 7) == 0) {
            const float* gr = gates + (row0 + t) * 16;
            GP_SBETA(sub)[t] = sigmoidf_(gr[4 + h]);
            GP_SG(sub)[t] = -__expf(a_log[h]) * softplusf_(gr[8 + h] + dt_bias[h]);
        }
    }
    __syncthreads();
    if (wave < 2) {
        float* sG = GP_SG(wave);
        float v = sG[lane];
#pragma unroll
        for (int o = 1; o < 64; o <<= 1) { const float nb = __shfl_up(v, o); if (lane >= o) v += nb; }
        sG[lane] = v;
    }
    __syncthreads();
#pragma unroll
    for (int sub = 0; sub < 2; ++sub) {
        const int ch = ch0 + sub; bf16_t* gt = gt_all + (size_t)ch * 5 * 4096;
        float* sG = GP_SG(sub); float* RHS = GP_RHS(sub);
        const float Gt = sG[t], Gl = sG[63], bt = GP_SBETA(sub)[t];
        const float eG = __expf(Gt), eD = __expf(Gl - Gt);
        u32x4 ok, oq, oqd, okd;
#pragma unroll
        for (int e = 0; e < 8; e += 2) {
            ok[e >> 1] = pk2(kn[sub][e], kn[sub][e + 1]); oq[e >> 1] = pk2(qn[sub][e], qn[sub][e + 1]);
            oqd[e >> 1] = pk2(qn[sub][e] * eG, qn[sub][e + 1] * eG); okd[e >> 1] = pk2(kn[sub][e] * eD, kn[sub][e + 1] * eD);
        }
        *(u32x4*)(GP_SK(sub) + t * TLD + d8) = ok; *(u32x4*)(GP_SQ(sub) + t * TLD + d8) = oq;
        *(u32x4*)(gt + 2 * 4096 + t * 64 + d8) = oqd; *(u32x4*)(gt + 3 * 4096 + t * 64 + d8) = okd;
#pragma unroll
        for (int e = 0; e < 8; ++e) { RHS[t * 132 + d8 + e] = vv[sub][e] * bt; RHS[t * 132 + 64 + d8 + e] = kn[sub][e] * bt * eG; }
        if (tid == 0) glast[ch] = __expf(Gl);
    }
    __syncthreads();
#pragma unroll
    for (int i = 0; i < 4; ++i) {
        const int idx = wave * 4 + i, sub = idx >> 4, tt = (idx >> 2) & 3, st = idx & 3;
        const bf16_t* sK = GP_SK(sub); const bf16_t* sQ = GP_SQ(sub); const float* sG = GP_SG(sub); const float* sBeta = GP_SBETA(sub); float* sM = GP_SM(sub);
        bf16_t* gt = gt_all + (size_t)(ch0 + sub) * 5 * 4096;
        f32x4 am = (f32x4){0.f, 0.f, 0.f, 0.f}, aq = (f32x4){0.f, 0.f, 0.f, 0.f};
#pragma unroll
        for (int ks = 0; ks < 2; ++ks) {
            const bf16x8 kfs = frag_rm(sK, TLD, st * 16, ks * 32, lane), kft = frag_rm(sK, TLD, tt * 16, ks * 32, lane);
            am = MFMA16(kft, kfs, am);
            aq = MFMA16(kfs, frag_rm(sQ, TLD, tt * 16, ks * 32, lane), aq);
        }
        {   const int sx = st * 16 + li, t0 = tt * 16 + 4 * g; const float Gs = sG[sx];
            f32x4 mo;
#pragma unroll
            for (int r = 0; r < 4; ++r) { const int tq = t0 + r; mo[r] = (sx < tq) ? sBeta[tq] * am[r] * __expf(sG[tq] - Gs) : 0.f; }
            *(f32x4*)(sM + sx * 68 + t0) = mo; }
        {   const int tq = tt * 16 + li, s0 = st * 16 + 4 * g; const float Gt = sG[tq];
            float ao[4];
#pragma unroll
            for (int r = 0; r < 4; ++r) { const int sx = s0 + r; ao[r] = (sx <= tq) ? aq[r] * __expf(Gt - sG[sx]) : 0.f; }
            uint2 o; o.x = pk2(ao[0], ao[1]); o.y = pk2(ao[2], ao[3]);
            *(uint2*)(gt + 4 * 4096 + tq * 64 + s0) = o; }
    }
    __syncthreads();
    if (tid < 256) {
        const int sub = tid >> 7, col = tid & 127;
        const float* RHS = GP_RHS(sub); const float* sM = GP_SM(sub);
        bf16_t* gt = gt_all + (size_t)(ch0 + sub) * 5 * 4096;
        float acc[64];
#pragma unroll
        for (int i = 0; i < 64; ++i) acc[i] = RHS[i * 132 + col];
#pragma unroll
        for (int half = 0; half < 2; ++half) {
            const int base = half * 32;
            if (half == 1) {
#pragma unroll
                for (int sx = 0; sx < 32; sx += 2) {
                    f32x4 r0[8], r1[8];
#pragma unroll
                    for (int c = 0; c < 8; ++c) { r0[c] = *(const f32x4*)(sM + sx * 68 + 32 + c * 4); r1[c] = *(const f32x4*)(sM + (sx + 1) * 68 + 32 + c * 4); }
                    const float x0 = acc[sx], x1 = acc[sx + 1];
#pragma unroll
                    for (int tq = 0; tq < 32; ++tq) { acc[32 + tq] -= r0[tq >> 2][tq & 3] * x0; acc[32 + tq] -= r1[tq >> 2][tq & 3] * x1; }
                }
            }
            f32x4 cur[8];
#pragma unroll
            for (int c = 0; c < 8; ++c) cur[c] = *(const f32x4*)(sM + base * 68 + base + c * 4);
#pragma unroll
            for (int sx = 0; sx < 31; ++sx) {
                f32x4 nxt[8];
#pragma unroll
                for (int c = (sx + 2) >> 2; c < 8; ++c) nxt[c] = *(const f32x4*)(sM + (base + sx + 1) * 68 + base + c * 4);
                const float xs = acc[base + sx];
#pragma unroll
                for (int tq = sx + 1; tq < 32; ++tq) acc[base + tq] -= cur[tq >> 2][tq & 3] * xs;
#pragma unroll
                for (int c = (sx + 2) >> 2; c < 8; ++c) cur[c] = nxt[c];
            }
        }
        if (col < 64) {
#pragma unroll
            for (int tt = 0; tt < 64; ++tt) gt[tt * 64 + col] = f2bf(acc[tt]);
        } else {
#pragma unroll
            for (int tt = 0; tt < 64; ++tt) gt[4096 + tt * 64 + (col - 64)] = f2bf(-acc[tt]);
        }
    }
#undef GP_SG
#undef GP_SBETA
#undef GP_RHS
#undef GP_SM
#undef GP_SK
#undef GP_SQ
}

__device__ __forceinline__ void gdn_scan_step(bf16_t* sT, bf16_t* sST, bf16_t* sVn, f32x4 (&sacc)[4], const uint2 (&zraw)[4], float glv, const f32x4 (&mgr)[4],
                                              bf16_t* __restrict__ y, int bh, int n, int tid) {
    const int lane = tid & 63, wave = tid >> 6, g = lane >> 4, li = lane & 15;
    const int b = bh >> 2, h = bh & 3;
    const int buf = n & 1;
        const bf16_t* cT = sT + buf * 5 * 64 * TLD;
        const bf16_t* sU = cT; const bf16_t* sWn = cT + 64 * TLD; const bf16_t* sQd = cT + 2 * 64 * TLD; const bf16_t* sKd = cT + 3 * 64 * TLD; const bf16_t* sAq = cT + 4 * 64 * TLD;
        const bf16_t* cST = sST + buf * 64 * TLD; bf16_t* nST = sST + (buf ^ 1) * 64 * TLD;
        const size_t rowz = (size_t)(b * SEQ + n * 64 + (wave & 3) * 16 + li);
#pragma unroll
        for (int i = 0; i < 2; ++i) {
            const int idx = wave * 2 + i, tt = idx >> 2, vt = idx & 3;
            const int tq = tt * 16 + li, v0 = vt * 16 + 4 * g;
            const uint2 uraw = *(const uint2*)(sU + tq * TLD + v0);
            f32x4 acc = (f32x4){__uint_as_float(uraw.x << 16), __uint_as_float(uraw.x & 0xffff0000u), __uint_as_float(uraw.y << 16), __uint_as_float(uraw.y & 0xffff0000u)};
#pragma unroll
            for (int ks = 0; ks < 2; ++ks) acc = MFMA16(frag_rm(cST, TLD, vt * 16, ks * 32, lane), frag_rm(sWn, TLD, tt * 16, ks * 32, lane), acc);
            uint2 o; o.x = pk2(acc[0], acc[1]); o.y = pk2(acc[2], acc[3]);
            *(uint2*)(sVn + tq * TLD + v0) = o;
        }
        __syncthreads();
        if (wave < 4) {
            const int tt = wave;
            f32x4 oacc[4]; float ms = 0.f;
#pragma unroll
            for (int vt = 0; vt < 4; ++vt) {
                f32x4 acc = (f32x4){0.f, 0.f, 0.f, 0.f};
#pragma unroll
                for (int ks = 0; ks < 2; ++ks) acc = MFMA16(frag_rm(cST, TLD, vt * 16, ks * 32, lane), frag_rm(sQd, TLD, tt * 16, ks * 32, lane), acc);
#pragma unroll
                for (int ks = 0; ks < 2; ++ks) acc = MFMA16(frag_cm(sVn, TLD, ks * 32, vt * 16, lane), frag_rm(sAq, TLD, tt * 16, ks * 32, lane), acc);
                oacc[vt] = acc; ms += acc[0] * acc[0] + acc[1] * acc[1] + acc[2] * acc[2] + acc[3] * acc[3];
            }
            ms += __shfl_xor(ms, 16); ms += __shfl_xor(ms, 32);
            const float rinv = rsqrtf(ms * (1.f / 64.f) + EPS);
#pragma unroll
            for (int vt = 0; vt < 4; ++vt) {
                const int v0 = vt * 16 + 4 * g;
                const f32x4 mgv = mgr[vt];
                const float z0 = __uint_as_float(zraw[vt].x << 16), z1 = __uint_as_float(zraw[vt].x & 0xffff0000u), z2 = __uint_as_float(zraw[vt].y << 16), z3 = __uint_as_float(zraw[vt].y & 0xffff0000u);
                uint2 o; o.x = pk2(oacc[vt][0] * rinv * siluf_(z0) * mgv[0], oacc[vt][1] * rinv * siluf_(z1) * mgv[1]);
                o.y = pk2(oacc[vt][2] * rinv * siluf_(z2) * mgv[2], oacc[vt][3] * rinv * siluf_(z3) * mgv[3]);
                *(uint2*)(y + rowz * 1024 + 768 + h * 64 + v0) = o;
            }
        } else {
            const int kt = wave - 4;
            const float gl = __shfl(glv, n);
#pragma unroll
            for (int vt = 0; vt < 4; ++vt) {
                f32x4 acc = sacc[vt] * gl;
#pragma unroll
                for (int ks = 0; ks < 2; ++ks) acc = MFMA16(frag_cm(sKd, TLD, ks * 32, kt * 16, lane), frag_cm(sVn, TLD, ks * 32, vt * 16, lane), acc);
                sacc[vt] = acc;
                uint2 o; o.x = pk2(acc[0], acc[1]); o.y = pk2(acc[2], acc[3]);
                *(uint2*)(nST + (vt * 16 + li) * TLD + kt * 16 + 4 * g) = o;
            }
        }
}

__device__ __forceinline__ void gdn_scan_task(char* smem, const bf16_t* __restrict__ gt_all, const float* __restrict__ glast, const bf16_t* __restrict__ proj, const float* __restrict__ mix_gain,
                                              bf16_t* __restrict__ y, int bh) {
    bf16_t* sT = (bf16_t*)smem;
    bf16_t* sST = sT + 2 * 5 * 64 * TLD;
    bf16_t* sVn = sST + 2 * 64 * TLD;
    const int tid = TIDX, lane = tid & 63, wave = tid >> 6, g = lane >> 4, li = lane & 15;
    const int b = bh >> 2, h = bh & 3;
    const int sr = tid >> 3, sc8 = (tid & 7) * 8;
    const bf16_t* gsrc = gt_all + (size_t)bh * 32 * 5 * 4096 + sr * 64 + sc8;
    __syncthreads();
    u32x4 rs0[5], rs1[5], rs2[5], rs3[5];
#define GS_LOAD(RS, n) { _Pragma("unroll") for (int i = 0; i < 5; ++i) RS[i] = *(const u32x4*)(gsrc + (size_t)(n) * 5 * 4096 + i * 4096); }
#define GS_STORE(RS, buf) { bf16_t* nT = sT + (buf) * 5 * 64 * TLD; _Pragma("unroll") for (int i = 0; i < 5; ++i) *(u32x4*)(nT + i * 64 * TLD + sr * TLD + sc8) = RS[i]; }
#define GS_ZLOAD(Z, n) { if (wave < 4) { const size_t rz = (size_t)(b * SEQ + (n) * 64 + (wave & 3) * 16 + li); _Pragma("unroll") for (int vt = 0; vt < 4; ++vt) Z[vt] = *(const uint2*)(proj + rz * NP + C_DZ + h * 64 + vt * 16 + 4 * g); } }
    GS_LOAD(rs0, 0) GS_LOAD(rs1, 1) GS_LOAD(rs2, 2) GS_LOAD(rs3, 3)
    f32x4 mgr[4];
#pragma unroll
    for (int vt = 0; vt < 4; ++vt) mgr[vt] = *(const f32x4*)(mix_gain + 768 + h * 64 + vt * 16 + 4 * g);
    const float glv = glast[bh * 32 + (lane & 31)];
    uint2 zraw[4], znext[4];
    GS_ZLOAD(zraw, 0)
    GS_STORE(rs0, 0)
    *(u32x4*)(sST + sr * TLD + sc8) = (u32x4){0u, 0u, 0u, 0u};
    f32x4 sacc[4];
#pragma unroll
    for (int i = 0; i < 4; ++i) sacc[i] = (f32x4){0.f, 0.f, 0.f, 0.f};
    __syncthreads();
#define GS_STEP(n, LSET, SSET) { \
        if ((n) + 4 < 32) GS_LOAD(LSET, (n) + 4) \
        if ((n) + 1 < 32) GS_ZLOAD(znext, (n) + 1) \
        gdn_scan_step(sT, sST, sVn, sacc, zraw, glv, mgr, y, bh, (n), tid); \
        if ((n) + 1 < 32) GS_STORE(SSET, ((n) + 1) & 1) \
        _Pragma("unroll") for (int vt = 0; vt < 4; ++vt) zraw[vt] = znext[vt]; \
        __syncthreads(); }
    for (int n = 0; n < 32; n += 4) {
        GS_STEP(n, rs0, rs1)
        GS_STEP(n + 1, rs1, rs2)
        GS_STEP(n + 2, rs2, rs3)
        GS_STEP(n + 3, rs3, rs0)
    }
#undef GS_LOAD
#undef GS_STORE
#undef GS_ZLOAD
#undef GS_STEP
}


constexpr int XLD = 264;
__device__ __forceinline__ void lru_local_task(char* smem, const bf16_t* __restrict__ proj, const float* __restrict__ conv_w, const float* __restrict__ conv_b,
                                               const float* __restrict__ w_a, const float* __restrict__ b_a, const float* __restrict__ w_x, const float* __restrict__ b_x,
                                               const float* __restrict__ lam, float* __restrict__ hl_out, float* __restrict__ ac_out, float* __restrict__ lsum, int task) {
    bf16_t* sX = (bf16_t*)smem;
    bf16_t* sW = sX + 64 * XLD;
    const int tid = TIDX, lane = tid & 63, wave = tid >> 6, g = lane >> 4, li = lane & 15;
    const int b = task >> 5, n = task & 31;
    const size_t row0 = (size_t)(b * SEQ + n * 64);
    const int t = tid >> 3;
    __syncthreads();
    {
        const int i = tid >> 3, j8 = (tid & 7) * 8;
#pragma unroll
        for (int mat = 0; mat < 8; ++mat) {
            const float* src = ((mat & 1) ? w_x : w_a) + (size_t)(mat >> 1) * 4096 + i * 64 + j8;
            const f32x4 v0 = *(const f32x4*)src, v1 = *(const f32x4*)(src + 4);
            u32x4 o; o[0] = pk2(v0[0], v0[1]); o[1] = pk2(v0[2], v0[3]); o[2] = pk2(v1[0], v1[1]); o[3] = pk2(v1[2], v1[3]);
            *(u32x4*)(sW + mat * 64 * TLD + i * TLD + j8) = o;
        }
    }
    {
        const int spos = n * 64 + t;
#pragma unroll
        for (int i = 0; i < 4; ++i) {
            const int c8 = ((tid & 7) + 8 * i) * 8;
            float acc[8];
            { const f32x4 cb0 = *(const f32x4*)(conv_b + c8), cb1 = *(const f32x4*)(conv_b + c8 + 4);
#pragma unroll
              for (int e = 0; e < 8; ++e) acc[e] = e < 4 ? cb0[e] : cb1[e - 4]; }
#pragma unroll
            for (int j = 0; j < 4; ++j) {
                if (spos - (3 - j) >= 0) {
                    const u32x4 raw = *(const u32x4*)(proj + (row0 + t - (3 - j)) * NP + C_CX + c8);
                    const f32x4 w0 = *(const f32x4*)(conv_w + j * 256 + c8), w1 = *(const f32x4*)(conv_w + j * 256 + c8 + 4);
#pragma unroll
                    for (int e = 0; e < 8; ++e) acc[e] += (e < 4 ? w0[e] : w1[e - 4]) * bfx(raw, e);
                }
            }
            u32x4 o; o[0] = pk2(acc[0], acc[1]); o[1] = pk2(acc[2], acc[3]); o[2] = pk2(acc[4], acc[5]); o[3] = pk2(acc[6], acc[7]);
            *(u32x4*)(sX + t * XLD + c8) = o;
        }
    }
    __syncthreads();
    const int hh = wave >> 1;
#pragma unroll
    for (int j2 = 0; j2 < 2; ++j2) {
        const int jt = (wave & 1) * 2 + j2, cl = jt * 16 + 4 * g, c = hh * 64 + cl;
        f32x4 ra[4], rx[4];
#pragma unroll
        for (int tt = 0; tt < 4; ++tt) { ra[tt] = (f32x4){0.f, 0.f, 0.f, 0.f}; rx[tt] = (f32x4){0.f, 0.f, 0.f, 0.f}; }
#pragma unroll
        for (int ks = 0; ks < 2; ++ks) {
            const bf16x8 wa = frag_cm(sW + (hh * 2) * 64 * TLD, TLD, ks * 32, jt * 16, lane), wx = frag_cm(sW + (hh * 2 + 1) * 64 * TLD, TLD, ks * 32, jt * 16, lane);
#pragma unroll
            for (int tt = 0; tt < 4; ++tt) {
                const bf16x8 xf = frag_rm(sX + hh * 64, XLD, tt * 16, ks * 32, lane);
                ra[tt] = MFMA16(wa, xf, ra[tt]);
                rx[tt] = MFMA16(wx, xf, rx[tt]);
            }
        }
        const f32x4 ba = *(const f32x4*)(b_a + c), bx = *(const f32x4*)(b_x + c), lm = *(const f32x4*)(lam + c);
        float sp[4];
#pragma unroll
        for (int r = 0; r < 4; ++r) sp[r] = softplusf_(-lm[r]);
        f32x4 cA = (f32x4){1.f, 1.f, 1.f, 1.f}, cH = (f32x4){0.f, 0.f, 0.f, 0.f};
#pragma unroll
        for (int tt = 0; tt < 4; ++tt) {
            const int tq = tt * 16 + li;
            const uint2 xraw = *(const uint2*)(sX + tq * XLD + c);
            const float xc[4] = {__uint_as_float(xraw.x << 16), __uint_as_float(xraw.x & 0xffff0000u), __uint_as_float(xraw.y << 16), __uint_as_float(xraw.y & 0xffff0000u)};
            f32x4 A, H;
#pragma unroll
            for (int r = 0; r < 4; ++r) {
                const float rr = sigmoidf_(ra[tt][r] + ba[r]), ig = sigmoidf_(rx[tt][r] + bx[r]);
                const float log_a = -8.f * rr * sp[r];
                A[r] = __expf(log_a);
                H[r] = sqrtf(fmaxf(1.f - A[r] * A[r], 0.f)) * (ig * xc[r]);
            }
#pragma unroll
            for (int o = 1; o < 16; o <<= 1) {
#pragma unroll
                for (int r = 0; r < 4; ++r) {
                    const float pA = __shfl_up(A[r], o, 16), pH = __shfl_up(H[r], o, 16);
                    if (li >= o) { H[r] = A[r] * pH + H[r]; A[r] = A[r] * pA; }
                }
            }
            const f32x4 Hf = H + A * cH, Af = A * cA;
            const size_t oidx = (row0 + tq) * 256 + c;
            *(f32x4*)(hl_out + oidx) = Hf; *(f32x4*)(ac_out + oidx) = Af;
#pragma unroll
            for (int r = 0; r < 4; ++r) { cH[r] = __shfl(Hf[r], 15, 16); cA[r] = __shfl(Af[r], 15, 16); }
            if (tt == 3 && li == 15) { *(f32x4*)(lsum + (size_t)task * 256 + c) = Af; *(f32x4*)(lsum + (size_t)(256 + task) * 256 + c) = Hf; }
        }
    }
}
__device__ __forceinline__ void lru_out_task(const float* __restrict__ hl_in, const float* __restrict__ ac_in, const float* __restrict__ lcar, const bf16_t* __restrict__ proj,
                                             const float* __restrict__ mix_gain, bf16_t* __restrict__ y, int task) {
    const int tid = TIDX, half = tid & 1, row = (tid >> 1) & 63, head = tid >> 7;
    const int b = task >> 5, n = task & 31, c0 = head * 64 + half * 32;
    const size_t grow = (size_t)(b * SEQ + n * 64 + row);
    const float* hp = hl_in + grow * 256 + c0; const float* ap = ac_in + grow * 256 + c0; const float* cp = lcar + (size_t)task * 256 + c0;
    f32x4 hv[8], av[8], cv[8]; u32x4 gr[4];
#pragma unroll
    for (int i = 0; i < 8; ++i) { hv[i] = *(const f32x4*)(hp + 4 * i); av[i] = *(const f32x4*)(ap + 4 * i); cv[i] = *(const f32x4*)(cp + 4 * i); }
#pragma unroll
    for (int i = 0; i < 4; ++i) gr[i] = *(const u32x4*)(proj + grow * NP + C_CG + c0 + 8 * i);
    float ss = 0.f;
#pragma unroll
    for (int i = 0; i < 8; ++i) {
#pragma unroll
        for (int e = 0; e < 4; ++e) {
            const int j = 4 * i + e;
            const float gate = bfx(gr[j >> 3], j & 7);
            const float yv = (hv[i][e] + av[i][e] * cv[i][e]) * geluf_(gate);
            hv[i][e] = yv; ss += yv * yv;
        }
    }
    ss += __shfl_xor(ss, 1);
    const float rinv = rsqrtf(ss * (1.f / 64.f) + EPS);
    bf16_t* yp = y + grow * 1024 + 512 + c0;
#pragma unroll
    for (int i = 0; i < 8; i += 2) {
        const f32x4 m0 = *(const f32x4*)(mix_gain + 512 + c0 + 4 * i), m1 = *(const f32x4*)(mix_gain + 512 + c0 + 4 * i + 4);
        u32x4 o; o[0] = pk2(hv[i][0] * rinv * m0[0], hv[i][1] * rinv * m0[1]); o[1] = pk2(hv[i][2] * rinv * m0[2], hv[i][3] * rinv * m0[3]);
        o[2] = pk2(hv[i + 1][0] * rinv * m1[0], hv[i + 1][1] * rinv * m1[1]); o[3] = pk2(hv[i + 1][2] * rinv * m1[2], hv[i + 1][3] * rinv * m1[3]);
        *(u32x4*)(yp + 4 * i) = o;
    }
}


__device__ __forceinline__ void state_scan_phase(const float* __restrict__ HL, const float* __restrict__ HD, bf16_t* __restrict__ HS, const float* __restrict__ lsum, float* __restrict__ lcar, int u0, int ustride) {
    const int tid = TIDX;
    for (int u = u0; u < 128 + 4; u += ustride) {
        if (u < 128) {
            const int gid = u * NTHR + tid, bh = gid >> 11, v = gid & 63, kp = (gid >> 6) & 31;
            const float* Lb = HL + (size_t)bh * 32 * 4096 + (2 * kp) * 64 + v; const float* Db = HD + (size_t)bh * 32 * 64 + 2 * kp;
            bf16_t* Sb = HS + (size_t)bh * 32 * 4096 + (2 * kp) * 64 + v;
            float S0 = 0.f, S1 = 0.f;
#pragma unroll
            for (int n0 = 0; n0 < 32; n0 += 16) {
                float l0[16], l1[16], d0[16], d1[16];
#pragma unroll
                for (int i = 0; i < 16; ++i) { l0[i] = Lb[(size_t)(n0 + i) * 4096]; l1[i] = Lb[(size_t)(n0 + i) * 4096 + 64]; d0[i] = Db[(n0 + i) * 64]; d1[i] = Db[(n0 + i) * 64 + 1]; }
#pragma unroll
                for (int i = 0; i < 16; ++i) {
                    Sb[(size_t)(n0 + i) * 4096] = f2bf(S0); Sb[(size_t)(n0 + i) * 4096 + 64] = f2bf(S1);
                    S0 = d0[i] * S0 + l0[i]; S1 = d1[i] * S1 + l1[i];
                }
            }
        } else {
            const int gid = (u - 128) * NTHR + tid, b = gid >> 8, c = gid & 255;
            float A[32], H[32];
#pragma unroll
            for (int n = 0; n < 32; ++n) { A[n] = lsum[(size_t)(b * 32 + n) * 256 + c]; H[n] = lsum[(size_t)(256 + b * 32 + n) * 256 + c]; }
            float Hc = 0.f;
#pragma unroll
            for (int n = 0; n < 32; ++n) { lcar[(size_t)(b * 32 + n) * 256 + c] = Hc; Hc = A[n] * Hc + H[n]; }
        }
    }
}


__device__ __forceinline__ void middle_task(char* smem, const bf16_t* xg1  , const float* pss_in, const bf16_t* __restrict__ Wq_t  , const bf16_t* __restrict__ kv  ,
                                            const bf16_t* __restrict__ Wmo_t  , const float* __restrict__ x1, float* __restrict__ x2, const float* __restrict__ gn, bf16_t* xg2, float* pss_out,
                                            const bf16_t* __restrict__ wr  , const float* __restrict__ b_rg, const float* __restrict__ b_re, int* __restrict__ cnt, int* __restrict__ list, float* __restrict__ pgate, int tile) {
    constexpr int QLD = 264;
    bf16_t* sQ = (bf16_t*)(smem + 92160);
    float* sZ = (float*)(smem + 92160 + 64 * QLD * 2);
    const int tid = TIDX, lane = tid & 63, wave = tid >> 6, g = lane >> 4, li = lane & 15;
    const int r0 = tile * 64, b = r0 >> 11;
    __syncthreads();
    if (tid < 64) sZ[tid] = 0.f;
    {
        const int sr = tid >> 3, sc8 = (tid & 7) * 8;
        const bf16_t* ga = xg1 + (size_t)(r0 + sr) * 1024 + sc8;
        const bf16_t* gb = Wq_t + (size_t)sr * 1024 + sc8;
        const int mt = wave & 3, nh = wave >> 2;
        f32x4 acc[8];
#pragma unroll
        for (int n = 0; n < 8; ++n) acc[n] = (f32x4){0.f, 0.f, 0.f, 0.f};
        u32x4 rA[5], rB[5];
#define MA_LOAD(R, kc) { R[0] = *(const u32x4*)(ga + (kc) * 64); _Pragma("unroll") for (int i = 0; i < 4; ++i) R[1 + i] = *(const u32x4*)(gb + (size_t)(i * 64) * 1024 + (kc) * 64); }
#define MA_STORE(R, buf) { bf16_t* dA = (bf16_t*)(smem + (buf) * 46080); bf16_t* dB = dA + 64 * TLD; *(u32x4*)(dA + sr * TLD + sc8) = R[0]; \
        _Pragma("unroll") for (int i = 0; i < 4; ++i) *(u32x4*)(dB + (sr + i * 64) * TLD + sc8) = R[1 + i]; }
#define MA_COMPUTE(buf) { const bf16_t* cA = (const bf16_t*)(smem + (buf) * 46080); const bf16_t* cB = cA + 64 * TLD; \
        _Pragma("unroll") for (int ks = 0; ks < 2; ++ks) { const bf16x8 af = frag_rm(cA, TLD, mt * 16, ks * 32, lane); \
            _Pragma("unroll") for (int n = 0; n < 8; ++n) acc[n] = MFMA16(frag_rm(cB, TLD, nh * 128 + n * 16, ks * 32, lane), af, acc[n]); } }
        MA_LOAD(rA, 0) MA_LOAD(rB, 1)
        MA_STORE(rA, 0)
        __syncthreads();
        for (int kc = 0; kc < 16; kc += 2) {
            if (kc + 2 < 16) MA_LOAD(rA, kc + 2)
            MA_COMPUTE(0)
            MA_STORE(rB, 1)
            __syncthreads();
            if (kc + 3 < 16) MA_LOAD(rB, kc + 3)
            MA_COMPUTE(1)
            if (kc + 2 < 16) MA_STORE(rA, 0)
            __syncthreads();
        }
#undef MA_LOAD
#undef MA_STORE
#undef MA_COMPUTE
        const float ri = rinv_from_pss(pss_in, (size_t)(r0 + mt * 16 + li));
#pragma unroll
        for (int n = 0; n < 8; ++n) { uint2 o; o.x = pk2(acc[n][0] * ri, acc[n][1] * ri); o.y = pk2(acc[n][2] * ri, acc[n][3] * ri);
            *(uint2*)(sQ + (mt * 16 + li) * QLD + nh * 128 + n * 16 + 4 * g) = o; }
    }
    __syncthreads();
    {
        const int head = wave >> 1, mt0 = (wave & 1) * 2;
        bf16x8 qf[2][2];
#pragma unroll
        for (int m = 0; m < 2; ++m)
#pragma unroll
            for (int ks = 0; ks < 2; ++ks) qf[m][ks] = frag_rm(sQ + head * 64, QLD, (mt0 + m) * 16, ks * 32, lane);
        bf16_t* sK = (bf16_t*)smem;
        bf16_t* sV = sK + 4 * 64 * TLD;
        const int sr = tid >> 3, sc8 = (tid & 7) * 8;
        const bf16_t* kvg = kv + (size_t)(b * MEMLEN + sr) * 512 + sc8;
        u32x4 rk[4], rv[4];
#define MB_LOAD(kt) { _Pragma("unroll") for (int hh = 0; hh < 4; ++hh) { rk[hh] = *(const u32x4*)(kvg + (size_t)((kt) * 64) * 512 + hh * 64); rv[hh] = *(const u32x4*)(kvg + (size_t)((kt) * 64) * 512 + 256 + hh * 64); } }
        MB_LOAD(0)
        f32x4 oacc[2][4]; float mrun[2] = {-INFINITY, -INFINITY}, lrun[2] = {0.f, 0.f};
#pragma unroll
        for (int m = 0; m < 2; ++m)
#pragma unroll
            for (int n = 0; n < 4; ++n) oacc[m][n] = (f32x4){0.f, 0.f, 0.f, 0.f};
        constexpr float SC2 = 0.125f * 1.4426950408889634f;
        for (int kt = 0; kt < 4; ++kt) {
            __syncthreads();
#pragma unroll
            for (int hh = 0; hh < 4; ++hh) { *(u32x4*)(sK + (hh * 64 + sr) * TLD + sc8) = rk[hh]; *(u32x4*)(sV + (hh * 64 + sr) * TLD + sc8) = rv[hh]; }
            __syncthreads();
            if (kt + 1 < 4) MB_LOAD(kt + 1)
#pragma unroll
            for (int m = 0; m < 2; ++m)
                attn_compute_t<false, 1>(sK + head * 64 * TLD, sV + head * 64 * TLD, sZ, qf[m], oacc[m], mrun[m], lrun[m], 0.f, SC2, 0, 0, lane, g);
        }
#undef MB_LOAD
#pragma unroll
        for (int m = 0; m < 2; ++m) {
            const float inv = 1.f / lrun[m];
#pragma unroll
            for (int n = 0; n < 4; ++n) { uint2 o; o.x = pk2(oacc[m][n][0] * inv, oacc[m][n][1] * inv); o.y = pk2(oacc[m][n][2] * inv, oacc[m][n][3] * inv);
                *(uint2*)(sQ + ((mt0 + m) * 16 + li) * QLD + head * 64 + n * 16 + 4 * g) = o; }
        }
    }
    __syncthreads();
    {
        constexpr int RLD = 264;
        bf16_t* sXh = (bf16_t*)smem;
        bf16_t* sXl = sXh + 64 * RLD;
        float* sLog = (float*)(sXl + 64 * RLD);
        float* sPart = sLog + 64 * 48;
        int* sCnt = (int*)(sPart + 64 * 8);
        float ssum[4] = {0.f, 0.f, 0.f, 0.f};
        const int rm = wave & 3, re0 = (wave < 4) ? 0 : 2, nre = (wave < 4) ? 2 : 1;
        f32x4 racc[2] = {(f32x4){0.f, 0.f, 0.f, 0.f}, (f32x4){0.f, 0.f, 0.f, 0.f}};
        for (int nq = 0; nq < 4; ++nq) {
            const int c0 = wave * 128 + nq * 32;
            const bf16_t* wg = Wmo_t + (size_t)(c0 + li) * 256 + g * 8;
            f32x4 acc[4][2], xr[4][2];
#pragma unroll
            for (int m = 0; m < 4; ++m)
#pragma unroll
                for (int n = 0; n < 2; ++n) { acc[m][n] = (f32x4){0.f, 0.f, 0.f, 0.f}; xr[m][n] = *(const f32x4*)(x1 + (size_t)(r0 + m * 16 + li) * 1024 + c0 + n * 16 + 4 * g); }
            u32x4 bw[3][2];
#define MC_BW(slot, ks) { _Pragma("unroll") for (int n = 0; n < 2; ++n) bw[slot][n] = *(const u32x4*)(wg + (size_t)(n * 16) * 256 + (ks) * 32); }
            MC_BW(0, 0) MC_BW(1, 1)
#pragma unroll
            for (int ks = 0; ks < 8; ++ks) {
                if (ks + 2 < 8) MC_BW((ks + 2) % 3, ks + 2)
#pragma unroll
                for (int m = 0; m < 4; ++m) {
                    const bf16x8 af = frag_rm(sQ, QLD, m * 16, ks * 32, lane);
#pragma unroll
                    for (int n = 0; n < 2; ++n) acc[m][n] = MFMA16(__builtin_bit_cast(bf16x8, bw[ks % 3][n]), af, acc[m][n]);
                }
                if (ks & 1) asm volatile("" ::: "memory");
            }
#undef MC_BW
            u32x4 rw[3][2][2];
#define MC_RW(slot, ks) { _Pragma("unroll") for (int e = 0; e < 2; ++e) if (e < nre) { const bf16_t* wp = wr + (size_t)((re0 + e) * 16 + li) * 1024 + (ks) * 128 + nq * 32 + g * 8; \
                rw[slot][e][0] = *(const u32x4*)wp; rw[slot][e][1] = *(const u32x4*)(wp + 48 * 1024); } }
            MC_RW(0, 0) MC_RW(1, 1)
            __syncthreads();
#pragma unroll
            for (int m = 0; m < 4; ++m) {
                const size_t row = (size_t)(r0 + m * 16 + li);
#pragma unroll
                for (int n = 0; n < 2; ++n) {
                    const int col = c0 + n * 16 + 4 * g;
                    const f32x4 o = xr[m][n] + acc[m][n];
                    *(f32x4*)(x2 + row * 1024 + col) = o;
                    ssum[m] += (o[0] * o[0] + o[1] * o[1]) + (o[2] * o[2] + o[3] * o[3]);
                    const f32x4 og = o * *(const f32x4*)(gn + col);
                    uint2 wh; wh.x = pk2(og[0], og[1]); wh.y = pk2(og[2], og[3]);
                    *(uint2*)(xg2 + row * 1024 + col) = wh;
                    uint2 wl; wl.x = pk2(og[0] - __uint_as_float(wh.x << 16), og[1] - __uint_as_float(wh.x & 0xffff0000u)); wl.y = pk2(og[2] - __uint_as_float(wh.y << 16), og[3] - __uint_as_float(wh.y & 0xffff0000u));
                    const int lc = (m * 16 + li) * RLD + wave * 32 + n * 16 + 4 * g;
                    *(uint2*)(sXh + lc) = wh; *(uint2*)(sXl + lc) = wl;
                }
            }
            __syncthreads();
#pragma unroll
            for (int ks = 0; ks < 8; ++ks) {
                if (ks + 2 < 8) MC_RW((ks + 2) % 3, ks + 2)
                const bf16x8 xh = frag_rm(sXh, RLD, rm * 16, ks * 32, lane), xl = frag_rm(sXl, RLD, rm * 16, ks * 32, lane);
#pragma unroll
                for (int e = 0; e < 2; ++e) {
                    if (e < nre) {
                        const bf16x8 fh = __builtin_bit_cast(bf16x8, rw[ks % 3][e][0]), fl = __builtin_bit_cast(bf16x8, rw[ks % 3][e][1]);
                        racc[e] = MFMA16(fh, xh, racc[e]); racc[e] = MFMA16(fl, xh, racc[e]); racc[e] = MFMA16(fh, xl, racc[e]);
                    }
                }
            }
#undef MC_RW
        }
#pragma unroll
        for (int m = 0; m < 4; ++m) {
            float ss = ssum[m]; ss += __shfl_xor(ss, 16); ss += __shfl_xor(ss, 32);
            if (g == 0) { pss_out[(size_t)(r0 + m * 16 + li) * 16 + wave] = ss; pss_out[(size_t)(r0 + m * 16 + li) * 16 + 8 + wave] = 0.f; sPart[(m * 16 + li) * 8 + wave] = ss; }
        }
#pragma unroll
        for (int e = 0; e < 2; ++e) if (e < nre) *(f32x4*)(sLog + (rm * 16 + li) * 48 + (re0 + e) * 16 + 4 * g) = racc[e];
        if (tid < 64) sCnt[tid] = 0;
        __syncthreads();
        int ex0 = 0, ex1 = 0, lr0 = 0, lr1 = 0; float gw0 = 0.f, gw1 = 0.f;
        if (tid < 64) {
            const float* pp = sPart + tid * 8;
            const float rinv = rsqrtf((((pp[0] + pp[1]) + (pp[2] + pp[3])) + ((pp[4] + pp[5]) + (pp[6] + pp[7]))) * (1.f / 1024.f) + EPS);
            const float* l0 = sLog + tid * 48;
            float lg[4];
#pragma unroll
            for (int i = 0; i < 4; ++i) lg[i] = l0[i] * rinv + b_rg[i];
            int gs = 0; float gm = lg[0];
#pragma unroll
            for (int i = 1; i < 4; ++i) if (lg[i] > gm) { gm = lg[i]; gs = i; }
            float den = 0.f;
#pragma unroll
            for (int i = 0; i < 4; ++i) den += __expf(lg[i] - gm);
            const float pg = 1.f / den;
            int i0 = 0, i1 = -1; float m0 = -INFINITY, m1 = -INFINITY;
            for (int i = 0; i < 8; ++i) {
                const float v = l0[4 + gs * 8 + i] * rinv + b_re[gs * 8 + i];
                if (v > m0) { m1 = m0; i1 = i0; m0 = v; i0 = i; } else if (v > m1) { m1 = v; i1 = i; }
            }
            const float e1 = __expf(m1 - m0);
            gw0 = pg / (1.f + e1); gw1 = pg * e1 / (1.f + e1);
            ex0 = gs * 8 + i0; ex1 = gs * 8 + i1;
            lr0 = atomicAdd(&sCnt[ex0], 1); lr1 = atomicAdd(&sCnt[ex1], 1);
        }
        __syncthreads();
        if (tid < 32) { const int c = sCnt[tid]; sCnt[32 + tid] = c ? atomicAdd(&cnt[tid * CNT_STRIDE], c) : 0; }
        __syncthreads();
        if (tid < 64) {
            const int t = r0 + tid;
            list[(size_t)ex0 * T + sCnt[32 + ex0] + lr0] = 2 * t; pgate[2 * t] = gw0;
            list[(size_t)ex1 * T + sCnt[32 + ex1] + lr1] = 2 * t + 1; pgate[2 * t + 1] = gw1;
        }
    }
}

__device__ __forceinline__ void router_phase(char* smem, const float* __restrict__ x, const float* __restrict__ g, const bf16_t* __restrict__ wr  , const float* __restrict__ b_rg,
                                             const float* __restrict__ b_re, const float* __restrict__ pss, int* __restrict__ cnt, int* __restrict__ list, float* __restrict__ pgate) {
    bf16_t* sXh = (bf16_t*)smem;
    bf16_t* sXl = sXh + 64 * TLD;
    float* sLog = (float*)(sXl + 64 * TLD);
    const int tid = TIDX, lane = tid & 63, wave = tid >> 6, gq = lane >> 4, li = lane & 15;
    const int mt = wave & 3, kh = wave >> 2;
    const int stok = tid >> 3, c8 = (tid & 7) * 8;
    BLK_LOOP(tile, T / 64) {
        const int t0 = tile * 64;
        f32x4 acc[3];
#pragma unroll
        for (int n = 0; n < 3; ++n) acc[n] = (f32x4){0.f, 0.f, 0.f, 0.f};
        const float* xp = x + (size_t)(t0 + stok) * 1024 + c8;
        const bf16_t* wp = wr + (size_t)li * 1024 + kh * 32 + gq * 8;
        f32x4 x0 = *(const f32x4*)xp, x1 = *(const f32x4*)(xp + 4);
        u32x4 wh[3], wl[3];
#pragma unroll
        for (int n = 0; n < 3; ++n) { wh[n] = *(const u32x4*)(wp + n * 16 * 1024); wl[n] = *(const u32x4*)(wp + 48 * 1024 + n * 16 * 1024); }
        for (int kc = 0; kc < 16; ++kc) {
            const f32x4 g0 = *(const f32x4*)(g + kc * 64 + c8), g1 = *(const f32x4*)(g + kc * 64 + c8 + 4);
            const f32x4 v0 = x0 * g0, v1 = x1 * g1;
            u32x4 oh, ol;
#pragma unroll
            for (int j = 0; j < 2; ++j) {
                const unsigned h0 = pk2(v0[2 * j], v0[2 * j + 1]), h1 = pk2(v1[2 * j], v1[2 * j + 1]);
                oh[j] = h0; oh[2 + j] = h1;
                ol[j] = pk2(v0[2 * j] - __uint_as_float(h0 << 16), v0[2 * j + 1] - __uint_as_float(h0 & 0xffff0000u));
                ol[2 + j] = pk2(v1[2 * j] - __uint_as_float(h1 << 16), v1[2 * j + 1] - __uint_as_float(h1 & 0xffff0000u));
            }
            __syncthreads();
            *(u32x4*)(sXh + stok * TLD + c8) = oh; *(u32x4*)(sXl + stok * TLD + c8) = ol;
            __syncthreads();
            u32x4 cwh[3], cwl[3];
#pragma unroll
            for (int n = 0; n < 3; ++n) { cwh[n] = wh[n]; cwl[n] = wl[n]; }
            if (kc + 1 < 16) {
                x0 = *(const f32x4*)(xp + (kc + 1) * 64); x1 = *(const f32x4*)(xp + (kc + 1) * 64 + 4);
#pragma unroll
                for (int n = 0; n < 3; ++n) { wh[n] = *(const u32x4*)(wp + n * 16 * 1024 + (kc + 1) * 64); wl[n] = *(const u32x4*)(wp + 48 * 1024 + n * 16 * 1024 + (kc + 1) * 64); }
            }
            const bf16x8 xh = frag_rm(sXh, TLD, mt * 16, kh * 32, lane), xl = frag_rm(sXl, TLD, mt * 16, kh * 32, lane);
#pragma unroll
            for (int n = 0; n < 3; ++n) {
                const bf16x8 fh = __builtin_bit_cast(bf16x8, cwh[n]), fl = __builtin_bit_cast(bf16x8, cwl[n]);
                acc[n] = MFMA16(fh, xh, acc[n]);
                acc[n] = MFMA16(fl, xh, acc[n]);
                acc[n] = MFMA16(fh, xl, acc[n]);
            }
        }
#pragma unroll
        for (int n = 0; n < 3; ++n) *(f32x4*)(sLog + (kh * 64 + mt * 16 + li) * 48 + n * 16 + 4 * gq) = acc[n];
        __syncthreads();
        int* sCnt = (int*)(sLog + 2 * 64 * 48);
        if (tid < 64) sCnt[tid] = 0;
        __syncthreads();
        int ex0 = 0, ex1 = 0, lr0 = 0, lr1 = 0; float gw0 = 0.f, gw1 = 0.f;
        if (tid < 64) {
            const float rinv = rinv_from_pss(pss, (size_t)(t0 + tid));
            const float* l0 = sLog + tid * 48; const float* l1 = sLog + (64 + tid) * 48;
            float lg[4];
#pragma unroll
            for (int i = 0; i < 4; ++i) lg[i] = (l0[i] + l1[i]) * rinv + b_rg[i];
            int gs = 0; float gm = lg[0];
#pragma unroll
            for (int i = 1; i < 4; ++i) if (lg[i] > gm) { gm = lg[i]; gs = i; }
            float den = 0.f;
#pragma unroll
            for (int i = 0; i < 4; ++i) den += __expf(lg[i] - gm);
            const float pg = 1.f / den;
            int i0 = 0, i1 = -1; float m0 = -INFINITY, m1 = -INFINITY;
            for (int i = 0; i < 8; ++i) {
                const float v = (l0[4 + gs * 8 + i] + l1[4 + gs * 8 + i]) * rinv + b_re[gs * 8 + i];
                if (v > m0) { m1 = m0; i1 = i0; m0 = v; i0 = i; } else if (v > m1) { m1 = v; i1 = i; }
            }
            const float e1 = __expf(m1 - m0);
            gw0 = pg / (1.f + e1); gw1 = pg * e1 / (1.f + e1);
            ex0 = gs * 8 + i0; ex1 = gs * 8 + i1;
            lr0 = atomicAdd(&sCnt[ex0], 1); lr1 = atomicAdd(&sCnt[ex1], 1);
        }
        __syncthreads();
        if (tid < 32) { const int c = sCnt[tid]; sCnt[32 + tid] = c ? atomicAdd(&cnt[tid * CNT_STRIDE], c) : 0; }
        __syncthreads();
        if (tid < 64) {
            const int t = t0 + tid;
            list[(size_t)ex0 * T + sCnt[32 + ex0] + lr0] = 2 * t; pgate[2 * t] = gw0;
            list[(size_t)ex1 * T + sCnt[32 + ex1] + lr1] = 2 * t + 1; pgate[2 * t + 1] = gw1;
        }
        __syncthreads();
    }
}

__device__ __forceinline__ void combine_phase(const float* x2, const bf16_t* __restrict__ eo, const float* __restrict__ g, float* xout, bf16_t* __restrict__ hn, int mode) {
    const int lane = TIDX & 63;
    for (int t = blockIdx.x * 8 + (TIDX >> 6); t < T; t += gridDim.x * 8) {
        f32x4 v[4]; float s = 0.f;
#pragma unroll
        for (int j = 0; j < 4; ++j) {
            const int c = (lane + 64 * j) * 4;
            v[j] = *(const f32x4*)(x2 + (size_t)t * 1024 + c);
            const uint2 e0 = *(const uint2*)(eo + (size_t)(2 * t) * 1024 + c), e1 = *(const uint2*)(eo + (size_t)(2 * t + 1) * 1024 + c);
            v[j].x += __uint_as_float(e0.x << 16) + __uint_as_float(e1.x << 16);
            v[j].y += __uint_as_float(e0.x & 0xffff0000u) + __uint_as_float(e1.x & 0xffff0000u);
            v[j].z += __uint_as_float(e0.y << 16) + __uint_as_float(e1.y << 16);
            v[j].w += __uint_as_float(e0.y & 0xffff0000u) + __uint_as_float(e1.y & 0xffff0000u);
            s += v[j].x * v[j].x + v[j].y * v[j].y + v[j].z * v[j].z + v[j].w * v[j].w;
        }
        const float rinv = rsqrtf(wave_sum(s) * (1.f / 1024.f) + EPS);
#pragma unroll
        for (int j = 0; j < 4; ++j) {
            const int c = (lane + 64 * j) * 4;
            const f32x4 gg = *(const f32x4*)(g + c);
            const f32x4 hv = v[j] * rinv * gg;
            if (mode == 0) {
                *(f32x4*)(xout + (size_t)t * 1024 + c) = v[j];
                uint2 o; o.x = pk2(hv.x, hv.y); o.y = pk2(hv.z, hv.w);
                *(uint2*)(hn + (size_t)t * 1024 + c) = o;
            } else {
                *(f32x4*)(xout + (size_t)t * 1024 + c) = hv;
            }
        }
    }
}

template <int l>
__device__ __forceinline__ void layer_body(const Params& P, char* smem, const XcdBarrier& xb, const float* xcur) {
    char* ws = P.ws;
    bf16_t* Wt_in = (bf16_t*)(ws + OFF_WIN); bf16_t* Wt_out = (bf16_t*)(ws + OFF_WOUT); bf16_t* Wt_mq = (bf16_t*)(ws + OFF_WMQ); bf16_t* Wt_mkv = (bf16_t*)(ws + OFF_WMKV);
    bf16_t* Wt_mo = (bf16_t*)(ws + OFF_WMO); bf16_t* Wt_gu = (bf16_t*)(ws + OFF_WGU); bf16_t* Wt_dn = (bf16_t*)(ws + OFF_WDN);
    bf16_t* hn = (bf16_t*)(ws + OFF_HN); bf16_t* proj = (bf16_t*)(ws + OFF_PROJ); float* gates = (float*)(ws + OFF_GATES); bf16_t* y = (bf16_t*)(ws + OFF_Y);
    float* XA = P.out; float* XB = (float*)(ws + OFF_XB);
    bf16_t* qm = (bf16_t*)(ws + OFF_QM); bf16_t* om = (bf16_t*)(ws + OFF_OM); bf16_t* kvm = (bf16_t*)(ws + OFF_KVM); bf16_t* memn = (bf16_t*)(ws + OFF_MEMN);
    float* foxc = (float*)(ws + OFF_FOXC); float* lrua = (float*)(ws + OFF_LRUA); float* lruu = (float*)(ws + OFF_LRUU);
    int* cnt_all = (int*)(ws + OFF_CTL) + CTL_CNT_WORD; int* list = (int*)(ws + OFF_LIST); float* pgate = (float*)(ws + OFF_PGATE);
    bf16_t* act = (bf16_t*)(ws + OFF_ACT); bf16_t* eo = (bf16_t*)(ws + OFF_EO); float* pss = (float*)(ws + OFF_PSS);
    const int wave = TIDX >> 6, lane = TIDX & 63;


        float* x1 = (l == 0) ? XA : XB;
        float* x2 = (l == 0) ? XB : XA;
        int* cnt = cnt_all + 32 * CNT_STRIDE * l;
        const float* mg = P.in[I_MIX_GAIN] + l * 1024;
        REP(2, { pg8::Gemm g{hn, Wt_in + (size_t)l * NP * 1024, T, NP, 1024}; pg8::StaticOrder S; S.init(T, NP, (int)gridDim.x, (int)blockIdx.x);
                 pg8::EpiInProj E{proj, NP, gates, C_GATE};
                 pg8::gemm_phase<pg8::EpiInProj, pg8::StaticOrder, true, true>((PG8_LAS unsigned char*)smem, g, S, E); });
        if (l == 0) for (int l2 = 0; l2 < NL; ++l2)
            gemm_phase<EPI_BF16>(smem, memn + (size_t)l2 * 2048 * 1024, 1024, Wt_mkv + (size_t)l2 * 512 * 1024, 1024, 2048, 512, 1024, kvm + (size_t)l2 * 2048 * 512, 512, nullptr, nullptr,
                                 (gridDim.x >= 192) ? ((int)blockIdx.x - 128 - 32 * l2) : (int)blockIdx.x, (gridDim.x >= 192) ? 4096 : (int)gridDim.x);
        GSYNC();
        unsigned* fl_scan = (unsigned*)(ws + OFF_CTL) + CTL_FLAG_WORD + 64 * (2 * l + 1);
        {
            const int bx = blockIdx.x;
            bf16_t* gtiles = (bf16_t*)(ws + OFF_GDN); float* glast = (float*)(ws + OFF_GLAST);
            if (bx < 32 && wave == 1) fox_cumsum(gates, P.in[I_FOX_FB] + l * 4, foxc, bx, lane);
            BLK_LOOP(cp, 512) gdn_prep_pair(smem, proj, gates, P.in[I_GDN_CONV_W] + l * 4 * 768, P.in[I_GDN_A_LOG] + l * 4, P.in[I_GDN_DT_BIAS] + l * 4, gtiles, glast, 2 * cp);
            BLK_LOOP(ch, 1024) hgrn_local_task(smem, proj, P.in[I_HGRN_LB], l, (float*)(ws + OFF_HL), (float*)(ws + OFF_HD), ch);
            BLK_LOOP(task, 256) lru_local_task(smem, proj, P.in[I_LRU_CONV_W] + l * 1024, P.in[I_LRU_CONV_B] + l * 256, P.in[I_LRU_WA] + l * 16384, P.in[I_LRU_BA] + l * 256,
                                               P.in[I_LRU_WX] + l * 16384, P.in[I_LRU_BX] + l * 256, P.in[I_LRU_LAM] + l * 256, lrua, lruu, (float*)(ws + OFF_LSUM), task);
        }
        GSYNC();
        {
            const int natt = (SEQ / 128) * 4 * NB;
            const int bx = blockIdx.x, nfree = (int)gridDim.x - 32;
            if (bx < 32) gdn_scan_task(smem, (const bf16_t*)(ws + OFF_GDN), (const float*)(ws + OFF_GLAST), proj, mg, y, bx);
            else {
                const int u0 = bx - 32;
                if (u0 < 132) {
                    state_scan_phase((const float*)(ws + OFF_HL), (const float*)(ws + OFF_HD), (bf16_t*)(ws + OFF_HS), (const float*)(ws + OFF_LSUM), (float*)(ws + OFF_LCAR), u0, nfree);
                    flag_signal(fl_scan, (unsigned)((132 - u0 + nfree - 1) / nfree));
                }
                for (int r = 0; r * nfree < natt; ++r) {
                    const int i = r * nfree + ((r & 1) ? (nfree - 1 - (bx - 32)) : (bx - 32));
                    if (i >= natt) continue;
                    const int qt = 15 - (i >> 5), bh = i & 31;
                    attn_task(smem, proj + C_BQ, NP, proj + C_BK, NP, proj + C_BV, NP, foxc, SEQ, SEQ, 1, 0.125f, y + 256, 1024, mg + 256, 1, (bh * 16) + qt);
                }
                flag_wait(fl_scan, 132u);
                for (int i = bx - 32; i < 1024; i += nfree) {
                    const int ch = (i & 31) * 32 + (31 - (i >> 5));
                    hgrn_out_task(smem, proj, P.in[I_HGRN_LB], l, (const bf16_t*)(ws + OFF_HS), mg, y, ch);
                }
                for (int i = bx - 32; i < 256; i += nfree) lru_out_task(lrua, lruu, (const float*)(ws + OFF_LCAR), proj, mg, y, i);
            }
        }
        GSYNC();
        REP(16, { pg8::Gemm g{y, Wt_out + (size_t)l * 1024 * 1024, T, 1024, 1024}; pg8::StaticOrder S; S.init(T, 1024, (int)gridDim.x, (int)blockIdx.x);
                  pg8::EpiResidNorm E{xcur, x1, 1024, P.in[I_NORM_MEM] + l * 1024, hn, pss};
                  pg8::gemm_phase<pg8::EpiResidNorm, pg8::StaticOrder, true, true>((PG8_LAS unsigned char*)smem, g, S, E); });
        GSYNC();
        REP(64, BLK_LOOP(tile, T / 64) middle_task(smem, hn, pss, Wt_mq + (size_t)l * 256 * 1024, kvm + (size_t)l * 2048 * 512, Wt_mo + (size_t)l * 1024 * 256, x1, x2, P.in[I_NORM_FFN] + l * 1024, hn, pss,
                                                            (const bf16_t*)(ws + OFF_WR) + (size_t)l * 2 * 48 * 1024, P.in[I_B_RG] + l * 4, P.in[I_B_RE] + l * 32, cnt, list, pgate, tile));
        GSYNC();
        REP(512, moe_phase<1>(smem, hn, 1024, Wt_gu + (size_t)l * 32 * 512 * 1024, (size_t)512 * 1024, 1024, 1024, cnt, list, pgate, act, pss));
        GSYNC();
        REP(1024, moe_phase<2>(smem, act, 256, Wt_dn + (size_t)l * 32 * 1024 * 256, (size_t)1024 * 256, 256, 256, cnt, list, pgate, eo, pss));
        if (PROBE_MASK & 2048) { for (int i = 0; i < 10; ++i) GSYNC(); }
        GSYNC();
        if (l == 0) { combine_phase(x2, eo, P.in[I_NORM_MIX] + 1024, XA, hn, 0); GSYNC(); }
        else combine_phase(x2, eo, P.in[I_NORM_FINAL], P.out, hn, 1);
}
__global__ void __launch_bounds__(NTHR, 2) mega_kernel(Params P) {
    extern __shared__ __attribute__((aligned(16))) char smem[];
    volatile LDS_AS unsigned* st = (volatile LDS_AS unsigned*)(smem + LDS_BYTES - 16);
    if (TIDX < 4) st[TIDX] = 0u;
    __syncthreads();
    if (PROBE_TS >= 0 && TIDX == 0) *(volatile unsigned*)(smem + LDS_BYTES - 1032) = 0u;
    __syncthreads();
    const XcdBarrier xb = xcd_barrier_post((unsigned*)(P.ws + OFF_CTL), st);
    TS_STAMP();
    phase0(P, smem);
    GSYNC();
    layer_body<0>(P, smem, xb, P.in[I_X]);
    layer_body<1>(P, smem, xb, P.out);
    if (PROBE_TS >= 0) {
        __syncthreads();
        if (blockIdx.x == 0 && TIDX == 0) {
            volatile unsigned long long* ts_ = (volatile unsigned long long*)(smem + LDS_BYTES - 1024);
            const unsigned long long tend = __builtin_amdgcn_s_memrealtime();
            const unsigned n_ = *(volatile unsigned*)(smem + LDS_BYTES - 1032);
            const unsigned long long t1 = ((unsigned)PROBE_TS + 1 < n_) ? ts_[PROBE_TS + 1] : tend, t0 = ts_[PROBE_TS];
            const unsigned long long wait = (t1 - t0) * PROBE_K;
            while (__builtin_amdgcn_s_memrealtime() - tend < wait) __builtin_amdgcn_s_sleep(8);
        }
    }
}

extern "C" void kernel_launch(void* const* d_in, const int* in_sizes, int n_in, void* d_out, int out_size, void* d_ws, size_t ws_size, hipStream_t stream) {
    static int grid_blocks = 0;
    if (grid_blocks == 0) {
        if (n_in != N_INPUTS || ws_size < OFF_END || out_size != T * 1024) { fprintf(stderr, "kernel_launch: unexpected sizes n_in=%d ws=%zu out=%d (need ws >= %zu)\n", n_in, ws_size, out_size, (size_t)OFF_END); grid_blocks = -1; return; }
        int dev = 0, cus = 0, per_cu = 0;
        if (hipGetDevice(&dev) != hipSuccess || hipDeviceGetAttribute(&cus, hipDeviceAttributeMultiprocessorCount, dev) != hipSuccess) { fprintf(stderr, "kernel_launch: device query failed\n"); grid_blocks = -1; return; }
        if (hipFuncSetAttribute((const void*)mega_kernel, hipFuncAttributeMaxDynamicSharedMemorySize, LDS_BYTES) != hipSuccess) { fprintf(stderr, "kernel_launch: hipFuncSetAttribute failed\n"); grid_blocks = -1; return; }
        if (hipOccupancyMaxActiveBlocksPerMultiprocessor(&per_cu, (const void*)mega_kernel, NTHR, LDS_BYTES) != hipSuccess || per_cu < 1) { fprintf(stderr, "kernel_launch: occupancy query says %d blocks/CU\n", per_cu); grid_blocks = -1; return; }
        grid_blocks = cus;
        fprintf(stderr, "kernel_launch: cus=%d per_cu=%d grid=%d\n", cus, per_cu, grid_blocks);
    }
    if (grid_blocks < 0) return;
    if (hipMemsetAsync((char*)d_ws + OFF_CTL, 0, CTL_BYTES, stream) != hipSuccess) { fprintf(stderr, "kernel_launch: memset failed\n"); return; }
    Params p; memset(&p, 0, sizeof p);
    for (int i = 0; i < N_INPUTS; ++i) p.in[i] = (const float*)d_in[i];
    p.out = (float*)d_out; p.ws = (char*)d_ws;
    void* args[] = {&p};
    hipError_t e = hipLaunchCooperativeKernel((const void*)mega_kernel, dim3(grid_blocks), dim3(NTHR), args, LDS_BYTES, stream);
    if (e != hipSuccess) fprintf(stderr, "kernel_launch: cooperative launch failed: %s (grid %d)\n", hipGetErrorString(e), grid_blocks);
}
```

```cpp
#include <hip/hip_runtime.h>
#include <stdint.h>
#include <stdio.h>
#include <string.h>
#include <hip/hip_cooperative_groups.h>
namespace cg = cooperative_groups;

typedef unsigned short bf16_t;
typedef short bf16x8 __attribute__((ext_vector_type(8)));
typedef float f32x4 __attribute__((ext_vector_type(4)));
typedef unsigned u32x4 __attribute__((ext_vector_type(4)));

constexpr int NB = 8, SEQ = 2048, DM = 1024, T = NB * SEQ, NL = 2;
constexpr int NP = 3584;
constexpr int NIN = 3340;
constexpr int C_AQ = 0, C_AF = 256, C_AI = 512, C_AG = 768, C_BQ = 1024, C_BK = 1280, C_BV = 1536, C_CX = 1792, C_CG = 2048,
              C_DQ = 2304, C_DK = 2560, C_DV = 2816, C_DZ = 3072, C_GATE = 3328;
constexpr int MEMLEN = 256;
constexpr int NEXP = 32, DEXP = 256;
constexpr float EPS = 1e-6f;

constexpr size_t al256(size_t x) { return (x + 255) & ~(size_t)255; }
constexpr size_t SZ_WIN = (size_t)NP * 1024 * 2, SZ_WOUT = (size_t)1024 * 1024 * 2, SZ_WMQ = (size_t)256 * 1024 * 2, SZ_WMKV = (size_t)512 * 1024 * 2,
                 SZ_WMO = (size_t)1024 * 256 * 2, SZ_WGU = (size_t)32 * 512 * 1024 * 2, SZ_WDN = (size_t)32 * 1024 * 256 * 2;
constexpr size_t OFF_WIN = 0;
constexpr size_t OFF_WOUT = OFF_WIN + NL * SZ_WIN;
constexpr size_t OFF_WMQ = OFF_WOUT + NL * SZ_WOUT;
constexpr size_t OFF_WMKV = OFF_WMQ + NL * SZ_WMQ;
constexpr size_t OFF_WMO = OFF_WMKV + NL * SZ_WMKV;
constexpr size_t OFF_WGU = OFF_WMO + NL * SZ_WMO;
constexpr size_t OFF_WDN = OFF_WGU + NL * SZ_WGU;
constexpr size_t OFF_HN = OFF_WDN + NL * SZ_WDN;
constexpr size_t OFF_PROJ = OFF_HN + (size_t)T * 1024 * 2;
constexpr size_t OFF_GATES = OFF_PROJ + (size_t)T * NP * 2;
constexpr size_t OFF_Y = OFF_GATES + (size_t)T * 16 * 4;
constexpr size_t OFF_XB = OFF_Y + (size_t)T * 1024 * 2;
constexpr size_t OFF_QM = OFF_XB + (size_t)T * 1024 * 4;
constexpr size_t OFF_OM = OFF_QM + (size_t)T * 256 * 2;
constexpr size_t OFF_KVM = OFF_OM + (size_t)T * 256 * 2;
constexpr size_t OFF_MEMN = OFF_KVM + (size_t)NL * 2048 * 512 * 2;
constexpr size_t OFF_FOXC = OFF_MEMN + (size_t)2048 * 1024 * 2;
constexpr size_t OFF_LRUA = OFF_FOXC + (size_t)NB * 4 * SEQ * 4;
constexpr size_t OFF_LRUU = OFF_LRUA + (size_t)T * 256 * 4;
constexpr size_t OFF_CNT = OFF_LRUU + (size_t)T * 256 * 4;
constexpr size_t OFF_LIST = OFF_CNT + 256;
constexpr size_t OFF_PGATE = OFF_LIST + (size_t)NEXP * T * 4;
constexpr size_t OFF_HL = OFF_PGATE + (size_t)2 * T * 4;
constexpr size_t OFF_HD = OFF_HL + (size_t)1024 * 4096 * 4;
constexpr size_t OFF_GDN = OFF_HD + (size_t)1024 * 64 * 4;
constexpr size_t OFF_GLAST = OFF_GDN + (size_t)1024 * 5 * 4096 * 2;
constexpr size_t OFF_LSUM = OFF_GLAST + 4096;
constexpr size_t OFF_HS = OFF_LSUM + (size_t)2 * 256 * 256 * 4;
constexpr size_t OFF_LCAR = OFF_HS + (size_t)1024 * 4096 * 2;
constexpr size_t OFF_PSS = OFF_LCAR + (size_t)256 * 256 * 4;
constexpr size_t OFF_WR = OFF_PSS + (size_t)T * 16 * 4;
constexpr size_t OFF_CTL = OFF_WR + (size_t)NL * 2 * 48 * 1024 * 2;
constexpr size_t CTL_BYTES = 32768;
constexpr int CTL_CNT_WORD = 4096;
constexpr int CNT_STRIDE = 64;
constexpr size_t OFF_PRINV = OFF_CTL + CTL_BYTES;
constexpr size_t OFF_END = OFF_PRINV + (size_t)2 * T * 4;
constexpr int MOE_MAXROWS = 2 * T + NEXP * 256;
constexpr size_t OFF_ACT = OFF_PROJ;
constexpr size_t OFF_EO = OFF_PROJ + (size_t)MOE_MAXROWS * 256 * 2;
static_assert(OFF_EO + (size_t)MOE_MAXROWS * 1024 * 2 <= OFF_GATES, "overlay fits");

__device__ __forceinline__ int tid_opaque() { int t = threadIdx.x; asm volatile("" : "+v"(t)); return t; }
#define TIDX tid_opaque()
__device__ __forceinline__ float bf2f(bf16_t v) { return __uint_as_float(((unsigned)v) << 16); }
typedef __bf16 bf16x2_t __attribute__((ext_vector_type(2)));
__device__ __forceinline__ bf16_t f2bf(float f) { return __builtin_bit_cast(unsigned short, (__bf16)f); }
__device__ __forceinline__ unsigned pk2(float lo, float hi) { bf16x2_t v = {(__bf16)lo, (__bf16)hi}; return __builtin_bit_cast(unsigned, v); }
__device__ __forceinline__ float sigmoidf_(float x) { return 1.f / (1.f + __expf(-x)); }
__device__ __forceinline__ float siluf_(float x) { return x / (1.f + __expf(-x)); }
__device__ __forceinline__ float softplusf_(float x) { return x > 20.f ? x : log1pf(__expf(x)); }
__device__ __forceinline__ float logsigmoidf_(float x) { return x < 0.f ? x - log1pf(__expf(x)) : -log1pf(__expf(-x)); }
__device__ __forceinline__ float geluf_(float x) { float u = 0.7978845608028654f * (x + 0.044715f * x * x * x); return 0.5f * x * (1.f + tanhf(u)); }
__device__ __forceinline__ float wave_sum(float v) {
#pragma unroll
    for (int o = 1; o < 64; o <<= 1) v += __shfl_xor(v, o);
    return v;
}
__device__ __forceinline__ float bfx(const u32x4& raw, int j) { return __uint_as_float((j & 1) ? (raw[j >> 1] & 0xffff0000u) : (raw[j >> 1] << 16)); }
__device__ __forceinline__ float rdlane(float v, int l) { return __int_as_float(__builtin_amdgcn_readlane(__float_as_int(v), l)); }

#define PROBE_MASK 0
#define PROBE_TS -1
#define PROBE_K 4
#define TS_STAMP() do { if (PROBE_TS >= 0 && blockIdx.x == 0 && TIDX == 0) { volatile unsigned long long* ts_ = (volatile unsigned long long*)(smem + LDS_BYTES - 1024); volatile unsigned* tc_ = (volatile unsigned*)(smem + LDS_BYTES - 1032); \
        const unsigned k_ = tc_[0]; ts_[k_] = __builtin_amdgcn_s_memrealtime(); tc_[0] = k_ + 1; } } while (0)
#define GSYNC() do { xcd_barrier(xb); TS_STAMP(); } while (0)
#define REP(bit, ...) do { __VA_ARGS__; if (PROBE_MASK & (bit)) { GSYNC(); __VA_ARGS__; } } while (0)
constexpr int NTHR = 512;
constexpr int LDS_BYTES = 147456;
enum { I_X = 0, I_MEM, I_NORM_MIX, I_W_IN, I_HGRN_LB, I_FOX_FB, I_LRU_CONV_W, I_LRU_CONV_B, I_LRU_WA, I_LRU_BA, I_LRU_WX, I_LRU_BX, I_LRU_LAM, I_GDN_CONV_W, I_GDN_A_LOG,
       I_GDN_DT_BIAS, I_MIX_GAIN, I_W_OUT, I_NORM_MEM, I_NORM_MEMKV, I_W_MQ, I_W_MKV, I_W_MO, I_NORM_FFN, I_W_RG, I_B_RG, I_W_RE, I_B_RE, I_W_E_GU, I_W_E_DN, I_NORM_FINAL, N_INPUTS };
struct Params { const float* in[N_INPUTS]; float* out; char* ws; };
static_assert(sizeof(Params) == 8 * (N_INPUTS + 2), "no padding");

#define BLK_LOOP(it, n) for (int it = (int)blockIdx.x; it < (n); it += (int)gridDim.x)


__device__ __forceinline__ float rinv_from_pss(const float* __restrict__ pss, size_t row) {
    const f32x4 a = *(const f32x4*)(pss + row * 16), b = *(const f32x4*)(pss + row * 16 + 4), c = *(const f32x4*)(pss + row * 16 + 8), d = *(const f32x4*)(pss + row * 16 + 12);
    const float sm = ((a[0] + a[1]) + (a[2] + a[3])) + ((b[0] + b[1]) + (b[2] + b[3])) + ((c[0] + c[1]) + (c[2] + c[3])) + ((d[0] + d[1]) + (d[2] + d[3]));
    return rsqrtf(sm * (1.f / 1024.f) + EPS);
}

__device__ __forceinline__ int rowmap_fn(int mode, int n) {
    if (mode == 1) {
        if (n < 1792) return n;
        if (n < 1796) return C_GATE + (n - 1792);
        if (n < 3076) return n - 4;
        if (n < 3084) return C_GATE + 4 + (n - 3076);
        return n - 12;
    } else if (mode == 2) {
        int j = n & 255; return (j >> 4) * 32 + ((n >= 256) ? 16 : 0) + (j & 15);
    }
    return n;
}
constexpr int CT_PER_LAYER = 27 * 16 + 128 + 32 + 64 + 32;
constexpr int CT_GU = 64 * 64, CT_DN = 64 * 32;
constexpr int CT_TOTAL = NL * CT_PER_LAYER + CT_GU + CT_DN;

struct CtJob { const float* src; bf16_t* dst; int K, N, mode, ntn, idx; };
__device__ __forceinline__ CtJob ct_decode(const Params& P, int it) {
    char* ws = P.ws; CtJob j; int r = it;
    const int l = r / CT_PER_LAYER; r -= l * CT_PER_LAYER;
    if (r < 432) { j.src = P.in[I_W_IN] + (size_t)l * 1024 * NIN; j.dst = (bf16_t*)(ws + OFF_WIN) + (size_t)l * NP * 1024; j.K = 1024; j.N = NIN; j.mode = 1; j.ntn = 27; j.idx = r; return j; } r -= 432;
    if (r < 128) { j.src = P.in[I_W_OUT] + (size_t)l * 1024 * 1024; j.dst = (bf16_t*)(ws + OFF_WOUT) + (size_t)l * 1024 * 1024; j.K = 1024; j.N = 1024; j.mode = 0; j.ntn = 8; j.idx = r; return j; } r -= 128;
    if (r < 32) { j.src = P.in[I_W_MQ] + (size_t)l * 1024 * 256; j.dst = (bf16_t*)(ws + OFF_WMQ) + (size_t)l * 256 * 1024; j.K = 1024; j.N = 256; j.mode = 0; j.ntn = 2; j.idx = r; return j; } r -= 32;
    if (r < 64) { j.src = P.in[I_W_MKV] + (size_t)l * 1024 * 512; j.dst = (bf16_t*)(ws + OFF_WMKV) + (size_t)l * 512 * 1024; j.K = 1024; j.N = 512; j.mode = 0; j.ntn = 4; j.idx = r; return j; } r -= 64;
    j.src = P.in[I_W_MO] + (size_t)l * 256 * 1024; j.dst = (bf16_t*)(ws + OFF_WMO) + (size_t)l * 1024 * 256; j.K = 256; j.N = 1024; j.mode = 0; j.ntn = 8; j.idx = r; return j;
}
__device__ __forceinline__ CtJob ct_decode_all(const Params& P, int it) {
    if (it < NL * CT_PER_LAYER) return ct_decode(P, it);
    char* ws = P.ws; CtJob j; int r = it - NL * CT_PER_LAYER;
    if (r < CT_GU) { const int m = r >> 6; j.src = P.in[I_W_E_GU] + (size_t)m * 1024 * 512; j.dst = (bf16_t*)(ws + OFF_WGU) + (size_t)m * 512 * 1024; j.K = 1024; j.N = 512; j.mode = 2; j.ntn = 4; j.idx = r & 63; return j; }
    r -= CT_GU;
    { const int m = r >> 5; j.src = P.in[I_W_E_DN] + (size_t)m * 256 * 1024; j.dst = (bf16_t*)(ws + OFF_WDN) + (size_t)m * 1024 * 256; j.K = 256; j.N = 1024; j.mode = 0; j.ntn = 8; j.idx = r & 31; return j; }
}
__device__ __forceinline__ void ct_load(const CtJob& j, int tid, f32x4 (&v)[4]) {
    const int n0 = (j.idx % j.ntn) * 128, k0 = (j.idx / j.ntn) * 64;
#pragma unroll
    for (int i = 0; i < 4; ++i) {
        const int k = (tid >> 5) + 16 * i, n = n0 + (tid & 31) * 4;
        v[i] = __builtin_nontemporal_load((const f32x4*)(j.src + (size_t)(k0 + k) * j.N + min(n, j.N - 4)));
    }
}
__device__ __forceinline__ void ct_store(float* tile  , const CtJob& j, int tid, const f32x4 (&v)[4]) {
    const int n0 = (j.idx % j.ntn) * 128, k0 = (j.idx / j.ntn) * 64;
    __syncthreads();
#pragma unroll
    for (int i = 0; i < 4; ++i) {
        const int k = (tid >> 5) + 16 * i;
#pragma unroll
        for (int e = 0; e < 4; ++e) tile[k * 129 + (tid & 31) * 4 + e] = v[i][e];
    }
    __syncthreads();
    const int nl = tid >> 2, k16 = (tid & 3) * 16, n = n0 + nl;
    if (n < j.N) {
        const int r = rowmap_fn(j.mode, n);
#pragma unroll
        for (int hh = 0; hh < 2; ++hh) {
            u32x4 o;
#pragma unroll
            for (int q = 0; q < 4; ++q) o[q] = pk2(tile[(k16 + hh * 8 + 2 * q) * 129 + nl], tile[(k16 + hh * 8 + 2 * q + 1) * 129 + nl]);
            *(u32x4*)(j.dst + (size_t)r * j.K + k0 + k16 + hh * 8) = o;
        }
    }
}
__device__ __forceinline__ void rms_row_bf16(const float* __restrict__ xrow, const float* __restrict__ g, bf16_t* __restrict__ orow, int lane) {
    const f32x4* xr = (const f32x4*)xrow + lane;
    f32x4 v[4]; float s = 0.f;
#pragma unroll
    for (int j = 0; j < 4; ++j) { v[j] = xr[64 * j]; s += v[j].x * v[j].x + v[j].y * v[j].y + v[j].z * v[j].z + v[j].w * v[j].w; }
    const float rinv = rsqrtf(wave_sum(s) * (1.f / 1024.f) + EPS);
#pragma unroll
    for (int j = 0; j < 4; ++j) {
        const f32x4 gg = ((const f32x4*)g)[lane + 64 * j];
        uint2 o; o.x = pk2(v[j].x * rinv * gg.x, v[j].y * rinv * gg.y); o.y = pk2(v[j].z * rinv * gg.z, v[j].w * rinv * gg.w);
        *(uint2*)(orow + (lane + 64 * j) * 4) = o;
    }
}

__device__ __forceinline__ void phase0(const Params& P, char* smem) {
    char* ws = P.ws;
    float* tile = (float*)smem;
    {
        const int tid = TIDX;
        int it = (int)blockIdx.x;
        f32x4 vcur[4], vnxt[4];
        CtJob jc, jn;
        jc = ct_decode_all(P, min(it, CT_TOTAL - 1)); ct_load(jc, tid, vcur);
        for (; it < CT_TOTAL; it += (int)gridDim.x) {
            const int nx = min(it + (int)gridDim.x, CT_TOTAL - 1);
            jn = ct_decode_all(P, nx); ct_load(jn, tid, vnxt);
            ct_store(tile, jc, tid, vcur);
            jc = jn; vcur[0] = vnxt[0]; vcur[1] = vnxt[1]; vcur[2] = vnxt[2]; vcur[3] = vnxt[3];
        }
    }
    for (int i = blockIdx.x * NTHR + TIDX; i < NL * (NP - NIN) * 512; i += gridDim.x * NTHR) {
        const int l = i / ((NP - NIN) * 512), w = i % ((NP - NIN) * 512);
        ((unsigned*)((bf16_t*)(ws + OFF_WIN) + (size_t)l * NP * 1024 + (size_t)NIN * 1024))[w] = 0u;
    }
    for (int i = blockIdx.x * NTHR + TIDX; i < NL * 48 * 1024; i += gridDim.x * NTHR) {
        const int l = i / (48 * 1024), r = (i / 1024) % 48, k = i & 1023;
        float w = 0.f;
        if (r < 4) w = P.in[I_W_RG][(size_t)l * 4096 + k * 4 + r]; else if (r < 36) w = P.in[I_W_RE][(size_t)l * 32768 + k * 32 + (r - 4)];
        const bf16_t hi = f2bf(w); const bf16_t lo = f2bf(w - bf2f(hi));
        bf16_t* wr = (bf16_t*)(ws + OFF_WR) + (size_t)l * 2 * 48 * 1024;
        wr[r * 1024 + k] = hi; wr[48 * 1024 + r * 1024 + k] = lo;
    }
    const int gw = blockIdx.x * 8 + (TIDX >> 6), ngw = gridDim.x * 8, lane = TIDX & 63;
    for (int row = gw; row < T + NL * 2048; row += ngw) {
        if (row < T) rms_row_bf16(P.in[I_X] + (size_t)row * 1024, P.in[I_NORM_MIX], (bf16_t*)(ws + OFF_HN) + (size_t)row * 1024, lane);
        else { const int r2 = row - T, l = r2 >> 11, rr = r2 & 2047;
               rms_row_bf16(P.in[I_MEM] + (size_t)rr * 1024, P.in[I_NORM_MEMKV] + l * 1024, (bf16_t*)(ws + OFF_MEMN) + (size_t)r2 * 1024, lane); }
    }
}

constexpr int GLD = 80;
constexpr int GEMM_STAGE = (256 + 128) * GLD * 2;
constexpr int GEMM_LDS = 2 * GEMM_STAGE;
template <class RowPtr>
__device__ __forceinline__ void gemm_tile(char* smem, RowPtr rowptr, const bf16_t* __restrict__ Bt, int ldb, int n0, int K, f32x4 (&acc)[4][4]) {
    const int tid = TIDX, lane = tid & 63, wave = tid >> 6, wm = wave >> 1, wn = wave & 1;
    const u32x4* ga[4]; const u32x4* gb[2];
#pragma unroll
    for (int i = 0; i < 4; ++i) { const int c = tid + i * 512, r = c >> 3, ch = c & 7; ga[i] = (const u32x4*)(rowptr(r) + ch * 8); }
#pragma unroll
    for (int i = 0; i < 2; ++i) { const int c = tid + i * 512, r = c >> 3, ch = c & 7; gb[i] = (const u32x4*)(Bt + (size_t)(n0 + r) * ldb + ch * 8); }
#pragma unroll
    for (int m = 0; m < 4; ++m)
#pragma unroll
        for (int n = 0; n < 4; ++n) acc[m][n] = (f32x4){0.f, 0.f, 0.f, 0.f};
    const int nk = K / 64;
    u32x4 raA[4], rbA[2], raB[4], rbB[2];
#define GT_LOAD(RA, RB, kt) { _Pragma("unroll") for (int i = 0; i < 4; ++i) RA[i] = ga[i][(kt) * 8]; _Pragma("unroll") for (int i = 0; i < 2; ++i) RB[i] = gb[i][(kt) * 8]; }
#define GT_STORE(RA, RB, buf) { bf16_t* dA = (bf16_t*)(smem + (buf) * GEMM_STAGE); bf16_t* dB = dA + 256 * GLD; \
        _Pragma("unroll") for (int i = 0; i < 4; ++i) { const int c = tid + i * 512, r = c >> 3, ch = c & 7; *(u32x4*)(dA + r * GLD + ch * 8) = RA[i]; } \
        _Pragma("unroll") for (int i = 0; i < 2; ++i) { const int c = tid + i * 512, r = c >> 3, ch = c & 7; *(u32x4*)(dB + r * GLD + ch * 8) = RB[i]; } }
#define GT_COMPUTE(buf) { const bf16_t* sA = (const bf16_t*)(smem + (buf) * GEMM_STAGE); const bf16_t* sB = sA + 256 * GLD; \
        _Pragma("unroll") for (int kk = 0; kk < 2; ++kk) { bf16x8 af[4], bfr[4]; \
            _Pragma("unroll") for (int m = 0; m < 4; ++m) af[m] = *(const bf16x8*)(sA + (wm * 64 + m * 16 + (lane & 15)) * GLD + kk * 32 + (lane >> 4) * 8); \
            _Pragma("unroll") for (int n = 0; n < 4; ++n) bfr[n] = *(const bf16x8*)(sB + (wn * 64 + n * 16 + (lane & 15)) * GLD + kk * 32 + (lane >> 4) * 8); \
            _Pragma("unroll") for (int m = 0; m < 4; ++m) _Pragma("unroll") for (int n = 0; n < 4; ++n) acc[m][n] = __builtin_amdgcn_mfma_f32_16x16x32_bf16(bfr[n], af[m], acc[m][n], 0, 0, 0); } }
    GT_LOAD(raA, rbA, 0)
    GT_LOAD(raB, rbB, 1)
    __syncthreads();
    GT_STORE(raA, rbA, 0)
    __syncthreads();
    for (int kt = 0; kt < nk; kt += 2) {
        if (kt + 2 < nk) GT_LOAD(raA, rbA, kt + 2)
        GT_COMPUTE(0)
        GT_STORE(raB, rbB, 1)
        __syncthreads();
        if (kt + 3 < nk) GT_LOAD(raB, rbB, kt + 3)
        GT_COMPUTE(1)
        if (kt + 2 < nk) GT_STORE(raA, rbA, 0)
        __syncthreads();
    }
#undef GT_LOAD
#undef GT_STORE
#undef GT_COMPUTE
}
struct RowDirect { const bf16_t* A; int lda; int m0; __device__ __forceinline__ const bf16_t* operator()(int r) const { return A + (size_t)(m0 + r) * lda; } };
enum { EPI_INPROJ = 0, EPI_RESID = 1, EPI_BF16 = 2, EPI_BF16_RS = 3, EPI_RESID_NORM = 4 };

__device__ __forceinline__ int vcu_id() { const int G = gridDim.x, bx = blockIdx.x; return (G % 8 == 0) ? (bx % 8) * (G / 8) + bx / 8 : bx; }

template <int EPI>
__device__ __forceinline__ void gemm_phase(char* smem, const bf16_t* A, int lda, const bf16_t* Bt, int ldb, int M, int N, int K, void* out, int ldo, const float* resid, float* gates, int idx0 = -1, int stride = 0, bf16_t* xg = nullptr, const float* gn = nullptr) {
    const int ntn = N / 128, ntiles = (M / 256) * ntn;
    if (stride == 0) { idx0 = vcu_id(); stride = gridDim.x; }
    if (idx0 < 0) return;
    const int lane = TIDX & 63, wave = TIDX >> 6, wm = wave >> 1, wn = wave & 1;
    for (int tIdx = idx0; tIdx < ntiles; tIdx += stride) {
        const int m0 = (tIdx / ntn) * 256, n0 = (tIdx % ntn) * 128;
        f32x4 acc[4][4];
        RowDirect rp{A, lda, m0};
        gemm_tile(smem, rp, Bt, ldb, n0, K, acc);
        float rsc[4] = {1.f, 1.f, 1.f, 1.f};
        if (EPI == EPI_BF16_RS) {
#pragma unroll
            for (int m = 0; m < 4; ++m) rsc[m] = rinv_from_pss(resid, (size_t)(m0 + wm * 64 + m * 16 + (lane & 15)));
        }
        if (EPI == EPI_RESID_NORM) {
#pragma unroll
            for (int m = 0; m < 4; ++m) {
                const int row = m0 + wm * 64 + m * 16 + (lane & 15);
                float ss = 0.f;
#pragma unroll
                for (int n = 0; n < 4; ++n) {
                    const int col = n0 + wn * 64 + n * 16 + (lane >> 4) * 4;
                    const f32x4 o = *(const f32x4*)(resid + (size_t)row * ldo + col) + acc[m][n];
                    *(f32x4*)((float*)out + (size_t)row * ldo + col) = o;
                    ss += (o[0] * o[0] + o[1] * o[1]) + (o[2] * o[2] + o[3] * o[3]);
                    const f32x4 og = o * *(const f32x4*)(gn + col);
                    uint2 w; w.x = pk2(og[0], og[1]); w.y = pk2(og[2], og[3]);
                    *(uint2*)(xg + (size_t)row * ldo + col) = w;
                }
                ss += __shfl_xor(ss, 16); ss += __shfl_xor(ss, 32);
                if ((lane >> 4) == 0) gates[(size_t)row * 16 + (n0 >> 7) * 2 + wn] = ss;
            }
            continue;
        }
#pragma unroll
        for (int m = 0; m < 4; ++m)
#pragma unroll
            for (int n = 0; n < 4; ++n) {
                const int row = m0 + wm * 64 + m * 16 + (lane & 15), col = n0 + wn * 64 + n * 16 + (lane >> 4) * 4;
                const f32x4 v = acc[m][n];
                if (EPI == EPI_INPROJ) {
                    uint2 o; o.x = pk2(v.x, v.y); o.y = pk2(v.z, v.w);
                    *(uint2*)((bf16_t*)out + (size_t)row * ldo + col) = o;
                    if (col >= C_GATE && col < C_GATE + 16) *(f32x4*)(gates + (size_t)row * 16 + (col - C_GATE)) = v;
                } else if (EPI == EPI_RESID) {
                    const f32x4 r = *(const f32x4*)(resid + (size_t)row * ldo + col);
                    *(f32x4*)((float*)out + (size_t)row * ldo + col) = r + v;
                } else if (EPI == EPI_BF16_RS) {
                    const float ri = rsc[m];
                    uint2 o; o.x = pk2(v.x * ri, v.y * ri); o.y = pk2(v.z * ri, v.w * ri);
                    *(uint2*)((bf16_t*)out + (size_t)row * ldo + col) = o;
                } else {
                    uint2 o; o.x = pk2(v.x, v.y); o.y = pk2(v.z, v.w);
                    *(uint2*)((bf16_t*)out + (size_t)row * ldo + col) = o;
                }
            }
    }
}


namespace pg8 {
#define PG8_LAS __attribute__((address_space(3)))
typedef unsigned short bf16_t;
typedef short bf16x8 __attribute__((ext_vector_type(8)));
typedef float f32x4 __attribute__((ext_vector_type(4)));
typedef unsigned u32x4 __attribute__((ext_vector_type(4)));
constexpr int BM = 256, BK = 64, HALF = 128, HTB = HALF * BK * 2  , STAGE_BYTES = 8 * HTB, NXCD = 8, WGM = 8;

__host__ __device__ __forceinline__ int lds_byte(int r, int c) { const int st = (r >> 4) * 2 + (c >> 5), rr = r & 15, cc = c & 31, ob = rr * 64 + cc * 2; return st * 1024 + (ob ^ (((ob >> 9) & 1) << 5)); }
__host__ __device__ __forceinline__ void stage_rc(int b, int& R, int& C) { const int st = b / 1024, sb = b % 1024, swz = sb ^ (((sb >> 9) & 1) << 5); R = (st >> 1) * 16 + swz / 64; C = (st & 1) * 32 + (swz % 64) / 2; }
__host__ __device__ __forceinline__ int perm32(int rho) { const int n = rho >> 4, i = rho & 15; return 8 * (i >> 2) + 4 * n + (i & 3); }

struct Unit { int pm, pn; };
struct Gemm { const bf16_t* A; const bf16_t* Bt; int M, N, K; };

struct StaticOrder {
    int nM, nN, nwg, G, c;
    __host__ __device__ void init(int M, int N, int G_, int c_) { nM = M / BM; nN = N / BM; nwg = nM * nN; G = G_; c = c_; }
    __host__ __device__ bool next(int i, Unit& u) const {
        const long L = (long)i * G + c; if (L >= nwg) return false;
        int wgid = (int)L; { const int q = nwg / NXCD, r = nwg % NXCD, xcd = wgid % NXCD, off = wgid / NXCD; wgid = (xcd < r ? xcd * (q + 1) : r * (q + 1) + (xcd - r) * q) + off; }
        const int nig = WGM * nN, gid = wgid / nig, fm = gid * WGM, gsz = (nM - fm) < WGM ? (nM - fm) : WGM;
        u.pm = fm + ((wgid % nig) % gsz); u.pn = (wgid % nig) / gsz; return true;
    }
    __device__ __forceinline__ void a_ready(const Unit&) const {}
    __device__ __forceinline__ void done(const Unit&) const {}
    __device__ __forceinline__ size_t boff(const Unit&) const { return 0; }
};
struct MoeOrder {
    const int* blk2e;
    int nunits, G, c; size_t estride;
    __device__ __forceinline__ bool next(int i, Unit& u) const { const int L = i * G + c; if (L >= nunits) return false; u.pm = L >> 2; u.pn = L & 3; return true; }
    __device__ __forceinline__ void a_ready(const Unit&) const {}
    __device__ __forceinline__ void done(const Unit&) const {}
    __device__ __forceinline__ size_t boff(const Unit& u) const { return (size_t)__builtin_amdgcn_readfirstlane(blk2e[u.pm]) * estride; }
};
__device__ __forceinline__ unsigned cvt_pk_bf16(float lo, float hi) { unsigned r; asm volatile("v_cvt_pk_bf16_f32 %0, %1, %2" : "=v"(r) : "v"(lo), "v"(hi)); return r; }
typedef float f32x2 __attribute__((ext_vector_type(2)));

struct EpiBf16P {
    static constexpr bool PERM = true, AFTER_DRAIN = false;
    bf16_t* O; int ldc;
    __device__ __forceinline__ void operator()(const f32x4 (&acc)[2][2][4][2], const Unit& u, int wr, int wc, int fr, int fq) const {
        const int row0 = u.pm * BM + wr * 64 + fr, col0 = u.pn * BM + wc * 32 + 8 * fq;
#pragma unroll
        for (int ai = 0; ai < 2; ++ai)
#pragma unroll
            for (int m = 0; m < 4; ++m) {
                bf16_t* rowp = O + (size_t)(row0 + ai * HALF + m * 16) * ldc + col0;
#pragma unroll
                for (int bj = 0; bj < 2; ++bj) {
                    const f32x4 v0 = acc[ai][bj][m][0], v1 = acc[ai][bj][m][1];
                    u32x4 w; w.x = cvt_pk_bf16(v0[0], v0[1]); w.y = cvt_pk_bf16(v0[2], v0[3]); w.z = cvt_pk_bf16(v1[0], v1[1]); w.w = cvt_pk_bf16(v1[2], v1[3]);
                    *(u32x4*)(rowp + bj * HALF) = w;
                }
            }
    }
};
struct EpiInProj {
    static constexpr bool PERM = true, AFTER_DRAIN = false;
    bf16_t* O; int ldc; float* gates; int gate_col;
    __device__ __forceinline__ void operator()(const f32x4 (&acc)[2][2][4][2], const Unit& u, int wr, int wc, int fr, int fq) const {
        const int row0 = u.pm * BM + wr * 64 + fr, col0 = u.pn * BM + wc * 32 + 8 * fq;
#pragma unroll
        for (int ai = 0; ai < 2; ++ai)
#pragma unroll
            for (int m = 0; m < 4; ++m) {
                const int row = row0 + ai * HALF + m * 16;
                bf16_t* rowp = O + (size_t)row * ldc + col0;
#pragma unroll
                for (int bj = 0; bj < 2; ++bj) {
                    const f32x4 v0 = acc[ai][bj][m][0], v1 = acc[ai][bj][m][1];
                    u32x4 w; w.x = cvt_pk_bf16(v0[0], v0[1]); w.y = cvt_pk_bf16(v0[2], v0[3]); w.z = cvt_pk_bf16(v1[0], v1[1]); w.w = cvt_pk_bf16(v1[2], v1[3]);
                    *(u32x4*)(rowp + bj * HALF) = w;
                    const int gc = col0 + bj * HALF - gate_col;
                    if (gates && gc >= 0 && gc < 16) { *(f32x4*)(gates + (size_t)row * 16 + gc) = v0; *(f32x4*)(gates + (size_t)row * 16 + gc + 4) = v1; }
                }
            }
    }
};
struct EpiResid {
    static constexpr bool PERM = false, AFTER_DRAIN = false;
    const float* base; float* out; int ldc;
    __device__ __forceinline__ void operator()(const f32x4 (&acc)[2][2][4][2], const Unit& u, int wr, int wc, int fr, int fq) const {
        const int col0 = u.pn * BM + wc * 32 + 4 * fq;
#pragma unroll
        for (int ai = 0; ai < 2; ++ai)
#pragma unroll
            for (int m = 0; m < 4; ++m) {
                const size_t off = (size_t)(u.pm * BM + ai * HALF + wr * 64 + m * 16 + fr) * ldc + col0;
#pragma unroll
                for (int bj = 0; bj < 2; ++bj)
#pragma unroll
                    for (int n = 0; n < 2; ++n) { const f32x4 bs = *(const f32x4*)(base + off + bj * HALF + n * 16); *(f32x4*)(out + off + bj * HALF + n * 16) = bs + acc[ai][bj][m][n]; }
                if (m & 1) asm volatile("" ::: "memory");
            }
    }
};

template <bool BASE_BF16>
struct EpiResidNorm {
    static constexpr bool PERM = false, AFTER_DRAIN = false;
    const void* base; bf16_t* out; int ldc; float* pss;
    __device__ __forceinline__ void operator()(const f32x4 (&acc)[2][2][4][2], const Unit& u, int wr, int wc, int fr, int fq) const {
        const int col0 = u.pn * BM + wc * 32 + 4 * fq;
#pragma unroll
        for (int ai = 0; ai < 2; ++ai)
#pragma unroll
            for (int m = 0; m < 4; ++m) {
                const int row = u.pm * BM + ai * HALF + wr * 64 + m * 16 + fr;
                const size_t off = (size_t)row * ldc + col0;
                float ss = 0.f;
#pragma unroll
                for (int bj = 0; bj < 2; ++bj)
#pragma unroll
                    for (int n = 0; n < 2; ++n) {
                        f32x4 bs;
                        if (BASE_BF16) { const uint2 r = *(const uint2*)((const bf16_t*)base + off + bj * HALF + n * 16);
                            bs = (f32x4){__uint_as_float(r.x << 16), __uint_as_float(r.x & 0xffff0000u), __uint_as_float(r.y << 16), __uint_as_float(r.y & 0xffff0000u)}; }
                        else bs = *(const f32x4*)((const float*)base + off + bj * HALF + n * 16);
                        const f32x4 o = bs + acc[ai][bj][m][n];
                        ss += (o[0] * o[0] + o[1] * o[1]) + (o[2] * o[2] + o[3] * o[3]);
                        uint2 w; w.x = cvt_pk_bf16(o[0], o[1]); w.y = cvt_pk_bf16(o[2], o[3]);
                        *(uint2*)(out + off + bj * HALF + n * 16) = w;
                    }
                ss += __shfl_xor(ss, 16); ss += __shfl_xor(ss, 32);
                if (fq == 0) pss[(size_t)row * 16 + u.pn * 4 + wc] = ss;
                if (m & 1) asm volatile("" ::: "memory");
            }
    }
};
template <class Epi, class Sched, bool ALIGN_EPI = false, bool SP2 = false>
__device__ __forceinline__ void gemm_phase(PG8_LAS unsigned char* lds, const Gemm g, const Sched& S, const Epi& E) {
    const int tid = TIDX, wid = __builtin_amdgcn_readfirstlane(tid >> 6), lane = tid & 63, wr = wid >> 2, wc = wid & 3, fr = lane & 15, fq = lane >> 4;
    const int K = g.K, nt = K / BK;
    unsigned voffA[2], voffB[2];
#pragma unroll
    for (int i = 0; i < 2; ++i) { int R, C; stage_rc(tid * 16 + i * 8192, R, C); const int Rb = Epi::PERM ? ((R & ~31) + perm32(R & 31)) : R;
        voffA[i] = (unsigned)(R * K + C) * 2u; voffB[i] = (unsigned)(Rb * K + C) * 2u; }
    const size_t kstep = (size_t)(BK * 2);
    const size_t hstep = (size_t)HALF * K * 2;
    const size_t tstep = 2 * hstep;
    const unsigned ldsw = (unsigned)wid * 1024u;
    const int aoff = lds_byte(wr * 64 + fr, fq * 8), boff = lds_byte(wc * 32 + fr, fq * 8);
#define PG8_SA(b, h) (((b) * 2 + (h)) * HTB)
#define PG8_SB(b, h) ((4 + (b) * 2 + (h)) * HTB)
#define PG8_STAGE(bufoff, gbase, voff) do { _Pragma("unroll") for (int _i = 0; _i < 2; ++_i) \
        __builtin_amdgcn_global_load_lds((const unsigned*)((const char*)(gbase) + (voff)[_i]), (PG8_LAS unsigned*)(lds + (bufoff) + ldsw + _i * 8192), 16, 0, 0); } while (0)
#define PG8_LDA(dst, b, h) do { _Pragma("unroll") for (int m = 0; m < 4; ++m) _Pragma("unroll") for (int k = 0; k < 2; ++k) dst[m][k] = *(const PG8_LAS bf16x8*)(lds + PG8_SA(b, h) + aoff + m * 2048 + k * 1024); } while (0)
#define PG8_LDB(dst, b, h) do { _Pragma("unroll") for (int n = 0; n < 2; ++n) _Pragma("unroll") for (int k = 0; k < 2; ++k) dst[n][k] = *(const PG8_LAS bf16x8*)(lds + PG8_SB(b, h) + boff + n * 2048 + k * 1024); } while (0)
#define PG8_MMA(ai, bj, At, Bt) do { __builtin_amdgcn_s_setprio(1); _Pragma("unroll") for (int m = 0; m < 4; ++m) _Pragma("unroll") for (int n = 0; n < 2; ++n) _Pragma("unroll") for (int k = 0; k < 2; ++k) \
        acc[ai][bj][m][n] = __builtin_amdgcn_mfma_f32_16x16x32_bf16(Bt[n][k], At[m][k], acc[ai][bj][m][n], 0, 0, 0); __builtin_amdgcn_s_setprio(0); } while (0)
#define PG8_WAIT_V(n) asm volatile("s_waitcnt vmcnt(" #n ")" ::: "memory")
#define PG8_WAIT_L(n) asm volatile("s_waitcnt lgkmcnt(" #n ")" ::: "memory")
#define PG8_BAR __builtin_amdgcn_s_barrier()
#define PG8_SCHED __builtin_amdgcn_sched_barrier(0)
    Unit cur, nxt; int ui = 0;
    if (!S.next(0, cur)) return;
    f32x4 acc[2][2][4][2];
#pragma unroll
    for (int a = 0; a < 2; ++a)
#pragma unroll
        for (int b = 0; b < 2; ++b)
#pragma unroll
            for (int m = 0; m < 4; ++m)
#pragma unroll
                for (int n = 0; n < 2; ++n) acc[a][b][m][n] = (f32x4){0.f, 0.f, 0.f, 0.f};
    bf16x8 At[4][2], B0[2][2], B1[2][2];
    const char* cA = (const char*)g.A + (size_t)cur.pm * tstep; const char* cB = (const char*)g.Bt + (size_t)cur.pn * tstep + S.boff(cur);
    S.a_ready(cur);
    if constexpr (SP2) {
        PG8_STAGE(PG8_SB(0, 0), cB, voffB); PG8_STAGE(PG8_SB(0, 1), cB + hstep, voffB); PG8_STAGE(PG8_SA(0, 0), cA, voffA); PG8_STAGE(PG8_SA(0, 1), cA + hstep, voffA);
        if (wr == 1) PG8_BAR;
        PG8_WAIT_V(2); PG8_BAR;
        PG8_STAGE(PG8_SB(1, 0), cB + kstep, voffB); PG8_STAGE(PG8_SA(1, 0), cA + kstep, voffA); PG8_STAGE(PG8_SB(1, 1), cB + hstep + kstep, voffB);
        PG8_WAIT_V(6); PG8_BAR;
    } else {
        PG8_STAGE(PG8_SB(0, 0), cB, voffB); PG8_STAGE(PG8_SA(0, 0), cA, voffA); PG8_STAGE(PG8_SB(0, 1), cB + hstep, voffB); PG8_STAGE(PG8_SA(0, 1), cA + hstep, voffA);
        if (wr == 1) PG8_BAR;
        PG8_WAIT_V(4); PG8_BAR;
        PG8_STAGE(PG8_SB(1, 0), cB + kstep, voffB); PG8_STAGE(PG8_SA(1, 0), cA + kstep, voffA); PG8_STAGE(PG8_SB(1, 1), cB + hstep + kstep, voffB);
        PG8_WAIT_V(6); PG8_BAR;
    }
    for (;;) {
        const bool has_next = S.next(ui + 1, nxt);
        const char* nA = has_next ? (const char*)g.A + (size_t)nxt.pm * tstep : cA; const char* nB = has_next ? (const char*)g.Bt + (size_t)nxt.pn * tstep + S.boff(nxt) : cB;
        for (int t = 0; t < nt; t += 2) {
            const bool last = (t == nt - 2);
            const char* a1 = cA + (size_t)(t + 1) * kstep;
            const char* a2 = last ? nA : cA + (size_t)(t + 2) * kstep; const char* b2 = last ? nB : cB + (size_t)(t + 2) * kstep;
            const char* a3 = a2 + kstep; const char* b3 = b2 + kstep;
            if (last && has_next) S.a_ready(nxt);
            if constexpr (SP2) {
            PG8_LDB(B0, 0, 0); PG8_LDB(B1, 0, 1); PG8_SCHED; PG8_LDA(At, 0, 0); PG8_STAGE(PG8_SA(1, 1), a1 + hstep, voffA);
            PG8_WAIT_V(8); PG8_WAIT_L(0); PG8_BAR; PG8_MMA(0, 0, At, B0); PG8_MMA(0, 1, At, B1); PG8_BAR; PG8_SCHED;
            PG8_LDA(At, 0, 1); PG8_STAGE(PG8_SB(0, 0), b2, voffB); PG8_STAGE(PG8_SB(0, 1), b2 + hstep, voffB); PG8_STAGE(PG8_SA(0, 0), a2, voffA);
            PG8_WAIT_V(8); PG8_WAIT_L(0); PG8_BAR; PG8_MMA(1, 0, At, B0); PG8_MMA(1, 1, At, B1); PG8_BAR; PG8_SCHED;
            PG8_LDB(B0, 1, 0); PG8_LDB(B1, 1, 1); PG8_SCHED; PG8_LDA(At, 1, 0); PG8_STAGE(PG8_SA(0, 1), a2 + hstep, voffA);
            PG8_WAIT_V(8); PG8_WAIT_L(0); PG8_BAR; PG8_MMA(0, 0, At, B0); PG8_MMA(0, 1, At, B1); PG8_BAR; PG8_SCHED;
            PG8_LDA(At, 1, 1); PG8_STAGE(PG8_SB(1, 0), b3, voffB); PG8_STAGE(PG8_SB(1, 1), b3 + hstep, voffB); PG8_STAGE(PG8_SA(1, 0), a3, voffA);
            PG8_WAIT_V(8); PG8_WAIT_L(0); PG8_BAR; PG8_MMA(1, 0, At, B0); PG8_MMA(1, 1, At, B1); PG8_BAR; PG8_SCHED;
            } else {
            PG8_LDB(B0, 0, 0); PG8_SCHED; PG8_LDA(At, 0, 0); PG8_STAGE(PG8_SA(1, 1), a1 + hstep, voffA);
            PG8_WAIT_L(8); PG8_BAR; PG8_WAIT_L(0); PG8_MMA(0, 0, At, B0); PG8_BAR; PG8_SCHED;
            PG8_LDB(B1, 0, 1); PG8_STAGE(PG8_SB(0, 0), b2, voffB);
            PG8_BAR; PG8_WAIT_L(0); PG8_MMA(0, 1, At, B1); PG8_BAR;
            PG8_LDA(At, 0, 1); PG8_STAGE(PG8_SA(0, 0), a2, voffA);
            PG8_BAR; PG8_WAIT_L(0); PG8_MMA(1, 0, At, B0); PG8_BAR; PG8_SCHED;
            PG8_STAGE(PG8_SB(0, 1), b2 + hstep, voffB);
            PG8_WAIT_V(6); PG8_BAR; PG8_MMA(1, 1, At, B1); PG8_BAR;
            PG8_LDB(B0, 1, 0); PG8_SCHED; PG8_LDA(At, 1, 0); PG8_STAGE(PG8_SA(0, 1), a2 + hstep, voffA);
            PG8_WAIT_L(8); PG8_BAR; PG8_WAIT_L(0); PG8_MMA(0, 0, At, B0); PG8_BAR; PG8_SCHED;
            PG8_LDB(B1, 1, 1); PG8_STAGE(PG8_SB(1, 0), b3, voffB);
            PG8_BAR; PG8_WAIT_L(0); PG8_MMA(0, 1, At, B1); PG8_BAR;
            PG8_LDA(At, 1, 1); PG8_STAGE(PG8_SA(1, 0), a3, voffA);
            PG8_BAR; PG8_WAIT_L(0); PG8_MMA(1, 0, At, B0); PG8_BAR; PG8_SCHED;
            PG8_STAGE(PG8_SB(1, 1), b3 + hstep, voffB);
            PG8_WAIT_V(6); PG8_BAR; PG8_MMA(1, 1, At, B1); PG8_BAR;
            }
        }
        if constexpr (ALIGN_EPI) { if (wr == 0) PG8_BAR; }
        if constexpr (!Epi::AFTER_DRAIN) { E(acc, cur, wr, wc, fr, fq); S.done(cur); }
        if (!has_next) break;
#pragma unroll
        for (int a = 0; a < 2; ++a)
#pragma unroll
            for (int b = 0; b < 2; ++b)
#pragma unroll
                for (int m = 0; m < 4; ++m)
#pragma unroll
                    for (int n = 0; n < 2; ++n) acc[a][b][m][n] = (f32x4){0.f, 0.f, 0.f, 0.f};
        cur = nxt; cA = nA; cB = nB; ++ui;
        if constexpr (ALIGN_EPI) { if (wr == 1) PG8_BAR; }
    }
    PG8_WAIT_V(0);
    if constexpr (!ALIGN_EPI) { if (wr == 0) PG8_BAR; }
    PG8_BAR;
    if constexpr (Epi::AFTER_DRAIN) { E.fused(acc, cur, wr, wc, fr, fq, lds, wid, lane); S.done(cur); }
#undef PG8_SA
#undef PG8_SB
#undef PG8_STAGE
#undef PG8_LDA
#undef PG8_LDB
#undef PG8_MMA
#undef PG8_WAIT_V
#undef PG8_WAIT_L
#undef PG8_BAR
#undef PG8_SCHED
}
}

struct RowGather { const bf16_t* A; int lda; const int* ids; int shift; __device__ __forceinline__ const bf16_t* operator()(int r) const { return A + (size_t)(ids[r] >> shift) * lda; } };
__device__ __forceinline__ void moe_flag_signal(unsigned* ctr) {
    asm volatile("s_waitcnt vmcnt(0)" ::: "memory");
    __syncthreads();
    if (TIDX == 0) {
        __builtin_amdgcn_fence(__ATOMIC_RELEASE, "agent");
        asm volatile("s_waitcnt vmcnt(0)" ::: "memory");
        (void)__hip_atomic_fetch_add(ctr, 1u, __ATOMIC_RELAXED, __HIP_MEMORY_SCOPE_AGENT);
    }
}
template <int STAGE>
__device__ __forceinline__ void moe_phase(char* smem, const bf16_t* A, int lda, const bf16_t* Wt, size_t wstride, int ldb, int K, const int* cnt, const int* list, const float* pgate, bf16_t* out, const float* pss, int* rowpos, unsigned* flA, unsigned* flB, const float* prinv) {
    int* ids = (int*)(smem + GEMM_LDS);
    int* tpre = ids + 256;
    constexpr int NTN = (STAGE == 1) ? 4 : 8;
    __syncthreads();
    if (TIDX < 64) {
        const int ln = TIDX; int nt = (ln < NEXP) ? ((cnt[ln * CNT_STRIDE] + 255) >> 8) : 0; int inc = nt;
#pragma unroll
        for (int o = 1; o < 64; o <<= 1) { const int nb = __shfl_up(inc, o); if (ln >= o) inc += nb; }
        if (ln <= NEXP) tpre[ln] = inc - nt;
    }
    __syncthreads();
    const int ntiles = tpre[NEXP] * NTN;
    const int lane = TIDX & 63, wave = TIDX >> 6, wm = wave >> 1, wn = wave & 1;
    int ndone = 0;
    for (int tIdx = vcu_id(); tIdx < ntiles; tIdx += gridDim.x) {
        const int mtg = tIdx / NTN, n0 = (tIdx % NTN) * 128;
        int e = 0;
        for (int i = 1; i < NEXP; ++i) if (tpre[i] <= mtg) e = i;
        const int mt = mtg - tpre[e];
        const int cn = cnt[e * CNT_STRIDE];
        __syncthreads();
        if (TIDX < 256) { const int pos = mt * 256 + TIDX; ids[TIDX] = list[(size_t)e * T + (pos < cn ? pos : cn - 1)]; }
        __syncthreads();
        f32x4 acc[4][4];
        RowGather rp{A, lda, ids, STAGE == 1 ? 1 : 0};
        float gtv[4], riv[4];
#pragma unroll
        for (int m = 0; m < 4; ++m) { const int pid_ = ids[wm * 64 + m * 16 + (lane & 15)]; gtv[m] = pgate[pid_]; riv[m] = (STAGE == 1) ? prinv[pid_] : 1.f; }
        gemm_tile(smem, rp, Wt + (size_t)e * wstride, ldb, n0, K, acc);
#pragma unroll
        for (int m = 0; m < 4; ++m) {
            const int rl = wm * 64 + m * 16 + (lane & 15);
            if (mt * 256 + rl >= cn) continue;
            const int pid = ids[rl];
            if (STAGE == 1) {
                const float gt = gtv[m], ri = riv[m];
                if (n0 == 0 && wn == 0 && (lane >> 4) == 0) rowpos[pid] = mtg * 256 + rl;
#pragma unroll
                for (int np = 0; np < 2; ++np) {
                    const f32x4 g = acc[m][2 * np], u = acc[m][2 * np + 1];
                    const int j = (n0 + wn * 64 + np * 32) / 2 + (lane >> 4) * 4;
                    const f32x4 gs = g * ri; const float ug = ri * gt;
                    uint2 o; o.x = pk2(siluf_(gs.x) * u.x * ug, siluf_(gs.y) * u.y * ug); o.y = pk2(siluf_(gs.z) * u.z * ug, siluf_(gs.w) * u.w * ug);
                    *(uint2*)(out + (size_t)(mtg * 256 + rl) * DEXP + j) = o;
                }
            } else {
#pragma unroll
                for (int n = 0; n < 4; ++n) {
                    const f32x4 v = acc[m][n]; const int col = n0 + wn * 64 + n * 16 + (lane >> 4) * 4;
                    uint2 o; o.x = pk2(v.x, v.y); o.y = pk2(v.z, v.w);
                    *(uint2*)(out + (size_t)pid * 1024 + col) = o;
                }
            }
        }
        ++ndone;
        if (STAGE == 1) { if (ndone == 2) moe_flag_signal(flA); else if (ndone == 3) moe_flag_signal(flB); }
    }
    if (STAGE == 1 && ndone < 2) moe_flag_signal(flA);
}

__device__ __forceinline__ void hgrn2_naive(const bf16_t* __restrict__ proj, const float* __restrict__ hgrn_lb, int layer, const float* __restrict__ mix_gain, bf16_t* __restrict__ y, int bh, int lane) {
    const int b = bh >> 2, h = bh & 3;
    float lbk = 0.f;
    if (layer == 1) { float a0 = hgrn_lb[h * 64 + lane], a1 = hgrn_lb[256 + h * 64 + lane]; lbk = 1.f / (1.f + __expf(a0 - a1)); }
    const float mg = mix_gain[C_AQ + h * 64 + lane];
    float S[64];
#pragma unroll
    for (int k = 0; k < 64; ++k) S[k] = 0.f;
    for (int t = 0; t < SEQ; ++t) {
        const bf16_t* pr = proj + (size_t)(b * SEQ + t) * NP + h * 64 + lane;
        const float qk = siluf_(bf2f(pr[C_AQ]));
        const float sg = sigmoidf_(bf2f(pr[C_AF]));
        const float f = lbk + (1.f - lbk) * sg, kk = (1.f - lbk) * (1.f - sg);
        const float iv = bf2f(pr[C_AI]);
        const float gv = bf2f(pr[C_AG]);
        float o = 0.f;
#pragma unroll
        for (int k = 0; k < 64; ++k) { S[k] = rdlane(f, k) * S[k] + rdlane(kk, k) * iv; o += rdlane(qk, k) * S[k]; }
        const float ms = wave_sum(o * o) * (1.f / 64.f);
        const float yv = o * rsqrtf(ms + EPS) * siluf_(gv) * mg;
        y[(size_t)(b * SEQ + t) * 1024 + 0 + h * 64 + lane] = f2bf(yv);
    }
}
__device__ __forceinline__ void gdn_naive(const bf16_t* __restrict__ proj, const float* __restrict__ gates, const float* __restrict__ conv_w  ,
                                          const float* __restrict__ a_log, const float* __restrict__ dt_bias, const float* __restrict__ mix_gain, bf16_t* __restrict__ y, int bh, int lane) {
    const int b = bh >> 2, h = bh & 3;
    float wq[4], wk[4], wv[4];
#pragma unroll
    for (int j = 0; j < 4; ++j) { wq[j] = conv_w[j * 768 + h * 64 + lane]; wk[j] = conv_w[j * 768 + 256 + h * 64 + lane]; wv[j] = conv_w[j * 768 + 512 + h * 64 + lane]; }
    float xq[3] = {0.f, 0.f, 0.f}, xk[3] = {0.f, 0.f, 0.f}, xv[3] = {0.f, 0.f, 0.f};
    const float Aexp = __expf(a_log[h]), dtb = dt_bias[h];
    const float mg = mix_gain[768 + h * 64 + lane];
    float S[64];
#pragma unroll
    for (int k = 0; k < 64; ++k) S[k] = 0.f;
    for (int t = 0; t < SEQ; ++t) {
        const size_t row = (size_t)(b * SEQ + t);
        const bf16_t* pr = proj + row * NP + h * 64 + lane;
        const float q0 = bf2f(pr[C_DQ]), k0 = bf2f(pr[C_DK]), v0 = bf2f(pr[C_DV]), zv = bf2f(pr[C_DZ]);
        float q = siluf_(wq[0] * xq[0] + wq[1] * xq[1] + wq[2] * xq[2] + wq[3] * q0);
        float k = siluf_(wk[0] * xk[0] + wk[1] * xk[1] + wk[2] * xk[2] + wk[3] * k0);
        float v = siluf_(wv[0] * xv[0] + wv[1] * xv[1] + wv[2] * xv[2] + wv[3] * v0);
        xq[0] = xq[1]; xq[1] = xq[2]; xq[2] = q0; xk[0] = xk[1]; xk[1] = xk[2]; xk[2] = k0; xv[0] = xv[1]; xv[1] = xv[2]; xv[2] = v0;
        q = q * rsqrtf(wave_sum(q * q) + EPS) * 0.125f;
        k = k * rsqrtf(wave_sum(k * k) + EPS);
        const float beta = sigmoidf_(gates[row * 16 + 4 + h]);
        const float g = -Aexp * softplusf_(gates[row * 16 + 8 + h] + dtb);
        const float eg = __expf(g);
        float r = 0.f;
#pragma unroll
        for (int i = 0; i < 64; ++i) { S[i] *= eg; r += rdlane(k, i) * S[i]; }
        const float dlt = beta * (v - r);
        float o = 0.f;
#pragma unroll
        for (int i = 0; i < 64; ++i) { S[i] += rdlane(k, i) * dlt; o += rdlane(q, i) * S[i]; }
        const float ms = wave_sum(o * o) * (1.f / 64.f);
        const float yv = o * rsqrtf(ms + EPS) * siluf_(zv) * mg;
        y[row * 1024 + 768 + h * 64 + lane] = f2bf(yv);
    }
}
__device__ __forceinline__ void fox_cumsum(const float* __restrict__ gates, const float* __restrict__ fb, float* __restrict__ cc, int bh, int lane) {
    const int b = bh >> 2, h = bh & 3;
    const float bias = fb[h];
    float v[32];
#pragma unroll
    for (int i = 0; i < 32; ++i) v[i] = gates[(size_t)(b * SEQ + lane * 32 + i) * 16 + h];
    float run = 0.f;
#pragma unroll
    for (int i = 0; i < 32; ++i) { run += logsigmoidf_(v[i] + bias); v[i] = run; }
    float tot = run;
#pragma unroll
    for (int o = 1; o < 64; o <<= 1) { const float nb = __shfl_up(tot, o); if (lane >= o) tot += nb; }
    const float off = tot - run;
    float* dst = cc + (size_t)(b * 4 + h) * SEQ + lane * 32;
#pragma unroll
    for (int i = 0; i < 32; i += 4) *(f32x4*)(dst + i) = (f32x4){v[i] + off, v[i + 1] + off, v[i + 2] + off, v[i + 3] + off};
}
__device__ __forceinline__ void fox_cumsum_block(char* smem, const float* __restrict__ gates, const float* __restrict__ fb, float* __restrict__ cc, int bh) {
    const int tid = TIDX, lane = tid & 63, wave = tid >> 6, b = bh >> 2, h = bh & 3;
    float* sW = (float*)smem;
    const float bias = fb[h];
    float v[4];
#pragma unroll
    for (int i = 0; i < 4; ++i) v[i] = gates[(size_t)(b * SEQ + tid * 4 + i) * 16 + h];
    float run = 0.f;
#pragma unroll
    for (int i = 0; i < 4; ++i) { run += logsigmoidf_(v[i] + bias); v[i] = run; }
    float tot = run;
#pragma unroll
    for (int o = 1; o < 64; o <<= 1) { const float nb = __shfl_up(tot, o); if (lane >= o) tot += nb; }
    const float off = tot - run;
    __syncthreads();
    if (lane == 63) sW[wave] = tot;
    __syncthreads();
    float woff = 0.f;
    for (int w = 0; w < wave; ++w) woff += sW[w];
    const float o2 = off + woff;
    *(f32x4*)(cc + (size_t)(b * 4 + h) * SEQ + tid * 4) = (f32x4){v[0] + o2, v[1] + o2, v[2] + o2, v[3] + o2};
}
__device__ __forceinline__ void lru_prep_task(float* xc  , const bf16_t* __restrict__ proj, const float* __restrict__ conv_w, const float* __restrict__ conv_b,
                                              const float* __restrict__ w_a, const float* __restrict__ b_a, const float* __restrict__ w_x, const float* __restrict__ b_x,
                                              const float* __restrict__ lam, float* __restrict__ a_out, float* __restrict__ u_out, int task, bool active) {
    const int c = TIDX & 255, t0 = task * 16;
    if (active) {
        const float w0 = conv_w[c], w1 = conv_w[256 + c], w2 = conv_w[512 + c], w3 = conv_w[768 + c], cb = conv_b[c];
        for (int i = 0; i < 16; ++i) {
            const int t = t0 + i, s = t & (SEQ - 1);
            const bf16_t* pr = proj + (size_t)t * NP + C_CX + c;
            float acc = cb + w3 * bf2f(pr[0]);
            if (s >= 1) acc += w2 * bf2f(pr[-(ptrdiff_t)NP]);
            if (s >= 2) acc += w1 * bf2f(pr[-(ptrdiff_t)2 * NP]);
            if (s >= 3) acc += w0 * bf2f(pr[-(ptrdiff_t)3 * NP]);
            xc[i * 256 + c] = acc;
        }
    }
    __syncthreads();
    if (active) {
        const int h = c >> 6, jj = c & 63;
        float ra[16], rx[16];
#pragma unroll
        for (int i = 0; i < 16; ++i) { ra[i] = 0.f; rx[i] = 0.f; }
        for (int k = 0; k < 64; ++k) {
            const float wa = w_a[(h * 64 + k) * 64 + jj], wx = w_x[(h * 64 + k) * 64 + jj];
#pragma unroll
            for (int i = 0; i < 16; ++i) { const float xv = xc[i * 256 + h * 64 + k]; ra[i] += xv * wa; rx[i] += xv * wx; }
        }
        const float ba = b_a[c], bx = b_x[c], sp = softplusf_(-lam[c]);
#pragma unroll
        for (int i = 0; i < 16; ++i) {
            const float r = sigmoidf_(ra[i] + ba), ig = sigmoidf_(rx[i] + bx);
            const float log_a = -8.f * r * sp;
            const float a = __expf(log_a);
            const float u = sqrtf(-expm1f(2.f * log_a)) * (ig * xc[i * 256 + c]);
            a_out[(size_t)(t0 + i) * 256 + c] = a; u_out[(size_t)(t0 + i) * 256 + c] = u;
        }
    }
    __syncthreads();
}
__device__ __forceinline__ void lru_scan_task(const float* __restrict__ a_in, const float* __restrict__ u_in, const bf16_t* __restrict__ proj, const float* __restrict__ mix_gain, bf16_t* __restrict__ y, int b) {
    const int c = TIDX;
    const float mg = mix_gain[512 + c];
    float hst = 0.f;
    for (int t = 0; t < SEQ; ++t) {
        const size_t row = (size_t)(b * SEQ + t);
        hst = a_in[row * 256 + c] * hst + u_in[row * 256 + c];
        const float yv = hst * geluf_(bf2f(proj[row * NP + C_CG + c]));
        const float ms = wave_sum(yv * yv) * (1.f / 64.f);
        y[row * 1024 + 512 + c] = f2bf(yv * rsqrtf(ms + EPS) * mg);
    }
}

typedef short s16x4 __attribute__((ext_vector_type(4)));
#define LDS_AS __attribute__((address_space(3)))
__device__ __forceinline__ bf16x8 frag_rm(const bf16_t* tile, int ld, int r0, int k0, int lane) { return *(const bf16x8*)(tile + (r0 + (lane & 15)) * ld + k0 + (lane >> 4) * 8); }
__device__ __forceinline__ s16x4 tr4(const bf16_t* tile, int ld, int rbase, int c0, int lane) {
    const bf16_t* p = tile + (rbase + ((lane & 15) >> 2)) * ld + c0 + 4 * (lane & 3);
    return __builtin_amdgcn_ds_read_tr16_b64_v4i16((LDS_AS s16x4*)p);
}
__device__ __forceinline__ bf16x8 frag_cm(const bf16_t* tile, int ld, int k0, int c0, int lane) {
    const s16x4 lo = tr4(tile, ld, k0 + (lane >> 4) * 8, c0, lane), hi = tr4(tile, ld, k0 + (lane >> 4) * 8 + 4, c0, lane);
    return (bf16x8){lo[0], lo[1], lo[2], lo[3], hi[0], hi[1], hi[2], hi[3]};
}
#define MFMA16(a, b, c) __builtin_amdgcn_mfma_f32_16x16x32_bf16((a), (b), (c), 0, 0, 0)
constexpr int TLD = 72;


#define XB_TMO      128
#define XB_XCNT(j)  (256  + 64 * (j))
#define XB_XSUB(j)  (1280 + 64 * (j))
#define XB_XGEN(j)  (2304 + 64 * (j))
#define XB_TOP      3328
#define XB_TOPGEN   3392
#define XCD_BAR_WORDS 3456
#define XB_SPIN_CAP (1u << 18)
__device__ __forceinline__ unsigned xb_ld(unsigned* p)              { return __hip_atomic_load(p, __ATOMIC_RELAXED, __HIP_MEMORY_SCOPE_AGENT); }
__device__ __forceinline__ unsigned xb_add(unsigned* p, unsigned v) { return __hip_atomic_fetch_add(p, v, __ATOMIC_RELAXED, __HIP_MEMORY_SCOPE_AGENT); }
__device__ __forceinline__ unsigned xb_xcc_id() { return (unsigned)__builtin_amdgcn_s_getreg((3 << 11) | 20) & 0xFu; }
#define XB_SPIN(cond, bar) do { unsigned _sp = 0; while (cond) { __builtin_amdgcn_s_sleep(1); \
    if ((++_sp & 255u) == 0u) { if (xb_ld(&(bar)[XB_TMO])) break; if (_sp > XB_SPIN_CAP) { atomicAdd(&(bar)[XB_TMO], 1u); break; } } } } while (0)
struct XcdBarrier { unsigned* bar; unsigned x; volatile LDS_AS unsigned* st; };
__device__ __forceinline__ XcdBarrier xcd_barrier_post(unsigned* bar, volatile LDS_AS unsigned* st) {
    XcdBarrier b; b.bar = bar; b.x = xb_xcc_id(); b.st = st;
    if (TIDX == 0) (void)xb_add(&bar[XB_XCNT(b.x)], 1u);
    return b;
}
__device__ __forceinline__ void xcd_barrier_complete(unsigned* bar, unsigned x, unsigned& nloc, unsigned& nx) {
    const unsigned G = gridDim.x * gridDim.y * gridDim.z;
    unsigned sum, cnt, mine, sp = 0u;
    for (;;) {
        sum = 0u; cnt = 0u; mine = 0u;
#pragma unroll
        for (unsigned j = 0; j < 16; ++j) { const unsigned c = xb_ld(&bar[XB_XCNT(j)]); sum += c; cnt += (c > 0u) ? 1u : 0u; mine = (j == x) ? c : mine; }
        if (sum == G) break;
        __builtin_amdgcn_s_sleep(1);
        if ((++sp & 255u) == 0u) { if (xb_ld(&bar[XB_TMO])) break; if (sp > XB_SPIN_CAP) { atomicAdd(&bar[XB_TMO], 1u); break; } }
    }
    nloc = mine > 0u ? mine : 1u; nx = cnt > 0u ? cnt : 1u;
}
__device__ __forceinline__ void xcd_barrier(const XcdBarrier& b) {
    asm volatile("s_waitcnt vmcnt(0)" ::: "memory");
    __syncthreads();
    if (TIDX == 0) {
        unsigned* bar = b.bar;
        __builtin_amdgcn_s_waitcnt(0);
        unsigned nloc = b.st[0], nx = b.st[1];
        if (nloc == 0u) { xcd_barrier_complete(bar, b.x, nloc, nx); b.st[0] = nloc; b.st[1] = nx; }
        const unsigned old = xb_add(&bar[XB_XSUB(b.x)], 1u);
        const unsigned gen = old / nloc;
        if (old + 1u == (gen + 1u) * nloc) {
            __builtin_amdgcn_fence(__ATOMIC_RELEASE, "agent");
            asm volatile("s_waitcnt vmcnt(0)" ::: "memory");
            const unsigned og = xb_add(&bar[XB_TOP], 1u);
            const unsigned tg = og / nx;
            if (og + 1u == (tg + 1u) * nx) xb_add(&bar[XB_TOPGEN], 1u);
            else XB_SPIN(xb_ld(&bar[XB_TOPGEN]) == tg, bar);
            __builtin_amdgcn_fence(__ATOMIC_ACQUIRE, "agent");
            xb_add(&bar[XB_XGEN(b.x)], 1u);
            asm volatile("s_waitcnt vmcnt(0)" ::: "memory");
        } else {
            XB_SPIN(xb_ld(&bar[XB_XGEN(b.x)]) == gen, bar);
            __builtin_amdgcn_fence(__ATOMIC_ACQUIRE, "agent");
            asm volatile("s_waitcnt vmcnt(0)" ::: "memory");
        }
    }
    __syncthreads();
}


__device__ __forceinline__ void flag_signal(unsigned* ctr, unsigned n) {
    asm volatile("s_waitcnt vmcnt(0)" ::: "memory");
    __syncthreads();
    if (TIDX == 0) {
        __builtin_amdgcn_fence(__ATOMIC_RELEASE, "agent");
        asm volatile("s_waitcnt vmcnt(0)" ::: "memory");
        (void)__hip_atomic_fetch_add(ctr, n, __ATOMIC_RELAXED, __HIP_MEMORY_SCOPE_AGENT);
    }
}
__device__ __forceinline__ void flag_wait(unsigned* ctr, unsigned target) {
    if (TIDX == 0) {
        unsigned sp = 0;
        while (__hip_atomic_load(ctr, __ATOMIC_RELAXED, __HIP_MEMORY_SCOPE_AGENT) < target) { __builtin_amdgcn_s_sleep(2); if (++sp > (1u << 22)) break; }
        __builtin_amdgcn_fence(__ATOMIC_ACQUIRE, "agent");
        asm volatile("s_waitcnt vmcnt(0)" ::: "memory");
    }
    __syncthreads();
}
constexpr int CTL_FLAG_WORD = 3520;

typedef unsigned u32x2_t __attribute__((ext_vector_type(2)));
__device__ __forceinline__ float rows_max(float x) {
    u32x2_t r = __builtin_amdgcn_permlane32_swap(__float_as_uint(x), __float_as_uint(x), false, false);
    x = fmaxf(__uint_as_float(r[0]), __uint_as_float(r[1]));
    r = __builtin_amdgcn_permlane16_swap(__float_as_uint(x), __float_as_uint(x), false, false);
    return fmaxf(__uint_as_float(r[0]), __uint_as_float(r[1]));
}
__device__ __forceinline__ float rows_sum(float x) {
    u32x2_t r = __builtin_amdgcn_permlane32_swap(__float_as_uint(x), __float_as_uint(x), false, false);
    x = __uint_as_float(r[0]) + __uint_as_float(r[1]);
    r = __builtin_amdgcn_permlane16_swap(__float_as_uint(x), __float_as_uint(x), false, false);
    return __uint_as_float(r[0]) + __uint_as_float(r[1]);
}
template <bool MASK, int NS, int REL = 0>
__device__ __forceinline__ void attn_compute_t(const bf16_t* cK, const bf16_t* cV, const float* cC, const bf16x8 (&qf)[2], f32x4 (&oacc)[4], float& mrun, float& lrun,
                                               float ct2, float scale2, int key0, int tq, int lane, int g) {
    f32x4 sacc[4 * NS];
    const float ctm = REL ? ct2 - mrun : ct2;
    {
        bf16x8 kf[3][2]; f32x4 csv[3];
#define AT_KLOAD(slot, n_) { kf[slot][0] = frag_rm(cK, TLD, (n_) * 16, 0, lane); kf[slot][1] = frag_rm(cK, TLD, (n_) * 16, 32, lane); csv[slot] = *(const f32x4*)(cC + (n_) * 16 + 4 * g); }
        AT_KLOAD(0, 0) AT_KLOAD(1, 1)
#pragma unroll
        for (int n = 0; n < 4 * NS; ++n) {
            if (n + 2 < 4 * NS) AT_KLOAD((n + 2) % 3, n + 2)
            const f32x4 cs = csv[n % 3];
            const f32x4 b4 = {ctm - cs[0], ctm - cs[1], ctm - cs[2], ctm - cs[3]};
            sacc[n] = MFMA16(kf[n % 3][0], qf[0], b4);
            sacc[n] = MFMA16(kf[n % 3][1], qf[1], sacc[n]);
        }
#undef AT_KLOAD
    }
    bf16x8 vf[3][2 * NS];
#define AT_VLOAD(buf, n2_) { _Pragma("unroll") for (int kk = 0; kk < 2 * NS; ++kk) { \
        const s16x4 lo = tr4(cV, TLD, (2 * kk) * 16 + 4 * g, (n2_) * 16, lane), hi = tr4(cV, TLD, (2 * kk + 1) * 16 + 4 * g, (n2_) * 16, lane); \
        vf[buf][kk] = (bf16x8){lo[0], lo[1], lo[2], lo[3], hi[0], hi[1], hi[2], hi[3]}; } }
    float mx = -INFINITY;
#pragma unroll
    for (int n = 0; n < 4 * NS; ++n) {
#pragma unroll
        for (int r = 0; r < 4; ++r) {
            if (MASK) { if (key0 + n * 16 + 4 * g + r > tq) sacc[n][r] = -INFINITY; }
            mx = fmaxf(mx, sacc[n][r]);
        }
    }
    if (REL == 1) {
        if (__builtin_amdgcn_ballot_w64(mx > -140.f) == 0ull) return;
    }
    AT_VLOAD(0, 0) AT_VLOAD(1, 1)
    mx = rows_max(mx);
    float corr = 1.f, rs = 0.f;
    bool rescale = true;
    if (REL == 0) {
        const float mnew = fmaxf(mrun, mx);
        corr = __builtin_amdgcn_exp2f(mrun - mnew);
#pragma unroll
        for (int n = 0; n < 4 * NS; ++n)
#pragma unroll
            for (int r = 0; r < 4; ++r) { const float p = __builtin_amdgcn_exp2f(sacc[n][r] - mnew); sacc[n][r] = p; rs += p; }
        mrun = mnew;
    } else {
        const float d = (REL == 2) ? mx : fmaxf(mx, 0.f);
        rescale = (REL == 2) || (__builtin_amdgcn_ballot_w64(d > 0.f) != 0ull);
        if (rescale) {
            corr = __builtin_amdgcn_exp2f(-d);
#pragma unroll
            for (int n = 0; n < 4 * NS; ++n)
#pragma unroll
                for (int r = 0; r < 4; ++r) { const float p = __builtin_amdgcn_exp2f(sacc[n][r] - d); sacc[n][r] = p; rs += p; }
            mrun += d;
        } else {
#pragma unroll
            for (int n = 0; n < 4 * NS; ++n)
#pragma unroll
                for (int r = 0; r < 4; ++r) { const float p = __builtin_amdgcn_exp2f(sacc[n][r]); sacc[n][r] = p; rs += p; }
        }
    }
    rs = rows_sum(rs);
    lrun = lrun * corr + rs;
    if (rescale) {
#pragma unroll
        for (int n2 = 0; n2 < 4; ++n2) oacc[n2] = oacc[n2] * corr;
    }
    bf16x8 pf[2 * NS];
#pragma unroll
    for (int kk = 0; kk < 2 * NS; ++kk) {
        const u32x4 pk = (u32x4){pk2(sacc[2 * kk][0], sacc[2 * kk][1]), pk2(sacc[2 * kk][2], sacc[2 * kk][3]), pk2(sacc[2 * kk + 1][0], sacc[2 * kk + 1][1]), pk2(sacc[2 * kk + 1][2], sacc[2 * kk + 1][3])};
        pf[kk] = __builtin_bit_cast(bf16x8, pk);
    }
    {
#pragma unroll
        for (int n2 = 0; n2 < 4; ++n2) {
            if (n2 + 2 < 4) AT_VLOAD((n2 + 2) % 3, n2 + 2)
#pragma unroll
            for (int kk = 0; kk < 2 * NS; ++kk) oacc[n2] = MFMA16(vf[n2 % 3][kk], pf[kk], oacc[n2]);
        }
#undef AT_VLOAD
    }
}
__device__ __forceinline__ void attn_compute_diag(const bf16_t* cK, const bf16_t* cV, const float* cC, const bf16x8 (&qf)[2], f32x4 (&oacc)[4], float& mrun, float& lrun,
                                                  float ct2, float scale2, int key0, int r0, int tq, int lane, int g) {
    if (key0 + 64 > r0 + 15) attn_compute_t<true, 1, 2>(cK, cV, cC, qf, oacc, mrun, lrun, ct2, scale2, key0, tq, lane, g);
    else attn_compute_t<true, 2, 2>(cK, cV, cC, qf, oacc, mrun, lrun, ct2, scale2, key0, tq, lane, g);
}

__device__ __forceinline__ void attn_task(char* smem, const bf16_t* __restrict__ Q, int ldq, const bf16_t* __restrict__ Kp, int ldk, const bf16_t* __restrict__ Vp, int ldv, const float* __restrict__ bias,
                                          int nq_per_b, int nk_per_b, int causal, float scale, bf16_t* __restrict__ O, int ldo, const float* __restrict__ gain, int rms, int task) {
    constexpr int KT = 128;
    bf16_t* sK = (bf16_t*)smem;
    bf16_t* sV = sK + 2 * KT * TLD;
    float* sC = (float*)(sV + 2 * KT * TLD);
    const int tid = TIDX, lane = tid & 63, wave = tid >> 6, g = lane >> 4, li = lane & 15;
    const int nqt = nq_per_b / 128;
    const int qt = task % nqt, h = (task / nqt) & 3, b = task / (nqt * 4);
    const int q0 = qt * 128, r0 = q0 + wave * 16, tq = r0 + li;
    const size_t qrow = (size_t)b * nq_per_b + tq;
    constexpr float LOG2E = 1.4426950408889634f;
    const float scale2 = scale * LOG2E;
    bf16x8 qf[2];
#pragma unroll
    for (int kk = 0; kk < 2; ++kk) {
        const u32x4 qr = *(const u32x4*)(Q + qrow * ldq + h * 64 + kk * 32 + g * 8); u32x4 qs;
#pragma unroll
        for (int e = 0; e < 8; e += 2) qs[e >> 1] = pk2(bfx(qr, e) * scale2, bfx(qr, e + 1) * scale2);
        qf[kk] = __builtin_bit_cast(bf16x8, qs);
    }
    const float ct = bias[(size_t)(b * 4 + h) * nq_per_b + tq] * LOG2E;
    const int nkt = causal ? (q0 + 128) / KT : nk_per_b / KT;
    const int sr = tid >> 3, sc = tid & 7;
    const bf16_t* kg = Kp + ((size_t)b * nk_per_b + sr) * ldk + h * 64 + sc * 8;
    const bf16_t* vg = Vp + ((size_t)b * nk_per_b + sr) * ldv + h * 64 + sc * 8;
    const float* cg_ = bias + (size_t)(b * 4 + h) * nk_per_b;
    u32x4 rkA[2], rvA[2], rkB[2], rvB[2]; float rcA = 0.f, rcB = 0.f;
#define AT_LOAD(RK, RV, RC, kt) { _Pragma("unroll") for (int i = 0; i < 2; ++i) { RK[i] = *(const u32x4*)(kg + (size_t)((kt) * KT + i * 64) * ldk); RV[i] = *(const u32x4*)(vg + (size_t)((kt) * KT + i * 64) * ldv); } \
        RC = cg_[(kt) * KT + (tid & (KT - 1))]; }
#define AT_STORE(RK, RV, RC, buf) { _Pragma("unroll") for (int i = 0; i < 2; ++i) { *(u32x4*)(sK + ((buf) * KT + sr + i * 64) * TLD + sc * 8) = RK[i]; *(u32x4*)(sV + ((buf) * KT + sr + i * 64) * TLD + sc * 8) = RV[i]; } \
        if (tid < KT) sC[(buf) * KT + tid] = RC * LOG2E; }
#define AT_COMPUTE(buf) attn_compute_t<false, 2, 1>(sK + (buf) * KT * TLD, sV + (buf) * KT * TLD, sC + (buf) * KT, qf, oacc, mrun, lrun, ct, scale2, 0, tq, lane, g)
#define KTR(j) (nkt - 1 - (j))
    AT_LOAD(rkA, rvA, rcA, KTR(0))
    AT_LOAD(rkB, rvB, rcB, KTR(min(1, nkt - 1)))
    __syncthreads();
    AT_STORE(rkA, rvA, rcA, 0)
    __syncthreads();
    f32x4 oacc[4];
#pragma unroll
    for (int n = 0; n < 4; ++n) oacc[n] = (f32x4){0.f, 0.f, 0.f, 0.f};
    float mrun = 0.f, lrun = 0.f;
    for (int kt = 0; kt < nkt; kt += 2) {
        AT_LOAD(rkA, rvA, rcA, KTR(min(kt + 2, nkt - 1)))
        if (kt == 0) attn_compute_diag(sK, sV, sC, qf, oacc, mrun, lrun, ct, scale2, q0, r0, tq, lane, g);
        else AT_COMPUTE(0);
        if (kt + 1 < nkt) AT_STORE(rkB, rvB, rcB, 1)
        __syncthreads();
        if (kt + 1 < nkt) {
            AT_LOAD(rkB, rvB, rcB, KTR(min(kt + 3, nkt - 1)))
            AT_COMPUTE(1);
            if (kt + 2 < nkt) AT_STORE(rkA, rvA, rcA, 0)
            __syncthreads();
        }
    }
#undef KTR
#undef AT_LOAD
#undef AT_STORE
#undef AT_COMPUTE
    const float inv = 1.f / lrun;
    float ms = 0.f;
#pragma unroll
    for (int n = 0; n < 4; ++n) { oacc[n] = oacc[n] * inv; ms += oacc[n][0] * oacc[n][0] + oacc[n][1] * oacc[n][1] + oacc[n][2] * oacc[n][2] + oacc[n][3] * oacc[n][3]; }
    ms += __shfl_xor(ms, 16); ms += __shfl_xor(ms, 32);
    const float rinv = rms ? rsqrtf(ms * (1.f / 64.f) + EPS) : 1.f;
#pragma unroll
    for (int n = 0; n < 4; ++n) {
        const int d = n * 16 + 4 * g;
        f32x4 gg = (f32x4){1.f, 1.f, 1.f, 1.f};
        if (gain) gg = *(const f32x4*)(gain + h * 64 + d);
        uint2 o; o.x = pk2(oacc[n][0] * rinv * gg[0], oacc[n][1] * rinv * gg[1]); o.y = pk2(oacc[n][2] * rinv * gg[2], oacc[n][3] * rinv * gg[3]);
        *(uint2*)(O + qrow * ldo + h * 64 + d) = o;
    }
}


__device__ __forceinline__ void hgrn_lbk(const float* __restrict__ hgrn_lb, int layer, int h, float (&lbk)[8]) {
    const int k8 = (TIDX & 7) * 8;
#pragma unroll
    for (int j = 0; j < 8; ++j) {
        lbk[j] = 0.f;
        if (layer == 1) { const float a0 = hgrn_lb[h * 64 + k8 + j], a1 = hgrn_lb[256 + h * 64 + k8 + j]; lbk[j] = 1.f / (1.f + __expf(a0 - a1)); }
    }
}
__device__ __forceinline__ void hgrn_scan(float* LF  , float* SEGT  , const u32x4 raw  , const float (&lbk8)[8], float (&kk)[8]) {
    const int tid = TIDX, t = tid >> 3, k8 = (tid & 7) * 8;
#pragma unroll
    for (int j = 0; j < 8; ++j) {
        const float fl = __uint_as_float((j & 1) ? (raw[j >> 1] & 0xffff0000u) : (raw[j >> 1] << 16));
        const float lbk = lbk8[j];
        const float sg = sigmoidf_(fl);
        const float f = lbk + (1.f - lbk) * sg;
        kk[j] = (1.f - lbk) * (1.f - sg);
        LF[t * 65 + k8 + j] = __logf(f);
    }
    __syncthreads();
    { const int k = tid & 63, seg = tid >> 6; float run = 0.f;
#pragma unroll
      for (int i = 0; i < 8; ++i) { run += LF[(seg * 8 + i) * 65 + k]; LF[(seg * 8 + i) * 65 + k] = run; }
      SEGT[seg * 64 + k] = run; }
    __syncthreads();
    { const int k = tid & 63, seg = tid >> 6; float off = 0.f;
      for (int s2 = 0; s2 < seg; ++s2) off += SEGT[s2 * 64 + k];
#pragma unroll
      for (int i = 0; i < 8; ++i) LF[(seg * 8 + i) * 65 + k] += off; }
    __syncthreads();
}

struct HlPre { u32x4 v, f; };
__device__ __forceinline__ void hgrn_local_prefetch(const bf16_t* __restrict__ proj, int ch, HlPre& P) {
    const int tid = TIDX, bh = ch >> 5, n = ch & 31, b = bh >> 2, h = bh & 3, t = tid >> 3, k8 = (tid & 7) * 8;
    const bf16_t* prow = proj + (size_t)(b * SEQ + n * 64 + t) * NP + h * 64 + k8;
    P.v = *(const u32x4*)(prow + C_AI); P.f = *(const u32x4*)(prow + C_AF);
}
__device__ __forceinline__ void hgrn_local_task(char* smem, const HlPre& P, const float (&lbk)[8], float* __restrict__ HL, float* __restrict__ HD, int ch) {
    float* LF = (float*)smem; float* SEGT = LF + 64 * 65;
    bf16_t* sKd = (bf16_t*)(SEGT + 8 * 64); bf16_t* sV = sKd + 64 * TLD;
    const int tid = TIDX, lane = tid & 63, wave = tid >> 6, g = lane >> 4, li = lane & 15;
    const int t = tid >> 3, k8 = (tid & 7) * 8;
    __syncthreads();
    *(u32x4*)(sV + t * TLD + k8) = P.v;
    float kk[8];
    hgrn_scan(LF, SEGT, P.f, lbk, kk);
    { u32x4 o;
#pragma unroll
      for (int j = 0; j < 8; j += 2) {
          const float e0 = kk[j] * __expf(LF[63 * 65 + k8 + j] - LF[t * 65 + k8 + j]), e1 = kk[j + 1] * __expf(LF[63 * 65 + k8 + j + 1] - LF[t * 65 + k8 + j + 1]);
          o[j >> 1] = pk2(e0, e1);
      }
      *(u32x4*)(sKd + t * TLD + k8) = o; }
    if (tid < 64) HD[(size_t)ch * 64 + tid] = __expf(LF[63 * 65 + tid]);
    __syncthreads();
#pragma unroll
    for (int i = 0; i < 2; ++i) {
        const int idx = wave * 2 + i, vt = idx >> 2, kt = idx & 3;
        f32x4 acc = (f32x4){0.f, 0.f, 0.f, 0.f};
#pragma unroll
        for (int ks = 0; ks < 2; ++ks) acc = MFMA16(frag_cm(sV, TLD, ks * 32, vt * 16, lane), frag_cm(sKd, TLD, ks * 32, kt * 16, lane), acc);
        *(f32x4*)(HL + (size_t)ch * 4096 + (kt * 16 + li) * 64 + vt * 16 + 4 * g) = acc;
    }
}

struct HoPre { u32x4 hs, q, v, f; uint2 gt[2]; };
__device__ __forceinline__ void hgrn_out_prefetch(const bf16_t* __restrict__ proj, const bf16_t* __restrict__ HS, int ch, HoPre& P) {
    const int tid = TIDX, lane = tid & 63, wave = tid >> 6, g = lane >> 4, li = lane & 15;
    const int bh = ch >> 5, n = ch & 31, b = bh >> 2, h = bh & 3, t = tid >> 3, k8 = (tid & 7) * 8;
    const bf16_t* prow = proj + (size_t)(b * SEQ + n * 64) * NP + h * 64;
    P.hs = *(const u32x4*)(HS + (size_t)ch * 4096 + t * 64 + k8);
    P.q = *(const u32x4*)(prow + (size_t)t * NP + C_AQ + k8);
    P.v = *(const u32x4*)(prow + (size_t)t * NP + C_AI + k8);
    P.f = *(const u32x4*)(prow + (size_t)t * NP + C_AF + k8);
    const int tq = (wave >> 1) * 16 + li;
#pragma unroll
    for (int i = 0; i < 2; ++i) P.gt[i] = *(const uint2*)(prow + (size_t)tq * NP + C_AG + ((wave & 1) * 2 + i) * 16 + 4 * g);
}
__device__ __forceinline__ void hgrn_out_task(char* smem, const HoPre& P, const float (&lbk)[8], const float* __restrict__ mix_gain, bf16_t* __restrict__ y, int ch) {
    float* LF = (float*)smem; float* SEGT = LF + 64 * 65; float* sMS = SEGT + 8 * 64;
    bf16_t* sST = (bf16_t*)(sMS + 128); bf16_t* sQ0 = sST + 64 * TLD; bf16_t* sQm = sQ0 + 64 * TLD; bf16_t* sKm = sQm + 64 * TLD; bf16_t* sV = sKm + 64 * TLD; bf16_t* sA = sV + 64 * TLD;
    const int tid = TIDX, lane = tid & 63, wave = tid >> 6, g = lane >> 4, li = lane & 15;
    const int bh = ch >> 5, n = ch & 31, b = bh >> 2, h = bh & 3;
    const int t = tid >> 3, k8 = (tid & 7) * 8;
    __syncthreads();
    *(u32x4*)(sST + t * TLD + k8) = P.hs;
    const u32x4 qraw = P.q;
    *(u32x4*)(sV + t * TLD + k8) = P.v;
    float kk[8];
    hgrn_scan(LF, SEGT, P.f, lbk, kk);
    { u32x4 o0, om, ok;
#pragma unroll
      for (int j = 0; j < 8; j += 2) {
          float q0v[2], qmv[2], kmv[2];
#pragma unroll
          for (int e = 0; e < 2; ++e) {
              const float bt = LF[t * 65 + k8 + j + e], r = LF[31 * 65 + k8 + j + e], q = siluf_(bfx(qraw, j + e));
              q0v[e] = q * __expf(bt); qmv[e] = q * __expf(bt - r); kmv[e] = kk[j + e] * __expf(r - bt);
          }
          o0[j >> 1] = pk2(q0v[0], q0v[1]); om[j >> 1] = pk2(qmv[0], qmv[1]); ok[j >> 1] = pk2(kmv[0], kmv[1]);
      }
      *(u32x4*)(sQ0 + t * TLD + k8) = o0; *(u32x4*)(sQm + t * TLD + k8) = om; *(u32x4*)(sKm + t * TLD + k8) = ok; }
    __syncthreads();
#pragma unroll
    for (int i = 0; i < 2; ++i) {
        const int idx = wave * 2 + i, tt = idx >> 2, st = idx & 3;
        f32x4 acc = (f32x4){0.f, 0.f, 0.f, 0.f};
#pragma unroll
        for (int ks = 0; ks < 2; ++ks) acc = MFMA16(frag_rm(sKm, TLD, st * 16, ks * 32, lane), frag_rm(sQm, TLD, tt * 16, ks * 32, lane), acc);
        const int tq = tt * 16 + li, s0 = st * 16 + 4 * g;
        uint2 o; o.x = pk2(s0 <= tq ? acc[0] : 0.f, s0 + 1 <= tq ? acc[1] : 0.f); o.y = pk2(s0 + 2 <= tq ? acc[2] : 0.f, s0 + 3 <= tq ? acc[3] : 0.f);
        *(uint2*)(sA + tq * TLD + s0) = o;
    }
    __syncthreads();
    { const int tt = wave >> 1;
      f32x4 oacc[2]; float ms = 0.f;
#pragma unroll
      for (int i = 0; i < 2; ++i) {
          const int vt = (wave & 1) * 2 + i;
          f32x4 acc = (f32x4){0.f, 0.f, 0.f, 0.f};
#pragma unroll
          for (int ks = 0; ks < 2; ++ks) acc = MFMA16(frag_cm(sST, TLD, ks * 32, vt * 16, lane), frag_rm(sQ0, TLD, tt * 16, ks * 32, lane), acc);
#pragma unroll
          for (int ks = 0; ks < 2; ++ks) acc = MFMA16(frag_cm(sV, TLD, ks * 32, vt * 16, lane), frag_rm(sA, TLD, tt * 16, ks * 32, lane), acc);
          oacc[i] = acc; ms += acc[0] * acc[0] + acc[1] * acc[1] + acc[2] * acc[2] + acc[3] * acc[3];
      }
      ms += __shfl_xor(ms, 16); ms += __shfl_xor(ms, 32);
      if (g == 0) sMS[(tt * 16 + li) * 2 + (wave & 1)] = ms;
      __syncthreads();
      const int tq = tt * 16 + li;
      const float rinv = rsqrtf((sMS[tq * 2] + sMS[tq * 2 + 1]) * (1.f / 64.f) + EPS);
      const size_t row = (size_t)(b * SEQ + n * 64 + tq);
#pragma unroll
      for (int i = 0; i < 2; ++i) {
          const int v0 = ((wave & 1) * 2 + i) * 16 + 4 * g;
          const uint2 graw = P.gt[i];
          const f32x4 mgv = *(const f32x4*)(mix_gain + C_AQ + h * 64 + v0);
          const float g0 = __uint_as_float(graw.x << 16), g1 = __uint_as_float(graw.x & 0xffff0000u), g2 = __uint_as_float(graw.y << 16), g3 = __uint_as_float(graw.y & 0xffff0000u);
          uint2 o; o.x = pk2(oacc[i][0] * rinv * siluf_(g0) * mgv[0], oacc[i][1] * rinv * siluf_(g1) * mgv[1]);
          o.y = pk2(oacc[i][2] * rinv * siluf_(g2) * mgv[2], oacc[i][3] * rinv * siluf_(g3) * mgv[3]);
          *(uint2*)(y + row * 1024 + h * 64 + v0) = o;
      }
    }
}


typedef float f32x2_t __attribute__((ext_vector_type(2)));
constexpr int GP_BYTES = (128 + 64 * 132 + 64 * 68) * 4 + 2 * 64 * TLD * 2;
__device__ __forceinline__ void gdn_prep_pair(char* smem, const bf16_t* __restrict__ proj, const float* __restrict__ gates, const float* __restrict__ conv_w  ,
                                              const float* __restrict__ a_log, const float* __restrict__ dt_bias, bf16_t* __restrict__ gt_all, float* __restrict__ glast, int ch0) {
#define GP_SG(sub) ((float*)(smem + (sub) * GP_BYTES))
#define GP_SBETA(sub) (GP_SG(sub) + 64)
#define GP_RHS(sub) (GP_SG(sub) + 128)
#define GP_SM(sub) (GP_RHS(sub) + 64 * 132)
#define GP_SK(sub) ((bf16_t*)(GP_SM(sub) + 64 * 68))
#define GP_SQ(sub) (GP_SK(sub) + 64 * TLD)
    const int tid = TIDX, lane = tid & 63, wave = tid >> 6, g = lane >> 4, li = lane & 15;
    const int bh = ch0 >> 5, n0 = ch0 & 31, b = bh >> 2, h = bh & 3;
    const int t = tid >> 3, d8 = (tid & 7) * 8;
    __syncthreads();
    float qn[2][8], kn[2][8], vv[2][8];
#pragma unroll
    for (int sub = 0; sub < 2; ++sub) {
        const int n = n0 + sub; const size_t row0 = (size_t)(b * SEQ + n * 64);
        const int spos = n * 64 + t;
#pragma unroll
        for (int sec = 0; sec < 3; ++sec) {
            const int col = (sec == 0 ? C_DQ : (sec == 1 ? C_DK : C_DV)) + h * 64 + d8;
            float acc[8];
#pragma unroll
            for (int e = 0; e < 8; ++e) acc[e] = 0.f;
            u32x4 raw4[4]; f32x4 w04[4], w14[4];
#pragma unroll
            for (int j = 0; j < 4; ++j) {
                const bool ok = spos - (3 - j) >= 0;
                raw4[j] = *(const u32x4*)(proj + (row0 + t - (ok ? (3 - j) : 0)) * NP + col);
                w04[j] = *(const f32x4*)(conv_w + j * 768 + sec * 256 + h * 64 + d8); w14[j] = *(const f32x4*)(conv_w + j * 768 + sec * 256 + h * 64 + d8 + 4);
            }
#pragma unroll
            for (int j = 0; j < 4; ++j) {
                const float mk = (spos - (3 - j) >= 0) ? 1.f : 0.f;
#pragma unroll
                for (int e = 0; e < 8; ++e) acc[e] += (e < 4 ? w04[j][e] : w14[j][e - 4]) * mk * bfx(raw4[j], e);
            }
#pragma unroll
            for (int e = 0; e < 8; ++e) { const float sv = siluf_(acc[e]); if (sec == 0) qn[sub][e] = sv; else if (sec == 1) kn[sub][e] = sv; else vv[sub][e] = sv; }
        }
        float sq = 0.f, sk = 0.f;
#pragma unroll
        for (int e = 0; e < 8; ++e) { sq += qn[sub][e] * qn[sub][e]; sk += kn[sub][e] * kn[sub][e]; }
        sq += __shfl_xor(sq, 1); sq += __shfl_xor(sq, 2); sq += __shfl_xor(sq, 4);
        sk += __shfl_xor(sk, 1); sk += __shfl_xor(sk, 2); sk += __shfl_xor(sk, 4);
        const float rq = rsqrtf(sq + EPS) * 0.125f, rk = rsqrtf(sk + EPS);
#pragma unroll
        for (int e = 0; e < 8; ++e) { qn[sub][e] *= rq; kn[sub][e] *= rk; }
        if ((tid & 7) == 0) {
            const float* gr = gates + (row0 + t) * 16;
            GP_SBETA(sub)[t] = sigmoidf_(gr[4 + h]);
            GP_SG(sub)[t] = -__expf(a_log[h]) * softplusf_(gr[8 + h] + dt_bias[h]);
        }
    }
    __syncthreads();
    if (wave < 2) {
        float* sG = GP_SG(wave);
        float v = sG[lane];
#pragma unroll
        for (int o = 1; o < 64; o <<= 1) { const float nb = __shfl_up(v, o); if (lane >= o) v += nb; }
        sG[lane] = v;
    }
    __syncthreads();
#pragma unroll
    for (int sub = 0; sub < 2; ++sub) {
        const int ch = ch0 + sub;
        float* sG = GP_SG(sub); float* RHS = GP_RHS(sub);
        const float Gt = sG[t], Gl = sG[63], bt = GP_SBETA(sub)[t];
        const float eG = __expf(Gt);
        u32x4 ok, oq;
#pragma unroll
        for (int e = 0; e < 8; e += 2) { ok[e >> 1] = pk2(kn[sub][e], kn[sub][e + 1]); oq[e >> 1] = pk2(qn[sub][e], qn[sub][e + 1]); }
        *(u32x4*)(GP_SK(sub) + t * TLD + d8) = ok; *(u32x4*)(GP_SQ(sub) + t * TLD + d8) = oq;
#pragma unroll
        for (int e = 0; e < 8; ++e) { RHS[t * 132 + d8 + e] = vv[sub][e] * bt; RHS[t * 132 + 64 + d8 + e] = kn[sub][e] * bt * eG; }
        if (tid == 0) glast[ch] = __expf(Gl);
    }
    __syncthreads();
    uint2 aqr[4];
#pragma unroll
    for (int i = 0; i < 4; ++i) {
        const int idx = wave * 4 + i, sub = idx >> 4, tt = (idx >> 2) & 3, st = idx & 3;
        const bf16_t* sK = GP_SK(sub); const bf16_t* sQ = GP_SQ(sub); const float* sG = GP_SG(sub); const float* sBeta = GP_SBETA(sub); float* sM = GP_SM(sub);
        f32x4 am = (f32x4){0.f, 0.f, 0.f, 0.f}, aq = (f32x4){0.f, 0.f, 0.f, 0.f};
#pragma unroll
        for (int ks = 0; ks < 2; ++ks) {
            const bf16x8 kfs = frag_rm(sK, TLD, st * 16, ks * 32, lane), kft = frag_rm(sK, TLD, tt * 16, ks * 32, lane);
            am = MFMA16(kft, kfs, am);
            aq = MFMA16(kfs, frag_rm(sQ, TLD, tt * 16, ks * 32, lane), aq);
        }
        {   const int sx = st * 16 + li, t0 = tt * 16 + 4 * g; const float Gs = sG[sx];
            f32x4 mo;
#pragma unroll
            for (int r = 0; r < 4; ++r) { const int tq = t0 + r; mo[r] = (sx < tq) ? sBeta[tq] * am[r] * __expf(sG[tq] - Gs) : 0.f; }
            *(f32x4*)(sM + sx * 68 + t0) = mo; }
        {   const int tq = tt * 16 + li, s0 = st * 16 + 4 * g; const float Gt = sG[tq];
            float ao[4];
#pragma unroll
            for (int r = 0; r < 4; ++r) { const int sx = s0 + r; ao[r] = (sx <= tq) ? aq[r] * __expf(Gt - sG[sx]) : 0.f; }
            aqr[i].x = pk2(ao[0], ao[1]); aqr[i].y = pk2(ao[2], ao[3]); }
    }
    __syncthreads();
    f32x2_t acc2[32];
    if (tid < 256) {
        const float* RHS = GP_RHS(tid >> 7);
#pragma unroll
        for (int i = 0; i < 32; ++i) acc2[i] = (f32x2_t){RHS[(2 * i) * 132 + (tid & 127)], RHS[(2 * i + 1) * 132 + (tid & 127)]};
    }
    __syncthreads();
#define GP_SAQ(sub) ((bf16_t*)GP_RHS(sub))
#define GP_SU(sub) (GP_SAQ(sub) + 64 * TLD)
#define GP_SWN(sub) (GP_SAQ(sub) + 2 * 64 * TLD)
#pragma unroll
    for (int i = 0; i < 4; ++i) {
        const int idx = wave * 4 + i, sub = idx >> 4, tt = (idx >> 2) & 3, st = idx & 3;
        *(uint2*)(GP_SAQ(sub) + (tt * 16 + li) * TLD + st * 16 + 4 * g) = aqr[i];
    }
    if (tid < 256) {
        const int sub = tid >> 7, col = tid & 127;
        const float* sM = GP_SM(sub);
#define GP_PAIR(v4, p) ((p) & 1 ? (f32x2_t){(v4)[2], (v4)[3]} : (f32x2_t){(v4)[0], (v4)[1]})
#pragma unroll
        for (int half = 0; half < 2; ++half) {
            const int base = half * 32;
            if (half == 1) {
#pragma unroll
                for (int sx = 0; sx < 32; sx += 2) {
                    f32x4 r0[8], r1[8];
#pragma unroll
                    for (int c = 0; c < 8; ++c) { r0[c] = *(const f32x4*)(sM + sx * 68 + 32 + c * 4); r1[c] = *(const f32x4*)(sM + (sx + 1) * 68 + 32 + c * 4); }
                    const float x0 = acc2[sx >> 1][0], x1 = acc2[sx >> 1][1];
                    const f32x2_t x0p = (f32x2_t){x0, x0}, x1p = (f32x2_t){x1, x1};
#pragma unroll
                    for (int pp = 0; pp < 16; ++pp) { acc2[16 + pp] -= GP_PAIR(r0[pp >> 1], pp) * x0p; acc2[16 + pp] -= GP_PAIR(r1[pp >> 1], pp) * x1p; }
                }
            }
            f32x4 cur[8], nx1[8];
#pragma unroll
            for (int c = 0; c < 8; ++c) { cur[c] = *(const f32x4*)(sM + base * 68 + base + c * 4); nx1[c] = *(const f32x4*)(sM + (base + 1) * 68 + base + c * 4); }
#pragma unroll
            for (int sx = 0; sx < 31; ++sx) {
                f32x4 nx2[8];
                if (sx + 2 < 32) {
#pragma unroll
                    for (int c = (sx + 3) >> 2; c < 8; ++c) nx2[c] = *(const f32x4*)(sM + (base + sx + 2) * 68 + base + c * 4);
                }
                const float xs = acc2[(base + sx) >> 1][sx & 1];
                const f32x2_t xsp = (f32x2_t){xs, xs};
#pragma unroll
                for (int pp = (sx + 1) >> 1; pp < 16; ++pp) acc2[(base >> 1) + pp] -= GP_PAIR(cur[pp >> 1], pp) * xsp;
#pragma unroll
                for (int c = (sx + 2) >> 2; c < 8; ++c) cur[c] = nx1[c];
                if (sx + 2 < 32) {
#pragma unroll
                    for (int c = (sx + 3) >> 2; c < 8; ++c) nx1[c] = nx2[c];
                }
            }
        }
#undef GP_PAIR
        if (col < 64) { bf16_t* d = GP_SU(sub) + col;
#pragma unroll
            for (int tt = 0; tt < 64; ++tt) d[tt * TLD] = f2bf(acc2[tt >> 1][tt & 1]);
        } else { bf16_t* d = GP_SWN(sub) + (col - 64);
#pragma unroll
            for (int tt = 0; tt < 64; ++tt) d[tt * TLD] = f2bf(-acc2[tt >> 1][tt & 1]);
        }
    } else {
        const int q = tid - 256, tr = q >> 2, c16 = (q & 3) * 16;
#pragma unroll
        for (int sub = 0; sub < 2; ++sub) {
            const float* sG = GP_SG(sub);
            const float eG = __expf(sG[tr]), eD = __expf(sG[63] - sG[tr]);
#pragma unroll
            for (int hh = 0; hh < 2; ++hh) {
                u32x4* pk_ = (u32x4*)(GP_SK(sub) + tr * TLD + c16 + hh * 8); u32x4* pq_ = (u32x4*)(GP_SQ(sub) + tr * TLD + c16 + hh * 8);
                const u32x4 kv = *pk_, qv = *pq_; u32x4 ko, qo;
#pragma unroll
                for (int e = 0; e < 8; e += 2) { ko[e >> 1] = pk2(bfx(kv, e) * eD, bfx(kv, e + 1) * eD); qo[e >> 1] = pk2(bfx(qv, e) * eG, bfx(qv, e + 1) * eG); }
                *pk_ = ko; *pq_ = qo;
            }
        }
    }
    __syncthreads();
    {
        const int sub = wave >> 2, mat = wave & 3;
        const bf16_t* sKd = GP_SK(sub); const bf16_t* sQd = GP_SQ(sub); const bf16_t* sAq = GP_SAQ(sub); const bf16_t* sU = GP_SU(sub); const bf16_t* sWn = GP_SWN(sub);
        const bf16_t* aT = (mat == 1) ? sKd : ((mat == 3) ? sU : sWn);
        const bf16_t* bT = (mat == 0) ? sKd : sU;
        bf16_t* gt = gt_all + (size_t)(ch0 + sub) * 5 * 4096 + mat * 4096;
#pragma unroll
        for (int ta = 0; ta < 4; ++ta) {
            const bf16x8 a0 = frag_cm(aT, TLD, 0, ta * 16, lane), a1 = frag_cm(aT, TLD, 32, ta * 16, lane);
#pragma unroll
            for (int tb = 0; tb < 4; ++tb) {
                f32x4 c4 = (f32x4){0.f, 0.f, 0.f, 0.f};
                bf16x8 b0, b1;
                if (mat >= 2) { b0 = frag_rm(sAq, TLD, tb * 16, 0, lane); b1 = frag_rm(sAq, TLD, tb * 16, 32, lane); }
                else { b0 = frag_cm(bT, TLD, 0, tb * 16, lane); b1 = frag_cm(bT, TLD, 32, tb * 16, lane); }
                if (mat == 2) { const uint2 qr = *(const uint2*)(sQd + (tb * 16 + li) * TLD + ta * 16 + 4 * g);
                    c4 = (f32x4){__uint_as_float(qr.x << 16), __uint_as_float(qr.x & 0xffff0000u), __uint_as_float(qr.y << 16), __uint_as_float(qr.y & 0xffff0000u)}; }
                c4 = MFMA16(a0, b0, c4); c4 = MFMA16(a1, b1, c4);
                uint2 o; o.x = pk2(c4[0], c4[1]); o.y = pk2(c4[2], c4[3]);
                *(uint2*)(gt + (tb * 16 + li) * 64 + ta * 16 + 4 * g) = o;
            }
        }
    }
#undef GP_SAQ
#undef GP_SU
#undef GP_SWN
#undef GP_SG
#undef GP_SBETA
#undef GP_RHS
#undef GP_SM
#undef GP_SK
#undef GP_SQ
}

__device__ __forceinline__ void gdn_scan_task(char* smem, const bf16_t* __restrict__ gt_all, const float* __restrict__ glast, bf16_t* __restrict__ gs_all, int bh) {
    bf16_t* sT = (bf16_t*)smem;
    bf16_t* sST = sT + 2 * 2 * 64 * TLD;
    const int tid = TIDX, lane = tid & 63, wave = tid >> 6, g = lane >> 4, li = lane & 15;
    const int sr = tid >> 3, sc8 = (tid & 7) * 8;
    const bf16_t* gsrc = gt_all + (size_t)bh * 32 * 5 * 4096 + sr * 64 + sc8;
    bf16_t* gdst = gs_all + (size_t)bh * 32 * 4096 + sr * 64 + sc8;
    __syncthreads();
    u32x4 rs0[2], rs1[2], rs2[2], rs3[2];
#define GS_LOAD(RS, n) { RS[0] = *(const u32x4*)(gsrc + (size_t)(n) * 5 * 4096); RS[1] = *(const u32x4*)(gsrc + (size_t)(n) * 5 * 4096 + 4096); }
#define GS_STORE(RS, buf) { bf16_t* nT = sT + (buf) * 2 * 64 * TLD; *(u32x4*)(nT + sr * TLD + sc8) = RS[0]; *(u32x4*)(nT + 64 * TLD + sr * TLD + sc8) = RS[1]; }
    GS_LOAD(rs0, 0) GS_LOAD(rs1, 1) GS_LOAD(rs2, 2) GS_LOAD(rs3, 3)
    const float glv = glast[bh * 32 + (lane & 31)];
    GS_STORE(rs0, 0)
    *(u32x4*)(sST + sr * TLD + sc8) = (u32x4){0u, 0u, 0u, 0u};
    const int kot = wave & 3, vt0 = (wave >> 2) * 2;
    f32x4 sacc[2] = {(f32x4){0.f, 0.f, 0.f, 0.f}, (f32x4){0.f, 0.f, 0.f, 0.f}};
    __syncthreads();
#define GS_STEP(n, LSET, SSET) { \
        const int buf = (n) & 1; \
        GS_LOAD(LSET, min((n) + 4, 31))        \
        const bf16_t* cA = sT + buf * 2 * 64 * TLD; const bf16_t* cB = cA + 64 * TLD; const bf16_t* cST = sST + buf * 64 * TLD; bf16_t* nST = sST + (buf ^ 1) * 64 * TLD; \
        *(u32x4*)(gdst + (size_t)(n) * 4096) = *(const u32x4*)(cST + sr * TLD + sc8);        \
        const float gl = __shfl(glv, (n)); \
        const bf16x8 af0 = frag_rm(cA, TLD, kot * 16, 0, lane), af1 = frag_rm(cA, TLD, kot * 16, 32, lane); \
        _Pragma("unroll") for (int i = 0; i < 2; ++i) { const int vt = vt0 + i; \
            const uint2 braw = *(const uint2*)(cB + (vt * 16 + li) * TLD + kot * 16 + 4 * g); \
            f32x4 c4 = sacc[i] * gl + (f32x4){__uint_as_float(braw.x << 16), __uint_as_float(braw.x & 0xffff0000u), __uint_as_float(braw.y << 16), __uint_as_float(braw.y & 0xffff0000u)}; \
            c4 = MFMA16(af0, frag_rm(cST, TLD, vt * 16, 0, lane), c4); c4 = MFMA16(af1, frag_rm(cST, TLD, vt * 16, 32, lane), c4);        \
            sacc[i] = c4; uint2 o; o.x = pk2(c4[0], c4[1]); o.y = pk2(c4[2], c4[3]); \
            *(uint2*)(nST + (vt * 16 + li) * TLD + kot * 16 + 4 * g) = o; } \
        if ((n) + 1 < 32) GS_STORE(SSET, ((n) + 1) & 1) \
        __syncthreads(); }
    for (int n = 0; n < 32; n += 4) {
        GS_STEP(n, rs0, rs1)
        GS_STEP(n + 1, rs1, rs2)
        GS_STEP(n + 2, rs2, rs3)
        GS_STEP(n + 3, rs3, rs0)
    }
#undef GS_LOAD
#undef GS_STORE
#undef GS_STEP
}

__device__ __forceinline__ void gdn_out_pair(char* smem, const bf16_t* __restrict__ gt_all, const bf16_t* __restrict__ gs_all, const bf16_t* __restrict__ proj, const float* __restrict__ mix_gain,
                                             bf16_t* __restrict__ y, int ch0) {
    const int tid = TIDX, lane = tid & 63, wave = tid >> 6, g = lane >> 4, li = lane & 15;
    const int hf = wave >> 2, tt = wave & 3, ch = ch0 + hf;
    const int bh = ch >> 5, n = ch & 31, b = bh >> 2, h = bh & 3;
    bf16_t* sST = (bf16_t*)smem + hf * 2 * 64 * TLD;
    bf16_t* sQp = sST + 64 * TLD;
    const bf16_t* gt = gt_all + (size_t)ch * 5 * 4096;
    const int q = tid & 255;
    __syncthreads();
    u32x4 r0[2], r1[2];
#pragma unroll
    for (int i = 0; i < 2; ++i) { const int c = q + i * 256, rr = c >> 3, c8 = (c & 7) * 8; r0[i] = *(const u32x4*)(gs_all + (size_t)ch * 4096 + rr * 64 + c8); r1[i] = *(const u32x4*)(gt + 2 * 4096 + rr * 64 + c8); }
    const size_t row = (size_t)(b * SEQ + n * 64 + tt * 16 + li);
    uint2 oraw[4], zraw[4];
#pragma unroll
    for (int vt = 0; vt < 4; ++vt) { oraw[vt] = *(const uint2*)(gt + 3 * 4096 + (tt * 16 + li) * 64 + vt * 16 + 4 * g); zraw[vt] = *(const uint2*)(proj + row * NP + C_DZ + h * 64 + vt * 16 + 4 * g); }
#pragma unroll
    for (int i = 0; i < 2; ++i) { const int c = q + i * 256, rr = c >> 3, c8 = (c & 7) * 8; *(u32x4*)(sST + rr * TLD + c8) = r0[i]; *(u32x4*)(sQp + rr * TLD + c8) = r1[i]; }
    __syncthreads();
    const bf16x8 qf0 = frag_rm(sQp, TLD, tt * 16, 0, lane), qf1 = frag_rm(sQp, TLD, tt * 16, 32, lane);
    f32x4 oacc[4]; float ms = 0.f;
#pragma unroll
    for (int vt = 0; vt < 4; ++vt) {
        f32x4 c4 = (f32x4){__uint_as_float(oraw[vt].x << 16), __uint_as_float(oraw[vt].x & 0xffff0000u), __uint_as_float(oraw[vt].y << 16), __uint_as_float(oraw[vt].y & 0xffff0000u)};
        c4 = MFMA16(frag_rm(sST, TLD, vt * 16, 0, lane), qf0, c4); c4 = MFMA16(frag_rm(sST, TLD, vt * 16, 32, lane), qf1, c4);
        oacc[vt] = c4; ms += c4[0] * c4[0] + c4[1] * c4[1] + c4[2] * c4[2] + c4[3] * c4[3];
    }
    ms += __shfl_xor(ms, 16); ms += __shfl_xor(ms, 32);
    const float rinv = rsqrtf(ms * (1.f / 64.f) + EPS);
#pragma unroll
    for (int vt = 0; vt < 4; ++vt) {
        const int v0 = vt * 16 + 4 * g;
        const f32x4 mgv = *(const f32x4*)(mix_gain + 768 + h * 64 + v0);
        const float z0 = __uint_as_float(zraw[vt].x << 16), z1 = __uint_as_float(zraw[vt].x & 0xffff0000u), z2 = __uint_as_float(zraw[vt].y << 16), z3 = __uint_as_float(zraw[vt].y & 0xffff0000u);
        uint2 o; o.x = pk2(oacc[vt][0] * rinv * siluf_(z0) * mgv[0], oacc[vt][1] * rinv * siluf_(z1) * mgv[1]);
        o.y = pk2(oacc[vt][2] * rinv * siluf_(z2) * mgv[2], oacc[vt][3] * rinv * siluf_(z3) * mgv[3]);
        *(uint2*)(y + row * 1024 + 768 + h * 64 + v0) = o;
    }
}

constexpr int XLD = 264;
__device__ __forceinline__ void lru_local_task(char* smem, const bf16_t* __restrict__ proj, const float* __restrict__ conv_w, const float* __restrict__ conv_b,
                                               const float* __restrict__ w_a, const float* __restrict__ b_a, const float* __restrict__ w_x, const float* __restrict__ b_x,
                                               const float* __restrict__ lam, float* __restrict__ hl_out, float* __restrict__ ac_out, float* __restrict__ lsum, int task) {
    bf16_t* sX = (bf16_t*)smem;
    bf16_t* sW = sX + 64 * XLD;
    const int tid = TIDX, lane = tid & 63, wave = tid >> 6, g = lane >> 4, li = lane & 15;
    const int b = task >> 5, n = task & 31;
    const size_t row0 = (size_t)(b * SEQ + n * 64);
    const int t = tid >> 3;
    __syncthreads();
    {
        const int i = tid >> 3, j8 = (tid & 7) * 8;
        f32x4 wv[8][2];
#pragma unroll
        for (int mat = 0; mat < 8; ++mat) {
            const float* src = ((mat & 1) ? w_x : w_a) + (size_t)(mat >> 1) * 4096 + i * 64 + j8;
            wv[mat][0] = *(const f32x4*)src; wv[mat][1] = *(const f32x4*)(src + 4);
        }
        asm volatile("" ::: "memory");
#pragma unroll
        for (int mat = 0; mat < 8; ++mat) {
            const f32x4 v0 = wv[mat][0], v1 = wv[mat][1];
            u32x4 o; o[0] = pk2(v0[0], v0[1]); o[1] = pk2(v0[2], v0[3]); o[2] = pk2(v1[0], v1[1]); o[3] = pk2(v1[2], v1[3]);
            *(u32x4*)(sW + mat * 64 * TLD + i * TLD + j8) = o;
        }
    }
    {
        const int spos = n * 64 + t;
#pragma unroll
        for (int i = 0; i < 4; ++i) {
            const int c8 = ((tid & 7) + 8 * i) * 8;
            float acc[8];
            { const f32x4 cb0 = *(const f32x4*)(conv_b + c8), cb1 = *(const f32x4*)(conv_b + c8 + 4);
#pragma unroll
              for (int e = 0; e < 8; ++e) acc[e] = e < 4 ? cb0[e] : cb1[e - 4]; }
            u32x4 raw4[4]; f32x4 w04[4], w14[4];
#pragma unroll
            for (int j = 0; j < 4; ++j) {
                const bool ok = spos - (3 - j) >= 0;
                raw4[j] = *(const u32x4*)(proj + (row0 + t - (ok ? (3 - j) : 0)) * NP + C_CX + c8);
                w04[j] = *(const f32x4*)(conv_w + j * 256 + c8); w14[j] = *(const f32x4*)(conv_w + j * 256 + c8 + 4);
            }
#pragma unroll
            for (int j = 0; j < 4; ++j) {
                const float mk = (spos - (3 - j) >= 0) ? 1.f : 0.f;
#pragma unroll
                for (int e = 0; e < 8; ++e) acc[e] += (e < 4 ? w04[j][e] : w14[j][e - 4]) * mk * bfx(raw4[j], e);
            }
            u32x4 o; o[0] = pk2(acc[0], acc[1]); o[1] = pk2(acc[2], acc[3]); o[2] = pk2(acc[4], acc[5]); o[3] = pk2(acc[6], acc[7]);
            *(u32x4*)(sX + t * XLD + c8) = o;
        }
    }
    __syncthreads();
    const int hh = wave >> 1;
#pragma unroll
    for (int j2 = 0; j2 < 2; ++j2) {
        const int jt = (wave & 1) * 2 + j2, cl = jt * 16 + 4 * g, c = hh * 64 + cl;
        f32x4 ra[4], rx[4];
#pragma unroll
        for (int tt = 0; tt < 4; ++tt) { ra[tt] = (f32x4){0.f, 0.f, 0.f, 0.f}; rx[tt] = (f32x4){0.f, 0.f, 0.f, 0.f}; }
#pragma unroll
        for (int ks = 0; ks < 2; ++ks) {
            const bf16x8 wa = frag_cm(sW + (hh * 2) * 64 * TLD, TLD, ks * 32, jt * 16, lane), wx = frag_cm(sW + (hh * 2 + 1) * 64 * TLD, TLD, ks * 32, jt * 16, lane);
#pragma unroll
            for (int tt = 0; tt < 4; ++tt) {
                const bf16x8 xf = frag_rm(sX + hh * 64, XLD, tt * 16, ks * 32, lane);
                ra[tt] = MFMA16(wa, xf, ra[tt]);
                rx[tt] = MFMA16(wx, xf, rx[tt]);
            }
        }
        const f32x4 ba = *(const f32x4*)(b_a + c), bx = *(const f32x4*)(b_x + c), lm = *(const f32x4*)(lam + c);
        float sp[4];
#pragma unroll
        for (int r = 0; r < 4; ++r) sp[r] = softplusf_(-lm[r]);
        f32x4 cA = (f32x4){1.f, 1.f, 1.f, 1.f}, cH = (f32x4){0.f, 0.f, 0.f, 0.f};
#pragma unroll
        for (int tt = 0; tt < 4; ++tt) {
            const int tq = tt * 16 + li;
            const uint2 xraw = *(const uint2*)(sX + tq * XLD + c);
            const float xc[4] = {__uint_as_float(xraw.x << 16), __uint_as_float(xraw.x & 0xffff0000u), __uint_as_float(xraw.y << 16), __uint_as_float(xraw.y & 0xffff0000u)};
            f32x4 A, H;
#pragma unroll
            for (int r = 0; r < 4; ++r) {
                const float rr = sigmoidf_(ra[tt][r] + ba[r]), ig = sigmoidf_(rx[tt][r] + bx[r]);
                const float log_a = -8.f * rr * sp[r];
                A[r] = __expf(log_a);
                H[r] = sqrtf(fmaxf(1.f - A[r] * A[r], 0.f)) * (ig * xc[r]);
            }
#pragma unroll
            for (int o = 1; o < 16; o <<= 1) {
#pragma unroll
                for (int r = 0; r < 4; ++r) {
                    const float pA = __shfl_up(A[r], o, 16), pH = __shfl_up(H[r], o, 16);
                    if (li >= o) { H[r] = A[r] * pH + H[r]; A[r] = A[r] * pA; }
                }
            }
            const f32x4 Hf = H + A * cH, Af = A * cA;
            const size_t oidx = (row0 + tq) * 256 + c;
            *(f32x4*)(hl_out + oidx) = Hf; *(f32x4*)(ac_out + oidx) = Af;
#pragma unroll
            for (int r = 0; r < 4; ++r) { cH[r] = __shfl(Hf[r], 15, 16); cA[r] = __shfl(Af[r], 15, 16); }
            if (tt == 3 && li == 15) { *(f32x4*)(lsum + (size_t)task * 256 + c) = Af; *(f32x4*)(lsum + (size_t)(256 + task) * 256 + c) = Hf; }
        }
    }
}
__device__ __forceinline__ void lru_out_task(const float* __restrict__ hl_in, const float* __restrict__ ac_in, const float* __restrict__ lcar, const bf16_t* __restrict__ proj,
                                             const float* __restrict__ mix_gain, bf16_t* __restrict__ y, int task) {
    const int tid = TIDX, half = tid & 1, row = (tid >> 1) & 63, head = tid >> 7;
    const int b = task >> 5, n = task & 31, c0 = head * 64 + half * 32;
    const size_t grow = (size_t)(b * SEQ + n * 64 + row);
    const float* hp = hl_in + grow * 256 + c0; const float* ap = ac_in + grow * 256 + c0; const float* cp = lcar + (size_t)task * 256 + c0;
    f32x4 hv[8], av[8], cv[8]; u32x4 gr[4];
#pragma unroll
    for (int i = 0; i < 8; ++i) { hv[i] = *(const f32x4*)(hp + 4 * i); av[i] = *(const f32x4*)(ap + 4 * i); cv[i] = *(const f32x4*)(cp + 4 * i); }
#pragma unroll
    for (int i = 0; i < 4; ++i) gr[i] = *(const u32x4*)(proj + grow * NP + C_CG + c0 + 8 * i);
    float ss = 0.f;
#pragma unroll
    for (int i = 0; i < 8; ++i) {
#pragma unroll
        for (int e = 0; e < 4; ++e) {
            const int j = 4 * i + e;
            const float gate = bfx(gr[j >> 3], j & 7);
            const float yv = (hv[i][e] + av[i][e] * cv[i][e]) * geluf_(gate);
            hv[i][e] = yv; ss += yv * yv;
        }
    }
    ss += __shfl_xor(ss, 1);
    const float rinv = rsqrtf(ss * (1.f / 64.f) + EPS);
    bf16_t* yp = y + grow * 1024 + 512 + c0;
#pragma unroll
    for (int i = 0; i < 8; i += 2) {
        const f32x4 m0 = *(const f32x4*)(mix_gain + 512 + c0 + 4 * i), m1 = *(const f32x4*)(mix_gain + 512 + c0 + 4 * i + 4);
        u32x4 o; o[0] = pk2(hv[i][0] * rinv * m0[0], hv[i][1] * rinv * m0[1]); o[1] = pk2(hv[i][2] * rinv * m0[2], hv[i][3] * rinv * m0[3]);
        o[2] = pk2(hv[i + 1][0] * rinv * m1[0], hv[i + 1][1] * rinv * m1[1]); o[3] = pk2(hv[i + 1][2] * rinv * m1[2], hv[i + 1][3] * rinv * m1[3]);
        *(u32x4*)(yp + 4 * i) = o;
    }
}


__device__ __forceinline__ void state_scan_phase(const float* __restrict__ HL, const float* __restrict__ HD, bf16_t* __restrict__ HS, const float* __restrict__ lsum, float* __restrict__ lcar, int u0, int ustride) {
    const int tid = TIDX;
    for (int u = u0; u < 128 + 4; u += ustride) {
        if (u < 128) {
            const int gid = u * NTHR + tid, bh = gid >> 11, v = gid & 63, kp = (gid >> 6) & 31;
            const float* Lb = HL + (size_t)bh * 32 * 4096 + (2 * kp) * 64 + v; const float* Db = HD + (size_t)bh * 32 * 64 + 2 * kp;
            bf16_t* Sb = HS + (size_t)bh * 32 * 4096 + (2 * kp) * 64 + v;
            float S0 = 0.f, S1 = 0.f;
#pragma unroll
            for (int n0 = 0; n0 < 32; n0 += 16) {
                float l0[16], l1[16], d0[16], d1[16];
#pragma unroll
                for (int i = 0; i < 16; ++i) { l0[i] = Lb[(size_t)(n0 + i) * 4096]; l1[i] = Lb[(size_t)(n0 + i) * 4096 + 64]; d0[i] = Db[(n0 + i) * 64]; d1[i] = Db[(n0 + i) * 64 + 1]; }
#pragma unroll
                for (int i = 0; i < 16; ++i) {
                    Sb[(size_t)(n0 + i) * 4096] = f2bf(S0); Sb[(size_t)(n0 + i) * 4096 + 64] = f2bf(S1);
                    S0 = d0[i] * S0 + l0[i]; S1 = d1[i] * S1 + l1[i];
                }
            }
        } else {
            const int gid = (u - 128) * NTHR + tid, b = gid >> 8, c = gid & 255;
            float A[32], H[32];
#pragma unroll
            for (int n = 0; n < 32; ++n) { A[n] = lsum[(size_t)(b * 32 + n) * 256 + c]; H[n] = lsum[(size_t)(256 + b * 32 + n) * 256 + c]; }
            float Hc = 0.f;
#pragma unroll
            for (int n = 0; n < 32; ++n) { lcar[(size_t)(b * 32 + n) * 256 + c] = Hc; Hc = A[n] * Hc + H[n]; }
        }
    }
}


__device__ __forceinline__ void middle_task(char* smem, const bf16_t* __restrict__ x1b  , const float* __restrict__ gq  , const float* pss_in, const bf16_t* __restrict__ Wq_t  , const bf16_t* __restrict__ kv  ,
                                            const bf16_t* __restrict__ Wmo_t  , bf16_t* __restrict__ x2b, const float* __restrict__ gn, bf16_t* xg2, float* pss_out,
                                            const bf16_t* __restrict__ wr  , const float* __restrict__ b_rg, const float* __restrict__ b_re, int* __restrict__ cnt, int* __restrict__ list, float* __restrict__ pgate, float* __restrict__ prinv, int tile) {
    constexpr int QLD = 264;
    bf16_t* sQ = (bf16_t*)(smem + 92160);
    float* sZ = (float*)(smem + 92160 + 64 * QLD * 2);
    const int tid = TIDX, lane = tid & 63, wave = tid >> 6, g = lane >> 4, li = lane & 15;
    const int r0 = tile * 64, b = r0 >> 11;
    __syncthreads();
    if (tid < 64) sZ[tid] = 0.f;
    {
        const int sr = tid >> 3, sc8 = (tid & 7) * 8;
        const bf16_t* ga = x1b + (size_t)(r0 + sr) * 1024 + sc8;
        const float* gg = gq + sc8;
        const bf16_t* gb = Wq_t + (size_t)sr * 1024 + sc8;
        const int mt = wave & 3, nh = wave >> 2;
        f32x4 acc[8];
#pragma unroll
        for (int n = 0; n < 8; ++n) acc[n] = (f32x4){0.f, 0.f, 0.f, 0.f};
        u32x4 rA[5], rB[5]; f32x4 rA_g[2], rB_g[2];
#define MA_LOAD(R, kc) { R[0] = *(const u32x4*)(ga + (kc) * 64); R##_g[0] = *(const f32x4*)(gg + (kc) * 64); R##_g[1] = *(const f32x4*)(gg + (kc) * 64 + 4); _Pragma("unroll") for (int i = 0; i < 4; ++i) R[1 + i] = *(const u32x4*)(gb + (size_t)(i * 64) * 1024 + (kc) * 64); }
#define MA_STORE(R, buf) { bf16_t* dA = (bf16_t*)(smem + (buf) * 46080); bf16_t* dB = dA + 64 * TLD; \
        { u32x4 xa_; _Pragma("unroll") for (int e_ = 0; e_ < 8; e_ += 2) xa_[e_ >> 1] = pk2(bfx(R[0], e_) * R##_g[e_ >> 2][e_ & 3], bfx(R[0], e_ + 1) * R##_g[e_ >> 2][(e_ & 3) + 1]); *(u32x4*)(dA + sr * TLD + sc8) = xa_; } \
        _Pragma("unroll") for (int i = 0; i < 4; ++i) *(u32x4*)(dB + (sr + i * 64) * TLD + sc8) = R[1 + i]; }
#define MA_COMPUTE(buf) { const bf16_t* cA = (const bf16_t*)(smem + (buf) * 46080); const bf16_t* cB = cA + 64 * TLD; \
        _Pragma("unroll") for (int ks = 0; ks < 2; ++ks) { const bf16x8 af = frag_rm(cA, TLD, mt * 16, ks * 32, lane); \
            _Pragma("unroll") for (int n = 0; n < 8; ++n) acc[n] = MFMA16(frag_rm(cB, TLD, nh * 128 + n * 16, ks * 32, lane), af, acc[n]); } }
        MA_LOAD(rA, 0) MA_LOAD(rB, 1)
        MA_STORE(rA, 0)
        __syncthreads();
        for (int kc = 0; kc < 16; kc += 2) {
            MA_LOAD(rA, min(kc + 2, 15))
            MA_COMPUTE(0)
            MA_STORE(rB, 1)
            __syncthreads();
            MA_LOAD(rB, min(kc + 3, 15))
            MA_COMPUTE(1)
            if (kc + 2 < 16) MA_STORE(rA, 0)
            __syncthreads();
        }
#undef MA_LOAD
#undef MA_STORE
#undef MA_COMPUTE
        const float ri = rinv_from_pss(pss_in, (size_t)(r0 + mt * 16 + li)) * (0.125f * 1.4426950408889634f);
#pragma unroll
        for (int n = 0; n < 8; ++n) { uint2 o; o.x = pk2(acc[n][0] * ri, acc[n][1] * ri); o.y = pk2(acc[n][2] * ri, acc[n][3] * ri);
            *(uint2*)(sQ + (mt * 16 + li) * QLD + nh * 128 + n * 16 + 4 * g) = o; }
    }
    __syncthreads();
    {
        const int head = wave >> 1, mt0 = (wave & 1) * 2;
        bf16x8 qf[2][2];
#pragma unroll
        for (int m = 0; m < 2; ++m)
#pragma unroll
            for (int ks = 0; ks < 2; ++ks) qf[m][ks] = frag_rm(sQ + head * 64, QLD, (mt0 + m) * 16, ks * 32, lane);
        bf16_t* sK = (bf16_t*)smem;
        bf16_t* sV = sK + 4 * 64 * TLD;
        const int sr = tid >> 3, sc8 = (tid & 7) * 8;
        const bf16_t* kvg = kv + (size_t)(b * MEMLEN + sr) * 512 + sc8;
        u32x4 rk[4], rv[4];
#define MB_LOAD(kt) { _Pragma("unroll") for (int hh = 0; hh < 4; ++hh) { rk[hh] = *(const u32x4*)(kvg + (size_t)((kt) * 64) * 512 + hh * 64); rv[hh] = *(const u32x4*)(kvg + (size_t)((kt) * 64) * 512 + 256 + hh * 64); } }
        MB_LOAD(0)
        f32x4 oacc[2][4]; float mrun[2] = {-INFINITY, -INFINITY}, lrun[2] = {0.f, 0.f};
#pragma unroll
        for (int m = 0; m < 2; ++m)
#pragma unroll
            for (int n = 0; n < 4; ++n) oacc[m][n] = (f32x4){0.f, 0.f, 0.f, 0.f};
        constexpr float SC2 = 0.125f * 1.4426950408889634f;
        for (int kt = 0; kt < 4; ++kt) {
            __syncthreads();
#pragma unroll
            for (int hh = 0; hh < 4; ++hh) { *(u32x4*)(sK + (hh * 64 + sr) * TLD + sc8) = rk[hh]; *(u32x4*)(sV + (hh * 64 + sr) * TLD + sc8) = rv[hh]; }
            __syncthreads();
            if (kt + 1 < 4) MB_LOAD(kt + 1)
#pragma unroll
            for (int m = 0; m < 2; ++m)
                attn_compute_t<false, 1>(sK + head * 64 * TLD, sV + head * 64 * TLD, sZ, qf[m], oacc[m], mrun[m], lrun[m], 0.f, SC2, 0, 0, lane, g);
        }
#undef MB_LOAD
#pragma unroll
        for (int m = 0; m < 2; ++m) {
            const float inv = 1.f / lrun[m];
#pragma unroll
            for (int n = 0; n < 4; ++n) { uint2 o; o.x = pk2(oacc[m][n][0] * inv, oacc[m][n][1] * inv); o.y = pk2(oacc[m][n][2] * inv, oacc[m][n][3] * inv);
                *(uint2*)(sQ + ((mt0 + m) * 16 + li) * QLD + head * 64 + n * 16 + 4 * g) = o; }
        }
    }
    __syncthreads();
    {
        constexpr int WLD = 40;
        bf16_t* sWh = (bf16_t*)smem + wave * (2 * 64 * WLD);
        bf16_t* sWl = sWh + 64 * WLD;
        float* sRed = (float*)smem;
        float* sLog = sRed;
        float* sPart = (float*)(smem + 8 * 2 * 64 * WLD * 2);
        int* sCnt = (int*)(sPart + 64 * 8);
        float ssum[4] = {0.f, 0.f, 0.f, 0.f};
        f32x4 racc[4][3];
#pragma unroll
        for (int m = 0; m < 4; ++m)
#pragma unroll
            for (int e = 0; e < 3; ++e) racc[m][e] = (f32x4){0.f, 0.f, 0.f, 0.f};
        u32x4 bw[8][2];
#define MC_BWHALF(nq_, h_) { const bf16_t* wg_ = Wmo_t + (size_t)(wave * 128 + (nq_) * 32 + li) * 256 + g * 8; \
        _Pragma("unroll") for (int ks = 4 * (h_); ks < 4 * (h_) + 4; ++ks) _Pragma("unroll") for (int n = 0; n < 2; ++n) bw[ks][n] = *(const u32x4*)(wg_ + (size_t)(n * 16) * 256 + ks * 32); }
        MC_BWHALF(0, 0)
        for (int nq = 0; nq < 4; ++nq) {
            const int c0 = wave * 128 + nq * 32;
            f32x4 acc[4][2]; uint2 xr[4][2];
#pragma unroll
            for (int m = 0; m < 4; ++m)
#pragma unroll
                for (int n = 0; n < 2; ++n) { acc[m][n] = (f32x4){0.f, 0.f, 0.f, 0.f}; xr[m][n] = *(const uint2*)(x1b + (size_t)(r0 + m * 16 + li) * 1024 + c0 + n * 16 + 4 * g); }
            MC_BWHALF(nq, 1)
#pragma unroll
            for (int ks = 0; ks < 8; ++ks) {
#pragma unroll
                for (int m = 0; m < 4; ++m) {
                    const bf16x8 af = frag_rm(sQ, QLD, m * 16, ks * 32, lane);
#pragma unroll
                    for (int n = 0; n < 2; ++n) acc[m][n] = MFMA16(__builtin_bit_cast(bf16x8, bw[ks][n]), af, acc[m][n]);
                }
            }
            MC_BWHALF(min(nq + 1, 3), 0)
            u32x4 rw[3][2];
#pragma unroll
            for (int e = 0; e < 3; ++e) { const bf16_t* wp = wr + (size_t)(e * 16 + li) * 1024 + c0 + g * 8; rw[e][0] = *(const u32x4*)wp; rw[e][1] = *(const u32x4*)(wp + 48 * 1024); }
#pragma unroll
            for (int m = 0; m < 4; ++m) {
                const size_t row = (size_t)(r0 + m * 16 + li);
#pragma unroll
                for (int n = 0; n < 2; ++n) {
                    const int col = c0 + n * 16 + 4 * g;
                    const f32x4 o = (f32x4){__uint_as_float(xr[m][n].x << 16), __uint_as_float(xr[m][n].x & 0xffff0000u), __uint_as_float(xr[m][n].y << 16), __uint_as_float(xr[m][n].y & 0xffff0000u)} + acc[m][n];
                    { uint2 w2; w2.x = pk2(o[0], o[1]); w2.y = pk2(o[2], o[3]); *(uint2*)(x2b + row * 1024 + col) = w2; }
                    ssum[m] += (o[0] * o[0] + o[1] * o[1]) + (o[2] * o[2] + o[3] * o[3]);
                    const f32x4 og = o * *(const f32x4*)(gn + col);
                    uint2 wh; wh.x = pk2(og[0], og[1]); wh.y = pk2(og[2], og[3]);
                    *(uint2*)(xg2 + row * 1024 + col) = wh;
                    uint2 wl; wl.x = pk2(og[0] - __uint_as_float(wh.x << 16), og[1] - __uint_as_float(wh.x & 0xffff0000u)); wl.y = pk2(og[2] - __uint_as_float(wh.y << 16), og[3] - __uint_as_float(wh.y & 0xffff0000u));
                    const int lc = (m * 16 + li) * WLD + n * 16 + 4 * g;
                    *(uint2*)(sWh + lc) = wh; *(uint2*)(sWl + lc) = wl;
                }
            }
            asm volatile("" ::: "memory");
#pragma unroll
            for (int m = 0; m < 4; ++m) {
                const bf16x8 xh = frag_rm(sWh, WLD, m * 16, 0, lane), xl = frag_rm(sWl, WLD, m * 16, 0, lane);
#pragma unroll
                for (int e = 0; e < 3; ++e) {
                    const bf16x8 fh = __builtin_bit_cast(bf16x8, rw[e][0]), fl = __builtin_bit_cast(bf16x8, rw[e][1]);
                    racc[m][e] = MFMA16(fh, xh, racc[m][e]); racc[m][e] = MFMA16(fl, xh, racc[m][e]); racc[m][e] = MFMA16(fh, xl, racc[m][e]);
                }
            }
            asm volatile("" ::: "memory");
        }
#undef MC_BWHALF
        __syncthreads();
#pragma unroll
        for (int m = 0; m < 4; ++m) {
            float ss = ssum[m]; ss += __shfl_xor(ss, 16); ss += __shfl_xor(ss, 32);
            if (g == 0) { pss_out[(size_t)(r0 + m * 16 + li) * 16 + wave] = ss; pss_out[(size_t)(r0 + m * 16 + li) * 16 + 8 + wave] = 0.f; sPart[(m * 16 + li) * 8 + wave] = ss; }
        }
        if (wave >= 4) {
#pragma unroll
            for (int m = 0; m < 4; ++m)
#pragma unroll
                for (int e = 0; e < 3; ++e) *(f32x4*)(sRed + (wave - 4) * 3072 + (m * 16 + li) * 48 + e * 16 + 4 * g) = racc[m][e];
        }
        __syncthreads();
        if (wave < 4) {
#pragma unroll
            for (int m = 0; m < 4; ++m)
#pragma unroll
                for (int e = 0; e < 3; ++e) { f32x4* q = (f32x4*)(sRed + wave * 3072 + (m * 16 + li) * 48 + e * 16 + 4 * g); *q = racc[m][e] + *q; }
        }
        __syncthreads();
        for (int i = tid; i < 3072; i += NTHR) sLog[i] = (sRed[i] + sRed[3072 + i]) + (sRed[2 * 3072 + i] + sRed[3 * 3072 + i]);
        if (tid < 64) sCnt[tid] = 0;
        __syncthreads();
        int ex0 = 0, ex1 = 0, lr0 = 0, lr1 = 0; float gw0 = 0.f, gw1 = 0.f, rtk = 0.f;
        if (tid < 64) {
            const float* pp = sPart + tid * 8;
            const float rinv = rsqrtf((((pp[0] + pp[1]) + (pp[2] + pp[3])) + ((pp[4] + pp[5]) + (pp[6] + pp[7]))) * (1.f / 1024.f) + EPS);
            rtk = rinv;
            const float* l0 = sLog + tid * 48;
            const f32x4 brg = *(const f32x4*)b_rg;
            float lg[4];
#pragma unroll
            for (int i = 0; i < 4; ++i) lg[i] = l0[i] * rinv + brg[i];
            int gs = 0; float gm = lg[0];
#pragma unroll
            for (int i = 1; i < 4; ++i) if (lg[i] > gm) { gm = lg[i]; gs = i; }
            float den = 0.f;
#pragma unroll
            for (int i = 0; i < 4; ++i) den += __expf(lg[i] - gm);
            const float pg = 1.f / den;
            int i0 = 0, i1 = -1; float m0 = -INFINITY, m1 = -INFINITY;
            const f32x4 bre0 = *(const f32x4*)(b_re + gs * 8), bre1 = *(const f32x4*)(b_re + gs * 8 + 4);
#pragma unroll
            for (int i = 0; i < 8; ++i) {
                const float v = l0[4 + gs * 8 + i] * rinv + (i < 4 ? bre0[i & 3] : bre1[i & 3]);
                if (v > m0) { m1 = m0; i1 = i0; m0 = v; i0 = i; } else if (v > m1) { m1 = v; i1 = i; }
            }
            const float e1 = __expf(m1 - m0);
            gw0 = pg / (1.f + e1); gw1 = pg * e1 / (1.f + e1);
            ex0 = gs * 8 + i0; ex1 = gs * 8 + i1;
            lr0 = atomicAdd(&sCnt[ex0], 1); lr1 = atomicAdd(&sCnt[ex1], 1);
        }
        __syncthreads();
        if (tid < 32) { const int c = sCnt[tid]; sCnt[32 + tid] = c ? atomicAdd(&cnt[tid * CNT_STRIDE], c) : 0; }
        __syncthreads();
        if (tid < 64) {
            const int t = r0 + tid;
            list[(size_t)ex0 * T + sCnt[32 + ex0] + lr0] = 2 * t; pgate[2 * t] = gw0; prinv[2 * t] = rtk;
            list[(size_t)ex1 * T + sCnt[32 + ex1] + lr1] = 2 * t + 1; pgate[2 * t + 1] = gw1; prinv[2 * t + 1] = rtk;
        }
    }
}

__device__ __forceinline__ void router_phase(char* smem, const float* __restrict__ x, const float* __restrict__ g, const bf16_t* __restrict__ wr  , const float* __restrict__ b_rg,
                                             const float* __restrict__ b_re, const float* __restrict__ pss, int* __restrict__ cnt, int* __restrict__ list, float* __restrict__ pgate) {
    bf16_t* sXh = (bf16_t*)smem;
    bf16_t* sXl = sXh + 64 * TLD;
    float* sLog = (float*)(sXl + 64 * TLD);
    const int tid = TIDX, lane = tid & 63, wave = tid >> 6, gq = lane >> 4, li = lane & 15;
    const int mt = wave & 3, kh = wave >> 2;
    const int stok = tid >> 3, c8 = (tid & 7) * 8;
    BLK_LOOP(tile, T / 64) {
        const int t0 = tile * 64;
        f32x4 acc[3];
#pragma unroll
        for (int n = 0; n < 3; ++n) acc[n] = (f32x4){0.f, 0.f, 0.f, 0.f};
        const float* xp = x + (size_t)(t0 + stok) * 1024 + c8;
        const bf16_t* wp = wr + (size_t)li * 1024 + kh * 32 + gq * 8;
        f32x4 x0 = *(const f32x4*)xp, x1 = *(const f32x4*)(xp + 4);
        u32x4 wh[3], wl[3];
#pragma unroll
        for (int n = 0; n < 3; ++n) { wh[n] = *(const u32x4*)(wp + n * 16 * 1024); wl[n] = *(const u32x4*)(wp + 48 * 1024 + n * 16 * 1024); }
        for (int kc = 0; kc < 16; ++kc) {
            const f32x4 g0 = *(const f32x4*)(g + kc * 64 + c8), g1 = *(const f32x4*)(g + kc * 64 + c8 + 4);
            const f32x4 v0 = x0 * g0, v1 = x1 * g1;
            u32x4 oh, ol;
#pragma unroll
            for (int j = 0; j < 2; ++j) {
                const unsigned h0 = pk2(v0[2 * j], v0[2 * j + 1]), h1 = pk2(v1[2 * j], v1[2 * j + 1]);
                oh[j] = h0; oh[2 + j] = h1;
                ol[j] = pk2(v0[2 * j] - __uint_as_float(h0 << 16), v0[2 * j + 1] - __uint_as_float(h0 & 0xffff0000u));
                ol[2 + j] = pk2(v1[2 * j] - __uint_as_float(h1 << 16), v1[2 * j + 1] - __uint_as_float(h1 & 0xffff0000u));
            }
            __syncthreads();
            *(u32x4*)(sXh + stok * TLD + c8) = oh; *(u32x4*)(sXl + stok * TLD + c8) = ol;
            __syncthreads();
            u32x4 cwh[3], cwl[3];
#pragma unroll
            for (int n = 0; n < 3; ++n) { cwh[n] = wh[n]; cwl[n] = wl[n]; }
            if (kc + 1 < 16) {
                x0 = *(const f32x4*)(xp + (kc + 1) * 64); x1 = *(const f32x4*)(xp + (kc + 1) * 64 + 4);
#pragma unroll
                for (int n = 0; n < 3; ++n) { wh[n] = *(const u32x4*)(wp + n * 16 * 1024 + (kc + 1) * 64); wl[n] = *(const u32x4*)(wp + 48 * 1024 + n * 16 * 1024 + (kc + 1) * 64); }
            }
            const bf16x8 xh = frag_rm(sXh, TLD, mt * 16, kh * 32, lane), xl = frag_rm(sXl, TLD, mt * 16, kh * 32, lane);
#pragma unroll
            for (int n = 0; n < 3; ++n) {
                const bf16x8 fh = __builtin_bit_cast(bf16x8, cwh[n]), fl = __builtin_bit_cast(bf16x8, cwl[n]);
                acc[n] = MFMA16(fh, xh, acc[n]);
                acc[n] = MFMA16(fl, xh, acc[n]);
                acc[n] = MFMA16(fh, xl, acc[n]);
            }
        }
#pragma unroll
        for (int n = 0; n < 3; ++n) *(f32x4*)(sLog + (kh * 64 + mt * 16 + li) * 48 + n * 16 + 4 * gq) = acc[n];
        __syncthreads();
        int* sCnt = (int*)(sLog + 2 * 64 * 48);
        if (tid < 64) sCnt[tid] = 0;
        __syncthreads();
        int ex0 = 0, ex1 = 0, lr0 = 0, lr1 = 0; float gw0 = 0.f, gw1 = 0.f;
        if (tid < 64) {
            const float rinv = rinv_from_pss(pss, (size_t)(t0 + tid));
            const float* l0 = sLog + tid * 48; const float* l1 = sLog + (64 + tid) * 48;
            float lg[4];
#pragma unroll
            for (int i = 0; i < 4; ++i) lg[i] = (l0[i] + l1[i]) * rinv + b_rg[i];
            int gs = 0; float gm = lg[0];
#pragma unroll
            for (int i = 1; i < 4; ++i) if (lg[i] > gm) { gm = lg[i]; gs = i; }
            float den = 0.f;
#pragma unroll
            for (int i = 0; i < 4; ++i) den += __expf(lg[i] - gm);
            const float pg = 1.f / den;
            int i0 = 0, i1 = -1; float m0 = -INFINITY, m1 = -INFINITY;
            for (int i = 0; i < 8; ++i) {
                const float v = (l0[4 + gs * 8 + i] + l1[4 + gs * 8 + i]) * rinv + b_re[gs * 8 + i];
                if (v > m0) { m1 = m0; i1 = i0; m0 = v; i0 = i; } else if (v > m1) { m1 = v; i1 = i; }
            }
            const float e1 = __expf(m1 - m0);
            gw0 = pg / (1.f + e1); gw1 = pg * e1 / (1.f + e1);
            ex0 = gs * 8 + i0; ex1 = gs * 8 + i1;
            lr0 = atomicAdd(&sCnt[ex0], 1); lr1 = atomicAdd(&sCnt[ex1], 1);
        }
        __syncthreads();
        if (tid < 32) { const int c = sCnt[tid]; sCnt[32 + tid] = c ? atomicAdd(&cnt[tid * CNT_STRIDE], c) : 0; }
        __syncthreads();
        if (tid < 64) {
            const int t = t0 + tid;
            list[(size_t)ex0 * T + sCnt[32 + ex0] + lr0] = 2 * t; pgate[2 * t] = gw0;
            list[(size_t)ex1 * T + sCnt[32 + ex1] + lr1] = 2 * t + 1; pgate[2 * t + 1] = gw1;
        }
        __syncthreads();
    }
}

__device__ __forceinline__ void combine_phase(const bf16_t* __restrict__ x2b, const bf16_t* __restrict__ eo, const float* __restrict__ g, float* __restrict__ xout, bf16_t* __restrict__ x3b, bf16_t* __restrict__ hn, int mode, const int* __restrict__ rowpos) {
    const int lane = TIDX & 63;
    for (int t = blockIdx.x * 8 + (TIDX >> 6); t < T; t += gridDim.x * 8) {
        f32x4 v[4]; float s = 0.f;
        const size_t p0 = (size_t)rowpos[2 * t], p1 = (size_t)rowpos[2 * t + 1];
#pragma unroll
        for (int j = 0; j < 4; ++j) {
            const int c = (lane + 64 * j) * 4;
            const uint2 xr = *(const uint2*)(x2b + (size_t)t * 1024 + c);
            const uint2 e0 = *(const uint2*)(eo + p0 * 1024 + c), e1 = *(const uint2*)(eo + p1 * 1024 + c);
            v[j].x = __uint_as_float(xr.x << 16) + (__uint_as_float(e0.x << 16) + __uint_as_float(e1.x << 16));
            v[j].y = __uint_as_float(xr.x & 0xffff0000u) + (__uint_as_float(e0.x & 0xffff0000u) + __uint_as_float(e1.x & 0xffff0000u));
            v[j].z = __uint_as_float(xr.y << 16) + (__uint_as_float(e0.y << 16) + __uint_as_float(e1.y << 16));
            v[j].w = __uint_as_float(xr.y & 0xffff0000u) + (__uint_as_float(e0.y & 0xffff0000u) + __uint_as_float(e1.y & 0xffff0000u));
            s += v[j].x * v[j].x + v[j].y * v[j].y + v[j].z * v[j].z + v[j].w * v[j].w;
        }
        const float rinv = rsqrtf(wave_sum(s) * (1.f / 1024.f) + EPS);
#pragma unroll
        for (int j = 0; j < 4; ++j) {
            const int c = (lane + 64 * j) * 4;
            const f32x4 gg = *(const f32x4*)(g + c);
            const f32x4 hv = v[j] * rinv * gg;
            if (mode == 0) {
                uint2 o3; o3.x = pk2(v[j].x, v[j].y); o3.y = pk2(v[j].z, v[j].w);
                *(uint2*)(x3b + (size_t)t * 1024 + c) = o3;
                uint2 o; o.x = pk2(hv.x, hv.y); o.y = pk2(hv.z, hv.w);
                *(uint2*)(hn + (size_t)t * 1024 + c) = o;
            } else {
                *(f32x4*)(xout + (size_t)t * 1024 + c) = hv;
            }
        }
    }
}

template <int l>
__device__ __forceinline__ void layer_body(const Params& P, char* smem, const XcdBarrier& xb, const float* xcur) {
    char* ws = P.ws;
    bf16_t* Wt_in = (bf16_t*)(ws + OFF_WIN); bf16_t* Wt_out = (bf16_t*)(ws + OFF_WOUT); bf16_t* Wt_mq = (bf16_t*)(ws + OFF_WMQ); bf16_t* Wt_mkv = (bf16_t*)(ws + OFF_WMKV);
    bf16_t* Wt_mo = (bf16_t*)(ws + OFF_WMO); bf16_t* Wt_gu = (bf16_t*)(ws + OFF_WGU); bf16_t* Wt_dn = (bf16_t*)(ws + OFF_WDN);
    bf16_t* hn = (bf16_t*)(ws + OFF_HN); bf16_t* proj = (bf16_t*)(ws + OFF_PROJ); float* gates = (float*)(ws + OFF_GATES); bf16_t* y = (bf16_t*)(ws + OFF_Y);
    float* XA = P.out; float* XB = (float*)(ws + OFF_XB);
    bf16_t* qm = (bf16_t*)(ws + OFF_QM); bf16_t* om = (bf16_t*)(ws + OFF_OM); bf16_t* kvm = (bf16_t*)(ws + OFF_KVM); bf16_t* memn = (bf16_t*)(ws + OFF_MEMN);
    float* foxc = (float*)(ws + OFF_FOXC); float* lrua = (float*)(ws + OFF_LRUA); float* lruu = (float*)(ws + OFF_LRUU);
    int* cnt_all = (int*)(ws + OFF_CTL) + CTL_CNT_WORD; int* list = (int*)(ws + OFF_LIST); float* pgate = (float*)(ws + OFF_PGATE);
    bf16_t* act = (bf16_t*)(ws + OFF_ACT); bf16_t* eo = (bf16_t*)(ws + OFF_EO); float* pss = (float*)(ws + OFF_PSS);
    int* rowpos = (int*)(ws + OFF_OM);
    const int wave = TIDX >> 6, lane = TIDX & 63;


        bf16_t* x1b = (bf16_t*)(ws + OFF_XB); bf16_t* x2b = x1b + (size_t)T * 1024; bf16_t* x3b = (bf16_t*)P.out;
        int* cnt = cnt_all + 32 * CNT_STRIDE * l;
        const float* mg = P.in[I_MIX_GAIN] + l * 1024;
        REP(2, { pg8::Gemm g{hn, Wt_in + (size_t)l * NP * 1024, T, NP, 1024}; pg8::StaticOrder S; S.init(T, NP, (int)gridDim.x, (int)blockIdx.x);
                 pg8::EpiInProj E{proj, NP, gates, C_GATE};
                 pg8::gemm_phase<pg8::EpiInProj, pg8::StaticOrder, true, true>((PG8_LAS unsigned char*)smem, g, S, E); });
        if (l == 0) for (int l2 = 0; l2 < NL; ++l2)
            gemm_phase<EPI_BF16>(smem, memn + (size_t)l2 * 2048 * 1024, 1024, Wt_mkv + (size_t)l2 * 512 * 1024, 1024, 2048, 512, 1024, kvm + (size_t)l2 * 2048 * 512, 512, nullptr, nullptr,
                                 (gridDim.x >= 192) ? ((int)blockIdx.x - 128 - 32 * l2) : (int)blockIdx.x, (gridDim.x >= 192) ? 4096 : (int)gridDim.x);
        GSYNC();
        unsigned* fl_scan = (unsigned*)(ws + OFF_CTL) + CTL_FLAG_WORD + 64 * (2 * l + 1);
        {
            const int bx = blockIdx.x;
            bf16_t* gtiles = (bf16_t*)(ws + OFF_GDN); float* glast = (float*)(ws + OFF_GLAST);
            for (int bh = bx; bh < 32; bh += (int)gridDim.x) fox_cumsum_block(smem, gates, P.in[I_FOX_FB] + l * 4, foxc, bh);
            BLK_LOOP(cp, 512) gdn_prep_pair(smem, proj, gates, P.in[I_GDN_CONV_W] + l * 4 * 768, P.in[I_GDN_A_LOG] + l * 4, P.in[I_GDN_DT_BIAS] + l * 4, gtiles, glast, 2 * cp);
            {
                HlPre pc, pn; float lbk[8]; int hc = -1;
                if (bx < 1024) hgrn_local_prefetch(proj, bx, pc);
                BLK_LOOP(ch, 1024) {
                    const int h = (ch >> 5) & 3;
                    if (h != hc) { hgrn_lbk(P.in[I_HGRN_LB], l, h, lbk); hc = h; }
                    hgrn_local_prefetch(proj, min(ch + (int)gridDim.x, 1023), pn);
                    hgrn_local_task(smem, pc, lbk, (float*)(ws + OFF_HL), (float*)(ws + OFF_HD), ch);
                    pc = pn;
                }
            }
            BLK_LOOP(task, 256) lru_local_task(smem, proj, P.in[I_LRU_CONV_W] + l * 1024, P.in[I_LRU_CONV_B] + l * 256, P.in[I_LRU_WA] + l * 16384, P.in[I_LRU_BA] + l * 256,
                                               P.in[I_LRU_WX] + l * 16384, P.in[I_LRU_BX] + l * 256, P.in[I_LRU_LAM] + l * 256, lrua, lruu, (float*)(ws + OFF_LSUM), task);
        }
        GSYNC();
        {
            const int natt = (SEQ / 128) * 4 * NB;
            const int bx = blockIdx.x, G = (int)gridDim.x;
            unsigned* fl_gdn = (unsigned*)(ws + OFF_CTL) + CTL_FLAG_WORD + 64 * (2 * l);
            bf16_t* gstate = (bf16_t*)(ws + OFF_QM);
            if (bx < 32) { gdn_scan_task(smem, (const bf16_t*)(ws + OFF_GDN), (const float*)(ws + OFF_GLAST), gstate, bx); flag_signal(fl_gdn, 1u); }
            else {
                const int u0 = bx - 32;
                if (u0 < 132) {
                    state_scan_phase((const float*)(ws + OFF_HL), (const float*)(ws + OFF_HD), (bf16_t*)(ws + OFF_HS), (const float*)(ws + OFF_LSUM), (float*)(ws + OFF_LCAR), u0, G - 32);
                    flag_signal(fl_scan, (unsigned)((132 - u0 + (G - 32) - 1) / (G - 32)));
                }
            }
            for (int r = 0; r * G < natt; ++r) {
                const int i = r * G + ((r & 1) ? (G - 1 - bx) : bx);
                if (i >= natt) continue;
                const int qt = 15 - (i >> 5), bh = i & 31;
                attn_task(smem, proj + C_BQ, NP, proj + C_BK, NP, proj + C_BV, NP, foxc, SEQ, SEQ, 1, 0.125f, y + 256, 1024, mg + 256, 1, (bh * 16) + qt);
            }
            flag_wait(fl_scan, 132u);
            {
                HoPre pc, pn; float lbk[8]; int hc = -1;
#define HO_CH(i_) ((((i_) & 31) * 32) + (31 - ((i_) >> 5)))
#define HO_TASK(k_) ((G != 256) ? ((bx + (k_) * G < 1024) ? bx + (k_) * G : -1) : (bx < 164) ? (((k_) < 3) ? bx + 256 * (k_) : -1) : ((k_) < 4) ? bx + 256 * (k_) : \
                     ((k_) < 6 && (bx - 164) + 92 * ((k_) - 4) < 164) ? (bx - 164) + 92 * ((k_) - 4) + 768 : -1)
                int k = 0, i = HO_TASK(0);
                if (i >= 0) hgrn_out_prefetch(proj, (const bf16_t*)(ws + OFF_HS), HO_CH(i), pc);
                while (i >= 0) {
                    const int ch = HO_CH(i), h = (ch >> 5) & 3;
                    if (h != hc) { hgrn_lbk(P.in[I_HGRN_LB], l, h, lbk); hc = h; }
                    const int inext = HO_TASK(k + 1);
                    hgrn_out_prefetch(proj, (const bf16_t*)(ws + OFF_HS), HO_CH(inext >= 0 ? inext : i), pn);
                    hgrn_out_task(smem, pc, lbk, mg, y, ch);
                    pc = pn; i = inext; ++k;
                }
#undef HO_TASK
#undef HO_CH
            }
            BLK_LOOP(i, 256) lru_out_task(lrua, lruu, (const float*)(ws + OFF_LCAR), proj, mg, y, i);
            flag_wait(fl_gdn, 32u);
            BLK_LOOP(cp, 512) gdn_out_pair(smem, (const bf16_t*)(ws + OFF_GDN), gstate, proj, mg, y, 2 * cp);
        }
        GSYNC();
        { pg8::Gemm g{y, Wt_out + (size_t)l * 1024 * 1024, T, 1024, 1024}; pg8::StaticOrder S; S.init(T, 1024, (int)gridDim.x, (int)blockIdx.x);
          if (l == 0) { pg8::EpiResidNorm<false> E{(const void*)P.in[I_X], x1b, 1024, pss}; pg8::gemm_phase<pg8::EpiResidNorm<false>, pg8::StaticOrder, true, true>((PG8_LAS unsigned char*)smem, g, S, E); }
          else { pg8::EpiResidNorm<true> E{(const void*)x3b, x1b, 1024, pss}; pg8::gemm_phase<pg8::EpiResidNorm<true>, pg8::StaticOrder, true, true>((PG8_LAS unsigned char*)smem, g, S, E); } }
        GSYNC();
        REP(64, BLK_LOOP(tile, T / 64) middle_task(smem, x1b, P.in[I_NORM_MEM] + l * 1024, pss, Wt_mq + (size_t)l * 256 * 1024, kvm + (size_t)l * 2048 * 512, Wt_mo + (size_t)l * 1024 * 256, x2b, P.in[I_NORM_FFN] + l * 1024, hn, pss,
                                                            (const bf16_t*)(ws + OFF_WR) + (size_t)l * 2 * 48 * 1024, P.in[I_B_RG] + l * 4, P.in[I_B_RE] + l * 32, cnt, list, pgate, (float*)(ws + OFF_PRINV), tile));
        GSYNC();
        unsigned* flA = (unsigned*)(ws + OFF_CTL) + CTL_FLAG_WORD + 64 * (4 + 2 * l); unsigned* flB = flA + 64;
        moe_phase<1>(smem, hn, 1024, Wt_gu + (size_t)l * 32 * 512 * 1024, (size_t)512 * 1024, 1024, 1024, cnt, list, pgate, act, pss, rowpos, flA, flB, (const float*)(ws + OFF_PRINV));
        {
            int* tpre = (int*)(smem + pg8::STAGE_BYTES + 64);
            __syncthreads();
            if (TIDX < 64) {
                const int ln = TIDX; int nt = (ln < NEXP) ? ((cnt[ln * CNT_STRIDE] + 255) >> 8) : 0; int inc = nt;
#pragma unroll
                for (int o = 1; o < 64; o <<= 1) { const int nb = __shfl_up(inc, o); if (ln >= o) inc += nb; }
                if (ln <= NEXP) tpre[ln] = inc - nt;
            }
            __syncthreads();
            const int nblk = tpre[NEXP];
            int* blk2e = tpre + 64;
            if (TIDX < nblk) { int e = 0; for (int i = 1; i < NEXP; ++i) if (tpre[i] <= (int)TIDX) e = i; blk2e[TIDX] = e; }
            __syncthreads();
            pg8::Gemm g{act, Wt_dn + (size_t)l * 32 * 1024 * 256, nblk * 256, 1024, 256};
            pg8::MoeOrder S{blk2e, nblk * 4, (int)gridDim.x, vcu_id(), (size_t)1024 * 256 * 2};
            const int nu = nblk * 4;
            if (gridDim.x == 256 && nu >= 512 && nu <= 768) {
                const int n3 = nu - 512, n2 = 256 - n3, ue = min(512, min(3 * n2, nu)), v = vcu_id();
                flag_wait(flA, 256u);
                if (v >= n3) { S.nunits = ue; S.G = n2; S.c = v - n3; }
                else { flag_wait(flB, (unsigned)n3); S.nunits = nu; S.G = n3; S.c = ue + v; }
            } else { GSYNC(); }
            pg8::EpiBf16P E{eo, 1024};
            pg8::gemm_phase<pg8::EpiBf16P, pg8::MoeOrder, false, true>((PG8_LAS unsigned char*)smem, g, S, E);
        }
        GSYNC();
        if (l == 0) { combine_phase(x2b, eo, P.in[I_NORM_MIX] + 1024, nullptr, x3b, hn, 0, rowpos); GSYNC(); }
        else combine_phase(x2b, eo, P.in[I_NORM_FINAL], P.out, nullptr, hn, 1, rowpos);
}
__global__ void __launch_bounds__(NTHR, 2) mega_kernel(Params P) {
    extern __shared__ __attribute__((aligned(16))) char smem[];
    volatile LDS_AS unsigned* st = (volatile LDS_AS unsigned*)(smem + LDS_BYTES - 16);
    if (TIDX < 4) st[TIDX] = 0u;
    __syncthreads();
    if (PROBE_TS >= 0 && TIDX == 0) *(volatile unsigned*)(smem + LDS_BYTES - 1032) = 0u;
    __syncthreads();
    const XcdBarrier xb = xcd_barrier_post((unsigned*)(P.ws + OFF_CTL), st);
    TS_STAMP();
    phase0(P, smem);
    GSYNC();
    layer_body<0>(P, smem, xb, P.in[I_X]);
    layer_body<1>(P, smem, xb, P.out);
    if (PROBE_TS >= 0) {
        __syncthreads();
        if (blockIdx.x == 0 && TIDX == 0) {
            volatile unsigned long long* ts_ = (volatile unsigned long long*)(smem + LDS_BYTES - 1024);
            const unsigned long long tend = __builtin_amdgcn_s_memrealtime();
            const unsigned n_ = *(volatile unsigned*)(smem + LDS_BYTES - 1032);
            const unsigned long long t1 = ((unsigned)PROBE_TS + 1 < n_) ? ts_[PROBE_TS + 1] : tend, t0 = ts_[PROBE_TS];
            const unsigned long long wait = (t1 - t0) * PROBE_K;
            while (__builtin_amdgcn_s_memrealtime() - tend < wait) __builtin_amdgcn_s_sleep(8);
        }
    }
}

extern "C" void kernel_launch(void* const* d_in, const int* in_sizes, int n_in, void* d_out, int out_size, void* d_ws, size_t ws_size, hipStream_t stream) {
    static int grid_blocks = 0;
    if (grid_blocks == 0) {
        if (n_in != N_INPUTS || ws_size < OFF_END || out_size != T * 1024) { fprintf(stderr, "kernel_launch: unexpected sizes n_in=%d ws=%zu out=%d (need ws >= %zu)\n", n_in, ws_size, out_size, (size_t)OFF_END); grid_blocks = -1; return; }
        int dev = 0, cus = 0, per_cu = 0;
        if (hipGetDevice(&dev) != hipSuccess || hipDeviceGetAttribute(&cus, hipDeviceAttributeMultiprocessorCount, dev) != hipSuccess) { fprintf(stderr, "kernel_launch: device query failed\n"); grid_blocks = -1; return; }
        if (hipFuncSetAttribute((const void*)mega_kernel, hipFuncAttributeMaxDynamicSharedMemorySize, LDS_BYTES) != hipSuccess) { fprintf(stderr, "kernel_launch: hipFuncSetAttribute failed\n"); grid_blocks = -1; return; }
        if (hipOccupancyMaxActiveBlocksPerMultiprocessor(&per_cu, (const void*)mega_kernel, NTHR, LDS_BYTES) != hipSuccess || per_cu < 1) { fprintf(stderr, "kernel_launch: occupancy query says %d blocks/CU\n", per_cu); grid_blocks = -1; return; }
        grid_blocks = cus;
        fprintf(stderr, "kernel_launch: cus=%d per_cu=%d grid=%d\n", cus, per_cu, grid_blocks);
    }
    if (grid_blocks < 0) return;
    if (hipMemsetAsync((char*)d_ws + OFF_CTL, 0, CTL_BYTES, stream) != hipSuccess) { fprintf(stderr, "kernel_launch: memset failed\n"); return; }
    Params p; memset(&p, 0, sizeof p);
    for (int i = 0; i < N_INPUTS; ++i) p.in[i] = (const float*)d_in[i];
    p.out = (float*)d_out; p.ws = (char*)d_ws;
    void* args[] = {&p};
    hipError_t e = hipLaunchCooperativeKernel((const void*)mega_kernel, dim3(grid_blocks), dim3(NTHR), args, LDS_BYTES, stream);
    if (e != hipSuccess) fprintf(stderr, "kernel_launch: cooperative launch failed: %s (grid %d)\n", hipGetErrorString(e), grid_blocks);
}
```
